# Optimizing an MI355X kernel written in HIP

```python
import math
import jax, jax.numpy as jnp
from jax import lax
import numpy as np

D_MODEL = 2048
BATCH = 2
SEQ = 4096
DEPTH = 2

MIX_WIDTH = D_MODEL // 2
N_BRANCH = 4
EPS = 1e-6

LRU_WIDTH = MIX_WIDTH
LRU_BLOCKS = 8
LRU_BLOCK = LRU_WIDTH // LRU_BLOCKS
CONV_WIDTH = 4
LRU_C = 8.0

RET_HEADS = 8
RET_QK_DIM = MIX_WIDTH // (2 * RET_HEADS)
RET_V_DIM = MIX_WIDTH // RET_HEADS
RET_CHUNK = 128
ROPE_THETA = 10000.0

SGU_WIDTH = MIX_WIDTH
SGU_GROUPS = 8
SGU_CHUNK = 128

RWKV_HEAD_DIM = 64
RWKV_HEADS = MIX_WIDTH // RWKV_HEAD_DIM
DECAY_LORA = 64
ICLR_LORA = 64
GATE_LORA = 128
RWKV_FEAT = 3 * MIX_WIDTH + 2 * DECAY_LORA + 2 * ICLR_LORA + GATE_LORA
DECAY_SCALE = math.exp(-0.5)

N_GROUPS = 4
EXPERTS_PER_GROUP = 8
N_EXPERTS = N_GROUPS * EXPERTS_PER_GROUP
TOP_K = 2
EXPERT_HIDDEN = D_MODEL // 4
MOE_BLOCK = 256

IN_SPLITS = (LRU_WIDTH, LRU_WIDTH,
             RET_HEADS * RET_QK_DIM, RET_HEADS * RET_QK_DIM, RET_HEADS * RET_V_DIM, RET_HEADS * RET_V_DIM,
             SGU_WIDTH, SGU_WIDTH,
             RWKV_FEAT,
             N_BRANCH * D_MODEL)
IN_WIDTH = sum(IN_SPLITS)

kernel_name = "hybrid_bidir_lru_ret_sgu_rwkv7_hmoe"

F32 = jnp.float32


def rms_norm(x, g):
    xf = x.astype(F32)
    y = xf * lax.rsqrt(jnp.mean(xf * xf, axis=-1, keepdims=True) + EPS)
    return (y * g.astype(F32)).astype(x.dtype)


def head_norm(x):
    xf = x.astype(F32)
    mu = jnp.mean(xf, axis=-1, keepdims=True)
    var = jnp.mean(jnp.square(xf - mu), axis=-1, keepdims=True)
    return ((xf - mu) * lax.rsqrt(var + EPS)).astype(x.dtype)


def rope(x, cos, sin):
    x1, x2 = jnp.split(x, 2, axis=-1)
    return jnp.concatenate([x1 * cos - x2 * sin, x2 * cos + x1 * sin], axis=-1)


def linear_scan_combine(left, right):
    a_l, b_l = left
    a_r, b_r = right
    return a_l * a_r, a_r * b_l + b_r


def rglru_branch(x_in, gate_in, conv_w, conv_b, w_r, b_r, w_i, b_i, lam):
    B, S, W = x_in.shape
    xc = lax.conv_general_dilated(
        x_in, conv_w[:, None, :], window_strides=(1,),
        padding=[(CONV_WIDTH // 2, CONV_WIDTH - 1 - CONV_WIDTH // 2)],
        dimension_numbers=("NWC", "WIO", "NWC"), feature_group_count=W) + conv_b
    xf = xc.astype(F32)
    xb = xf.reshape(B, S, LRU_BLOCKS, LRU_BLOCK)
    r = jax.nn.sigmoid(jnp.einsum("bsne,znef->zbsnf", xb, w_r.astype(F32)).reshape(2, B, S, W) + b_r[:, None, None, :])
    i = jax.nn.sigmoid(jnp.einsum("bsne,znef->zbsnf", xb, w_i.astype(F32)).reshape(2, B, S, W) + b_i[:, None, None, :])
    log_a = -LRU_C * r * jax.nn.softplus(-lam.astype(F32))[:, None, None, :]
    a = jnp.exp(log_a)
    u = jnp.sqrt(-jnp.expm1(2.0 * log_a)) * i * xf[None]
    _, h_fwd = lax.associative_scan(linear_scan_combine, (a[0], u[0]), axis=1)
    _, h_bwd = lax.associative_scan(linear_scan_combine, (a[1], u[1]), axis=1, reverse=True)
    return (h_fwd + h_bwd).astype(x_in.dtype) * jax.nn.gelu(gate_in)


def retention_branch(q, k, v, g, cos, sin):
    B, S, _ = q.shape
    H, dk, dv, C = RET_HEADS, RET_QK_DIM, RET_V_DIM, RET_CHUNK
    N = S // C
    q = rope(q.reshape(B, S, H, dk), cos, sin) * (dk ** -0.5)
    k = rope(k.reshape(B, S, H, dk), cos, sin)
    qc = q.reshape(B, N, C, H, dk).astype(F32)
    kc = k.reshape(B, N, C, H, dk).astype(F32)
    vc = v.reshape(B, N, C, H, dv).astype(F32)
    log_gamma = jnp.log1p(-jnp.exp2(-5.0 - jnp.arange(H, dtype=F32)))
    pos = jnp.arange(C, dtype=F32)

    def dec(p):
        return jnp.exp(p[:, None] * log_gamma[None, :])[..., None]

    intra = jnp.exp(jnp.abs(pos[:, None] - pos[None, :])[None] * log_gamma[:, None, None])
    scores = jnp.einsum("bnihd,bnjhd->bnhij", qc, kc) * intra
    o = jnp.einsum("bnhij,bnjhe->bnihe", scores, vc)
    kv_fwd = jnp.einsum("bnjhd,bnjhe->nbhde", kc * dec(C - 1 - pos), vc)
    kv_bwd = jnp.einsum("bnjhd,bnjhe->nbhde", kc * dec(pos), vc)
    chunk_decay = jnp.exp(C * log_gamma)[None, :, None, None]

    def carry_step(state, kv):
        return chunk_decay * state + kv, state

    zero = jnp.zeros((B, H, dk, dv), F32)
    _, st_fwd = lax.scan(carry_step, zero, kv_fwd)
    _, st_bwd = lax.scan(carry_step, zero, kv_bwd, reverse=True)
    o = (o + jnp.einsum("bnihd,nbhde->bnihe", qc * dec(pos + 1.0), st_fwd)
           + jnp.einsum("bnihd,nbhde->bnihe", qc * dec(C - pos), st_bwd))
    o = head_norm(o.reshape(B, S, H, dv)).reshape(B, S, H * dv)
    return jax.nn.silu(g) * o.astype(g.dtype)


def spatial_gating_branch(u, v, norm_g, w_s, b_s):
    B, S, W = u.shape
    N = S // SGU_CHUNK
    u = jax.nn.gelu(u)
    v = head_norm(jax.nn.gelu(v)) * norm_g
    vc = v.reshape(B, N, SGU_CHUNK, SGU_GROUPS, W // SGU_GROUPS)
    mixed = jnp.einsum("gij,bnjgd->bnigd", w_s, vc) + b_s.T[:, :, None]
    return u * mixed.reshape(B, S, W)


def rwkv7_branch(feat, mu_prev, mu_next, w0, w_up, a0, a_up, g_up, k_k, k_a, r_k):
    B, S, _ = feat.shape
    H, hd, W = RWKV_HEADS, RWKV_HEAD_DIM, MIX_WIDTH
    zero = jnp.zeros_like(feat[:, :1])
    prev = jnp.concatenate([zero, feat[:, :-1]], axis=1)
    nxt = jnp.concatenate([feat[:, 1:], zero], axis=1)
    feat = feat + mu_prev * (prev - feat) + mu_next * (nxt - feat)
    r, k, v, wd, ad, gd = jnp.split(
        feat, [W, 2 * W, 3 * W, 3 * W + 2 * DECAY_LORA, 3 * W + 2 * DECAY_LORA + 2 * ICLR_LORA], axis=-1)
    w_raw = jnp.einsum("bszr,zrw->zbsw", jnp.tanh(wd.reshape(B, S, 2, DECAY_LORA)), w_up) + w0[:, None, None, :]
    decay = jnp.exp(-DECAY_SCALE * jax.nn.sigmoid(w_raw.astype(F32)))
    a = jax.nn.sigmoid((jnp.einsum("bszr,zrw->zbsw", ad.reshape(B, S, 2, ICLR_LORA), a_up)
                        + a0[:, None, None, :]).astype(F32))
    g = jax.nn.sigmoid(gd) @ g_up
    kk = (k * k_k).reshape(B, S, H, hd).astype(F32)
    kk = kk * lax.rsqrt(jnp.sum(kk * kk, axis=-1, keepdims=True) + EPS)
    k_t = k.astype(F32)[None] * (1.0 + (a - 1.0) * k_a.astype(F32))
    rf = r.astype(F32).reshape(B, S, H, hd)
    vf = v.astype(F32).reshape(B, S, H, hd)

    def shared(t):
        return jnp.stack([t, jnp.flip(t, 1)])

    def own(t):
        return jnp.stack([t[0], jnp.flip(t[1], 1)]).reshape(2, B, S, H, hd)

    seq_in = (shared(rf), own(decay), shared(kk), own(a), own(k_t), shared(vf))
    seq_in = tuple(jnp.moveaxis(t, 2, 0) for t in seq_in)

    def step(state, inp):
        r_t, w_t, kk_t, a_t, k_tt, v_t = inp
        removal = jnp.einsum("zbhvk,zbhk->zbhv", state, kk_t)
        state = (state * w_t[..., None, :] - removal[..., None] * (a_t * kk_t)[..., None, :]
                 + v_t[..., None] * k_tt[..., None, :])
        return state, jnp.einsum("zbhvk,zbhk->zbhv", state, r_t)

    _, y = lax.scan(step, jnp.zeros((2, B, H, hd, hd), F32), seq_in)
    y = jnp.moveaxis(y, 0, 2)
    y = jnp.stack([y[0], jnp.flip(y[1], 1)])
    bonus = jnp.sum(rf[None] * k_t.reshape(2, B, S, H, hd) * r_k, axis=-1, keepdims=True) * vf[None]
    o = jnp.sum(head_norm(y) + bonus, axis=0).reshape(B, S, W)
    return o.astype(feat.dtype) * g


def hierarchical_moe(h, w_grp, b_grp, w_exp, b_exp, w_gu, w_down):
    B, S, D = h.shape
    T = B * S
    hf = h.reshape(T, D)
    grp_prob = jax.nn.softmax((hf @ w_grp + b_grp).astype(F32), axis=-1)
    grp_p, grp_i = lax.top_k(grp_prob, 1)
    exp_logits = (hf @ w_exp + b_exp).astype(F32).reshape(T, N_GROUPS, EXPERTS_PER_GROUP)
    in_group = exp_logits[jnp.arange(T), grp_i[:, 0]]
    top_p, top_i = lax.top_k(jax.nn.softmax(in_group, axis=-1), TOP_K)
    weights = grp_p * top_p / jnp.sum(top_p, axis=-1, keepdims=True)
    flat_e = (grp_i * EXPERTS_PER_GROUP + top_i).reshape(T * TOP_K)

    A = T * TOP_K
    order = jnp.argsort(flat_e)
    sorted_e = flat_e[order]
    counts = jnp.zeros((N_EXPERTS,), jnp.int32).at[flat_e].add(1)
    padded = (counts + MOE_BLOCK - 1) // MOE_BLOCK * MOE_BLOCK
    pad_end = jnp.cumsum(padded)
    pad_start = pad_end - padded
    start = jnp.cumsum(counts) - counts
    dest_sorted = pad_start[sorted_e] + jnp.arange(A, dtype=jnp.int32) - start[sorted_e]
    n_blocks = -(-A // MOE_BLOCK) + N_EXPERTS
    cap = n_blocks * MOE_BLOCK
    slot_token = jnp.full((cap,), T, jnp.int32).at[dest_sorted].set((order // TOP_K).astype(jnp.int32))
    block_expert = jnp.minimum(
        jnp.searchsorted(pad_end, jnp.arange(n_blocks, dtype=jnp.int32) * MOE_BLOCK, side="right"), N_EXPERTS - 1)
    x_pad = jnp.concatenate([hf, jnp.zeros((1, D), hf.dtype)], axis=0)
    xs = x_pad[slot_token].reshape(n_blocks, MOE_BLOCK, D)

    def expert_block(args):
        xb, e = args
        gate, up = jnp.split(xb @ w_gu[e], 2, axis=-1)
        return (jax.nn.silu(gate) * up) @ w_down[e]

    ys = lax.map(expert_block, (xs, block_expert)).reshape(cap, D)
    dest = jnp.zeros((A,), jnp.int32).at[order].set(dest_sorted)
    y_assign = ys[dest].reshape(T, TOP_K, D)
    return jnp.einsum("tk,tkd->td", weights.astype(hf.dtype), y_assign).reshape(B, S, D)


def setup_inputs(seed: int = 0) -> dict:
    key = jax.random.key(seed)
    ks = iter(jax.random.split(key, 48))
    L, D, W = DEPTH, D_MODEL, MIX_WIDTH

    def nrm(shape, scale):
        return scale * jax.random.normal(next(ks), shape, F32)

    def unif(shape, lo, hi):
        return jax.random.uniform(next(ks), shape, F32, lo, hi)

    lru_p = unif((L, 2, W), 0.9, 0.999) ** (1.0 / LRU_C)
    return {
        "x": nrm((BATCH, SEQ, D), 1.0),
        "c": nrm((BATCH, D), 1.0),
        "positions": jnp.broadcast_to(jnp.arange(SEQ, dtype=jnp.int32), (BATCH, SEQ)),
        "norm1_g": 1.0 + nrm((L, D), 0.02),
        "norm2_g": 1.0 + nrm((L, D), 0.02),
        "ada_w": nrm((L, D, 6 * D), 0.5 * D ** -0.5),
        "ada_b": nrm((L, 6 * D), 0.02),
        "w_in": nrm((L, D, IN_WIDTH), D ** -0.5),
        "lru_conv_w": nrm((L, CONV_WIDTH, W), CONV_WIDTH ** -0.5),
        "lru_conv_b": nrm((L, W), 0.02),
        "lru_w_r": nrm((L, 2, LRU_BLOCKS, LRU_BLOCK, LRU_BLOCK), LRU_BLOCK ** -0.5),
        "lru_b_r": nrm((L, 2, W), 0.1),
        "lru_w_i": nrm((L, 2, LRU_BLOCKS, LRU_BLOCK, LRU_BLOCK), LRU_BLOCK ** -0.5),
        "lru_b_i": nrm((L, 2, W), 0.1),
        "lru_lambda": jnp.log(lru_p) - jnp.log1p(-lru_p),
        "sgu_norm_g": 1.0 + nrm((L, W), 0.02),
        "sgu_w": nrm((L, SGU_GROUPS, SGU_CHUNK, SGU_CHUNK), 0.5 * SGU_CHUNK ** -0.5),
        "sgu_b": 1.0 + nrm((L, SGU_GROUPS, SGU_CHUNK), 0.1),
        "rwkv_mu_prev": unif((L, RWKV_FEAT), 0.0, 0.5),
        "rwkv_mu_next": unif((L, RWKV_FEAT), 0.0, 0.5),
        "rwkv_w0": -1.0 + nrm((L, 2, W), 0.5),
        "rwkv_w_up": nrm((L, 2, DECAY_LORA, W), 0.3 * DECAY_LORA ** -0.5),
        "rwkv_a0": nrm((L, 2, W), 0.5),
        "rwkv_a_up": nrm((L, 2, ICLR_LORA, W), 0.3 * ICLR_LORA ** -0.5),
        "rwkv_g_up": nrm((L, GATE_LORA, W), GATE_LORA ** -0.5),
        "rwkv_k_k": 0.85 + nrm((L, W), 0.05),
        "rwkv_k_a": 1.0 + nrm((L, W), 0.05),
        "rwkv_r_k": nrm((L, RWKV_HEADS, RWKV_HEAD_DIM), 0.1),
        "w_branch": nrm((L, N_BRANCH, W, D), W ** -0.5),
        "w_out": nrm((L, D, D), D ** -0.5),
        "router_grp_w": nrm((L, D, N_GROUPS), D ** -0.5),
        "router_grp_b": nrm((L, N_GROUPS), 0.01),
        "router_exp_w": nrm((L, D, N_EXPERTS), D ** -0.5),
        "router_exp_b": nrm((L, N_EXPERTS), 0.01),
        "expert_w_gu": nrm((L, N_EXPERTS, D, 2 * EXPERT_HIDDEN), D ** -0.5),
        "expert_w_down": nrm((L, N_EXPERTS, EXPERT_HIDDEN, D), EXPERT_HIDDEN ** -0.5),
        "final_norm_g": 1.0 + nrm((D,), 0.02),
    }


def reference(x, c, positions, norm1_g, norm2_g, ada_w, ada_b, w_in,
              lru_conv_w, lru_conv_b, lru_w_r, lru_b_r, lru_w_i, lru_b_i, lru_lambda,
              sgu_norm_g, sgu_w, sgu_b,
              rwkv_mu_prev, rwkv_mu_next, rwkv_w0, rwkv_w_up, rwkv_a0, rwkv_a_up, rwkv_g_up,
              rwkv_k_k, rwkv_k_a, rwkv_r_k,
              w_branch, w_out,
              router_grp_w, router_grp_b, router_exp_w, router_exp_b, expert_w_gu, expert_w_down,
              final_norm_g):
    B, S, D = x.shape
    inv_freq = ROPE_THETA ** (-jnp.arange(0, RET_QK_DIM, 2, dtype=F32) / RET_QK_DIM)
    ang = positions.astype(F32)[..., None] * inv_freq
    cos = jnp.cos(ang)[:, :, None, :].astype(x.dtype)
    sin = jnp.sin(ang)[:, :, None, :].astype(x.dtype)
    cond = jax.nn.silu(c)
    split_points = np.cumsum(IN_SPLITS)[:-1].tolist()
    for l in range(DEPTH):
        mod = cond @ ada_w[l] + ada_b[l]
        sh1, sc1, g1, sh2, sc2, g2 = [m[:, None, :] for m in jnp.split(mod, 6, axis=-1)]

        h = rms_norm(x, norm1_g[l]) * (1.0 + sc1) + sh1
        (lru_x, lru_g, ret_q, ret_k, ret_v, ret_g, sgu_u, sgu_v, rwkv_feat,
         merge_logits) = jnp.split(h @ w_in[l], split_points, axis=-1)
        y_a = rglru_branch(lru_x, lru_g, lru_conv_w[l], lru_conv_b[l], lru_w_r[l], lru_b_r[l],
                           lru_w_i[l], lru_b_i[l], lru_lambda[l])
        y_b = retention_branch(ret_q, ret_k, ret_v, ret_g, cos, sin)
        y_c = spatial_gating_branch(sgu_u, sgu_v, sgu_norm_g[l], sgu_w[l], sgu_b[l])
        y_d = rwkv7_branch(rwkv_feat, rwkv_mu_prev[l], rwkv_mu_next[l], rwkv_w0[l], rwkv_w_up[l],
                           rwkv_a0[l], rwkv_a_up[l], rwkv_g_up[l], rwkv_k_k[l], rwkv_k_a[l], rwkv_r_k[l])
        ys = jnp.stack([y_a, y_b, y_c, y_d], axis=2)
        branches = jnp.einsum("bsnw,nwd->bsnd", ys, w_branch[l])
        gates = jax.nn.sigmoid(merge_logits.reshape(B, S, N_BRANCH, D))
        merged = jnp.einsum("bsnd,bsnd->bsd", gates, branches)
        x = x + g1 * (merged @ w_out[l])

        h = rms_norm(x, norm2_g[l]) * (1.0 + sc2) + sh2
        x = x + g2 * hierarchical_moe(h, router_grp_w[l], router_grp_b[l], router_exp_w[l],
                                      router_exp_b[l], expert_w_gu[l], expert_w_down[l])
    return rms_norm(x, final_norm_g)
```

```cpp
#ifndef CPU_EMU
#include <hip/hip_runtime.h>
#endif
#include <cstdio>
#include <cstdint>
#include <cmath>

#ifndef SEQ
#define SEQ 4096
#endif
#ifndef ONE_LAUNCH
#define ONE_LAUNCH 1
#endif

namespace {
constexpr int D = 2048, NB = 2, S = SEQ, T = NB * S, NL = 2, W = 1024;
constexpr int INW = 18816, RF = 3456, D6 = 6 * D;
constexpr int C_LX = 0, C_LG = 1024, C_RQ = 2048, C_RK = 2560, C_RV = 3072, C_RG = 4096, C_SU = 5120, C_SV = 6144, C_RW = 7168, C_ML = 10624;
constexpr int NCH = S / 128;
constexpr int NLC = S / 64;
constexpr int NE = 32, CAP = (T * 2 / 256 + NE) * 256, MAXBLK = CAP / 256;
constexpr float EPS = 1e-6f;
constexpr float DECAY_SCALE = 0.60653065971263342f;
constexpr int NT = 512;
constexpr int NPH_LAYER = 31, NPH = 1 + NL * NPH_LAYER + 1;

constexpr size_t al256(size_t x) { return (x + 255) & ~(size_t)255; }
constexpr size_t SZ_X = (size_t)T * D * 4, SZ_W = (size_t)T * W * 4;
constexpr size_t O_CTL = 0, CTL_BYTES = 1u << 20;
constexpr size_t O_MOD = CTL_BYTES;
constexpr size_t O_X0 = O_MOD + al256((size_t)NL * NB * D6 * 4);
constexpr size_t O_X1 = O_X0 + SZ_X, O_X2 = O_X1 + SZ_X, O_X3 = O_X2 + SZ_X;
constexpr size_t O_H = O_X3 + SZ_X;
constexpr size_t O_P = O_H + SZ_X;
constexpr size_t SZ_P = (size_t)T * INW * 4;
constexpr size_t O_XC = O_P + SZ_P;
constexpr size_t O_LA = O_XC + SZ_W, O_LU = O_LA + 2 * SZ_W;
constexpr size_t SZ_LC = (size_t)2 * NB * NLC * W * 4;
constexpr size_t O_LCA = O_LU + 2 * SZ_W, O_LCH = O_LCA + SZ_LC, O_LCI = O_LCH + SZ_LC;
constexpr size_t O_YS = O_LCI + SZ_LC;
constexpr size_t O_QR = O_YS + 4 * SZ_W, O_KR = O_QR + (size_t)T * 512 * 4;
constexpr size_t O_SC = O_KR + (size_t)T * 512 * 4;
constexpr size_t SZ_KV = (size_t)NB * NCH * 8 * 64 * 128 * 4;
constexpr size_t O_KVF = O_SC + (size_t)T * 8 * 128 * 4, O_KVB = O_KVF + SZ_KV, O_STF = O_KVB + SZ_KV, O_STB = O_STF + SZ_KV;
constexpr size_t O_VN = O_STB + SZ_KV;
constexpr size_t O_FS = O_VN + SZ_W;
constexpr size_t O_DEC = O_FS + al256((size_t)T * RF * 4), O_AA = O_DEC + 2 * SZ_W, O_KT = O_AA + 2 * SZ_W, O_AKK = O_KT + 2 * SZ_W;
constexpr size_t O_GG = O_AKK + 2 * SZ_W, O_KK = O_GG + SZ_W, O_YY = O_KK + SZ_W;
constexpr size_t O_BON = O_YY + 2 * SZ_W;
constexpr size_t O_MRG = O_BON + al256((size_t)2 * T * 16 * 4);
constexpr size_t O_LOG = O_MRG + SZ_X;
constexpr size_t O_EID = O_LOG + al256((size_t)T * 40 * 4), O_EWT = O_EID + al256((size_t)T * 2 * 4), O_DEST = O_EWT + al256((size_t)T * 2 * 4);
constexpr size_t O_SLOT = O_DEST + al256((size_t)T * 2 * 4);
constexpr size_t WS_END0 = O_SLOT + al256((size_t)CAP * 4);
constexpr size_t SZ_MOE = (size_t)CAP * (1024 + 512 + D) * 4;
constexpr bool MOE_OVERLAY = SZ_MOE <= SZ_P;
constexpr size_t O_GU = MOE_OVERLAY ? O_P : WS_END0, O_ACT = O_GU + (size_t)CAP * 1024 * 4, O_YE = O_ACT + (size_t)CAP * 512 * 4;
constexpr size_t WS_END = MOE_OVERLAY ? WS_END0 : WS_END0 + SZ_MOE;
constexpr int CW_BAR = 4096;
constexpr int CW_CNT = 32768;
constexpr int CW_FILL = CW_CNT + NL * 64;
constexpr int CW_PLAN = CW_FILL + NL * 64;
static_assert(MAXBLK <= 160, "plan words");

struct Params { const float* in[37]; float* out; unsigned char* ws; int ph_lo, ph_hi; };

struct Ctx { const float* const* in; float* out; unsigned char* ws; long gt, gs; };
#define WSF(off) ((float*)(c.ws + (off)))
#define WSI(off) ((int*)(c.ws + (off)))
#define CTLW(c) ((int*)((c).ws + O_CTL))

__device__ __forceinline__ float sigmoidf_(float x) { return 1.f / (1.f + expf(-x)); }
__device__ __forceinline__ float siluf_(float x) { return x / (1.f + expf(-x)); }
__device__ __forceinline__ float geluf_(float x) { return 0.5f * x * (1.f + tanhf(0.7978845608028654f * (x + 0.044715f * x * x * x))); }
__device__ __forceinline__ float softplusf_(float x) { return x > 0.f ? x + log1pf(expf(-x)) : log1pf(expf(x)); }
__device__ __forceinline__ float loggamma_(int h) { return log1pf(-exp2f(-5.f - (float)h)); }
__device__ __forceinline__ int atomic_add_i(int* p, int v) {
#ifdef CPU_EMU
    return __atomic_fetch_add(p, v, __ATOMIC_RELAXED);
#else
    return atomicAdd(p, v);
#endif
}

__device__ __forceinline__ void ph_mod(const Ctx& c) {
    const float* cc = c.in[1]; const float* aw = c.in[5]; const float* ab = c.in[6]; float* mod = WSF(O_MOD);
    for (long i = c.gt; i < (long)NL * NB * D6; i += c.gs) {
        const int j = (int)(i % D6), b = (int)((i / D6) % NB), l = (int)(i / ((long)D6 * NB));
        const float* w = aw + (size_t)l * D * D6 + j; float acc = 0.f;
        for (int k = 0; k < D; ++k) acc += siluf_(cc[b * D + k]) * w[(size_t)k * D6];
        mod[i] = acc + ab[l * D6 + j];
    }
}
__device__ __forceinline__ void ph_norm(const Ctx& c, const float* x, const float* g, const float* sh, const float* sc, float* h) {
    for (long t = c.gt; t < T; t += c.gs) {
        const int b = (int)(t / S); const float* xr = x + (size_t)t * D; float ss = 0.f;
        for (int k = 0; k < D; ++k) ss += xr[k] * xr[k];
        const float rs = 1.f / sqrtf(ss / D + EPS);
        for (int k = 0; k < D; ++k) h[(size_t)t * D + k] = xr[k] * rs * g[k] * (1.f + sc[b * D6 + k]) + sh[b * D6 + k];
    }
}
__device__ __forceinline__ void ph_final(const Ctx& c, const float* x, const float* g, float* o) {
    for (long t = c.gt; t < T; t += c.gs) {
        const float* xr = x + (size_t)t * D; float ss = 0.f;
        for (int k = 0; k < D; ++k) ss += xr[k] * xr[k];
        const float rs = 1.f / sqrtf(ss / D + EPS);
        for (int k = 0; k < D; ++k) o[(size_t)t * D + k] = xr[k] * rs * g[k];
    }
}

template <int NSEG, class AL, class BL, class EP>
__device__ __forceinline__ void gemm_f32(const Ctx& c, float* lds, int mt, int ntl, int K, int ldb, const AL& al, const BL& bl, const EP& ep) {
    const int ntiles = mt * ntl;
    for (int tile = blockIdx.x; tile < ntiles; tile += gridDim.x) {
        const int tm = tile / ntl, tn = tile % ntl;
        if (!ep.active(tm)) continue;
#ifdef CPU_EMU
        if (threadIdx.x == 0) {
            for (int r = 0; r < 128; ++r) {
                const int row = tm * 128 + r; float accv[128], maccv[128];
                for (int q = 0; q < 128; ++q) maccv[q] = 0.f;
                for (int seg = 0; seg < NSEG; ++seg) {
                    const float* ap = al.arow(row, seg); const float* bp = bl.bbase(tm, seg) + tn * 128;
                    for (int q = 0; q < 128; ++q) accv[q] = 0.f;
                    if (ap) for (int k = 0; k < K; ++k) { const float av = ap[k]; const float* br = bp + (size_t)k * ldb; for (int q = 0; q < 128; ++q) accv[q] += av * br[q]; }
                    if (NSEG > 1) for (int q = 0; q < 128; ++q) maccv[q] += ep.segscale(row, tn * 128 + q, seg) * accv[q];
                }
                for (int q = 0; q < 128; ++q) ep.store(row, tn * 128 + q, NSEG > 1 ? maccv[q] : accv[q]);
            }
        }
#else
        float* As = lds; float* Bs = lds + 16 * 132;
        const int tid = threadIdx.x, ty = tid >> 5, tx = tid & 31;
        const int ar = tid >> 2, ak = (tid & 3) * 4, bk = tid >> 5, bc = (tid & 31) * 4;
        float acc[8][4], macc[8][4];
#pragma unroll
        for (int i = 0; i < 8; ++i)
#pragma unroll
            for (int j = 0; j < 4; ++j) { acc[i][j] = 0.f; macc[i][j] = 0.f; }
#pragma unroll 1
        for (int seg = 0; seg < NSEG; ++seg) {
            const float* ap = al.arow(tm * 128 + ar, seg);
            const float* bp = bl.bbase(tm, seg) + tn * 128 + bc;
#pragma unroll 1
            for (int k0 = 0; k0 < K; k0 += 16) {
                float4 av = make_float4(0.f, 0.f, 0.f, 0.f);
                if (ap) av = *(const float4*)(ap + k0 + ak);
                const float4 bv = *(const float4*)(bp + (size_t)(k0 + bk) * ldb);
                __syncthreads();
                As[(ak + 0) * 132 + ar] = av.x; As[(ak + 1) * 132 + ar] = av.y; As[(ak + 2) * 132 + ar] = av.z; As[(ak + 3) * 132 + ar] = av.w;
                *(float4*)&Bs[bk * 128 + bc] = bv;
                __syncthreads();
#pragma unroll 4
                for (int kk = 0; kk < 16; ++kk) {
                    const float4 a0 = *(const float4*)&As[kk * 132 + ty * 8], a1 = *(const float4*)&As[kk * 132 + ty * 8 + 4];
                    const float4 b4 = *(const float4*)&Bs[kk * 128 + tx * 4];
                    const float a[8] = {a0.x, a0.y, a0.z, a0.w, a1.x, a1.y, a1.z, a1.w}; const float b[4] = {b4.x, b4.y, b4.z, b4.w};
#pragma unroll
                    for (int i = 0; i < 8; ++i)
#pragma unroll
                        for (int j = 0; j < 4; ++j) acc[i][j] += a[i] * b[j];
                }
            }
            if (NSEG > 1) {
#pragma unroll
                for (int i = 0; i < 8; ++i) {
#pragma unroll
                    for (int j = 0; j < 4; ++j) { macc[i][j] += ep.segscale(tm * 128 + ty * 8 + i, tn * 128 + tx * 4 + j, seg) * acc[i][j]; acc[i][j] = 0.f; }
                    asm volatile("" ::: "memory");
                }
            }
        }
#pragma unroll
        for (int i = 0; i < 8; ++i) {
#pragma unroll
            for (int j = 0; j < 4; ++j) ep.store(tm * 128 + ty * 8 + i, tn * 128 + tx * 4 + j, NSEG > 1 ? macc[i][j] : acc[i][j]);
            asm volatile("" ::: "memory");
        }
        __syncthreads();
#endif
    }
}

struct ARows { const float* base; size_t ld; size_t segstride; __device__ __forceinline__ const float* arow(int r, int seg) const { return base + (size_t)seg * segstride + (size_t)r * ld; } };
struct AGather { const float* base; const int* slot; __device__ __forceinline__ const float* arow(int r, int) const { const int t = slot[r]; return t < T ? base + (size_t)t * D : nullptr; } };
struct BPlain { const float* base; size_t segstride; __device__ __forceinline__ const float* bbase(int, int seg) const { return base + (size_t)seg * segstride; } };
struct BExpert { const float* base; size_t estride; const int* blkexp; __device__ __forceinline__ const float* bbase(int tm, int) const { return base + (size_t)blkexp[tm >> 1] * estride; } };
struct EpStore { float* C; size_t ldc; __device__ __forceinline__ bool active(int) const { return true; } __device__ __forceinline__ float segscale(int, int, int) const { return 1.f; }
    __device__ __forceinline__ void store(int r, int cc, float v) const { C[(size_t)r * ldc + cc] = v; } };
struct EpMerge { float* C; const float* P; __device__ __forceinline__ bool active(int) const { return true; }
    __device__ __forceinline__ float segscale(int r, int cc, int seg) const { return sigmoidf_(P[(size_t)r * INW + C_ML + seg * D + cc]); }
    __device__ __forceinline__ void store(int r, int cc, float v) const { C[(size_t)r * D + cc] = v; } };
struct EpResid { float* C; const float* xin; const float* g; __device__ __forceinline__ bool active(int) const { return true; } __device__ __forceinline__ float segscale(int, int, int) const { return 1.f; }
    __device__ __forceinline__ void store(int r, int cc, float v) const { C[(size_t)r * D + cc] = xin[(size_t)r * D + cc] + g[(r / S) * D6 + cc] * v; } };
struct EpMoe { float* C; size_t ldc; const int* nblk; __device__ __forceinline__ bool active(int tm) const { return (tm >> 1) < *nblk; } __device__ __forceinline__ float segscale(int, int, int) const { return 1.f; }
    __device__ __forceinline__ void store(int r, int cc, float v) const { C[(size_t)r * ldc + cc] = v; } };

__device__ __forceinline__ void ph_lru_conv(const Ctx& c, int l) {
    const float* cw = c.in[8] + (size_t)l * 4 * W; const float* cb = c.in[9] + (size_t)l * W; const float* P = WSF(O_P); float* XC = WSF(O_XC);
    for (long i = c.gt; i < (long)T * W; i += c.gs) {
        const int w = (int)(i % W); const long t = i / W; const int s = (int)(t % S); float acc = cb[w];
        for (int k = 0; k < 4; ++k) { const int ss = s + k - 2; if (ss >= 0 && ss < S) acc += P[(size_t)(t + k - 2) * INW + C_LX + w] * cw[k * W + w]; }
        XC[i] = acc;
    }
}
__device__ __forceinline__ void ph_lru_gate(const Ctx& c, int l) {
    const float* wr = c.in[10] + (size_t)l * 2 * 8 * 128 * 128; const float* br = c.in[11] + (size_t)l * 2 * W;
    const float* wi = c.in[12] + (size_t)l * 2 * 8 * 128 * 128; const float* bi = c.in[13] + (size_t)l * 2 * W; const float* lam = c.in[14] + (size_t)l * 2 * W;
    const float* XC = WSF(O_XC); float* LA = WSF(O_LA); float* LU = WSF(O_LU);
    for (long i = c.gt; i < (long)2 * T * W; i += c.gs) {
        const int w = (int)(i % W); const long t = (i / W) % T; const int z = (int)(i / ((long)W * T));
        const int n = w >> 7, f = w & 127; const float* xr = XC + (size_t)t * W + n * 128;
        const float* wrp = wr + ((size_t)(z * 8 + n) * 128) * 128 + f; const float* wip = wi + ((size_t)(z * 8 + n) * 128) * 128 + f;
        float ra = 0.f, ia = 0.f;
        for (int e = 0; e < 128; ++e) { const float xv = xr[e]; ra += xv * wrp[e * 128]; ia += xv * wip[e * 128]; }
        const float r = sigmoidf_(ra + br[z * W + w]), ig = sigmoidf_(ia + bi[z * W + w]);
        const float la = -8.f * r * softplusf_(-lam[z * W + w]);
        LA[i] = expf(la); LU[i] = sqrtf(-expm1f(2.f * la)) * ig * XC[(size_t)t * W + w];
    }
}
__device__ __forceinline__ void ph_lru_scan1(const Ctx& c) {
    const float* LA = WSF(O_LA); const float* LU = WSF(O_LU); float* CA = WSF(O_LCA); float* CH = WSF(O_LCH);
    for (long i = c.gt; i < (long)2 * NB * NLC * W; i += c.gs) {
        const int w = (int)(i % W), ch = (int)((i / W) % NLC), b = (int)((i / ((long)W * NLC)) % NB), z = (int)(i / ((long)W * NLC * NB));
        const long t0 = (long)b * S + ch * 64; float prod = 1.f, h = 0.f;
        for (int q = 0; q < 64; ++q) { const int s = z == 0 ? q : 63 - q; const size_t idx = ((size_t)z * T + t0 + s) * W + w; const float a = LA[idx]; h = a * h + LU[idx]; prod *= a; }
        CA[i] = prod; CH[i] = h;
    }
}
__device__ __forceinline__ void ph_lru_scan2(const Ctx& c) {
    const float* CA = WSF(O_LCA); const float* CH = WSF(O_LCH); float* CI = WSF(O_LCI);
    for (long i = c.gt; i < (long)2 * NB * W; i += c.gs) {
        const int w = (int)(i % W), b = (int)((i / W) % NB), z = (int)(i / ((long)W * NB)); float carry = 0.f;
        for (int q = 0; q < NLC; ++q) { const int ch = z == 0 ? q : NLC - 1 - q; const size_t idx = (((size_t)z * NB + b) * NLC + ch) * W + w; CI[idx] = carry; carry = CA[idx] * carry + CH[idx]; }
    }
}
__device__ __forceinline__ void ph_lru_scan3(const Ctx& c) {
    const float* LA = WSF(O_LA); const float* LU = WSF(O_LU); const float* CI = WSF(O_LCI); const float* P = WSF(O_P); float* Y = WSF(O_YS);
    for (long i = c.gt; i < (long)NB * NLC * W; i += c.gs) {
        const int w = (int)(i % W), ch = (int)((i / W) % NLC), b = (int)(i / ((long)W * NLC)); const long t0 = (long)b * S + ch * 64;
        float h = CI[(((size_t)0 * NB + b) * NLC + ch) * W + w];
        for (int s = 0; s < 64; ++s) { const size_t idx = ((size_t)(t0 + s)) * W + w; h = LA[idx] * h + LU[idx]; Y[idx] = h; }
        h = CI[(((size_t)1 * NB + b) * NLC + ch) * W + w];
        for (int s = 63; s >= 0; --s) { const size_t idx = ((size_t)(t0 + s)) * W + w; h = LA[(size_t)T * W + idx] * h + LU[(size_t)T * W + idx];
            Y[idx] = (Y[idx] + h) * geluf_(P[(size_t)(t0 + s) * INW + C_LG + w]); }
    }
}
__device__ __forceinline__ void ph_ret_rope(const Ctx& c) {
    const int* pos = (const int*)c.in[2]; const float* P = WSF(O_P); float* QR = WSF(O_QR); float* KR = WSF(O_KR);
    for (long i = c.gt; i < (long)T * 8 * 32; i += c.gs) {
        const int j = (int)(i % 32), h = (int)((i / 32) % 8); const long t = i / 256;
        const float inv = powf(10000.f, -(float)(2 * j) / 64.f), ang = (float)pos[t] * inv, cs = cosf(ang), sn = sinf(ang);
        const float q1 = P[(size_t)t * INW + C_RQ + h * 64 + j], q2 = P[(size_t)t * INW + C_RQ + h * 64 + j + 32];
        const float k1 = P[(size_t)t * INW + C_RK + h * 64 + j], k2 = P[(size_t)t * INW + C_RK + h * 64 + j + 32];
        QR[(size_t)t * 512 + h * 64 + j] = (q1 * cs - q2 * sn) * 0.125f; QR[(size_t)t * 512 + h * 64 + j + 32] = (q2 * cs + q1 * sn) * 0.125f;
        KR[(size_t)t * 512 + h * 64 + j] = k1 * cs - k2 * sn; KR[(size_t)t * 512 + h * 64 + j + 32] = k2 * cs + k1 * sn;
    }
}
__device__ __forceinline__ void ph_ret_kv(const Ctx& c) {
    const float* P = WSF(O_P); const float* KR = WSF(O_KR); float* KVF = WSF(O_KVF); float* KVB = WSF(O_KVB);
    for (long i = c.gt; i < (long)NB * NCH * 8 * 64 * 128; i += c.gs) {
        const int e = (int)(i % 128), d = (int)((i / 128) % 64), h = (int)((i / 8192) % 8), n = (int)((i / 65536) % NCH), b = (int)(i / ((long)65536 * NCH));
        const long t0 = (long)b * S + n * 128; const float lg = loggamma_(h); float f = 0.f, bw = 0.f;
        for (int j = 0; j < 128; ++j) { const float kd = KR[(size_t)(t0 + j) * 512 + h * 64 + d], v = P[(size_t)(t0 + j) * INW + C_RV + h * 128 + e];
            f += kd * expf((float)(127 - j) * lg) * v; bw += kd * expf((float)j * lg) * v; }
        KVF[i] = f; KVB[i] = bw;
    }
}
__device__ __forceinline__ void ph_ret_state(const Ctx& c) {
    const float* KVF = WSF(O_KVF); const float* KVB = WSF(O_KVB); float* STF = WSF(O_STF); float* STB = WSF(O_STB);
    for (long i = c.gt; i < (long)NB * 8 * 64 * 128; i += c.gs) {
        const int e = (int)(i % 128), d = (int)((i / 128) % 64), h = (int)((i / 8192) % 8), b = (int)(i / 65536);
        const float cd = expf(128.f * loggamma_(h)); float st = 0.f;
        for (int n = 0; n < NCH; ++n) { const size_t idx = ((((size_t)b * NCH + n) * 8 + h) * 64 + d) * 128 + e; STF[idx] = st; st = cd * st + KVF[idx]; }
        st = 0.f;
        for (int n = NCH - 1; n >= 0; --n) { const size_t idx = ((((size_t)b * NCH + n) * 8 + h) * 64 + d) * 128 + e; STB[idx] = st; st = cd * st + KVB[idx]; }
    }
}
__device__ __forceinline__ void ph_ret_score(const Ctx& c) {
    const float* QR = WSF(O_QR); const float* KR = WSF(O_KR); float* SC = WSF(O_SC);
    for (long i = c.gt; i < (long)NB * NCH * 8 * 128 * 128; i += c.gs) {
        const int j = (int)(i % 128), ii = (int)((i / 128) % 128), h = (int)((i / 16384) % 8), n = (int)((i / 131072) % NCH), b = (int)(i / ((long)131072 * NCH));
        const long t0 = (long)b * S + n * 128; float s = 0.f;
        for (int d = 0; d < 64; ++d) s += QR[(size_t)(t0 + ii) * 512 + h * 64 + d] * KR[(size_t)(t0 + j) * 512 + h * 64 + d];
        const int dist = ii > j ? ii - j : j - ii;
        SC[i] = s * expf((float)dist * loggamma_(h));
    }
}
__device__ __forceinline__ void ph_ret_out1(const Ctx& c) {
    const float* P = WSF(O_P); const float* QR = WSF(O_QR); const float* SC = WSF(O_SC); const float* STF = WSF(O_STF); const float* STB = WSF(O_STB); float* Y = WSF(O_YS) + (size_t)1 * T * W;
    for (long i = c.gt; i < (long)T * 8 * 128; i += c.gs) {
        const int e = (int)(i % 128), h = (int)((i / 128) % 8); const long t = i / 1024; const int b = (int)(t / S), s = (int)(t % S), n = s >> 7, ii = s & 127; const long t0 = t - ii;
        const float* sc = SC + ((((size_t)b * NCH + n) * 8 + h) * 128 + ii) * 128; float o = 0.f;
        for (int j = 0; j < 128; ++j) o += sc[j] * P[(size_t)(t0 + j) * INW + C_RV + h * 128 + e];
        const size_t sb = ((((size_t)b * NCH + n) * 8 + h) * 64) * 128 + e; const float lg = loggamma_(h), qf = expf((float)(ii + 1) * lg), qb = expf((float)(128 - ii) * lg);
        for (int d = 0; d < 64; ++d) { const float q = QR[(size_t)t * 512 + h * 64 + d]; o += q * qf * STF[sb + (size_t)d * 128] + q * qb * STB[sb + (size_t)d * 128]; }
        Y[(size_t)t * W + h * 128 + e] = o;
    }
}
__device__ __forceinline__ void ph_ret_out2(const Ctx& c) {
    const float* P = WSF(O_P); float* Y = WSF(O_YS) + (size_t)1 * T * W;
    for (long i = c.gt; i < (long)T * 8; i += c.gs) {
        const int h = (int)(i % 8); const long t = i / 8; float* y = Y + (size_t)t * W + h * 128; float mu = 0.f, var = 0.f;
        for (int e = 0; e < 128; ++e) mu += y[e];
        mu *= (1.f / 128.f);
        for (int e = 0; e < 128; ++e) { const float dd = y[e] - mu; var += dd * dd; }
        const float rs = 1.f / sqrtf(var * (1.f / 128.f) + EPS);
        for (int e = 0; e < 128; ++e) y[e] = siluf_(P[(size_t)t * INW + C_RG + h * 128 + e]) * ((y[e] - mu) * rs);
    }
}
__device__ __forceinline__ void ph_sgu_norm(const Ctx& c, int l) {
    const float* P = WSF(O_P); const float* ng = c.in[15] + (size_t)l * W; float* VN = WSF(O_VN);
    for (long t = c.gt; t < T; t += c.gs) {
        const float* v = P + (size_t)t * INW + C_SV; float mu = 0.f, var = 0.f;
        for (int k = 0; k < W; ++k) mu += geluf_(v[k]);
        mu *= (1.f / W);
        for (int k = 0; k < W; ++k) { const float dd = geluf_(v[k]) - mu; var += dd * dd; }
        const float rs = 1.f / sqrtf(var * (1.f / W) + EPS);
        for (int k = 0; k < W; ++k) VN[(size_t)t * W + k] = (geluf_(v[k]) - mu) * rs * ng[k];
    }
}
__device__ __forceinline__ void ph_sgu_mix(const Ctx& c, int l) {
    const float* P = WSF(O_P); const float* VN = WSF(O_VN); float* Y = WSF(O_YS) + (size_t)2 * T * W;
    for (long i = c.gt; i < (long)T * W; i += c.gs) {
        const int cc = (int)(i % W); const long t = i / W; const int g = cc >> 7, ii = (int)((t % S) & 127); const long t0 = t - ii;
        const float* ws = c.in[16] + (size_t)l * 8 * 128 * 128 + ((size_t)g * 128 + ii) * 128; float m = c.in[17][(size_t)l * 8 * 128 + g * 128 + ii];
        for (int j = 0; j < 128; ++j) m += ws[j] * VN[(size_t)(t0 + j) * W + cc];
        Y[i] = geluf_(P[(size_t)t * INW + C_SU + cc]) * m;
    }
}
__device__ __forceinline__ void ph_rw_shift(const Ctx& c, int l) {
    const float* P = WSF(O_P); const float* mup = c.in[18] + (size_t)l * RF; const float* mun = c.in[19] + (size_t)l * RF; float* FS = WSF(O_FS);
    for (long i = c.gt; i < (long)T * RF; i += c.gs) {
        const int j = (int)(i % RF); const long t = i / RF; const int s = (int)(t % S);
        const float f = P[(size_t)t * INW + C_RW + j], pv = s > 0 ? P[(size_t)(t - 1) * INW + C_RW + j] : 0.f, nv = s < S - 1 ? P[(size_t)(t + 1) * INW + C_RW + j] : 0.f;
        float v = f + mup[j] * (pv - f) + mun[j] * (nv - f);
        if (j >= 3072 && j < 3200) v = tanhf(v); else if (j >= 3328) v = sigmoidf_(v);
        FS[i] = v;
    }
}
__device__ __forceinline__ void ph_rw_lora(const Ctx& c, int l) {
    const float* FS = WSF(O_FS); const float* w0 = c.in[20] + (size_t)l * 2 * W; const float* wup = c.in[21] + (size_t)l * 2 * 64 * W;
    const float* a0 = c.in[22] + (size_t)l * 2 * W; const float* aup = c.in[23] + (size_t)l * 2 * 64 * W; const float* gup = c.in[24] + (size_t)l * 128 * W;
    float* DEC = WSF(O_DEC); float* AA = WSF(O_AA); float* GG = WSF(O_GG);
    for (long i = c.gt; i < (long)T * W; i += c.gs) {
        const int w = (int)(i % W); const long t = i / W; const float* f = FS + (size_t)t * RF;
        for (int z = 0; z < 2; ++z) {
            float a1 = 0.f, a2 = 0.f;
            for (int r = 0; r < 64; ++r) { a1 += f[3072 + z * 64 + r] * wup[((size_t)z * 64 + r) * W + w]; a2 += f[3200 + z * 64 + r] * aup[((size_t)z * 64 + r) * W + w]; }
            DEC[((size_t)z * T + t) * W + w] = expf(-DECAY_SCALE * sigmoidf_(a1 + w0[z * W + w]));
            AA[((size_t)z * T + t) * W + w] = sigmoidf_(a2 + a0[z * W + w]);
        }
        float g = 0.f;
        for (int r = 0; r < 128; ++r) g += f[3328 + r] * gup[(size_t)r * W + w];
        GG[i] = g;
    }
}
__device__ __forceinline__ void ph_rw_prep(const Ctx& c, int l) {
    const float* FS = WSF(O_FS); const float* AA = WSF(O_AA); const float* kkw = c.in[25] + (size_t)l * W; const float* kaw = c.in[26] + (size_t)l * W; const float* rk = c.in[27] + (size_t)l * W;
    float* KK = WSF(O_KK); float* KT = WSF(O_KT); float* AKK = WSF(O_AKK); float* BON = WSF(O_BON);
    for (long i = c.gt; i < (long)T * 16; i += c.gs) {
        const int h = (int)(i % 16); const long t = i / 16; const float* f = FS + (size_t)t * RF; float ss = 0.f;
        for (int k = 0; k < 64; ++k) { const float v = f[1024 + h * 64 + k] * kkw[h * 64 + k]; ss += v * v; }
        const float rs = 1.f / sqrtf(ss + EPS); float b0 = 0.f, b1 = 0.f;
        for (int k = 0; k < 64; ++k) {
            const int ch = h * 64 + k; const float kv = f[1024 + ch], kkn = kv * kkw[ch] * rs, rr = f[ch] * rk[ch];
            KK[(size_t)t * W + ch] = kkn;
            const float aa0 = AA[(size_t)t * W + ch], aa1 = AA[((size_t)T + t) * W + ch];
            const float kt0 = kv * (1.f + (aa0 - 1.f) * kaw[ch]), kt1 = kv * (1.f + (aa1 - 1.f) * kaw[ch]);
            KT[(size_t)t * W + ch] = kt0; KT[((size_t)T + t) * W + ch] = kt1; AKK[(size_t)t * W + ch] = aa0 * kkn; AKK[((size_t)T + t) * W + ch] = aa1 * kkn;
            b0 += rr * kt0; b1 += rr * kt1;
        }
        BON[(size_t)t * 16 + h] = b0; BON[((size_t)T + t) * 16 + h] = b1;
    }
}
__device__ __forceinline__ void ph_rw_scan(const Ctx& c) {
    const float* FS = WSF(O_FS); const float* DEC = WSF(O_DEC); const float* KK = WSF(O_KK); const float* KT = WSF(O_KT); const float* AKK = WSF(O_AKK); float* YY = WSF(O_YY);
    for (long i = c.gt; i < (long)2 * NB * 16 * 64; i += c.gs) {
        const int row = (int)(i % 64), h = (int)((i / 64) % 16), b = (int)((i / 1024) % NB), z = (int)(i / ((long)1024 * NB));
        float st[64];
#pragma unroll
        for (int k = 0; k < 64; ++k) st[k] = 0.f;
        for (int step = 0; step < S; ++step) {
            const long t = (long)b * S + (z == 0 ? step : S - 1 - step);
            const float* wv = DEC + ((size_t)z * T + t) * W + h * 64; const float* kkv = KK + (size_t)t * W + h * 64; const float* akv = AKK + ((size_t)z * T + t) * W + h * 64;
            const float* ktv = KT + ((size_t)z * T + t) * W + h * 64; const float* rv = FS + (size_t)t * RF + h * 64; const float vv = FS[(size_t)t * RF + 2048 + h * 64 + row];
            float rem = 0.f;
#pragma unroll
            for (int k0 = 0; k0 < 64; k0 += 16) {
#pragma unroll
                for (int k = k0; k < k0 + 16; ++k) rem += st[k] * kkv[k];
                asm volatile("" ::: "memory");
            }
            float y = 0.f;
#pragma unroll
            for (int k0 = 0; k0 < 64; k0 += 8) {
#pragma unroll
                for (int k = k0; k < k0 + 8; ++k) { st[k] = st[k] * wv[k] - rem * akv[k] + vv * ktv[k]; y += st[k] * rv[k]; }
                asm volatile("" ::: "memory");
            }
            YY[((size_t)z * T + t) * W + h * 64 + row] = y;
        }
    }
}
__device__ __forceinline__ void ph_rw_out(const Ctx& c) {
    const float* FS = WSF(O_FS); const float* YY = WSF(O_YY); const float* BON = WSF(O_BON); const float* GG = WSF(O_GG); float* Y = WSF(O_YS) + (size_t)3 * T * W;
    for (long i = c.gt; i < (long)T * 16; i += c.gs) {
        const int h = (int)(i % 16); const long t = i / 16; float mu[2], rs[2];
        for (int z = 0; z < 2; ++z) {
            const float* y = YY + ((size_t)z * T + t) * W + h * 64; float m = 0.f, v = 0.f;
            for (int k = 0; k < 64; ++k) m += y[k];
            m *= (1.f / 64.f);
            for (int k = 0; k < 64; ++k) { const float dd = y[k] - m; v += dd * dd; }
            mu[z] = m; rs[z] = 1.f / sqrtf(v * (1.f / 64.f) + EPS);
        }
        const float b0 = BON[(size_t)t * 16 + h], b1 = BON[((size_t)T + t) * 16 + h];
        for (int k = 0; k < 64; ++k) {
            const int ch = h * 64 + k; const float vv = FS[(size_t)t * RF + 2048 + ch];
            const float o = (YY[(size_t)t * W + ch] - mu[0]) * rs[0] + b0 * vv + (YY[((size_t)T + t) * W + ch] - mu[1]) * rs[1] + b1 * vv;
            Y[(size_t)t * W + ch] = o * GG[(size_t)t * W + ch];
        }
    }
}
__device__ __forceinline__ void ph_router1(const Ctx& c, int l) {
    const float* H = WSF(O_H); const float* wg = c.in[30] + (size_t)l * D * 4; const float* bg = c.in[31] + (size_t)l * 4;
    const float* we = c.in[32] + (size_t)l * D * 32; const float* be = c.in[33] + (size_t)l * 32; float* LOG = WSF(O_LOG);
    for (long i = c.gt; i < (long)T * 36; i += c.gs) {
        const int j = (int)(i % 36); const long t = i / 36; const float* h = H + (size_t)t * D; float acc = 0.f;
        if (j < 4) { for (int k = 0; k < D; ++k) acc += h[k] * wg[k * 4 + j]; acc += bg[j]; }
        else { const int jj = j - 4; for (int k = 0; k < D; ++k) acc += h[k] * we[k * 32 + jj]; acc += be[jj]; }
        LOG[(size_t)t * 40 + j] = acc;
    }
}
__device__ __forceinline__ void ph_router2(const Ctx& c, int l) {
    const float* LOG = WSF(O_LOG); int* EID = WSI(O_EID); float* EWT = WSF(O_EWT); int* cnt = CTLW(c) + CW_CNT + l * 64;
    for (long t = c.gt; t < T; t += c.gs) {
        const float* lg = LOG + (size_t)t * 40; int gi = 0; float m = lg[0];
        for (int q = 1; q < 4; ++q) if (lg[q] > m) { m = lg[q]; gi = q; }
        float den = 0.f; for (int q = 0; q < 4; ++q) den += expf(lg[q] - m);
        const float gp = 1.f / den;
        const float* el = lg + 4 + gi * 8; int i1 = 0; float m1 = el[0];
        for (int q = 1; q < 8; ++q) if (el[q] > m1) { m1 = el[q]; i1 = q; }
        int i2 = -1; float m2 = 0.f;
        for (int q = 0; q < 8; ++q) if (q != i1 && (i2 < 0 || el[q] > m2)) { m2 = el[q]; i2 = q; }
        const float p1 = 1.f, p2 = expf(m2 - m1);
        EID[t * 2] = gi * 8 + i1; EID[t * 2 + 1] = gi * 8 + i2;
        EWT[t * 2] = gp * p1 / (p1 + p2); EWT[t * 2 + 1] = gp * p2 / (p1 + p2);
        atomic_add_i(cnt + gi * 8 + i1, 1); atomic_add_i(cnt + gi * 8 + i2, 1);
    }
}
__device__ __forceinline__ void ph_moe_plan(const Ctx& c, int l) {
    int* cnt = CTLW(c) + CW_CNT + l * 64; int* plan = CTLW(c) + CW_PLAN + l * 256; int* SLOT = WSI(O_SLOT);
    if (c.gt == 0) {
        int ps = 0, nb = 0;
        for (int e = 0; e < NE; ++e) { plan[e] = ps; const int nblk = (cnt[e] + 255) / 256; for (int q = 0; q < nblk; ++q) plan[64 + nb++] = e; ps += nblk * 256; }
        plan[32] = ps; plan[40] = nb;
    }
    for (long i = c.gt; i < CAP; i += c.gs) SLOT[i] = T;
}
__device__ __forceinline__ void ph_moe_assign(const Ctx& c, int l) {
    const int* EID = WSI(O_EID); int* fill = CTLW(c) + CW_FILL + l * 64; const int* plan = CTLW(c) + CW_PLAN + l * 256; int* SLOT = WSI(O_SLOT); int* DEST = WSI(O_DEST);
    for (long i = c.gt; i < (long)T * 2; i += c.gs) {
        const int e = EID[i]; const int pos = atomic_add_i(fill + e, 1); const int slot = plan[e] + pos;
        SLOT[slot] = (int)(i / 2); DEST[i] = slot;
    }
}
__device__ __forceinline__ void ph_moe_act(const Ctx& c, int l) {
    const int nblk = (CTLW(c) + CW_PLAN + l * 256)[40]; const float* GU = WSF(O_GU); float* ACT = WSF(O_ACT);
    for (long i = c.gt; i < (long)nblk * 256 * 512; i += c.gs) { const long slot = i / 512; const int cc = (int)(i % 512);
        ACT[i] = siluf_(GU[(size_t)slot * 1024 + cc]) * GU[(size_t)slot * 1024 + 512 + cc]; }
}
__device__ __forceinline__ void ph_moe_comb(const Ctx& c, const float* xmid, const float* g2, float* xout) {
    const float* YE = WSF(O_YE); const float* EWT = WSF(O_EWT); const int* DEST = WSI(O_DEST);
    for (long i = c.gt; i < (long)T * D; i += c.gs) {
        const int cc = (int)(i % D); const long t = i / D; const int b = (int)(t / S);
        xout[i] = xmid[i] + g2[b * D6 + cc] * (EWT[t * 2] * YE[(size_t)DEST[t * 2] * D + cc] + EWT[t * 2 + 1] * YE[(size_t)DEST[t * 2 + 1] * D + cc]);
    }
}

#ifndef CPU_EMU
#define XB_TMO      128
#define XB_XCNT(j)  (256  + 64 * (j))
#define XB_XSUB(j)  (1280 + 64 * (j))
#define XB_XGEN(j)  (2304 + 64 * (j))
#define XB_TOP      3328
#define XB_TOPGEN   3392
#define XCD_BAR_WORDS 3456
#define XB_SPIN_CAP (1u << 26)
#define LAS __attribute__((address_space(3)))
__device__ __forceinline__ unsigned xb_ld(unsigned* p)              { return __hip_atomic_load(p, __ATOMIC_RELAXED, __HIP_MEMORY_SCOPE_AGENT); }
__device__ __forceinline__ unsigned xb_add(unsigned* p, unsigned v) { return __hip_atomic_fetch_add(p, v, __ATOMIC_RELAXED, __HIP_MEMORY_SCOPE_AGENT); }
__device__ __forceinline__ unsigned xb_xcc_id() { return (unsigned)__builtin_amdgcn_s_getreg((3 << 11) | 20) & 0xFu; }
#define XB_SPIN(cond, bar) do { unsigned _sp = 0; while (cond) { __builtin_amdgcn_s_sleep(1); \
    if ((++_sp & 255u) == 0u) { if (xb_ld(&(bar)[XB_TMO])) break; if (_sp > XB_SPIN_CAP) { atomicAdd(&(bar)[XB_TMO], 1u); break; } } } } while (0)
struct XcdBarrier { unsigned* bar; unsigned x; volatile LAS unsigned* st; };
__device__ __forceinline__ XcdBarrier xcd_barrier_post(unsigned* bar, volatile LAS unsigned* st) {
    XcdBarrier b; b.bar = bar; b.x = xb_xcc_id(); b.st = st;
    if (threadIdx.x == 0) (void)xb_add(&bar[XB_XCNT(b.x)], 1u);
    return b;
}
__device__ __forceinline__ void xcd_barrier_complete(unsigned* bar, unsigned x, unsigned& nloc, unsigned& nx) {
    const unsigned G = gridDim.x * gridDim.y * gridDim.z;
    unsigned sum, cnt, mine, sp = 0u;
    for (;;) {
        sum = 0u; cnt = 0u; mine = 0u;
#pragma unroll
        for (unsigned j = 0; j < 16; ++j) { const unsigned cc = xb_ld(&bar[XB_XCNT(j)]); sum += cc; cnt += (cc > 0u) ? 1u : 0u; mine = (j == x) ? cc : mine; }
        if (sum == G) break;
        __builtin_amdgcn_s_sleep(1);
        if ((++sp & 255u) == 0u) { if (xb_ld(&bar[XB_TMO])) break; if (sp > XB_SPIN_CAP) { atomicAdd(&bar[XB_TMO], 1u); break; } }
    }
    nloc = mine > 0u ? mine : 1u; nx = cnt > 0u ? cnt : 1u;
}
__device__ __forceinline__ void xcd_barrier(const XcdBarrier& b) {
    asm volatile("s_waitcnt vmcnt(0)" ::: "memory");
    __syncthreads();
    if (threadIdx.x == 0) {
        unsigned* bar = b.bar;
        __builtin_amdgcn_s_waitcnt(0);
        unsigned nloc = b.st[0], nx = b.st[1];
        if (nloc == 0u) { xcd_barrier_complete(bar, b.x, nloc, nx); b.st[0] = nloc; b.st[1] = nx; }
        const unsigned old = xb_add(&bar[XB_XSUB(b.x)], 1u);
        const unsigned gen = old / nloc;
        if (old + 1u == (gen + 1u) * nloc) {
            __builtin_amdgcn_fence(__ATOMIC_RELEASE, "agent");
            asm volatile("s_waitcnt vmcnt(0)" ::: "memory");
            const unsigned og = xb_add(&bar[XB_TOP], 1u);
            const unsigned tg = og / nx;
            if (og + 1u == (tg + 1u) * nx) xb_add(&bar[XB_TOPGEN], 1u);
            else XB_SPIN(xb_ld(&bar[XB_TOPGEN]) == tg, bar);
            __builtin_amdgcn_fence(__ATOMIC_ACQUIRE, "agent");
            xb_add(&bar[XB_XGEN(b.x)], 1u);
            asm volatile("s_waitcnt vmcnt(0)" ::: "memory");
        } else {
            XB_SPIN(xb_ld(&bar[XB_XGEN(b.x)]) == gen, bar);
            __builtin_amdgcn_fence(__ATOMIC_ACQUIRE, "agent");
            asm volatile("s_waitcnt vmcnt(0)" ::: "memory");
        }
    }
    __syncthreads();
}
#endif

constexpr int LDS_BYTES = 147456;

__global__ void __launch_bounds__(NT, 2) fwd(Params p) {
#ifdef CPU_EMU
    float* ldsf = nullptr;
#else
    extern __shared__ __attribute__((aligned(16))) unsigned char lds[];
    float* ldsf = (float*)lds;
    volatile LAS unsigned* misc = (volatile LAS unsigned*)((LAS unsigned char*)lds + LDS_BYTES - 64);
    if (threadIdx.x == 0) { misc[0] = 0u; misc[1] = 0u; }
    __syncthreads();
    XcdBarrier bar = xcd_barrier_post((unsigned*)(p.ws + O_CTL) + CW_BAR, misc);
#endif
    Ctx c; c.in = p.in; c.out = p.out; c.ws = p.ws; c.gt = (long)blockIdx.x * blockDim.x + threadIdx.x; c.gs = (long)gridDim.x * blockDim.x;
    const int lo = p.ph_lo, hi = p.ph_hi; int ph = 0;
#ifdef CPU_EMU
#define GRID_BAR()
#else
#define GRID_BAR() xcd_barrier(bar)
#endif
#define PHASE(body) do { if (lo <= ph && ph < hi) { body; if (ph + 1 < hi) { GRID_BAR(); } } ++ph; } while (0)
    PHASE(ph_mod(c));
#define LAYER_BODY(l) do { const float* mod = WSF(O_MOD); \
        const float* xin = l == 0 ? c.in[0] : WSF(O_X1); float* xmid = l == 0 ? WSF(O_X0) : WSF(O_X2); float* xout = l == 0 ? WSF(O_X1) : WSF(O_X3); \
        const float* ml = mod + (size_t)l * NB * D6; \
        PHASE(ph_norm(c, xin, c.in[3] + (size_t)l * D, ml + 0 * D, ml + 1 * D, WSF(O_H))); \
        PHASE((gemm_f32<1>(c, ldsf, T / 128, INW / 128, D, INW, ARows{WSF(O_H), (size_t)D, 0}, BPlain{c.in[7] + (size_t)l * D * INW, 0}, EpStore{WSF(O_P), (size_t)INW}))); \
        PHASE(ph_lru_conv(c, l)); \
        PHASE(ph_lru_gate(c, l)); \
        PHASE(ph_lru_scan1(c)); \
        PHASE(ph_lru_scan2(c)); \
        PHASE(ph_lru_scan3(c)); \
        PHASE(ph_ret_rope(c)); \
        PHASE(ph_ret_kv(c)); \
        PHASE(ph_ret_state(c)); \
        PHASE(ph_ret_score(c)); \
        PHASE(ph_ret_out1(c)); \
        PHASE(ph_ret_out2(c)); \
        PHASE(ph_sgu_norm(c, l)); \
        PHASE(ph_sgu_mix(c, l)); \
        PHASE(ph_rw_shift(c, l)); \
        PHASE(ph_rw_lora(c, l)); \
        PHASE(ph_rw_prep(c, l)); \
        PHASE(ph_rw_scan(c)); \
        PHASE(ph_rw_out(c)); \
        PHASE((gemm_f32<4>(c, ldsf, T / 128, D / 128, W, D, ARows{WSF(O_YS), (size_t)W, (size_t)T * W}, BPlain{c.in[28] + (size_t)l * 4 * W * D, (size_t)W * D}, EpMerge{WSF(O_MRG), WSF(O_P)}))); \
        PHASE((gemm_f32<1>(c, ldsf, T / 128, D / 128, D, D, ARows{WSF(O_MRG), (size_t)D, 0}, BPlain{c.in[29] + (size_t)l * D * D, 0}, EpResid{xmid, xin, ml + 2 * D}))); \
        PHASE(ph_norm(c, xmid, c.in[4] + (size_t)l * D, ml + 3 * D, ml + 4 * D, WSF(O_H))); \
        PHASE(ph_router1(c, l)); \
        PHASE(ph_router2(c, l)); \
        PHASE(ph_moe_plan(c, l)); \
        PHASE(ph_moe_assign(c, l)); \
        const int* plan = CTLW(c) + CW_PLAN + l * 256; \
        PHASE((gemm_f32<1>(c, ldsf, CAP / 128, 1024 / 128, D, 1024, AGather{WSF(O_H), WSI(O_SLOT)}, BExpert{c.in[34] + (size_t)l * NE * D * 1024, (size_t)D * 1024, plan + 64}, EpMoe{WSF(O_GU), 1024, plan + 40}))); \
        PHASE(ph_moe_act(c, l)); \
        PHASE((gemm_f32<1>(c, ldsf, CAP / 128, D / 128, 512, D, ARows{WSF(O_ACT), 512, 0}, BExpert{c.in[35] + (size_t)l * NE * 512 * D, (size_t)512 * D, plan + 64}, EpMoe{WSF(O_YE), (size_t)D, plan + 40}))); \
        PHASE(ph_moe_comb(c, xmid, ml + 5 * D, xout)); \
    } while (0)
    LAYER_BODY(0);
    LAYER_BODY(1);
#undef LAYER_BODY
    PHASE(ph_final(c, WSF(O_X3), c.in[36], c.out));
#undef PHASE
}
}

#ifndef CPU_EMU
extern "C" void kernel_launch(void* const* d_in, const int* in_sizes, int n_in, void* d_out, int out_size, void* d_ws, size_t ws_size, hipStream_t stream) {
    static int grid = 0;
    if (grid == 0) {
        if (n_in != 37 || out_size != T * D || ws_size < WS_END) { fprintf(stderr, "kernel_launch: unexpected shapes (n_in %d out %d ws %zu need %zu)\n", n_in, out_size, ws_size, (size_t)WS_END); grid = -1; return; }
        int dev = 0, cus = 0, per_cu = 0;
        if (hipGetDevice(&dev) != hipSuccess || hipDeviceGetAttribute(&cus, hipDeviceAttributeMultiprocessorCount, dev) != hipSuccess) { grid = -1; return; }
        if (hipFuncSetAttribute((const void*)fwd, hipFuncAttributeMaxDynamicSharedMemorySize, LDS_BYTES) != hipSuccess) { fprintf(stderr, "kernel_launch: hipFuncSetAttribute failed\n"); grid = -1; return; }
        if (hipOccupancyMaxActiveBlocksPerMultiprocessor(&per_cu, (const void*)fwd, NT, LDS_BYTES) != hipSuccess || per_cu < 1) fprintf(stderr, "kernel_launch: occupancy query says %d\n", per_cu);
        (void)hipGetLastError();
        grid = cus;
    }
    if (grid < 0) return;
    (void)in_sizes;
    hipMemsetAsync((char*)d_ws + O_CTL, 0, CTL_BYTES, stream);
    Params p{};
    for (int i = 0; i < 37; ++i) p.in[i] = (const float*)d_in[i];
    p.out = (float*)d_out; p.ws = (unsigned char*)d_ws;
#if ONE_LAUNCH
    p.ph_lo = 0; p.ph_hi = NPH;
    hipLaunchKernelGGL(fwd, dim3(grid), dim3(NT), LDS_BYTES, stream, p);
#else
    for (int k = 0; k < NPH; ++k) { p.ph_lo = k; p.ph_hi = k + 1; hipLaunchKernelGGL(fwd, dim3(grid), dim3(NT), LDS_BYTES, stream, p); }
#endif
}
#endif
```

```cpp
#ifndef CPU_EMU
#include <hip/hip_runtime.h>
#endif
#include <cstdio>
#include <cstdint>
#include <cmath>
#include <cstring>

#ifndef SEQ
#define SEQ 4096
#endif
#ifndef ONE_LAUNCH
#define ONE_LAUNCH 1
#endif

namespace {
constexpr int D = 2048, NB = 2, S = SEQ, T = NB * S, NL = 2, W = 1024;
constexpr int INW = 18816, RF = 3456, D6 = 6 * D;
constexpr int C_LX = 0, C_LG = 1024, C_RQ = 2048, C_RK = 2560, C_RV = 3072, C_RG = 4096, C_SU = 5120, C_SV = 6144, C_RW = 7168;
constexpr int PW = 18944, C_MLP = 10752;
constexpr int NCH = S / 128;
constexpr int NLC = S / 64;
constexpr int NE = 32, CAP = (T * 2 / 256 + NE) * 256, MAXBLK = CAP / 256;
constexpr float EPS = 1e-6f;
constexpr float DECAY_SCALE = 0.60653065971263342f;
constexpr int NT = 512;
constexpr int NPH_LAYER = 26, NPH = 2 + NL * NPH_LAYER;
typedef unsigned short bf16_t;
#ifdef CPU_EMU
typedef float f32x4 __attribute__((vector_size(16)));
typedef unsigned u32x4 __attribute__((vector_size(16)));
#else
typedef float f32x4 __attribute__((ext_vector_type(4)));
typedef unsigned u32x4 __attribute__((ext_vector_type(4)));
typedef short bf16x8 __attribute__((ext_vector_type(8)));
#endif

constexpr size_t al256(size_t x) { return (x + 255) & ~(size_t)255; }
constexpr size_t SZ_X = (size_t)T * D * 4, SZ_W = (size_t)T * W * 4;
constexpr size_t O_CTL = 0, CTL_BYTES = 1u << 20;
constexpr size_t O_MOD = CTL_BYTES;
constexpr size_t O_X0 = O_MOD + al256((size_t)NL * NB * D6 * 4);
constexpr size_t O_X1 = O_X0 + SZ_X;
constexpr size_t O_H = O_X1 + SZ_X;
constexpr size_t O_HF = O_H + SZ_X / 2;
constexpr size_t O_P = O_HF + SZ_X;
constexpr size_t SZ_P = (size_t)T * PW * 2;
constexpr size_t O_XC = O_P + SZ_P;
constexpr size_t O_LA = O_XC + SZ_W, O_LU = O_LA + 2 * SZ_W;
constexpr size_t SZ_LC = (size_t)2 * NB * NLC * W * 4;
constexpr size_t O_LCA = O_LU + 2 * SZ_W, O_LCH = O_LCA + SZ_LC, O_LCI = O_LCH + SZ_LC;
constexpr size_t O_YS = O_LCI + SZ_LC;
constexpr size_t O_SC = O_YS + (size_t)T * 4 * W * 2;
constexpr size_t SZ_KV = (size_t)NB * NCH * 8 * 64 * 128 * 4;
constexpr size_t O_KVF = O_SC, O_KVB = O_KVF + SZ_KV, O_STF = O_KVB + SZ_KV, O_STB = O_STF + SZ_KV;
constexpr size_t O_VN = O_STB + SZ_KV;
constexpr size_t O_FS = O_VN + SZ_W;
constexpr size_t O_DEC = O_FS + al256((size_t)T * RF * 4), O_AA = O_DEC + 2 * SZ_W, O_AKK = O_AA + 2 * SZ_W;
constexpr size_t O_GG = O_AKK, O_YY = O_GG + SZ_W;

constexpr size_t O_BON = O_YY + 2 * SZ_W;
constexpr size_t O_PART = O_BON + al256((size_t)2 * T * 16 * 4);
constexpr size_t O_MRG = O_PART + SZ_X;
constexpr size_t O_LOG = O_MRG + SZ_X / 2;
constexpr size_t O_EID = O_LOG + al256((size_t)T * 40 * 4), O_EWT = O_EID + al256((size_t)T * 2 * 4), O_DEST = O_EWT + al256((size_t)T * 2 * 4);
constexpr size_t O_SLOT = O_DEST + al256((size_t)T * 2 * 4);
constexpr size_t O_STR = O_SLOT + al256((size_t)CAP * 4);
constexpr size_t O_WIN = O_STR + (size_t)64 * S * 384 * 4;
constexpr size_t O_WBR = O_WIN + (size_t)PW * D * 2;
constexpr size_t O_WOUT = O_WBR + (size_t)D * 4 * W * 2;
constexpr size_t O_WGU = O_WOUT + (size_t)D * D * 2;
constexpr size_t O_WDN = O_WGU + (size_t)NE * 1024 * D * 2;
constexpr size_t WS_END0 = O_WDN + (size_t)NE * D * 512 * 2;
constexpr size_t SZ_MOE = (size_t)CAP * (D + 512 + D) * 2;
constexpr bool MOE_OVERLAY = SZ_MOE <= SZ_P;
constexpr size_t O_XS = MOE_OVERLAY ? O_P : WS_END0;
constexpr size_t O_ACT = O_XS + (size_t)CAP * D * 2;
constexpr size_t O_YE = O_ACT + (size_t)CAP * 512 * 2;
constexpr size_t WS_END = MOE_OVERLAY ? WS_END0 : WS_END0 + SZ_MOE;
static_assert(SEQ != 4096 || WS_END <= (size_t)2040 * 1024 * 1024, "workspace budget: d_ws is 4 x the largest input = 2048 MiB");
constexpr int CW_BAR = 4096;
constexpr int CW_CNT = 32768;
constexpr int CW_FILL = CW_CNT + NL * 64;
constexpr int CW_PLAN = CW_FILL + NL * 64;
static_assert(MAXBLK <= 160, "plan words");

struct Params { const float* in[37]; float* out; unsigned char* ws; int ph_lo, ph_hi; };

struct Ctx { const float* const* in; float* out; unsigned char* ws; };
#define GT_ ((long)blockIdx.x * NT + threadIdx.x)
#define GS_ ((long)gridDim.x * NT)
#define WSF(off) ((float*)(c.ws + (off)))
#define WSI(off) ((int*)(c.ws + (off)))
#define WSH(off) ((bf16_t*)(c.ws + (off)))
#define CTLW(c) ((int*)((c).ws + O_CTL))

__device__ __forceinline__ float sigmoidf_(float x) { return 1.f / (1.f + expf(-x)); }
__device__ __forceinline__ float siluf_(float x) { return x / (1.f + expf(-x)); }
__device__ __forceinline__ float geluf_(float x) { return 0.5f * x * (1.f + tanhf(0.7978845608028654f * (x + 0.044715f * x * x * x))); }
__device__ __forceinline__ float softplusf_(float x) { return x > 0.f ? x + log1pf(expf(-x)) : log1pf(expf(x)); }
__device__ __forceinline__ float loggamma_(int h) { return log1pf(-exp2f(-5.f - (float)h)); }
__device__ __forceinline__ unsigned f2u_(float f) { unsigned u; memcpy(&u, &f, 4); return u; }
__device__ __forceinline__ float u2f_(unsigned u) { float f; memcpy(&f, &u, 4); return f; }
__device__ __forceinline__ float bf2f(bf16_t v) { return u2f_((unsigned)v << 16); }
__device__ __forceinline__ unsigned f2bf(float f) { const unsigned u = f2u_(f); return (u + 0x7fffu + ((u >> 16) & 1u)) >> 16; }
__device__ __forceinline__ unsigned pk2(float lo, float hi) { return f2bf(lo) | (f2bf(hi) << 16); }
__device__ __forceinline__ float bflo(unsigned w) { return u2f_(w << 16); }
__device__ __forceinline__ float bfhi(unsigned w) { return u2f_(w & 0xffff0000u); }
__device__ __forceinline__ int atomic_add_i(int* p, int v) {
#ifdef CPU_EMU
    return __atomic_fetch_add(p, v, __ATOMIC_RELAXED);
#else
    return atomicAdd(p, v);
#endif
}
#define PF(P, r, col) bf2f((P)[(size_t)(r) * PW + (col)])
#ifdef CPU_EMU
#define SYNCTHREADS() emu_syncthreads()
#define SHFL_XOR(v, m) emu_shfl_xor(v, m)
#else
#define SYNCTHREADS() __syncthreads()
#define SHFL_XOR(v, m) __shfl_xor(v, m)
#endif
__device__ __forceinline__ float wave_sum(float v) {
#pragma unroll
    for (int o = 1; o < 64; o <<= 1) v += SHFL_XOR(v, o);
    return v;
}
__device__ __forceinline__ f32x4 ld_bf4(const bf16_t* p) { const unsigned long long q = *(const unsigned long long*)p; const unsigned lo = (unsigned)q, hi = (unsigned)(q >> 32); return (f32x4){bflo(lo), bfhi(lo), bflo(hi), bfhi(hi)}; }
__device__ __forceinline__ void st_bf4(bf16_t* p, const f32x4 v) { *(unsigned long long*)p = (unsigned long long)pk2(v[0], v[1]) | ((unsigned long long)pk2(v[2], v[3]) << 32); }

__device__ __forceinline__ void ph_mod(const Ctx& c, float* ldsf) {
    const float* cc = c.in[1]; const float* aw = c.in[5]; const float* ab = c.in[6]; float* mod = WSF(O_MOD);
    float* scs = ldsf; float* part = ldsf + NB * D; const int tid = threadIdx.x;
    for (int i = tid; i < NB * D; i += NT) scs[i] = siluf_(cc[i]);
    SYNCTHREADS();
    for (int u = blockIdx.x; u < NL * (D6 / 128); u += gridDim.x) {
        const int l = u / (D6 / 128), j0 = (u % (D6 / 128)) * 128, col = tid & 127, kq = tid >> 7;
        const float* w = aw + (size_t)l * D * D6 + j0 + col; float a0 = 0.f, a1 = 0.f;
        for (int k = kq * 512; k < kq * 512 + 512; ++k) { const float wv = w[(size_t)k * D6]; a0 += scs[k] * wv; a1 += scs[D + k] * wv; }
        part[(kq * 2 + 0) * 128 + col] = a0; part[(kq * 2 + 1) * 128 + col] = a1;
        SYNCTHREADS();
        if (tid < 256) { const int b = tid >> 7; float sacc = 0.f; for (int q = 0; q < 4; ++q) sacc += part[(q * 2 + b) * 128 + col]; mod[((size_t)l * NB + b) * D6 + j0 + col] = sacc + ab[l * D6 + j0 + col]; }
        SYNCTHREADS();
    }
}
__device__ __forceinline__ void ph_norm(const Ctx& c, const float* x, const float* g, const float* sh, const float* sc, bf16_t* hb, float* hf) {
    const int lane = threadIdx.x & 63, gw = blockIdx.x * (NT / 64) + (threadIdx.x >> 6), ngw = gridDim.x * (NT / 64);
    for (int t = gw; t < T; t += ngw) {
        const int b = t / S; const float* xr = x + (size_t)t * D; f32x4 v[8]; float ss = 0.f;
#pragma unroll
        for (int j = 0; j < 8; ++j) { v[j] = *(const f32x4*)(xr + (j * 64 + lane) * 4); ss += (v[j][0] * v[j][0] + v[j][1] * v[j][1]) + (v[j][2] * v[j][2] + v[j][3] * v[j][3]); }
        const float rs = 1.f / sqrtf(wave_sum(ss) * (1.f / D) + EPS);
#pragma unroll
        for (int j = 0; j < 8; ++j) { const int col = (j * 64 + lane) * 4;
            const f32x4 o = v[j] * rs * *(const f32x4*)(g + col) * (*(const f32x4*)(sc + b * D6 + col) + 1.f) + *(const f32x4*)(sh + b * D6 + col);
            st_bf4(hb + (size_t)t * D + col, o); if (hf) *(f32x4*)(hf + (size_t)t * D + col) = o; }
    }
}
template <int MODE>
__device__ __forceinline__ void ph_comb_norm(const Ctx& c, const float* xmid, const float* g2, float* xout, const float* g, const float* sh, const float* sc, bf16_t* hb, float* outp) {
    const bf16_t* YE = WSH(O_YE); const float* EWT = WSF(O_EWT); const int* DEST = WSI(O_DEST);
    const int lane = threadIdx.x & 63, gw = blockIdx.x * (NT / 64) + (threadIdx.x >> 6), ngw = gridDim.x * (NT / 64);
    for (int t = gw; t < T; t += ngw) {
        const int b = t / S; const float w0 = EWT[t * 2], w1 = EWT[t * 2 + 1]; const bf16_t* y0 = YE + (size_t)DEST[t * 2] * D; const bf16_t* y1 = YE + (size_t)DEST[t * 2 + 1] * D;
        f32x4 v[8]; float ss = 0.f;
#pragma unroll
        for (int j = 0; j < 8; ++j) { const int col = (j * 64 + lane) * 4;
            v[j] = *(const f32x4*)(xmid + (size_t)t * D + col) + *(const f32x4*)(g2 + b * D6 + col) * (ld_bf4(y0 + col) * w0 + ld_bf4(y1 + col) * w1);
            if (MODE == 0) *(f32x4*)(xout + (size_t)t * D + col) = v[j];
            ss += (v[j][0] * v[j][0] + v[j][1] * v[j][1]) + (v[j][2] * v[j][2] + v[j][3] * v[j][3]); }
        const float rs = 1.f / sqrtf(wave_sum(ss) * (1.f / D) + EPS);
#pragma unroll
        for (int j = 0; j < 8; ++j) { const int col = (j * 64 + lane) * 4;
            if (MODE == 0) st_bf4(hb + (size_t)t * D + col, v[j] * rs * *(const f32x4*)(g + col) * (*(const f32x4*)(sc + b * D6 + col) + 1.f) + *(const f32x4*)(sh + b * D6 + col));
            else *(f32x4*)(outp + (size_t)t * D + col) = v[j] * rs * *(const f32x4*)(g + col); }
    }
}

struct CvtItem { const float* Wp; int ldw; bf16_t* WT; int ldt; int drow, k0, n0; };
constexpr int I_IN = 32 * (INW / 32), I_BR = 4 * 16 * 64, I_OUT = 32 * 64, I_GU = NE * 32 * 32, I_DN = NE * 8 * 64, I_ALL = I_IN + I_BR + I_OUT + I_GU + I_DN;
__device__ __forceinline__ CvtItem cvt_decode(const Ctx& c, int l, int it) {
    CvtItem r;
    if (it < I_IN) { const int kb = it / (INW / 32), nb = it % (INW / 32); r.n0 = nb * 32; r.k0 = kb * 64; r.Wp = c.in[7] + (size_t)l * D * INW; r.ldw = INW; r.WT = WSH(O_WIN); r.ldt = D; r.drow = r.n0 < 10624 ? r.n0 : r.n0 + 128; return r; }
    it -= I_IN;
    if (it < I_BR) { const int sgm = it / 1024, q = it % 1024, kb = q / 64, nb = q % 64; r.n0 = nb * 32; r.k0 = kb * 64; r.Wp = c.in[28] + ((size_t)l * 4 + sgm) * W * D; r.ldw = D; r.WT = WSH(O_WBR) + sgm * W; r.ldt = 4 * W; r.drow = r.n0; return r; }
    it -= I_BR;
    if (it < I_OUT) { const int kb = it / 64, nb = it % 64; r.n0 = nb * 32; r.k0 = kb * 64; r.Wp = c.in[29] + (size_t)l * D * D; r.ldw = D; r.WT = WSH(O_WOUT); r.ldt = D; r.drow = r.n0; return r; }
    it -= I_OUT;
    if (it < I_GU) { const int e = it / 1024, q = it % 1024, kb = q / 32, nb = q % 32; r.n0 = nb * 32; r.k0 = kb * 64; r.Wp = c.in[34] + ((size_t)l * NE + e) * D * 1024; r.ldw = 1024; r.WT = WSH(O_WGU) + (size_t)e * 1024 * D; r.ldt = D;
        r.drow = r.n0 < 512 ? (r.n0 / 128) * 256 + (r.n0 % 128) : ((r.n0 - 512) / 128) * 256 + 128 + ((r.n0 - 512) % 128); return r; }
    it -= I_GU;
    { const int e = it / 512, q = it % 512, kb = q / 64, nb = q % 64; r.n0 = nb * 32; r.k0 = kb * 64; r.Wp = c.in[35] + ((size_t)l * NE + e) * 512 * D; r.ldw = D; r.WT = WSH(O_WDN) + (size_t)e * D * 512; r.ldt = 512; r.drow = r.n0; return r; }
}
__device__ __forceinline__ void ph_convert(const Ctx& c, int l, float* ldsf) {
    const int lane = threadIdx.x & 63, wave = threadIdx.x >> 6; const int gw = blockIdx.x * (NT / 64) + wave, ngw = gridDim.x * (NT / 64);
#ifdef CPU_EMU
    if (lane == 0) for (int it = gw; it < I_ALL; it += ngw) { const CvtItem r = cvt_decode(c, l, it);
        for (int kk = 0; kk < 64; ++kk) for (int nn = 0; nn < 32; ++nn) r.WT[(size_t)(r.drow + nn) * r.ldt + r.k0 + kk] = (bf16_t)f2bf(r.Wp[(size_t)(r.k0 + kk) * r.ldw + r.n0 + nn]); }
#else
    float* scr = ldsf + wave * (64 * 33 + 16);
    for (int it = gw; it < I_ALL; it += ngw) {
        const CvtItem r = cvt_decode(c, l, it);
#pragma unroll 8
        for (int i = 0; i < 32; ++i) { const int kk = 2 * i + (lane >> 5); scr[kk * 33 + (lane & 31)] = r.Wp[(size_t)(r.k0 + kk) * r.ldw + r.n0 + (lane & 31)]; }
        asm volatile("s_waitcnt lgkmcnt(0)" ::: "memory");
        const int cc = lane & 7;
#pragma unroll
        for (int j = 0; j < 4; ++j) { const int n = (lane >> 3) + 8 * j; const float* sp = scr + (8 * cc) * 33 + n;
            u32x4 o; o[0] = pk2(sp[0 * 33], sp[1 * 33]); o[1] = pk2(sp[2 * 33], sp[3 * 33]); o[2] = pk2(sp[4 * 33], sp[5 * 33]); o[3] = pk2(sp[6 * 33], sp[7 * 33]);
            *(u32x4*)(r.WT + (size_t)(r.drow + n) * r.ldt + r.k0 + 8 * cc) = o; }
        asm volatile("s_waitcnt lgkmcnt(0)" ::: "memory");
    }
#endif
    for (long i = GT_; i < (long)128 * D / 2; i += GS_) ((unsigned*)(WSH(O_WIN) + (size_t)10624 * D))[i] = 0u;
}

namespace pg8 {
constexpr int BM = 256, BK = 64, HALF = 128, HTB = HALF * BK * 2, STAGE_BYTES = 8 * HTB;
__host__ __device__ __forceinline__ int lds_byte(int r, int cc) { const int st = (r >> 4) * 2 + (cc >> 5), rr = r & 15, c2 = cc & 31, ob = rr * 64 + c2 * 2; return st * 1024 + (ob ^ (((ob >> 9) & 1) << 5)); }
__host__ __device__ __forceinline__ void stage_rc(int b, int& R, int& C) { const int st = b / 1024, sb = b % 1024, swz = sb ^ (((sb >> 9) & 1) << 5); R = (st >> 1) * 16 + swz / 64; C = (st & 1) * 32 + (swz % 64) / 2; }
__host__ __device__ __forceinline__ int perm32(int rho) { const int n = rho >> 4, i = rho & 15; return 8 * (i >> 2) + 4 * n + (i & 3); }
struct Unit { int pm, pn, aux; const char* A; const char* B; };
struct Gemm { int K, lda, ldb; };

template <class Epi, class Sched>
__device__ __forceinline__ void gemm_phase(unsigned char* lds_, const Gemm g, const Sched& S, const Epi& E) {
#ifdef CPU_EMU
    if (threadIdx.x != 0) return;
    Unit u; const int K = g.K;
    float* Af = (float*)malloc((size_t)256 * K * 4); float* Bf = (float*)malloc((size_t)256 * K * 4); float* Cf = (float*)malloc(256 * 256 * 4);
    for (int i = 0; S.next(i, u); ++i) {
        const bf16_t* A = (const bf16_t*)u.A; const bf16_t* B = (const bf16_t*)u.B;
        for (int r = 0; r < 256; ++r) for (int k = 0; k < K; ++k) { Af[(size_t)r * K + k] = bf2f(A[(size_t)r * g.lda + k]); Bf[(size_t)r * K + k] = bf2f(B[(size_t)r * g.ldb + k]); }
        for (int r = 0; r < 256; ++r) for (int cc = 0; cc < 256; ++cc) { const float* a = Af + (size_t)r * K; const float* b = Bf + (size_t)cc * K; float sacc = 0.f; for (int k = 0; k < K; ++k) sacc += a[k] * b[k]; Cf[r * 256 + cc] = sacc; }
        for (int wid = 0; wid < 8; ++wid) for (int lane = 0; lane < 64; ++lane) {
            const int wr = wid >> 2, wc = wid & 3, fr = lane & 15, fq = lane >> 4; f32x4 acc[2][2][4][2];
            for (int ai = 0; ai < 2; ++ai) for (int bj = 0; bj < 2; ++bj) for (int m = 0; m < 4; ++m) for (int n = 0; n < 2; ++n) for (int j = 0; j < 4; ++j) {
                const int r = 128 * ai + 64 * wr + 16 * m + fr, cc = 128 * bj + 32 * wc + (Epi::PERM ? 8 * fq + 4 * n + j : 16 * n + 4 * fq + j); acc[ai][bj][m][n][j] = Cf[r * 256 + cc]; }
            E(acc, u, wr, wc, fr, fq);
        }
    }
    free(Af); free(Bf); free(Cf);
#else
    typedef __attribute__((address_space(3))) unsigned char* ldsp_t;
    ldsp_t lds = (ldsp_t)lds_;
    const int tid = threadIdx.x, wid = __builtin_amdgcn_readfirstlane(tid >> 6), lane = tid & 63, wr = wid >> 2, wc = wid & 3, fr = lane & 15, fq = lane >> 4;
    const int K = g.K, nt = K / BK;
    unsigned voffA[2], voffB[2];
#pragma unroll
    for (int i = 0; i < 2; ++i) { int R, C; stage_rc(tid * 16 + i * 8192, R, C); const int Rb = Epi::PERM ? ((R & ~31) + perm32(R & 31)) : R;
        voffA[i] = (unsigned)(R * g.lda + C) * 2u; voffB[i] = (unsigned)(Rb * g.ldb + C) * 2u; }
    const size_t kstep = (size_t)(BK * 2);
    const size_t hstepA = (size_t)HALF * g.lda * 2, hstepB = (size_t)HALF * g.ldb * 2;
    const unsigned ldsw = (unsigned)wid * 1024u;
    const int aoff = lds_byte(wr * 64 + fr, fq * 8), boff = lds_byte(wc * 32 + fr, fq * 8);
#define PG8_SA(b, h) (((b) * 2 + (h)) * HTB)
#define PG8_SB(b, h) ((4 + (b) * 2 + (h)) * HTB)
#define PG8_STAGE(bufoff, gbase, voff) do { _Pragma("unroll") for (int _i = 0; _i < 2; ++_i) \
        __builtin_amdgcn_global_load_lds((const unsigned*)((const char*)(gbase) + (voff)[_i]), (__attribute__((address_space(3))) unsigned*)(lds + (bufoff) + ldsw + _i * 8192), 16, 0, 0); } while (0)
#define PG8_LDA(dst, b, h) do { _Pragma("unroll") for (int m = 0; m < 4; ++m) _Pragma("unroll") for (int k = 0; k < 2; ++k) dst[m][k] = *(const __attribute__((address_space(3))) bf16x8*)(lds + PG8_SA(b, h) + aoff + m * 2048 + k * 1024); } while (0)
#define PG8_LDB(dst, b, h) do { _Pragma("unroll") for (int n = 0; n < 2; ++n) _Pragma("unroll") for (int k = 0; k < 2; ++k) dst[n][k] = *(const __attribute__((address_space(3))) bf16x8*)(lds + PG8_SB(b, h) + boff + n * 2048 + k * 1024); } while (0)
#define PG8_MMA(ai, bj, At, Bt) do { __builtin_amdgcn_s_setprio(1); _Pragma("unroll") for (int m = 0; m < 4; ++m) _Pragma("unroll") for (int n = 0; n < 2; ++n) _Pragma("unroll") for (int k = 0; k < 2; ++k) \
        acc[ai][bj][m][n] = __builtin_amdgcn_mfma_f32_16x16x32_bf16(Bt[n][k], At[m][k], acc[ai][bj][m][n], 0, 0, 0); __builtin_amdgcn_s_setprio(0); } while (0)
#define PG8_WAIT_V(n) asm volatile("s_waitcnt vmcnt(" #n ")" ::: "memory")
#define PG8_WAIT_L(n) asm volatile("s_waitcnt lgkmcnt(" #n ")" ::: "memory")
#define PG8_BAR __builtin_amdgcn_s_barrier()
#define PG8_SCHED __builtin_amdgcn_sched_barrier(0)
    Unit cur, nxt; int ui = 0;
    if (!S.next(0, cur)) return;
    f32x4 acc[2][2][4][2];
#pragma unroll
    for (int a = 0; a < 2; ++a)
#pragma unroll
        for (int b = 0; b < 2; ++b)
#pragma unroll
            for (int m = 0; m < 4; ++m)
#pragma unroll
                for (int n = 0; n < 2; ++n) acc[a][b][m][n] = (f32x4){0.f, 0.f, 0.f, 0.f};
    bf16x8 At[4][2], B0[2][2], B1[2][2];
    const char* cA = cur.A; const char* cB = cur.B;
    S.a_ready(cur);
    PG8_STAGE(PG8_SB(0, 0), cB, voffB); PG8_STAGE(PG8_SA(0, 0), cA, voffA); PG8_STAGE(PG8_SB(0, 1), cB + hstepB, voffB); PG8_STAGE(PG8_SA(0, 1), cA + hstepA, voffA);
    if (wr == 1) PG8_BAR;
    PG8_WAIT_V(4); PG8_BAR;
    PG8_STAGE(PG8_SB(1, 0), cB + kstep, voffB); PG8_STAGE(PG8_SA(1, 0), cA + kstep, voffA); PG8_STAGE(PG8_SB(1, 1), cB + hstepB + kstep, voffB);
    PG8_WAIT_V(6); PG8_BAR;
    for (;;) {
        const bool has_next = S.next(ui + 1, nxt);
        const char* nA = has_next ? nxt.A : cA; const char* nB = has_next ? nxt.B : cB;
        for (int t = 0; t < nt; t += 2) {
            const bool last = (t == nt - 2);
            const char* a1 = cA + (size_t)(t + 1) * kstep;
            const char* a2 = last ? nA : cA + (size_t)(t + 2) * kstep; const char* b2 = last ? nB : cB + (size_t)(t + 2) * kstep;
            const char* a3 = a2 + kstep; const char* b3 = b2 + kstep;
            if (last && has_next) S.a_ready(nxt);
            PG8_LDB(B0, 0, 0); PG8_SCHED; PG8_LDA(At, 0, 0); PG8_STAGE(PG8_SA(1, 1), a1 + hstepA, voffA);
            PG8_WAIT_L(8); PG8_BAR; PG8_WAIT_L(0); PG8_MMA(0, 0, At, B0); PG8_BAR; PG8_SCHED;
            PG8_LDB(B1, 0, 1); PG8_STAGE(PG8_SB(0, 0), b2, voffB);
            PG8_BAR; PG8_WAIT_L(0); PG8_MMA(0, 1, At, B1); PG8_BAR;
            PG8_LDA(At, 0, 1); PG8_STAGE(PG8_SA(0, 0), a2, voffA);
            PG8_BAR; PG8_WAIT_L(0); PG8_MMA(1, 0, At, B0); PG8_BAR; PG8_SCHED;
            PG8_STAGE(PG8_SB(0, 1), b2 + hstepB, voffB);
            PG8_WAIT_V(6); PG8_BAR; PG8_MMA(1, 1, At, B1); PG8_BAR;
            PG8_LDB(B0, 1, 0); PG8_SCHED; PG8_LDA(At, 1, 0); PG8_STAGE(PG8_SA(0, 1), a2 + hstepA, voffA);
            PG8_WAIT_L(8); PG8_BAR; PG8_WAIT_L(0); PG8_MMA(0, 0, At, B0); PG8_BAR; PG8_SCHED;
            PG8_LDB(B1, 1, 1); PG8_STAGE(PG8_SB(1, 0), b3, voffB);
            PG8_BAR; PG8_WAIT_L(0); PG8_MMA(0, 1, At, B1); PG8_BAR;
            PG8_LDA(At, 1, 1); PG8_STAGE(PG8_SA(1, 0), a3, voffA);
            PG8_BAR; PG8_WAIT_L(0); PG8_MMA(1, 0, At, B0); PG8_BAR; PG8_SCHED;
            PG8_STAGE(PG8_SB(1, 1), b3 + hstepB, voffB);
            PG8_WAIT_V(6); PG8_BAR; PG8_MMA(1, 1, At, B1); PG8_BAR;
        }
        E(acc, cur, wr, wc, fr, fq); S.done(cur);
        if (!has_next) break;
#pragma unroll
        for (int a = 0; a < 2; ++a)
#pragma unroll
            for (int b = 0; b < 2; ++b)
#pragma unroll
                for (int m = 0; m < 4; ++m)
#pragma unroll
                    for (int n = 0; n < 2; ++n) acc[a][b][m][n] = (f32x4){0.f, 0.f, 0.f, 0.f};
        cur = nxt; cA = nA; cB = nB; ++ui;
    }
    PG8_WAIT_V(0);
    if (wr == 0) PG8_BAR;
    PG8_BAR;
#undef PG8_SA
#undef PG8_SB
#undef PG8_STAGE
#undef PG8_LDA
#undef PG8_LDB
#undef PG8_MMA
#undef PG8_WAIT_V
#undef PG8_WAIT_L
#undef PG8_BAR
#undef PG8_SCHED
#endif
}

struct StaticOrder {
    int nM, nN, nwg, G, c; const char* A; const char* B; size_t tstepA, tstepB;
    __device__ __forceinline__ void init(int M, int N, int G_, int c_, const void* A_, const void* B_, int lda, int ldb) { nM = M / BM; nN = N / BM; nwg = nM * nN; G = G_; c = c_; A = (const char*)A_; B = (const char*)B_; tstepA = (size_t)BM * lda * 2; tstepB = (size_t)BM * ldb * 2; }
    __device__ __forceinline__ bool next(int i, Unit& u) const {
        const long L = (long)i * G + c; if (L >= nwg) return false;
        int wgid = (int)L; { const int q = nwg / 8, r = nwg % 8, xcd = wgid % 8, off = wgid / 8; wgid = (xcd < r ? xcd * (q + 1) : r * (q + 1) + (xcd - r) * q) + off; }
        const int nig = 8 * nN, gid = wgid / nig, fm = gid * 8, gsz = (nM - fm) < 8 ? (nM - fm) : 8;
        u.pm = fm + ((wgid % nig) % gsz); u.pn = (wgid % nig) / gsz; u.aux = 0; u.A = A + (size_t)u.pm * tstepA; u.B = B + (size_t)u.pn * tstepB; return true;
    }
    __device__ __forceinline__ void a_ready(const Unit&) const {}
    __device__ __forceinline__ void done(const Unit&) const {}
};
struct MergeOrder {
    StaticOrder so; int kseg_bytes;
    __device__ __forceinline__ bool next(int i, Unit& u) const { if (!so.next(i >> 2, u)) return false; u.aux = i & 3; u.A += (size_t)u.aux * kseg_bytes; u.B += (size_t)u.aux * kseg_bytes; return true; }
    __device__ __forceinline__ void a_ready(const Unit&) const {}
    __device__ __forceinline__ void done(const Unit&) const {}
};
struct MoeOrder {
    int G, c, ncol; const int* plan; const char* A; const char* B; size_t tstepA, tstepB, estep;
    __device__ __forceinline__ bool next(int i, Unit& u) const {
        const long L = (long)i * G + c; const int nblk = plan[40]; if (L >= (long)nblk * ncol) return false;
        u.pm = (int)(L / ncol); u.pn = (int)(L % ncol); u.aux = plan[64 + u.pm]; u.A = A + (size_t)u.pm * tstepA; u.B = B + (size_t)u.aux * estep + (size_t)u.pn * tstepB; return true;
    }
    __device__ __forceinline__ void a_ready(const Unit&) const {}
    __device__ __forceinline__ void done(const Unit&) const {}
};

__device__ __forceinline__ u32x4 pack8(const f32x4 v0, const f32x4 v1) { u32x4 w; w[0] = pk2(v0[0], v0[1]); w[1] = pk2(v0[2], v0[3]); w[2] = pk2(v1[0], v1[1]); w[3] = pk2(v1[2], v1[3]); return w; }
struct EpiBf16 {
    static constexpr bool PERM = true; bf16_t* O; int ldc;
    __device__ __forceinline__ void operator()(const f32x4 (&acc)[2][2][4][2], const Unit& u, int wr, int wc, int fr, int fq) const {
        const int row0 = u.pm * BM + wr * 64 + fr, col0 = u.pn * BM + wc * 32 + 8 * fq;
#pragma unroll
        for (int ai = 0; ai < 2; ++ai)
#pragma unroll
            for (int m = 0; m < 4; ++m) { bf16_t* rowp = O + (size_t)(row0 + ai * HALF + m * 16) * ldc + col0;
#pragma unroll
                for (int bj = 0; bj < 2; ++bj) *(u32x4*)(rowp + bj * HALF) = pack8(acc[ai][bj][m][0], acc[ai][bj][m][1]); }
    }
};
struct EpiMerge {
    static constexpr bool PERM = true; const bf16_t* P; float* PART; bf16_t* MRG;
    __device__ __forceinline__ void operator()(const f32x4 (&acc)[2][2][4][2], const Unit& u, int wr, int wc, int fr, int fq) const {
        const int row0 = u.pm * BM + wr * 64 + fr, col0 = u.pn * BM + wc * 32 + 8 * fq, seg = u.aux;
#pragma unroll
        for (int ai = 0; ai < 2; ++ai)
#pragma unroll
            for (int m = 0; m < 4; ++m) { const size_t r = (size_t)(row0 + ai * HALF + m * 16);
#pragma unroll
                for (int bj = 0; bj < 2; ++bj) { const int cc = col0 + bj * HALF;
                    const u32x4 gw = *(const u32x4*)(P + r * PW + C_MLP + seg * D + cc);
                    f32x4 v0, v1;
#pragma unroll
                    for (int q = 0; q < 2; ++q) { v0[2 * q] = sigmoidf_(bflo(gw[q])) * acc[ai][bj][m][0][2 * q]; v0[2 * q + 1] = sigmoidf_(bfhi(gw[q])) * acc[ai][bj][m][0][2 * q + 1];
                        v1[2 * q] = sigmoidf_(bflo(gw[2 + q])) * acc[ai][bj][m][1][2 * q]; v1[2 * q + 1] = sigmoidf_(bfhi(gw[2 + q])) * acc[ai][bj][m][1][2 * q + 1]; }
                    float* pp = PART + r * D + cc;
                    if (seg > 0) { v0 += *(const f32x4*)pp; v1 += *(const f32x4*)(pp + 4); }
                    if (seg < 3) { *(f32x4*)pp = v0; *(f32x4*)(pp + 4) = v1; } else *(u32x4*)(MRG + r * D + cc) = pack8(v0, v1);
                }
#ifndef CPU_EMU
                asm volatile("" ::: "memory");
#endif
            }
    }
};
struct EpiResid {
    static constexpr bool PERM = false; const float* xin; const float* g1; float* xmid;
    __device__ __forceinline__ void operator()(const f32x4 (&acc)[2][2][4][2], const Unit& u, int wr, int wc, int fr, int fq) const {
        const int row0 = u.pm * BM + wr * 64 + fr, col0 = u.pn * BM + wc * 32 + 4 * fq;
#pragma unroll
        for (int ai = 0; ai < 2; ++ai)
#pragma unroll
            for (int m = 0; m < 4; ++m) { const int r = row0 + ai * HALF + m * 16; const float* gp = g1 + (size_t)(r / S) * D6;
#pragma unroll
                for (int bj = 0; bj < 2; ++bj)
#pragma unroll
                    for (int n = 0; n < 2; ++n) { const int cc = col0 + bj * HALF + n * 16; *(f32x4*)(xmid + (size_t)r * D + cc) = *(const f32x4*)(xin + (size_t)r * D + cc) + *(const f32x4*)(gp + cc) * acc[ai][bj][m][n]; }
#ifndef CPU_EMU
                asm volatile("" ::: "memory");
#endif
            }
    }
};
struct EpiGU {
    static constexpr bool PERM = true; bf16_t* ACT;
    __device__ __forceinline__ void operator()(const f32x4 (&acc)[2][2][4][2], const Unit& u, int wr, int wc, int fr, int fq) const {
        const int row0 = u.pm * BM + wr * 64 + fr, col0 = u.pn * HALF + wc * 32 + 8 * fq;
#pragma unroll
        for (int ai = 0; ai < 2; ++ai)
#pragma unroll
            for (int m = 0; m < 4; ++m) { f32x4 v0, v1;
#pragma unroll
                for (int j = 0; j < 4; ++j) { v0[j] = siluf_(acc[ai][0][m][0][j]) * acc[ai][1][m][0][j]; v1[j] = siluf_(acc[ai][0][m][1][j]) * acc[ai][1][m][1][j]; }
                *(u32x4*)(ACT + (size_t)(row0 + ai * HALF + m * 16) * 512 + col0) = pack8(v0, v1); }
    }
};
}

__device__ __forceinline__ void ph_lru_gate(const Ctx& c, int l, float* ldsf) {
    const bf16_t* P = WSH(O_P); const float* cw = c.in[8] + (size_t)l * 4 * W; const float* cb = c.in[9] + (size_t)l * W;
    const float* wr = c.in[10] + (size_t)l * 2 * 8 * 128 * 128; const float* br = c.in[11] + (size_t)l * 2 * W;
    const float* wi = c.in[12] + (size_t)l * 2 * 8 * 128 * 128; const float* bi = c.in[13] + (size_t)l * 2 * W; const float* lam = c.in[14] + (size_t)l * 2 * W;
    float* LA = WSF(O_LA); float* LU = WSF(O_LU);
    float* Xc = ldsf; bf16_t* Wr = (bf16_t*)(ldsf + 128 * 128); bf16_t* Wi = Wr + 128 * 128;
    const int tid = threadIdx.x, ty = tid >> 5, tx = tid & 31;
    for (int u = blockIdx.x; u < (T / 128) * 8; u += gridDim.x) {
        const int n = u & 7; const long t0 = (long)(u >> 3) * 128;
#pragma unroll 2
        for (int q = 0; q < 8; ++q) { const int id = tid + NT * q, tl = id >> 5, e4 = (id & 31) * 4, ch = n * 128 + e4; const long t = t0 + tl; const int sI = (int)(t % S);
            f32x4 acc = *(const f32x4*)(cb + ch);
#pragma unroll
            for (int k = 0; k < 4; ++k) { const int ss = sI + k - 2; if (ss >= 0 && ss < S) acc += ld_bf4(P + (size_t)(t + k - 2) * PW + C_LX + ch) * *(const f32x4*)(cw + k * W + ch); }
            *(f32x4*)(Xc + tl * 128 + e4) = acc; }
        for (int z = 0; z < 2; ++z) {
#pragma unroll 2
            for (int q = 0; q < 8; ++q) { const int id = tid + NT * q, e = id >> 5, f4 = (id & 31) * 4; const size_t so = ((size_t)(z * 8 + n) * 128 + e) * 128 + f4;
                st_bf4(Wr + e * 128 + f4, *(const f32x4*)(wr + so)); st_bf4(Wi + e * 128 + f4, *(const f32x4*)(wi + so)); }
            SYNCTHREADS();
            f32x4 ar[8], ai[8];
#pragma unroll
            for (int ii = 0; ii < 8; ++ii) { ar[ii] = (f32x4){0.f, 0.f, 0.f, 0.f}; ai[ii] = (f32x4){0.f, 0.f, 0.f, 0.f}; }
#pragma unroll 1
            for (int e4 = 0; e4 < 128; e4 += 4) {
                f32x4 xa[8];
#pragma unroll
                for (int ii = 0; ii < 8; ++ii) xa[ii] = *(const f32x4*)(Xc + (ty * 8 + ii) * 128 + e4);
#pragma unroll
                for (int ee = 0; ee < 4; ++ee) { const f32x4 w1 = ld_bf4(Wr + (e4 + ee) * 128 + tx * 4), w2 = ld_bf4(Wi + (e4 + ee) * 128 + tx * 4);
#pragma unroll
                    for (int ii = 0; ii < 8; ++ii) { ar[ii] += w1 * xa[ii][ee]; ai[ii] += w2 * xa[ii][ee]; } }
            }
            const int ch = n * 128 + tx * 4; const f32x4 brv = *(const f32x4*)(br + z * W + ch), biv = *(const f32x4*)(bi + z * W + ch), lmv = *(const f32x4*)(lam + z * W + ch);
            f32x4 spv;
#pragma unroll
            for (int e = 0; e < 4; ++e) spv[e] = softplusf_(-lmv[e]);
#pragma unroll
            for (int ii = 0; ii < 8; ++ii) { const int tl = ty * 8 + ii; const f32x4 xcv = *(const f32x4*)(Xc + tl * 128 + tx * 4); f32x4 av, uv;
#pragma unroll
                for (int e = 0; e < 4; ++e) { const float r = sigmoidf_(ar[ii][e] + brv[e]), ig = sigmoidf_(ai[ii][e] + biv[e]), la = -8.f * r * spv[e]; av[e] = expf(la); uv[e] = sqrtf(-expm1f(2.f * la)) * ig * xcv[e]; }
                *(f32x4*)(LA + ((size_t)z * T + t0 + tl) * W + ch) = av; *(f32x4*)(LU + ((size_t)z * T + t0 + tl) * W + ch) = uv; }
            SYNCTHREADS();
        }
    }
}
__device__ __forceinline__ void ph_lru_scan1(const Ctx& c) {
    const float* LA = WSF(O_LA); const float* LU = WSF(O_LU); float* CA = WSF(O_LCA); float* CH = WSF(O_LCH);
    for (long i = GT_; i < (long)2 * NB * NLC * W; i += GS_) {
        const int w = (int)(i % W), ch = (int)((i / W) % NLC), b = (int)((i / ((long)W * NLC)) % NB), z = (int)(i / ((long)W * NLC * NB));
        const long t0 = (long)b * S + ch * 64; float prod = 1.f, h = 0.f;
        for (int q = 0; q < 64; ++q) { const int s = z == 0 ? q : 63 - q; const size_t idx = ((size_t)z * T + t0 + s) * W + w; const float a = LA[idx]; h = a * h + LU[idx]; prod *= a; }
        CA[i] = prod; CH[i] = h;
    }
}
__device__ __forceinline__ void ph_lru_scan2(const Ctx& c) {
    const float* CA = WSF(O_LCA); const float* CH = WSF(O_LCH); float* CI = WSF(O_LCI);
    for (long i = GT_; i < (long)2 * NB * W; i += GS_) {
        const int w = (int)(i % W), b = (int)((i / W) % NB), z = (int)(i / ((long)W * NB)); float carry = 0.f;
        for (int q = 0; q < NLC; ++q) { const int ch = z == 0 ? q : NLC - 1 - q; const size_t idx = (((size_t)z * NB + b) * NLC + ch) * W + w; CI[idx] = carry; carry = CA[idx] * carry + CH[idx]; }
    }
}
__device__ __forceinline__ void ph_lru_scan3(const Ctx& c) {
    const float* LA = WSF(O_LA); const float* LU = WSF(O_LU); const float* CI = WSF(O_LCI); const bf16_t* P = WSH(O_P); float* HFW = WSF(O_XC); bf16_t* Y = WSH(O_YS);
    for (long i = GT_; i < (long)NB * NLC * W; i += GS_) {
        const int w = (int)(i % W), ch = (int)((i / W) % NLC), b = (int)(i / ((long)W * NLC)); const long t0 = (long)b * S + ch * 64;
        float h = CI[(((size_t)0 * NB + b) * NLC + ch) * W + w];
        for (int s = 0; s < 64; ++s) { const size_t idx = ((size_t)(t0 + s)) * W + w; h = LA[idx] * h + LU[idx]; HFW[idx] = h; }
        h = CI[(((size_t)1 * NB + b) * NLC + ch) * W + w];
        for (int s = 63; s >= 0; --s) { const size_t idx = ((size_t)(t0 + s)) * W + w; h = LA[(size_t)T * W + idx] * h + LU[(size_t)T * W + idx];
            Y[(size_t)(t0 + s) * 4 * W + 0 * W + w] = (bf16_t)f2bf((HFW[idx] + h) * geluf_(PF(P, t0 + s, C_LG + w))); }
    }
}
__device__ __forceinline__ void rope_pair(const bf16_t* prow, int colbase, int dj, float cs, float sn, float scale, float* dst) {
    const float x1 = bf2f(prow[colbase + dj]), x2 = bf2f(prow[colbase + dj + 32]);
    dst[dj] = (x1 * cs - x2 * sn) * scale; dst[dj + 32] = (x2 * cs + x1 * sn) * scale;
}
__device__ __forceinline__ void ph_ret_kv(const Ctx& c, float* ldsf) {
    const int* pos = (const int*)c.in[2]; const bf16_t* P = WSH(O_P); float* KVF = WSF(O_KVF); float* KVB = WSF(O_KVB);
    float* Ks = ldsf; bf16_t* Vs = (bf16_t*)(ldsf + 128 * 64); float* tab = ldsf + 128 * 64 + 128 * 64;
    const int tid = threadIdx.x, dg = tid >> 5, eg = tid & 31;
    for (int u = blockIdx.x; u < (T / 128) * 8; u += gridDim.x) {
        const int h = u & 7; const long t0 = (long)(u >> 3) * 128; const float lg = loggamma_(h);
        if (tid < 32) tab[tid] = powf(10000.f, -(float)(2 * tid) / 64.f);
        if (tid >= 64 && tid < 64 + 129) tab[tid] = expf((float)(tid - 64) * lg);
        SYNCTHREADS();
#pragma unroll 1
        for (int q = 0; q < 8; ++q) { const int id = tid + NT * q, j = id >> 5, dj = id & 31; const float ang = (float)pos[t0 + j] * tab[dj]; const float cs = cosf(ang), sn = sinf(ang);
            rope_pair(P + (size_t)(t0 + j) * PW, C_RK + h * 64, dj, cs, sn, 1.f, Ks + j * 64); }
#pragma unroll
        for (int q = 0; q < 4; ++q) { const int id = tid + NT * q, j = id >> 4, e8 = (id & 15) * 8; *(u32x4*)(Vs + j * 128 + e8) = *(const u32x4*)(P + (size_t)(t0 + j) * PW + C_RV + h * 128 + e8); }
        SYNCTHREADS();
        f32x4 af[4], ab[4];
#pragma unroll
        for (int dd = 0; dd < 4; ++dd) { af[dd] = (f32x4){0.f, 0.f, 0.f, 0.f}; ab[dd] = (f32x4){0.f, 0.f, 0.f, 0.f}; }
#pragma unroll 4
        for (int j = 0; j < 128; ++j) { const f32x4 k4 = *(const f32x4*)(Ks + j * 64 + dg * 4), v4 = ld_bf4(Vs + j * 128 + eg * 4); const float fj = tab[64 + 127 - j], bj = tab[64 + j];
#pragma unroll
            for (int dd = 0; dd < 4; ++dd) { af[dd] += v4 * (k4[dd] * fj); ab[dd] += v4 * (k4[dd] * bj); } }
        const size_t ob = (((size_t)(u >> 3) * 8 + h) * 64 + dg * 4) * 128 + eg * 4;
#pragma unroll
        for (int dd = 0; dd < 4; ++dd) { *(f32x4*)(KVF + ob + (size_t)dd * 128) = af[dd]; *(f32x4*)(KVB + ob + (size_t)dd * 128) = ab[dd]; }
        SYNCTHREADS();
    }
}
__device__ __forceinline__ void ph_ret_state(const Ctx& c) {
    const float* KVF = WSF(O_KVF); const float* KVB = WSF(O_KVB); float* STF = WSF(O_STF); float* STB = WSF(O_STB);
    for (long i = GT_; i < (long)NB * 8 * 64 * 128; i += GS_) {
        const int e = (int)(i % 128), d = (int)((i / 128) % 64), h = (int)((i / 8192) % 8), b = (int)(i / 65536);
        const float cd = expf(128.f * loggamma_(h)); float st = 0.f;
        for (int n = 0; n < NCH; ++n) { const size_t idx = ((((size_t)b * NCH + n) * 8 + h) * 64 + d) * 128 + e; STF[idx] = st; st = cd * st + KVF[idx]; }
        st = 0.f;
        for (int n = NCH - 1; n >= 0; --n) { const size_t idx = ((((size_t)b * NCH + n) * 8 + h) * 64 + d) * 128 + e; STB[idx] = st; st = cd * st + KVB[idx]; }
    }
}
__device__ __forceinline__ void ph_ret_out(const Ctx& c, float* ldsf) {
    const int* pos = (const int*)c.in[2]; const bf16_t* P = WSH(O_P); const float* STF = WSF(O_STF); const float* STB = WSF(O_STB); bf16_t* Y = WSH(O_YS);
    float* Qs = ldsf; float* Ks = ldsf + 128 * 68; bf16_t* Vs = (bf16_t*)(ldsf + 2 * 128 * 68); bf16_t* Ss = Vs + 128 * 128; float* tab = ldsf + 2 * 128 * 68 + 128 * 64 + 128 * 64;
    const int tid = threadIdx.x, ty = tid >> 5, tx = tid & 31;
    for (int u = blockIdx.x; u < (T / 128) * 8; u += gridDim.x) {
        const int h = u & 7; const long t0 = (long)(u >> 3) * 128; const float lg = loggamma_(h);
        if (tid < 32) tab[tid] = powf(10000.f, -(float)(2 * tid) / 64.f);
        if (tid >= 64 && tid < 64 + 129) tab[tid] = expf((float)(tid - 64) * lg);
        SYNCTHREADS();
#pragma unroll 1
        for (int q = 0; q < 8; ++q) { const int id = tid + NT * q, j = id >> 5, dj = id & 31; const float ang = (float)pos[t0 + j] * tab[dj]; const float cs = cosf(ang), sn = sinf(ang);
            const bf16_t* prow = P + (size_t)(t0 + j) * PW; rope_pair(prow, C_RQ + h * 64, dj, cs, sn, 0.125f, Qs + j * 68); rope_pair(prow, C_RK + h * 64, dj, cs, sn, 1.f, Ks + j * 68); }
#pragma unroll
        for (int q = 0; q < 4; ++q) { const int id = tid + NT * q, j = id >> 4, e8 = (id & 15) * 8; *(u32x4*)(Vs + j * 128 + e8) = *(const u32x4*)(P + (size_t)(t0 + j) * PW + C_RV + h * 128 + e8); }
        SYNCTHREADS();
        {
            float sc[8][4];
#pragma unroll
            for (int ii = 0; ii < 8; ++ii)
#pragma unroll
                for (int jj = 0; jj < 4; ++jj) sc[ii][jj] = 0.f;
#pragma unroll 1
            for (int d4 = 0; d4 < 64; d4 += 4) {
                f32x4 q4[8], k4[4];
#pragma unroll
                for (int ii = 0; ii < 8; ++ii) q4[ii] = *(const f32x4*)(Qs + (ty * 8 + ii) * 68 + d4);
#pragma unroll
                for (int jj = 0; jj < 4; ++jj) k4[jj] = *(const f32x4*)(Ks + (tx + 32 * jj) * 68 + d4);
#pragma unroll
                for (int ii = 0; ii < 8; ++ii)
#pragma unroll
                    for (int jj = 0; jj < 4; ++jj) sc[ii][jj] += (q4[ii][0] * k4[jj][0] + q4[ii][1] * k4[jj][1]) + (q4[ii][2] * k4[jj][2] + q4[ii][3] * k4[jj][3]);
            }
#pragma unroll
            for (int ii = 0; ii < 8; ++ii)
#pragma unroll
                for (int jj = 0; jj < 4; ++jj) { const int i = ty * 8 + ii, j = tx + 32 * jj, dist = i > j ? i - j : j - i; Ss[i * 128 + j] = (bf16_t)f2bf(sc[ii][jj] * tab[64 + dist]); }
        }
        SYNCTHREADS();
        f32x4 ao[8];
#pragma unroll
        for (int ii = 0; ii < 8; ++ii) ao[ii] = (f32x4){0.f, 0.f, 0.f, 0.f};
        const size_t sbase = (((size_t)(u >> 3) * 8 + h) * 64) * 128;
#pragma unroll
        for (int q = 0; q < 4; ++q) { const int id = tid + NT * q; *(f32x4*)(Ks + id * 4) = *(const f32x4*)(STF + sbase + (size_t)id * 4); }
#pragma unroll 1
        for (int j4 = 0; j4 < 128; j4 += 4) {
            f32x4 s4[8], v4[4];
#pragma unroll
            for (int ii = 0; ii < 8; ++ii) s4[ii] = ld_bf4(Ss + (ty * 8 + ii) * 128 + j4);
#pragma unroll
            for (int jj = 0; jj < 4; ++jj) v4[jj] = ld_bf4(Vs + (j4 + jj) * 128 + tx * 4);
#pragma unroll
            for (int ii = 0; ii < 8; ++ii)
#pragma unroll
                for (int jj = 0; jj < 4; ++jj) ao[ii] += v4[jj] * s4[ii][jj];
        }
        for (int dirn = 0; dirn < 2; ++dirn) {
            SYNCTHREADS();
            f32x4 tm[8];
#pragma unroll
            for (int ii = 0; ii < 8; ++ii) tm[ii] = (f32x4){0.f, 0.f, 0.f, 0.f};
#pragma unroll 1
            for (int d4 = 0; d4 < 64; d4 += 4) {
                f32x4 q4[8], s4[4];
#pragma unroll
                for (int ii = 0; ii < 8; ++ii) q4[ii] = *(const f32x4*)(Qs + (ty * 8 + ii) * 68 + d4);
#pragma unroll
                for (int dd = 0; dd < 4; ++dd) s4[dd] = *(const f32x4*)(Ks + (d4 + dd) * 128 + tx * 4);
#pragma unroll
                for (int ii = 0; ii < 8; ++ii)
#pragma unroll
                    for (int dd = 0; dd < 4; ++dd) tm[ii] += s4[dd] * q4[ii][dd];
            }
#pragma unroll
            for (int ii = 0; ii < 8; ++ii) { const int i = ty * 8 + ii; ao[ii] += tm[ii] * (dirn == 0 ? tab[64 + i + 1] : tab[64 + 128 - i]); }
            if (dirn == 0) { SYNCTHREADS();
#pragma unroll
                for (int q = 0; q < 4; ++q) { const int id = tid + NT * q; *(f32x4*)(Ks + id * 4) = *(const f32x4*)(STB + sbase + (size_t)id * 4); } }
        }
#pragma unroll
        for (int ii = 0; ii < 8; ++ii) { const long t = t0 + ty * 8 + ii;
            float sm = (ao[ii][0] + ao[ii][1]) + (ao[ii][2] + ao[ii][3]);
#pragma unroll
            for (int o = 1; o < 32; o <<= 1) sm += SHFL_XOR(sm, o);
            const float mu = sm * (1.f / 128.f); const f32x4 dv = ao[ii] - mu; float sq = (dv[0] * dv[0] + dv[1] * dv[1]) + (dv[2] * dv[2] + dv[3] * dv[3]);
#pragma unroll
            for (int o = 1; o < 32; o <<= 1) sq += SHFL_XOR(sq, o);
            const float rs = 1.f / sqrtf(sq * (1.f / 128.f) + EPS); f32x4 gv = ld_bf4(P + (size_t)t * PW + C_RG + h * 128 + tx * 4);
#pragma unroll
            for (int e = 0; e < 4; ++e) gv[e] = siluf_(gv[e]) * (dv[e] * rs);
            st_bf4(Y + (size_t)t * 4 * W + 1 * W + h * 128 + tx * 4, gv); }
        SYNCTHREADS();
    }
}
__device__ __forceinline__ void ph_sgu_norm(const Ctx& c, int l) {
    const bf16_t* P = WSH(O_P); float* ST = WSF(O_VN);
    const int lane = threadIdx.x & 63, gw = blockIdx.x * (NT / 64) + (threadIdx.x >> 6), ngw = gridDim.x * (NT / 64);
    for (int t = gw; t < T; t += ngw) {
        f32x4 v[4]; float sm = 0.f;
#pragma unroll
        for (int j = 0; j < 4; ++j) { v[j] = ld_bf4(P + (size_t)t * PW + C_SV + (j * 64 + lane) * 4);
#pragma unroll
            for (int q = 0; q < 4; ++q) { v[j][q] = geluf_(v[j][q]); sm += v[j][q]; } }
        const float mu = wave_sum(sm) * (1.f / W); float sq = 0.f;
#pragma unroll
        for (int j = 0; j < 4; ++j)
#pragma unroll
            for (int q = 0; q < 4; ++q) { const float dd = v[j][q] - mu; sq += dd * dd; }
        const float rs = 1.f / sqrtf(wave_sum(sq) * (1.f / W) + EPS);
        if (lane == 0) { ST[(size_t)t * 2] = mu; ST[(size_t)t * 2 + 1] = rs; }
    }
}
__device__ __forceinline__ void ph_sgu_mix(const Ctx& c, int l, float* ldsf) {
    const bf16_t* P = WSH(O_P); const float* ST = WSF(O_VN); bf16_t* Y = WSH(O_YS); const float* ng = c.in[15] + (size_t)l * W;
    float* Wm = ldsf; float* Vt = ldsf + 128 * 128; const int tid = threadIdx.x, ty = tid >> 5, tx = tid & 31;
    for (int u = blockIdx.x; u < (T / 128) * 8; u += gridDim.x) {
        const int g = u & 7; const long t0 = (long)(u >> 3) * 128;
        const float* ws = c.in[16] + ((size_t)l * 8 + g) * 128 * 128; const float* bs = c.in[17] + ((size_t)l * 8 + g) * 128;
#pragma unroll
        for (int q = 0; q < 8; ++q) { const int id = tid + NT * q; *(f32x4*)(Wm + id * 4) = *(const f32x4*)(ws + id * 4); }
#pragma unroll
        for (int q = 0; q < 8; ++q) { const int id = tid + NT * q, j = id >> 5, d4 = (id & 31) * 4; const float mu = ST[(size_t)(t0 + j) * 2], rs = ST[(size_t)(t0 + j) * 2 + 1];
            f32x4 v = ld_bf4(P + (size_t)(t0 + j) * PW + C_SV + g * 128 + d4); const f32x4 gn = *(const f32x4*)(ng + g * 128 + d4);
#pragma unroll
            for (int e = 0; e < 4; ++e) v[e] = (geluf_(v[e]) - mu) * rs * gn[e];
            *(f32x4*)(Vt + j * 128 + d4) = v; }
        SYNCTHREADS();
        f32x4 acc[8];
#pragma unroll
        for (int ii = 0; ii < 8; ++ii) acc[ii] = (f32x4){0.f, 0.f, 0.f, 0.f};
#pragma unroll 2
        for (int j4 = 0; j4 < 128; j4 += 4) {
            f32x4 bv[4];
#pragma unroll
            for (int jj = 0; jj < 4; ++jj) bv[jj] = *(const f32x4*)(Vt + (j4 + jj) * 128 + tx * 4);
#pragma unroll
            for (int ii = 0; ii < 8; ++ii) { const f32x4 a = *(const f32x4*)(Wm + (ty * 8 + ii) * 128 + j4);
#pragma unroll
                for (int jj = 0; jj < 4; ++jj) acc[ii] += bv[jj] * a[jj]; }
        }
#pragma unroll
        for (int ii = 0; ii < 8; ++ii) { const int i = ty * 8 + ii; const long t = t0 + i;
            f32x4 uu = ld_bf4(P + (size_t)t * PW + C_SU + g * 128 + tx * 4); const float bsi = bs[i];
#pragma unroll
            for (int e = 0; e < 4; ++e) uu[e] = geluf_(uu[e]) * (acc[ii][e] + bsi);
            st_bf4(Y + (size_t)t * 4 * W + 2 * W + g * 128 + tx * 4, uu); }
        SYNCTHREADS();
    }
}
__device__ __forceinline__ void ph_rw_shift(const Ctx& c, int l) {
    const bf16_t* P = WSH(O_P); const float* mup = c.in[18] + (size_t)l * RF; const float* mun = c.in[19] + (size_t)l * RF; float* FS = WSF(O_FS);
    for (long i = GT_; i < (long)T * RF; i += GS_) {
        const int j = (int)(i % RF); const long t = i / RF; const int s = (int)(t % S);
        const float f = PF(P, t, C_RW + j), pv = s > 0 ? PF(P, t - 1, C_RW + j) : 0.f, nv = s < S - 1 ? PF(P, t + 1, C_RW + j) : 0.f;
        float v = f + mup[j] * (pv - f) + mun[j] * (nv - f);
        if (j >= 3072 && j < 3200) v = tanhf(v); else if (j >= 3328) v = sigmoidf_(v);
        FS[i] = v;
    }
}
__device__ __forceinline__ void ph_rw_lora(const Ctx& c, int l, float* ldsf) {
    const float* FS = WSF(O_FS); const float* w0 = c.in[20] + (size_t)l * 2 * W; const float* wup = c.in[21] + (size_t)l * 2 * 64 * W;
    const float* a0 = c.in[22] + (size_t)l * 2 * W; const float* aup = c.in[23] + (size_t)l * 2 * 64 * W; const float* gup = c.in[24] + (size_t)l * 128 * W;
    float* DEC = WSF(O_DEC); float* AA = WSF(O_AA); float* GG = WSF(O_GG);
    float* F = ldsf; float* Wt = ldsf + 128 * 128; const int tid = threadIdx.x, ty = tid >> 5, tx = tid & 31;
    for (int u = blockIdx.x; u < (T / 128) * 8; u += gridDim.x) {
        const int wc0 = (u & 7) * 128; const long t0 = (long)(u >> 3) * 128; const int ch = wc0 + tx * 4;
        for (int rd = 0; rd < 3; ++rd) {
#pragma unroll 2
            for (int q = 0; q < 8; ++q) { const int id = tid + NT * q, r = id >> 5, c4 = (id & 31) * 4;
                const int col = rd < 2 ? (c4 < 64 ? 3072 + rd * 64 + c4 : 3200 + rd * 64 + (c4 - 64)) : 3328 + c4;
                *(f32x4*)(F + r * 128 + c4) = *(const f32x4*)(FS + (size_t)(t0 + r) * RF + col);
                const float* src = rd < 2 ? (r < 64 ? wup + ((size_t)rd * 64 + r) * W : aup + ((size_t)rd * 64 + (r - 64)) * W) : gup + (size_t)r * W;
                *(f32x4*)(Wt + r * 128 + c4) = *(const f32x4*)(src + wc0 + c4); }
            SYNCTHREADS();
            f32x4 a1[8], a2[8];
#pragma unroll
            for (int ii = 0; ii < 8; ++ii) { a1[ii] = (f32x4){0.f, 0.f, 0.f, 0.f}; a2[ii] = (f32x4){0.f, 0.f, 0.f, 0.f}; }
#pragma unroll 1
            for (int r4 = 0; r4 < 64; r4 += 4) {
                f32x4 fa[8], fb[8];
#pragma unroll
                for (int ii = 0; ii < 8; ++ii) { fa[ii] = *(const f32x4*)(F + (ty * 8 + ii) * 128 + r4); fb[ii] = *(const f32x4*)(F + (ty * 8 + ii) * 128 + 64 + r4); }
#pragma unroll
                for (int rr = 0; rr < 4; ++rr) { const f32x4 w1 = *(const f32x4*)(Wt + (r4 + rr) * 128 + tx * 4), w2 = *(const f32x4*)(Wt + (64 + r4 + rr) * 128 + tx * 4);
#pragma unroll
                    for (int ii = 0; ii < 8; ++ii) { a1[ii] += w1 * fa[ii][rr]; a2[ii] += w2 * fb[ii][rr]; } }
            }
            if (rd < 2) { const f32x4 w0v = *(const f32x4*)(w0 + rd * W + ch), a0v = *(const f32x4*)(a0 + rd * W + ch);
#pragma unroll
                for (int ii = 0; ii < 8; ++ii) { f32x4 dv, av;
#pragma unroll
                    for (int e = 0; e < 4; ++e) { dv[e] = expf(-DECAY_SCALE * sigmoidf_(a1[ii][e] + w0v[e])); av[e] = sigmoidf_(a2[ii][e] + a0v[e]); }
                    *(f32x4*)(DEC + ((size_t)rd * T + t0 + ty * 8 + ii) * W + ch) = dv; *(f32x4*)(AA + ((size_t)rd * T + t0 + ty * 8 + ii) * W + ch) = av; }
            } else {
#pragma unroll
                for (int ii = 0; ii < 8; ++ii) *(f32x4*)(GG + (size_t)(t0 + ty * 8 + ii) * W + ch) = a1[ii] + a2[ii];
            }
            SYNCTHREADS();
        }
    }
}
__device__ __forceinline__ void ph_rw_prep(const Ctx& c, int l) {
    const float* FS = WSF(O_FS); const float* AA = WSF(O_AA); const float* DEC = WSF(O_DEC); const float* kkw = c.in[25] + (size_t)l * W; const float* kaw = c.in[26] + (size_t)l * W; const float* rk = c.in[27] + (size_t)l * W;
    float* STR = WSF(O_STR); float* BON = WSF(O_BON);
    const int lane = threadIdx.x & 63, gw = blockIdx.x * (NT / 64) + (threadIdx.x >> 6), ngw = gridDim.x * (NT / 64);
    for (int i = gw; i < T * 16; i += ngw) {
        const int h = i & 15; const long t = i >> 4; const int ch = h * 64 + lane, b = (int)(t / S), sidx = (int)(t % S); const float* f = FS + (size_t)t * RF;
        const float kv = f[1024 + ch], v = kv * kkw[ch]; const float rs = 1.f / sqrtf(wave_sum(v * v) + EPS); const float kkn = v * rs, rv = f[ch], rr = rv * rk[ch], vv = f[2048 + ch];
        const float aa0 = AA[(size_t)t * W + ch], aa1 = AA[((size_t)T + t) * W + ch], ka = kaw[ch];
        const float kt0 = kv * (1.f + (aa0 - 1.f) * ka), kt1 = kv * (1.f + (aa1 - 1.f) * ka);
        float* s0 = STR + (((size_t)(0 * 32 + b * 16 + h)) * S + sidx) * 384 + lane; float* s1 = STR + (((size_t)(1 * 32 + b * 16 + h)) * S + (S - 1 - sidx)) * 384 + lane;
        s0[0] = DEC[(size_t)t * W + ch]; s0[64] = kkn; s0[128] = aa0 * kkn; s0[192] = kt0; s0[256] = rv; s0[320] = vv;
        s1[0] = DEC[((size_t)T + t) * W + ch]; s1[64] = kkn; s1[128] = aa1 * kkn; s1[192] = kt1; s1[256] = rv; s1[320] = vv;
        const float b0 = wave_sum(rr * kt0), b1 = wave_sum(rr * kt1);
        if (lane == 0) { BON[(size_t)t * 16 + h] = b0; BON[((size_t)T + t) * 16 + h] = b1; }
    }
}
#ifdef CPU_EMU
__device__ __forceinline__ float red16_(float x) { x += SHFL_XOR(x, 1); x += SHFL_XOR(x, 2); x += SHFL_XOR(x, 4); x += SHFL_XOR(x, 8); return x; }
#define LDS_BARRIER() emu_syncthreads()
#else
__device__ __forceinline__ float red16_(float x) {
    x += __builtin_bit_cast(float, __builtin_amdgcn_update_dpp(0, __builtin_bit_cast(int, x), 0xB1, 0xF, 0xF, true));
    x += __builtin_bit_cast(float, __builtin_amdgcn_update_dpp(0, __builtin_bit_cast(int, x), 0x4E, 0xF, 0xF, true));
    x += __builtin_bit_cast(float, __builtin_amdgcn_update_dpp(0, __builtin_bit_cast(int, x), 0x141, 0xF, 0xF, true));
    x += __builtin_bit_cast(float, __builtin_amdgcn_update_dpp(0, __builtin_bit_cast(int, x), 0x140, 0xF, 0xF, true));
    return x;
}
#define LDS_BARRIER() do { asm volatile("s_waitcnt lgkmcnt(0)" ::: "memory"); __builtin_amdgcn_s_barrier(); asm volatile("" ::: "memory"); } while (0)
#endif
__device__ __forceinline__ void ph_rw_scan(const Ctx& c, float* ldsf) {
    const float* STR = WSF(O_STR); float* YY = WSF(O_YY);
#ifdef CPU_EMU
    const int tid = threadIdx.x, lane = tid & 63, wave = tid >> 6;
#else
    const int tid = threadIdx.x, lane = tid & 63, wave = __builtin_amdgcn_readfirstlane(tid >> 6);
#endif
    constexpr int CH = 16, NCK = S / CH, CHF = CH * 384;
    static_assert(NCK % 2 == 0 && NCK >= 4, "chunk pipeline");
    for (int u = blockIdx.x; u < 256; u += gridDim.x) {
        const int x = u & 7, jq = u >> 3, chain = x * 8 + (jq >> 2), qt = jq & 3, h = chain & 15, b = (chain >> 4) & 1, z = chain >> 5;
        const float* src = STR + (size_t)chain * S * 384;
        if (wave >= 4) {
            const int ll = tid - 256; f32x4 R0[6], R1[6];
#pragma unroll
            for (int q = 0; q < 6; ++q) { *(f32x4*)(ldsf + 0 * CHF + (q * 256 + ll) * 4) = *(const f32x4*)(src + 0 * CHF + (q * 256 + ll) * 4); *(f32x4*)(ldsf + 1 * CHF + (q * 256 + ll) * 4) = *(const f32x4*)(src + 1 * CHF + (q * 256 + ll) * 4); }
#pragma unroll
            for (int q = 0; q < 6; ++q) { R0[q] = *(const f32x4*)(src + 2 * CHF + (q * 256 + ll) * 4); R1[q] = *(const f32x4*)(src + 3 * CHF + (q * 256 + ll) * 4); }
            LDS_BARRIER();
            for (int ck = 0; ck < NCK; ck += 2) {
                if (ck + 2 < NCK) {
#pragma unroll
                    for (int q = 0; q < 6; ++q) *(f32x4*)(ldsf + ((ck + 2) & 3) * CHF + (q * 256 + ll) * 4) = R0[q]; }
                if (ck + 4 < NCK) {
#pragma unroll
                    for (int q = 0; q < 6; ++q) R0[q] = *(const f32x4*)(src + (size_t)(ck + 4) * CHF + (q * 256 + ll) * 4); }
                LDS_BARRIER();
                if (ck + 3 < NCK) {
#pragma unroll
                    for (int q = 0; q < 6; ++q) *(f32x4*)(ldsf + ((ck + 3) & 3) * CHF + (q * 256 + ll) * 4) = R1[q]; }
                if (ck + 5 < NCK) {
#pragma unroll
                    for (int q = 0; q < 6; ++q) R1[q] = *(const f32x4*)(src + (size_t)(ck + 5) * CHF + (q * 256 + ll) * 4); }
                LDS_BARRIER();
            }
        } else {
            const int rsub = lane >> 4, kq = lane & 15, row = qt * 16 + wave * 4 + rsub;
            float* yp = YY + ((size_t)z * T + (size_t)b * S) * W + h * 64 + row;
            f32x4 st = (f32x4){0.f, 0.f, 0.f, 0.f};
            LDS_BARRIER();
            for (int ck = 0; ck < NCK; ++ck) {
                const float* bufp = ldsf + (ck & 3) * CHF + 4 * kq; const float* vp = ldsf + (ck & 3) * CHF + 320 + row;
                f32x4 cw = *(const f32x4*)(bufp), ckk = *(const f32x4*)(bufp + 64), cak = *(const f32x4*)(bufp + 128), ckt = *(const f32x4*)(bufp + 192), cr = *(const f32x4*)(bufp + 256); float cv = vp[0];
                float ysel = 0.f;
#pragma unroll
                for (int sI = 0; sI < CH; ++sI) {
                    f32x4 nw = cw, nkk = ckk, nak = cak, nkt = ckt, nr = cr; float nv = cv;
                    if (sI + 1 < CH) { const float* sp = bufp + (sI + 1) * 384; nw = *(const f32x4*)(sp); nkk = *(const f32x4*)(sp + 64); nak = *(const f32x4*)(sp + 128); nkt = *(const f32x4*)(sp + 192); nr = *(const f32x4*)(sp + 256); nv = vp[(sI + 1) * 384]; }
                    const f32x4 pp = st * ckk; const float rem = red16_((pp[0] + pp[1]) + (pp[2] + pp[3]));
                    st = st * cw + (ckt * cv - cak * rem);
                    const f32x4 yy = st * cr; const float y = red16_((yy[0] + yy[1]) + (yy[2] + yy[3]));
                    ysel = (kq == (sI & 3)) ? y : ysel;
                    if ((sI & 3) == 3) { const int step = ck * CH + sI - 3 + kq; const int sidx = z ? S - 1 - step : step; if (kq < 4) yp[(size_t)sidx * W] = ysel; }
                    cw = nw; ckk = nkk; cak = nak; ckt = nkt; cr = nr; cv = nv;
                }
                LDS_BARRIER();
            }
        }
    }
}
__device__ __forceinline__ void ph_rw_out(const Ctx& c) {
    const float* FS = WSF(O_FS); const float* YY = WSF(O_YY); const float* BON = WSF(O_BON); const float* GG = WSF(O_GG); bf16_t* Y = WSH(O_YS);
    const int lane = threadIdx.x & 63, gw = blockIdx.x * (NT / 64) + (threadIdx.x >> 6), ngw = gridDim.x * (NT / 64);
    for (int i = gw; i < T * 16; i += ngw) {
        const int h = i & 15; const long t = i >> 4; const int ch = h * 64 + lane;
        const float y0 = YY[(size_t)t * W + ch], y1 = YY[((size_t)T + t) * W + ch];
        const float m0 = wave_sum(y0) * (1.f / 64.f), m1 = wave_sum(y1) * (1.f / 64.f); const float d0 = y0 - m0, d1 = y1 - m1;
        const float r0 = 1.f / sqrtf(wave_sum(d0 * d0) * (1.f / 64.f) + EPS), r1 = 1.f / sqrtf(wave_sum(d1 * d1) * (1.f / 64.f) + EPS);
        const float vv = FS[(size_t)t * RF + 2048 + ch]; const float o = d0 * r0 + d1 * r1 + (BON[(size_t)t * 16 + h] + BON[((size_t)T + t) * 16 + h]) * vv;
        Y[(size_t)t * 4 * W + 3 * W + ch] = (bf16_t)f2bf(o * GG[(size_t)t * W + ch]);
    }
}
__device__ __forceinline__ void ph_router(const Ctx& c, int l) {
    const float* H = WSF(O_HF); const float* wg = c.in[30] + (size_t)l * D * 4; const float* bg = c.in[31] + (size_t)l * 4;
    const float* we = c.in[32] + (size_t)l * D * 32; const float* be = c.in[33] + (size_t)l * 32;
    int* EID = WSI(O_EID); float* EWT = WSF(O_EWT); int* cnt = CTLW(c) + CW_CNT + l * 64;
    const int kl = threadIdx.x & 31, gh = blockIdx.x * (NT / 32) + (threadIdx.x >> 5), ngh = gridDim.x * (NT / 32);
    for (int t = gh; t < T; t += ngh) {
        const float* h = H + (size_t)t * D; float lg[36];
#pragma unroll
        for (int q = 0; q < 36; ++q) lg[q] = 0.f;
        for (int k = kl; k < D; k += 32) { const float hv = h[k]; const f32x4 g4 = *(const f32x4*)(wg + (size_t)k * 4);
#pragma unroll
            for (int q = 0; q < 4; ++q) lg[q] += hv * g4[q];
#pragma unroll
            for (int q8 = 0; q8 < 8; ++q8) { const f32x4 e4 = *(const f32x4*)(we + (size_t)k * 32 + q8 * 4);
#pragma unroll
                for (int q = 0; q < 4; ++q) lg[4 + q8 * 4 + q] += hv * e4[q]; } }
#pragma unroll
        for (int q = 0; q < 36; ++q) {
#pragma unroll
            for (int o = 1; o < 32; o <<= 1) lg[q] += SHFL_XOR(lg[q], o);
        }
        if (kl == 0) {
#pragma unroll
            for (int q = 0; q < 4; ++q) lg[q] += bg[q];
#pragma unroll
            for (int q = 0; q < 32; ++q) lg[4 + q] += be[q];
            int gi = 0; float m = lg[0];
#pragma unroll
            for (int q = 1; q < 4; ++q) if (lg[q] > m) { m = lg[q]; gi = q; }
            float den = 0.f;
#pragma unroll
            for (int q = 0; q < 4; ++q) den += expf(lg[q] - m);
            const float gp = 1.f / den; float el[8];
#pragma unroll
            for (int q = 0; q < 8; ++q) el[q] = gi == 0 ? lg[4 + q] : gi == 1 ? lg[12 + q] : gi == 2 ? lg[20 + q] : lg[28 + q];
            int i1 = 0; float m1 = el[0];
#pragma unroll
            for (int q = 1; q < 8; ++q) if (el[q] > m1) { m1 = el[q]; i1 = q; }
            int i2 = -1; float m2 = 0.f;
#pragma unroll
            for (int q = 0; q < 8; ++q) if (q != i1 && (i2 < 0 || el[q] > m2)) { m2 = el[q]; i2 = q; }
            const float p2 = expf(m2 - m1);
            EID[t * 2] = gi * 8 + i1; EID[t * 2 + 1] = gi * 8 + i2; EWT[t * 2] = gp / (1.f + p2); EWT[t * 2 + 1] = gp * p2 / (1.f + p2);
            atomic_add_i(cnt + gi * 8 + i1, 1); atomic_add_i(cnt + gi * 8 + i2, 1);
        }
    }
}
__device__ __forceinline__ void ph_moe_plan(const Ctx& c, int l) {
    int* cnt = CTLW(c) + CW_CNT + l * 64; int* plan = CTLW(c) + CW_PLAN + l * 256;
    if (GT_ == 0) {
        int ps = 0, nb = 0;
        for (int e = 0; e < NE; ++e) { plan[e] = ps; const int nblk = (cnt[e] + 255) / 256; for (int q = 0; q < nblk; ++q) plan[64 + nb++] = e; ps += nblk * 256; }
        plan[32] = ps; plan[40] = nb;
    }
}
__device__ __forceinline__ void ph_moe_assign(const Ctx& c, int l) {
    const int* EID = WSI(O_EID); int* fill = CTLW(c) + CW_FILL + l * 64; const int* plan = CTLW(c) + CW_PLAN + l * 256; int* DEST = WSI(O_DEST);
    for (long i = GT_; i < (long)T * 2; i += GS_) { const int e = EID[i]; const int pos = atomic_add_i(fill + e, 1); DEST[i] = plan[e] + pos; }
}
__device__ __forceinline__ void ph_moe_gather(const Ctx& c) {
    const int* DEST = WSI(O_DEST); const u32x4* H = (const u32x4*)WSH(O_H); u32x4* XS = (u32x4*)WSH(O_XS);
    for (long i = GT_; i < (long)T * 2 * (D / 8); i += GS_) { const int q = (int)(i % (D / 8)); const long a = i / (D / 8); XS[(size_t)DEST[a] * (D / 8) + q] = H[(size_t)(a >> 1) * (D / 8) + q]; }
}
#ifndef CPU_EMU
#define XB_TMO      128
#define XB_XCNT(j)  (256  + 64 * (j))
#define XB_XSUB(j)  (1280 + 64 * (j))
#define XB_XGEN(j)  (2304 + 64 * (j))
#define XB_TOP      3328
#define XB_TOPGEN   3392
#define XCD_BAR_WORDS 3456
#define XB_SPIN_CAP (1u << 26)
#define LAS __attribute__((address_space(3)))
__device__ __forceinline__ unsigned xb_ld(unsigned* p)              { return __hip_atomic_load(p, __ATOMIC_RELAXED, __HIP_MEMORY_SCOPE_AGENT); }
__device__ __forceinline__ unsigned xb_add(unsigned* p, unsigned v) { return __hip_atomic_fetch_add(p, v, __ATOMIC_RELAXED, __HIP_MEMORY_SCOPE_AGENT); }
__device__ __forceinline__ unsigned xb_xcc_id() { return (unsigned)__builtin_amdgcn_s_getreg((3 << 11) | 20) & 0xFu; }
#define XB_SPIN(cond, bar) do { unsigned _sp = 0; while (cond) { __builtin_amdgcn_s_sleep(1); \
    if ((++_sp & 255u) == 0u) { if (xb_ld(&(bar)[XB_TMO])) break; if (_sp > XB_SPIN_CAP) { atomicAdd(&(bar)[XB_TMO], 1u); break; } } } } while (0)
struct XcdBarrier { unsigned* bar; unsigned x; volatile LAS unsigned* st; };
__device__ __forceinline__ XcdBarrier xcd_barrier_post(unsigned* bar, volatile LAS unsigned* st) {
    XcdBarrier b; b.bar = bar; b.x = xb_xcc_id(); b.st = st;
    if (threadIdx.x == 0) (void)xb_add(&bar[XB_XCNT(b.x)], 1u);
    return b;
}
__device__ __forceinline__ void xcd_barrier_complete(unsigned* bar, unsigned x, unsigned& nloc, unsigned& nx) {
    const unsigned G = gridDim.x * gridDim.y * gridDim.z;
    unsigned sum, cnt, mine, sp = 0u;
    for (;;) {
        sum = 0u; cnt = 0u; mine = 0u;
#pragma unroll
        for (unsigned j = 0; j < 16; ++j) { const unsigned cc = xb_ld(&bar[XB_XCNT(j)]); sum += cc; cnt += (cc > 0u) ? 1u : 0u; mine = (j == x) ? cc : mine; }
        if (sum == G) break;
        __builtin_amdgcn_s_sleep(1);
        if ((++sp & 255u) == 0u) { if (xb_ld(&bar[XB_TMO])) break; if (sp > XB_SPIN_CAP) { atomicAdd(&bar[XB_TMO], 1u); break; } }
    }
    nloc = mine > 0u ? mine : 1u; nx = cnt > 0u ? cnt : 1u;
}
__device__ __forceinline__ void xcd_barrier(const XcdBarrier& b) {
    asm volatile("s_waitcnt vmcnt(0)" ::: "memory");
    __syncthreads();
    if (threadIdx.x == 0) {
        unsigned* bar = b.bar;
        __builtin_amdgcn_s_waitcnt(0);
        unsigned nloc = b.st[0], nx = b.st[1];
        if (nloc == 0u) { xcd_barrier_complete(bar, b.x, nloc, nx); b.st[0] = nloc; b.st[1] = nx; }
        const unsigned old = xb_add(&bar[XB_XSUB(b.x)], 1u);
        const unsigned gen = old / nloc;
        if (old + 1u == (gen + 1u) * nloc) {
            __builtin_amdgcn_fence(__ATOMIC_RELEASE, "agent");
            asm volatile("s_waitcnt vmcnt(0)" ::: "memory");
            const unsigned og = xb_add(&bar[XB_TOP], 1u);
            const unsigned tg = og / nx;
            if (og + 1u == (tg + 1u) * nx) xb_add(&bar[XB_TOPGEN], 1u);
            else XB_SPIN(xb_ld(&bar[XB_TOPGEN]) == tg, bar);
            __builtin_amdgcn_fence(__ATOMIC_ACQUIRE, "agent");
            xb_add(&bar[XB_XGEN(b.x)], 1u);
            asm volatile("s_waitcnt vmcnt(0)" ::: "memory");
        } else {
            XB_SPIN(xb_ld(&bar[XB_XGEN(b.x)]) == gen, bar);
            __builtin_amdgcn_fence(__ATOMIC_ACQUIRE, "agent");
            asm volatile("s_waitcnt vmcnt(0)" ::: "memory");
        }
    }
    __syncthreads();
}
#endif

constexpr int LDS_BYTES = 147456;

__global__ void __launch_bounds__(NT, 2) fwd(Params p) {
#ifdef CPU_EMU
    unsigned char* lds = g_lds; float* ldsf = (float*)g_lds;
#else
    extern __shared__ __attribute__((aligned(16))) unsigned char lds[];
    float* ldsf = (float*)lds;
    volatile LAS unsigned* misc = (volatile LAS unsigned*)((LAS unsigned char*)lds + LDS_BYTES - 64);
    if (threadIdx.x == 0) { misc[0] = 0u; misc[1] = 0u; }
    __syncthreads();
    XcdBarrier bar = xcd_barrier_post((unsigned*)(p.ws + O_CTL) + CW_BAR, misc);
#endif
    Ctx c; c.in = p.in; c.out = p.out; c.ws = p.ws;
    const int lo = p.ph_lo, hi = p.ph_hi; int ph = 0;
    const int G = (int)gridDim.x, cwg = (int)blockIdx.x;
#ifdef CPU_EMU
#define GRID_BAR()
#else
#define GRID_BAR() xcd_barrier(bar)
#endif
#define PHASE(...) do { if (lo <= ph && ph < hi) { __VA_ARGS__; if (ph + 1 < hi) { GRID_BAR(); } } ++ph; } while (0)
    PHASE(ph_mod(c, ldsf));
#define LAYER_BODY(l) do { const float* mod = WSF(O_MOD); \
        const float* xin = l == 0 ? c.in[0] : WSF(O_X1); float* xmid = WSF(O_X0); float* xout = WSF(O_X1); \
        const float* ml = mod + (size_t)l * NB * D6; \
        PHASE(ph_convert(c, l, ldsf)); \
        PHASE({ pg8::Gemm g{D, D, D}; pg8::StaticOrder so; so.init(T, PW, G, cwg, WSH(O_H), WSH(O_WIN), D, D); pg8::EpiBf16 E{WSH(O_P), PW}; pg8::gemm_phase(lds, g, so, E); }); \
        PHASE(ph_lru_gate(c, l, ldsf)); \
        PHASE(ph_lru_scan1(c)); \
        PHASE(ph_lru_scan2(c)); \
        PHASE(ph_lru_scan3(c)); \
        PHASE(ph_ret_kv(c, ldsf)); \
        PHASE(ph_ret_state(c)); \
        PHASE(ph_ret_out(c, ldsf)); \
        PHASE(ph_sgu_norm(c, l)); \
        PHASE(ph_sgu_mix(c, l, ldsf)); \
        PHASE(ph_rw_shift(c, l)); \
        PHASE(ph_rw_lora(c, l, ldsf)); \
        PHASE(ph_rw_prep(c, l)); \
        PHASE(ph_rw_scan(c, ldsf)); \
        PHASE(ph_rw_out(c)); \
        PHASE({ pg8::Gemm g{W, 4 * W, 4 * W}; pg8::MergeOrder mo; mo.so.init(T, D, G, cwg, WSH(O_YS), WSH(O_WBR), 4 * W, 4 * W); mo.kseg_bytes = W * 2; pg8::EpiMerge E{WSH(O_P), WSF(O_PART), WSH(O_MRG)}; pg8::gemm_phase(lds, g, mo, E); }); \
        PHASE({ pg8::Gemm g{D, D, D}; pg8::StaticOrder so; so.init(T, D, G, cwg, WSH(O_MRG), WSH(O_WOUT), D, D); pg8::EpiResid E{xin, ml + 2 * D, xmid}; pg8::gemm_phase(lds, g, so, E); }); \
        PHASE(ph_norm(c, xmid, c.in[4] + (size_t)l * D, ml + 3 * D, ml + 4 * D, WSH(O_H), WSF(O_HF))); \
        PHASE(ph_router(c, l)); \
        PHASE(ph_moe_plan(c, l)); \
        PHASE(ph_moe_assign(c, l)); \
        PHASE(ph_moe_gather(c)); \
        const int* plan = CTLW(c) + CW_PLAN + l * 256; \
        PHASE({ pg8::Gemm g{D, D, D}; pg8::MoeOrder mo{G, cwg, 4, plan, (const char*)WSH(O_XS), (const char*)WSH(O_WGU), (size_t)256 * D * 2, (size_t)256 * D * 2, (size_t)1024 * D * 2}; pg8::EpiGU E{WSH(O_ACT)}; pg8::gemm_phase(lds, g, mo, E); }); \
        PHASE({ pg8::Gemm g{512, 512, 512}; pg8::MoeOrder mo{G, cwg, 8, plan, (const char*)WSH(O_ACT), (const char*)WSH(O_WDN), (size_t)256 * 512 * 2, (size_t)256 * 512 * 2, (size_t)D * 512 * 2}; pg8::EpiBf16 E{WSH(O_YE), D}; pg8::gemm_phase(lds, g, mo, E); }); \
        if (l == 0) PHASE(ph_comb_norm<0>(c, xmid, ml + 5 * D, xout, c.in[3] + (size_t)1 * D, mod + (size_t)1 * NB * D6 + 0 * D, mod + (size_t)1 * NB * D6 + 1 * D, WSH(O_H), nullptr)); \
        else PHASE(ph_comb_norm<1>(c, xmid, ml + 5 * D, xout, c.in[36], nullptr, nullptr, nullptr, c.out)); \
    } while (0)
    PHASE(ph_norm(c, c.in[0], c.in[3], WSF(O_MOD) + 0 * D, WSF(O_MOD) + 1 * D, WSH(O_H), nullptr));
    LAYER_BODY(0);
    LAYER_BODY(1);
#undef LAYER_BODY
#undef PHASE
}
}

#ifndef CPU_EMU
extern "C" void kernel_launch(void* const* d_in, const int* in_sizes, int n_in, void* d_out, int out_size, void* d_ws, size_t ws_size, hipStream_t stream) {
    static int grid = 0;
    if (grid == 0) {
        if (n_in != 37 || out_size != T * D || ws_size < WS_END) { fprintf(stderr, "kernel_launch: unexpected shapes (n_in %d out %d ws %zu need %zu)\n", n_in, out_size, ws_size, (size_t)WS_END); grid = -1; return; }
        int dev = 0, cus = 0, per_cu = 0;
        if (hipGetDevice(&dev) != hipSuccess || hipDeviceGetAttribute(&cus, hipDeviceAttributeMultiprocessorCount, dev) != hipSuccess) { grid = -1; return; }
        if (hipFuncSetAttribute((const void*)fwd, hipFuncAttributeMaxDynamicSharedMemorySize, LDS_BYTES) != hipSuccess) { fprintf(stderr, "kernel_launch: hipFuncSetAttribute failed\n"); grid = -1; return; }
        if (hipOccupancyMaxActiveBlocksPerMultiprocessor(&per_cu, (const void*)fwd, NT, LDS_BYTES) != hipSuccess || per_cu < 1) fprintf(stderr, "kernel_launch: occupancy query says %d\n", per_cu);
        (void)hipGetLastError();
        grid = cus;
    }
    if (grid < 0) return;
    (void)in_sizes;
    (void)hipMemsetAsync((char*)d_ws + O_CTL, 0, CTL_BYTES, stream);
    Params p{};
    for (int i = 0; i < 37; ++i) p.in[i] = (const float*)d_in[i];
    p.out = (float*)d_out; p.ws = (unsigned char*)d_ws;
#if ONE_LAUNCH
    p.ph_lo = 0; p.ph_hi = NPH;
    hipLaunchKernelGGL(fwd, dim3(grid), dim3(NT), LDS_BYTES, stream, p);
#else
    for (int k = 0; k < NPH; ++k) { p.ph_lo = k; p.ph_hi = k + 1; hipLaunchKernelGGL(fwd, dim3(grid), dim3(NT), LDS_BYTES, stream, p); }
#endif
}
#endif
```

```cpp
#ifndef CPU_EMU
#include <hip/hip_runtime.h>
#endif
#include <cstdio>
#include <cstdint>
#include <cmath>
#include <cstring>

#ifndef SEQ
#define SEQ 4096
#endif
#ifndef ONE_LAUNCH
#define ONE_LAUNCH 1
#endif

namespace {
constexpr int D = 2048, NB = 2, S = SEQ, T = NB * S, NL = 2, W = 1024;
constexpr int INW = 18816, RF = 3456, D6 = 6 * D;
constexpr int C_LX = 0, C_LG = 1024, C_RQ = 2048, C_RK = 2560, C_RV = 3072, C_RG = 4096, C_SU = 5120, C_SV = 6144, C_RW = 7168;
constexpr int PW = 18944, C_MLP = 10752;
constexpr int NCH = S / 128;
constexpr int NLC = S / 64;
constexpr int NE = 32, CAP = (T * 2 / 256 + NE) * 256, MAXBLK = CAP / 256;
constexpr float EPS = 1e-6f;
constexpr float DECAY_SCALE = 0.60653065971263342f;
constexpr int NT = 512;
constexpr int NPH_LAYER = 17, NPH = 2 + NL * NPH_LAYER;
typedef unsigned short bf16_t;
#ifdef CPU_EMU
typedef float f32x4 __attribute__((vector_size(16)));
typedef unsigned u32x4 __attribute__((vector_size(16)));
#else
typedef float f32x4 __attribute__((ext_vector_type(4)));
typedef unsigned u32x4 __attribute__((ext_vector_type(4)));
typedef short bf16x8 __attribute__((ext_vector_type(8)));
#endif

constexpr size_t al256(size_t x) { return (x + 255) & ~(size_t)255; }
constexpr size_t SZ_X = (size_t)T * D * 4, SZ_W = (size_t)T * W * 4;
constexpr size_t O_CTL = 0, CTL_BYTES = 1u << 20;
constexpr size_t O_MOD = CTL_BYTES;
constexpr size_t O_X0 = O_MOD + al256((size_t)NL * NB * D6 * 4);
constexpr size_t O_X1 = O_X0 + SZ_X;
constexpr size_t O_H = O_X1 + SZ_X;
constexpr size_t O_HF = O_H + SZ_X / 2;
constexpr size_t O_P = O_HF + SZ_X;
constexpr size_t SZ_P = (size_t)T * PW * 2;
constexpr size_t O_XC = O_P + SZ_P;
constexpr size_t O_LA = O_XC + SZ_W, O_LU = O_LA + 2 * SZ_W;
constexpr size_t SZ_LC = (size_t)2 * NB * NLC * W * 4;
constexpr size_t O_LCA = O_LU + 2 * SZ_W, O_LCH = O_LCA + SZ_LC, O_LCI = O_LCH + SZ_LC;
constexpr size_t O_YS = O_LCI + SZ_LC;
constexpr size_t O_SC = O_YS + (size_t)T * 4 * W * 2;
constexpr size_t SZ_KV = (size_t)NB * NCH * 8 * 64 * 128 * 4;
constexpr size_t O_KVF = O_SC, O_KVB = O_KVF + SZ_KV, O_STF = O_KVB + SZ_KV, O_STB = O_STF + SZ_KV;
constexpr size_t O_VN = O_STB + SZ_KV;
constexpr size_t O_FS = O_VN + SZ_W;
constexpr size_t O_DEC = O_FS + al256((size_t)T * RF * 4), O_AA = O_DEC + 2 * SZ_W, O_AKK = O_AA + 2 * SZ_W;
constexpr size_t O_GG = O_AKK, O_YY = O_GG + SZ_W;
constexpr int RCK = 64, NRC = S / RCK;
constexpr size_t O_BON = O_YY + 2 * SZ_W;
constexpr size_t O_PART = O_BON + al256((size_t)2 * T * 16 * 4);
constexpr size_t O_MRG = O_PART + SZ_X;
constexpr size_t O_LOG = O_MRG + SZ_X / 2;
constexpr size_t O_EID = O_LOG + al256((size_t)T * 40 * 4), O_EWT = O_EID + al256((size_t)T * 2 * 4), O_DEST = O_EWT + al256((size_t)T * 2 * 4);
constexpr size_t O_SLOT = O_DEST + al256((size_t)T * 2 * 4);
constexpr size_t O_PST = O_SLOT + al256((size_t)CAP * 4), O_PYT = O_PST + (size_t)64 * NRC * 4096 * 2, O_SVB = O_PYT + (size_t)64 * NRC * 4096 * 2, O_YVB = O_SVB + (size_t)64 * NRC * 4096 * 4;
constexpr size_t O_WIN = O_YVB + (size_t)64 * NRC * 4096 * 4;
constexpr size_t O_WBR = O_WIN + (size_t)PW * D * 2;
constexpr size_t O_WOUT = O_WBR + (size_t)D * 4 * W * 2;
constexpr size_t O_WGU = O_WOUT + (size_t)D * D * 2;
constexpr size_t O_WDN = O_WGU + (size_t)NE * 1024 * D * 2;
constexpr size_t O_WLR = O_WDN + (size_t)NE * D * 512 * 2;
constexpr size_t O_WUT = O_WLR + (size_t)32 * 128 * 128 * 2;
constexpr size_t O_WAT = O_WUT + (size_t)2 * W * 64 * 2;
constexpr size_t O_WGT = O_WAT + (size_t)2 * W * 64 * 2;
constexpr size_t O_WRH = O_WGT + (size_t)W * 128 * 2;
constexpr size_t O_WRL = O_WRH + (size_t)48 * D * 2;
constexpr size_t WS_END0 = O_WRL + (size_t)48 * D * 2;
constexpr size_t SZ_MOE = (size_t)CAP * (D + 512 + D) * 2;
constexpr bool MOE_OVERLAY = SZ_MOE <= SZ_P;
constexpr size_t O_XS = MOE_OVERLAY ? O_P : WS_END0;
constexpr size_t O_ACT = O_XS + (size_t)CAP * D * 2;
constexpr size_t O_YE = O_ACT + (size_t)CAP * 512 * 2;
constexpr size_t WS_END = MOE_OVERLAY ? WS_END0 : WS_END0 + SZ_MOE;
static_assert(SEQ != 4096 || WS_END <= (size_t)2040 * 1024 * 1024, "workspace budget: d_ws is 4 x the largest input = 2048 MiB");
constexpr int CW_BAR = 4096;
constexpr int CW_CNT = 32768;
constexpr int CW_FILL = CW_CNT + NL * 64;
constexpr int CW_PLAN = CW_FILL + NL * 64;
static_assert(MAXBLK <= 160, "plan words");

struct Params { const float* in[37]; float* out; unsigned char* ws; int ph_lo, ph_hi; };

struct Ctx { const float* const* in; float* out; unsigned char* ws; };
#define GT_ ((long)blockIdx.x * NT + threadIdx.x)
#define GS_ ((long)gridDim.x * NT)
#define WSF(off) ((float*)(c.ws + (off)))
#define WSI(off) ((int*)(c.ws + (off)))
#define WSH(off) ((bf16_t*)(c.ws + (off)))
#define CTLW(c) ((int*)((c).ws + O_CTL))

__device__ __forceinline__ float sigmoidf_(float x) { return 1.f / (1.f + expf(-x)); }
__device__ __forceinline__ float siluf_(float x) { return x / (1.f + expf(-x)); }
__device__ __forceinline__ float geluf_(float x) { return 0.5f * x * (1.f + tanhf(0.7978845608028654f * (x + 0.044715f * x * x * x))); }
__device__ __forceinline__ float softplusf_(float x) { return x > 0.f ? x + log1pf(expf(-x)) : log1pf(expf(x)); }
__device__ __forceinline__ float loggamma_(int h) { return log1pf(-exp2f(-5.f - (float)h)); }
__device__ __forceinline__ unsigned f2u_(float f) { unsigned u; memcpy(&u, &f, 4); return u; }
__device__ __forceinline__ float u2f_(unsigned u) { float f; memcpy(&f, &u, 4); return f; }
__device__ __forceinline__ float bf2f(bf16_t v) { return u2f_((unsigned)v << 16); }
__device__ __forceinline__ unsigned f2bf(float f) { const unsigned u = f2u_(f); return (u + 0x7fffu + ((u >> 16) & 1u)) >> 16; }
__device__ __forceinline__ unsigned pk2(float lo, float hi) { return f2bf(lo) | (f2bf(hi) << 16); }
__device__ __forceinline__ float bflo(unsigned w) { return u2f_(w << 16); }
__device__ __forceinline__ float bfhi(unsigned w) { return u2f_(w & 0xffff0000u); }
__device__ __forceinline__ int atomic_add_i(int* p, int v) {
#ifdef CPU_EMU
    return __atomic_fetch_add(p, v, __ATOMIC_RELAXED);
#else
    return atomicAdd(p, v);
#endif
}
#define PF(P, r, col) bf2f((P)[(size_t)(r) * PW + (col)])
#ifdef CPU_EMU
#define SYNCTHREADS() emu_syncthreads()
#define SHFL_XOR(v, m) emu_shfl_xor(v, m)
#else
#define SYNCTHREADS() __syncthreads()
#define SHFL_XOR(v, m) __shfl_xor(v, m)
#endif
__device__ __forceinline__ float wave_sum(float v) {
#pragma unroll
    for (int o = 1; o < 64; o <<= 1) v += SHFL_XOR(v, o);
    return v;
}
__device__ __forceinline__ f32x4 ld_bf4(const bf16_t* p) { const unsigned long long q = *(const unsigned long long*)p; const unsigned lo = (unsigned)q, hi = (unsigned)(q >> 32); return (f32x4){bflo(lo), bfhi(lo), bflo(hi), bfhi(hi)}; }
__device__ __forceinline__ void st_bf4(bf16_t* p, const f32x4 v) { *(unsigned long long*)p = (unsigned long long)pk2(v[0], v[1]) | ((unsigned long long)pk2(v[2], v[3]) << 32); }

template <int KT, int NTL>
__device__ __forceinline__ void wave_mma(f32x4 (&acc)[NTL], const bf16_t* A, int lda, const bf16_t* Bt, int ldb) {
    const int lane = threadIdx.x & 63, fr = lane & 15, fq = lane >> 4;
#ifdef CPU_EMU
    for (int nt = 0; nt < NTL; ++nt) for (int r = 0; r < 4; ++r) { float sacc = 0.f; const bf16_t* a = A + fr * lda; const bf16_t* b = Bt + (16 * nt + 4 * fq + r) * ldb;
        for (int k = 0; k < 32 * KT; ++k) sacc += bf2f(a[k]) * bf2f(b[k]);
        acc[nt][r] += sacc; }
#else
#pragma unroll
    for (int kt = 0; kt < KT; ++kt) {
        const bf16x8 af = *(const bf16x8*)(A + fr * lda + kt * 32 + fq * 8);
#pragma unroll
        for (int nt = 0; nt < NTL; ++nt) { const bf16x8 bfr = *(const bf16x8*)(Bt + (16 * nt + fr) * ldb + kt * 32 + fq * 8);
            acc[nt] = __builtin_amdgcn_mfma_f32_16x16x32_bf16(bfr, af, acc[nt], 0, 0, 0); }
    }
#endif
}
__device__ __forceinline__ void ph_mod(const Ctx& c, float* ldsf) {
    const float* cc = c.in[1]; const float* aw = c.in[5]; const float* ab = c.in[6]; float* mod = WSF(O_MOD);
    float* scs = ldsf; float* part = ldsf + NB * D; const int tid = threadIdx.x, c4 = (tid & 31) * 4, kq = tid >> 5;
    for (int i = tid; i < NB * D; i += NT) scs[i] = siluf_(cc[i]);
    SYNCTHREADS();
    for (int u = blockIdx.x; u < NL * (D6 / 128); u += gridDim.x) {
        const int l = u / (D6 / 128), j0 = (u % (D6 / 128)) * 128;
        const float* w = aw + (size_t)l * D * D6 + j0 + c4; f32x4 a0 = (f32x4){0.f, 0.f, 0.f, 0.f}, a1 = a0;
#pragma unroll 8
        for (int k = kq * 128; k < kq * 128 + 128; ++k) { const f32x4 wv = *(const f32x4*)(w + (size_t)k * D6); a0 += wv * scs[k]; a1 += wv * scs[D + k]; }
        *(f32x4*)(part + (kq * 2 + 0) * 128 + c4) = a0; *(f32x4*)(part + (kq * 2 + 1) * 128 + c4) = a1;
        SYNCTHREADS();
        if (tid < 256) { const int b = tid >> 7, col = tid & 127; float sacc = 0.f;
#pragma unroll
            for (int q = 0; q < 16; ++q) sacc += part[(q * 2 + b) * 128 + col];
            mod[((size_t)l * NB + b) * D6 + j0 + col] = sacc + ab[l * D6 + j0 + col]; }
        SYNCTHREADS();
    }
}
__device__ __forceinline__ void ph_norm(const Ctx& c, const float* x, const float* g, const float* sh, const float* sc, bf16_t* hb, float* hf) {
    const int lane = threadIdx.x & 63, gw = blockIdx.x * (NT / 64) + (threadIdx.x >> 6), ngw = gridDim.x * (NT / 64);
    for (int t = gw; t < T; t += ngw) {
        const int b = t / S; const float* xr = x + (size_t)t * D; f32x4 v[8]; float ss = 0.f;
#pragma unroll
        for (int j = 0; j < 8; ++j) { v[j] = *(const f32x4*)(xr + (j * 64 + lane) * 4); ss += (v[j][0] * v[j][0] + v[j][1] * v[j][1]) + (v[j][2] * v[j][2] + v[j][3] * v[j][3]); }
        const float rs = 1.f / sqrtf(wave_sum(ss) * (1.f / D) + EPS);
#pragma unroll
        for (int j = 0; j < 8; ++j) { const int col = (j * 64 + lane) * 4;
            const f32x4 o = v[j] * rs * *(const f32x4*)(g + col) * (*(const f32x4*)(sc + b * D6 + col) + 1.f) + *(const f32x4*)(sh + b * D6 + col);
            st_bf4(hb + (size_t)t * D + col, o); if (hf) *(f32x4*)(hf + (size_t)t * D + col) = o; }
    }
}
template <int MODE>
__device__ __forceinline__ void ph_comb_norm(const Ctx& c, const float* xmid, const float* g2, float* xout, const float* g, const float* sh, const float* sc, bf16_t* hb, float* outp) {
    const bf16_t* YE = WSH(O_YE); const float* EWT = WSF(O_EWT); const int* DEST = WSI(O_DEST);
    const int lane = threadIdx.x & 63, gw = blockIdx.x * (NT / 64) + (threadIdx.x >> 6), ngw = gridDim.x * (NT / 64);
    for (int t = gw; t < T; t += ngw) {
        const int b = t / S; const float w0 = EWT[t * 2], w1 = EWT[t * 2 + 1]; const bf16_t* y0 = YE + (size_t)DEST[t * 2] * D; const bf16_t* y1 = YE + (size_t)DEST[t * 2 + 1] * D;
        f32x4 v[8]; float ss = 0.f;
#pragma unroll
        for (int j = 0; j < 8; ++j) { const int col = (j * 64 + lane) * 4;
            v[j] = *(const f32x4*)(xmid + (size_t)t * D + col) + *(const f32x4*)(g2 + b * D6 + col) * (ld_bf4(y0 + col) * w0 + ld_bf4(y1 + col) * w1);
            if (MODE == 0) *(f32x4*)(xout + (size_t)t * D + col) = v[j];
            ss += (v[j][0] * v[j][0] + v[j][1] * v[j][1]) + (v[j][2] * v[j][2] + v[j][3] * v[j][3]); }
        const float rs = 1.f / sqrtf(wave_sum(ss) * (1.f / D) + EPS);
#pragma unroll
        for (int j = 0; j < 8; ++j) { const int col = (j * 64 + lane) * 4;
            if (MODE == 0) st_bf4(hb + (size_t)t * D + col, v[j] * rs * *(const f32x4*)(g + col) * (*(const f32x4*)(sc + b * D6 + col) + 1.f) + *(const f32x4*)(sh + b * D6 + col));
            else *(f32x4*)(outp + (size_t)t * D + col) = v[j] * rs * *(const f32x4*)(g + col); }
    }
}

struct CvtItem { const float* Wp; int ldw; bf16_t* WT; int ldt; int drow, k0, n0; };
constexpr int I_IN = 32 * (INW / 32), I_BR = 4 * 16 * 64, I_OUT = 32 * 64, I_GU = NE * 32 * 32, I_DN = NE * 8 * 64, I_LR = 32 * 8, I_WU = 2 * 32, I_WG = 64, I_ALL = I_IN + I_BR + I_OUT + I_GU + I_DN + I_LR + 2 * I_WU + I_WG;
__device__ __forceinline__ CvtItem cvt_decode(const Ctx& c, int l, int it) {
    CvtItem r;
    if (it < I_IN) { const int kb = it / (INW / 32), nb = it % (INW / 32); r.n0 = nb * 32; r.k0 = kb * 64; r.Wp = c.in[7] + (size_t)l * D * INW; r.ldw = INW; r.WT = WSH(O_WIN); r.ldt = D; r.drow = r.n0 < 10624 ? r.n0 : r.n0 + 128; return r; }
    it -= I_IN;
    if (it < I_BR) { const int sgm = it / 1024, q = it % 1024, kb = q / 64, nb = q % 64; r.n0 = nb * 32; r.k0 = kb * 64; r.Wp = c.in[28] + ((size_t)l * 4 + sgm) * W * D; r.ldw = D; r.WT = WSH(O_WBR) + sgm * W; r.ldt = 4 * W; r.drow = r.n0; return r; }
    it -= I_BR;
    if (it < I_OUT) { const int kb = it / 64, nb = it % 64; r.n0 = nb * 32; r.k0 = kb * 64; r.Wp = c.in[29] + (size_t)l * D * D; r.ldw = D; r.WT = WSH(O_WOUT); r.ldt = D; r.drow = r.n0; return r; }
    it -= I_OUT;
    if (it < I_GU) { const int e = it / 1024, q = it % 1024, kb = q / 32, nb = q % 32; r.n0 = nb * 32; r.k0 = kb * 64; r.Wp = c.in[34] + ((size_t)l * NE + e) * D * 1024; r.ldw = 1024; r.WT = WSH(O_WGU) + (size_t)e * 1024 * D; r.ldt = D;
        r.drow = r.n0 < 512 ? (r.n0 / 128) * 256 + (r.n0 % 128) : ((r.n0 - 512) / 128) * 256 + 128 + ((r.n0 - 512) % 128); return r; }
    it -= I_GU;
    if (it < I_DN) { const int e = it / 512, q = it % 512, kb = q / 64, nb = q % 64; r.n0 = nb * 32; r.k0 = kb * 64; r.Wp = c.in[35] + ((size_t)l * NE + e) * 512 * D; r.ldw = D; r.WT = WSH(O_WDN) + (size_t)e * D * 512; r.ldt = 512; r.drow = r.n0; return r; }
    it -= I_DN;
    if (it < I_LR) { const int m = it / 8, q = it % 8, kb = q / 4, nb = q % 4, z = m >> 4, ty = (m >> 3) & 1, n = m & 7; r.n0 = nb * 32; r.k0 = kb * 64; r.Wp = c.in[ty ? 12 : 10] + (((size_t)l * 2 + z) * 8 + n) * 128 * 128; r.ldw = 128;
        r.WT = WSH(O_WLR) + (size_t)m * 128 * 128; r.ldt = 128; r.drow = r.n0; return r; }
    it -= I_LR;
    if (it < 2 * I_WU) { const int ua = it / I_WU, q = it % I_WU, z = q / 32, nb = q % 32; r.n0 = nb * 32; r.k0 = 0; r.Wp = c.in[ua ? 23 : 21] + ((size_t)l * 2 + z) * 64 * W; r.ldw = W; r.WT = WSH(ua ? O_WAT : O_WUT) + (size_t)z * W * 64; r.ldt = 64; r.drow = r.n0; return r; }
    it -= 2 * I_WU;
    { const int kb = it / 32, nb = it % 32; r.n0 = nb * 32; r.k0 = kb * 64; r.Wp = c.in[24] + (size_t)l * 128 * W; r.ldw = W; r.WT = WSH(O_WGT); r.ldt = 128; r.drow = r.n0; return r; }
}
__device__ __forceinline__ void ph_convert(const Ctx& c, int l, float* ldsf) {
    const int lane = threadIdx.x & 63, wave = threadIdx.x >> 6; const int gw = blockIdx.x * (NT / 64) + wave, ngw = gridDim.x * (NT / 64);
#ifdef CPU_EMU
    if (lane == 0) for (int it = gw; it < I_ALL; it += ngw) { const CvtItem r = cvt_decode(c, l, it);
        for (int kk = 0; kk < 64; ++kk) for (int nn = 0; nn < 32; ++nn) r.WT[(size_t)(r.drow + nn) * r.ldt + r.k0 + kk] = (bf16_t)f2bf(r.Wp[(size_t)(r.k0 + kk) * r.ldw + r.n0 + nn]); }
#else
    float* scr = ldsf + wave * (64 * 33 + 16);
    for (int it = gw; it < I_ALL; it += ngw) {
        const CvtItem r = cvt_decode(c, l, it);
#pragma unroll 8
        for (int i = 0; i < 32; ++i) { const int kk = 2 * i + (lane >> 5); scr[kk * 33 + (lane & 31)] = r.Wp[(size_t)(r.k0 + kk) * r.ldw + r.n0 + (lane & 31)]; }
        asm volatile("s_waitcnt lgkmcnt(0)" ::: "memory");
        const int cc = lane & 7;
#pragma unroll
        for (int j = 0; j < 4; ++j) { const int n = (lane >> 3) + 8 * j; const float* sp = scr + (8 * cc) * 33 + n;
            u32x4 o; o[0] = pk2(sp[0 * 33], sp[1 * 33]); o[1] = pk2(sp[2 * 33], sp[3 * 33]); o[2] = pk2(sp[4 * 33], sp[5 * 33]); o[3] = pk2(sp[6 * 33], sp[7 * 33]);
            *(u32x4*)(r.WT + (size_t)(r.drow + n) * r.ldt + r.k0 + 8 * cc) = o; }
        asm volatile("s_waitcnt lgkmcnt(0)" ::: "memory");
    }
#endif
    { const float* wg = c.in[30] + (size_t)l * D * 4; const float* we = c.in[32] + (size_t)l * D * 32; bf16_t* wh = WSH(O_WRH); bf16_t* wl = WSH(O_WRL);
      for (long i = GT_; i < (long)48 * D; i += GS_) { const int n = (int)(i / D), k = (int)(i % D); const float w = n < 4 ? wg[k * 4 + n] : n < 36 ? we[k * 32 + (n - 4)] : 0.f; const unsigned hb = f2bf(w); wh[i] = (bf16_t)hb; wl[i] = (bf16_t)f2bf(w - bf2f((bf16_t)hb)); } }
    for (long i = GT_; i < (long)128 * D / 2; i += GS_) ((unsigned*)(WSH(O_WIN) + (size_t)10624 * D))[i] = 0u;
}

namespace pg8 {
constexpr int BM = 256, BK = 64, HALF = 128, HTB = HALF * BK * 2, STAGE_BYTES = 8 * HTB;
__host__ __device__ __forceinline__ int lds_byte(int r, int cc) { const int st = (r >> 4) * 2 + (cc >> 5), rr = r & 15, c2 = cc & 31, ob = rr * 64 + c2 * 2; return st * 1024 + (ob ^ (((ob >> 9) & 1) << 5)); }
__host__ __device__ __forceinline__ void stage_rc(int b, int& R, int& C) { const int st = b / 1024, sb = b % 1024, swz = sb ^ (((sb >> 9) & 1) << 5); R = (st >> 1) * 16 + swz / 64; C = (st & 1) * 32 + (swz % 64) / 2; }
__host__ __device__ __forceinline__ int perm32(int rho) { const int n = rho >> 4, i = rho & 15; return 8 * (i >> 2) + 4 * n + (i & 3); }
struct Unit { int pm, pn, aux; const char* A; const char* B; };
struct Gemm { int K, lda, ldb; };

template <class Epi, class Sched>
__device__ __forceinline__ void gemm_phase(unsigned char* lds_, const Gemm g, const Sched& S, const Epi& E) {
#ifdef CPU_EMU
    if (threadIdx.x != 0) return;
    Unit u; const int K = g.K;
    float* Af = (float*)malloc((size_t)256 * K * 4); float* Bf = (float*)malloc((size_t)256 * K * 4); float* Cf = (float*)malloc(256 * 256 * 4);
    for (int i = 0; S.next(i, u); ++i) {
        const bf16_t* A = (const bf16_t*)u.A; const bf16_t* B = (const bf16_t*)u.B;
        for (int r = 0; r < 256; ++r) for (int k = 0; k < K; ++k) { Af[(size_t)r * K + k] = bf2f(A[(size_t)r * g.lda + k]); Bf[(size_t)r * K + k] = bf2f(B[(size_t)r * g.ldb + k]); }
        for (int r = 0; r < 256; ++r) for (int cc = 0; cc < 256; ++cc) { const float* a = Af + (size_t)r * K; const float* b = Bf + (size_t)cc * K; float sacc = 0.f; for (int k = 0; k < K; ++k) sacc += a[k] * b[k]; Cf[r * 256 + cc] = sacc; }
        for (int wid = 0; wid < 8; ++wid) for (int lane = 0; lane < 64; ++lane) {
            const int wr = wid >> 2, wc = wid & 3, fr = lane & 15, fq = lane >> 4; f32x4 acc[2][2][4][2];
            for (int ai = 0; ai < 2; ++ai) for (int bj = 0; bj < 2; ++bj) for (int m = 0; m < 4; ++m) for (int n = 0; n < 2; ++n) for (int j = 0; j < 4; ++j) {
                const int r = 128 * ai + 64 * wr + 16 * m + fr, cc = 128 * bj + 32 * wc + (Epi::PERM ? 8 * fq + 4 * n + j : 16 * n + 4 * fq + j); acc[ai][bj][m][n][j] = Cf[r * 256 + cc]; }
            E(acc, u, wr, wc, fr, fq);
        }
    }
    free(Af); free(Bf); free(Cf);
#else
    typedef __attribute__((address_space(3))) unsigned char* ldsp_t;
    ldsp_t lds = (ldsp_t)lds_;
    const int tid = threadIdx.x, wid = __builtin_amdgcn_readfirstlane(tid >> 6), lane = tid & 63, wr = wid >> 2, wc = wid & 3, fr = lane & 15, fq = lane >> 4;
    const int K = g.K, nt = K / BK;
    unsigned voffA[2], voffB[2];
#pragma unroll
    for (int i = 0; i < 2; ++i) { int R, C; stage_rc(tid * 16 + i * 8192, R, C); const int Rb = Epi::PERM ? ((R & ~31) + perm32(R & 31)) : R;
        voffA[i] = (unsigned)(R * g.lda + C) * 2u; voffB[i] = (unsigned)(Rb * g.ldb + C) * 2u; }
    const size_t kstep = (size_t)(BK * 2);
    const size_t hstepA = (size_t)HALF * g.lda * 2, hstepB = (size_t)HALF * g.ldb * 2;
    const unsigned ldsw = (unsigned)wid * 1024u;
    const int aoff = lds_byte(wr * 64 + fr, fq * 8), boff = lds_byte(wc * 32 + fr, fq * 8);
#define PG8_SA(b, h) (((b) * 2 + (h)) * HTB)
#define PG8_SB(b, h) ((4 + (b) * 2 + (h)) * HTB)
#define PG8_STAGE(bufoff, gbase, voff) do { _Pragma("unroll") for (int _i = 0; _i < 2; ++_i) \
        __builtin_amdgcn_global_load_lds((const unsigned*)((const char*)(gbase) + (voff)[_i]), (__attribute__((address_space(3))) unsigned*)(lds + (bufoff) + ldsw + _i * 8192), 16, 0, 0); } while (0)
#define PG8_LDA(dst, b, h) do { _Pragma("unroll") for (int m = 0; m < 4; ++m) _Pragma("unroll") for (int k = 0; k < 2; ++k) dst[m][k] = *(const __attribute__((address_space(3))) bf16x8*)(lds + PG8_SA(b, h) + aoff + m * 2048 + k * 1024); } while (0)
#define PG8_LDB(dst, b, h) do { _Pragma("unroll") for (int n = 0; n < 2; ++n) _Pragma("unroll") for (int k = 0; k < 2; ++k) dst[n][k] = *(const __attribute__((address_space(3))) bf16x8*)(lds + PG8_SB(b, h) + boff + n * 2048 + k * 1024); } while (0)
#define PG8_MMA(ai, bj, At, Bt) do { __builtin_amdgcn_s_setprio(1); _Pragma("unroll") for (int m = 0; m < 4; ++m) _Pragma("unroll") for (int n = 0; n < 2; ++n) _Pragma("unroll") for (int k = 0; k < 2; ++k) \
        acc[ai][bj][m][n] = __builtin_amdgcn_mfma_f32_16x16x32_bf16(Bt[n][k], At[m][k], acc[ai][bj][m][n], 0, 0, 0); __builtin_amdgcn_s_setprio(0); } while (0)
#define PG8_WAIT_V(n) asm volatile("s_waitcnt vmcnt(" #n ")" ::: "memory")
#define PG8_WAIT_L(n) asm volatile("s_waitcnt lgkmcnt(" #n ")" ::: "memory")
#define PG8_BAR __builtin_amdgcn_s_barrier()
#define PG8_SCHED __builtin_amdgcn_sched_barrier(0)
    Unit cur, nxt; int ui = 0;
    if (!S.next(0, cur)) return;
    f32x4 acc[2][2][4][2];
#pragma unroll
    for (int a = 0; a < 2; ++a)
#pragma unroll
        for (int b = 0; b < 2; ++b)
#pragma unroll
            for (int m = 0; m < 4; ++m)
#pragma unroll
                for (int n = 0; n < 2; ++n) acc[a][b][m][n] = (f32x4){0.f, 0.f, 0.f, 0.f};
    bf16x8 At[4][2], B0[2][2], B1[2][2];
    const char* cA = cur.A; const char* cB = cur.B;
    S.a_ready(cur);
    PG8_STAGE(PG8_SB(0, 0), cB, voffB); PG8_STAGE(PG8_SA(0, 0), cA, voffA); PG8_STAGE(PG8_SB(0, 1), cB + hstepB, voffB); PG8_STAGE(PG8_SA(0, 1), cA + hstepA, voffA);
    if (wr == 1) PG8_BAR;
    PG8_WAIT_V(4); PG8_BAR;
    PG8_STAGE(PG8_SB(1, 0), cB + kstep, voffB); PG8_STAGE(PG8_SA(1, 0), cA + kstep, voffA); PG8_STAGE(PG8_SB(1, 1), cB + hstepB + kstep, voffB);
    PG8_WAIT_V(6); PG8_BAR;
    for (;;) {
        const bool has_next = S.next(ui + 1, nxt);
        const char* nA = has_next ? nxt.A : cA; const char* nB = has_next ? nxt.B : cB;
        for (int t = 0; t < nt; t += 2) {
            const bool last = (t == nt - 2);
            const char* a1 = cA + (size_t)(t + 1) * kstep;
            const char* a2 = last ? nA : cA + (size_t)(t + 2) * kstep; const char* b2 = last ? nB : cB + (size_t)(t + 2) * kstep;
            const char* a3 = a2 + kstep; const char* b3 = b2 + kstep;
            if (last && has_next) S.a_ready(nxt);
            PG8_LDB(B0, 0, 0); PG8_SCHED; PG8_LDA(At, 0, 0); PG8_STAGE(PG8_SA(1, 1), a1 + hstepA, voffA);
            PG8_WAIT_L(8); PG8_BAR; PG8_WAIT_L(0); PG8_MMA(0, 0, At, B0); PG8_BAR; PG8_SCHED;
            PG8_LDB(B1, 0, 1); PG8_STAGE(PG8_SB(0, 0), b2, voffB);
            PG8_BAR; PG8_WAIT_L(0); PG8_MMA(0, 1, At, B1); PG8_BAR;
            PG8_LDA(At, 0, 1); PG8_STAGE(PG8_SA(0, 0), a2, voffA);
            PG8_BAR; PG8_WAIT_L(0); PG8_MMA(1, 0, At, B0); PG8_BAR; PG8_SCHED;
            PG8_STAGE(PG8_SB(0, 1), b2 + hstepB, voffB);
            PG8_WAIT_V(6); PG8_BAR; PG8_MMA(1, 1, At, B1); PG8_BAR;
            PG8_LDB(B0, 1, 0); PG8_SCHED; PG8_LDA(At, 1, 0); PG8_STAGE(PG8_SA(0, 1), a2 + hstepA, voffA);
            PG8_WAIT_L(8); PG8_BAR; PG8_WAIT_L(0); PG8_MMA(0, 0, At, B0); PG8_BAR; PG8_SCHED;
            PG8_LDB(B1, 1, 1); PG8_STAGE(PG8_SB(1, 0), b3, voffB);
            PG8_BAR; PG8_WAIT_L(0); PG8_MMA(0, 1, At, B1); PG8_BAR;
            PG8_LDA(At, 1, 1); PG8_STAGE(PG8_SA(1, 0), a3, voffA);
            PG8_BAR; PG8_WAIT_L(0); PG8_MMA(1, 0, At, B0); PG8_BAR; PG8_SCHED;
            PG8_STAGE(PG8_SB(1, 1), b3 + hstepB, voffB);
            PG8_WAIT_V(6); PG8_BAR; PG8_MMA(1, 1, At, B1); PG8_BAR;
        }
        E(acc, cur, wr, wc, fr, fq); S.done(cur);
        if (!has_next) break;
#pragma unroll
        for (int a = 0; a < 2; ++a)
#pragma unroll
            for (int b = 0; b < 2; ++b)
#pragma unroll
                for (int m = 0; m < 4; ++m)
#pragma unroll
                    for (int n = 0; n < 2; ++n) acc[a][b][m][n] = (f32x4){0.f, 0.f, 0.f, 0.f};
        cur = nxt; cA = nA; cB = nB; ++ui;
    }
    PG8_WAIT_V(0);
    if (wr == 0) PG8_BAR;
    PG8_BAR;
#undef PG8_SA
#undef PG8_SB
#undef PG8_STAGE
#undef PG8_LDA
#undef PG8_LDB
#undef PG8_MMA
#undef PG8_WAIT_V
#undef PG8_WAIT_L
#undef PG8_BAR
#undef PG8_SCHED
#endif
}

struct StaticOrder {
    int nM, nN, nwg, G, c; const char* A; const char* B; size_t tstepA, tstepB;
    __device__ __forceinline__ void init(int M, int N, int G_, int c_, const void* A_, const void* B_, int lda, int ldb) { nM = M / BM; nN = N / BM; nwg = nM * nN; G = G_; c = c_; A = (const char*)A_; B = (const char*)B_; tstepA = (size_t)BM * lda * 2; tstepB = (size_t)BM * ldb * 2; }
    __device__ __forceinline__ bool next(int i, Unit& u) const {
        const long L = (long)i * G + c; if (L >= nwg) return false;
        int wgid = (int)L; { const int q = nwg / 8, r = nwg % 8, xcd = wgid % 8, off = wgid / 8; wgid = (xcd < r ? xcd * (q + 1) : r * (q + 1) + (xcd - r) * q) + off; }
        const int nig = 8 * nN, gid = wgid / nig, fm = gid * 8, gsz = (nM - fm) < 8 ? (nM - fm) : 8;
        u.pm = fm + ((wgid % nig) % gsz); u.pn = (wgid % nig) / gsz; u.aux = 0; u.A = A + (size_t)u.pm * tstepA; u.B = B + (size_t)u.pn * tstepB; return true;
    }
    __device__ __forceinline__ void a_ready(const Unit&) const {}
    __device__ __forceinline__ void done(const Unit&) const {}
};
struct MergeOrder {
    StaticOrder so; int kseg_bytes;
    __device__ __forceinline__ bool next(int i, Unit& u) const { if (!so.next(i >> 2, u)) return false; u.aux = i & 3; u.A += (size_t)u.aux * kseg_bytes; u.B += (size_t)u.aux * kseg_bytes; return true; }
    __device__ __forceinline__ void a_ready(const Unit&) const {}
    __device__ __forceinline__ void done(const Unit&) const {}
};
struct MoeOrder {
    int G, c, ncol; const int* plan; const char* A; const char* B; size_t tstepA, tstepB, estep;
    __device__ __forceinline__ bool next(int i, Unit& u) const {
        const long L = (long)i * G + c; const int nblk = plan[40]; if (L >= (long)nblk * ncol) return false;
        u.pm = (int)(L / ncol); u.pn = (int)(L % ncol); u.aux = plan[64 + u.pm]; u.A = A + (size_t)u.pm * tstepA; u.B = B + (size_t)u.aux * estep + (size_t)u.pn * tstepB; return true;
    }
    __device__ __forceinline__ void a_ready(const Unit&) const {}
    __device__ __forceinline__ void done(const Unit&) const {}
};

__device__ __forceinline__ u32x4 pack8(const f32x4 v0, const f32x4 v1) { u32x4 w; w[0] = pk2(v0[0], v0[1]); w[1] = pk2(v0[2], v0[3]); w[2] = pk2(v1[0], v1[1]); w[3] = pk2(v1[2], v1[3]); return w; }
struct EpiBf16 {
    static constexpr bool PERM = true; bf16_t* O; int ldc;
    __device__ __forceinline__ void operator()(const f32x4 (&acc)[2][2][4][2], const Unit& u, int wr, int wc, int fr, int fq) const {
        const int row0 = u.pm * BM + wr * 64 + fr, col0 = u.pn * BM + wc * 32 + 8 * fq;
#pragma unroll
        for (int ai = 0; ai < 2; ++ai)
#pragma unroll
            for (int m = 0; m < 4; ++m) { bf16_t* rowp = O + (size_t)(row0 + ai * HALF + m * 16) * ldc + col0;
#pragma unroll
                for (int bj = 0; bj < 2; ++bj) *(u32x4*)(rowp + bj * HALF) = pack8(acc[ai][bj][m][0], acc[ai][bj][m][1]); }
    }
};
struct EpiMerge {
    static constexpr bool PERM = true; const bf16_t* P; float* PART; bf16_t* MRG;
    __device__ __forceinline__ void operator()(const f32x4 (&acc)[2][2][4][2], const Unit& u, int wr, int wc, int fr, int fq) const {
        const int row0 = u.pm * BM + wr * 64 + fr, col0 = u.pn * BM + wc * 32 + 8 * fq, seg = u.aux;
#pragma unroll
        for (int ai = 0; ai < 2; ++ai)
#pragma unroll
            for (int m = 0; m < 4; ++m) { const size_t r = (size_t)(row0 + ai * HALF + m * 16);
#pragma unroll
                for (int bj = 0; bj < 2; ++bj) { const int cc = col0 + bj * HALF;
                    const u32x4 gw = *(const u32x4*)(P + r * PW + C_MLP + seg * D + cc);
                    f32x4 v0, v1;
#pragma unroll
                    for (int q = 0; q < 2; ++q) { v0[2 * q] = sigmoidf_(bflo(gw[q])) * acc[ai][bj][m][0][2 * q]; v0[2 * q + 1] = sigmoidf_(bfhi(gw[q])) * acc[ai][bj][m][0][2 * q + 1];
                        v1[2 * q] = sigmoidf_(bflo(gw[2 + q])) * acc[ai][bj][m][1][2 * q]; v1[2 * q + 1] = sigmoidf_(bfhi(gw[2 + q])) * acc[ai][bj][m][1][2 * q + 1]; }
                    float* pp = PART + r * D + cc;
                    if (seg > 0) { v0 += *(const f32x4*)pp; v1 += *(const f32x4*)(pp + 4); }
                    if (seg < 3) { *(f32x4*)pp = v0; *(f32x4*)(pp + 4) = v1; } else *(u32x4*)(MRG + r * D + cc) = pack8(v0, v1);
                }
#ifndef CPU_EMU
                asm volatile("" ::: "memory");
#endif
            }
    }
};
struct EpiResid {
    static constexpr bool PERM = false; const float* xin; const float* g1; float* xmid;
    __device__ __forceinline__ void operator()(const f32x4 (&acc)[2][2][4][2], const Unit& u, int wr, int wc, int fr, int fq) const {
        const int row0 = u.pm * BM + wr * 64 + fr, col0 = u.pn * BM + wc * 32 + 4 * fq;
#pragma unroll
        for (int ai = 0; ai < 2; ++ai)
#pragma unroll
            for (int m = 0; m < 4; ++m) { const int r = row0 + ai * HALF + m * 16; const float* gp = g1 + (size_t)(r / S) * D6;
#pragma unroll
                for (int bj = 0; bj < 2; ++bj)
#pragma unroll
                    for (int n = 0; n < 2; ++n) { const int cc = col0 + bj * HALF + n * 16; *(f32x4*)(xmid + (size_t)r * D + cc) = *(const f32x4*)(xin + (size_t)r * D + cc) + *(const f32x4*)(gp + cc) * acc[ai][bj][m][n]; }
#ifndef CPU_EMU
                asm volatile("" ::: "memory");
#endif
            }
    }
};
struct EpiGU {
    static constexpr bool PERM = true; bf16_t* ACT;
    __device__ __forceinline__ void operator()(const f32x4 (&acc)[2][2][4][2], const Unit& u, int wr, int wc, int fr, int fq) const {
        const int row0 = u.pm * BM + wr * 64 + fr, col0 = u.pn * HALF + wc * 32 + 8 * fq;
#pragma unroll
        for (int ai = 0; ai < 2; ++ai)
#pragma unroll
            for (int m = 0; m < 4; ++m) { f32x4 v0, v1;
#pragma unroll
                for (int j = 0; j < 4; ++j) { v0[j] = siluf_(acc[ai][0][m][0][j]) * acc[ai][1][m][0][j]; v1[j] = siluf_(acc[ai][0][m][1][j]) * acc[ai][1][m][1][j]; }
                *(u32x4*)(ACT + (size_t)(row0 + ai * HALF + m * 16) * 512 + col0) = pack8(v0, v1); }
    }
};
}

__device__ __forceinline__ void ph_lru_gate(const Ctx& c, int l, float* ldsf) {
    const bf16_t* P = WSH(O_P); const float* cw = c.in[8] + (size_t)l * 4 * W; const float* cb = c.in[9] + (size_t)l * W;
    const float* br = c.in[11] + (size_t)l * 2 * W; const float* bi = c.in[13] + (size_t)l * 2 * W; const float* lam = c.in[14] + (size_t)l * 2 * W; const bf16_t* WLR = WSH(O_WLR);
    float* LA = WSF(O_LA); float* LU = WSF(O_LU);
    bf16_t* Xs = (bf16_t*)ldsf; bf16_t* Wr = Xs + 128 * 136; bf16_t* Wi = Wr + 128 * 136;
    const int tid = threadIdx.x, wv = tid >> 6, lane = tid & 63, fr = lane & 15, fq = lane >> 4;
    for (int u = blockIdx.x; u < (T / 128) * 8; u += gridDim.x) {
        const int n = u & 7; const long t0 = (long)(u >> 3) * 128;
#pragma unroll 2
        for (int q = 0; q < 8; ++q) { const int id = tid + NT * q, tl = id >> 5, e4 = (id & 31) * 4, ch = n * 128 + e4; const long t = t0 + tl; const int sI = (int)(t % S);
            f32x4 acc = *(const f32x4*)(cb + ch);
#pragma unroll
            for (int k = 0; k < 4; ++k) { const int ss = sI + k - 2; if (ss >= 0 && ss < S) acc += ld_bf4(P + (size_t)(t + k - 2) * PW + C_LX + ch) * *(const f32x4*)(cw + k * W + ch); }
            st_bf4(Xs + tl * 136 + e4, acc); }
        for (int z = 0; z < 2; ++z) {
#pragma unroll
            for (int q = 0; q < 4; ++q) { const int id = tid + NT * q, f = id >> 4, e8 = (id & 15) * 8;
                *(u32x4*)(Wr + f * 136 + e8) = *(const u32x4*)(WLR + ((size_t)((z * 2 + 0) * 8 + n) * 128 + f) * 128 + e8); *(u32x4*)(Wi + f * 136 + e8) = *(const u32x4*)(WLR + ((size_t)((z * 2 + 1) * 8 + n) * 128 + f) * 128 + e8); }
            SYNCTHREADS();
            f32x4 ar[8], ai[8];
#pragma unroll
            for (int nt = 0; nt < 8; ++nt) { ar[nt] = (f32x4){0.f, 0.f, 0.f, 0.f}; ai[nt] = (f32x4){0.f, 0.f, 0.f, 0.f}; }
            wave_mma<4, 8>(ar, Xs + wv * 16 * 136, 136, Wr, 136);
            wave_mma<4, 8>(ai, Xs + wv * 16 * 136, 136, Wi, 136);
            const int tl = wv * 16 + fr;
#pragma unroll
            for (int nt = 0; nt < 8; ++nt) { const int f = 16 * nt + 4 * fq, ch = n * 128 + f;
                const f32x4 brv = *(const f32x4*)(br + z * W + ch), biv = *(const f32x4*)(bi + z * W + ch), lmv = *(const f32x4*)(lam + z * W + ch), xcv = ld_bf4(Xs + tl * 136 + f); f32x4 av, uv;
#pragma unroll
                for (int e = 0; e < 4; ++e) { const float r = sigmoidf_(ar[nt][e] + brv[e]), ig = sigmoidf_(ai[nt][e] + biv[e]), la = -8.f * r * softplusf_(-lmv[e]); av[e] = expf(la); uv[e] = sqrtf(-expm1f(2.f * la)) * ig * xcv[e]; }
                *(f32x4*)(LA + ((size_t)z * T + t0 + tl) * W + ch) = av; *(f32x4*)(LU + ((size_t)z * T + t0 + tl) * W + ch) = uv; }
            SYNCTHREADS();
        }
    }
}
__device__ __forceinline__ void ph_lru_scan1(const Ctx& c) {
    const float* LA = WSF(O_LA); const float* LU = WSF(O_LU); float* CA = WSF(O_LCA); float* CH = WSF(O_LCH);
    for (long i = GT_; i < (long)2 * NB * NLC * W; i += GS_) {
        const int w = (int)(i % W), ch = (int)((i / W) % NLC), b = (int)((i / ((long)W * NLC)) % NB), z = (int)(i / ((long)W * NLC * NB));
        const long t0 = (long)b * S + ch * 64; float prod = 1.f, h = 0.f;
        for (int q = 0; q < 64; ++q) { const int s = z == 0 ? q : 63 - q; const size_t idx = ((size_t)z * T + t0 + s) * W + w; const float a = LA[idx]; h = a * h + LU[idx]; prod *= a; }
        CA[i] = prod; CH[i] = h;
    }
}
__device__ __forceinline__ void ph_lru_scan2(const Ctx& c) {
    const float* CA = WSF(O_LCA); const float* CH = WSF(O_LCH); float* CI = WSF(O_LCI);
    for (long i = GT_; i < (long)2 * NB * W; i += GS_) {
        const int w = (int)(i % W), b = (int)((i / W) % NB), z = (int)(i / ((long)W * NB)); float carry = 0.f;
        for (int q = 0; q < NLC; ++q) { const int ch = z == 0 ? q : NLC - 1 - q; const size_t idx = (((size_t)z * NB + b) * NLC + ch) * W + w; CI[idx] = carry; carry = CA[idx] * carry + CH[idx]; }
    }
}
__device__ __forceinline__ void ph_lru_scan3(const Ctx& c) {
    const float* LA = WSF(O_LA); const float* LU = WSF(O_LU); const float* CI = WSF(O_LCI); const bf16_t* P = WSH(O_P); float* HFW = WSF(O_XC); bf16_t* Y = WSH(O_YS);
    for (long i = GT_; i < (long)NB * NLC * W; i += GS_) {
        const int w = (int)(i % W), ch = (int)((i / W) % NLC), b = (int)(i / ((long)W * NLC)); const long t0 = (long)b * S + ch * 64;
        float h = CI[(((size_t)0 * NB + b) * NLC + ch) * W + w];
        for (int s = 0; s < 64; ++s) { const size_t idx = ((size_t)(t0 + s)) * W + w; h = LA[idx] * h + LU[idx]; HFW[idx] = h; }
        h = CI[(((size_t)1 * NB + b) * NLC + ch) * W + w];
        for (int s = 63; s >= 0; --s) { const size_t idx = ((size_t)(t0 + s)) * W + w; h = LA[(size_t)T * W + idx] * h + LU[(size_t)T * W + idx];
            Y[(size_t)(t0 + s) * 4 * W + 0 * W + w] = (bf16_t)f2bf((HFW[idx] + h) * geluf_(PF(P, t0 + s, C_LG + w))); }
    }
}
__device__ __forceinline__ void ret_tables(float* tab, int h) {
    const int tid = threadIdx.x; const float lg = loggamma_(h);
    if (tid < 32) tab[tid] = powf(10000.f, -(float)(2 * tid) / 64.f);
    if (tid >= 64 && tid < 64 + 129) tab[tid] = expf((float)(tid - 64) * lg);
}
__device__ __forceinline__ void ph_ret_kv(const Ctx& c, float* ldsf) {
    const int* pos = (const int*)c.in[2]; const bf16_t* P = WSH(O_P); float* KVF = WSF(O_KVF); float* KVB = WSF(O_KVB);
    bf16_t* VT = (bf16_t*)ldsf; bf16_t* KF = VT + 128 * 136; bf16_t* KB = KF + 64 * 136; float* tab = (float*)(KB + 64 * 136);
    const int tid = threadIdx.x, wv = tid >> 6, lane = tid & 63, fr = lane & 15, fq = lane >> 4;
    for (int u = blockIdx.x; u < (T / 128) * 8; u += gridDim.x) {
        const int h = u & 7; const long t0 = (long)(u >> 3) * 128;
        ret_tables(tab, h);
        SYNCTHREADS();
#pragma unroll 1
        for (int q = 0; q < 8; ++q) { const int id = tid + NT * q, j = id & 127, dj = id >> 7; const float ang = (float)pos[t0 + j] * tab[dj]; const float cs = cosf(ang), sn = sinf(ang);
            const bf16_t* prow = P + (size_t)(t0 + j) * PW + C_RK + h * 64; const float x1 = bf2f(prow[dj]), x2 = bf2f(prow[dj + 32]), k1 = x1 * cs - x2 * sn, k2 = x2 * cs + x1 * sn, fj = tab[64 + 127 - j], bj = tab[64 + j];
            KF[dj * 136 + j] = (bf16_t)f2bf(k1 * fj); KF[(dj + 32) * 136 + j] = (bf16_t)f2bf(k2 * fj); KB[dj * 136 + j] = (bf16_t)f2bf(k1 * bj); KB[(dj + 32) * 136 + j] = (bf16_t)f2bf(k2 * bj); }
#pragma unroll
        for (int q = 0; q < 4; ++q) { const int id = tid + NT * q, j = id & 127, e8 = (id >> 7) * 8; const u32x4 raw = *(const u32x4*)(P + (size_t)(t0 + j) * PW + C_RV + h * 128 + e8);
#pragma unroll
            for (int e = 0; e < 4; ++e) { VT[(e8 + 2 * e) * 136 + j] = (bf16_t)(raw[e] & 0xffffu); VT[(e8 + 2 * e + 1) * 136 + j] = (bf16_t)(raw[e] >> 16); } }
        SYNCTHREADS();
        f32x4 af[4], ab[4];
#pragma unroll
        for (int nt = 0; nt < 4; ++nt) { af[nt] = (f32x4){0.f, 0.f, 0.f, 0.f}; ab[nt] = (f32x4){0.f, 0.f, 0.f, 0.f}; }
        wave_mma<4, 4>(af, VT + wv * 16 * 136, 136, KF, 136);
        wave_mma<4, 4>(ab, VT + wv * 16 * 136, 136, KB, 136);
        const size_t ob = (((size_t)(u >> 3) * 8 + h) * 128 + wv * 16 + fr) * 64 + 4 * fq;
#pragma unroll
        for (int nt = 0; nt < 4; ++nt) { *(f32x4*)(KVF + ob + 16 * nt) = af[nt]; *(f32x4*)(KVB + ob + 16 * nt) = ab[nt]; }
        SYNCTHREADS();
    }
}
__device__ __forceinline__ void ph_ret_state(const Ctx& c) {
    const float* KVF = WSF(O_KVF); const float* KVB = WSF(O_KVB); float* STF = WSF(O_STF); float* STB = WSF(O_STB);
    for (long i = GT_; i < (long)NB * 8 * 8192; i += GS_) {
        const int x = (int)(i % 8192), h = (int)((i / 8192) % 8), b = (int)(i / 65536);
        const float cd = expf(128.f * loggamma_(h)); float st = 0.f;
        for (int n = 0; n < NCH; ++n) { const size_t idx = (((size_t)b * NCH + n) * 8 + h) * 8192 + x; STF[idx] = st; st = cd * st + KVF[idx]; }
        st = 0.f;
        for (int n = NCH - 1; n >= 0; --n) { const size_t idx = (((size_t)b * NCH + n) * 8 + h) * 8192 + x; STB[idx] = st; st = cd * st + KVB[idx]; }
    }
}
__device__ __forceinline__ void ph_ret_out(const Ctx& c, float* ldsf) {
    const int* pos = (const int*)c.in[2]; const bf16_t* P = WSH(O_P); const float* STF = WSF(O_STF); const float* STB = WSF(O_STB); bf16_t* Y = WSH(O_YS);
    bf16_t* Qs = (bf16_t*)ldsf; bf16_t* Ks = Qs + 128 * 72; bf16_t* VT = Ks + 128 * 72; bf16_t* Ss = VT + 128 * 136; bf16_t* SF = Ss + 128 * 136; bf16_t* SB = SF + 128 * 72; float* tab = (float*)(SB + 128 * 72);
    const int tid = threadIdx.x, wv = tid >> 6, lane = tid & 63, fr = lane & 15, fq = lane >> 4;
    for (int u = blockIdx.x; u < (T / 128) * 8; u += gridDim.x) {
        const int h = u & 7; const long t0 = (long)(u >> 3) * 128;
        ret_tables(tab, h);
        SYNCTHREADS();
#pragma unroll 1
        for (int q = 0; q < 8; ++q) { const int id = tid + NT * q, j = id >> 5, dj = id & 31; const float ang = (float)pos[t0 + j] * tab[dj]; const float cs = cosf(ang), sn = sinf(ang);
            const bf16_t* prow = P + (size_t)(t0 + j) * PW; const float q1 = bf2f(prow[C_RQ + h * 64 + dj]), q2 = bf2f(prow[C_RQ + h * 64 + dj + 32]), k1 = bf2f(prow[C_RK + h * 64 + dj]), k2 = bf2f(prow[C_RK + h * 64 + dj + 32]);
            Qs[j * 72 + dj] = (bf16_t)f2bf((q1 * cs - q2 * sn) * 0.125f); Qs[j * 72 + dj + 32] = (bf16_t)f2bf((q2 * cs + q1 * sn) * 0.125f); Ks[j * 72 + dj] = (bf16_t)f2bf(k1 * cs - k2 * sn); Ks[j * 72 + dj + 32] = (bf16_t)f2bf(k2 * cs + k1 * sn); }
#pragma unroll
        for (int q = 0; q < 4; ++q) { const int id = tid + NT * q, j = id & 127, e8 = (id >> 7) * 8; const u32x4 raw = *(const u32x4*)(P + (size_t)(t0 + j) * PW + C_RV + h * 128 + e8);
#pragma unroll
            for (int e = 0; e < 4; ++e) { VT[(e8 + 2 * e) * 136 + j] = (bf16_t)(raw[e] & 0xffffu); VT[(e8 + 2 * e + 1) * 136 + j] = (bf16_t)(raw[e] >> 16); } }
        const size_t sbase = (((size_t)(u >> 3) * 8 + h)) * 8192;
#pragma unroll
        for (int q = 0; q < 4; ++q) { const int id = tid + NT * q, e = id >> 4, d4 = (id & 15) * 4; st_bf4(SF + e * 72 + d4, *(const f32x4*)(STF + sbase + (size_t)e * 64 + d4)); st_bf4(SB + e * 72 + d4, *(const f32x4*)(STB + sbase + (size_t)e * 64 + d4)); }
        SYNCTHREADS();
        const int i = wv * 16 + fr; const long t = t0 + i;
        {
            f32x4 sc[8];
#pragma unroll
            for (int nt = 0; nt < 8; ++nt) sc[nt] = (f32x4){0.f, 0.f, 0.f, 0.f};
            wave_mma<2, 8>(sc, Qs + wv * 16 * 72, 72, Ks, 72);
#pragma unroll
            for (int nt = 0; nt < 8; ++nt) { const int j0 = 16 * nt + 4 * fq; f32x4 sv;
#pragma unroll
                for (int e = 0; e < 4; ++e) { const int j = j0 + e, dist = i > j ? i - j : j - i; sv[e] = sc[nt][e] * tab[64 + dist]; }
                st_bf4(Ss + i * 136 + j0, sv); }
        }
#ifdef CPU_EMU
        SYNCTHREADS();
#else
        asm volatile("s_waitcnt lgkmcnt(0)" ::: "memory");
#endif
        f32x4 ao[8], tm[8];
#pragma unroll
        for (int nt = 0; nt < 8; ++nt) { ao[nt] = (f32x4){0.f, 0.f, 0.f, 0.f}; tm[nt] = (f32x4){0.f, 0.f, 0.f, 0.f}; }
        wave_mma<4, 8>(ao, Ss + wv * 16 * 136, 136, VT, 136);
        wave_mma<2, 8>(tm, Qs + wv * 16 * 72, 72, SF, 72);
        { const float qf = tab[64 + i + 1];
#pragma unroll
            for (int nt = 0; nt < 8; ++nt) { ao[nt] += tm[nt] * qf; tm[nt] = (f32x4){0.f, 0.f, 0.f, 0.f}; } }
        wave_mma<2, 8>(tm, Qs + wv * 16 * 72, 72, SB, 72);
        { const float qb = tab[64 + 128 - i];
#pragma unroll
            for (int nt = 0; nt < 8; ++nt) ao[nt] += tm[nt] * qb; }
        float sm = 0.f;
#pragma unroll
        for (int nt = 0; nt < 8; ++nt) sm += (ao[nt][0] + ao[nt][1]) + (ao[nt][2] + ao[nt][3]);
        sm += SHFL_XOR(sm, 16); sm += SHFL_XOR(sm, 32);
        const float mu = sm * (1.f / 128.f); float sq = 0.f;
#pragma unroll
        for (int nt = 0; nt < 8; ++nt) { ao[nt] -= mu; sq += (ao[nt][0] * ao[nt][0] + ao[nt][1] * ao[nt][1]) + (ao[nt][2] * ao[nt][2] + ao[nt][3] * ao[nt][3]); }
        sq += SHFL_XOR(sq, 16); sq += SHFL_XOR(sq, 32);
        const float rs = 1.f / sqrtf(sq * (1.f / 128.f) + EPS);
#pragma unroll
        for (int nt = 0; nt < 8; ++nt) { const int e0 = 16 * nt + 4 * fq; f32x4 gv = ld_bf4(P + (size_t)t * PW + C_RG + h * 128 + e0);
#pragma unroll
            for (int e = 0; e < 4; ++e) gv[e] = siluf_(gv[e]) * (ao[nt][e] * rs);
            st_bf4(Y + (size_t)t * 4 * W + 1 * W + h * 128 + e0, gv); }
        SYNCTHREADS();
    }
}
__device__ __forceinline__ void ph_sgu_norm(const Ctx& c, int l) {
    const bf16_t* P = WSH(O_P); float* ST = WSF(O_VN);
    const int lane = threadIdx.x & 63, gw = blockIdx.x * (NT / 64) + (threadIdx.x >> 6), ngw = gridDim.x * (NT / 64);
    for (int t = gw; t < T; t += ngw) {
        f32x4 v[4]; float sm = 0.f;
#pragma unroll
        for (int j = 0; j < 4; ++j) { v[j] = ld_bf4(P + (size_t)t * PW + C_SV + (j * 64 + lane) * 4);
#pragma unroll
            for (int q = 0; q < 4; ++q) { v[j][q] = geluf_(v[j][q]); sm += v[j][q]; } }
        const float mu = wave_sum(sm) * (1.f / W); float sq = 0.f;
#pragma unroll
        for (int j = 0; j < 4; ++j)
#pragma unroll
            for (int q = 0; q < 4; ++q) { const float dd = v[j][q] - mu; sq += dd * dd; }
        const float rs = 1.f / sqrtf(wave_sum(sq) * (1.f / W) + EPS);
        if (lane == 0) { ST[(size_t)t * 2] = mu; ST[(size_t)t * 2 + 1] = rs; }
    }
}
__device__ __forceinline__ void ph_sgu_mix(const Ctx& c, int l, float* ldsf) {
    const bf16_t* P = WSH(O_P); const float* ST = WSF(O_VN); bf16_t* Y = WSH(O_YS); const float* ng = c.in[15] + (size_t)l * W;
    bf16_t* As = (bf16_t*)ldsf; bf16_t* Bs = As + 128 * 136; const int tid = threadIdx.x, wv = tid >> 6, lane = tid & 63, fr = lane & 15, fq = lane >> 4;
    for (int u = blockIdx.x; u < (T / 128) * 8; u += gridDim.x) {
        const int g = u & 7; const long t0 = (long)(u >> 3) * 128;
        const float* ws = c.in[16] + ((size_t)l * 8 + g) * 128 * 128; const float* bs = c.in[17] + ((size_t)l * 8 + g) * 128;
#pragma unroll
        for (int q = 0; q < 8; ++q) { const int id = tid + NT * q, i = id >> 5, j4 = (id & 31) * 4; st_bf4(As + i * 136 + j4, *(const f32x4*)(ws + i * 128 + j4)); }
#pragma unroll
        for (int q = 0; q < 4; ++q) { const int id = tid + NT * q, j = id & 127, d8 = (id >> 7) * 8; const float mu = ST[(size_t)(t0 + j) * 2], rs = ST[(size_t)(t0 + j) * 2 + 1];
            const u32x4 raw = *(const u32x4*)(P + (size_t)(t0 + j) * PW + C_SV + g * 128 + d8);
#pragma unroll
            for (int e = 0; e < 4; ++e) { const float v0 = (geluf_(bflo(raw[e])) - mu) * rs * ng[g * 128 + d8 + 2 * e], v1 = (geluf_(bfhi(raw[e])) - mu) * rs * ng[g * 128 + d8 + 2 * e + 1];
                Bs[(d8 + 2 * e) * 136 + j] = (bf16_t)f2bf(v0); Bs[(d8 + 2 * e + 1) * 136 + j] = (bf16_t)f2bf(v1); } }
        SYNCTHREADS();
        f32x4 acc[8];
#pragma unroll
        for (int nt = 0; nt < 8; ++nt) acc[nt] = (f32x4){0.f, 0.f, 0.f, 0.f};
        wave_mma<4, 8>(acc, As + wv * 16 * 136, 136, Bs, 136);
        const int i = wv * 16 + fr; const long t = t0 + i; const float bsi = bs[i];
#pragma unroll
        for (int nt = 0; nt < 8; ++nt) { const int d = 16 * nt + 4 * fq; f32x4 uu = ld_bf4(P + (size_t)t * PW + C_SU + g * 128 + d);
#pragma unroll
            for (int e = 0; e < 4; ++e) uu[e] = geluf_(uu[e]) * (acc[nt][e] + bsi);
            st_bf4(Y + (size_t)t * 4 * W + 2 * W + g * 128 + d, uu); }
        SYNCTHREADS();
    }
}
__device__ __forceinline__ void ph_rw_shift(const Ctx& c, int l) {
    const bf16_t* P = WSH(O_P); const float* mup = c.in[18] + (size_t)l * RF; const float* mun = c.in[19] + (size_t)l * RF; float* FS = WSF(O_FS);
    for (long i = GT_; i < (long)T * RF; i += GS_) {
        const int j = (int)(i % RF); const long t = i / RF; const int s = (int)(t % S);
        const float f = PF(P, t, C_RW + j), pv = s > 0 ? PF(P, t - 1, C_RW + j) : 0.f, nv = s < S - 1 ? PF(P, t + 1, C_RW + j) : 0.f;
        float v = f + mup[j] * (pv - f) + mun[j] * (nv - f);
        if (j >= 3072 && j < 3200) v = tanhf(v); else if (j >= 3328) v = sigmoidf_(v);
        FS[i] = v;
    }
}
__device__ __forceinline__ void ph_rw_lora(const Ctx& c, int l, float* ldsf) {
    const float* FS = WSF(O_FS); const float* w0 = c.in[20] + (size_t)l * 2 * W; const float* a0 = c.in[22] + (size_t)l * 2 * W;
    const bf16_t* WUT = WSH(O_WUT); const bf16_t* WAT = WSH(O_WAT); const bf16_t* WGT = WSH(O_WGT);
    float* DEC = WSF(O_DEC); float* AA = WSF(O_AA); float* GG = WSF(O_GG);
    bf16_t* F = (bf16_t*)ldsf; bf16_t* B1 = F + 128 * 136; bf16_t* B2 = B1 + 128 * 136; const int tid = threadIdx.x, wv = tid >> 6, lane = tid & 63, fr = lane & 15, fq = lane >> 4;
    for (int u = blockIdx.x; u < (T / 128) * 8; u += gridDim.x) {
        const int wc0 = (u & 7) * 128; const long t0 = (long)(u >> 3) * 128;
        for (int rd = 0; rd < 3; ++rd) {
#pragma unroll 2
            for (int q = 0; q < 8; ++q) { const int id = tid + NT * q, r = id >> 5, c4 = (id & 31) * 4;
                const int col = rd < 2 ? (c4 < 64 ? 3072 + rd * 64 + c4 : 3200 + rd * 64 + (c4 - 64)) : 3328 + c4;
                st_bf4(F + r * 136 + c4, *(const f32x4*)(FS + (size_t)(t0 + r) * RF + col)); }
            if (rd < 2) {
#pragma unroll
                for (int q = 0; q < 2; ++q) { const int id = tid + NT * q, w = id >> 3, r8 = (id & 7) * 8;
                    *(u32x4*)(B1 + w * 72 + r8) = *(const u32x4*)(WUT + ((size_t)rd * W + wc0 + w) * 64 + r8); *(u32x4*)(B2 + w * 72 + r8) = *(const u32x4*)(WAT + ((size_t)rd * W + wc0 + w) * 64 + r8); }
            } else {
#pragma unroll
                for (int q = 0; q < 4; ++q) { const int id = tid + NT * q, w = id >> 4, r8 = (id & 15) * 8; *(u32x4*)(B1 + w * 136 + r8) = *(const u32x4*)(WGT + ((size_t)wc0 + w) * 128 + r8); }
            }
            SYNCTHREADS();
            f32x4 a1[8], a2[8];
#pragma unroll
            for (int nt = 0; nt < 8; ++nt) { a1[nt] = (f32x4){0.f, 0.f, 0.f, 0.f}; a2[nt] = (f32x4){0.f, 0.f, 0.f, 0.f}; }
            const long t = t0 + wv * 16 + fr;
            if (rd < 2) {
                wave_mma<2, 8>(a1, F + wv * 16 * 136, 136, B1, 72);
                wave_mma<2, 8>(a2, F + wv * 16 * 136 + 64, 136, B2, 72);
#pragma unroll
                for (int nt = 0; nt < 8; ++nt) { const int ch = wc0 + 16 * nt + 4 * fq; const f32x4 w0v = *(const f32x4*)(w0 + rd * W + ch), a0v = *(const f32x4*)(a0 + rd * W + ch); f32x4 dv, av;
#pragma unroll
                    for (int e = 0; e < 4; ++e) { dv[e] = expf(-DECAY_SCALE * sigmoidf_(a1[nt][e] + w0v[e])); av[e] = sigmoidf_(a2[nt][e] + a0v[e]); }
                    *(f32x4*)(DEC + ((size_t)rd * T + t) * W + ch) = dv; *(f32x4*)(AA + ((size_t)rd * T + t) * W + ch) = av; }
            } else {
                wave_mma<4, 8>(a1, F + wv * 16 * 136, 136, B1, 136);
#pragma unroll
                for (int nt = 0; nt < 8; ++nt) *(f32x4*)(GG + (size_t)t * W + wc0 + 16 * nt + 4 * fq) = a1[nt];
            }
            SYNCTHREADS();
        }
    }
}
#ifdef CPU_EMU
__device__ __forceinline__ float red16_(float x) { x += SHFL_XOR(x, 1); x += SHFL_XOR(x, 2); x += SHFL_XOR(x, 4); x += SHFL_XOR(x, 8); return x; }
#define LDS_BARRIER() emu_syncthreads()
#else
__device__ __forceinline__ float red16_(float x) {
    x += __builtin_bit_cast(float, __builtin_amdgcn_update_dpp(0, __builtin_bit_cast(int, x), 0xB1, 0xF, 0xF, true));
    x += __builtin_bit_cast(float, __builtin_amdgcn_update_dpp(0, __builtin_bit_cast(int, x), 0x4E, 0xF, 0xF, true));
    x += __builtin_bit_cast(float, __builtin_amdgcn_update_dpp(0, __builtin_bit_cast(int, x), 0x141, 0xF, 0xF, true));
    x += __builtin_bit_cast(float, __builtin_amdgcn_update_dpp(0, __builtin_bit_cast(int, x), 0x140, 0xF, 0xF, true));
    return x;
}
#define LDS_BARRIER() do { asm volatile("s_waitcnt lgkmcnt(0)" ::: "memory"); __builtin_amdgcn_s_barrier(); asm volatile("" ::: "memory"); } while (0)
#endif
#define RC_M(k) (lm + (k) * 4608)
__device__ __forceinline__ void ph_rw_chunk(const Ctx& c, int l, float* ldsf) {
    const float* FS = WSF(O_FS); const float* DEC = WSF(O_DEC); const float* AA = WSF(O_AA); float* BON = WSF(O_BON);
    const float* kkw = c.in[25] + (size_t)l * W; const float* kaw = c.in[26] + (size_t)l * W; const float* rk = c.in[27] + (size_t)l * W;
    bf16_t* PST = WSH(O_PST); bf16_t* PYT = WSH(O_PYT); float* SVB = WSF(O_SVB); float* YVB = WSF(O_YVB);
    bf16_t* lm = (bf16_t*)ldsf; float* gam = (float*)RC_M(7); float* segp = (float*)RC_M(13); float* gl = segp + 512;
    const int tid = threadIdx.x, wv = tid >> 6, lane = tid & 63, fr = lane & 15, fq = lane >> 4, rt = wv & 3, hf = wv >> 2;
    const int m0 = 16 * rt + fr;
    for (int u = blockIdx.x; u < 64 * NRC; u += gridDim.x) {
        const int chain = u / NRC, ck = u % NRC, h = chain & 15, b = (chain >> 4) & 1, z = chain >> 5;
        const long tb = (long)b * S + (z ? S - 1 - ck * RCK : ck * RCK); const int dirn = z ? -1 : 1;
        const float* decp = DEC + ((size_t)z * T) * W + h * 64; const float* aap = AA + ((size_t)z * T) * W + h * 64;
        { const int k = tid & 63, sg = tid >> 6; float p = 1.f; float wv8[8];
#pragma unroll
          for (int q = 0; q < 8; ++q) wv8[q] = decp[(size_t)(tb + dirn * (sg * 8 + q)) * W + k];
#pragma unroll
          for (int q = 0; q < 8; ++q) { p *= wv8[q]; gam[(sg * 8 + q) * 64 + k] = p; }
          segp[sg * 64 + k] = p; }
        SYNCTHREADS();
        { const int k = tid & 63, sg = tid >> 6; float pre = 1.f;
          for (int q = 0; q < sg; ++q) pre *= segp[q * 64 + k];
#pragma unroll
          for (int q = 0; q < 8; ++q) gam[(sg * 8 + q) * 64 + k] *= pre;
          if (sg == 7) gl[k] = gam[63 * 64 + k]; }
        SYNCTHREADS();
        { const int k = lane, ch = h * 64 + k; const float kkwv = kkw[ch], kav = kaw[ch], rkv = rk[ch];
          float kv8[8], rv8[8], vv8[8], aa8[8];
#pragma unroll
          for (int q = 0; q < 8; ++q) { const long t = tb + dirn * (wv + 8 * q); const float* f = FS + (size_t)t * RF; kv8[q] = f[1024 + ch]; rv8[q] = f[ch]; vv8[q] = f[2048 + ch]; aa8[q] = aap[(size_t)t * W + k]; }
#pragma unroll
          for (int q = 0; q < 8; ++q) { const int tt = wv + 8 * q; const long t = tb + dirn * tt;
            const float vk = kv8[q] * kkwv; const float kkn = vk * (1.f / sqrtf(wave_sum(vk * vk) + EPS)); const float ktv = kv8[q] * (1.f + (aa8[q] - 1.f) * kav);
            const float bsum = wave_sum(rv8[q] * rkv * ktv); if (lane == 0) BON[((size_t)z * T + t) * 16 + h] = bsum;
            const float g = gam[tt * 64 + k], gp = tt ? gam[(tt - 1) * 64 + k] : 1.f, ig = 1.f / g;
            const bf16_t khv = (bf16_t)f2bf(kkn * gp), bhv = (bf16_t)f2bf(aa8[q] * kkn * ig);
            RC_M(0)[tt * 72 + k] = khv; RC_M(1)[k * 72 + tt] = khv; RC_M(2)[tt * 72 + k] = bhv; RC_M(3)[k * 72 + tt] = bhv;
            RC_M(4)[tt * 72 + k] = (bf16_t)f2bf(ktv * ig); RC_M(5)[tt * 72 + k] = (bf16_t)f2bf(rv8[q] * g); RC_M(6)[k * 72 + tt] = (bf16_t)f2bf(vv8[q]); } }
        SYNCTHREADS();
        f32x4 mkr[2], khr[2], rhT[2];
        {
            f32x4 a0[2], a1[2], a2[2], a3[2];
#pragma unroll
            for (int nt = 0; nt < 2; ++nt) { a0[nt] = (f32x4){0.f, 0.f, 0.f, 0.f}; a1[nt] = a0[nt]; a2[nt] = a0[nt]; a3[nt] = a0[nt]; }
            wave_mma<2, 2>(a0, RC_M(2) + rt * 16 * 72, 72, RC_M(0) + hf * 32 * 72, 72);
            wave_mma<2, 2>(a1, RC_M(4) + rt * 16 * 72, 72, RC_M(0) + hf * 32 * 72, 72);
            wave_mma<2, 2>(a2, RC_M(2) + rt * 16 * 72, 72, RC_M(5) + hf * 32 * 72, 72);
            wave_mma<2, 2>(a3, RC_M(4) + rt * 16 * 72, 72, RC_M(5) + hf * 32 * 72, 72);
#pragma unroll
            for (int nt = 0; nt < 2; ++nt) { const int n0 = 32 * hf + 16 * nt + 4 * fq; f32x4 nn, ti, mk;
#pragma unroll
                for (int r = 0; r < 4; ++r) { const int n = n0 + r; const bool lt = m0 < n, le = m0 <= n;
                    nn[r] = lt ? -a0[nt][r] : 0.f; ti[r] = nn[r] + (m0 == n ? 1.f : 0.f); mk[r] = lt ? a1[nt][r] : 0.f; mkr[nt][r] = le ? a3[nt][r] : 0.f;
                    RC_M(12)[n * 72 + m0] = (bf16_t)f2bf(le ? a2[nt][r] : 0.f);
                    RC_M(8)[n * 72 + m0] = (bf16_t)f2bf(nn[r]);
                    khr[nt][r] = bf2f(RC_M(4)[m0 * 72 + n]); rhT[nt][r] = bf2f(RC_M(5)[n * 72 + m0]); }
                st_bf4(RC_M(7) + m0 * 72 + n0, nn); st_bf4(RC_M(9) + m0 * 72 + n0, ti); st_bf4(RC_M(11) + m0 * 72 + n0, mk); }
        }
        SYNCTHREADS();
        f32x4 tiv[2];
#pragma unroll
        for (int nt = 0; nt < 2; ++nt) tiv[nt] = ld_bf4(RC_M(9) + m0 * 72 + 32 * hf + 16 * nt + 4 * fq);
#pragma unroll 1
        for (int it = 0; it < 5; ++it) {
            bf16_t* pw = (it & 1) ? RC_M(0) : RC_M(7); bf16_t* pwT = (it & 1) ? RC_M(2) : RC_M(8); bf16_t* pw2 = (it & 1) ? RC_M(7) : RC_M(0); bf16_t* pw2T = (it & 1) ? RC_M(8) : RC_M(2);
            bf16_t* tcur = (it & 1) ? RC_M(4) : RC_M(9); bf16_t* tnxt = (it & 1) ? RC_M(9) : RC_M(4);
            f32x4 sq[2];
#pragma unroll
            for (int nt = 0; nt < 2; ++nt) sq[nt] = (f32x4){0.f, 0.f, 0.f, 0.f};
            wave_mma<2, 2>(sq, pw + rt * 16 * 72, 72, pwT + hf * 32 * 72, 72);
#pragma unroll
            for (int nt = 0; nt < 2; ++nt) { const int n0 = 32 * hf + 16 * nt + 4 * fq; st_bf4(pw2 + m0 * 72 + n0, sq[nt]);
#pragma unroll
                for (int r = 0; r < 4; ++r) pw2T[(n0 + r) * 72 + m0] = (bf16_t)f2bf(sq[nt][r]); }
            SYNCTHREADS();
            f32x4 up[2];
#pragma unroll
            for (int nt = 0; nt < 2; ++nt) up[nt] = (f32x4){0.f, 0.f, 0.f, 0.f};
            wave_mma<2, 2>(up, tcur + rt * 16 * 72, 72, pw2T + hf * 32 * 72, 72);
#pragma unroll
            for (int nt = 0; nt < 2; ++nt) { const int n0 = 32 * hf + 16 * nt + 4 * fq; tiv[nt] += up[nt]; st_bf4(tnxt + m0 * 72 + n0, tiv[nt]);
                if (it == 4) {
#pragma unroll
                    for (int r = 0; r < 4; ++r) RC_M(10)[(n0 + r) * 72 + m0] = (bf16_t)f2bf(tiv[nt][r]); } }
            SYNCTHREADS();
        }
        {
            f32x4 w1[2], w2[2];
#pragma unroll
            for (int nt = 0; nt < 2; ++nt) { w1[nt] = (f32x4){0.f, 0.f, 0.f, 0.f}; w2[nt] = w1[nt]; }
            wave_mma<2, 2>(w1, RC_M(1) + rt * 16 * 72, 72, RC_M(10) + hf * 32 * 72, 72);
            wave_mma<2, 2>(w2, RC_M(11) + rt * 16 * 72, 72, RC_M(10) + hf * 32 * 72, 72);
#pragma unroll
            for (int nt = 0; nt < 2; ++nt) { const int n0 = 32 * hf + 16 * nt + 4 * fq; st_bf4(RC_M(7) + m0 * 72 + n0, w1[nt]); st_bf4(RC_M(8) + m0 * 72 + n0, w2[nt]); }
        }
        SYNCTHREADS();
        {
            f32x4 py[2], qy[2], ps[2], qs[2];
#pragma unroll
            for (int nt = 0; nt < 2; ++nt) { py[nt] = (f32x4){0.f, 0.f, 0.f, 0.f}; qy[nt] = py[nt]; ps[nt] = py[nt]; qs[nt] = py[nt]; }
            wave_mma<2, 2>(py, RC_M(7) + rt * 16 * 72, 72, RC_M(12) + hf * 32 * 72, 72);
            wave_mma<2, 2>(qy, RC_M(8) + rt * 16 * 72, 72, RC_M(12) + hf * 32 * 72, 72);
            wave_mma<2, 2>(ps, RC_M(7) + rt * 16 * 72, 72, RC_M(3) + hf * 32 * 72, 72);
            wave_mma<2, 2>(qs, RC_M(8) + rt * 16 * 72, 72, RC_M(3) + hf * 32 * 72, 72);
#pragma unroll
            for (int nt = 0; nt < 2; ++nt) { const int n0 = 32 * hf + 16 * nt + 4 * fq;
#pragma unroll
                for (int r = 0; r < 4; ++r) { const int n = n0 + r; const float gln = gl[n];
                    RC_M(0)[n * 72 + m0] = (bf16_t)f2bf(rhT[nt][r] - py[nt][r]); RC_M(2)[n * 72 + m0] = (bf16_t)f2bf(mkr[nt][r] - qy[nt][r]);
                    RC_M(4)[n * 72 + m0] = (bf16_t)f2bf(((m0 == n ? 1.f : 0.f) - ps[nt][r]) * gln); RC_M(5)[n * 72 + m0] = (bf16_t)f2bf((khr[nt][r] - qs[nt][r]) * gln); } }
        }
        SYNCTHREADS();
        {
            f32x4 yv[2], sv[2];
#pragma unroll
            for (int nt = 0; nt < 2; ++nt) { yv[nt] = (f32x4){0.f, 0.f, 0.f, 0.f}; sv[nt] = yv[nt]; }
            wave_mma<2, 2>(yv, RC_M(6) + rt * 16 * 72, 72, RC_M(2) + hf * 32 * 72, 72);
            wave_mma<2, 2>(sv, RC_M(6) + rt * 16 * 72, 72, RC_M(5) + hf * 32 * 72, 72);
#pragma unroll
            for (int nt = 0; nt < 2; ++nt) { const int n0 = 32 * hf + 16 * nt + 4 * fq; *(f32x4*)(YVB + (size_t)u * 4096 + m0 * 64 + n0) = yv[nt]; *(f32x4*)(SVB + (size_t)u * 4096 + m0 * 64 + n0) = sv[nt]; }
            { const int rr = tid >> 3, c8 = (tid & 7) * 8; *(u32x4*)(PYT + (size_t)u * 4096 + rr * 64 + c8) = *(const u32x4*)(RC_M(0) + rr * 72 + c8); *(u32x4*)(PST + (size_t)u * 4096 + rr * 64 + c8) = *(const u32x4*)(RC_M(4) + rr * 72 + c8); }
        }
        SYNCTHREADS();
    }
}
#undef RC_M
__device__ __forceinline__ void ph_rw_seq(const Ctx& c, float* ldsf) {
    const bf16_t* PST = WSH(O_PST); const bf16_t* PYT = WSH(O_PYT); const float* SVB = WSF(O_SVB); const float* YVB = WSF(O_YVB); float* YY = WSF(O_YY);
    bf16_t* Sb = (bf16_t*)ldsf;
    bf16_t* Pm = Sb + 2 * 16 * 72;
    const int tid = threadIdx.x, wv = tid >> 6, lane = tid & 63, fr = lane & 15, fq = lane >> 4, isY = wv >> 2, nt0 = wv & 3;
    for (int u = blockIdx.x; u < 256; u += gridDim.x) {
        const int x = u & 7, jq = u >> 3, chain = x * 8 + (jq >> 2), qt = jq & 3, h = chain & 15, b = (chain >> 4) & 1, z = chain >> 5;
        const size_t ub = (size_t)chain * NRC;
        const int rr = tid >> 3, c8 = (tid & 7) * 8;
        constexpr int PD = NRC >= 8 ? 8 : 4;
        for (int i = tid; i < 2 * 16 * 72 / 2; i += NT) ((unsigned*)Sb)[i] = 0u;
        const int row = 16 * qt + fr, n0 = 16 * nt0 + 4 * fq; const float* addp = (isY ? YVB : SVB) + ub * 4096 + row * 64 + n0;
        const bf16_t* psp = PST + ub * 4096 + rr * 64 + c8; const bf16_t* pyp = PYT + ub * 4096 + rr * 64 + c8;
        u32x4 gps[PD], gpy[PD]; f32x4 add[PD];
#pragma unroll
        for (int j = 0; j < PD; ++j) { gps[j] = *(const u32x4*)(psp + (size_t)j * 4096); gpy[j] = *(const u32x4*)(pyp + (size_t)j * 4096); add[j] = *(const f32x4*)(addp + (size_t)j * 4096); }
        *(u32x4*)(Pm + (0 * 2 + 0) * 4608 + rr * 72 + c8) = gps[0]; *(u32x4*)(Pm + (0 * 2 + 1) * 4608 + rr * 72 + c8) = gpy[0];
        if (PD < NRC) { gps[0] = *(const u32x4*)(psp + (size_t)PD * 4096); gpy[0] = *(const u32x4*)(pyp + (size_t)PD * 4096); }
        SYNCTHREADS();
        for (int ck0 = 0; ck0 < NRC; ck0 += PD) {
#pragma unroll
            for (int j = 0; j < PD; ++j) {
                const int ck = ck0 + j, cur = j & 1, nxt = cur ^ 1;
                f32x4 acc[1]; acc[0] = (f32x4){0.f, 0.f, 0.f, 0.f};
                wave_mma<2, 1>(acc, Sb + cur * 16 * 72, 72, Pm + (cur * 2 + isY) * 4608 + nt0 * 16 * 72, 72);
                acc[0] += add[j];
                if (ck + PD < NRC) add[j] = *(const f32x4*)(addp + (size_t)(ck + PD) * 4096);
                if (isY) {
#pragma unroll
                    for (int r = 0; r < 4; ++r) { const int step = ck * RCK + n0 + r, sidx = z ? S - 1 - step : step; YY[((size_t)z * T + (size_t)b * S + sidx) * W + h * 64 + row] = acc[0][r]; }
                } else st_bf4(Sb + nxt * 16 * 72 + fr * 72 + n0, acc[0]);
                const int jn = (j + 1) % PD;
                if (ck + 1 < NRC) { *(u32x4*)(Pm + (nxt * 2 + 0) * 4608 + rr * 72 + c8) = gps[jn]; *(u32x4*)(Pm + (nxt * 2 + 1) * 4608 + rr * 72 + c8) = gpy[jn]; }
                if (ck + 1 + PD < NRC) { gps[jn] = *(const u32x4*)(psp + (size_t)(ck + 1 + PD) * 4096); gpy[jn] = *(const u32x4*)(pyp + (size_t)(ck + 1 + PD) * 4096); }
                LDS_BARRIER();
            }
        }
    }
}
__device__ __forceinline__ void ph_rw_out(const Ctx& c) {
    const float* FS = WSF(O_FS); const float* YY = WSF(O_YY); const float* BON = WSF(O_BON); const float* GG = WSF(O_GG); bf16_t* Y = WSH(O_YS);
    const int lane = threadIdx.x & 63, gw = blockIdx.x * (NT / 64) + (threadIdx.x >> 6), ngw = gridDim.x * (NT / 64);
    for (int i = gw; i < T * 16; i += ngw) {
        const int h = i & 15; const long t = i >> 4; const int ch = h * 64 + lane;
        const float y0 = YY[(size_t)t * W + ch], y1 = YY[((size_t)T + t) * W + ch];
        const float m0 = wave_sum(y0) * (1.f / 64.f), m1 = wave_sum(y1) * (1.f / 64.f); const float d0 = y0 - m0, d1 = y1 - m1;
        const float r0 = 1.f / sqrtf(wave_sum(d0 * d0) * (1.f / 64.f) + EPS), r1 = 1.f / sqrtf(wave_sum(d1 * d1) * (1.f / 64.f) + EPS);
        const float vv = FS[(size_t)t * RF + 2048 + ch]; const float o = d0 * r0 + d1 * r1 + (BON[(size_t)t * 16 + h] + BON[((size_t)T + t) * 16 + h]) * vv;
        Y[(size_t)t * 4 * W + 3 * W + ch] = (bf16_t)f2bf(o * GG[(size_t)t * W + ch]);
    }
}
__device__ __forceinline__ void ph_router(const Ctx& c, int l, float* ldsf) {
    const float* H = WSF(O_HF); const bf16_t* WH = WSH(O_WRH); const bf16_t* WL = WSH(O_WRL); const float* bg = c.in[31] + (size_t)l * 4; const float* be = c.in[33] + (size_t)l * 32;
    int* EID = WSI(O_EID); float* EWT = WSF(O_EWT); int* cnt = CTLW(c) + CW_CNT + l * 64;
    const int tid = threadIdx.x, wv = tid >> 6, lane = tid & 63, fr = lane & 15, fq = lane >> 4, rt = wv & 1, kq = wv >> 1;
    float* part = ldsf;
    for (int u = blockIdx.x; u < T / 32; u += gridDim.x) {
        const long t0 = (long)u * 32; f32x4 acc[3];
#pragma unroll
        for (int nt = 0; nt < 3; ++nt) acc[nt] = (f32x4){0.f, 0.f, 0.f, 0.f};
#ifdef CPU_EMU
        for (int nt = 0; nt < 3; ++nt) for (int r = 0; r < 4; ++r) { const int n = 16 * nt + 4 * fq + r; float sacc = 0.f;
            for (int k = kq * 512; k < kq * 512 + 512; ++k) { const float hv = H[(size_t)(t0 + 16 * rt + fr) * D + k]; const float hh = bf2f((bf16_t)f2bf(hv)), hl = bf2f((bf16_t)f2bf(hv - hh));
                const float wh = bf2f(WH[(size_t)n * D + k]), wl = bf2f(WL[(size_t)n * D + k]); sacc += hh * wh + hl * wh + hh * wl; }
            acc[nt][r] = sacc; }
#else
        const float* hp = H + (size_t)(t0 + 16 * rt + fr) * D + kq * 512 + fq * 8;
#pragma unroll 4
        for (int ks = 0; ks < 16; ++ks) {
            const f32x4 h0 = *(const f32x4*)(hp + ks * 32), h1 = *(const f32x4*)(hp + ks * 32 + 4); bf16x8 ah, al;
#pragma unroll
            for (int e = 0; e < 4; ++e) { const unsigned b0 = f2bf(h0[e]), b1 = f2bf(h1[e]); ah[e] = (short)b0; ah[4 + e] = (short)b1; al[e] = (short)f2bf(h0[e] - u2f_(b0 << 16)); al[4 + e] = (short)f2bf(h1[e] - u2f_(b1 << 16)); }
#pragma unroll
            for (int nt = 0; nt < 3; ++nt) { const size_t wo = (size_t)(16 * nt + fr) * D + kq * 512 + ks * 32 + fq * 8; const bf16x8 bh = *(const bf16x8*)(WH + wo), bl = *(const bf16x8*)(WL + wo);
                acc[nt] = __builtin_amdgcn_mfma_f32_16x16x32_bf16(bh, ah, acc[nt], 0, 0, 0); acc[nt] = __builtin_amdgcn_mfma_f32_16x16x32_bf16(bh, al, acc[nt], 0, 0, 0); acc[nt] = __builtin_amdgcn_mfma_f32_16x16x32_bf16(bl, ah, acc[nt], 0, 0, 0); }
        }
#endif
#pragma unroll
        for (int nt = 0; nt < 3; ++nt) *(f32x4*)(part + (kq * 32 + 16 * rt + fr) * 48 + 16 * nt + 4 * fq) = acc[nt];
        SYNCTHREADS();
        if (tid < 32) { const long t = t0 + tid; float lg[36];
#pragma unroll
            for (int q = 0; q < 36; ++q) lg[q] = (part[(0 * 32 + tid) * 48 + q] + part[(1 * 32 + tid) * 48 + q]) + (part[(2 * 32 + tid) * 48 + q] + part[(3 * 32 + tid) * 48 + q]) + (q < 4 ? bg[q < 4 ? q : 0] : be[q >= 4 ? q - 4 : 0]);
            int gi = 0; float m = lg[0];
#pragma unroll
            for (int q = 1; q < 4; ++q) if (lg[q] > m) { m = lg[q]; gi = q; }
            float den = 0.f;
#pragma unroll
            for (int q = 0; q < 4; ++q) den += expf(lg[q] - m);
            const float gp = 1.f / den; float el[8];
#pragma unroll
            for (int q = 0; q < 8; ++q) el[q] = gi == 0 ? lg[4 + q] : gi == 1 ? lg[12 + q] : gi == 2 ? lg[20 + q] : lg[28 + q];
            int i1 = 0; float m1 = el[0];
#pragma unroll
            for (int q = 1; q < 8; ++q) if (el[q] > m1) { m1 = el[q]; i1 = q; }
            int i2 = -1; float m2 = 0.f;
#pragma unroll
            for (int q = 0; q < 8; ++q) if (q != i1 && (i2 < 0 || el[q] > m2)) { m2 = el[q]; i2 = q; }
            const float p2 = expf(m2 - m1);
            EID[t * 2] = gi * 8 + i1; EID[t * 2 + 1] = gi * 8 + i2; EWT[t * 2] = gp / (1.f + p2); EWT[t * 2 + 1] = gp * p2 / (1.f + p2);
            atomic_add_i(cnt + gi * 8 + i1, 1); atomic_add_i(cnt + gi * 8 + i2, 1);
        }
        SYNCTHREADS();
    }
}
__device__ __forceinline__ void ph_moe_plan(const Ctx& c, int l) {
    int* cnt = CTLW(c) + CW_CNT + l * 64; int* plan = CTLW(c) + CW_PLAN + l * 256;
    if (GT_ == 0) {
        int ps = 0, nb = 0;
        for (int e = 0; e < NE; ++e) { plan[e] = ps; const int nblk = (cnt[e] + 255) / 256; for (int q = 0; q < nblk; ++q) plan[64 + nb++] = e; ps += nblk * 256; }
        plan[32] = ps; plan[40] = nb;
    }
}
__device__ __forceinline__ void ph_moe_assign(const Ctx& c, int l) {
    const int* EID = WSI(O_EID); int* fill = CTLW(c) + CW_FILL + l * 64; const int* plan = CTLW(c) + CW_PLAN + l * 256; int* DEST = WSI(O_DEST);
    for (long i = GT_; i < (long)T * 2; i += GS_) { const int e = EID[i]; const int pos = atomic_add_i(fill + e, 1); DEST[i] = plan[e] + pos; }
}
__device__ __forceinline__ void ph_moe_gather(const Ctx& c) {
    const int* DEST = WSI(O_DEST); const u32x4* H = (const u32x4*)WSH(O_H); u32x4* XS = (u32x4*)WSH(O_XS);
    for (long i = GT_; i < (long)T * 2 * (D / 8); i += GS_) { const int q = (int)(i % (D / 8)); const long a = i / (D / 8); XS[(size_t)DEST[a] * (D / 8) + q] = H[(size_t)(a >> 1) * (D / 8) + q]; }
}
#ifndef CPU_EMU
#define XB_TMO      128
#define XB_XCNT(j)  (256  + 64 * (j))
#define XB_XSUB(j)  (1280 + 64 * (j))
#define XB_XGEN(j)  (2304 + 64 * (j))
#define XB_TOP      3328
#define XB_TOPGEN   3392
#define XCD_BAR_WORDS 3456
#define XB_SPIN_CAP (1u << 26)
#define LAS __attribute__((address_space(3)))
__device__ __forceinline__ unsigned xb_ld(unsigned* p)              { return __hip_atomic_load(p, __ATOMIC_RELAXED, __HIP_MEMORY_SCOPE_AGENT); }
__device__ __forceinline__ unsigned xb_add(unsigned* p, unsigned v) { return __hip_atomic_fetch_add(p, v, __ATOMIC_RELAXED, __HIP_MEMORY_SCOPE_AGENT); }
__device__ __forceinline__ unsigned xb_xcc_id() { return (unsigned)__builtin_amdgcn_s_getreg((3 << 11) | 20) & 0xFu; }
#define XB_SPIN(cond, bar) do { unsigned _sp = 0; while (cond) { __builtin_amdgcn_s_sleep(1); \
    if ((++_sp & 255u) == 0u) { if (xb_ld(&(bar)[XB_TMO])) break; if (_sp > XB_SPIN_CAP) { atomicAdd(&(bar)[XB_TMO], 1u); break; } } } } while (0)
struct XcdBarrier { unsigned* bar; unsigned x; volatile LAS unsigned* st; };
__device__ __forceinline__ XcdBarrier xcd_barrier_post(unsigned* bar, volatile LAS unsigned* st) {
    XcdBarrier b; b.bar = bar; b.x = xb_xcc_id(); b.st = st;
    if (threadIdx.x == 0) (void)xb_add(&bar[XB_XCNT(b.x)], 1u);
    return b;
}
__device__ __forceinline__ void xcd_barrier_complete(unsigned* bar, unsigned x, unsigned& nloc, unsigned& nx) {
    const unsigned G = gridDim.x * gridDim.y * gridDim.z;
    unsigned sum, cnt, mine, sp = 0u;
    for (;;) {
        sum = 0u; cnt = 0u; mine = 0u;
#pragma unroll
        for (unsigned j = 0; j < 16; ++j) { const unsigned cc = xb_ld(&bar[XB_XCNT(j)]); sum += cc; cnt += (cc > 0u) ? 1u : 0u; mine = (j == x) ? cc : mine; }
        if (sum == G) break;
        __builtin_amdgcn_s_sleep(1);
        if ((++sp & 255u) == 0u) { if (xb_ld(&bar[XB_TMO])) break; if (sp > XB_SPIN_CAP) { atomicAdd(&bar[XB_TMO], 1u); break; } }
    }
    nloc = mine > 0u ? mine : 1u; nx = cnt > 0u ? cnt : 1u;
}
__device__ __forceinline__ void xcd_barrier(const XcdBarrier& b) {
    asm volatile("s_waitcnt vmcnt(0)" ::: "memory");
    __syncthreads();
    if (threadIdx.x == 0) {
        unsigned* bar = b.bar;
        __builtin_amdgcn_s_waitcnt(0);
        unsigned nloc = b.st[0], nx = b.st[1];
        if (nloc == 0u) { xcd_barrier_complete(bar, b.x, nloc, nx); b.st[0] = nloc; b.st[1] = nx; }
        const unsigned old = xb_add(&bar[XB_XSUB(b.x)], 1u);
        const unsigned gen = old / nloc;
        if (old + 1u == (gen + 1u) * nloc) {
            __builtin_amdgcn_fence(__ATOMIC_RELEASE, "agent");
            asm volatile("s_waitcnt vmcnt(0)" ::: "memory");
            const unsigned og = xb_add(&bar[XB_TOP], 1u);
            const unsigned tg = og / nx;
            if (og + 1u == (tg + 1u) * nx) xb_add(&bar[XB_TOPGEN], 1u);
            else XB_SPIN(xb_ld(&bar[XB_TOPGEN]) == tg, bar);
            __builtin_amdgcn_fence(__ATOMIC_ACQUIRE, "agent");
            xb_add(&bar[XB_XGEN(b.x)], 1u);
            asm volatile("s_waitcnt vmcnt(0)" ::: "memory");
        } else {
            XB_SPIN(xb_ld(&bar[XB_XGEN(b.x)]) == gen, bar);
            __builtin_amdgcn_fence(__ATOMIC_ACQUIRE, "agent");
            asm volatile("s_waitcnt vmcnt(0)" ::: "memory");
        }
    }
    __syncthreads();
}
#endif

constexpr int LDS_BYTES = 147456;

__global__ void __launch_bounds__(NT, 2) fwd(Params p) {
#ifdef CPU_EMU
    unsigned char* lds = g_lds; float* ldsf = (float*)g_lds;
#else
    extern __shared__ __attribute__((aligned(16))) unsigned char lds[];
    float* ldsf = (float*)lds;
    volatile LAS unsigned* misc = (volatile LAS unsigned*)((LAS unsigned char*)lds + LDS_BYTES - 64);
    if (threadIdx.x == 0) { misc[0] = 0u; misc[1] = 0u; }
    __syncthreads();
    XcdBarrier bar = xcd_barrier_post((unsigned*)(p.ws + O_CTL) + CW_BAR, misc);
#endif
    Ctx c; c.in = p.in; c.out = p.out; c.ws = p.ws;
    const int lo = p.ph_lo, hi = p.ph_hi; int ph = 0;
    const int G = (int)gridDim.x, cwg = (int)blockIdx.x;
#ifdef CPU_EMU
#define GRID_BAR()
#else
#define GRID_BAR() xcd_barrier(bar)
#endif
#ifndef REPEAT_MASK
#define REPEAT_MASK 0
#endif
#ifndef TIME_PHASE
#define TIME_PHASE -1
#endif
#if TIME_PHASE >= 0 && !defined(CPU_EMU)
    unsigned long long tp0 = 0, tp1 = 0;
#define TP_BEGIN() do { if (ph == TIME_PHASE) tp0 = __builtin_amdgcn_s_memrealtime(); } while (0)
#define TP_END() do { if (ph == TIME_PHASE) tp1 = __builtin_amdgcn_s_memrealtime(); } while (0)
#else
#define TP_BEGIN()
#define TP_END()
#endif
#define PHASE(...) do { if (lo <= ph && ph < hi) { TP_BEGIN(); __VA_ARGS__; if (ph + 1 < hi) { GRID_BAR(); } TP_END(); } ++ph; } while (0)
#define PHASEG(grp, ...) do { if (lo <= ph && ph < hi) { TP_BEGIN(); if ((REPEAT_MASK >> (grp)) & 1) { __VA_ARGS__; GRID_BAR(); } __VA_ARGS__; if (ph + 1 < hi) { GRID_BAR(); } TP_END(); } ++ph; } while (0)
    PHASE(ph_mod(c, ldsf));
#define LAYER_BODY(l) do { const float* mod = WSF(O_MOD); \
        const float* xin = l == 0 ? c.in[0] : WSF(O_X1); float* xmid = WSF(O_X0); float* xout = WSF(O_X1); \
        const float* ml = mod + (size_t)l * NB * D6; \
        PHASEG(3, ph_convert(c, l, ldsf)); \
        PHASEG(0, { pg8::Gemm g{D, D, D}; pg8::StaticOrder so; so.init(T, PW, G, cwg, WSH(O_H), WSH(O_WIN), D, D); pg8::EpiBf16 E{WSH(O_P), PW}; pg8::gemm_phase(lds, g, so, E); }); \
        PHASE(ph_lru_gate(c, l, ldsf); ph_ret_kv(c, ldsf); ph_sgu_norm(c, l); ph_rw_shift(c, l)); \
        PHASE(ph_lru_scan1(c); ph_ret_state(c); ph_sgu_mix(c, l, ldsf); ph_rw_lora(c, l, ldsf)); \
        PHASE(ph_lru_scan2(c); ph_ret_out(c, ldsf); ph_rw_chunk(c, l, ldsf)); \
        PHASE(ph_lru_scan3(c); ph_rw_seq(c, ldsf)); \
        PHASE(ph_rw_out(c)); \
        PHASEG(1, { pg8::Gemm g{W, 4 * W, 4 * W}; pg8::MergeOrder mo; mo.so.init(T, D, G, cwg, WSH(O_YS), WSH(O_WBR), 4 * W, 4 * W); mo.kseg_bytes = W * 2; pg8::EpiMerge E{WSH(O_P), WSF(O_PART), WSH(O_MRG)}; pg8::gemm_phase(lds, g, mo, E); }); \
        PHASEG(1, { pg8::Gemm g{D, D, D}; pg8::StaticOrder so; so.init(T, D, G, cwg, WSH(O_MRG), WSH(O_WOUT), D, D); pg8::EpiResid E{xin, ml + 2 * D, xmid}; pg8::gemm_phase(lds, g, so, E); }); \
        PHASEG(6, ph_norm(c, xmid, c.in[4] + (size_t)l * D, ml + 3 * D, ml + 4 * D, WSH(O_H), WSF(O_HF))); \
        PHASE(ph_router(c, l, ldsf)); \
        PHASE(ph_moe_plan(c, l)); \
        PHASE(ph_moe_assign(c, l)); \
        PHASEG(6, ph_moe_gather(c)); \
        const int* plan = CTLW(c) + CW_PLAN + l * 256; \
        PHASEG(2, { pg8::Gemm g{D, D, D}; pg8::MoeOrder mo{G, cwg, 4, plan, (const char*)WSH(O_XS), (const char*)WSH(O_WGU), (size_t)256 * D * 2, (size_t)256 * D * 2, (size_t)1024 * D * 2}; pg8::EpiGU E{WSH(O_ACT)}; pg8::gemm_phase(lds, g, mo, E); }); \
        PHASEG(2, { pg8::Gemm g{512, 512, 512}; pg8::MoeOrder mo{G, cwg, 8, plan, (const char*)WSH(O_ACT), (const char*)WSH(O_WDN), (size_t)256 * 512 * 2, (size_t)256 * 512 * 2, (size_t)D * 512 * 2}; pg8::EpiBf16 E{WSH(O_YE), D}; pg8::gemm_phase(lds, g, mo, E); }); \
        if (l == 0) PHASE(ph_comb_norm<0>(c, xmid, ml + 5 * D, xout, c.in[3] + (size_t)1 * D, mod + (size_t)1 * NB * D6 + 0 * D, mod + (size_t)1 * NB * D6 + 1 * D, WSH(O_H), nullptr)); \
        else PHASE(ph_comb_norm<1>(c, xmid, ml + 5 * D, xout, c.in[36], nullptr, nullptr, nullptr, c.out)); \
    } while (0)
    PHASE(ph_norm(c, c.in[0], c.in[3], WSF(O_MOD) + 0 * D, WSF(O_MOD) + 1 * D, WSH(O_H), nullptr));
    LAYER_BODY(0);
    LAYER_BODY(1);
#undef LAYER_BODY
#if TIME_PHASE >= 0 && !defined(CPU_EMU)
    if (blockIdx.x == 0) { const unsigned long long te = __builtin_amdgcn_s_memrealtime(), dl = 8ull * (tp1 - tp0); while (__builtin_amdgcn_s_memrealtime() - te < dl) __builtin_amdgcn_s_sleep(8); }
#endif
#undef PHASE
}
}

#ifndef CPU_EMU
extern "C" void kernel_launch(void* const* d_in, const int* in_sizes, int n_in, void* d_out, int out_size, void* d_ws, size_t ws_size, hipStream_t stream) {
    static int grid = 0;
    if (grid == 0) {
        if (n_in != 37 || out_size != T * D || ws_size < WS_END) { fprintf(stderr, "kernel_launch: unexpected shapes (n_in %d out %d ws %zu need %zu)\n", n_in, out_size, ws_size, (size_t)WS_END); grid = -1; return; }
        int dev = 0, cus = 0, per_cu = 0;
        if (hipGetDevice(&dev) != hipSuccess || hipDeviceGetAttribute(&cus, hipDeviceAttributeMultiprocessorCount, dev) != hipSuccess) { grid = -1; return; }
        if (hipFuncSetAttribute((const void*)fwd, hipFuncAttributeMaxDynamicSharedMemorySize, LDS_BYTES) != hipSuccess) { fprintf(stderr, "kernel_launch: hipFuncSetAttribute failed\n"); grid = -1; return; }
        if (hipOccupancyMaxActiveBlocksPerMultiprocessor(&per_cu, (const void*)fwd, NT, LDS_BYTES) != hipSuccess || per_cu < 1) fprintf(stderr, "kernel_launch: occupancy query says %d\n", per_cu);
        (void)hipGetLastError();
        grid = cus;
    }
    if (grid < 0) return;
    (void)in_sizes;
    (void)hipMemsetAsync((char*)d_ws + O_CTL, 0, CTL_BYTES, stream);
    Params p{};
    for (int i = 0; i < 37; ++i) p.in[i] = (const float*)d_in[i];
    p.out = (float*)d_out; p.ws = (unsigned char*)d_ws;
#if ONE_LAUNCH
    p.ph_lo = 0; p.ph_hi = NPH;
    hipLaunchKernelGGL(fwd, dim3(grid), dim3(NT), LDS_BYTES, stream, p);
#else
    for (int k = 0; k < NPH; ++k) { p.ph_lo = k; p.ph_hi = k + 1; hipLaunchKernelGGL(fwd, dim3(grid), dim3(NT), LDS_BYTES, stream, p); }
#endif
}
#endif
```

```cpp
#ifndef CPU_EMU
#include <hip/hip_runtime.h>
#endif
#include <cstdio>
#include <cstdint>
#include <cmath>
#include <cstring>

#ifndef SEQ
#define SEQ 4096
#endif
#ifndef ONE_LAUNCH
#define ONE_LAUNCH 1
#endif

namespace {
constexpr int D = 2048, NB = 2, S = SEQ, T = NB * S, NL = 2, W = 1024;
constexpr int INW = 18816, RF = 3456, D6 = 6 * D;
constexpr int C_LX = 0, C_LG = 1024, C_RQ = 2048, C_RK = 2560, C_RV = 3072, C_RG = 4096, C_SU = 5120, C_SV = 6144, C_RW = 7168;
constexpr int PW = 18944, C_MLP = 10752;
constexpr int NCH = S / 128;
constexpr int NLC = S / 64;
constexpr int NE = 32, CAP = (T * 2 / 256 + NE) * 256, MAXBLK = CAP / 256;
constexpr float EPS = 1e-6f;
constexpr float DECAY_SCALE = 0.60653065971263342f;
constexpr int NT = 512;
constexpr int NPH_LAYER = 17, NPH = 2 + NL * NPH_LAYER;
typedef unsigned short bf16_t;
#ifdef CPU_EMU
typedef float f32x4 __attribute__((vector_size(16)));
typedef unsigned u32x4 __attribute__((vector_size(16)));
#else
typedef float f32x4 __attribute__((ext_vector_type(4)));
typedef unsigned u32x4 __attribute__((ext_vector_type(4)));
typedef short bf16x8 __attribute__((ext_vector_type(8)));
#endif

constexpr size_t al256(size_t x) { return (x + 255) & ~(size_t)255; }
constexpr size_t SZ_X = (size_t)T * D * 4, SZ_W = (size_t)T * W * 4;
constexpr size_t O_CTL = 0, CTL_BYTES = 1u << 20;
constexpr size_t O_MOD = CTL_BYTES;
constexpr size_t O_X0 = O_MOD + al256((size_t)NL * NB * D6 * 4);
constexpr size_t O_X1 = O_X0 + SZ_X;
constexpr size_t O_H = O_X1 + SZ_X;
constexpr size_t O_HF = O_H + SZ_X / 2;
constexpr size_t O_P = O_HF + SZ_X;
constexpr size_t SZ_P = (size_t)T * PW * 2;
constexpr size_t O_XC = O_P + SZ_P;
constexpr size_t O_LA = O_XC + SZ_W, O_LU = O_LA + 2 * SZ_W;
constexpr size_t SZ_LC = (size_t)2 * NB * NLC * W * 4;
constexpr size_t O_LCA = O_LU + 2 * SZ_W, O_LCH = O_LCA + SZ_LC, O_LCI = O_LCH + SZ_LC;
constexpr size_t O_YS = O_LCI + SZ_LC;
constexpr size_t O_SC = O_YS + (size_t)T * 4 * W * 2;
constexpr size_t SZ_KV = (size_t)NB * NCH * 8 * 64 * 128 * 4;
constexpr size_t O_KVF = O_SC, O_KVB = O_KVF + SZ_KV, O_STF = O_KVB + SZ_KV, O_STB = O_STF + SZ_KV;
constexpr size_t O_VN = O_STB + SZ_KV;
constexpr size_t O_FS = O_VN + SZ_W;
constexpr size_t O_DEC = O_FS + al256((size_t)T * RF * 4), O_AA = O_DEC + 2 * SZ_W, O_AKK = O_AA + 2 * SZ_W;
constexpr size_t O_GG = O_AKK, O_YY = O_GG + SZ_W;
constexpr int RCK = 64, NRC = S / RCK;
constexpr size_t O_BON = O_YY + 2 * SZ_W;
constexpr size_t O_PART = O_BON + al256((size_t)2 * T * 16 * 4);
constexpr size_t O_MRG = O_PART + SZ_X;
constexpr size_t O_LOG = O_MRG + SZ_X / 2;
constexpr size_t O_EID = O_LOG + al256((size_t)T * 40 * 4), O_EWT = O_EID + al256((size_t)T * 2 * 4), O_DEST = O_EWT + al256((size_t)T * 2 * 4);
constexpr size_t O_SLOT = O_DEST + al256((size_t)T * 2 * 4);
constexpr size_t O_PST = O_SLOT + al256((size_t)CAP * 4), O_PYT = O_PST + (size_t)64 * NRC * 4096 * 2, O_SVB = O_PYT + (size_t)64 * NRC * 4096 * 2, O_YVB = O_SVB + (size_t)64 * NRC * 4096 * 4;
constexpr size_t O_WIN = O_YVB + (size_t)64 * NRC * 4096 * 4;
constexpr size_t O_WBR = O_WIN + (size_t)PW * D * 2;
constexpr size_t O_WOUT = O_WBR + (size_t)D * 4 * W * 2;
constexpr size_t O_WGU = O_WOUT + (size_t)D * D * 2;
constexpr size_t O_WDN = O_WGU + (size_t)NE * 1024 * D * 2;
constexpr size_t O_WLR = O_WDN + (size_t)NE * D * 512 * 2;
constexpr size_t O_WUT = O_WLR + (size_t)32 * 128 * 128 * 2;
constexpr size_t O_WAT = O_WUT + (size_t)2 * W * 64 * 2;
constexpr size_t O_WGT = O_WAT + (size_t)2 * W * 64 * 2;
constexpr size_t O_WRH = O_WGT + (size_t)W * 128 * 2;
constexpr size_t O_WRL = O_WRH + (size_t)48 * D * 2;
constexpr size_t WS_END0 = O_WRL + (size_t)48 * D * 2;
constexpr size_t SZ_MOE = (size_t)CAP * (D + 512 + D) * 2;
constexpr bool MOE_OVERLAY = SZ_MOE <= SZ_P;
constexpr size_t O_XS = MOE_OVERLAY ? O_P : WS_END0;
constexpr size_t O_ACT = O_XS + (size_t)CAP * D * 2;
constexpr size_t O_YE = O_ACT + (size_t)CAP * 512 * 2;
constexpr size_t WS_END = MOE_OVERLAY ? WS_END0 : WS_END0 + SZ_MOE;
static_assert(SEQ != 4096 || WS_END <= (size_t)2040 * 1024 * 1024, "workspace budget: d_ws is 4 x the largest input = 2048 MiB");
constexpr int CW_BAR = 4096;
constexpr int CW_CNT = 32768;
constexpr int CW_FILL = CW_CNT + NL * 64;
constexpr int CW_PLAN = CW_FILL + NL * 64;
static_assert(MAXBLK <= 160, "plan words");

struct Params { const float* in[37]; float* out; unsigned char* ws; int ph_lo, ph_hi; };

struct Ctx { const float* const* in; float* out; unsigned char* ws; };
#define GT_ ((long)blockIdx.x * NT + threadIdx.x)
#define GS_ ((long)gridDim.x * NT)
#define WSF(off) ((float*)(c.ws + (off)))
#define WSI(off) ((int*)(c.ws + (off)))
#define WSH(off) ((bf16_t*)(c.ws + (off)))
#define CTLW(c) ((int*)((c).ws + O_CTL))

#ifdef CPU_EMU
__device__ __forceinline__ float fexp_(float x) { return expf(x); }
__device__ __forceinline__ float frcp_(float x) { return 1.f / x; }
#else
__device__ __forceinline__ float fexp_(float x) { return __builtin_amdgcn_exp2f(x * 1.4426950408889634f); }
__device__ __forceinline__ float frcp_(float x) { return __builtin_amdgcn_rcpf(x); }
#endif
__device__ __forceinline__ float sigmoidf_(float x) { return frcp_(1.f + fexp_(-x)); }
__device__ __forceinline__ float siluf_(float x) { return x * frcp_(1.f + fexp_(-x)); }
__device__ __forceinline__ float tanhf_(float x) { return 1.f - 2.f * frcp_(1.f + fexp_(2.f * x)); }
__device__ __forceinline__ float geluf_(float x) { return 0.5f * x * (1.f + tanhf_(0.7978845608028654f * (x + 0.044715f * x * x * x))); }
__device__ __forceinline__ float softplusf_(float x) { return x > 0.f ? x + log1pf(expf(-x)) : log1pf(expf(x)); }
__device__ __forceinline__ float loggamma_(int h) { return log1pf(-exp2f(-5.f - (float)h)); }
__device__ __forceinline__ unsigned f2u_(float f) { unsigned u; memcpy(&u, &f, 4); return u; }
__device__ __forceinline__ float u2f_(unsigned u) { float f; memcpy(&f, &u, 4); return f; }
__device__ __forceinline__ float bf2f(bf16_t v) { return u2f_((unsigned)v << 16); }
__device__ __forceinline__ unsigned f2bf(float f) { const unsigned u = f2u_(f); return (u + 0x7fffu + ((u >> 16) & 1u)) >> 16; }
__device__ __forceinline__ unsigned pk2(float lo, float hi) { return f2bf(lo) | (f2bf(hi) << 16); }
__device__ __forceinline__ float bflo(unsigned w) { return u2f_(w << 16); }
__device__ __forceinline__ float bfhi(unsigned w) { return u2f_(w & 0xffff0000u); }
__device__ __forceinline__ int atomic_add_i(int* p, int v) {
#ifdef CPU_EMU
    return __atomic_fetch_add(p, v, __ATOMIC_RELAXED);
#else
    return atomicAdd(p, v);
#endif
}
#define PF(P, r, col) bf2f((P)[(size_t)(r) * PW + (col)])
#ifdef CPU_EMU
#define SYNCTHREADS() emu_syncthreads()
#define SHFL_XOR(v, m) emu_shfl_xor(v, m)
#else
#define SYNCTHREADS() __syncthreads()
#define SHFL_XOR(v, m) __shfl_xor(v, m)
#endif
#ifdef CPU_EMU
__device__ __forceinline__ float wave_sum(float v) {
    for (int o = 1; o < 64; o <<= 1) v += SHFL_XOR(v, o);
    return v;
}
#else
__device__ __forceinline__ float wave_sum(float x) {
    x += __builtin_bit_cast(float, __builtin_amdgcn_update_dpp(0, __builtin_bit_cast(int, x), 0xB1, 0xF, 0xF, true));
    x += __builtin_bit_cast(float, __builtin_amdgcn_update_dpp(0, __builtin_bit_cast(int, x), 0x4E, 0xF, 0xF, true));
    x += __builtin_bit_cast(float, __builtin_amdgcn_update_dpp(0, __builtin_bit_cast(int, x), 0x141, 0xF, 0xF, true));
    x += __builtin_bit_cast(float, __builtin_amdgcn_update_dpp(0, __builtin_bit_cast(int, x), 0x140, 0xF, 0xF, true));
    const int xi = __builtin_bit_cast(int, x);
    return (__builtin_bit_cast(float, __builtin_amdgcn_readlane(xi, 0)) + __builtin_bit_cast(float, __builtin_amdgcn_readlane(xi, 16))) + (__builtin_bit_cast(float, __builtin_amdgcn_readlane(xi, 32)) + __builtin_bit_cast(float, __builtin_amdgcn_readlane(xi, 48)));
}
#endif
__device__ __forceinline__ f32x4 ld_bf4(const bf16_t* p) { const unsigned long long q = *(const unsigned long long*)p; const unsigned lo = (unsigned)q, hi = (unsigned)(q >> 32); return (f32x4){bflo(lo), bfhi(lo), bflo(hi), bfhi(hi)}; }
__device__ __forceinline__ void st_bf4(bf16_t* p, const f32x4 v) { *(unsigned long long*)p = (unsigned long long)pk2(v[0], v[1]) | ((unsigned long long)pk2(v[2], v[3]) << 32); }

template <int KT, int NTL>
__device__ __forceinline__ void wave_mma(f32x4 (&acc)[NTL], const bf16_t* A, int lda, const bf16_t* Bt, int ldb) {
    const int lane = threadIdx.x & 63, fr = lane & 15, fq = lane >> 4;
#ifdef CPU_EMU
    for (int nt = 0; nt < NTL; ++nt) for (int r = 0; r < 4; ++r) { float sacc = 0.f; const bf16_t* a = A + fr * lda; const bf16_t* b = Bt + (16 * nt + 4 * fq + r) * ldb;
        for (int k = 0; k < 32 * KT; ++k) sacc += bf2f(a[k]) * bf2f(b[k]);
        acc[nt][r] += sacc; }
#else
#pragma unroll
    for (int kt = 0; kt < KT; ++kt) {
        const bf16x8 af = *(const bf16x8*)(A + fr * lda + kt * 32 + fq * 8);
#pragma unroll
        for (int nt = 0; nt < NTL; ++nt) { const bf16x8 bfr = *(const bf16x8*)(Bt + (16 * nt + fr) * ldb + kt * 32 + fq * 8);
            acc[nt] = __builtin_amdgcn_mfma_f32_16x16x32_bf16(bfr, af, acc[nt], 0, 0, 0); }
    }
#endif
}
__device__ __forceinline__ void ph_mod(const Ctx& c, float* ldsf) {
    const float* cc = c.in[1]; const float* aw = c.in[5]; const float* ab = c.in[6]; float* mod = WSF(O_MOD);
    float* scs = ldsf; float* part = ldsf + NB * D; const int tid = threadIdx.x, c4 = (tid & 31) * 4, kq = tid >> 5;
    for (int i = tid; i < NB * D; i += NT) scs[i] = siluf_(cc[i]);
    SYNCTHREADS();
    for (int u = blockIdx.x; u < NL * (D6 / 128); u += gridDim.x) {
        const int l = u / (D6 / 128), j0 = (u % (D6 / 128)) * 128;
        const float* w = aw + (size_t)l * D * D6 + j0 + c4; f32x4 a0 = (f32x4){0.f, 0.f, 0.f, 0.f}, a1 = a0;
#pragma unroll 8
        for (int k = kq * 128; k < kq * 128 + 128; ++k) { const f32x4 wv = *(const f32x4*)(w + (size_t)k * D6); a0 += wv * scs[k]; a1 += wv * scs[D + k]; }
        *(f32x4*)(part + (kq * 2 + 0) * 128 + c4) = a0; *(f32x4*)(part + (kq * 2 + 1) * 128 + c4) = a1;
        SYNCTHREADS();
        if (tid < 256) { const int b = tid >> 7, col = tid & 127; float sacc = 0.f;
#pragma unroll
            for (int q = 0; q < 16; ++q) sacc += part[(q * 2 + b) * 128 + col];
            mod[((size_t)l * NB + b) * D6 + j0 + col] = sacc + ab[l * D6 + j0 + col]; }
        SYNCTHREADS();
    }
}
__device__ __forceinline__ void ph_norm(const Ctx& c, const float* x, const float* g, const float* sh, const float* sc, bf16_t* hb, float* hf) {
    const int lane = threadIdx.x & 63, gw = blockIdx.x * (NT / 64) + (threadIdx.x >> 6), ngw = gridDim.x * (NT / 64);
    for (int t = gw; t < T; t += ngw) {
        const int b = t / S; const float* xr = x + (size_t)t * D; f32x4 v[8]; float ss = 0.f;
#pragma unroll
        for (int j = 0; j < 8; ++j) { v[j] = *(const f32x4*)(xr + (j * 64 + lane) * 4); ss += (v[j][0] * v[j][0] + v[j][1] * v[j][1]) + (v[j][2] * v[j][2] + v[j][3] * v[j][3]); }
        const float rs = 1.f / sqrtf(wave_sum(ss) * (1.f / D) + EPS);
#pragma unroll
        for (int j = 0; j < 8; ++j) { const int col = (j * 64 + lane) * 4;
            const f32x4 o = v[j] * rs * *(const f32x4*)(g + col) * (*(const f32x4*)(sc + b * D6 + col) + 1.f) + *(const f32x4*)(sh + b * D6 + col);
            st_bf4(hb + (size_t)t * D + col, o); if (hf) *(f32x4*)(hf + (size_t)t * D + col) = o; }
    }
}
template <int MODE>
__device__ __forceinline__ void ph_comb_norm(const Ctx& c, const float* xmid, const float* g2, float* xout, const float* g, const float* sh, const float* sc, bf16_t* hb, float* outp) {
    const bf16_t* YE = WSH(O_YE); const float* EWT = WSF(O_EWT); const int* DEST = WSI(O_DEST);
    const int lane = threadIdx.x & 63, gw = blockIdx.x * (NT / 64) + (threadIdx.x >> 6), ngw = gridDim.x * (NT / 64);
    for (int t = gw; t < T; t += ngw) {
        const int b = t / S; const float w0 = EWT[t * 2], w1 = EWT[t * 2 + 1]; const bf16_t* y0 = YE + (size_t)DEST[t * 2] * D; const bf16_t* y1 = YE + (size_t)DEST[t * 2 + 1] * D;
        f32x4 v[8]; float ss = 0.f;
#pragma unroll
        for (int j = 0; j < 8; ++j) { const int col = (j * 64 + lane) * 4;
            v[j] = *(const f32x4*)(xmid + (size_t)t * D + col) + *(const f32x4*)(g2 + b * D6 + col) * (ld_bf4(y0 + col) * w0 + ld_bf4(y1 + col) * w1);
            if (MODE == 0) *(f32x4*)(xout + (size_t)t * D + col) = v[j];
            ss += (v[j][0] * v[j][0] + v[j][1] * v[j][1]) + (v[j][2] * v[j][2] + v[j][3] * v[j][3]); }
        const float rs = 1.f / sqrtf(wave_sum(ss) * (1.f / D) + EPS);
#pragma unroll
        for (int j = 0; j < 8; ++j) { const int col = (j * 64 + lane) * 4;
            if (MODE == 0) st_bf4(hb + (size_t)t * D + col, v[j] * rs * *(const f32x4*)(g + col) * (*(const f32x4*)(sc + b * D6 + col) + 1.f) + *(const f32x4*)(sh + b * D6 + col));
            else *(f32x4*)(outp + (size_t)t * D + col) = v[j] * rs * *(const f32x4*)(g + col); }
    }
}

struct CvtItem { const float* Wp; int ldw; bf16_t* WT; int ldt; int drow, k0, n0; };
constexpr int I_IN = 32 * (INW / 32), I_BR = 4 * 16 * 64, I_OUT = 32 * 64, I_GU = NE * 32 * 32, I_DN = NE * 8 * 64, I_LR = 32 * 8, I_WU = 2 * 32, I_WG = 64, I_ALL = I_IN + I_BR + I_OUT + I_GU + I_DN + I_LR + 2 * I_WU + I_WG;
__device__ __forceinline__ CvtItem cvt_decode(const Ctx& c, int l, int it) {
    CvtItem r;
    if (it < I_IN) { const int kb = it / (INW / 32), nb = it % (INW / 32); r.n0 = nb * 32; r.k0 = kb * 64; r.Wp = c.in[7] + (size_t)l * D * INW; r.ldw = INW; r.WT = WSH(O_WIN); r.ldt = D; r.drow = r.n0 < 10624 ? r.n0 : r.n0 + 128; return r; }
    it -= I_IN;
    if (it < I_BR) { const int sgm = it / 1024, q = it % 1024, kb = q / 64, nb = q % 64; r.n0 = nb * 32; r.k0 = kb * 64; r.Wp = c.in[28] + ((size_t)l * 4 + sgm) * W * D; r.ldw = D; r.WT = WSH(O_WBR) + sgm * W; r.ldt = 4 * W; r.drow = r.n0; return r; }
    it -= I_BR;
    if (it < I_OUT) { const int kb = it / 64, nb = it % 64; r.n0 = nb * 32; r.k0 = kb * 64; r.Wp = c.in[29] + (size_t)l * D * D; r.ldw = D; r.WT = WSH(O_WOUT); r.ldt = D; r.drow = r.n0; return r; }
    it -= I_OUT;
    if (it < I_GU) { const int e = it / 1024, q = it % 1024, kb = q / 32, nb = q % 32; r.n0 = nb * 32; r.k0 = kb * 64; r.Wp = c.in[34] + ((size_t)l * NE + e) * D * 1024; r.ldw = 1024; r.WT = WSH(O_WGU) + (size_t)e * 1024 * D; r.ldt = D;
        r.drow = r.n0 < 512 ? (r.n0 / 128) * 256 + (r.n0 % 128) : ((r.n0 - 512) / 128) * 256 + 128 + ((r.n0 - 512) % 128); return r; }
    it -= I_GU;
    if (it < I_DN) { const int e = it / 512, q = it % 512, kb = q / 64, nb = q % 64; r.n0 = nb * 32; r.k0 = kb * 64; r.Wp = c.in[35] + ((size_t)l * NE + e) * 512 * D; r.ldw = D; r.WT = WSH(O_WDN) + (size_t)e * D * 512; r.ldt = 512; r.drow = r.n0; return r; }
    it -= I_DN;
    if (it < I_LR) { const int m = it / 8, q = it % 8, kb = q / 4, nb = q % 4, z = m >> 4, ty = (m >> 3) & 1, n = m & 7; r.n0 = nb * 32; r.k0 = kb * 64; r.Wp = c.in[ty ? 12 : 10] + (((size_t)l * 2 + z) * 8 + n) * 128 * 128; r.ldw = 128;
        r.WT = WSH(O_WLR) + (size_t)m * 128 * 128; r.ldt = 128; r.drow = r.n0; return r; }
    it -= I_LR;
    if (it < 2 * I_WU) { const int ua = it / I_WU, q = it % I_WU, z = q / 32, nb = q % 32; r.n0 = nb * 32; r.k0 = 0; r.Wp = c.in[ua ? 23 : 21] + ((size_t)l * 2 + z) * 64 * W; r.ldw = W; r.WT = WSH(ua ? O_WAT : O_WUT) + (size_t)z * W * 64; r.ldt = 64; r.drow = r.n0; return r; }
    it -= 2 * I_WU;
    { const int kb = it / 32, nb = it % 32; r.n0 = nb * 32; r.k0 = kb * 64; r.Wp = c.in[24] + (size_t)l * 128 * W; r.ldw = W; r.WT = WSH(O_WGT); r.ldt = 128; r.drow = r.n0; return r; }
}
__device__ __forceinline__ void ph_convert(const Ctx& c, int l, float* ldsf) {
    const int lane = threadIdx.x & 63, wave = threadIdx.x >> 6; const int gw = blockIdx.x * (NT / 64) + wave, ngw = gridDim.x * (NT / 64);
#ifdef CPU_EMU
    if (lane == 0) for (int it = gw; it < I_ALL; it += ngw) { const CvtItem r = cvt_decode(c, l, it);
        for (int kk = 0; kk < 64; ++kk) for (int nn = 0; nn < 32; ++nn) r.WT[(size_t)(r.drow + nn) * r.ldt + r.k0 + kk] = (bf16_t)f2bf(r.Wp[(size_t)(r.k0 + kk) * r.ldw + r.n0 + nn]); }
#else
    float* scr = ldsf + wave * (64 * 33 + 16);
    for (int it = gw; it < I_ALL; it += ngw) {
        const CvtItem r = cvt_decode(c, l, it);
#pragma unroll 8
        for (int i = 0; i < 32; ++i) { const int kk = 2 * i + (lane >> 5); scr[kk * 33 + (lane & 31)] = r.Wp[(size_t)(r.k0 + kk) * r.ldw + r.n0 + (lane & 31)]; }
        asm volatile("s_waitcnt lgkmcnt(0)" ::: "memory");
        const int cc = lane & 7;
#pragma unroll
        for (int j = 0; j < 4; ++j) { const int n = (lane >> 3) + 8 * j; const float* sp = scr + (8 * cc) * 33 + n;
            u32x4 o; o[0] = pk2(sp[0 * 33], sp[1 * 33]); o[1] = pk2(sp[2 * 33], sp[3 * 33]); o[2] = pk2(sp[4 * 33], sp[5 * 33]); o[3] = pk2(sp[6 * 33], sp[7 * 33]);
            *(u32x4*)(r.WT + (size_t)(r.drow + n) * r.ldt + r.k0 + 8 * cc) = o; }
        asm volatile("s_waitcnt lgkmcnt(0)" ::: "memory");
    }
#endif
    { const float* wg = c.in[30] + (size_t)l * D * 4; const float* we = c.in[32] + (size_t)l * D * 32; bf16_t* wh = WSH(O_WRH); bf16_t* wl = WSH(O_WRL);
      for (long i = GT_; i < (long)48 * D; i += GS_) { const int n = (int)(i / D), k = (int)(i % D); const float w = n < 4 ? wg[k * 4 + n] : n < 36 ? we[k * 32 + (n - 4)] : 0.f; const unsigned hb = f2bf(w); wh[i] = (bf16_t)hb; wl[i] = (bf16_t)f2bf(w - bf2f((bf16_t)hb)); } }
    for (long i = GT_; i < (long)128 * D / 2; i += GS_) ((unsigned*)(WSH(O_WIN) + (size_t)10624 * D))[i] = 0u;
}

namespace pg8 {
constexpr int BM = 256, BK = 64, HALF = 128, HTB = HALF * BK * 2, STAGE_BYTES = 8 * HTB;
__host__ __device__ __forceinline__ int lds_byte(int r, int cc) { const int st = (r >> 4) * 2 + (cc >> 5), rr = r & 15, c2 = cc & 31, ob = rr * 64 + c2 * 2; return st * 1024 + (ob ^ (((ob >> 9) & 1) << 5)); }
__host__ __device__ __forceinline__ void stage_rc(int b, int& R, int& C) { const int st = b / 1024, sb = b % 1024, swz = sb ^ (((sb >> 9) & 1) << 5); R = (st >> 1) * 16 + swz / 64; C = (st & 1) * 32 + (swz % 64) / 2; }
__host__ __device__ __forceinline__ int perm32(int rho) { const int n = rho >> 4, i = rho & 15; return 8 * (i >> 2) + 4 * n + (i & 3); }
struct Unit { int pm, pn, aux; const char* A; const char* B; };
struct Gemm { int K, lda, ldb; };

template <class Epi, class Sched>
__device__ __forceinline__ void gemm_phase(unsigned char* lds_, const Gemm g, const Sched& S, const Epi& E) {
#ifdef CPU_EMU
    if (threadIdx.x != 0) return;
    Unit u; const int K = g.K;
    float* Af = (float*)malloc((size_t)256 * K * 4); float* Bf = (float*)malloc((size_t)256 * K * 4); float* Cf = (float*)malloc(256 * 256 * 4);
    for (int i = 0; S.next(i, u); ++i) {
        const bf16_t* A = (const bf16_t*)u.A; const bf16_t* B = (const bf16_t*)u.B;
        for (int r = 0; r < 256; ++r) for (int k = 0; k < K; ++k) { Af[(size_t)r * K + k] = bf2f(A[(size_t)r * g.lda + k]); Bf[(size_t)r * K + k] = bf2f(B[(size_t)r * g.ldb + k]); }
        for (int r = 0; r < 256; ++r) for (int cc = 0; cc < 256; ++cc) { const float* a = Af + (size_t)r * K; const float* b = Bf + (size_t)cc * K; float sacc = 0.f; for (int k = 0; k < K; ++k) sacc += a[k] * b[k]; Cf[r * 256 + cc] = sacc; }
        for (int wid = 0; wid < 8; ++wid) for (int lane = 0; lane < 64; ++lane) {
            const int wr = wid >> 2, wc = wid & 3, fr = lane & 15, fq = lane >> 4; f32x4 acc[2][2][4][2];
            for (int ai = 0; ai < 2; ++ai) for (int bj = 0; bj < 2; ++bj) for (int m = 0; m < 4; ++m) for (int n = 0; n < 2; ++n) for (int j = 0; j < 4; ++j) {
                const int r = 128 * ai + 64 * wr + 16 * m + fr, cc = 128 * bj + 32 * wc + (Epi::PERM ? 8 * fq + 4 * n + j : 16 * n + 4 * fq + j); acc[ai][bj][m][n][j] = Cf[r * 256 + cc]; }
            E(acc, u, wr, wc, fr, fq);
        }
    }
    free(Af); free(Bf); free(Cf);
#else
    typedef __attribute__((address_space(3))) unsigned char* ldsp_t;
    ldsp_t lds = (ldsp_t)lds_;
    const int tid = threadIdx.x, wid = __builtin_amdgcn_readfirstlane(tid >> 6), lane = tid & 63, wr = wid >> 2, wc = wid & 3, fr = lane & 15, fq = lane >> 4;
    const int K = g.K, nt = K / BK;
    unsigned voffA[2], voffB[2];
#pragma unroll
    for (int i = 0; i < 2; ++i) { int R, C; stage_rc(tid * 16 + i * 8192, R, C); const int Rb = Epi::PERM ? ((R & ~31) + perm32(R & 31)) : R;
        voffA[i] = (unsigned)(R * g.lda + C) * 2u; voffB[i] = (unsigned)(Rb * g.ldb + C) * 2u; }
    const size_t kstep = (size_t)(BK * 2);
    const size_t hstepA = (size_t)HALF * g.lda * 2, hstepB = (size_t)HALF * g.ldb * 2;
    const unsigned ldsw = (unsigned)wid * 1024u;
    const int aoff = lds_byte(wr * 64 + fr, fq * 8), boff = lds_byte(wc * 32 + fr, fq * 8);
#define PG8_SA(b, h) (((b) * 2 + (h)) * HTB)
#define PG8_SB(b, h) ((4 + (b) * 2 + (h)) * HTB)
#define PG8_STAGE(bufoff, gbase, voff) do { _Pragma("unroll") for (int _i = 0; _i < 2; ++_i) \
        __builtin_amdgcn_global_load_lds((const unsigned*)((const char*)(gbase) + (voff)[_i]), (__attribute__((address_space(3))) unsigned*)(lds + (bufoff) + ldsw + _i * 8192), 16, 0, 0); } while (0)
#define PG8_LDA(dst, b, h) do { _Pragma("unroll") for (int m = 0; m < 4; ++m) _Pragma("unroll") for (int k = 0; k < 2; ++k) dst[m][k] = *(const __attribute__((address_space(3))) bf16x8*)(lds + PG8_SA(b, h) + aoff + m * 2048 + k * 1024); } while (0)
#define PG8_LDB(dst, b, h) do { _Pragma("unroll") for (int n = 0; n < 2; ++n) _Pragma("unroll") for (int k = 0; k < 2; ++k) dst[n][k] = *(const __attribute__((address_space(3))) bf16x8*)(lds + PG8_SB(b, h) + boff + n * 2048 + k * 1024); } while (0)
#define PG8_MMA(ai, bj, At, Bt) do { __builtin_amdgcn_s_setprio(1); _Pragma("unroll") for (int m = 0; m < 4; ++m) _Pragma("unroll") for (int n = 0; n < 2; ++n) _Pragma("unroll") for (int k = 0; k < 2; ++k) \
        acc[ai][bj][m][n] = __builtin_amdgcn_mfma_f32_16x16x32_bf16(Bt[n][k], At[m][k], acc[ai][bj][m][n], 0, 0, 0); __builtin_amdgcn_s_setprio(0); } while (0)
#define PG8_WAIT_V(n) asm volatile("s_waitcnt vmcnt(" #n ")" ::: "memory")
#define PG8_WAIT_L(n) asm volatile("s_waitcnt lgkmcnt(" #n ")" ::: "memory")
#define PG8_BAR __builtin_amdgcn_s_barrier()
#define PG8_SCHED __builtin_amdgcn_sched_barrier(0)
    Unit cur, nxt; int ui = 0;
    if (!S.next(0, cur)) return;
    f32x4 acc[2][2][4][2];
#pragma unroll
    for (int a = 0; a < 2; ++a)
#pragma unroll
        for (int b = 0; b < 2; ++b)
#pragma unroll
            for (int m = 0; m < 4; ++m)
#pragma unroll
                for (int n = 0; n < 2; ++n) acc[a][b][m][n] = (f32x4){0.f, 0.f, 0.f, 0.f};
    bf16x8 At[4][2], B0[2][2], B1[2][2];
    const char* cA = cur.A; const char* cB = cur.B;
    S.a_ready(cur);
    PG8_STAGE(PG8_SB(0, 0), cB, voffB); PG8_STAGE(PG8_SA(0, 0), cA, voffA); PG8_STAGE(PG8_SB(0, 1), cB + hstepB, voffB); PG8_STAGE(PG8_SA(0, 1), cA + hstepA, voffA);
    if (wr == 1) PG8_BAR;
    PG8_WAIT_V(4); PG8_BAR;
    PG8_STAGE(PG8_SB(1, 0), cB + kstep, voffB); PG8_STAGE(PG8_SA(1, 0), cA + kstep, voffA); PG8_STAGE(PG8_SB(1, 1), cB + hstepB + kstep, voffB);
    PG8_WAIT_V(6); PG8_BAR;
    for (;;) {
        const bool has_next = S.next(ui + 1, nxt);
        const char* nA = has_next ? nxt.A : cA; const char* nB = has_next ? nxt.B : cB;
        for (int t = 0; t < nt; t += 2) {
            const bool last = (t == nt - 2);
            const char* a1 = cA + (size_t)(t + 1) * kstep;
            const char* a2 = last ? nA : cA + (size_t)(t + 2) * kstep; const char* b2 = last ? nB : cB + (size_t)(t + 2) * kstep;
            const char* a3 = a2 + kstep; const char* b3 = b2 + kstep;
            if (last && has_next) S.a_ready(nxt);
            PG8_LDB(B0, 0, 0); PG8_SCHED; PG8_LDA(At, 0, 0); PG8_STAGE(PG8_SA(1, 1), a1 + hstepA, voffA);
            PG8_WAIT_L(8); PG8_BAR; PG8_WAIT_L(0); PG8_MMA(0, 0, At, B0); PG8_BAR; PG8_SCHED;
            PG8_LDB(B1, 0, 1); PG8_STAGE(PG8_SB(0, 0), b2, voffB);
            PG8_BAR; PG8_WAIT_L(0); PG8_MMA(0, 1, At, B1); PG8_BAR;
            PG8_LDA(At, 0, 1); PG8_STAGE(PG8_SA(0, 0), a2, voffA);
            PG8_BAR; PG8_WAIT_L(0); PG8_MMA(1, 0, At, B0); PG8_BAR; PG8_SCHED;
            PG8_STAGE(PG8_SB(0, 1), b2 + hstepB, voffB);
            PG8_WAIT_V(6); PG8_BAR; PG8_MMA(1, 1, At, B1); PG8_BAR;
            PG8_LDB(B0, 1, 0); PG8_SCHED; PG8_LDA(At, 1, 0); PG8_STAGE(PG8_SA(0, 1), a2 + hstepA, voffA);
            PG8_WAIT_L(8); PG8_BAR; PG8_WAIT_L(0); PG8_MMA(0, 0, At, B0); PG8_BAR; PG8_SCHED;
            PG8_LDB(B1, 1, 1); PG8_STAGE(PG8_SB(1, 0), b3, voffB);
            PG8_BAR; PG8_WAIT_L(0); PG8_MMA(0, 1, At, B1); PG8_BAR;
            PG8_LDA(At, 1, 1); PG8_STAGE(PG8_SA(1, 0), a3, voffA);
            PG8_BAR; PG8_WAIT_L(0); PG8_MMA(1, 0, At, B0); PG8_BAR; PG8_SCHED;
            PG8_STAGE(PG8_SB(1, 1), b3 + hstepB, voffB);
            PG8_WAIT_V(6); PG8_BAR; PG8_MMA(1, 1, At, B1); PG8_BAR;
        }
        E(acc, cur, wr, wc, fr, fq); S.done(cur);
        if (!has_next) break;
#pragma unroll
        for (int a = 0; a < 2; ++a)
#pragma unroll
            for (int b = 0; b < 2; ++b)
#pragma unroll
                for (int m = 0; m < 4; ++m)
#pragma unroll
                    for (int n = 0; n < 2; ++n) acc[a][b][m][n] = (f32x4){0.f, 0.f, 0.f, 0.f};
        cur = nxt; cA = nA; cB = nB; ++ui;
    }
    PG8_WAIT_V(0);
    if (wr == 0) PG8_BAR;
    PG8_BAR;
#undef PG8_SA
#undef PG8_SB
#undef PG8_STAGE
#undef PG8_LDA
#undef PG8_LDB
#undef PG8_MMA
#undef PG8_WAIT_V
#undef PG8_WAIT_L
#undef PG8_BAR
#undef PG8_SCHED
#endif
}

struct StaticOrder {
    int nM, nN, nwg, G, c; const char* A; const char* B; size_t tstepA, tstepB;
    __device__ __forceinline__ void init(int M, int N, int G_, int c_, const void* A_, const void* B_, int lda, int ldb) { nM = M / BM; nN = N / BM; nwg = nM * nN; G = G_; c = c_; A = (const char*)A_; B = (const char*)B_; tstepA = (size_t)BM * lda * 2; tstepB = (size_t)BM * ldb * 2; }
    __device__ __forceinline__ bool next(int i, Unit& u) const {
        const long L = (long)i * G + c; if (L >= nwg) return false;
        int wgid = (int)L; { const int q = nwg / 8, r = nwg % 8, xcd = wgid % 8, off = wgid / 8; wgid = (xcd < r ? xcd * (q + 1) : r * (q + 1) + (xcd - r) * q) + off; }
        const int nig = 8 * nN, gid = wgid / nig, fm = gid * 8, gsz = (nM - fm) < 8 ? (nM - fm) : 8;
        u.pm = fm + ((wgid % nig) % gsz); u.pn = (wgid % nig) / gsz; u.aux = 0; u.A = A + (size_t)u.pm * tstepA; u.B = B + (size_t)u.pn * tstepB; return true;
    }
    __device__ __forceinline__ void a_ready(const Unit&) const {}
    __device__ __forceinline__ void done(const Unit&) const {}
};
struct MergeOrder {
    StaticOrder so; int kseg_bytes;
    __device__ __forceinline__ bool next(int i, Unit& u) const { if (!so.next(i >> 2, u)) return false; u.aux = i & 3; u.A += (size_t)u.aux * kseg_bytes; u.B += (size_t)u.aux * kseg_bytes; return true; }
    __device__ __forceinline__ void a_ready(const Unit&) const {}
    __device__ __forceinline__ void done(const Unit&) const {}
};
struct MoeOrder {
    int G, c, ncol; const int* plan; const char* A; const char* B; size_t tstepA, tstepB, estep;
    __device__ __forceinline__ bool next(int i, Unit& u) const {
        const long L = (long)i * G + c; const int nblk = plan[40]; if (L >= (long)nblk * ncol) return false;
        u.pm = (int)(L / ncol); u.pn = (int)(L % ncol); u.aux = plan[64 + u.pm]; u.A = A + (size_t)u.pm * tstepA; u.B = B + (size_t)u.aux * estep + (size_t)u.pn * tstepB; return true;
    }
    __device__ __forceinline__ void a_ready(const Unit&) const {}
    __device__ __forceinline__ void done(const Unit&) const {}
};

__device__ __forceinline__ u32x4 pack8(const f32x4 v0, const f32x4 v1) { u32x4 w; w[0] = pk2(v0[0], v0[1]); w[1] = pk2(v0[2], v0[3]); w[2] = pk2(v1[0], v1[1]); w[3] = pk2(v1[2], v1[3]); return w; }
struct EpiBf16 {
    static constexpr bool PERM = true; bf16_t* O; int ldc;
    __device__ __forceinline__ void operator()(const f32x4 (&acc)[2][2][4][2], const Unit& u, int wr, int wc, int fr, int fq) const {
        const int row0 = u.pm * BM + wr * 64 + fr, col0 = u.pn * BM + wc * 32 + 8 * fq;
#pragma unroll
        for (int ai = 0; ai < 2; ++ai)
#pragma unroll
            for (int m = 0; m < 4; ++m) { bf16_t* rowp = O + (size_t)(row0 + ai * HALF + m * 16) * ldc + col0;
#pragma unroll
                for (int bj = 0; bj < 2; ++bj) *(u32x4*)(rowp + bj * HALF) = pack8(acc[ai][bj][m][0], acc[ai][bj][m][1]); }
    }
};
struct EpiMerge {
    static constexpr bool PERM = true; const bf16_t* P; float* PART; bf16_t* MRG;
    __device__ __forceinline__ void operator()(const f32x4 (&acc)[2][2][4][2], const Unit& u, int wr, int wc, int fr, int fq) const {
        const int row0 = u.pm * BM + wr * 64 + fr, col0 = u.pn * BM + wc * 32 + 8 * fq, seg = u.aux;
#pragma unroll
        for (int ai = 0; ai < 2; ++ai)
#pragma unroll
            for (int m = 0; m < 4; ++m) { const size_t r = (size_t)(row0 + ai * HALF + m * 16);
#pragma unroll
                for (int bj = 0; bj < 2; ++bj) { const int cc = col0 + bj * HALF;
                    const u32x4 gw = *(const u32x4*)(P + r * PW + C_MLP + seg * D + cc);
                    f32x4 v0, v1;
#pragma unroll
                    for (int q = 0; q < 2; ++q) { v0[2 * q] = sigmoidf_(bflo(gw[q])) * acc[ai][bj][m][0][2 * q]; v0[2 * q + 1] = sigmoidf_(bfhi(gw[q])) * acc[ai][bj][m][0][2 * q + 1];
                        v1[2 * q] = sigmoidf_(bflo(gw[2 + q])) * acc[ai][bj][m][1][2 * q]; v1[2 * q + 1] = sigmoidf_(bfhi(gw[2 + q])) * acc[ai][bj][m][1][2 * q + 1]; }
                    float* pp = PART + r * D + cc;
                    if (seg > 0) { v0 += *(const f32x4*)pp; v1 += *(const f32x4*)(pp + 4); }
                    if (seg < 3) { *(f32x4*)pp = v0; *(f32x4*)(pp + 4) = v1; } else *(u32x4*)(MRG + r * D + cc) = pack8(v0, v1);
                }
#ifndef CPU_EMU
                asm volatile("" ::: "memory");
#endif
            }
    }
};
struct EpiResid {
    static constexpr bool PERM = false; const float* xin; const float* g1; float* xmid;
    __device__ __forceinline__ void operator()(const f32x4 (&acc)[2][2][4][2], const Unit& u, int wr, int wc, int fr, int fq) const {
        const int row0 = u.pm * BM + wr * 64 + fr, col0 = u.pn * BM + wc * 32 + 4 * fq;
#pragma unroll
        for (int ai = 0; ai < 2; ++ai)
#pragma unroll
            for (int m = 0; m < 4; ++m) { const int r = row0 + ai * HALF + m * 16; const float* gp = g1 + (size_t)(r / S) * D6;
#pragma unroll
                for (int bj = 0; bj < 2; ++bj)
#pragma unroll
                    for (int n = 0; n < 2; ++n) { const int cc = col0 + bj * HALF + n * 16; *(f32x4*)(xmid + (size_t)r * D + cc) = *(const f32x4*)(xin + (size_t)r * D + cc) + *(const f32x4*)(gp + cc) * acc[ai][bj][m][n]; }
#ifndef CPU_EMU
                asm volatile("" ::: "memory");
#endif
            }
    }
};
struct EpiGU {
    static constexpr bool PERM = true; bf16_t* ACT;
    __device__ __forceinline__ void operator()(const f32x4 (&acc)[2][2][4][2], const Unit& u, int wr, int wc, int fr, int fq) const {
        const int row0 = u.pm * BM + wr * 64 + fr, col0 = u.pn * HALF + wc * 32 + 8 * fq;
#pragma unroll
        for (int ai = 0; ai < 2; ++ai)
#pragma unroll
            for (int m = 0; m < 4; ++m) { f32x4 v0, v1;
#pragma unroll
                for (int j = 0; j < 4; ++j) { v0[j] = siluf_(acc[ai][0][m][0][j]) * acc[ai][1][m][0][j]; v1[j] = siluf_(acc[ai][0][m][1][j]) * acc[ai][1][m][1][j]; }
                *(u32x4*)(ACT + (size_t)(row0 + ai * HALF + m * 16) * 512 + col0) = pack8(v0, v1); }
    }
};
}

__device__ __forceinline__ void ph_lru_gate(const Ctx& c, int l, float* ldsf) {
    const bf16_t* P = WSH(O_P); const float* cw = c.in[8] + (size_t)l * 4 * W; const float* cb = c.in[9] + (size_t)l * W;
    const float* br = c.in[11] + (size_t)l * 2 * W; const float* bi = c.in[13] + (size_t)l * 2 * W; const float* lam = c.in[14] + (size_t)l * 2 * W; const bf16_t* WLR = WSH(O_WLR);
    float* LA = WSF(O_LA); float* LU = WSF(O_LU);
    bf16_t* Xs = (bf16_t*)ldsf; bf16_t* Wr = Xs + 128 * 136; bf16_t* Wi = Wr + 128 * 136; float* spl = (float*)(Wi + 128 * 136);
    const int tid = threadIdx.x, wv = tid >> 6, lane = tid & 63, fr = lane & 15, fq = lane >> 4;
    for (int u = blockIdx.x; u < (T / 128) * 8; u += gridDim.x) {
        const int n = u & 7; const long t0 = (long)(u >> 3) * 128;
        if (tid < 256) spl[tid] = softplusf_(-lam[(tid >> 7) * W + n * 128 + (tid & 127)]);
#pragma unroll
        for (int q = 0; q < 8; ++q) { const int id = tid + NT * q, tl = id >> 5, e4 = (id & 31) * 4, ch = n * 128 + e4; const long t = t0 + tl; const int sI = (int)(t % S);
            f32x4 acc = *(const f32x4*)(cb + ch);
#pragma unroll
            for (int k = 0; k < 4; ++k) { const int ss = sI + k - 2; if (ss >= 0 && ss < S) acc += ld_bf4(P + (size_t)(t + k - 2) * PW + C_LX + ch) * *(const f32x4*)(cw + k * W + ch); }
            st_bf4(Xs + tl * 136 + e4, acc); }
        for (int z = 0; z < 2; ++z) {
#pragma unroll
            for (int q = 0; q < 4; ++q) { const int id = tid + NT * q, f = id >> 4, e8 = (id & 15) * 8;
                *(u32x4*)(Wr + f * 136 + e8) = *(const u32x4*)(WLR + ((size_t)((z * 2 + 0) * 8 + n) * 128 + f) * 128 + e8); *(u32x4*)(Wi + f * 136 + e8) = *(const u32x4*)(WLR + ((size_t)((z * 2 + 1) * 8 + n) * 128 + f) * 128 + e8); }
            SYNCTHREADS();
            f32x4 ar[8], ai[8];
#pragma unroll
            for (int nt = 0; nt < 8; ++nt) { ar[nt] = (f32x4){0.f, 0.f, 0.f, 0.f}; ai[nt] = (f32x4){0.f, 0.f, 0.f, 0.f}; }
            wave_mma<4, 8>(ar, Xs + wv * 16 * 136, 136, Wr, 136);
            wave_mma<4, 8>(ai, Xs + wv * 16 * 136, 136, Wi, 136);
            const int tl = wv * 16 + fr;
#pragma unroll
            for (int nt = 0; nt < 8; ++nt) { const int f = 16 * nt + 4 * fq, ch = n * 128 + f;
                const f32x4 brv = *(const f32x4*)(br + z * W + ch), biv = *(const f32x4*)(bi + z * W + ch), lmv = *(const f32x4*)(spl + z * 128 + f), xcv = ld_bf4(Xs + tl * 136 + f); f32x4 av, uv;
#pragma unroll
                for (int e = 0; e < 4; ++e) { const float r = sigmoidf_(ar[nt][e] + brv[e]), ig = sigmoidf_(ai[nt][e] + biv[e]), la = -8.f * r * lmv[e]; const float a = fexp_(la); av[e] = a; uv[e] = sqrtf(fmaxf(1.f - a * a, 0.f)) * ig * xcv[e]; }
                *(f32x4*)(LA + ((size_t)z * T + t0 + tl) * W + ch) = av; *(f32x4*)(LU + ((size_t)z * T + t0 + tl) * W + ch) = uv; }
            SYNCTHREADS();
        }
    }
}
__device__ __forceinline__ void ph_lru_scan1(const Ctx& c) {
    const float* LA = WSF(O_LA); const float* LU = WSF(O_LU); float* CA = WSF(O_LCA); float* CH = WSF(O_LCH);
    for (long i = GT_; i < (long)2 * NB * NLC * W; i += GS_) {
        const int w = (int)(i % W), ch = (int)((i / W) % NLC), b = (int)((i / ((long)W * NLC)) % NB), z = (int)(i / ((long)W * NLC * NB));
        const long t0 = (long)b * S + ch * 64; float prod = 1.f, h = 0.f;
#pragma unroll 16
        for (int q = 0; q < 64; ++q) { const int s = z == 0 ? q : 63 - q; const size_t idx = ((size_t)z * T + t0 + s) * W + w; const float a = LA[idx]; h = a * h + LU[idx]; prod *= a; }
        CA[i] = prod; CH[i] = h;
    }
}
__device__ __forceinline__ void ph_lru_scan2(const Ctx& c) {
    const float* CA = WSF(O_LCA); const float* CH = WSF(O_LCH); float* CI = WSF(O_LCI);
    for (long i = GT_; i < (long)2 * NB * W; i += GS_) {
        const int w = (int)(i % W), b = (int)((i / W) % NB), z = (int)(i / ((long)W * NB)); float carry = 0.f;
        for (int q = 0; q < NLC; ++q) { const int ch = z == 0 ? q : NLC - 1 - q; const size_t idx = (((size_t)z * NB + b) * NLC + ch) * W + w; CI[idx] = carry; carry = CA[idx] * carry + CH[idx]; }
    }
}
__device__ __forceinline__ void ph_lru_scan3(const Ctx& c) {
    const float* LA = WSF(O_LA); const float* LU = WSF(O_LU); const float* CI = WSF(O_LCI); const bf16_t* P = WSH(O_P); float* HFW = WSF(O_XC); bf16_t* Y = WSH(O_YS);
    for (long i = GT_; i < (long)NB * NLC * W; i += GS_) {
        const int w = (int)(i % W), ch = (int)((i / W) % NLC), b = (int)(i / ((long)W * NLC)); const long t0 = (long)b * S + ch * 64;
        float h = CI[(((size_t)0 * NB + b) * NLC + ch) * W + w];
#pragma unroll 16
        for (int s = 0; s < 64; ++s) { const size_t idx = ((size_t)(t0 + s)) * W + w; h = LA[idx] * h + LU[idx]; HFW[idx] = h; }
        h = CI[(((size_t)1 * NB + b) * NLC + ch) * W + w];
#pragma unroll 8
        for (int s = 63; s >= 0; --s) { const size_t idx = ((size_t)(t0 + s)) * W + w; h = LA[(size_t)T * W + idx] * h + LU[(size_t)T * W + idx];
            Y[(size_t)(t0 + s) * 4 * W + 0 * W + w] = (bf16_t)f2bf((HFW[idx] + h) * geluf_(PF(P, t0 + s, C_LG + w))); }
    }
}
__device__ __forceinline__ void ret_tables(float* tab, int h) {
    const int tid = threadIdx.x; const float lg = loggamma_(h);
    if (tid < 32) tab[tid] = powf(10000.f, -(float)(2 * tid) / 64.f);
    if (tid >= 64 && tid < 64 + 129) tab[tid] = expf((float)(tid - 64) * lg);
}
__device__ __forceinline__ void ph_ret_kv(const Ctx& c, float* ldsf) {
    const int* pos = (const int*)c.in[2]; const bf16_t* P = WSH(O_P); float* KVF = WSF(O_KVF); float* KVB = WSF(O_KVB);
    bf16_t* VT = (bf16_t*)ldsf; bf16_t* KF = VT + 128 * 136; bf16_t* KB = KF + 64 * 136; float* tab = (float*)(KB + 64 * 136);
    const int tid = threadIdx.x, wv = tid >> 6, lane = tid & 63, fr = lane & 15, fq = lane >> 4;
    for (int u = blockIdx.x; u < (T / 128) * 8; u += gridDim.x) {
        const int h = u & 7; const long t0 = (long)(u >> 3) * 128;
        ret_tables(tab, h);
        SYNCTHREADS();
        { float x1[8], x2[8], pj[8];
#pragma unroll
          for (int q = 0; q < 8; ++q) { const int id = tid + NT * q, j = id & 127, dj = id >> 7; const bf16_t* prow = P + (size_t)(t0 + j) * PW + C_RK + h * 64; x1[q] = bf2f(prow[dj]); x2[q] = bf2f(prow[dj + 32]); pj[q] = (float)pos[t0 + j]; }
#pragma unroll 1
          for (int q = 0; q < 8; ++q) { const int id = tid + NT * q, j = id & 127, dj = id >> 7; const float ang = pj[q] * tab[dj]; const float cs = cosf(ang), sn = sinf(ang);
            const float k1 = x1[q] * cs - x2[q] * sn, k2 = x2[q] * cs + x1[q] * sn, fj = tab[64 + 127 - j], bj = tab[64 + j];
            KF[dj * 136 + j] = (bf16_t)f2bf(k1 * fj); KF[(dj + 32) * 136 + j] = (bf16_t)f2bf(k2 * fj); KB[dj * 136 + j] = (bf16_t)f2bf(k1 * bj); KB[(dj + 32) * 136 + j] = (bf16_t)f2bf(k2 * bj); } }
#pragma unroll
        for (int q = 0; q < 4; ++q) { const int id = tid + NT * q, j = id & 127, e8 = (id >> 7) * 8; const u32x4 raw = *(const u32x4*)(P + (size_t)(t0 + j) * PW + C_RV + h * 128 + e8);
#pragma unroll
            for (int e = 0; e < 4; ++e) { VT[(e8 + 2 * e) * 136 + j] = (bf16_t)(raw[e] & 0xffffu); VT[(e8 + 2 * e + 1) * 136 + j] = (bf16_t)(raw[e] >> 16); } }
        SYNCTHREADS();
        f32x4 af[4], ab[4];
#pragma unroll
        for (int nt = 0; nt < 4; ++nt) { af[nt] = (f32x4){0.f, 0.f, 0.f, 0.f}; ab[nt] = (f32x4){0.f, 0.f, 0.f, 0.f}; }
        wave_mma<4, 4>(af, VT + wv * 16 * 136, 136, KF, 136);
        wave_mma<4, 4>(ab, VT + wv * 16 * 136, 136, KB, 136);
        const size_t ob = (((size_t)(u >> 3) * 8 + h) * 128 + wv * 16 + fr) * 64 + 4 * fq;
#pragma unroll
        for (int nt = 0; nt < 4; ++nt) { *(f32x4*)(KVF + ob + 16 * nt) = af[nt]; *(f32x4*)(KVB + ob + 16 * nt) = ab[nt]; }
        SYNCTHREADS();
    }
}
__device__ __forceinline__ void ph_ret_state(const Ctx& c) {
    const float* KVF = WSF(O_KVF); const float* KVB = WSF(O_KVB); float* STF = WSF(O_STF); float* STB = WSF(O_STB);
    for (long i = GT_; i < (long)NB * 8 * 8192; i += GS_) {
        const int x = (int)(i % 8192), h = (int)((i / 8192) % 8), b = (int)(i / 65536);
        const float cd = expf(128.f * loggamma_(h)); float st = 0.f;
#pragma unroll 8
        for (int n = 0; n < NCH; ++n) { const size_t idx = (((size_t)b * NCH + n) * 8 + h) * 8192 + x; STF[idx] = st; st = cd * st + KVF[idx]; }
        st = 0.f;
#pragma unroll 8
        for (int n = NCH - 1; n >= 0; --n) { const size_t idx = (((size_t)b * NCH + n) * 8 + h) * 8192 + x; STB[idx] = st; st = cd * st + KVB[idx]; }
    }
}
__device__ __forceinline__ void ph_ret_out(const Ctx& c, float* ldsf) {
    const int* pos = (const int*)c.in[2]; const bf16_t* P = WSH(O_P); const float* STF = WSF(O_STF); const float* STB = WSF(O_STB); bf16_t* Y = WSH(O_YS);
    bf16_t* Qs = (bf16_t*)ldsf; bf16_t* Ks = Qs + 128 * 72; bf16_t* VT = Ks + 128 * 72; bf16_t* Ss = VT + 128 * 136; bf16_t* SF = Ss + 128 * 136; bf16_t* SB = SF + 128 * 72; float* tab = (float*)(SB + 128 * 72);
    const int tid = threadIdx.x, wv = tid >> 6, lane = tid & 63, fr = lane & 15, fq = lane >> 4;
    for (int u = blockIdx.x; u < (T / 128) * 8; u += gridDim.x) {
        const int h = u & 7; const long t0 = (long)(u >> 3) * 128;
        ret_tables(tab, h);
        SYNCTHREADS();
#pragma unroll 1
        for (int qh = 0; qh < 8; qh += 4) { float q1[4], q2[4], k1[4], k2[4], pj[4];
#pragma unroll
          for (int q = 0; q < 4; ++q) { const int id = tid + NT * (qh + q), j = id >> 5, dj = id & 31; const bf16_t* prow = P + (size_t)(t0 + j) * PW;
            q1[q] = bf2f(prow[C_RQ + h * 64 + dj]); q2[q] = bf2f(prow[C_RQ + h * 64 + dj + 32]); k1[q] = bf2f(prow[C_RK + h * 64 + dj]); k2[q] = bf2f(prow[C_RK + h * 64 + dj + 32]); pj[q] = (float)pos[t0 + j]; }
#pragma unroll
          for (int q = 0; q < 4; ++q) { const int id = tid + NT * (qh + q), j = id >> 5, dj = id & 31; const float ang = pj[q] * tab[dj]; const float cs = cosf(ang), sn = sinf(ang);
            Qs[j * 72 + dj] = (bf16_t)f2bf((q1[q] * cs - q2[q] * sn) * 0.125f); Qs[j * 72 + dj + 32] = (bf16_t)f2bf((q2[q] * cs + q1[q] * sn) * 0.125f); Ks[j * 72 + dj] = (bf16_t)f2bf(k1[q] * cs - k2[q] * sn); Ks[j * 72 + dj + 32] = (bf16_t)f2bf(k2[q] * cs + k1[q] * sn); } }
#pragma unroll
        for (int q = 0; q < 4; ++q) { const int id = tid + NT * q, j = id & 127, e8 = (id >> 7) * 8; const u32x4 raw = *(const u32x4*)(P + (size_t)(t0 + j) * PW + C_RV + h * 128 + e8);
#pragma unroll
            for (int e = 0; e < 4; ++e) { VT[(e8 + 2 * e) * 136 + j] = (bf16_t)(raw[e] & 0xffffu); VT[(e8 + 2 * e + 1) * 136 + j] = (bf16_t)(raw[e] >> 16); } }
        const size_t sbase = (((size_t)(u >> 3) * 8 + h)) * 8192;
#pragma unroll
        for (int q = 0; q < 4; ++q) { const int id = tid + NT * q, e = id >> 4, d4 = (id & 15) * 4; st_bf4(SF + e * 72 + d4, *(const f32x4*)(STF + sbase + (size_t)e * 64 + d4)); st_bf4(SB + e * 72 + d4, *(const f32x4*)(STB + sbase + (size_t)e * 64 + d4)); }
        SYNCTHREADS();
        const int i = wv * 16 + fr; const long t = t0 + i;
        {
            f32x4 sc[8];
#pragma unroll
            for (int nt = 0; nt < 8; ++nt) sc[nt] = (f32x4){0.f, 0.f, 0.f, 0.f};
            wave_mma<2, 8>(sc, Qs + wv * 16 * 72, 72, Ks, 72);
#pragma unroll
            for (int nt = 0; nt < 8; ++nt) { const int j0 = 16 * nt + 4 * fq; f32x4 sv;
#pragma unroll
                for (int e = 0; e < 4; ++e) { const int j = j0 + e, dist = i > j ? i - j : j - i; sv[e] = sc[nt][e] * tab[64 + dist]; }
                st_bf4(Ss + i * 136 + j0, sv); }
        }
#ifdef CPU_EMU
        SYNCTHREADS();
#else
        asm volatile("s_waitcnt lgkmcnt(0)" ::: "memory");
#endif
        f32x4 ao[8], tm[8];
#pragma unroll
        for (int nt = 0; nt < 8; ++nt) { ao[nt] = (f32x4){0.f, 0.f, 0.f, 0.f}; tm[nt] = (f32x4){0.f, 0.f, 0.f, 0.f}; }
        wave_mma<4, 8>(ao, Ss + wv * 16 * 136, 136, VT, 136);
        wave_mma<2, 8>(tm, Qs + wv * 16 * 72, 72, SF, 72);
        { const float qf = tab[64 + i + 1];
#pragma unroll
            for (int nt = 0; nt < 8; ++nt) { ao[nt] += tm[nt] * qf; tm[nt] = (f32x4){0.f, 0.f, 0.f, 0.f}; } }
        wave_mma<2, 8>(tm, Qs + wv * 16 * 72, 72, SB, 72);
        { const float qb = tab[64 + 128 - i];
#pragma unroll
            for (int nt = 0; nt < 8; ++nt) ao[nt] += tm[nt] * qb; }
        float sm = 0.f;
#pragma unroll
        for (int nt = 0; nt < 8; ++nt) sm += (ao[nt][0] + ao[nt][1]) + (ao[nt][2] + ao[nt][3]);
        sm += SHFL_XOR(sm, 16); sm += SHFL_XOR(sm, 32);
        const float mu = sm * (1.f / 128.f); float sq = 0.f;
#pragma unroll
        for (int nt = 0; nt < 8; ++nt) { ao[nt] -= mu; sq += (ao[nt][0] * ao[nt][0] + ao[nt][1] * ao[nt][1]) + (ao[nt][2] * ao[nt][2] + ao[nt][3] * ao[nt][3]); }
        sq += SHFL_XOR(sq, 16); sq += SHFL_XOR(sq, 32);
        const float rs = 1.f / sqrtf(sq * (1.f / 128.f) + EPS);
#pragma unroll
        for (int nt = 0; nt < 8; ++nt) { const int e0 = 16 * nt + 4 * fq; f32x4 gv = ld_bf4(P + (size_t)t * PW + C_RG + h * 128 + e0);
#pragma unroll
            for (int e = 0; e < 4; ++e) gv[e] = siluf_(gv[e]) * (ao[nt][e] * rs);
            st_bf4(Y + (size_t)t * 4 * W + 1 * W + h * 128 + e0, gv); }
        SYNCTHREADS();
    }
}
__device__ __forceinline__ void ph_sgu_norm(const Ctx& c, int l) {
    const bf16_t* P = WSH(O_P); float* ST = WSF(O_VN);
    const int lane = threadIdx.x & 63, gw = blockIdx.x * (NT / 64) + (threadIdx.x >> 6), ngw = gridDim.x * (NT / 64);
    for (int t = gw; t < T; t += ngw) {
        f32x4 v[4]; float sm = 0.f;
#pragma unroll
        for (int j = 0; j < 4; ++j) { v[j] = ld_bf4(P + (size_t)t * PW + C_SV + (j * 64 + lane) * 4);
#pragma unroll
            for (int q = 0; q < 4; ++q) { v[j][q] = geluf_(v[j][q]); sm += v[j][q]; } }
        const float mu = wave_sum(sm) * (1.f / W); float sq = 0.f;
#pragma unroll
        for (int j = 0; j < 4; ++j)
#pragma unroll
            for (int q = 0; q < 4; ++q) { const float dd = v[j][q] - mu; sq += dd * dd; }
        const float rs = 1.f / sqrtf(wave_sum(sq) * (1.f / W) + EPS);
        if (lane == 0) { ST[(size_t)t * 2] = mu; ST[(size_t)t * 2 + 1] = rs; }
    }
}
__device__ __forceinline__ void ph_sgu_mix(const Ctx& c, int l, float* ldsf) {
    const bf16_t* P = WSH(O_P); const float* ST = WSF(O_VN); bf16_t* Y = WSH(O_YS); const float* ng = c.in[15] + (size_t)l * W;
    bf16_t* As = (bf16_t*)ldsf; bf16_t* Bs = As + 128 * 136; const int tid = threadIdx.x, wv = tid >> 6, lane = tid & 63, fr = lane & 15, fq = lane >> 4;
    for (int u = blockIdx.x; u < (T / 128) * 8; u += gridDim.x) {
        const int g = u & 7; const long t0 = (long)(u >> 3) * 128;
        const float* ws = c.in[16] + ((size_t)l * 8 + g) * 128 * 128; const float* bs = c.in[17] + ((size_t)l * 8 + g) * 128;
#pragma unroll
        for (int q = 0; q < 8; ++q) { const int id = tid + NT * q, i = id >> 5, j4 = (id & 31) * 4; st_bf4(As + i * 136 + j4, *(const f32x4*)(ws + i * 128 + j4)); }
#pragma unroll
        for (int q = 0; q < 4; ++q) { const int id = tid + NT * q, j = id & 127, d8 = (id >> 7) * 8; const float mu = ST[(size_t)(t0 + j) * 2], rs = ST[(size_t)(t0 + j) * 2 + 1];
            const u32x4 raw = *(const u32x4*)(P + (size_t)(t0 + j) * PW + C_SV + g * 128 + d8);
#pragma unroll
            for (int e = 0; e < 4; ++e) { const float v0 = (geluf_(bflo(raw[e])) - mu) * rs * ng[g * 128 + d8 + 2 * e], v1 = (geluf_(bfhi(raw[e])) - mu) * rs * ng[g * 128 + d8 + 2 * e + 1];
                Bs[(d8 + 2 * e) * 136 + j] = (bf16_t)f2bf(v0); Bs[(d8 + 2 * e + 1) * 136 + j] = (bf16_t)f2bf(v1); } }
        SYNCTHREADS();
        f32x4 acc[8];
#pragma unroll
        for (int nt = 0; nt < 8; ++nt) acc[nt] = (f32x4){0.f, 0.f, 0.f, 0.f};
        wave_mma<4, 8>(acc, As + wv * 16 * 136, 136, Bs, 136);
        const int i = wv * 16 + fr; const long t = t0 + i; const float bsi = bs[i];
#pragma unroll
        for (int nt = 0; nt < 8; ++nt) { const int d = 16 * nt + 4 * fq; f32x4 uu = ld_bf4(P + (size_t)t * PW + C_SU + g * 128 + d);
#pragma unroll
            for (int e = 0; e < 4; ++e) uu[e] = geluf_(uu[e]) * (acc[nt][e] + bsi);
            st_bf4(Y + (size_t)t * 4 * W + 2 * W + g * 128 + d, uu); }
        SYNCTHREADS();
    }
}
__device__ __forceinline__ f32x4 rw_shift4(const bf16_t* P, const float* mup, const float* mun, long t, int sI, int j) {
    const f32x4 f = ld_bf4(P + (size_t)t * PW + C_RW + j); const f32x4 z4 = (f32x4){0.f, 0.f, 0.f, 0.f};
    const f32x4 pv = sI > 0 ? ld_bf4(P + (size_t)(t - 1) * PW + C_RW + j) : z4, nv = sI < S - 1 ? ld_bf4(P + (size_t)(t + 1) * PW + C_RW + j) : z4;
    return f + *(const f32x4*)(mup + j) * (pv - f) + *(const f32x4*)(mun + j) * (nv - f);
}
__device__ __forceinline__ float rw_shift1(const bf16_t* P, float mp, float mn, long t, int sI, int j) {
    const float f = PF(P, t, C_RW + j), pv = sI > 0 ? PF(P, t - 1, C_RW + j) : 0.f, nv = sI < S - 1 ? PF(P, t + 1, C_RW + j) : 0.f;
    return f + mp * (pv - f) + mn * (nv - f);
}
__device__ __forceinline__ void ph_rw_shift(const Ctx& c, int l) {
    const bf16_t* P = WSH(O_P); const float* mup = c.in[18] + (size_t)l * RF; const float* mun = c.in[19] + (size_t)l * RF; float* FS = WSF(O_FS);
    for (long i = GT_; i < (long)T * RF; i += GS_) {
        const int j = (int)(i % RF); const long t = i / RF; const int s = (int)(t % S);
        const float f = PF(P, t, C_RW + j), pv = s > 0 ? PF(P, t - 1, C_RW + j) : 0.f, nv = s < S - 1 ? PF(P, t + 1, C_RW + j) : 0.f;
        float v = f + mup[j] * (pv - f) + mun[j] * (nv - f);
        if (j >= 3072 && j < 3200) v = tanhf_(v); else if (j >= 3328) v = sigmoidf_(v);
        FS[i] = v;
    }
}
__device__ __forceinline__ void ph_rw_lora(const Ctx& c, int l, float* ldsf) {
    const bf16_t* P = WSH(O_P); const float* mup = c.in[18] + (size_t)l * RF; const float* mun = c.in[19] + (size_t)l * RF; const float* w0 = c.in[20] + (size_t)l * 2 * W; const float* a0 = c.in[22] + (size_t)l * 2 * W;
    const bf16_t* WUT = WSH(O_WUT); const bf16_t* WAT = WSH(O_WAT); const bf16_t* WGT = WSH(O_WGT);
    float* DEC = WSF(O_DEC); float* AA = WSF(O_AA); float* GG = WSF(O_GG);
    bf16_t* F = (bf16_t*)ldsf; bf16_t* B1 = F + 128 * 136; bf16_t* B2 = B1 + 128 * 136; const int tid = threadIdx.x, wv = tid >> 6, lane = tid & 63, fr = lane & 15, fq = lane >> 4;
    for (int u = blockIdx.x; u < (T / 128) * 8; u += gridDim.x) {
        const int wc0 = (u & 7) * 128; const long t0 = (long)(u >> 3) * 128;
        for (int rd = 0; rd < 3; ++rd) {
#pragma unroll
            for (int q = 0; q < 8; ++q) { const int id = tid + NT * q, r = id >> 5, c4 = (id & 31) * 4;
                const int col = rd < 2 ? (c4 < 64 ? 3072 + rd * 64 + c4 : 3200 + rd * 64 + (c4 - 64)) : 3328 + c4;
                f32x4 fv = rw_shift4(P, mup, mun, t0 + r, (int)((t0 + r) % S), col);
#pragma unroll
                for (int e = 0; e < 4; ++e) fv[e] = rd == 2 ? sigmoidf_(fv[e]) : (c4 < 64 ? tanhf_(fv[e]) : fv[e]);
                st_bf4(F + r * 136 + c4, fv); }
            if (rd < 2) {
#pragma unroll
                for (int q = 0; q < 2; ++q) { const int id = tid + NT * q, w = id >> 3, r8 = (id & 7) * 8;
                    *(u32x4*)(B1 + w * 72 + r8) = *(const u32x4*)(WUT + ((size_t)rd * W + wc0 + w) * 64 + r8); *(u32x4*)(B2 + w * 72 + r8) = *(const u32x4*)(WAT + ((size_t)rd * W + wc0 + w) * 64 + r8); }
            } else {
#pragma unroll
                for (int q = 0; q < 4; ++q) { const int id = tid + NT * q, w = id >> 4, r8 = (id & 15) * 8; *(u32x4*)(B1 + w * 136 + r8) = *(const u32x4*)(WGT + ((size_t)wc0 + w) * 128 + r8); }
            }
            SYNCTHREADS();
            f32x4 a1[8], a2[8];
#pragma unroll
            for (int nt = 0; nt < 8; ++nt) { a1[nt] = (f32x4){0.f, 0.f, 0.f, 0.f}; a2[nt] = (f32x4){0.f, 0.f, 0.f, 0.f}; }
            const long t = t0 + wv * 16 + fr;
            if (rd < 2) {
                wave_mma<2, 8>(a1, F + wv * 16 * 136, 136, B1, 72);
                wave_mma<2, 8>(a2, F + wv * 16 * 136 + 64, 136, B2, 72);
#pragma unroll
                for (int nt = 0; nt < 8; ++nt) { const int ch = wc0 + 16 * nt + 4 * fq; const f32x4 w0v = *(const f32x4*)(w0 + rd * W + ch), a0v = *(const f32x4*)(a0 + rd * W + ch); f32x4 dv, av;
#pragma unroll
                    for (int e = 0; e < 4; ++e) { dv[e] = fexp_(-DECAY_SCALE * sigmoidf_(a1[nt][e] + w0v[e])); av[e] = sigmoidf_(a2[nt][e] + a0v[e]); }
                    *(f32x4*)(DEC + ((size_t)rd * T + t) * W + ch) = dv; *(f32x4*)(AA + ((size_t)rd * T + t) * W + ch) = av; }
            } else {
                wave_mma<4, 8>(a1, F + wv * 16 * 136, 136, B1, 136);
#pragma unroll
                for (int nt = 0; nt < 8; ++nt) *(f32x4*)(GG + (size_t)t * W + wc0 + 16 * nt + 4 * fq) = a1[nt];
            }
            SYNCTHREADS();
        }
    }
}
#ifdef CPU_EMU
__device__ __forceinline__ float red16_(float x) { x += SHFL_XOR(x, 1); x += SHFL_XOR(x, 2); x += SHFL_XOR(x, 4); x += SHFL_XOR(x, 8); return x; }
#define LDS_BARRIER() emu_syncthreads()
#else
__device__ __forceinline__ float red16_(float x) {
    x += __builtin_bit_cast(float, __builtin_amdgcn_update_dpp(0, __builtin_bit_cast(int, x), 0xB1, 0xF, 0xF, true));
    x += __builtin_bit_cast(float, __builtin_amdgcn_update_dpp(0, __builtin_bit_cast(int, x), 0x4E, 0xF, 0xF, true));
    x += __builtin_bit_cast(float, __builtin_amdgcn_update_dpp(0, __builtin_bit_cast(int, x), 0x141, 0xF, 0xF, true));
    x += __builtin_bit_cast(float, __builtin_amdgcn_update_dpp(0, __builtin_bit_cast(int, x), 0x140, 0xF, 0xF, true));
    return x;
}
#define LDS_BARRIER() do { asm volatile("s_waitcnt lgkmcnt(0)" ::: "memory"); __builtin_amdgcn_s_barrier(); asm volatile("" ::: "memory"); } while (0)
#endif
#define RC_M(k) (lm + (k) * 4608)
__device__ __forceinline__ void ph_rw_chunk(const Ctx& c, int l, float* ldsf) {
    const bf16_t* P = WSH(O_P); const float* mup = c.in[18] + (size_t)l * RF; const float* mun = c.in[19] + (size_t)l * RF; const float* DEC = WSF(O_DEC); const float* AA = WSF(O_AA); float* BON = WSF(O_BON);
    const float* kkw = c.in[25] + (size_t)l * W; const float* kaw = c.in[26] + (size_t)l * W; const float* rk = c.in[27] + (size_t)l * W;
    bf16_t* PST = WSH(O_PST); bf16_t* PYT = WSH(O_PYT); float* SVB = WSF(O_SVB); float* YVB = WSF(O_YVB);
    bf16_t* lm = (bf16_t*)ldsf; float* gam = (float*)RC_M(7); float* segp = (float*)RC_M(13); float* gl = segp + 512;
    const int tid = threadIdx.x, wv = tid >> 6, lane = tid & 63, fr = lane & 15, fq = lane >> 4, rt = wv & 3, hf = wv >> 2;
    const int m0 = 16 * rt + fr;
    for (int u = blockIdx.x; u < 64 * NRC; u += gridDim.x) {
        const int chain = u / NRC, ck = u % NRC, h = chain & 15, b = (chain >> 4) & 1, z = chain >> 5;
        const long tb = (long)b * S + (z ? S - 1 - ck * RCK : ck * RCK); const int dirn = z ? -1 : 1;
        const float* decp = DEC + ((size_t)z * T) * W + h * 64; const float* aap = AA + ((size_t)z * T) * W + h * 64;
        { const int k = tid & 63, sg = tid >> 6; float p = 1.f; float wv8[8];
#pragma unroll
          for (int q = 0; q < 8; ++q) wv8[q] = decp[(size_t)(tb + dirn * (sg * 8 + q)) * W + k];
#pragma unroll
          for (int q = 0; q < 8; ++q) { p *= wv8[q]; gam[(sg * 8 + q) * 64 + k] = p; }
          segp[sg * 64 + k] = p; }
        SYNCTHREADS();
        { const int k = tid & 63, sg = tid >> 6; float pre = 1.f;
          for (int q = 0; q < sg; ++q) pre *= segp[q * 64 + k];
#pragma unroll
          for (int q = 0; q < 8; ++q) gam[(sg * 8 + q) * 64 + k] *= pre;
          if (sg == 7) gl[k] = gam[63 * 64 + k]; }
        SYNCTHREADS();
        { const int k = lane, ch = h * 64 + k; const float kkwv = kkw[ch], kav = kaw[ch], rkv = rk[ch];
          float kv8[8], rv8[8], vv8[8], aa8[8];
          const float mpr = mup[ch], mnr = mun[ch], mpk = mup[1024 + ch], mnk = mun[1024 + ch], mpv = mup[2048 + ch], mnv = mun[2048 + ch];
#pragma unroll
          for (int q = 0; q < 8; ++q) { const long t = tb + dirn * (wv + 8 * q); const int sI = (int)(t % S); kv8[q] = rw_shift1(P, mpk, mnk, t, sI, 1024 + ch); rv8[q] = rw_shift1(P, mpr, mnr, t, sI, ch); vv8[q] = rw_shift1(P, mpv, mnv, t, sI, 2048 + ch); aa8[q] = aap[(size_t)t * W + k]; }
#pragma unroll
          for (int q = 0; q < 8; ++q) { const int tt = wv + 8 * q; const long t = tb + dirn * tt;
            const float vk = kv8[q] * kkwv; const float kkn = vk * (1.f / sqrtf(wave_sum(vk * vk) + EPS)); const float ktv = kv8[q] * (1.f + (aa8[q] - 1.f) * kav);
            const float bsum = wave_sum(rv8[q] * rkv * ktv); if (lane == 0) BON[((size_t)z * T + t) * 16 + h] = bsum;
            const float g = gam[tt * 64 + k], gp = tt ? gam[(tt - 1) * 64 + k] : 1.f, ig = 1.f / g;
            const bf16_t khv = (bf16_t)f2bf(kkn * gp), bhv = (bf16_t)f2bf(aa8[q] * kkn * ig);
            RC_M(0)[tt * 72 + k] = khv; RC_M(1)[k * 72 + tt] = khv; RC_M(2)[tt * 72 + k] = bhv; RC_M(3)[k * 72 + tt] = bhv;
            RC_M(4)[tt * 72 + k] = (bf16_t)f2bf(ktv * ig); RC_M(5)[tt * 72 + k] = (bf16_t)f2bf(rv8[q] * g); RC_M(6)[k * 72 + tt] = (bf16_t)f2bf(vv8[q]); } }
        SYNCTHREADS();
        f32x4 mkr[2], khr[2], rhT[2];
        {
            f32x4 a0[2], a1[2], a2[2], a3[2];
#pragma unroll
            for (int nt = 0; nt < 2; ++nt) { a0[nt] = (f32x4){0.f, 0.f, 0.f, 0.f}; a1[nt] = a0[nt]; a2[nt] = a0[nt]; a3[nt] = a0[nt]; }
            wave_mma<2, 2>(a0, RC_M(2) + rt * 16 * 72, 72, RC_M(0) + hf * 32 * 72, 72);
            wave_mma<2, 2>(a1, RC_M(4) + rt * 16 * 72, 72, RC_M(0) + hf * 32 * 72, 72);
            wave_mma<2, 2>(a2, RC_M(2) + rt * 16 * 72, 72, RC_M(5) + hf * 32 * 72, 72);
            wave_mma<2, 2>(a3, RC_M(4) + rt * 16 * 72, 72, RC_M(5) + hf * 32 * 72, 72);
#pragma unroll
            for (int nt = 0; nt < 2; ++nt) { const int n0 = 32 * hf + 16 * nt + 4 * fq; f32x4 nn, ti, mk;
#pragma unroll
                for (int r = 0; r < 4; ++r) { const int n = n0 + r; const bool lt = m0 < n, le = m0 <= n;
                    nn[r] = lt ? -a0[nt][r] : 0.f; ti[r] = nn[r] + (m0 == n ? 1.f : 0.f); mk[r] = lt ? a1[nt][r] : 0.f; mkr[nt][r] = le ? a3[nt][r] : 0.f;
                    RC_M(12)[n * 72 + m0] = (bf16_t)f2bf(le ? a2[nt][r] : 0.f);
                    RC_M(8)[n * 72 + m0] = (bf16_t)f2bf(nn[r]);
                    khr[nt][r] = bf2f(RC_M(4)[m0 * 72 + n]); rhT[nt][r] = bf2f(RC_M(5)[n * 72 + m0]); }
                st_bf4(RC_M(7) + m0 * 72 + n0, nn); st_bf4(RC_M(9) + m0 * 72 + n0, ti); st_bf4(RC_M(11) + m0 * 72 + n0, mk); }
        }
        SYNCTHREADS();
        f32x4 tiv[2];
#pragma unroll
        for (int nt = 0; nt < 2; ++nt) tiv[nt] = ld_bf4(RC_M(9) + m0 * 72 + 32 * hf + 16 * nt + 4 * fq);
#pragma unroll 1
        for (int it = 0; it < 5; ++it) {
            bf16_t* pw = (it & 1) ? RC_M(0) : RC_M(7); bf16_t* pwT = (it & 1) ? RC_M(2) : RC_M(8); bf16_t* pw2 = (it & 1) ? RC_M(7) : RC_M(0); bf16_t* pw2T = (it & 1) ? RC_M(8) : RC_M(2);
            bf16_t* tcur = (it & 1) ? RC_M(4) : RC_M(9); bf16_t* tnxt = (it & 1) ? RC_M(9) : RC_M(4);
            f32x4 sq[2];
#pragma unroll
            for (int nt = 0; nt < 2; ++nt) sq[nt] = (f32x4){0.f, 0.f, 0.f, 0.f};
            wave_mma<2, 2>(sq, pw + rt * 16 * 72, 72, pwT + hf * 32 * 72, 72);
#pragma unroll
            for (int nt = 0; nt < 2; ++nt) { const int n0 = 32 * hf + 16 * nt + 4 * fq; st_bf4(pw2 + m0 * 72 + n0, sq[nt]);
#pragma unroll
                for (int r = 0; r < 4; ++r) pw2T[(n0 + r) * 72 + m0] = (bf16_t)f2bf(sq[nt][r]); }
            SYNCTHREADS();
            f32x4 up[2];
#pragma unroll
            for (int nt = 0; nt < 2; ++nt) up[nt] = (f32x4){0.f, 0.f, 0.f, 0.f};
            wave_mma<2, 2>(up, tcur + rt * 16 * 72, 72, pw2T + hf * 32 * 72, 72);
#pragma unroll
            for (int nt = 0; nt < 2; ++nt) { const int n0 = 32 * hf + 16 * nt + 4 * fq; tiv[nt] += up[nt]; st_bf4(tnxt + m0 * 72 + n0, tiv[nt]);
                if (it == 4) {
#pragma unroll
                    for (int r = 0; r < 4; ++r) RC_M(10)[(n0 + r) * 72 + m0] = (bf16_t)f2bf(tiv[nt][r]); } }
            SYNCTHREADS();
        }
        {
            f32x4 w1[2], w2[2];
#pragma unroll
            for (int nt = 0; nt < 2; ++nt) { w1[nt] = (f32x4){0.f, 0.f, 0.f, 0.f}; w2[nt] = w1[nt]; }
            wave_mma<2, 2>(w1, RC_M(1) + rt * 16 * 72, 72, RC_M(10) + hf * 32 * 72, 72);
            wave_mma<2, 2>(w2, RC_M(11) + rt * 16 * 72, 72, RC_M(10) + hf * 32 * 72, 72);
#pragma unroll
            for (int nt = 0; nt < 2; ++nt) { const int n0 = 32 * hf + 16 * nt + 4 * fq; st_bf4(RC_M(7) + m0 * 72 + n0, w1[nt]); st_bf4(RC_M(8) + m0 * 72 + n0, w2[nt]); }
        }
        SYNCTHREADS();
        {
            f32x4 py[2], qy[2], ps[2], qs[2];
#pragma unroll
            for (int nt = 0; nt < 2; ++nt) { py[nt] = (f32x4){0.f, 0.f, 0.f, 0.f}; qy[nt] = py[nt]; ps[nt] = py[nt]; qs[nt] = py[nt]; }
            wave_mma<2, 2>(py, RC_M(7) + rt * 16 * 72, 72, RC_M(12) + hf * 32 * 72, 72);
            wave_mma<2, 2>(qy, RC_M(8) + rt * 16 * 72, 72, RC_M(12) + hf * 32 * 72, 72);
            wave_mma<2, 2>(ps, RC_M(7) + rt * 16 * 72, 72, RC_M(3) + hf * 32 * 72, 72);
            wave_mma<2, 2>(qs, RC_M(8) + rt * 16 * 72, 72, RC_M(3) + hf * 32 * 72, 72);
#pragma unroll
            for (int nt = 0; nt < 2; ++nt) { const int n0 = 32 * hf + 16 * nt + 4 * fq;
#pragma unroll
                for (int r = 0; r < 4; ++r) { const int n = n0 + r; const float gln = gl[n];
                    RC_M(0)[n * 72 + m0] = (bf16_t)f2bf(rhT[nt][r] - py[nt][r]); RC_M(2)[n * 72 + m0] = (bf16_t)f2bf(mkr[nt][r] - qy[nt][r]);
                    RC_M(4)[n * 72 + m0] = (bf16_t)f2bf(((m0 == n ? 1.f : 0.f) - ps[nt][r]) * gln); RC_M(5)[n * 72 + m0] = (bf16_t)f2bf((khr[nt][r] - qs[nt][r]) * gln); } }
        }
        SYNCTHREADS();
        {
            f32x4 yv[2], sv[2];
#pragma unroll
            for (int nt = 0; nt < 2; ++nt) { yv[nt] = (f32x4){0.f, 0.f, 0.f, 0.f}; sv[nt] = yv[nt]; }
            wave_mma<2, 2>(yv, RC_M(6) + rt * 16 * 72, 72, RC_M(2) + hf * 32 * 72, 72);
            wave_mma<2, 2>(sv, RC_M(6) + rt * 16 * 72, 72, RC_M(5) + hf * 32 * 72, 72);
#pragma unroll
            for (int nt = 0; nt < 2; ++nt) { const int n0 = 32 * hf + 16 * nt + 4 * fq; *(f32x4*)(YVB + (size_t)u * 4096 + m0 * 64 + n0) = yv[nt]; *(f32x4*)(SVB + (size_t)u * 4096 + m0 * 64 + n0) = sv[nt]; }
            { const int rr = tid >> 3, c8 = (tid & 7) * 8; *(u32x4*)(PYT + (size_t)u * 4096 + rr * 64 + c8) = *(const u32x4*)(RC_M(0) + rr * 72 + c8); *(u32x4*)(PST + (size_t)u * 4096 + rr * 64 + c8) = *(const u32x4*)(RC_M(4) + rr * 72 + c8); }
        }
        SYNCTHREADS();
    }
}
#undef RC_M
__device__ __forceinline__ void ph_rw_seq(const Ctx& c, float* ldsf) {
    const bf16_t* PST = WSH(O_PST); const bf16_t* PYT = WSH(O_PYT); const float* SVB = WSF(O_SVB); const float* YVB = WSF(O_YVB); float* YY = WSF(O_YY);
    bf16_t* Sb = (bf16_t*)ldsf;
    bf16_t* Pm = Sb + 2 * 16 * 72;
    const int tid = threadIdx.x, wv = tid >> 6, lane = tid & 63, fr = lane & 15, fq = lane >> 4, isY = wv >> 2, nt0 = wv & 3;
    for (int u = blockIdx.x; u < 256; u += gridDim.x) {
        const int x = u & 7, jq = u >> 3, chain = x * 8 + (jq >> 2), qt = jq & 3, h = chain & 15, b = (chain >> 4) & 1, z = chain >> 5;
        const size_t ub = (size_t)chain * NRC;
        const int rr = tid >> 3, c8 = (tid & 7) * 8;
        constexpr int PD = NRC >= 8 ? 8 : 4;
        for (int i = tid; i < 2 * 16 * 72 / 2; i += NT) ((unsigned*)Sb)[i] = 0u;
        const int row = 16 * qt + fr, n0 = 16 * nt0 + 4 * fq; const float* addp = (isY ? YVB : SVB) + ub * 4096 + row * 64 + n0;
        const bf16_t* psp = PST + ub * 4096 + rr * 64 + c8; const bf16_t* pyp = PYT + ub * 4096 + rr * 64 + c8;
        u32x4 gps[PD], gpy[PD]; f32x4 add[PD];
#pragma unroll
        for (int j = 0; j < PD; ++j) { gps[j] = *(const u32x4*)(psp + (size_t)j * 4096); gpy[j] = *(const u32x4*)(pyp + (size_t)j * 4096); add[j] = *(const f32x4*)(addp + (size_t)j * 4096); }
        *(u32x4*)(Pm + (0 * 2 + 0) * 4608 + rr * 72 + c8) = gps[0]; *(u32x4*)(Pm + (0 * 2 + 1) * 4608 + rr * 72 + c8) = gpy[0];
        if (PD < NRC) { gps[0] = *(const u32x4*)(psp + (size_t)PD * 4096); gpy[0] = *(const u32x4*)(pyp + (size_t)PD * 4096); }
        SYNCTHREADS();
        for (int ck0 = 0; ck0 < NRC; ck0 += PD) {
#pragma unroll
            for (int j = 0; j < PD; ++j) {
                const int ck = ck0 + j, cur = j & 1, nxt = cur ^ 1;
                f32x4 acc[1]; acc[0] = (f32x4){0.f, 0.f, 0.f, 0.f};
                wave_mma<2, 1>(acc, Sb + cur * 16 * 72, 72, Pm + (cur * 2 + isY) * 4608 + nt0 * 16 * 72, 72);
                acc[0] += add[j];
                if (ck + PD < NRC) add[j] = *(const f32x4*)(addp + (size_t)(ck + PD) * 4096);
                if (isY) {
#pragma unroll
                    for (int r = 0; r < 4; ++r) { const int step = ck * RCK + n0 + r, sidx = z ? S - 1 - step : step; YY[((size_t)z * T + (size_t)b * S + sidx) * W + h * 64 + row] = acc[0][r]; }
                } else st_bf4(Sb + nxt * 16 * 72 + fr * 72 + n0, acc[0]);
                const int jn = (j + 1) % PD;
                if (ck + 1 < NRC) { *(u32x4*)(Pm + (nxt * 2 + 0) * 4608 + rr * 72 + c8) = gps[jn]; *(u32x4*)(Pm + (nxt * 2 + 1) * 4608 + rr * 72 + c8) = gpy[jn]; }
                if (ck + 1 + PD < NRC) { gps[jn] = *(const u32x4*)(psp + (size_t)(ck + 1 + PD) * 4096); gpy[jn] = *(const u32x4*)(pyp + (size_t)(ck + 1 + PD) * 4096); }
                LDS_BARRIER();
            }
        }
    }
}
__device__ __forceinline__ void ph_rw_out(const Ctx& c, int l) {
    const bf16_t* P = WSH(O_P); const float* mup = c.in[18] + (size_t)l * RF; const float* mun = c.in[19] + (size_t)l * RF; const float* YY = WSF(O_YY); const float* BON = WSF(O_BON); const float* GG = WSF(O_GG); bf16_t* Y = WSH(O_YS);
    const int lane = threadIdx.x & 63, gw = blockIdx.x * (NT / 64) + (threadIdx.x >> 6), ngw = gridDim.x * (NT / 64);
    for (int i = gw; i < T * 16; i += ngw) {
        const int h = i & 15; const long t = i >> 4; const int ch = h * 64 + lane;
        const float y0 = YY[(size_t)t * W + ch], y1 = YY[((size_t)T + t) * W + ch];
        const float m0 = wave_sum(y0) * (1.f / 64.f), m1 = wave_sum(y1) * (1.f / 64.f); const float d0 = y0 - m0, d1 = y1 - m1;
        const float r0 = 1.f / sqrtf(wave_sum(d0 * d0) * (1.f / 64.f) + EPS), r1 = 1.f / sqrtf(wave_sum(d1 * d1) * (1.f / 64.f) + EPS);
        const float vv = rw_shift1(P, mup[2048 + ch], mun[2048 + ch], t, (int)(t % S), 2048 + ch); const float o = d0 * r0 + d1 * r1 + (BON[(size_t)t * 16 + h] + BON[((size_t)T + t) * 16 + h]) * vv;
        Y[(size_t)t * 4 * W + 3 * W + ch] = (bf16_t)f2bf(o * GG[(size_t)t * W + ch]);
    }
}
__device__ __forceinline__ void ph_router(const Ctx& c, int l, float* ldsf) {
    const float* H = WSF(O_HF); const bf16_t* WH = WSH(O_WRH); const bf16_t* WL = WSH(O_WRL); const float* bg = c.in[31] + (size_t)l * 4; const float* be = c.in[33] + (size_t)l * 32;
    int* EID = WSI(O_EID); float* EWT = WSF(O_EWT); int* cnt = CTLW(c) + CW_CNT + l * 64;
    const int tid = threadIdx.x, wv = tid >> 6, lane = tid & 63, fr = lane & 15, fq = lane >> 4, rt = wv & 1, kq = wv >> 1;
    float* part = ldsf;
    for (int u = blockIdx.x; u < T / 32; u += gridDim.x) {
        const long t0 = (long)u * 32; f32x4 acc[3];
#pragma unroll
        for (int nt = 0; nt < 3; ++nt) acc[nt] = (f32x4){0.f, 0.f, 0.f, 0.f};
#ifdef CPU_EMU
        for (int nt = 0; nt < 3; ++nt) for (int r = 0; r < 4; ++r) { const int n = 16 * nt + 4 * fq + r; float sacc = 0.f;
            for (int k = kq * 512; k < kq * 512 + 512; ++k) { const float hv = H[(size_t)(t0 + 16 * rt + fr) * D + k]; const float hh = bf2f((bf16_t)f2bf(hv)), hl = bf2f((bf16_t)f2bf(hv - hh));
                const float wh = bf2f(WH[(size_t)n * D + k]), wl = bf2f(WL[(size_t)n * D + k]); sacc += hh * wh + hl * wh + hh * wl; }
            acc[nt][r] = sacc; }
#else
        const float* hp = H + (size_t)(t0 + 16 * rt + fr) * D + kq * 512 + fq * 8;
#pragma unroll 4
        for (int ks = 0; ks < 16; ++ks) {
            const f32x4 h0 = *(const f32x4*)(hp + ks * 32), h1 = *(const f32x4*)(hp + ks * 32 + 4); bf16x8 ah, al;
#pragma unroll
            for (int e = 0; e < 4; ++e) { const unsigned b0 = f2bf(h0[e]), b1 = f2bf(h1[e]); ah[e] = (short)b0; ah[4 + e] = (short)b1; al[e] = (short)f2bf(h0[e] - u2f_(b0 << 16)); al[4 + e] = (short)f2bf(h1[e] - u2f_(b1 << 16)); }
#pragma unroll
            for (int nt = 0; nt < 3; ++nt) { const size_t wo = (size_t)(16 * nt + fr) * D + kq * 512 + ks * 32 + fq * 8; const bf16x8 bh = *(const bf16x8*)(WH + wo), bl = *(const bf16x8*)(WL + wo);
                acc[nt] = __builtin_amdgcn_mfma_f32_16x16x32_bf16(bh, ah, acc[nt], 0, 0, 0); acc[nt] = __builtin_amdgcn_mfma_f32_16x16x32_bf16(bh, al, acc[nt], 0, 0, 0); acc[nt] = __builtin_amdgcn_mfma_f32_16x16x32_bf16(bl, ah, acc[nt], 0, 0, 0); }
        }
#endif
#pragma unroll
        for (int nt = 0; nt < 3; ++nt) *(f32x4*)(part + (kq * 32 + 16 * rt + fr) * 48 + 16 * nt + 4 * fq) = acc[nt];
        SYNCTHREADS();
        if (tid < 32) { const long t = t0 + tid; float lg[36];
#pragma unroll
            for (int q = 0; q < 36; ++q) lg[q] = (part[(0 * 32 + tid) * 48 + q] + part[(1 * 32 + tid) * 48 + q]) + (part[(2 * 32 + tid) * 48 + q] + part[(3 * 32 + tid) * 48 + q]) + (q < 4 ? bg[q < 4 ? q : 0] : be[q >= 4 ? q - 4 : 0]);
            int gi = 0; float m = lg[0];
#pragma unroll
            for (int q = 1; q < 4; ++q) if (lg[q] > m) { m = lg[q]; gi = q; }
            float den = 0.f;
#pragma unroll
            for (int q = 0; q < 4; ++q) den += expf(lg[q] - m);
            const float gp = 1.f / den; float el[8];
#pragma unroll
            for (int q = 0; q < 8; ++q) el[q] = gi == 0 ? lg[4 + q] : gi == 1 ? lg[12 + q] : gi == 2 ? lg[20 + q] : lg[28 + q];
            int i1 = 0; float m1 = el[0];
#pragma unroll
            for (int q = 1; q < 8; ++q) if (el[q] > m1) { m1 = el[q]; i1 = q; }
            int i2 = -1; float m2 = 0.f;
#pragma unroll
            for (int q = 0; q < 8; ++q) if (q != i1 && (i2 < 0 || el[q] > m2)) { m2 = el[q]; i2 = q; }
            const float p2 = expf(m2 - m1);
            EID[t * 2] = gi * 8 + i1; EID[t * 2 + 1] = gi * 8 + i2; EWT[t * 2] = gp / (1.f + p2); EWT[t * 2 + 1] = gp * p2 / (1.f + p2);
            atomic_add_i(cnt + gi * 8 + i1, 1); atomic_add_i(cnt + gi * 8 + i2, 1);
        }
        SYNCTHREADS();
    }
}
__device__ __forceinline__ void ph_moe_plan(const Ctx& c, int l) {
    int* cnt = CTLW(c) + CW_CNT + l * 64; int* plan = CTLW(c) + CW_PLAN + l * 256;
    if (GT_ == 0) {
        int ps = 0, nb = 0;
        for (int e = 0; e < NE; ++e) { plan[e] = ps; const int nblk = (cnt[e] + 255) / 256; for (int q = 0; q < nblk; ++q) plan[64 + nb++] = e; ps += nblk * 256; }
        plan[32] = ps; plan[40] = nb;
    }
}
__device__ __forceinline__ void ph_moe_assign(const Ctx& c, int l) {
    const int* EID = WSI(O_EID); int* fill = CTLW(c) + CW_FILL + l * 64; const int* plan = CTLW(c) + CW_PLAN + l * 256; int* DEST = WSI(O_DEST);
    for (long i = GT_; i < (long)T * 2; i += GS_) { const int e = EID[i]; const int pos = atomic_add_i(fill + e, 1); DEST[i] = plan[e] + pos; }
}
__device__ __forceinline__ void ph_moe_gather(const Ctx& c) {
    const int* DEST = WSI(O_DEST); const u32x4* H = (const u32x4*)WSH(O_H); u32x4* XS = (u32x4*)WSH(O_XS);
    for (long i = GT_; i < (long)T * 2 * (D / 8); i += GS_) { const int q = (int)(i % (D / 8)); const long a = i / (D / 8); XS[(size_t)DEST[a] * (D / 8) + q] = H[(size_t)(a >> 1) * (D / 8) + q]; }
}
#ifndef CPU_EMU
#define XB_TMO      128
#define XB_XCNT(j)  (256  + 64 * (j))
#define XB_XSUB(j)  (1280 + 64 * (j))
#define XB_XGEN(j)  (2304 + 64 * (j))
#define XB_TOP      3328
#define XB_TOPGEN   3392
#define XCD_BAR_WORDS 3456
#define XB_SPIN_CAP (1u << 26)
#define LAS __attribute__((address_space(3)))
__device__ __forceinline__ unsigned xb_ld(unsigned* p)              { return __hip_atomic_load(p, __ATOMIC_RELAXED, __HIP_MEMORY_SCOPE_AGENT); }
__device__ __forceinline__ unsigned xb_add(unsigned* p, unsigned v) { return __hip_atomic_fetch_add(p, v, __ATOMIC_RELAXED, __HIP_MEMORY_SCOPE_AGENT); }
__device__ __forceinline__ unsigned xb_xcc_id() { return (unsigned)__builtin_amdgcn_s_getreg((3 << 11) | 20) & 0xFu; }
#define XB_SPIN(cond, bar) do { unsigned _sp = 0; while (cond) { __builtin_amdgcn_s_sleep(1); \
    if ((++_sp & 255u) == 0u) { if (xb_ld(&(bar)[XB_TMO])) break; if (_sp > XB_SPIN_CAP) { atomicAdd(&(bar)[XB_TMO], 1u); break; } } } } while (0)
struct XcdBarrier { unsigned* bar; unsigned x; volatile LAS unsigned* st; };
__device__ __forceinline__ XcdBarrier xcd_barrier_post(unsigned* bar, volatile LAS unsigned* st) {
    XcdBarrier b; b.bar = bar; b.x = xb_xcc_id(); b.st = st;
    if (threadIdx.x == 0) (void)xb_add(&bar[XB_XCNT(b.x)], 1u);
    return b;
}
__device__ __forceinline__ void xcd_barrier_complete(unsigned* bar, unsigned x, unsigned& nloc, unsigned& nx) {
    const unsigned G = gridDim.x * gridDim.y * gridDim.z;
    unsigned sum, cnt, mine, sp = 0u;
    for (;;) {
        sum = 0u; cnt = 0u; mine = 0u;
#pragma unroll
        for (unsigned j = 0; j < 16; ++j) { const unsigned cc = xb_ld(&bar[XB_XCNT(j)]); sum += cc; cnt += (cc > 0u) ? 1u : 0u; mine = (j == x) ? cc : mine; }
        if (sum == G) break;
        __builtin_amdgcn_s_sleep(1);
        if ((++sp & 255u) == 0u) { if (xb_ld(&bar[XB_TMO])) break; if (sp > XB_SPIN_CAP) { atomicAdd(&bar[XB_TMO], 1u); break; } }
    }
    nloc = mine > 0u ? mine : 1u; nx = cnt > 0u ? cnt : 1u;
}
__device__ __forceinline__ void xcd_barrier(const XcdBarrier& b) {
    asm volatile("s_waitcnt vmcnt(0)" ::: "memory");
    __syncthreads();
    if (threadIdx.x == 0) {
        unsigned* bar = b.bar;
        __builtin_amdgcn_s_waitcnt(0);
        unsigned nloc = b.st[0], nx = b.st[1];
        if (nloc == 0u) { xcd_barrier_complete(bar, b.x, nloc, nx); b.st[0] = nloc; b.st[1] = nx; }
        const unsigned old = xb_add(&bar[XB_XSUB(b.x)], 1u);
        const unsigned gen = old / nloc;
        if (old + 1u == (gen + 1u) * nloc) {
            __builtin_amdgcn_fence(__ATOMIC_RELEASE, "agent");
            asm volatile("s_waitcnt vmcnt(0)" ::: "memory");
            const unsigned og = xb_add(&bar[XB_TOP], 1u);
            const unsigned tg = og / nx;
            if (og + 1u == (tg + 1u) * nx) xb_add(&bar[XB_TOPGEN], 1u);
            else XB_SPIN(xb_ld(&bar[XB_TOPGEN]) == tg, bar);
            __builtin_amdgcn_fence(__ATOMIC_ACQUIRE, "agent");
            xb_add(&bar[XB_XGEN(b.x)], 1u);
            asm volatile("s_waitcnt vmcnt(0)" ::: "memory");
        } else {
            XB_SPIN(xb_ld(&bar[XB_XGEN(b.x)]) == gen, bar);
            __builtin_amdgcn_fence(__ATOMIC_ACQUIRE, "agent");
            asm volatile("s_waitcnt vmcnt(0)" ::: "memory");
        }
    }
    __syncthreads();
}
#endif

constexpr int LDS_BYTES = 147456;

__global__ void __launch_bounds__(NT, 2) fwd(Params p) {
#ifdef CPU_EMU
    unsigned char* lds = g_lds; float* ldsf = (float*)g_lds;
#else
    extern __shared__ __attribute__((aligned(16))) unsigned char lds[];
    float* ldsf = (float*)lds;
    volatile LAS unsigned* misc = (volatile LAS unsigned*)((LAS unsigned char*)lds + LDS_BYTES - 64);
    if (threadIdx.x == 0) { misc[0] = 0u; misc[1] = 0u; }
    __syncthreads();
    XcdBarrier bar = xcd_barrier_post((unsigned*)(p.ws + O_CTL) + CW_BAR, misc);
#endif
    Ctx c; c.in = p.in; c.out = p.out; c.ws = p.ws;
    const int lo = p.ph_lo, hi = p.ph_hi; int ph = 0;
    const int G = (int)gridDim.x, cwg = (int)blockIdx.x;
#ifdef CPU_EMU
#define GRID_BAR()
#else
#define GRID_BAR() xcd_barrier(bar)
#endif
#ifndef REPEAT_MASK
#define REPEAT_MASK 0
#endif
#ifndef TIME_PHASE
#define TIME_PHASE -1
#endif
#if TIME_PHASE >= 0 && !defined(CPU_EMU)
    unsigned long long tp0 = 0, tp1 = 0;
#define TP_BEGIN() do { if (ph == TIME_PHASE) tp0 = __builtin_amdgcn_s_memrealtime(); } while (0)
#define TP_END() do { if (ph == TIME_PHASE) tp1 = __builtin_amdgcn_s_memrealtime(); } while (0)
#else
#define TP_BEGIN()
#define TP_END()
#endif
#define PHASE(...) do { if (lo <= ph && ph < hi) { TP_BEGIN(); __VA_ARGS__; if (ph + 1 < hi) { GRID_BAR(); } TP_END(); } ++ph; } while (0)
#define PHASEG(grp, ...) do { if (lo <= ph && ph < hi) { TP_BEGIN(); if ((REPEAT_MASK >> (grp)) & 1) { __VA_ARGS__; GRID_BAR(); } __VA_ARGS__; if (ph + 1 < hi) { GRID_BAR(); } TP_END(); } ++ph; } while (0)
    PHASE(ph_mod(c, ldsf));
#define LAYER_BODY(l) do { const float* mod = WSF(O_MOD); \
        const float* xin = l == 0 ? c.in[0] : WSF(O_X1); float* xmid = WSF(O_X0); float* xout = WSF(O_X1); \
        const float* ml = mod + (size_t)l * NB * D6; \
        PHASEG(3, ph_convert(c, l, ldsf)); \
        PHASEG(0, { pg8::Gemm g{D, D, D}; pg8::StaticOrder so; so.init(T, PW, G, cwg, WSH(O_H), WSH(O_WIN), D, D); pg8::EpiBf16 E{WSH(O_P), PW}; pg8::gemm_phase(lds, g, so, E); }); \
        PHASE(ph_lru_gate(c, l, ldsf); ph_ret_kv(c, ldsf); ph_sgu_norm(c, l)); \
        PHASE(ph_lru_scan1(c); ph_ret_state(c); ph_sgu_mix(c, l, ldsf); ph_rw_lora(c, l, ldsf)); \
        PHASE(ph_lru_scan2(c); ph_ret_out(c, ldsf); ph_rw_chunk(c, l, ldsf)); \
        PHASE(ph_lru_scan3(c); ph_rw_seq(c, ldsf)); \
        PHASE(ph_rw_out(c, l)); \
        PHASEG(1, { pg8::Gemm g{W, 4 * W, 4 * W}; pg8::MergeOrder mo; mo.so.init(T, D, G, cwg, WSH(O_YS), WSH(O_WBR), 4 * W, 4 * W); mo.kseg_bytes = W * 2; pg8::EpiMerge E{WSH(O_P), WSF(O_PART), WSH(O_MRG)}; pg8::gemm_phase(lds, g, mo, E); }); \
        PHASEG(1, { pg8::Gemm g{D, D, D}; pg8::StaticOrder so; so.init(T, D, G, cwg, WSH(O_MRG), WSH(O_WOUT), D, D); pg8::EpiResid E{xin, ml + 2 * D, xmid}; pg8::gemm_phase(lds, g, so, E); }); \
        PHASEG(6, ph_norm(c, xmid, c.in[4] + (size_t)l * D, ml + 3 * D, ml + 4 * D, WSH(O_H), WSF(O_HF))); \
        PHASE(ph_router(c, l, ldsf)); \
        PHASE(ph_moe_plan(c, l)); \
        PHASE(ph_moe_assign(c, l)); \
        PHASEG(6, ph_moe_gather(c)); \
        const int* plan = CTLW(c) + CW_PLAN + l * 256; \
        PHASEG(2, { pg8::Gemm g{D, D, D}; pg8::MoeOrder mo{G, cwg, 4, plan, (const char*)WSH(O_XS), (const char*)WSH(O_WGU), (size_t)256 * D * 2, (size_t)256 * D * 2, (size_t)1024 * D * 2}; pg8::EpiGU E{WSH(O_ACT)}; pg8::gemm_phase(lds, g, mo, E); }); \
        PHASEG(2, { pg8::Gemm g{512, 512, 512}; pg8::MoeOrder mo{G, cwg, 8, plan, (const char*)WSH(O_ACT), (const char*)WSH(O_WDN), (size_t)256 * 512 * 2, (size_t)256 * 512 * 2, (size_t)D * 512 * 2}; pg8::EpiBf16 E{WSH(O_YE), D}; pg8::gemm_phase(lds, g, mo, E); }); \
        if (l == 0) PHASE(ph_comb_norm<0>(c, xmid, ml + 5 * D, xout, c.in[3] + (size_t)1 * D, mod + (size_t)1 * NB * D6 + 0 * D, mod + (size_t)1 * NB * D6 + 1 * D, WSH(O_H), nullptr)); \
        else PHASE(ph_comb_norm<1>(c, xmid, ml + 5 * D, xout, c.in[36], nullptr, nullptr, nullptr, c.out)); \
    } while (0)
    PHASE(ph_norm(c, c.in[0], c.in[3], WSF(O_MOD) + 0 * D, WSF(O_MOD) + 1 * D, WSH(O_H), nullptr));
    LAYER_BODY(0);
    LAYER_BODY(1);
#undef LAYER_BODY
#if TIME_PHASE >= 0 && !defined(CPU_EMU)
    if (blockIdx.x == 0) { const unsigned long long te = __builtin_amdgcn_s_memrealtime(), dl = 8ull * (tp1 - tp0); while (__builtin_amdgcn_s_memrealtime() - te < dl) __builtin_amdgcn_s_sleep(8); }
#endif
#undef PHASE
}
}

#ifndef CPU_EMU
extern "C" void kernel_launch(void* const* d_in, const int* in_sizes, int n_in, void* d_out, int out_size, void* d_ws, size_t ws_size, hipStream_t stream) {
    static int grid = 0;
    if (grid == 0) {
        if (n_in != 37 || out_size != T * D || ws_size < WS_END) { fprintf(stderr, "kernel_launch: unexpected shapes (n_in %d out %d ws %zu need %zu)\n", n_in, out_size, ws_size, (size_t)WS_END); grid = -1; return; }
        int dev = 0, cus = 0, per_cu = 0;
        if (hipGetDevice(&dev) != hipSuccess || hipDeviceGetAttribute(&cus, hipDeviceAttributeMultiprocessorCount, dev) != hipSuccess) { grid = -1; return; }
        if (hipFuncSetAttribute((const void*)fwd, hipFuncAttributeMaxDynamicSharedMemorySize, LDS_BYTES) != hipSuccess) { fprintf(stderr, "kernel_launch: hipFuncSetAttribute failed\n"); grid = -1; return; }
        if (hipOccupancyMaxActiveBlocksPerMultiprocessor(&per_cu, (const void*)fwd, NT, LDS_BYTES) != hipSuccess || per_cu < 1) fprintf(stderr, "kernel_launch: occupancy query says %d\n", per_cu);
        (void)hipGetLastError();
        grid = cus;
    }
    if (grid < 0) return;
    (void)in_sizes;
    (void)hipMemsetAsync((char*)d_ws + O_CTL, 0, CTL_BYTES, stream);
    Params p{};
    for (int i = 0; i < 37; ++i) p.in[i] = (const float*)d_in[i];
    p.out = (float*)d_out; p.ws = (unsigned char*)d_ws;
#if ONE_LAUNCH
    p.ph_lo = 0; p.ph_hi = NPH;
    hipLaunchKernelGGL(fwd, dim3(grid), dim3(NT), LDS_BYTES, stream, p);
#else
    for (int k = 0; k < NPH; ++k) { p.ph_lo = k; p.ph_hi = k + 1; hipLaunchKernelGGL(fwd, dim3(grid), dim3(NT), LDS_BYTES, stream, p); }
#endif
}
#endif
```

```cpp
#ifndef CPU_EMU
#include <hip/hip_runtime.h>
#endif
#include <cstdio>
#include <cstdint>
#include <cmath>
#include <cstring>

#ifndef SEQ
#define SEQ 4096
#endif
#ifndef ONE_LAUNCH
#define ONE_LAUNCH 1
#endif

namespace {
constexpr int D = 2048, NB = 2, S = SEQ, T = NB * S, NL = 2, W = 1024;
constexpr int INW = 18816, RF = 3456, D6 = 6 * D;
constexpr int C_LX = 0, C_LG = 1024, C_RQ = 2048, C_RK = 2560, C_RV = 3072, C_RG = 4096, C_SU = 5120, C_SV = 6144, C_RW = 7168;
constexpr int PW = 18944, C_MLP = 10752;
constexpr int NCH = S / 128;
constexpr int NLC = S / 64;
constexpr int NE = 32, CAP = (T * 2 / 256 + NE) * 256, MAXBLK = CAP / 256;
constexpr float EPS = 1e-6f;
constexpr float DECAY_SCALE = 0.60653065971263342f;
constexpr int NT = 512;
constexpr int NPH_LAYER = 17, NPH = 2 + NL * NPH_LAYER;
typedef unsigned short bf16_t;
#ifdef CPU_EMU
typedef float f32x4 __attribute__((vector_size(16)));
typedef unsigned u32x4 __attribute__((vector_size(16)));
#else
typedef float f32x4 __attribute__((ext_vector_type(4)));
typedef unsigned u32x4 __attribute__((ext_vector_type(4)));
typedef short bf16x8 __attribute__((ext_vector_type(8)));
#endif

constexpr size_t al256(size_t x) { return (x + 255) & ~(size_t)255; }
constexpr size_t SZ_X = (size_t)T * D * 4, SZ_W = (size_t)T * W * 4;
constexpr size_t O_CTL = 0, CTL_BYTES = 1u << 20;
constexpr size_t O_MOD = CTL_BYTES;
constexpr size_t O_X0 = O_MOD + al256((size_t)NL * NB * D6 * 4);
constexpr size_t O_X1 = O_X0 + SZ_X;
constexpr size_t O_H = O_X1 + SZ_X;
constexpr size_t O_HF = O_H + SZ_X / 2;
constexpr size_t O_P = O_HF + SZ_X;
constexpr size_t SZ_P = (size_t)T * PW * 2;
constexpr size_t O_XC = O_P + SZ_P;
constexpr size_t O_LA = O_XC + SZ_W, O_LU = O_LA + 2 * SZ_W;
constexpr size_t SZ_LC = (size_t)2 * NB * NLC * W * 4;
constexpr size_t O_LCA = O_LU + 2 * SZ_W, O_LCH = O_LCA + SZ_LC, O_LCI = O_LCH + SZ_LC;
constexpr size_t O_YS = O_LCI + SZ_LC;
constexpr size_t O_SC = O_YS + (size_t)T * 4 * W * 2;
constexpr size_t SZ_KV = (size_t)NB * NCH * 8 * 64 * 128 * 4;
constexpr size_t O_KVF = O_SC, O_KVB = O_KVF + SZ_KV, O_STF = O_KVB + SZ_KV, O_STB = O_STF + SZ_KV;
constexpr size_t O_VN = O_STB + SZ_KV;
constexpr size_t O_FS = O_VN + SZ_W;
constexpr size_t O_DEC = O_FS + al256((size_t)T * RF * 4), O_AA = O_DEC + 2 * SZ_W, O_AKK = O_AA + 2 * SZ_W;
constexpr size_t O_GG = O_AKK, O_YY = O_GG + SZ_W;
constexpr int RCK = 64, NRC = S / RCK;
constexpr size_t O_BON = O_YY + 2 * SZ_W;
constexpr size_t O_PART = O_BON + al256((size_t)2 * T * 16 * 4);
constexpr size_t O_MRG = O_PART + SZ_X;
constexpr size_t O_LOG = O_MRG + SZ_X / 2;
constexpr size_t O_EID = O_LOG + al256((size_t)T * 40 * 4), O_EWT = O_EID + al256((size_t)T * 2 * 4), O_DEST = O_EWT + al256((size_t)T * 2 * 4);
constexpr size_t O_SLOT = O_DEST + al256((size_t)T * 2 * 4);
constexpr size_t O_PST = O_SLOT + al256((size_t)CAP * 4), O_PYT = O_PST + (size_t)64 * NRC * 4096 * 2, O_SVB = O_PYT + (size_t)64 * NRC * 4096 * 2, O_YVB = O_SVB + (size_t)64 * NRC * 4096 * 4;
constexpr size_t O_WIN = O_YVB + (size_t)64 * NRC * 4096 * 4;
constexpr size_t O_WBR = O_WIN + (size_t)PW * D * 2;
constexpr size_t O_WOUT = O_WBR + (size_t)D * 4 * W * 2;
constexpr size_t O_WGU = O_WOUT + (size_t)D * D * 2;
constexpr size_t O_WDN = O_WGU + (size_t)NE * 1024 * D * 2;
constexpr size_t O_WLR = O_WDN + (size_t)NE * D * 512 * 2;
constexpr size_t O_WUT = O_WLR + (size_t)32 * 128 * 128 * 2;
constexpr size_t O_WAT = O_WUT + (size_t)2 * W * 64 * 2;
constexpr size_t O_WGT = O_WAT + (size_t)2 * W * 64 * 2;
constexpr size_t O_WRH = O_WGT + (size_t)W * 128 * 2;
constexpr size_t O_WRL = O_WRH + (size_t)48 * D * 2;
constexpr size_t WS_END0 = O_WRL + (size_t)48 * D * 2;
constexpr size_t SZ_MOE = (size_t)CAP * (D + 512 + D) * 2;
constexpr bool MOE_OVERLAY = SZ_MOE <= SZ_P;
constexpr size_t O_XS = MOE_OVERLAY ? O_P : WS_END0;
constexpr size_t O_ACT = O_XS + (size_t)CAP * D * 2;
constexpr size_t O_YE = O_ACT + (size_t)CAP * 512 * 2;
constexpr size_t WS_END = MOE_OVERLAY ? WS_END0 : WS_END0 + SZ_MOE;
static_assert(SEQ != 4096 || WS_END <= (size_t)2040 * 1024 * 1024, "workspace budget: d_ws is 4 x the largest input = 2048 MiB");
constexpr int CW_BAR = 4096;
constexpr int CW_CNT = 32768;
constexpr int CW_FILL = CW_CNT + NL * 64;
constexpr int CW_PLAN = CW_FILL + NL * 64;
static_assert(MAXBLK <= 160, "plan words");

struct Params { const float* in[37]; float* out; unsigned char* ws; int ph_lo, ph_hi; };

struct Ctx { const float* const* in; float* out; unsigned char* ws; };
#define GT_ ((long)blockIdx.x * NT + threadIdx.x)
#define GS_ ((long)gridDim.x * NT)
#define WSF(off) ((float*)(c.ws + (off)))
#define WSI(off) ((int*)(c.ws + (off)))
#define WSH(off) ((bf16_t*)(c.ws + (off)))
#define CTLW(c) ((int*)((c).ws + O_CTL))

#ifdef CPU_EMU
__device__ __forceinline__ float fexp_(float x) { return expf(x); }
__device__ __forceinline__ float frcp_(float x) { return 1.f / x; }
#else
__device__ __forceinline__ float fexp_(float x) { return __builtin_amdgcn_exp2f(x * 1.4426950408889634f); }
__device__ __forceinline__ float frcp_(float x) { return __builtin_amdgcn_rcpf(x); }
#endif
__device__ __forceinline__ float sigmoidf_(float x) { return frcp_(1.f + fexp_(-x)); }
__device__ __forceinline__ float siluf_(float x) { return x * frcp_(1.f + fexp_(-x)); }
__device__ __forceinline__ float tanhf_(float x) { return 1.f - 2.f * frcp_(1.f + fexp_(2.f * x)); }
__device__ __forceinline__ float geluf_(float x) { return 0.5f * x * (1.f + tanhf_(0.7978845608028654f * (x + 0.044715f * x * x * x))); }
__device__ __forceinline__ float softplusf_(float x) { return x > 0.f ? x + log1pf(expf(-x)) : log1pf(expf(x)); }
__device__ __forceinline__ float loggamma_(int h) { return log1pf(-exp2f(-5.f - (float)h)); }
__device__ __forceinline__ unsigned f2u_(float f) { unsigned u; memcpy(&u, &f, 4); return u; }
__device__ __forceinline__ float u2f_(unsigned u) { float f; memcpy(&f, &u, 4); return f; }
__device__ __forceinline__ float bf2f(bf16_t v) { return u2f_((unsigned)v << 16); }
__device__ __forceinline__ unsigned f2bf(float f) { const unsigned u = f2u_(f); return (u + 0x7fffu + ((u >> 16) & 1u)) >> 16; }
__device__ __forceinline__ unsigned pk2(float lo, float hi) { return f2bf(lo) | (f2bf(hi) << 16); }
__device__ __forceinline__ float bflo(unsigned w) { return u2f_(w << 16); }
__device__ __forceinline__ float bfhi(unsigned w) { return u2f_(w & 0xffff0000u); }
__device__ __forceinline__ int atomic_add_i(int* p, int v) {
#ifdef CPU_EMU
    return __atomic_fetch_add(p, v, __ATOMIC_RELAXED);
#else
    return atomicAdd(p, v);
#endif
}
#define PF(P, r, col) bf2f((P)[(size_t)(r) * PW + (col)])
#ifdef CPU_EMU
#define SYNCTHREADS() emu_syncthreads()
#define SHFL_XOR(v, m) emu_shfl_xor(v, m)
#else
#define SYNCTHREADS() __syncthreads()
#define SHFL_XOR(v, m) __shfl_xor(v, m)
#endif
#ifdef CPU_EMU
__device__ __forceinline__ float wave_sum(float v) {
    for (int o = 1; o < 64; o <<= 1) v += SHFL_XOR(v, o);
    return v;
}
#else
__device__ __forceinline__ float wave_sum(float x) {
    x += __builtin_bit_cast(float, __builtin_amdgcn_update_dpp(0, __builtin_bit_cast(int, x), 0xB1, 0xF, 0xF, true));
    x += __builtin_bit_cast(float, __builtin_amdgcn_update_dpp(0, __builtin_bit_cast(int, x), 0x4E, 0xF, 0xF, true));
    x += __builtin_bit_cast(float, __builtin_amdgcn_update_dpp(0, __builtin_bit_cast(int, x), 0x141, 0xF, 0xF, true));
    x += __builtin_bit_cast(float, __builtin_amdgcn_update_dpp(0, __builtin_bit_cast(int, x), 0x140, 0xF, 0xF, true));
    const int xi = __builtin_bit_cast(int, x);
    return (__builtin_bit_cast(float, __builtin_amdgcn_readlane(xi, 0)) + __builtin_bit_cast(float, __builtin_amdgcn_readlane(xi, 16))) + (__builtin_bit_cast(float, __builtin_amdgcn_readlane(xi, 32)) + __builtin_bit_cast(float, __builtin_amdgcn_readlane(xi, 48)));
}
#endif
__device__ __forceinline__ f32x4 ld_bf4(const bf16_t* p) { const unsigned long long q = *(const unsigned long long*)p; const unsigned lo = (unsigned)q, hi = (unsigned)(q >> 32); return (f32x4){bflo(lo), bfhi(lo), bflo(hi), bfhi(hi)}; }
__device__ __forceinline__ void st_bf4(bf16_t* p, const f32x4 v) { *(unsigned long long*)p = (unsigned long long)pk2(v[0], v[1]) | ((unsigned long long)pk2(v[2], v[3]) << 32); }

template <int KT, int NTL>
__device__ __forceinline__ void wave_mma(f32x4 (&acc)[NTL], const bf16_t* A, int lda, const bf16_t* Bt, int ldb) {
    const int lane = threadIdx.x & 63, fr = lane & 15, fq = lane >> 4;
#ifdef CPU_EMU
    for (int nt = 0; nt < NTL; ++nt) for (int r = 0; r < 4; ++r) { float sacc = 0.f; const bf16_t* a = A + fr * lda; const bf16_t* b = Bt + (16 * nt + 4 * fq + r) * ldb;
        for (int k = 0; k < 32 * KT; ++k) sacc += bf2f(a[k]) * bf2f(b[k]);
        acc[nt][r] += sacc; }
#else
#pragma unroll
    for (int kt = 0; kt < KT; ++kt) {
        const bf16x8 af = *(const bf16x8*)(A + fr * lda + kt * 32 + fq * 8);
#pragma unroll
        for (int nt = 0; nt < NTL; ++nt) { const bf16x8 bfr = *(const bf16x8*)(Bt + (16 * nt + fr) * ldb + kt * 32 + fq * 8);
            acc[nt] = __builtin_amdgcn_mfma_f32_16x16x32_bf16(bfr, af, acc[nt], 0, 0, 0); }
    }
#endif
}
__device__ __forceinline__ void ph_mod(const Ctx& c, float* ldsf) {
    const float* cc = c.in[1]; const float* aw = c.in[5]; const float* ab = c.in[6]; float* mod = WSF(O_MOD);
    float* scs = ldsf; float* part = ldsf + NB * D; const int tid = threadIdx.x, c4 = (tid & 31) * 4, kq = tid >> 5;
    for (int i = tid; i < NB * D; i += NT) scs[i] = siluf_(cc[i]);
    SYNCTHREADS();
    for (int u = blockIdx.x; u < NL * (D6 / 128); u += gridDim.x) {
        const int l = u / (D6 / 128), j0 = (u % (D6 / 128)) * 128;
        const float* w = aw + (size_t)l * D * D6 + j0 + c4; f32x4 a0 = (f32x4){0.f, 0.f, 0.f, 0.f}, a1 = a0;
#pragma unroll 8
        for (int k = kq * 128; k < kq * 128 + 128; ++k) { const f32x4 wv = *(const f32x4*)(w + (size_t)k * D6); a0 += wv * scs[k]; a1 += wv * scs[D + k]; }
        *(f32x4*)(part + (kq * 2 + 0) * 128 + c4) = a0; *(f32x4*)(part + (kq * 2 + 1) * 128 + c4) = a1;
        SYNCTHREADS();
        if (tid < 256) { const int b = tid >> 7, col = tid & 127; float sacc = 0.f;
#pragma unroll
            for (int q = 0; q < 16; ++q) sacc += part[(q * 2 + b) * 128 + col];
            mod[((size_t)l * NB + b) * D6 + j0 + col] = sacc + ab[l * D6 + j0 + col]; }
        SYNCTHREADS();
    }
}
__device__ __forceinline__ void ph_norm(const Ctx& c, const float* x, const float* g, const float* sh, const float* sc, bf16_t* hb, float* hf) {
    const int lane = threadIdx.x & 63, gw = blockIdx.x * (NT / 64) + (threadIdx.x >> 6), ngw = gridDim.x * (NT / 64);
    for (int t = gw; t < T; t += ngw) {
        const int b = t / S; const float* xr = x + (size_t)t * D; f32x4 v[8]; float ss = 0.f;
#pragma unroll
        for (int j = 0; j < 8; ++j) { v[j] = *(const f32x4*)(xr + (j * 64 + lane) * 4); ss += (v[j][0] * v[j][0] + v[j][1] * v[j][1]) + (v[j][2] * v[j][2] + v[j][3] * v[j][3]); }
        const float rs = 1.f / sqrtf(wave_sum(ss) * (1.f / D) + EPS);
#pragma unroll
        for (int j = 0; j < 8; ++j) { const int col = (j * 64 + lane) * 4;
            const f32x4 o = v[j] * rs * *(const f32x4*)(g + col) * (*(const f32x4*)(sc + b * D6 + col) + 1.f) + *(const f32x4*)(sh + b * D6 + col);
            st_bf4(hb + (size_t)t * D + col, o); if (hf) *(f32x4*)(hf + (size_t)t * D + col) = o; }
    }
}
template <int MODE>
__device__ __forceinline__ void ph_comb_norm(const Ctx& c, const float* xmid, const float* g2, float* xout, const float* g, const float* sh, const float* sc, bf16_t* hb, float* outp) {
    const bf16_t* YE = WSH(O_YE); const float* EWT = WSF(O_EWT); const int* DEST = WSI(O_DEST);
    const int lane = threadIdx.x & 63, gw = blockIdx.x * (NT / 64) + (threadIdx.x >> 6), ngw = gridDim.x * (NT / 64);
    for (int t = gw; t < T; t += ngw) {
        const int b = t / S; const float w0 = EWT[t * 2], w1 = EWT[t * 2 + 1]; const bf16_t* y0 = YE + (size_t)DEST[t * 2] * D; const bf16_t* y1 = YE + (size_t)DEST[t * 2 + 1] * D;
        f32x4 v[8]; float ss = 0.f;
#pragma unroll
        for (int j = 0; j < 8; ++j) { const int col = (j * 64 + lane) * 4;
            v[j] = *(const f32x4*)(xmid + (size_t)t * D + col) + *(const f32x4*)(g2 + b * D6 + col) * (ld_bf4(y0 + col) * w0 + ld_bf4(y1 + col) * w1);
            if (MODE == 0) *(f32x4*)(xout + (size_t)t * D + col) = v[j];
            ss += (v[j][0] * v[j][0] + v[j][1] * v[j][1]) + (v[j][2] * v[j][2] + v[j][3] * v[j][3]); }
        const float rs = 1.f / sqrtf(wave_sum(ss) * (1.f / D) + EPS);
#pragma unroll
        for (int j = 0; j < 8; ++j) { const int col = (j * 64 + lane) * 4;
            if (MODE == 0) st_bf4(hb + (size_t)t * D + col, v[j] * rs * *(const f32x4*)(g + col) * (*(const f32x4*)(sc + b * D6 + col) + 1.f) + *(const f32x4*)(sh + b * D6 + col));
            else *(f32x4*)(outp + (size_t)t * D + col) = v[j] * rs * *(const f32x4*)(g + col); }
    }
}

struct CvtItem { const float* Wp; int ldw; bf16_t* WT; int ldt; int drow, k0, n0; };
constexpr int I_IN = 32 * (INW / 32), I_BR = 4 * 16 * 64, I_OUT = 32 * 64, I_GU = NE * 32 * 32, I_DN = NE * 8 * 64, I_LR = 32 * 8, I_WU = 2 * 32, I_WG = 64, I_BIG = I_IN + I_BR + I_OUT + I_GU + I_DN, I_ALL = I_BIG + I_LR + 2 * I_WU + I_WG;
__device__ __forceinline__ CvtItem cvt_decode(const Ctx& c, int l, int it) {
    CvtItem r;
    if (it < I_IN) { const int kb = it / (INW / 32), nb = it % (INW / 32); r.n0 = nb * 32; r.k0 = kb * 64; r.Wp = c.in[7] + (size_t)l * D * INW; r.ldw = INW; r.WT = WSH(O_WIN); r.ldt = D; r.drow = r.n0 < 10624 ? r.n0 : r.n0 + 128; return r; }
    it -= I_IN;
    if (it < I_BR) { const int sgm = it / 1024, q = it % 1024, kb = q / 64, nb = q % 64; r.n0 = nb * 32; r.k0 = kb * 64; r.Wp = c.in[28] + ((size_t)l * 4 + sgm) * W * D; r.ldw = D; r.WT = WSH(O_WBR) + sgm * W; r.ldt = 4 * W; r.drow = r.n0; return r; }
    it -= I_BR;
    if (it < I_OUT) { const int kb = it / 64, nb = it % 64; r.n0 = nb * 32; r.k0 = kb * 64; r.Wp = c.in[29] + (size_t)l * D * D; r.ldw = D; r.WT = WSH(O_WOUT); r.ldt = D; r.drow = r.n0; return r; }
    it -= I_OUT;
    if (it < I_GU) { const int e = it / 1024, q = it % 1024, kb = q / 32, nb = q % 32; r.n0 = nb * 32; r.k0 = kb * 64; r.Wp = c.in[34] + ((size_t)l * NE + e) * D * 1024; r.ldw = 1024; r.WT = WSH(O_WGU) + (size_t)e * 1024 * D; r.ldt = D;
        r.drow = r.n0 < 512 ? (r.n0 / 128) * 256 + (r.n0 % 128) : ((r.n0 - 512) / 128) * 256 + 128 + ((r.n0 - 512) % 128); return r; }
    it -= I_GU;
    if (it < I_DN) { const int e = it / 512, q = it % 512, kb = q / 64, nb = q % 64; r.n0 = nb * 32; r.k0 = kb * 64; r.Wp = c.in[35] + ((size_t)l * NE + e) * 512 * D; r.ldw = D; r.WT = WSH(O_WDN) + (size_t)e * D * 512; r.ldt = 512; r.drow = r.n0; return r; }
    it -= I_DN;
    if (it < I_LR) { const int m = it / 8, q = it % 8, kb = q / 4, nb = q % 4, z = m >> 4, ty = (m >> 3) & 1, n = m & 7; r.n0 = nb * 32; r.k0 = kb * 64; r.Wp = c.in[ty ? 12 : 10] + (((size_t)l * 2 + z) * 8 + n) * 128 * 128; r.ldw = 128;
        r.WT = WSH(O_WLR) + (size_t)m * 128 * 128; r.ldt = 128; r.drow = r.n0; return r; }
    it -= I_LR;
    if (it < 2 * I_WU) { const int ua = it / I_WU, q = it % I_WU, z = q / 32, nb = q % 32; r.n0 = nb * 32; r.k0 = 0; r.Wp = c.in[ua ? 23 : 21] + ((size_t)l * 2 + z) * 64 * W; r.ldw = W; r.WT = WSH(ua ? O_WAT : O_WUT) + (size_t)z * W * 64; r.ldt = 64; r.drow = r.n0; return r; }
    it -= 2 * I_WU;
    { const int kb = it / 32, nb = it % 32; r.n0 = nb * 32; r.k0 = kb * 64; r.Wp = c.in[24] + (size_t)l * 128 * W; r.ldw = W; r.WT = WSH(O_WGT); r.ldt = 128; r.drow = r.n0; return r; }
}
constexpr int J_IN = 16 * (INW / 128), J_BR = 4 * 8 * 16, J_OUT = 16 * 16, J_GU = NE * 16 * 8, J_DN = NE * 4 * 16, J_ALL = J_IN + J_BR + J_OUT + J_GU + J_DN;
__device__ __forceinline__ CvtItem cvt_decode_big(const Ctx& c, int l, int it) {
    CvtItem r;
    if (it < J_IN) { const int kb = it / (INW / 128), nb = it % (INW / 128); r.n0 = nb * 128; r.k0 = kb * 128; r.Wp = c.in[7] + (size_t)l * D * INW; r.ldw = INW; r.WT = WSH(O_WIN); r.ldt = D; r.drow = r.n0 < 10624 ? r.n0 : r.n0 + 128; return r; }
    it -= J_IN;
    if (it < J_BR) { const int sgm = it / 128, q = it % 128, kb = q / 16, nb = q % 16; r.n0 = nb * 128; r.k0 = kb * 128; r.Wp = c.in[28] + ((size_t)l * 4 + sgm) * W * D; r.ldw = D; r.WT = WSH(O_WBR) + sgm * W; r.ldt = 4 * W; r.drow = r.n0; return r; }
    it -= J_BR;
    if (it < J_OUT) { const int kb = it / 16, nb = it % 16; r.n0 = nb * 128; r.k0 = kb * 128; r.Wp = c.in[29] + (size_t)l * D * D; r.ldw = D; r.WT = WSH(O_WOUT); r.ldt = D; r.drow = r.n0; return r; }
    it -= J_OUT;
    if (it < J_GU) { const int e = it / 128, q = it % 128, kb = q / 8, nb = q % 8; r.n0 = nb * 128; r.k0 = kb * 128; r.Wp = c.in[34] + ((size_t)l * NE + e) * D * 1024; r.ldw = 1024; r.WT = WSH(O_WGU) + (size_t)e * 1024 * D; r.ldt = D;
        r.drow = r.n0 < 512 ? (r.n0 / 128) * 256 : ((r.n0 - 512) / 128) * 256 + 128; return r; }
    it -= J_GU;
    { const int e = it / 64, q = it % 64, kb = q / 16, nb = q % 16; r.n0 = nb * 128; r.k0 = kb * 128; r.Wp = c.in[35] + ((size_t)l * NE + e) * 512 * D; r.ldw = D; r.WT = WSH(O_WDN) + (size_t)e * D * 512; r.ldt = 512; r.drow = r.n0; return r; }
}
__device__ __forceinline__ void ph_convert(const Ctx& c, int l, float* ldsf) {
    const int lane = threadIdx.x & 63, wave = threadIdx.x >> 6; const int gw = blockIdx.x * (NT / 64) + wave, ngw = gridDim.x * (NT / 64);
    {
        const int tid = threadIdx.x, lr = tid >> 5, lc = (tid & 31) * 4;
        f32x4 rg[8]; int it = blockIdx.x; CvtItem r;
        if (it < J_ALL) { r = cvt_decode_big(c, l, it);
#pragma unroll
            for (int i = 0; i < 8; ++i) rg[i] = *(const f32x4*)(r.Wp + (size_t)(r.k0 + lr + 16 * i) * r.ldw + r.n0 + lc); }
        for (; it < J_ALL; it += gridDim.x) {
#pragma unroll
            for (int i = 0; i < 8; ++i) { float* dp = ldsf + (lr + 16 * i) * 129 + lc; dp[0] = rg[i][0]; dp[1] = rg[i][1]; dp[2] = rg[i][2]; dp[3] = rg[i][3]; }
            const CvtItem cur = r; const int nx = it + gridDim.x;
            if (nx < J_ALL) { r = cvt_decode_big(c, l, nx);
#pragma unroll
                for (int i = 0; i < 8; ++i) rg[i] = *(const f32x4*)(r.Wp + (size_t)(r.k0 + lr + 16 * i) * r.ldw + r.n0 + lc); }
            SYNCTHREADS();
#pragma unroll
            for (int q = 0; q < 4; ++q) { const int id = tid + NT * q, n = id >> 4, k8 = (id & 15) * 8; const float* sp = ldsf + k8 * 129 + n;
                u32x4 o; o[0] = pk2(sp[0 * 129], sp[1 * 129]); o[1] = pk2(sp[2 * 129], sp[3 * 129]); o[2] = pk2(sp[4 * 129], sp[5 * 129]); o[3] = pk2(sp[6 * 129], sp[7 * 129]);
                *(u32x4*)(cur.WT + (size_t)(cur.drow + n) * cur.ldt + cur.k0 + k8) = o; }
            SYNCTHREADS();
        }
    }
#ifdef CPU_EMU
    if (lane == 0) for (int it = I_BIG + gw; it < I_ALL; it += ngw) { const CvtItem r = cvt_decode(c, l, it);
        for (int kk = 0; kk < 64; ++kk) for (int nn = 0; nn < 32; ++nn) r.WT[(size_t)(r.drow + nn) * r.ldt + r.k0 + kk] = (bf16_t)f2bf(r.Wp[(size_t)(r.k0 + kk) * r.ldw + r.n0 + nn]); }
#else
    float* scr = ldsf + wave * (64 * 33 + 16);
    for (int it = I_BIG + gw; it < I_ALL; it += ngw) {
        const CvtItem r = cvt_decode(c, l, it);
#pragma unroll 8
        for (int i = 0; i < 32; ++i) { const int kk = 2 * i + (lane >> 5); scr[kk * 33 + (lane & 31)] = r.Wp[(size_t)(r.k0 + kk) * r.ldw + r.n0 + (lane & 31)]; }
        asm volatile("s_waitcnt lgkmcnt(0)" ::: "memory");
        const int cc = lane & 7;
#pragma unroll
        for (int j = 0; j < 4; ++j) { const int n = (lane >> 3) + 8 * j; const float* sp = scr + (8 * cc) * 33 + n;
            u32x4 o; o[0] = pk2(sp[0 * 33], sp[1 * 33]); o[1] = pk2(sp[2 * 33], sp[3 * 33]); o[2] = pk2(sp[4 * 33], sp[5 * 33]); o[3] = pk2(sp[6 * 33], sp[7 * 33]);
            *(u32x4*)(r.WT + (size_t)(r.drow + n) * r.ldt + r.k0 + 8 * cc) = o; }
        asm volatile("s_waitcnt lgkmcnt(0)" ::: "memory");
    }
#endif
    { const float* wg = c.in[30] + (size_t)l * D * 4; const float* we = c.in[32] + (size_t)l * D * 32; bf16_t* wh = WSH(O_WRH); bf16_t* wl = WSH(O_WRL);
      for (long i = GT_; i < (long)48 * D; i += GS_) { const int n = (int)(i / D), k = (int)(i % D); const float w = n < 4 ? wg[k * 4 + n] : n < 36 ? we[k * 32 + (n - 4)] : 0.f; const unsigned hb = f2bf(w); wh[i] = (bf16_t)hb; wl[i] = (bf16_t)f2bf(w - bf2f((bf16_t)hb)); } }
    for (long i = GT_; i < (long)128 * D / 2; i += GS_) ((unsigned*)(WSH(O_WIN) + (size_t)10624 * D))[i] = 0u;
}

namespace pg8 {
constexpr int BM = 256, BK = 64, HALF = 128, HTB = HALF * BK * 2, STAGE_BYTES = 8 * HTB;
__host__ __device__ __forceinline__ int lds_byte(int r, int cc) { const int st = (r >> 4) * 2 + (cc >> 5), rr = r & 15, c2 = cc & 31, ob = rr * 64 + c2 * 2; return st * 1024 + (ob ^ (((ob >> 9) & 1) << 5)); }
__host__ __device__ __forceinline__ void stage_rc(int b, int& R, int& C) { const int st = b / 1024, sb = b % 1024, swz = sb ^ (((sb >> 9) & 1) << 5); R = (st >> 1) * 16 + swz / 64; C = (st & 1) * 32 + (swz % 64) / 2; }
__host__ __device__ __forceinline__ int perm32(int rho) { const int n = rho >> 4, i = rho & 15; return 8 * (i >> 2) + 4 * n + (i & 3); }
struct Unit { int pm, pn, aux; const char* A; const char* B; };
struct Gemm { int K, lda, ldb; };

template <class Epi, class Sched>
__device__ __forceinline__ void gemm_phase(unsigned char* lds_, const Gemm g, const Sched& S, const Epi& E) {
#ifdef CPU_EMU
    if (threadIdx.x != 0) return;
    Unit u; const int K = g.K;
    float* Af = (float*)malloc((size_t)256 * K * 4); float* Bf = (float*)malloc((size_t)256 * K * 4); float* Cf = (float*)malloc(256 * 256 * 4);
    for (int i = 0; S.next(i, u); ++i) {
        const bf16_t* A = (const bf16_t*)u.A; const bf16_t* B = (const bf16_t*)u.B;
        for (int r = 0; r < 256; ++r) for (int k = 0; k < K; ++k) { Af[(size_t)r * K + k] = bf2f(A[(size_t)r * g.lda + k]); Bf[(size_t)r * K + k] = bf2f(B[(size_t)r * g.ldb + k]); }
        for (int r = 0; r < 256; ++r) for (int cc = 0; cc < 256; ++cc) { const float* a = Af + (size_t)r * K; const float* b = Bf + (size_t)cc * K; float sacc = 0.f; for (int k = 0; k < K; ++k) sacc += a[k] * b[k]; Cf[r * 256 + cc] = sacc; }
        for (int wid = 0; wid < 8; ++wid) for (int lane = 0; lane < 64; ++lane) {
            const int wr = wid >> 2, wc = wid & 3, fr = lane & 15, fq = lane >> 4; f32x4 acc[2][2][4][2];
            for (int ai = 0; ai < 2; ++ai) for (int bj = 0; bj < 2; ++bj) for (int m = 0; m < 4; ++m) for (int n = 0; n < 2; ++n) for (int j = 0; j < 4; ++j) {
                const int r = 128 * ai + 64 * wr + 16 * m + fr, cc = 128 * bj + 32 * wc + (Epi::PERM ? 8 * fq + 4 * n + j : 16 * n + 4 * fq + j); acc[ai][bj][m][n][j] = Cf[r * 256 + cc]; }
            E(acc, u, wr, wc, fr, fq);
        }
    }
    free(Af); free(Bf); free(Cf);
#else
    typedef __attribute__((address_space(3))) unsigned char* ldsp_t;
    ldsp_t lds = (ldsp_t)lds_;
    const int tid = threadIdx.x, wid = __builtin_amdgcn_readfirstlane(tid >> 6), lane = tid & 63, wr = wid >> 2, wc = wid & 3, fr = lane & 15, fq = lane >> 4;
    const int K = g.K, nt = K / BK;
    unsigned voffA[2], voffB[2];
#pragma unroll
    for (int i = 0; i < 2; ++i) { int R, C; stage_rc(tid * 16 + i * 8192, R, C); const int Rb = Epi::PERM ? ((R & ~31) + perm32(R & 31)) : R;
        voffA[i] = (unsigned)(R * g.lda + C) * 2u; voffB[i] = (unsigned)(Rb * g.ldb + C) * 2u; }
    const size_t kstep = (size_t)(BK * 2);
    const size_t hstepA = (size_t)HALF * g.lda * 2, hstepB = (size_t)HALF * g.ldb * 2;
    const unsigned ldsw = (unsigned)wid * 1024u;
    const int aoff = lds_byte(wr * 64 + fr, fq * 8), boff = lds_byte(wc * 32 + fr, fq * 8);
#define PG8_SA(b, h) (((b) * 2 + (h)) * HTB)
#define PG8_SB(b, h) ((4 + (b) * 2 + (h)) * HTB)
#define PG8_STAGE(bufoff, gbase, voff) do { _Pragma("unroll") for (int _i = 0; _i < 2; ++_i) \
        __builtin_amdgcn_global_load_lds((const unsigned*)((const char*)(gbase) + (voff)[_i]), (__attribute__((address_space(3))) unsigned*)(lds + (bufoff) + ldsw + _i * 8192), 16, 0, 0); } while (0)
#define PG8_LDA(dst, b, h) do { _Pragma("unroll") for (int m = 0; m < 4; ++m) _Pragma("unroll") for (int k = 0; k < 2; ++k) dst[m][k] = *(const __attribute__((address_space(3))) bf16x8*)(lds + PG8_SA(b, h) + aoff + m * 2048 + k * 1024); } while (0)
#define PG8_LDB(dst, b, h) do { _Pragma("unroll") for (int n = 0; n < 2; ++n) _Pragma("unroll") for (int k = 0; k < 2; ++k) dst[n][k] = *(const __attribute__((address_space(3))) bf16x8*)(lds + PG8_SB(b, h) + boff + n * 2048 + k * 1024); } while (0)
#define PG8_MMA(ai, bj, At, Bt) do { __builtin_amdgcn_s_setprio(1); _Pragma("unroll") for (int m = 0; m < 4; ++m) _Pragma("unroll") for (int n = 0; n < 2; ++n) _Pragma("unroll") for (int k = 0; k < 2; ++k) \
        acc[ai][bj][m][n] = __builtin_amdgcn_mfma_f32_16x16x32_bf16(Bt[n][k], At[m][k], acc[ai][bj][m][n], 0, 0, 0); __builtin_amdgcn_s_setprio(0); } while (0)
#define PG8_WAIT_V(n) asm volatile("s_waitcnt vmcnt(" #n ")" ::: "memory")
#define PG8_WAIT_L(n) asm volatile("s_waitcnt lgkmcnt(" #n ")" ::: "memory")
#define PG8_BAR __builtin_amdgcn_s_barrier()
#define PG8_SCHED __builtin_amdgcn_sched_barrier(0)
    Unit cur, nxt; int ui = 0;
    if (!S.next(0, cur)) return;
    f32x4 acc[2][2][4][2];
#pragma unroll
    for (int a = 0; a < 2; ++a)
#pragma unroll
        for (int b = 0; b < 2; ++b)
#pragma unroll
            for (int m = 0; m < 4; ++m)
#pragma unroll
                for (int n = 0; n < 2; ++n) acc[a][b][m][n] = (f32x4){0.f, 0.f, 0.f, 0.f};
    bf16x8 At[4][2], B0[2][2], B1[2][2];
    const char* cA = cur.A; const char* cB = cur.B;
    S.a_ready(cur);
    PG8_STAGE(PG8_SB(0, 0), cB, voffB); PG8_STAGE(PG8_SA(0, 0), cA, voffA); PG8_STAGE(PG8_SB(0, 1), cB + hstepB, voffB); PG8_STAGE(PG8_SA(0, 1), cA + hstepA, voffA);
    if (wr == 1) PG8_BAR;
    PG8_WAIT_V(4); PG8_BAR;
    PG8_STAGE(PG8_SB(1, 0), cB + kstep, voffB); PG8_STAGE(PG8_SA(1, 0), cA + kstep, voffA); PG8_STAGE(PG8_SB(1, 1), cB + hstepB + kstep, voffB);
    PG8_WAIT_V(6); PG8_BAR;
    for (;;) {
        const bool has_next = S.next(ui + 1, nxt);
        const char* nA = has_next ? nxt.A : cA; const char* nB = has_next ? nxt.B : cB;
        for (int t = 0; t < nt; t += 2) {
            const bool last = (t == nt - 2);
            const char* a1 = cA + (size_t)(t + 1) * kstep;
            const char* a2 = last ? nA : cA + (size_t)(t + 2) * kstep; const char* b2 = last ? nB : cB + (size_t)(t + 2) * kstep;
            const char* a3 = a2 + kstep; const char* b3 = b2 + kstep;
            if (last && has_next) S.a_ready(nxt);
            PG8_LDB(B0, 0, 0); PG8_SCHED; PG8_LDA(At, 0, 0); PG8_STAGE(PG8_SA(1, 1), a1 + hstepA, voffA);
            PG8_WAIT_L(8); PG8_BAR; PG8_WAIT_L(0); PG8_MMA(0, 0, At, B0); PG8_BAR; PG8_SCHED;
            PG8_LDB(B1, 0, 1); PG8_STAGE(PG8_SB(0, 0), b2, voffB);
            PG8_BAR; PG8_WAIT_L(0); PG8_MMA(0, 1, At, B1); PG8_BAR;
            PG8_LDA(At, 0, 1); PG8_STAGE(PG8_SA(0, 0), a2, voffA);
            PG8_BAR; PG8_WAIT_L(0); PG8_MMA(1, 0, At, B0); PG8_BAR; PG8_SCHED;
            PG8_STAGE(PG8_SB(0, 1), b2 + hstepB, voffB);
            PG8_WAIT_V(6); PG8_BAR; PG8_MMA(1, 1, At, B1); PG8_BAR;
            PG8_LDB(B0, 1, 0); PG8_SCHED; PG8_LDA(At, 1, 0); PG8_STAGE(PG8_SA(0, 1), a2 + hstepA, voffA);
            PG8_WAIT_L(8); PG8_BAR; PG8_WAIT_L(0); PG8_MMA(0, 0, At, B0); PG8_BAR; PG8_SCHED;
            PG8_LDB(B1, 1, 1); PG8_STAGE(PG8_SB(1, 0), b3, voffB);
            PG8_BAR; PG8_WAIT_L(0); PG8_MMA(0, 1, At, B1); PG8_BAR;
            PG8_LDA(At, 1, 1); PG8_STAGE(PG8_SA(1, 0), a3, voffA);
            PG8_BAR; PG8_WAIT_L(0); PG8_MMA(1, 0, At, B0); PG8_BAR; PG8_SCHED;
            PG8_STAGE(PG8_SB(1, 1), b3 + hstepB, voffB);
            PG8_WAIT_V(6); PG8_BAR; PG8_MMA(1, 1, At, B1); PG8_BAR;
        }
        E(acc, cur, wr, wc, fr, fq); S.done(cur);
        if (!has_next) break;
#pragma unroll
        for (int a = 0; a < 2; ++a)
#pragma unroll
            for (int b = 0; b < 2; ++b)
#pragma unroll
                for (int m = 0; m < 4; ++m)
#pragma unroll
                    for (int n = 0; n < 2; ++n) acc[a][b][m][n] = (f32x4){0.f, 0.f, 0.f, 0.f};
        cur = nxt; cA = nA; cB = nB; ++ui;
    }
    PG8_WAIT_V(0);
    if (wr == 0) PG8_BAR;
    PG8_BAR;
#undef PG8_SA
#undef PG8_SB
#undef PG8_STAGE
#undef PG8_LDA
#undef PG8_LDB
#undef PG8_MMA
#undef PG8_WAIT_V
#undef PG8_WAIT_L
#undef PG8_BAR
#undef PG8_SCHED
#endif
}

struct StaticOrder {
    int nM, nN, nwg, G, c; const char* A; const char* B; size_t tstepA, tstepB;
    __device__ __forceinline__ void init(int M, int N, int G_, int c_, const void* A_, const void* B_, int lda, int ldb) { nM = M / BM; nN = N / BM; nwg = nM * nN; G = G_; c = c_; A = (const char*)A_; B = (const char*)B_; tstepA = (size_t)BM * lda * 2; tstepB = (size_t)BM * ldb * 2; }
    __device__ __forceinline__ bool next(int i, Unit& u) const {
        const long L = (long)i * G + c; if (L >= nwg) return false;
        int wgid = (int)L; { const int q = nwg / 8, r = nwg % 8, xcd = wgid % 8, off = wgid / 8; wgid = (xcd < r ? xcd * (q + 1) : r * (q + 1) + (xcd - r) * q) + off; }
        const int nig = 8 * nN, gid = wgid / nig, fm = gid * 8, gsz = (nM - fm) < 8 ? (nM - fm) : 8;
        u.pm = fm + ((wgid % nig) % gsz); u.pn = (wgid % nig) / gsz; u.aux = 0; u.A = A + (size_t)u.pm * tstepA; u.B = B + (size_t)u.pn * tstepB; return true;
    }
    __device__ __forceinline__ void a_ready(const Unit&) const {}
    __device__ __forceinline__ void done(const Unit&) const {}
};
struct MergeOrder {
    StaticOrder so; int kseg_bytes;
    __device__ __forceinline__ bool next(int i, Unit& u) const { if (!so.next(i >> 2, u)) return false; u.aux = i & 3; u.A += (size_t)u.aux * kseg_bytes; u.B += (size_t)u.aux * kseg_bytes; return true; }
    __device__ __forceinline__ void a_ready(const Unit&) const {}
    __device__ __forceinline__ void done(const Unit&) const {}
};
struct MoeOrder {
    int G, c, ncol; const int* plan; const char* A; const char* B; size_t tstepA, tstepB, estep;
    __device__ __forceinline__ bool next(int i, Unit& u) const {
        const long L = (long)i * G + c; const int nblk = plan[40]; if (L >= (long)nblk * ncol) return false;
        u.pm = (int)(L / ncol); u.pn = (int)(L % ncol); u.aux = plan[64 + u.pm]; u.A = A + (size_t)u.pm * tstepA; u.B = B + (size_t)u.aux * estep + (size_t)u.pn * tstepB; return true;
    }
    __device__ __forceinline__ void a_ready(const Unit&) const {}
    __device__ __forceinline__ void done(const Unit&) const {}
};

__device__ __forceinline__ u32x4 pack8(const f32x4 v0, const f32x4 v1) { u32x4 w; w[0] = pk2(v0[0], v0[1]); w[1] = pk2(v0[2], v0[3]); w[2] = pk2(v1[0], v1[1]); w[3] = pk2(v1[2], v1[3]); return w; }
struct EpiBf16 {
    static constexpr bool PERM = true; bf16_t* O; int ldc;
    __device__ __forceinline__ void operator()(const f32x4 (&acc)[2][2][4][2], const Unit& u, int wr, int wc, int fr, int fq) const {
        const int row0 = u.pm * BM + wr * 64 + fr, col0 = u.pn * BM + wc * 32 + 8 * fq;
#pragma unroll
        for (int ai = 0; ai < 2; ++ai)
#pragma unroll
            for (int m = 0; m < 4; ++m) { bf16_t* rowp = O + (size_t)(row0 + ai * HALF + m * 16) * ldc + col0;
#pragma unroll
                for (int bj = 0; bj < 2; ++bj) *(u32x4*)(rowp + bj * HALF) = pack8(acc[ai][bj][m][0], acc[ai][bj][m][1]); }
    }
};
struct EpiMerge {
    static constexpr bool PERM = true; const bf16_t* P; float* PART; bf16_t* MRG;
    __device__ __forceinline__ void operator()(const f32x4 (&acc)[2][2][4][2], const Unit& u, int wr, int wc, int fr, int fq) const {
        const int row0 = u.pm * BM + wr * 64 + fr, col0 = u.pn * BM + wc * 32 + 8 * fq, seg = u.aux;
#pragma unroll
        for (int ai = 0; ai < 2; ++ai)
#pragma unroll
            for (int m = 0; m < 4; ++m) { const size_t r = (size_t)(row0 + ai * HALF + m * 16);
#pragma unroll
                for (int bj = 0; bj < 2; ++bj) { const int cc = col0 + bj * HALF;
                    const u32x4 gw = *(const u32x4*)(P + r * PW + C_MLP + seg * D + cc);
                    f32x4 v0, v1;
#pragma unroll
                    for (int q = 0; q < 2; ++q) { v0[2 * q] = sigmoidf_(bflo(gw[q])) * acc[ai][bj][m][0][2 * q]; v0[2 * q + 1] = sigmoidf_(bfhi(gw[q])) * acc[ai][bj][m][0][2 * q + 1];
                        v1[2 * q] = sigmoidf_(bflo(gw[2 + q])) * acc[ai][bj][m][1][2 * q]; v1[2 * q + 1] = sigmoidf_(bfhi(gw[2 + q])) * acc[ai][bj][m][1][2 * q + 1]; }
                    float* pp = PART + r * D + cc;
                    if (seg > 0) { v0 += *(const f32x4*)pp; v1 += *(const f32x4*)(pp + 4); }
                    if (seg < 3) { *(f32x4*)pp = v0; *(f32x4*)(pp + 4) = v1; } else *(u32x4*)(MRG + r * D + cc) = pack8(v0, v1);
                }
#ifndef CPU_EMU
                asm volatile("" ::: "memory");
#endif
            }
    }
};
struct EpiResid {
    static constexpr bool PERM = false; const float* xin; const float* g1; float* xmid;
    __device__ __forceinline__ void operator()(const f32x4 (&acc)[2][2][4][2], const Unit& u, int wr, int wc, int fr, int fq) const {
        const int row0 = u.pm * BM + wr * 64 + fr, col0 = u.pn * BM + wc * 32 + 4 * fq;
#pragma unroll
        for (int ai = 0; ai < 2; ++ai)
#pragma unroll
            for (int m = 0; m < 4; ++m) { const int r = row0 + ai * HALF + m * 16; const float* gp = g1 + (size_t)(r / S) * D6;
#pragma unroll
                for (int bj = 0; bj < 2; ++bj)
#pragma unroll
                    for (int n = 0; n < 2; ++n) { const int cc = col0 + bj * HALF + n * 16; *(f32x4*)(xmid + (size_t)r * D + cc) = *(const f32x4*)(xin + (size_t)r * D + cc) + *(const f32x4*)(gp + cc) * acc[ai][bj][m][n]; }
#ifndef CPU_EMU
                asm volatile("" ::: "memory");
#endif
            }
    }
};
struct EpiGU {
    static constexpr bool PERM = true; bf16_t* ACT;
    __device__ __forceinline__ void operator()(const f32x4 (&acc)[2][2][4][2], const Unit& u, int wr, int wc, int fr, int fq) const {
        const int row0 = u.pm * BM + wr * 64 + fr, col0 = u.pn * HALF + wc * 32 + 8 * fq;
#pragma unroll
        for (int ai = 0; ai < 2; ++ai)
#pragma unroll
            for (int m = 0; m < 4; ++m) { f32x4 v0, v1;
#pragma unroll
                for (int j = 0; j < 4; ++j) { v0[j] = siluf_(acc[ai][0][m][0][j]) * acc[ai][1][m][0][j]; v1[j] = siluf_(acc[ai][0][m][1][j]) * acc[ai][1][m][1][j]; }
                *(u32x4*)(ACT + (size_t)(row0 + ai * HALF + m * 16) * 512 + col0) = pack8(v0, v1); }
    }
};
}

__device__ __forceinline__ void ph_lru_gate(const Ctx& c, int l, float* ldsf) {
    const bf16_t* P = WSH(O_P); const float* cw = c.in[8] + (size_t)l * 4 * W; const float* cb = c.in[9] + (size_t)l * W;
    const float* br = c.in[11] + (size_t)l * 2 * W; const float* bi = c.in[13] + (size_t)l * 2 * W; const float* lam = c.in[14] + (size_t)l * 2 * W; const bf16_t* WLR = WSH(O_WLR);
    float* LA = WSF(O_LA); float* LU = WSF(O_LU);
    bf16_t* Xs = (bf16_t*)ldsf; bf16_t* Wr = Xs + 128 * 136; bf16_t* Wi = Wr + 128 * 136; float* spl = (float*)(Wi + 128 * 136);
    const int tid = threadIdx.x, wv = tid >> 6, lane = tid & 63, fr = lane & 15, fq = lane >> 4;
    for (int u = blockIdx.x; u < (T / 128) * 8; u += gridDim.x) {
        const int n = u & 7; const long t0 = (long)(u >> 3) * 128;
        if (tid < 256) spl[tid] = softplusf_(-lam[(tid >> 7) * W + n * 128 + (tid & 127)]);
#pragma unroll
        for (int q = 0; q < 8; ++q) { const int id = tid + NT * q, tl = id >> 5, e4 = (id & 31) * 4, ch = n * 128 + e4; const long t = t0 + tl; const int sI = (int)(t % S);
            f32x4 acc = *(const f32x4*)(cb + ch);
#pragma unroll
            for (int k = 0; k < 4; ++k) { const int ss = sI + k - 2; if (ss >= 0 && ss < S) acc += ld_bf4(P + (size_t)(t + k - 2) * PW + C_LX + ch) * *(const f32x4*)(cw + k * W + ch); }
            st_bf4(Xs + tl * 136 + e4, acc); }
        for (int z = 0; z < 2; ++z) {
#pragma unroll
            for (int q = 0; q < 4; ++q) { const int id = tid + NT * q, f = id >> 4, e8 = (id & 15) * 8;
                *(u32x4*)(Wr + f * 136 + e8) = *(const u32x4*)(WLR + ((size_t)((z * 2 + 0) * 8 + n) * 128 + f) * 128 + e8); *(u32x4*)(Wi + f * 136 + e8) = *(const u32x4*)(WLR + ((size_t)((z * 2 + 1) * 8 + n) * 128 + f) * 128 + e8); }
            SYNCTHREADS();
            f32x4 ar[8], ai[8];
#pragma unroll
            for (int nt = 0; nt < 8; ++nt) { ar[nt] = (f32x4){0.f, 0.f, 0.f, 0.f}; ai[nt] = (f32x4){0.f, 0.f, 0.f, 0.f}; }
            wave_mma<4, 8>(ar, Xs + wv * 16 * 136, 136, Wr, 136);
            wave_mma<4, 8>(ai, Xs + wv * 16 * 136, 136, Wi, 136);
            const int tl = wv * 16 + fr;
#pragma unroll
            for (int nt = 0; nt < 8; ++nt) { const int f = 16 * nt + 4 * fq, ch = n * 128 + f;
                const f32x4 brv = *(const f32x4*)(br + z * W + ch), biv = *(const f32x4*)(bi + z * W + ch), lmv = *(const f32x4*)(spl + z * 128 + f), xcv = ld_bf4(Xs + tl * 136 + f); f32x4 av, uv;
#pragma unroll
                for (int e = 0; e < 4; ++e) { const float r = sigmoidf_(ar[nt][e] + brv[e]), ig = sigmoidf_(ai[nt][e] + biv[e]), la = -8.f * r * lmv[e]; const float a = fexp_(la); av[e] = a; uv[e] = sqrtf(fmaxf(1.f - a * a, 0.f)) * ig * xcv[e]; }
                *(f32x4*)(LA + ((size_t)z * T + t0 + tl) * W + ch) = av; *(f32x4*)(LU + ((size_t)z * T + t0 + tl) * W + ch) = uv; }
            SYNCTHREADS();
        }
    }
}
__device__ __forceinline__ void ph_lru_scan1(const Ctx& c) {
    const float* LA = WSF(O_LA); const float* LU = WSF(O_LU); float* CA = WSF(O_LCA); float* CH = WSF(O_LCH);
    for (long i = GT_; i < (long)2 * NB * NLC * W; i += GS_) {
        const int w = (int)(i % W), ch = (int)((i / W) % NLC), b = (int)((i / ((long)W * NLC)) % NB), z = (int)(i / ((long)W * NLC * NB));
        const long t0 = (long)b * S + ch * 64; float prod = 1.f, h = 0.f;
#pragma unroll 16
        for (int q = 0; q < 64; ++q) { const int s = z == 0 ? q : 63 - q; const size_t idx = ((size_t)z * T + t0 + s) * W + w; const float a = LA[idx]; h = a * h + LU[idx]; prod *= a; }
        CA[i] = prod; CH[i] = h;
    }
}
__device__ __forceinline__ void ph_lru_scan2(const Ctx& c) {
    const float* CA = WSF(O_LCA); const float* CH = WSF(O_LCH); float* CI = WSF(O_LCI);
    for (long i = GT_; i < (long)2 * NB * W; i += GS_) {
        const int w = (int)(i % W), b = (int)((i / W) % NB), z = (int)(i / ((long)W * NB)); float carry = 0.f;
        for (int q = 0; q < NLC; ++q) { const int ch = z == 0 ? q : NLC - 1 - q; const size_t idx = (((size_t)z * NB + b) * NLC + ch) * W + w; CI[idx] = carry; carry = CA[idx] * carry + CH[idx]; }
    }
}
__device__ __forceinline__ void ph_lru_scan3(const Ctx& c) {
    const float* LA = WSF(O_LA); const float* LU = WSF(O_LU); const float* CI = WSF(O_LCI); const bf16_t* P = WSH(O_P); float* HFW = WSF(O_XC); bf16_t* Y = WSH(O_YS);
    for (long i = GT_; i < (long)NB * NLC * W; i += GS_) {
        const int w = (int)(i % W), ch = (int)((i / W) % NLC), b = (int)(i / ((long)W * NLC)); const long t0 = (long)b * S + ch * 64;
        float h = CI[(((size_t)0 * NB + b) * NLC + ch) * W + w];
#pragma unroll 16
        for (int s = 0; s < 64; ++s) { const size_t idx = ((size_t)(t0 + s)) * W + w; h = LA[idx] * h + LU[idx]; HFW[idx] = h; }
        h = CI[(((size_t)1 * NB + b) * NLC + ch) * W + w];
#pragma unroll 8
        for (int s = 63; s >= 0; --s) { const size_t idx = ((size_t)(t0 + s)) * W + w; h = LA[(size_t)T * W + idx] * h + LU[(size_t)T * W + idx];
            Y[(size_t)(t0 + s) * 4 * W + 0 * W + w] = (bf16_t)f2bf((HFW[idx] + h) * geluf_(PF(P, t0 + s, C_LG + w))); }
    }
}
__device__ __forceinline__ void ret_tables(float* tab, int h) {
    const int tid = threadIdx.x; const float lg = loggamma_(h);
    if (tid < 32) tab[tid] = powf(10000.f, -(float)(2 * tid) / 64.f);
    if (tid >= 64 && tid < 64 + 129) tab[tid] = expf((float)(tid - 64) * lg);
}
__device__ __forceinline__ void ph_ret_kv(const Ctx& c, float* ldsf) {
    const int* pos = (const int*)c.in[2]; const bf16_t* P = WSH(O_P); float* KVF = WSF(O_KVF); float* KVB = WSF(O_KVB);
    bf16_t* VT = (bf16_t*)ldsf; bf16_t* KF = VT + 128 * 136; bf16_t* KB = KF + 64 * 136; float* tab = (float*)(KB + 64 * 136);
    const int tid = threadIdx.x, wv = tid >> 6, lane = tid & 63, fr = lane & 15, fq = lane >> 4;
    for (int u = blockIdx.x; u < (T / 128) * 8; u += gridDim.x) {
        const int h = u & 7; const long t0 = (long)(u >> 3) * 128;
        ret_tables(tab, h);
        SYNCTHREADS();
        { float x1[8], x2[8], pj[8];
#pragma unroll
          for (int q = 0; q < 8; ++q) { const int id = tid + NT * q, j = id & 127, dj = id >> 7; const bf16_t* prow = P + (size_t)(t0 + j) * PW + C_RK + h * 64; x1[q] = bf2f(prow[dj]); x2[q] = bf2f(prow[dj + 32]); pj[q] = (float)pos[t0 + j]; }
#pragma unroll 1
          for (int q = 0; q < 8; ++q) { const int id = tid + NT * q, j = id & 127, dj = id >> 7; const float ang = pj[q] * tab[dj]; const float cs = cosf(ang), sn = sinf(ang);
            const float k1 = x1[q] * cs - x2[q] * sn, k2 = x2[q] * cs + x1[q] * sn, fj = tab[64 + 127 - j], bj = tab[64 + j];
            KF[dj * 136 + j] = (bf16_t)f2bf(k1 * fj); KF[(dj + 32) * 136 + j] = (bf16_t)f2bf(k2 * fj); KB[dj * 136 + j] = (bf16_t)f2bf(k1 * bj); KB[(dj + 32) * 136 + j] = (bf16_t)f2bf(k2 * bj); } }
#pragma unroll
        for (int q = 0; q < 4; ++q) { const int id = tid + NT * q, j = id & 127, e8 = (id >> 7) * 8; const u32x4 raw = *(const u32x4*)(P + (size_t)(t0 + j) * PW + C_RV + h * 128 + e8);
#pragma unroll
            for (int e = 0; e < 4; ++e) { VT[(e8 + 2 * e) * 136 + j] = (bf16_t)(raw[e] & 0xffffu); VT[(e8 + 2 * e + 1) * 136 + j] = (bf16_t)(raw[e] >> 16); } }
        SYNCTHREADS();
        f32x4 af[4], ab[4];
#pragma unroll
        for (int nt = 0; nt < 4; ++nt) { af[nt] = (f32x4){0.f, 0.f, 0.f, 0.f}; ab[nt] = (f32x4){0.f, 0.f, 0.f, 0.f}; }
        wave_mma<4, 4>(af, VT + wv * 16 * 136, 136, KF, 136);
        wave_mma<4, 4>(ab, VT + wv * 16 * 136, 136, KB, 136);
        const size_t ob = (((size_t)(u >> 3) * 8 + h) * 128 + wv * 16 + fr) * 64 + 4 * fq;
#pragma unroll
        for (int nt = 0; nt < 4; ++nt) { *(f32x4*)(KVF + ob + 16 * nt) = af[nt]; *(f32x4*)(KVB + ob + 16 * nt) = ab[nt]; }
        SYNCTHREADS();
    }
}
__device__ __forceinline__ void ph_ret_state(const Ctx& c) {
    const float* KVF = WSF(O_KVF); const float* KVB = WSF(O_KVB); float* STF = WSF(O_STF); float* STB = WSF(O_STB);
    for (long i = GT_; i < (long)NB * 8 * 8192; i += GS_) {
        const int x = (int)(i % 8192), h = (int)((i / 8192) % 8), b = (int)(i / 65536);
        const float cd = expf(128.f * loggamma_(h)); float st = 0.f;
#pragma unroll 8
        for (int n = 0; n < NCH; ++n) { const size_t idx = (((size_t)b * NCH + n) * 8 + h) * 8192 + x; STF[idx] = st; st = cd * st + KVF[idx]; }
        st = 0.f;
#pragma unroll 8
        for (int n = NCH - 1; n >= 0; --n) { const size_t idx = (((size_t)b * NCH + n) * 8 + h) * 8192 + x; STB[idx] = st; st = cd * st + KVB[idx]; }
    }
}
__device__ __forceinline__ void ph_ret_out(const Ctx& c, float* ldsf) {
    const int* pos = (const int*)c.in[2]; const bf16_t* P = WSH(O_P); const float* STF = WSF(O_STF); const float* STB = WSF(O_STB); bf16_t* Y = WSH(O_YS);
    bf16_t* Qs = (bf16_t*)ldsf; bf16_t* Ks = Qs + 128 * 72; bf16_t* VT = Ks + 128 * 72; bf16_t* Ss = VT + 128 * 136; bf16_t* SF = Ss + 128 * 136; bf16_t* SB = SF + 128 * 72; float* tab = (float*)(SB + 128 * 72);
    const int tid = threadIdx.x, wv = tid >> 6, lane = tid & 63, fr = lane & 15, fq = lane >> 4;
    for (int u = blockIdx.x; u < (T / 128) * 8; u += gridDim.x) {
        const int h = u & 7; const long t0 = (long)(u >> 3) * 128;
        ret_tables(tab, h);
        SYNCTHREADS();
#pragma unroll 1
        for (int qh = 0; qh < 8; qh += 4) { float q1[4], q2[4], k1[4], k2[4], pj[4];
#pragma unroll
          for (int q = 0; q < 4; ++q) { const int id = tid + NT * (qh + q), j = id >> 5, dj = id & 31; const bf16_t* prow = P + (size_t)(t0 + j) * PW;
            q1[q] = bf2f(prow[C_RQ + h * 64 + dj]); q2[q] = bf2f(prow[C_RQ + h * 64 + dj + 32]); k1[q] = bf2f(prow[C_RK + h * 64 + dj]); k2[q] = bf2f(prow[C_RK + h * 64 + dj + 32]); pj[q] = (float)pos[t0 + j]; }
#pragma unroll
          for (int q = 0; q < 4; ++q) { const int id = tid + NT * (qh + q), j = id >> 5, dj = id & 31; const float ang = pj[q] * tab[dj]; const float cs = cosf(ang), sn = sinf(ang);
            Qs[j * 72 + dj] = (bf16_t)f2bf((q1[q] * cs - q2[q] * sn) * 0.125f); Qs[j * 72 + dj + 32] = (bf16_t)f2bf((q2[q] * cs + q1[q] * sn) * 0.125f); Ks[j * 72 + dj] = (bf16_t)f2bf(k1[q] * cs - k2[q] * sn); Ks[j * 72 + dj + 32] = (bf16_t)f2bf(k2[q] * cs + k1[q] * sn); } }
#pragma unroll
        for (int q = 0; q < 4; ++q) { const int id = tid + NT * q, j = id & 127, e8 = (id >> 7) * 8; const u32x4 raw = *(const u32x4*)(P + (size_t)(t0 + j) * PW + C_RV + h * 128 + e8);
#pragma unroll
            for (int e = 0; e < 4; ++e) { VT[(e8 + 2 * e) * 136 + j] = (bf16_t)(raw[e] & 0xffffu); VT[(e8 + 2 * e + 1) * 136 + j] = (bf16_t)(raw[e] >> 16); } }
        const size_t sbase = (((size_t)(u >> 3) * 8 + h)) * 8192;
#pragma unroll
        for (int q = 0; q < 4; ++q) { const int id = tid + NT * q, e = id >> 4, d4 = (id & 15) * 4; st_bf4(SF + e * 72 + d4, *(const f32x4*)(STF + sbase + (size_t)e * 64 + d4)); st_bf4(SB + e * 72 + d4, *(const f32x4*)(STB + sbase + (size_t)e * 64 + d4)); }
        SYNCTHREADS();
        const int i = wv * 16 + fr; const long t = t0 + i;
        {
            f32x4 sc[8];
#pragma unroll
            for (int nt = 0; nt < 8; ++nt) sc[nt] = (f32x4){0.f, 0.f, 0.f, 0.f};
            wave_mma<2, 8>(sc, Qs + wv * 16 * 72, 72, Ks, 72);
#pragma unroll
            for (int nt = 0; nt < 8; ++nt) { const int j0 = 16 * nt + 4 * fq; f32x4 sv;
#pragma unroll
                for (int e = 0; e < 4; ++e) { const int j = j0 + e, dist = i > j ? i - j : j - i; sv[e] = sc[nt][e] * tab[64 + dist]; }
                st_bf4(Ss + i * 136 + j0, sv); }
        }
#ifdef CPU_EMU
        SYNCTHREADS();
#else
        asm volatile("s_waitcnt lgkmcnt(0)" ::: "memory");
#endif
        f32x4 ao[8], tm[8];
#pragma unroll
        for (int nt = 0; nt < 8; ++nt) { ao[nt] = (f32x4){0.f, 0.f, 0.f, 0.f}; tm[nt] = (f32x4){0.f, 0.f, 0.f, 0.f}; }
        wave_mma<4, 8>(ao, Ss + wv * 16 * 136, 136, VT, 136);
        wave_mma<2, 8>(tm, Qs + wv * 16 * 72, 72, SF, 72);
        { const float qf = tab[64 + i + 1];
#pragma unroll
            for (int nt = 0; nt < 8; ++nt) { ao[nt] += tm[nt] * qf; tm[nt] = (f32x4){0.f, 0.f, 0.f, 0.f}; } }
        wave_mma<2, 8>(tm, Qs + wv * 16 * 72, 72, SB, 72);
        { const float qb = tab[64 + 128 - i];
#pragma unroll
            for (int nt = 0; nt < 8; ++nt) ao[nt] += tm[nt] * qb; }
        float sm = 0.f;
#pragma unroll
        for (int nt = 0; nt < 8; ++nt) sm += (ao[nt][0] + ao[nt][1]) + (ao[nt][2] + ao[nt][3]);
        sm += SHFL_XOR(sm, 16); sm += SHFL_XOR(sm, 32);
        const float mu = sm * (1.f / 128.f); float sq = 0.f;
#pragma unroll
        for (int nt = 0; nt < 8; ++nt) { ao[nt] -= mu; sq += (ao[nt][0] * ao[nt][0] + ao[nt][1] * ao[nt][1]) + (ao[nt][2] * ao[nt][2] + ao[nt][3] * ao[nt][3]); }
        sq += SHFL_XOR(sq, 16); sq += SHFL_XOR(sq, 32);
        const float rs = 1.f / sqrtf(sq * (1.f / 128.f) + EPS);
#pragma unroll
        for (int nt = 0; nt < 8; ++nt) { const int e0 = 16 * nt + 4 * fq; f32x4 gv = ld_bf4(P + (size_t)t * PW + C_RG + h * 128 + e0);
#pragma unroll
            for (int e = 0; e < 4; ++e) gv[e] = siluf_(gv[e]) * (ao[nt][e] * rs);
            st_bf4(Y + (size_t)t * 4 * W + 1 * W + h * 128 + e0, gv); }
        SYNCTHREADS();
    }
}
__device__ __forceinline__ void ph_sgu_norm(const Ctx& c, int l) {
    const bf16_t* P = WSH(O_P); float* ST = WSF(O_VN);
    const int lane = threadIdx.x & 63, gw = blockIdx.x * (NT / 64) + (threadIdx.x >> 6), ngw = gridDim.x * (NT / 64);
    for (int t = gw; t < T; t += ngw) {
        f32x4 v[4]; float sm = 0.f;
#pragma unroll
        for (int j = 0; j < 4; ++j) { v[j] = ld_bf4(P + (size_t)t * PW + C_SV + (j * 64 + lane) * 4);
#pragma unroll
            for (int q = 0; q < 4; ++q) { v[j][q] = geluf_(v[j][q]); sm += v[j][q]; } }
        const float mu = wave_sum(sm) * (1.f / W); float sq = 0.f;
#pragma unroll
        for (int j = 0; j < 4; ++j)
#pragma unroll
            for (int q = 0; q < 4; ++q) { const float dd = v[j][q] - mu; sq += dd * dd; }
        const float rs = 1.f / sqrtf(wave_sum(sq) * (1.f / W) + EPS);
        if (lane == 0) { ST[(size_t)t * 2] = mu; ST[(size_t)t * 2 + 1] = rs; }
    }
}
__device__ __forceinline__ void ph_sgu_mix(const Ctx& c, int l, float* ldsf) {
    const bf16_t* P = WSH(O_P); const float* ST = WSF(O_VN); bf16_t* Y = WSH(O_YS); const float* ng = c.in[15] + (size_t)l * W;
    bf16_t* As = (bf16_t*)ldsf; bf16_t* Bs = As + 128 * 136; const int tid = threadIdx.x, wv = tid >> 6, lane = tid & 63, fr = lane & 15, fq = lane >> 4;
    for (int u = blockIdx.x; u < (T / 128) * 8; u += gridDim.x) {
        const int g = u & 7; const long t0 = (long)(u >> 3) * 128;
        const float* ws = c.in[16] + ((size_t)l * 8 + g) * 128 * 128; const float* bs = c.in[17] + ((size_t)l * 8 + g) * 128;
#pragma unroll
        for (int q = 0; q < 8; ++q) { const int id = tid + NT * q, i = id >> 5, j4 = (id & 31) * 4; st_bf4(As + i * 136 + j4, *(const f32x4*)(ws + i * 128 + j4)); }
#pragma unroll
        for (int q = 0; q < 4; ++q) { const int id = tid + NT * q, j = id & 127, d8 = (id >> 7) * 8; const float mu = ST[(size_t)(t0 + j) * 2], rs = ST[(size_t)(t0 + j) * 2 + 1];
            const u32x4 raw = *(const u32x4*)(P + (size_t)(t0 + j) * PW + C_SV + g * 128 + d8);
#pragma unroll
            for (int e = 0; e < 4; ++e) { const float v0 = (geluf_(bflo(raw[e])) - mu) * rs * ng[g * 128 + d8 + 2 * e], v1 = (geluf_(bfhi(raw[e])) - mu) * rs * ng[g * 128 + d8 + 2 * e + 1];
                Bs[(d8 + 2 * e) * 136 + j] = (bf16_t)f2bf(v0); Bs[(d8 + 2 * e + 1) * 136 + j] = (bf16_t)f2bf(v1); } }
        SYNCTHREADS();
        f32x4 acc[8];
#pragma unroll
        for (int nt = 0; nt < 8; ++nt) acc[nt] = (f32x4){0.f, 0.f, 0.f, 0.f};
        wave_mma<4, 8>(acc, As + wv * 16 * 136, 136, Bs, 136);
        const int i = wv * 16 + fr; const long t = t0 + i; const float bsi = bs[i];
#pragma unroll
        for (int nt = 0; nt < 8; ++nt) { const int d = 16 * nt + 4 * fq; f32x4 uu = ld_bf4(P + (size_t)t * PW + C_SU + g * 128 + d);
#pragma unroll
            for (int e = 0; e < 4; ++e) uu[e] = geluf_(uu[e]) * (acc[nt][e] + bsi);
            st_bf4(Y + (size_t)t * 4 * W + 2 * W + g * 128 + d, uu); }
        SYNCTHREADS();
    }
}
__device__ __forceinline__ void ph_rw_shift(const Ctx& c, int l) {
    const bf16_t* P = WSH(O_P); const float* mup = c.in[18] + (size_t)l * RF; const float* mun = c.in[19] + (size_t)l * RF; bf16_t* FS = WSH(O_FS);
    const int lane = threadIdx.x & 63, gw = blockIdx.x * (NT / 64) + (threadIdx.x >> 6), ngw = gridDim.x * (NT / 64);
    for (int t = gw; t < T; t += ngw) {
        const int sI = t % S; const bf16_t* pc = P + (size_t)t * PW + C_RW;
#pragma unroll 2
        for (int j = lane * 4; j < RF; j += 256) {
            const f32x4 f = ld_bf4(pc + j), z4 = (f32x4){0.f, 0.f, 0.f, 0.f}; const f32x4 pv = sI > 0 ? ld_bf4(pc - PW + j) : z4, nv = sI < S - 1 ? ld_bf4(pc + PW + j) : z4;
            f32x4 v = f + *(const f32x4*)(mup + j) * (pv - f) + *(const f32x4*)(mun + j) * (nv - f);
            if (j >= 3072 && j < 3200) {
#pragma unroll
                for (int e = 0; e < 4; ++e) v[e] = tanhf_(v[e]); }
            else if (j >= 3328) {
#pragma unroll
                for (int e = 0; e < 4; ++e) v[e] = sigmoidf_(v[e]); }
            st_bf4(FS + (size_t)t * RF + j, v);
        }
    }
}
__device__ __forceinline__ void ph_rw_lora(const Ctx& c, int l, float* ldsf) {
    const bf16_t* FS = WSH(O_FS); const float* w0 = c.in[20] + (size_t)l * 2 * W; const float* a0 = c.in[22] + (size_t)l * 2 * W;
    const bf16_t* WUT = WSH(O_WUT); const bf16_t* WAT = WSH(O_WAT); const bf16_t* WGT = WSH(O_WGT);
    float* DEC = WSF(O_DEC); float* AA = WSF(O_AA); float* GG = WSF(O_GG);
    bf16_t* F = (bf16_t*)ldsf; bf16_t* B1 = F + 128 * 136; bf16_t* B2 = B1 + 128 * 136; const int tid = threadIdx.x, wv = tid >> 6, lane = tid & 63, fr = lane & 15, fq = lane >> 4;
    for (int u = blockIdx.x; u < (T / 128) * 8; u += gridDim.x) {
        const int wc0 = (u & 7) * 128; const long t0 = (long)(u >> 3) * 128;
        for (int rd = 0; rd < 3; ++rd) {
#pragma unroll
            for (int q = 0; q < 8; ++q) { const int id = tid + NT * q, r = id >> 5, c4 = (id & 31) * 4;
                const int col = rd < 2 ? (c4 < 64 ? 3072 + rd * 64 + c4 : 3200 + rd * 64 + (c4 - 64)) : 3328 + c4;
                *(unsigned long long*)(F + r * 136 + c4) = *(const unsigned long long*)(FS + (size_t)(t0 + r) * RF + col); }
            if (rd < 2) {
#pragma unroll
                for (int q = 0; q < 2; ++q) { const int id = tid + NT * q, w = id >> 3, r8 = (id & 7) * 8;
                    *(u32x4*)(B1 + w * 72 + r8) = *(const u32x4*)(WUT + ((size_t)rd * W + wc0 + w) * 64 + r8); *(u32x4*)(B2 + w * 72 + r8) = *(const u32x4*)(WAT + ((size_t)rd * W + wc0 + w) * 64 + r8); }
            } else {
#pragma unroll
                for (int q = 0; q < 4; ++q) { const int id = tid + NT * q, w = id >> 4, r8 = (id & 15) * 8; *(u32x4*)(B1 + w * 136 + r8) = *(const u32x4*)(WGT + ((size_t)wc0 + w) * 128 + r8); }
            }
            SYNCTHREADS();
            f32x4 a1[8], a2[8];
#pragma unroll
            for (int nt = 0; nt < 8; ++nt) { a1[nt] = (f32x4){0.f, 0.f, 0.f, 0.f}; a2[nt] = (f32x4){0.f, 0.f, 0.f, 0.f}; }
            const long t = t0 + wv * 16 + fr;
            if (rd < 2) {
                wave_mma<2, 8>(a1, F + wv * 16 * 136, 136, B1, 72);
                wave_mma<2, 8>(a2, F + wv * 16 * 136 + 64, 136, B2, 72);
#pragma unroll
                for (int nt = 0; nt < 8; ++nt) { const int ch = wc0 + 16 * nt + 4 * fq; const f32x4 w0v = *(const f32x4*)(w0 + rd * W + ch), a0v = *(const f32x4*)(a0 + rd * W + ch); f32x4 dv, av;
#pragma unroll
                    for (int e = 0; e < 4; ++e) { dv[e] = fexp_(-DECAY_SCALE * sigmoidf_(a1[nt][e] + w0v[e])); av[e] = sigmoidf_(a2[nt][e] + a0v[e]); }
                    *(f32x4*)(DEC + ((size_t)rd * T + t) * W + ch) = dv; *(f32x4*)(AA + ((size_t)rd * T + t) * W + ch) = av; }
            } else {
                wave_mma<4, 8>(a1, F + wv * 16 * 136, 136, B1, 136);
#pragma unroll
                for (int nt = 0; nt < 8; ++nt) *(f32x4*)(GG + (size_t)t * W + wc0 + 16 * nt + 4 * fq) = a1[nt];
            }
            SYNCTHREADS();
        }
    }
}
#ifdef CPU_EMU
__device__ __forceinline__ float red16_(float x) { x += SHFL_XOR(x, 1); x += SHFL_XOR(x, 2); x += SHFL_XOR(x, 4); x += SHFL_XOR(x, 8); return x; }
#define LDS_BARRIER() emu_syncthreads()
#else
__device__ __forceinline__ float red16_(float x) {
    x += __builtin_bit_cast(float, __builtin_amdgcn_update_dpp(0, __builtin_bit_cast(int, x), 0xB1, 0xF, 0xF, true));
    x += __builtin_bit_cast(float, __builtin_amdgcn_update_dpp(0, __builtin_bit_cast(int, x), 0x4E, 0xF, 0xF, true));
    x += __builtin_bit_cast(float, __builtin_amdgcn_update_dpp(0, __builtin_bit_cast(int, x), 0x141, 0xF, 0xF, true));
    x += __builtin_bit_cast(float, __builtin_amdgcn_update_dpp(0, __builtin_bit_cast(int, x), 0x140, 0xF, 0xF, true));
    return x;
}
#define LDS_BARRIER() do { asm volatile("s_waitcnt lgkmcnt(0)" ::: "memory"); __builtin_amdgcn_s_barrier(); asm volatile("" ::: "memory"); } while (0)
#endif
#define RC_M(k) (lm + (k) * 4608)
__device__ __forceinline__ void ph_rw_chunk(const Ctx& c, int l, float* ldsf) {
    const bf16_t* FS = WSH(O_FS); const float* DEC = WSF(O_DEC); const float* AA = WSF(O_AA); float* BON = WSF(O_BON);
    const float* kkw = c.in[25] + (size_t)l * W; const float* kaw = c.in[26] + (size_t)l * W; const float* rk = c.in[27] + (size_t)l * W;
    bf16_t* PST = WSH(O_PST); bf16_t* PYT = WSH(O_PYT); float* SVB = WSF(O_SVB); float* YVB = WSF(O_YVB);
    bf16_t* lm = (bf16_t*)ldsf; float* gam = (float*)RC_M(7); float* segp = (float*)RC_M(13); float* gl = segp + 512;
    const int tid = threadIdx.x, wv = tid >> 6, lane = tid & 63, fr = lane & 15, fq = lane >> 4, rt = wv & 3, hf = wv >> 2;
    const int m0 = 16 * rt + fr;
    for (int u = blockIdx.x; u < 64 * NRC; u += gridDim.x) {
        const int chain = u / NRC, ck = u % NRC, h = chain & 15, b = (chain >> 4) & 1, z = chain >> 5;
        const long tb = (long)b * S + (z ? S - 1 - ck * RCK : ck * RCK); const int dirn = z ? -1 : 1;
        const float* decp = DEC + ((size_t)z * T) * W + h * 64; const float* aap = AA + ((size_t)z * T) * W + h * 64;
        { const int k = tid & 63, sg = tid >> 6; float p = 1.f; float wv8[8];
#pragma unroll
          for (int q = 0; q < 8; ++q) wv8[q] = decp[(size_t)(tb + dirn * (sg * 8 + q)) * W + k];
#pragma unroll
          for (int q = 0; q < 8; ++q) { p *= wv8[q]; gam[(sg * 8 + q) * 64 + k] = p; }
          segp[sg * 64 + k] = p; }
        SYNCTHREADS();
        { const int k = tid & 63, sg = tid >> 6; float pre = 1.f;
          for (int q = 0; q < sg; ++q) pre *= segp[q * 64 + k];
#pragma unroll
          for (int q = 0; q < 8; ++q) gam[(sg * 8 + q) * 64 + k] *= pre;
          if (sg == 7) gl[k] = gam[63 * 64 + k]; }
        SYNCTHREADS();
        { const int k = lane, ch = h * 64 + k; const float kkwv = kkw[ch], kav = kaw[ch], rkv = rk[ch];
          float kv8[8], rv8[8], vv8[8], aa8[8];
#pragma unroll
          for (int q = 0; q < 8; ++q) { const long t = tb + dirn * (wv + 8 * q); const bf16_t* f = FS + (size_t)t * RF; kv8[q] = bf2f(f[1024 + ch]); rv8[q] = bf2f(f[ch]); vv8[q] = bf2f(f[2048 + ch]); aa8[q] = aap[(size_t)t * W + k]; }
#pragma unroll
          for (int q = 0; q < 8; ++q) { const int tt = wv + 8 * q; const long t = tb + dirn * tt;
            const float vk = kv8[q] * kkwv; const float kkn = vk * (1.f / sqrtf(wave_sum(vk * vk) + EPS)); const float ktv = kv8[q] * (1.f + (aa8[q] - 1.f) * kav);
            const float bsum = wave_sum(rv8[q] * rkv * ktv); if (lane == 0) BON[((size_t)z * T + t) * 16 + h] = bsum;
            const float g = gam[tt * 64 + k], gp = tt ? gam[(tt - 1) * 64 + k] : 1.f, ig = 1.f / g;
            const bf16_t khv = (bf16_t)f2bf(kkn * gp), bhv = (bf16_t)f2bf(aa8[q] * kkn * ig);
            RC_M(0)[tt * 72 + k] = khv; RC_M(1)[k * 72 + tt] = khv; RC_M(2)[tt * 72 + k] = bhv; RC_M(3)[k * 72 + tt] = bhv;
            RC_M(4)[tt * 72 + k] = (bf16_t)f2bf(ktv * ig); RC_M(5)[tt * 72 + k] = (bf16_t)f2bf(rv8[q] * g); RC_M(6)[k * 72 + tt] = (bf16_t)f2bf(vv8[q]); } }
        SYNCTHREADS();
        f32x4 mkr[2], khr[2], rhT[2];
        {
            f32x4 a0[2], a1[2], a2[2], a3[2];
#pragma unroll
            for (int nt = 0; nt < 2; ++nt) { a0[nt] = (f32x4){0.f, 0.f, 0.f, 0.f}; a1[nt] = a0[nt]; a2[nt] = a0[nt]; a3[nt] = a0[nt]; }
            wave_mma<2, 2>(a0, RC_M(2) + rt * 16 * 72, 72, RC_M(0) + hf * 32 * 72, 72);
            wave_mma<2, 2>(a1, RC_M(4) + rt * 16 * 72, 72, RC_M(0) + hf * 32 * 72, 72);
            wave_mma<2, 2>(a2, RC_M(2) + rt * 16 * 72, 72, RC_M(5) + hf * 32 * 72, 72);
            wave_mma<2, 2>(a3, RC_M(4) + rt * 16 * 72, 72, RC_M(5) + hf * 32 * 72, 72);
#pragma unroll
            for (int nt = 0; nt < 2; ++nt) { const int n0 = 32 * hf + 16 * nt + 4 * fq; f32x4 nn, ti, mk;
#pragma unroll
                for (int r = 0; r < 4; ++r) { const int n = n0 + r; const bool lt = m0 < n, le = m0 <= n;
                    nn[r] = lt ? -a0[nt][r] : 0.f; ti[r] = nn[r] + (m0 == n ? 1.f : 0.f); mk[r] = lt ? a1[nt][r] : 0.f; mkr[nt][r] = le ? a3[nt][r] : 0.f;
                    RC_M(12)[n * 72 + m0] = (bf16_t)f2bf(le ? a2[nt][r] : 0.f);
                    RC_M(8)[n * 72 + m0] = (bf16_t)f2bf(nn[r]);
                    khr[nt][r] = bf2f(RC_M(4)[m0 * 72 + n]); rhT[nt][r] = bf2f(RC_M(5)[n * 72 + m0]); }
                st_bf4(RC_M(7) + m0 * 72 + n0, nn); st_bf4(RC_M(9) + m0 * 72 + n0, ti); st_bf4(RC_M(11) + m0 * 72 + n0, mk); }
        }
        SYNCTHREADS();
        f32x4 tiv[2];
#pragma unroll
        for (int nt = 0; nt < 2; ++nt) tiv[nt] = ld_bf4(RC_M(9) + m0 * 72 + 32 * hf + 16 * nt + 4 * fq);
#pragma unroll 1
        for (int it = 0; it < 5; ++it) {
            bf16_t* pw = (it & 1) ? RC_M(0) : RC_M(7); bf16_t* pwT = (it & 1) ? RC_M(2) : RC_M(8); bf16_t* pw2 = (it & 1) ? RC_M(7) : RC_M(0); bf16_t* pw2T = (it & 1) ? RC_M(8) : RC_M(2);
            bf16_t* tcur = (it & 1) ? RC_M(4) : RC_M(9); bf16_t* tnxt = (it & 1) ? RC_M(9) : RC_M(4);
            f32x4 sq[2];
#pragma unroll
            for (int nt = 0; nt < 2; ++nt) sq[nt] = (f32x4){0.f, 0.f, 0.f, 0.f};
            wave_mma<2, 2>(sq, pw + rt * 16 * 72, 72, pwT + hf * 32 * 72, 72);
#pragma unroll
            for (int nt = 0; nt < 2; ++nt) { const int n0 = 32 * hf + 16 * nt + 4 * fq; st_bf4(pw2 + m0 * 72 + n0, sq[nt]);
#pragma unroll
                for (int r = 0; r < 4; ++r) pw2T[(n0 + r) * 72 + m0] = (bf16_t)f2bf(sq[nt][r]); }
            SYNCTHREADS();
            f32x4 up[2];
#pragma unroll
            for (int nt = 0; nt < 2; ++nt) up[nt] = (f32x4){0.f, 0.f, 0.f, 0.f};
            wave_mma<2, 2>(up, tcur + rt * 16 * 72, 72, pw2T + hf * 32 * 72, 72);
#pragma unroll
            for (int nt = 0; nt < 2; ++nt) { const int n0 = 32 * hf + 16 * nt + 4 * fq; tiv[nt] += up[nt]; st_bf4(tnxt + m0 * 72 + n0, tiv[nt]);
                if (it == 4) {
#pragma unroll
                    for (int r = 0; r < 4; ++r) RC_M(10)[(n0 + r) * 72 + m0] = (bf16_t)f2bf(tiv[nt][r]); } }
            SYNCTHREADS();
        }
        {
            f32x4 w1[2], w2[2];
#pragma unroll
            for (int nt = 0; nt < 2; ++nt) { w1[nt] = (f32x4){0.f, 0.f, 0.f, 0.f}; w2[nt] = w1[nt]; }
            wave_mma<2, 2>(w1, RC_M(1) + rt * 16 * 72, 72, RC_M(10) + hf * 32 * 72, 72);
            wave_mma<2, 2>(w2, RC_M(11) + rt * 16 * 72, 72, RC_M(10) + hf * 32 * 72, 72);
#pragma unroll
            for (int nt = 0; nt < 2; ++nt) { const int n0 = 32 * hf + 16 * nt + 4 * fq; st_bf4(RC_M(7) + m0 * 72 + n0, w1[nt]); st_bf4(RC_M(8) + m0 * 72 + n0, w2[nt]); }
        }
        SYNCTHREADS();
        {
            f32x4 py[2], qy[2], ps[2], qs[2];
#pragma unroll
            for (int nt = 0; nt < 2; ++nt) { py[nt] = (f32x4){0.f, 0.f, 0.f, 0.f}; qy[nt] = py[nt]; ps[nt] = py[nt]; qs[nt] = py[nt]; }
            wave_mma<2, 2>(py, RC_M(7) + rt * 16 * 72, 72, RC_M(12) + hf * 32 * 72, 72);
            wave_mma<2, 2>(qy, RC_M(8) + rt * 16 * 72, 72, RC_M(12) + hf * 32 * 72, 72);
            wave_mma<2, 2>(ps, RC_M(7) + rt * 16 * 72, 72, RC_M(3) + hf * 32 * 72, 72);
            wave_mma<2, 2>(qs, RC_M(8) + rt * 16 * 72, 72, RC_M(3) + hf * 32 * 72, 72);
#pragma unroll
            for (int nt = 0; nt < 2; ++nt) { const int n0 = 32 * hf + 16 * nt + 4 * fq;
#pragma unroll
                for (int r = 0; r < 4; ++r) { const int n = n0 + r; const float gln = gl[n];
                    RC_M(0)[n * 72 + m0] = (bf16_t)f2bf(rhT[nt][r] - py[nt][r]); RC_M(2)[n * 72 + m0] = (bf16_t)f2bf(mkr[nt][r] - qy[nt][r]);
                    RC_M(4)[n * 72 + m0] = (bf16_t)f2bf(((m0 == n ? 1.f : 0.f) - ps[nt][r]) * gln); RC_M(5)[n * 72 + m0] = (bf16_t)f2bf((khr[nt][r] - qs[nt][r]) * gln); } }
        }
        SYNCTHREADS();
        {
            f32x4 yv[2], sv[2];
#pragma unroll
            for (int nt = 0; nt < 2; ++nt) { yv[nt] = (f32x4){0.f, 0.f, 0.f, 0.f}; sv[nt] = yv[nt]; }
            wave_mma<2, 2>(yv, RC_M(6) + rt * 16 * 72, 72, RC_M(2) + hf * 32 * 72, 72);
            wave_mma<2, 2>(sv, RC_M(6) + rt * 16 * 72, 72, RC_M(5) + hf * 32 * 72, 72);
#pragma unroll
            for (int nt = 0; nt < 2; ++nt) { const int n0 = 32 * hf + 16 * nt + 4 * fq; *(f32x4*)(YVB + (size_t)u * 4096 + m0 * 64 + n0) = yv[nt]; *(f32x4*)(SVB + (size_t)u * 4096 + m0 * 64 + n0) = sv[nt]; }
            { const int rr = tid >> 3, c8 = (tid & 7) * 8; *(u32x4*)(PYT + (size_t)u * 4096 + rr * 64 + c8) = *(const u32x4*)(RC_M(0) + rr * 72 + c8); *(u32x4*)(PST + (size_t)u * 4096 + rr * 64 + c8) = *(const u32x4*)(RC_M(4) + rr * 72 + c8); }
        }
        SYNCTHREADS();
    }
}
#undef RC_M
__device__ __forceinline__ void ph_rw_seq(const Ctx& c, float* ldsf) {
    const bf16_t* PST = WSH(O_PST); const bf16_t* PYT = WSH(O_PYT); const float* SVB = WSF(O_SVB); const float* YVB = WSF(O_YVB); float* YY = WSF(O_YY);
    bf16_t* Sb = (bf16_t*)ldsf;
    bf16_t* Pm = Sb + 2 * 16 * 72;
    const int tid = threadIdx.x, wv = tid >> 6, lane = tid & 63, fr = lane & 15, fq = lane >> 4, isY = wv >> 2, nt0 = wv & 3;
    for (int u = blockIdx.x; u < 256; u += gridDim.x) {
        const int x = u & 7, jq = u >> 3, chain = x * 8 + (jq >> 2), qt = jq & 3, h = chain & 15, b = (chain >> 4) & 1, z = chain >> 5;
        const size_t ub = (size_t)chain * NRC;
        const int rr = tid >> 3, c8 = (tid & 7) * 8;
        constexpr int PD = NRC >= 8 ? 8 : 4;
        for (int i = tid; i < 2 * 16 * 72 / 2; i += NT) ((unsigned*)Sb)[i] = 0u;
        const int row = 16 * qt + fr, n0 = 16 * nt0 + 4 * fq; const float* addp = (isY ? YVB : SVB) + ub * 4096 + row * 64 + n0;
        const bf16_t* psp = PST + ub * 4096 + rr * 64 + c8; const bf16_t* pyp = PYT + ub * 4096 + rr * 64 + c8;
        u32x4 gps[PD], gpy[PD]; f32x4 add[PD];
#pragma unroll
        for (int j = 0; j < PD; ++j) { gps[j] = *(const u32x4*)(psp + (size_t)j * 4096); gpy[j] = *(const u32x4*)(pyp + (size_t)j * 4096); add[j] = *(const f32x4*)(addp + (size_t)j * 4096); }
        *(u32x4*)(Pm + (0 * 2 + 0) * 4608 + rr * 72 + c8) = gps[0]; *(u32x4*)(Pm + (0 * 2 + 1) * 4608 + rr * 72 + c8) = gpy[0];
        if (PD < NRC) { gps[0] = *(const u32x4*)(psp + (size_t)PD * 4096); gpy[0] = *(const u32x4*)(pyp + (size_t)PD * 4096); }
        SYNCTHREADS();
        for (int ck0 = 0; ck0 < NRC; ck0 += PD) {
#pragma unroll
            for (int j = 0; j < PD; ++j) {
                const int ck = ck0 + j, cur = j & 1, nxt = cur ^ 1;
                f32x4 acc[1]; acc[0] = (f32x4){0.f, 0.f, 0.f, 0.f};
                wave_mma<2, 1>(acc, Sb + cur * 16 * 72, 72, Pm + (cur * 2 + isY) * 4608 + nt0 * 16 * 72, 72);
                acc[0] += add[j];
                if (ck + PD < NRC) add[j] = *(const f32x4*)(addp + (size_t)(ck + PD) * 4096);
                if (isY) {
#pragma unroll
                    for (int r = 0; r < 4; ++r) { const int step = ck * RCK + n0 + r, sidx = z ? S - 1 - step : step; YY[((size_t)z * T + (size_t)b * S + sidx) * W + h * 64 + row] = acc[0][r]; }
                } else st_bf4(Sb + nxt * 16 * 72 + fr * 72 + n0, acc[0]);
                const int jn = (j + 1) % PD;
                if (ck + 1 < NRC) { *(u32x4*)(Pm + (nxt * 2 + 0) * 4608 + rr * 72 + c8) = gps[jn]; *(u32x4*)(Pm + (nxt * 2 + 1) * 4608 + rr * 72 + c8) = gpy[jn]; }
                if (ck + 1 + PD < NRC) { gps[jn] = *(const u32x4*)(psp + (size_t)(ck + 1 + PD) * 4096); gpy[jn] = *(const u32x4*)(pyp + (size_t)(ck + 1 + PD) * 4096); }
                LDS_BARRIER();
            }
        }
    }
}
__device__ __forceinline__ void ph_rw_out(const Ctx& c) {
    const bf16_t* FS = WSH(O_FS); const float* YY = WSF(O_YY); const float* BON = WSF(O_BON); const float* GG = WSF(O_GG); bf16_t* Y = WSH(O_YS);
    const int lane = threadIdx.x & 63, gw = blockIdx.x * (NT / 64) + (threadIdx.x >> 6), ngw = gridDim.x * (NT / 64);
    for (int i = gw; i < T * 16; i += ngw) {
        const int h = i & 15; const long t = i >> 4; const int ch = h * 64 + lane;
        const float y0 = YY[(size_t)t * W + ch], y1 = YY[((size_t)T + t) * W + ch];
        const float m0 = wave_sum(y0) * (1.f / 64.f), m1 = wave_sum(y1) * (1.f / 64.f); const float d0 = y0 - m0, d1 = y1 - m1;
        const float r0 = 1.f / sqrtf(wave_sum(d0 * d0) * (1.f / 64.f) + EPS), r1 = 1.f / sqrtf(wave_sum(d1 * d1) * (1.f / 64.f) + EPS);
        const float vv = bf2f(FS[(size_t)t * RF + 2048 + ch]); const float o = d0 * r0 + d1 * r1 + (BON[(size_t)t * 16 + h] + BON[((size_t)T + t) * 16 + h]) * vv;
        Y[(size_t)t * 4 * W + 3 * W + ch] = (bf16_t)f2bf(o * GG[(size_t)t * W + ch]);
    }
}
__device__ __forceinline__ void ph_router(const Ctx& c, int l, float* ldsf) {
    const float* H = WSF(O_HF); const bf16_t* WH = WSH(O_WRH); const bf16_t* WL = WSH(O_WRL); const float* bg = c.in[31] + (size_t)l * 4; const float* be = c.in[33] + (size_t)l * 32;
    int* EID = WSI(O_EID); float* EWT = WSF(O_EWT); int* cnt = CTLW(c) + CW_CNT + l * 64;
    const int tid = threadIdx.x, wv = tid >> 6, lane = tid & 63, fr = lane & 15, fq = lane >> 4, rt = wv & 1, kq = wv >> 1;
    float* part = ldsf;
    for (int u = blockIdx.x; u < T / 32; u += gridDim.x) {
        const long t0 = (long)u * 32; f32x4 acc[3];
#pragma unroll
        for (int nt = 0; nt < 3; ++nt) acc[nt] = (f32x4){0.f, 0.f, 0.f, 0.f};
#ifdef CPU_EMU
        for (int nt = 0; nt < 3; ++nt) for (int r = 0; r < 4; ++r) { const int n = 16 * nt + 4 * fq + r; float sacc = 0.f;
            for (int k = kq * 512; k < kq * 512 + 512; ++k) { const float hv = H[(size_t)(t0 + 16 * rt + fr) * D + k]; const float hh = bf2f((bf16_t)f2bf(hv)), hl = bf2f((bf16_t)f2bf(hv - hh));
                const float wh = bf2f(WH[(size_t)n * D + k]), wl = bf2f(WL[(size_t)n * D + k]); sacc += hh * wh + hl * wh + hh * wl; }
            acc[nt][r] = sacc; }
#else
        const float* hp = H + (size_t)(t0 + 16 * rt + fr) * D + kq * 512 + fq * 8;
#pragma unroll 4
        for (int ks = 0; ks < 16; ++ks) {
            const f32x4 h0 = *(const f32x4*)(hp + ks * 32), h1 = *(const f32x4*)(hp + ks * 32 + 4); bf16x8 ah, al;
#pragma unroll
            for (int e = 0; e < 4; ++e) { const unsigned b0 = f2bf(h0[e]), b1 = f2bf(h1[e]); ah[e] = (short)b0; ah[4 + e] = (short)b1; al[e] = (short)f2bf(h0[e] - u2f_(b0 << 16)); al[4 + e] = (short)f2bf(h1[e] - u2f_(b1 << 16)); }
#pragma unroll
            for (int nt = 0; nt < 3; ++nt) { const size_t wo = (size_t)(16 * nt + fr) * D + kq * 512 + ks * 32 + fq * 8; const bf16x8 bh = *(const bf16x8*)(WH + wo), bl = *(const bf16x8*)(WL + wo);
                acc[nt] = __builtin_amdgcn_mfma_f32_16x16x32_bf16(bh, ah, acc[nt], 0, 0, 0); acc[nt] = __builtin_amdgcn_mfma_f32_16x16x32_bf16(bh, al, acc[nt], 0, 0, 0); acc[nt] = __builtin_amdgcn_mfma_f32_16x16x32_bf16(bl, ah, acc[nt], 0, 0, 0); }
        }
#endif
#pragma unroll
        for (int nt = 0; nt < 3; ++nt) *(f32x4*)(part + (kq * 32 + 16 * rt + fr) * 48 + 16 * nt + 4 * fq) = acc[nt];
        SYNCTHREADS();
        if (tid < 32) { const long t = t0 + tid; float lg[36];
#pragma unroll
            for (int q = 0; q < 36; ++q) lg[q] = (part[(0 * 32 + tid) * 48 + q] + part[(1 * 32 + tid) * 48 + q]) + (part[(2 * 32 + tid) * 48 + q] + part[(3 * 32 + tid) * 48 + q]) + (q < 4 ? bg[q < 4 ? q : 0] : be[q >= 4 ? q - 4 : 0]);
            int gi = 0; float m = lg[0];
#pragma unroll
            for (int q = 1; q < 4; ++q) if (lg[q] > m) { m = lg[q]; gi = q; }
            float den = 0.f;
#pragma unroll
            for (int q = 0; q < 4; ++q) den += expf(lg[q] - m);
            const float gp = 1.f / den; float el[8];
#pragma unroll
            for (int q = 0; q < 8; ++q) el[q] = gi == 0 ? lg[4 + q] : gi == 1 ? lg[12 + q] : gi == 2 ? lg[20 + q] : lg[28 + q];
            int i1 = 0; float m1 = el[0];
#pragma unroll
            for (int q = 1; q < 8; ++q) if (el[q] > m1) { m1 = el[q]; i1 = q; }
            int i2 = -1; float m2 = 0.f;
#pragma unroll
            for (int q = 0; q < 8; ++q) if (q != i1 && (i2 < 0 || el[q] > m2)) { m2 = el[q]; i2 = q; }
            const float p2 = expf(m2 - m1);
            EID[t * 2] = gi * 8 + i1; EID[t * 2 + 1] = gi * 8 + i2; EWT[t * 2] = gp / (1.f + p2); EWT[t * 2 + 1] = gp * p2 / (1.f + p2);
            atomic_add_i(cnt + gi * 8 + i1, 1); atomic_add_i(cnt + gi * 8 + i2, 1);
        }
        SYNCTHREADS();
    }
}
__device__ __forceinline__ void ph_moe_plan(const Ctx& c, int l) {
    int* cnt = CTLW(c) + CW_CNT + l * 64; int* plan = CTLW(c) + CW_PLAN + l * 256;
    if (GT_ == 0) {
        int ps = 0, nb = 0;
        for (int e = 0; e < NE; ++e) { plan[e] = ps; const int nblk = (cnt[e] + 255) / 256; for (int q = 0; q < nblk; ++q) plan[64 + nb++] = e; ps += nblk * 256; }
        plan[32] = ps; plan[40] = nb;
    }
}
__device__ __forceinline__ void ph_moe_assign(const Ctx& c, int l) {
    const int* EID = WSI(O_EID); int* fill = CTLW(c) + CW_FILL + l * 64; const int* plan = CTLW(c) + CW_PLAN + l * 256; int* DEST = WSI(O_DEST);
    for (long i = GT_; i < (long)T * 2; i += GS_) { const int e = EID[i]; const int pos = atomic_add_i(fill + e, 1); DEST[i] = plan[e] + pos; }
}
__device__ __forceinline__ void ph_moe_gather(const Ctx& c) {
    const int* DEST = WSI(O_DEST); const u32x4* H = (const u32x4*)WSH(O_H); u32x4* XS = (u32x4*)WSH(O_XS);
    for (long i = GT_; i < (long)T * 2 * (D / 8); i += GS_) { const int q = (int)(i % (D / 8)); const long a = i / (D / 8); XS[(size_t)DEST[a] * (D / 8) + q] = H[(size_t)(a >> 1) * (D / 8) + q]; }
}
#ifndef CPU_EMU
#define XB_TMO      128
#define XB_XCNT(j)  (256  + 64 * (j))
#define XB_XSUB(j)  (1280 + 64 * (j))
#define XB_XGEN(j)  (2304 + 64 * (j))
#define XB_TOP      3328
#define XB_TOPGEN   3392
#define XCD_BAR_WORDS 3456
#define XB_SPIN_CAP (1u << 26)
#define LAS __attribute__((address_space(3)))
__device__ __forceinline__ unsigned xb_ld(unsigned* p)              { return __hip_atomic_load(p, __ATOMIC_RELAXED, __HIP_MEMORY_SCOPE_AGENT); }
__device__ __forceinline__ unsigned xb_add(unsigned* p, unsigned v) { return __hip_atomic_fetch_add(p, v, __ATOMIC_RELAXED, __HIP_MEMORY_SCOPE_AGENT); }
__device__ __forceinline__ unsigned xb_xcc_id() { return (unsigned)__builtin_amdgcn_s_getreg((3 << 11) | 20) & 0xFu; }
#define XB_SPIN(cond, bar) do { unsigned _sp = 0; while (cond) { __builtin_amdgcn_s_sleep(1); \
    if ((++_sp & 255u) == 0u) { if (xb_ld(&(bar)[XB_TMO])) break; if (_sp > XB_SPIN_CAP) { atomicAdd(&(bar)[XB_TMO], 1u); break; } } } } while (0)
struct XcdBarrier { unsigned* bar; unsigned x; volatile LAS unsigned* st; };
__device__ __forceinline__ XcdBarrier xcd_barrier_post(unsigned* bar, volatile LAS unsigned* st) {
    XcdBarrier b; b.bar = bar; b.x = xb_xcc_id(); b.st = st;
    if (threadIdx.x == 0) (void)xb_add(&bar[XB_XCNT(b.x)], 1u);
    return b;
}
__device__ __forceinline__ void xcd_barrier_complete(unsigned* bar, unsigned x, unsigned& nloc, unsigned& nx) {
    const unsigned G = gridDim.x * gridDim.y * gridDim.z;
    unsigned sum, cnt, mine, sp = 0u;
    for (;;) {
        sum = 0u; cnt = 0u; mine = 0u;
#pragma unroll
        for (unsigned j = 0; j < 16; ++j) { const unsigned cc = xb_ld(&bar[XB_XCNT(j)]); sum += cc; cnt += (cc > 0u) ? 1u : 0u; mine = (j == x) ? cc : mine; }
        if (sum == G) break;
        __builtin_amdgcn_s_sleep(1);
        if ((++sp & 255u) == 0u) { if (xb_ld(&bar[XB_TMO])) break; if (sp > XB_SPIN_CAP) { atomicAdd(&bar[XB_TMO], 1u); break; } }
    }
    nloc = mine > 0u ? mine : 1u; nx = cnt > 0u ? cnt : 1u;
}
__device__ __forceinline__ void xcd_barrier(const XcdBarrier& b) {
    asm volatile("s_waitcnt vmcnt(0)" ::: "memory");
    __syncthreads();
    if (threadIdx.x == 0) {
        unsigned* bar = b.bar;
        __builtin_amdgcn_s_waitcnt(0);
        unsigned nloc = b.st[0], nx = b.st[1];
        if (nloc == 0u) { xcd_barrier_complete(bar, b.x, nloc, nx); b.st[0] = nloc; b.st[1] = nx; }
        const unsigned old = xb_add(&bar[XB_XSUB(b.x)], 1u);
        const unsigned gen = old / nloc;
        if (old + 1u == (gen + 1u) * nloc) {
            __builtin_amdgcn_fence(__ATOMIC_RELEASE, "agent");
            asm volatile("s_waitcnt vmcnt(0)" ::: "memory");
            const unsigned og = xb_add(&bar[XB_TOP], 1u);
            const unsigned tg = og / nx;
            if (og + 1u == (tg + 1u) * nx) xb_add(&bar[XB_TOPGEN], 1u);
            else XB_SPIN(xb_ld(&bar[XB_TOPGEN]) == tg, bar);
            __builtin_amdgcn_fence(__ATOMIC_ACQUIRE, "agent");
            xb_add(&bar[XB_XGEN(b.x)], 1u);
            asm volatile("s_waitcnt vmcnt(0)" ::: "memory");
        } else {
            XB_SPIN(xb_ld(&bar[XB_XGEN(b.x)]) == gen, bar);
            __builtin_amdgcn_fence(__ATOMIC_ACQUIRE, "agent");
            asm volatile("s_waitcnt vmcnt(0)" ::: "memory");
        }
    }
    __syncthreads();
}
#endif

constexpr int LDS_BYTES = 147456;

__global__ void __launch_bounds__(NT, 2) fwd(Params p) {
#ifdef CPU_EMU
    unsigned char* lds = g_lds; float* ldsf = (float*)g_lds;
#else
    extern __shared__ __attribute__((aligned(16))) unsigned char lds[];
    float* ldsf = (float*)lds;
    volatile LAS unsigned* misc = (volatile LAS unsigned*)((LAS unsigned char*)lds + LDS_BYTES - 64);
    if (threadIdx.x == 0) { misc[0] = 0u; misc[1] = 0u; }
    __syncthreads();
    XcdBarrier bar = xcd_barrier_post((unsigned*)(p.ws + O_CTL) + CW_BAR, misc);
#endif
    Ctx c; c.in = p.in; c.out = p.out; c.ws = p.ws;
    const int lo = p.ph_lo, hi = p.ph_hi; int ph = 0;
    const int G = (int)gridDim.x, cwg = (int)blockIdx.x;
#ifdef CPU_EMU
#define GRID_BAR()
#else
#define GRID_BAR() xcd_barrier(bar)
#endif
#ifndef REPEAT_MASK
#define REPEAT_MASK 0
#endif
#ifndef TIME_PHASE
#define TIME_PHASE -1
#endif
#if TIME_PHASE >= 0 && !defined(CPU_EMU)
    unsigned long long tp0 = 0, tp1 = 0;
#define TP_BEGIN() do { if (ph == TIME_PHASE) tp0 = __builtin_amdgcn_s_memrealtime(); } while (0)
#define TP_END() do { if (ph == TIME_PHASE) tp1 = __builtin_amdgcn_s_memrealtime(); } while (0)
#else
#define TP_BEGIN()
#define TP_END()
#endif
#define PHASE(...) do { if (lo <= ph && ph < hi) { TP_BEGIN(); __VA_ARGS__; if (ph + 1 < hi) { GRID_BAR(); } TP_END(); } ++ph; } while (0)
#define PHASEG(grp, ...) do { if (lo <= ph && ph < hi) { TP_BEGIN(); if ((REPEAT_MASK >> (grp)) & 1) { __VA_ARGS__; GRID_BAR(); } __VA_ARGS__; if (ph + 1 < hi) { GRID_BAR(); } TP_END(); } ++ph; } while (0)
    PHASE(ph_mod(c, ldsf));
#define LAYER_BODY(l) do { const float* mod = WSF(O_MOD); \
        const float* xin = l == 0 ? c.in[0] : WSF(O_X1); float* xmid = WSF(O_X0); float* xout = WSF(O_X1); \
        const float* ml = mod + (size_t)l * NB * D6; \
        PHASEG(3, ph_convert(c, l, ldsf)); \
        PHASEG(0, { pg8::Gemm g{D, D, D}; pg8::StaticOrder so; so.init(T, PW, G, cwg, WSH(O_H), WSH(O_WIN), D, D); pg8::EpiBf16 E{WSH(O_P), PW}; pg8::gemm_phase(lds, g, so, E); }); \
        PHASE(ph_lru_gate(c, l, ldsf); ph_ret_kv(c, ldsf); ph_sgu_norm(c, l); ph_rw_shift(c, l)); \
        PHASE(ph_lru_scan1(c); ph_ret_state(c); ph_sgu_mix(c, l, ldsf); ph_rw_lora(c, l, ldsf)); \
        PHASE(ph_lru_scan2(c); ph_ret_out(c, ldsf); ph_rw_chunk(c, l, ldsf)); \
        PHASE(ph_lru_scan3(c); ph_rw_seq(c, ldsf)); \
        PHASE(ph_rw_out(c)); \
        PHASEG(1, { pg8::Gemm g{W, 4 * W, 4 * W}; pg8::MergeOrder mo; mo.so.init(T, D, G, cwg, WSH(O_YS), WSH(O_WBR), 4 * W, 4 * W); mo.kseg_bytes = W * 2; pg8::EpiMerge E{WSH(O_P), WSF(O_PART), WSH(O_MRG)}; pg8::gemm_phase(lds, g, mo, E); }); \
        PHASEG(1, { pg8::Gemm g{D, D, D}; pg8::StaticOrder so; so.init(T, D, G, cwg, WSH(O_MRG), WSH(O_WOUT), D, D); pg8::EpiResid E{xin, ml + 2 * D, xmid}; pg8::gemm_phase(lds, g, so, E); }); \
        PHASEG(6, ph_norm(c, xmid, c.in[4] + (size_t)l * D, ml + 3 * D, ml + 4 * D, WSH(O_H), WSF(O_HF))); \
        PHASE(ph_router(c, l, ldsf)); \
        PHASE(ph_moe_plan(c, l)); \
        PHASE(ph_moe_assign(c, l)); \
        PHASEG(6, ph_moe_gather(c)); \
        const int* plan = CTLW(c) + CW_PLAN + l * 256; \
        PHASEG(2, { pg8::Gemm g{D, D, D}; pg8::MoeOrder mo{G, cwg, 4, plan, (const char*)WSH(O_XS), (const char*)WSH(O_WGU), (size_t)256 * D * 2, (size_t)256 * D * 2, (size_t)1024 * D * 2}; pg8::EpiGU E{WSH(O_ACT)}; pg8::gemm_phase(lds, g, mo, E); }); \
        PHASEG(2, { pg8::Gemm g{512, 512, 512}; pg8::MoeOrder mo{G, cwg, 8, plan, (const char*)WSH(O_ACT), (const char*)WSH(O_WDN), (size_t)256 * 512 * 2, (size_t)256 * 512 * 2, (size_t)D * 512 * 2}; pg8::EpiBf16 E{WSH(O_YE), D}; pg8::gemm_phase(lds, g, mo, E); }); \
        if (l == 0) PHASE(ph_comb_norm<0>(c, xmid, ml + 5 * D, xout, c.in[3] + (size_t)1 * D, mod + (size_t)1 * NB * D6 + 0 * D, mod + (size_t)1 * NB * D6 + 1 * D, WSH(O_H), nullptr)); \
        else PHASE(ph_comb_norm<1>(c, xmid, ml + 5 * D, xout, c.in[36], nullptr, nullptr, nullptr, c.out)); \
    } while (0)
    PHASE(ph_norm(c, c.in[0], c.in[3], WSF(O_MOD) + 0 * D, WSF(O_MOD) + 1 * D, WSH(O_H), nullptr));
    LAYER_BODY(0);
    LAYER_BODY(1);
#undef LAYER_BODY
#if TIME_PHASE >= 0 && !defined(CPU_EMU)
    if (blockIdx.x == 0) { const unsigned long long te = __builtin_amdgcn_s_memrealtime(), dl = 8ull * (tp1 - tp0); while (__builtin_amdgcn_s_memrealtime() - te < dl) __builtin_amdgcn_s_sleep(8); }
#endif
#undef PHASE
}
}

#ifndef CPU_EMU
extern "C" void kernel_launch(void* const* d_in, const int* in_sizes, int n_in, void* d_out, int out_size, void* d_ws, size_t ws_size, hipStream_t stream) {
    static int grid = 0;
    if (grid == 0) {
        if (n_in != 37 || out_size != T * D || ws_size < WS_END) { fprintf(stderr, "kernel_launch: unexpected shapes (n_in %d out %d ws %zu need %zu)\n", n_in, out_size, ws_size, (size_t)WS_END); grid = -1; return; }
        int dev = 0, cus = 0, per_cu = 0;
        if (hipGetDevice(&dev) != hipSuccess || hipDeviceGetAttribute(&cus, hipDeviceAttributeMultiprocessorCount, dev) != hipSuccess) { grid = -1; return; }
        if (hipFuncSetAttribute((const void*)fwd, hipFuncAttributeMaxDynamicSharedMemorySize, LDS_BYTES) != hipSuccess) { fprintf(stderr, "kernel_launch: hipFuncSetAttribute failed\n"); grid = -1; return; }
        if (hipOccupancyMaxActiveBlocksPerMultiprocessor(&per_cu, (const void*)fwd, NT, LDS_BYTES) != hipSuccess || per_cu < 1) fprintf(stderr, "kernel_launch: occupancy query says %d\n", per_cu);
        (void)hipGetLastError();
        grid = cus;
    }
    if (grid < 0) return;
    (void)in_sizes;
    (void)hipMemsetAsync((char*)d_ws + O_CTL, 0, CTL_BYTES, stream);
    Params p{};
    for (int i = 0; i < 37; ++i) p.in[i] = (const float*)d_in[i];
    p.out = (float*)d_out; p.ws = (unsigned char*)d_ws;
#if ONE_LAUNCH
    p.ph_lo = 0; p.ph_hi = NPH;
    hipLaunchKernelGGL(fwd, dim3(grid), dim3(NT), LDS_BYTES, stream, p);
#else
    for (int k = 0; k < NPH; ++k) { p.ph_lo = k; p.ph_hi = k + 1; hipLaunchKernelGGL(fwd, dim3(grid), dim3(NT), LDS_BYTES, stream, p); }
#endif
}
#endif
```

```cpp
#ifndef CPU_EMU
#include <hip/hip_runtime.h>
#endif
#include <cstdio>
#include <cstdint>
#include <cmath>
#include <cstring>

#ifndef SEQ
#define SEQ 4096
#endif
#ifndef ONE_LAUNCH
#define ONE_LAUNCH 1
#endif

namespace {
constexpr int D = 2048, NB = 2, S = SEQ, T = NB * S, NL = 2, W = 1024;
constexpr int INW = 18816, RF = 3456, D6 = 6 * D;
constexpr int C_LX = 0, C_LG = 1024, C_RQ = 2048, C_RK = 2560, C_RV = 3072, C_RG = 4096, C_SU = 5120, C_SV = 6144, C_RW = 7168;
constexpr int PW = 18944, C_MLP = 10752;
constexpr int NCH = S / 128;
constexpr int NLC = S / 64;
constexpr int NE = 32, CAP = (T * 2 / 256 + NE) * 256, MAXBLK = CAP / 256;
constexpr float EPS = 1e-6f;
constexpr float DECAY_SCALE = 0.60653065971263342f;
constexpr int NT = 512;
constexpr int NPH_LAYER = 17, NPH = 2 + NL * NPH_LAYER;
typedef unsigned short bf16_t;
#ifdef CPU_EMU
typedef float f32x4 __attribute__((vector_size(16)));
typedef unsigned u32x4 __attribute__((vector_size(16)));
#else
typedef float f32x4 __attribute__((ext_vector_type(4)));
typedef unsigned u32x4 __attribute__((ext_vector_type(4)));
typedef short bf16x8 __attribute__((ext_vector_type(8)));
#endif

constexpr size_t al256(size_t x) { return (x + 255) & ~(size_t)255; }
constexpr size_t SZ_X = (size_t)T * D * 4, SZ_W = (size_t)T * W * 4;
constexpr size_t O_CTL = 0, CTL_BYTES = 1u << 20;
constexpr size_t O_MOD = CTL_BYTES;
constexpr size_t O_X0 = O_MOD + al256((size_t)NL * NB * D6 * 4);
constexpr size_t O_X1 = O_X0 + SZ_X;
constexpr size_t O_H = O_X1 + SZ_X;
constexpr size_t O_HF = O_H + SZ_X / 2;
constexpr size_t O_P = O_HF + SZ_X;
constexpr size_t SZ_P = (size_t)T * PW * 2;
constexpr size_t O_XC = O_P + SZ_P;
constexpr size_t O_LA = O_XC + SZ_W, O_LU = O_LA + 2 * SZ_W;
constexpr size_t SZ_LC = (size_t)2 * NB * NLC * W * 4;
constexpr size_t O_LCA = O_LU + 2 * SZ_W, O_LCH = O_LCA + SZ_LC, O_LCI = O_LCH + SZ_LC;
constexpr size_t O_YS = O_LCI + SZ_LC;
constexpr size_t O_SC = O_YS + (size_t)T * 4 * W * 2;
constexpr size_t SZ_KV = (size_t)NB * NCH * 8 * 64 * 128 * 4;
constexpr size_t O_KVF = O_SC, O_KVB = O_KVF + SZ_KV, O_STF = O_KVB + SZ_KV, O_STB = O_STF + SZ_KV;
constexpr size_t O_VN = O_STB + SZ_KV;
constexpr size_t O_FS = O_VN + SZ_W;
constexpr size_t O_DEC = O_FS + al256((size_t)T * RF * 4), O_AA = O_DEC + 2 * SZ_W, O_AKK = O_AA + 2 * SZ_W;
constexpr size_t O_GG = O_AKK, O_YY = O_GG + SZ_W;
constexpr int RCK = 64, NRC = S / RCK;
constexpr size_t O_BON = O_YY + 2 * SZ_W;
constexpr size_t O_PART = O_BON + al256((size_t)2 * T * 16 * 4);
constexpr size_t O_MRG = O_PART + SZ_X;
constexpr size_t O_LOG = O_MRG + SZ_X / 2;
constexpr size_t O_EID = O_LOG + al256((size_t)T * 40 * 4), O_EWT = O_EID + al256((size_t)T * 2 * 4), O_DEST = O_EWT + al256((size_t)T * 2 * 4);
constexpr size_t O_SLOT = O_DEST + al256((size_t)T * 2 * 4);
constexpr size_t O_PST = O_SLOT + al256((size_t)CAP * 4), O_PYT = O_PST + (size_t)64 * NRC * 4096 * 2, O_SVB = O_PYT + (size_t)64 * NRC * 4096 * 2, O_YVB = O_SVB + (size_t)64 * NRC * 4096 * 4;
constexpr size_t O_WIN = O_YVB + (size_t)64 * NRC * 4096 * 4;
constexpr size_t O_WBR = O_WIN + (size_t)PW * D * 2;
constexpr size_t O_WOUT = O_WBR + (size_t)D * 4 * W * 2;
constexpr size_t O_WGU = O_WOUT + (size_t)D * D * 2;
constexpr size_t O_WDN = O_WGU + (size_t)NE * 1024 * D * 2;
constexpr size_t O_WLR = O_WDN + (size_t)NE * D * 512 * 2;
constexpr size_t O_WUT = O_WLR + (size_t)32 * 128 * 128 * 2;
constexpr size_t O_WAT = O_WUT + (size_t)2 * W * 64 * 2;
constexpr size_t O_WGT = O_WAT + (size_t)2 * W * 64 * 2;
constexpr size_t O_WRH = O_WGT + (size_t)W * 128 * 2;
constexpr size_t O_WRL = O_WRH + (size_t)48 * D * 2;
constexpr size_t WS_END0 = O_WRL + (size_t)48 * D * 2;
constexpr size_t SZ_MOE = (size_t)CAP * (D + 512 + D) * 2;
constexpr bool MOE_OVERLAY = SZ_MOE <= SZ_P;
constexpr size_t O_XS = MOE_OVERLAY ? O_P : WS_END0;
constexpr size_t O_ACT = O_XS + (size_t)CAP * D * 2;
constexpr size_t O_YE = O_ACT + (size_t)CAP * 512 * 2;
constexpr size_t WS_END = MOE_OVERLAY ? WS_END0 : WS_END0 + SZ_MOE;
static_assert(SEQ != 4096 || WS_END <= (size_t)2040 * 1024 * 1024, "workspace budget: d_ws is 4 x the largest input = 2048 MiB");
constexpr int CW_BAR = 4096;
constexpr int CW_CNT = 32768;
constexpr int CW_FILL = CW_CNT + NL * 64;
constexpr int CW_PLAN = CW_FILL + NL * 64;
static_assert(MAXBLK <= 160, "plan words");

struct Params { const float* in[37]; float* out; unsigned char* ws; int ph_lo, ph_hi; };

struct Ctx { const float* const* in; float* out; unsigned char* ws; };
#define GT_ ((long)blockIdx.x * NT + threadIdx.x)
#define GS_ ((long)gridDim.x * NT)
#define WSF(off) ((float*)(c.ws + (off)))
#define WSI(off) ((int*)(c.ws + (off)))
#define WSH(off) ((bf16_t*)(c.ws + (off)))
#define CTLW(c) ((int*)((c).ws + O_CTL))

#ifdef CPU_EMU
__device__ __forceinline__ float fexp_(float x) { return expf(x); }
__device__ __forceinline__ float frcp_(float x) { return 1.f / x; }
#else
__device__ __forceinline__ float fexp_(float x) { return __builtin_amdgcn_exp2f(x * 1.4426950408889634f); }
__device__ __forceinline__ float frcp_(float x) { return __builtin_amdgcn_rcpf(x); }
#endif
__device__ __forceinline__ float sigmoidf_(float x) { return frcp_(1.f + fexp_(-x)); }
__device__ __forceinline__ float siluf_(float x) { return x * frcp_(1.f + fexp_(-x)); }
__device__ __forceinline__ float tanhf_(float x) { return 1.f - 2.f * frcp_(1.f + fexp_(2.f * x)); }
__device__ __forceinline__ float geluf_(float x) { return 0.5f * x * (1.f + tanhf_(0.7978845608028654f * (x + 0.044715f * x * x * x))); }
__device__ __forceinline__ float softplusf_(float x) { return x > 0.f ? x + log1pf(expf(-x)) : log1pf(expf(x)); }
__device__ __forceinline__ float loggamma_(int h) { return log1pf(-exp2f(-5.f - (float)h)); }
__device__ __forceinline__ unsigned f2u_(float f) { unsigned u; memcpy(&u, &f, 4); return u; }
__device__ __forceinline__ float u2f_(unsigned u) { float f; memcpy(&f, &u, 4); return f; }
__device__ __forceinline__ float bf2f(bf16_t v) { return u2f_((unsigned)v << 16); }
__device__ __forceinline__ unsigned f2bf(float f) { const unsigned u = f2u_(f); return (u + 0x7fffu + ((u >> 16) & 1u)) >> 16; }
__device__ __forceinline__ unsigned pk2(float lo, float hi) { return f2bf(lo) | (f2bf(hi) << 16); }
__device__ __forceinline__ float bflo(unsigned w) { return u2f_(w << 16); }
__device__ __forceinline__ float bfhi(unsigned w) { return u2f_(w & 0xffff0000u); }
__device__ __forceinline__ int atomic_add_i(int* p, int v) {
#ifdef CPU_EMU
    return __atomic_fetch_add(p, v, __ATOMIC_RELAXED);
#else
    return atomicAdd(p, v);
#endif
}
#define PF(P, r, col) bf2f((P)[(size_t)(r) * PW + (col)])
#ifdef CPU_EMU
#define SYNCTHREADS() emu_syncthreads()
#define SHFL_XOR(v, m) emu_shfl_xor(v, m)
#else
#define SYNCTHREADS() __syncthreads()
#define SHFL_XOR(v, m) __shfl_xor(v, m)
#endif
#ifdef CPU_EMU
__device__ __forceinline__ float wave_sum(float v) {
    for (int o = 1; o < 64; o <<= 1) v += SHFL_XOR(v, o);
    return v;
}
#else
__device__ __forceinline__ float wave_sum(float x) {
    x += __builtin_bit_cast(float, __builtin_amdgcn_update_dpp(0, __builtin_bit_cast(int, x), 0xB1, 0xF, 0xF, true));
    x += __builtin_bit_cast(float, __builtin_amdgcn_update_dpp(0, __builtin_bit_cast(int, x), 0x4E, 0xF, 0xF, true));
    x += __builtin_bit_cast(float, __builtin_amdgcn_update_dpp(0, __builtin_bit_cast(int, x), 0x141, 0xF, 0xF, true));
    x += __builtin_bit_cast(float, __builtin_amdgcn_update_dpp(0, __builtin_bit_cast(int, x), 0x140, 0xF, 0xF, true));
    const int xi = __builtin_bit_cast(int, x);
    return (__builtin_bit_cast(float, __builtin_amdgcn_readlane(xi, 0)) + __builtin_bit_cast(float, __builtin_amdgcn_readlane(xi, 16))) + (__builtin_bit_cast(float, __builtin_amdgcn_readlane(xi, 32)) + __builtin_bit_cast(float, __builtin_amdgcn_readlane(xi, 48)));
}
#endif
__device__ __forceinline__ f32x4 ld_bf4(const bf16_t* p) { const unsigned long long q = *(const unsigned long long*)p; const unsigned lo = (unsigned)q, hi = (unsigned)(q >> 32); return (f32x4){bflo(lo), bfhi(lo), bflo(hi), bfhi(hi)}; }
__device__ __forceinline__ void st_bf4(bf16_t* p, const f32x4 v) { *(unsigned long long*)p = (unsigned long long)pk2(v[0], v[1]) | ((unsigned long long)pk2(v[2], v[3]) << 32); }

template <int KT, int NTL>
__device__ __forceinline__ void wave_mma(f32x4 (&acc)[NTL], const bf16_t* A, int lda, const bf16_t* Bt, int ldb) {
    const int lane = threadIdx.x & 63, fr = lane & 15, fq = lane >> 4;
#ifdef CPU_EMU
    for (int nt = 0; nt < NTL; ++nt) for (int r = 0; r < 4; ++r) { float sacc = 0.f; const bf16_t* a = A + fr * lda; const bf16_t* b = Bt + (16 * nt + 4 * fq + r) * ldb;
        for (int k = 0; k < 32 * KT; ++k) sacc += bf2f(a[k]) * bf2f(b[k]);
        acc[nt][r] += sacc; }
#else
#pragma unroll
    for (int kt = 0; kt < KT; ++kt) {
        const bf16x8 af = *(const bf16x8*)(A + fr * lda + kt * 32 + fq * 8);
#pragma unroll
        for (int nt = 0; nt < NTL; ++nt) { const bf16x8 bfr = *(const bf16x8*)(Bt + (16 * nt + fr) * ldb + kt * 32 + fq * 8);
            acc[nt] = __builtin_amdgcn_mfma_f32_16x16x32_bf16(bfr, af, acc[nt], 0, 0, 0); }
    }
#endif
}
__device__ __forceinline__ void ph_mod(const Ctx& c, float* ldsf) {
    const float* cc = c.in[1]; const float* aw = c.in[5]; const float* ab = c.in[6]; float* mod = WSF(O_MOD);
    float* scs = ldsf; float* part = ldsf + NB * D; const int tid = threadIdx.x, c4 = (tid & 31) * 4, kq = tid >> 5;
    for (int i = tid; i < NB * D; i += NT) scs[i] = siluf_(cc[i]);
    SYNCTHREADS();
    for (int u = blockIdx.x; u < NL * (D6 / 128); u += gridDim.x) {
        const int l = u / (D6 / 128), j0 = (u % (D6 / 128)) * 128;
        const float* w = aw + (size_t)l * D * D6 + j0 + c4; f32x4 a0 = (f32x4){0.f, 0.f, 0.f, 0.f}, a1 = a0;
#pragma unroll 8
        for (int k = kq * 128; k < kq * 128 + 128; ++k) { const f32x4 wv = *(const f32x4*)(w + (size_t)k * D6); a0 += wv * scs[k]; a1 += wv * scs[D + k]; }
        *(f32x4*)(part + (kq * 2 + 0) * 128 + c4) = a0; *(f32x4*)(part + (kq * 2 + 1) * 128 + c4) = a1;
        SYNCTHREADS();
        if (tid < 256) { const int b = tid >> 7, col = tid & 127; float sacc = 0.f;
#pragma unroll
            for (int q = 0; q < 16; ++q) sacc += part[(q * 2 + b) * 128 + col];
            mod[((size_t)l * NB + b) * D6 + j0 + col] = sacc + ab[l * D6 + j0 + col]; }
        SYNCTHREADS();
    }
}
__device__ __forceinline__ void ph_norm(const Ctx& c, const float* x, const float* g, const float* sh, const float* sc, bf16_t* hb, float* hf) {
    const int lane = threadIdx.x & 63, gw = blockIdx.x * (NT / 64) + (threadIdx.x >> 6), ngw = gridDim.x * (NT / 64);
    for (int t0 = gw * 2; t0 < T; t0 += ngw * 2) {
        f32x4 v[2][8]; float ss[2] = {0.f, 0.f};
#pragma unroll
        for (int r = 0; r < 2; ++r)
#pragma unroll
            for (int j = 0; j < 8; ++j) v[r][j] = *(const f32x4*)(x + (size_t)(t0 + r) * D + (j * 64 + lane) * 4);
#pragma unroll
        for (int r = 0; r < 2; ++r) {
#pragma unroll
            for (int j = 0; j < 8; ++j) ss[r] += (v[r][j][0] * v[r][j][0] + v[r][j][1] * v[r][j][1]) + (v[r][j][2] * v[r][j][2] + v[r][j][3] * v[r][j][3]);
            const int t = t0 + r, b = t / S; const float rs = 1.f / sqrtf(wave_sum(ss[r]) * (1.f / D) + EPS);
#pragma unroll
            for (int j = 0; j < 8; ++j) { const int col = (j * 64 + lane) * 4;
                const f32x4 o = v[r][j] * rs * *(const f32x4*)(g + col) * (*(const f32x4*)(sc + b * D6 + col) + 1.f) + *(const f32x4*)(sh + b * D6 + col);
                st_bf4(hb + (size_t)t * D + col, o); if (hf) *(f32x4*)(hf + (size_t)t * D + col) = o; }
        }
    }
}
template <int MODE>
__device__ __forceinline__ void ph_comb_norm(const Ctx& c, const float* xmid, const float* g2, float* xout, const float* g, const float* sh, const float* sc, bf16_t* hb, float* outp) {
    const bf16_t* YE = WSH(O_YE); const float* EWT = WSF(O_EWT); const int* DEST = WSI(O_DEST);
    const int lane = threadIdx.x & 63, gw = blockIdx.x * (NT / 64) + (threadIdx.x >> 6), ngw = gridDim.x * (NT / 64);
    for (int t = gw; t < T; t += ngw) {
        const int b = t / S; const float w0 = EWT[t * 2], w1 = EWT[t * 2 + 1]; const bf16_t* y0 = YE + (size_t)DEST[t * 2] * D; const bf16_t* y1 = YE + (size_t)DEST[t * 2 + 1] * D;
        f32x4 v[8]; float ss = 0.f;
#pragma unroll
        for (int j = 0; j < 8; ++j) { const int col = (j * 64 + lane) * 4;
            v[j] = *(const f32x4*)(xmid + (size_t)t * D + col) + *(const f32x4*)(g2 + b * D6 + col) * (ld_bf4(y0 + col) * w0 + ld_bf4(y1 + col) * w1);
            if (MODE == 0) *(f32x4*)(xout + (size_t)t * D + col) = v[j];
            ss += (v[j][0] * v[j][0] + v[j][1] * v[j][1]) + (v[j][2] * v[j][2] + v[j][3] * v[j][3]); }
        const float rs = 1.f / sqrtf(wave_sum(ss) * (1.f / D) + EPS);
#pragma unroll
        for (int j = 0; j < 8; ++j) { const int col = (j * 64 + lane) * 4;
            if (MODE == 0) st_bf4(hb + (size_t)t * D + col, v[j] * rs * *(const f32x4*)(g + col) * (*(const f32x4*)(sc + b * D6 + col) + 1.f) + *(const f32x4*)(sh + b * D6 + col));
            else *(f32x4*)(outp + (size_t)t * D + col) = v[j] * rs * *(const f32x4*)(g + col); }
    }
}

struct CvtItem { const float* Wp; int ldw; bf16_t* WT; int ldt; int drow, k0, n0; };
constexpr int I_IN = 32 * (INW / 32), I_BR = 4 * 16 * 64, I_OUT = 32 * 64, I_GU = NE * 32 * 32, I_DN = NE * 8 * 64, I_LR = 32 * 8, I_WU = 2 * 32, I_WG = 64, I_BIG = I_IN + I_BR + I_OUT + I_GU + I_DN, I_ALL = I_BIG + I_LR + 2 * I_WU + I_WG;
__device__ __forceinline__ CvtItem cvt_decode(const Ctx& c, int l, int it) {
    CvtItem r;
    if (it < I_IN) { const int kb = it / (INW / 32), nb = it % (INW / 32); r.n0 = nb * 32; r.k0 = kb * 64; r.Wp = c.in[7] + (size_t)l * D * INW; r.ldw = INW; r.WT = WSH(O_WIN); r.ldt = D; r.drow = r.n0 < 10624 ? r.n0 : r.n0 + 128; return r; }
    it -= I_IN;
    if (it < I_BR) { const int sgm = it / 1024, q = it % 1024, kb = q / 64, nb = q % 64; r.n0 = nb * 32; r.k0 = kb * 64; r.Wp = c.in[28] + ((size_t)l * 4 + sgm) * W * D; r.ldw = D; r.WT = WSH(O_WBR) + sgm * W; r.ldt = 4 * W; r.drow = r.n0; return r; }
    it -= I_BR;
    if (it < I_OUT) { const int kb = it / 64, nb = it % 64; r.n0 = nb * 32; r.k0 = kb * 64; r.Wp = c.in[29] + (size_t)l * D * D; r.ldw = D; r.WT = WSH(O_WOUT); r.ldt = D; r.drow = r.n0; return r; }
    it -= I_OUT;
    if (it < I_GU) { const int e = it / 1024, q = it % 1024, kb = q / 32, nb = q % 32; r.n0 = nb * 32; r.k0 = kb * 64; r.Wp = c.in[34] + ((size_t)l * NE + e) * D * 1024; r.ldw = 1024; r.WT = WSH(O_WGU) + (size_t)e * 1024 * D; r.ldt = D;
        r.drow = r.n0 < 512 ? (r.n0 / 128) * 256 + (r.n0 % 128) : ((r.n0 - 512) / 128) * 256 + 128 + ((r.n0 - 512) % 128); return r; }
    it -= I_GU;
    if (it < I_DN) { const int e = it / 512, q = it % 512, kb = q / 64, nb = q % 64; r.n0 = nb * 32; r.k0 = kb * 64; r.Wp = c.in[35] + ((size_t)l * NE + e) * 512 * D; r.ldw = D; r.WT = WSH(O_WDN) + (size_t)e * D * 512; r.ldt = 512; r.drow = r.n0; return r; }
    it -= I_DN;
    if (it < I_LR) { const int m = it / 8, q = it % 8, kb = q / 4, nb = q % 4, z = m >> 4, ty = (m >> 3) & 1, n = m & 7; r.n0 = nb * 32; r.k0 = kb * 64; r.Wp = c.in[ty ? 12 : 10] + (((size_t)l * 2 + z) * 8 + n) * 128 * 128; r.ldw = 128;
        r.WT = WSH(O_WLR) + (size_t)m * 128 * 128; r.ldt = 128; r.drow = r.n0; return r; }
    it -= I_LR;
    if (it < 2 * I_WU) { const int ua = it / I_WU, q = it % I_WU, z = q / 32, nb = q % 32; r.n0 = nb * 32; r.k0 = 0; r.Wp = c.in[ua ? 23 : 21] + ((size_t)l * 2 + z) * 64 * W; r.ldw = W; r.WT = WSH(ua ? O_WAT : O_WUT) + (size_t)z * W * 64; r.ldt = 64; r.drow = r.n0; return r; }
    it -= 2 * I_WU;
    { const int kb = it / 32, nb = it % 32; r.n0 = nb * 32; r.k0 = kb * 64; r.Wp = c.in[24] + (size_t)l * 128 * W; r.ldw = W; r.WT = WSH(O_WGT); r.ldt = 128; r.drow = r.n0; return r; }
}
constexpr int J_IN = 16 * (INW / 128), J_BR = 4 * 8 * 16, J_OUT = 16 * 16, J_GU = NE * 16 * 8, J_DN = NE * 4 * 16, J_ALL = J_IN + J_BR + J_OUT + J_GU + J_DN;
__device__ __forceinline__ CvtItem cvt_decode_big(const Ctx& c, int l, int it) {
    CvtItem r;
    if (it < J_IN) { const int kb = it / (INW / 128), nb = it % (INW / 128); r.n0 = nb * 128; r.k0 = kb * 128; r.Wp = c.in[7] + (size_t)l * D * INW; r.ldw = INW; r.WT = WSH(O_WIN); r.ldt = D; r.drow = r.n0 < 10624 ? r.n0 : r.n0 + 128; return r; }
    it -= J_IN;
    if (it < J_BR) { const int sgm = it / 128, q = it % 128, kb = q / 16, nb = q % 16; r.n0 = nb * 128; r.k0 = kb * 128; r.Wp = c.in[28] + ((size_t)l * 4 + sgm) * W * D; r.ldw = D; r.WT = WSH(O_WBR) + sgm * W; r.ldt = 4 * W; r.drow = r.n0; return r; }
    it -= J_BR;
    if (it < J_OUT) { const int kb = it / 16, nb = it % 16; r.n0 = nb * 128; r.k0 = kb * 128; r.Wp = c.in[29] + (size_t)l * D * D; r.ldw = D; r.WT = WSH(O_WOUT); r.ldt = D; r.drow = r.n0; return r; }
    it -= J_OUT;
    if (it < J_GU) { const int e = it / 128, q = it % 128, kb = q / 8, nb = q % 8; r.n0 = nb * 128; r.k0 = kb * 128; r.Wp = c.in[34] + ((size_t)l * NE + e) * D * 1024; r.ldw = 1024; r.WT = WSH(O_WGU) + (size_t)e * 1024 * D; r.ldt = D;
        r.drow = r.n0 < 512 ? (r.n0 / 128) * 256 : ((r.n0 - 512) / 128) * 256 + 128; return r; }
    it -= J_GU;
    { const int e = it / 64, q = it % 64, kb = q / 16, nb = q % 16; r.n0 = nb * 128; r.k0 = kb * 128; r.Wp = c.in[35] + ((size_t)l * NE + e) * 512 * D; r.ldw = D; r.WT = WSH(O_WDN) + (size_t)e * D * 512; r.ldt = 512; r.drow = r.n0; return r; }
}
__device__ __forceinline__ void ph_convert(const Ctx& c, int l, float* ldsf) {
    const int lane = threadIdx.x & 63, wave = threadIdx.x >> 6; const int gw = blockIdx.x * (NT / 64) + wave, ngw = gridDim.x * (NT / 64);
    {
        const int tid = threadIdx.x, lr = tid >> 5, lc = (tid & 31) * 4;
        f32x4 rg[8]; int it = blockIdx.x; CvtItem r;
        if (it < J_ALL) { r = cvt_decode_big(c, l, it);
#pragma unroll
            for (int i = 0; i < 8; ++i) rg[i] = *(const f32x4*)(r.Wp + (size_t)(r.k0 + lr + 16 * i) * r.ldw + r.n0 + lc); }
        for (; it < J_ALL; it += gridDim.x) {
#pragma unroll
            for (int i = 0; i < 8; ++i) { float* dp = ldsf + (lr + 16 * i) * 129 + lc; dp[0] = rg[i][0]; dp[1] = rg[i][1]; dp[2] = rg[i][2]; dp[3] = rg[i][3]; }
            const CvtItem cur = r; const int nx = it + gridDim.x;
            if (nx < J_ALL) { r = cvt_decode_big(c, l, nx);
#pragma unroll
                for (int i = 0; i < 8; ++i) rg[i] = *(const f32x4*)(r.Wp + (size_t)(r.k0 + lr + 16 * i) * r.ldw + r.n0 + lc); }
            SYNCTHREADS();
#pragma unroll
            for (int q = 0; q < 4; ++q) { const int id = tid + NT * q, n = id >> 4, k8 = (id & 15) * 8; const float* sp = ldsf + k8 * 129 + n;
                u32x4 o; o[0] = pk2(sp[0 * 129], sp[1 * 129]); o[1] = pk2(sp[2 * 129], sp[3 * 129]); o[2] = pk2(sp[4 * 129], sp[5 * 129]); o[3] = pk2(sp[6 * 129], sp[7 * 129]);
                *(u32x4*)(cur.WT + (size_t)(cur.drow + n) * cur.ldt + cur.k0 + k8) = o; }
            SYNCTHREADS();
        }
    }
#ifdef CPU_EMU
    if (lane == 0) for (int it = I_BIG + gw; it < I_ALL; it += ngw) { const CvtItem r = cvt_decode(c, l, it);
        for (int kk = 0; kk < 64; ++kk) for (int nn = 0; nn < 32; ++nn) r.WT[(size_t)(r.drow + nn) * r.ldt + r.k0 + kk] = (bf16_t)f2bf(r.Wp[(size_t)(r.k0 + kk) * r.ldw + r.n0 + nn]); }
#else
    float* scr = ldsf + wave * (64 * 33 + 16);
    for (int it = I_BIG + gw; it < I_ALL; it += ngw) {
        const CvtItem r = cvt_decode(c, l, it);
#pragma unroll 8
        for (int i = 0; i < 32; ++i) { const int kk = 2 * i + (lane >> 5); scr[kk * 33 + (lane & 31)] = r.Wp[(size_t)(r.k0 + kk) * r.ldw + r.n0 + (lane & 31)]; }
        asm volatile("s_waitcnt lgkmcnt(0)" ::: "memory");
        const int cc = lane & 7;
#pragma unroll
        for (int j = 0; j < 4; ++j) { const int n = (lane >> 3) + 8 * j; const float* sp = scr + (8 * cc) * 33 + n;
            u32x4 o; o[0] = pk2(sp[0 * 33], sp[1 * 33]); o[1] = pk2(sp[2 * 33], sp[3 * 33]); o[2] = pk2(sp[4 * 33], sp[5 * 33]); o[3] = pk2(sp[6 * 33], sp[7 * 33]);
            *(u32x4*)(r.WT + (size_t)(r.drow + n) * r.ldt + r.k0 + 8 * cc) = o; }
        asm volatile("s_waitcnt lgkmcnt(0)" ::: "memory");
    }
#endif
    { const float* wg = c.in[30] + (size_t)l * D * 4; const float* we = c.in[32] + (size_t)l * D * 32; bf16_t* wh = WSH(O_WRH); bf16_t* wl = WSH(O_WRL);
      for (long i = GT_; i < (long)48 * D; i += GS_) { const int n = (int)(i / D), k = (int)(i % D); const float w = n < 4 ? wg[k * 4 + n] : n < 36 ? we[k * 32 + (n - 4)] : 0.f; const unsigned hb = f2bf(w); wh[i] = (bf16_t)hb; wl[i] = (bf16_t)f2bf(w - bf2f((bf16_t)hb)); } }
    for (long i = GT_; i < (long)128 * D / 2; i += GS_) ((unsigned*)(WSH(O_WIN) + (size_t)10624 * D))[i] = 0u;
}

namespace pg8 {
constexpr int BM = 256, BK = 64, HALF = 128, HTB = HALF * BK * 2, STAGE_BYTES = 8 * HTB;
__host__ __device__ __forceinline__ int lds_byte(int r, int cc) { const int st = (r >> 4) * 2 + (cc >> 5), rr = r & 15, c2 = cc & 31, ob = rr * 64 + c2 * 2; return st * 1024 + (ob ^ (((ob >> 9) & 1) << 5)); }
__host__ __device__ __forceinline__ void stage_rc(int b, int& R, int& C) { const int st = b / 1024, sb = b % 1024, swz = sb ^ (((sb >> 9) & 1) << 5); R = (st >> 1) * 16 + swz / 64; C = (st & 1) * 32 + (swz % 64) / 2; }
__host__ __device__ __forceinline__ int perm32(int rho) { const int n = rho >> 4, i = rho & 15; return 8 * (i >> 2) + 4 * n + (i & 3); }
struct Unit { int pm, pn, aux; const char* A; const char* B; };
struct Gemm { int K, lda, ldb; };

template <class Epi, class Sched>
__device__ __forceinline__ void gemm_phase(unsigned char* lds_, const Gemm g, const Sched& S, const Epi& E) {
#ifdef CPU_EMU
    if (threadIdx.x != 0) return;
    Unit u; const int K = g.K;
    float* Af = (float*)malloc((size_t)256 * K * 4); float* Bf = (float*)malloc((size_t)256 * K * 4); float* Cf = (float*)malloc(256 * 256 * 4);
    for (int i = 0; S.next(i, u); ++i) {
        const bf16_t* A = (const bf16_t*)u.A; const bf16_t* B = (const bf16_t*)u.B;
        for (int r = 0; r < 256; ++r) for (int k = 0; k < K; ++k) { Af[(size_t)r * K + k] = bf2f(A[(size_t)r * g.lda + k]); Bf[(size_t)r * K + k] = bf2f(B[(size_t)r * g.ldb + k]); }
        for (int r = 0; r < 256; ++r) for (int cc = 0; cc < 256; ++cc) { const float* a = Af + (size_t)r * K; const float* b = Bf + (size_t)cc * K; float sacc = 0.f; for (int k = 0; k < K; ++k) sacc += a[k] * b[k]; Cf[r * 256 + cc] = sacc; }
        for (int wid = 0; wid < 8; ++wid) for (int lane = 0; lane < 64; ++lane) {
            const int wr = wid >> 2, wc = wid & 3, fr = lane & 15, fq = lane >> 4; f32x4 acc[2][2][4][2];
            for (int ai = 0; ai < 2; ++ai) for (int bj = 0; bj < 2; ++bj) for (int m = 0; m < 4; ++m) for (int n = 0; n < 2; ++n) for (int j = 0; j < 4; ++j) {
                const int r = 128 * ai + 64 * wr + 16 * m + fr, cc = 128 * bj + 32 * wc + (Epi::PERM ? 8 * fq + 4 * n + j : 16 * n + 4 * fq + j); acc[ai][bj][m][n][j] = Cf[r * 256 + cc]; }
            E(acc, u, wr, wc, fr, fq);
        }
    }
    free(Af); free(Bf); free(Cf);
#else
    typedef __attribute__((address_space(3))) unsigned char* ldsp_t;
    ldsp_t lds = (ldsp_t)lds_;
    const int tid = threadIdx.x, wid = __builtin_amdgcn_readfirstlane(tid >> 6), lane = tid & 63, wr = wid >> 2, wc = wid & 3, fr = lane & 15, fq = lane >> 4;
    const int K = g.K, nt = K / BK;
    unsigned voffA[2], voffB[2];
#pragma unroll
    for (int i = 0; i < 2; ++i) { int R, C; stage_rc(tid * 16 + i * 8192, R, C); const int Rb = Epi::PERM ? ((R & ~31) + perm32(R & 31)) : R;
        voffA[i] = (unsigned)(R * g.lda + C) * 2u; voffB[i] = (unsigned)(Rb * g.ldb + C) * 2u; }
    const size_t kstep = (size_t)(BK * 2);
    const size_t hstepA = (size_t)HALF * g.lda * 2, hstepB = (size_t)HALF * g.ldb * 2;
    const unsigned ldsw = (unsigned)wid * 1024u;
    const int aoff = lds_byte(wr * 64 + fr, fq * 8), boff = lds_byte(wc * 32 + fr, fq * 8);
#define PG8_SA(b, h) (((b) * 2 + (h)) * HTB)
#define PG8_SB(b, h) ((4 + (b) * 2 + (h)) * HTB)
#define PG8_STAGE(bufoff, gbase, voff) do { _Pragma("unroll") for (int _i = 0; _i < 2; ++_i) \
        __builtin_amdgcn_global_load_lds((const unsigned*)((const char*)(gbase) + (voff)[_i]), (__attribute__((address_space(3))) unsigned*)(lds + (bufoff) + ldsw + _i * 8192), 16, 0, 0); } while (0)
#define PG8_LDA(dst, b, h) do { _Pragma("unroll") for (int m = 0; m < 4; ++m) _Pragma("unroll") for (int k = 0; k < 2; ++k) dst[m][k] = *(const __attribute__((address_space(3))) bf16x8*)(lds + PG8_SA(b, h) + aoff + m * 2048 + k * 1024); } while (0)
#define PG8_LDB(dst, b, h) do { _Pragma("unroll") for (int n = 0; n < 2; ++n) _Pragma("unroll") for (int k = 0; k < 2; ++k) dst[n][k] = *(const __attribute__((address_space(3))) bf16x8*)(lds + PG8_SB(b, h) + boff + n * 2048 + k * 1024); } while (0)
#define PG8_MMA(ai, bj, At, Bt) do { __builtin_amdgcn_s_setprio(1); _Pragma("unroll") for (int m = 0; m < 4; ++m) _Pragma("unroll") for (int n = 0; n < 2; ++n) _Pragma("unroll") for (int k = 0; k < 2; ++k) \
        acc[ai][bj][m][n] = __builtin_amdgcn_mfma_f32_16x16x32_bf16(Bt[n][k], At[m][k], acc[ai][bj][m][n], 0, 0, 0); __builtin_amdgcn_s_setprio(0); } while (0)
#define PG8_WAIT_V(n) asm volatile("s_waitcnt vmcnt(" #n ")" ::: "memory")
#define PG8_WAIT_L(n) asm volatile("s_waitcnt lgkmcnt(" #n ")" ::: "memory")
#define PG8_BAR __builtin_amdgcn_s_barrier()
#define PG8_SCHED __builtin_amdgcn_sched_barrier(0)
    Unit cur, nxt; int ui = 0;
    if (!S.next(0, cur)) return;
    f32x4 acc[2][2][4][2];
#pragma unroll
    for (int a = 0; a < 2; ++a)
#pragma unroll
        for (int b = 0; b < 2; ++b)
#pragma unroll
            for (int m = 0; m < 4; ++m)
#pragma unroll
                for (int n = 0; n < 2; ++n) acc[a][b][m][n] = (f32x4){0.f, 0.f, 0.f, 0.f};
    bf16x8 At[4][2], B0[2][2], B1[2][2];
    const char* cA = cur.A; const char* cB = cur.B;
    S.a_ready(cur);
    PG8_STAGE(PG8_SB(0, 0), cB, voffB); PG8_STAGE(PG8_SA(0, 0), cA, voffA); PG8_STAGE(PG8_SB(0, 1), cB + hstepB, voffB); PG8_STAGE(PG8_SA(0, 1), cA + hstepA, voffA);
    if (wr == 1) PG8_BAR;
    PG8_WAIT_V(4); PG8_BAR;
    PG8_STAGE(PG8_SB(1, 0), cB + kstep, voffB); PG8_STAGE(PG8_SA(1, 0), cA + kstep, voffA); PG8_STAGE(PG8_SB(1, 1), cB + hstepB + kstep, voffB);
    PG8_WAIT_V(6); PG8_BAR;
    for (;;) {
        const bool has_next = S.next(ui + 1, nxt);
        const char* nA = has_next ? nxt.A : cA; const char* nB = has_next ? nxt.B : cB;
        for (int t = 0; t < nt; t += 2) {
            const bool last = (t == nt - 2);
            const char* a1 = cA + (size_t)(t + 1) * kstep;
            const char* a2 = last ? nA : cA + (size_t)(t + 2) * kstep; const char* b2 = last ? nB : cB + (size_t)(t + 2) * kstep;
            const char* a3 = a2 + kstep; const char* b3 = b2 + kstep;
            if (last && has_next) S.a_ready(nxt);
            PG8_LDB(B0, 0, 0); PG8_SCHED; PG8_LDA(At, 0, 0); PG8_STAGE(PG8_SA(1, 1), a1 + hstepA, voffA);
            PG8_WAIT_L(8); PG8_BAR; PG8_WAIT_L(0); PG8_MMA(0, 0, At, B0); PG8_BAR; PG8_SCHED;
            PG8_LDB(B1, 0, 1); PG8_STAGE(PG8_SB(0, 0), b2, voffB);
            PG8_BAR; PG8_WAIT_L(0); PG8_MMA(0, 1, At, B1); PG8_BAR;
            PG8_LDA(At, 0, 1); PG8_STAGE(PG8_SA(0, 0), a2, voffA);
            PG8_BAR; PG8_WAIT_L(0); PG8_MMA(1, 0, At, B0); PG8_BAR; PG8_SCHED;
            PG8_STAGE(PG8_SB(0, 1), b2 + hstepB, voffB);
            PG8_WAIT_V(6); PG8_BAR; PG8_MMA(1, 1, At, B1); PG8_BAR;
            PG8_LDB(B0, 1, 0); PG8_SCHED; PG8_LDA(At, 1, 0); PG8_STAGE(PG8_SA(0, 1), a2 + hstepA, voffA);
            PG8_WAIT_L(8); PG8_BAR; PG8_WAIT_L(0); PG8_MMA(0, 0, At, B0); PG8_BAR; PG8_SCHED;
            PG8_LDB(B1, 1, 1); PG8_STAGE(PG8_SB(1, 0), b3, voffB);
            PG8_BAR; PG8_WAIT_L(0); PG8_MMA(0, 1, At, B1); PG8_BAR;
            PG8_LDA(At, 1, 1); PG8_STAGE(PG8_SA(1, 0), a3, voffA);
            PG8_BAR; PG8_WAIT_L(0); PG8_MMA(1, 0, At, B0); PG8_BAR; PG8_SCHED;
            PG8_STAGE(PG8_SB(1, 1), b3 + hstepB, voffB);
            PG8_WAIT_V(6); PG8_BAR; PG8_MMA(1, 1, At, B1); PG8_BAR;
        }
        E(acc, cur, wr, wc, fr, fq); S.done(cur);
        if (!has_next) break;
#pragma unroll
        for (int a = 0; a < 2; ++a)
#pragma unroll
            for (int b = 0; b < 2; ++b)
#pragma unroll
                for (int m = 0; m < 4; ++m)
#pragma unroll
                    for (int n = 0; n < 2; ++n) acc[a][b][m][n] = (f32x4){0.f, 0.f, 0.f, 0.f};
        cur = nxt; cA = nA; cB = nB; ++ui;
    }
    PG8_WAIT_V(0);
    if (wr == 0) PG8_BAR;
    PG8_BAR;
#undef PG8_SA
#undef PG8_SB
#undef PG8_STAGE
#undef PG8_LDA
#undef PG8_LDB
#undef PG8_MMA
#undef PG8_WAIT_V
#undef PG8_WAIT_L
#undef PG8_BAR
#undef PG8_SCHED
#endif
}

struct StaticOrder {
    int nM, nN, nwg, G, c; const char* A; const char* B; size_t tstepA, tstepB;
    __device__ __forceinline__ void init(int M, int N, int G_, int c_, const void* A_, const void* B_, int lda, int ldb) { nM = M / BM; nN = N / BM; nwg = nM * nN; G = G_; c = c_; A = (const char*)A_; B = (const char*)B_; tstepA = (size_t)BM * lda * 2; tstepB = (size_t)BM * ldb * 2; }
    __device__ __forceinline__ bool next(int i, Unit& u) const {
        const long L = (long)i * G + c; if (L >= nwg) return false;
        int wgid = (int)L; { const int q = nwg / 8, r = nwg % 8, xcd = wgid % 8, off = wgid / 8; wgid = (xcd < r ? xcd * (q + 1) : r * (q + 1) + (xcd - r) * q) + off; }
        const int nig = 8 * nN, gid = wgid / nig, fm = gid * 8, gsz = (nM - fm) < 8 ? (nM - fm) : 8;
        u.pm = fm + ((wgid % nig) % gsz); u.pn = (wgid % nig) / gsz; u.aux = 0; u.A = A + (size_t)u.pm * tstepA; u.B = B + (size_t)u.pn * tstepB; return true;
    }
    __device__ __forceinline__ void a_ready(const Unit&) const {}
    __device__ __forceinline__ void done(const Unit&) const {}
};
struct MergeOrder {
    StaticOrder so; int kseg_bytes;
    __device__ __forceinline__ bool next(int i, Unit& u) const { if (!so.next(i >> 2, u)) return false; u.aux = i & 3; u.A += (size_t)u.aux * kseg_bytes; u.B += (size_t)u.aux * kseg_bytes; return true; }
    __device__ __forceinline__ void a_ready(const Unit&) const {}
    __device__ __forceinline__ void done(const Unit&) const {}
};
struct MoeOrder {
    int G, c, ncol; const int* plan; const char* A; const char* B; size_t tstepA, tstepB, estep;
    __device__ __forceinline__ bool next(int i, Unit& u) const {
        const long L = (long)i * G + c; const int nblk = plan[40]; if (L >= (long)nblk * ncol) return false;
        u.pm = (int)(L / ncol); u.pn = (int)(L % ncol); u.aux = plan[64 + u.pm]; u.A = A + (size_t)u.pm * tstepA; u.B = B + (size_t)u.aux * estep + (size_t)u.pn * tstepB; return true;
    }
    __device__ __forceinline__ void a_ready(const Unit&) const {}
    __device__ __forceinline__ void done(const Unit&) const {}
};

__device__ __forceinline__ u32x4 pack8(const f32x4 v0, const f32x4 v1) { u32x4 w; w[0] = pk2(v0[0], v0[1]); w[1] = pk2(v0[2], v0[3]); w[2] = pk2(v1[0], v1[1]); w[3] = pk2(v1[2], v1[3]); return w; }
struct EpiBf16 {
    static constexpr bool PERM = true; bf16_t* O; int ldc;
    __device__ __forceinline__ void operator()(const f32x4 (&acc)[2][2][4][2], const Unit& u, int wr, int wc, int fr, int fq) const {
        const int row0 = u.pm * BM + wr * 64 + fr, col0 = u.pn * BM + wc * 32 + 8 * fq;
#pragma unroll
        for (int ai = 0; ai < 2; ++ai)
#pragma unroll
            for (int m = 0; m < 4; ++m) { bf16_t* rowp = O + (size_t)(row0 + ai * HALF + m * 16) * ldc + col0;
#pragma unroll
                for (int bj = 0; bj < 2; ++bj) *(u32x4*)(rowp + bj * HALF) = pack8(acc[ai][bj][m][0], acc[ai][bj][m][1]); }
    }
};
struct EpiMerge {
    static constexpr bool PERM = true; const bf16_t* P; float* PART; bf16_t* MRG;
    __device__ __forceinline__ void operator()(const f32x4 (&acc)[2][2][4][2], const Unit& u, int wr, int wc, int fr, int fq) const {
        const int row0 = u.pm * BM + wr * 64 + fr, col0 = u.pn * BM + wc * 32 + 8 * fq, seg = u.aux;
#pragma unroll
        for (int ai = 0; ai < 2; ++ai)
#pragma unroll
            for (int m = 0; m < 4; ++m) { const size_t r = (size_t)(row0 + ai * HALF + m * 16);
#pragma unroll
                for (int bj = 0; bj < 2; ++bj) { const int cc = col0 + bj * HALF;
                    const u32x4 gw = *(const u32x4*)(P + r * PW + C_MLP + seg * D + cc);
                    f32x4 v0, v1;
#pragma unroll
                    for (int q = 0; q < 2; ++q) { v0[2 * q] = sigmoidf_(bflo(gw[q])) * acc[ai][bj][m][0][2 * q]; v0[2 * q + 1] = sigmoidf_(bfhi(gw[q])) * acc[ai][bj][m][0][2 * q + 1];
                        v1[2 * q] = sigmoidf_(bflo(gw[2 + q])) * acc[ai][bj][m][1][2 * q]; v1[2 * q + 1] = sigmoidf_(bfhi(gw[2 + q])) * acc[ai][bj][m][1][2 * q + 1]; }
                    float* pp = PART + r * D + cc;
                    if (seg > 0) { v0 += *(const f32x4*)pp; v1 += *(const f32x4*)(pp + 4); }
                    if (seg < 3) { *(f32x4*)pp = v0; *(f32x4*)(pp + 4) = v1; } else *(u32x4*)(MRG + r * D + cc) = pack8(v0, v1);
                }
#ifndef CPU_EMU
                asm volatile("" ::: "memory");
#endif
            }
    }
};
struct EpiResid {
    static constexpr bool PERM = false; const float* xin; const float* g1; float* xmid;
    __device__ __forceinline__ void operator()(const f32x4 (&acc)[2][2][4][2], const Unit& u, int wr, int wc, int fr, int fq) const {
        const int row0 = u.pm * BM + wr * 64 + fr, col0 = u.pn * BM + wc * 32 + 4 * fq;
#pragma unroll
        for (int ai = 0; ai < 2; ++ai)
#pragma unroll
            for (int m = 0; m < 4; ++m) { const int r = row0 + ai * HALF + m * 16; const float* gp = g1 + (size_t)(r / S) * D6;
#pragma unroll
                for (int bj = 0; bj < 2; ++bj)
#pragma unroll
                    for (int n = 0; n < 2; ++n) { const int cc = col0 + bj * HALF + n * 16; *(f32x4*)(xmid + (size_t)r * D + cc) = *(const f32x4*)(xin + (size_t)r * D + cc) + *(const f32x4*)(gp + cc) * acc[ai][bj][m][n]; }
#ifndef CPU_EMU
                asm volatile("" ::: "memory");
#endif
            }
    }
};
struct EpiGU {
    static constexpr bool PERM = true; bf16_t* ACT;
    __device__ __forceinline__ void operator()(const f32x4 (&acc)[2][2][4][2], const Unit& u, int wr, int wc, int fr, int fq) const {
        const int row0 = u.pm * BM + wr * 64 + fr, col0 = u.pn * HALF + wc * 32 + 8 * fq;
#pragma unroll
        for (int ai = 0; ai < 2; ++ai)
#pragma unroll
            for (int m = 0; m < 4; ++m) { f32x4 v0, v1;
#pragma unroll
                for (int j = 0; j < 4; ++j) { v0[j] = siluf_(acc[ai][0][m][0][j]) * acc[ai][1][m][0][j]; v1[j] = siluf_(acc[ai][0][m][1][j]) * acc[ai][1][m][1][j]; }
                *(u32x4*)(ACT + (size_t)(row0 + ai * HALF + m * 16) * 512 + col0) = pack8(v0, v1); }
    }
};
}

template <int PASS>
__device__ __forceinline__ void ph_lru(const Ctx& c, int l, float* ldsf) {
    const bf16_t* P = WSH(O_P); const float* cw = c.in[8] + (size_t)l * 4 * W; const float* cb = c.in[9] + (size_t)l * W;
    const float* br = c.in[11] + (size_t)l * 2 * W; const float* bi = c.in[13] + (size_t)l * 2 * W; const float* lam = c.in[14] + (size_t)l * 2 * W; const bf16_t* WLR = WSH(O_WLR);
    float* CA = WSF(O_LCA); float* CH = WSF(O_LCH); const float* CI = WSF(O_LCI); bf16_t* Y = WSH(O_YS);
    bf16_t* Xs = (bf16_t*)ldsf; bf16_t* Wr = Xs + 64 * 136; bf16_t* Wi = Wr + 128 * 136; float* AUa = (float*)Wr; float* AUu = AUa + 64 * 128; float* HF = (float*)(Wi + 128 * 136); float* spl = HF + 64 * 128;
    const int tid = threadIdx.x, wv = tid >> 6, lane = tid & 63, fr = lane & 15, fq = lane >> 4, rt = wv & 3, hf = wv >> 2;
    for (int u = blockIdx.x; u < (T / 64) * 8; u += gridDim.x) {
        const int n = u & 7, tile = u >> 3, b = tile / NLC, chk = tile % NLC; const long t0 = (long)tile * 64;
        if (tid < 256) spl[tid] = softplusf_(-lam[(tid >> 7) * W + n * 128 + (tid & 127)]);
#pragma unroll
        for (int q = 0; q < 4; ++q) { const int id = tid + NT * q, tl = id >> 5, e4 = (id & 31) * 4, ch = n * 128 + e4; const long t = t0 + tl; const int sI = (int)(t % S);
            f32x4 acc = *(const f32x4*)(cb + ch);
#pragma unroll
            for (int k = 0; k < 4; ++k) { const int ss = sI + k - 2; if (ss >= 0 && ss < S) acc += ld_bf4(P + (size_t)(t + k - 2) * PW + C_LX + ch) * *(const f32x4*)(cw + k * W + ch); }
            st_bf4(Xs + tl * 136 + e4, acc); }
        for (int z = 0; z < 2; ++z) {
#pragma unroll
            for (int q = 0; q < 4; ++q) { const int id = tid + NT * q, f = id >> 4, e8 = (id & 15) * 8;
                *(u32x4*)(Wr + f * 136 + e8) = *(const u32x4*)(WLR + ((size_t)((z * 2 + 0) * 8 + n) * 128 + f) * 128 + e8); *(u32x4*)(Wi + f * 136 + e8) = *(const u32x4*)(WLR + ((size_t)((z * 2 + 1) * 8 + n) * 128 + f) * 128 + e8); }
            SYNCTHREADS();
            f32x4 ar[4], ai[4];
#pragma unroll
            for (int nt = 0; nt < 4; ++nt) { ar[nt] = (f32x4){0.f, 0.f, 0.f, 0.f}; ai[nt] = (f32x4){0.f, 0.f, 0.f, 0.f}; }
            wave_mma<4, 4>(ar, Xs + rt * 16 * 136, 136, Wr + hf * 64 * 136, 136);
            wave_mma<4, 4>(ai, Xs + rt * 16 * 136, 136, Wi + hf * 64 * 136, 136);
            SYNCTHREADS();
            const int tl = rt * 16 + fr;
#pragma unroll
            for (int nt = 0; nt < 4; ++nt) { const int f = 64 * hf + 16 * nt + 4 * fq, ch = n * 128 + f;
                const f32x4 brv = *(const f32x4*)(br + z * W + ch), biv = *(const f32x4*)(bi + z * W + ch), lmv = *(const f32x4*)(spl + z * 128 + f), xcv = ld_bf4(Xs + tl * 136 + f); f32x4 av, uv;
#pragma unroll
                for (int e = 0; e < 4; ++e) { const float r = sigmoidf_(ar[nt][e] + brv[e]), ig = sigmoidf_(ai[nt][e] + biv[e]), la = -8.f * r * lmv[e]; const float a = fexp_(la); av[e] = a; uv[e] = sqrtf(fmaxf(1.f - a * a, 0.f)) * ig * xcv[e]; }
                *(f32x4*)(AUa + tl * 128 + f) = av; *(f32x4*)(AUu + tl * 128 + f) = uv; }
            SYNCTHREADS();
            if (tid < 128) { const int f = tid; const size_t ci = (((size_t)z * NB + b) * NLC + chk) * W + n * 128 + f;
                if (PASS == 1) { float prod = 1.f, h = 0.f;
#pragma unroll 8
                    for (int q = 0; q < 64; ++q) { const int sI = z == 0 ? q : 63 - q; const float a = AUa[sI * 128 + f]; h = a * h + AUu[sI * 128 + f]; prod *= a; }
                    CA[ci] = prod; CH[ci] = h;
                } else { float h = CI[ci];
                    if (z == 0) {
#pragma unroll 8
                        for (int q = 0; q < 64; ++q) { h = AUa[q * 128 + f] * h + AUu[q * 128 + f]; HF[q * 128 + f] = h; }
                    } else {
#pragma unroll 8
                        for (int q = 63; q >= 0; --q) { h = AUa[q * 128 + f] * h + AUu[q * 128 + f]; HF[q * 128 + f] += h; } } }
            }
            SYNCTHREADS();
        }
        if (PASS == 2) {
#pragma unroll
            for (int q = 0; q < 4; ++q) { const int id = tid + NT * q, tl = id >> 5, f4 = (id & 31) * 4; const long t = t0 + tl; f32x4 hv = *(const f32x4*)(HF + tl * 128 + f4); const f32x4 gv = ld_bf4(P + (size_t)t * PW + C_LG + n * 128 + f4);
#pragma unroll
                for (int e = 0; e < 4; ++e) hv[e] *= geluf_(gv[e]);
                st_bf4(Y + (size_t)t * 4 * W + 0 * W + n * 128 + f4, hv); }
            SYNCTHREADS();
        }
    }
}
__device__ __forceinline__ void ph_lru_scan2(const Ctx& c) {
    const float* CA = WSF(O_LCA); const float* CH = WSF(O_LCH); float* CI = WSF(O_LCI);
    for (long i = GT_; i < (long)2 * NB * W; i += GS_) {
        const int w = (int)(i % W), b = (int)((i / W) % NB), z = (int)(i / ((long)W * NB)); float carry = 0.f;
        for (int q = 0; q < NLC; ++q) { const int ch = z == 0 ? q : NLC - 1 - q; const size_t idx = (((size_t)z * NB + b) * NLC + ch) * W + w; CI[idx] = carry; carry = CA[idx] * carry + CH[idx]; }
    }
}
__device__ __forceinline__ void ret_tables(float* tab, int h) {
    const int tid = threadIdx.x; const float lg = loggamma_(h);
    if (tid < 32) tab[tid] = powf(10000.f, -(float)(2 * tid) / 64.f);
    if (tid >= 64 && tid < 64 + 129) tab[tid] = expf((float)(tid - 64) * lg);
}
__device__ __forceinline__ void ph_ret_kv(const Ctx& c, float* ldsf) {
    const int* pos = (const int*)c.in[2]; const bf16_t* P = WSH(O_P); float* KVF = WSF(O_KVF); float* KVB = WSF(O_KVB);
    bf16_t* VT = (bf16_t*)ldsf; bf16_t* KF = VT + 128 * 136; bf16_t* KB = KF + 64 * 136; float* tab = (float*)(KB + 64 * 136);
    const int tid = threadIdx.x, wv = tid >> 6, lane = tid & 63, fr = lane & 15, fq = lane >> 4;
    for (int u = blockIdx.x; u < (T / 128) * 8; u += gridDim.x) {
        const int h = u & 7; const long t0 = (long)(u >> 3) * 128;
        ret_tables(tab, h);
        SYNCTHREADS();
        { float x1[8], x2[8], pj[8];
#pragma unroll
          for (int q = 0; q < 8; ++q) { const int id = tid + NT * q, j = id & 127, dj = id >> 7; const bf16_t* prow = P + (size_t)(t0 + j) * PW + C_RK + h * 64; x1[q] = bf2f(prow[dj]); x2[q] = bf2f(prow[dj + 32]); pj[q] = (float)pos[t0 + j]; }
#pragma unroll 1
          for (int q = 0; q < 8; ++q) { const int id = tid + NT * q, j = id & 127, dj = id >> 7; const float ang = pj[q] * tab[dj]; const float cs = cosf(ang), sn = sinf(ang);
            const float k1 = x1[q] * cs - x2[q] * sn, k2 = x2[q] * cs + x1[q] * sn, fj = tab[64 + 127 - j], bj = tab[64 + j];
            KF[dj * 136 + j] = (bf16_t)f2bf(k1 * fj); KF[(dj + 32) * 136 + j] = (bf16_t)f2bf(k2 * fj); KB[dj * 136 + j] = (bf16_t)f2bf(k1 * bj); KB[(dj + 32) * 136 + j] = (bf16_t)f2bf(k2 * bj); } }
#pragma unroll
        for (int q = 0; q < 4; ++q) { const int id = tid + NT * q, j = id & 127, e8 = (id >> 7) * 8; const u32x4 raw = *(const u32x4*)(P + (size_t)(t0 + j) * PW + C_RV + h * 128 + e8);
#pragma unroll
            for (int e = 0; e < 4; ++e) { VT[(e8 + 2 * e) * 136 + j] = (bf16_t)(raw[e] & 0xffffu); VT[(e8 + 2 * e + 1) * 136 + j] = (bf16_t)(raw[e] >> 16); } }
        SYNCTHREADS();
        f32x4 af[4], ab[4];
#pragma unroll
        for (int nt = 0; nt < 4; ++nt) { af[nt] = (f32x4){0.f, 0.f, 0.f, 0.f}; ab[nt] = (f32x4){0.f, 0.f, 0.f, 0.f}; }
        wave_mma<4, 4>(af, VT + wv * 16 * 136, 136, KF, 136);
        wave_mma<4, 4>(ab, VT + wv * 16 * 136, 136, KB, 136);
        const size_t ob = (((size_t)(u >> 3) * 8 + h) * 128 + wv * 16 + fr) * 64 + 4 * fq;
#pragma unroll
        for (int nt = 0; nt < 4; ++nt) { *(f32x4*)(KVF + ob + 16 * nt) = af[nt]; *(f32x4*)(KVB + ob + 16 * nt) = ab[nt]; }
        SYNCTHREADS();
    }
}
__device__ __forceinline__ void ph_ret_state(const Ctx& c) {
    const float* KVF = WSF(O_KVF); const float* KVB = WSF(O_KVB); float* STF = WSF(O_STF); float* STB = WSF(O_STB);
    for (long i = GT_; i < (long)NB * 8 * 8192; i += GS_) {
        const int x = (int)(i % 8192), h = (int)((i / 8192) % 8), b = (int)(i / 65536);
        const float cd = expf(128.f * loggamma_(h)); float st = 0.f;
#pragma unroll 8
        for (int n = 0; n < NCH; ++n) { const size_t idx = (((size_t)b * NCH + n) * 8 + h) * 8192 + x; STF[idx] = st; st = cd * st + KVF[idx]; }
        st = 0.f;
#pragma unroll 8
        for (int n = NCH - 1; n >= 0; --n) { const size_t idx = (((size_t)b * NCH + n) * 8 + h) * 8192 + x; STB[idx] = st; st = cd * st + KVB[idx]; }
    }
}
__device__ __forceinline__ void ph_ret_out(const Ctx& c, float* ldsf) {
    const int* pos = (const int*)c.in[2]; const bf16_t* P = WSH(O_P); const float* STF = WSF(O_STF); const float* STB = WSF(O_STB); bf16_t* Y = WSH(O_YS);
    bf16_t* Qs = (bf16_t*)ldsf; bf16_t* Ks = Qs + 128 * 72; bf16_t* VT = Ks + 128 * 72; bf16_t* Ss = VT + 128 * 136; bf16_t* SF = Ss + 128 * 136; bf16_t* SB = SF + 128 * 72; float* tab = (float*)(SB + 128 * 72);
    const int tid = threadIdx.x, wv = tid >> 6, lane = tid & 63, fr = lane & 15, fq = lane >> 4;
    for (int u = blockIdx.x; u < (T / 128) * 8; u += gridDim.x) {
        const int h = u & 7; const long t0 = (long)(u >> 3) * 128;
        ret_tables(tab, h);
        SYNCTHREADS();
#pragma unroll 1
        for (int qh = 0; qh < 8; qh += 4) { float q1[4], q2[4], k1[4], k2[4], pj[4];
#pragma unroll
          for (int q = 0; q < 4; ++q) { const int id = tid + NT * (qh + q), j = id >> 5, dj = id & 31; const bf16_t* prow = P + (size_t)(t0 + j) * PW;
            q1[q] = bf2f(prow[C_RQ + h * 64 + dj]); q2[q] = bf2f(prow[C_RQ + h * 64 + dj + 32]); k1[q] = bf2f(prow[C_RK + h * 64 + dj]); k2[q] = bf2f(prow[C_RK + h * 64 + dj + 32]); pj[q] = (float)pos[t0 + j]; }
#pragma unroll
          for (int q = 0; q < 4; ++q) { const int id = tid + NT * (qh + q), j = id >> 5, dj = id & 31; const float ang = pj[q] * tab[dj]; const float cs = cosf(ang), sn = sinf(ang);
            Qs[j * 72 + dj] = (bf16_t)f2bf((q1[q] * cs - q2[q] * sn) * 0.125f); Qs[j * 72 + dj + 32] = (bf16_t)f2bf((q2[q] * cs + q1[q] * sn) * 0.125f); Ks[j * 72 + dj] = (bf16_t)f2bf(k1[q] * cs - k2[q] * sn); Ks[j * 72 + dj + 32] = (bf16_t)f2bf(k2[q] * cs + k1[q] * sn); } }
#pragma unroll
        for (int q = 0; q < 4; ++q) { const int id = tid + NT * q, j = id & 127, e8 = (id >> 7) * 8; const u32x4 raw = *(const u32x4*)(P + (size_t)(t0 + j) * PW + C_RV + h * 128 + e8);
#pragma unroll
            for (int e = 0; e < 4; ++e) { VT[(e8 + 2 * e) * 136 + j] = (bf16_t)(raw[e] & 0xffffu); VT[(e8 + 2 * e + 1) * 136 + j] = (bf16_t)(raw[e] >> 16); } }
        const size_t sbase = (((size_t)(u >> 3) * 8 + h)) * 8192;
#pragma unroll
        for (int q = 0; q < 4; ++q) { const int id = tid + NT * q, e = id >> 4, d4 = (id & 15) * 4; st_bf4(SF + e * 72 + d4, *(const f32x4*)(STF + sbase + (size_t)e * 64 + d4)); st_bf4(SB + e * 72 + d4, *(const f32x4*)(STB + sbase + (size_t)e * 64 + d4)); }
        SYNCTHREADS();
        const int i = wv * 16 + fr; const long t = t0 + i;
        {
            f32x4 sc[8];
#pragma unroll
            for (int nt = 0; nt < 8; ++nt) sc[nt] = (f32x4){0.f, 0.f, 0.f, 0.f};
            wave_mma<2, 8>(sc, Qs + wv * 16 * 72, 72, Ks, 72);
#pragma unroll
            for (int nt = 0; nt < 8; ++nt) { const int j0 = 16 * nt + 4 * fq; f32x4 sv;
#pragma unroll
                for (int e = 0; e < 4; ++e) { const int j = j0 + e, dist = i > j ? i - j : j - i; sv[e] = sc[nt][e] * tab[64 + dist]; }
                st_bf4(Ss + i * 136 + j0, sv); }
        }
#ifdef CPU_EMU
        SYNCTHREADS();
#else
        asm volatile("s_waitcnt lgkmcnt(0)" ::: "memory");
#endif
        f32x4 ao[8], tm[8];
#pragma unroll
        for (int nt = 0; nt < 8; ++nt) { ao[nt] = (f32x4){0.f, 0.f, 0.f, 0.f}; tm[nt] = (f32x4){0.f, 0.f, 0.f, 0.f}; }
        wave_mma<4, 8>(ao, Ss + wv * 16 * 136, 136, VT, 136);
        wave_mma<2, 8>(tm, Qs + wv * 16 * 72, 72, SF, 72);
        { const float qf = tab[64 + i + 1];
#pragma unroll
            for (int nt = 0; nt < 8; ++nt) { ao[nt] += tm[nt] * qf; tm[nt] = (f32x4){0.f, 0.f, 0.f, 0.f}; } }
        wave_mma<2, 8>(tm, Qs + wv * 16 * 72, 72, SB, 72);
        { const float qb = tab[64 + 128 - i];
#pragma unroll
            for (int nt = 0; nt < 8; ++nt) ao[nt] += tm[nt] * qb; }
        float sm = 0.f;
#pragma unroll
        for (int nt = 0; nt < 8; ++nt) sm += (ao[nt][0] + ao[nt][1]) + (ao[nt][2] + ao[nt][3]);
        sm += SHFL_XOR(sm, 16); sm += SHFL_XOR(sm, 32);
        const float mu = sm * (1.f / 128.f); float sq = 0.f;
#pragma unroll
        for (int nt = 0; nt < 8; ++nt) { ao[nt] -= mu; sq += (ao[nt][0] * ao[nt][0] + ao[nt][1] * ao[nt][1]) + (ao[nt][2] * ao[nt][2] + ao[nt][3] * ao[nt][3]); }
        sq += SHFL_XOR(sq, 16); sq += SHFL_XOR(sq, 32);
        const float rs = 1.f / sqrtf(sq * (1.f / 128.f) + EPS);
#pragma unroll
        for (int nt = 0; nt < 8; ++nt) { const int e0 = 16 * nt + 4 * fq; f32x4 gv = ld_bf4(P + (size_t)t * PW + C_RG + h * 128 + e0);
#pragma unroll
            for (int e = 0; e < 4; ++e) gv[e] = siluf_(gv[e]) * (ao[nt][e] * rs);
            st_bf4(Y + (size_t)t * 4 * W + 1 * W + h * 128 + e0, gv); }
        SYNCTHREADS();
    }
}
__device__ __forceinline__ void ph_sgu_norm(const Ctx& c, int l) {
    const bf16_t* P = WSH(O_P); float* ST = WSF(O_VN);
    const int lane = threadIdx.x & 63, gw = blockIdx.x * (NT / 64) + (threadIdx.x >> 6), ngw = gridDim.x * (NT / 64);
    for (int t = gw; t < T; t += ngw) {
        f32x4 v[4]; float sm = 0.f;
#pragma unroll
        for (int j = 0; j < 4; ++j) { v[j] = ld_bf4(P + (size_t)t * PW + C_SV + (j * 64 + lane) * 4);
#pragma unroll
            for (int q = 0; q < 4; ++q) { v[j][q] = geluf_(v[j][q]); sm += v[j][q]; } }
        const float mu = wave_sum(sm) * (1.f / W); float sq = 0.f;
#pragma unroll
        for (int j = 0; j < 4; ++j)
#pragma unroll
            for (int q = 0; q < 4; ++q) { const float dd = v[j][q] - mu; sq += dd * dd; }
        const float rs = 1.f / sqrtf(wave_sum(sq) * (1.f / W) + EPS);
        if (lane == 0) { ST[(size_t)t * 2] = mu; ST[(size_t)t * 2 + 1] = rs; }
    }
}
__device__ __forceinline__ void ph_sgu_mix(const Ctx& c, int l, float* ldsf) {
    const bf16_t* P = WSH(O_P); const float* ST = WSF(O_VN); bf16_t* Y = WSH(O_YS); const float* ng = c.in[15] + (size_t)l * W;
    bf16_t* As = (bf16_t*)ldsf; bf16_t* Bs = As + 128 * 136; const int tid = threadIdx.x, wv = tid >> 6, lane = tid & 63, fr = lane & 15, fq = lane >> 4;
    for (int u = blockIdx.x; u < (T / 128) * 8; u += gridDim.x) {
        const int g = u & 7; const long t0 = (long)(u >> 3) * 128;
        const float* ws = c.in[16] + ((size_t)l * 8 + g) * 128 * 128; const float* bs = c.in[17] + ((size_t)l * 8 + g) * 128;
#pragma unroll
        for (int q = 0; q < 8; ++q) { const int id = tid + NT * q, i = id >> 5, j4 = (id & 31) * 4; st_bf4(As + i * 136 + j4, *(const f32x4*)(ws + i * 128 + j4)); }
#pragma unroll
        for (int q = 0; q < 4; ++q) { const int id = tid + NT * q, j = id & 127, d8 = (id >> 7) * 8; const float mu = ST[(size_t)(t0 + j) * 2], rs = ST[(size_t)(t0 + j) * 2 + 1];
            const u32x4 raw = *(const u32x4*)(P + (size_t)(t0 + j) * PW + C_SV + g * 128 + d8);
#pragma unroll
            for (int e = 0; e < 4; ++e) { const float v0 = (geluf_(bflo(raw[e])) - mu) * rs * ng[g * 128 + d8 + 2 * e], v1 = (geluf_(bfhi(raw[e])) - mu) * rs * ng[g * 128 + d8 + 2 * e + 1];
                Bs[(d8 + 2 * e) * 136 + j] = (bf16_t)f2bf(v0); Bs[(d8 + 2 * e + 1) * 136 + j] = (bf16_t)f2bf(v1); } }
        SYNCTHREADS();
        f32x4 acc[8];
#pragma unroll
        for (int nt = 0; nt < 8; ++nt) acc[nt] = (f32x4){0.f, 0.f, 0.f, 0.f};
        wave_mma<4, 8>(acc, As + wv * 16 * 136, 136, Bs, 136);
        const int i = wv * 16 + fr; const long t = t0 + i; const float bsi = bs[i];
#pragma unroll
        for (int nt = 0; nt < 8; ++nt) { const int d = 16 * nt + 4 * fq; f32x4 uu = ld_bf4(P + (size_t)t * PW + C_SU + g * 128 + d);
#pragma unroll
            for (int e = 0; e < 4; ++e) uu[e] = geluf_(uu[e]) * (acc[nt][e] + bsi);
            st_bf4(Y + (size_t)t * 4 * W + 2 * W + g * 128 + d, uu); }
        SYNCTHREADS();
    }
}
__device__ __forceinline__ void ph_rw_shift(const Ctx& c, int l) {
    const bf16_t* P = WSH(O_P); const float* mup = c.in[18] + (size_t)l * RF; const float* mun = c.in[19] + (size_t)l * RF; bf16_t* FS = WSH(O_FS);
    const int lane = threadIdx.x & 63, gw = blockIdx.x * (NT / 64) + (threadIdx.x >> 6), ngw = gridDim.x * (NT / 64);
    for (int t = gw; t < T; t += ngw) {
        const int sI = t % S; const bf16_t* pc = P + (size_t)t * PW + C_RW;
#pragma unroll 2
        for (int j = lane * 4; j < RF; j += 256) {
            const f32x4 f = ld_bf4(pc + j), z4 = (f32x4){0.f, 0.f, 0.f, 0.f}; const f32x4 pv = sI > 0 ? ld_bf4(pc - PW + j) : z4, nv = sI < S - 1 ? ld_bf4(pc + PW + j) : z4;
            f32x4 v = f + *(const f32x4*)(mup + j) * (pv - f) + *(const f32x4*)(mun + j) * (nv - f);
            if (j >= 3072 && j < 3200) {
#pragma unroll
                for (int e = 0; e < 4; ++e) v[e] = tanhf_(v[e]); }
            else if (j >= 3328) {
#pragma unroll
                for (int e = 0; e < 4; ++e) v[e] = sigmoidf_(v[e]); }
            st_bf4(FS + (size_t)t * RF + j, v);
        }
    }
}
__device__ __forceinline__ void ph_rw_lora(const Ctx& c, int l, float* ldsf) {
    const bf16_t* FS = WSH(O_FS); const float* w0 = c.in[20] + (size_t)l * 2 * W; const float* a0 = c.in[22] + (size_t)l * 2 * W;
    const bf16_t* WUT = WSH(O_WUT); const bf16_t* WAT = WSH(O_WAT); const bf16_t* WGT = WSH(O_WGT);
    float* DEC = WSF(O_DEC); float* AA = WSF(O_AA); float* GG = WSF(O_GG);
    bf16_t* F = (bf16_t*)ldsf; bf16_t* B1 = F + 128 * 136; bf16_t* B2 = B1 + 128 * 136; const int tid = threadIdx.x, wv = tid >> 6, lane = tid & 63, fr = lane & 15, fq = lane >> 4;
    for (int u = blockIdx.x; u < (T / 128) * 8; u += gridDim.x) {
        const int wc0 = (u & 7) * 128; const long t0 = (long)(u >> 3) * 128;
        for (int rd = 0; rd < 3; ++rd) {
#pragma unroll
            for (int q = 0; q < 8; ++q) { const int id = tid + NT * q, r = id >> 5, c4 = (id & 31) * 4;
                const int col = rd < 2 ? (c4 < 64 ? 3072 + rd * 64 + c4 : 3200 + rd * 64 + (c4 - 64)) : 3328 + c4;
                *(unsigned long long*)(F + r * 136 + c4) = *(const unsigned long long*)(FS + (size_t)(t0 + r) * RF + col); }
            if (rd < 2) {
#pragma unroll
                for (int q = 0; q < 2; ++q) { const int id = tid + NT * q, w = id >> 3, r8 = (id & 7) * 8;
                    *(u32x4*)(B1 + w * 72 + r8) = *(const u32x4*)(WUT + ((size_t)rd * W + wc0 + w) * 64 + r8); *(u32x4*)(B2 + w * 72 + r8) = *(const u32x4*)(WAT + ((size_t)rd * W + wc0 + w) * 64 + r8); }
            } else {
#pragma unroll
                for (int q = 0; q < 4; ++q) { const int id = tid + NT * q, w = id >> 4, r8 = (id & 15) * 8; *(u32x4*)(B1 + w * 136 + r8) = *(const u32x4*)(WGT + ((size_t)wc0 + w) * 128 + r8); }
            }
            SYNCTHREADS();
            f32x4 a1[8], a2[8];
#pragma unroll
            for (int nt = 0; nt < 8; ++nt) { a1[nt] = (f32x4){0.f, 0.f, 0.f, 0.f}; a2[nt] = (f32x4){0.f, 0.f, 0.f, 0.f}; }
            const long t = t0 + wv * 16 + fr;
            if (rd < 2) {
                wave_mma<2, 8>(a1, F + wv * 16 * 136, 136, B1, 72);
                wave_mma<2, 8>(a2, F + wv * 16 * 136 + 64, 136, B2, 72);
#pragma unroll
                for (int nt = 0; nt < 8; ++nt) { const int ch = wc0 + 16 * nt + 4 * fq; const f32x4 w0v = *(const f32x4*)(w0 + rd * W + ch), a0v = *(const f32x4*)(a0 + rd * W + ch); f32x4 dv, av;
#pragma unroll
                    for (int e = 0; e < 4; ++e) { dv[e] = fexp_(-DECAY_SCALE * sigmoidf_(a1[nt][e] + w0v[e])); av[e] = sigmoidf_(a2[nt][e] + a0v[e]); }
                    *(f32x4*)(DEC + ((size_t)rd * T + t) * W + ch) = dv; *(f32x4*)(AA + ((size_t)rd * T + t) * W + ch) = av; }
            } else {
                wave_mma<4, 8>(a1, F + wv * 16 * 136, 136, B1, 136);
#pragma unroll
                for (int nt = 0; nt < 8; ++nt) *(f32x4*)(GG + (size_t)t * W + wc0 + 16 * nt + 4 * fq) = a1[nt];
            }
            SYNCTHREADS();
        }
    }
}
#ifdef CPU_EMU
__device__ __forceinline__ float red16_(float x) { x += SHFL_XOR(x, 1); x += SHFL_XOR(x, 2); x += SHFL_XOR(x, 4); x += SHFL_XOR(x, 8); return x; }
#define LDS_BARRIER() emu_syncthreads()
#else
__device__ __forceinline__ float red16_(float x) {
    x += __builtin_bit_cast(float, __builtin_amdgcn_update_dpp(0, __builtin_bit_cast(int, x), 0xB1, 0xF, 0xF, true));
    x += __builtin_bit_cast(float, __builtin_amdgcn_update_dpp(0, __builtin_bit_cast(int, x), 0x4E, 0xF, 0xF, true));
    x += __builtin_bit_cast(float, __builtin_amdgcn_update_dpp(0, __builtin_bit_cast(int, x), 0x141, 0xF, 0xF, true));
    x += __builtin_bit_cast(float, __builtin_amdgcn_update_dpp(0, __builtin_bit_cast(int, x), 0x140, 0xF, 0xF, true));
    return x;
}
#define LDS_BARRIER() do { asm volatile("s_waitcnt lgkmcnt(0)" ::: "memory"); __builtin_amdgcn_s_barrier(); asm volatile("" ::: "memory"); } while (0)
#endif
#define RC_M(k) (lm + (k) * 4608)
__device__ __forceinline__ void ph_rw_chunk(const Ctx& c, int l, float* ldsf) {
    const bf16_t* FS = WSH(O_FS); const float* DEC = WSF(O_DEC); const float* AA = WSF(O_AA); float* BON = WSF(O_BON);
    const float* kkw = c.in[25] + (size_t)l * W; const float* kaw = c.in[26] + (size_t)l * W; const float* rk = c.in[27] + (size_t)l * W;
    bf16_t* PST = WSH(O_PST); bf16_t* PYT = WSH(O_PYT); float* SVB = WSF(O_SVB); float* YVB = WSF(O_YVB);
    bf16_t* lm = (bf16_t*)ldsf; float* gam = (float*)RC_M(7); float* segp = (float*)RC_M(13); float* gl = segp + 512;
    const int tid = threadIdx.x, wv = tid >> 6, lane = tid & 63, fr = lane & 15, fq = lane >> 4, rt = wv & 3, hf = wv >> 2;
    const int m0 = 16 * rt + fr;
    float wv8[8], kv8[8], rv8[8], vv8[8], aa8[8];
#define RC_LOAD(uu) do { const int chain_ = (uu) / NRC, ck_ = (uu) % NRC, h_ = chain_ & 15, b_ = (chain_ >> 4) & 1, z_ = chain_ >> 5; \
        const long tb_ = (long)b_ * S + (z_ ? S - 1 - ck_ * RCK : ck_ * RCK); const int dirn_ = z_ ? -1 : 1; \
        const float* decp_ = DEC + ((size_t)z_ * T) * W + h_ * 64; const float* aap_ = AA + ((size_t)z_ * T) * W + h_ * 64; const int ch_ = h_ * 64 + lane; \
        _Pragma("unroll") for (int q = 0; q < 8; ++q) wv8[q] = decp_[(size_t)(tb_ + dirn_ * ((tid >> 6) * 8 + q)) * W + (tid & 63)]; \
        _Pragma("unroll") for (int q = 0; q < 8; ++q) { const long t_ = tb_ + dirn_ * (wv + 8 * q); const bf16_t* f_ = FS + (size_t)t_ * RF; kv8[q] = bf2f(f_[1024 + ch_]); rv8[q] = bf2f(f_[ch_]); vv8[q] = bf2f(f_[2048 + ch_]); aa8[q] = aap_[(size_t)t_ * W + lane]; } } while (0)
    if ((int)blockIdx.x < 64 * NRC) RC_LOAD((int)blockIdx.x);
    for (int u = blockIdx.x; u < 64 * NRC; u += gridDim.x) {
        const int chain = u / NRC, ck = u % NRC, h = chain & 15, b = (chain >> 4) & 1, z = chain >> 5;
        const long tb = (long)b * S + (z ? S - 1 - ck * RCK : ck * RCK); const int dirn = z ? -1 : 1;
        { const int k = tid & 63, sg = tid >> 6; float p = 1.f;
#pragma unroll
          for (int q = 0; q < 8; ++q) { p *= wv8[q]; gam[(sg * 8 + q) * 64 + k] = p; }
          segp[sg * 64 + k] = p; }
        LDS_BARRIER();
        { const int k = tid & 63, sg = tid >> 6; float pre = 1.f;
          for (int q = 0; q < sg; ++q) pre *= segp[q * 64 + k];
#pragma unroll
          for (int q = 0; q < 8; ++q) gam[(sg * 8 + q) * 64 + k] *= pre;
          if (sg == 7) gl[k] = gam[63 * 64 + k]; }
        LDS_BARRIER();
        { const int k = lane, ch = h * 64 + k; const float kkwv = kkw[ch], kav = kaw[ch], rkv = rk[ch];
#pragma unroll
          for (int q = 0; q < 8; ++q) { const int tt = wv + 8 * q; const long t = tb + dirn * tt;
            const float vk = kv8[q] * kkwv; const float kkn = vk * (1.f / sqrtf(wave_sum(vk * vk) + EPS)); const float ktv = kv8[q] * (1.f + (aa8[q] - 1.f) * kav);
            const float bsum = wave_sum(rv8[q] * rkv * ktv); if (lane == 0) BON[((size_t)z * T + t) * 16 + h] = bsum;
            const float g = gam[tt * 64 + k], gp = tt ? gam[(tt - 1) * 64 + k] : 1.f, ig = 1.f / g;
            const bf16_t khv = (bf16_t)f2bf(kkn * gp), bhv = (bf16_t)f2bf(aa8[q] * kkn * ig);
            RC_M(0)[tt * 72 + k] = khv; RC_M(1)[k * 72 + tt] = khv; RC_M(2)[tt * 72 + k] = bhv; RC_M(3)[k * 72 + tt] = bhv;
            RC_M(4)[tt * 72 + k] = (bf16_t)f2bf(ktv * ig); RC_M(5)[tt * 72 + k] = (bf16_t)f2bf(rv8[q] * g); RC_M(6)[k * 72 + tt] = (bf16_t)f2bf(vv8[q]); } }
        if (u + (int)gridDim.x < 64 * NRC) RC_LOAD(u + (int)gridDim.x);
        LDS_BARRIER();
        f32x4 mkr[2], khr[2], rhT[2];
        {
            f32x4 a0[2], a1[2], a2[2], a3[2];
#pragma unroll
            for (int nt = 0; nt < 2; ++nt) { a0[nt] = (f32x4){0.f, 0.f, 0.f, 0.f}; a1[nt] = a0[nt]; a2[nt] = a0[nt]; a3[nt] = a0[nt]; }
            wave_mma<2, 2>(a0, RC_M(2) + rt * 16 * 72, 72, RC_M(0) + hf * 32 * 72, 72);
            wave_mma<2, 2>(a1, RC_M(4) + rt * 16 * 72, 72, RC_M(0) + hf * 32 * 72, 72);
            wave_mma<2, 2>(a2, RC_M(2) + rt * 16 * 72, 72, RC_M(5) + hf * 32 * 72, 72);
            wave_mma<2, 2>(a3, RC_M(4) + rt * 16 * 72, 72, RC_M(5) + hf * 32 * 72, 72);
#pragma unroll
            for (int nt = 0; nt < 2; ++nt) { const int n0 = 32 * hf + 16 * nt + 4 * fq; f32x4 nn, ti, mk;
#pragma unroll
                for (int r = 0; r < 4; ++r) { const int n = n0 + r; const bool lt = m0 < n, le = m0 <= n;
                    nn[r] = lt ? -a0[nt][r] : 0.f; ti[r] = nn[r] + (m0 == n ? 1.f : 0.f); mk[r] = lt ? a1[nt][r] : 0.f; mkr[nt][r] = le ? a3[nt][r] : 0.f;
                    RC_M(12)[n * 72 + m0] = (bf16_t)f2bf(le ? a2[nt][r] : 0.f);
                    RC_M(8)[n * 72 + m0] = (bf16_t)f2bf(nn[r]);
                    khr[nt][r] = bf2f(RC_M(4)[m0 * 72 + n]); rhT[nt][r] = bf2f(RC_M(5)[n * 72 + m0]); }
                st_bf4(RC_M(7) + m0 * 72 + n0, nn); st_bf4(RC_M(9) + m0 * 72 + n0, ti); st_bf4(RC_M(11) + m0 * 72 + n0, mk); }
        }
        LDS_BARRIER();
        f32x4 tiv[2];
#pragma unroll
        for (int nt = 0; nt < 2; ++nt) tiv[nt] = ld_bf4(RC_M(9) + m0 * 72 + 32 * hf + 16 * nt + 4 * fq);
#pragma unroll 1
        for (int it = 0; it < 5; ++it) {
            bf16_t* pw = (it & 1) ? RC_M(0) : RC_M(7); bf16_t* pwT = (it & 1) ? RC_M(2) : RC_M(8); bf16_t* pw2 = (it & 1) ? RC_M(7) : RC_M(0); bf16_t* pw2T = (it & 1) ? RC_M(8) : RC_M(2);
            bf16_t* tcur = (it & 1) ? RC_M(4) : RC_M(9); bf16_t* tnxt = (it & 1) ? RC_M(9) : RC_M(4);
            f32x4 sq[2];
#pragma unroll
            for (int nt = 0; nt < 2; ++nt) sq[nt] = (f32x4){0.f, 0.f, 0.f, 0.f};
            wave_mma<2, 2>(sq, pw + rt * 16 * 72, 72, pwT + hf * 32 * 72, 72);
#pragma unroll
            for (int nt = 0; nt < 2; ++nt) { const int n0 = 32 * hf + 16 * nt + 4 * fq; st_bf4(pw2 + m0 * 72 + n0, sq[nt]);
#pragma unroll
                for (int r = 0; r < 4; ++r) pw2T[(n0 + r) * 72 + m0] = (bf16_t)f2bf(sq[nt][r]); }
            LDS_BARRIER();
            f32x4 up[2];
#pragma unroll
            for (int nt = 0; nt < 2; ++nt) up[nt] = (f32x4){0.f, 0.f, 0.f, 0.f};
            wave_mma<2, 2>(up, tcur + rt * 16 * 72, 72, pw2T + hf * 32 * 72, 72);
#pragma unroll
            for (int nt = 0; nt < 2; ++nt) { const int n0 = 32 * hf + 16 * nt + 4 * fq; tiv[nt] += up[nt]; st_bf4(tnxt + m0 * 72 + n0, tiv[nt]);
                if (it == 4) {
#pragma unroll
                    for (int r = 0; r < 4; ++r) RC_M(10)[(n0 + r) * 72 + m0] = (bf16_t)f2bf(tiv[nt][r]); } }
            LDS_BARRIER();
        }
        {
            f32x4 w1[2], w2[2];
#pragma unroll
            for (int nt = 0; nt < 2; ++nt) { w1[nt] = (f32x4){0.f, 0.f, 0.f, 0.f}; w2[nt] = w1[nt]; }
            wave_mma<2, 2>(w1, RC_M(1) + rt * 16 * 72, 72, RC_M(10) + hf * 32 * 72, 72);
            wave_mma<2, 2>(w2, RC_M(11) + rt * 16 * 72, 72, RC_M(10) + hf * 32 * 72, 72);
#pragma unroll
            for (int nt = 0; nt < 2; ++nt) { const int n0 = 32 * hf + 16 * nt + 4 * fq; st_bf4(RC_M(7) + m0 * 72 + n0, w1[nt]); st_bf4(RC_M(8) + m0 * 72 + n0, w2[nt]); }
        }
        LDS_BARRIER();
        {
            f32x4 py[2], qy[2], ps[2], qs[2];
#pragma unroll
            for (int nt = 0; nt < 2; ++nt) { py[nt] = (f32x4){0.f, 0.f, 0.f, 0.f}; qy[nt] = py[nt]; ps[nt] = py[nt]; qs[nt] = py[nt]; }
            wave_mma<2, 2>(py, RC_M(7) + rt * 16 * 72, 72, RC_M(12) + hf * 32 * 72, 72);
            wave_mma<2, 2>(qy, RC_M(8) + rt * 16 * 72, 72, RC_M(12) + hf * 32 * 72, 72);
            wave_mma<2, 2>(ps, RC_M(7) + rt * 16 * 72, 72, RC_M(3) + hf * 32 * 72, 72);
            wave_mma<2, 2>(qs, RC_M(8) + rt * 16 * 72, 72, RC_M(3) + hf * 32 * 72, 72);
#pragma unroll
            for (int nt = 0; nt < 2; ++nt) { const int n0 = 32 * hf + 16 * nt + 4 * fq;
#pragma unroll
                for (int r = 0; r < 4; ++r) { const int n = n0 + r; const float gln = gl[n];
                    RC_M(0)[n * 72 + m0] = (bf16_t)f2bf(rhT[nt][r] - py[nt][r]); RC_M(2)[n * 72 + m0] = (bf16_t)f2bf(mkr[nt][r] - qy[nt][r]);
                    RC_M(4)[n * 72 + m0] = (bf16_t)f2bf(((m0 == n ? 1.f : 0.f) - ps[nt][r]) * gln); RC_M(5)[n * 72 + m0] = (bf16_t)f2bf((khr[nt][r] - qs[nt][r]) * gln); } }
        }
        LDS_BARRIER();
        {
            f32x4 yv[2], sv[2];
#pragma unroll
            for (int nt = 0; nt < 2; ++nt) { yv[nt] = (f32x4){0.f, 0.f, 0.f, 0.f}; sv[nt] = yv[nt]; }
            wave_mma<2, 2>(yv, RC_M(6) + rt * 16 * 72, 72, RC_M(2) + hf * 32 * 72, 72);
            wave_mma<2, 2>(sv, RC_M(6) + rt * 16 * 72, 72, RC_M(5) + hf * 32 * 72, 72);
#pragma unroll
            for (int nt = 0; nt < 2; ++nt) { const int n0 = 32 * hf + 16 * nt + 4 * fq; *(f32x4*)(YVB + (size_t)u * 4096 + m0 * 64 + n0) = yv[nt]; *(f32x4*)(SVB + (size_t)u * 4096 + m0 * 64 + n0) = sv[nt]; }
            { const int rr = tid >> 3, c8 = (tid & 7) * 8; *(u32x4*)(PYT + (size_t)u * 4096 + rr * 64 + c8) = *(const u32x4*)(RC_M(0) + rr * 72 + c8); *(u32x4*)(PST + (size_t)u * 4096 + rr * 64 + c8) = *(const u32x4*)(RC_M(4) + rr * 72 + c8); }
        }
        LDS_BARRIER();
    }
}
#undef RC_M
#undef RC_LOAD
__device__ __forceinline__ void ph_rw_seq(const Ctx& c, float* ldsf) {
    const bf16_t* PST = WSH(O_PST); const bf16_t* PYT = WSH(O_PYT); const float* SVB = WSF(O_SVB); const float* YVB = WSF(O_YVB); float* YY = WSF(O_YY);
    bf16_t* Sb = (bf16_t*)ldsf;
    bf16_t* Pm = Sb + 2 * 16 * 72;
    const int tid = threadIdx.x, wv = tid >> 6, lane = tid & 63, fr = lane & 15, fq = lane >> 4, isY = wv >> 2, nt0 = wv & 3;
    for (int u = blockIdx.x; u < 256; u += gridDim.x) {
        const int x = u & 7, jq = u >> 3, chain = x * 8 + (jq >> 2), qt = jq & 3, h = chain & 15, b = (chain >> 4) & 1, z = chain >> 5;
        const size_t ub = (size_t)chain * NRC;
        const int rr = tid >> 3, c8 = (tid & 7) * 8;
        constexpr int PD = NRC >= 8 ? 8 : 4;
        for (int i = tid; i < 2 * 16 * 72 / 2; i += NT) ((unsigned*)Sb)[i] = 0u;
        const int row = 16 * qt + fr, n0 = 16 * nt0 + 4 * fq; const float* addp = (isY ? YVB : SVB) + ub * 4096 + row * 64 + n0;
        const bf16_t* psp = PST + ub * 4096 + rr * 64 + c8; const bf16_t* pyp = PYT + ub * 4096 + rr * 64 + c8;
        u32x4 gps[PD], gpy[PD]; f32x4 add[PD];
#pragma unroll
        for (int j = 0; j < PD; ++j) { gps[j] = *(const u32x4*)(psp + (size_t)j * 4096); gpy[j] = *(const u32x4*)(pyp + (size_t)j * 4096); add[j] = *(const f32x4*)(addp + (size_t)j * 4096); }
        *(u32x4*)(Pm + (0 * 2 + 0) * 4608 + rr * 72 + c8) = gps[0]; *(u32x4*)(Pm + (0 * 2 + 1) * 4608 + rr * 72 + c8) = gpy[0];
        if (PD < NRC) { gps[0] = *(const u32x4*)(psp + (size_t)PD * 4096); gpy[0] = *(const u32x4*)(pyp + (size_t)PD * 4096); }
        SYNCTHREADS();
        for (int ck0 = 0; ck0 < NRC; ck0 += PD) {
#pragma unroll
            for (int j = 0; j < PD; ++j) {
                const int ck = ck0 + j, cur = j & 1, nxt = cur ^ 1;
                f32x4 acc[1]; acc[0] = (f32x4){0.f, 0.f, 0.f, 0.f};
                wave_mma<2, 1>(acc, Sb + cur * 16 * 72, 72, Pm + (cur * 2 + isY) * 4608 + nt0 * 16 * 72, 72);
                acc[0] += add[j];
                if (ck + PD < NRC) add[j] = *(const f32x4*)(addp + (size_t)(ck + PD) * 4096);
                if (isY) {
#pragma unroll
                    for (int r = 0; r < 4; ++r) { const int step = ck * RCK + n0 + r, sidx = z ? S - 1 - step : step; YY[((size_t)z * T + (size_t)b * S + sidx) * W + h * 64 + row] = acc[0][r]; }
                } else st_bf4(Sb + nxt * 16 * 72 + fr * 72 + n0, acc[0]);
                const int jn = (j + 1) % PD;
                if (ck + 1 < NRC) { *(u32x4*)(Pm + (nxt * 2 + 0) * 4608 + rr * 72 + c8) = gps[jn]; *(u32x4*)(Pm + (nxt * 2 + 1) * 4608 + rr * 72 + c8) = gpy[jn]; }
                if (ck + 1 + PD < NRC) { gps[jn] = *(const u32x4*)(psp + (size_t)(ck + 1 + PD) * 4096); gpy[jn] = *(const u32x4*)(pyp + (size_t)(ck + 1 + PD) * 4096); }
                LDS_BARRIER();
            }
        }
    }
}
__device__ __forceinline__ void ph_rw_out(const Ctx& c) {
    const bf16_t* FS = WSH(O_FS); const float* YY = WSF(O_YY); const float* BON = WSF(O_BON); const float* GG = WSF(O_GG); bf16_t* Y = WSH(O_YS);
    const int lane = threadIdx.x & 63, gw = blockIdx.x * (NT / 64) + (threadIdx.x >> 6), ngw = gridDim.x * (NT / 64);
    for (int i = gw; i < T * 4; i += ngw) {
        const int h0 = (i & 3) * 4; const long t = i >> 2; float y0[4], y1[4], gv[4], vv[4], bs[4];
#pragma unroll
        for (int q = 0; q < 4; ++q) { const int ch = (h0 + q) * 64 + lane; y0[q] = YY[(size_t)t * W + ch]; y1[q] = YY[((size_t)T + t) * W + ch]; gv[q] = GG[(size_t)t * W + ch]; vv[q] = bf2f(FS[(size_t)t * RF + 2048 + ch]);
            bs[q] = BON[(size_t)t * 16 + h0 + q] + BON[((size_t)T + t) * 16 + h0 + q]; }
#pragma unroll
        for (int q = 0; q < 4; ++q) { const int ch = (h0 + q) * 64 + lane;
            const float m0 = wave_sum(y0[q]) * (1.f / 64.f), m1 = wave_sum(y1[q]) * (1.f / 64.f); const float d0 = y0[q] - m0, d1 = y1[q] - m1;
            const float r0 = 1.f / sqrtf(wave_sum(d0 * d0) * (1.f / 64.f) + EPS), r1 = 1.f / sqrtf(wave_sum(d1 * d1) * (1.f / 64.f) + EPS);
            Y[(size_t)t * 4 * W + 3 * W + ch] = (bf16_t)f2bf((d0 * r0 + d1 * r1 + bs[q] * vv[q]) * gv[q]); }
    }
}
__device__ __forceinline__ void ph_router(const Ctx& c, int l, float* ldsf) {
    const float* H = WSF(O_HF); const bf16_t* WH = WSH(O_WRH); const bf16_t* WL = WSH(O_WRL); const float* bg = c.in[31] + (size_t)l * 4; const float* be = c.in[33] + (size_t)l * 32;
    int* EID = WSI(O_EID); float* EWT = WSF(O_EWT); int* cnt = CTLW(c) + CW_CNT + l * 64;
    const int tid = threadIdx.x, wv = tid >> 6, lane = tid & 63, fr = lane & 15, fq = lane >> 4, rt = wv & 1, kq = wv >> 1;
    float* part = ldsf;
    for (int u = blockIdx.x; u < T / 32; u += gridDim.x) {
        const long t0 = (long)u * 32; f32x4 acc[3];
#pragma unroll
        for (int nt = 0; nt < 3; ++nt) acc[nt] = (f32x4){0.f, 0.f, 0.f, 0.f};
#ifdef CPU_EMU
        for (int nt = 0; nt < 3; ++nt) for (int r = 0; r < 4; ++r) { const int n = 16 * nt + 4 * fq + r; float sacc = 0.f;
            for (int k = kq * 512; k < kq * 512 + 512; ++k) { const float hv = H[(size_t)(t0 + 16 * rt + fr) * D + k]; const float hh = bf2f((bf16_t)f2bf(hv)), hl = bf2f((bf16_t)f2bf(hv - hh));
                const float wh = bf2f(WH[(size_t)n * D + k]), wl = bf2f(WL[(size_t)n * D + k]); sacc += hh * wh + hl * wh + hh * wl; }
            acc[nt][r] = sacc; }
#else
        const float* hp = H + (size_t)(t0 + 16 * rt + fr) * D + kq * 512 + fq * 8;
#pragma unroll 4
        for (int ks = 0; ks < 16; ++ks) {
            const f32x4 h0 = *(const f32x4*)(hp + ks * 32), h1 = *(const f32x4*)(hp + ks * 32 + 4); bf16x8 ah, al;
#pragma unroll
            for (int e = 0; e < 4; ++e) { const unsigned b0 = f2bf(h0[e]), b1 = f2bf(h1[e]); ah[e] = (short)b0; ah[4 + e] = (short)b1; al[e] = (short)f2bf(h0[e] - u2f_(b0 << 16)); al[4 + e] = (short)f2bf(h1[e] - u2f_(b1 << 16)); }
#pragma unroll
            for (int nt = 0; nt < 3; ++nt) { const size_t wo = (size_t)(16 * nt + fr) * D + kq * 512 + ks * 32 + fq * 8; const bf16x8 bh = *(const bf16x8*)(WH + wo), bl = *(const bf16x8*)(WL + wo);
                acc[nt] = __builtin_amdgcn_mfma_f32_16x16x32_bf16(bh, ah, acc[nt], 0, 0, 0); acc[nt] = __builtin_amdgcn_mfma_f32_16x16x32_bf16(bh, al, acc[nt], 0, 0, 0); acc[nt] = __builtin_amdgcn_mfma_f32_16x16x32_bf16(bl, ah, acc[nt], 0, 0, 0); }
        }
#endif
#pragma unroll
        for (int nt = 0; nt < 3; ++nt) *(f32x4*)(part + (kq * 32 + 16 * rt + fr) * 48 + 16 * nt + 4 * fq) = acc[nt];
        SYNCTHREADS();
        if (tid < 32) { const long t = t0 + tid; float lg[36];
#pragma unroll
            for (int q = 0; q < 36; ++q) lg[q] = (part[(0 * 32 + tid) * 48 + q] + part[(1 * 32 + tid) * 48 + q]) + (part[(2 * 32 + tid) * 48 + q] + part[(3 * 32 + tid) * 48 + q]) + (q < 4 ? bg[q < 4 ? q : 0] : be[q >= 4 ? q - 4 : 0]);
            int gi = 0; float m = lg[0];
#pragma unroll
            for (int q = 1; q < 4; ++q) if (lg[q] > m) { m = lg[q]; gi = q; }
            float den = 0.f;
#pragma unroll
            for (int q = 0; q < 4; ++q) den += expf(lg[q] - m);
            const float gp = 1.f / den; float el[8];
#pragma unroll
            for (int q = 0; q < 8; ++q) el[q] = gi == 0 ? lg[4 + q] : gi == 1 ? lg[12 + q] : gi == 2 ? lg[20 + q] : lg[28 + q];
            int i1 = 0; float m1 = el[0];
#pragma unroll
            for (int q = 1; q < 8; ++q) if (el[q] > m1) { m1 = el[q]; i1 = q; }
            int i2 = -1; float m2 = 0.f;
#pragma unroll
            for (int q = 0; q < 8; ++q) if (q != i1 && (i2 < 0 || el[q] > m2)) { m2 = el[q]; i2 = q; }
            const float p2 = expf(m2 - m1);
            EID[t * 2] = gi * 8 + i1; EID[t * 2 + 1] = gi * 8 + i2; EWT[t * 2] = gp / (1.f + p2); EWT[t * 2 + 1] = gp * p2 / (1.f + p2);
            atomic_add_i(cnt + gi * 8 + i1, 1); atomic_add_i(cnt + gi * 8 + i2, 1);
        }
        SYNCTHREADS();
    }
}
__device__ __forceinline__ void ph_moe_plan(const Ctx& c, int l) {
    int* cnt = CTLW(c) + CW_CNT + l * 64; int* plan = CTLW(c) + CW_PLAN + l * 256;
    if (GT_ == 0) {
        int ps = 0, nb = 0;
        for (int e = 0; e < NE; ++e) { plan[e] = ps; const int nblk = (cnt[e] + 255) / 256; for (int q = 0; q < nblk; ++q) plan[64 + nb++] = e; ps += nblk * 256; }
        plan[32] = ps; plan[40] = nb;
    }
}
__device__ __forceinline__ void ph_moe_assign(const Ctx& c, int l) {
    const int* EID = WSI(O_EID); int* fill = CTLW(c) + CW_FILL + l * 64; const int* plan = CTLW(c) + CW_PLAN + l * 256; int* DEST = WSI(O_DEST);
    for (long i = GT_; i < (long)T * 2; i += GS_) { const int e = EID[i]; const int pos = atomic_add_i(fill + e, 1); DEST[i] = plan[e] + pos; }
}
__device__ __forceinline__ void ph_moe_gather(const Ctx& c) {
    const int* DEST = WSI(O_DEST); const u32x4* H = (const u32x4*)WSH(O_H); u32x4* XS = (u32x4*)WSH(O_XS);
    for (long i = GT_; i < (long)T * 2 * (D / 8); i += GS_) { const int q = (int)(i % (D / 8)); const long a = i / (D / 8); XS[(size_t)DEST[a] * (D / 8) + q] = H[(size_t)(a >> 1) * (D / 8) + q]; }
}
#ifndef CPU_EMU
#define XB_TMO      128
#define XB_XCNT(j)  (256  + 64 * (j))
#define XB_XSUB(j)  (1280 + 64 * (j))
#define XB_XGEN(j)  (2304 + 64 * (j))
#define XB_TOP      3328
#define XB_TOPGEN   3392
#define XCD_BAR_WORDS 3456
#define XB_SPIN_CAP (1u << 26)
#define LAS __attribute__((address_space(3)))
__device__ __forceinline__ unsigned xb_ld(unsigned* p)              { return __hip_atomic_load(p, __ATOMIC_RELAXED, __HIP_MEMORY_SCOPE_AGENT); }
__device__ __forceinline__ unsigned xb_add(unsigned* p, unsigned v) { return __hip_atomic_fetch_add(p, v, __ATOMIC_RELAXED, __HIP_MEMORY_SCOPE_AGENT); }
__device__ __forceinline__ unsigned xb_xcc_id() { return (unsigned)__builtin_amdgcn_s_getreg((3 << 11) | 20) & 0xFu; }
#define XB_SPIN(cond, bar) do { unsigned _sp = 0; while (cond) { __builtin_amdgcn_s_sleep(1); \
    if ((++_sp & 255u) == 0u) { if (xb_ld(&(bar)[XB_TMO])) break; if (_sp > XB_SPIN_CAP) { atomicAdd(&(bar)[XB_TMO], 1u); break; } } } } while (0)
struct XcdBarrier { unsigned* bar; unsigned x; volatile LAS unsigned* st; };
__device__ __forceinline__ XcdBarrier xcd_barrier_post(unsigned* bar, volatile LAS unsigned* st) {
    XcdBarrier b; b.bar = bar; b.x = xb_xcc_id(); b.st = st;
    if (threadIdx.x == 0) (void)xb_add(&bar[XB_XCNT(b.x)], 1u);
    return b;
}
__device__ __forceinline__ void xcd_barrier_complete(unsigned* bar, unsigned x, unsigned& nloc, unsigned& nx) {
    const unsigned G = gridDim.x * gridDim.y * gridDim.z;
    unsigned sum, cnt, mine, sp = 0u;
    for (;;) {
        sum = 0u; cnt = 0u; mine = 0u;
#pragma unroll
        for (unsigned j = 0; j < 16; ++j) { const unsigned cc = xb_ld(&bar[XB_XCNT(j)]); sum += cc; cnt += (cc > 0u) ? 1u : 0u; mine = (j == x) ? cc : mine; }
        if (sum == G) break;
        __builtin_amdgcn_s_sleep(1);
        if ((++sp & 255u) == 0u) { if (xb_ld(&bar[XB_TMO])) break; if (sp > XB_SPIN_CAP) { atomicAdd(&bar[XB_TMO], 1u); break; } }
    }
    nloc = mine > 0u ? mine : 1u; nx = cnt > 0u ? cnt : 1u;
}
__device__ __forceinline__ void xcd_barrier(const XcdBarrier& b) {
    asm volatile("s_waitcnt vmcnt(0)" ::: "memory");
    __syncthreads();
    if (threadIdx.x == 0) {
        unsigned* bar = b.bar;
        __builtin_amdgcn_s_waitcnt(0);
        unsigned nloc = b.st[0], nx = b.st[1];
        if (nloc == 0u) { xcd_barrier_complete(bar, b.x, nloc, nx); b.st[0] = nloc; b.st[1] = nx; }
        const unsigned old = xb_add(&bar[XB_XSUB(b.x)], 1u);
        const unsigned gen = old / nloc;
        if (old + 1u == (gen + 1u) * nloc) {
            __builtin_amdgcn_fence(__ATOMIC_RELEASE, "agent");
            asm volatile("s_waitcnt vmcnt(0)" ::: "memory");
            const unsigned og = xb_add(&bar[XB_TOP], 1u);
            const unsigned tg = og / nx;
            if (og + 1u == (tg + 1u) * nx) xb_add(&bar[XB_TOPGEN], 1u);
            else XB_SPIN(xb_ld(&bar[XB_TOPGEN]) == tg, bar);
            __builtin_amdgcn_fence(__ATOMIC_ACQUIRE, "agent");
            xb_add(&bar[XB_XGEN(b.x)], 1u);
            asm volatile("s_waitcnt vmcnt(0)" ::: "memory");
        } else {
            XB_SPIN(xb_ld(&bar[XB_XGEN(b.x)]) == gen, bar);
            __builtin_amdgcn_fence(__ATOMIC_ACQUIRE, "agent");
            asm volatile("s_waitcnt vmcnt(0)" ::: "memory");
        }
    }
    __syncthreads();
}
#endif

constexpr int LDS_BYTES = 147456;

__global__ void __launch_bounds__(NT, 2) fwd(Params p) {
#ifdef CPU_EMU
    unsigned char* lds = g_lds; float* ldsf = (float*)g_lds;
#else
    extern __shared__ __attribute__((aligned(16))) unsigned char lds[];
    float* ldsf = (float*)lds;
    volatile LAS unsigned* misc = (volatile LAS unsigned*)((LAS unsigned char*)lds + LDS_BYTES - 64);
    if (threadIdx.x == 0) { misc[0] = 0u; misc[1] = 0u; }
    __syncthreads();
    XcdBarrier bar = xcd_barrier_post((unsigned*)(p.ws + O_CTL) + CW_BAR, misc);
#endif
    Ctx c; c.in = p.in; c.out = p.out; c.ws = p.ws;
    const int lo = p.ph_lo, hi = p.ph_hi; int ph = 0;
    const int G = (int)gridDim.x, cwg = (int)blockIdx.x;
#ifdef CPU_EMU
#define GRID_BAR()
#else
#define GRID_BAR() xcd_barrier(bar)
#endif
#ifndef REPEAT_MASK
#define REPEAT_MASK 0
#endif
#ifndef TIME_PHASE
#define TIME_PHASE -1
#endif
#if TIME_PHASE >= 0 && !defined(CPU_EMU)
    unsigned long long tp0 = 0, tp1 = 0;
#define TP_BEGIN() do { if (ph == TIME_PHASE) tp0 = __builtin_amdgcn_s_memrealtime(); } while (0)
#define TP_END() do { if (ph == TIME_PHASE) tp1 = __builtin_amdgcn_s_memrealtime(); } while (0)
#else
#define TP_BEGIN()
#define TP_END()
#endif
#define PHASE(...) do { if (lo <= ph && ph < hi) { TP_BEGIN(); __VA_ARGS__; if (ph + 1 < hi) { GRID_BAR(); } TP_END(); } ++ph; } while (0)
#define PHASEG(grp, ...) do { if (lo <= ph && ph < hi) { TP_BEGIN(); if ((REPEAT_MASK >> (grp)) & 1) { __VA_ARGS__; GRID_BAR(); } __VA_ARGS__; if (ph + 1 < hi) { GRID_BAR(); } TP_END(); } ++ph; } while (0)
    PHASE(ph_mod(c, ldsf));
#define LAYER_BODY(l) do { const float* mod = WSF(O_MOD); \
        const float* xin = l == 0 ? c.in[0] : WSF(O_X1); float* xmid = WSF(O_X0); float* xout = WSF(O_X1); \
        const float* ml = mod + (size_t)l * NB * D6; \
        PHASEG(3, ph_convert(c, l, ldsf)); \
        PHASEG(0, { pg8::Gemm g{D, D, D}; pg8::StaticOrder so; so.init(T, PW, G, cwg, WSH(O_H), WSH(O_WIN), D, D); pg8::EpiBf16 E{WSH(O_P), PW}; pg8::gemm_phase(lds, g, so, E); }); \
        PHASE(ph_lru<1>(c, l, ldsf); ph_ret_kv(c, ldsf); ph_sgu_norm(c, l); ph_rw_shift(c, l)); \
        PHASE(ph_lru_scan2(c); ph_ret_state(c); ph_sgu_mix(c, l, ldsf); ph_rw_lora(c, l, ldsf)); \
        PHASE(ph_lru<2>(c, l, ldsf); ph_ret_out(c, ldsf); ph_rw_chunk(c, l, ldsf)); \
        PHASE(ph_rw_seq(c, ldsf)); \
        PHASE(ph_rw_out(c)); \
        PHASEG(1, { pg8::Gemm g{W, 4 * W, 4 * W}; pg8::MergeOrder mo; mo.so.init(T, D, G, cwg, WSH(O_YS), WSH(O_WBR), 4 * W, 4 * W); mo.kseg_bytes = W * 2; pg8::EpiMerge E{WSH(O_P), WSF(O_PART), WSH(O_MRG)}; pg8::gemm_phase(lds, g, mo, E); }); \
        PHASEG(1, { pg8::Gemm g{D, D, D}; pg8::StaticOrder so; so.init(T, D, G, cwg, WSH(O_MRG), WSH(O_WOUT), D, D); pg8::EpiResid E{xin, ml + 2 * D, xmid}; pg8::gemm_phase(lds, g, so, E); }); \
        PHASEG(6, ph_norm(c, xmid, c.in[4] + (size_t)l * D, ml + 3 * D, ml + 4 * D, WSH(O_H), WSF(O_HF))); \
        PHASE(ph_router(c, l, ldsf)); \
        PHASE(ph_moe_plan(c, l)); \
        PHASE(ph_moe_assign(c, l)); \
        PHASEG(6, ph_moe_gather(c)); \
        const int* plan = CTLW(c) + CW_PLAN + l * 256; \
        PHASEG(2, { pg8::Gemm g{D, D, D}; pg8::MoeOrder mo{G, cwg, 4, plan, (const char*)WSH(O_XS), (const char*)WSH(O_WGU), (size_t)256 * D * 2, (size_t)256 * D * 2, (size_t)1024 * D * 2}; pg8::EpiGU E{WSH(O_ACT)}; pg8::gemm_phase(lds, g, mo, E); }); \
        PHASEG(2, { pg8::Gemm g{512, 512, 512}; pg8::MoeOrder mo{G, cwg, 8, plan, (const char*)WSH(O_ACT), (const char*)WSH(O_WDN), (size_t)256 * 512 * 2, (size_t)256 * 512 * 2, (size_t)D * 512 * 2}; pg8::EpiBf16 E{WSH(O_YE), D}; pg8::gemm_phase(lds, g, mo, E); }); \
        if (l == 0) PHASE(ph_comb_norm<0>(c, xmid, ml + 5 * D, xout, c.in[3] + (size_t)1 * D, mod + (size_t)1 * NB * D6 + 0 * D, mod + (size_t)1 * NB * D6 + 1 * D, WSH(O_H), nullptr)); \
        else PHASE(ph_comb_norm<1>(c, xmid, ml + 5 * D, xout, c.in[36], nullptr, nullptr, nullptr, c.out)); \
    } while (0)
    PHASE(ph_norm(c, c.in[0], c.in[3], WSF(O_MOD) + 0 * D, WSF(O_MOD) + 1 * D, WSH(O_H), nullptr));
    LAYER_BODY(0);
    LAYER_BODY(1);
#undef LAYER_BODY
#if TIME_PHASE >= 0 && !defined(CPU_EMU)
    if (blockIdx.x == 0) { const unsigned long long te = __builtin_amdgcn_s_memrealtime(), dl = 8ull * (tp1 - tp0); while (__builtin_amdgcn_s_memrealtime() - te < dl) __builtin_amdgcn_s_sleep(8); }
#endif
#undef PHASE
}
}

#ifndef CPU_EMU
extern "C" void kernel_launch(void* const* d_in, const int* in_sizes, int n_in, void* d_out, int out_size, void* d_ws, size_t ws_size, hipStream_t stream) {
    static int grid = 0;
    if (grid == 0) {
        if (n_in != 37 || out_size != T * D || ws_size < WS_END) { fprintf(stderr, "kernel_launch: unexpected shapes (n_in %d out %d ws %zu need %zu)\n", n_in, out_size, ws_size, (size_t)WS_END); grid = -1; return; }
        int dev = 0, cus = 0, per_cu = 0;
        if (hipGetDevice(&dev) != hipSuccess || hipDeviceGetAttribute(&cus, hipDeviceAttributeMultiprocessorCount, dev) != hipSuccess) { grid = -1; return; }
        if (hipFuncSetAttribute((const void*)fwd, hipFuncAttributeMaxDynamicSharedMemorySize, LDS_BYTES) != hipSuccess) { fprintf(stderr, "kernel_launch: hipFuncSetAttribute failed\n"); grid = -1; return; }
        if (hipOccupancyMaxActiveBlocksPerMultiprocessor(&per_cu, (const void*)fwd, NT, LDS_BYTES) != hipSuccess || per_cu < 1) fprintf(stderr, "kernel_launch: occupancy query says %d\n", per_cu);
        (void)hipGetLastError();
        grid = cus;
    }
    if (grid < 0) return;
    (void)in_sizes;
    (void)hipMemsetAsync((char*)d_ws + O_CTL, 0, CTL_BYTES, stream);
    Params p{};
    for (int i = 0; i < 37; ++i) p.in[i] = (const float*)d_in[i];
    p.out = (float*)d_out; p.ws = (unsigned char*)d_ws;
#if ONE_LAUNCH
    p.ph_lo = 0; p.ph_hi = NPH;
    hipLaunchKernelGGL(fwd, dim3(grid), dim3(NT), LDS_BYTES, stream, p);
#else
    for (int k = 0; k < NPH; ++k) { p.ph_lo = k; p.ph_hi = k + 1; hipLaunchKernelGGL(fwd, dim3(grid), dim3(NT), LDS_BYTES, stream, p); }
#endif
}
#endif
```

```cpp
#ifndef CPU_EMU
#include <hip/hip_runtime.h>
#endif
#include <cstdio>
#include <cstdint>
#include <cmath>
#include <cstring>

#ifndef SEQ
#define SEQ 4096
#endif
#ifndef ONE_LAUNCH
#define ONE_LAUNCH 1
#endif

namespace {
constexpr int D = 2048, NB = 2, S = SEQ, T = NB * S, NL = 2, W = 1024;
constexpr int INW = 18816, RF = 3456, D6 = 6 * D;
constexpr int C_LX = 0, C_LG = 1024, C_RQ = 2048, C_RK = 2560, C_RV = 3072, C_RG = 4096, C_SU = 5120, C_SV = 6144, C_RW = 7168;
constexpr int PW = 18944, C_MLP = 10752;
constexpr int NCH = S / 128;
constexpr int NLC = S / 64;
constexpr int NE = 32, CAP = (T * 2 / 256 + NE) * 256, MAXBLK = CAP / 256;
constexpr float EPS = 1e-6f;
constexpr float DECAY_SCALE = 0.60653065971263342f;
constexpr int NT = 512;
constexpr int NPH_LAYER = 17, NPH = 2 + NL * NPH_LAYER;
typedef unsigned short bf16_t;
#ifdef CPU_EMU
typedef float f32x4 __attribute__((vector_size(16)));
typedef unsigned u32x4 __attribute__((vector_size(16)));
#else
typedef float f32x4 __attribute__((ext_vector_type(4)));
typedef unsigned u32x4 __attribute__((ext_vector_type(4)));
typedef short bf16x8 __attribute__((ext_vector_type(8)));
#endif

constexpr size_t al256(size_t x) { return (x + 255) & ~(size_t)255; }
constexpr size_t SZ_X = (size_t)T * D * 4, SZ_W = (size_t)T * W * 4;
constexpr size_t O_CTL = 0, CTL_BYTES = 1u << 20;
constexpr size_t O_MOD = CTL_BYTES;
constexpr size_t O_X0 = O_MOD + al256((size_t)NL * NB * D6 * 4);
constexpr size_t O_X1 = O_X0 + SZ_X;
constexpr size_t O_H = O_X1 + SZ_X;
constexpr size_t O_HF = O_H + SZ_X / 2;
constexpr size_t O_P = O_HF + SZ_X;
constexpr size_t SZ_P = (size_t)T * PW * 2;
constexpr size_t O_XC = O_P + SZ_P;
constexpr size_t O_LA = O_XC + SZ_W, O_LU = O_LA + 2 * SZ_W;
constexpr size_t SZ_LC = (size_t)2 * NB * NLC * W * 4;
constexpr size_t O_LCA = O_LU + 2 * SZ_W, O_LCH = O_LCA + SZ_LC, O_LCI = O_LCH + SZ_LC;
constexpr size_t O_YS = O_LCI + SZ_LC;
constexpr size_t O_SC = O_YS + (size_t)T * 4 * W * 2;
constexpr size_t SZ_KV = (size_t)NB * NCH * 8 * 64 * 128 * 4;
constexpr size_t O_KVF = O_SC, O_KVB = O_KVF + SZ_KV, O_STF = O_KVB + SZ_KV, O_STB = O_STF + SZ_KV;
constexpr size_t O_VN = O_STB + SZ_KV;
constexpr size_t O_FS = O_VN + SZ_W;
constexpr size_t O_DEC = O_FS + al256((size_t)T * RF * 4), O_AA = O_DEC + 2 * SZ_W, O_AKK = O_AA + 2 * SZ_W;
constexpr size_t O_GG = O_AKK, O_YY = O_GG + SZ_W;
constexpr int RCK = 64, NRC = S / RCK;
constexpr size_t O_BON = O_YY + 2 * SZ_W;
constexpr size_t O_PART = O_BON + al256((size_t)2 * T * 16 * 4);
constexpr size_t O_MRG = O_PART + SZ_X;
constexpr size_t O_LOG = O_MRG + SZ_X / 2;
constexpr size_t O_EID = O_LOG + al256((size_t)T * 40 * 4), O_EWT = O_EID + al256((size_t)T * 2 * 4), O_DEST = O_EWT + al256((size_t)T * 2 * 4);
constexpr size_t O_SLOT = O_DEST + al256((size_t)T * 2 * 4);
constexpr size_t O_PST = O_SLOT + al256((size_t)CAP * 4), O_PYT = O_PST + (size_t)64 * NRC * 4096 * 2, O_SVB = O_PYT + (size_t)64 * NRC * 4096 * 2, O_YVB = O_SVB + (size_t)64 * NRC * 4096 * 4;
constexpr size_t O_WIN = O_YVB + (size_t)64 * NRC * 4096 * 4;
constexpr size_t O_WBR = O_WIN + (size_t)PW * D * 2;
constexpr size_t O_WOUT = O_WBR + (size_t)D * 4 * W * 2;
constexpr size_t O_WGU = O_WOUT + (size_t)D * D * 2;
constexpr size_t O_WDN = O_WGU + (size_t)NE * 1024 * D * 2;
constexpr size_t O_WLR = O_WDN + (size_t)NE * D * 512 * 2;
constexpr size_t O_WUT = O_WLR + (size_t)32 * 128 * 128 * 2;
constexpr size_t O_WAT = O_WUT + (size_t)2 * W * 64 * 2;
constexpr size_t O_WGT = O_WAT + (size_t)2 * W * 64 * 2;
constexpr size_t O_WRH = O_WGT + (size_t)W * 128 * 2;
constexpr size_t O_WRL = O_WRH + (size_t)48 * D * 2;
constexpr size_t WS_END0 = O_WRL + (size_t)48 * D * 2;
constexpr size_t SZ_MOE = (size_t)CAP * (D + 512 + D) * 2;
constexpr bool MOE_OVERLAY = SZ_MOE <= SZ_P;
constexpr size_t O_XS = MOE_OVERLAY ? O_P : WS_END0;
constexpr size_t O_ACT = O_XS + (size_t)CAP * D * 2;
constexpr size_t O_YE = O_ACT + (size_t)CAP * 512 * 2;
constexpr size_t WS_END = MOE_OVERLAY ? WS_END0 : WS_END0 + SZ_MOE;
static_assert(SEQ != 4096 || WS_END <= (size_t)2040 * 1024 * 1024, "workspace budget: d_ws is 4 x the largest input = 2048 MiB");
constexpr int CW_BAR = 4096;
constexpr int CW_CNT = 32768;
constexpr int CW_FILL = CW_CNT + NL * 64;
constexpr int CW_PLAN = CW_FILL + NL * 64;
static_assert(MAXBLK <= 160, "plan words");

struct Params { const float* in[37]; float* out; unsigned char* ws; int ph_lo, ph_hi; };

struct Ctx { const float* const* in; float* out; unsigned char* ws; };
#define GT_ ((long)blockIdx.x * NT + threadIdx.x)
#define GS_ ((long)gridDim.x * NT)
#define WSF(off) ((float*)(c.ws + (off)))
#define WSI(off) ((int*)(c.ws + (off)))
#define WSH(off) ((bf16_t*)(c.ws + (off)))
#define CTLW(c) ((int*)((c).ws + O_CTL))

#ifdef CPU_EMU
__device__ __forceinline__ float fexp_(float x) { return expf(x); }
__device__ __forceinline__ float frcp_(float x) { return 1.f / x; }
#else
__device__ __forceinline__ float fexp_(float x) { return __builtin_amdgcn_exp2f(x * 1.4426950408889634f); }
__device__ __forceinline__ float frcp_(float x) { return __builtin_amdgcn_rcpf(x); }
#endif
__device__ __forceinline__ float sigmoidf_(float x) { return frcp_(1.f + fexp_(-x)); }
__device__ __forceinline__ float siluf_(float x) { return x * frcp_(1.f + fexp_(-x)); }
__device__ __forceinline__ float tanhf_(float x) { return 1.f - 2.f * frcp_(1.f + fexp_(2.f * x)); }
__device__ __forceinline__ float geluf_(float x) { return 0.5f * x * (1.f + tanhf_(0.7978845608028654f * (x + 0.044715f * x * x * x))); }
__device__ __forceinline__ float softplusf_(float x) { return x > 0.f ? x + log1pf(expf(-x)) : log1pf(expf(x)); }
__device__ __forceinline__ float loggamma_(int h) { return log1pf(-exp2f(-5.f - (float)h)); }
__device__ __forceinline__ unsigned f2u_(float f) { unsigned u; memcpy(&u, &f, 4); return u; }
__device__ __forceinline__ float u2f_(unsigned u) { float f; memcpy(&f, &u, 4); return f; }
__device__ __forceinline__ float bf2f(bf16_t v) { return u2f_((unsigned)v << 16); }
__device__ __forceinline__ unsigned f2bf(float f) { const unsigned u = f2u_(f); return (u + 0x7fffu + ((u >> 16) & 1u)) >> 16; }
__device__ __forceinline__ unsigned pk2(float lo, float hi) { return f2bf(lo) | (f2bf(hi) << 16); }
__device__ __forceinline__ float bflo(unsigned w) { return u2f_(w << 16); }
__device__ __forceinline__ float bfhi(unsigned w) { return u2f_(w & 0xffff0000u); }
__device__ __forceinline__ int atomic_add_i(int* p, int v) {
#ifdef CPU_EMU
    return __atomic_fetch_add(p, v, __ATOMIC_RELAXED);
#else
    return atomicAdd(p, v);
#endif
}
#define PF(P, r, col) bf2f((P)[(size_t)(r) * PW + (col)])
#ifdef CPU_EMU
#define SYNCTHREADS() emu_syncthreads()
#define SHFL_XOR(v, m) emu_shfl_xor(v, m)
#else
#define SYNCTHREADS() __syncthreads()
#define SHFL_XOR(v, m) __shfl_xor(v, m)
#endif
#ifdef CPU_EMU
__device__ __forceinline__ float wave_sum(float v) {
    for (int o = 1; o < 64; o <<= 1) v += SHFL_XOR(v, o);
    return v;
}
#else
__device__ __forceinline__ float wave_sum(float x) {
    x += __builtin_bit_cast(float, __builtin_amdgcn_update_dpp(0, __builtin_bit_cast(int, x), 0xB1, 0xF, 0xF, true));
    x += __builtin_bit_cast(float, __builtin_amdgcn_update_dpp(0, __builtin_bit_cast(int, x), 0x4E, 0xF, 0xF, true));
    x += __builtin_bit_cast(float, __builtin_amdgcn_update_dpp(0, __builtin_bit_cast(int, x), 0x141, 0xF, 0xF, true));
    x += __builtin_bit_cast(float, __builtin_amdgcn_update_dpp(0, __builtin_bit_cast(int, x), 0x140, 0xF, 0xF, true));
    const int xi = __builtin_bit_cast(int, x);
    return (__builtin_bit_cast(float, __builtin_amdgcn_readlane(xi, 0)) + __builtin_bit_cast(float, __builtin_amdgcn_readlane(xi, 16))) + (__builtin_bit_cast(float, __builtin_amdgcn_readlane(xi, 32)) + __builtin_bit_cast(float, __builtin_amdgcn_readlane(xi, 48)));
}
#endif
__device__ __forceinline__ f32x4 ld_bf4(const bf16_t* p) { const unsigned long long q = *(const unsigned long long*)p; const unsigned lo = (unsigned)q, hi = (unsigned)(q >> 32); return (f32x4){bflo(lo), bfhi(lo), bflo(hi), bfhi(hi)}; }
__device__ __forceinline__ void st_bf4(bf16_t* p, const f32x4 v) { *(unsigned long long*)p = (unsigned long long)pk2(v[0], v[1]) | ((unsigned long long)pk2(v[2], v[3]) << 32); }

template <int KT, int NTL>
__device__ __forceinline__ void wave_mma(f32x4 (&acc)[NTL], const bf16_t* A, int lda, const bf16_t* Bt, int ldb) {
    const int lane = threadIdx.x & 63, fr = lane & 15, fq = lane >> 4;
#ifdef CPU_EMU
    for (int nt = 0; nt < NTL; ++nt) for (int r = 0; r < 4; ++r) { float sacc = 0.f; const bf16_t* a = A + fr * lda; const bf16_t* b = Bt + (16 * nt + 4 * fq + r) * ldb;
        for (int k = 0; k < 32 * KT; ++k) sacc += bf2f(a[k]) * bf2f(b[k]);
        acc[nt][r] += sacc; }
#else
#pragma unroll
    for (int kt = 0; kt < KT; ++kt) {
        const bf16x8 af = *(const bf16x8*)(A + fr * lda + kt * 32 + fq * 8);
#pragma unroll
        for (int nt = 0; nt < NTL; ++nt) { const bf16x8 bfr = *(const bf16x8*)(Bt + (16 * nt + fr) * ldb + kt * 32 + fq * 8);
            acc[nt] = __builtin_amdgcn_mfma_f32_16x16x32_bf16(bfr, af, acc[nt], 0, 0, 0); }
    }
#endif
}
__device__ __forceinline__ void ph_mod(const Ctx& c, float* ldsf) {
    const float* cc = c.in[1]; const float* aw = c.in[5]; const float* ab = c.in[6]; float* mod = WSF(O_MOD);
    float* scs = ldsf; float* part = ldsf + NB * D; const int tid = threadIdx.x, c4 = (tid & 31) * 4, kq = tid >> 5;
    for (int i = tid; i < NB * D; i += NT) scs[i] = siluf_(cc[i]);
    SYNCTHREADS();
    for (int u = blockIdx.x; u < NL * (D6 / 128); u += gridDim.x) {
        const int l = u / (D6 / 128), j0 = (u % (D6 / 128)) * 128;
        const float* w = aw + (size_t)l * D * D6 + j0 + c4; f32x4 a0 = (f32x4){0.f, 0.f, 0.f, 0.f}, a1 = a0;
#pragma unroll 8
        for (int k = kq * 128; k < kq * 128 + 128; ++k) { const f32x4 wv = *(const f32x4*)(w + (size_t)k * D6); a0 += wv * scs[k]; a1 += wv * scs[D + k]; }
        *(f32x4*)(part + (kq * 2 + 0) * 128 + c4) = a0; *(f32x4*)(part + (kq * 2 + 1) * 128 + c4) = a1;
        SYNCTHREADS();
        if (tid < 256) { const int b = tid >> 7, col = tid & 127; float sacc = 0.f;
#pragma unroll
            for (int q = 0; q < 16; ++q) sacc += part[(q * 2 + b) * 128 + col];
            mod[((size_t)l * NB + b) * D6 + j0 + col] = sacc + ab[l * D6 + j0 + col]; }
        SYNCTHREADS();
    }
}
__device__ __forceinline__ void ph_norm(const Ctx& c, const float* x, const float* g, const float* sh, const float* sc, bf16_t* hb, float* hf) {
    const int lane = threadIdx.x & 63, gw = blockIdx.x * (NT / 64) + (threadIdx.x >> 6), ngw = gridDim.x * (NT / 64);
    for (int t0 = gw * 2; t0 < T; t0 += ngw * 2) {
        f32x4 v[2][8]; float ss[2] = {0.f, 0.f};
#pragma unroll
        for (int r = 0; r < 2; ++r)
#pragma unroll
            for (int j = 0; j < 8; ++j) v[r][j] = *(const f32x4*)(x + (size_t)(t0 + r) * D + (j * 64 + lane) * 4);
#pragma unroll
        for (int r = 0; r < 2; ++r) {
#pragma unroll
            for (int j = 0; j < 8; ++j) ss[r] += (v[r][j][0] * v[r][j][0] + v[r][j][1] * v[r][j][1]) + (v[r][j][2] * v[r][j][2] + v[r][j][3] * v[r][j][3]);
            const int t = t0 + r, b = t / S; const float rs = 1.f / sqrtf(wave_sum(ss[r]) * (1.f / D) + EPS);
#pragma unroll
            for (int j = 0; j < 8; ++j) { const int col = (j * 64 + lane) * 4;
                const f32x4 o = v[r][j] * rs * *(const f32x4*)(g + col) * (*(const f32x4*)(sc + b * D6 + col) + 1.f) + *(const f32x4*)(sh + b * D6 + col);
                st_bf4(hb + (size_t)t * D + col, o); if (hf) *(f32x4*)(hf + (size_t)t * D + col) = o; }
        }
    }
}
template <int MODE>
__device__ __forceinline__ void ph_comb_norm(const Ctx& c, const float* xmid, const float* g2, float* xout, const float* g, const float* sh, const float* sc, bf16_t* hb, float* outp) {
    const bf16_t* YE = WSH(O_YE); const float* EWT = WSF(O_EWT); const int* DEST = WSI(O_DEST);
    const int lane = threadIdx.x & 63, gw = blockIdx.x * (NT / 64) + (threadIdx.x >> 6), ngw = gridDim.x * (NT / 64);
    for (int t = gw; t < T; t += ngw) {
        const int b = t / S; const float w0 = EWT[t * 2], w1 = EWT[t * 2 + 1]; const bf16_t* y0 = YE + (size_t)DEST[t * 2] * D; const bf16_t* y1 = YE + (size_t)DEST[t * 2 + 1] * D;
        f32x4 v[8]; float ss = 0.f;
#pragma unroll
        for (int j = 0; j < 8; ++j) { const int col = (j * 64 + lane) * 4;
            v[j] = *(const f32x4*)(xmid + (size_t)t * D + col) + *(const f32x4*)(g2 + b * D6 + col) * (ld_bf4(y0 + col) * w0 + ld_bf4(y1 + col) * w1);
            if (MODE == 0) *(f32x4*)(xout + (size_t)t * D + col) = v[j];
            ss += (v[j][0] * v[j][0] + v[j][1] * v[j][1]) + (v[j][2] * v[j][2] + v[j][3] * v[j][3]); }
        const float rs = 1.f / sqrtf(wave_sum(ss) * (1.f / D) + EPS);
#pragma unroll
        for (int j = 0; j < 8; ++j) { const int col = (j * 64 + lane) * 4;
            if (MODE == 0) st_bf4(hb + (size_t)t * D + col, v[j] * rs * *(const f32x4*)(g + col) * (*(const f32x4*)(sc + b * D6 + col) + 1.f) + *(const f32x4*)(sh + b * D6 + col));
            else *(f32x4*)(outp + (size_t)t * D + col) = v[j] * rs * *(const f32x4*)(g + col); }
    }
}

struct CvtItem { const float* Wp; int ldw; bf16_t* WT; int ldt; int drow, k0, n0; };
constexpr int I_IN = 32 * (INW / 32), I_BR = 4 * 16 * 64, I_OUT = 32 * 64, I_GU = NE * 32 * 32, I_DN = NE * 8 * 64, I_LR = 32 * 8, I_WU = 2 * 32, I_WG = 64, I_BIG = I_IN + I_BR + I_OUT + I_GU + I_DN, I_ALL = I_BIG + I_LR + 2 * I_WU + I_WG;
__device__ __forceinline__ CvtItem cvt_decode(const Ctx& c, int l, int it) {
    CvtItem r;
    if (it < I_IN) { const int kb = it / (INW / 32), nb = it % (INW / 32); r.n0 = nb * 32; r.k0 = kb * 64; r.Wp = c.in[7] + (size_t)l * D * INW; r.ldw = INW; r.WT = WSH(O_WIN); r.ldt = D; r.drow = r.n0 < 10624 ? r.n0 : r.n0 + 128; return r; }
    it -= I_IN;
    if (it < I_BR) { const int sgm = it / 1024, q = it % 1024, kb = q / 64, nb = q % 64; r.n0 = nb * 32; r.k0 = kb * 64; r.Wp = c.in[28] + ((size_t)l * 4 + sgm) * W * D; r.ldw = D; r.WT = WSH(O_WBR) + sgm * W; r.ldt = 4 * W; r.drow = r.n0; return r; }
    it -= I_BR;
    if (it < I_OUT) { const int kb = it / 64, nb = it % 64; r.n0 = nb * 32; r.k0 = kb * 64; r.Wp = c.in[29] + (size_t)l * D * D; r.ldw = D; r.WT = WSH(O_WOUT); r.ldt = D; r.drow = r.n0; return r; }
    it -= I_OUT;
    if (it < I_GU) { const int e = it / 1024, q = it % 1024, kb = q / 32, nb = q % 32; r.n0 = nb * 32; r.k0 = kb * 64; r.Wp = c.in[34] + ((size_t)l * NE + e) * D * 1024; r.ldw = 1024; r.WT = WSH(O_WGU) + (size_t)e * 1024 * D; r.ldt = D;
        r.drow = r.n0 < 512 ? (r.n0 / 128) * 256 + (r.n0 % 128) : ((r.n0 - 512) / 128) * 256 + 128 + ((r.n0 - 512) % 128); return r; }
    it -= I_GU;
    if (it < I_DN) { const int e = it / 512, q = it % 512, kb = q / 64, nb = q % 64; r.n0 = nb * 32; r.k0 = kb * 64; r.Wp = c.in[35] + ((size_t)l * NE + e) * 512 * D; r.ldw = D; r.WT = WSH(O_WDN) + (size_t)e * D * 512; r.ldt = 512; r.drow = r.n0; return r; }
    it -= I_DN;
    if (it < I_LR) { const int m = it / 8, q = it % 8, kb = q / 4, nb = q % 4, z = m >> 4, ty = (m >> 3) & 1, n = m & 7; r.n0 = nb * 32; r.k0 = kb * 64; r.Wp = c.in[ty ? 12 : 10] + (((size_t)l * 2 + z) * 8 + n) * 128 * 128; r.ldw = 128;
        r.WT = WSH(O_WLR) + (size_t)m * 128 * 128; r.ldt = 128; r.drow = r.n0; return r; }
    it -= I_LR;
    if (it < 2 * I_WU) { const int ua = it / I_WU, q = it % I_WU, z = q / 32, nb = q % 32; r.n0 = nb * 32; r.k0 = 0; r.Wp = c.in[ua ? 23 : 21] + ((size_t)l * 2 + z) * 64 * W; r.ldw = W; r.WT = WSH(ua ? O_WAT : O_WUT) + (size_t)z * W * 64; r.ldt = 64; r.drow = r.n0; return r; }
    it -= 2 * I_WU;
    { const int kb = it / 32, nb = it % 32; r.n0 = nb * 32; r.k0 = kb * 64; r.Wp = c.in[24] + (size_t)l * 128 * W; r.ldw = W; r.WT = WSH(O_WGT); r.ldt = 128; r.drow = r.n0; return r; }
}
constexpr int J_IN = 16 * (INW / 128), J_BR = 4 * 8 * 16, J_OUT = 16 * 16, J_GU = NE * 16 * 8, J_DN = NE * 4 * 16, J_ALL = J_IN + J_BR + J_OUT + J_GU + J_DN;
__device__ __forceinline__ CvtItem cvt_decode_big(const Ctx& c, int l, int it) {
    CvtItem r;
    if (it < J_IN) { const int kb = it / (INW / 128), nb = it % (INW / 128); r.n0 = nb * 128; r.k0 = kb * 128; r.Wp = c.in[7] + (size_t)l * D * INW; r.ldw = INW; r.WT = WSH(O_WIN); r.ldt = D; r.drow = r.n0 < 10624 ? r.n0 : r.n0 + 128; return r; }
    it -= J_IN;
    if (it < J_BR) { const int sgm = it / 128, q = it % 128, kb = q / 16, nb = q % 16; r.n0 = nb * 128; r.k0 = kb * 128; r.Wp = c.in[28] + ((size_t)l * 4 + sgm) * W * D; r.ldw = D; r.WT = WSH(O_WBR) + sgm * W; r.ldt = 4 * W; r.drow = r.n0; return r; }
    it -= J_BR;
    if (it < J_OUT) { const int kb = it / 16, nb = it % 16; r.n0 = nb * 128; r.k0 = kb * 128; r.Wp = c.in[29] + (size_t)l * D * D; r.ldw = D; r.WT = WSH(O_WOUT); r.ldt = D; r.drow = r.n0; return r; }
    it -= J_OUT;
    if (it < J_GU) { const int e = it / 128, q = it % 128, kb = q / 8, nb = q % 8; r.n0 = nb * 128; r.k0 = kb * 128; r.Wp = c.in[34] + ((size_t)l * NE + e) * D * 1024; r.ldw = 1024; r.WT = WSH(O_WGU) + (size_t)e * 1024 * D; r.ldt = D;
        r.drow = r.n0 < 512 ? (r.n0 / 128) * 256 : ((r.n0 - 512) / 128) * 256 + 128; return r; }
    it -= J_GU;
    { const int e = it / 64, q = it % 64, kb = q / 16, nb = q % 16; r.n0 = nb * 128; r.k0 = kb * 128; r.Wp = c.in[35] + ((size_t)l * NE + e) * 512 * D; r.ldw = D; r.WT = WSH(O_WDN) + (size_t)e * D * 512; r.ldt = 512; r.drow = r.n0; return r; }
}
__device__ __forceinline__ void ph_convert(const Ctx& c, int l, float* ldsf) {
    const int lane = threadIdx.x & 63, wave = threadIdx.x >> 6; const int gw = blockIdx.x * (NT / 64) + wave, ngw = gridDim.x * (NT / 64);
    {
        const int tid = threadIdx.x, lr = tid >> 5, lc = (tid & 31) * 4;
        f32x4 rg[8]; int it = blockIdx.x; CvtItem r;
        if (it < J_ALL) { r = cvt_decode_big(c, l, it);
#pragma unroll
            for (int i = 0; i < 8; ++i) rg[i] = *(const f32x4*)(r.Wp + (size_t)(r.k0 + lr + 16 * i) * r.ldw + r.n0 + lc); }
        for (; it < J_ALL; it += gridDim.x) {
#pragma unroll
            for (int i = 0; i < 8; ++i) { float* dp = ldsf + (lr + 16 * i) * 129 + lc; dp[0] = rg[i][0]; dp[1] = rg[i][1]; dp[2] = rg[i][2]; dp[3] = rg[i][3]; }
            const CvtItem cur = r; const int nx = it + gridDim.x;
            if (nx < J_ALL) { r = cvt_decode_big(c, l, nx);
#pragma unroll
                for (int i = 0; i < 8; ++i) rg[i] = *(const f32x4*)(r.Wp + (size_t)(r.k0 + lr + 16 * i) * r.ldw + r.n0 + lc); }
            SYNCTHREADS();
#pragma unroll
            for (int q = 0; q < 4; ++q) { const int id = tid + NT * q, n = id >> 4, k8 = (id & 15) * 8; const float* sp = ldsf + k8 * 129 + n;
                u32x4 o; o[0] = pk2(sp[0 * 129], sp[1 * 129]); o[1] = pk2(sp[2 * 129], sp[3 * 129]); o[2] = pk2(sp[4 * 129], sp[5 * 129]); o[3] = pk2(sp[6 * 129], sp[7 * 129]);
                *(u32x4*)(cur.WT + (size_t)(cur.drow + n) * cur.ldt + cur.k0 + k8) = o; }
            SYNCTHREADS();
        }
    }
#ifdef CPU_EMU
    if (lane == 0) for (int it = I_BIG + gw; it < I_ALL; it += ngw) { const CvtItem r = cvt_decode(c, l, it);
        for (int kk = 0; kk < 64; ++kk) for (int nn = 0; nn < 32; ++nn) r.WT[(size_t)(r.drow + nn) * r.ldt + r.k0 + kk] = (bf16_t)f2bf(r.Wp[(size_t)(r.k0 + kk) * r.ldw + r.n0 + nn]); }
#else
    float* scr = ldsf + wave * (64 * 33 + 16);
    for (int it = I_BIG + gw; it < I_ALL; it += ngw) {
        const CvtItem r = cvt_decode(c, l, it);
#pragma unroll 8
        for (int i = 0; i < 32; ++i) { const int kk = 2 * i + (lane >> 5); scr[kk * 33 + (lane & 31)] = r.Wp[(size_t)(r.k0 + kk) * r.ldw + r.n0 + (lane & 31)]; }
        asm volatile("s_waitcnt lgkmcnt(0)" ::: "memory");
        const int cc = lane & 7;
#pragma unroll
        for (int j = 0; j < 4; ++j) { const int n = (lane >> 3) + 8 * j; const float* sp = scr + (8 * cc) * 33 + n;
            u32x4 o; o[0] = pk2(sp[0 * 33], sp[1 * 33]); o[1] = pk2(sp[2 * 33], sp[3 * 33]); o[2] = pk2(sp[4 * 33], sp[5 * 33]); o[3] = pk2(sp[6 * 33], sp[7 * 33]);
            *(u32x4*)(r.WT + (size_t)(r.drow + n) * r.ldt + r.k0 + 8 * cc) = o; }
        asm volatile("s_waitcnt lgkmcnt(0)" ::: "memory");
    }
#endif
    { const float* wg = c.in[30] + (size_t)l * D * 4; const float* we = c.in[32] + (size_t)l * D * 32; bf16_t* wh = WSH(O_WRH); bf16_t* wl = WSH(O_WRL);
      for (long i = GT_; i < (long)48 * D; i += GS_) { const int n = (int)(i / D), k = (int)(i % D); const float w = n < 4 ? wg[k * 4 + n] : n < 36 ? we[k * 32 + (n - 4)] : 0.f; const unsigned hb = f2bf(w); wh[i] = (bf16_t)hb; wl[i] = (bf16_t)f2bf(w - bf2f((bf16_t)hb)); } }
    for (long i = GT_; i < (long)128 * D / 2; i += GS_) ((unsigned*)(WSH(O_WIN) + (size_t)10624 * D))[i] = 0u;
}

namespace pg8 {
constexpr int BM = 256, BK = 64, HALF = 128, HTB = HALF * BK * 2, STAGE_BYTES = 8 * HTB;
__host__ __device__ __forceinline__ int lds_byte(int r, int cc) { const int st = (r >> 4) * 2 + (cc >> 5), rr = r & 15, c2 = cc & 31, ob = rr * 64 + c2 * 2; return st * 1024 + (ob ^ (((ob >> 9) & 1) << 5)); }
__host__ __device__ __forceinline__ void stage_rc(int b, int& R, int& C) { const int st = b / 1024, sb = b % 1024, swz = sb ^ (((sb >> 9) & 1) << 5); R = (st >> 1) * 16 + swz / 64; C = (st & 1) * 32 + (swz % 64) / 2; }
__host__ __device__ __forceinline__ int perm32(int rho) { const int n = rho >> 4, i = rho & 15; return 8 * (i >> 2) + 4 * n + (i & 3); }
struct Unit { int pm, pn, aux; const char* A; const char* B; };
struct Gemm { int K, lda, ldb; };

template <class Epi, class Sched>
__device__ __forceinline__ void gemm_phase(unsigned char* lds_, const Gemm g, const Sched& S, const Epi& E) {
#ifdef CPU_EMU
    if (threadIdx.x != 0) return;
    Unit u; const int K = g.K;
    float* Af = (float*)malloc((size_t)256 * K * 4); float* Bf = (float*)malloc((size_t)256 * K * 4); float* Cf = (float*)malloc(256 * 256 * 4);
    for (int i = 0; S.next(i, u); ++i) {
        const bf16_t* A = (const bf16_t*)u.A; const bf16_t* B = (const bf16_t*)u.B;
        for (int r = 0; r < 256; ++r) for (int k = 0; k < K; ++k) { Af[(size_t)r * K + k] = bf2f(A[(size_t)r * g.lda + k]); Bf[(size_t)r * K + k] = bf2f(B[(size_t)r * g.ldb + k]); }
        for (int r = 0; r < 256; ++r) for (int cc = 0; cc < 256; ++cc) { const float* a = Af + (size_t)r * K; const float* b = Bf + (size_t)cc * K; float sacc = 0.f; for (int k = 0; k < K; ++k) sacc += a[k] * b[k]; Cf[r * 256 + cc] = sacc; }
        for (int wid = 0; wid < 8; ++wid) for (int lane = 0; lane < 64; ++lane) {
            const int wr = wid >> 2, wc = wid & 3, fr = lane & 15, fq = lane >> 4; f32x4 acc[2][2][4][2];
            for (int ai = 0; ai < 2; ++ai) for (int bj = 0; bj < 2; ++bj) for (int m = 0; m < 4; ++m) for (int n = 0; n < 2; ++n) for (int j = 0; j < 4; ++j) {
                const int r = 128 * ai + 64 * wr + 16 * m + fr, cc = 128 * bj + 32 * wc + (Epi::PERM ? 8 * fq + 4 * n + j : 16 * n + 4 * fq + j); acc[ai][bj][m][n][j] = Cf[r * 256 + cc]; }
            E(acc, u, wr, wc, fr, fq);
        }
    }
    free(Af); free(Bf); free(Cf);
#else
    typedef __attribute__((address_space(3))) unsigned char* ldsp_t;
    ldsp_t lds = (ldsp_t)lds_;
    const int tid = threadIdx.x, wid = __builtin_amdgcn_readfirstlane(tid >> 6), lane = tid & 63, wr = wid >> 2, wc = wid & 3, fr = lane & 15, fq = lane >> 4;
    const int K = g.K, nt = K / BK;
    unsigned voffA[2], voffB[2];
#pragma unroll
    for (int i = 0; i < 2; ++i) { int R, C; stage_rc(tid * 16 + i * 8192, R, C); const int Rb = Epi::PERM ? ((R & ~31) + perm32(R & 31)) : R;
        voffA[i] = (unsigned)(R * g.lda + C) * 2u; voffB[i] = (unsigned)(Rb * g.ldb + C) * 2u; }
    const size_t kstep = (size_t)(BK * 2);
    const size_t hstepA = (size_t)HALF * g.lda * 2, hstepB = (size_t)HALF * g.ldb * 2;
    const unsigned ldsw = (unsigned)wid * 1024u;
    const int aoff = lds_byte(wr * 64 + fr, fq * 8), boff = lds_byte(wc * 32 + fr, fq * 8);
#define PG8_SA(b, h) (((b) * 2 + (h)) * HTB)
#define PG8_SB(b, h) ((4 + (b) * 2 + (h)) * HTB)
#define PG8_STAGE(bufoff, gbase, voff) do { _Pragma("unroll") for (int _i = 0; _i < 2; ++_i) \
        __builtin_amdgcn_global_load_lds((const unsigned*)((const char*)(gbase) + (voff)[_i]), (__attribute__((address_space(3))) unsigned*)(lds + (bufoff) + ldsw + _i * 8192), 16, 0, 0); } while (0)
#define PG8_LDA(dst, b, h) do { _Pragma("unroll") for (int m = 0; m < 4; ++m) _Pragma("unroll") for (int k = 0; k < 2; ++k) dst[m][k] = *(const __attribute__((address_space(3))) bf16x8*)(lds + PG8_SA(b, h) + aoff + m * 2048 + k * 1024); } while (0)
#define PG8_LDB(dst, b, h) do { _Pragma("unroll") for (int n = 0; n < 2; ++n) _Pragma("unroll") for (int k = 0; k < 2; ++k) dst[n][k] = *(const __attribute__((address_space(3))) bf16x8*)(lds + PG8_SB(b, h) + boff + n * 2048 + k * 1024); } while (0)
#define PG8_MMA(ai, bj, At, Bt) do { __builtin_amdgcn_s_setprio(1); _Pragma("unroll") for (int m = 0; m < 4; ++m) _Pragma("unroll") for (int n = 0; n < 2; ++n) _Pragma("unroll") for (int k = 0; k < 2; ++k) \
        acc[ai][bj][m][n] = __builtin_amdgcn_mfma_f32_16x16x32_bf16(Bt[n][k], At[m][k], acc[ai][bj][m][n], 0, 0, 0); __builtin_amdgcn_s_setprio(0); } while (0)
#define PG8_WAIT_V(n) asm volatile("s_waitcnt vmcnt(" #n ")" ::: "memory")
#define PG8_WAIT_L(n) asm volatile("s_waitcnt lgkmcnt(" #n ")" ::: "memory")
#define PG8_BAR __builtin_amdgcn_s_barrier()
#define PG8_SCHED __builtin_amdgcn_sched_barrier(0)
    Unit cur, nxt; int ui = 0;
    if (!S.next(0, cur)) return;
    f32x4 acc[2][2][4][2];
#pragma unroll
    for (int a = 0; a < 2; ++a)
#pragma unroll
        for (int b = 0; b < 2; ++b)
#pragma unroll
            for (int m = 0; m < 4; ++m)
#pragma unroll
                for (int n = 0; n < 2; ++n) acc[a][b][m][n] = (f32x4){0.f, 0.f, 0.f, 0.f};
    bf16x8 At[4][2], B0[2][2], B1[2][2];
    const char* cA = cur.A; const char* cB = cur.B;
    S.a_ready(cur);
    PG8_STAGE(PG8_SB(0, 0), cB, voffB); PG8_STAGE(PG8_SA(0, 0), cA, voffA); PG8_STAGE(PG8_SB(0, 1), cB + hstepB, voffB); PG8_STAGE(PG8_SA(0, 1), cA + hstepA, voffA);
    if (wr == 1) PG8_BAR;
    PG8_WAIT_V(4); PG8_BAR;
    PG8_STAGE(PG8_SB(1, 0), cB + kstep, voffB); PG8_STAGE(PG8_SA(1, 0), cA + kstep, voffA); PG8_STAGE(PG8_SB(1, 1), cB + hstepB + kstep, voffB);
    PG8_WAIT_V(6); PG8_BAR;
    for (;;) {
        const bool has_next = S.next(ui + 1, nxt);
        const char* nA = has_next ? nxt.A : cA; const char* nB = has_next ? nxt.B : cB;
        for (int t = 0; t < nt; t += 2) {
            const bool last = (t == nt - 2);
            const char* a1 = cA + (size_t)(t + 1) * kstep;
            const char* a2 = last ? nA : cA + (size_t)(t + 2) * kstep; const char* b2 = last ? nB : cB + (size_t)(t + 2) * kstep;
            const char* a3 = a2 + kstep; const char* b3 = b2 + kstep;
            if (last && has_next) S.a_ready(nxt);
            PG8_LDB(B0, 0, 0); PG8_SCHED; PG8_LDA(At, 0, 0); PG8_STAGE(PG8_SA(1, 1), a1 + hstepA, voffA);
            PG8_WAIT_L(8); PG8_BAR; PG8_WAIT_L(0); PG8_MMA(0, 0, At, B0); PG8_BAR; PG8_SCHED;
            PG8_LDB(B1, 0, 1); PG8_STAGE(PG8_SB(0, 0), b2, voffB);
            PG8_BAR; PG8_WAIT_L(0); PG8_MMA(0, 1, At, B1); PG8_BAR;
            PG8_LDA(At, 0, 1); PG8_STAGE(PG8_SA(0, 0), a2, voffA);
            PG8_BAR; PG8_WAIT_L(0); PG8_MMA(1, 0, At, B0); PG8_BAR; PG8_SCHED;
            PG8_STAGE(PG8_SB(0, 1), b2 + hstepB, voffB);
            PG8_WAIT_V(6); PG8_BAR; PG8_MMA(1, 1, At, B1); PG8_BAR;
            PG8_LDB(B0, 1, 0); PG8_SCHED; PG8_LDA(At, 1, 0); PG8_STAGE(PG8_SA(0, 1), a2 + hstepA, voffA);
            PG8_WAIT_L(8); PG8_BAR; PG8_WAIT_L(0); PG8_MMA(0, 0, At, B0); PG8_BAR; PG8_SCHED;
            PG8_LDB(B1, 1, 1); PG8_STAGE(PG8_SB(1, 0), b3, voffB);
            PG8_BAR; PG8_WAIT_L(0); PG8_MMA(0, 1, At, B1); PG8_BAR;
            PG8_LDA(At, 1, 1); PG8_STAGE(PG8_SA(1, 0), a3, voffA);
            PG8_BAR; PG8_WAIT_L(0); PG8_MMA(1, 0, At, B0); PG8_BAR; PG8_SCHED;
            PG8_STAGE(PG8_SB(1, 1), b3 + hstepB, voffB);
            PG8_WAIT_V(6); PG8_BAR; PG8_MMA(1, 1, At, B1); PG8_BAR;
        }
        E(acc, cur, wr, wc, fr, fq); S.done(cur);
        if (!has_next) break;
#pragma unroll
        for (int a = 0; a < 2; ++a)
#pragma unroll
            for (int b = 0; b < 2; ++b)
#pragma unroll
                for (int m = 0; m < 4; ++m)
#pragma unroll
                    for (int n = 0; n < 2; ++n) acc[a][b][m][n] = (f32x4){0.f, 0.f, 0.f, 0.f};
        cur = nxt; cA = nA; cB = nB; ++ui;
    }
    PG8_WAIT_V(0);
    if (wr == 0) PG8_BAR;
    PG8_BAR;
#undef PG8_SA
#undef PG8_SB
#undef PG8_STAGE
#undef PG8_LDA
#undef PG8_LDB
#undef PG8_MMA
#undef PG8_WAIT_V
#undef PG8_WAIT_L
#undef PG8_BAR
#undef PG8_SCHED
#endif
}

struct StaticOrder {
    int nM, nN, nwg, G, c; const char* A; const char* B; size_t tstepA, tstepB;
    __device__ __forceinline__ void init(int M, int N, int G_, int c_, const void* A_, const void* B_, int lda, int ldb) { nM = M / BM; nN = N / BM; nwg = nM * nN; G = G_; c = c_; A = (const char*)A_; B = (const char*)B_; tstepA = (size_t)BM * lda * 2; tstepB = (size_t)BM * ldb * 2; }
    __device__ __forceinline__ bool next(int i, Unit& u) const {
        const long L = (long)i * G + c; if (L >= nwg) return false;
        int wgid = (int)L; { const int q = nwg / 8, r = nwg % 8, xcd = wgid % 8, off = wgid / 8; wgid = (xcd < r ? xcd * (q + 1) : r * (q + 1) + (xcd - r) * q) + off; }
        const int nig = 8 * nN, gid = wgid / nig, fm = gid * 8, gsz = (nM - fm) < 8 ? (nM - fm) : 8;
        u.pm = fm + ((wgid % nig) % gsz); u.pn = (wgid % nig) / gsz; u.aux = 0; u.A = A + (size_t)u.pm * tstepA; u.B = B + (size_t)u.pn * tstepB; return true;
    }
    __device__ __forceinline__ void a_ready(const Unit&) const {}
    __device__ __forceinline__ void done(const Unit&) const {}
};
struct MergeOrder {
    StaticOrder so; int kseg_bytes;
    __device__ __forceinline__ bool next(int i, Unit& u) const { if (!so.next(i >> 2, u)) return false; u.aux = i & 3; u.A += (size_t)u.aux * kseg_bytes; u.B += (size_t)u.aux * kseg_bytes; return true; }
    __device__ __forceinline__ void a_ready(const Unit&) const {}
    __device__ __forceinline__ void done(const Unit&) const {}
};
struct MoeOrder {
    int G, c, ncol; const int* plan; const char* A; const char* B; size_t tstepA, tstepB, estep;
    __device__ __forceinline__ bool next(int i, Unit& u) const {
        const long L = (long)i * G + c; const int nblk = plan[40]; if (L >= (long)nblk * ncol) return false;
        u.pm = (int)(L / ncol); u.pn = (int)(L % ncol); u.aux = plan[64 + u.pm]; u.A = A + (size_t)u.pm * tstepA; u.B = B + (size_t)u.aux * estep + (size_t)u.pn * tstepB; return true;
    }
    __device__ __forceinline__ void a_ready(const Unit&) const {}
    __device__ __forceinline__ void done(const Unit&) const {}
};

__device__ __forceinline__ u32x4 pack8(const f32x4 v0, const f32x4 v1) { u32x4 w; w[0] = pk2(v0[0], v0[1]); w[1] = pk2(v0[2], v0[3]); w[2] = pk2(v1[0], v1[1]); w[3] = pk2(v1[2], v1[3]); return w; }
struct EpiBf16 {
    static constexpr bool PERM = true; bf16_t* O; int ldc;
    __device__ __forceinline__ void operator()(const f32x4 (&acc)[2][2][4][2], const Unit& u, int wr, int wc, int fr, int fq) const {
        const int row0 = u.pm * BM + wr * 64 + fr, col0 = u.pn * BM + wc * 32 + 8 * fq;
#pragma unroll
        for (int ai = 0; ai < 2; ++ai)
#pragma unroll
            for (int m = 0; m < 4; ++m) { bf16_t* rowp = O + (size_t)(row0 + ai * HALF + m * 16) * ldc + col0;
#pragma unroll
                for (int bj = 0; bj < 2; ++bj) *(u32x4*)(rowp + bj * HALF) = pack8(acc[ai][bj][m][0], acc[ai][bj][m][1]); }
    }
};
struct EpiMerge {
    static constexpr bool PERM = true; const bf16_t* P; bf16_t* MRG;
    __device__ __forceinline__ void operator()(const f32x4 (&acc)[2][2][4][2], const Unit& u, int wr, int wc, int fr, int fq) const {
        const int row0 = u.pm * BM + wr * 64 + fr, col0 = u.pn * BM + wc * 32 + 8 * fq, seg = u.aux;
#pragma unroll
        for (int ai = 0; ai < 2; ++ai)
#pragma unroll
            for (int m = 0; m < 4; ++m) { const size_t r = (size_t)(row0 + ai * HALF + m * 16);
#pragma unroll
                for (int bj = 0; bj < 2; ++bj) { const int cc = col0 + bj * HALF;
                    const u32x4 gw = *(const u32x4*)(P + r * PW + C_MLP + seg * D + cc);
                    f32x4 v0, v1;
#pragma unroll
                    for (int q = 0; q < 2; ++q) { v0[2 * q] = sigmoidf_(bflo(gw[q])) * acc[ai][bj][m][0][2 * q]; v0[2 * q + 1] = sigmoidf_(bfhi(gw[q])) * acc[ai][bj][m][0][2 * q + 1];
                        v1[2 * q] = sigmoidf_(bflo(gw[2 + q])) * acc[ai][bj][m][1][2 * q]; v1[2 * q + 1] = sigmoidf_(bfhi(gw[2 + q])) * acc[ai][bj][m][1][2 * q + 1]; }
                    bf16_t* mp = MRG + r * D + cc;
                    if (seg > 0) { const u32x4 pw = *(const u32x4*)mp;
#pragma unroll
                        for (int q = 0; q < 2; ++q) { v0[2 * q] += bflo(pw[q]); v0[2 * q + 1] += bfhi(pw[q]); v1[2 * q] += bflo(pw[2 + q]); v1[2 * q + 1] += bfhi(pw[2 + q]); } }
                    *(u32x4*)mp = pack8(v0, v1);
                }
#ifndef CPU_EMU
                asm volatile("" ::: "memory");
#endif
            }
    }
};
struct EpiResid {
    static constexpr bool PERM = false; const float* xin; const float* g1; float* xmid;
    __device__ __forceinline__ void operator()(const f32x4 (&acc)[2][2][4][2], const Unit& u, int wr, int wc, int fr, int fq) const {
        const int row0 = u.pm * BM + wr * 64 + fr, col0 = u.pn * BM + wc * 32 + 4 * fq;
#pragma unroll
        for (int ai = 0; ai < 2; ++ai)
#pragma unroll
            for (int m = 0; m < 4; ++m) { const int r = row0 + ai * HALF + m * 16; const float* gp = g1 + (size_t)(r / S) * D6;
#pragma unroll
                for (int bj = 0; bj < 2; ++bj)
#pragma unroll
                    for (int n = 0; n < 2; ++n) { const int cc = col0 + bj * HALF + n * 16; *(f32x4*)(xmid + (size_t)r * D + cc) = *(const f32x4*)(xin + (size_t)r * D + cc) + *(const f32x4*)(gp + cc) * acc[ai][bj][m][n]; }
#ifndef CPU_EMU
                asm volatile("" ::: "memory");
#endif
            }
    }
};
struct EpiGU {
    static constexpr bool PERM = true; bf16_t* ACT;
    __device__ __forceinline__ void operator()(const f32x4 (&acc)[2][2][4][2], const Unit& u, int wr, int wc, int fr, int fq) const {
        const int row0 = u.pm * BM + wr * 64 + fr, col0 = u.pn * HALF + wc * 32 + 8 * fq;
#pragma unroll
        for (int ai = 0; ai < 2; ++ai)
#pragma unroll
            for (int m = 0; m < 4; ++m) { f32x4 v0, v1;
#pragma unroll
                for (int j = 0; j < 4; ++j) { v0[j] = siluf_(acc[ai][0][m][0][j]) * acc[ai][1][m][0][j]; v1[j] = siluf_(acc[ai][0][m][1][j]) * acc[ai][1][m][1][j]; }
                *(u32x4*)(ACT + (size_t)(row0 + ai * HALF + m * 16) * 512 + col0) = pack8(v0, v1); }
    }
};
}

template <int PASS>
__device__ __forceinline__ void ph_lru(const Ctx& c, int l, float* ldsf) {
    const bf16_t* P = WSH(O_P); const float* cw = c.in[8] + (size_t)l * 4 * W; const float* cb = c.in[9] + (size_t)l * W;
    const float* br = c.in[11] + (size_t)l * 2 * W; const float* bi = c.in[13] + (size_t)l * 2 * W; const float* lam = c.in[14] + (size_t)l * 2 * W; const bf16_t* WLR = WSH(O_WLR);
    float* CA = WSF(O_LCA); float* CH = WSF(O_LCH); const float* CI = WSF(O_LCI); bf16_t* Y = WSH(O_YS);
    bf16_t* Xs = (bf16_t*)ldsf; bf16_t* Wr = Xs + 64 * 136; bf16_t* Wi = Wr + 128 * 136; float* AUa = (float*)Wr; float* AUu = AUa + 64 * 128; float* HF = (float*)(Wi + 128 * 136); float* spl = HF + 64 * 128;
    const int tid = threadIdx.x, wv = tid >> 6, lane = tid & 63, fr = lane & 15, fq = lane >> 4, rt = wv & 3, hf = wv >> 2;
    for (int u = blockIdx.x; u < (T / 64) * 8; u += gridDim.x) {
        const int n = u & 7, tile = u >> 3, b = tile / NLC, chk = tile % NLC; const long t0 = (long)tile * 64;
        if (tid < 256) spl[tid] = softplusf_(-lam[(tid >> 7) * W + n * 128 + (tid & 127)]);
#pragma unroll
        for (int q = 0; q < 4; ++q) { const int id = tid + NT * q, tl = id >> 5, e4 = (id & 31) * 4, ch = n * 128 + e4; const long t = t0 + tl; const int sI = (int)(t % S);
            f32x4 acc = *(const f32x4*)(cb + ch);
#pragma unroll
            for (int k = 0; k < 4; ++k) { const int ss = sI + k - 2; if (ss >= 0 && ss < S) acc += ld_bf4(P + (size_t)(t + k - 2) * PW + C_LX + ch) * *(const f32x4*)(cw + k * W + ch); }
            st_bf4(Xs + tl * 136 + e4, acc); }
        for (int z = 0; z < 2; ++z) {
#pragma unroll
            for (int q = 0; q < 4; ++q) { const int id = tid + NT * q, f = id >> 4, e8 = (id & 15) * 8;
                *(u32x4*)(Wr + f * 136 + e8) = *(const u32x4*)(WLR + ((size_t)((z * 2 + 0) * 8 + n) * 128 + f) * 128 + e8); *(u32x4*)(Wi + f * 136 + e8) = *(const u32x4*)(WLR + ((size_t)((z * 2 + 1) * 8 + n) * 128 + f) * 128 + e8); }
            SYNCTHREADS();
            f32x4 ar[4], ai[4];
#pragma unroll
            for (int nt = 0; nt < 4; ++nt) { ar[nt] = (f32x4){0.f, 0.f, 0.f, 0.f}; ai[nt] = (f32x4){0.f, 0.f, 0.f, 0.f}; }
            wave_mma<4, 4>(ar, Xs + rt * 16 * 136, 136, Wr + hf * 64 * 136, 136);
            wave_mma<4, 4>(ai, Xs + rt * 16 * 136, 136, Wi + hf * 64 * 136, 136);
            SYNCTHREADS();
            const int tl = rt * 16 + fr;
#pragma unroll
            for (int nt = 0; nt < 4; ++nt) { const int f = 64 * hf + 16 * nt + 4 * fq, ch = n * 128 + f;
                const f32x4 brv = *(const f32x4*)(br + z * W + ch), biv = *(const f32x4*)(bi + z * W + ch), lmv = *(const f32x4*)(spl + z * 128 + f), xcv = ld_bf4(Xs + tl * 136 + f); f32x4 av, uv;
#pragma unroll
                for (int e = 0; e < 4; ++e) { const float r = sigmoidf_(ar[nt][e] + brv[e]), ig = sigmoidf_(ai[nt][e] + biv[e]), la = -8.f * r * lmv[e]; const float a = fexp_(la); av[e] = a; uv[e] = sqrtf(fmaxf(1.f - a * a, 0.f)) * ig * xcv[e]; }
                *(f32x4*)(AUa + tl * 128 + f) = av; *(f32x4*)(AUu + tl * 128 + f) = uv; }
            SYNCTHREADS();
            if (tid < 128) { const int f = tid; const size_t ci = (((size_t)z * NB + b) * NLC + chk) * W + n * 128 + f;
                if (PASS == 1) { float prod = 1.f, h = 0.f;
#pragma unroll 8
                    for (int q = 0; q < 64; ++q) { const int sI = z == 0 ? q : 63 - q; const float a = AUa[sI * 128 + f]; h = a * h + AUu[sI * 128 + f]; prod *= a; }
                    CA[ci] = prod; CH[ci] = h;
                } else { float h = CI[ci];
                    if (z == 0) {
#pragma unroll 8
                        for (int q = 0; q < 64; ++q) { h = AUa[q * 128 + f] * h + AUu[q * 128 + f]; HF[q * 128 + f] = h; }
                    } else {
#pragma unroll 8
                        for (int q = 63; q >= 0; --q) { h = AUa[q * 128 + f] * h + AUu[q * 128 + f]; HF[q * 128 + f] += h; } } }
            }
            SYNCTHREADS();
        }
        if (PASS == 2) {
#pragma unroll
            for (int q = 0; q < 4; ++q) { const int id = tid + NT * q, tl = id >> 5, f4 = (id & 31) * 4; const long t = t0 + tl; f32x4 hv = *(const f32x4*)(HF + tl * 128 + f4); const f32x4 gv = ld_bf4(P + (size_t)t * PW + C_LG + n * 128 + f4);
#pragma unroll
                for (int e = 0; e < 4; ++e) hv[e] *= geluf_(gv[e]);
                st_bf4(Y + (size_t)t * 4 * W + 0 * W + n * 128 + f4, hv); }
            SYNCTHREADS();
        }
    }
}
__device__ __forceinline__ void ph_lru_scan2(const Ctx& c) {
    const float* CA = WSF(O_LCA); const float* CH = WSF(O_LCH); float* CI = WSF(O_LCI);
    for (long i = GT_; i < (long)2 * NB * W; i += GS_) {
        const int w = (int)(i % W), b = (int)((i / W) % NB), z = (int)(i / ((long)W * NB)); float carry = 0.f;
        for (int q = 0; q < NLC; ++q) { const int ch = z == 0 ? q : NLC - 1 - q; const size_t idx = (((size_t)z * NB + b) * NLC + ch) * W + w; CI[idx] = carry; carry = CA[idx] * carry + CH[idx]; }
    }
}
__device__ __forceinline__ void ret_tables(float* tab, int h) {
    const int tid = threadIdx.x; const float lg = loggamma_(h);
    if (tid < 32) tab[tid] = powf(10000.f, -(float)(2 * tid) / 64.f);
    if (tid >= 64 && tid < 64 + 129) tab[tid] = expf((float)(tid - 64) * lg);
}
__device__ __forceinline__ void ph_ret_kv(const Ctx& c, float* ldsf) {
    const int* pos = (const int*)c.in[2]; const bf16_t* P = WSH(O_P); float* KVF = WSF(O_KVF); float* KVB = WSF(O_KVB);
    bf16_t* VT = (bf16_t*)ldsf; bf16_t* KF = VT + 128 * 136; bf16_t* KB = KF + 64 * 136; float* tab = (float*)(KB + 64 * 136);
    const int tid = threadIdx.x, wv = tid >> 6, lane = tid & 63, fr = lane & 15, fq = lane >> 4;
    for (int u = blockIdx.x; u < (T / 128) * 8; u += gridDim.x) {
        const int h = u & 7; const long t0 = (long)(u >> 3) * 128;
        ret_tables(tab, h);
        SYNCTHREADS();
        { float x1[8], x2[8], pj[8];
#pragma unroll
          for (int q = 0; q < 8; ++q) { const int id = tid + NT * q, j = id & 127, dj = id >> 7; const bf16_t* prow = P + (size_t)(t0 + j) * PW + C_RK + h * 64; x1[q] = bf2f(prow[dj]); x2[q] = bf2f(prow[dj + 32]); pj[q] = (float)pos[t0 + j]; }
#pragma unroll 1
          for (int q = 0; q < 8; ++q) { const int id = tid + NT * q, j = id & 127, dj = id >> 7; const float ang = pj[q] * tab[dj]; const float cs = cosf(ang), sn = sinf(ang);
            const float k1 = x1[q] * cs - x2[q] * sn, k2 = x2[q] * cs + x1[q] * sn, fj = tab[64 + 127 - j], bj = tab[64 + j];
            KF[dj * 136 + j] = (bf16_t)f2bf(k1 * fj); KF[(dj + 32) * 136 + j] = (bf16_t)f2bf(k2 * fj); KB[dj * 136 + j] = (bf16_t)f2bf(k1 * bj); KB[(dj + 32) * 136 + j] = (bf16_t)f2bf(k2 * bj); } }
#pragma unroll
        for (int q = 0; q < 4; ++q) { const int id = tid + NT * q, j = id & 127, e8 = (id >> 7) * 8; const u32x4 raw = *(const u32x4*)(P + (size_t)(t0 + j) * PW + C_RV + h * 128 + e8);
#pragma unroll
            for (int e = 0; e < 4; ++e) { VT[(e8 + 2 * e) * 136 + j] = (bf16_t)(raw[e] & 0xffffu); VT[(e8 + 2 * e + 1) * 136 + j] = (bf16_t)(raw[e] >> 16); } }
        SYNCTHREADS();
        f32x4 af[4], ab[4];
#pragma unroll
        for (int nt = 0; nt < 4; ++nt) { af[nt] = (f32x4){0.f, 0.f, 0.f, 0.f}; ab[nt] = (f32x4){0.f, 0.f, 0.f, 0.f}; }
        wave_mma<4, 4>(af, VT + wv * 16 * 136, 136, KF, 136);
        wave_mma<4, 4>(ab, VT + wv * 16 * 136, 136, KB, 136);
        const size_t ob = (((size_t)(u >> 3) * 8 + h) * 128 + wv * 16 + fr) * 64 + 4 * fq;
#pragma unroll
        for (int nt = 0; nt < 4; ++nt) { *(f32x4*)(KVF + ob + 16 * nt) = af[nt]; *(f32x4*)(KVB + ob + 16 * nt) = ab[nt]; }
        SYNCTHREADS();
    }
}
__device__ __forceinline__ void ph_ret_state(const Ctx& c) {
    const float* KVF = WSF(O_KVF); const float* KVB = WSF(O_KVB); float* STF = WSF(O_STF); float* STB = WSF(O_STB);
    for (long i = GT_; i < (long)NB * 8 * 8192; i += GS_) {
        const int x = (int)(i % 8192), h = (int)((i / 8192) % 8), b = (int)(i / 65536);
        const float cd = expf(128.f * loggamma_(h)); float st = 0.f;
#pragma unroll 8
        for (int n = 0; n < NCH; ++n) { const size_t idx = (((size_t)b * NCH + n) * 8 + h) * 8192 + x; STF[idx] = st; st = cd * st + KVF[idx]; }
        st = 0.f;
#pragma unroll 8
        for (int n = NCH - 1; n >= 0; --n) { const size_t idx = (((size_t)b * NCH + n) * 8 + h) * 8192 + x; STB[idx] = st; st = cd * st + KVB[idx]; }
    }
}
__device__ __forceinline__ void ph_ret_out(const Ctx& c, float* ldsf) {
    const int* pos = (const int*)c.in[2]; const bf16_t* P = WSH(O_P); const float* STF = WSF(O_STF); const float* STB = WSF(O_STB); bf16_t* Y = WSH(O_YS);
    bf16_t* Qs = (bf16_t*)ldsf; bf16_t* Ks = Qs + 128 * 72; bf16_t* VT = Ks + 128 * 72; bf16_t* Ss = VT + 128 * 136; bf16_t* SF = Ss + 128 * 136; bf16_t* SB = SF + 128 * 72; float* tab = (float*)(SB + 128 * 72);
    const int tid = threadIdx.x, wv = tid >> 6, lane = tid & 63, fr = lane & 15, fq = lane >> 4;
    for (int u = blockIdx.x; u < (T / 128) * 8; u += gridDim.x) {
        const int h = u & 7; const long t0 = (long)(u >> 3) * 128;
        ret_tables(tab, h);
        SYNCTHREADS();
#pragma unroll 1
        for (int qh = 0; qh < 8; qh += 4) { float q1[4], q2[4], k1[4], k2[4], pj[4];
#pragma unroll
          for (int q = 0; q < 4; ++q) { const int id = tid + NT * (qh + q), j = id >> 5, dj = id & 31; const bf16_t* prow = P + (size_t)(t0 + j) * PW;
            q1[q] = bf2f(prow[C_RQ + h * 64 + dj]); q2[q] = bf2f(prow[C_RQ + h * 64 + dj + 32]); k1[q] = bf2f(prow[C_RK + h * 64 + dj]); k2[q] = bf2f(prow[C_RK + h * 64 + dj + 32]); pj[q] = (float)pos[t0 + j]; }
#pragma unroll
          for (int q = 0; q < 4; ++q) { const int id = tid + NT * (qh + q), j = id >> 5, dj = id & 31; const float ang = pj[q] * tab[dj]; const float cs = cosf(ang), sn = sinf(ang);
            Qs[j * 72 + dj] = (bf16_t)f2bf((q1[q] * cs - q2[q] * sn) * 0.125f); Qs[j * 72 + dj + 32] = (bf16_t)f2bf((q2[q] * cs + q1[q] * sn) * 0.125f); Ks[j * 72 + dj] = (bf16_t)f2bf(k1[q] * cs - k2[q] * sn); Ks[j * 72 + dj + 32] = (bf16_t)f2bf(k2[q] * cs + k1[q] * sn); } }
#pragma unroll
        for (int q = 0; q < 4; ++q) { const int id = tid + NT * q, j = id & 127, e8 = (id >> 7) * 8; const u32x4 raw = *(const u32x4*)(P + (size_t)(t0 + j) * PW + C_RV + h * 128 + e8);
#pragma unroll
            for (int e = 0; e < 4; ++e) { VT[(e8 + 2 * e) * 136 + j] = (bf16_t)(raw[e] & 0xffffu); VT[(e8 + 2 * e + 1) * 136 + j] = (bf16_t)(raw[e] >> 16); } }
        const size_t sbase = (((size_t)(u >> 3) * 8 + h)) * 8192;
#pragma unroll
        for (int q = 0; q < 4; ++q) { const int id = tid + NT * q, e = id >> 4, d4 = (id & 15) * 4; st_bf4(SF + e * 72 + d4, *(const f32x4*)(STF + sbase + (size_t)e * 64 + d4)); st_bf4(SB + e * 72 + d4, *(const f32x4*)(STB + sbase + (size_t)e * 64 + d4)); }
        SYNCTHREADS();
        const int i = wv * 16 + fr; const long t = t0 + i;
        {
            f32x4 sc[8];
#pragma unroll
            for (int nt = 0; nt < 8; ++nt) sc[nt] = (f32x4){0.f, 0.f, 0.f, 0.f};
            wave_mma<2, 8>(sc, Qs + wv * 16 * 72, 72, Ks, 72);
#pragma unroll
            for (int nt = 0; nt < 8; ++nt) { const int j0 = 16 * nt + 4 * fq; f32x4 sv;
#pragma unroll
                for (int e = 0; e < 4; ++e) { const int j = j0 + e, dist = i > j ? i - j : j - i; sv[e] = sc[nt][e] * tab[64 + dist]; }
                st_bf4(Ss + i * 136 + j0, sv); }
        }
#ifdef CPU_EMU
        SYNCTHREADS();
#else
        asm volatile("s_waitcnt lgkmcnt(0)" ::: "memory");
#endif
        f32x4 ao[8], tm[8];
#pragma unroll
        for (int nt = 0; nt < 8; ++nt) { ao[nt] = (f32x4){0.f, 0.f, 0.f, 0.f}; tm[nt] = (f32x4){0.f, 0.f, 0.f, 0.f}; }
        wave_mma<4, 8>(ao, Ss + wv * 16 * 136, 136, VT, 136);
        wave_mma<2, 8>(tm, Qs + wv * 16 * 72, 72, SF, 72);
        { const float qf = tab[64 + i + 1];
#pragma unroll
            for (int nt = 0; nt < 8; ++nt) { ao[nt] += tm[nt] * qf; tm[nt] = (f32x4){0.f, 0.f, 0.f, 0.f}; } }
        wave_mma<2, 8>(tm, Qs + wv * 16 * 72, 72, SB, 72);
        { const float qb = tab[64 + 128 - i];
#pragma unroll
            for (int nt = 0; nt < 8; ++nt) ao[nt] += tm[nt] * qb; }
        float sm = 0.f;
#pragma unroll
        for (int nt = 0; nt < 8; ++nt) sm += (ao[nt][0] + ao[nt][1]) + (ao[nt][2] + ao[nt][3]);
        sm += SHFL_XOR(sm, 16); sm += SHFL_XOR(sm, 32);
        const float mu = sm * (1.f / 128.f); float sq = 0.f;
#pragma unroll
        for (int nt = 0; nt < 8; ++nt) { ao[nt] -= mu; sq += (ao[nt][0] * ao[nt][0] + ao[nt][1] * ao[nt][1]) + (ao[nt][2] * ao[nt][2] + ao[nt][3] * ao[nt][3]); }
        sq += SHFL_XOR(sq, 16); sq += SHFL_XOR(sq, 32);
        const float rs = 1.f / sqrtf(sq * (1.f / 128.f) + EPS);
#pragma unroll
        for (int nt = 0; nt < 8; ++nt) { const int e0 = 16 * nt + 4 * fq; f32x4 gv = ld_bf4(P + (size_t)t * PW + C_RG + h * 128 + e0);
#pragma unroll
            for (int e = 0; e < 4; ++e) gv[e] = siluf_(gv[e]) * (ao[nt][e] * rs);
            st_bf4(Y + (size_t)t * 4 * W + 1 * W + h * 128 + e0, gv); }
        SYNCTHREADS();
    }
}
__device__ __forceinline__ void ph_sgu_norm(const Ctx& c, int l) {
    const bf16_t* P = WSH(O_P); float* ST = WSF(O_VN);
    const int lane = threadIdx.x & 63, gw = blockIdx.x * (NT / 64) + (threadIdx.x >> 6), ngw = gridDim.x * (NT / 64);
    for (int t = gw; t < T; t += ngw) {
        f32x4 v[4]; float sm = 0.f;
#pragma unroll
        for (int j = 0; j < 4; ++j) { v[j] = ld_bf4(P + (size_t)t * PW + C_SV + (j * 64 + lane) * 4);
#pragma unroll
            for (int q = 0; q < 4; ++q) { v[j][q] = geluf_(v[j][q]); sm += v[j][q]; } }
        const float mu = wave_sum(sm) * (1.f / W); float sq = 0.f;
#pragma unroll
        for (int j = 0; j < 4; ++j)
#pragma unroll
            for (int q = 0; q < 4; ++q) { const float dd = v[j][q] - mu; sq += dd * dd; }
        const float rs = 1.f / sqrtf(wave_sum(sq) * (1.f / W) + EPS);
        if (lane == 0) { ST[(size_t)t * 2] = mu; ST[(size_t)t * 2 + 1] = rs; }
    }
}
__device__ __forceinline__ void ph_sgu_mix(const Ctx& c, int l, float* ldsf) {
    const bf16_t* P = WSH(O_P); const float* ST = WSF(O_VN); bf16_t* Y = WSH(O_YS); const float* ng = c.in[15] + (size_t)l * W;
    bf16_t* As = (bf16_t*)ldsf; bf16_t* Bs = As + 128 * 136; const int tid = threadIdx.x, wv = tid >> 6, lane = tid & 63, fr = lane & 15, fq = lane >> 4;
    for (int u = blockIdx.x; u < (T / 128) * 8; u += gridDim.x) {
        const int g = u & 7; const long t0 = (long)(u >> 3) * 128;
        const float* ws = c.in[16] + ((size_t)l * 8 + g) * 128 * 128; const float* bs = c.in[17] + ((size_t)l * 8 + g) * 128;
#pragma unroll
        for (int q = 0; q < 8; ++q) { const int id = tid + NT * q, i = id >> 5, j4 = (id & 31) * 4; st_bf4(As + i * 136 + j4, *(const f32x4*)(ws + i * 128 + j4)); }
#pragma unroll
        for (int q = 0; q < 4; ++q) { const int id = tid + NT * q, j = id & 127, d8 = (id >> 7) * 8; const float mu = ST[(size_t)(t0 + j) * 2], rs = ST[(size_t)(t0 + j) * 2 + 1];
            const u32x4 raw = *(const u32x4*)(P + (size_t)(t0 + j) * PW + C_SV + g * 128 + d8);
#pragma unroll
            for (int e = 0; e < 4; ++e) { const float v0 = (geluf_(bflo(raw[e])) - mu) * rs * ng[g * 128 + d8 + 2 * e], v1 = (geluf_(bfhi(raw[e])) - mu) * rs * ng[g * 128 + d8 + 2 * e + 1];
                Bs[(d8 + 2 * e) * 136 + j] = (bf16_t)f2bf(v0); Bs[(d8 + 2 * e + 1) * 136 + j] = (bf16_t)f2bf(v1); } }
        SYNCTHREADS();
        f32x4 acc[8];
#pragma unroll
        for (int nt = 0; nt < 8; ++nt) acc[nt] = (f32x4){0.f, 0.f, 0.f, 0.f};
        wave_mma<4, 8>(acc, As + wv * 16 * 136, 136, Bs, 136);
        const int i = wv * 16 + fr; const long t = t0 + i; const float bsi = bs[i];
#pragma unroll
        for (int nt = 0; nt < 8; ++nt) { const int d = 16 * nt + 4 * fq; f32x4 uu = ld_bf4(P + (size_t)t * PW + C_SU + g * 128 + d);
#pragma unroll
            for (int e = 0; e < 4; ++e) uu[e] = geluf_(uu[e]) * (acc[nt][e] + bsi);
            st_bf4(Y + (size_t)t * 4 * W + 2 * W + g * 128 + d, uu); }
        SYNCTHREADS();
    }
}
__device__ __forceinline__ void ph_rw_shift(const Ctx& c, int l) {
    const bf16_t* P = WSH(O_P); const float* mup = c.in[18] + (size_t)l * RF; const float* mun = c.in[19] + (size_t)l * RF; bf16_t* FS = WSH(O_FS);
    const int lane = threadIdx.x & 63, gw = blockIdx.x * (NT / 64) + (threadIdx.x >> 6), ngw = gridDim.x * (NT / 64);
    for (int t = gw; t < T; t += ngw) {
        const int sI = t % S; const bf16_t* pc = P + (size_t)t * PW + C_RW;
#pragma unroll 2
        for (int j = lane * 4; j < RF; j += 256) {
            const f32x4 f = ld_bf4(pc + j), z4 = (f32x4){0.f, 0.f, 0.f, 0.f}; const f32x4 pv = sI > 0 ? ld_bf4(pc - PW + j) : z4, nv = sI < S - 1 ? ld_bf4(pc + PW + j) : z4;
            f32x4 v = f + *(const f32x4*)(mup + j) * (pv - f) + *(const f32x4*)(mun + j) * (nv - f);
            if (j >= 3072 && j < 3200) {
#pragma unroll
                for (int e = 0; e < 4; ++e) v[e] = tanhf_(v[e]); }
            else if (j >= 3328) {
#pragma unroll
                for (int e = 0; e < 4; ++e) v[e] = sigmoidf_(v[e]); }
            st_bf4(FS + (size_t)t * RF + j, v);
        }
    }
}
__device__ __forceinline__ void ph_rw_lora(const Ctx& c, int l, float* ldsf) {
    const bf16_t* FS = WSH(O_FS); const float* w0 = c.in[20] + (size_t)l * 2 * W; const float* a0 = c.in[22] + (size_t)l * 2 * W;
    const bf16_t* WUT = WSH(O_WUT); const bf16_t* WAT = WSH(O_WAT); const bf16_t* WGT = WSH(O_WGT);
    float* DEC = WSF(O_DEC); float* AA = WSF(O_AA); float* GG = WSF(O_GG);
    bf16_t* F = (bf16_t*)ldsf; bf16_t* B1 = F + 128 * 136; bf16_t* B2 = B1 + 128 * 136; const int tid = threadIdx.x, wv = tid >> 6, lane = tid & 63, fr = lane & 15, fq = lane >> 4;
    for (int u = blockIdx.x; u < (T / 128) * 8; u += gridDim.x) {
        const int wc0 = (u & 7) * 128; const long t0 = (long)(u >> 3) * 128;
        for (int rd = 0; rd < 3; ++rd) {
#pragma unroll
            for (int q = 0; q < 8; ++q) { const int id = tid + NT * q, r = id >> 5, c4 = (id & 31) * 4;
                const int col = rd < 2 ? (c4 < 64 ? 3072 + rd * 64 + c4 : 3200 + rd * 64 + (c4 - 64)) : 3328 + c4;
                *(unsigned long long*)(F + r * 136 + c4) = *(const unsigned long long*)(FS + (size_t)(t0 + r) * RF + col); }
            if (rd < 2) {
#pragma unroll
                for (int q = 0; q < 2; ++q) { const int id = tid + NT * q, w = id >> 3, r8 = (id & 7) * 8;
                    *(u32x4*)(B1 + w * 72 + r8) = *(const u32x4*)(WUT + ((size_t)rd * W + wc0 + w) * 64 + r8); *(u32x4*)(B2 + w * 72 + r8) = *(const u32x4*)(WAT + ((size_t)rd * W + wc0 + w) * 64 + r8); }
            } else {
#pragma unroll
                for (int q = 0; q < 4; ++q) { const int id = tid + NT * q, w = id >> 4, r8 = (id & 15) * 8; *(u32x4*)(B1 + w * 136 + r8) = *(const u32x4*)(WGT + ((size_t)wc0 + w) * 128 + r8); }
            }
            SYNCTHREADS();
            f32x4 a1[8], a2[8];
#pragma unroll
            for (int nt = 0; nt < 8; ++nt) { a1[nt] = (f32x4){0.f, 0.f, 0.f, 0.f}; a2[nt] = (f32x4){0.f, 0.f, 0.f, 0.f}; }
            const long t = t0 + wv * 16 + fr;
            if (rd < 2) {
                wave_mma<2, 8>(a1, F + wv * 16 * 136, 136, B1, 72);
                wave_mma<2, 8>(a2, F + wv * 16 * 136 + 64, 136, B2, 72);
#pragma unroll
                for (int nt = 0; nt < 8; ++nt) { const int ch = wc0 + 16 * nt + 4 * fq; const f32x4 w0v = *(const f32x4*)(w0 + rd * W + ch), a0v = *(const f32x4*)(a0 + rd * W + ch); f32x4 dv, av;
#pragma unroll
                    for (int e = 0; e < 4; ++e) { dv[e] = fexp_(-DECAY_SCALE * sigmoidf_(a1[nt][e] + w0v[e])); av[e] = sigmoidf_(a2[nt][e] + a0v[e]); }
                    *(f32x4*)(DEC + ((size_t)rd * T + t) * W + ch) = dv; *(f32x4*)(AA + ((size_t)rd * T + t) * W + ch) = av; }
            } else {
                wave_mma<4, 8>(a1, F + wv * 16 * 136, 136, B1, 136);
#pragma unroll
                for (int nt = 0; nt < 8; ++nt) *(f32x4*)(GG + (size_t)t * W + wc0 + 16 * nt + 4 * fq) = a1[nt];
            }
            SYNCTHREADS();
        }
    }
}
#ifdef CPU_EMU
__device__ __forceinline__ float red16_(float x) { x += SHFL_XOR(x, 1); x += SHFL_XOR(x, 2); x += SHFL_XOR(x, 4); x += SHFL_XOR(x, 8); return x; }
#define LDS_BARRIER() emu_syncthreads()
#else
__device__ __forceinline__ float red16_(float x) {
    x += __builtin_bit_cast(float, __builtin_amdgcn_update_dpp(0, __builtin_bit_cast(int, x), 0xB1, 0xF, 0xF, true));
    x += __builtin_bit_cast(float, __builtin_amdgcn_update_dpp(0, __builtin_bit_cast(int, x), 0x4E, 0xF, 0xF, true));
    x += __builtin_bit_cast(float, __builtin_amdgcn_update_dpp(0, __builtin_bit_cast(int, x), 0x141, 0xF, 0xF, true));
    x += __builtin_bit_cast(float, __builtin_amdgcn_update_dpp(0, __builtin_bit_cast(int, x), 0x140, 0xF, 0xF, true));
    return x;
}
#define LDS_BARRIER() do { asm volatile("s_waitcnt lgkmcnt(0)" ::: "memory"); __builtin_amdgcn_s_barrier(); asm volatile("" ::: "memory"); } while (0)
#endif
#define RC_M(k) (lm + (k) * 4608)
__device__ __forceinline__ void ph_rw_chunk(const Ctx& c, int l, float* ldsf) {
    const bf16_t* FS = WSH(O_FS); const float* DEC = WSF(O_DEC); const float* AA = WSF(O_AA); float* BON = WSF(O_BON);
    const float* kkw = c.in[25] + (size_t)l * W; const float* kaw = c.in[26] + (size_t)l * W; const float* rk = c.in[27] + (size_t)l * W;
    bf16_t* PST = WSH(O_PST); bf16_t* PYT = WSH(O_PYT); float* SVB = WSF(O_SVB); float* YVB = WSF(O_YVB);
    bf16_t* lm = (bf16_t*)ldsf; float* gam = (float*)RC_M(7); float* segp = (float*)RC_M(13); float* gl = segp + 512;
    const int tid = threadIdx.x, wv = tid >> 6, lane = tid & 63, fr = lane & 15, fq = lane >> 4, rt = wv & 3, hf = wv >> 2;
    const int m0 = 16 * rt + fr;
    float wv8[8], kv8[8], rv8[8], vv8[8], aa8[8];
#define RC_LOAD(uu) do { const int chain_ = (uu) / NRC, ck_ = (uu) % NRC, h_ = chain_ & 15, b_ = (chain_ >> 4) & 1, z_ = chain_ >> 5; \
        const long tb_ = (long)b_ * S + (z_ ? S - 1 - ck_ * RCK : ck_ * RCK); const int dirn_ = z_ ? -1 : 1; \
        const float* decp_ = DEC + ((size_t)z_ * T) * W + h_ * 64; const float* aap_ = AA + ((size_t)z_ * T) * W + h_ * 64; const int ch_ = h_ * 64 + lane; \
        _Pragma("unroll") for (int q = 0; q < 8; ++q) wv8[q] = decp_[(size_t)(tb_ + dirn_ * ((tid >> 6) * 8 + q)) * W + (tid & 63)]; \
        _Pragma("unroll") for (int q = 0; q < 8; ++q) { const long t_ = tb_ + dirn_ * (wv + 8 * q); const bf16_t* f_ = FS + (size_t)t_ * RF; kv8[q] = bf2f(f_[1024 + ch_]); rv8[q] = bf2f(f_[ch_]); vv8[q] = bf2f(f_[2048 + ch_]); aa8[q] = aap_[(size_t)t_ * W + lane]; } } while (0)
    if ((int)blockIdx.x < 64 * NRC) RC_LOAD((int)blockIdx.x);
    for (int u = blockIdx.x; u < 64 * NRC; u += gridDim.x) {
        const int chain = u / NRC, ck = u % NRC, h = chain & 15, b = (chain >> 4) & 1, z = chain >> 5;
        const long tb = (long)b * S + (z ? S - 1 - ck * RCK : ck * RCK); const int dirn = z ? -1 : 1;
        { const int k = tid & 63, sg = tid >> 6; float p = 1.f;
#pragma unroll
          for (int q = 0; q < 8; ++q) { p *= wv8[q]; gam[(sg * 8 + q) * 64 + k] = p; }
          segp[sg * 64 + k] = p; }
        LDS_BARRIER();
        { const int k = tid & 63, sg = tid >> 6; float pre = 1.f;
          for (int q = 0; q < sg; ++q) pre *= segp[q * 64 + k];
#pragma unroll
          for (int q = 0; q < 8; ++q) gam[(sg * 8 + q) * 64 + k] *= pre;
          if (sg == 7) gl[k] = gam[63 * 64 + k]; }
        LDS_BARRIER();
        { const int k = lane, ch = h * 64 + k; const float kkwv = kkw[ch], kav = kaw[ch], rkv = rk[ch];
#pragma unroll
          for (int q = 0; q < 8; ++q) { const int tt = wv + 8 * q; const long t = tb + dirn * tt;
            const float vk = kv8[q] * kkwv; const float kkn = vk * (1.f / sqrtf(wave_sum(vk * vk) + EPS)); const float ktv = kv8[q] * (1.f + (aa8[q] - 1.f) * kav);
            const float bsum = wave_sum(rv8[q] * rkv * ktv); if (lane == 0) BON[((size_t)z * T + t) * 16 + h] = bsum;
            const float g = gam[tt * 64 + k], gp = tt ? gam[(tt - 1) * 64 + k] : 1.f, ig = 1.f / g;
            const bf16_t khv = (bf16_t)f2bf(kkn * gp), bhv = (bf16_t)f2bf(aa8[q] * kkn * ig);
            RC_M(0)[tt * 72 + k] = khv; RC_M(1)[k * 72 + tt] = khv; RC_M(2)[tt * 72 + k] = bhv; RC_M(3)[k * 72 + tt] = bhv;
            RC_M(4)[tt * 72 + k] = (bf16_t)f2bf(ktv * ig); RC_M(5)[tt * 72 + k] = (bf16_t)f2bf(rv8[q] * g); RC_M(6)[k * 72 + tt] = (bf16_t)f2bf(vv8[q]); } }
        if (u + (int)gridDim.x < 64 * NRC) RC_LOAD(u + (int)gridDim.x);
        LDS_BARRIER();
        f32x4 mkr[2], khr[2], rhT[2];
        {
            f32x4 a0[2], a1[2], a2[2], a3[2];
#pragma unroll
            for (int nt = 0; nt < 2; ++nt) { a0[nt] = (f32x4){0.f, 0.f, 0.f, 0.f}; a1[nt] = a0[nt]; a2[nt] = a0[nt]; a3[nt] = a0[nt]; }
            wave_mma<2, 2>(a0, RC_M(2) + rt * 16 * 72, 72, RC_M(0) + hf * 32 * 72, 72);
            wave_mma<2, 2>(a1, RC_M(4) + rt * 16 * 72, 72, RC_M(0) + hf * 32 * 72, 72);
            wave_mma<2, 2>(a2, RC_M(2) + rt * 16 * 72, 72, RC_M(5) + hf * 32 * 72, 72);
            wave_mma<2, 2>(a3, RC_M(4) + rt * 16 * 72, 72, RC_M(5) + hf * 32 * 72, 72);
#pragma unroll
            for (int nt = 0; nt < 2; ++nt) { const int n0 = 32 * hf + 16 * nt + 4 * fq; f32x4 nn, ti, mk;
#pragma unroll
                for (int r = 0; r < 4; ++r) { const int n = n0 + r; const bool lt = m0 < n, le = m0 <= n;
                    nn[r] = lt ? -a0[nt][r] : 0.f; ti[r] = nn[r] + (m0 == n ? 1.f : 0.f); mk[r] = lt ? a1[nt][r] : 0.f; mkr[nt][r] = le ? a3[nt][r] : 0.f;
                    RC_M(12)[n * 72 + m0] = (bf16_t)f2bf(le ? a2[nt][r] : 0.f);
                    RC_M(8)[n * 72 + m0] = (bf16_t)f2bf(nn[r]);
                    khr[nt][r] = bf2f(RC_M(4)[m0 * 72 + n]); rhT[nt][r] = bf2f(RC_M(5)[n * 72 + m0]); }
                st_bf4(RC_M(7) + m0 * 72 + n0, nn); st_bf4(RC_M(9) + m0 * 72 + n0, ti); st_bf4(RC_M(11) + m0 * 72 + n0, mk); }
        }
        LDS_BARRIER();
        f32x4 tiv[2];
#pragma unroll
        for (int nt = 0; nt < 2; ++nt) tiv[nt] = ld_bf4(RC_M(9) + m0 * 72 + 32 * hf + 16 * nt + 4 * fq);
#pragma unroll 1
        for (int it = 0; it < 5; ++it) {
            bf16_t* pw = (it & 1) ? RC_M(0) : RC_M(7); bf16_t* pwT = (it & 1) ? RC_M(2) : RC_M(8); bf16_t* pw2 = (it & 1) ? RC_M(7) : RC_M(0); bf16_t* pw2T = (it & 1) ? RC_M(8) : RC_M(2);
            bf16_t* tcur = (it & 1) ? RC_M(4) : RC_M(9); bf16_t* tnxt = (it & 1) ? RC_M(9) : RC_M(4);
            f32x4 sq[2];
#pragma unroll
            for (int nt = 0; nt < 2; ++nt) sq[nt] = (f32x4){0.f, 0.f, 0.f, 0.f};
            wave_mma<2, 2>(sq, pw + rt * 16 * 72, 72, pwT + hf * 32 * 72, 72);
#pragma unroll
            for (int nt = 0; nt < 2; ++nt) { const int n0 = 32 * hf + 16 * nt + 4 * fq; st_bf4(pw2 + m0 * 72 + n0, sq[nt]);
#pragma unroll
                for (int r = 0; r < 4; ++r) pw2T[(n0 + r) * 72 + m0] = (bf16_t)f2bf(sq[nt][r]); }
            LDS_BARRIER();
            f32x4 up[2];
#pragma unroll
            for (int nt = 0; nt < 2; ++nt) up[nt] = (f32x4){0.f, 0.f, 0.f, 0.f};
            wave_mma<2, 2>(up, tcur + rt * 16 * 72, 72, pw2T + hf * 32 * 72, 72);
#pragma unroll
            for (int nt = 0; nt < 2; ++nt) { const int n0 = 32 * hf + 16 * nt + 4 * fq; tiv[nt] += up[nt]; st_bf4(tnxt + m0 * 72 + n0, tiv[nt]);
                if (it == 4) {
#pragma unroll
                    for (int r = 0; r < 4; ++r) RC_M(10)[(n0 + r) * 72 + m0] = (bf16_t)f2bf(tiv[nt][r]); } }
            LDS_BARRIER();
        }
        {
            f32x4 w1[2], w2[2];
#pragma unroll
            for (int nt = 0; nt < 2; ++nt) { w1[nt] = (f32x4){0.f, 0.f, 0.f, 0.f}; w2[nt] = w1[nt]; }
            wave_mma<2, 2>(w1, RC_M(1) + rt * 16 * 72, 72, RC_M(10) + hf * 32 * 72, 72);
            wave_mma<2, 2>(w2, RC_M(11) + rt * 16 * 72, 72, RC_M(10) + hf * 32 * 72, 72);
#pragma unroll
            for (int nt = 0; nt < 2; ++nt) { const int n0 = 32 * hf + 16 * nt + 4 * fq; st_bf4(RC_M(7) + m0 * 72 + n0, w1[nt]); st_bf4(RC_M(8) + m0 * 72 + n0, w2[nt]); }
        }
        LDS_BARRIER();
        {
            f32x4 py[2], qy[2], ps[2], qs[2];
#pragma unroll
            for (int nt = 0; nt < 2; ++nt) { py[nt] = (f32x4){0.f, 0.f, 0.f, 0.f}; qy[nt] = py[nt]; ps[nt] = py[nt]; qs[nt] = py[nt]; }
            wave_mma<2, 2>(py, RC_M(7) + rt * 16 * 72, 72, RC_M(12) + hf * 32 * 72, 72);
            wave_mma<2, 2>(qy, RC_M(8) + rt * 16 * 72, 72, RC_M(12) + hf * 32 * 72, 72);
            wave_mma<2, 2>(ps, RC_M(7) + rt * 16 * 72, 72, RC_M(3) + hf * 32 * 72, 72);
            wave_mma<2, 2>(qs, RC_M(8) + rt * 16 * 72, 72, RC_M(3) + hf * 32 * 72, 72);
#pragma unroll
            for (int nt = 0; nt < 2; ++nt) { const int n0 = 32 * hf + 16 * nt + 4 * fq;
#pragma unroll
                for (int r = 0; r < 4; ++r) { const int n = n0 + r; const float gln = gl[n];
                    RC_M(0)[n * 72 + m0] = (bf16_t)f2bf(rhT[nt][r] - py[nt][r]); RC_M(2)[n * 72 + m0] = (bf16_t)f2bf(mkr[nt][r] - qy[nt][r]);
                    RC_M(4)[n * 72 + m0] = (bf16_t)f2bf(((m0 == n ? 1.f : 0.f) - ps[nt][r]) * gln); RC_M(5)[n * 72 + m0] = (bf16_t)f2bf((khr[nt][r] - qs[nt][r]) * gln); } }
        }
        LDS_BARRIER();
        {
            f32x4 yv[2], sv[2];
#pragma unroll
            for (int nt = 0; nt < 2; ++nt) { yv[nt] = (f32x4){0.f, 0.f, 0.f, 0.f}; sv[nt] = yv[nt]; }
            wave_mma<2, 2>(yv, RC_M(6) + rt * 16 * 72, 72, RC_M(2) + hf * 32 * 72, 72);
            wave_mma<2, 2>(sv, RC_M(6) + rt * 16 * 72, 72, RC_M(5) + hf * 32 * 72, 72);
#pragma unroll
            for (int nt = 0; nt < 2; ++nt) { const int n0 = 32 * hf + 16 * nt + 4 * fq; *(f32x4*)(YVB + (size_t)u * 4096 + m0 * 64 + n0) = yv[nt]; *(f32x4*)(SVB + (size_t)u * 4096 + m0 * 64 + n0) = sv[nt]; }
            { const int rr = tid >> 3, c8 = (tid & 7) * 8; *(u32x4*)(PYT + (size_t)u * 4096 + rr * 64 + c8) = *(const u32x4*)(RC_M(0) + rr * 72 + c8); *(u32x4*)(PST + (size_t)u * 4096 + rr * 64 + c8) = *(const u32x4*)(RC_M(4) + rr * 72 + c8); }
        }
        LDS_BARRIER();
    }
}
#undef RC_M
#undef RC_LOAD
__device__ __forceinline__ void ph_rw_seq(const Ctx& c, float* ldsf) {
    const bf16_t* PST = WSH(O_PST); const bf16_t* PYT = WSH(O_PYT); const float* SVB = WSF(O_SVB); const float* YVB = WSF(O_YVB); float* YY = WSF(O_YY);
    bf16_t* Sb = (bf16_t*)ldsf;
    bf16_t* Pm = Sb + 2 * 16 * 72;
    const int tid = threadIdx.x, wv = tid >> 6, lane = tid & 63, fr = lane & 15, fq = lane >> 4, isY = wv >> 2, nt0 = wv & 3;
    for (int u = blockIdx.x; u < 256; u += gridDim.x) {
        const int x = u & 7, jq = u >> 3, chain = x * 8 + (jq >> 2), qt = jq & 3, h = chain & 15, b = (chain >> 4) & 1, z = chain >> 5;
        const size_t ub = (size_t)chain * NRC;
        const int rr = tid >> 3, c8 = (tid & 7) * 8;
        constexpr int PD = NRC >= 8 ? 8 : 4;
        for (int i = tid; i < 2 * 16 * 72 / 2; i += NT) ((unsigned*)Sb)[i] = 0u;
        const int row = 16 * qt + fr, n0 = 16 * nt0 + 4 * fq; const float* addp = (isY ? YVB : SVB) + ub * 4096 + row * 64 + n0;
        const bf16_t* psp = PST + ub * 4096 + rr * 64 + c8; const bf16_t* pyp = PYT + ub * 4096 + rr * 64 + c8;
        u32x4 gps[PD], gpy[PD]; f32x4 add[PD];
#pragma unroll
        for (int j = 0; j < PD; ++j) { gps[j] = *(const u32x4*)(psp + (size_t)j * 4096); gpy[j] = *(const u32x4*)(pyp + (size_t)j * 4096); add[j] = *(const f32x4*)(addp + (size_t)j * 4096); }
        *(u32x4*)(Pm + (0 * 2 + 0) * 4608 + rr * 72 + c8) = gps[0]; *(u32x4*)(Pm + (0 * 2 + 1) * 4608 + rr * 72 + c8) = gpy[0];
        if (PD < NRC) { gps[0] = *(const u32x4*)(psp + (size_t)PD * 4096); gpy[0] = *(const u32x4*)(pyp + (size_t)PD * 4096); }
        SYNCTHREADS();
        for (int ck0 = 0; ck0 < NRC; ck0 += PD) {
#pragma unroll
            for (int j = 0; j < PD; ++j) {
                const int ck = ck0 + j, cur = j & 1, nxt = cur ^ 1;
                f32x4 acc[1]; acc[0] = (f32x4){0.f, 0.f, 0.f, 0.f};
                wave_mma<2, 1>(acc, Sb + cur * 16 * 72, 72, Pm + (cur * 2 + isY) * 4608 + nt0 * 16 * 72, 72);
                acc[0] += add[j];
                if (ck + PD < NRC) add[j] = *(const f32x4*)(addp + (size_t)(ck + PD) * 4096);
                if (isY) {
#pragma unroll
                    for (int r = 0; r < 4; ++r) { const int step = ck * RCK + n0 + r, sidx = z ? S - 1 - step : step; YY[((size_t)z * T + (size_t)b * S + sidx) * W + h * 64 + row] = acc[0][r]; }
                } else st_bf4(Sb + nxt * 16 * 72 + fr * 72 + n0, acc[0]);
                const int jn = (j + 1) % PD;
                if (ck + 1 < NRC) { *(u32x4*)(Pm + (nxt * 2 + 0) * 4608 + rr * 72 + c8) = gps[jn]; *(u32x4*)(Pm + (nxt * 2 + 1) * 4608 + rr * 72 + c8) = gpy[jn]; }
                if (ck + 1 + PD < NRC) { gps[jn] = *(const u32x4*)(psp + (size_t)(ck + 1 + PD) * 4096); gpy[jn] = *(const u32x4*)(pyp + (size_t)(ck + 1 + PD) * 4096); }
                LDS_BARRIER();
            }
        }
    }
}
__device__ __forceinline__ void ph_rw_out(const Ctx& c) {
    const bf16_t* FS = WSH(O_FS); const float* YY = WSF(O_YY); const float* BON = WSF(O_BON); const float* GG = WSF(O_GG); bf16_t* Y = WSH(O_YS);
    const int lane = threadIdx.x & 63, gw = blockIdx.x * (NT / 64) + (threadIdx.x >> 6), ngw = gridDim.x * (NT / 64);
    for (int i = gw; i < T * 4; i += ngw) {
        const int h0 = (i & 3) * 4; const long t = i >> 2; float y0[4], y1[4], gv[4], vv[4], bs[4];
#pragma unroll
        for (int q = 0; q < 4; ++q) { const int ch = (h0 + q) * 64 + lane; y0[q] = YY[(size_t)t * W + ch]; y1[q] = YY[((size_t)T + t) * W + ch]; gv[q] = GG[(size_t)t * W + ch]; vv[q] = bf2f(FS[(size_t)t * RF + 2048 + ch]);
            bs[q] = BON[(size_t)t * 16 + h0 + q] + BON[((size_t)T + t) * 16 + h0 + q]; }
#pragma unroll
        for (int q = 0; q < 4; ++q) { const int ch = (h0 + q) * 64 + lane;
            const float m0 = wave_sum(y0[q]) * (1.f / 64.f), m1 = wave_sum(y1[q]) * (1.f / 64.f); const float d0 = y0[q] - m0, d1 = y1[q] - m1;
            const float r0 = 1.f / sqrtf(wave_sum(d0 * d0) * (1.f / 64.f) + EPS), r1 = 1.f / sqrtf(wave_sum(d1 * d1) * (1.f / 64.f) + EPS);
            Y[(size_t)t * 4 * W + 3 * W + ch] = (bf16_t)f2bf((d0 * r0 + d1 * r1 + bs[q] * vv[q]) * gv[q]); }
    }
}
__device__ __forceinline__ void ph_router(const Ctx& c, int l, float* ldsf) {
    const float* H = WSF(O_HF); const bf16_t* WH = WSH(O_WRH); const bf16_t* WL = WSH(O_WRL); const float* bg = c.in[31] + (size_t)l * 4; const float* be = c.in[33] + (size_t)l * 32;
    int* EID = WSI(O_EID); float* EWT = WSF(O_EWT); int* cnt = CTLW(c) + CW_CNT + l * 64;
    const int tid = threadIdx.x, wv = tid >> 6, lane = tid & 63, fr = lane & 15, fq = lane >> 4, rt = wv & 1, kq = wv >> 1;
    float* part = ldsf;
    for (int u = blockIdx.x; u < T / 32; u += gridDim.x) {
        const long t0 = (long)u * 32; f32x4 acc[3];
#pragma unroll
        for (int nt = 0; nt < 3; ++nt) acc[nt] = (f32x4){0.f, 0.f, 0.f, 0.f};
#ifdef CPU_EMU
        for (int nt = 0; nt < 3; ++nt) for (int r = 0; r < 4; ++r) { const int n = 16 * nt + 4 * fq + r; float sacc = 0.f;
            for (int k = kq * 512; k < kq * 512 + 512; ++k) { const float hv = H[(size_t)(t0 + 16 * rt + fr) * D + k]; const float hh = bf2f((bf16_t)f2bf(hv)), hl = bf2f((bf16_t)f2bf(hv - hh));
                const float wh = bf2f(WH[(size_t)n * D + k]), wl = bf2f(WL[(size_t)n * D + k]); sacc += hh * wh + hl * wh + hh * wl; }
            acc[nt][r] = sacc; }
#else
        const float* hp = H + (size_t)(t0 + 16 * rt + fr) * D + kq * 512 + fq * 8;
#pragma unroll 4
        for (int ks = 0; ks < 16; ++ks) {
            const f32x4 h0 = *(const f32x4*)(hp + ks * 32), h1 = *(const f32x4*)(hp + ks * 32 + 4); bf16x8 ah, al;
#pragma unroll
            for (int e = 0; e < 4; ++e) { const unsigned b0 = f2bf(h0[e]), b1 = f2bf(h1[e]); ah[e] = (short)b0; ah[4 + e] = (short)b1; al[e] = (short)f2bf(h0[e] - u2f_(b0 << 16)); al[4 + e] = (short)f2bf(h1[e] - u2f_(b1 << 16)); }
#pragma unroll
            for (int nt = 0; nt < 3; ++nt) { const size_t wo = (size_t)(16 * nt + fr) * D + kq * 512 + ks * 32 + fq * 8; const bf16x8 bh = *(const bf16x8*)(WH + wo), bl = *(const bf16x8*)(WL + wo);
                acc[nt] = __builtin_amdgcn_mfma_f32_16x16x32_bf16(bh, ah, acc[nt], 0, 0, 0); acc[nt] = __builtin_amdgcn_mfma_f32_16x16x32_bf16(bh, al, acc[nt], 0, 0, 0); acc[nt] = __builtin_amdgcn_mfma_f32_16x16x32_bf16(bl, ah, acc[nt], 0, 0, 0); }
        }
#endif
#pragma unroll
        for (int nt = 0; nt < 3; ++nt) *(f32x4*)(part + (kq * 32 + 16 * rt + fr) * 48 + 16 * nt + 4 * fq) = acc[nt];
        SYNCTHREADS();
        if (tid < 32) { const long t = t0 + tid; float lg[36];
#pragma unroll
            for (int q = 0; q < 36; ++q) lg[q] = (part[(0 * 32 + tid) * 48 + q] + part[(1 * 32 + tid) * 48 + q]) + (part[(2 * 32 + tid) * 48 + q] + part[(3 * 32 + tid) * 48 + q]) + (q < 4 ? bg[q < 4 ? q : 0] : be[q >= 4 ? q - 4 : 0]);
            int gi = 0; float m = lg[0];
#pragma unroll
            for (int q = 1; q < 4; ++q) if (lg[q] > m) { m = lg[q]; gi = q; }
            float den = 0.f;
#pragma unroll
            for (int q = 0; q < 4; ++q) den += expf(lg[q] - m);
            const float gp = 1.f / den; float el[8];
#pragma unroll
            for (int q = 0; q < 8; ++q) el[q] = gi == 0 ? lg[4 + q] : gi == 1 ? lg[12 + q] : gi == 2 ? lg[20 + q] : lg[28 + q];
            int i1 = 0; float m1 = el[0];
#pragma unroll
            for (int q = 1; q < 8; ++q) if (el[q] > m1) { m1 = el[q]; i1 = q; }
            int i2 = -1; float m2 = 0.f;
#pragma unroll
            for (int q = 0; q < 8; ++q) if (q != i1 && (i2 < 0 || el[q] > m2)) { m2 = el[q]; i2 = q; }
            const float p2 = expf(m2 - m1);
            EID[t * 2] = gi * 8 + i1; EID[t * 2 + 1] = gi * 8 + i2; EWT[t * 2] = gp / (1.f + p2); EWT[t * 2 + 1] = gp * p2 / (1.f + p2);
            atomic_add_i(cnt + gi * 8 + i1, 1); atomic_add_i(cnt + gi * 8 + i2, 1);
        }
        SYNCTHREADS();
    }
}
__device__ __forceinline__ void ph_moe_plan(const Ctx& c, int l) {
    int* cnt = CTLW(c) + CW_CNT + l * 64; int* plan = CTLW(c) + CW_PLAN + l * 256;
    if (GT_ == 0) {
        int ps = 0, nb = 0;
        for (int e = 0; e < NE; ++e) { plan[e] = ps; const int nblk = (cnt[e] + 255) / 256; for (int q = 0; q < nblk; ++q) plan[64 + nb++] = e; ps += nblk * 256; }
        plan[32] = ps; plan[40] = nb;
    }
}
__device__ __forceinline__ void ph_moe_assign(const Ctx& c, int l) {
    const int* EID = WSI(O_EID); int* fill = CTLW(c) + CW_FILL + l * 64; const int* plan = CTLW(c) + CW_PLAN + l * 256; int* DEST = WSI(O_DEST);
    for (long i = GT_; i < (long)T * 2; i += GS_) { const int e = EID[i]; const int pos = atomic_add_i(fill + e, 1); DEST[i] = plan[e] + pos; }
}
__device__ __forceinline__ void ph_moe_gather(const Ctx& c) {
    const int* DEST = WSI(O_DEST); const u32x4* H = (const u32x4*)WSH(O_H); u32x4* XS = (u32x4*)WSH(O_XS);
    for (long i = GT_; i < (long)T * 2 * (D / 8); i += GS_) { const int q = (int)(i % (D / 8)); const long a = i / (D / 8); XS[(size_t)DEST[a] * (D / 8) + q] = H[(size_t)(a >> 1) * (D / 8) + q]; }
}
#ifndef CPU_EMU
#define XB_TMO      128
#define XB_XCNT(j)  (256  + 64 * (j))
#define XB_XSUB(j)  (1280 + 64 * (j))
#define XB_XGEN(j)  (2304 + 64 * (j))
#define XB_TOP      3328
#define XB_TOPGEN   3392
#define XCD_BAR_WORDS 3456
#define XB_SPIN_CAP (1u << 26)
#define LAS __attribute__((address_space(3)))
__device__ __forceinline__ unsigned xb_ld(unsigned* p)              { return __hip_atomic_load(p, __ATOMIC_RELAXED, __HIP_MEMORY_SCOPE_AGENT); }
__device__ __forceinline__ unsigned xb_add(unsigned* p, unsigned v) { return __hip_atomic_fetch_add(p, v, __ATOMIC_RELAXED, __HIP_MEMORY_SCOPE_AGENT); }
__device__ __forceinline__ unsigned xb_xcc_id() { return (unsigned)__builtin_amdgcn_s_getreg((3 << 11) | 20) & 0xFu; }
#define XB_SPIN(cond, bar) do { unsigned _sp = 0; while (cond) { __builtin_amdgcn_s_sleep(1); \
    if ((++_sp & 255u) == 0u) { if (xb_ld(&(bar)[XB_TMO])) break; if (_sp > XB_SPIN_CAP) { atomicAdd(&(bar)[XB_TMO], 1u); break; } } } } while (0)
struct XcdBarrier { unsigned* bar; unsigned x; volatile LAS unsigned* st; };
__device__ __forceinline__ XcdBarrier xcd_barrier_post(unsigned* bar, volatile LAS unsigned* st) {
    XcdBarrier b; b.bar = bar; b.x = xb_xcc_id(); b.st = st;
    if (threadIdx.x == 0) (void)xb_add(&bar[XB_XCNT(b.x)], 1u);
    return b;
}
__device__ __forceinline__ void xcd_barrier_complete(unsigned* bar, unsigned x, unsigned& nloc, unsigned& nx) {
    const unsigned G = gridDim.x * gridDim.y * gridDim.z;
    unsigned sum, cnt, mine, sp = 0u;
    for (;;) {
        sum = 0u; cnt = 0u; mine = 0u;
#pragma unroll
        for (unsigned j = 0; j < 16; ++j) { const unsigned cc = xb_ld(&bar[XB_XCNT(j)]); sum += cc; cnt += (cc > 0u) ? 1u : 0u; mine = (j == x) ? cc : mine; }
        if (sum == G) break;
        __builtin_amdgcn_s_sleep(1);
        if ((++sp & 255u) == 0u) { if (xb_ld(&bar[XB_TMO])) break; if (sp > XB_SPIN_CAP) { atomicAdd(&bar[XB_TMO], 1u); break; } }
    }
    nloc = mine > 0u ? mine : 1u; nx = cnt > 0u ? cnt : 1u;
}
__device__ __forceinline__ void xcd_barrier(const XcdBarrier& b) {
    asm volatile("s_waitcnt vmcnt(0)" ::: "memory");
    __syncthreads();
    if (threadIdx.x == 0) {
        unsigned* bar = b.bar;
        __builtin_amdgcn_s_waitcnt(0);
        unsigned nloc = b.st[0], nx = b.st[1];
        if (nloc == 0u) { xcd_barrier_complete(bar, b.x, nloc, nx); b.st[0] = nloc; b.st[1] = nx; }
        const unsigned old = xb_add(&bar[XB_XSUB(b.x)], 1u);
        const unsigned gen = old / nloc;
        if (old + 1u == (gen + 1u) * nloc) {
            __builtin_amdgcn_fence(__ATOMIC_RELEASE, "agent");
            asm volatile("s_waitcnt vmcnt(0)" ::: "memory");
            const unsigned og = xb_add(&bar[XB_TOP], 1u);
            const unsigned tg = og / nx;
            if (og + 1u == (tg + 1u) * nx) xb_add(&bar[XB_TOPGEN], 1u);
            else XB_SPIN(xb_ld(&bar[XB_TOPGEN]) == tg, bar);
            __builtin_amdgcn_fence(__ATOMIC_ACQUIRE, "agent");
            xb_add(&bar[XB_XGEN(b.x)], 1u);
            asm volatile("s_waitcnt vmcnt(0)" ::: "memory");
        } else {
            XB_SPIN(xb_ld(&bar[XB_XGEN(b.x)]) == gen, bar);
            __builtin_amdgcn_fence(__ATOMIC_ACQUIRE, "agent");
            asm volatile("s_waitcnt vmcnt(0)" ::: "memory");
        }
    }
    __syncthreads();
}
#endif

constexpr int LDS_BYTES = 147456;

__global__ void __launch_bounds__(NT, 2) fwd(Params p) {
#ifdef CPU_EMU
    unsigned char* lds = g_lds; float* ldsf = (float*)g_lds;
#else
    extern __shared__ __attribute__((aligned(16))) unsigned char lds[];
    float* ldsf = (float*)lds;
    volatile LAS unsigned* misc = (volatile LAS unsigned*)((LAS unsigned char*)lds + LDS_BYTES - 64);
    if (threadIdx.x == 0) { misc[0] = 0u; misc[1] = 0u; }
    __syncthreads();
    XcdBarrier bar = xcd_barrier_post((unsigned*)(p.ws + O_CTL) + CW_BAR, misc);
#endif
    Ctx c; c.in = p.in; c.out = p.out; c.ws = p.ws;
    const int lo = p.ph_lo, hi = p.ph_hi; int ph = 0;
    const int G = (int)gridDim.x, cwg = (int)blockIdx.x;
#ifdef CPU_EMU
#define GRID_BAR()
#else
#define GRID_BAR() xcd_barrier(bar)
#endif
#ifndef REPEAT_MASK
#define REPEAT_MASK 0
#endif
#ifndef TIME_PHASE
#define TIME_PHASE -1
#endif
#if TIME_PHASE >= 0 && !defined(CPU_EMU)
    unsigned long long tp0 = 0, tp1 = 0;
#define TP_BEGIN() do { if (ph == TIME_PHASE) tp0 = __builtin_amdgcn_s_memrealtime(); } while (0)
#define TP_END() do { if (ph == TIME_PHASE) tp1 = __builtin_amdgcn_s_memrealtime(); } while (0)
#else
#define TP_BEGIN()
#define TP_END()
#endif
#define PHASE(...) do { if (lo <= ph && ph < hi) { TP_BEGIN(); __VA_ARGS__; if (ph + 1 < hi) { GRID_BAR(); } TP_END(); } ++ph; } while (0)
#define PHASEG(grp, ...) do { if (lo <= ph && ph < hi) { TP_BEGIN(); if ((REPEAT_MASK >> (grp)) & 1) { __VA_ARGS__; GRID_BAR(); } __VA_ARGS__; if (ph + 1 < hi) { GRID_BAR(); } TP_END(); } ++ph; } while (0)
    PHASE(ph_mod(c, ldsf));
#define LAYER_BODY(l) do { const float* mod = WSF(O_MOD); \
        const float* xin = l == 0 ? c.in[0] : WSF(O_X1); float* xmid = WSF(O_X0); float* xout = WSF(O_X1); \
        const float* ml = mod + (size_t)l * NB * D6; \
        PHASEG(3, ph_convert(c, l, ldsf)); \
        PHASEG(0, { pg8::Gemm g{D, D, D}; pg8::StaticOrder so; so.init(T, PW, G, cwg, WSH(O_H), WSH(O_WIN), D, D); pg8::EpiBf16 E{WSH(O_P), PW}; pg8::gemm_phase(lds, g, so, E); }); \
        PHASE(ph_lru<1>(c, l, ldsf); ph_ret_kv(c, ldsf); ph_sgu_norm(c, l); ph_rw_shift(c, l)); \
        PHASE(ph_lru_scan2(c); ph_ret_state(c); ph_sgu_mix(c, l, ldsf); ph_rw_lora(c, l, ldsf)); \
        PHASE(ph_lru<2>(c, l, ldsf); ph_ret_out(c, ldsf); ph_rw_chunk(c, l, ldsf)); \
        PHASE(ph_rw_seq(c, ldsf)); \
        PHASE(ph_rw_out(c)); \
        PHASEG(1, { pg8::Gemm g{W, 4 * W, 4 * W}; pg8::MergeOrder mo; mo.so.init(T, D, G, cwg, WSH(O_YS), WSH(O_WBR), 4 * W, 4 * W); mo.kseg_bytes = W * 2; pg8::EpiMerge E{WSH(O_P), WSH(O_MRG)}; pg8::gemm_phase(lds, g, mo, E); }); \
        PHASEG(1, { pg8::Gemm g{D, D, D}; pg8::StaticOrder so; so.init(T, D, G, cwg, WSH(O_MRG), WSH(O_WOUT), D, D); pg8::EpiResid E{xin, ml + 2 * D, xmid}; pg8::gemm_phase(lds, g, so, E); }); \
        PHASEG(6, ph_norm(c, xmid, c.in[4] + (size_t)l * D, ml + 3 * D, ml + 4 * D, WSH(O_H), WSF(O_HF))); \
        PHASE(ph_router(c, l, ldsf)); \
        PHASE(ph_moe_plan(c, l)); \
        PHASE(ph_moe_assign(c, l)); \
        PHASEG(6, ph_moe_gather(c)); \
        const int* plan = CTLW(c) + CW_PLAN + l * 256; \
        PHASEG(2, { pg8::Gemm g{D, D, D}; pg8::MoeOrder mo{G, cwg, 4, plan, (const char*)WSH(O_XS), (const char*)WSH(O_WGU), (size_t)256 * D * 2, (size_t)256 * D * 2, (size_t)1024 * D * 2}; pg8::EpiGU E{WSH(O_ACT)}; pg8::gemm_phase(lds, g, mo, E); }); \
        PHASEG(2, { pg8::Gemm g{512, 512, 512}; pg8::MoeOrder mo{G, cwg, 8, plan, (const char*)WSH(O_ACT), (const char*)WSH(O_WDN), (size_t)256 * 512 * 2, (size_t)256 * 512 * 2, (size_t)D * 512 * 2}; pg8::EpiBf16 E{WSH(O_YE), D}; pg8::gemm_phase(lds, g, mo, E); }); \
        if (l == 0) PHASE(ph_comb_norm<0>(c, xmid, ml + 5 * D, xout, c.in[3] + (size_t)1 * D, mod + (size_t)1 * NB * D6 + 0 * D, mod + (size_t)1 * NB * D6 + 1 * D, WSH(O_H), nullptr)); \
        else PHASE(ph_comb_norm<1>(c, xmid, ml + 5 * D, xout, c.in[36], nullptr, nullptr, nullptr, c.out)); \
    } while (0)
    PHASE(ph_norm(c, c.in[0], c.in[3], WSF(O_MOD) + 0 * D, WSF(O_MOD) + 1 * D, WSH(O_H), nullptr));
    LAYER_BODY(0);
    LAYER_BODY(1);
#undef LAYER_BODY
#if TIME_PHASE >= 0 && !defined(CPU_EMU)
    if (blockIdx.x == 0) { const unsigned long long te = __builtin_amdgcn_s_memrealtime(), dl = 8ull * (tp1 - tp0); while (__builtin_amdgcn_s_memrealtime() - te < dl) __builtin_amdgcn_s_sleep(8); }
#endif
#undef PHASE
}
}

#ifndef CPU_EMU
extern "C" void kernel_launch(void* const* d_in, const int* in_sizes, int n_in, void* d_out, int out_size, void* d_ws, size_t ws_size, hipStream_t stream) {
    static int grid = 0;
    if (grid == 0) {
        if (n_in != 37 || out_size != T * D || ws_size < WS_END) { fprintf(stderr, "kernel_launch: unexpected shapes (n_in %d out %d ws %zu need %zu)\n", n_in, out_size, ws_size, (size_t)WS_END); grid = -1; return; }
        int dev = 0, cus = 0, per_cu = 0;
        if (hipGetDevice(&dev) != hipSuccess || hipDeviceGetAttribute(&cus, hipDeviceAttributeMultiprocessorCount, dev) != hipSuccess) { grid = -1; return; }
        if (hipFuncSetAttribute((const void*)fwd, hipFuncAttributeMaxDynamicSharedMemorySize, LDS_BYTES) != hipSuccess) { fprintf(stderr, "kernel_launch: hipFuncSetAttribute failed\n"); grid = -1; return; }
        if (hipOccupancyMaxActiveBlocksPerMultiprocessor(&per_cu, (const void*)fwd, NT, LDS_BYTES) != hipSuccess || per_cu < 1) fprintf(stderr, "kernel_launch: occupancy query says %d\n", per_cu);
        (void)hipGetLastError();
        grid = cus;
    }
    if (grid < 0) return;
    (void)in_sizes;
    (void)hipMemsetAsync((char*)d_ws + O_CTL, 0, CTL_BYTES, stream);
    Params p{};
    for (int i = 0; i < 37; ++i) p.in[i] = (const float*)d_in[i];
    p.out = (float*)d_out; p.ws = (unsigned char*)d_ws;
#if ONE_LAUNCH
    p.ph_lo = 0; p.ph_hi = NPH;
    hipLaunchKernelGGL(fwd, dim3(grid), dim3(NT), LDS_BYTES, stream, p);
#else
    for (int k = 0; k < NPH; ++k) { p.ph_lo = k; p.ph_hi = k + 1; hipLaunchKernelGGL(fwd, dim3(grid), dim3(NT), LDS_BYTES, stream, p); }
#endif
}
#endif
```

```cpp
#ifndef CPU_EMU
#include <hip/hip_runtime.h>
#endif
#include <cstdio>
#include <cstdint>
#include <cmath>
#include <cstring>

#ifndef SEQ
#define SEQ 4096
#endif
#ifndef ONE_LAUNCH
#define ONE_LAUNCH 1
#endif

namespace {
constexpr int D = 2048, NB = 2, S = SEQ, T = NB * S, NL = 2, W = 1024;
constexpr int INW = 18816, RF = 3456, D6 = 6 * D;
constexpr int C_LX = 0, C_LG = 1024, C_RQ = 2048, C_RK = 2560, C_RV = 3072, C_RG = 4096, C_SU = 5120, C_SV = 6144, C_RW = 7168;
constexpr int PW = 18944, C_MLP = 10752;
constexpr int NCH = S / 128;
constexpr int NLC = S / 64;
constexpr int NE = 32, CAP = (T * 2 / 256 + NE) * 256, MAXBLK = CAP / 256;
constexpr float EPS = 1e-6f;
constexpr float DECAY_SCALE = 0.60653065971263342f;
constexpr int NT = 512;
constexpr int NPH_LAYER = 17, NPH = 2 + NL * NPH_LAYER;
typedef unsigned short bf16_t;
#ifdef CPU_EMU
typedef float f32x4 __attribute__((vector_size(16)));
typedef unsigned u32x4 __attribute__((vector_size(16)));
#else
typedef float f32x4 __attribute__((ext_vector_type(4)));
typedef unsigned u32x4 __attribute__((ext_vector_type(4)));
typedef short bf16x8 __attribute__((ext_vector_type(8)));
#endif

constexpr size_t al256(size_t x) { return (x + 255) & ~(size_t)255; }
constexpr size_t SZ_X = (size_t)T * D * 4, SZ_W = (size_t)T * W * 4;
constexpr size_t O_CTL = 0, CTL_BYTES = 1u << 20;
constexpr size_t O_MOD = CTL_BYTES;
constexpr size_t O_X0 = O_MOD + al256((size_t)NL * NB * D6 * 4);
constexpr size_t O_X1 = O_X0 + SZ_X;
constexpr size_t O_H = O_X1 + SZ_X;
constexpr size_t O_HF = O_H + SZ_X / 2;
constexpr size_t O_P = O_HF + SZ_X;
constexpr size_t SZ_P = (size_t)T * PW * 2;
constexpr size_t O_XC = O_P + SZ_P;
constexpr size_t O_LA = O_XC + SZ_W, O_LU = O_LA + 2 * SZ_W;
constexpr size_t SZ_LC = (size_t)2 * NB * NLC * W * 4;
constexpr size_t O_LCA = O_LU + 2 * SZ_W, O_LCH = O_LCA + SZ_LC, O_LCI = O_LCH + SZ_LC;
constexpr size_t O_YS = O_LCI + SZ_LC;
constexpr size_t O_SC = O_YS + (size_t)T * 4 * W * 2;
constexpr size_t SZ_KV = (size_t)NB * NCH * 8 * 64 * 128 * 4;
constexpr size_t O_KVF = O_SC, O_KVB = O_KVF + SZ_KV, O_STF = O_KVB + SZ_KV, O_STB = O_STF + SZ_KV;
constexpr size_t O_VN = O_STB + SZ_KV;
constexpr size_t O_FS = O_VN + SZ_W;
constexpr size_t O_DEC = O_FS + al256((size_t)T * RF * 4), O_AA = O_DEC + 2 * SZ_W, O_AKK = O_AA + 2 * SZ_W;
constexpr size_t O_GG = O_AKK, O_YY = O_GG + SZ_W;
constexpr int RCK = 64, NRC = S / RCK;
constexpr size_t O_BON = O_YY + 2 * SZ_W;
constexpr size_t O_PART = O_BON + al256((size_t)2 * T * 16 * 4);
constexpr size_t O_MRG = O_PART + SZ_X;
constexpr size_t O_LOG = O_MRG + SZ_X / 2;
constexpr size_t O_EID = O_LOG + al256((size_t)T * 40 * 4), O_EWT = O_EID + al256((size_t)T * 2 * 4), O_DEST = O_EWT + al256((size_t)T * 2 * 4);
constexpr size_t O_SLOT = O_DEST + al256((size_t)T * 2 * 4);
constexpr size_t O_PST = O_SLOT + al256((size_t)CAP * 4), O_PYT = O_PST + (size_t)64 * NRC * 4096 * 2, O_SVB = O_PYT + (size_t)64 * NRC * 4096 * 2, O_YVB = O_SVB + (size_t)64 * NRC * 4096 * 4;
constexpr size_t O_WIN = O_YVB + (size_t)64 * NRC * 4096 * 4;
constexpr size_t O_WBR = O_WIN + (size_t)PW * D * 2;
constexpr size_t O_WOUT = O_WBR + (size_t)D * 4 * W * 2;
constexpr size_t O_WGU = O_WOUT + (size_t)D * D * 2;
constexpr size_t O_WDN = O_WGU + (size_t)NE * 1024 * D * 2;
constexpr size_t O_WLR = O_WDN + (size_t)NE * D * 512 * 2;
constexpr size_t O_WUT = O_WLR + (size_t)32 * 128 * 128 * 2;
constexpr size_t O_WAT = O_WUT + (size_t)2 * W * 64 * 2;
constexpr size_t O_WGT = O_WAT + (size_t)2 * W * 64 * 2;
constexpr size_t O_WRH = O_WGT + (size_t)W * 128 * 2;
constexpr size_t O_WRL = O_WRH + (size_t)48 * D * 2;
constexpr size_t WS_END0 = O_WRL + (size_t)48 * D * 2;
constexpr size_t SZ_MOE = (size_t)CAP * (D + 512 + D) * 2;
constexpr bool MOE_OVERLAY = SZ_MOE <= SZ_P;
constexpr size_t O_XS = MOE_OVERLAY ? O_P : WS_END0;
constexpr size_t O_ACT = O_XS + (size_t)CAP * D * 2;
constexpr size_t O_YE = O_ACT + (size_t)CAP * 512 * 2;
constexpr size_t WS_END = MOE_OVERLAY ? WS_END0 : WS_END0 + SZ_MOE;
static_assert(SEQ != 4096 || WS_END <= (size_t)2040 * 1024 * 1024, "workspace budget: d_ws is 4 x the largest input = 2048 MiB");
constexpr int CW_BAR = 4096;
constexpr int CW_CNT = 32768;
constexpr int CW_FILL = CW_CNT + NL * 64;
constexpr int CW_PLAN = CW_FILL + NL * 64;
static_assert(MAXBLK <= 160, "plan words");

struct Params { const float* in[37]; float* out; unsigned char* ws; int ph_lo, ph_hi; };

struct Ctx { const float* const* in; float* out; unsigned char* ws; };
#define GT_ ((long)blockIdx.x * NT + threadIdx.x)
#define GS_ ((long)gridDim.x * NT)
#define WSF(off) ((float*)(c.ws + (off)))
#define WSI(off) ((int*)(c.ws + (off)))
#define WSH(off) ((bf16_t*)(c.ws + (off)))
#define CTLW(c) ((int*)((c).ws + O_CTL))

#ifdef CPU_EMU
__device__ __forceinline__ float fexp_(float x) { return expf(x); }
__device__ __forceinline__ float frcp_(float x) { return 1.f / x; }
__device__ __forceinline__ float frsq_(float x) { return 1.f / sqrtf(x); }
#else
__device__ __forceinline__ float fexp_(float x) { return __builtin_amdgcn_exp2f(x * 1.4426950408889634f); }
__device__ __forceinline__ float frcp_(float x) { return __builtin_amdgcn_rcpf(x); }
__device__ __forceinline__ float frsq_(float x) { return __builtin_amdgcn_rsqf(x); }
#endif
__device__ __forceinline__ float sigmoidf_(float x) { return frcp_(1.f + fexp_(-x)); }
__device__ __forceinline__ float siluf_(float x) { return x * frcp_(1.f + fexp_(-x)); }
__device__ __forceinline__ float tanhf_(float x) { return 1.f - 2.f * frcp_(1.f + fexp_(2.f * x)); }
__device__ __forceinline__ float geluf_(float x) { return 0.5f * x * (1.f + tanhf_(0.7978845608028654f * (x + 0.044715f * x * x * x))); }
__device__ __forceinline__ float softplusf_(float x) { return x > 0.f ? x + log1pf(expf(-x)) : log1pf(expf(x)); }
__device__ __forceinline__ float loggamma_(int h) { return log1pf(-exp2f(-5.f - (float)h)); }
__device__ __forceinline__ unsigned f2u_(float f) { unsigned u; memcpy(&u, &f, 4); return u; }
__device__ __forceinline__ float u2f_(unsigned u) { float f; memcpy(&f, &u, 4); return f; }
__device__ __forceinline__ float bf2f(bf16_t v) { return u2f_((unsigned)v << 16); }
__device__ __forceinline__ unsigned f2bf(float f) { const unsigned u = f2u_(f); return (u + 0x7fffu + ((u >> 16) & 1u)) >> 16; }
__device__ __forceinline__ unsigned pk2(float lo, float hi) { return f2bf(lo) | (f2bf(hi) << 16); }
__device__ __forceinline__ float bflo(unsigned w) { return u2f_(w << 16); }
__device__ __forceinline__ float bfhi(unsigned w) { return u2f_(w & 0xffff0000u); }
__device__ __forceinline__ int atomic_add_i(int* p, int v) {
#ifdef CPU_EMU
    return __atomic_fetch_add(p, v, __ATOMIC_RELAXED);
#else
    return atomicAdd(p, v);
#endif
}
#define PF(P, r, col) bf2f((P)[(size_t)(r) * PW + (col)])
#ifdef CPU_EMU
#define SYNCTHREADS() emu_syncthreads()
#define SHFL_XOR(v, m) emu_shfl_xor(v, m)
#else
#define SYNCTHREADS() __syncthreads()
#define SHFL_XOR(v, m) __shfl_xor(v, m)
#endif
#ifdef CPU_EMU
__device__ __forceinline__ float wave_sum(float v) {
    for (int o = 1; o < 64; o <<= 1) v += SHFL_XOR(v, o);
    return v;
}
#else
__device__ __forceinline__ float wave_sum(float x) {
    x += __builtin_bit_cast(float, __builtin_amdgcn_update_dpp(0, __builtin_bit_cast(int, x), 0xB1, 0xF, 0xF, true));
    x += __builtin_bit_cast(float, __builtin_amdgcn_update_dpp(0, __builtin_bit_cast(int, x), 0x4E, 0xF, 0xF, true));
    x += __builtin_bit_cast(float, __builtin_amdgcn_update_dpp(0, __builtin_bit_cast(int, x), 0x141, 0xF, 0xF, true));
    x += __builtin_bit_cast(float, __builtin_amdgcn_update_dpp(0, __builtin_bit_cast(int, x), 0x140, 0xF, 0xF, true));
    const int xi = __builtin_bit_cast(int, x);
    return (__builtin_bit_cast(float, __builtin_amdgcn_readlane(xi, 0)) + __builtin_bit_cast(float, __builtin_amdgcn_readlane(xi, 16))) + (__builtin_bit_cast(float, __builtin_amdgcn_readlane(xi, 32)) + __builtin_bit_cast(float, __builtin_amdgcn_readlane(xi, 48)));
}
#endif
__device__ __forceinline__ f32x4 ld_bf4(const bf16_t* p) { const unsigned long long q = *(const unsigned long long*)p; const unsigned lo = (unsigned)q, hi = (unsigned)(q >> 32); return (f32x4){bflo(lo), bfhi(lo), bflo(hi), bfhi(hi)}; }
__device__ __forceinline__ void st_bf4(bf16_t* p, const f32x4 v) { *(unsigned long long*)p = (unsigned long long)pk2(v[0], v[1]) | ((unsigned long long)pk2(v[2], v[3]) << 32); }

template <int KT, int NTL>
__device__ __forceinline__ void wave_mma(f32x4 (&acc)[NTL], const bf16_t* A, int lda, const bf16_t* Bt, int ldb) {
    const int lane = threadIdx.x & 63, fr = lane & 15, fq = lane >> 4;
#ifdef CPU_EMU
    for (int nt = 0; nt < NTL; ++nt) for (int r = 0; r < 4; ++r) { float sacc = 0.f; const bf16_t* a = A + fr * lda; const bf16_t* b = Bt + (16 * nt + 4 * fq + r) * ldb;
        for (int k = 0; k < 32 * KT; ++k) sacc += bf2f(a[k]) * bf2f(b[k]);
        acc[nt][r] += sacc; }
#else
#pragma unroll
    for (int kt = 0; kt < KT; ++kt) {
        const bf16x8 af = *(const bf16x8*)(A + fr * lda + kt * 32 + fq * 8);
#pragma unroll
        for (int nt = 0; nt < NTL; ++nt) { const bf16x8 bfr = *(const bf16x8*)(Bt + (16 * nt + fr) * ldb + kt * 32 + fq * 8);
            acc[nt] = __builtin_amdgcn_mfma_f32_16x16x32_bf16(bfr, af, acc[nt], 0, 0, 0); }
    }
#endif
}
__device__ __forceinline__ void ph_mod(const Ctx& c, float* ldsf) {
    const float* cc = c.in[1]; const float* aw = c.in[5]; const float* ab = c.in[6]; float* mod = WSF(O_MOD);
    float* scs = ldsf; float* part = ldsf + NB * D; const int tid = threadIdx.x, c4 = (tid & 31) * 4, kq = tid >> 5;
    for (int i = tid; i < NB * D; i += NT) scs[i] = siluf_(cc[i]);
    SYNCTHREADS();
    for (int u = blockIdx.x; u < NL * (D6 / 128); u += gridDim.x) {
        const int l = u / (D6 / 128), j0 = (u % (D6 / 128)) * 128;
        const float* w = aw + (size_t)l * D * D6 + j0 + c4; f32x4 a0 = (f32x4){0.f, 0.f, 0.f, 0.f}, a1 = a0;
#pragma unroll 8
        for (int k = kq * 128; k < kq * 128 + 128; ++k) { const f32x4 wv = *(const f32x4*)(w + (size_t)k * D6); a0 += wv * scs[k]; a1 += wv * scs[D + k]; }
        *(f32x4*)(part + (kq * 2 + 0) * 128 + c4) = a0; *(f32x4*)(part + (kq * 2 + 1) * 128 + c4) = a1;
        SYNCTHREADS();
        if (tid < 256) { const int b = tid >> 7, col = tid & 127; float sacc = 0.f;
#pragma unroll
            for (int q = 0; q < 16; ++q) sacc += part[(q * 2 + b) * 128 + col];
            mod[((size_t)l * NB + b) * D6 + j0 + col] = sacc + ab[l * D6 + j0 + col]; }
        SYNCTHREADS();
    }
}
__device__ __forceinline__ void ph_norm(const Ctx& c, const float* x, const float* g, const float* sh, const float* sc, bf16_t* hb, float* hf) {
    const int lane = threadIdx.x & 63, gw = blockIdx.x * (NT / 64) + (threadIdx.x >> 6), ngw = gridDim.x * (NT / 64);
    for (int t0 = gw * 2; t0 < T; t0 += ngw * 2) {
        f32x4 v[2][8]; float ss[2] = {0.f, 0.f};
#pragma unroll
        for (int r = 0; r < 2; ++r)
#pragma unroll
            for (int j = 0; j < 8; ++j) v[r][j] = *(const f32x4*)(x + (size_t)(t0 + r) * D + (j * 64 + lane) * 4);
#pragma unroll
        for (int r = 0; r < 2; ++r) {
#pragma unroll
            for (int j = 0; j < 8; ++j) ss[r] += (v[r][j][0] * v[r][j][0] + v[r][j][1] * v[r][j][1]) + (v[r][j][2] * v[r][j][2] + v[r][j][3] * v[r][j][3]);
            const int t = t0 + r, b = t / S; const float rs = 1.f / sqrtf(wave_sum(ss[r]) * (1.f / D) + EPS);
#pragma unroll
            for (int j = 0; j < 8; ++j) { const int col = (j * 64 + lane) * 4;
                const f32x4 o = v[r][j] * rs * *(const f32x4*)(g + col) * (*(const f32x4*)(sc + b * D6 + col) + 1.f) + *(const f32x4*)(sh + b * D6 + col);
                st_bf4(hb + (size_t)t * D + col, o); if (hf) *(f32x4*)(hf + (size_t)t * D + col) = o; }
        }
    }
}
template <int MODE>
__device__ __forceinline__ void ph_comb_norm(const Ctx& c, const float* xmid, const float* g2, float* xout, const float* g, const float* sh, const float* sc, bf16_t* hb, float* outp) {
    const bf16_t* YE = WSH(O_YE); const float* EWT = WSF(O_EWT); const int* DEST = WSI(O_DEST);
    const int lane = threadIdx.x & 63, gw = blockIdx.x * (NT / 64) + (threadIdx.x >> 6), ngw = gridDim.x * (NT / 64);
    for (int t = gw; t < T; t += ngw) {
        const int b = t / S; const float w0 = EWT[t * 2], w1 = EWT[t * 2 + 1]; const bf16_t* y0 = YE + (size_t)DEST[t * 2] * D; const bf16_t* y1 = YE + (size_t)DEST[t * 2 + 1] * D;
        f32x4 v[8]; float ss = 0.f;
#pragma unroll
        for (int j = 0; j < 8; ++j) { const int col = (j * 64 + lane) * 4;
            v[j] = *(const f32x4*)(xmid + (size_t)t * D + col) + *(const f32x4*)(g2 + b * D6 + col) * (ld_bf4(y0 + col) * w0 + ld_bf4(y1 + col) * w1);
            if (MODE == 0) *(f32x4*)(xout + (size_t)t * D + col) = v[j];
            ss += (v[j][0] * v[j][0] + v[j][1] * v[j][1]) + (v[j][2] * v[j][2] + v[j][3] * v[j][3]); }
        const float rs = 1.f / sqrtf(wave_sum(ss) * (1.f / D) + EPS);
#pragma unroll
        for (int j = 0; j < 8; ++j) { const int col = (j * 64 + lane) * 4;
            if (MODE == 0) st_bf4(hb + (size_t)t * D + col, v[j] * rs * *(const f32x4*)(g + col) * (*(const f32x4*)(sc + b * D6 + col) + 1.f) + *(const f32x4*)(sh + b * D6 + col));
            else *(f32x4*)(outp + (size_t)t * D + col) = v[j] * rs * *(const f32x4*)(g + col); }
    }
}

struct CvtItem { const float* Wp; int ldw; bf16_t* WT; int ldt; int drow, k0, n0; };
constexpr int I_IN = 32 * (INW / 32), I_BR = 4 * 16 * 64, I_OUT = 32 * 64, I_GU = NE * 32 * 32, I_DN = NE * 8 * 64, I_LR = 32 * 8, I_WU = 2 * 32, I_WG = 64, I_BIG = I_IN + I_BR + I_OUT + I_GU + I_DN, I_ALL = I_BIG + I_LR + 2 * I_WU + I_WG;
__device__ __forceinline__ CvtItem cvt_decode(const Ctx& c, int l, int it) {
    CvtItem r;
    if (it < I_IN) { const int kb = it / (INW / 32), nb = it % (INW / 32); r.n0 = nb * 32; r.k0 = kb * 64; r.Wp = c.in[7] + (size_t)l * D * INW; r.ldw = INW; r.WT = WSH(O_WIN); r.ldt = D; r.drow = r.n0 < 10624 ? r.n0 : r.n0 + 128; return r; }
    it -= I_IN;
    if (it < I_BR) { const int sgm = it / 1024, q = it % 1024, kb = q / 64, nb = q % 64; r.n0 = nb * 32; r.k0 = kb * 64; r.Wp = c.in[28] + ((size_t)l * 4 + sgm) * W * D; r.ldw = D; r.WT = WSH(O_WBR) + sgm * W; r.ldt = 4 * W; r.drow = r.n0; return r; }
    it -= I_BR;
    if (it < I_OUT) { const int kb = it / 64, nb = it % 64; r.n0 = nb * 32; r.k0 = kb * 64; r.Wp = c.in[29] + (size_t)l * D * D; r.ldw = D; r.WT = WSH(O_WOUT); r.ldt = D; r.drow = r.n0; return r; }
    it -= I_OUT;
    if (it < I_GU) { const int e = it / 1024, q = it % 1024, kb = q / 32, nb = q % 32; r.n0 = nb * 32; r.k0 = kb * 64; r.Wp = c.in[34] + ((size_t)l * NE + e) * D * 1024; r.ldw = 1024; r.WT = WSH(O_WGU) + (size_t)e * 1024 * D; r.ldt = D;
        r.drow = r.n0 < 512 ? (r.n0 / 128) * 256 + (r.n0 % 128) : ((r.n0 - 512) / 128) * 256 + 128 + ((r.n0 - 512) % 128); return r; }
    it -= I_GU;
    if (it < I_DN) { const int e = it / 512, q = it % 512, kb = q / 64, nb = q % 64; r.n0 = nb * 32; r.k0 = kb * 64; r.Wp = c.in[35] + ((size_t)l * NE + e) * 512 * D; r.ldw = D; r.WT = WSH(O_WDN) + (size_t)e * D * 512; r.ldt = 512; r.drow = r.n0; return r; }
    it -= I_DN;
    if (it < I_LR) { const int m = it / 8, q = it % 8, kb = q / 4, nb = q % 4, z = m >> 4, ty = (m >> 3) & 1, n = m & 7; r.n0 = nb * 32; r.k0 = kb * 64; r.Wp = c.in[ty ? 12 : 10] + (((size_t)l * 2 + z) * 8 + n) * 128 * 128; r.ldw = 128;
        r.WT = WSH(O_WLR) + (size_t)m * 128 * 128; r.ldt = 128; r.drow = r.n0; return r; }
    it -= I_LR;
    if (it < 2 * I_WU) { const int ua = it / I_WU, q = it % I_WU, z = q / 32, nb = q % 32; r.n0 = nb * 32; r.k0 = 0; r.Wp = c.in[ua ? 23 : 21] + ((size_t)l * 2 + z) * 64 * W; r.ldw = W; r.WT = WSH(ua ? O_WAT : O_WUT) + (size_t)z * W * 64; r.ldt = 64; r.drow = r.n0; return r; }
    it -= 2 * I_WU;
    { const int kb = it / 32, nb = it % 32; r.n0 = nb * 32; r.k0 = kb * 64; r.Wp = c.in[24] + (size_t)l * 128 * W; r.ldw = W; r.WT = WSH(O_WGT); r.ldt = 128; r.drow = r.n0; return r; }
}
constexpr int J_IN = 16 * (INW / 128), J_BR = 4 * 8 * 16, J_OUT = 16 * 16, J_GU = NE * 16 * 8, J_DN = NE * 4 * 16, J_ALL = J_IN + J_BR + J_OUT + J_GU + J_DN;
__device__ __forceinline__ CvtItem cvt_decode_big(const Ctx& c, int l, int it) {
    CvtItem r;
    if (it < J_IN) { const int kb = it / (INW / 128), nb = it % (INW / 128); r.n0 = nb * 128; r.k0 = kb * 128; r.Wp = c.in[7] + (size_t)l * D * INW; r.ldw = INW; r.WT = WSH(O_WIN); r.ldt = D; r.drow = r.n0 < 10624 ? r.n0 : r.n0 + 128; return r; }
    it -= J_IN;
    if (it < J_BR) { const int sgm = it / 128, q = it % 128, kb = q / 16, nb = q % 16; r.n0 = nb * 128; r.k0 = kb * 128; r.Wp = c.in[28] + ((size_t)l * 4 + sgm) * W * D; r.ldw = D; r.WT = WSH(O_WBR) + sgm * W; r.ldt = 4 * W; r.drow = r.n0; return r; }
    it -= J_BR;
    if (it < J_OUT) { const int kb = it / 16, nb = it % 16; r.n0 = nb * 128; r.k0 = kb * 128; r.Wp = c.in[29] + (size_t)l * D * D; r.ldw = D; r.WT = WSH(O_WOUT); r.ldt = D; r.drow = r.n0; return r; }
    it -= J_OUT;
    if (it < J_GU) { const int e = it / 128, q = it % 128, kb = q / 8, nb = q % 8; r.n0 = nb * 128; r.k0 = kb * 128; r.Wp = c.in[34] + ((size_t)l * NE + e) * D * 1024; r.ldw = 1024; r.WT = WSH(O_WGU) + (size_t)e * 1024 * D; r.ldt = D;
        r.drow = r.n0 < 512 ? (r.n0 / 128) * 256 : ((r.n0 - 512) / 128) * 256 + 128; return r; }
    it -= J_GU;
    { const int e = it / 64, q = it % 64, kb = q / 16, nb = q % 16; r.n0 = nb * 128; r.k0 = kb * 128; r.Wp = c.in[35] + ((size_t)l * NE + e) * 512 * D; r.ldw = D; r.WT = WSH(O_WDN) + (size_t)e * D * 512; r.ldt = 512; r.drow = r.n0; return r; }
}
__device__ __forceinline__ void convert_big(const Ctx& c, int l, float* ldsf, int first, int last, int widx, int wcnt) {
    const int tid = threadIdx.x, lr = tid >> 5, lc = (tid & 31) * 4;
    f32x4 rg[8]; int it = first + widx; CvtItem r;
    if (it < last) { r = cvt_decode_big(c, l, it);
#pragma unroll
        for (int i = 0; i < 8; ++i) rg[i] = *(const f32x4*)(r.Wp + (size_t)(r.k0 + lr + 16 * i) * r.ldw + r.n0 + lc); }
    for (; it < last; it += wcnt) {
#pragma unroll
        for (int i = 0; i < 8; ++i) { float* dp = ldsf + (lr + 16 * i) * 129 + lc; dp[0] = rg[i][0]; dp[1] = rg[i][1]; dp[2] = rg[i][2]; dp[3] = rg[i][3]; }
        const CvtItem cur = r; const int nx = it + wcnt;
        if (nx < last) { r = cvt_decode_big(c, l, nx);
#pragma unroll
            for (int i = 0; i < 8; ++i) rg[i] = *(const f32x4*)(r.Wp + (size_t)(r.k0 + lr + 16 * i) * r.ldw + r.n0 + lc); }
        SYNCTHREADS();
#pragma unroll
        for (int q = 0; q < 4; ++q) { const int id = tid + NT * q, n = id >> 4, k8 = (id & 15) * 8; const float* sp = ldsf + k8 * 129 + n;
            u32x4 o; o[0] = pk2(sp[0 * 129], sp[1 * 129]); o[1] = pk2(sp[2 * 129], sp[3 * 129]); o[2] = pk2(sp[4 * 129], sp[5 * 129]); o[3] = pk2(sp[6 * 129], sp[7 * 129]);
            *(u32x4*)(cur.WT + (size_t)(cur.drow + n) * cur.ldt + cur.k0 + k8) = o; }
        SYNCTHREADS();
    }
}
__device__ __forceinline__ int convert_tail_tiles() { const int nun = (T / 256) * (PW / 256), G = (int)gridDim.x, rem = nun % G; return rem == 0 ? 0 : (G - rem) * 10 < J_GU + J_DN ? (G - rem) * 10 : J_GU + J_DN; }
__device__ __forceinline__ void ph_convert(const Ctx& c, int l, float* ldsf) {
    const int lane = threadIdx.x & 63, wave = threadIdx.x >> 6; const int gw = blockIdx.x * (NT / 64) + wave, ngw = gridDim.x * (NT / 64);
    convert_big(c, l, ldsf, 0, J_ALL - convert_tail_tiles(), (int)blockIdx.x, (int)gridDim.x);
#ifdef CPU_EMU
    if (lane == 0) for (int it = I_BIG + gw; it < I_ALL; it += ngw) { const CvtItem r = cvt_decode(c, l, it);
        for (int kk = 0; kk < 64; ++kk) for (int nn = 0; nn < 32; ++nn) r.WT[(size_t)(r.drow + nn) * r.ldt + r.k0 + kk] = (bf16_t)f2bf(r.Wp[(size_t)(r.k0 + kk) * r.ldw + r.n0 + nn]); }
#else
    float* scr = ldsf + wave * (64 * 33 + 16);
    for (int it = I_BIG + gw; it < I_ALL; it += ngw) {
        const CvtItem r = cvt_decode(c, l, it);
#pragma unroll 8
        for (int i = 0; i < 32; ++i) { const int kk = 2 * i + (lane >> 5); scr[kk * 33 + (lane & 31)] = r.Wp[(size_t)(r.k0 + kk) * r.ldw + r.n0 + (lane & 31)]; }
        asm volatile("s_waitcnt lgkmcnt(0)" ::: "memory");
        const int cc = lane & 7;
#pragma unroll
        for (int j = 0; j < 4; ++j) { const int n = (lane >> 3) + 8 * j; const float* sp = scr + (8 * cc) * 33 + n;
            u32x4 o; o[0] = pk2(sp[0 * 33], sp[1 * 33]); o[1] = pk2(sp[2 * 33], sp[3 * 33]); o[2] = pk2(sp[4 * 33], sp[5 * 33]); o[3] = pk2(sp[6 * 33], sp[7 * 33]);
            *(u32x4*)(r.WT + (size_t)(r.drow + n) * r.ldt + r.k0 + 8 * cc) = o; }
        asm volatile("s_waitcnt lgkmcnt(0)" ::: "memory");
    }
#endif
    { const float* wg = c.in[30] + (size_t)l * D * 4; const float* we = c.in[32] + (size_t)l * D * 32; bf16_t* wh = WSH(O_WRH); bf16_t* wl = WSH(O_WRL);
      for (long i = GT_; i < (long)48 * D; i += GS_) { const int n = (int)(i / D), k = (int)(i % D); const float w = n < 4 ? wg[k * 4 + n] : n < 36 ? we[k * 32 + (n - 4)] : 0.f; const unsigned hb = f2bf(w); wh[i] = (bf16_t)hb; wl[i] = (bf16_t)f2bf(w - bf2f((bf16_t)hb)); } }
    for (long i = GT_; i < (long)128 * D / 2; i += GS_) ((unsigned*)(WSH(O_WIN) + (size_t)10624 * D))[i] = 0u;
}

namespace pg8 {
constexpr int BM = 256, BK = 64, HALF = 128, HTB = HALF * BK * 2, STAGE_BYTES = 8 * HTB;
__host__ __device__ __forceinline__ int lds_byte(int r, int cc) { const int st = (r >> 4) * 2 + (cc >> 5), rr = r & 15, c2 = cc & 31, ob = rr * 64 + c2 * 2; return st * 1024 + (ob ^ (((ob >> 9) & 1) << 5)); }
__host__ __device__ __forceinline__ void stage_rc(int b, int& R, int& C) { const int st = b / 1024, sb = b % 1024, swz = sb ^ (((sb >> 9) & 1) << 5); R = (st >> 1) * 16 + swz / 64; C = (st & 1) * 32 + (swz % 64) / 2; }
__host__ __device__ __forceinline__ int perm32(int rho) { const int n = rho >> 4, i = rho & 15; return 8 * (i >> 2) + 4 * n + (i & 3); }
struct Unit { int pm, pn, aux; const char* A; const char* B; };
struct Gemm { int K, lda, ldb; };

template <class Epi, class Sched>
__device__ __forceinline__ void gemm_phase(unsigned char* lds_, const Gemm g, const Sched& S, const Epi& E) {
#ifdef CPU_EMU
    if (threadIdx.x != 0) return;
    Unit u; const int K = g.K;
    float* Af = (float*)malloc((size_t)256 * K * 4); float* Bf = (float*)malloc((size_t)256 * K * 4); float* Cf = (float*)malloc(256 * 256 * 4);
    for (int i = 0; S.next(i, u); ++i) {
        const bf16_t* A = (const bf16_t*)u.A; const bf16_t* B = (const bf16_t*)u.B;
        for (int r = 0; r < 256; ++r) for (int k = 0; k < K; ++k) { Af[(size_t)r * K + k] = bf2f(A[(size_t)r * g.lda + k]); Bf[(size_t)r * K + k] = bf2f(B[(size_t)r * g.ldb + k]); }
        for (int r = 0; r < 256; ++r) for (int cc = 0; cc < 256; ++cc) { const float* a = Af + (size_t)r * K; const float* b = Bf + (size_t)cc * K; float sacc = 0.f; for (int k = 0; k < K; ++k) sacc += a[k] * b[k]; Cf[r * 256 + cc] = sacc; }
        for (int wid = 0; wid < 8; ++wid) for (int lane = 0; lane < 64; ++lane) {
            const int wr = wid >> 2, wc = wid & 3, fr = lane & 15, fq = lane >> 4; f32x4 acc[2][2][4][2];
            for (int ai = 0; ai < 2; ++ai) for (int bj = 0; bj < 2; ++bj) for (int m = 0; m < 4; ++m) for (int n = 0; n < 2; ++n) for (int j = 0; j < 4; ++j) {
                const int r = 128 * ai + 64 * wr + 16 * m + fr, cc = 128 * bj + 32 * wc + (Epi::PERM ? 8 * fq + 4 * n + j : 16 * n + 4 * fq + j); acc[ai][bj][m][n][j] = Cf[r * 256 + cc]; }
            E(acc, u, wr, wc, fr, fq);
        }
    }
    free(Af); free(Bf); free(Cf);
#else
    typedef __attribute__((address_space(3))) unsigned char* ldsp_t;
    ldsp_t lds = (ldsp_t)lds_;
    const int tid = threadIdx.x, wid = __builtin_amdgcn_readfirstlane(tid >> 6), lane = tid & 63, wr = wid >> 2, wc = wid & 3, fr = lane & 15, fq = lane >> 4;
    const int K = g.K, nt = K / BK;
    unsigned voffA[2], voffB[2];
#pragma unroll
    for (int i = 0; i < 2; ++i) { int R, C; stage_rc(tid * 16 + i * 8192, R, C); const int Rb = Epi::PERM ? ((R & ~31) + perm32(R & 31)) : R;
        voffA[i] = (unsigned)(R * g.lda + C) * 2u; voffB[i] = (unsigned)(Rb * g.ldb + C) * 2u; }
    const size_t kstep = (size_t)(BK * 2);
    const size_t hstepA = (size_t)HALF * g.lda * 2, hstepB = (size_t)HALF * g.ldb * 2;
    const unsigned ldsw = (unsigned)wid * 1024u;
    const int aoff = lds_byte(wr * 64 + fr, fq * 8), boff = lds_byte(wc * 32 + fr, fq * 8);
#define PG8_SA(b, h) (((b) * 2 + (h)) * HTB)
#define PG8_SB(b, h) ((4 + (b) * 2 + (h)) * HTB)
#define PG8_STAGE(bufoff, gbase, voff) do { _Pragma("unroll") for (int _i = 0; _i < 2; ++_i) \
        __builtin_amdgcn_global_load_lds((const unsigned*)((const char*)(gbase) + (voff)[_i]), (__attribute__((address_space(3))) unsigned*)(lds + (bufoff) + ldsw + _i * 8192), 16, 0, 0); } while (0)
#define PG8_LDA(dst, b, h) do { _Pragma("unroll") for (int m = 0; m < 4; ++m) _Pragma("unroll") for (int k = 0; k < 2; ++k) dst[m][k] = *(const __attribute__((address_space(3))) bf16x8*)(lds + PG8_SA(b, h) + aoff + m * 2048 + k * 1024); } while (0)
#define PG8_LDB(dst, b, h) do { _Pragma("unroll") for (int n = 0; n < 2; ++n) _Pragma("unroll") for (int k = 0; k < 2; ++k) dst[n][k] = *(const __attribute__((address_space(3))) bf16x8*)(lds + PG8_SB(b, h) + boff + n * 2048 + k * 1024); } while (0)
#define PG8_MMA(ai, bj, At, Bt) do { __builtin_amdgcn_s_setprio(1); _Pragma("unroll") for (int m = 0; m < 4; ++m) _Pragma("unroll") for (int n = 0; n < 2; ++n) _Pragma("unroll") for (int k = 0; k < 2; ++k) \
        acc[ai][bj][m][n] = __builtin_amdgcn_mfma_f32_16x16x32_bf16(Bt[n][k], At[m][k], acc[ai][bj][m][n], 0, 0, 0); __builtin_amdgcn_s_setprio(0); } while (0)
#define PG8_WAIT_V(n) asm volatile("s_waitcnt vmcnt(" #n ")" ::: "memory")
#define PG8_WAIT_L(n) asm volatile("s_waitcnt lgkmcnt(" #n ")" ::: "memory")
#define PG8_BAR __builtin_amdgcn_s_barrier()
#define PG8_SCHED __builtin_amdgcn_sched_barrier(0)
    Unit cur, nxt; int ui = 0;
    if (!S.next(0, cur)) return;
    f32x4 acc[2][2][4][2];
#pragma unroll
    for (int a = 0; a < 2; ++a)
#pragma unroll
        for (int b = 0; b < 2; ++b)
#pragma unroll
            for (int m = 0; m < 4; ++m)
#pragma unroll
                for (int n = 0; n < 2; ++n) acc[a][b][m][n] = (f32x4){0.f, 0.f, 0.f, 0.f};
    bf16x8 At[4][2], B0[2][2], B1[2][2];
    const char* cA = cur.A; const char* cB = cur.B;
    S.a_ready(cur);
    PG8_STAGE(PG8_SB(0, 0), cB, voffB); PG8_STAGE(PG8_SA(0, 0), cA, voffA); PG8_STAGE(PG8_SB(0, 1), cB + hstepB, voffB); PG8_STAGE(PG8_SA(0, 1), cA + hstepA, voffA);
    if (wr == 1) PG8_BAR;
    PG8_WAIT_V(4); PG8_BAR;
    PG8_STAGE(PG8_SB(1, 0), cB + kstep, voffB); PG8_STAGE(PG8_SA(1, 0), cA + kstep, voffA); PG8_STAGE(PG8_SB(1, 1), cB + hstepB + kstep, voffB);
    PG8_WAIT_V(6); PG8_BAR;
    for (;;) {
        const bool has_next = S.next(ui + 1, nxt);
        const char* nA = has_next ? nxt.A : cA; const char* nB = has_next ? nxt.B : cB;
        for (int t = 0; t < nt; t += 2) {
            const bool last = (t == nt - 2);
            const char* a1 = cA + (size_t)(t + 1) * kstep;
            const char* a2 = last ? nA : cA + (size_t)(t + 2) * kstep; const char* b2 = last ? nB : cB + (size_t)(t + 2) * kstep;
            const char* a3 = a2 + kstep; const char* b3 = b2 + kstep;
            if (last && has_next) S.a_ready(nxt);
            PG8_LDB(B0, 0, 0); PG8_SCHED; PG8_LDA(At, 0, 0); PG8_STAGE(PG8_SA(1, 1), a1 + hstepA, voffA);
            PG8_WAIT_L(8); PG8_BAR; PG8_WAIT_L(0); PG8_MMA(0, 0, At, B0); PG8_BAR; PG8_SCHED;
            PG8_LDB(B1, 0, 1); PG8_STAGE(PG8_SB(0, 0), b2, voffB);
            PG8_BAR; PG8_WAIT_L(0); PG8_MMA(0, 1, At, B1); PG8_BAR;
            PG8_LDA(At, 0, 1); PG8_STAGE(PG8_SA(0, 0), a2, voffA);
            PG8_BAR; PG8_WAIT_L(0); PG8_MMA(1, 0, At, B0); PG8_BAR; PG8_SCHED;
            PG8_STAGE(PG8_SB(0, 1), b2 + hstepB, voffB);
            PG8_WAIT_V(6); PG8_BAR; PG8_MMA(1, 1, At, B1); PG8_BAR;
            PG8_LDB(B0, 1, 0); PG8_SCHED; PG8_LDA(At, 1, 0); PG8_STAGE(PG8_SA(0, 1), a2 + hstepA, voffA);
            PG8_WAIT_L(8); PG8_BAR; PG8_WAIT_L(0); PG8_MMA(0, 0, At, B0); PG8_BAR; PG8_SCHED;
            PG8_LDB(B1, 1, 1); PG8_STAGE(PG8_SB(1, 0), b3, voffB);
            PG8_BAR; PG8_WAIT_L(0); PG8_MMA(0, 1, At, B1); PG8_BAR;
            PG8_LDA(At, 1, 1); PG8_STAGE(PG8_SA(1, 0), a3, voffA);
            PG8_BAR; PG8_WAIT_L(0); PG8_MMA(1, 0, At, B0); PG8_BAR; PG8_SCHED;
            PG8_STAGE(PG8_SB(1, 1), b3 + hstepB, voffB);
            PG8_WAIT_V(6); PG8_BAR; PG8_MMA(1, 1, At, B1); PG8_BAR;
        }
        E(acc, cur, wr, wc, fr, fq); S.done(cur);
        if (!has_next) break;
#pragma unroll
        for (int a = 0; a < 2; ++a)
#pragma unroll
            for (int b = 0; b < 2; ++b)
#pragma unroll
                for (int m = 0; m < 4; ++m)
#pragma unroll
                    for (int n = 0; n < 2; ++n) acc[a][b][m][n] = (f32x4){0.f, 0.f, 0.f, 0.f};
        cur = nxt; cA = nA; cB = nB; ++ui;
    }
    PG8_WAIT_V(0);
    if (wr == 0) PG8_BAR;
    PG8_BAR;
#undef PG8_SA
#undef PG8_SB
#undef PG8_STAGE
#undef PG8_LDA
#undef PG8_LDB
#undef PG8_MMA
#undef PG8_WAIT_V
#undef PG8_WAIT_L
#undef PG8_BAR
#undef PG8_SCHED
#endif
}

struct StaticOrder {
    int nM, nN, nwg, G, c; const char* A; const char* B; size_t tstepA, tstepB;
    __device__ __forceinline__ void init(int M, int N, int G_, int c_, const void* A_, const void* B_, int lda, int ldb) { nM = M / BM; nN = N / BM; nwg = nM * nN; G = G_; c = c_; A = (const char*)A_; B = (const char*)B_; tstepA = (size_t)BM * lda * 2; tstepB = (size_t)BM * ldb * 2; }
    __device__ __forceinline__ bool next(int i, Unit& u) const {
        const long L = (long)i * G + c; if (L >= nwg) return false;
        int wgid = (int)L; { const int q = nwg / 8, r = nwg % 8, xcd = wgid % 8, off = wgid / 8; wgid = (xcd < r ? xcd * (q + 1) : r * (q + 1) + (xcd - r) * q) + off; }
        const int nig = 8 * nN, gid = wgid / nig, fm = gid * 8, gsz = (nM - fm) < 8 ? (nM - fm) : 8;
        u.pm = fm + ((wgid % nig) % gsz); u.pn = (wgid % nig) / gsz; u.aux = 0; u.A = A + (size_t)u.pm * tstepA; u.B = B + (size_t)u.pn * tstepB; return true;
    }
    __device__ __forceinline__ void a_ready(const Unit&) const {}
    __device__ __forceinline__ void done(const Unit&) const {}
};
struct MergeOrder {
    StaticOrder so; int kseg_bytes;
    __device__ __forceinline__ bool next(int i, Unit& u) const { if (!so.next(i >> 2, u)) return false; u.aux = i & 3; u.A += (size_t)u.aux * kseg_bytes; u.B += (size_t)u.aux * kseg_bytes; return true; }
    __device__ __forceinline__ void a_ready(const Unit&) const {}
    __device__ __forceinline__ void done(const Unit&) const {}
};
struct MoeOrder {
    int G, c, ncol; const int* plan; const char* A; const char* B; size_t tstepA, tstepB, estep;
    __device__ __forceinline__ bool next(int i, Unit& u) const {
        const long L = (long)i * G + c; const int nblk = plan[40]; if (L >= (long)nblk * ncol) return false;
        u.pm = (int)(L / ncol); u.pn = (int)(L % ncol); u.aux = plan[64 + u.pm]; u.A = A + (size_t)u.pm * tstepA; u.B = B + (size_t)u.aux * estep + (size_t)u.pn * tstepB; return true;
    }
    __device__ __forceinline__ void a_ready(const Unit&) const {}
    __device__ __forceinline__ void done(const Unit&) const {}
};

__device__ __forceinline__ u32x4 pack8(const f32x4 v0, const f32x4 v1) { u32x4 w; w[0] = pk2(v0[0], v0[1]); w[1] = pk2(v0[2], v0[3]); w[2] = pk2(v1[0], v1[1]); w[3] = pk2(v1[2], v1[3]); return w; }
struct EpiBf16 {
    static constexpr bool PERM = true; bf16_t* O; int ldc;
    __device__ __forceinline__ void operator()(const f32x4 (&acc)[2][2][4][2], const Unit& u, int wr, int wc, int fr, int fq) const {
        const int row0 = u.pm * BM + wr * 64 + fr, col0 = u.pn * BM + wc * 32 + 8 * fq;
#pragma unroll
        for (int ai = 0; ai < 2; ++ai)
#pragma unroll
            for (int m = 0; m < 4; ++m) { bf16_t* rowp = O + (size_t)(row0 + ai * HALF + m * 16) * ldc + col0;
#pragma unroll
                for (int bj = 0; bj < 2; ++bj) *(u32x4*)(rowp + bj * HALF) = pack8(acc[ai][bj][m][0], acc[ai][bj][m][1]); }
    }
};
struct EpiMerge {
    static constexpr bool PERM = true; const bf16_t* P; bf16_t* MRG;
    __device__ __forceinline__ void operator()(const f32x4 (&acc)[2][2][4][2], const Unit& u, int wr, int wc, int fr, int fq) const {
        const int row0 = u.pm * BM + wr * 64 + fr, col0 = u.pn * BM + wc * 32 + 8 * fq, seg = u.aux;
#pragma unroll
        for (int ai = 0; ai < 2; ++ai)
#pragma unroll
            for (int m = 0; m < 4; ++m) { const size_t r = (size_t)(row0 + ai * HALF + m * 16);
#pragma unroll
                for (int bj = 0; bj < 2; ++bj) { const int cc = col0 + bj * HALF;
                    const u32x4 gw = *(const u32x4*)(P + r * PW + C_MLP + seg * D + cc);
                    f32x4 v0, v1;
#pragma unroll
                    for (int q = 0; q < 2; ++q) { v0[2 * q] = sigmoidf_(bflo(gw[q])) * acc[ai][bj][m][0][2 * q]; v0[2 * q + 1] = sigmoidf_(bfhi(gw[q])) * acc[ai][bj][m][0][2 * q + 1];
                        v1[2 * q] = sigmoidf_(bflo(gw[2 + q])) * acc[ai][bj][m][1][2 * q]; v1[2 * q + 1] = sigmoidf_(bfhi(gw[2 + q])) * acc[ai][bj][m][1][2 * q + 1]; }
                    bf16_t* mp = MRG + r * D + cc;
                    if (seg > 0) { const u32x4 pw = *(const u32x4*)mp;
#pragma unroll
                        for (int q = 0; q < 2; ++q) { v0[2 * q] += bflo(pw[q]); v0[2 * q + 1] += bfhi(pw[q]); v1[2 * q] += bflo(pw[2 + q]); v1[2 * q + 1] += bfhi(pw[2 + q]); } }
                    *(u32x4*)mp = pack8(v0, v1);
                }
#ifndef CPU_EMU
                asm volatile("" ::: "memory");
#endif
            }
    }
};
struct EpiResid {
    static constexpr bool PERM = false; const float* xin; const float* g1; float* xmid;
    __device__ __forceinline__ void operator()(const f32x4 (&acc)[2][2][4][2], const Unit& u, int wr, int wc, int fr, int fq) const {
        const int row0 = u.pm * BM + wr * 64 + fr, col0 = u.pn * BM + wc * 32 + 4 * fq;
#pragma unroll
        for (int ai = 0; ai < 2; ++ai)
#pragma unroll
            for (int m = 0; m < 4; ++m) { const int r = row0 + ai * HALF + m * 16; const float* gp = g1 + (size_t)(r / S) * D6;
#pragma unroll
                for (int bj = 0; bj < 2; ++bj)
#pragma unroll
                    for (int n = 0; n < 2; ++n) { const int cc = col0 + bj * HALF + n * 16; *(f32x4*)(xmid + (size_t)r * D + cc) = *(const f32x4*)(xin + (size_t)r * D + cc) + *(const f32x4*)(gp + cc) * acc[ai][bj][m][n]; }
#ifndef CPU_EMU
                asm volatile("" ::: "memory");
#endif
            }
    }
};
struct EpiGU {
    static constexpr bool PERM = true; bf16_t* ACT;
    __device__ __forceinline__ void operator()(const f32x4 (&acc)[2][2][4][2], const Unit& u, int wr, int wc, int fr, int fq) const {
        const int row0 = u.pm * BM + wr * 64 + fr, col0 = u.pn * HALF + wc * 32 + 8 * fq;
#pragma unroll
        for (int ai = 0; ai < 2; ++ai)
#pragma unroll
            for (int m = 0; m < 4; ++m) { f32x4 v0, v1;
#pragma unroll
                for (int j = 0; j < 4; ++j) { v0[j] = siluf_(acc[ai][0][m][0][j]) * acc[ai][1][m][0][j]; v1[j] = siluf_(acc[ai][0][m][1][j]) * acc[ai][1][m][1][j]; }
                *(u32x4*)(ACT + (size_t)(row0 + ai * HALF + m * 16) * 512 + col0) = pack8(v0, v1); }
    }
};
}

template <int PASS>
__device__ __forceinline__ void ph_lru(const Ctx& c, int l, float* ldsf) {
    const bf16_t* P = WSH(O_P); const float* cw = c.in[8] + (size_t)l * 4 * W; const float* cb = c.in[9] + (size_t)l * W;
    const float* br = c.in[11] + (size_t)l * 2 * W; const float* bi = c.in[13] + (size_t)l * 2 * W; const float* lam = c.in[14] + (size_t)l * 2 * W; const bf16_t* WLR = WSH(O_WLR);
    float* CA = WSF(O_LCA); float* CH = WSF(O_LCH); const float* CI = WSF(O_LCI); bf16_t* Y = WSH(O_YS);
    bf16_t* Xs = (bf16_t*)ldsf; bf16_t* Wr = Xs + 64 * 136; bf16_t* Wi = Wr + 128 * 136; float* AUa = (float*)Wr; float* AUu = AUa + 64 * 128; float* HF = (float*)(Wi + 128 * 136); float* spl = HF + 64 * 128;
    const int tid = threadIdx.x, wv = tid >> 6, lane = tid & 63, fr = lane & 15, fq = lane >> 4, rt = wv & 3, hf = wv >> 2;
    for (int u = blockIdx.x; u < (T / 64) * 8; u += gridDim.x) {
        const int n = u & 7, tile = u >> 3, b = tile / NLC, chk = tile % NLC; const long t0 = (long)tile * 64;
        if (tid < 256) spl[tid] = softplusf_(-lam[(tid >> 7) * W + n * 128 + (tid & 127)]);
#pragma unroll
        for (int q = 0; q < 4; ++q) { const int id = tid + NT * q, tl = id >> 5, e4 = (id & 31) * 4, ch = n * 128 + e4; const long t = t0 + tl; const int sI = (int)(t % S);
            f32x4 acc = *(const f32x4*)(cb + ch);
#pragma unroll
            for (int k = 0; k < 4; ++k) { const int ss = sI + k - 2; if (ss >= 0 && ss < S) acc += ld_bf4(P + (size_t)(t + k - 2) * PW + C_LX + ch) * *(const f32x4*)(cw + k * W + ch); }
            st_bf4(Xs + tl * 136 + e4, acc); }
        for (int z = 0; z < 2; ++z) {
#pragma unroll
            for (int q = 0; q < 4; ++q) { const int id = tid + NT * q, f = id >> 4, e8 = (id & 15) * 8;
                *(u32x4*)(Wr + f * 136 + e8) = *(const u32x4*)(WLR + ((size_t)((z * 2 + 0) * 8 + n) * 128 + f) * 128 + e8); *(u32x4*)(Wi + f * 136 + e8) = *(const u32x4*)(WLR + ((size_t)((z * 2 + 1) * 8 + n) * 128 + f) * 128 + e8); }
            SYNCTHREADS();
            f32x4 ar[4], ai[4];
#pragma unroll
            for (int nt = 0; nt < 4; ++nt) { ar[nt] = (f32x4){0.f, 0.f, 0.f, 0.f}; ai[nt] = (f32x4){0.f, 0.f, 0.f, 0.f}; }
            wave_mma<4, 4>(ar, Xs + rt * 16 * 136, 136, Wr + hf * 64 * 136, 136);
            wave_mma<4, 4>(ai, Xs + rt * 16 * 136, 136, Wi + hf * 64 * 136, 136);
            SYNCTHREADS();
            const int tl = rt * 16 + fr;
#pragma unroll
            for (int nt = 0; nt < 4; ++nt) { const int f = 64 * hf + 16 * nt + 4 * fq, ch = n * 128 + f;
                const f32x4 brv = *(const f32x4*)(br + z * W + ch), biv = *(const f32x4*)(bi + z * W + ch), lmv = *(const f32x4*)(spl + z * 128 + f), xcv = ld_bf4(Xs + tl * 136 + f); f32x4 av, uv;
#pragma unroll
                for (int e = 0; e < 4; ++e) { const float r = sigmoidf_(ar[nt][e] + brv[e]), ig = sigmoidf_(ai[nt][e] + biv[e]), la = -8.f * r * lmv[e]; const float a = fexp_(la); av[e] = a; uv[e] = sqrtf(fmaxf(1.f - a * a, 0.f)) * ig * xcv[e]; }
                *(f32x4*)(AUa + tl * 128 + f) = av; *(f32x4*)(AUu + tl * 128 + f) = uv; }
            SYNCTHREADS();
            if (tid < 128) { const int f = tid; const size_t ci = (((size_t)z * NB + b) * NLC + chk) * W + n * 128 + f;
                if (PASS == 1) { float prod = 1.f, h = 0.f;
#pragma unroll 8
                    for (int q = 0; q < 64; ++q) { const int sI = z == 0 ? q : 63 - q; const float a = AUa[sI * 128 + f]; h = a * h + AUu[sI * 128 + f]; prod *= a; }
                    CA[ci] = prod; CH[ci] = h;
                } else { float h = CI[ci];
                    if (z == 0) {
#pragma unroll 8
                        for (int q = 0; q < 64; ++q) { h = AUa[q * 128 + f] * h + AUu[q * 128 + f]; HF[q * 128 + f] = h; }
                    } else {
#pragma unroll 8
                        for (int q = 63; q >= 0; --q) { h = AUa[q * 128 + f] * h + AUu[q * 128 + f]; HF[q * 128 + f] += h; } } }
            }
            SYNCTHREADS();
        }
        if (PASS == 2) {
#pragma unroll
            for (int q = 0; q < 4; ++q) { const int id = tid + NT * q, tl = id >> 5, f4 = (id & 31) * 4; const long t = t0 + tl; f32x4 hv = *(const f32x4*)(HF + tl * 128 + f4); const f32x4 gv = ld_bf4(P + (size_t)t * PW + C_LG + n * 128 + f4);
#pragma unroll
                for (int e = 0; e < 4; ++e) hv[e] *= geluf_(gv[e]);
                st_bf4(Y + (size_t)t * 4 * W + 0 * W + n * 128 + f4, hv); }
            SYNCTHREADS();
        }
    }
}
__device__ __forceinline__ void ph_lru_scan2(const Ctx& c) {
    const float* CA = WSF(O_LCA); const float* CH = WSF(O_LCH); float* CI = WSF(O_LCI);
    for (long i = GT_; i < (long)2 * NB * W; i += GS_) {
        const int w = (int)(i % W), b = (int)((i / W) % NB), z = (int)(i / ((long)W * NB)); float carry = 0.f;
#pragma unroll 16
        for (int q = 0; q < NLC; ++q) { const int ch = z == 0 ? q : NLC - 1 - q; const size_t idx = (((size_t)z * NB + b) * NLC + ch) * W + w; CI[idx] = carry; carry = CA[idx] * carry + CH[idx]; }
    }
}
__device__ __forceinline__ void ret_tables(float* tab, int h) {
    const int tid = threadIdx.x; const float lg = loggamma_(h);
    if (tid < 32) tab[tid] = powf(10000.f, -(float)(2 * tid) / 64.f);
    if (tid >= 64 && tid < 64 + 129) tab[tid] = expf((float)(tid - 64) * lg);
}
__device__ __forceinline__ void ph_ret_kv(const Ctx& c, float* ldsf) {
    const int* pos = (const int*)c.in[2]; const bf16_t* P = WSH(O_P); float* KVF = WSF(O_KVF); float* KVB = WSF(O_KVB);
    bf16_t* VT = (bf16_t*)ldsf; bf16_t* KF = VT + 128 * 136; bf16_t* KB = KF + 64 * 136; float* tab = (float*)(KB + 64 * 136);
    const int tid = threadIdx.x, wv = tid >> 6, lane = tid & 63, fr = lane & 15, fq = lane >> 4;
    for (int u = blockIdx.x; u < (T / 128) * 8; u += gridDim.x) {
        const int h = u & 7; const long t0 = (long)(u >> 3) * 128;
        ret_tables(tab, h);
        SYNCTHREADS();
        { float x1[8], x2[8], pj[8];
#pragma unroll
          for (int q = 0; q < 8; ++q) { const int id = tid + NT * q, j = id & 127, dj = id >> 7; const bf16_t* prow = P + (size_t)(t0 + j) * PW + C_RK + h * 64; x1[q] = bf2f(prow[dj]); x2[q] = bf2f(prow[dj + 32]); pj[q] = (float)pos[t0 + j]; }
#pragma unroll 1
          for (int q = 0; q < 8; ++q) { const int id = tid + NT * q, j = id & 127, dj = id >> 7; const float ang = pj[q] * tab[dj]; const float cs = cosf(ang), sn = sinf(ang);
            const float k1 = x1[q] * cs - x2[q] * sn, k2 = x2[q] * cs + x1[q] * sn, fj = tab[64 + 127 - j], bj = tab[64 + j];
            KF[dj * 136 + j] = (bf16_t)f2bf(k1 * fj); KF[(dj + 32) * 136 + j] = (bf16_t)f2bf(k2 * fj); KB[dj * 136 + j] = (bf16_t)f2bf(k1 * bj); KB[(dj + 32) * 136 + j] = (bf16_t)f2bf(k2 * bj); } }
#pragma unroll
        for (int q = 0; q < 4; ++q) { const int id = tid + NT * q, j = id & 127, e8 = (id >> 7) * 8; const u32x4 raw = *(const u32x4*)(P + (size_t)(t0 + j) * PW + C_RV + h * 128 + e8);
#pragma unroll
            for (int e = 0; e < 4; ++e) { VT[(e8 + 2 * e) * 136 + j] = (bf16_t)(raw[e] & 0xffffu); VT[(e8 + 2 * e + 1) * 136 + j] = (bf16_t)(raw[e] >> 16); } }
        SYNCTHREADS();
        f32x4 af[4], ab[4];
#pragma unroll
        for (int nt = 0; nt < 4; ++nt) { af[nt] = (f32x4){0.f, 0.f, 0.f, 0.f}; ab[nt] = (f32x4){0.f, 0.f, 0.f, 0.f}; }
        wave_mma<4, 4>(af, VT + wv * 16 * 136, 136, KF, 136);
        wave_mma<4, 4>(ab, VT + wv * 16 * 136, 136, KB, 136);
        const size_t ob = (((size_t)(u >> 3) * 8 + h) * 128 + wv * 16 + fr) * 64 + 4 * fq;
#pragma unroll
        for (int nt = 0; nt < 4; ++nt) { *(f32x4*)(KVF + ob + 16 * nt) = af[nt]; *(f32x4*)(KVB + ob + 16 * nt) = ab[nt]; }
        SYNCTHREADS();
    }
}
__device__ __forceinline__ void ph_ret_state(const Ctx& c) {
    const float* KVF = WSF(O_KVF); const float* KVB = WSF(O_KVB); float* STF = WSF(O_STF); float* STB = WSF(O_STB);
    for (long i = GT_; i < (long)NB * 8 * 8192; i += GS_) {
        const int x = (int)(i % 8192), h = (int)((i / 8192) % 8), b = (int)(i / 65536);
        const float cd = expf(128.f * loggamma_(h)); float st = 0.f;
#pragma unroll 16
        for (int n = 0; n < NCH; ++n) { const size_t idx = (((size_t)b * NCH + n) * 8 + h) * 8192 + x; STF[idx] = st; st = cd * st + KVF[idx]; }
        st = 0.f;
#pragma unroll 16
        for (int n = NCH - 1; n >= 0; --n) { const size_t idx = (((size_t)b * NCH + n) * 8 + h) * 8192 + x; STB[idx] = st; st = cd * st + KVB[idx]; }
    }
}
__device__ __forceinline__ void ph_ret_out(const Ctx& c, float* ldsf) {
    const int* pos = (const int*)c.in[2]; const bf16_t* P = WSH(O_P); const float* STF = WSF(O_STF); const float* STB = WSF(O_STB); bf16_t* Y = WSH(O_YS);
    bf16_t* Qs = (bf16_t*)ldsf; bf16_t* Ks = Qs + 128 * 72; bf16_t* VT = Ks + 128 * 72; bf16_t* Ss = VT + 128 * 136; bf16_t* SF = Ss + 128 * 136; bf16_t* SB = SF + 128 * 72; float* tab = (float*)(SB + 128 * 72);
    const int tid = threadIdx.x, wv = tid >> 6, lane = tid & 63, fr = lane & 15, fq = lane >> 4;
    for (int u = blockIdx.x; u < (T / 128) * 8; u += gridDim.x) {
        const int h = u & 7; const long t0 = (long)(u >> 3) * 128;
        ret_tables(tab, h);
        SYNCTHREADS();
#pragma unroll 1
        for (int qh = 0; qh < 8; qh += 4) { float q1[4], q2[4], k1[4], k2[4], pj[4];
#pragma unroll
          for (int q = 0; q < 4; ++q) { const int id = tid + NT * (qh + q), j = id >> 5, dj = id & 31; const bf16_t* prow = P + (size_t)(t0 + j) * PW;
            q1[q] = bf2f(prow[C_RQ + h * 64 + dj]); q2[q] = bf2f(prow[C_RQ + h * 64 + dj + 32]); k1[q] = bf2f(prow[C_RK + h * 64 + dj]); k2[q] = bf2f(prow[C_RK + h * 64 + dj + 32]); pj[q] = (float)pos[t0 + j]; }
#pragma unroll
          for (int q = 0; q < 4; ++q) { const int id = tid + NT * (qh + q), j = id >> 5, dj = id & 31; const float ang = pj[q] * tab[dj]; const float cs = cosf(ang), sn = sinf(ang);
            Qs[j * 72 + dj] = (bf16_t)f2bf((q1[q] * cs - q2[q] * sn) * 0.125f); Qs[j * 72 + dj + 32] = (bf16_t)f2bf((q2[q] * cs + q1[q] * sn) * 0.125f); Ks[j * 72 + dj] = (bf16_t)f2bf(k1[q] * cs - k2[q] * sn); Ks[j * 72 + dj + 32] = (bf16_t)f2bf(k2[q] * cs + k1[q] * sn); } }
#pragma unroll
        for (int q = 0; q < 4; ++q) { const int id = tid + NT * q, j = id & 127, e8 = (id >> 7) * 8; const u32x4 raw = *(const u32x4*)(P + (size_t)(t0 + j) * PW + C_RV + h * 128 + e8);
#pragma unroll
            for (int e = 0; e < 4; ++e) { VT[(e8 + 2 * e) * 136 + j] = (bf16_t)(raw[e] & 0xffffu); VT[(e8 + 2 * e + 1) * 136 + j] = (bf16_t)(raw[e] >> 16); } }
        const size_t sbase = (((size_t)(u >> 3) * 8 + h)) * 8192;
#pragma unroll
        for (int q = 0; q < 4; ++q) { const int id = tid + NT * q, e = id >> 4, d4 = (id & 15) * 4; st_bf4(SF + e * 72 + d4, *(const f32x4*)(STF + sbase + (size_t)e * 64 + d4)); st_bf4(SB + e * 72 + d4, *(const f32x4*)(STB + sbase + (size_t)e * 64 + d4)); }
        SYNCTHREADS();
        const int i = wv * 16 + fr; const long t = t0 + i;
        {
            f32x4 sc[8];
#pragma unroll
            for (int nt = 0; nt < 8; ++nt) sc[nt] = (f32x4){0.f, 0.f, 0.f, 0.f};
            wave_mma<2, 8>(sc, Qs + wv * 16 * 72, 72, Ks, 72);
#pragma unroll
            for (int nt = 0; nt < 8; ++nt) { const int j0 = 16 * nt + 4 * fq; f32x4 sv;
#pragma unroll
                for (int e = 0; e < 4; ++e) { const int j = j0 + e, dist = i > j ? i - j : j - i; sv[e] = sc[nt][e] * tab[64 + dist]; }
                st_bf4(Ss + i * 136 + j0, sv); }
        }
#ifdef CPU_EMU
        SYNCTHREADS();
#else
        asm volatile("s_waitcnt lgkmcnt(0)" ::: "memory");
#endif
        f32x4 ao[8], tm[8];
#pragma unroll
        for (int nt = 0; nt < 8; ++nt) { ao[nt] = (f32x4){0.f, 0.f, 0.f, 0.f}; tm[nt] = (f32x4){0.f, 0.f, 0.f, 0.f}; }
        wave_mma<4, 8>(ao, Ss + wv * 16 * 136, 136, VT, 136);
        wave_mma<2, 8>(tm, Qs + wv * 16 * 72, 72, SF, 72);
        { const float qf = tab[64 + i + 1];
#pragma unroll
            for (int nt = 0; nt < 8; ++nt) { ao[nt] += tm[nt] * qf; tm[nt] = (f32x4){0.f, 0.f, 0.f, 0.f}; } }
        wave_mma<2, 8>(tm, Qs + wv * 16 * 72, 72, SB, 72);
        { const float qb = tab[64 + 128 - i];
#pragma unroll
            for (int nt = 0; nt < 8; ++nt) ao[nt] += tm[nt] * qb; }
        float sm = 0.f;
#pragma unroll
        for (int nt = 0; nt < 8; ++nt) sm += (ao[nt][0] + ao[nt][1]) + (ao[nt][2] + ao[nt][3]);
        sm += SHFL_XOR(sm, 16); sm += SHFL_XOR(sm, 32);
        const float mu = sm * (1.f / 128.f); float sq = 0.f;
#pragma unroll
        for (int nt = 0; nt < 8; ++nt) { ao[nt] -= mu; sq += (ao[nt][0] * ao[nt][0] + ao[nt][1] * ao[nt][1]) + (ao[nt][2] * ao[nt][2] + ao[nt][3] * ao[nt][3]); }
        sq += SHFL_XOR(sq, 16); sq += SHFL_XOR(sq, 32);
        const float rs = 1.f / sqrtf(sq * (1.f / 128.f) + EPS);
#pragma unroll
        for (int nt = 0; nt < 8; ++nt) { const int e0 = 16 * nt + 4 * fq; f32x4 gv = ld_bf4(P + (size_t)t * PW + C_RG + h * 128 + e0);
#pragma unroll
            for (int e = 0; e < 4; ++e) gv[e] = siluf_(gv[e]) * (ao[nt][e] * rs);
            st_bf4(Y + (size_t)t * 4 * W + 1 * W + h * 128 + e0, gv); }
        SYNCTHREADS();
    }
}
__device__ __forceinline__ void ph_sgu_norm(const Ctx& c, int l) {
    const bf16_t* P = WSH(O_P); float* ST = WSF(O_VN);
    const int lane = threadIdx.x & 63, gw = blockIdx.x * (NT / 64) + (threadIdx.x >> 6), ngw = gridDim.x * (NT / 64);
    for (int t = gw; t < T; t += ngw) {
        f32x4 v[4]; float sm = 0.f;
#pragma unroll
        for (int j = 0; j < 4; ++j) { v[j] = ld_bf4(P + (size_t)t * PW + C_SV + (j * 64 + lane) * 4);
#pragma unroll
            for (int q = 0; q < 4; ++q) { v[j][q] = geluf_(v[j][q]); sm += v[j][q]; } }
        const float mu = wave_sum(sm) * (1.f / W); float sq = 0.f;
#pragma unroll
        for (int j = 0; j < 4; ++j)
#pragma unroll
            for (int q = 0; q < 4; ++q) { const float dd = v[j][q] - mu; sq += dd * dd; }
        const float rs = 1.f / sqrtf(wave_sum(sq) * (1.f / W) + EPS);
        if (lane == 0) { ST[(size_t)t * 2] = mu; ST[(size_t)t * 2 + 1] = rs; }
    }
}
__device__ __forceinline__ void ph_sgu_mix(const Ctx& c, int l, float* ldsf) {
    const bf16_t* P = WSH(O_P); const float* ST = WSF(O_VN); bf16_t* Y = WSH(O_YS); const float* ng = c.in[15] + (size_t)l * W;
    bf16_t* As = (bf16_t*)ldsf; bf16_t* Bs = As + 128 * 136; const int tid = threadIdx.x, wv = tid >> 6, lane = tid & 63, fr = lane & 15, fq = lane >> 4;
    for (int u = blockIdx.x; u < (T / 128) * 8; u += gridDim.x) {
        const int g = u & 7; const long t0 = (long)(u >> 3) * 128;
        const float* ws = c.in[16] + ((size_t)l * 8 + g) * 128 * 128; const float* bs = c.in[17] + ((size_t)l * 8 + g) * 128;
#pragma unroll
        for (int q = 0; q < 8; ++q) { const int id = tid + NT * q, i = id >> 5, j4 = (id & 31) * 4; st_bf4(As + i * 136 + j4, *(const f32x4*)(ws + i * 128 + j4)); }
#pragma unroll
        for (int q = 0; q < 4; ++q) { const int id = tid + NT * q, j = id & 127, d8 = (id >> 7) * 8; const float mu = ST[(size_t)(t0 + j) * 2], rs = ST[(size_t)(t0 + j) * 2 + 1];
            const u32x4 raw = *(const u32x4*)(P + (size_t)(t0 + j) * PW + C_SV + g * 128 + d8);
#pragma unroll
            for (int e = 0; e < 4; ++e) { const float v0 = (geluf_(bflo(raw[e])) - mu) * rs * ng[g * 128 + d8 + 2 * e], v1 = (geluf_(bfhi(raw[e])) - mu) * rs * ng[g * 128 + d8 + 2 * e + 1];
                Bs[(d8 + 2 * e) * 136 + j] = (bf16_t)f2bf(v0); Bs[(d8 + 2 * e + 1) * 136 + j] = (bf16_t)f2bf(v1); } }
        SYNCTHREADS();
        f32x4 acc[8];
#pragma unroll
        for (int nt = 0; nt < 8; ++nt) acc[nt] = (f32x4){0.f, 0.f, 0.f, 0.f};
        wave_mma<4, 8>(acc, As + wv * 16 * 136, 136, Bs, 136);
        const int i = wv * 16 + fr; const long t = t0 + i; const float bsi = bs[i];
#pragma unroll
        for (int nt = 0; nt < 8; ++nt) { const int d = 16 * nt + 4 * fq; f32x4 uu = ld_bf4(P + (size_t)t * PW + C_SU + g * 128 + d);
#pragma unroll
            for (int e = 0; e < 4; ++e) uu[e] = geluf_(uu[e]) * (acc[nt][e] + bsi);
            st_bf4(Y + (size_t)t * 4 * W + 2 * W + g * 128 + d, uu); }
        SYNCTHREADS();
    }
}
__device__ __forceinline__ void ph_rw_shift(const Ctx& c, int l) {
    const bf16_t* P = WSH(O_P); const float* mup = c.in[18] + (size_t)l * RF; const float* mun = c.in[19] + (size_t)l * RF; bf16_t* FS = WSH(O_FS);
    const int lane = threadIdx.x & 63, gw = blockIdx.x * (NT / 64) + (threadIdx.x >> 6), ngw = gridDim.x * (NT / 64);
    for (int t = gw; t < T; t += ngw) {
        const int sI = t % S; const bf16_t* pc = P + (size_t)t * PW + C_RW;
#pragma unroll 2
        for (int j = lane * 4; j < RF; j += 256) {
            const f32x4 f = ld_bf4(pc + j), z4 = (f32x4){0.f, 0.f, 0.f, 0.f}; const f32x4 pv = sI > 0 ? ld_bf4(pc - PW + j) : z4, nv = sI < S - 1 ? ld_bf4(pc + PW + j) : z4;
            f32x4 v = f + *(const f32x4*)(mup + j) * (pv - f) + *(const f32x4*)(mun + j) * (nv - f);
            if (j >= 3072 && j < 3200) {
#pragma unroll
                for (int e = 0; e < 4; ++e) v[e] = tanhf_(v[e]); }
            else if (j >= 3328) {
#pragma unroll
                for (int e = 0; e < 4; ++e) v[e] = sigmoidf_(v[e]); }
            st_bf4(FS + (size_t)t * RF + j, v);
        }
    }
}
__device__ __forceinline__ void ph_rw_lora(const Ctx& c, int l, float* ldsf) {
    const bf16_t* FS = WSH(O_FS); const float* w0 = c.in[20] + (size_t)l * 2 * W; const float* a0 = c.in[22] + (size_t)l * 2 * W;
    const bf16_t* WUT = WSH(O_WUT); const bf16_t* WAT = WSH(O_WAT); const bf16_t* WGT = WSH(O_WGT);
    float* DEC = WSF(O_DEC); float* AA = WSF(O_AA); float* GG = WSF(O_GG);
    bf16_t* F = (bf16_t*)ldsf; bf16_t* B1 = F + 128 * 136; bf16_t* B2 = B1 + 128 * 136; const int tid = threadIdx.x, wv = tid >> 6, lane = tid & 63, fr = lane & 15, fq = lane >> 4;
    for (int u = blockIdx.x; u < (T / 128) * 8; u += gridDim.x) {
        const int wc0 = (u & 7) * 128; const long t0 = (long)(u >> 3) * 128;
        for (int rd = 0; rd < 3; ++rd) {
#pragma unroll
            for (int q = 0; q < 8; ++q) { const int id = tid + NT * q, r = id >> 5, c4 = (id & 31) * 4;
                const int col = rd < 2 ? (c4 < 64 ? 3072 + rd * 64 + c4 : 3200 + rd * 64 + (c4 - 64)) : 3328 + c4;
                *(unsigned long long*)(F + r * 136 + c4) = *(const unsigned long long*)(FS + (size_t)(t0 + r) * RF + col); }
            if (rd < 2) {
#pragma unroll
                for (int q = 0; q < 2; ++q) { const int id = tid + NT * q, w = id >> 3, r8 = (id & 7) * 8;
                    *(u32x4*)(B1 + w * 72 + r8) = *(const u32x4*)(WUT + ((size_t)rd * W + wc0 + w) * 64 + r8); *(u32x4*)(B2 + w * 72 + r8) = *(const u32x4*)(WAT + ((size_t)rd * W + wc0 + w) * 64 + r8); }
            } else {
#pragma unroll
                for (int q = 0; q < 4; ++q) { const int id = tid + NT * q, w = id >> 4, r8 = (id & 15) * 8; *(u32x4*)(B1 + w * 136 + r8) = *(const u32x4*)(WGT + ((size_t)wc0 + w) * 128 + r8); }
            }
            SYNCTHREADS();
            f32x4 a1[8], a2[8];
#pragma unroll
            for (int nt = 0; nt < 8; ++nt) { a1[nt] = (f32x4){0.f, 0.f, 0.f, 0.f}; a2[nt] = (f32x4){0.f, 0.f, 0.f, 0.f}; }
            const long t = t0 + wv * 16 + fr;
            if (rd < 2) {
                wave_mma<2, 8>(a1, F + wv * 16 * 136, 136, B1, 72);
                wave_mma<2, 8>(a2, F + wv * 16 * 136 + 64, 136, B2, 72);
#pragma unroll
                for (int nt = 0; nt < 8; ++nt) { const int ch = wc0 + 16 * nt + 4 * fq; const f32x4 w0v = *(const f32x4*)(w0 + rd * W + ch), a0v = *(const f32x4*)(a0 + rd * W + ch); f32x4 dv, av;
#pragma unroll
                    for (int e = 0; e < 4; ++e) { dv[e] = fexp_(-DECAY_SCALE * sigmoidf_(a1[nt][e] + w0v[e])); av[e] = sigmoidf_(a2[nt][e] + a0v[e]); }
                    *(f32x4*)(DEC + ((size_t)rd * T + t) * W + ch) = dv; *(f32x4*)(AA + ((size_t)rd * T + t) * W + ch) = av; }
            } else {
                wave_mma<4, 8>(a1, F + wv * 16 * 136, 136, B1, 136);
#pragma unroll
                for (int nt = 0; nt < 8; ++nt) *(f32x4*)(GG + (size_t)t * W + wc0 + 16 * nt + 4 * fq) = a1[nt];
            }
            SYNCTHREADS();
        }
    }
}
#ifdef CPU_EMU
__device__ __forceinline__ float red16_(float x) { x += SHFL_XOR(x, 1); x += SHFL_XOR(x, 2); x += SHFL_XOR(x, 4); x += SHFL_XOR(x, 8); return x; }
#define LDS_BARRIER() emu_syncthreads()
#else
__device__ __forceinline__ float red16_(float x) {
    x += __builtin_bit_cast(float, __builtin_amdgcn_update_dpp(0, __builtin_bit_cast(int, x), 0xB1, 0xF, 0xF, true));
    x += __builtin_bit_cast(float, __builtin_amdgcn_update_dpp(0, __builtin_bit_cast(int, x), 0x4E, 0xF, 0xF, true));
    x += __builtin_bit_cast(float, __builtin_amdgcn_update_dpp(0, __builtin_bit_cast(int, x), 0x141, 0xF, 0xF, true));
    x += __builtin_bit_cast(float, __builtin_amdgcn_update_dpp(0, __builtin_bit_cast(int, x), 0x140, 0xF, 0xF, true));
    return x;
}
#define LDS_BARRIER() do { asm volatile("s_waitcnt lgkmcnt(0)" ::: "memory"); __builtin_amdgcn_s_barrier(); asm volatile("" ::: "memory"); } while (0)
#endif
#define RC_M(k) (lm + (k) * 4608)
__device__ __forceinline__ void ph_rw_chunk(const Ctx& c, int l, float* ldsf) {
    const bf16_t* FS = WSH(O_FS); const float* DEC = WSF(O_DEC); const float* AA = WSF(O_AA); float* BON = WSF(O_BON);
    const float* kkw = c.in[25] + (size_t)l * W; const float* kaw = c.in[26] + (size_t)l * W; const float* rk = c.in[27] + (size_t)l * W;
    bf16_t* PST = WSH(O_PST); bf16_t* PYT = WSH(O_PYT); float* SVB = WSF(O_SVB); float* YVB = WSF(O_YVB);
    bf16_t* lm = (bf16_t*)ldsf; float* gam = (float*)RC_M(7); float* segp = (float*)RC_M(13); float* gl = segp + 512;
    const int tid = threadIdx.x, wv = tid >> 6, lane = tid & 63, fr = lane & 15, fq = lane >> 4, rt = wv & 3, hf = wv >> 2;
    const int m0 = 16 * rt + fr;
    float wv8[8], kv8[8], rv8[8], vv8[8], aa8[8];
#define RC_LOAD(uu) do { const int chain_ = (uu) / NRC, ck_ = (uu) % NRC, h_ = chain_ & 15, b_ = (chain_ >> 4) & 1, z_ = chain_ >> 5; \
        const long tb_ = (long)b_ * S + (z_ ? S - 1 - ck_ * RCK : ck_ * RCK); const int dirn_ = z_ ? -1 : 1; \
        const float* decp_ = DEC + ((size_t)z_ * T) * W + h_ * 64; const float* aap_ = AA + ((size_t)z_ * T) * W + h_ * 64; const int ch_ = h_ * 64 + lane; \
        _Pragma("unroll") for (int q = 0; q < 8; ++q) wv8[q] = decp_[(size_t)(tb_ + dirn_ * ((tid >> 6) * 8 + q)) * W + (tid & 63)]; \
        _Pragma("unroll") for (int q = 0; q < 8; ++q) { const long t_ = tb_ + dirn_ * (wv + 8 * q); const bf16_t* f_ = FS + (size_t)t_ * RF; kv8[q] = bf2f(f_[1024 + ch_]); rv8[q] = bf2f(f_[ch_]); vv8[q] = bf2f(f_[2048 + ch_]); aa8[q] = aap_[(size_t)t_ * W + lane]; } } while (0)
    if ((int)blockIdx.x < 64 * NRC) RC_LOAD((int)blockIdx.x);
    for (int u = blockIdx.x; u < 64 * NRC; u += gridDim.x) {
        const int chain = u / NRC, ck = u % NRC, h = chain & 15, b = (chain >> 4) & 1, z = chain >> 5;
        const long tb = (long)b * S + (z ? S - 1 - ck * RCK : ck * RCK); const int dirn = z ? -1 : 1;
        { const int k = tid & 63, sg = tid >> 6; float p = 1.f;
#pragma unroll
          for (int q = 0; q < 8; ++q) { p *= wv8[q]; gam[(sg * 8 + q) * 64 + k] = p; }
          segp[sg * 64 + k] = p; }
        LDS_BARRIER();
        { const int k = tid & 63, sg = tid >> 6; float pre = 1.f;
          for (int q = 0; q < sg; ++q) pre *= segp[q * 64 + k];
#pragma unroll
          for (int q = 0; q < 8; ++q) gam[(sg * 8 + q) * 64 + k] *= pre;
          if (sg == 7) gl[k] = gam[63 * 64 + k]; }
        LDS_BARRIER();
        { const int k = lane, ch = h * 64 + k; const float kkwv = kkw[ch], kav = kaw[ch], rkv = rk[ch];
#pragma unroll
          for (int q = 0; q < 8; ++q) { const int tt = wv + 8 * q; const long t = tb + dirn * tt;
            const float vk = kv8[q] * kkwv; const float kkn = vk * frsq_(wave_sum(vk * vk) + EPS); const float ktv = kv8[q] * (1.f + (aa8[q] - 1.f) * kav);
            const float bsum = wave_sum(rv8[q] * rkv * ktv); if (lane == 0) BON[((size_t)z * T + t) * 16 + h] = bsum;
            const float g = gam[tt * 64 + k], gp = tt ? gam[(tt - 1) * 64 + k] : 1.f, ig = frcp_(g);
            const bf16_t khv = (bf16_t)f2bf(kkn * gp), bhv = (bf16_t)f2bf(aa8[q] * kkn * ig);
            RC_M(0)[tt * 72 + k] = khv; RC_M(1)[k * 72 + tt] = khv; RC_M(2)[tt * 72 + k] = bhv; RC_M(3)[k * 72 + tt] = bhv;
            RC_M(4)[tt * 72 + k] = (bf16_t)f2bf(ktv * ig); RC_M(5)[tt * 72 + k] = (bf16_t)f2bf(rv8[q] * g); RC_M(6)[k * 72 + tt] = (bf16_t)f2bf(vv8[q]); } }
        if (u + (int)gridDim.x < 64 * NRC) RC_LOAD(u + (int)gridDim.x);
        LDS_BARRIER();
        f32x4 mkr[2], khr[2], rhT[2];
        {
            f32x4 a0[2], a1[2], a2[2], a3[2];
#pragma unroll
            for (int nt = 0; nt < 2; ++nt) { a0[nt] = (f32x4){0.f, 0.f, 0.f, 0.f}; a1[nt] = a0[nt]; a2[nt] = a0[nt]; a3[nt] = a0[nt]; }
            wave_mma<2, 2>(a0, RC_M(2) + rt * 16 * 72, 72, RC_M(0) + hf * 32 * 72, 72);
            wave_mma<2, 2>(a1, RC_M(4) + rt * 16 * 72, 72, RC_M(0) + hf * 32 * 72, 72);
            wave_mma<2, 2>(a2, RC_M(2) + rt * 16 * 72, 72, RC_M(5) + hf * 32 * 72, 72);
            wave_mma<2, 2>(a3, RC_M(4) + rt * 16 * 72, 72, RC_M(5) + hf * 32 * 72, 72);
#pragma unroll
            for (int nt = 0; nt < 2; ++nt) { const int n0 = 32 * hf + 16 * nt + 4 * fq; f32x4 nn, ti, mk;
#pragma unroll
                for (int r = 0; r < 4; ++r) { const int n = n0 + r; const bool lt = m0 < n, le = m0 <= n;
                    nn[r] = lt ? -a0[nt][r] : 0.f; ti[r] = nn[r] + (m0 == n ? 1.f : 0.f); mk[r] = lt ? a1[nt][r] : 0.f; mkr[nt][r] = le ? a3[nt][r] : 0.f;
                    RC_M(12)[n * 72 + m0] = (bf16_t)f2bf(le ? a2[nt][r] : 0.f);
                    RC_M(8)[n * 72 + m0] = (bf16_t)f2bf(nn[r]);
                    khr[nt][r] = bf2f(RC_M(4)[m0 * 72 + n]); rhT[nt][r] = bf2f(RC_M(5)[n * 72 + m0]); }
                st_bf4(RC_M(7) + m0 * 72 + n0, nn); st_bf4(RC_M(9) + m0 * 72 + n0, ti); st_bf4(RC_M(11) + m0 * 72 + n0, mk); }
        }
        LDS_BARRIER();
        f32x4 tiv[2];
#pragma unroll
        for (int nt = 0; nt < 2; ++nt) tiv[nt] = ld_bf4(RC_M(9) + m0 * 72 + 32 * hf + 16 * nt + 4 * fq);
#pragma unroll 1
        for (int it = 0; it < 5; ++it) {
            bf16_t* pw = (it & 1) ? RC_M(0) : RC_M(7); bf16_t* pwT = (it & 1) ? RC_M(2) : RC_M(8); bf16_t* pw2 = (it & 1) ? RC_M(7) : RC_M(0); bf16_t* pw2T = (it & 1) ? RC_M(8) : RC_M(2);
            bf16_t* tcur = (it & 1) ? RC_M(4) : RC_M(9); bf16_t* tnxt = (it & 1) ? RC_M(9) : RC_M(4);
            f32x4 sq[2];
#pragma unroll
            for (int nt = 0; nt < 2; ++nt) sq[nt] = (f32x4){0.f, 0.f, 0.f, 0.f};
            wave_mma<2, 2>(sq, pw + rt * 16 * 72, 72, pwT + hf * 32 * 72, 72);
#pragma unroll
            for (int nt = 0; nt < 2; ++nt) { const int n0 = 32 * hf + 16 * nt + 4 * fq; st_bf4(pw2 + m0 * 72 + n0, sq[nt]);
#pragma unroll
                for (int r = 0; r < 4; ++r) pw2T[(n0 + r) * 72 + m0] = (bf16_t)f2bf(sq[nt][r]); }
            LDS_BARRIER();
            f32x4 up[2];
#pragma unroll
            for (int nt = 0; nt < 2; ++nt) up[nt] = (f32x4){0.f, 0.f, 0.f, 0.f};
            wave_mma<2, 2>(up, tcur + rt * 16 * 72, 72, pw2T + hf * 32 * 72, 72);
#pragma unroll
            for (int nt = 0; nt < 2; ++nt) { const int n0 = 32 * hf + 16 * nt + 4 * fq; tiv[nt] += up[nt]; st_bf4(tnxt + m0 * 72 + n0, tiv[nt]);
                if (it == 4) {
#pragma unroll
                    for (int r = 0; r < 4; ++r) RC_M(10)[(n0 + r) * 72 + m0] = (bf16_t)f2bf(tiv[nt][r]); } }
            LDS_BARRIER();
        }
        {
            f32x4 w1[2], w2[2];
#pragma unroll
            for (int nt = 0; nt < 2; ++nt) { w1[nt] = (f32x4){0.f, 0.f, 0.f, 0.f}; w2[nt] = w1[nt]; }
            wave_mma<2, 2>(w1, RC_M(1) + rt * 16 * 72, 72, RC_M(10) + hf * 32 * 72, 72);
            wave_mma<2, 2>(w2, RC_M(11) + rt * 16 * 72, 72, RC_M(10) + hf * 32 * 72, 72);
#pragma unroll
            for (int nt = 0; nt < 2; ++nt) { const int n0 = 32 * hf + 16 * nt + 4 * fq; st_bf4(RC_M(7) + m0 * 72 + n0, w1[nt]); st_bf4(RC_M(8) + m0 * 72 + n0, w2[nt]); }
        }
        LDS_BARRIER();
        {
            f32x4 py[2], qy[2], ps[2], qs[2];
#pragma unroll
            for (int nt = 0; nt < 2; ++nt) { py[nt] = (f32x4){0.f, 0.f, 0.f, 0.f}; qy[nt] = py[nt]; ps[nt] = py[nt]; qs[nt] = py[nt]; }
            wave_mma<2, 2>(py, RC_M(7) + rt * 16 * 72, 72, RC_M(12) + hf * 32 * 72, 72);
            wave_mma<2, 2>(qy, RC_M(8) + rt * 16 * 72, 72, RC_M(12) + hf * 32 * 72, 72);
            wave_mma<2, 2>(ps, RC_M(7) + rt * 16 * 72, 72, RC_M(3) + hf * 32 * 72, 72);
            wave_mma<2, 2>(qs, RC_M(8) + rt * 16 * 72, 72, RC_M(3) + hf * 32 * 72, 72);
#pragma unroll
            for (int nt = 0; nt < 2; ++nt) { const int n0 = 32 * hf + 16 * nt + 4 * fq;
#pragma unroll
                for (int r = 0; r < 4; ++r) { const int n = n0 + r; const float gln = gl[n];
                    RC_M(0)[n * 72 + m0] = (bf16_t)f2bf(rhT[nt][r] - py[nt][r]); RC_M(2)[n * 72 + m0] = (bf16_t)f2bf(mkr[nt][r] - qy[nt][r]);
                    RC_M(4)[n * 72 + m0] = (bf16_t)f2bf(((m0 == n ? 1.f : 0.f) - ps[nt][r]) * gln); RC_M(5)[n * 72 + m0] = (bf16_t)f2bf((khr[nt][r] - qs[nt][r]) * gln); } }
        }
        LDS_BARRIER();
        {
            f32x4 yv[2], sv[2];
#pragma unroll
            for (int nt = 0; nt < 2; ++nt) { yv[nt] = (f32x4){0.f, 0.f, 0.f, 0.f}; sv[nt] = yv[nt]; }
            wave_mma<2, 2>(yv, RC_M(6) + rt * 16 * 72, 72, RC_M(2) + hf * 32 * 72, 72);
            wave_mma<2, 2>(sv, RC_M(6) + rt * 16 * 72, 72, RC_M(5) + hf * 32 * 72, 72);
#pragma unroll
            for (int nt = 0; nt < 2; ++nt) { const int n0 = 32 * hf + 16 * nt + 4 * fq; *(f32x4*)(YVB + (size_t)u * 4096 + m0 * 64 + n0) = yv[nt]; *(f32x4*)(SVB + (size_t)u * 4096 + m0 * 64 + n0) = sv[nt]; }
            { const int rr = tid >> 3, c8 = (tid & 7) * 8; *(u32x4*)(PYT + (size_t)u * 4096 + rr * 64 + c8) = *(const u32x4*)(RC_M(0) + rr * 72 + c8); *(u32x4*)(PST + (size_t)u * 4096 + rr * 64 + c8) = *(const u32x4*)(RC_M(4) + rr * 72 + c8); }
        }
        LDS_BARRIER();
    }
}
#undef RC_M
#undef RC_LOAD
__device__ __forceinline__ void ph_rw_seq(const Ctx& c, float* ldsf) {
    const bf16_t* PST = WSH(O_PST); const bf16_t* PYT = WSH(O_PYT); const float* SVB = WSF(O_SVB); const float* YVB = WSF(O_YVB); float* YY = WSF(O_YY);
    bf16_t* Sb = (bf16_t*)ldsf;
    bf16_t* Pm = Sb + 2 * 16 * 72;
    const int tid = threadIdx.x, wv = tid >> 6, lane = tid & 63, fr = lane & 15, fq = lane >> 4, isY = wv >> 2, nt0 = wv & 3;
    for (int u = blockIdx.x; u < 256; u += gridDim.x) {
        const int x = u & 7, jq = u >> 3, chain = x * 8 + (jq >> 2), qt = jq & 3, h = chain & 15, b = (chain >> 4) & 1, z = chain >> 5;
        const size_t ub = (size_t)chain * NRC;
        const int rr = tid >> 3, c8 = (tid & 7) * 8;
        constexpr int PD = NRC >= 8 ? 8 : 4;
        for (int i = tid; i < 2 * 16 * 72 / 2; i += NT) ((unsigned*)Sb)[i] = 0u;
        const int row = 16 * qt + fr, n0 = 16 * nt0 + 4 * fq; const float* addp = (isY ? YVB : SVB) + ub * 4096 + row * 64 + n0;
        const bf16_t* psp = PST + ub * 4096 + rr * 64 + c8; const bf16_t* pyp = PYT + ub * 4096 + rr * 64 + c8;
        u32x4 gps[PD], gpy[PD]; f32x4 add[PD];
#pragma unroll
        for (int j = 0; j < PD; ++j) { gps[j] = *(const u32x4*)(psp + (size_t)j * 4096); gpy[j] = *(const u32x4*)(pyp + (size_t)j * 4096); add[j] = *(const f32x4*)(addp + (size_t)j * 4096); }
        *(u32x4*)(Pm + (0 * 2 + 0) * 4608 + rr * 72 + c8) = gps[0]; *(u32x4*)(Pm + (0 * 2 + 1) * 4608 + rr * 72 + c8) = gpy[0];
        if (PD < NRC) { gps[0] = *(const u32x4*)(psp + (size_t)PD * 4096); gpy[0] = *(const u32x4*)(pyp + (size_t)PD * 4096); }
        SYNCTHREADS();
        for (int ck0 = 0; ck0 < NRC; ck0 += PD) {
#pragma unroll
            for (int j = 0; j < PD; ++j) {
                const int ck = ck0 + j, cur = j & 1, nxt = cur ^ 1;
                f32x4 acc[1]; acc[0] = (f32x4){0.f, 0.f, 0.f, 0.f};
                wave_mma<2, 1>(acc, Sb + cur * 16 * 72, 72, Pm + (cur * 2 + isY) * 4608 + nt0 * 16 * 72, 72);
                acc[0] += add[j];
                if (ck + PD < NRC) add[j] = *(const f32x4*)(addp + (size_t)(ck + PD) * 4096);
                if (isY) {
#pragma unroll
                    for (int r = 0; r < 4; ++r) { const int step = ck * RCK + n0 + r, sidx = z ? S - 1 - step : step; YY[((size_t)z * T + (size_t)b * S + sidx) * W + h * 64 + row] = acc[0][r]; }
                } else st_bf4(Sb + nxt * 16 * 72 + fr * 72 + n0, acc[0]);
                const int jn = (j + 1) % PD;
                if (ck + 1 < NRC) { *(u32x4*)(Pm + (nxt * 2 + 0) * 4608 + rr * 72 + c8) = gps[jn]; *(u32x4*)(Pm + (nxt * 2 + 1) * 4608 + rr * 72 + c8) = gpy[jn]; }
                if (ck + 1 + PD < NRC) { gps[jn] = *(const u32x4*)(psp + (size_t)(ck + 1 + PD) * 4096); gpy[jn] = *(const u32x4*)(pyp + (size_t)(ck + 1 + PD) * 4096); }
                LDS_BARRIER();
            }
        }
    }
}
__device__ __forceinline__ void ph_rw_out(const Ctx& c) {
    const bf16_t* FS = WSH(O_FS); const float* YY = WSF(O_YY); const float* BON = WSF(O_BON); const float* GG = WSF(O_GG); bf16_t* Y = WSH(O_YS);
    const int lane = threadIdx.x & 63, gw = blockIdx.x * (NT / 64) + (threadIdx.x >> 6), ngw = gridDim.x * (NT / 64);
    for (int i = gw; i < T * 4; i += ngw) {
        const int h0 = (i & 3) * 4; const long t = i >> 2; float y0[4], y1[4], gv[4], vv[4], bs[4];
#pragma unroll
        for (int q = 0; q < 4; ++q) { const int ch = (h0 + q) * 64 + lane; y0[q] = YY[(size_t)t * W + ch]; y1[q] = YY[((size_t)T + t) * W + ch]; gv[q] = GG[(size_t)t * W + ch]; vv[q] = bf2f(FS[(size_t)t * RF + 2048 + ch]);
            bs[q] = BON[(size_t)t * 16 + h0 + q] + BON[((size_t)T + t) * 16 + h0 + q]; }
#pragma unroll
        for (int q = 0; q < 4; ++q) { const int ch = (h0 + q) * 64 + lane;
            const float m0 = wave_sum(y0[q]) * (1.f / 64.f), m1 = wave_sum(y1[q]) * (1.f / 64.f); const float d0 = y0[q] - m0, d1 = y1[q] - m1;
            const float r0 = 1.f / sqrtf(wave_sum(d0 * d0) * (1.f / 64.f) + EPS), r1 = 1.f / sqrtf(wave_sum(d1 * d1) * (1.f / 64.f) + EPS);
            Y[(size_t)t * 4 * W + 3 * W + ch] = (bf16_t)f2bf((d0 * r0 + d1 * r1 + bs[q] * vv[q]) * gv[q]); }
    }
}
__device__ __forceinline__ void ph_router(const Ctx& c, int l, float* ldsf) {
    const float* H = WSF(O_HF); const bf16_t* WH = WSH(O_WRH); const bf16_t* WL = WSH(O_WRL); const float* bg = c.in[31] + (size_t)l * 4; const float* be = c.in[33] + (size_t)l * 32;
    int* EID = WSI(O_EID); float* EWT = WSF(O_EWT); int* cnt = CTLW(c) + CW_CNT + l * 64;
    const int tid = threadIdx.x, wv = tid >> 6, lane = tid & 63, fr = lane & 15, fq = lane >> 4, rt = wv & 1, kq = wv >> 1;
    float* part = ldsf;
    for (int u = blockIdx.x; u < T / 32; u += gridDim.x) {
        const long t0 = (long)u * 32; f32x4 acc[3];
#pragma unroll
        for (int nt = 0; nt < 3; ++nt) acc[nt] = (f32x4){0.f, 0.f, 0.f, 0.f};
#ifdef CPU_EMU
        for (int nt = 0; nt < 3; ++nt) for (int r = 0; r < 4; ++r) { const int n = 16 * nt + 4 * fq + r; float sacc = 0.f;
            for (int k = kq * 512; k < kq * 512 + 512; ++k) { const float hv = H[(size_t)(t0 + 16 * rt + fr) * D + k]; const float hh = bf2f((bf16_t)f2bf(hv)), hl = bf2f((bf16_t)f2bf(hv - hh));
                const float wh = bf2f(WH[(size_t)n * D + k]), wl = bf2f(WL[(size_t)n * D + k]); sacc += hh * wh + hl * wh + hh * wl; }
            acc[nt][r] = sacc; }
#else
        const float* hp = H + (size_t)(t0 + 16 * rt + fr) * D + kq * 512 + fq * 8;
#pragma unroll 4
        for (int ks = 0; ks < 16; ++ks) {
            const f32x4 h0 = *(const f32x4*)(hp + ks * 32), h1 = *(const f32x4*)(hp + ks * 32 + 4); bf16x8 ah, al;
#pragma unroll
            for (int e = 0; e < 4; ++e) { const unsigned b0 = f2bf(h0[e]), b1 = f2bf(h1[e]); ah[e] = (short)b0; ah[4 + e] = (short)b1; al[e] = (short)f2bf(h0[e] - u2f_(b0 << 16)); al[4 + e] = (short)f2bf(h1[e] - u2f_(b1 << 16)); }
#pragma unroll
            for (int nt = 0; nt < 3; ++nt) { const size_t wo = (size_t)(16 * nt + fr) * D + kq * 512 + ks * 32 + fq * 8; const bf16x8 bh = *(const bf16x8*)(WH + wo), bl = *(const bf16x8*)(WL + wo);
                acc[nt] = __builtin_amdgcn_mfma_f32_16x16x32_bf16(bh, ah, acc[nt], 0, 0, 0); acc[nt] = __builtin_amdgcn_mfma_f32_16x16x32_bf16(bh, al, acc[nt], 0, 0, 0); acc[nt] = __builtin_amdgcn_mfma_f32_16x16x32_bf16(bl, ah, acc[nt], 0, 0, 0); }
        }
#endif
#pragma unroll
        for (int nt = 0; nt < 3; ++nt) *(f32x4*)(part + (kq * 32 + 16 * rt + fr) * 48 + 16 * nt + 4 * fq) = acc[nt];
        SYNCTHREADS();
        if (tid < 32) { const long t = t0 + tid; float lg[36];
#pragma unroll
            for (int q = 0; q < 36; ++q) lg[q] = (part[(0 * 32 + tid) * 48 + q] + part[(1 * 32 + tid) * 48 + q]) + (part[(2 * 32 + tid) * 48 + q] + part[(3 * 32 + tid) * 48 + q]) + (q < 4 ? bg[q < 4 ? q : 0] : be[q >= 4 ? q - 4 : 0]);
            int gi = 0; float m = lg[0];
#pragma unroll
            for (int q = 1; q < 4; ++q) if (lg[q] > m) { m = lg[q]; gi = q; }
            float den = 0.f;
#pragma unroll
            for (int q = 0; q < 4; ++q) den += expf(lg[q] - m);
            const float gp = 1.f / den; float el[8];
#pragma unroll
            for (int q = 0; q < 8; ++q) el[q] = gi == 0 ? lg[4 + q] : gi == 1 ? lg[12 + q] : gi == 2 ? lg[20 + q] : lg[28 + q];
            int i1 = 0; float m1 = el[0];
#pragma unroll
            for (int q = 1; q < 8; ++q) if (el[q] > m1) { m1 = el[q]; i1 = q; }
            int i2 = -1; float m2 = 0.f;
#pragma unroll
            for (int q = 0; q < 8; ++q) if (q != i1 && (i2 < 0 || el[q] > m2)) { m2 = el[q]; i2 = q; }
            const float p2 = expf(m2 - m1);
            EID[t * 2] = gi * 8 + i1; EID[t * 2 + 1] = gi * 8 + i2; EWT[t * 2] = gp / (1.f + p2); EWT[t * 2 + 1] = gp * p2 / (1.f + p2);
            atomic_add_i(cnt + gi * 8 + i1, 1); atomic_add_i(cnt + gi * 8 + i2, 1);
        }
        SYNCTHREADS();
    }
}
__device__ __forceinline__ void ph_moe_plan(const Ctx& c, int l) {
    int* cnt = CTLW(c) + CW_CNT + l * 64; int* plan = CTLW(c) + CW_PLAN + l * 256;
    if (GT_ == 0) {
        int ps = 0, nb = 0;
        for (int e = 0; e < NE; ++e) { plan[e] = ps; const int nblk = (cnt[e] + 255) / 256; for (int q = 0; q < nblk; ++q) plan[64 + nb++] = e; ps += nblk * 256; }
        plan[32] = ps; plan[40] = nb;
    }
}
__device__ __forceinline__ void ph_moe_assign(const Ctx& c, int l) {
    const int* EID = WSI(O_EID); int* fill = CTLW(c) + CW_FILL + l * 64; const int* plan = CTLW(c) + CW_PLAN + l * 256; int* DEST = WSI(O_DEST);
    for (long i = GT_; i < (long)T * 2; i += GS_) { const int e = EID[i]; const int pos = atomic_add_i(fill + e, 1); DEST[i] = plan[e] + pos; }
}
__device__ __forceinline__ void ph_moe_gather(const Ctx& c) {
    const int* DEST = WSI(O_DEST); const u32x4* H = (const u32x4*)WSH(O_H); u32x4* XS = (u32x4*)WSH(O_XS);
    for (long i = GT_; i < (long)T * 2 * (D / 8); i += GS_) { const int q = (int)(i % (D / 8)); const long a = i / (D / 8); XS[(size_t)DEST[a] * (D / 8) + q] = H[(size_t)(a >> 1) * (D / 8) + q]; }
}
#ifndef CPU_EMU
#define XB_TMO      128
#define XB_XCNT(j)  (256  + 64 * (j))
#define XB_XSUB(j)  (1280 + 64 * (j))
#define XB_XGEN(j)  (2304 + 64 * (j))
#define XB_TOP      3328
#define XB_TOPGEN   3392
#define XCD_BAR_WORDS 3456
#define XB_SPIN_CAP (1u << 26)
#define LAS __attribute__((address_space(3)))
__device__ __forceinline__ unsigned xb_ld(unsigned* p)              { return __hip_atomic_load(p, __ATOMIC_RELAXED, __HIP_MEMORY_SCOPE_AGENT); }
__device__ __forceinline__ unsigned xb_add(unsigned* p, unsigned v) { return __hip_atomic_fetch_add(p, v, __ATOMIC_RELAXED, __HIP_MEMORY_SCOPE_AGENT); }
__device__ __forceinline__ unsigned xb_xcc_id() { return (unsigned)__builtin_amdgcn_s_getreg((3 << 11) | 20) & 0xFu; }
#define XB_SPIN(cond, bar) do { unsigned _sp = 0; while (cond) { __builtin_amdgcn_s_sleep(1); \
    if ((++_sp & 255u) == 0u) { if (xb_ld(&(bar)[XB_TMO])) break; if (_sp > XB_SPIN_CAP) { atomicAdd(&(bar)[XB_TMO], 1u); break; } } } } while (0)
struct XcdBarrier { unsigned* bar; unsigned x; volatile LAS unsigned* st; };
__device__ __forceinline__ XcdBarrier xcd_barrier_post(unsigned* bar, volatile LAS unsigned* st) {
    XcdBarrier b; b.bar = bar; b.x = xb_xcc_id(); b.st = st;
    if (threadIdx.x == 0) (void)xb_add(&bar[XB_XCNT(b.x)], 1u);
    return b;
}
__device__ __forceinline__ void xcd_barrier_complete(unsigned* bar, unsigned x, unsigned& nloc, unsigned& nx) {
    const unsigned G = gridDim.x * gridDim.y * gridDim.z;
    unsigned sum, cnt, mine, sp = 0u;
    for (;;) {
        sum = 0u; cnt = 0u; mine = 0u;
#pragma unroll
        for (unsigned j = 0; j < 16; ++j) { const unsigned cc = xb_ld(&bar[XB_XCNT(j)]); sum += cc; cnt += (cc > 0u) ? 1u : 0u; mine = (j == x) ? cc : mine; }
        if (sum == G) break;
        __builtin_amdgcn_s_sleep(1);
        if ((++sp & 255u) == 0u) { if (xb_ld(&bar[XB_TMO])) break; if (sp > XB_SPIN_CAP) { atomicAdd(&bar[XB_TMO], 1u); break; } }
    }
    nloc = mine > 0u ? mine : 1u; nx = cnt > 0u ? cnt : 1u;
}
__device__ __forceinline__ void xcd_barrier(const XcdBarrier& b) {
    asm volatile("s_waitcnt vmcnt(0)" ::: "memory");
    __syncthreads();
    if (threadIdx.x == 0) {
        unsigned* bar = b.bar;
        __builtin_amdgcn_s_waitcnt(0);
        unsigned nloc = b.st[0], nx = b.st[1];
        if (nloc == 0u) { xcd_barrier_complete(bar, b.x, nloc, nx); b.st[0] = nloc; b.st[1] = nx; }
        const unsigned old = xb_add(&bar[XB_XSUB(b.x)], 1u);
        const unsigned gen = old / nloc;
        if (old + 1u == (gen + 1u) * nloc) {
            __builtin_amdgcn_fence(__ATOMIC_RELEASE, "agent");
            asm volatile("s_waitcnt vmcnt(0)" ::: "memory");
            const unsigned og = xb_add(&bar[XB_TOP], 1u);
            const unsigned tg = og / nx;
            if (og + 1u == (tg + 1u) * nx) xb_add(&bar[XB_TOPGEN], 1u);
            else XB_SPIN(xb_ld(&bar[XB_TOPGEN]) == tg, bar);
            __builtin_amdgcn_fence(__ATOMIC_ACQUIRE, "agent");
            xb_add(&bar[XB_XGEN(b.x)], 1u);
            asm volatile("s_waitcnt vmcnt(0)" ::: "memory");
        } else {
            XB_SPIN(xb_ld(&bar[XB_XGEN(b.x)]) == gen, bar);
            __builtin_amdgcn_fence(__ATOMIC_ACQUIRE, "agent");
            asm volatile("s_waitcnt vmcnt(0)" ::: "memory");
        }
    }
    __syncthreads();
}
#endif

constexpr int LDS_BYTES = 147456;

__global__ void __launch_bounds__(NT, 2) fwd(Params p) {
#ifdef CPU_EMU
    unsigned char* lds = g_lds; float* ldsf = (float*)g_lds;
#else
    extern __shared__ __attribute__((aligned(16))) unsigned char lds[];
    float* ldsf = (float*)lds;
    volatile LAS unsigned* misc = (volatile LAS unsigned*)((LAS unsigned char*)lds + LDS_BYTES - 64);
    if (threadIdx.x == 0) { misc[0] = 0u; misc[1] = 0u; }
    __syncthreads();
    XcdBarrier bar = xcd_barrier_post((unsigned*)(p.ws + O_CTL) + CW_BAR, misc);
#endif
    Ctx c; c.in = p.in; c.out = p.out; c.ws = p.ws;
    const int lo = p.ph_lo, hi = p.ph_hi; int ph = 0;
    const int G = (int)gridDim.x, cwg = (int)blockIdx.x;
#ifdef CPU_EMU
#define GRID_BAR()
#else
#define GRID_BAR() xcd_barrier(bar)
#endif
#ifndef REPEAT_MASK
#define REPEAT_MASK 0
#endif
#ifndef TIME_PHASE
#define TIME_PHASE -1
#endif
#if TIME_PHASE >= 0 && !defined(CPU_EMU)
    unsigned long long tp0 = 0, tp1 = 0;
#define TP_BEGIN() do { if (ph == TIME_PHASE) tp0 = __builtin_amdgcn_s_memrealtime(); } while (0)
#define TP_END() do { if (ph == TIME_PHASE) tp1 = __builtin_amdgcn_s_memrealtime(); } while (0)
#else
#define TP_BEGIN()
#define TP_END()
#endif
#define PHASE(...) do { if (lo <= ph && ph < hi) { TP_BEGIN(); __VA_ARGS__; if (ph + 1 < hi) { GRID_BAR(); } TP_END(); } ++ph; } while (0)
#define PHASEG(grp, ...) do { if (lo <= ph && ph < hi) { TP_BEGIN(); if ((REPEAT_MASK >> (grp)) & 1) { __VA_ARGS__; GRID_BAR(); } __VA_ARGS__; if (ph + 1 < hi) { GRID_BAR(); } TP_END(); } ++ph; } while (0)
    PHASE(ph_mod(c, ldsf));
#define LAYER_BODY(l) do { const float* mod = WSF(O_MOD); \
        const float* xin = l == 0 ? c.in[0] : WSF(O_X1); float* xmid = WSF(O_X0); float* xout = WSF(O_X1); \
        const float* ml = mod + (size_t)l * NB * D6; \
        PHASEG(3, ph_convert(c, l, ldsf)); \
        PHASEG(0, { pg8::Gemm g{D, D, D}; pg8::StaticOrder so; so.init(T, PW, G, cwg, WSH(O_H), WSH(O_WIN), D, D); pg8::EpiBf16 E{WSH(O_P), PW}; pg8::gemm_phase(lds, g, so, E); \
            { const int nun_ = (T / 256) * (PW / 256), rem_ = nun_ % G; if (rem_ != 0 && cwg >= rem_) { SYNCTHREADS(); convert_big(c, l, ldsf, J_ALL - convert_tail_tiles(), J_ALL, cwg - rem_, G - rem_); } } }); \
        PHASE(ph_lru<1>(c, l, ldsf); ph_ret_kv(c, ldsf); ph_sgu_norm(c, l); ph_rw_shift(c, l)); \
        PHASE(ph_lru_scan2(c); ph_ret_state(c); ph_sgu_mix(c, l, ldsf); ph_rw_lora(c, l, ldsf)); \
        PHASE(ph_lru<2>(c, l, ldsf); ph_ret_out(c, ldsf); ph_rw_chunk(c, l, ldsf)); \
        PHASE(ph_rw_seq(c, ldsf)); \
        PHASE(ph_rw_out(c)); \
        PHASEG(1, { pg8::Gemm g{W, 4 * W, 4 * W}; pg8::MergeOrder mo; mo.so.init(T, D, G, cwg, WSH(O_YS), WSH(O_WBR), 4 * W, 4 * W); mo.kseg_bytes = W * 2; pg8::EpiMerge E{WSH(O_P), WSH(O_MRG)}; pg8::gemm_phase(lds, g, mo, E); }); \
        PHASEG(1, { pg8::Gemm g{D, D, D}; pg8::StaticOrder so; so.init(T, D, G, cwg, WSH(O_MRG), WSH(O_WOUT), D, D); pg8::EpiResid E{xin, ml + 2 * D, xmid}; pg8::gemm_phase(lds, g, so, E); }); \
        PHASEG(6, ph_norm(c, xmid, c.in[4] + (size_t)l * D, ml + 3 * D, ml + 4 * D, WSH(O_H), WSF(O_HF))); \
        PHASE(ph_router(c, l, ldsf)); \
        PHASE(ph_moe_plan(c, l)); \
        PHASE(ph_moe_assign(c, l)); \
        PHASEG(6, ph_moe_gather(c)); \
        const int* plan = CTLW(c) + CW_PLAN + l * 256; \
        PHASEG(2, { pg8::Gemm g{D, D, D}; pg8::MoeOrder mo{G, cwg, 4, plan, (const char*)WSH(O_XS), (const char*)WSH(O_WGU), (size_t)256 * D * 2, (size_t)256 * D * 2, (size_t)1024 * D * 2}; pg8::EpiGU E{WSH(O_ACT)}; pg8::gemm_phase(lds, g, mo, E); }); \
        PHASEG(2, { pg8::Gemm g{512, 512, 512}; pg8::MoeOrder mo{G, cwg, 8, plan, (const char*)WSH(O_ACT), (const char*)WSH(O_WDN), (size_t)256 * 512 * 2, (size_t)256 * 512 * 2, (size_t)D * 512 * 2}; pg8::EpiBf16 E{WSH(O_YE), D}; pg8::gemm_phase(lds, g, mo, E); }); \
        if (l == 0) PHASE(ph_comb_norm<0>(c, xmid, ml + 5 * D, xout, c.in[3] + (size_t)1 * D, mod + (size_t)1 * NB * D6 + 0 * D, mod + (size_t)1 * NB * D6 + 1 * D, WSH(O_H), nullptr)); \
        else PHASE(ph_comb_norm<1>(c, xmid, ml + 5 * D, xout, c.in[36], nullptr, nullptr, nullptr, c.out)); \
    } while (0)
    PHASE(ph_norm(c, c.in[0], c.in[3], WSF(O_MOD) + 0 * D, WSF(O_MOD) + 1 * D, WSH(O_H), nullptr));
    LAYER_BODY(0);
    LAYER_BODY(1);
#undef LAYER_BODY
#if TIME_PHASE >= 0 && !defined(CPU_EMU)
    if (blockIdx.x == 0) { const unsigned long long te = __builtin_amdgcn_s_memrealtime(), dl = 8ull * (tp1 - tp0); while (__builtin_amdgcn_s_memrealtime() - te < dl) __builtin_amdgcn_s_sleep(8); }
#endif
#undef PHASE
}
}

#ifndef CPU_EMU
extern "C" void kernel_launch(void* const* d_in, const int* in_sizes, int n_in, void* d_out, int out_size, void* d_ws, size_t ws_size, hipStream_t stream) {
    static int grid = 0;
    if (grid == 0) {
        if (n_in != 37 || out_size != T * D || ws_size < WS_END) { fprintf(stderr, "kernel_launch: unexpected shapes (n_in %d out %d ws %zu need %zu)\n", n_in, out_size, ws_size, (size_t)WS_END); grid = -1; return; }
        int dev = 0, cus = 0, per_cu = 0;
        if (hipGetDevice(&dev) != hipSuccess || hipDeviceGetAttribute(&cus, hipDeviceAttributeMultiprocessorCount, dev) != hipSuccess) { grid = -1; return; }
        if (hipFuncSetAttribute((const void*)fwd, hipFuncAttributeMaxDynamicSharedMemorySize, LDS_BYTES) != hipSuccess) { fprintf(stderr, "kernel_launch: hipFuncSetAttribute failed\n"); grid = -1; return; }
        if (hipOccupancyMaxActiveBlocksPerMultiprocessor(&per_cu, (const void*)fwd, NT, LDS_BYTES) != hipSuccess || per_cu < 1) fprintf(stderr, "kernel_launch: occupancy query says %d\n", per_cu);
        (void)hipGetLastError();
        grid = cus;
    }
    if (grid < 0) return;
    (void)in_sizes;
    (void)hipMemsetAsync((char*)d_ws + O_CTL, 0, CTL_BYTES, stream);
    Params p{};
    for (int i = 0; i < 37; ++i) p.in[i] = (const float*)d_in[i];
    p.out = (float*)d_out; p.ws = (unsigned char*)d_ws;
#if ONE_LAUNCH
    p.ph_lo = 0; p.ph_hi = NPH;
    hipLaunchKernelGGL(fwd, dim3(grid), dim3(NT), LDS_BYTES, stream, p);
#else
    for (int k = 0; k < NPH; ++k) { p.ph_lo = k; p.ph_hi = k + 1; hipLaunchKernelGGL(fwd, dim3(grid), dim3(NT), LDS_BYTES, stream, p); }
#endif
}
#endif
```

```cpp
#ifndef CPU_EMU
#include <hip/hip_runtime.h>
#endif
#include <cstdio>
#include <cstdint>
#include <cmath>
#include <cstring>

#ifndef SEQ
#define SEQ 4096
#endif
#ifndef ONE_LAUNCH
#define ONE_LAUNCH 1
#endif

namespace {
constexpr int D = 2048, NB = 2, S = SEQ, T = NB * S, NL = 2, W = 1024;
constexpr int INW = 18816, RF = 3456, D6 = 6 * D;
constexpr int C_LX = 0, C_LG = 1024, C_RQ = 2048, C_RK = 2560, C_RV = 3072, C_RG = 4096, C_SU = 5120, C_SV = 6144, C_RW = 7168;
constexpr int PW = 18944, C_MLP = 10752;
constexpr int NCH = S / 128;
constexpr int NLC = S / 64;
constexpr int NE = 32, CAP = (T * 2 / 256 + NE) * 256, MAXBLK = CAP / 256;
constexpr float EPS = 1e-6f;
constexpr float DECAY_SCALE = 0.60653065971263342f;
constexpr int NT = 512;
constexpr int NPH_LAYER = 17, NPH = 2 + NL * NPH_LAYER;
typedef unsigned short bf16_t;
#ifdef CPU_EMU
typedef float f32x4 __attribute__((vector_size(16)));
typedef unsigned u32x4 __attribute__((vector_size(16)));
#else
typedef float f32x4 __attribute__((ext_vector_type(4)));
typedef unsigned u32x4 __attribute__((ext_vector_type(4)));
typedef short bf16x8 __attribute__((ext_vector_type(8)));
#endif

constexpr size_t al256(size_t x) { return (x + 255) & ~(size_t)255; }
constexpr size_t SZ_X = (size_t)T * D * 4, SZ_W = (size_t)T * W * 4;
constexpr size_t O_CTL = 0, CTL_BYTES = 1u << 20;
constexpr size_t O_MOD = CTL_BYTES;
constexpr size_t O_X0 = O_MOD + al256((size_t)NL * NB * D6 * 4);
constexpr size_t O_X1 = O_X0 + SZ_X;
constexpr size_t O_H = O_X1 + SZ_X;
constexpr size_t O_HF = O_H + SZ_X / 2;
constexpr size_t O_P = O_HF + SZ_X;
constexpr size_t SZ_P = (size_t)T * PW * 2;
constexpr size_t O_XC = O_P + SZ_P;
constexpr size_t O_LA = O_XC + SZ_W, O_LU = O_LA + 2 * SZ_W;
constexpr size_t SZ_LC = (size_t)2 * NB * NLC * W * 4;
constexpr size_t O_LCA = O_LU + 2 * SZ_W, O_LCH = O_LCA + SZ_LC, O_LCI = O_LCH + SZ_LC;
constexpr size_t O_YS = O_LCI + SZ_LC;
constexpr size_t O_SC = O_YS + (size_t)T * 4 * W * 2;
constexpr size_t SZ_KV = (size_t)NB * NCH * 8 * 64 * 128 * 4;
constexpr size_t O_KVF = O_SC, O_KVB = O_KVF + SZ_KV, O_STF = O_KVB + SZ_KV, O_STB = O_STF + SZ_KV;
constexpr size_t O_VN = O_STB + SZ_KV;
constexpr size_t O_FS = O_VN + SZ_W;
constexpr size_t O_DEC = O_FS + al256((size_t)T * RF * 4), O_AA = O_DEC + 2 * SZ_W, O_AKK = O_AA + 2 * SZ_W;
constexpr size_t O_GG = O_AKK, O_YY = O_GG + SZ_W;
constexpr int RCK = 64, NRC = S / RCK;
constexpr size_t O_BON = O_YY + 2 * SZ_W;
constexpr size_t O_PART = O_BON + al256((size_t)2 * T * 16 * 4);
constexpr size_t O_MRG = O_PART + SZ_X;
constexpr size_t O_LOG = O_MRG + SZ_X / 2;
constexpr size_t O_EID = O_LOG + al256((size_t)T * 40 * 4), O_EWT = O_EID + al256((size_t)T * 2 * 4), O_DEST = O_EWT + al256((size_t)T * 2 * 4);
constexpr size_t O_SLOT = O_DEST + al256((size_t)T * 2 * 4);
constexpr size_t O_PST = O_SLOT + al256((size_t)CAP * 4), O_PYT = O_PST + (size_t)64 * NRC * 4096 * 2, O_SVB = O_PYT + (size_t)64 * NRC * 4096 * 2, O_YVB = O_SVB + (size_t)64 * NRC * 4096 * 4;
constexpr size_t O_WIN = O_YVB + (size_t)64 * NRC * 4096 * 4;
constexpr size_t O_WBR = O_WIN + (size_t)PW * D * 2;
constexpr size_t O_WOUT = O_WBR + (size_t)D * 4 * W * 2;
constexpr size_t O_WGU = O_WOUT + (size_t)D * D * 2;
constexpr size_t O_WDN = O_WGU + (size_t)NE * 1024 * D * 2;
constexpr size_t O_WLR = O_WDN + (size_t)NE * D * 512 * 2;
constexpr size_t O_WUT = O_WLR + (size_t)32 * 128 * 128 * 2;
constexpr size_t O_WAT = O_WUT + (size_t)2 * W * 64 * 2;
constexpr size_t O_WGT = O_WAT + (size_t)2 * W * 64 * 2;
constexpr size_t O_WRH = O_WGT + (size_t)W * 128 * 2;
constexpr size_t O_WRL = O_WRH + (size_t)48 * D * 2;
constexpr size_t WS_END0 = O_WRL + (size_t)48 * D * 2;
constexpr size_t SZ_MOE = (size_t)CAP * (D + 512 + D) * 2;
constexpr bool MOE_OVERLAY = SZ_MOE <= SZ_P;
constexpr size_t O_XS = MOE_OVERLAY ? O_P : WS_END0;
constexpr size_t O_ACT = O_XS + (size_t)CAP * D * 2;
constexpr size_t O_YE = O_ACT + (size_t)CAP * 512 * 2;
constexpr size_t WS_END = MOE_OVERLAY ? WS_END0 : WS_END0 + SZ_MOE;
static_assert(SEQ != 4096 || WS_END <= (size_t)2040 * 1024 * 1024, "workspace budget: d_ws is 4 x the largest input = 2048 MiB");
constexpr int CW_BAR = 4096;
constexpr int CW_CNT = 32768;
constexpr int CW_FILL = CW_CNT + NL * 64;
constexpr int CW_PLAN = CW_FILL + NL * 64;
static_assert(MAXBLK <= 160, "plan words");

struct Params { const float* in[37]; float* out; unsigned char* ws; int ph_lo, ph_hi; };

struct Ctx { const float* const* in; float* out; unsigned char* ws; };
#define GT_ ((long)blockIdx.x * NT + threadIdx.x)
#define GS_ ((long)gridDim.x * NT)
#define WSF(off) ((float*)(c.ws + (off)))
#define WSI(off) ((int*)(c.ws + (off)))
#define WSH(off) ((bf16_t*)(c.ws + (off)))
#define CTLW(c) ((int*)((c).ws + O_CTL))

#ifdef CPU_EMU
__device__ __forceinline__ float fexp_(float x) { return expf(x); }
__device__ __forceinline__ float frcp_(float x) { return 1.f / x; }
__device__ __forceinline__ float frsq_(float x) { return 1.f / sqrtf(x); }
#else
__device__ __forceinline__ float fexp_(float x) { return __builtin_amdgcn_exp2f(x * 1.4426950408889634f); }
__device__ __forceinline__ float frcp_(float x) { return __builtin_amdgcn_rcpf(x); }
__device__ __forceinline__ float frsq_(float x) { return __builtin_amdgcn_rsqf(x); }
#endif
__device__ __forceinline__ float sigmoidf_(float x) { return frcp_(1.f + fexp_(-x)); }
__device__ __forceinline__ float siluf_(float x) { return x * frcp_(1.f + fexp_(-x)); }
__device__ __forceinline__ float tanhf_(float x) { return 1.f - 2.f * frcp_(1.f + fexp_(2.f * x)); }
__device__ __forceinline__ float geluf_(float x) { return 0.5f * x * (1.f + tanhf_(0.7978845608028654f * (x + 0.044715f * x * x * x))); }
__device__ __forceinline__ float softplusf_(float x) { return x > 0.f ? x + log1pf(expf(-x)) : log1pf(expf(x)); }
__device__ __forceinline__ float loggamma_(int h) { return log1pf(-exp2f(-5.f - (float)h)); }
__device__ __forceinline__ unsigned f2u_(float f) { unsigned u; memcpy(&u, &f, 4); return u; }
__device__ __forceinline__ float u2f_(unsigned u) { float f; memcpy(&f, &u, 4); return f; }
__device__ __forceinline__ float bf2f(bf16_t v) { return u2f_((unsigned)v << 16); }
__device__ __forceinline__ unsigned f2bf(float f) { const unsigned u = f2u_(f); return (u + 0x7fffu + ((u >> 16) & 1u)) >> 16; }
__device__ __forceinline__ unsigned pk2(float lo, float hi) { return f2bf(lo) | (f2bf(hi) << 16); }
__device__ __forceinline__ float bflo(unsigned w) { return u2f_(w << 16); }
__device__ __forceinline__ float bfhi(unsigned w) { return u2f_(w & 0xffff0000u); }
__device__ __forceinline__ int atomic_add_i(int* p, int v) {
#ifdef CPU_EMU
    return __atomic_fetch_add(p, v, __ATOMIC_RELAXED);
#else
    return atomicAdd(p, v);
#endif
}
#define PF(P, r, col) bf2f((P)[(size_t)(r) * PW + (col)])
#ifdef CPU_EMU
#define SYNCTHREADS() emu_syncthreads()
#define SHFL_XOR(v, m) emu_shfl_xor(v, m)
#else
#define SYNCTHREADS() __syncthreads()
#define SHFL_XOR(v, m) __shfl_xor(v, m)
#endif
#ifdef CPU_EMU
__device__ __forceinline__ float wave_sum(float v) {
    for (int o = 1; o < 64; o <<= 1) v += SHFL_XOR(v, o);
    return v;
}
#else
__device__ __forceinline__ float wave_sum(float x) {
    x += __builtin_bit_cast(float, __builtin_amdgcn_update_dpp(0, __builtin_bit_cast(int, x), 0xB1, 0xF, 0xF, true));
    x += __builtin_bit_cast(float, __builtin_amdgcn_update_dpp(0, __builtin_bit_cast(int, x), 0x4E, 0xF, 0xF, true));
    x += __builtin_bit_cast(float, __builtin_amdgcn_update_dpp(0, __builtin_bit_cast(int, x), 0x141, 0xF, 0xF, true));
    x += __builtin_bit_cast(float, __builtin_amdgcn_update_dpp(0, __builtin_bit_cast(int, x), 0x140, 0xF, 0xF, true));
    const int xi = __builtin_bit_cast(int, x);
    return (__builtin_bit_cast(float, __builtin_amdgcn_readlane(xi, 0)) + __builtin_bit_cast(float, __builtin_amdgcn_readlane(xi, 16))) + (__builtin_bit_cast(float, __builtin_amdgcn_readlane(xi, 32)) + __builtin_bit_cast(float, __builtin_amdgcn_readlane(xi, 48)));
}
#endif
__device__ __forceinline__ f32x4 ld_bf4(const bf16_t* p) { const unsigned long long q = *(const unsigned long long*)p; const unsigned lo = (unsigned)q, hi = (unsigned)(q >> 32); return (f32x4){bflo(lo), bfhi(lo), bflo(hi), bfhi(hi)}; }
__device__ __forceinline__ void st_bf4(bf16_t* p, const f32x4 v) { *(unsigned long long*)p = (unsigned long long)pk2(v[0], v[1]) | ((unsigned long long)pk2(v[2], v[3]) << 32); }

template <int KT, int NTL>
__device__ __forceinline__ void wave_mma(f32x4 (&acc)[NTL], const bf16_t* A, int lda, const bf16_t* Bt, int ldb) {
    const int lane = threadIdx.x & 63, fr = lane & 15, fq = lane >> 4;
#ifdef CPU_EMU
    for (int nt = 0; nt < NTL; ++nt) for (int r = 0; r < 4; ++r) { float sacc = 0.f; const bf16_t* a = A + fr * lda; const bf16_t* b = Bt + (16 * nt + 4 * fq + r) * ldb;
        for (int k = 0; k < 32 * KT; ++k) sacc += bf2f(a[k]) * bf2f(b[k]);
        acc[nt][r] += sacc; }
#else
#pragma unroll
    for (int kt = 0; kt < KT; ++kt) {
        const bf16x8 af = *(const bf16x8*)(A + fr * lda + kt * 32 + fq * 8);
#pragma unroll
        for (int nt = 0; nt < NTL; ++nt) { const bf16x8 bfr = *(const bf16x8*)(Bt + (16 * nt + fr) * ldb + kt * 32 + fq * 8);
            acc[nt] = __builtin_amdgcn_mfma_f32_16x16x32_bf16(bfr, af, acc[nt], 0, 0, 0); }
    }
#endif
}
__device__ __forceinline__ void ph_mod(const Ctx& c, float* ldsf) {
    const float* cc = c.in[1]; const float* aw = c.in[5]; const float* ab = c.in[6]; float* mod = WSF(O_MOD);
    float* scs = ldsf; float* part = ldsf + NB * D; const int tid = threadIdx.x, c4 = (tid & 31) * 4, kq = tid >> 5;
    for (int i = tid; i < NB * D; i += NT) scs[i] = siluf_(cc[i]);
    SYNCTHREADS();
    for (int u = blockIdx.x; u < NL * (D6 / 128); u += gridDim.x) {
        const int l = u / (D6 / 128), j0 = (u % (D6 / 128)) * 128;
        const float* w = aw + (size_t)l * D * D6 + j0 + c4; f32x4 a0 = (f32x4){0.f, 0.f, 0.f, 0.f}, a1 = a0;
#pragma unroll 8
        for (int k = kq * 128; k < kq * 128 + 128; ++k) { const f32x4 wv = *(const f32x4*)(w + (size_t)k * D6); a0 += wv * scs[k]; a1 += wv * scs[D + k]; }
        *(f32x4*)(part + (kq * 2 + 0) * 128 + c4) = a0; *(f32x4*)(part + (kq * 2 + 1) * 128 + c4) = a1;
        SYNCTHREADS();
        if (tid < 256) { const int b = tid >> 7, col = tid & 127; float sacc = 0.f;
#pragma unroll
            for (int q = 0; q < 16; ++q) sacc += part[(q * 2 + b) * 128 + col];
            mod[((size_t)l * NB + b) * D6 + j0 + col] = sacc + ab[l * D6 + j0 + col]; }
        SYNCTHREADS();
    }
}
__device__ __forceinline__ void ph_norm(const Ctx& c, const float* x, const float* g, const float* sh, const float* sc, bf16_t* hb, float* hf) {
    const int lane = threadIdx.x & 63, gw = blockIdx.x * (NT / 64) + (threadIdx.x >> 6), ngw = gridDim.x * (NT / 64);
    for (int t0 = gw * 2; t0 < T; t0 += ngw * 2) {
        f32x4 v[2][8]; float ss[2] = {0.f, 0.f};
#pragma unroll
        for (int r = 0; r < 2; ++r)
#pragma unroll
            for (int j = 0; j < 8; ++j) v[r][j] = *(const f32x4*)(x + (size_t)(t0 + r) * D + (j * 64 + lane) * 4);
#pragma unroll
        for (int r = 0; r < 2; ++r) {
#pragma unroll
            for (int j = 0; j < 8; ++j) ss[r] += (v[r][j][0] * v[r][j][0] + v[r][j][1] * v[r][j][1]) + (v[r][j][2] * v[r][j][2] + v[r][j][3] * v[r][j][3]);
            const int t = t0 + r, b = t / S; const float rs = 1.f / sqrtf(wave_sum(ss[r]) * (1.f / D) + EPS);
#pragma unroll
            for (int j = 0; j < 8; ++j) { const int col = (j * 64 + lane) * 4;
                const f32x4 o = v[r][j] * rs * *(const f32x4*)(g + col) * (*(const f32x4*)(sc + b * D6 + col) + 1.f) + *(const f32x4*)(sh + b * D6 + col);
                st_bf4(hb + (size_t)t * D + col, o); if (hf) *(f32x4*)(hf + (size_t)t * D + col) = o; }
        }
    }
}
template <int MODE>
__device__ __forceinline__ void ph_comb_norm(const Ctx& c, const float* xmid, const float* g2, float* xout, const float* g, const float* sh, const float* sc, bf16_t* hb, float* outp) {
    const bf16_t* YE = WSH(O_YE); const float* EWT = WSF(O_EWT); const int* DEST = WSI(O_DEST);
    const int lane = threadIdx.x & 63, gw = blockIdx.x * (NT / 64) + (threadIdx.x >> 6), ngw = gridDim.x * (NT / 64);
    for (int t = gw; t < T; t += ngw) {
        const int b = t / S; const float w0 = EWT[t * 2], w1 = EWT[t * 2 + 1]; const bf16_t* y0 = YE + (size_t)DEST[t * 2] * D; const bf16_t* y1 = YE + (size_t)DEST[t * 2 + 1] * D;
        f32x4 v[8]; float ss = 0.f;
#pragma unroll
        for (int j = 0; j < 8; ++j) { const int col = (j * 64 + lane) * 4;
            v[j] = *(const f32x4*)(xmid + (size_t)t * D + col) + *(const f32x4*)(g2 + b * D6 + col) * (ld_bf4(y0 + col) * w0 + ld_bf4(y1 + col) * w1);
            if (MODE == 0) *(f32x4*)(xout + (size_t)t * D + col) = v[j];
            ss += (v[j][0] * v[j][0] + v[j][1] * v[j][1]) + (v[j][2] * v[j][2] + v[j][3] * v[j][3]); }
        const float rs = 1.f / sqrtf(wave_sum(ss) * (1.f / D) + EPS);
#pragma unroll
        for (int j = 0; j < 8; ++j) { const int col = (j * 64 + lane) * 4;
            if (MODE == 0) st_bf4(hb + (size_t)t * D + col, v[j] * rs * *(const f32x4*)(g + col) * (*(const f32x4*)(sc + b * D6 + col) + 1.f) + *(const f32x4*)(sh + b * D6 + col));
            else *(f32x4*)(outp + (size_t)t * D + col) = v[j] * rs * *(const f32x4*)(g + col); }
    }
}

struct CvtItem { const float* Wp; int ldw; bf16_t* WT; int ldt; int drow, k0, n0; };
constexpr int I_IN = 32 * (INW / 32), I_BR = 4 * 16 * 64, I_OUT = 32 * 64, I_GU = NE * 32 * 32, I_DN = NE * 8 * 64, I_LR = 32 * 8, I_WU = 2 * 32, I_WG = 64, I_BIG = I_IN + I_BR + I_OUT + I_GU + I_DN, I_ALL = I_BIG + I_LR + 2 * I_WU + I_WG;
__device__ __forceinline__ CvtItem cvt_decode(const Ctx& c, int l, int it) {
    CvtItem r;
    if (it < I_IN) { const int kb = it / (INW / 32), nb = it % (INW / 32); r.n0 = nb * 32; r.k0 = kb * 64; r.Wp = c.in[7] + (size_t)l * D * INW; r.ldw = INW; r.WT = WSH(O_WIN); r.ldt = D; r.drow = r.n0 < 10624 ? r.n0 : r.n0 + 128; return r; }
    it -= I_IN;
    if (it < I_BR) { const int sgm = it / 1024, q = it % 1024, kb = q / 64, nb = q % 64; r.n0 = nb * 32; r.k0 = kb * 64; r.Wp = c.in[28] + ((size_t)l * 4 + sgm) * W * D; r.ldw = D; r.WT = WSH(O_WBR) + sgm * W; r.ldt = 4 * W; r.drow = r.n0; return r; }
    it -= I_BR;
    if (it < I_OUT) { const int kb = it / 64, nb = it % 64; r.n0 = nb * 32; r.k0 = kb * 64; r.Wp = c.in[29] + (size_t)l * D * D; r.ldw = D; r.WT = WSH(O_WOUT); r.ldt = D; r.drow = r.n0; return r; }
    it -= I_OUT;
    if (it < I_GU) { const int e = it / 1024, q = it % 1024, kb = q / 32, nb = q % 32; r.n0 = nb * 32; r.k0 = kb * 64; r.Wp = c.in[34] + ((size_t)l * NE + e) * D * 1024; r.ldw = 1024; r.WT = WSH(O_WGU) + (size_t)e * 1024 * D; r.ldt = D;
        r.drow = r.n0 < 512 ? (r.n0 / 128) * 256 + (r.n0 % 128) : ((r.n0 - 512) / 128) * 256 + 128 + ((r.n0 - 512) % 128); return r; }
    it -= I_GU;
    if (it < I_DN) { const int e = it / 512, q = it % 512, kb = q / 64, nb = q % 64; r.n0 = nb * 32; r.k0 = kb * 64; r.Wp = c.in[35] + ((size_t)l * NE + e) * 512 * D; r.ldw = D; r.WT = WSH(O_WDN) + (size_t)e * D * 512; r.ldt = 512; r.drow = r.n0; return r; }
    it -= I_DN;
    if (it < I_LR) { const int m = it / 8, q = it % 8, kb = q / 4, nb = q % 4, z = m >> 4, ty = (m >> 3) & 1, n = m & 7; r.n0 = nb * 32; r.k0 = kb * 64; r.Wp = c.in[ty ? 12 : 10] + (((size_t)l * 2 + z) * 8 + n) * 128 * 128; r.ldw = 128;
        r.WT = WSH(O_WLR) + (size_t)m * 128 * 128; r.ldt = 128; r.drow = r.n0; return r; }
    it -= I_LR;
    if (it < 2 * I_WU) { const int ua = it / I_WU, q = it % I_WU, z = q / 32, nb = q % 32; r.n0 = nb * 32; r.k0 = 0; r.Wp = c.in[ua ? 23 : 21] + ((size_t)l * 2 + z) * 64 * W; r.ldw = W; r.WT = WSH(ua ? O_WAT : O_WUT) + (size_t)z * W * 64; r.ldt = 64; r.drow = r.n0; return r; }
    it -= 2 * I_WU;
    { const int kb = it / 32, nb = it % 32; r.n0 = nb * 32; r.k0 = kb * 64; r.Wp = c.in[24] + (size_t)l * 128 * W; r.ldw = W; r.WT = WSH(O_WGT); r.ldt = 128; r.drow = r.n0; return r; }
}
constexpr int J_IN = 16 * (INW / 128), J_BR = 4 * 8 * 16, J_OUT = 16 * 16, J_GU = NE * 16 * 8, J_DN = NE * 4 * 16, J_ALL = J_IN + J_BR + J_OUT + J_GU + J_DN;
__device__ __forceinline__ CvtItem cvt_decode_big(const Ctx& c, int l, int it) {
    CvtItem r;
    if (it < J_IN) { const int kb = it / (INW / 128), nb = it % (INW / 128); r.n0 = nb * 128; r.k0 = kb * 128; r.Wp = c.in[7] + (size_t)l * D * INW; r.ldw = INW; r.WT = WSH(O_WIN); r.ldt = D; r.drow = r.n0 < 10624 ? r.n0 : r.n0 + 128; return r; }
    it -= J_IN;
    if (it < J_BR) { const int sgm = it / 128, q = it % 128, kb = q / 16, nb = q % 16; r.n0 = nb * 128; r.k0 = kb * 128; r.Wp = c.in[28] + ((size_t)l * 4 + sgm) * W * D; r.ldw = D; r.WT = WSH(O_WBR) + sgm * W; r.ldt = 4 * W; r.drow = r.n0; return r; }
    it -= J_BR;
    if (it < J_OUT) { const int kb = it / 16, nb = it % 16; r.n0 = nb * 128; r.k0 = kb * 128; r.Wp = c.in[29] + (size_t)l * D * D; r.ldw = D; r.WT = WSH(O_WOUT); r.ldt = D; r.drow = r.n0; return r; }
    it -= J_OUT;
    if (it < J_GU) { const int e = it / 128, q = it % 128, kb = q / 8, nb = q % 8; r.n0 = nb * 128; r.k0 = kb * 128; r.Wp = c.in[34] + ((size_t)l * NE + e) * D * 1024; r.ldw = 1024; r.WT = WSH(O_WGU) + (size_t)e * 1024 * D; r.ldt = D;
        r.drow = r.n0 < 512 ? (r.n0 / 128) * 256 : ((r.n0 - 512) / 128) * 256 + 128; return r; }
    it -= J_GU;
    { const int e = it / 64, q = it % 64, kb = q / 16, nb = q % 16; r.n0 = nb * 128; r.k0 = kb * 128; r.Wp = c.in[35] + ((size_t)l * NE + e) * 512 * D; r.ldw = D; r.WT = WSH(O_WDN) + (size_t)e * D * 512; r.ldt = 512; r.drow = r.n0; return r; }
}
__device__ __forceinline__ void convert_big(const Ctx& c, int l, float* ldsf, int first, int last, int widx, int wcnt) {
    const int tid = threadIdx.x, lr = tid >> 5, lc = (tid & 31) * 4;
    f32x4 rg[8]; int it = first + widx; CvtItem r;
    if (it < last) { r = cvt_decode_big(c, l, it);
#pragma unroll
        for (int i = 0; i < 8; ++i) rg[i] = *(const f32x4*)(r.Wp + (size_t)(r.k0 + lr + 16 * i) * r.ldw + r.n0 + lc); }
    for (; it < last; it += wcnt) {
#pragma unroll
        for (int i = 0; i < 8; ++i) { float* dp = ldsf + (lr + 16 * i) * 129 + lc; dp[0] = rg[i][0]; dp[1] = rg[i][1]; dp[2] = rg[i][2]; dp[3] = rg[i][3]; }
        const CvtItem cur = r; const int nx = it + wcnt;
        if (nx < last) { r = cvt_decode_big(c, l, nx);
#pragma unroll
            for (int i = 0; i < 8; ++i) rg[i] = *(const f32x4*)(r.Wp + (size_t)(r.k0 + lr + 16 * i) * r.ldw + r.n0 + lc); }
        SYNCTHREADS();
#pragma unroll
        for (int q = 0; q < 4; ++q) { const int id = tid + NT * q, n = id >> 4, k8 = (id & 15) * 8; const float* sp = ldsf + k8 * 129 + n;
            u32x4 o; o[0] = pk2(sp[0 * 129], sp[1 * 129]); o[1] = pk2(sp[2 * 129], sp[3 * 129]); o[2] = pk2(sp[4 * 129], sp[5 * 129]); o[3] = pk2(sp[6 * 129], sp[7 * 129]);
            *(u32x4*)(cur.WT + (size_t)(cur.drow + n) * cur.ldt + cur.k0 + k8) = o; }
        SYNCTHREADS();
    }
}
__device__ __forceinline__ int convert_tail_tiles() { const int nun = (T / 256) * (PW / 256), G = (int)gridDim.x, rem = nun % G; return rem == 0 ? 0 : (G - rem) * 10 < J_GU + J_DN ? (G - rem) * 10 : J_GU + J_DN; }
__device__ __forceinline__ int convert_early_tiles(const Ctx& c) { const int G = (int)gridDim.x, nrest = (CTLW(c) + CW_PLAN)[40] * 4 - G; return (nrest >= 0 && nrest < G) ? ((G - nrest) * 12 < J_IN ? (G - nrest) * 12 : J_IN) : 0; }
__device__ __forceinline__ void ph_convert(const Ctx& c, int l, float* ldsf) {
    const int lane = threadIdx.x & 63, wave = threadIdx.x >> 6; const int gw = blockIdx.x * (NT / 64) + wave, ngw = gridDim.x * (NT / 64);
    convert_big(c, l, ldsf, l == 1 ? convert_early_tiles(c) : 0, J_ALL - convert_tail_tiles(), (int)blockIdx.x, (int)gridDim.x);
#ifdef CPU_EMU
    if (lane == 0) for (int it = I_BIG + gw; it < I_ALL; it += ngw) { const CvtItem r = cvt_decode(c, l, it);
        for (int kk = 0; kk < 64; ++kk) for (int nn = 0; nn < 32; ++nn) r.WT[(size_t)(r.drow + nn) * r.ldt + r.k0 + kk] = (bf16_t)f2bf(r.Wp[(size_t)(r.k0 + kk) * r.ldw + r.n0 + nn]); }
#else
    float* scr = ldsf + wave * (64 * 33 + 16);
    for (int it = I_BIG + gw; it < I_ALL; it += ngw) {
        const CvtItem r = cvt_decode(c, l, it);
#pragma unroll 8
        for (int i = 0; i < 32; ++i) { const int kk = 2 * i + (lane >> 5); scr[kk * 33 + (lane & 31)] = r.Wp[(size_t)(r.k0 + kk) * r.ldw + r.n0 + (lane & 31)]; }
        asm volatile("s_waitcnt lgkmcnt(0)" ::: "memory");
        const int cc = lane & 7;
#pragma unroll
        for (int j = 0; j < 4; ++j) { const int n = (lane >> 3) + 8 * j; const float* sp = scr + (8 * cc) * 33 + n;
            u32x4 o; o[0] = pk2(sp[0 * 33], sp[1 * 33]); o[1] = pk2(sp[2 * 33], sp[3 * 33]); o[2] = pk2(sp[4 * 33], sp[5 * 33]); o[3] = pk2(sp[6 * 33], sp[7 * 33]);
            *(u32x4*)(r.WT + (size_t)(r.drow + n) * r.ldt + r.k0 + 8 * cc) = o; }
        asm volatile("s_waitcnt lgkmcnt(0)" ::: "memory");
    }
#endif
    { const float* wg = c.in[30] + (size_t)l * D * 4; const float* we = c.in[32] + (size_t)l * D * 32; bf16_t* wh = WSH(O_WRH); bf16_t* wl = WSH(O_WRL);
      for (long i = GT_; i < (long)48 * D; i += GS_) { const int n = (int)(i / D), k = (int)(i % D); const float w = n < 4 ? wg[k * 4 + n] : n < 36 ? we[k * 32 + (n - 4)] : 0.f; const unsigned hb = f2bf(w); wh[i] = (bf16_t)hb; wl[i] = (bf16_t)f2bf(w - bf2f((bf16_t)hb)); } }
    for (long i = GT_; i < (long)128 * D / 2; i += GS_) ((unsigned*)(WSH(O_WIN) + (size_t)10624 * D))[i] = 0u;
}

namespace pg8 {
constexpr int BM = 256, BK = 64, HALF = 128, HTB = HALF * BK * 2, STAGE_BYTES = 8 * HTB;
__host__ __device__ __forceinline__ int lds_byte(int r, int cc) { const int st = (r >> 4) * 2 + (cc >> 5), rr = r & 15, c2 = cc & 31, ob = rr * 64 + c2 * 2; return st * 1024 + (ob ^ (((ob >> 9) & 1) << 5)); }
__host__ __device__ __forceinline__ void stage_rc(int b, int& R, int& C) { const int st = b / 1024, sb = b % 1024, swz = sb ^ (((sb >> 9) & 1) << 5); R = (st >> 1) * 16 + swz / 64; C = (st & 1) * 32 + (swz % 64) / 2; }
__host__ __device__ __forceinline__ int perm32(int rho) { const int n = rho >> 4, i = rho & 15; return 8 * (i >> 2) + 4 * n + (i & 3); }
struct Unit { int pm, pn, aux; const char* A; const char* B; };
struct Gemm { int K, lda, ldb; };

template <class Epi, class Sched>
__device__ __forceinline__ void gemm_phase(unsigned char* lds_, const Gemm g, const Sched& S, const Epi& E) {
#ifdef CPU_EMU
    if (threadIdx.x != 0) return;
    Unit u; const int K = g.K;
    float* Af = (float*)malloc((size_t)256 * K * 4); float* Bf = (float*)malloc((size_t)256 * K * 4); float* Cf = (float*)malloc(256 * 256 * 4);
    for (int i = 0; S.next(i, u); ++i) {
        const bf16_t* A = (const bf16_t*)u.A; const bf16_t* B = (const bf16_t*)u.B;
        for (int r = 0; r < 256; ++r) for (int k = 0; k < K; ++k) { Af[(size_t)r * K + k] = bf2f(A[(size_t)r * g.lda + k]); Bf[(size_t)r * K + k] = bf2f(B[(size_t)r * g.ldb + k]); }
        for (int r = 0; r < 256; ++r) for (int cc = 0; cc < 256; ++cc) { const float* a = Af + (size_t)r * K; const float* b = Bf + (size_t)cc * K; float sacc = 0.f; for (int k = 0; k < K; ++k) sacc += a[k] * b[k]; Cf[r * 256 + cc] = sacc; }
        for (int wid = 0; wid < 8; ++wid) for (int lane = 0; lane < 64; ++lane) {
            const int wr = wid >> 2, wc = wid & 3, fr = lane & 15, fq = lane >> 4; f32x4 acc[2][2][4][2];
            for (int ai = 0; ai < 2; ++ai) for (int bj = 0; bj < 2; ++bj) for (int m = 0; m < 4; ++m) for (int n = 0; n < 2; ++n) for (int j = 0; j < 4; ++j) {
                const int r = 128 * ai + 64 * wr + 16 * m + fr, cc = 128 * bj + 32 * wc + (Epi::PERM ? 8 * fq + 4 * n + j : 16 * n + 4 * fq + j); acc[ai][bj][m][n][j] = Cf[r * 256 + cc]; }
            E(acc, u, wr, wc, fr, fq);
        }
    }
    free(Af); free(Bf); free(Cf);
#else
    typedef __attribute__((address_space(3))) unsigned char* ldsp_t;
    ldsp_t lds = (ldsp_t)lds_;
    const int tid = threadIdx.x, wid = __builtin_amdgcn_readfirstlane(tid >> 6), lane = tid & 63, wr = wid >> 2, wc = wid & 3, fr = lane & 15, fq = lane >> 4;
    const int K = g.K, nt = K / BK;
    unsigned voffA[2], voffB[2];
#pragma unroll
    for (int i = 0; i < 2; ++i) { int R, C; stage_rc(tid * 16 + i * 8192, R, C); const int Rb = Epi::PERM ? ((R & ~31) + perm32(R & 31)) : R;
        voffA[i] = (unsigned)(R * g.lda + C) * 2u; voffB[i] = (unsigned)(Rb * g.ldb + C) * 2u; }
    const size_t kstep = (size_t)(BK * 2);
    const size_t hstepA = (size_t)HALF * g.lda * 2, hstepB = (size_t)HALF * g.ldb * 2;
    const unsigned ldsw = (unsigned)wid * 1024u;
    const int aoff = lds_byte(wr * 64 + fr, fq * 8), boff = lds_byte(wc * 32 + fr, fq * 8);
#define PG8_SA(b, h) (((b) * 2 + (h)) * HTB)
#define PG8_SB(b, h) ((4 + (b) * 2 + (h)) * HTB)
#define PG8_STAGE(bufoff, gbase, voff) do { _Pragma("unroll") for (int _i = 0; _i < 2; ++_i) \
        __builtin_amdgcn_global_load_lds((const unsigned*)((const char*)(gbase) + (voff)[_i]), (__attribute__((address_space(3))) unsigned*)(lds + (bufoff) + ldsw + _i * 8192), 16, 0, 0); } while (0)
#define PG8_LDA(dst, b, h) do { _Pragma("unroll") for (int m = 0; m < 4; ++m) _Pragma("unroll") for (int k = 0; k < 2; ++k) dst[m][k] = *(const __attribute__((address_space(3))) bf16x8*)(lds + PG8_SA(b, h) + aoff + m * 2048 + k * 1024); } while (0)
#define PG8_LDB(dst, b, h) do { _Pragma("unroll") for (int n = 0; n < 2; ++n) _Pragma("unroll") for (int k = 0; k < 2; ++k) dst[n][k] = *(const __attribute__((address_space(3))) bf16x8*)(lds + PG8_SB(b, h) + boff + n * 2048 + k * 1024); } while (0)
#define PG8_MMA(ai, bj, At, Bt) do { __builtin_amdgcn_s_setprio(1); _Pragma("unroll") for (int m = 0; m < 4; ++m) _Pragma("unroll") for (int n = 0; n < 2; ++n) _Pragma("unroll") for (int k = 0; k < 2; ++k) \
        acc[ai][bj][m][n] = __builtin_amdgcn_mfma_f32_16x16x32_bf16(Bt[n][k], At[m][k], acc[ai][bj][m][n], 0, 0, 0); __builtin_amdgcn_s_setprio(0); } while (0)
#define PG8_WAIT_V(n) asm volatile("s_waitcnt vmcnt(" #n ")" ::: "memory")
#define PG8_WAIT_L(n) asm volatile("s_waitcnt lgkmcnt(" #n ")" ::: "memory")
#define PG8_BAR __builtin_amdgcn_s_barrier()
#define PG8_SCHED __builtin_amdgcn_sched_barrier(0)
    Unit cur, nxt; int ui = 0;
    if (!S.next(0, cur)) return;
    f32x4 acc[2][2][4][2];
#pragma unroll
    for (int a = 0; a < 2; ++a)
#pragma unroll
        for (int b = 0; b < 2; ++b)
#pragma unroll
            for (int m = 0; m < 4; ++m)
#pragma unroll
                for (int n = 0; n < 2; ++n) acc[a][b][m][n] = (f32x4){0.f, 0.f, 0.f, 0.f};
    bf16x8 At[4][2], B0[2][2], B1[2][2];
    const char* cA = cur.A; const char* cB = cur.B;
    S.a_ready(cur);
    PG8_STAGE(PG8_SB(0, 0), cB, voffB); PG8_STAGE(PG8_SA(0, 0), cA, voffA); PG8_STAGE(PG8_SB(0, 1), cB + hstepB, voffB); PG8_STAGE(PG8_SA(0, 1), cA + hstepA, voffA);
    if (wr == 1) PG8_BAR;
    PG8_WAIT_V(4); PG8_BAR;
    PG8_STAGE(PG8_SB(1, 0), cB + kstep, voffB); PG8_STAGE(PG8_SA(1, 0), cA + kstep, voffA); PG8_STAGE(PG8_SB(1, 1), cB + hstepB + kstep, voffB);
    PG8_WAIT_V(6); PG8_BAR;
    for (;;) {
        const bool has_next = S.next(ui + 1, nxt);
        const char* nA = has_next ? nxt.A : cA; const char* nB = has_next ? nxt.B : cB;
        for (int t = 0; t < nt; t += 2) {
            const bool last = (t == nt - 2);
            const char* a1 = cA + (size_t)(t + 1) * kstep;
            const char* a2 = last ? nA : cA + (size_t)(t + 2) * kstep; const char* b2 = last ? nB : cB + (size_t)(t + 2) * kstep;
            const char* a3 = a2 + kstep; const char* b3 = b2 + kstep;
            if (last && has_next) S.a_ready(nxt);
            PG8_LDB(B0, 0, 0); PG8_SCHED; PG8_LDA(At, 0, 0); PG8_STAGE(PG8_SA(1, 1), a1 + hstepA, voffA);
            PG8_WAIT_L(8); PG8_BAR; PG8_WAIT_L(0); PG8_MMA(0, 0, At, B0); PG8_BAR; PG8_SCHED;
            PG8_LDB(B1, 0, 1); PG8_STAGE(PG8_SB(0, 0), b2, voffB);
            PG8_BAR; PG8_WAIT_L(0); PG8_MMA(0, 1, At, B1); PG8_BAR;
            PG8_LDA(At, 0, 1); PG8_STAGE(PG8_SA(0, 0), a2, voffA);
            PG8_BAR; PG8_WAIT_L(0); PG8_MMA(1, 0, At, B0); PG8_BAR; PG8_SCHED;
            PG8_STAGE(PG8_SB(0, 1), b2 + hstepB, voffB);
            PG8_WAIT_V(6); PG8_BAR; PG8_MMA(1, 1, At, B1); PG8_BAR;
            PG8_LDB(B0, 1, 0); PG8_SCHED; PG8_LDA(At, 1, 0); PG8_STAGE(PG8_SA(0, 1), a2 + hstepA, voffA);
            PG8_WAIT_L(8); PG8_BAR; PG8_WAIT_L(0); PG8_MMA(0, 0, At, B0); PG8_BAR; PG8_SCHED;
            PG8_LDB(B1, 1, 1); PG8_STAGE(PG8_SB(1, 0), b3, voffB);
            PG8_BAR; PG8_WAIT_L(0); PG8_MMA(0, 1, At, B1); PG8_BAR;
            PG8_LDA(At, 1, 1); PG8_STAGE(PG8_SA(1, 0), a3, voffA);
            PG8_BAR; PG8_WAIT_L(0); PG8_MMA(1, 0, At, B0); PG8_BAR; PG8_SCHED;
            PG8_STAGE(PG8_SB(1, 1), b3 + hstepB, voffB);
            PG8_WAIT_V(6); PG8_BAR; PG8_MMA(1, 1, At, B1); PG8_BAR;
        }
        E(acc, cur, wr, wc, fr, fq); S.done(cur);
        if (!has_next) break;
#pragma unroll
        for (int a = 0; a < 2; ++a)
#pragma unroll
            for (int b = 0; b < 2; ++b)
#pragma unroll
                for (int m = 0; m < 4; ++m)
#pragma unroll
                    for (int n = 0; n < 2; ++n) acc[a][b][m][n] = (f32x4){0.f, 0.f, 0.f, 0.f};
        cur = nxt; cA = nA; cB = nB; ++ui;
    }
    PG8_WAIT_V(0);
    if (wr == 0) PG8_BAR;
    PG8_BAR;
#undef PG8_SA
#undef PG8_SB
#undef PG8_STAGE
#undef PG8_LDA
#undef PG8_LDB
#undef PG8_MMA
#undef PG8_WAIT_V
#undef PG8_WAIT_L
#undef PG8_BAR
#undef PG8_SCHED
#endif
}

struct StaticOrder {
    int nM, nN, nwg, G, c; const char* A; const char* B; size_t tstepA, tstepB;
    __device__ __forceinline__ void init(int M, int N, int G_, int c_, const void* A_, const void* B_, int lda, int ldb) { nM = M / BM; nN = N / BM; nwg = nM * nN; G = G_; c = c_; A = (const char*)A_; B = (const char*)B_; tstepA = (size_t)BM * lda * 2; tstepB = (size_t)BM * ldb * 2; }
    __device__ __forceinline__ bool next(int i, Unit& u) const {
        const long L = (long)i * G + c; if (L >= nwg) return false;
        int wgid = (int)L; { const int q = nwg / 8, r = nwg % 8, xcd = wgid % 8, off = wgid / 8; wgid = (xcd < r ? xcd * (q + 1) : r * (q + 1) + (xcd - r) * q) + off; }
        const int nig = 8 * nN, gid = wgid / nig, fm = gid * 8, gsz = (nM - fm) < 8 ? (nM - fm) : 8;
        u.pm = fm + ((wgid % nig) % gsz); u.pn = (wgid % nig) / gsz; u.aux = 0; u.A = A + (size_t)u.pm * tstepA; u.B = B + (size_t)u.pn * tstepB; return true;
    }
    __device__ __forceinline__ void a_ready(const Unit&) const {}
    __device__ __forceinline__ void done(const Unit&) const {}
};
struct MergeOrder {
    StaticOrder so; int kseg_bytes;
    __device__ __forceinline__ bool next(int i, Unit& u) const { if (!so.next(i >> 2, u)) return false; u.aux = i & 3; u.A += (size_t)u.aux * kseg_bytes; u.B += (size_t)u.aux * kseg_bytes; return true; }
    __device__ __forceinline__ void a_ready(const Unit&) const {}
    __device__ __forceinline__ void done(const Unit&) const {}
};
struct MoeOrder {
    int G, c, ncol; const int* plan; const char* A; const char* B; size_t tstepA, tstepB, estep;
    __device__ __forceinline__ bool next(int i, Unit& u) const {
        const long L = (long)i * G + c; const int nblk = plan[40]; if (L >= (long)nblk * ncol) return false;
        u.pm = (int)(L / ncol); u.pn = (int)(L % ncol); u.aux = plan[64 + u.pm]; u.A = A + (size_t)u.pm * tstepA; u.B = B + (size_t)u.aux * estep + (size_t)u.pn * tstepB; return true;
    }
    __device__ __forceinline__ void a_ready(const Unit&) const {}
    __device__ __forceinline__ void done(const Unit&) const {}
};

__device__ __forceinline__ u32x4 pack8(const f32x4 v0, const f32x4 v1) { u32x4 w; w[0] = pk2(v0[0], v0[1]); w[1] = pk2(v0[2], v0[3]); w[2] = pk2(v1[0], v1[1]); w[3] = pk2(v1[2], v1[3]); return w; }
struct EpiBf16 {
    static constexpr bool PERM = true; bf16_t* O; int ldc;
    __device__ __forceinline__ void operator()(const f32x4 (&acc)[2][2][4][2], const Unit& u, int wr, int wc, int fr, int fq) const {
        const int row0 = u.pm * BM + wr * 64 + fr, col0 = u.pn * BM + wc * 32 + 8 * fq;
#pragma unroll
        for (int ai = 0; ai < 2; ++ai)
#pragma unroll
            for (int m = 0; m < 4; ++m) { bf16_t* rowp = O + (size_t)(row0 + ai * HALF + m * 16) * ldc + col0;
#pragma unroll
                for (int bj = 0; bj < 2; ++bj) *(u32x4*)(rowp + bj * HALF) = pack8(acc[ai][bj][m][0], acc[ai][bj][m][1]); }
    }
};
struct EpiMerge {
    static constexpr bool PERM = true; const bf16_t* P; bf16_t* MRG;
    __device__ __forceinline__ void operator()(const f32x4 (&acc)[2][2][4][2], const Unit& u, int wr, int wc, int fr, int fq) const {
        const int row0 = u.pm * BM + wr * 64 + fr, col0 = u.pn * BM + wc * 32 + 8 * fq, seg = u.aux;
#pragma unroll
        for (int ai = 0; ai < 2; ++ai)
#pragma unroll
            for (int m = 0; m < 4; ++m) { const size_t r = (size_t)(row0 + ai * HALF + m * 16);
#pragma unroll
                for (int bj = 0; bj < 2; ++bj) { const int cc = col0 + bj * HALF;
                    const u32x4 gw = *(const u32x4*)(P + r * PW + C_MLP + seg * D + cc);
                    f32x4 v0, v1;
#pragma unroll
                    for (int q = 0; q < 2; ++q) { v0[2 * q] = sigmoidf_(bflo(gw[q])) * acc[ai][bj][m][0][2 * q]; v0[2 * q + 1] = sigmoidf_(bfhi(gw[q])) * acc[ai][bj][m][0][2 * q + 1];
                        v1[2 * q] = sigmoidf_(bflo(gw[2 + q])) * acc[ai][bj][m][1][2 * q]; v1[2 * q + 1] = sigmoidf_(bfhi(gw[2 + q])) * acc[ai][bj][m][1][2 * q + 1]; }
                    bf16_t* mp = MRG + r * D + cc;
                    if (seg > 0) { const u32x4 pw = *(const u32x4*)mp;
#pragma unroll
                        for (int q = 0; q < 2; ++q) { v0[2 * q] += bflo(pw[q]); v0[2 * q + 1] += bfhi(pw[q]); v1[2 * q] += bflo(pw[2 + q]); v1[2 * q + 1] += bfhi(pw[2 + q]); } }
                    *(u32x4*)mp = pack8(v0, v1);
                }
#ifndef CPU_EMU
                asm volatile("" ::: "memory");
#endif
            }
    }
};
struct EpiResid {
    static constexpr bool PERM = false; const float* xin; const float* g1; float* xmid;
    __device__ __forceinline__ void operator()(const f32x4 (&acc)[2][2][4][2], const Unit& u, int wr, int wc, int fr, int fq) const {
        const int row0 = u.pm * BM + wr * 64 + fr, col0 = u.pn * BM + wc * 32 + 4 * fq;
#pragma unroll
        for (int ai = 0; ai < 2; ++ai)
#pragma unroll
            for (int m = 0; m < 4; ++m) { const int r = row0 + ai * HALF + m * 16; const float* gp = g1 + (size_t)(r / S) * D6;
#pragma unroll
                for (int bj = 0; bj < 2; ++bj)
#pragma unroll
                    for (int n = 0; n < 2; ++n) { const int cc = col0 + bj * HALF + n * 16; *(f32x4*)(xmid + (size_t)r * D + cc) = *(const f32x4*)(xin + (size_t)r * D + cc) + *(const f32x4*)(gp + cc) * acc[ai][bj][m][n]; }
#ifndef CPU_EMU
                asm volatile("" ::: "memory");
#endif
            }
    }
};
struct EpiGU {
    static constexpr bool PERM = true; bf16_t* ACT;
    __device__ __forceinline__ void operator()(const f32x4 (&acc)[2][2][4][2], const Unit& u, int wr, int wc, int fr, int fq) const {
        const int row0 = u.pm * BM + wr * 64 + fr, col0 = u.pn * HALF + wc * 32 + 8 * fq;
#pragma unroll
        for (int ai = 0; ai < 2; ++ai)
#pragma unroll
            for (int m = 0; m < 4; ++m) { f32x4 v0, v1;
#pragma unroll
                for (int j = 0; j < 4; ++j) { v0[j] = siluf_(acc[ai][0][m][0][j]) * acc[ai][1][m][0][j]; v1[j] = siluf_(acc[ai][0][m][1][j]) * acc[ai][1][m][1][j]; }
                *(u32x4*)(ACT + (size_t)(row0 + ai * HALF + m * 16) * 512 + col0) = pack8(v0, v1); }
    }
};
}

template <int PASS>
__device__ __forceinline__ void ph_lru(const Ctx& c, int l, float* ldsf) {
    const bf16_t* P = WSH(O_P); const float* cw = c.in[8] + (size_t)l * 4 * W; const float* cb = c.in[9] + (size_t)l * W;
    const float* br = c.in[11] + (size_t)l * 2 * W; const float* bi = c.in[13] + (size_t)l * 2 * W; const float* lam = c.in[14] + (size_t)l * 2 * W; const bf16_t* WLR = WSH(O_WLR);
    float* CA = WSF(O_LCA); float* CH = WSF(O_LCH); const float* CI = WSF(O_LCI); bf16_t* Y = WSH(O_YS);
    bf16_t* Xs = (bf16_t*)ldsf; bf16_t* Wr = Xs + 64 * 136; bf16_t* Wi = Wr + 128 * 136; float* AUa = (float*)Wr; float* AUu = AUa + 64 * 128; float* HF = (float*)(Wi + 128 * 136); float* spl = HF + 64 * 128;
    const int tid = threadIdx.x, wv = tid >> 6, lane = tid & 63, fr = lane & 15, fq = lane >> 4, rt = wv & 3, hf = wv >> 2;
    for (int u = blockIdx.x; u < (T / 64) * 8; u += gridDim.x) {
        const int n = u & 7, tile = u >> 3, b = tile / NLC, chk = tile % NLC; const long t0 = (long)tile * 64;
        if (tid < 256) spl[tid] = softplusf_(-lam[(tid >> 7) * W + n * 128 + (tid & 127)]);
#pragma unroll
        for (int q = 0; q < 4; ++q) { const int id = tid + NT * q, tl = id >> 5, e4 = (id & 31) * 4, ch = n * 128 + e4; const long t = t0 + tl; const int sI = (int)(t % S);
            f32x4 acc = *(const f32x4*)(cb + ch);
#pragma unroll
            for (int k = 0; k < 4; ++k) { const int ss = sI + k - 2; if (ss >= 0 && ss < S) acc += ld_bf4(P + (size_t)(t + k - 2) * PW + C_LX + ch) * *(const f32x4*)(cw + k * W + ch); }
            st_bf4(Xs + tl * 136 + e4, acc); }
        for (int z = 0; z < 2; ++z) {
#pragma unroll
            for (int q = 0; q < 4; ++q) { const int id = tid + NT * q, f = id >> 4, e8 = (id & 15) * 8;
                *(u32x4*)(Wr + f * 136 + e8) = *(const u32x4*)(WLR + ((size_t)((z * 2 + 0) * 8 + n) * 128 + f) * 128 + e8); *(u32x4*)(Wi + f * 136 + e8) = *(const u32x4*)(WLR + ((size_t)((z * 2 + 1) * 8 + n) * 128 + f) * 128 + e8); }
            SYNCTHREADS();
            f32x4 ar[4], ai[4];
#pragma unroll
            for (int nt = 0; nt < 4; ++nt) { ar[nt] = (f32x4){0.f, 0.f, 0.f, 0.f}; ai[nt] = (f32x4){0.f, 0.f, 0.f, 0.f}; }
            wave_mma<4, 4>(ar, Xs + rt * 16 * 136, 136, Wr + hf * 64 * 136, 136);
            wave_mma<4, 4>(ai, Xs + rt * 16 * 136, 136, Wi + hf * 64 * 136, 136);
            SYNCTHREADS();
            const int tl = rt * 16 + fr;
#pragma unroll
            for (int nt = 0; nt < 4; ++nt) { const int f = 64 * hf + 16 * nt + 4 * fq, ch = n * 128 + f;
                const f32x4 brv = *(const f32x4*)(br + z * W + ch), biv = *(const f32x4*)(bi + z * W + ch), lmv = *(const f32x4*)(spl + z * 128 + f), xcv = ld_bf4(Xs + tl * 136 + f); f32x4 av, uv;
#pragma unroll
                for (int e = 0; e < 4; ++e) { const float r = sigmoidf_(ar[nt][e] + brv[e]), ig = sigmoidf_(ai[nt][e] + biv[e]), la = -8.f * r * lmv[e]; const float a = fexp_(la); av[e] = a; uv[e] = sqrtf(fmaxf(1.f - a * a, 0.f)) * ig * xcv[e]; }
                *(f32x4*)(AUa + tl * 128 + f) = av; *(f32x4*)(AUu + tl * 128 + f) = uv; }
            SYNCTHREADS();
            if (tid < 128) { const int f = tid; const size_t ci = (((size_t)z * NB + b) * NLC + chk) * W + n * 128 + f;
                if (PASS == 1) { float prod = 1.f, h = 0.f;
#pragma unroll 8
                    for (int q = 0; q < 64; ++q) { const int sI = z == 0 ? q : 63 - q; const float a = AUa[sI * 128 + f]; h = a * h + AUu[sI * 128 + f]; prod *= a; }
                    CA[ci] = prod; CH[ci] = h;
                } else { float h = CI[ci];
                    if (z == 0) {
#pragma unroll 8
                        for (int q = 0; q < 64; ++q) { h = AUa[q * 128 + f] * h + AUu[q * 128 + f]; HF[q * 128 + f] = h; }
                    } else {
#pragma unroll 8
                        for (int q = 63; q >= 0; --q) { h = AUa[q * 128 + f] * h + AUu[q * 128 + f]; HF[q * 128 + f] += h; } } }
            }
            SYNCTHREADS();
        }
        if (PASS == 2) {
#pragma unroll
            for (int q = 0; q < 4; ++q) { const int id = tid + NT * q, tl = id >> 5, f4 = (id & 31) * 4; const long t = t0 + tl; f32x4 hv = *(const f32x4*)(HF + tl * 128 + f4); const f32x4 gv = ld_bf4(P + (size_t)t * PW + C_LG + n * 128 + f4);
#pragma unroll
                for (int e = 0; e < 4; ++e) hv[e] *= geluf_(gv[e]);
                st_bf4(Y + (size_t)t * 4 * W + 0 * W + n * 128 + f4, hv); }
            SYNCTHREADS();
        }
    }
}
__device__ __forceinline__ void ph_lru_scan2(const Ctx& c) {
    const float* CA = WSF(O_LCA); const float* CH = WSF(O_LCH); float* CI = WSF(O_LCI);
    for (long i = GT_; i < (long)2 * NB * W; i += GS_) {
        const int w = (int)(i % W), b = (int)((i / W) % NB), z = (int)(i / ((long)W * NB)); float carry = 0.f;
#pragma unroll 16
        for (int q = 0; q < NLC; ++q) { const int ch = z == 0 ? q : NLC - 1 - q; const size_t idx = (((size_t)z * NB + b) * NLC + ch) * W + w; CI[idx] = carry; carry = CA[idx] * carry + CH[idx]; }
    }
}
__device__ __forceinline__ void ret_tables(float* tab, int h) {
    const int tid = threadIdx.x; const float lg = loggamma_(h);
    if (tid < 32) tab[tid] = powf(10000.f, -(float)(2 * tid) / 64.f);
    if (tid >= 64 && tid < 64 + 129) tab[tid] = expf((float)(tid - 64) * lg);
}
__device__ __forceinline__ void ph_ret_kv(const Ctx& c, float* ldsf) {
    const int* pos = (const int*)c.in[2]; const bf16_t* P = WSH(O_P); float* KVF = WSF(O_KVF); float* KVB = WSF(O_KVB);
    bf16_t* VT = (bf16_t*)ldsf; bf16_t* KF = VT + 128 * 136; bf16_t* KB = KF + 64 * 136; float* tab = (float*)(KB + 64 * 136);
    const int tid = threadIdx.x, wv = tid >> 6, lane = tid & 63, fr = lane & 15, fq = lane >> 4;
    for (int u = blockIdx.x; u < (T / 128) * 8; u += gridDim.x) {
        const int h = u & 7; const long t0 = (long)(u >> 3) * 128;
        ret_tables(tab, h);
        SYNCTHREADS();
        { float x1[8], x2[8], pj[8];
#pragma unroll
          for (int q = 0; q < 8; ++q) { const int id = tid + NT * q, j = id & 127, dj = id >> 7; const bf16_t* prow = P + (size_t)(t0 + j) * PW + C_RK + h * 64; x1[q] = bf2f(prow[dj]); x2[q] = bf2f(prow[dj + 32]); pj[q] = (float)pos[t0 + j]; }
#pragma unroll 1
          for (int q = 0; q < 8; ++q) { const int id = tid + NT * q, j = id & 127, dj = id >> 7; const float ang = pj[q] * tab[dj]; const float cs = cosf(ang), sn = sinf(ang);
            const float k1 = x1[q] * cs - x2[q] * sn, k2 = x2[q] * cs + x1[q] * sn, fj = tab[64 + 127 - j], bj = tab[64 + j];
            KF[dj * 136 + j] = (bf16_t)f2bf(k1 * fj); KF[(dj + 32) * 136 + j] = (bf16_t)f2bf(k2 * fj); KB[dj * 136 + j] = (bf16_t)f2bf(k1 * bj); KB[(dj + 32) * 136 + j] = (bf16_t)f2bf(k2 * bj); } }
#pragma unroll
        for (int q = 0; q < 4; ++q) { const int id = tid + NT * q, j = id & 127, e8 = (id >> 7) * 8; const u32x4 raw = *(const u32x4*)(P + (size_t)(t0 + j) * PW + C_RV + h * 128 + e8);
#pragma unroll
            for (int e = 0; e < 4; ++e) { VT[(e8 + 2 * e) * 136 + j] = (bf16_t)(raw[e] & 0xffffu); VT[(e8 + 2 * e + 1) * 136 + j] = (bf16_t)(raw[e] >> 16); } }
        SYNCTHREADS();
        f32x4 af[4], ab[4];
#pragma unroll
        for (int nt = 0; nt < 4; ++nt) { af[nt] = (f32x4){0.f, 0.f, 0.f, 0.f}; ab[nt] = (f32x4){0.f, 0.f, 0.f, 0.f}; }
        wave_mma<4, 4>(af, VT + wv * 16 * 136, 136, KF, 136);
        wave_mma<4, 4>(ab, VT + wv * 16 * 136, 136, KB, 136);
        const size_t ob = (((size_t)(u >> 3) * 8 + h) * 128 + wv * 16 + fr) * 64 + 4 * fq;
#pragma unroll
        for (int nt = 0; nt < 4; ++nt) { *(f32x4*)(KVF + ob + 16 * nt) = af[nt]; *(f32x4*)(KVB + ob + 16 * nt) = ab[nt]; }
        SYNCTHREADS();
    }
}
__device__ __forceinline__ void ph_ret_state(const Ctx& c) {
    const float* KVF = WSF(O_KVF); const float* KVB = WSF(O_KVB); float* STF = WSF(O_STF); float* STB = WSF(O_STB);
    for (long i = GT_; i < (long)NB * 8 * 8192; i += GS_) {
        const int x = (int)(i % 8192), h = (int)((i / 8192) % 8), b = (int)(i / 65536);
        const float cd = expf(128.f * loggamma_(h)); float st = 0.f;
#pragma unroll 16
        for (int n = 0; n < NCH; ++n) { const size_t idx = (((size_t)b * NCH + n) * 8 + h) * 8192 + x; STF[idx] = st; st = cd * st + KVF[idx]; }
        st = 0.f;
#pragma unroll 16
        for (int n = NCH - 1; n >= 0; --n) { const size_t idx = (((size_t)b * NCH + n) * 8 + h) * 8192 + x; STB[idx] = st; st = cd * st + KVB[idx]; }
    }
}
__device__ __forceinline__ void ph_ret_out(const Ctx& c, float* ldsf) {
    const int* pos = (const int*)c.in[2]; const bf16_t* P = WSH(O_P); const float* STF = WSF(O_STF); const float* STB = WSF(O_STB); bf16_t* Y = WSH(O_YS);
    bf16_t* Qs = (bf16_t*)ldsf; bf16_t* Ks = Qs + 128 * 72; bf16_t* VT = Ks + 128 * 72; bf16_t* Ss = VT + 128 * 136; bf16_t* SF = Ss + 128 * 136; bf16_t* SB = SF + 128 * 72; float* tab = (float*)(SB + 128 * 72);
    const int tid = threadIdx.x, wv = tid >> 6, lane = tid & 63, fr = lane & 15, fq = lane >> 4;
    for (int u = blockIdx.x; u < (T / 128) * 8; u += gridDim.x) {
        const int h = u & 7; const long t0 = (long)(u >> 3) * 128;
        ret_tables(tab, h);
        SYNCTHREADS();
#pragma unroll 1
        for (int qh = 0; qh < 8; qh += 4) { float q1[4], q2[4], k1[4], k2[4], pj[4];
#pragma unroll
          for (int q = 0; q < 4; ++q) { const int id = tid + NT * (qh + q), j = id >> 5, dj = id & 31; const bf16_t* prow = P + (size_t)(t0 + j) * PW;
            q1[q] = bf2f(prow[C_RQ + h * 64 + dj]); q2[q] = bf2f(prow[C_RQ + h * 64 + dj + 32]); k1[q] = bf2f(prow[C_RK + h * 64 + dj]); k2[q] = bf2f(prow[C_RK + h * 64 + dj + 32]); pj[q] = (float)pos[t0 + j]; }
#pragma unroll
          for (int q = 0; q < 4; ++q) { const int id = tid + NT * (qh + q), j = id >> 5, dj = id & 31; const float ang = pj[q] * tab[dj]; const float cs = cosf(ang), sn = sinf(ang);
            Qs[j * 72 + dj] = (bf16_t)f2bf((q1[q] * cs - q2[q] * sn) * 0.125f); Qs[j * 72 + dj + 32] = (bf16_t)f2bf((q2[q] * cs + q1[q] * sn) * 0.125f); Ks[j * 72 + dj] = (bf16_t)f2bf(k1[q] * cs - k2[q] * sn); Ks[j * 72 + dj + 32] = (bf16_t)f2bf(k2[q] * cs + k1[q] * sn); } }
#pragma unroll
        for (int q = 0; q < 4; ++q) { const int id = tid + NT * q, j = id & 127, e8 = (id >> 7) * 8; const u32x4 raw = *(const u32x4*)(P + (size_t)(t0 + j) * PW + C_RV + h * 128 + e8);
#pragma unroll
            for (int e = 0; e < 4; ++e) { VT[(e8 + 2 * e) * 136 + j] = (bf16_t)(raw[e] & 0xffffu); VT[(e8 + 2 * e + 1) * 136 + j] = (bf16_t)(raw[e] >> 16); } }
        const size_t sbase = (((size_t)(u >> 3) * 8 + h)) * 8192;
#pragma unroll
        for (int q = 0; q < 4; ++q) { const int id = tid + NT * q, e = id >> 4, d4 = (id & 15) * 4; st_bf4(SF + e * 72 + d4, *(const f32x4*)(STF + sbase + (size_t)e * 64 + d4)); st_bf4(SB + e * 72 + d4, *(const f32x4*)(STB + sbase + (size_t)e * 64 + d4)); }
        SYNCTHREADS();
        const int i = wv * 16 + fr; const long t = t0 + i;
        {
            f32x4 sc[8];
#pragma unroll
            for (int nt = 0; nt < 8; ++nt) sc[nt] = (f32x4){0.f, 0.f, 0.f, 0.f};
            wave_mma<2, 8>(sc, Qs + wv * 16 * 72, 72, Ks, 72);
#pragma unroll
            for (int nt = 0; nt < 8; ++nt) { const int j0 = 16 * nt + 4 * fq; f32x4 sv;
#pragma unroll
                for (int e = 0; e < 4; ++e) { const int j = j0 + e, dist = i > j ? i - j : j - i; sv[e] = sc[nt][e] * tab[64 + dist]; }
                st_bf4(Ss + i * 136 + j0, sv); }
        }
#ifdef CPU_EMU
        SYNCTHREADS();
#else
        asm volatile("s_waitcnt lgkmcnt(0)" ::: "memory");
#endif
        f32x4 ao[8], tm[8];
#pragma unroll
        for (int nt = 0; nt < 8; ++nt) { ao[nt] = (f32x4){0.f, 0.f, 0.f, 0.f}; tm[nt] = (f32x4){0.f, 0.f, 0.f, 0.f}; }
        wave_mma<4, 8>(ao, Ss + wv * 16 * 136, 136, VT, 136);
        wave_mma<2, 8>(tm, Qs + wv * 16 * 72, 72, SF, 72);
        { const float qf = tab[64 + i + 1];
#pragma unroll
            for (int nt = 0; nt < 8; ++nt) { ao[nt] += tm[nt] * qf; tm[nt] = (f32x4){0.f, 0.f, 0.f, 0.f}; } }
        wave_mma<2, 8>(tm, Qs + wv * 16 * 72, 72, SB, 72);
        { const float qb = tab[64 + 128 - i];
#pragma unroll
            for (int nt = 0; nt < 8; ++nt) ao[nt] += tm[nt] * qb; }
        float sm = 0.f;
#pragma unroll
        for (int nt = 0; nt < 8; ++nt) sm += (ao[nt][0] + ao[nt][1]) + (ao[nt][2] + ao[nt][3]);
        sm += SHFL_XOR(sm, 16); sm += SHFL_XOR(sm, 32);
        const float mu = sm * (1.f / 128.f); float sq = 0.f;
#pragma unroll
        for (int nt = 0; nt < 8; ++nt) { ao[nt] -= mu; sq += (ao[nt][0] * ao[nt][0] + ao[nt][1] * ao[nt][1]) + (ao[nt][2] * ao[nt][2] + ao[nt][3] * ao[nt][3]); }
        sq += SHFL_XOR(sq, 16); sq += SHFL_XOR(sq, 32);
        const float rs = 1.f / sqrtf(sq * (1.f / 128.f) + EPS);
#pragma unroll
        for (int nt = 0; nt < 8; ++nt) { const int e0 = 16 * nt + 4 * fq; f32x4 gv = ld_bf4(P + (size_t)t * PW + C_RG + h * 128 + e0);
#pragma unroll
            for (int e = 0; e < 4; ++e) gv[e] = siluf_(gv[e]) * (ao[nt][e] * rs);
            st_bf4(Y + (size_t)t * 4 * W + 1 * W + h * 128 + e0, gv); }
        SYNCTHREADS();
    }
}
__device__ __forceinline__ void ph_sgu_norm(const Ctx& c, int l) {
    const bf16_t* P = WSH(O_P); float* ST = WSF(O_VN);
    const int lane = threadIdx.x & 63, gw = blockIdx.x * (NT / 64) + (threadIdx.x >> 6), ngw = gridDim.x * (NT / 64);
    for (int t = gw; t < T; t += ngw) {
        f32x4 v[4]; float sm = 0.f;
#pragma unroll
        for (int j = 0; j < 4; ++j) { v[j] = ld_bf4(P + (size_t)t * PW + C_SV + (j * 64 + lane) * 4);
#pragma unroll
            for (int q = 0; q < 4; ++q) { v[j][q] = geluf_(v[j][q]); sm += v[j][q]; } }
        const float mu = wave_sum(sm) * (1.f / W); float sq = 0.f;
#pragma unroll
        for (int j = 0; j < 4; ++j)
#pragma unroll
            for (int q = 0; q < 4; ++q) { const float dd = v[j][q] - mu; sq += dd * dd; }
        const float rs = 1.f / sqrtf(wave_sum(sq) * (1.f / W) + EPS);
        if (lane == 0) { ST[(size_t)t * 2] = mu; ST[(size_t)t * 2 + 1] = rs; }
    }
}
__device__ __forceinline__ void ph_sgu_mix(const Ctx& c, int l, float* ldsf) {
    const bf16_t* P = WSH(O_P); const float* ST = WSF(O_VN); bf16_t* Y = WSH(O_YS); const float* ng = c.in[15] + (size_t)l * W;
    bf16_t* As = (bf16_t*)ldsf; bf16_t* Bs = As + 128 * 136; const int tid = threadIdx.x, wv = tid >> 6, lane = tid & 63, fr = lane & 15, fq = lane >> 4;
    for (int u = blockIdx.x; u < (T / 128) * 8; u += gridDim.x) {
        const int g = u & 7; const long t0 = (long)(u >> 3) * 128;
        const float* ws = c.in[16] + ((size_t)l * 8 + g) * 128 * 128; const float* bs = c.in[17] + ((size_t)l * 8 + g) * 128;
#pragma unroll
        for (int q = 0; q < 8; ++q) { const int id = tid + NT * q, i = id >> 5, j4 = (id & 31) * 4; st_bf4(As + i * 136 + j4, *(const f32x4*)(ws + i * 128 + j4)); }
#pragma unroll
        for (int q = 0; q < 4; ++q) { const int id = tid + NT * q, j = id & 127, d8 = (id >> 7) * 8; const float mu = ST[(size_t)(t0 + j) * 2], rs = ST[(size_t)(t0 + j) * 2 + 1];
            const u32x4 raw = *(const u32x4*)(P + (size_t)(t0 + j) * PW + C_SV + g * 128 + d8);
#pragma unroll
            for (int e = 0; e < 4; ++e) { const float v0 = (geluf_(bflo(raw[e])) - mu) * rs * ng[g * 128 + d8 + 2 * e], v1 = (geluf_(bfhi(raw[e])) - mu) * rs * ng[g * 128 + d8 + 2 * e + 1];
                Bs[(d8 + 2 * e) * 136 + j] = (bf16_t)f2bf(v0); Bs[(d8 + 2 * e + 1) * 136 + j] = (bf16_t)f2bf(v1); } }
        SYNCTHREADS();
        f32x4 acc[8];
#pragma unroll
        for (int nt = 0; nt < 8; ++nt) acc[nt] = (f32x4){0.f, 0.f, 0.f, 0.f};
        wave_mma<4, 8>(acc, As + wv * 16 * 136, 136, Bs, 136);
        const int i = wv * 16 + fr; const long t = t0 + i; const float bsi = bs[i];
#pragma unroll
        for (int nt = 0; nt < 8; ++nt) { const int d = 16 * nt + 4 * fq; f32x4 uu = ld_bf4(P + (size_t)t * PW + C_SU + g * 128 + d);
#pragma unroll
            for (int e = 0; e < 4; ++e) uu[e] = geluf_(uu[e]) * (acc[nt][e] + bsi);
            st_bf4(Y + (size_t)t * 4 * W + 2 * W + g * 128 + d, uu); }
        SYNCTHREADS();
    }
}
__device__ __forceinline__ void ph_rw_shift(const Ctx& c, int l) {
    const bf16_t* P = WSH(O_P); const float* mup = c.in[18] + (size_t)l * RF; const float* mun = c.in[19] + (size_t)l * RF; bf16_t* FS = WSH(O_FS);
    const int lane = threadIdx.x & 63, gw = blockIdx.x * (NT / 64) + (threadIdx.x >> 6), ngw = gridDim.x * (NT / 64);
    for (int t = gw; t < T; t += ngw) {
        const int sI = t % S; const bf16_t* pc = P + (size_t)t * PW + C_RW;
#pragma unroll 2
        for (int j = lane * 4; j < RF; j += 256) {
            const f32x4 f = ld_bf4(pc + j), z4 = (f32x4){0.f, 0.f, 0.f, 0.f}; const f32x4 pv = sI > 0 ? ld_bf4(pc - PW + j) : z4, nv = sI < S - 1 ? ld_bf4(pc + PW + j) : z4;
            f32x4 v = f + *(const f32x4*)(mup + j) * (pv - f) + *(const f32x4*)(mun + j) * (nv - f);
            if (j >= 3072 && j < 3200) {
#pragma unroll
                for (int e = 0; e < 4; ++e) v[e] = tanhf_(v[e]); }
            else if (j >= 3328) {
#pragma unroll
                for (int e = 0; e < 4; ++e) v[e] = sigmoidf_(v[e]); }
            st_bf4(FS + (size_t)t * RF + j, v);
        }
    }
}
__device__ __forceinline__ void ph_rw_lora(const Ctx& c, int l, float* ldsf) {
    const bf16_t* FS = WSH(O_FS); const float* w0 = c.in[20] + (size_t)l * 2 * W; const float* a0 = c.in[22] + (size_t)l * 2 * W;
    const bf16_t* WUT = WSH(O_WUT); const bf16_t* WAT = WSH(O_WAT); const bf16_t* WGT = WSH(O_WGT);
    float* DEC = WSF(O_DEC); float* AA = WSF(O_AA); float* GG = WSF(O_GG);
    bf16_t* F = (bf16_t*)ldsf; bf16_t* B1 = F + 128 * 136; bf16_t* B2 = B1 + 128 * 136; const int tid = threadIdx.x, wv = tid >> 6, lane = tid & 63, fr = lane & 15, fq = lane >> 4;
    for (int u = blockIdx.x; u < (T / 128) * 8; u += gridDim.x) {
        const int wc0 = (u & 7) * 128; const long t0 = (long)(u >> 3) * 128;
        for (int rd = 0; rd < 3; ++rd) {
#pragma unroll
            for (int q = 0; q < 8; ++q) { const int id = tid + NT * q, r = id >> 5, c4 = (id & 31) * 4;
                const int col = rd < 2 ? (c4 < 64 ? 3072 + rd * 64 + c4 : 3200 + rd * 64 + (c4 - 64)) : 3328 + c4;
                *(unsigned long long*)(F + r * 136 + c4) = *(const unsigned long long*)(FS + (size_t)(t0 + r) * RF + col); }
            if (rd < 2) {
#pragma unroll
                for (int q = 0; q < 2; ++q) { const int id = tid + NT * q, w = id >> 3, r8 = (id & 7) * 8;
                    *(u32x4*)(B1 + w * 72 + r8) = *(const u32x4*)(WUT + ((size_t)rd * W + wc0 + w) * 64 + r8); *(u32x4*)(B2 + w * 72 + r8) = *(const u32x4*)(WAT + ((size_t)rd * W + wc0 + w) * 64 + r8); }
            } else {
#pragma unroll
                for (int q = 0; q < 4; ++q) { const int id = tid + NT * q, w = id >> 4, r8 = (id & 15) * 8; *(u32x4*)(B1 + w * 136 + r8) = *(const u32x4*)(WGT + ((size_t)wc0 + w) * 128 + r8); }
            }
            SYNCTHREADS();
            f32x4 a1[8], a2[8];
#pragma unroll
            for (int nt = 0; nt < 8; ++nt) { a1[nt] = (f32x4){0.f, 0.f, 0.f, 0.f}; a2[nt] = (f32x4){0.f, 0.f, 0.f, 0.f}; }
            const long t = t0 + wv * 16 + fr;
            if (rd < 2) {
                wave_mma<2, 8>(a1, F + wv * 16 * 136, 136, B1, 72);
                wave_mma<2, 8>(a2, F + wv * 16 * 136 + 64, 136, B2, 72);
#pragma unroll
                for (int nt = 0; nt < 8; ++nt) { const int ch = wc0 + 16 * nt + 4 * fq; const f32x4 w0v = *(const f32x4*)(w0 + rd * W + ch), a0v = *(const f32x4*)(a0 + rd * W + ch); f32x4 dv, av;
#pragma unroll
                    for (int e = 0; e < 4; ++e) { dv[e] = fexp_(-DECAY_SCALE * sigmoidf_(a1[nt][e] + w0v[e])); av[e] = sigmoidf_(a2[nt][e] + a0v[e]); }
                    *(f32x4*)(DEC + ((size_t)rd * T + t) * W + ch) = dv; *(f32x4*)(AA + ((size_t)rd * T + t) * W + ch) = av; }
            } else {
                wave_mma<4, 8>(a1, F + wv * 16 * 136, 136, B1, 136);
#pragma unroll
                for (int nt = 0; nt < 8; ++nt) *(f32x4*)(GG + (size_t)t * W + wc0 + 16 * nt + 4 * fq) = a1[nt];
            }
            SYNCTHREADS();
        }
    }
}
#ifdef CPU_EMU
__device__ __forceinline__ float red16_(float x) { x += SHFL_XOR(x, 1); x += SHFL_XOR(x, 2); x += SHFL_XOR(x, 4); x += SHFL_XOR(x, 8); return x; }
#define LDS_BARRIER() emu_syncthreads()
#else
__device__ __forceinline__ float red16_(float x) {
    x += __builtin_bit_cast(float, __builtin_amdgcn_update_dpp(0, __builtin_bit_cast(int, x), 0xB1, 0xF, 0xF, true));
    x += __builtin_bit_cast(float, __builtin_amdgcn_update_dpp(0, __builtin_bit_cast(int, x), 0x4E, 0xF, 0xF, true));
    x += __builtin_bit_cast(float, __builtin_amdgcn_update_dpp(0, __builtin_bit_cast(int, x), 0x141, 0xF, 0xF, true));
    x += __builtin_bit_cast(float, __builtin_amdgcn_update_dpp(0, __builtin_bit_cast(int, x), 0x140, 0xF, 0xF, true));
    return x;
}
#define LDS_BARRIER() do { asm volatile("s_waitcnt lgkmcnt(0)" ::: "memory"); __builtin_amdgcn_s_barrier(); asm volatile("" ::: "memory"); } while (0)
#endif
#define RC_M(k) (lm + (k) * 4608)
__device__ __forceinline__ void ph_rw_chunk(const Ctx& c, int l, float* ldsf) {
    const bf16_t* FS = WSH(O_FS); const float* DEC = WSF(O_DEC); const float* AA = WSF(O_AA); float* BON = WSF(O_BON);
    const float* kkw = c.in[25] + (size_t)l * W; const float* kaw = c.in[26] + (size_t)l * W; const float* rk = c.in[27] + (size_t)l * W;
    bf16_t* PST = WSH(O_PST); bf16_t* PYT = WSH(O_PYT); float* SVB = WSF(O_SVB); float* YVB = WSF(O_YVB);
    bf16_t* lm = (bf16_t*)ldsf; float* gam = (float*)RC_M(7); float* segp = (float*)RC_M(13); float* gl = segp + 512;
    const int tid = threadIdx.x, wv = tid >> 6, lane = tid & 63, fr = lane & 15, fq = lane >> 4, rt = wv & 3, hf = wv >> 2;
    const int m0 = 16 * rt + fr;
    float wv8[8], kv8[8], rv8[8], vv8[8], aa8[8];
#define RC_LOAD(uu) do { const int chain_ = (uu) / NRC, ck_ = (uu) % NRC, h_ = chain_ & 15, b_ = (chain_ >> 4) & 1, z_ = chain_ >> 5; \
        const long tb_ = (long)b_ * S + (z_ ? S - 1 - ck_ * RCK : ck_ * RCK); const int dirn_ = z_ ? -1 : 1; \
        const float* decp_ = DEC + ((size_t)z_ * T) * W + h_ * 64; const float* aap_ = AA + ((size_t)z_ * T) * W + h_ * 64; const int ch_ = h_ * 64 + lane; \
        _Pragma("unroll") for (int q = 0; q < 8; ++q) wv8[q] = decp_[(size_t)(tb_ + dirn_ * ((tid >> 6) * 8 + q)) * W + (tid & 63)]; \
        _Pragma("unroll") for (int q = 0; q < 8; ++q) { const long t_ = tb_ + dirn_ * (wv + 8 * q); const bf16_t* f_ = FS + (size_t)t_ * RF; kv8[q] = bf2f(f_[1024 + ch_]); rv8[q] = bf2f(f_[ch_]); vv8[q] = bf2f(f_[2048 + ch_]); aa8[q] = aap_[(size_t)t_ * W + lane]; } } while (0)
    if ((int)blockIdx.x < 64 * NRC) RC_LOAD((int)blockIdx.x);
    for (int u = blockIdx.x; u < 64 * NRC; u += gridDim.x) {
        const int chain = u / NRC, ck = u % NRC, h = chain & 15, b = (chain >> 4) & 1, z = chain >> 5;
        const long tb = (long)b * S + (z ? S - 1 - ck * RCK : ck * RCK); const int dirn = z ? -1 : 1;
        { const int k = tid & 63, sg = tid >> 6; float p = 1.f;
#pragma unroll
          for (int q = 0; q < 8; ++q) { p *= wv8[q]; gam[(sg * 8 + q) * 64 + k] = p; }
          segp[sg * 64 + k] = p; }
        LDS_BARRIER();
        { const int k = tid & 63, sg = tid >> 6; float pre = 1.f;
          for (int q = 0; q < sg; ++q) pre *= segp[q * 64 + k];
#pragma unroll
          for (int q = 0; q < 8; ++q) gam[(sg * 8 + q) * 64 + k] *= pre;
          if (sg == 7) gl[k] = gam[63 * 64 + k]; }
        LDS_BARRIER();
        { const int k = lane, ch = h * 64 + k; const float kkwv = kkw[ch], kav = kaw[ch], rkv = rk[ch];
#pragma unroll
          for (int q = 0; q < 8; ++q) { const int tt = wv + 8 * q; const long t = tb + dirn * tt;
            const float vk = kv8[q] * kkwv; const float kkn = vk * frsq_(wave_sum(vk * vk) + EPS); const float ktv = kv8[q] * (1.f + (aa8[q] - 1.f) * kav);
            const float bsum = wave_sum(rv8[q] * rkv * ktv); if (lane == 0) BON[((size_t)z * T + t) * 16 + h] = bsum;
            const float g = gam[tt * 64 + k], gp = tt ? gam[(tt - 1) * 64 + k] : 1.f, ig = frcp_(g);
            const bf16_t khv = (bf16_t)f2bf(kkn * gp), bhv = (bf16_t)f2bf(aa8[q] * kkn * ig);
            RC_M(0)[tt * 72 + k] = khv; RC_M(1)[k * 72 + tt] = khv; RC_M(2)[tt * 72 + k] = bhv; RC_M(3)[k * 72 + tt] = bhv;
            RC_M(4)[tt * 72 + k] = (bf16_t)f2bf(ktv * ig); RC_M(5)[tt * 72 + k] = (bf16_t)f2bf(rv8[q] * g); RC_M(6)[k * 72 + tt] = (bf16_t)f2bf(vv8[q]); } }
        if (u + (int)gridDim.x < 64 * NRC) RC_LOAD(u + (int)gridDim.x);
        LDS_BARRIER();
        f32x4 mkr[2], khr[2], rhT[2];
        {
            f32x4 a0[2], a1[2], a2[2], a3[2];
#pragma unroll
            for (int nt = 0; nt < 2; ++nt) { a0[nt] = (f32x4){0.f, 0.f, 0.f, 0.f}; a1[nt] = a0[nt]; a2[nt] = a0[nt]; a3[nt] = a0[nt]; }
            wave_mma<2, 2>(a0, RC_M(2) + rt * 16 * 72, 72, RC_M(0) + hf * 32 * 72, 72);
            wave_mma<2, 2>(a1, RC_M(4) + rt * 16 * 72, 72, RC_M(0) + hf * 32 * 72, 72);
            wave_mma<2, 2>(a2, RC_M(2) + rt * 16 * 72, 72, RC_M(5) + hf * 32 * 72, 72);
            wave_mma<2, 2>(a3, RC_M(4) + rt * 16 * 72, 72, RC_M(5) + hf * 32 * 72, 72);
#pragma unroll
            for (int nt = 0; nt < 2; ++nt) { const int n0 = 32 * hf + 16 * nt + 4 * fq; f32x4 nn, ti, mk;
#pragma unroll
                for (int r = 0; r < 4; ++r) { const int n = n0 + r; const bool lt = m0 < n, le = m0 <= n;
                    nn[r] = lt ? -a0[nt][r] : 0.f; ti[r] = nn[r] + (m0 == n ? 1.f : 0.f); mk[r] = lt ? a1[nt][r] : 0.f; mkr[nt][r] = le ? a3[nt][r] : 0.f;
                    RC_M(12)[n * 72 + m0] = (bf16_t)f2bf(le ? a2[nt][r] : 0.f);
                    RC_M(8)[n * 72 + m0] = (bf16_t)f2bf(nn[r]);
                    khr[nt][r] = bf2f(RC_M(4)[m0 * 72 + n]); rhT[nt][r] = bf2f(RC_M(5)[n * 72 + m0]); }
                st_bf4(RC_M(7) + m0 * 72 + n0, nn); st_bf4(RC_M(9) + m0 * 72 + n0, ti); st_bf4(RC_M(11) + m0 * 72 + n0, mk); }
        }
        LDS_BARRIER();
        f32x4 tiv[2];
#pragma unroll
        for (int nt = 0; nt < 2; ++nt) tiv[nt] = ld_bf4(RC_M(9) + m0 * 72 + 32 * hf + 16 * nt + 4 * fq);
#pragma unroll 1
        for (int it = 0; it < 5; ++it) {
            bf16_t* pw = (it & 1) ? RC_M(0) : RC_M(7); bf16_t* pwT = (it & 1) ? RC_M(2) : RC_M(8); bf16_t* pw2 = (it & 1) ? RC_M(7) : RC_M(0); bf16_t* pw2T = (it & 1) ? RC_M(8) : RC_M(2);
            bf16_t* tcur = (it & 1) ? RC_M(4) : RC_M(9); bf16_t* tnxt = (it & 1) ? RC_M(9) : RC_M(4);
            f32x4 sq[2];
#pragma unroll
            for (int nt = 0; nt < 2; ++nt) sq[nt] = (f32x4){0.f, 0.f, 0.f, 0.f};
            wave_mma<2, 2>(sq, pw + rt * 16 * 72, 72, pwT + hf * 32 * 72, 72);
#pragma unroll
            for (int nt = 0; nt < 2; ++nt) { const int n0 = 32 * hf + 16 * nt + 4 * fq; st_bf4(pw2 + m0 * 72 + n0, sq[nt]);
#pragma unroll
                for (int r = 0; r < 4; ++r) pw2T[(n0 + r) * 72 + m0] = (bf16_t)f2bf(sq[nt][r]); }
            LDS_BARRIER();
            f32x4 up[2];
#pragma unroll
            for (int nt = 0; nt < 2; ++nt) up[nt] = (f32x4){0.f, 0.f, 0.f, 0.f};
            wave_mma<2, 2>(up, tcur + rt * 16 * 72, 72, pw2T + hf * 32 * 72, 72);
#pragma unroll
            for (int nt = 0; nt < 2; ++nt) { const int n0 = 32 * hf + 16 * nt + 4 * fq; tiv[nt] += up[nt]; st_bf4(tnxt + m0 * 72 + n0, tiv[nt]);
                if (it == 4) {
#pragma unroll
                    for (int r = 0; r < 4; ++r) RC_M(10)[(n0 + r) * 72 + m0] = (bf16_t)f2bf(tiv[nt][r]); } }
            LDS_BARRIER();
        }
        {
            f32x4 w1[2], w2[2];
#pragma unroll
            for (int nt = 0; nt < 2; ++nt) { w1[nt] = (f32x4){0.f, 0.f, 0.f, 0.f}; w2[nt] = w1[nt]; }
            wave_mma<2, 2>(w1, RC_M(1) + rt * 16 * 72, 72, RC_M(10) + hf * 32 * 72, 72);
            wave_mma<2, 2>(w2, RC_M(11) + rt * 16 * 72, 72, RC_M(10) + hf * 32 * 72, 72);
#pragma unroll
            for (int nt = 0; nt < 2; ++nt) { const int n0 = 32 * hf + 16 * nt + 4 * fq; st_bf4(RC_M(7) + m0 * 72 + n0, w1[nt]); st_bf4(RC_M(8) + m0 * 72 + n0, w2[nt]); }
        }
        LDS_BARRIER();
        {
            f32x4 py[2], qy[2], ps[2], qs[2];
#pragma unroll
            for (int nt = 0; nt < 2; ++nt) { py[nt] = (f32x4){0.f, 0.f, 0.f, 0.f}; qy[nt] = py[nt]; ps[nt] = py[nt]; qs[nt] = py[nt]; }
            wave_mma<2, 2>(py, RC_M(7) + rt * 16 * 72, 72, RC_M(12) + hf * 32 * 72, 72);
            wave_mma<2, 2>(qy, RC_M(8) + rt * 16 * 72, 72, RC_M(12) + hf * 32 * 72, 72);
            wave_mma<2, 2>(ps, RC_M(7) + rt * 16 * 72, 72, RC_M(3) + hf * 32 * 72, 72);
            wave_mma<2, 2>(qs, RC_M(8) + rt * 16 * 72, 72, RC_M(3) + hf * 32 * 72, 72);
#pragma unroll
            for (int nt = 0; nt < 2; ++nt) { const int n0 = 32 * hf + 16 * nt + 4 * fq;
#pragma unroll
                for (int r = 0; r < 4; ++r) { const int n = n0 + r; const float gln = gl[n];
                    RC_M(0)[n * 72 + m0] = (bf16_t)f2bf(rhT[nt][r] - py[nt][r]); RC_M(2)[n * 72 + m0] = (bf16_t)f2bf(mkr[nt][r] - qy[nt][r]);
                    RC_M(4)[n * 72 + m0] = (bf16_t)f2bf(((m0 == n ? 1.f : 0.f) - ps[nt][r]) * gln); RC_M(5)[n * 72 + m0] = (bf16_t)f2bf((khr[nt][r] - qs[nt][r]) * gln); } }
        }
        LDS_BARRIER();
        {
            f32x4 yv[2], sv[2];
#pragma unroll
            for (int nt = 0; nt < 2; ++nt) { yv[nt] = (f32x4){0.f, 0.f, 0.f, 0.f}; sv[nt] = yv[nt]; }
            wave_mma<2, 2>(yv, RC_M(6) + rt * 16 * 72, 72, RC_M(2) + hf * 32 * 72, 72);
            wave_mma<2, 2>(sv, RC_M(6) + rt * 16 * 72, 72, RC_M(5) + hf * 32 * 72, 72);
#pragma unroll
            for (int nt = 0; nt < 2; ++nt) { const int n0 = 32 * hf + 16 * nt + 4 * fq; *(f32x4*)(YVB + (size_t)u * 4096 + m0 * 64 + n0) = yv[nt]; *(f32x4*)(SVB + (size_t)u * 4096 + m0 * 64 + n0) = sv[nt]; }
            { const int rr = tid >> 3, c8 = (tid & 7) * 8; *(u32x4*)(PYT + (size_t)u * 4096 + rr * 64 + c8) = *(const u32x4*)(RC_M(0) + rr * 72 + c8); *(u32x4*)(PST + (size_t)u * 4096 + rr * 64 + c8) = *(const u32x4*)(RC_M(4) + rr * 72 + c8); }
        }
        LDS_BARRIER();
    }
}
#undef RC_M
#undef RC_LOAD
__device__ __forceinline__ void ph_rw_seq(const Ctx& c, float* ldsf) {
    const bf16_t* PST = WSH(O_PST); const bf16_t* PYT = WSH(O_PYT); const float* SVB = WSF(O_SVB); const float* YVB = WSF(O_YVB); float* YY = WSF(O_YY);
    bf16_t* Sb = (bf16_t*)ldsf;
    bf16_t* Pm = Sb + 2 * 16 * 72;
    const int tid = threadIdx.x, wv = tid >> 6, lane = tid & 63, fr = lane & 15, fq = lane >> 4, isY = wv >> 2, nt0 = wv & 3;
    for (int u = blockIdx.x; u < 256; u += gridDim.x) {
        const int x = u & 7, jq = u >> 3, chain = x * 8 + (jq >> 2), qt = jq & 3, h = chain & 15, b = (chain >> 4) & 1, z = chain >> 5;
        const size_t ub = (size_t)chain * NRC;
        const int rr = tid >> 3, c8 = (tid & 7) * 8;
        constexpr int PD = NRC >= 8 ? 8 : 4;
        for (int i = tid; i < 2 * 16 * 72 / 2; i += NT) ((unsigned*)Sb)[i] = 0u;
        const int row = 16 * qt + fr, n0 = 16 * nt0 + 4 * fq; const float* addp = (isY ? YVB : SVB) + ub * 4096 + row * 64 + n0;
        const bf16_t* psp = PST + ub * 4096 + rr * 64 + c8; const bf16_t* pyp = PYT + ub * 4096 + rr * 64 + c8;
        u32x4 gps[PD], gpy[PD]; f32x4 add[PD];
#pragma unroll
        for (int j = 0; j < PD; ++j) { gps[j] = *(const u32x4*)(psp + (size_t)j * 4096); gpy[j] = *(const u32x4*)(pyp + (size_t)j * 4096); add[j] = *(const f32x4*)(addp + (size_t)j * 4096); }
        *(u32x4*)(Pm + (0 * 2 + 0) * 4608 + rr * 72 + c8) = gps[0]; *(u32x4*)(Pm + (0 * 2 + 1) * 4608 + rr * 72 + c8) = gpy[0];
        if (PD < NRC) { gps[0] = *(const u32x4*)(psp + (size_t)PD * 4096); gpy[0] = *(const u32x4*)(pyp + (size_t)PD * 4096); }
        SYNCTHREADS();
        for (int ck0 = 0; ck0 < NRC; ck0 += PD) {
#pragma unroll
            for (int j = 0; j < PD; ++j) {
                const int ck = ck0 + j, cur = j & 1, nxt = cur ^ 1;
                f32x4 acc[1]; acc[0] = (f32x4){0.f, 0.f, 0.f, 0.f};
                wave_mma<2, 1>(acc, Sb + cur * 16 * 72, 72, Pm + (cur * 2 + isY) * 4608 + nt0 * 16 * 72, 72);
                acc[0] += add[j];
                if (ck + PD < NRC) add[j] = *(const f32x4*)(addp + (size_t)(ck + PD) * 4096);
                if (isY) {
#pragma unroll
                    for (int r = 0; r < 4; ++r) { const int step = ck * RCK + n0 + r, sidx = z ? S - 1 - step : step; YY[((size_t)z * T + (size_t)b * S + sidx) * W + h * 64 + row] = acc[0][r]; }
                } else st_bf4(Sb + nxt * 16 * 72 + fr * 72 + n0, acc[0]);
                const int jn = (j + 1) % PD;
                if (ck + 1 < NRC) { *(u32x4*)(Pm + (nxt * 2 + 0) * 4608 + rr * 72 + c8) = gps[jn]; *(u32x4*)(Pm + (nxt * 2 + 1) * 4608 + rr * 72 + c8) = gpy[jn]; }
                if (ck + 1 + PD < NRC) { gps[jn] = *(const u32x4*)(psp + (size_t)(ck + 1 + PD) * 4096); gpy[jn] = *(const u32x4*)(pyp + (size_t)(ck + 1 + PD) * 4096); }
                LDS_BARRIER();
            }
        }
    }
}
__device__ __forceinline__ void ph_rw_out(const Ctx& c) {
    const bf16_t* FS = WSH(O_FS); const float* YY = WSF(O_YY); const float* BON = WSF(O_BON); const float* GG = WSF(O_GG); bf16_t* Y = WSH(O_YS);
    const int lane = threadIdx.x & 63, gw = blockIdx.x * (NT / 64) + (threadIdx.x >> 6), ngw = gridDim.x * (NT / 64);
    for (int i = gw; i < T * 4; i += ngw) {
        const int h0 = (i & 3) * 4; const long t = i >> 2; float y0[4], y1[4], gv[4], vv[4], bs[4];
#pragma unroll
        for (int q = 0; q < 4; ++q) { const int ch = (h0 + q) * 64 + lane; y0[q] = YY[(size_t)t * W + ch]; y1[q] = YY[((size_t)T + t) * W + ch]; gv[q] = GG[(size_t)t * W + ch]; vv[q] = bf2f(FS[(size_t)t * RF + 2048 + ch]);
            bs[q] = BON[(size_t)t * 16 + h0 + q] + BON[((size_t)T + t) * 16 + h0 + q]; }
#pragma unroll
        for (int q = 0; q < 4; ++q) { const int ch = (h0 + q) * 64 + lane;
            const float m0 = wave_sum(y0[q]) * (1.f / 64.f), m1 = wave_sum(y1[q]) * (1.f / 64.f); const float d0 = y0[q] - m0, d1 = y1[q] - m1;
            const float r0 = 1.f / sqrtf(wave_sum(d0 * d0) * (1.f / 64.f) + EPS), r1 = 1.f / sqrtf(wave_sum(d1 * d1) * (1.f / 64.f) + EPS);
            Y[(size_t)t * 4 * W + 3 * W + ch] = (bf16_t)f2bf((d0 * r0 + d1 * r1 + bs[q] * vv[q]) * gv[q]); }
    }
}
__device__ __forceinline__ void ph_router(const Ctx& c, int l, float* ldsf) {
    const float* H = WSF(O_HF); const bf16_t* WH = WSH(O_WRH); const bf16_t* WL = WSH(O_WRL); const float* bg = c.in[31] + (size_t)l * 4; const float* be = c.in[33] + (size_t)l * 32;
    int* EID = WSI(O_EID); float* EWT = WSF(O_EWT); int* cnt = CTLW(c) + CW_CNT + l * 64;
    const int tid = threadIdx.x, wv = tid >> 6, lane = tid & 63, fr = lane & 15, fq = lane >> 4, rt = wv & 1, kq = wv >> 1;
    float* part = ldsf;
    for (int u = blockIdx.x; u < T / 32; u += gridDim.x) {
        const long t0 = (long)u * 32; f32x4 acc[3];
#pragma unroll
        for (int nt = 0; nt < 3; ++nt) acc[nt] = (f32x4){0.f, 0.f, 0.f, 0.f};
#ifdef CPU_EMU
        for (int nt = 0; nt < 3; ++nt) for (int r = 0; r < 4; ++r) { const int n = 16 * nt + 4 * fq + r; float sacc = 0.f;
            for (int k = kq * 512; k < kq * 512 + 512; ++k) { const float hv = H[(size_t)(t0 + 16 * rt + fr) * D + k]; const float hh = bf2f((bf16_t)f2bf(hv)), hl = bf2f((bf16_t)f2bf(hv - hh));
                const float wh = bf2f(WH[(size_t)n * D + k]), wl = bf2f(WL[(size_t)n * D + k]); sacc += hh * wh + hl * wh + hh * wl; }
            acc[nt][r] = sacc; }
#else
        const float* hp = H + (size_t)(t0 + 16 * rt + fr) * D + kq * 512 + fq * 8;
#pragma unroll 4
        for (int ks = 0; ks < 16; ++ks) {
            const f32x4 h0 = *(const f32x4*)(hp + ks * 32), h1 = *(const f32x4*)(hp + ks * 32 + 4); bf16x8 ah, al;
#pragma unroll
            for (int e = 0; e < 4; ++e) { const unsigned b0 = f2bf(h0[e]), b1 = f2bf(h1[e]); ah[e] = (short)b0; ah[4 + e] = (short)b1; al[e] = (short)f2bf(h0[e] - u2f_(b0 << 16)); al[4 + e] = (short)f2bf(h1[e] - u2f_(b1 << 16)); }
#pragma unroll
            for (int nt = 0; nt < 3; ++nt) { const size_t wo = (size_t)(16 * nt + fr) * D + kq * 512 + ks * 32 + fq * 8; const bf16x8 bh = *(const bf16x8*)(WH + wo), bl = *(const bf16x8*)(WL + wo);
                acc[nt] = __builtin_amdgcn_mfma_f32_16x16x32_bf16(bh, ah, acc[nt], 0, 0, 0); acc[nt] = __builtin_amdgcn_mfma_f32_16x16x32_bf16(bh, al, acc[nt], 0, 0, 0); acc[nt] = __builtin_amdgcn_mfma_f32_16x16x32_bf16(bl, ah, acc[nt], 0, 0, 0); }
        }
#endif
#pragma unroll
        for (int nt = 0; nt < 3; ++nt) *(f32x4*)(part + (kq * 32 + 16 * rt + fr) * 48 + 16 * nt + 4 * fq) = acc[nt];
        SYNCTHREADS();
        if (tid < 32) { const long t = t0 + tid; float lg[36];
#pragma unroll
            for (int q = 0; q < 36; ++q) lg[q] = (part[(0 * 32 + tid) * 48 + q] + part[(1 * 32 + tid) * 48 + q]) + (part[(2 * 32 + tid) * 48 + q] + part[(3 * 32 + tid) * 48 + q]) + (q < 4 ? bg[q < 4 ? q : 0] : be[q >= 4 ? q - 4 : 0]);
            int gi = 0; float m = lg[0];
#pragma unroll
            for (int q = 1; q < 4; ++q) if (lg[q] > m) { m = lg[q]; gi = q; }
            float den = 0.f;
#pragma unroll
            for (int q = 0; q < 4; ++q) den += expf(lg[q] - m);
            const float gp = 1.f / den; float el[8];
#pragma unroll
            for (int q = 0; q < 8; ++q) el[q] = gi == 0 ? lg[4 + q] : gi == 1 ? lg[12 + q] : gi == 2 ? lg[20 + q] : lg[28 + q];
            int i1 = 0; float m1 = el[0];
#pragma unroll
            for (int q = 1; q < 8; ++q) if (el[q] > m1) { m1 = el[q]; i1 = q; }
            int i2 = -1; float m2 = 0.f;
#pragma unroll
            for (int q = 0; q < 8; ++q) if (q != i1 && (i2 < 0 || el[q] > m2)) { m2 = el[q]; i2 = q; }
            const float p2 = expf(m2 - m1);
            EID[t * 2] = gi * 8 + i1; EID[t * 2 + 1] = gi * 8 + i2; EWT[t * 2] = gp / (1.f + p2); EWT[t * 2 + 1] = gp * p2 / (1.f + p2);
            atomic_add_i(cnt + gi * 8 + i1, 1); atomic_add_i(cnt + gi * 8 + i2, 1);
        }
        SYNCTHREADS();
    }
}
__device__ __forceinline__ void ph_moe_plan(const Ctx& c, int l) {
    int* cnt = CTLW(c) + CW_CNT + l * 64; int* plan = CTLW(c) + CW_PLAN + l * 256;
    if (GT_ == 0) {
        int ps = 0, nb = 0;
        for (int e = 0; e < NE; ++e) { plan[e] = ps; const int nblk = (cnt[e] + 255) / 256; for (int q = 0; q < nblk; ++q) plan[64 + nb++] = e; ps += nblk * 256; }
        plan[32] = ps; plan[40] = nb;
    }
}
__device__ __forceinline__ void ph_moe_assign(const Ctx& c, int l) {
    const int* EID = WSI(O_EID); int* fill = CTLW(c) + CW_FILL + l * 64; const int* plan = CTLW(c) + CW_PLAN + l * 256; int* DEST = WSI(O_DEST);
    for (long i = GT_; i < (long)T * 2; i += GS_) { const int e = EID[i]; const int pos = atomic_add_i(fill + e, 1); DEST[i] = plan[e] + pos; }
}
__device__ __forceinline__ void ph_moe_gather(const Ctx& c) {
    const int* DEST = WSI(O_DEST); const u32x4* H = (const u32x4*)WSH(O_H); u32x4* XS = (u32x4*)WSH(O_XS);
    for (long i = GT_; i < (long)T * 2 * (D / 8); i += GS_) { const int q = (int)(i % (D / 8)); const long a = i / (D / 8); XS[(size_t)DEST[a] * (D / 8) + q] = H[(size_t)(a >> 1) * (D / 8) + q]; }
}
#ifndef CPU_EMU
#define XB_TMO      128
#define XB_XCNT(j)  (256  + 64 * (j))
#define XB_XSUB(j)  (1280 + 64 * (j))
#define XB_XGEN(j)  (2304 + 64 * (j))
#define XB_TOP      3328
#define XB_TOPGEN   3392
#define XCD_BAR_WORDS 3456
#define XB_SPIN_CAP (1u << 26)
#define LAS __attribute__((address_space(3)))
__device__ __forceinline__ unsigned xb_ld(unsigned* p)              { return __hip_atomic_load(p, __ATOMIC_RELAXED, __HIP_MEMORY_SCOPE_AGENT); }
__device__ __forceinline__ unsigned xb_add(unsigned* p, unsigned v) { return __hip_atomic_fetch_add(p, v, __ATOMIC_RELAXED, __HIP_MEMORY_SCOPE_AGENT); }
__device__ __forceinline__ unsigned xb_xcc_id() { return (unsigned)__builtin_amdgcn_s_getreg((3 << 11) | 20) & 0xFu; }
#define XB_SPIN(cond, bar) do { unsigned _sp = 0; while (cond) { __builtin_amdgcn_s_sleep(1); \
    if ((++_sp & 255u) == 0u) { if (xb_ld(&(bar)[XB_TMO])) break; if (_sp > XB_SPIN_CAP) { atomicAdd(&(bar)[XB_TMO], 1u); break; } } } } while (0)
struct XcdBarrier { unsigned* bar; unsigned x; volatile LAS unsigned* st; };
__device__ __forceinline__ XcdBarrier xcd_barrier_post(unsigned* bar, volatile LAS unsigned* st) {
    XcdBarrier b; b.bar = bar; b.x = xb_xcc_id(); b.st = st;
    if (threadIdx.x == 0) (void)xb_add(&bar[XB_XCNT(b.x)], 1u);
    return b;
}
__device__ __forceinline__ void xcd_barrier_complete(unsigned* bar, unsigned x, unsigned& nloc, unsigned& nx) {
    const unsigned G = gridDim.x * gridDim.y * gridDim.z;
    unsigned sum, cnt, mine, sp = 0u;
    for (;;) {
        sum = 0u; cnt = 0u; mine = 0u;
#pragma unroll
        for (unsigned j = 0; j < 16; ++j) { const unsigned cc = xb_ld(&bar[XB_XCNT(j)]); sum += cc; cnt += (cc > 0u) ? 1u : 0u; mine = (j == x) ? cc : mine; }
        if (sum == G) break;
        __builtin_amdgcn_s_sleep(1);
        if ((++sp & 255u) == 0u) { if (xb_ld(&bar[XB_TMO])) break; if (sp > XB_SPIN_CAP) { atomicAdd(&bar[XB_TMO], 1u); break; } }
    }
    nloc = mine > 0u ? mine : 1u; nx = cnt > 0u ? cnt : 1u;
}
__device__ __forceinline__ void xcd_barrier(const XcdBarrier& b) {
    asm volatile("s_waitcnt vmcnt(0)" ::: "memory");
    __syncthreads();
    if (threadIdx.x == 0) {
        unsigned* bar = b.bar;
        __builtin_amdgcn_s_waitcnt(0);
        unsigned nloc = b.st[0], nx = b.st[1];
        if (nloc == 0u) { xcd_barrier_complete(bar, b.x, nloc, nx); b.st[0] = nloc; b.st[1] = nx; }
        const unsigned old = xb_add(&bar[XB_XSUB(b.x)], 1u);
        const unsigned gen = old / nloc;
        if (old + 1u == (gen + 1u) * nloc) {
            __builtin_amdgcn_fence(__ATOMIC_RELEASE, "agent");
            asm volatile("s_waitcnt vmcnt(0)" ::: "memory");
            const unsigned og = xb_add(&bar[XB_TOP], 1u);
            const unsigned tg = og / nx;
            if (og + 1u == (tg + 1u) * nx) xb_add(&bar[XB_TOPGEN], 1u);
            else XB_SPIN(xb_ld(&bar[XB_TOPGEN]) == tg, bar);
            __builtin_amdgcn_fence(__ATOMIC_ACQUIRE, "agent");
            xb_add(&bar[XB_XGEN(b.x)], 1u);
            asm volatile("s_waitcnt vmcnt(0)" ::: "memory");
        } else {
            XB_SPIN(xb_ld(&bar[XB_XGEN(b.x)]) == gen, bar);
            __builtin_amdgcn_fence(__ATOMIC_ACQUIRE, "agent");
            asm volatile("s_waitcnt vmcnt(0)" ::: "memory");
        }
    }
    __syncthreads();
}
#endif

constexpr int LDS_BYTES = 147456;

__global__ void __launch_bounds__(NT, 2) fwd(Params p) {
#ifdef CPU_EMU
    unsigned char* lds = g_lds; float* ldsf = (float*)g_lds;
#else
    extern __shared__ __attribute__((aligned(16))) unsigned char lds[];
    float* ldsf = (float*)lds;
    volatile LAS unsigned* misc = (volatile LAS unsigned*)((LAS unsigned char*)lds + LDS_BYTES - 64);
    if (threadIdx.x == 0) { misc[0] = 0u; misc[1] = 0u; }
    __syncthreads();
    XcdBarrier bar = xcd_barrier_post((unsigned*)(p.ws + O_CTL) + CW_BAR, misc);
#endif
    Ctx c; c.in = p.in; c.out = p.out; c.ws = p.ws;
    const int lo = p.ph_lo, hi = p.ph_hi; int ph = 0;
    const int G = (int)gridDim.x, cwg = (int)blockIdx.x;
#ifdef CPU_EMU
#define GRID_BAR()
#else
#define GRID_BAR() xcd_barrier(bar)
#endif
#ifndef REPEAT_MASK
#define REPEAT_MASK 0
#endif
#ifndef TIME_PHASE
#define TIME_PHASE -1
#endif
#if TIME_PHASE >= 0 && !defined(CPU_EMU)
    unsigned long long tp0 = 0, tp1 = 0;
#define TP_BEGIN() do { if (ph == TIME_PHASE) tp0 = __builtin_amdgcn_s_memrealtime(); } while (0)
#define TP_END() do { if (ph == TIME_PHASE) tp1 = __builtin_amdgcn_s_memrealtime(); } while (0)
#else
#define TP_BEGIN()
#define TP_END()
#endif
#define PHASE(...) do { if (lo <= ph && ph < hi) { TP_BEGIN(); __VA_ARGS__; if (ph + 1 < hi) { GRID_BAR(); } TP_END(); } ++ph; } while (0)
#define PHASEG(grp, ...) do { if (lo <= ph && ph < hi) { TP_BEGIN(); if ((REPEAT_MASK >> (grp)) & 1) { __VA_ARGS__; GRID_BAR(); } __VA_ARGS__; if (ph + 1 < hi) { GRID_BAR(); } TP_END(); } ++ph; } while (0)
    PHASE(ph_mod(c, ldsf));
#define LAYER_BODY(l) do { const float* mod = WSF(O_MOD); \
        const float* xin = l == 0 ? c.in[0] : WSF(O_X1); float* xmid = WSF(O_X0); float* xout = WSF(O_X1); \
        const float* ml = mod + (size_t)l * NB * D6; \
        PHASEG(3, ph_convert(c, l, ldsf)); \
        PHASEG(0, { pg8::Gemm g{D, D, D}; pg8::StaticOrder so; so.init(T, PW, G, cwg, WSH(O_H), WSH(O_WIN), D, D); pg8::EpiBf16 E{WSH(O_P), PW}; pg8::gemm_phase(lds, g, so, E); \
            { const int nun_ = (T / 256) * (PW / 256), rem_ = nun_ % G; if (rem_ != 0 && cwg >= rem_) { SYNCTHREADS(); convert_big(c, l, ldsf, J_ALL - convert_tail_tiles(), J_ALL, cwg - rem_, G - rem_); } } }); \
        PHASE(ph_lru<1>(c, l, ldsf); ph_ret_kv(c, ldsf); ph_sgu_norm(c, l); ph_rw_shift(c, l)); \
        PHASE(ph_lru_scan2(c); ph_ret_state(c); ph_sgu_mix(c, l, ldsf); ph_rw_lora(c, l, ldsf)); \
        PHASE(ph_lru<2>(c, l, ldsf); ph_ret_out(c, ldsf); ph_rw_chunk(c, l, ldsf)); \
        PHASE(ph_rw_seq(c, ldsf)); \
        PHASE(ph_rw_out(c)); \
        PHASEG(1, { pg8::Gemm g{W, 4 * W, 4 * W}; pg8::MergeOrder mo; mo.so.init(T, D, G, cwg, WSH(O_YS), WSH(O_WBR), 4 * W, 4 * W); mo.kseg_bytes = W * 2; pg8::EpiMerge E{WSH(O_P), WSH(O_MRG)}; pg8::gemm_phase(lds, g, mo, E); }); \
        PHASEG(1, { pg8::Gemm g{D, D, D}; pg8::StaticOrder so; so.init(T, D, G, cwg, WSH(O_MRG), WSH(O_WOUT), D, D); pg8::EpiResid E{xin, ml + 2 * D, xmid}; pg8::gemm_phase(lds, g, so, E); }); \
        PHASEG(6, ph_norm(c, xmid, c.in[4] + (size_t)l * D, ml + 3 * D, ml + 4 * D, WSH(O_H), WSF(O_HF))); \
        PHASE(ph_router(c, l, ldsf)); \
        PHASE(ph_moe_plan(c, l)); \
        PHASE(ph_moe_assign(c, l)); \
        PHASEG(6, ph_moe_gather(c)); \
        const int* plan = CTLW(c) + CW_PLAN + l * 256; \
        PHASEG(2, { pg8::Gemm g{D, D, D}; pg8::MoeOrder mo{G, cwg, 4, plan, (const char*)WSH(O_XS), (const char*)WSH(O_WGU), (size_t)256 * D * 2, (size_t)256 * D * 2, (size_t)1024 * D * 2}; pg8::EpiGU E{WSH(O_ACT)}; pg8::gemm_phase(lds, g, mo, E); \
            if (l == 0) { const int nrest_ = plan[40] * 4 - G; if (nrest_ >= 0 && nrest_ < G && cwg >= nrest_) { SYNCTHREADS(); convert_big(c, 1, ldsf, 0, convert_early_tiles(c), cwg - nrest_, G - nrest_); } } }); \
        PHASEG(2, { pg8::Gemm g{512, 512, 512}; pg8::MoeOrder mo{G, cwg, 8, plan, (const char*)WSH(O_ACT), (const char*)WSH(O_WDN), (size_t)256 * 512 * 2, (size_t)256 * 512 * 2, (size_t)D * 512 * 2}; pg8::EpiBf16 E{WSH(O_YE), D}; pg8::gemm_phase(lds, g, mo, E); }); \
        if (l == 0) PHASE(ph_comb_norm<0>(c, xmid, ml + 5 * D, xout, c.in[3] + (size_t)1 * D, mod + (size_t)1 * NB * D6 + 0 * D, mod + (size_t)1 * NB * D6 + 1 * D, WSH(O_H), nullptr)); \
        else PHASE(ph_comb_norm<1>(c, xmid, ml + 5 * D, xout, c.in[36], nullptr, nullptr, nullptr, c.out)); \
    } while (0)
    PHASE(ph_norm(c, c.in[0], c.in[3], WSF(O_MOD) + 0 * D, WSF(O_MOD) + 1 * D, WSH(O_H), nullptr));
    LAYER_BODY(0);
    LAYER_BODY(1);
#undef LAYER_BODY
#if TIME_PHASE >= 0 && !defined(CPU_EMU)
    if (blockIdx.x == 0) { const unsigned long long te = __builtin_amdgcn_s_memrealtime(), dl = 8ull * (tp1 - tp0); while (__builtin_amdgcn_s_memrealtime() - te < dl) __builtin_amdgcn_s_sleep(8); }
#endif
#undef PHASE
}
}

#ifndef CPU_EMU
extern "C" void kernel_launch(void* const* d_in, const int* in_sizes, int n_in, void* d_out, int out_size, void* d_ws, size_t ws_size, hipStream_t stream) {
    static int grid = 0;
    if (grid == 0) {
        if (n_in != 37 || out_size != T * D || ws_size < WS_END) { fprintf(stderr, "kernel_launch: unexpected shapes (n_in %d out %d ws %zu need %zu)\n", n_in, out_size, ws_size, (size_t)WS_END); grid = -1; return; }
        int dev = 0, cus = 0, per_cu = 0;
        if (hipGetDevice(&dev) != hipSuccess || hipDeviceGetAttribute(&cus, hipDeviceAttributeMultiprocessorCount, dev) != hipSuccess) { grid = -1; return; }
        if (hipFuncSetAttribute((const void*)fwd, hipFuncAttributeMaxDynamicSharedMemorySize, LDS_BYTES) != hipSuccess) { fprintf(stderr, "kernel_launch: hipFuncSetAttribute failed\n"); grid = -1; return; }
        if (hipOccupancyMaxActiveBlocksPerMultiprocessor(&per_cu, (const void*)fwd, NT, LDS_BYTES) != hipSuccess || per_cu < 1) fprintf(stderr, "kernel_launch: occupancy query says %d\n", per_cu);
        (void)hipGetLastError();
        grid = cus;
    }
    if (grid < 0) return;
    (void)in_sizes;
    (void)hipMemsetAsync((char*)d_ws + O_CTL, 0, CTL_BYTES, stream);
    Params p{};
    for (int i = 0; i < 37; ++i) p.in[i] = (const float*)d_in[i];
    p.out = (float*)d_out; p.ws = (unsigned char*)d_ws;
#if ONE_LAUNCH
    p.ph_lo = 0; p.ph_hi = NPH;
    hipLaunchKernelGGL(fwd, dim3(grid), dim3(NT), LDS_BYTES, stream, p);
#else
    for (int k = 0; k < NPH; ++k) { p.ph_lo = k; p.ph_hi = k + 1; hipLaunchKernelGGL(fwd, dim3(grid), dim3(NT), LDS_BYTES, stream, p); }
#endif
}
#endif
```

```cpp
#ifndef CPU_EMU
#include <hip/hip_runtime.h>
#endif
#include <cstdio>
#include <cstdint>
#include <cmath>
#include <cstring>

#ifndef SEQ
#define SEQ 4096
#endif
#ifndef ONE_LAUNCH
#define ONE_LAUNCH 1
#endif

namespace {
constexpr int D = 2048, NB = 2, S = SEQ, T = NB * S, NL = 2, W = 1024;
constexpr int INW = 18816, RF = 3456, D6 = 6 * D;
constexpr int C_LX = 0, C_LG = 1024, C_RQ = 2048, C_RK = 2560, C_RV = 3072, C_RG = 4096, C_SU = 5120, C_SV = 6144, C_RW = 7168;
constexpr int PW = 18944, C_MLP = 10752;
constexpr int NCH = S / 128;
constexpr int NLC = S / 64;
constexpr int NE = 32, CAP = (T * 2 / 256 + NE) * 256, MAXBLK = CAP / 256;
constexpr float EPS = 1e-6f;
constexpr float DECAY_SCALE = 0.60653065971263342f;
constexpr int NT = 512;
constexpr int NPH_LAYER = 17, NPH = 2 + NL * NPH_LAYER;
typedef unsigned short bf16_t;
#ifdef CPU_EMU
typedef float f32x4 __attribute__((vector_size(16)));
typedef unsigned u32x4 __attribute__((vector_size(16)));
#else
typedef float f32x4 __attribute__((ext_vector_type(4)));
typedef unsigned u32x4 __attribute__((ext_vector_type(4)));
typedef short bf16x8 __attribute__((ext_vector_type(8)));
#endif

constexpr size_t al256(size_t x) { return (x + 255) & ~(size_t)255; }
constexpr size_t SZ_X = (size_t)T * D * 4, SZ_W = (size_t)T * W * 4;
constexpr size_t O_CTL = 0, CTL_BYTES = 1u << 20;
constexpr size_t O_MOD = CTL_BYTES;
constexpr size_t O_X0 = O_MOD + al256((size_t)NL * NB * D6 * 4);
constexpr size_t O_X1 = O_X0 + SZ_X;
constexpr size_t O_H = O_X1 + SZ_X;
constexpr size_t O_HF = O_H + SZ_X / 2;
constexpr size_t O_P = O_HF + SZ_X;
constexpr size_t SZ_P = (size_t)T * PW * 2;
constexpr size_t O_XC = O_P + SZ_P;
constexpr size_t O_LA = O_XC + SZ_W, O_LU = O_LA + 2 * SZ_W;
constexpr size_t SZ_LC = (size_t)2 * NB * NLC * W * 4;
constexpr size_t O_LCA = O_LU + 2 * SZ_W, O_LCH = O_LCA + SZ_LC, O_LCI = O_LCH + SZ_LC;
constexpr size_t O_YS = O_LCI + SZ_LC;
constexpr size_t O_SC = O_YS + (size_t)T * 4 * W * 2;
constexpr size_t SZ_KV = (size_t)NB * NCH * 8 * 64 * 128 * 4;
constexpr size_t O_KVF = O_SC, O_KVB = O_KVF + SZ_KV, O_STF = O_KVB + SZ_KV, O_STB = O_STF + SZ_KV;
constexpr size_t O_VN = O_STB + SZ_KV;
constexpr size_t O_FS = O_VN + SZ_W;
constexpr size_t O_DEC = O_FS + al256((size_t)T * RF * 4), O_AA = O_DEC + 2 * SZ_W, O_AKK = O_AA + 2 * SZ_W;
constexpr size_t O_GG = O_AKK, O_YY = O_GG + SZ_W;
constexpr int RCK = 64, NRC = S / RCK;
constexpr size_t O_BON = O_YY + 2 * SZ_W;
constexpr size_t O_PART = O_BON + al256((size_t)2 * T * 16 * 4);
constexpr size_t O_MRG = O_PART + SZ_X;
constexpr size_t O_LOG = O_MRG + SZ_X / 2;
constexpr size_t O_EID = O_LOG + al256((size_t)T * 40 * 4), O_EWT = O_EID + al256((size_t)T * 2 * 4), O_DEST = O_EWT + al256((size_t)T * 2 * 4);
constexpr size_t O_SLOT = O_DEST + al256((size_t)T * 2 * 4);
constexpr size_t O_PST = O_SLOT + al256((size_t)CAP * 4), O_PYT = O_PST + (size_t)64 * NRC * 4096 * 2, O_SVB = O_PYT + (size_t)64 * NRC * 4096 * 2, O_YVB = O_SVB + (size_t)64 * NRC * 4096 * 4;
constexpr size_t O_WIN = O_YVB + (size_t)64 * NRC * 4096 * 4;
constexpr size_t O_WBR = O_WIN + (size_t)PW * D * 2;
constexpr size_t O_WOUT = O_WBR + (size_t)D * 4 * W * 2;
constexpr size_t O_WGU = O_WOUT + (size_t)D * D * 2;
constexpr size_t O_WDN = O_WGU + (size_t)NE * 1024 * D * 2;
constexpr size_t O_G8 = O_WDN + (size_t)NE * D * 512 * 2;
constexpr size_t O_WLR = O_G8 + (size_t)T * 4 * D;
constexpr size_t O_WUT = O_WLR + (size_t)32 * 128 * 128 * 2;
constexpr size_t O_WAT = O_WUT + (size_t)2 * W * 64 * 2;
constexpr size_t O_WGT = O_WAT + (size_t)2 * W * 64 * 2;
constexpr size_t O_WRH = O_WGT + (size_t)W * 128 * 2;
constexpr size_t O_WRL = O_WRH + (size_t)48 * D * 2;
constexpr size_t WS_END0 = O_WRL + (size_t)48 * D * 2;
constexpr size_t SZ_MOE = (size_t)CAP * (D + 512 + D) * 2;
constexpr bool MOE_OVERLAY = SZ_MOE <= SZ_P;
constexpr size_t O_XS = MOE_OVERLAY ? O_P : WS_END0;
constexpr size_t O_ACT = O_XS + (size_t)CAP * D * 2;
constexpr size_t O_YE = O_ACT + (size_t)CAP * 512 * 2;
constexpr size_t WS_END = MOE_OVERLAY ? WS_END0 : WS_END0 + SZ_MOE;
static_assert(SEQ != 4096 || WS_END <= (size_t)2040 * 1024 * 1024, "workspace budget: d_ws is 4 x the largest input = 2048 MiB");
constexpr int CW_BAR = 4096;
constexpr int CW_CNT = 32768;
constexpr int CW_FILL = CW_CNT + NL * 64;
constexpr int CW_PLAN = CW_FILL + NL * 64;
static_assert(MAXBLK <= 160, "plan words");

struct Params { const float* in[37]; float* out; unsigned char* ws; int ph_lo, ph_hi; };

struct Ctx { const float* const* in; float* out; unsigned char* ws; };
#define GT_ ((long)blockIdx.x * NT + threadIdx.x)
#define GS_ ((long)gridDim.x * NT)
#define WSF(off) ((float*)(c.ws + (off)))
#define WSI(off) ((int*)(c.ws + (off)))
#define WSH(off) ((bf16_t*)(c.ws + (off)))
#define CTLW(c) ((int*)((c).ws + O_CTL))

#ifdef CPU_EMU
__device__ __forceinline__ float fexp_(float x) { return expf(x); }
__device__ __forceinline__ float frcp_(float x) { return 1.f / x; }
__device__ __forceinline__ float frsq_(float x) { return 1.f / sqrtf(x); }
#else
__device__ __forceinline__ float fexp_(float x) { return __builtin_amdgcn_exp2f(x * 1.4426950408889634f); }
__device__ __forceinline__ float frcp_(float x) { return __builtin_amdgcn_rcpf(x); }
__device__ __forceinline__ float frsq_(float x) { return __builtin_amdgcn_rsqf(x); }
#endif
__device__ __forceinline__ float sigmoidf_(float x) { return frcp_(1.f + fexp_(-x)); }
__device__ __forceinline__ float siluf_(float x) { return x * frcp_(1.f + fexp_(-x)); }
__device__ __forceinline__ float tanhf_(float x) { return 1.f - 2.f * frcp_(1.f + fexp_(2.f * x)); }
__device__ __forceinline__ float geluf_(float x) { return 0.5f * x * (1.f + tanhf_(0.7978845608028654f * (x + 0.044715f * x * x * x))); }
__device__ __forceinline__ float softplusf_(float x) { return x > 0.f ? x + log1pf(expf(-x)) : log1pf(expf(x)); }
__device__ __forceinline__ float loggamma_(int h) { return log1pf(-exp2f(-5.f - (float)h)); }
__device__ __forceinline__ unsigned f2u_(float f) { unsigned u; memcpy(&u, &f, 4); return u; }
__device__ __forceinline__ float u2f_(unsigned u) { float f; memcpy(&f, &u, 4); return f; }
__device__ __forceinline__ float bf2f(bf16_t v) { return u2f_((unsigned)v << 16); }
__device__ __forceinline__ unsigned f2bf(float f) { const unsigned u = f2u_(f); return (u + 0x7fffu + ((u >> 16) & 1u)) >> 16; }
__device__ __forceinline__ unsigned pk2(float lo, float hi) { return f2bf(lo) | (f2bf(hi) << 16); }
__device__ __forceinline__ float bflo(unsigned w) { return u2f_(w << 16); }
__device__ __forceinline__ float bfhi(unsigned w) { return u2f_(w & 0xffff0000u); }
__device__ __forceinline__ int atomic_add_i(int* p, int v) {
#ifdef CPU_EMU
    return __atomic_fetch_add(p, v, __ATOMIC_RELAXED);
#else
    return atomicAdd(p, v);
#endif
}
#define PF(P, r, col) bf2f((P)[(size_t)(r) * PW + (col)])
#ifdef CPU_EMU
#define SYNCTHREADS() emu_syncthreads()
#define SHFL_XOR(v, m) emu_shfl_xor(v, m)
#else
#define SYNCTHREADS() __syncthreads()
#define SHFL_XOR(v, m) __shfl_xor(v, m)
#endif
#ifdef CPU_EMU
__device__ __forceinline__ float wave_sum(float v) {
    for (int o = 1; o < 64; o <<= 1) v += SHFL_XOR(v, o);
    return v;
}
#else
__device__ __forceinline__ float wave_sum(float x) {
    x += __builtin_bit_cast(float, __builtin_amdgcn_update_dpp(0, __builtin_bit_cast(int, x), 0xB1, 0xF, 0xF, true));
    x += __builtin_bit_cast(float, __builtin_amdgcn_update_dpp(0, __builtin_bit_cast(int, x), 0x4E, 0xF, 0xF, true));
    x += __builtin_bit_cast(float, __builtin_amdgcn_update_dpp(0, __builtin_bit_cast(int, x), 0x141, 0xF, 0xF, true));
    x += __builtin_bit_cast(float, __builtin_amdgcn_update_dpp(0, __builtin_bit_cast(int, x), 0x140, 0xF, 0xF, true));
    const int xi = __builtin_bit_cast(int, x);
    return (__builtin_bit_cast(float, __builtin_amdgcn_readlane(xi, 0)) + __builtin_bit_cast(float, __builtin_amdgcn_readlane(xi, 16))) + (__builtin_bit_cast(float, __builtin_amdgcn_readlane(xi, 32)) + __builtin_bit_cast(float, __builtin_amdgcn_readlane(xi, 48)));
}
#endif
__device__ __forceinline__ f32x4 ld_bf4(const bf16_t* p) { const unsigned long long q = *(const unsigned long long*)p; const unsigned lo = (unsigned)q, hi = (unsigned)(q >> 32); return (f32x4){bflo(lo), bfhi(lo), bflo(hi), bfhi(hi)}; }
__device__ __forceinline__ void st_bf4(bf16_t* p, const f32x4 v) { *(unsigned long long*)p = (unsigned long long)pk2(v[0], v[1]) | ((unsigned long long)pk2(v[2], v[3]) << 32); }

template <int KT, int NTL>
__device__ __forceinline__ void wave_mma(f32x4 (&acc)[NTL], const bf16_t* A, int lda, const bf16_t* Bt, int ldb) {
    const int lane = threadIdx.x & 63, fr = lane & 15, fq = lane >> 4;
#ifdef CPU_EMU
    for (int nt = 0; nt < NTL; ++nt) for (int r = 0; r < 4; ++r) { float sacc = 0.f; const bf16_t* a = A + fr * lda; const bf16_t* b = Bt + (16 * nt + 4 * fq + r) * ldb;
        for (int k = 0; k < 32 * KT; ++k) sacc += bf2f(a[k]) * bf2f(b[k]);
        acc[nt][r] += sacc; }
#else
#pragma unroll
    for (int kt = 0; kt < KT; ++kt) {
        const bf16x8 af = *(const bf16x8*)(A + fr * lda + kt * 32 + fq * 8);
#pragma unroll
        for (int nt = 0; nt < NTL; ++nt) { const bf16x8 bfr = *(const bf16x8*)(Bt + (16 * nt + fr) * ldb + kt * 32 + fq * 8);
            acc[nt] = __builtin_amdgcn_mfma_f32_16x16x32_bf16(bfr, af, acc[nt], 0, 0, 0); }
    }
#endif
}
__device__ __forceinline__ void ph_mod(const Ctx& c, float* ldsf) {
    const float* cc = c.in[1]; const float* aw = c.in[5]; const float* ab = c.in[6]; float* mod = WSF(O_MOD);
    float* scs = ldsf; float* part = ldsf + NB * D; const int tid = threadIdx.x, c4 = (tid & 31) * 4, kq = tid >> 5;
    for (int i = tid; i < NB * D; i += NT) scs[i] = siluf_(cc[i]);
    SYNCTHREADS();
    for (int u = blockIdx.x; u < NL * (D6 / 128); u += gridDim.x) {
        const int l = u / (D6 / 128), j0 = (u % (D6 / 128)) * 128;
        const float* w = aw + (size_t)l * D * D6 + j0 + c4; f32x4 a0 = (f32x4){0.f, 0.f, 0.f, 0.f}, a1 = a0;
#pragma unroll 8
        for (int k = kq * 128; k < kq * 128 + 128; ++k) { const f32x4 wv = *(const f32x4*)(w + (size_t)k * D6); a0 += wv * scs[k]; a1 += wv * scs[D + k]; }
        *(f32x4*)(part + (kq * 2 + 0) * 128 + c4) = a0; *(f32x4*)(part + (kq * 2 + 1) * 128 + c4) = a1;
        SYNCTHREADS();
        if (tid < 256) { const int b = tid >> 7, col = tid & 127; float sacc = 0.f;
#pragma unroll
            for (int q = 0; q < 16; ++q) sacc += part[(q * 2 + b) * 128 + col];
            mod[((size_t)l * NB + b) * D6 + j0 + col] = sacc + ab[l * D6 + j0 + col]; }
        SYNCTHREADS();
    }
}
__device__ __forceinline__ void ph_norm(const Ctx& c, const float* x, const float* g, const float* sh, const float* sc, bf16_t* hb, float* hf) {
    const int lane = threadIdx.x & 63, gw = blockIdx.x * (NT / 64) + (threadIdx.x >> 6), ngw = gridDim.x * (NT / 64);
    for (int t0 = gw * 2; t0 < T; t0 += ngw * 2) {
        f32x4 v[2][8]; float ss[2] = {0.f, 0.f};
#pragma unroll
        for (int r = 0; r < 2; ++r)
#pragma unroll
            for (int j = 0; j < 8; ++j) v[r][j] = *(const f32x4*)(x + (size_t)(t0 + r) * D + (j * 64 + lane) * 4);
#pragma unroll
        for (int r = 0; r < 2; ++r) {
#pragma unroll
            for (int j = 0; j < 8; ++j) ss[r] += (v[r][j][0] * v[r][j][0] + v[r][j][1] * v[r][j][1]) + (v[r][j][2] * v[r][j][2] + v[r][j][3] * v[r][j][3]);
            const int t = t0 + r, b = t / S; const float rs = 1.f / sqrtf(wave_sum(ss[r]) * (1.f / D) + EPS);
#pragma unroll
            for (int j = 0; j < 8; ++j) { const int col = (j * 64 + lane) * 4;
                const f32x4 o = v[r][j] * rs * *(const f32x4*)(g + col) * (*(const f32x4*)(sc + b * D6 + col) + 1.f) + *(const f32x4*)(sh + b * D6 + col);
                st_bf4(hb + (size_t)t * D + col, o); if (hf) *(f32x4*)(hf + (size_t)t * D + col) = o; }
        }
    }
}
template <int MODE>
__device__ __forceinline__ void ph_comb_norm(const Ctx& c, const float* xmid, const float* g2, float* xout, const float* g, const float* sh, const float* sc, bf16_t* hb, float* outp) {
    const bf16_t* YE = WSH(O_YE); const float* EWT = WSF(O_EWT); const int* DEST = WSI(O_DEST);
    const int lane = threadIdx.x & 63, gw = blockIdx.x * (NT / 64) + (threadIdx.x >> 6), ngw = gridDim.x * (NT / 64);
    for (int t = gw; t < T; t += ngw) {
        const int b = t / S; const float w0 = EWT[t * 2], w1 = EWT[t * 2 + 1]; const bf16_t* y0 = YE + (size_t)DEST[t * 2] * D; const bf16_t* y1 = YE + (size_t)DEST[t * 2 + 1] * D;
        f32x4 v[8]; float ss = 0.f;
#pragma unroll
        for (int j = 0; j < 8; ++j) { const int col = (j * 64 + lane) * 4;
            v[j] = *(const f32x4*)(xmid + (size_t)t * D + col) + *(const f32x4*)(g2 + b * D6 + col) * (ld_bf4(y0 + col) * w0 + ld_bf4(y1 + col) * w1);
            if (MODE == 0) *(f32x4*)(xout + (size_t)t * D + col) = v[j];
            ss += (v[j][0] * v[j][0] + v[j][1] * v[j][1]) + (v[j][2] * v[j][2] + v[j][3] * v[j][3]); }
        const float rs = 1.f / sqrtf(wave_sum(ss) * (1.f / D) + EPS);
#pragma unroll
        for (int j = 0; j < 8; ++j) { const int col = (j * 64 + lane) * 4;
            if (MODE == 0) st_bf4(hb + (size_t)t * D + col, v[j] * rs * *(const f32x4*)(g + col) * (*(const f32x4*)(sc + b * D6 + col) + 1.f) + *(const f32x4*)(sh + b * D6 + col));
            else *(f32x4*)(outp + (size_t)t * D + col) = v[j] * rs * *(const f32x4*)(g + col); }
    }
}

struct CvtItem { const float* Wp; int ldw; bf16_t* WT; int ldt; int drow, k0, n0; };
constexpr int I_IN = 32 * (INW / 32), I_BR = 4 * 16 * 64, I_OUT = 32 * 64, I_GU = NE * 32 * 32, I_DN = NE * 8 * 64, I_LR = 32 * 8, I_WU = 2 * 32, I_WG = 64, I_BIG = I_IN + I_BR + I_OUT + I_GU + I_DN, I_ALL = I_BIG + I_LR + 2 * I_WU + I_WG;
__device__ __forceinline__ CvtItem cvt_decode(const Ctx& c, int l, int it) {
    CvtItem r;
    if (it < I_IN) { const int kb = it / (INW / 32), nb = it % (INW / 32); r.n0 = nb * 32; r.k0 = kb * 64; r.Wp = c.in[7] + (size_t)l * D * INW; r.ldw = INW; r.WT = WSH(O_WIN); r.ldt = D; r.drow = r.n0 < 10624 ? r.n0 : r.n0 + 128; return r; }
    it -= I_IN;
    if (it < I_BR) { const int sgm = it / 1024, q = it % 1024, kb = q / 64, nb = q % 64; r.n0 = nb * 32; r.k0 = kb * 64; r.Wp = c.in[28] + ((size_t)l * 4 + sgm) * W * D; r.ldw = D; r.WT = WSH(O_WBR) + sgm * W; r.ldt = 4 * W; r.drow = r.n0; return r; }
    it -= I_BR;
    if (it < I_OUT) { const int kb = it / 64, nb = it % 64; r.n0 = nb * 32; r.k0 = kb * 64; r.Wp = c.in[29] + (size_t)l * D * D; r.ldw = D; r.WT = WSH(O_WOUT); r.ldt = D; r.drow = r.n0; return r; }
    it -= I_OUT;
    if (it < I_GU) { const int e = it / 1024, q = it % 1024, kb = q / 32, nb = q % 32; r.n0 = nb * 32; r.k0 = kb * 64; r.Wp = c.in[34] + ((size_t)l * NE + e) * D * 1024; r.ldw = 1024; r.WT = WSH(O_WGU) + (size_t)e * 1024 * D; r.ldt = D;
        r.drow = r.n0 < 512 ? (r.n0 / 128) * 256 + (r.n0 % 128) : ((r.n0 - 512) / 128) * 256 + 128 + ((r.n0 - 512) % 128); return r; }
    it -= I_GU;
    if (it < I_DN) { const int e = it / 512, q = it % 512, kb = q / 64, nb = q % 64; r.n0 = nb * 32; r.k0 = kb * 64; r.Wp = c.in[35] + ((size_t)l * NE + e) * 512 * D; r.ldw = D; r.WT = WSH(O_WDN) + (size_t)e * D * 512; r.ldt = 512; r.drow = r.n0; return r; }
    it -= I_DN;
    if (it < I_LR) { const int m = it / 8, q = it % 8, kb = q / 4, nb = q % 4, z = m >> 4, ty = (m >> 3) & 1, n = m & 7; r.n0 = nb * 32; r.k0 = kb * 64; r.Wp = c.in[ty ? 12 : 10] + (((size_t)l * 2 + z) * 8 + n) * 128 * 128; r.ldw = 128;
        r.WT = WSH(O_WLR) + (size_t)m * 128 * 128; r.ldt = 128; r.drow = r.n0; return r; }
    it -= I_LR;
    if (it < 2 * I_WU) { const int ua = it / I_WU, q = it % I_WU, z = q / 32, nb = q % 32; r.n0 = nb * 32; r.k0 = 0; r.Wp = c.in[ua ? 23 : 21] + ((size_t)l * 2 + z) * 64 * W; r.ldw = W; r.WT = WSH(ua ? O_WAT : O_WUT) + (size_t)z * W * 64; r.ldt = 64; r.drow = r.n0; return r; }
    it -= 2 * I_WU;
    { const int kb = it / 32, nb = it % 32; r.n0 = nb * 32; r.k0 = kb * 64; r.Wp = c.in[24] + (size_t)l * 128 * W; r.ldw = W; r.WT = WSH(O_WGT); r.ldt = 128; r.drow = r.n0; return r; }
}
constexpr int J_IN = 16 * (INW / 128), J_BR = 4 * 8 * 16, J_OUT = 16 * 16, J_GU = NE * 16 * 8, J_DN = NE * 4 * 16, J_ALL = J_IN + J_BR + J_OUT + J_GU + J_DN;
__device__ __forceinline__ CvtItem cvt_decode_big(const Ctx& c, int l, int it) {
    CvtItem r;
    if (it < J_IN) { const int kb = it / (INW / 128), nb = it % (INW / 128); r.n0 = nb * 128; r.k0 = kb * 128; r.Wp = c.in[7] + (size_t)l * D * INW; r.ldw = INW; r.WT = WSH(O_WIN); r.ldt = D; r.drow = r.n0 < 10624 ? r.n0 : r.n0 + 128; return r; }
    it -= J_IN;
    if (it < J_BR) { const int sgm = it / 128, q = it % 128, kb = q / 16, nb = q % 16; r.n0 = nb * 128; r.k0 = kb * 128; r.Wp = c.in[28] + ((size_t)l * 4 + sgm) * W * D; r.ldw = D; r.WT = WSH(O_WBR) + sgm * W; r.ldt = 4 * W; r.drow = r.n0; return r; }
    it -= J_BR;
    if (it < J_OUT) { const int kb = it / 16, nb = it % 16; r.n0 = nb * 128; r.k0 = kb * 128; r.Wp = c.in[29] + (size_t)l * D * D; r.ldw = D; r.WT = WSH(O_WOUT); r.ldt = D; r.drow = r.n0; return r; }
    it -= J_OUT;
    if (it < J_GU) { const int e = it / 128, q = it % 128, kb = q / 8, nb = q % 8; r.n0 = nb * 128; r.k0 = kb * 128; r.Wp = c.in[34] + ((size_t)l * NE + e) * D * 1024; r.ldw = 1024; r.WT = WSH(O_WGU) + (size_t)e * 1024 * D; r.ldt = D;
        r.drow = r.n0 < 512 ? (r.n0 / 128) * 256 : ((r.n0 - 512) / 128) * 256 + 128; return r; }
    it -= J_GU;
    { const int e = it / 64, q = it % 64, kb = q / 16, nb = q % 16; r.n0 = nb * 128; r.k0 = kb * 128; r.Wp = c.in[35] + ((size_t)l * NE + e) * 512 * D; r.ldw = D; r.WT = WSH(O_WDN) + (size_t)e * D * 512; r.ldt = 512; r.drow = r.n0; return r; }
}
__device__ __forceinline__ void convert_big(const Ctx& c, int l, float* ldsf, int first, int last, int widx, int wcnt) {
    const int tid = threadIdx.x, lr = tid >> 5, lc = (tid & 31) * 4;
    f32x4 rg[8]; int it = first + widx; CvtItem r;
    if (it < last) { r = cvt_decode_big(c, l, it);
#pragma unroll
        for (int i = 0; i < 8; ++i) rg[i] = *(const f32x4*)(r.Wp + (size_t)(r.k0 + lr + 16 * i) * r.ldw + r.n0 + lc); }
    for (; it < last; it += wcnt) {
#pragma unroll
        for (int i = 0; i < 8; ++i) { float* dp = ldsf + (lr + 16 * i) * 129 + lc; dp[0] = rg[i][0]; dp[1] = rg[i][1]; dp[2] = rg[i][2]; dp[3] = rg[i][3]; }
        const CvtItem cur = r; const int nx = it + wcnt;
        if (nx < last) { r = cvt_decode_big(c, l, nx);
#pragma unroll
            for (int i = 0; i < 8; ++i) rg[i] = *(const f32x4*)(r.Wp + (size_t)(r.k0 + lr + 16 * i) * r.ldw + r.n0 + lc); }
        SYNCTHREADS();
#pragma unroll
        for (int q = 0; q < 4; ++q) { const int id = tid + NT * q, n = id >> 4, k8 = (id & 15) * 8; const float* sp = ldsf + k8 * 129 + n;
            u32x4 o; o[0] = pk2(sp[0 * 129], sp[1 * 129]); o[1] = pk2(sp[2 * 129], sp[3 * 129]); o[2] = pk2(sp[4 * 129], sp[5 * 129]); o[3] = pk2(sp[6 * 129], sp[7 * 129]);
            *(u32x4*)(cur.WT + (size_t)(cur.drow + n) * cur.ldt + cur.k0 + k8) = o; }
        SYNCTHREADS();
    }
}
__device__ __forceinline__ int convert_tail_tiles() { const int nun = (T / 256) * (PW / 256), G = (int)gridDim.x, rem = nun % G; return rem == 0 ? 0 : (G - rem) * 10 < J_GU + J_DN ? (G - rem) * 10 : J_GU + J_DN; }
__device__ __forceinline__ int convert_early_tiles(const Ctx& c) { const int G = (int)gridDim.x, nrest = (CTLW(c) + CW_PLAN)[40] * 4 - G; return (nrest >= 0 && nrest < G) ? ((G - nrest) * 12 < J_IN ? (G - nrest) * 12 : J_IN) : 0; }
__device__ __forceinline__ void ph_convert(const Ctx& c, int l, float* ldsf) {
    const int lane = threadIdx.x & 63, wave = threadIdx.x >> 6; const int gw = blockIdx.x * (NT / 64) + wave, ngw = gridDim.x * (NT / 64);
    convert_big(c, l, ldsf, l == 1 ? convert_early_tiles(c) : 0, J_ALL - convert_tail_tiles(), (int)blockIdx.x, (int)gridDim.x);
#ifdef CPU_EMU
    if (lane == 0) for (int it = I_BIG + gw; it < I_ALL; it += ngw) { const CvtItem r = cvt_decode(c, l, it);
        for (int kk = 0; kk < 64; ++kk) for (int nn = 0; nn < 32; ++nn) r.WT[(size_t)(r.drow + nn) * r.ldt + r.k0 + kk] = (bf16_t)f2bf(r.Wp[(size_t)(r.k0 + kk) * r.ldw + r.n0 + nn]); }
#else
    float* scr = ldsf + wave * (64 * 33 + 16);
    for (int it = I_BIG + gw; it < I_ALL; it += ngw) {
        const CvtItem r = cvt_decode(c, l, it);
#pragma unroll 8
        for (int i = 0; i < 32; ++i) { const int kk = 2 * i + (lane >> 5); scr[kk * 33 + (lane & 31)] = r.Wp[(size_t)(r.k0 + kk) * r.ldw + r.n0 + (lane & 31)]; }
        asm volatile("s_waitcnt lgkmcnt(0)" ::: "memory");
        const int cc = lane & 7;
#pragma unroll
        for (int j = 0; j < 4; ++j) { const int n = (lane >> 3) + 8 * j; const float* sp = scr + (8 * cc) * 33 + n;
            u32x4 o; o[0] = pk2(sp[0 * 33], sp[1 * 33]); o[1] = pk2(sp[2 * 33], sp[3 * 33]); o[2] = pk2(sp[4 * 33], sp[5 * 33]); o[3] = pk2(sp[6 * 33], sp[7 * 33]);
            *(u32x4*)(r.WT + (size_t)(r.drow + n) * r.ldt + r.k0 + 8 * cc) = o; }
        asm volatile("s_waitcnt lgkmcnt(0)" ::: "memory");
    }
#endif
    { const float* wg = c.in[30] + (size_t)l * D * 4; const float* we = c.in[32] + (size_t)l * D * 32; bf16_t* wh = WSH(O_WRH); bf16_t* wl = WSH(O_WRL);
      for (long i = GT_; i < (long)48 * D; i += GS_) { const int n = (int)(i / D), k = (int)(i % D); const float w = n < 4 ? wg[k * 4 + n] : n < 36 ? we[k * 32 + (n - 4)] : 0.f; const unsigned hb = f2bf(w); wh[i] = (bf16_t)hb; wl[i] = (bf16_t)f2bf(w - bf2f((bf16_t)hb)); } }
    for (long i = GT_; i < (long)128 * D / 2; i += GS_) ((unsigned*)(WSH(O_WIN) + (size_t)10624 * D))[i] = 0u;
}

namespace pg8 {
constexpr int BM = 256, BK = 64, HALF = 128, HTB = HALF * BK * 2, STAGE_BYTES = 8 * HTB;
__host__ __device__ __forceinline__ int lds_byte(int r, int cc) { const int st = (r >> 4) * 2 + (cc >> 5), rr = r & 15, c2 = cc & 31, ob = rr * 64 + c2 * 2; return st * 1024 + (ob ^ (((ob >> 9) & 1) << 5)); }
__host__ __device__ __forceinline__ void stage_rc(int b, int& R, int& C) { const int st = b / 1024, sb = b % 1024, swz = sb ^ (((sb >> 9) & 1) << 5); R = (st >> 1) * 16 + swz / 64; C = (st & 1) * 32 + (swz % 64) / 2; }
__host__ __device__ __forceinline__ int perm32(int rho) { const int n = rho >> 4, i = rho & 15; return 8 * (i >> 2) + 4 * n + (i & 3); }
struct Unit { int pm, pn, aux; const char* A; const char* B; };
struct Gemm { int K, lda, ldb; };

template <class Epi, class Sched>
__device__ __forceinline__ void gemm_phase(unsigned char* lds_, const Gemm g, const Sched& S, const Epi& E) {
#ifdef CPU_EMU
    if (threadIdx.x != 0) return;
    Unit u; const int K = g.K;
    float* Af = (float*)malloc((size_t)256 * K * 4); float* Bf = (float*)malloc((size_t)256 * K * 4); float* Cf = (float*)malloc(256 * 256 * 4);
    for (int i = 0; S.next(i, u); ++i) {
        const bf16_t* A = (const bf16_t*)u.A; const bf16_t* B = (const bf16_t*)u.B;
        for (int r = 0; r < 256; ++r) for (int k = 0; k < K; ++k) { Af[(size_t)r * K + k] = bf2f(A[(size_t)r * g.lda + k]); Bf[(size_t)r * K + k] = bf2f(B[(size_t)r * g.ldb + k]); }
        for (int r = 0; r < 256; ++r) for (int cc = 0; cc < 256; ++cc) { const float* a = Af + (size_t)r * K; const float* b = Bf + (size_t)cc * K; float sacc = 0.f; for (int k = 0; k < K; ++k) sacc += a[k] * b[k]; Cf[r * 256 + cc] = sacc; }
        for (int wid = 0; wid < 8; ++wid) for (int lane = 0; lane < 64; ++lane) {
            const int wr = wid >> 2, wc = wid & 3, fr = lane & 15, fq = lane >> 4; f32x4 acc[2][2][4][2];
            for (int ai = 0; ai < 2; ++ai) for (int bj = 0; bj < 2; ++bj) for (int m = 0; m < 4; ++m) for (int n = 0; n < 2; ++n) for (int j = 0; j < 4; ++j) {
                const int r = 128 * ai + 64 * wr + 16 * m + fr, cc = 128 * bj + 32 * wc + (Epi::PERM ? 8 * fq + 4 * n + j : 16 * n + 4 * fq + j); acc[ai][bj][m][n][j] = Cf[r * 256 + cc]; }
            E(acc, u, wr, wc, fr, fq);
        }
    }
    free(Af); free(Bf); free(Cf);
#else
    typedef __attribute__((address_space(3))) unsigned char* ldsp_t;
    ldsp_t lds = (ldsp_t)lds_;
    const int tid = threadIdx.x, wid = __builtin_amdgcn_readfirstlane(tid >> 6), lane = tid & 63, wr = wid >> 2, wc = wid & 3, fr = lane & 15, fq = lane >> 4;
    const int K = g.K, nt = K / BK;
    unsigned voffA[2], voffB[2];
#pragma unroll
    for (int i = 0; i < 2; ++i) { int R, C; stage_rc(tid * 16 + i * 8192, R, C); const int Rb = Epi::PERM ? ((R & ~31) + perm32(R & 31)) : R;
        voffA[i] = (unsigned)(R * g.lda + C) * 2u; voffB[i] = (unsigned)(Rb * g.ldb + C) * 2u; }
    const size_t kstep = (size_t)(BK * 2);
    const size_t hstepA = (size_t)HALF * g.lda * 2, hstepB = (size_t)HALF * g.ldb * 2;
    const unsigned ldsw = (unsigned)wid * 1024u;
    const int aoff = lds_byte(wr * 64 + fr, fq * 8), boff = lds_byte(wc * 32 + fr, fq * 8);
#define PG8_SA(b, h) (((b) * 2 + (h)) * HTB)
#define PG8_SB(b, h) ((4 + (b) * 2 + (h)) * HTB)
#define PG8_STAGE(bufoff, gbase, voff) do { _Pragma("unroll") for (int _i = 0; _i < 2; ++_i) \
        __builtin_amdgcn_global_load_lds((const unsigned*)((const char*)(gbase) + (voff)[_i]), (__attribute__((address_space(3))) unsigned*)(lds + (bufoff) + ldsw + _i * 8192), 16, 0, 0); } while (0)
#define PG8_LDA(dst, b, h) do { _Pragma("unroll") for (int m = 0; m < 4; ++m) _Pragma("unroll") for (int k = 0; k < 2; ++k) dst[m][k] = *(const __attribute__((address_space(3))) bf16x8*)(lds + PG8_SA(b, h) + aoff + m * 2048 + k * 1024); } while (0)
#define PG8_LDB(dst, b, h) do { _Pragma("unroll") for (int n = 0; n < 2; ++n) _Pragma("unroll") for (int k = 0; k < 2; ++k) dst[n][k] = *(const __attribute__((address_space(3))) bf16x8*)(lds + PG8_SB(b, h) + boff + n * 2048 + k * 1024); } while (0)
#define PG8_MMA(ai, bj, At, Bt) do { __builtin_amdgcn_s_setprio(1); _Pragma("unroll") for (int m = 0; m < 4; ++m) _Pragma("unroll") for (int n = 0; n < 2; ++n) _Pragma("unroll") for (int k = 0; k < 2; ++k) \
        acc[ai][bj][m][n] = __builtin_amdgcn_mfma_f32_16x16x32_bf16(Bt[n][k], At[m][k], acc[ai][bj][m][n], 0, 0, 0); __builtin_amdgcn_s_setprio(0); } while (0)
#define PG8_WAIT_V(n) asm volatile("s_waitcnt vmcnt(" #n ")" ::: "memory")
#define PG8_WAIT_L(n) asm volatile("s_waitcnt lgkmcnt(" #n ")" ::: "memory")
#define PG8_BAR __builtin_amdgcn_s_barrier()
#define PG8_SCHED __builtin_amdgcn_sched_barrier(0)
    Unit cur, nxt; int ui = 0;
    if (!S.next(0, cur)) return;
    f32x4 acc[2][2][4][2];
#pragma unroll
    for (int a = 0; a < 2; ++a)
#pragma unroll
        for (int b = 0; b < 2; ++b)
#pragma unroll
            for (int m = 0; m < 4; ++m)
#pragma unroll
                for (int n = 0; n < 2; ++n) acc[a][b][m][n] = (f32x4){0.f, 0.f, 0.f, 0.f};
    bf16x8 At[4][2], B0[2][2], B1[2][2];
    const char* cA = cur.A; const char* cB = cur.B;
    S.a_ready(cur);
    PG8_STAGE(PG8_SB(0, 0), cB, voffB); PG8_STAGE(PG8_SA(0, 0), cA, voffA); PG8_STAGE(PG8_SB(0, 1), cB + hstepB, voffB); PG8_STAGE(PG8_SA(0, 1), cA + hstepA, voffA);
    if (wr == 1) PG8_BAR;
    PG8_WAIT_V(4); PG8_BAR;
    PG8_STAGE(PG8_SB(1, 0), cB + kstep, voffB); PG8_STAGE(PG8_SA(1, 0), cA + kstep, voffA); PG8_STAGE(PG8_SB(1, 1), cB + hstepB + kstep, voffB);
    PG8_WAIT_V(6); PG8_BAR;
    for (;;) {
        const bool has_next = S.next(ui + 1, nxt);
        const char* nA = has_next ? nxt.A : cA; const char* nB = has_next ? nxt.B : cB;
        for (int t = 0; t < nt; t += 2) {
            const bool last = (t == nt - 2);
            const char* a1 = cA + (size_t)(t + 1) * kstep;
            const char* a2 = last ? nA : cA + (size_t)(t + 2) * kstep; const char* b2 = last ? nB : cB + (size_t)(t + 2) * kstep;
            const char* a3 = a2 + kstep; const char* b3 = b2 + kstep;
            if (last && has_next) S.a_ready(nxt);
            PG8_LDB(B0, 0, 0); PG8_SCHED; PG8_LDA(At, 0, 0); PG8_STAGE(PG8_SA(1, 1), a1 + hstepA, voffA);
            PG8_WAIT_L(8); PG8_BAR; PG8_WAIT_L(0); PG8_MMA(0, 0, At, B0); PG8_BAR; PG8_SCHED;
            PG8_LDB(B1, 0, 1); PG8_STAGE(PG8_SB(0, 0), b2, voffB);
            PG8_BAR; PG8_WAIT_L(0); PG8_MMA(0, 1, At, B1); PG8_BAR;
            PG8_LDA(At, 0, 1); PG8_STAGE(PG8_SA(0, 0), a2, voffA);
            PG8_BAR; PG8_WAIT_L(0); PG8_MMA(1, 0, At, B0); PG8_BAR; PG8_SCHED;
            PG8_STAGE(PG8_SB(0, 1), b2 + hstepB, voffB);
            PG8_WAIT_V(6); PG8_BAR; PG8_MMA(1, 1, At, B1); PG8_BAR;
            PG8_LDB(B0, 1, 0); PG8_SCHED; PG8_LDA(At, 1, 0); PG8_STAGE(PG8_SA(0, 1), a2 + hstepA, voffA);
            PG8_WAIT_L(8); PG8_BAR; PG8_WAIT_L(0); PG8_MMA(0, 0, At, B0); PG8_BAR; PG8_SCHED;
            PG8_LDB(B1, 1, 1); PG8_STAGE(PG8_SB(1, 0), b3, voffB);
            PG8_BAR; PG8_WAIT_L(0); PG8_MMA(0, 1, At, B1); PG8_BAR;
            PG8_LDA(At, 1, 1); PG8_STAGE(PG8_SA(1, 0), a3, voffA);
            PG8_BAR; PG8_WAIT_L(0); PG8_MMA(1, 0, At, B0); PG8_BAR; PG8_SCHED;
            PG8_STAGE(PG8_SB(1, 1), b3 + hstepB, voffB);
            PG8_WAIT_V(6); PG8_BAR; PG8_MMA(1, 1, At, B1); PG8_BAR;
        }
        E(acc, cur, wr, wc, fr, fq); S.done(cur);
        if (!has_next) break;
#pragma unroll
        for (int a = 0; a < 2; ++a)
#pragma unroll
            for (int b = 0; b < 2; ++b)
#pragma unroll
                for (int m = 0; m < 4; ++m)
#pragma unroll
                    for (int n = 0; n < 2; ++n) acc[a][b][m][n] = (f32x4){0.f, 0.f, 0.f, 0.f};
        cur = nxt; cA = nA; cB = nB; ++ui;
    }
    PG8_WAIT_V(0);
    if (wr == 0) PG8_BAR;
    PG8_BAR;
#undef PG8_SA
#undef PG8_SB
#undef PG8_STAGE
#undef PG8_LDA
#undef PG8_LDB
#undef PG8_MMA
#undef PG8_WAIT_V
#undef PG8_WAIT_L
#undef PG8_BAR
#undef PG8_SCHED
#endif
}

struct StaticOrder {
    int nM, nN, nwg, G, c; const char* A; const char* B; size_t tstepA, tstepB;
    __device__ __forceinline__ void init(int M, int N, int G_, int c_, const void* A_, const void* B_, int lda, int ldb) { nM = M / BM; nN = N / BM; nwg = nM * nN; G = G_; c = c_; A = (const char*)A_; B = (const char*)B_; tstepA = (size_t)BM * lda * 2; tstepB = (size_t)BM * ldb * 2; }
    __device__ __forceinline__ bool next(int i, Unit& u) const {
        const long L = (long)i * G + c; if (L >= nwg) return false;
        int wgid = (int)L; { const int q = nwg / 8, r = nwg % 8, xcd = wgid % 8, off = wgid / 8; wgid = (xcd < r ? xcd * (q + 1) : r * (q + 1) + (xcd - r) * q) + off; }
        const int nig = 8 * nN, gid = wgid / nig, fm = gid * 8, gsz = (nM - fm) < 8 ? (nM - fm) : 8;
        u.pm = fm + ((wgid % nig) % gsz); u.pn = (wgid % nig) / gsz; u.aux = 0; u.A = A + (size_t)u.pm * tstepA; u.B = B + (size_t)u.pn * tstepB; return true;
    }
    __device__ __forceinline__ void a_ready(const Unit&) const {}
    __device__ __forceinline__ void done(const Unit&) const {}
};
struct MergeOrder {
    StaticOrder so; int kseg_bytes;
    __device__ __forceinline__ bool next(int i, Unit& u) const { if (!so.next(i >> 2, u)) return false; u.aux = i & 3; u.A += (size_t)u.aux * kseg_bytes; u.B += (size_t)u.aux * kseg_bytes; return true; }
    __device__ __forceinline__ void a_ready(const Unit&) const {}
    __device__ __forceinline__ void done(const Unit&) const {}
};
struct MoeOrder {
    int G, c, ncol; const int* plan; const char* A; const char* B; size_t tstepA, tstepB, estep;
    __device__ __forceinline__ bool next(int i, Unit& u) const {
        const long L = (long)i * G + c; const int nblk = plan[40]; if (L >= (long)nblk * ncol) return false;
        u.pm = (int)(L / ncol); u.pn = (int)(L % ncol); u.aux = plan[64 + u.pm]; u.A = A + (size_t)u.pm * tstepA; u.B = B + (size_t)u.aux * estep + (size_t)u.pn * tstepB; return true;
    }
    __device__ __forceinline__ void a_ready(const Unit&) const {}
    __device__ __forceinline__ void done(const Unit&) const {}
};

__device__ __forceinline__ u32x4 pack8(const f32x4 v0, const f32x4 v1) { u32x4 w; w[0] = pk2(v0[0], v0[1]); w[1] = pk2(v0[2], v0[3]); w[2] = pk2(v1[0], v1[1]); w[3] = pk2(v1[2], v1[3]); return w; }
struct EpiBf16 {
    static constexpr bool PERM = true; bf16_t* O; int ldc;
    __device__ __forceinline__ void operator()(const f32x4 (&acc)[2][2][4][2], const Unit& u, int wr, int wc, int fr, int fq) const {
        const int row0 = u.pm * BM + wr * 64 + fr, col0 = u.pn * BM + wc * 32 + 8 * fq;
#pragma unroll
        for (int ai = 0; ai < 2; ++ai)
#pragma unroll
            for (int m = 0; m < 4; ++m) { bf16_t* rowp = O + (size_t)(row0 + ai * HALF + m * 16) * ldc + col0;
#pragma unroll
                for (int bj = 0; bj < 2; ++bj) *(u32x4*)(rowp + bj * HALF) = pack8(acc[ai][bj][m][0], acc[ai][bj][m][1]); }
    }
};
struct EpiP {
    static constexpr bool PERM = true; bf16_t* O; unsigned char* G8;
    __device__ __forceinline__ void operator()(const f32x4 (&acc)[2][2][4][2], const Unit& u, int wr, int wc, int fr, int fq) const {
        const int row0 = u.pm * BM + wr * 64 + fr, col0 = u.pn * BM + wc * 32 + 8 * fq;
        if (u.pn * BM < C_MLP) {
#pragma unroll
            for (int ai = 0; ai < 2; ++ai)
#pragma unroll
                for (int m = 0; m < 4; ++m) { bf16_t* rowp = O + (size_t)(row0 + ai * HALF + m * 16) * PW + col0;
#pragma unroll
                    for (int bj = 0; bj < 2; ++bj) *(u32x4*)(rowp + bj * HALF) = pack8(acc[ai][bj][m][0], acc[ai][bj][m][1]); }
        } else {
#pragma unroll
            for (int ai = 0; ai < 2; ++ai)
#pragma unroll
                for (int m = 0; m < 4; ++m) { unsigned char* rowp = G8 + (size_t)(row0 + ai * HALF + m * 16) * (4 * D) + (col0 - C_MLP);
#pragma unroll
                    for (int bj = 0; bj < 2; ++bj) { unsigned long long w = 0ull;
#pragma unroll
                        for (int q = 0; q < 8; ++q) { const float gq = sigmoidf_(acc[ai][bj][m][q >> 2][q & 3]); w |= (unsigned long long)(unsigned)(gq * 255.f + 0.5f) << (8 * q); }
                        *(unsigned long long*)(rowp + bj * HALF) = w; } }
        }
    }
};
struct EpiMerge {
    static constexpr bool PERM = true; const unsigned char* G8; bf16_t* MRG;
    __device__ __forceinline__ void operator()(const f32x4 (&acc)[2][2][4][2], const Unit& u, int wr, int wc, int fr, int fq) const {
        const int row0 = u.pm * BM + wr * 64 + fr, col0 = u.pn * BM + wc * 32 + 8 * fq, seg = u.aux;
#pragma unroll
        for (int ai = 0; ai < 2; ++ai)
#pragma unroll
            for (int m = 0; m < 4; ++m) { const size_t r = (size_t)(row0 + ai * HALF + m * 16);
#pragma unroll
                for (int bj = 0; bj < 2; ++bj) { const int cc = col0 + bj * HALF;
                    const unsigned long long gw = *(const unsigned long long*)(G8 + r * (4 * D) + seg * D + cc);
                    f32x4 v0, v1;
#pragma unroll
                    for (int q = 0; q < 4; ++q) { v0[q] = (float)((unsigned)(gw >> (8 * q)) & 255u) * (1.f / 255.f) * acc[ai][bj][m][0][q]; v1[q] = (float)((unsigned)(gw >> (8 * (4 + q))) & 255u) * (1.f / 255.f) * acc[ai][bj][m][1][q]; }
                    bf16_t* mp = MRG + r * D + cc;
                    if (seg > 0) { const u32x4 pw = *(const u32x4*)mp;
#pragma unroll
                        for (int q = 0; q < 2; ++q) { v0[2 * q] += bflo(pw[q]); v0[2 * q + 1] += bfhi(pw[q]); v1[2 * q] += bflo(pw[2 + q]); v1[2 * q + 1] += bfhi(pw[2 + q]); } }
                    *(u32x4*)mp = pack8(v0, v1);
                }
#ifndef CPU_EMU
                asm volatile("" ::: "memory");
#endif
            }
    }
};
struct EpiResid {
    static constexpr bool PERM = false; const float* xin; const float* g1; float* xmid;
    __device__ __forceinline__ void operator()(const f32x4 (&acc)[2][2][4][2], const Unit& u, int wr, int wc, int fr, int fq) const {
        const int row0 = u.pm * BM + wr * 64 + fr, col0 = u.pn * BM + wc * 32 + 4 * fq;
#pragma unroll
        for (int ai = 0; ai < 2; ++ai)
#pragma unroll
            for (int m = 0; m < 4; ++m) { const int r = row0 + ai * HALF + m * 16; const float* gp = g1 + (size_t)(r / S) * D6;
#pragma unroll
                for (int bj = 0; bj < 2; ++bj)
#pragma unroll
                    for (int n = 0; n < 2; ++n) { const int cc = col0 + bj * HALF + n * 16; *(f32x4*)(xmid + (size_t)r * D + cc) = *(const f32x4*)(xin + (size_t)r * D + cc) + *(const f32x4*)(gp + cc) * acc[ai][bj][m][n]; }
#ifndef CPU_EMU
                asm volatile("" ::: "memory");
#endif
            }
    }
};
struct EpiGU {
    static constexpr bool PERM = true; bf16_t* ACT;
    __device__ __forceinline__ void operator()(const f32x4 (&acc)[2][2][4][2], const Unit& u, int wr, int wc, int fr, int fq) const {
        const int row0 = u.pm * BM + wr * 64 + fr, col0 = u.pn * HALF + wc * 32 + 8 * fq;
#pragma unroll
        for (int ai = 0; ai < 2; ++ai)
#pragma unroll
            for (int m = 0; m < 4; ++m) { f32x4 v0, v1;
#pragma unroll
                for (int j = 0; j < 4; ++j) { v0[j] = siluf_(acc[ai][0][m][0][j]) * acc[ai][1][m][0][j]; v1[j] = siluf_(acc[ai][0][m][1][j]) * acc[ai][1][m][1][j]; }
                *(u32x4*)(ACT + (size_t)(row0 + ai * HALF + m * 16) * 512 + col0) = pack8(v0, v1); }
    }
};
}

template <int PASS>
__device__ __forceinline__ void ph_lru(const Ctx& c, int l, float* ldsf) {
    const bf16_t* P = WSH(O_P); const float* cw = c.in[8] + (size_t)l * 4 * W; const float* cb = c.in[9] + (size_t)l * W;
    const float* br = c.in[11] + (size_t)l * 2 * W; const float* bi = c.in[13] + (size_t)l * 2 * W; const float* lam = c.in[14] + (size_t)l * 2 * W; const bf16_t* WLR = WSH(O_WLR);
    float* CA = WSF(O_LCA); float* CH = WSF(O_LCH); const float* CI = WSF(O_LCI); bf16_t* Y = WSH(O_YS);
    bf16_t* Xs = (bf16_t*)ldsf; bf16_t* Wr = Xs + 64 * 136; bf16_t* Wi = Wr + 128 * 136; float* AUa = (float*)Wr; float* AUu = AUa + 64 * 128; float* HF = (float*)(Wi + 128 * 136); float* spl = HF + 64 * 128;
    const int tid = threadIdx.x, wv = tid >> 6, lane = tid & 63, fr = lane & 15, fq = lane >> 4, rt = wv & 3, hf = wv >> 2;
    for (int u = blockIdx.x; u < (T / 64) * 8; u += gridDim.x) {
        const int n = u & 7, tile = u >> 3, b = tile / NLC, chk = tile % NLC; const long t0 = (long)tile * 64;
        if (tid < 256) spl[tid] = softplusf_(-lam[(tid >> 7) * W + n * 128 + (tid & 127)]);
#pragma unroll
        for (int q = 0; q < 4; ++q) { const int id = tid + NT * q, tl = id >> 5, e4 = (id & 31) * 4, ch = n * 128 + e4; const long t = t0 + tl; const int sI = (int)(t % S);
            f32x4 acc = *(const f32x4*)(cb + ch);
#pragma unroll
            for (int k = 0; k < 4; ++k) { const int ss = sI + k - 2; if (ss >= 0 && ss < S) acc += ld_bf4(P + (size_t)(t + k - 2) * PW + C_LX + ch) * *(const f32x4*)(cw + k * W + ch); }
            st_bf4(Xs + tl * 136 + e4, acc); }
        for (int z = 0; z < 2; ++z) {
#pragma unroll
            for (int q = 0; q < 4; ++q) { const int id = tid + NT * q, f = id >> 4, e8 = (id & 15) * 8;
                *(u32x4*)(Wr + f * 136 + e8) = *(const u32x4*)(WLR + ((size_t)((z * 2 + 0) * 8 + n) * 128 + f) * 128 + e8); *(u32x4*)(Wi + f * 136 + e8) = *(const u32x4*)(WLR + ((size_t)((z * 2 + 1) * 8 + n) * 128 + f) * 128 + e8); }
            SYNCTHREADS();
            f32x4 ar[4], ai[4];
#pragma unroll
            for (int nt = 0; nt < 4; ++nt) { ar[nt] = (f32x4){0.f, 0.f, 0.f, 0.f}; ai[nt] = (f32x4){0.f, 0.f, 0.f, 0.f}; }
            wave_mma<4, 4>(ar, Xs + rt * 16 * 136, 136, Wr + hf * 64 * 136, 136);
            wave_mma<4, 4>(ai, Xs + rt * 16 * 136, 136, Wi + hf * 64 * 136, 136);
            SYNCTHREADS();
            const int tl = rt * 16 + fr;
#pragma unroll
            for (int nt = 0; nt < 4; ++nt) { const int f = 64 * hf + 16 * nt + 4 * fq, ch = n * 128 + f;
                const f32x4 brv = *(const f32x4*)(br + z * W + ch), biv = *(const f32x4*)(bi + z * W + ch), lmv = *(const f32x4*)(spl + z * 128 + f), xcv = ld_bf4(Xs + tl * 136 + f); f32x4 av, uv;
#pragma unroll
                for (int e = 0; e < 4; ++e) { const float r = sigmoidf_(ar[nt][e] + brv[e]), ig = sigmoidf_(ai[nt][e] + biv[e]), la = -8.f * r * lmv[e]; const float a = fexp_(la); av[e] = a; uv[e] = sqrtf(fmaxf(1.f - a * a, 0.f)) * ig * xcv[e]; }
                *(f32x4*)(AUa + tl * 128 + f) = av; *(f32x4*)(AUu + tl * 128 + f) = uv; }
            SYNCTHREADS();
            if (tid < 128) { const int f = tid; const size_t ci = (((size_t)z * NB + b) * NLC + chk) * W + n * 128 + f;
                if (PASS == 1) { float prod = 1.f, h = 0.f;
#pragma unroll 8
                    for (int q = 0; q < 64; ++q) { const int sI = z == 0 ? q : 63 - q; const float a = AUa[sI * 128 + f]; h = a * h + AUu[sI * 128 + f]; prod *= a; }
                    CA[ci] = prod; CH[ci] = h;
                } else { float h = CI[ci];
                    if (z == 0) {
#pragma unroll 8
                        for (int q = 0; q < 64; ++q) { h = AUa[q * 128 + f] * h + AUu[q * 128 + f]; HF[q * 128 + f] = h; }
                    } else {
#pragma unroll 8
                        for (int q = 63; q >= 0; --q) { h = AUa[q * 128 + f] * h + AUu[q * 128 + f]; HF[q * 128 + f] += h; } } }
            }
            SYNCTHREADS();
        }
        if (PASS == 2) {
#pragma unroll
            for (int q = 0; q < 4; ++q) { const int id = tid + NT * q, tl = id >> 5, f4 = (id & 31) * 4; const long t = t0 + tl; f32x4 hv = *(const f32x4*)(HF + tl * 128 + f4); const f32x4 gv = ld_bf4(P + (size_t)t * PW + C_LG + n * 128 + f4);
#pragma unroll
                for (int e = 0; e < 4; ++e) hv[e] *= geluf_(gv[e]);
                st_bf4(Y + (size_t)t * 4 * W + 0 * W + n * 128 + f4, hv); }
            SYNCTHREADS();
        }
    }
}
__device__ __forceinline__ void ph_lru_scan2(const Ctx& c) {
    const float* CA = WSF(O_LCA); const float* CH = WSF(O_LCH); float* CI = WSF(O_LCI);
    for (long i = GT_; i < (long)2 * NB * W; i += GS_) {
        const int w = (int)(i % W), b = (int)((i / W) % NB), z = (int)(i / ((long)W * NB)); float carry = 0.f;
#pragma unroll 16
        for (int q = 0; q < NLC; ++q) { const int ch = z == 0 ? q : NLC - 1 - q; const size_t idx = (((size_t)z * NB + b) * NLC + ch) * W + w; CI[idx] = carry; carry = CA[idx] * carry + CH[idx]; }
    }
}
__device__ __forceinline__ void ret_tables(float* tab, int h) {
    const int tid = threadIdx.x; const float lg = loggamma_(h);
    if (tid < 32) tab[tid] = powf(10000.f, -(float)(2 * tid) / 64.f);
    if (tid >= 64 && tid < 64 + 129) tab[tid] = expf((float)(tid - 64) * lg);
}
__device__ __forceinline__ void ph_ret_kv(const Ctx& c, float* ldsf) {
    const int* pos = (const int*)c.in[2]; const bf16_t* P = WSH(O_P); float* KVF = WSF(O_KVF); float* KVB = WSF(O_KVB);
    bf16_t* VT = (bf16_t*)ldsf; bf16_t* KF = VT + 128 * 136; bf16_t* KB = KF + 64 * 136; float* tab = (float*)(KB + 64 * 136);
    const int tid = threadIdx.x, wv = tid >> 6, lane = tid & 63, fr = lane & 15, fq = lane >> 4;
    for (int u = blockIdx.x; u < (T / 128) * 8; u += gridDim.x) {
        const int h = u & 7; const long t0 = (long)(u >> 3) * 128;
        ret_tables(tab, h);
        SYNCTHREADS();
        { float x1[8], x2[8], pj[8];
#pragma unroll
          for (int q = 0; q < 8; ++q) { const int id = tid + NT * q, j = id & 127, dj = id >> 7; const bf16_t* prow = P + (size_t)(t0 + j) * PW + C_RK + h * 64; x1[q] = bf2f(prow[dj]); x2[q] = bf2f(prow[dj + 32]); pj[q] = (float)pos[t0 + j]; }
#pragma unroll 1
          for (int q = 0; q < 8; ++q) { const int id = tid + NT * q, j = id & 127, dj = id >> 7; const float ang = pj[q] * tab[dj]; const float cs = cosf(ang), sn = sinf(ang);
            const float k1 = x1[q] * cs - x2[q] * sn, k2 = x2[q] * cs + x1[q] * sn, fj = tab[64 + 127 - j], bj = tab[64 + j];
            KF[dj * 136 + j] = (bf16_t)f2bf(k1 * fj); KF[(dj + 32) * 136 + j] = (bf16_t)f2bf(k2 * fj); KB[dj * 136 + j] = (bf16_t)f2bf(k1 * bj); KB[(dj + 32) * 136 + j] = (bf16_t)f2bf(k2 * bj); } }
#pragma unroll
        for (int q = 0; q < 4; ++q) { const int id = tid + NT * q, j = id & 127, e8 = (id >> 7) * 8; const u32x4 raw = *(const u32x4*)(P + (size_t)(t0 + j) * PW + C_RV + h * 128 + e8);
#pragma unroll
            for (int e = 0; e < 4; ++e) { VT[(e8 + 2 * e) * 136 + j] = (bf16_t)(raw[e] & 0xffffu); VT[(e8 + 2 * e + 1) * 136 + j] = (bf16_t)(raw[e] >> 16); } }
        SYNCTHREADS();
        f32x4 af[4], ab[4];
#pragma unroll
        for (int nt = 0; nt < 4; ++nt) { af[nt] = (f32x4){0.f, 0.f, 0.f, 0.f}; ab[nt] = (f32x4){0.f, 0.f, 0.f, 0.f}; }
        wave_mma<4, 4>(af, VT + wv * 16 * 136, 136, KF, 136);
        wave_mma<4, 4>(ab, VT + wv * 16 * 136, 136, KB, 136);
        const size_t ob = (((size_t)(u >> 3) * 8 + h) * 128 + wv * 16 + fr) * 64 + 4 * fq;
#pragma unroll
        for (int nt = 0; nt < 4; ++nt) { *(f32x4*)(KVF + ob + 16 * nt) = af[nt]; *(f32x4*)(KVB + ob + 16 * nt) = ab[nt]; }
        SYNCTHREADS();
    }
}
__device__ __forceinline__ void ph_ret_state(const Ctx& c) {
    const float* KVF = WSF(O_KVF); const float* KVB = WSF(O_KVB); float* STF = WSF(O_STF); float* STB = WSF(O_STB);
    for (long i = GT_; i < (long)NB * 8 * 8192; i += GS_) {
        const int x = (int)(i % 8192), h = (int)((i / 8192) % 8), b = (int)(i / 65536);
        const float cd = expf(128.f * loggamma_(h)); float st = 0.f;
#pragma unroll 16
        for (int n = 0; n < NCH; ++n) { const size_t idx = (((size_t)b * NCH + n) * 8 + h) * 8192 + x; STF[idx] = st; st = cd * st + KVF[idx]; }
        st = 0.f;
#pragma unroll 16
        for (int n = NCH - 1; n >= 0; --n) { const size_t idx = (((size_t)b * NCH + n) * 8 + h) * 8192 + x; STB[idx] = st; st = cd * st + KVB[idx]; }
    }
}
__device__ __forceinline__ void ph_ret_out(const Ctx& c, float* ldsf) {
    const int* pos = (const int*)c.in[2]; const bf16_t* P = WSH(O_P); const float* STF = WSF(O_STF); const float* STB = WSF(O_STB); bf16_t* Y = WSH(O_YS);
    bf16_t* Qs = (bf16_t*)ldsf; bf16_t* Ks = Qs + 128 * 72; bf16_t* VT = Ks + 128 * 72; bf16_t* Ss = VT + 128 * 136; bf16_t* SF = Ss + 128 * 136; bf16_t* SB = SF + 128 * 72; float* tab = (float*)(SB + 128 * 72);
    const int tid = threadIdx.x, wv = tid >> 6, lane = tid & 63, fr = lane & 15, fq = lane >> 4;
    for (int u = blockIdx.x; u < (T / 128) * 8; u += gridDim.x) {
        const int h = u & 7; const long t0 = (long)(u >> 3) * 128;
        ret_tables(tab, h);
        SYNCTHREADS();
#pragma unroll 1
        for (int qh = 0; qh < 8; qh += 4) { float q1[4], q2[4], k1[4], k2[4], pj[4];
#pragma unroll
          for (int q = 0; q < 4; ++q) { const int id = tid + NT * (qh + q), j = id >> 5, dj = id & 31; const bf16_t* prow = P + (size_t)(t0 + j) * PW;
            q1[q] = bf2f(prow[C_RQ + h * 64 + dj]); q2[q] = bf2f(prow[C_RQ + h * 64 + dj + 32]); k1[q] = bf2f(prow[C_RK + h * 64 + dj]); k2[q] = bf2f(prow[C_RK + h * 64 + dj + 32]); pj[q] = (float)pos[t0 + j]; }
#pragma unroll
          for (int q = 0; q < 4; ++q) { const int id = tid + NT * (qh + q), j = id >> 5, dj = id & 31; const float ang = pj[q] * tab[dj]; const float cs = cosf(ang), sn = sinf(ang);
            Qs[j * 72 + dj] = (bf16_t)f2bf((q1[q] * cs - q2[q] * sn) * 0.125f); Qs[j * 72 + dj + 32] = (bf16_t)f2bf((q2[q] * cs + q1[q] * sn) * 0.125f); Ks[j * 72 + dj] = (bf16_t)f2bf(k1[q] * cs - k2[q] * sn); Ks[j * 72 + dj + 32] = (bf16_t)f2bf(k2[q] * cs + k1[q] * sn); } }
#pragma unroll
        for (int q = 0; q < 4; ++q) { const int id = tid + NT * q, j = id & 127, e8 = (id >> 7) * 8; const u32x4 raw = *(const u32x4*)(P + (size_t)(t0 + j) * PW + C_RV + h * 128 + e8);
#pragma unroll
            for (int e = 0; e < 4; ++e) { VT[(e8 + 2 * e) * 136 + j] = (bf16_t)(raw[e] & 0xffffu); VT[(e8 + 2 * e + 1) * 136 + j] = (bf16_t)(raw[e] >> 16); } }
        const size_t sbase = (((size_t)(u >> 3) * 8 + h)) * 8192;
#pragma unroll
        for (int q = 0; q < 4; ++q) { const int id = tid + NT * q, e = id >> 4, d4 = (id & 15) * 4; st_bf4(SF + e * 72 + d4, *(const f32x4*)(STF + sbase + (size_t)e * 64 + d4)); st_bf4(SB + e * 72 + d4, *(const f32x4*)(STB + sbase + (size_t)e * 64 + d4)); }
        SYNCTHREADS();
        const int i = wv * 16 + fr; const long t = t0 + i;
        {
            f32x4 sc[8];
#pragma unroll
            for (int nt = 0; nt < 8; ++nt) sc[nt] = (f32x4){0.f, 0.f, 0.f, 0.f};
            wave_mma<2, 8>(sc, Qs + wv * 16 * 72, 72, Ks, 72);
#pragma unroll
            for (int nt = 0; nt < 8; ++nt) { const int j0 = 16 * nt + 4 * fq; f32x4 sv;
#pragma unroll
                for (int e = 0; e < 4; ++e) { const int j = j0 + e, dist = i > j ? i - j : j - i; sv[e] = sc[nt][e] * tab[64 + dist]; }
                st_bf4(Ss + i * 136 + j0, sv); }
        }
#ifdef CPU_EMU
        SYNCTHREADS();
#else
        asm volatile("s_waitcnt lgkmcnt(0)" ::: "memory");
#endif
        f32x4 ao[8], tm[8];
#pragma unroll
        for (int nt = 0; nt < 8; ++nt) { ao[nt] = (f32x4){0.f, 0.f, 0.f, 0.f}; tm[nt] = (f32x4){0.f, 0.f, 0.f, 0.f}; }
        wave_mma<4, 8>(ao, Ss + wv * 16 * 136, 136, VT, 136);
        wave_mma<2, 8>(tm, Qs + wv * 16 * 72, 72, SF, 72);
        { const float qf = tab[64 + i + 1];
#pragma unroll
            for (int nt = 0; nt < 8; ++nt) { ao[nt] += tm[nt] * qf; tm[nt] = (f32x4){0.f, 0.f, 0.f, 0.f}; } }
        wave_mma<2, 8>(tm, Qs + wv * 16 * 72, 72, SB, 72);
        { const float qb = tab[64 + 128 - i];
#pragma unroll
            for (int nt = 0; nt < 8; ++nt) ao[nt] += tm[nt] * qb; }
        float sm = 0.f;
#pragma unroll
        for (int nt = 0; nt < 8; ++nt) sm += (ao[nt][0] + ao[nt][1]) + (ao[nt][2] + ao[nt][3]);
        sm += SHFL_XOR(sm, 16); sm += SHFL_XOR(sm, 32);
        const float mu = sm * (1.f / 128.f); float sq = 0.f;
#pragma unroll
        for (int nt = 0; nt < 8; ++nt) { ao[nt] -= mu; sq += (ao[nt][0] * ao[nt][0] + ao[nt][1] * ao[nt][1]) + (ao[nt][2] * ao[nt][2] + ao[nt][3] * ao[nt][3]); }
        sq += SHFL_XOR(sq, 16); sq += SHFL_XOR(sq, 32);
        const float rs = 1.f / sqrtf(sq * (1.f / 128.f) + EPS);
#pragma unroll
        for (int nt = 0; nt < 8; ++nt) { const int e0 = 16 * nt + 4 * fq; f32x4 gv = ld_bf4(P + (size_t)t * PW + C_RG + h * 128 + e0);
#pragma unroll
            for (int e = 0; e < 4; ++e) gv[e] = siluf_(gv[e]) * (ao[nt][e] * rs);
            st_bf4(Y + (size_t)t * 4 * W + 1 * W + h * 128 + e0, gv); }
        SYNCTHREADS();
    }
}
__device__ __forceinline__ void ph_sgu_norm(const Ctx& c, int l) {
    const bf16_t* P = WSH(O_P); float* ST = WSF(O_VN);
    const int lane = threadIdx.x & 63, gw = blockIdx.x * (NT / 64) + (threadIdx.x >> 6), ngw = gridDim.x * (NT / 64);
    for (int t = gw; t < T; t += ngw) {
        f32x4 v[4]; float sm = 0.f;
#pragma unroll
        for (int j = 0; j < 4; ++j) { v[j] = ld_bf4(P + (size_t)t * PW + C_SV + (j * 64 + lane) * 4);
#pragma unroll
            for (int q = 0; q < 4; ++q) { v[j][q] = geluf_(v[j][q]); sm += v[j][q]; } }
        const float mu = wave_sum(sm) * (1.f / W); float sq = 0.f;
#pragma unroll
        for (int j = 0; j < 4; ++j)
#pragma unroll
            for (int q = 0; q < 4; ++q) { const float dd = v[j][q] - mu; sq += dd * dd; }
        const float rs = 1.f / sqrtf(wave_sum(sq) * (1.f / W) + EPS);
        if (lane == 0) { ST[(size_t)t * 2] = mu; ST[(size_t)t * 2 + 1] = rs; }
    }
}
__device__ __forceinline__ void ph_sgu_mix(const Ctx& c, int l, float* ldsf) {
    const bf16_t* P = WSH(O_P); const float* ST = WSF(O_VN); bf16_t* Y = WSH(O_YS); const float* ng = c.in[15] + (size_t)l * W;
    bf16_t* As = (bf16_t*)ldsf; bf16_t* Bs = As + 128 * 136; const int tid = threadIdx.x, wv = tid >> 6, lane = tid & 63, fr = lane & 15, fq = lane >> 4;
    for (int u = blockIdx.x; u < (T / 128) * 8; u += gridDim.x) {
        const int g = u & 7; const long t0 = (long)(u >> 3) * 128;
        const float* ws = c.in[16] + ((size_t)l * 8 + g) * 128 * 128; const float* bs = c.in[17] + ((size_t)l * 8 + g) * 128;
#pragma unroll
        for (int q = 0; q < 8; ++q) { const int id = tid + NT * q, i = id >> 5, j4 = (id & 31) * 4; st_bf4(As + i * 136 + j4, *(const f32x4*)(ws + i * 128 + j4)); }
#pragma unroll
        for (int q = 0; q < 4; ++q) { const int id = tid + NT * q, j = id & 127, d8 = (id >> 7) * 8; const float mu = ST[(size_t)(t0 + j) * 2], rs = ST[(size_t)(t0 + j) * 2 + 1];
            const u32x4 raw = *(const u32x4*)(P + (size_t)(t0 + j) * PW + C_SV + g * 128 + d8);
#pragma unroll
            for (int e = 0; e < 4; ++e) { const float v0 = (geluf_(bflo(raw[e])) - mu) * rs * ng[g * 128 + d8 + 2 * e], v1 = (geluf_(bfhi(raw[e])) - mu) * rs * ng[g * 128 + d8 + 2 * e + 1];
                Bs[(d8 + 2 * e) * 136 + j] = (bf16_t)f2bf(v0); Bs[(d8 + 2 * e + 1) * 136 + j] = (bf16_t)f2bf(v1); } }
        SYNCTHREADS();
        f32x4 acc[8];
#pragma unroll
        for (int nt = 0; nt < 8; ++nt) acc[nt] = (f32x4){0.f, 0.f, 0.f, 0.f};
        wave_mma<4, 8>(acc, As + wv * 16 * 136, 136, Bs, 136);
        const int i = wv * 16 + fr; const long t = t0 + i; const float bsi = bs[i];
#pragma unroll
        for (int nt = 0; nt < 8; ++nt) { const int d = 16 * nt + 4 * fq; f32x4 uu = ld_bf4(P + (size_t)t * PW + C_SU + g * 128 + d);
#pragma unroll
            for (int e = 0; e < 4; ++e) uu[e] = geluf_(uu[e]) * (acc[nt][e] + bsi);
            st_bf4(Y + (size_t)t * 4 * W + 2 * W + g * 128 + d, uu); }
        SYNCTHREADS();
    }
}
__device__ __forceinline__ void ph_rw_shift(const Ctx& c, int l) {
    const bf16_t* P = WSH(O_P); const float* mup = c.in[18] + (size_t)l * RF; const float* mun = c.in[19] + (size_t)l * RF; bf16_t* FS = WSH(O_FS);
    const int lane = threadIdx.x & 63, gw = blockIdx.x * (NT / 64) + (threadIdx.x >> 6), ngw = gridDim.x * (NT / 64);
    for (int t = gw; t < T; t += ngw) {
        const int sI = t % S; const bf16_t* pc = P + (size_t)t * PW + C_RW;
#pragma unroll 2
        for (int j = lane * 4; j < RF; j += 256) {
            const f32x4 f = ld_bf4(pc + j), z4 = (f32x4){0.f, 0.f, 0.f, 0.f}; const f32x4 pv = sI > 0 ? ld_bf4(pc - PW + j) : z4, nv = sI < S - 1 ? ld_bf4(pc + PW + j) : z4;
            f32x4 v = f + *(const f32x4*)(mup + j) * (pv - f) + *(const f32x4*)(mun + j) * (nv - f);
            if (j >= 3072 && j < 3200) {
#pragma unroll
                for (int e = 0; e < 4; ++e) v[e] = tanhf_(v[e]); }
            else if (j >= 3328) {
#pragma unroll
                for (int e = 0; e < 4; ++e) v[e] = sigmoidf_(v[e]); }
            st_bf4(FS + (size_t)t * RF + j, v);
        }
    }
}
__device__ __forceinline__ void ph_rw_lora(const Ctx& c, int l, float* ldsf) {
    const bf16_t* FS = WSH(O_FS); const float* w0 = c.in[20] + (size_t)l * 2 * W; const float* a0 = c.in[22] + (size_t)l * 2 * W;
    const bf16_t* WUT = WSH(O_WUT); const bf16_t* WAT = WSH(O_WAT); const bf16_t* WGT = WSH(O_WGT);
    bf16_t* DEC = WSH(O_DEC); bf16_t* AA = WSH(O_AA); bf16_t* GG = WSH(O_GG);
    bf16_t* F = (bf16_t*)ldsf; bf16_t* B1 = F + 128 * 136; bf16_t* B2 = B1 + 128 * 136; const int tid = threadIdx.x, wv = tid >> 6, lane = tid & 63, fr = lane & 15, fq = lane >> 4;
    for (int u = blockIdx.x; u < (T / 128) * 8; u += gridDim.x) {
        const int wc0 = (u & 7) * 128; const long t0 = (long)(u >> 3) * 128;
        for (int rd = 0; rd < 3; ++rd) {
#pragma unroll
            for (int q = 0; q < 8; ++q) { const int id = tid + NT * q, r = id >> 5, c4 = (id & 31) * 4;
                const int col = rd < 2 ? (c4 < 64 ? 3072 + rd * 64 + c4 : 3200 + rd * 64 + (c4 - 64)) : 3328 + c4;
                *(unsigned long long*)(F + r * 136 + c4) = *(const unsigned long long*)(FS + (size_t)(t0 + r) * RF + col); }
            if (rd < 2) {
#pragma unroll
                for (int q = 0; q < 2; ++q) { const int id = tid + NT * q, w = id >> 3, r8 = (id & 7) * 8;
                    *(u32x4*)(B1 + w * 72 + r8) = *(const u32x4*)(WUT + ((size_t)rd * W + wc0 + w) * 64 + r8); *(u32x4*)(B2 + w * 72 + r8) = *(const u32x4*)(WAT + ((size_t)rd * W + wc0 + w) * 64 + r8); }
            } else {
#pragma unroll
                for (int q = 0; q < 4; ++q) { const int id = tid + NT * q, w = id >> 4, r8 = (id & 15) * 8; *(u32x4*)(B1 + w * 136 + r8) = *(const u32x4*)(WGT + ((size_t)wc0 + w) * 128 + r8); }
            }
            SYNCTHREADS();
            f32x4 a1[8], a2[8];
#pragma unroll
            for (int nt = 0; nt < 8; ++nt) { a1[nt] = (f32x4){0.f, 0.f, 0.f, 0.f}; a2[nt] = (f32x4){0.f, 0.f, 0.f, 0.f}; }
            const long t = t0 + wv * 16 + fr;
            if (rd < 2) {
                wave_mma<2, 8>(a1, F + wv * 16 * 136, 136, B1, 72);
                wave_mma<2, 8>(a2, F + wv * 16 * 136 + 64, 136, B2, 72);
#pragma unroll
                for (int nt = 0; nt < 8; ++nt) { const int ch = wc0 + 16 * nt + 4 * fq; const f32x4 w0v = *(const f32x4*)(w0 + rd * W + ch), a0v = *(const f32x4*)(a0 + rd * W + ch); f32x4 dv, av;
#pragma unroll
                    for (int e = 0; e < 4; ++e) { dv[e] = fexp_(-DECAY_SCALE * sigmoidf_(a1[nt][e] + w0v[e])); av[e] = sigmoidf_(a2[nt][e] + a0v[e]); }
                    st_bf4(DEC + ((size_t)rd * T + t) * W + ch, dv); st_bf4(AA + ((size_t)rd * T + t) * W + ch, av); }
            } else {
                wave_mma<4, 8>(a1, F + wv * 16 * 136, 136, B1, 136);
#pragma unroll
                for (int nt = 0; nt < 8; ++nt) st_bf4(GG + (size_t)t * W + wc0 + 16 * nt + 4 * fq, a1[nt]);
            }
            SYNCTHREADS();
        }
    }
}
#ifdef CPU_EMU
__device__ __forceinline__ float red16_(float x) { x += SHFL_XOR(x, 1); x += SHFL_XOR(x, 2); x += SHFL_XOR(x, 4); x += SHFL_XOR(x, 8); return x; }
#define LDS_BARRIER() emu_syncthreads()
#else
__device__ __forceinline__ float red16_(float x) {
    x += __builtin_bit_cast(float, __builtin_amdgcn_update_dpp(0, __builtin_bit_cast(int, x), 0xB1, 0xF, 0xF, true));
    x += __builtin_bit_cast(float, __builtin_amdgcn_update_dpp(0, __builtin_bit_cast(int, x), 0x4E, 0xF, 0xF, true));
    x += __builtin_bit_cast(float, __builtin_amdgcn_update_dpp(0, __builtin_bit_cast(int, x), 0x141, 0xF, 0xF, true));
    x += __builtin_bit_cast(float, __builtin_amdgcn_update_dpp(0, __builtin_bit_cast(int, x), 0x140, 0xF, 0xF, true));
    return x;
}
#define LDS_BARRIER() do { asm volatile("s_waitcnt lgkmcnt(0)" ::: "memory"); __builtin_amdgcn_s_barrier(); asm volatile("" ::: "memory"); } while (0)
#endif
#define RC_M(k) (lm + (k) * 4608)
__device__ __forceinline__ void ph_rw_chunk(const Ctx& c, int l, float* ldsf) {
    const bf16_t* FS = WSH(O_FS); const bf16_t* DEC = WSH(O_DEC); const bf16_t* AA = WSH(O_AA); float* BON = WSF(O_BON);
    const float* kkw = c.in[25] + (size_t)l * W; const float* kaw = c.in[26] + (size_t)l * W; const float* rk = c.in[27] + (size_t)l * W;
    bf16_t* PST = WSH(O_PST); bf16_t* PYT = WSH(O_PYT); bf16_t* SVB = WSH(O_SVB); bf16_t* YVB = WSH(O_YVB);
    bf16_t* lm = (bf16_t*)ldsf; float* gam = (float*)RC_M(7); float* segp = (float*)RC_M(13); float* gl = segp + 512;
    const int tid = threadIdx.x, wv = tid >> 6, lane = tid & 63, fr = lane & 15, fq = lane >> 4, rt = wv & 3, hf = wv >> 2;
    const int m0 = 16 * rt + fr;
    float wv8[8], kv8[8], rv8[8], vv8[8], aa8[8];
#define RC_LOAD(uu) do { const int chain_ = (uu) / NRC, ck_ = (uu) % NRC, h_ = chain_ & 15, b_ = (chain_ >> 4) & 1, z_ = chain_ >> 5; \
        const long tb_ = (long)b_ * S + (z_ ? S - 1 - ck_ * RCK : ck_ * RCK); const int dirn_ = z_ ? -1 : 1; \
        const bf16_t* decp_ = DEC + ((size_t)z_ * T) * W + h_ * 64; const bf16_t* aap_ = AA + ((size_t)z_ * T) * W + h_ * 64; const int ch_ = h_ * 64 + lane; \
        _Pragma("unroll") for (int q = 0; q < 8; ++q) wv8[q] = bf2f(decp_[(size_t)(tb_ + dirn_ * ((tid >> 6) * 8 + q)) * W + (tid & 63)]); \
        _Pragma("unroll") for (int q = 0; q < 8; ++q) { const long t_ = tb_ + dirn_ * (wv + 8 * q); const bf16_t* f_ = FS + (size_t)t_ * RF; kv8[q] = bf2f(f_[1024 + ch_]); rv8[q] = bf2f(f_[ch_]); vv8[q] = bf2f(f_[2048 + ch_]); aa8[q] = bf2f(aap_[(size_t)t_ * W + lane]); } } while (0)
    if ((int)blockIdx.x < 64 * NRC) RC_LOAD((int)blockIdx.x);
    for (int u = blockIdx.x; u < 64 * NRC; u += gridDim.x) {
        const int chain = u / NRC, ck = u % NRC, h = chain & 15, b = (chain >> 4) & 1, z = chain >> 5;
        const long tb = (long)b * S + (z ? S - 1 - ck * RCK : ck * RCK); const int dirn = z ? -1 : 1;
        { const int k = tid & 63, sg = tid >> 6; float p = 1.f;
#pragma unroll
          for (int q = 0; q < 8; ++q) { p *= wv8[q]; gam[(sg * 8 + q) * 64 + k] = p; }
          segp[sg * 64 + k] = p; }
        LDS_BARRIER();
        { const int k = tid & 63, sg = tid >> 6; float pre = 1.f;
          for (int q = 0; q < sg; ++q) pre *= segp[q * 64 + k];
#pragma unroll
          for (int q = 0; q < 8; ++q) gam[(sg * 8 + q) * 64 + k] *= pre;
          if (sg == 7) gl[k] = gam[63 * 64 + k]; }
        LDS_BARRIER();
        { const int k = lane, ch = h * 64 + k; const float kkwv = kkw[ch], kav = kaw[ch], rkv = rk[ch];
#pragma unroll
          for (int q = 0; q < 8; ++q) { const int tt = wv + 8 * q; const long t = tb + dirn * tt;
            const float vk = kv8[q] * kkwv; const float kkn = vk * frsq_(wave_sum(vk * vk) + EPS); const float ktv = kv8[q] * (1.f + (aa8[q] - 1.f) * kav);
            const float bsum = wave_sum(rv8[q] * rkv * ktv); if (lane == 0) BON[((size_t)z * T + t) * 16 + h] = bsum;
            const float g = gam[tt * 64 + k], gp = tt ? gam[(tt - 1) * 64 + k] : 1.f, ig = frcp_(g);
            const bf16_t khv = (bf16_t)f2bf(kkn * gp), bhv = (bf16_t)f2bf(aa8[q] * kkn * ig);
            RC_M(0)[tt * 72 + k] = khv; RC_M(1)[k * 72 + tt] = khv; RC_M(2)[tt * 72 + k] = bhv; RC_M(3)[k * 72 + tt] = bhv;
            RC_M(4)[tt * 72 + k] = (bf16_t)f2bf(ktv * ig); RC_M(5)[tt * 72 + k] = (bf16_t)f2bf(rv8[q] * g); RC_M(6)[k * 72 + tt] = (bf16_t)f2bf(vv8[q]); } }
        if (u + (int)gridDim.x < 64 * NRC) RC_LOAD(u + (int)gridDim.x);
        LDS_BARRIER();
        f32x4 mkr[2], khr[2], rhT[2];
        {
            f32x4 a0[2], a1[2], a2[2], a3[2];
#pragma unroll
            for (int nt = 0; nt < 2; ++nt) { a0[nt] = (f32x4){0.f, 0.f, 0.f, 0.f}; a1[nt] = a0[nt]; a2[nt] = a0[nt]; a3[nt] = a0[nt]; }
            wave_mma<2, 2>(a0, RC_M(2) + rt * 16 * 72, 72, RC_M(0) + hf * 32 * 72, 72);
            wave_mma<2, 2>(a1, RC_M(4) + rt * 16 * 72, 72, RC_M(0) + hf * 32 * 72, 72);
            wave_mma<2, 2>(a2, RC_M(2) + rt * 16 * 72, 72, RC_M(5) + hf * 32 * 72, 72);
            wave_mma<2, 2>(a3, RC_M(4) + rt * 16 * 72, 72, RC_M(5) + hf * 32 * 72, 72);
#pragma unroll
            for (int nt = 0; nt < 2; ++nt) { const int n0 = 32 * hf + 16 * nt + 4 * fq; f32x4 nn, ti, mk;
#pragma unroll
                for (int r = 0; r < 4; ++r) { const int n = n0 + r; const bool lt = m0 < n, le = m0 <= n;
                    nn[r] = lt ? -a0[nt][r] : 0.f; ti[r] = nn[r] + (m0 == n ? 1.f : 0.f); mk[r] = lt ? a1[nt][r] : 0.f; mkr[nt][r] = le ? a3[nt][r] : 0.f;
                    RC_M(12)[n * 72 + m0] = (bf16_t)f2bf(le ? a2[nt][r] : 0.f);
                    RC_M(8)[n * 72 + m0] = (bf16_t)f2bf(nn[r]);
                    khr[nt][r] = bf2f(RC_M(4)[m0 * 72 + n]); rhT[nt][r] = bf2f(RC_M(5)[n * 72 + m0]); }
                st_bf4(RC_M(7) + m0 * 72 + n0, nn); st_bf4(RC_M(9) + m0 * 72 + n0, ti); st_bf4(RC_M(11) + m0 * 72 + n0, mk); }
        }
        LDS_BARRIER();
        f32x4 tiv[2];
#pragma unroll
        for (int nt = 0; nt < 2; ++nt) tiv[nt] = ld_bf4(RC_M(9) + m0 * 72 + 32 * hf + 16 * nt + 4 * fq);
#pragma unroll 1
        for (int it = 0; it < 5; ++it) {
            bf16_t* pw = (it & 1) ? RC_M(0) : RC_M(7); bf16_t* pwT = (it & 1) ? RC_M(2) : RC_M(8); bf16_t* pw2 = (it & 1) ? RC_M(7) : RC_M(0); bf16_t* pw2T = (it & 1) ? RC_M(8) : RC_M(2);
            bf16_t* tcur = (it & 1) ? RC_M(4) : RC_M(9); bf16_t* tnxt = (it & 1) ? RC_M(9) : RC_M(4);
            f32x4 sq[2];
#pragma unroll
            for (int nt = 0; nt < 2; ++nt) sq[nt] = (f32x4){0.f, 0.f, 0.f, 0.f};
            wave_mma<2, 2>(sq, pw + rt * 16 * 72, 72, pwT + hf * 32 * 72, 72);
#pragma unroll
            for (int nt = 0; nt < 2; ++nt) { const int n0 = 32 * hf + 16 * nt + 4 * fq; st_bf4(pw2 + m0 * 72 + n0, sq[nt]);
#pragma unroll
                for (int r = 0; r < 4; ++r) pw2T[(n0 + r) * 72 + m0] = (bf16_t)f2bf(sq[nt][r]); }
            LDS_BARRIER();
            f32x4 up[2];
#pragma unroll
            for (int nt = 0; nt < 2; ++nt) up[nt] = (f32x4){0.f, 0.f, 0.f, 0.f};
            wave_mma<2, 2>(up, tcur + rt * 16 * 72, 72, pw2T + hf * 32 * 72, 72);
#pragma unroll
            for (int nt = 0; nt < 2; ++nt) { const int n0 = 32 * hf + 16 * nt + 4 * fq; tiv[nt] += up[nt]; st_bf4(tnxt + m0 * 72 + n0, tiv[nt]);
                if (it == 4) {
#pragma unroll
                    for (int r = 0; r < 4; ++r) RC_M(10)[(n0 + r) * 72 + m0] = (bf16_t)f2bf(tiv[nt][r]); } }
            LDS_BARRIER();
        }
        {
            f32x4 w1[2], w2[2];
#pragma unroll
            for (int nt = 0; nt < 2; ++nt) { w1[nt] = (f32x4){0.f, 0.f, 0.f, 0.f}; w2[nt] = w1[nt]; }
            wave_mma<2, 2>(w1, RC_M(1) + rt * 16 * 72, 72, RC_M(10) + hf * 32 * 72, 72);
            wave_mma<2, 2>(w2, RC_M(11) + rt * 16 * 72, 72, RC_M(10) + hf * 32 * 72, 72);
#pragma unroll
            for (int nt = 0; nt < 2; ++nt) { const int n0 = 32 * hf + 16 * nt + 4 * fq; st_bf4(RC_M(7) + m0 * 72 + n0, w1[nt]); st_bf4(RC_M(8) + m0 * 72 + n0, w2[nt]); }
        }
        LDS_BARRIER();
        {
            f32x4 py[2], qy[2], ps[2], qs[2];
#pragma unroll
            for (int nt = 0; nt < 2; ++nt) { py[nt] = (f32x4){0.f, 0.f, 0.f, 0.f}; qy[nt] = py[nt]; ps[nt] = py[nt]; qs[nt] = py[nt]; }
            wave_mma<2, 2>(py, RC_M(7) + rt * 16 * 72, 72, RC_M(12) + hf * 32 * 72, 72);
            wave_mma<2, 2>(qy, RC_M(8) + rt * 16 * 72, 72, RC_M(12) + hf * 32 * 72, 72);
            wave_mma<2, 2>(ps, RC_M(7) + rt * 16 * 72, 72, RC_M(3) + hf * 32 * 72, 72);
            wave_mma<2, 2>(qs, RC_M(8) + rt * 16 * 72, 72, RC_M(3) + hf * 32 * 72, 72);
#pragma unroll
            for (int nt = 0; nt < 2; ++nt) { const int n0 = 32 * hf + 16 * nt + 4 * fq;
#pragma unroll
                for (int r = 0; r < 4; ++r) { const int n = n0 + r; const float gln = gl[n];
                    RC_M(0)[n * 72 + m0] = (bf16_t)f2bf(rhT[nt][r] - py[nt][r]); RC_M(2)[n * 72 + m0] = (bf16_t)f2bf(mkr[nt][r] - qy[nt][r]);
                    RC_M(4)[n * 72 + m0] = (bf16_t)f2bf(((m0 == n ? 1.f : 0.f) - ps[nt][r]) * gln); RC_M(5)[n * 72 + m0] = (bf16_t)f2bf((khr[nt][r] - qs[nt][r]) * gln); } }
        }
        LDS_BARRIER();
        {
            f32x4 yv[2], sv[2];
#pragma unroll
            for (int nt = 0; nt < 2; ++nt) { yv[nt] = (f32x4){0.f, 0.f, 0.f, 0.f}; sv[nt] = yv[nt]; }
            wave_mma<2, 2>(yv, RC_M(6) + rt * 16 * 72, 72, RC_M(2) + hf * 32 * 72, 72);
            wave_mma<2, 2>(sv, RC_M(6) + rt * 16 * 72, 72, RC_M(5) + hf * 32 * 72, 72);
#pragma unroll
            for (int nt = 0; nt < 2; ++nt) { const int n0 = 32 * hf + 16 * nt + 4 * fq; st_bf4(YVB + (size_t)u * 4096 + m0 * 64 + n0, yv[nt]); st_bf4(SVB + (size_t)u * 4096 + m0 * 64 + n0, sv[nt]); }
            { const int rr = tid >> 3, c8 = (tid & 7) * 8; *(u32x4*)(PYT + (size_t)u * 4096 + rr * 64 + c8) = *(const u32x4*)(RC_M(0) + rr * 72 + c8); *(u32x4*)(PST + (size_t)u * 4096 + rr * 64 + c8) = *(const u32x4*)(RC_M(4) + rr * 72 + c8); }
        }
        LDS_BARRIER();
    }
}
#undef RC_M
#undef RC_LOAD
__device__ __forceinline__ void ph_rw_seq(const Ctx& c, float* ldsf) {
    const bf16_t* PST = WSH(O_PST); const bf16_t* PYT = WSH(O_PYT); const bf16_t* SVB = WSH(O_SVB); const bf16_t* YVB = WSH(O_YVB); bf16_t* YY = WSH(O_YY);
    bf16_t* Sb = (bf16_t*)ldsf;
    bf16_t* Pm = Sb + 2 * 16 * 72;
    const int tid = threadIdx.x, wv = tid >> 6, lane = tid & 63, fr = lane & 15, fq = lane >> 4, isY = wv >> 2, nt0 = wv & 3;
    for (int u = blockIdx.x; u < 256; u += gridDim.x) {
        const int x = u & 7, jq = u >> 3, chain = x * 8 + (jq >> 2), qt = jq & 3, h = chain & 15, b = (chain >> 4) & 1, z = chain >> 5;
        const size_t ub = (size_t)chain * NRC;
        const int rr = tid >> 3, c8 = (tid & 7) * 8;
        constexpr int PD = NRC >= 8 ? 8 : 4;
        for (int i = tid; i < 2 * 16 * 72 / 2; i += NT) ((unsigned*)Sb)[i] = 0u;
        const int row = 16 * qt + fr, n0 = 16 * nt0 + 4 * fq; const bf16_t* addp = (isY ? YVB : SVB) + ub * 4096 + row * 64 + n0;
        const bf16_t* psp = PST + ub * 4096 + rr * 64 + c8; const bf16_t* pyp = PYT + ub * 4096 + rr * 64 + c8;
        u32x4 gps[PD], gpy[PD]; f32x4 add[PD];
#pragma unroll
        for (int j = 0; j < PD; ++j) { gps[j] = *(const u32x4*)(psp + (size_t)j * 4096); gpy[j] = *(const u32x4*)(pyp + (size_t)j * 4096); add[j] = ld_bf4(addp + (size_t)j * 4096); }
        *(u32x4*)(Pm + (0 * 2 + 0) * 4608 + rr * 72 + c8) = gps[0]; *(u32x4*)(Pm + (0 * 2 + 1) * 4608 + rr * 72 + c8) = gpy[0];
        if (PD < NRC) { gps[0] = *(const u32x4*)(psp + (size_t)PD * 4096); gpy[0] = *(const u32x4*)(pyp + (size_t)PD * 4096); }
        SYNCTHREADS();
        for (int ck0 = 0; ck0 < NRC; ck0 += PD) {
#pragma unroll
            for (int j = 0; j < PD; ++j) {
                const int ck = ck0 + j, cur = j & 1, nxt = cur ^ 1;
                f32x4 acc[1]; acc[0] = (f32x4){0.f, 0.f, 0.f, 0.f};
                wave_mma<2, 1>(acc, Sb + cur * 16 * 72, 72, Pm + (cur * 2 + isY) * 4608 + nt0 * 16 * 72, 72);
                acc[0] += add[j];
                if (ck + PD < NRC) add[j] = ld_bf4(addp + (size_t)(ck + PD) * 4096);
                if (isY) {
#pragma unroll
                    for (int r = 0; r < 4; ++r) { const int step = ck * RCK + n0 + r, sidx = z ? S - 1 - step : step; YY[((size_t)z * T + (size_t)b * S + sidx) * W + h * 64 + row] = (bf16_t)f2bf(acc[0][r]); }
                } else st_bf4(Sb + nxt * 16 * 72 + fr * 72 + n0, acc[0]);
                const int jn = (j + 1) % PD;
                if (ck + 1 < NRC) { *(u32x4*)(Pm + (nxt * 2 + 0) * 4608 + rr * 72 + c8) = gps[jn]; *(u32x4*)(Pm + (nxt * 2 + 1) * 4608 + rr * 72 + c8) = gpy[jn]; }
                if (ck + 1 + PD < NRC) { gps[jn] = *(const u32x4*)(psp + (size_t)(ck + 1 + PD) * 4096); gpy[jn] = *(const u32x4*)(pyp + (size_t)(ck + 1 + PD) * 4096); }
                LDS_BARRIER();
            }
        }
    }
}
__device__ __forceinline__ void ph_rw_out(const Ctx& c) {
    const bf16_t* FS = WSH(O_FS); const bf16_t* YY = WSH(O_YY); const float* BON = WSF(O_BON); const bf16_t* GG = WSH(O_GG); bf16_t* Y = WSH(O_YS);
    const int lane = threadIdx.x & 63, gw = blockIdx.x * (NT / 64) + (threadIdx.x >> 6), ngw = gridDim.x * (NT / 64);
    for (int i = gw; i < T * 4; i += ngw) {
        const int h0 = (i & 3) * 4; const long t = i >> 2; float y0[4], y1[4], gv[4], vv[4], bs[4];
#pragma unroll
        for (int q = 0; q < 4; ++q) { const int ch = (h0 + q) * 64 + lane; y0[q] = bf2f(YY[(size_t)t * W + ch]); y1[q] = bf2f(YY[((size_t)T + t) * W + ch]); gv[q] = bf2f(GG[(size_t)t * W + ch]); vv[q] = bf2f(FS[(size_t)t * RF + 2048 + ch]);
            bs[q] = BON[(size_t)t * 16 + h0 + q] + BON[((size_t)T + t) * 16 + h0 + q]; }
#pragma unroll
        for (int q = 0; q < 4; ++q) { const int ch = (h0 + q) * 64 + lane;
            const float m0 = wave_sum(y0[q]) * (1.f / 64.f), m1 = wave_sum(y1[q]) * (1.f / 64.f); const float d0 = y0[q] - m0, d1 = y1[q] - m1;
            const float r0 = 1.f / sqrtf(wave_sum(d0 * d0) * (1.f / 64.f) + EPS), r1 = 1.f / sqrtf(wave_sum(d1 * d1) * (1.f / 64.f) + EPS);
            Y[(size_t)t * 4 * W + 3 * W + ch] = (bf16_t)f2bf((d0 * r0 + d1 * r1 + bs[q] * vv[q]) * gv[q]); }
    }
}
__device__ __forceinline__ void ph_router(const Ctx& c, int l, float* ldsf) {
    const float* H = WSF(O_HF); const bf16_t* WH = WSH(O_WRH); const bf16_t* WL = WSH(O_WRL); const float* bg = c.in[31] + (size_t)l * 4; const float* be = c.in[33] + (size_t)l * 32;
    int* EID = WSI(O_EID); float* EWT = WSF(O_EWT); int* cnt = CTLW(c) + CW_CNT + l * 64;
    const int tid = threadIdx.x, wv = tid >> 6, lane = tid & 63, fr = lane & 15, fq = lane >> 4, rt = wv & 1, kq = wv >> 1;
    float* part = ldsf;
    for (int u = blockIdx.x; u < T / 32; u += gridDim.x) {
        const long t0 = (long)u * 32; f32x4 acc[3];
#pragma unroll
        for (int nt = 0; nt < 3; ++nt) acc[nt] = (f32x4){0.f, 0.f, 0.f, 0.f};
#ifdef CPU_EMU
        for (int nt = 0; nt < 3; ++nt) for (int r = 0; r < 4; ++r) { const int n = 16 * nt + 4 * fq + r; float sacc = 0.f;
            for (int k = kq * 512; k < kq * 512 + 512; ++k) { const float hv = H[(size_t)(t0 + 16 * rt + fr) * D + k]; const float hh = bf2f((bf16_t)f2bf(hv)), hl = bf2f((bf16_t)f2bf(hv - hh));
                const float wh = bf2f(WH[(size_t)n * D + k]), wl = bf2f(WL[(size_t)n * D + k]); sacc += hh * wh + hl * wh + hh * wl; }
            acc[nt][r] = sacc; }
#else
        const float* hp = H + (size_t)(t0 + 16 * rt + fr) * D + kq * 512 + fq * 8;
#pragma unroll 4
        for (int ks = 0; ks < 16; ++ks) {
            const f32x4 h0 = *(const f32x4*)(hp + ks * 32), h1 = *(const f32x4*)(hp + ks * 32 + 4); bf16x8 ah, al;
#pragma unroll
            for (int e = 0; e < 4; ++e) { const unsigned b0 = f2bf(h0[e]), b1 = f2bf(h1[e]); ah[e] = (short)b0; ah[4 + e] = (short)b1; al[e] = (short)f2bf(h0[e] - u2f_(b0 << 16)); al[4 + e] = (short)f2bf(h1[e] - u2f_(b1 << 16)); }
#pragma unroll
            for (int nt = 0; nt < 3; ++nt) { const size_t wo = (size_t)(16 * nt + fr) * D + kq * 512 + ks * 32 + fq * 8; const bf16x8 bh = *(const bf16x8*)(WH + wo), bl = *(const bf16x8*)(WL + wo);
                acc[nt] = __builtin_amdgcn_mfma_f32_16x16x32_bf16(bh, ah, acc[nt], 0, 0, 0); acc[nt] = __builtin_amdgcn_mfma_f32_16x16x32_bf16(bh, al, acc[nt], 0, 0, 0); acc[nt] = __builtin_amdgcn_mfma_f32_16x16x32_bf16(bl, ah, acc[nt], 0, 0, 0); }
        }
#endif
#pragma unroll
        for (int nt = 0; nt < 3; ++nt) *(f32x4*)(part + (kq * 32 + 16 * rt + fr) * 48 + 16 * nt + 4 * fq) = acc[nt];
        SYNCTHREADS();
        if (tid < 32) { const long t = t0 + tid; float lg[36];
#pragma unroll
            for (int q = 0; q < 36; ++q) lg[q] = (part[(0 * 32 + tid) * 48 + q] + part[(1 * 32 + tid) * 48 + q]) + (part[(2 * 32 + tid) * 48 + q] + part[(3 * 32 + tid) * 48 + q]) + (q < 4 ? bg[q < 4 ? q : 0] : be[q >= 4 ? q - 4 : 0]);
            int gi = 0; float m = lg[0];
#pragma unroll
            for (int q = 1; q < 4; ++q) if (lg[q] > m) { m = lg[q]; gi = q; }
            float den = 0.f;
#pragma unroll
            for (int q = 0; q < 4; ++q) den += expf(lg[q] - m);
            const float gp = 1.f / den; float el[8];
#pragma unroll
            for (int q = 0; q < 8; ++q) el[q] = gi == 0 ? lg[4 + q] : gi == 1 ? lg[12 + q] : gi == 2 ? lg[20 + q] : lg[28 + q];
            int i1 = 0; float m1 = el[0];
#pragma unroll
            for (int q = 1; q < 8; ++q) if (el[q] > m1) { m1 = el[q]; i1 = q; }
            int i2 = -1; float m2 = 0.f;
#pragma unroll
            for (int q = 0; q < 8; ++q) if (q != i1 && (i2 < 0 || el[q] > m2)) { m2 = el[q]; i2 = q; }
            const float p2 = expf(m2 - m1);
            EID[t * 2] = gi * 8 + i1; EID[t * 2 + 1] = gi * 8 + i2; EWT[t * 2] = gp / (1.f + p2); EWT[t * 2 + 1] = gp * p2 / (1.f + p2);
            atomic_add_i(cnt + gi * 8 + i1, 1); atomic_add_i(cnt + gi * 8 + i2, 1);
        }
        SYNCTHREADS();
    }
}
__device__ __forceinline__ void ph_moe_plan(const Ctx& c, int l) {
    int* cnt = CTLW(c) + CW_CNT + l * 64; int* plan = CTLW(c) + CW_PLAN + l * 256;
    if (GT_ == 0) {
        int ps = 0, nb = 0;
        for (int e = 0; e < NE; ++e) { plan[e] = ps; const int nblk = (cnt[e] + 255) / 256; for (int q = 0; q < nblk; ++q) plan[64 + nb++] = e; ps += nblk * 256; }
        plan[32] = ps; plan[40] = nb;
    }
}
__device__ __forceinline__ void ph_moe_assign(const Ctx& c, int l) {
    const int* EID = WSI(O_EID); int* fill = CTLW(c) + CW_FILL + l * 64; const int* plan = CTLW(c) + CW_PLAN + l * 256; int* DEST = WSI(O_DEST);
    for (long i = GT_; i < (long)T * 2; i += GS_) { const int e = EID[i]; const int pos = atomic_add_i(fill + e, 1); DEST[i] = plan[e] + pos; }
}
__device__ __forceinline__ void ph_moe_gather(const Ctx& c) {
    const int* DEST = WSI(O_DEST); const u32x4* H = (const u32x4*)WSH(O_H); u32x4* XS = (u32x4*)WSH(O_XS);
    for (long i = GT_; i < (long)T * 2 * (D / 8); i += GS_) { const int q = (int)(i % (D / 8)); const long a = i / (D / 8); XS[(size_t)DEST[a] * (D / 8) + q] = H[(size_t)(a >> 1) * (D / 8) + q]; }
}
#ifndef CPU_EMU
#define XB_TMO      128
#define XB_XCNT(j)  (256  + 64 * (j))
#define XB_XSUB(j)  (1280 + 64 * (j))
#define XB_XGEN(j)  (2304 + 64 * (j))
#define XB_TOP      3328
#define XB_TOPGEN   3392
#define XCD_BAR_WORDS 3456
#define XB_SPIN_CAP (1u << 26)
#define LAS __attribute__((address_space(3)))
__device__ __forceinline__ unsigned xb_ld(unsigned* p)              { return __hip_atomic_load(p, __ATOMIC_RELAXED, __HIP_MEMORY_SCOPE_AGENT); }
__device__ __forceinline__ unsigned xb_add(unsigned* p, unsigned v) { return __hip_atomic_fetch_add(p, v, __ATOMIC_RELAXED, __HIP_MEMORY_SCOPE_AGENT); }
__device__ __forceinline__ unsigned xb_xcc_id() { return (unsigned)__builtin_amdgcn_s_getreg((3 << 11) | 20) & 0xFu; }
#define XB_SPIN(cond, bar) do { unsigned _sp = 0; while (cond) { __builtin_amdgcn_s_sleep(1); \
    if ((++_sp & 255u) == 0u) { if (xb_ld(&(bar)[XB_TMO])) break; if (_sp > XB_SPIN_CAP) { atomicAdd(&(bar)[XB_TMO], 1u); break; } } } } while (0)
struct XcdBarrier { unsigned* bar; unsigned x; volatile LAS unsigned* st; };
__device__ __forceinline__ XcdBarrier xcd_barrier_post(unsigned* bar, volatile LAS unsigned* st) {
    XcdBarrier b; b.bar = bar; b.x = xb_xcc_id(); b.st = st;
    if (threadIdx.x == 0) (void)xb_add(&bar[XB_XCNT(b.x)], 1u);
    return b;
}
__device__ __forceinline__ void xcd_barrier_complete(unsigned* bar, unsigned x, unsigned& nloc, unsigned& nx) {
    const unsigned G = gridDim.x * gridDim.y * gridDim.z;
    unsigned sum, cnt, mine, sp = 0u;
    for (;;) {
        sum = 0u; cnt = 0u; mine = 0u;
#pragma unroll
        for (unsigned j = 0; j < 16; ++j) { const unsigned cc = xb_ld(&bar[XB_XCNT(j)]); sum += cc; cnt += (cc > 0u) ? 1u : 0u; mine = (j == x) ? cc : mine; }
        if (sum == G) break;
        __builtin_amdgcn_s_sleep(1);
        if ((++sp & 255u) == 0u) { if (xb_ld(&bar[XB_TMO])) break; if (sp > XB_SPIN_CAP) { atomicAdd(&bar[XB_TMO], 1u); break; } }
    }
    nloc = mine > 0u ? mine : 1u; nx = cnt > 0u ? cnt : 1u;
}
__device__ __forceinline__ void xcd_barrier(const XcdBarrier& b) {
    asm volatile("s_waitcnt vmcnt(0)" ::: "memory");
    __syncthreads();
    if (threadIdx.x == 0) {
        unsigned* bar = b.bar;
        __builtin_amdgcn_s_waitcnt(0);
        unsigned nloc = b.st[0], nx = b.st[1];
        if (nloc == 0u) { xcd_barrier_complete(bar, b.x, nloc, nx); b.st[0] = nloc; b.st[1] = nx; }
        const unsigned old = xb_add(&bar[XB_XSUB(b.x)], 1u);
        const unsigned gen = old / nloc;
        if (old + 1u == (gen + 1u) * nloc) {
            __builtin_amdgcn_fence(__ATOMIC_RELEASE, "agent");
            asm volatile("s_waitcnt vmcnt(0)" ::: "memory");
            const unsigned og = xb_add(&bar[XB_TOP], 1u);
            const unsigned tg = og / nx;
            if (og + 1u == (tg + 1u) * nx) xb_add(&bar[XB_TOPGEN], 1u);
            else XB_SPIN(xb_ld(&bar[XB_TOPGEN]) == tg, bar);
            __builtin_amdgcn_fence(__ATOMIC_ACQUIRE, "agent");
            xb_add(&bar[XB_XGEN(b.x)], 1u);
            asm volatile("s_waitcnt vmcnt(0)" ::: "memory");
        } else {
            XB_SPIN(xb_ld(&bar[XB_XGEN(b.x)]) == gen, bar);
            __builtin_amdgcn_fence(__ATOMIC_ACQUIRE, "agent");
            asm volatile("s_waitcnt vmcnt(0)" ::: "memory");
        }
    }
    __syncthreads();
}
#endif

constexpr int LDS_BYTES = 147456;

__global__ void __launch_bounds__(NT, 2) fwd(Params p) {
#ifdef CPU_EMU
    unsigned char* lds = g_lds; float* ldsf = (float*)g_lds;
#else
    extern __shared__ __attribute__((aligned(16))) unsigned char lds[];
    float* ldsf = (float*)lds;
    volatile LAS unsigned* misc = (volatile LAS unsigned*)((LAS unsigned char*)lds + LDS_BYTES - 64);
    if (threadIdx.x == 0) { misc[0] = 0u; misc[1] = 0u; }
    __syncthreads();
    XcdBarrier bar = xcd_barrier_post((unsigned*)(p.ws + O_CTL) + CW_BAR, misc);
#endif
    Ctx c; c.in = p.in; c.out = p.out; c.ws = p.ws;
    const int lo = p.ph_lo, hi = p.ph_hi; int ph = 0;
    const int G = (int)gridDim.x, cwg = (int)blockIdx.x;
#ifdef CPU_EMU
#define GRID_BAR()
#else
#define GRID_BAR() xcd_barrier(bar)
#endif
#ifndef REPEAT_MASK
#define REPEAT_MASK 0
#endif
#ifndef TIME_PHASE
#define TIME_PHASE -1
#endif
#if TIME_PHASE >= 0 && !defined(CPU_EMU)
    unsigned long long tp0 = 0, tp1 = 0;
#define TP_BEGIN() do { if (ph == TIME_PHASE) tp0 = __builtin_amdgcn_s_memrealtime(); } while (0)
#define TP_END() do { if (ph == TIME_PHASE) tp1 = __builtin_amdgcn_s_memrealtime(); } while (0)
#else
#define TP_BEGIN()
#define TP_END()
#endif
#define PHASE(...) do { if (lo <= ph && ph < hi) { TP_BEGIN(); __VA_ARGS__; if (ph + 1 < hi) { GRID_BAR(); } TP_END(); } ++ph; } while (0)
#define PHASEG(grp, ...) do { if (lo <= ph && ph < hi) { TP_BEGIN(); if ((REPEAT_MASK >> (grp)) & 1) { __VA_ARGS__; GRID_BAR(); } __VA_ARGS__; if (ph + 1 < hi) { GRID_BAR(); } TP_END(); } ++ph; } while (0)
    PHASE(ph_mod(c, ldsf));
#define LAYER_BODY(l) do { const float* mod = WSF(O_MOD); \
        const float* xin = l == 0 ? c.in[0] : WSF(O_X1); float* xmid = WSF(O_X0); float* xout = WSF(O_X1); \
        const float* ml = mod + (size_t)l * NB * D6; \
        PHASEG(3, ph_convert(c, l, ldsf)); \
        PHASEG(0, { pg8::Gemm g{D, D, D}; pg8::StaticOrder so; so.init(T, PW, G, cwg, WSH(O_H), WSH(O_WIN), D, D); pg8::EpiP E{WSH(O_P), (unsigned char*)(c.ws + O_G8)}; pg8::gemm_phase(lds, g, so, E); \
            { const int nun_ = (T / 256) * (PW / 256), rem_ = nun_ % G; if (rem_ != 0 && cwg >= rem_) { SYNCTHREADS(); convert_big(c, l, ldsf, J_ALL - convert_tail_tiles(), J_ALL, cwg - rem_, G - rem_); } } }); \
        PHASE(ph_lru<1>(c, l, ldsf); ph_ret_kv(c, ldsf); ph_sgu_norm(c, l); ph_rw_shift(c, l)); \
        PHASE(ph_lru_scan2(c); ph_ret_state(c); ph_sgu_mix(c, l, ldsf); ph_rw_lora(c, l, ldsf)); \
        PHASE(ph_lru<2>(c, l, ldsf); ph_ret_out(c, ldsf); ph_rw_chunk(c, l, ldsf)); \
        PHASE(ph_rw_seq(c, ldsf)); \
        PHASE(ph_rw_out(c)); \
        PHASEG(1, { pg8::Gemm g{W, 4 * W, 4 * W}; pg8::MergeOrder mo; mo.so.init(T, D, G, cwg, WSH(O_YS), WSH(O_WBR), 4 * W, 4 * W); mo.kseg_bytes = W * 2; pg8::EpiMerge E{(const unsigned char*)(c.ws + O_G8), WSH(O_MRG)}; pg8::gemm_phase(lds, g, mo, E); }); \
        PHASEG(1, { pg8::Gemm g{D, D, D}; pg8::StaticOrder so; so.init(T, D, G, cwg, WSH(O_MRG), WSH(O_WOUT), D, D); pg8::EpiResid E{xin, ml + 2 * D, xmid}; pg8::gemm_phase(lds, g, so, E); }); \
        PHASEG(6, ph_norm(c, xmid, c.in[4] + (size_t)l * D, ml + 3 * D, ml + 4 * D, WSH(O_H), WSF(O_HF))); \
        PHASE(ph_router(c, l, ldsf)); \
        PHASE(ph_moe_plan(c, l)); \
        PHASE(ph_moe_assign(c, l)); \
        PHASEG(6, ph_moe_gather(c)); \
        const int* plan = CTLW(c) + CW_PLAN + l * 256; \
        PHASEG(2, { pg8::Gemm g{D, D, D}; pg8::MoeOrder mo{G, cwg, 4, plan, (const char*)WSH(O_XS), (const char*)WSH(O_WGU), (size_t)256 * D * 2, (size_t)256 * D * 2, (size_t)1024 * D * 2}; pg8::EpiGU E{WSH(O_ACT)}; pg8::gemm_phase(lds, g, mo, E); \
            if (l == 0) { const int nrest_ = plan[40] * 4 - G; if (nrest_ >= 0 && nrest_ < G && cwg >= nrest_) { SYNCTHREADS(); convert_big(c, 1, ldsf, 0, convert_early_tiles(c), cwg - nrest_, G - nrest_); } } }); \
        PHASEG(2, { pg8::Gemm g{512, 512, 512}; pg8::MoeOrder mo{G, cwg, 8, plan, (const char*)WSH(O_ACT), (const char*)WSH(O_WDN), (size_t)256 * 512 * 2, (size_t)256 * 512 * 2, (size_t)D * 512 * 2}; pg8::EpiBf16 E{WSH(O_YE), D}; pg8::gemm_phase(lds, g, mo, E); }); \
        if (l == 0) PHASE(ph_comb_norm<0>(c, xmid, ml + 5 * D, xout, c.in[3] + (size_t)1 * D, mod + (size_t)1 * NB * D6 + 0 * D, mod + (size_t)1 * NB * D6 + 1 * D, WSH(O_H), nullptr)); \
        else PHASE(ph_comb_norm<1>(c, xmid, ml + 5 * D, xout, c.in[36], nullptr, nullptr, nullptr, c.out)); \
    } while (0)
    PHASE(ph_norm(c, c.in[0], c.in[3], WSF(O_MOD) + 0 * D, WSF(O_MOD) + 1 * D, WSH(O_H), nullptr));
    LAYER_BODY(0);
    LAYER_BODY(1);
#undef LAYER_BODY
#if TIME_PHASE >= 0 && !defined(CPU_EMU)
    if (blockIdx.x == 0) { const unsigned long long te = __builtin_amdgcn_s_memrealtime(), dl = 8ull * (tp1 - tp0); while (__builtin_amdgcn_s_memrealtime() - te < dl) __builtin_amdgcn_s_sleep(8); }
#endif
#undef PHASE
}
}

#ifndef CPU_EMU
extern "C" void kernel_launch(void* const* d_in, const int* in_sizes, int n_in, void* d_out, int out_size, void* d_ws, size_t ws_size, hipStream_t stream) {
    static int grid = 0;
    if (grid == 0) {
        if (n_in != 37 || out_size != T * D || ws_size < WS_END) { fprintf(stderr, "kernel_launch: unexpected shapes (n_in %d out %d ws %zu need %zu)\n", n_in, out_size, ws_size, (size_t)WS_END); grid = -1; return; }
        int dev = 0, cus = 0, per_cu = 0;
        if (hipGetDevice(&dev) != hipSuccess || hipDeviceGetAttribute(&cus, hipDeviceAttributeMultiprocessorCount, dev) != hipSuccess) { grid = -1; return; }
        if (hipFuncSetAttribute((const void*)fwd, hipFuncAttributeMaxDynamicSharedMemorySize, LDS_BYTES) != hipSuccess) { fprintf(stderr, "kernel_launch: hipFuncSetAttribute failed\n"); grid = -1; return; }
        if (hipOccupancyMaxActiveBlocksPerMultiprocessor(&per_cu, (const void*)fwd, NT, LDS_BYTES) != hipSuccess || per_cu < 1) fprintf(stderr, "kernel_launch: occupancy query says %d\n", per_cu);
        (void)hipGetLastError();
        grid = cus;
    }
    if (grid < 0) return;
    (void)in_sizes;
    (void)hipMemsetAsync((char*)d_ws + O_CTL, 0, CTL_BYTES, stream);
    Params p{};
    for (int i = 0; i < 37; ++i) p.in[i] = (const float*)d_in[i];
    p.out = (float*)d_out; p.ws = (unsigned char*)d_ws;
#if ONE_LAUNCH
    p.ph_lo = 0; p.ph_hi = NPH;
    hipLaunchKernelGGL(fwd, dim3(grid), dim3(NT), LDS_BYTES, stream, p);
#else
    for (int k = 0; k < NPH; ++k) { p.ph_lo = k; p.ph_hi = k + 1; hipLaunchKernelGGL(fwd, dim3(grid), dim3(NT), LDS_BYTES, stream, p); }
#endif
}
#endif
```

```cpp
#ifndef CPU_EMU
#include <hip/hip_runtime.h>
#endif
#include <cstdio>
#include <cstdint>
#include <cmath>
#include <cstring>

#ifndef SEQ
#define SEQ 4096
#endif
#ifndef ONE_LAUNCH
#define ONE_LAUNCH 1
#endif

namespace {
constexpr int D = 2048, NB = 2, S = SEQ, T = NB * S, NL = 2, W = 1024;
constexpr int INW = 18816, RF = 3456, D6 = 6 * D;
constexpr int C_LX = 0, C_LG = 1024, C_RQ = 2048, C_RK = 2560, C_RV = 3072, C_RG = 4096, C_SU = 5120, C_SV = 6144, C_RW = 7168;
constexpr int PW = 18944, C_MLP = 10752;
constexpr int NCH = S / 128;
constexpr int NLC = S / 64;
constexpr int NE = 32, CAP = (T * 2 / 256 + NE) * 256, MAXBLK = CAP / 256;
constexpr float EPS = 1e-6f;
constexpr float DECAY_SCALE = 0.60653065971263342f;
constexpr int NT = 512;
constexpr int NPH_LAYER = 17, NPH = 2 + NL * NPH_LAYER;
typedef unsigned short bf16_t;
#ifdef CPU_EMU
typedef float f32x4 __attribute__((vector_size(16)));
typedef unsigned u32x4 __attribute__((vector_size(16)));
#else
typedef float f32x4 __attribute__((ext_vector_type(4)));
typedef unsigned u32x4 __attribute__((ext_vector_type(4)));
typedef short bf16x8 __attribute__((ext_vector_type(8)));
#endif

constexpr size_t al256(size_t x) { return (x + 255) & ~(size_t)255; }
constexpr size_t SZ_X = (size_t)T * D * 4, SZ_W = (size_t)T * W * 4;
constexpr size_t O_CTL = 0, CTL_BYTES = 1u << 20;
constexpr size_t O_MOD = CTL_BYTES;
constexpr size_t O_X0 = O_MOD + al256((size_t)NL * NB * D6 * 4);
constexpr size_t O_X1 = O_X0 + SZ_X;
constexpr size_t O_H = O_X1 + SZ_X;
constexpr size_t O_HF = O_H + SZ_X / 2;
constexpr size_t O_P = O_HF + SZ_X;
constexpr size_t SZ_P = (size_t)T * PW * 2;
constexpr size_t O_XC = O_P + SZ_P;
constexpr size_t O_LA = O_XC + SZ_W, O_LU = O_LA + 2 * SZ_W;
constexpr size_t SZ_LC = (size_t)2 * NB * NLC * W * 4;
constexpr size_t O_LCA = O_LU + 2 * SZ_W, O_LCH = O_LCA + SZ_LC, O_LCI = O_LCH + SZ_LC;
constexpr size_t O_YS = O_LCI + SZ_LC;
constexpr size_t O_SC = O_YS + (size_t)T * 4 * W * 2;
constexpr size_t SZ_KV = (size_t)NB * NCH * 8 * 64 * 128 * 4;
constexpr size_t O_KVF = O_SC, O_KVB = O_KVF + SZ_KV, O_STF = O_KVB + SZ_KV, O_STB = O_STF + SZ_KV;
constexpr size_t O_VN = O_STB + SZ_KV;
constexpr size_t O_FS = O_VN + SZ_W;
constexpr size_t O_DEC = O_FS + al256((size_t)T * RF * 4), O_AA = O_DEC + 2 * SZ_W, O_AKK = O_AA + 2 * SZ_W;
constexpr size_t O_GG = O_AKK, O_YY = O_GG + SZ_W;
constexpr int RCK = 64, NRC = S / RCK;
constexpr size_t O_BON = O_YY + 2 * SZ_W;
constexpr size_t O_PART = O_BON + al256((size_t)2 * T * 16 * 4);
constexpr size_t O_MRG = O_PART + SZ_X;
constexpr size_t O_LOG = O_MRG + SZ_X / 2;
constexpr size_t O_EID = O_LOG + al256((size_t)T * 40 * 4), O_EWT = O_EID + al256((size_t)T * 2 * 4), O_DEST = O_EWT + al256((size_t)T * 2 * 4);
constexpr size_t O_SLOT = O_DEST + al256((size_t)T * 2 * 4);
constexpr size_t O_PST = O_SLOT + al256((size_t)CAP * 4), O_PYT = O_PST + (size_t)64 * NRC * 4096 * 2, O_SVB = O_PYT + (size_t)64 * NRC * 4096 * 2, O_YVB = O_SVB + (size_t)64 * NRC * 4096 * 4;
constexpr size_t O_WIN = O_YVB + (size_t)64 * NRC * 4096 * 4;
constexpr size_t O_WBR = O_WIN + (size_t)PW * D * 2;
constexpr size_t O_WOUT = O_WBR + (size_t)D * 4 * W * 2;
constexpr size_t O_WGU = O_WOUT + (size_t)D * D * 2;
constexpr size_t O_WDN = O_WGU + (size_t)NE * 1024 * D * 2;
constexpr size_t O_G8 = O_WDN + (size_t)NE * D * 512 * 2;
constexpr size_t O_WLR = O_G8 + (size_t)T * 4 * D;
constexpr size_t O_WUT = O_WLR + (size_t)32 * 128 * 128 * 2;
constexpr size_t O_WAT = O_WUT + (size_t)2 * W * 64 * 2;
constexpr size_t O_WGT = O_WAT + (size_t)2 * W * 64 * 2;
constexpr size_t O_WRH = O_WGT + (size_t)W * 128 * 2;
constexpr size_t O_WRL = O_WRH + (size_t)48 * D * 2;
constexpr size_t WS_END0 = O_WRL + (size_t)48 * D * 2;
constexpr size_t SZ_MOE = (size_t)CAP * (D + 512 + D) * 2;
constexpr bool MOE_OVERLAY = SZ_MOE <= SZ_P;
constexpr size_t O_XS = MOE_OVERLAY ? O_P : WS_END0;
constexpr size_t O_ACT = O_XS + (size_t)CAP * D * 2;
constexpr size_t O_YE = O_ACT + (size_t)CAP * 512 * 2;
constexpr size_t WS_END = MOE_OVERLAY ? WS_END0 : WS_END0 + SZ_MOE;
static_assert(SEQ != 4096 || WS_END <= (size_t)2040 * 1024 * 1024, "workspace budget: d_ws is 4 x the largest input = 2048 MiB");
constexpr int CW_BAR = 4096;
constexpr int CW_CNT = 32768;
constexpr int CW_FILL = CW_CNT + NL * 64;
constexpr int CW_PLAN = CW_FILL + NL * 64;
static_assert(MAXBLK <= 160, "plan words");

struct Params { const float* in[37]; float* out; unsigned char* ws; int ph_lo, ph_hi; };

struct Ctx { const float* const* in; float* out; unsigned char* ws; };
#define GT_ ((long)blockIdx.x * NT + threadIdx.x)
#define GS_ ((long)gridDim.x * NT)
#define WSF(off) ((float*)(c.ws + (off)))
#define WSI(off) ((int*)(c.ws + (off)))
#define WSH(off) ((bf16_t*)(c.ws + (off)))
#define CTLW(c) ((int*)((c).ws + O_CTL))

#ifdef CPU_EMU
__device__ __forceinline__ float fexp_(float x) { return expf(x); }
__device__ __forceinline__ float frcp_(float x) { return 1.f / x; }
__device__ __forceinline__ float frsq_(float x) { return 1.f / sqrtf(x); }
#else
__device__ __forceinline__ float fexp_(float x) { return __builtin_amdgcn_exp2f(x * 1.4426950408889634f); }
__device__ __forceinline__ float frcp_(float x) { return __builtin_amdgcn_rcpf(x); }
__device__ __forceinline__ float frsq_(float x) { return __builtin_amdgcn_rsqf(x); }
#endif
__device__ __forceinline__ float sigmoidf_(float x) { return frcp_(1.f + fexp_(-x)); }
__device__ __forceinline__ float siluf_(float x) { return x * frcp_(1.f + fexp_(-x)); }
__device__ __forceinline__ float tanhf_(float x) { return 1.f - 2.f * frcp_(1.f + fexp_(2.f * x)); }
__device__ __forceinline__ float geluf_(float x) { return 0.5f * x * (1.f + tanhf_(0.7978845608028654f * (x + 0.044715f * x * x * x))); }
__device__ __forceinline__ float softplusf_(float x) { return x > 0.f ? x + log1pf(expf(-x)) : log1pf(expf(x)); }
__device__ __forceinline__ float loggamma_(int h) { return log1pf(-exp2f(-5.f - (float)h)); }
__device__ __forceinline__ unsigned f2u_(float f) { unsigned u; memcpy(&u, &f, 4); return u; }
__device__ __forceinline__ float u2f_(unsigned u) { float f; memcpy(&f, &u, 4); return f; }
__device__ __forceinline__ float bf2f(bf16_t v) { return u2f_((unsigned)v << 16); }
__device__ __forceinline__ unsigned f2bf(float f) { const unsigned u = f2u_(f); return (u + 0x7fffu + ((u >> 16) & 1u)) >> 16; }
__device__ __forceinline__ unsigned pk2(float lo, float hi) { return f2bf(lo) | (f2bf(hi) << 16); }
__device__ __forceinline__ float bflo(unsigned w) { return u2f_(w << 16); }
__device__ __forceinline__ float bfhi(unsigned w) { return u2f_(w & 0xffff0000u); }
__device__ __forceinline__ int atomic_add_i(int* p, int v) {
#ifdef CPU_EMU
    return __atomic_fetch_add(p, v, __ATOMIC_RELAXED);
#else
    return atomicAdd(p, v);
#endif
}
#define PF(P, r, col) bf2f((P)[(size_t)(r) * PW + (col)])
#ifdef CPU_EMU
#define SYNCTHREADS() emu_syncthreads()
#define SHFL_XOR(v, m) emu_shfl_xor(v, m)
#else
#define SYNCTHREADS() __syncthreads()
#define SHFL_XOR(v, m) __shfl_xor(v, m)
#endif
#ifdef CPU_EMU
__device__ __forceinline__ float wave_sum(float v) {
    for (int o = 1; o < 64; o <<= 1) v += SHFL_XOR(v, o);
    return v;
}
#else
__device__ __forceinline__ float wave_sum(float x) {
    x += __builtin_bit_cast(float, __builtin_amdgcn_update_dpp(0, __builtin_bit_cast(int, x), 0xB1, 0xF, 0xF, true));
    x += __builtin_bit_cast(float, __builtin_amdgcn_update_dpp(0, __builtin_bit_cast(int, x), 0x4E, 0xF, 0xF, true));
    x += __builtin_bit_cast(float, __builtin_amdgcn_update_dpp(0, __builtin_bit_cast(int, x), 0x141, 0xF, 0xF, true));
    x += __builtin_bit_cast(float, __builtin_amdgcn_update_dpp(0, __builtin_bit_cast(int, x), 0x140, 0xF, 0xF, true));
    const int xi = __builtin_bit_cast(int, x);
    return (__builtin_bit_cast(float, __builtin_amdgcn_readlane(xi, 0)) + __builtin_bit_cast(float, __builtin_amdgcn_readlane(xi, 16))) + (__builtin_bit_cast(float, __builtin_amdgcn_readlane(xi, 32)) + __builtin_bit_cast(float, __builtin_amdgcn_readlane(xi, 48)));
}
#endif
__device__ __forceinline__ f32x4 ld_bf4(const bf16_t* p) { const unsigned long long q = *(const unsigned long long*)p; const unsigned lo = (unsigned)q, hi = (unsigned)(q >> 32); return (f32x4){bflo(lo), bfhi(lo), bflo(hi), bfhi(hi)}; }
__device__ __forceinline__ void st_bf4(bf16_t* p, const f32x4 v) { *(unsigned long long*)p = (unsigned long long)pk2(v[0], v[1]) | ((unsigned long long)pk2(v[2], v[3]) << 32); }

template <int KT, int NTL>
__device__ __forceinline__ void wave_mma(f32x4 (&acc)[NTL], const bf16_t* A, int lda, const bf16_t* Bt, int ldb) {
    const int lane = threadIdx.x & 63, fr = lane & 15, fq = lane >> 4;
#ifdef CPU_EMU
    for (int nt = 0; nt < NTL; ++nt) for (int r = 0; r < 4; ++r) { float sacc = 0.f; const bf16_t* a = A + fr * lda; const bf16_t* b = Bt + (16 * nt + 4 * fq + r) * ldb;
        for (int k = 0; k < 32 * KT; ++k) sacc += bf2f(a[k]) * bf2f(b[k]);
        acc[nt][r] += sacc; }
#else
#pragma unroll
    for (int kt = 0; kt < KT; ++kt) {
        const bf16x8 af = *(const bf16x8*)(A + fr * lda + kt * 32 + fq * 8);
#pragma unroll
        for (int nt = 0; nt < NTL; ++nt) { const bf16x8 bfr = *(const bf16x8*)(Bt + (16 * nt + fr) * ldb + kt * 32 + fq * 8);
            acc[nt] = __builtin_amdgcn_mfma_f32_16x16x32_bf16(bfr, af, acc[nt], 0, 0, 0); }
    }
#endif
}
__device__ __forceinline__ void ph_mod(const Ctx& c, float* ldsf) {
    const float* cc = c.in[1]; const float* aw = c.in[5]; const float* ab = c.in[6]; float* mod = WSF(O_MOD);
    float* scs = ldsf; float* part = ldsf + NB * D; const int tid = threadIdx.x, c4 = (tid & 31) * 4, kq = tid >> 5;
    for (int i = tid; i < NB * D; i += NT) scs[i] = siluf_(cc[i]);
    SYNCTHREADS();
    for (int u = blockIdx.x; u < NL * (D6 / 128); u += gridDim.x) {
        const int l = u / (D6 / 128), j0 = (u % (D6 / 128)) * 128;
        const float* w = aw + (size_t)l * D * D6 + j0 + c4; f32x4 a0 = (f32x4){0.f, 0.f, 0.f, 0.f}, a1 = a0;
#pragma unroll 8
        for (int k = kq * 128; k < kq * 128 + 128; ++k) { const f32x4 wv = *(const f32x4*)(w + (size_t)k * D6); a0 += wv * scs[k]; a1 += wv * scs[D + k]; }
        *(f32x4*)(part + (kq * 2 + 0) * 128 + c4) = a0; *(f32x4*)(part + (kq * 2 + 1) * 128 + c4) = a1;
        SYNCTHREADS();
        if (tid < 256) { const int b = tid >> 7, col = tid & 127; float sacc = 0.f;
#pragma unroll
            for (int q = 0; q < 16; ++q) sacc += part[(q * 2 + b) * 128 + col];
            mod[((size_t)l * NB + b) * D6 + j0 + col] = sacc + ab[l * D6 + j0 + col]; }
        SYNCTHREADS();
    }
}
__device__ __forceinline__ void ph_norm(const Ctx& c, const float* x, const float* g, const float* sh, const float* sc, bf16_t* hb, float* hf) {
    const int lane = threadIdx.x & 63, gw = blockIdx.x * (NT / 64) + (threadIdx.x >> 6), ngw = gridDim.x * (NT / 64);
    for (int t0 = gw * 2; t0 < T; t0 += ngw * 2) {
        f32x4 v[2][8]; float ss[2] = {0.f, 0.f};
#pragma unroll
        for (int r = 0; r < 2; ++r)
#pragma unroll
            for (int j = 0; j < 8; ++j) v[r][j] = *(const f32x4*)(x + (size_t)(t0 + r) * D + (j * 64 + lane) * 4);
#pragma unroll
        for (int r = 0; r < 2; ++r) {
#pragma unroll
            for (int j = 0; j < 8; ++j) ss[r] += (v[r][j][0] * v[r][j][0] + v[r][j][1] * v[r][j][1]) + (v[r][j][2] * v[r][j][2] + v[r][j][3] * v[r][j][3]);
            const int t = t0 + r, b = t / S; const float rs = 1.f / sqrtf(wave_sum(ss[r]) * (1.f / D) + EPS);
#pragma unroll
            for (int j = 0; j < 8; ++j) { const int col = (j * 64 + lane) * 4;
                const f32x4 o = v[r][j] * rs * *(const f32x4*)(g + col) * (*(const f32x4*)(sc + b * D6 + col) + 1.f) + *(const f32x4*)(sh + b * D6 + col);
                st_bf4(hb + (size_t)t * D + col, o); }
            if (hf && lane == 0) hf[t] = rs;
        }
    }
}
template <int MODE>
__device__ __forceinline__ void ph_comb_norm(const Ctx& c, const float* xmid, const float* g2, float* xout, const float* g, const float* sh, const float* sc, bf16_t* hb, float* outp) {
    const bf16_t* YE = WSH(O_YE); const float* EWT = WSF(O_EWT); const int* DEST = WSI(O_DEST);
    const int lane = threadIdx.x & 63, gw = blockIdx.x * (NT / 64) + (threadIdx.x >> 6), ngw = gridDim.x * (NT / 64);
    for (int t = gw; t < T; t += ngw) {
        const int b = t / S; const float w0 = EWT[t * 2], w1 = EWT[t * 2 + 1]; const bf16_t* y0 = YE + (size_t)DEST[t * 2] * D; const bf16_t* y1 = YE + (size_t)DEST[t * 2 + 1] * D;
        f32x4 v[8]; float ss = 0.f;
#pragma unroll
        for (int j = 0; j < 8; ++j) { const int col = (j * 64 + lane) * 4;
            v[j] = *(const f32x4*)(xmid + (size_t)t * D + col) + *(const f32x4*)(g2 + b * D6 + col) * (ld_bf4(y0 + col) * w0 + ld_bf4(y1 + col) * w1);
            if (MODE == 0) *(f32x4*)(xout + (size_t)t * D + col) = v[j];
            ss += (v[j][0] * v[j][0] + v[j][1] * v[j][1]) + (v[j][2] * v[j][2] + v[j][3] * v[j][3]); }
        const float rs = 1.f / sqrtf(wave_sum(ss) * (1.f / D) + EPS);
#pragma unroll
        for (int j = 0; j < 8; ++j) { const int col = (j * 64 + lane) * 4;
            if (MODE == 0) st_bf4(hb + (size_t)t * D + col, v[j] * rs * *(const f32x4*)(g + col) * (*(const f32x4*)(sc + b * D6 + col) + 1.f) + *(const f32x4*)(sh + b * D6 + col));
            else *(f32x4*)(outp + (size_t)t * D + col) = v[j] * rs * *(const f32x4*)(g + col); }
    }
}

struct CvtItem { const float* Wp; int ldw; bf16_t* WT; int ldt; int drow, k0, n0; };
constexpr int I_IN = 32 * (INW / 32), I_BR = 4 * 16 * 64, I_OUT = 32 * 64, I_GU = NE * 32 * 32, I_DN = NE * 8 * 64, I_LR = 32 * 8, I_WU = 2 * 32, I_WG = 64, I_BIG = I_IN + I_BR + I_OUT + I_GU + I_DN, I_ALL = I_BIG + I_LR + 2 * I_WU + I_WG;
__device__ __forceinline__ CvtItem cvt_decode(const Ctx& c, int l, int it) {
    CvtItem r;
    if (it < I_IN) { const int kb = it / (INW / 32), nb = it % (INW / 32); r.n0 = nb * 32; r.k0 = kb * 64; r.Wp = c.in[7] + (size_t)l * D * INW; r.ldw = INW; r.WT = WSH(O_WIN); r.ldt = D; r.drow = r.n0 < 10624 ? r.n0 : r.n0 + 128; return r; }
    it -= I_IN;
    if (it < I_BR) { const int sgm = it / 1024, q = it % 1024, kb = q / 64, nb = q % 64; r.n0 = nb * 32; r.k0 = kb * 64; r.Wp = c.in[28] + ((size_t)l * 4 + sgm) * W * D; r.ldw = D; r.WT = WSH(O_WBR) + sgm * W; r.ldt = 4 * W; r.drow = r.n0; return r; }
    it -= I_BR;
    if (it < I_OUT) { const int kb = it / 64, nb = it % 64; r.n0 = nb * 32; r.k0 = kb * 64; r.Wp = c.in[29] + (size_t)l * D * D; r.ldw = D; r.WT = WSH(O_WOUT); r.ldt = D; r.drow = r.n0; return r; }
    it -= I_OUT;
    if (it < I_GU) { const int e = it / 1024, q = it % 1024, kb = q / 32, nb = q % 32; r.n0 = nb * 32; r.k0 = kb * 64; r.Wp = c.in[34] + ((size_t)l * NE + e) * D * 1024; r.ldw = 1024; r.WT = WSH(O_WGU) + (size_t)e * 1024 * D; r.ldt = D;
        r.drow = r.n0 < 512 ? (r.n0 / 128) * 256 + (r.n0 % 128) : ((r.n0 - 512) / 128) * 256 + 128 + ((r.n0 - 512) % 128); return r; }
    it -= I_GU;
    if (it < I_DN) { const int e = it / 512, q = it % 512, kb = q / 64, nb = q % 64; r.n0 = nb * 32; r.k0 = kb * 64; r.Wp = c.in[35] + ((size_t)l * NE + e) * 512 * D; r.ldw = D; r.WT = WSH(O_WDN) + (size_t)e * D * 512; r.ldt = 512; r.drow = r.n0; return r; }
    it -= I_DN;
    if (it < I_LR) { const int m = it / 8, q = it % 8, kb = q / 4, nb = q % 4, z = m >> 4, ty = (m >> 3) & 1, n = m & 7; r.n0 = nb * 32; r.k0 = kb * 64; r.Wp = c.in[ty ? 12 : 10] + (((size_t)l * 2 + z) * 8 + n) * 128 * 128; r.ldw = 128;
        r.WT = WSH(O_WLR) + (size_t)m * 128 * 128; r.ldt = 128; r.drow = r.n0; return r; }
    it -= I_LR;
    if (it < 2 * I_WU) { const int ua = it / I_WU, q = it % I_WU, z = q / 32, nb = q % 32; r.n0 = nb * 32; r.k0 = 0; r.Wp = c.in[ua ? 23 : 21] + ((size_t)l * 2 + z) * 64 * W; r.ldw = W; r.WT = WSH(ua ? O_WAT : O_WUT) + (size_t)z * W * 64; r.ldt = 64; r.drow = r.n0; return r; }
    it -= 2 * I_WU;
    { const int kb = it / 32, nb = it % 32; r.n0 = nb * 32; r.k0 = kb * 64; r.Wp = c.in[24] + (size_t)l * 128 * W; r.ldw = W; r.WT = WSH(O_WGT); r.ldt = 128; r.drow = r.n0; return r; }
}
constexpr int J_IN = 16 * (INW / 128), J_BR = 4 * 8 * 16, J_OUT = 16 * 16, J_GU = NE * 16 * 8, J_DN = NE * 4 * 16, J_ALL = J_IN + J_BR + J_OUT + J_GU + J_DN;
__device__ __forceinline__ CvtItem cvt_decode_big(const Ctx& c, int l, int it) {
    CvtItem r;
    if (it < J_IN) { const int kb = it / (INW / 128), nb = it % (INW / 128); r.n0 = nb * 128; r.k0 = kb * 128; r.Wp = c.in[7] + (size_t)l * D * INW; r.ldw = INW; r.WT = WSH(O_WIN); r.ldt = D; r.drow = r.n0 < 10624 ? r.n0 : r.n0 + 128; return r; }
    it -= J_IN;
    if (it < J_BR) { const int sgm = it / 128, q = it % 128, kb = q / 16, nb = q % 16; r.n0 = nb * 128; r.k0 = kb * 128; r.Wp = c.in[28] + ((size_t)l * 4 + sgm) * W * D; r.ldw = D; r.WT = WSH(O_WBR) + sgm * W; r.ldt = 4 * W; r.drow = r.n0; return r; }
    it -= J_BR;
    if (it < J_OUT) { const int kb = it / 16, nb = it % 16; r.n0 = nb * 128; r.k0 = kb * 128; r.Wp = c.in[29] + (size_t)l * D * D; r.ldw = D; r.WT = WSH(O_WOUT); r.ldt = D; r.drow = r.n0; return r; }
    it -= J_OUT;
    if (it < J_GU) { const int e = it / 128, q = it % 128, kb = q / 8, nb = q % 8; r.n0 = nb * 128; r.k0 = kb * 128; r.Wp = c.in[34] + ((size_t)l * NE + e) * D * 1024; r.ldw = 1024; r.WT = WSH(O_WGU) + (size_t)e * 1024 * D; r.ldt = D;
        r.drow = r.n0 < 512 ? (r.n0 / 128) * 256 : ((r.n0 - 512) / 128) * 256 + 128; return r; }
    it -= J_GU;
    { const int e = it / 64, q = it % 64, kb = q / 16, nb = q % 16; r.n0 = nb * 128; r.k0 = kb * 128; r.Wp = c.in[35] + ((size_t)l * NE + e) * 512 * D; r.ldw = D; r.WT = WSH(O_WDN) + (size_t)e * D * 512; r.ldt = 512; r.drow = r.n0; return r; }
}
__device__ __forceinline__ void convert_big(const Ctx& c, int l, float* ldsf, int first, int last, int widx, int wcnt) {
    const int tid = threadIdx.x, lr = tid >> 5, lc = (tid & 31) * 4;
    f32x4 rg[8]; int it = first + widx; CvtItem r;
    if (it < last) { r = cvt_decode_big(c, l, it);
#pragma unroll
        for (int i = 0; i < 8; ++i) rg[i] = *(const f32x4*)(r.Wp + (size_t)(r.k0 + lr + 16 * i) * r.ldw + r.n0 + lc); }
    for (; it < last; it += wcnt) {
#pragma unroll
        for (int i = 0; i < 8; ++i) { float* dp = ldsf + (lr + 16 * i) * 129 + lc; dp[0] = rg[i][0]; dp[1] = rg[i][1]; dp[2] = rg[i][2]; dp[3] = rg[i][3]; }
        const CvtItem cur = r; const int nx = it + wcnt;
        if (nx < last) { r = cvt_decode_big(c, l, nx);
#pragma unroll
            for (int i = 0; i < 8; ++i) rg[i] = *(const f32x4*)(r.Wp + (size_t)(r.k0 + lr + 16 * i) * r.ldw + r.n0 + lc); }
        SYNCTHREADS();
#pragma unroll
        for (int q = 0; q < 4; ++q) { const int id = tid + NT * q, n = id >> 4, k8 = (id & 15) * 8; const float* sp = ldsf + k8 * 129 + n;
            u32x4 o; o[0] = pk2(sp[0 * 129], sp[1 * 129]); o[1] = pk2(sp[2 * 129], sp[3 * 129]); o[2] = pk2(sp[4 * 129], sp[5 * 129]); o[3] = pk2(sp[6 * 129], sp[7 * 129]);
            *(u32x4*)(cur.WT + (size_t)(cur.drow + n) * cur.ldt + cur.k0 + k8) = o; }
        SYNCTHREADS();
    }
}
__device__ __forceinline__ int convert_tail_tiles() { const int nun = (T / 256) * (PW / 256), G = (int)gridDim.x, rem = nun % G; return rem == 0 ? 0 : (G - rem) * 10 < J_GU + J_DN ? (G - rem) * 10 : J_GU + J_DN; }
__device__ __forceinline__ int convert_early_tiles(const Ctx& c) { const int G = (int)gridDim.x, nrest = (CTLW(c) + CW_PLAN)[40] * 4 - G; return (nrest >= 0 && nrest < G) ? ((G - nrest) * 12 < J_IN ? (G - nrest) * 12 : J_IN) : 0; }
__device__ __forceinline__ void ph_convert(const Ctx& c, int l, float* ldsf) {
    const int lane = threadIdx.x & 63, wave = threadIdx.x >> 6; const int gw = blockIdx.x * (NT / 64) + wave, ngw = gridDim.x * (NT / 64);
    convert_big(c, l, ldsf, l == 1 ? convert_early_tiles(c) : 0, J_ALL - convert_tail_tiles(), (int)blockIdx.x, (int)gridDim.x);
#ifdef CPU_EMU
    if (lane == 0) for (int it = I_BIG + gw; it < I_ALL; it += ngw) { const CvtItem r = cvt_decode(c, l, it);
        for (int kk = 0; kk < 64; ++kk) for (int nn = 0; nn < 32; ++nn) r.WT[(size_t)(r.drow + nn) * r.ldt + r.k0 + kk] = (bf16_t)f2bf(r.Wp[(size_t)(r.k0 + kk) * r.ldw + r.n0 + nn]); }
#else
    float* scr = ldsf + wave * (64 * 33 + 16);
    for (int it = I_BIG + gw; it < I_ALL; it += ngw) {
        const CvtItem r = cvt_decode(c, l, it);
#pragma unroll 8
        for (int i = 0; i < 32; ++i) { const int kk = 2 * i + (lane >> 5); scr[kk * 33 + (lane & 31)] = r.Wp[(size_t)(r.k0 + kk) * r.ldw + r.n0 + (lane & 31)]; }
        asm volatile("s_waitcnt lgkmcnt(0)" ::: "memory");
        const int cc = lane & 7;
#pragma unroll
        for (int j = 0; j < 4; ++j) { const int n = (lane >> 3) + 8 * j; const float* sp = scr + (8 * cc) * 33 + n;
            u32x4 o; o[0] = pk2(sp[0 * 33], sp[1 * 33]); o[1] = pk2(sp[2 * 33], sp[3 * 33]); o[2] = pk2(sp[4 * 33], sp[5 * 33]); o[3] = pk2(sp[6 * 33], sp[7 * 33]);
            *(u32x4*)(r.WT + (size_t)(r.drow + n) * r.ldt + r.k0 + 8 * cc) = o; }
        asm volatile("s_waitcnt lgkmcnt(0)" ::: "memory");
    }
#endif
    { const float* wg = c.in[30] + (size_t)l * D * 4; const float* we = c.in[32] + (size_t)l * D * 32; bf16_t* wh = WSH(O_WRH); bf16_t* wl = WSH(O_WRL);
      for (long i = GT_; i < (long)48 * D; i += GS_) { const int n = (int)(i / D), k = (int)(i % D); const float w = n < 4 ? wg[k * 4 + n] : n < 36 ? we[k * 32 + (n - 4)] : 0.f; const unsigned hb = f2bf(w); wh[i] = (bf16_t)hb; wl[i] = (bf16_t)f2bf(w - bf2f((bf16_t)hb)); } }
    for (long i = GT_; i < (long)128 * D / 2; i += GS_) ((unsigned*)(WSH(O_WIN) + (size_t)10624 * D))[i] = 0u;
}

namespace pg8 {
constexpr int BM = 256, BK = 64, HALF = 128, HTB = HALF * BK * 2, STAGE_BYTES = 8 * HTB;
__host__ __device__ __forceinline__ int lds_byte(int r, int cc) { const int st = (r >> 4) * 2 + (cc >> 5), rr = r & 15, c2 = cc & 31, ob = rr * 64 + c2 * 2; return st * 1024 + (ob ^ (((ob >> 9) & 1) << 5)); }
__host__ __device__ __forceinline__ void stage_rc(int b, int& R, int& C) { const int st = b / 1024, sb = b % 1024, swz = sb ^ (((sb >> 9) & 1) << 5); R = (st >> 1) * 16 + swz / 64; C = (st & 1) * 32 + (swz % 64) / 2; }
__host__ __device__ __forceinline__ int perm32(int rho) { const int n = rho >> 4, i = rho & 15; return 8 * (i >> 2) + 4 * n + (i & 3); }
struct Unit { int pm, pn, aux; const char* A; const char* B; };
struct Gemm { int K, lda, ldb; };

template <class Epi, class Sched>
__device__ __forceinline__ void gemm_phase(unsigned char* lds_, const Gemm g, const Sched& S, const Epi& E) {
#ifdef CPU_EMU
    if (threadIdx.x != 0) return;
    Unit u; const int K = g.K;
    float* Af = (float*)malloc((size_t)256 * K * 4); float* Bf = (float*)malloc((size_t)256 * K * 4); float* Cf = (float*)malloc(256 * 256 * 4);
    for (int i = 0; S.next(i, u); ++i) {
        const bf16_t* A = (const bf16_t*)u.A; const bf16_t* B = (const bf16_t*)u.B;
        for (int r = 0; r < 256; ++r) for (int k = 0; k < K; ++k) { Af[(size_t)r * K + k] = bf2f(A[(size_t)r * g.lda + k]); Bf[(size_t)r * K + k] = bf2f(B[(size_t)r * g.ldb + k]); }
        for (int r = 0; r < 256; ++r) for (int cc = 0; cc < 256; ++cc) { const float* a = Af + (size_t)r * K; const float* b = Bf + (size_t)cc * K; float sacc = 0.f; for (int k = 0; k < K; ++k) sacc += a[k] * b[k]; Cf[r * 256 + cc] = sacc; }
        for (int wid = 0; wid < 8; ++wid) for (int lane = 0; lane < 64; ++lane) {
            const int wr = wid >> 2, wc = wid & 3, fr = lane & 15, fq = lane >> 4; f32x4 acc[2][2][4][2];
            for (int ai = 0; ai < 2; ++ai) for (int bj = 0; bj < 2; ++bj) for (int m = 0; m < 4; ++m) for (int n = 0; n < 2; ++n) for (int j = 0; j < 4; ++j) {
                const int r = 128 * ai + 64 * wr + 16 * m + fr, cc = 128 * bj + 32 * wc + (Epi::PERM ? 8 * fq + 4 * n + j : 16 * n + 4 * fq + j); acc[ai][bj][m][n][j] = Cf[r * 256 + cc]; }
            E(acc, u, wr, wc, fr, fq);
        }
    }
    free(Af); free(Bf); free(Cf);
#else
    typedef __attribute__((address_space(3))) unsigned char* ldsp_t;
    ldsp_t lds = (ldsp_t)lds_;
    const int tid = threadIdx.x, wid = __builtin_amdgcn_readfirstlane(tid >> 6), lane = tid & 63, wr = wid >> 2, wc = wid & 3, fr = lane & 15, fq = lane >> 4;
    const int K = g.K, nt = K / BK;
    unsigned voffA[2], voffB[2];
#pragma unroll
    for (int i = 0; i < 2; ++i) { int R, C; stage_rc(tid * 16 + i * 8192, R, C); const int Rb = Epi::PERM ? ((R & ~31) + perm32(R & 31)) : R;
        voffA[i] = (unsigned)(R * g.lda + C) * 2u; voffB[i] = (unsigned)(Rb * g.ldb + C) * 2u; }
    const size_t kstep = (size_t)(BK * 2);
    const size_t hstepA = (size_t)HALF * g.lda * 2, hstepB = (size_t)HALF * g.ldb * 2;
    const unsigned ldsw = (unsigned)wid * 1024u;
    const int aoff = lds_byte(wr * 64 + fr, fq * 8), boff = lds_byte(wc * 32 + fr, fq * 8);
#define PG8_SA(b, h) (((b) * 2 + (h)) * HTB)
#define PG8_SB(b, h) ((4 + (b) * 2 + (h)) * HTB)
#define PG8_STAGE(bufoff, gbase, voff) do { _Pragma("unroll") for (int _i = 0; _i < 2; ++_i) \
        __builtin_amdgcn_global_load_lds((const unsigned*)((const char*)(gbase) + (voff)[_i]), (__attribute__((address_space(3))) unsigned*)(lds + (bufoff) + ldsw + _i * 8192), 16, 0, 0); } while (0)
#define PG8_LDA(dst, b, h) do { _Pragma("unroll") for (int m = 0; m < 4; ++m) _Pragma("unroll") for (int k = 0; k < 2; ++k) dst[m][k] = *(const __attribute__((address_space(3))) bf16x8*)(lds + PG8_SA(b, h) + aoff + m * 2048 + k * 1024); } while (0)
#define PG8_LDB(dst, b, h) do { _Pragma("unroll") for (int n = 0; n < 2; ++n) _Pragma("unroll") for (int k = 0; k < 2; ++k) dst[n][k] = *(const __attribute__((address_space(3))) bf16x8*)(lds + PG8_SB(b, h) + boff + n * 2048 + k * 1024); } while (0)
#define PG8_MMA(ai, bj, At, Bt) do { __builtin_amdgcn_s_setprio(1); _Pragma("unroll") for (int m = 0; m < 4; ++m) _Pragma("unroll") for (int n = 0; n < 2; ++n) _Pragma("unroll") for (int k = 0; k < 2; ++k) \
        acc[ai][bj][m][n] = __builtin_amdgcn_mfma_f32_16x16x32_bf16(Bt[n][k], At[m][k], acc[ai][bj][m][n], 0, 0, 0); __builtin_amdgcn_s_setprio(0); } while (0)
#define PG8_WAIT_V(n) asm volatile("s_waitcnt vmcnt(" #n ")" ::: "memory")
#define PG8_WAIT_L(n) asm volatile("s_waitcnt lgkmcnt(" #n ")" ::: "memory")
#define PG8_BAR __builtin_amdgcn_s_barrier()
#define PG8_SCHED __builtin_amdgcn_sched_barrier(0)
    Unit cur, nxt; int ui = 0;
    if (!S.next(0, cur)) return;
    f32x4 acc[2][2][4][2];
#pragma unroll
    for (int a = 0; a < 2; ++a)
#pragma unroll
        for (int b = 0; b < 2; ++b)
#pragma unroll
            for (int m = 0; m < 4; ++m)
#pragma unroll
                for (int n = 0; n < 2; ++n) acc[a][b][m][n] = (f32x4){0.f, 0.f, 0.f, 0.f};
    bf16x8 At[4][2], B0[2][2], B1[2][2];
    const char* cA = cur.A; const char* cB = cur.B;
    S.a_ready(cur);
    PG8_STAGE(PG8_SB(0, 0), cB, voffB); PG8_STAGE(PG8_SA(0, 0), cA, voffA); PG8_STAGE(PG8_SB(0, 1), cB + hstepB, voffB); PG8_STAGE(PG8_SA(0, 1), cA + hstepA, voffA);
    if (wr == 1) PG8_BAR;
    PG8_WAIT_V(4); PG8_BAR;
    PG8_STAGE(PG8_SB(1, 0), cB + kstep, voffB); PG8_STAGE(PG8_SA(1, 0), cA + kstep, voffA); PG8_STAGE(PG8_SB(1, 1), cB + hstepB + kstep, voffB);
    PG8_WAIT_V(6); PG8_BAR;
    for (;;) {
        const bool has_next = S.next(ui + 1, nxt);
        const char* nA = has_next ? nxt.A : cA; const char* nB = has_next ? nxt.B : cB;
        for (int t = 0; t < nt; t += 2) {
            const bool last = (t == nt - 2);
            const char* a1 = cA + (size_t)(t + 1) * kstep;
            const char* a2 = last ? nA : cA + (size_t)(t + 2) * kstep; const char* b2 = last ? nB : cB + (size_t)(t + 2) * kstep;
            const char* a3 = a2 + kstep; const char* b3 = b2 + kstep;
            if (last && has_next) S.a_ready(nxt);
            PG8_LDB(B0, 0, 0); PG8_SCHED; PG8_LDA(At, 0, 0); PG8_STAGE(PG8_SA(1, 1), a1 + hstepA, voffA);
            PG8_WAIT_L(8); PG8_BAR; PG8_WAIT_L(0); PG8_MMA(0, 0, At, B0); PG8_BAR; PG8_SCHED;
            PG8_LDB(B1, 0, 1); PG8_STAGE(PG8_SB(0, 0), b2, voffB);
            PG8_BAR; PG8_WAIT_L(0); PG8_MMA(0, 1, At, B1); PG8_BAR;
            PG8_LDA(At, 0, 1); PG8_STAGE(PG8_SA(0, 0), a2, voffA);
            PG8_BAR; PG8_WAIT_L(0); PG8_MMA(1, 0, At, B0); PG8_BAR; PG8_SCHED;
            PG8_STAGE(PG8_SB(0, 1), b2 + hstepB, voffB);
            PG8_WAIT_V(6); PG8_BAR; PG8_MMA(1, 1, At, B1); PG8_BAR;
            PG8_LDB(B0, 1, 0); PG8_SCHED; PG8_LDA(At, 1, 0); PG8_STAGE(PG8_SA(0, 1), a2 + hstepA, voffA);
            PG8_WAIT_L(8); PG8_BAR; PG8_WAIT_L(0); PG8_MMA(0, 0, At, B0); PG8_BAR; PG8_SCHED;
            PG8_LDB(B1, 1, 1); PG8_STAGE(PG8_SB(1, 0), b3, voffB);
            PG8_BAR; PG8_WAIT_L(0); PG8_MMA(0, 1, At, B1); PG8_BAR;
            PG8_LDA(At, 1, 1); PG8_STAGE(PG8_SA(1, 0), a3, voffA);
            PG8_BAR; PG8_WAIT_L(0); PG8_MMA(1, 0, At, B0); PG8_BAR; PG8_SCHED;
            PG8_STAGE(PG8_SB(1, 1), b3 + hstepB, voffB);
            PG8_WAIT_V(6); PG8_BAR; PG8_MMA(1, 1, At, B1); PG8_BAR;
        }
        E(acc, cur, wr, wc, fr, fq); S.done(cur);
        if (!has_next) break;
#pragma unroll
        for (int a = 0; a < 2; ++a)
#pragma unroll
            for (int b = 0; b < 2; ++b)
#pragma unroll
                for (int m = 0; m < 4; ++m)
#pragma unroll
                    for (int n = 0; n < 2; ++n) acc[a][b][m][n] = (f32x4){0.f, 0.f, 0.f, 0.f};
        cur = nxt; cA = nA; cB = nB; ++ui;
    }
    PG8_WAIT_V(0);
    if (wr == 0) PG8_BAR;
    PG8_BAR;
#undef PG8_SA
#undef PG8_SB
#undef PG8_STAGE
#undef PG8_LDA
#undef PG8_LDB
#undef PG8_MMA
#undef PG8_WAIT_V
#undef PG8_WAIT_L
#undef PG8_BAR
#undef PG8_SCHED
#endif
}

struct StaticOrder {
    int nM, nN, nwg, G, c; const char* A; const char* B; size_t tstepA, tstepB;
    __device__ __forceinline__ void init(int M, int N, int G_, int c_, const void* A_, const void* B_, int lda, int ldb) { nM = M / BM; nN = N / BM; nwg = nM * nN; G = G_; c = c_; A = (const char*)A_; B = (const char*)B_; tstepA = (size_t)BM * lda * 2; tstepB = (size_t)BM * ldb * 2; }
    __device__ __forceinline__ bool next(int i, Unit& u) const {
        const long L = (long)i * G + c; if (L >= nwg) return false;
        int wgid = (int)L; { const int q = nwg / 8, r = nwg % 8, xcd = wgid % 8, off = wgid / 8; wgid = (xcd < r ? xcd * (q + 1) : r * (q + 1) + (xcd - r) * q) + off; }
        const int nig = 8 * nN, gid = wgid / nig, fm = gid * 8, gsz = (nM - fm) < 8 ? (nM - fm) : 8;
        u.pm = fm + ((wgid % nig) % gsz); u.pn = (wgid % nig) / gsz; u.aux = 0; u.A = A + (size_t)u.pm * tstepA; u.B = B + (size_t)u.pn * tstepB; return true;
    }
    __device__ __forceinline__ void a_ready(const Unit&) const {}
    __device__ __forceinline__ void done(const Unit&) const {}
};
struct MergeOrder {
    StaticOrder so; int kseg_bytes;
    __device__ __forceinline__ bool next(int i, Unit& u) const { if (!so.next(i >> 2, u)) return false; u.aux = i & 3; u.A += (size_t)u.aux * kseg_bytes; u.B += (size_t)u.aux * kseg_bytes; return true; }
    __device__ __forceinline__ void a_ready(const Unit&) const {}
    __device__ __forceinline__ void done(const Unit&) const {}
};
struct MoeOrder {
    int G, c, ncol; const int* plan; const char* A; const char* B; size_t tstepA, tstepB, estep;
    __device__ __forceinline__ bool next(int i, Unit& u) const {
        const long L = (long)i * G + c; const int nblk = plan[40]; if (L >= (long)nblk * ncol) return false;
        u.pm = (int)(L / ncol); u.pn = (int)(L % ncol); u.aux = plan[64 + u.pm]; u.A = A + (size_t)u.pm * tstepA; u.B = B + (size_t)u.aux * estep + (size_t)u.pn * tstepB; return true;
    }
    __device__ __forceinline__ void a_ready(const Unit&) const {}
    __device__ __forceinline__ void done(const Unit&) const {}
};

__device__ __forceinline__ u32x4 pack8(const f32x4 v0, const f32x4 v1) { u32x4 w; w[0] = pk2(v0[0], v0[1]); w[1] = pk2(v0[2], v0[3]); w[2] = pk2(v1[0], v1[1]); w[3] = pk2(v1[2], v1[3]); return w; }
struct EpiBf16 {
    static constexpr bool PERM = true; bf16_t* O; int ldc;
    __device__ __forceinline__ void operator()(const f32x4 (&acc)[2][2][4][2], const Unit& u, int wr, int wc, int fr, int fq) const {
        const int row0 = u.pm * BM + wr * 64 + fr, col0 = u.pn * BM + wc * 32 + 8 * fq;
#pragma unroll
        for (int ai = 0; ai < 2; ++ai)
#pragma unroll
            for (int m = 0; m < 4; ++m) { bf16_t* rowp = O + (size_t)(row0 + ai * HALF + m * 16) * ldc + col0;
#pragma unroll
                for (int bj = 0; bj < 2; ++bj) *(u32x4*)(rowp + bj * HALF) = pack8(acc[ai][bj][m][0], acc[ai][bj][m][1]); }
    }
};
struct EpiP {
    static constexpr bool PERM = true; bf16_t* O; unsigned char* G8;
    __device__ __forceinline__ void operator()(const f32x4 (&acc)[2][2][4][2], const Unit& u, int wr, int wc, int fr, int fq) const {
        const int row0 = u.pm * BM + wr * 64 + fr, col0 = u.pn * BM + wc * 32 + 8 * fq;
        if (u.pn * BM < C_MLP) {
#pragma unroll
            for (int ai = 0; ai < 2; ++ai)
#pragma unroll
                for (int m = 0; m < 4; ++m) { bf16_t* rowp = O + (size_t)(row0 + ai * HALF + m * 16) * PW + col0;
#pragma unroll
                    for (int bj = 0; bj < 2; ++bj) *(u32x4*)(rowp + bj * HALF) = pack8(acc[ai][bj][m][0], acc[ai][bj][m][1]); }
        } else {
#pragma unroll
            for (int ai = 0; ai < 2; ++ai)
#pragma unroll
                for (int m = 0; m < 4; ++m) { unsigned char* rowp = G8 + (size_t)(row0 + ai * HALF + m * 16) * (4 * D) + (col0 - C_MLP);
#pragma unroll
                    for (int bj = 0; bj < 2; ++bj) { unsigned long long w = 0ull;
#pragma unroll
                        for (int q = 0; q < 8; ++q) { const float gq = sigmoidf_(acc[ai][bj][m][q >> 2][q & 3]); w |= (unsigned long long)(unsigned)(gq * 255.f + 0.5f) << (8 * q); }
                        *(unsigned long long*)(rowp + bj * HALF) = w; } }
        }
    }
};
struct EpiMerge {
    static constexpr bool PERM = true; const unsigned char* G8; bf16_t* MRG;
    __device__ __forceinline__ void operator()(const f32x4 (&acc)[2][2][4][2], const Unit& u, int wr, int wc, int fr, int fq) const {
        const int row0 = u.pm * BM + wr * 64 + fr, col0 = u.pn * BM + wc * 32 + 8 * fq, seg = u.aux;
#pragma unroll
        for (int ai = 0; ai < 2; ++ai)
#pragma unroll
            for (int m = 0; m < 4; ++m) { const size_t r = (size_t)(row0 + ai * HALF + m * 16);
#pragma unroll
                for (int bj = 0; bj < 2; ++bj) { const int cc = col0 + bj * HALF;
                    const unsigned long long gw = *(const unsigned long long*)(G8 + r * (4 * D) + seg * D + cc);
                    f32x4 v0, v1;
#pragma unroll
                    for (int q = 0; q < 4; ++q) { v0[q] = (float)((unsigned)(gw >> (8 * q)) & 255u) * (1.f / 255.f) * acc[ai][bj][m][0][q]; v1[q] = (float)((unsigned)(gw >> (8 * (4 + q))) & 255u) * (1.f / 255.f) * acc[ai][bj][m][1][q]; }
                    bf16_t* mp = MRG + r * D + cc;
                    if (seg > 0) { const u32x4 pw = *(const u32x4*)mp;
#pragma unroll
                        for (int q = 0; q < 2; ++q) { v0[2 * q] += bflo(pw[q]); v0[2 * q + 1] += bfhi(pw[q]); v1[2 * q] += bflo(pw[2 + q]); v1[2 * q + 1] += bfhi(pw[2 + q]); } }
                    *(u32x4*)mp = pack8(v0, v1);
                }
#ifndef CPU_EMU
                asm volatile("" ::: "memory");
#endif
            }
    }
};
struct EpiResid {
    static constexpr bool PERM = false; const float* xin; const float* g1; float* xmid;
    __device__ __forceinline__ void operator()(const f32x4 (&acc)[2][2][4][2], const Unit& u, int wr, int wc, int fr, int fq) const {
        const int row0 = u.pm * BM + wr * 64 + fr, col0 = u.pn * BM + wc * 32 + 4 * fq;
#pragma unroll
        for (int ai = 0; ai < 2; ++ai)
#pragma unroll
            for (int m = 0; m < 4; ++m) { const int r = row0 + ai * HALF + m * 16; const float* gp = g1 + (size_t)(r / S) * D6;
#pragma unroll
                for (int bj = 0; bj < 2; ++bj)
#pragma unroll
                    for (int n = 0; n < 2; ++n) { const int cc = col0 + bj * HALF + n * 16; *(f32x4*)(xmid + (size_t)r * D + cc) = *(const f32x4*)(xin + (size_t)r * D + cc) + *(const f32x4*)(gp + cc) * acc[ai][bj][m][n]; }
#ifndef CPU_EMU
                asm volatile("" ::: "memory");
#endif
            }
    }
};
struct EpiGU {
    static constexpr bool PERM = true; bf16_t* ACT;
    __device__ __forceinline__ void operator()(const f32x4 (&acc)[2][2][4][2], const Unit& u, int wr, int wc, int fr, int fq) const {
        const int row0 = u.pm * BM + wr * 64 + fr, col0 = u.pn * HALF + wc * 32 + 8 * fq;
#pragma unroll
        for (int ai = 0; ai < 2; ++ai)
#pragma unroll
            for (int m = 0; m < 4; ++m) { f32x4 v0, v1;
#pragma unroll
                for (int j = 0; j < 4; ++j) { v0[j] = siluf_(acc[ai][0][m][0][j]) * acc[ai][1][m][0][j]; v1[j] = siluf_(acc[ai][0][m][1][j]) * acc[ai][1][m][1][j]; }
                *(u32x4*)(ACT + (size_t)(row0 + ai * HALF + m * 16) * 512 + col0) = pack8(v0, v1); }
    }
};
}

template <int PASS>
__device__ __forceinline__ void ph_lru(const Ctx& c, int l, float* ldsf) {
    const bf16_t* P = WSH(O_P); const float* cw = c.in[8] + (size_t)l * 4 * W; const float* cb = c.in[9] + (size_t)l * W;
    const float* br = c.in[11] + (size_t)l * 2 * W; const float* bi = c.in[13] + (size_t)l * 2 * W; const float* lam = c.in[14] + (size_t)l * 2 * W; const bf16_t* WLR = WSH(O_WLR);
    float* CA = WSF(O_LCA); float* CH = WSF(O_LCH); const float* CI = WSF(O_LCI); bf16_t* Y = WSH(O_YS);
    bf16_t* Xs = (bf16_t*)ldsf; bf16_t* Wr = Xs + 64 * 136; bf16_t* Wi = Wr + 128 * 136; float* AUa = (float*)Wr; float* AUu = AUa + 64 * 128; float* HF = (float*)(Wi + 128 * 136); float* spl = HF + 64 * 128;
    const int tid = threadIdx.x, wv = tid >> 6, lane = tid & 63, fr = lane & 15, fq = lane >> 4, rt = wv & 3, hf = wv >> 2;
    for (int u = blockIdx.x; u < (T / 64) * 8; u += gridDim.x) {
        const int n = u & 7, tile = u >> 3, b = tile / NLC, chk = tile % NLC; const long t0 = (long)tile * 64;
        if (tid < 256) spl[tid] = softplusf_(-lam[(tid >> 7) * W + n * 128 + (tid & 127)]);
#pragma unroll
        for (int q = 0; q < 4; ++q) { const int id = tid + NT * q, tl = id >> 5, e4 = (id & 31) * 4, ch = n * 128 + e4; const long t = t0 + tl; const int sI = (int)(t % S);
            f32x4 acc = *(const f32x4*)(cb + ch);
#pragma unroll
            for (int k = 0; k < 4; ++k) { const int ss = sI + k - 2; if (ss >= 0 && ss < S) acc += ld_bf4(P + (size_t)(t + k - 2) * PW + C_LX + ch) * *(const f32x4*)(cw + k * W + ch); }
            st_bf4(Xs + tl * 136 + e4, acc); }
        for (int z = 0; z < 2; ++z) {
#pragma unroll
            for (int q = 0; q < 4; ++q) { const int id = tid + NT * q, f = id >> 4, e8 = (id & 15) * 8;
                *(u32x4*)(Wr + f * 136 + e8) = *(const u32x4*)(WLR + ((size_t)((z * 2 + 0) * 8 + n) * 128 + f) * 128 + e8); *(u32x4*)(Wi + f * 136 + e8) = *(const u32x4*)(WLR + ((size_t)((z * 2 + 1) * 8 + n) * 128 + f) * 128 + e8); }
            SYNCTHREADS();
            f32x4 ar[4], ai[4];
#pragma unroll
            for (int nt = 0; nt < 4; ++nt) { ar[nt] = (f32x4){0.f, 0.f, 0.f, 0.f}; ai[nt] = (f32x4){0.f, 0.f, 0.f, 0.f}; }
            wave_mma<4, 4>(ar, Xs + rt * 16 * 136, 136, Wr + hf * 64 * 136, 136);
            wave_mma<4, 4>(ai, Xs + rt * 16 * 136, 136, Wi + hf * 64 * 136, 136);
            SYNCTHREADS();
            const int tl = rt * 16 + fr;
#pragma unroll
            for (int nt = 0; nt < 4; ++nt) { const int f = 64 * hf + 16 * nt + 4 * fq, ch = n * 128 + f;
                const f32x4 brv = *(const f32x4*)(br + z * W + ch), biv = *(const f32x4*)(bi + z * W + ch), lmv = *(const f32x4*)(spl + z * 128 + f), xcv = ld_bf4(Xs + tl * 136 + f); f32x4 av, uv;
#pragma unroll
                for (int e = 0; e < 4; ++e) { const float r = sigmoidf_(ar[nt][e] + brv[e]), ig = sigmoidf_(ai[nt][e] + biv[e]), la = -8.f * r * lmv[e]; const float a = fexp_(la); av[e] = a; uv[e] = sqrtf(fmaxf(1.f - a * a, 0.f)) * ig * xcv[e]; }
                *(f32x4*)(AUa + tl * 128 + f) = av; *(f32x4*)(AUu + tl * 128 + f) = uv; }
            SYNCTHREADS();
            if (tid < 128) { const int f = tid; const size_t ci = (((size_t)z * NB + b) * NLC + chk) * W + n * 128 + f;
                if (PASS == 1) { float prod = 1.f, h = 0.f;
#pragma unroll 8
                    for (int q = 0; q < 64; ++q) { const int sI = z == 0 ? q : 63 - q; const float a = AUa[sI * 128 + f]; h = a * h + AUu[sI * 128 + f]; prod *= a; }
                    CA[ci] = prod; CH[ci] = h;
                } else { float h = CI[ci];
                    if (z == 0) {
#pragma unroll 8
                        for (int q = 0; q < 64; ++q) { h = AUa[q * 128 + f] * h + AUu[q * 128 + f]; HF[q * 128 + f] = h; }
                    } else {
#pragma unroll 8
                        for (int q = 63; q >= 0; --q) { h = AUa[q * 128 + f] * h + AUu[q * 128 + f]; HF[q * 128 + f] += h; } } }
            }
            SYNCTHREADS();
        }
        if (PASS == 2) {
#pragma unroll
            for (int q = 0; q < 4; ++q) { const int id = tid + NT * q, tl = id >> 5, f4 = (id & 31) * 4; const long t = t0 + tl; f32x4 hv = *(const f32x4*)(HF + tl * 128 + f4); const f32x4 gv = ld_bf4(P + (size_t)t * PW + C_LG + n * 128 + f4);
#pragma unroll
                for (int e = 0; e < 4; ++e) hv[e] *= geluf_(gv[e]);
                st_bf4(Y + (size_t)t * 4 * W + 0 * W + n * 128 + f4, hv); }
            SYNCTHREADS();
        }
    }
}
__device__ __forceinline__ void ph_lru_scan2(const Ctx& c) {
    const float* CA = WSF(O_LCA); const float* CH = WSF(O_LCH); float* CI = WSF(O_LCI);
    for (long i = GT_; i < (long)2 * NB * W; i += GS_) {
        const int w = (int)(i % W), b = (int)((i / W) % NB), z = (int)(i / ((long)W * NB)); float carry = 0.f;
#pragma unroll 16
        for (int q = 0; q < NLC; ++q) { const int ch = z == 0 ? q : NLC - 1 - q; const size_t idx = (((size_t)z * NB + b) * NLC + ch) * W + w; CI[idx] = carry; carry = CA[idx] * carry + CH[idx]; }
    }
}
__device__ __forceinline__ void ret_tables(float* tab, int h) {
    const int tid = threadIdx.x; const float lg = loggamma_(h);
    if (tid < 32) tab[tid] = powf(10000.f, -(float)(2 * tid) / 64.f);
    if (tid >= 64 && tid < 64 + 129) tab[tid] = expf((float)(tid - 64) * lg);
}
__device__ __forceinline__ void ph_ret_kv(const Ctx& c, float* ldsf) {
    const int* pos = (const int*)c.in[2]; const bf16_t* P = WSH(O_P); float* KVF = WSF(O_KVF); float* KVB = WSF(O_KVB);
    bf16_t* VT = (bf16_t*)ldsf; bf16_t* KF = VT + 128 * 136; bf16_t* KB = KF + 64 * 136; float* tab = (float*)(KB + 64 * 136);
    const int tid = threadIdx.x, wv = tid >> 6, lane = tid & 63, fr = lane & 15, fq = lane >> 4;
    for (int u = blockIdx.x; u < (T / 128) * 8; u += gridDim.x) {
        const int h = u & 7; const long t0 = (long)(u >> 3) * 128;
        ret_tables(tab, h);
        SYNCTHREADS();
        { float x1[8], x2[8], pj[8];
#pragma unroll
          for (int q = 0; q < 8; ++q) { const int id = tid + NT * q, j = id & 127, dj = id >> 7; const bf16_t* prow = P + (size_t)(t0 + j) * PW + C_RK + h * 64; x1[q] = bf2f(prow[dj]); x2[q] = bf2f(prow[dj + 32]); pj[q] = (float)pos[t0 + j]; }
#pragma unroll 1
          for (int q = 0; q < 8; ++q) { const int id = tid + NT * q, j = id & 127, dj = id >> 7; const float ang = pj[q] * tab[dj]; const float cs = cosf(ang), sn = sinf(ang);
            const float k1 = x1[q] * cs - x2[q] * sn, k2 = x2[q] * cs + x1[q] * sn, fj = tab[64 + 127 - j], bj = tab[64 + j];
            KF[dj * 136 + j] = (bf16_t)f2bf(k1 * fj); KF[(dj + 32) * 136 + j] = (bf16_t)f2bf(k2 * fj); KB[dj * 136 + j] = (bf16_t)f2bf(k1 * bj); KB[(dj + 32) * 136 + j] = (bf16_t)f2bf(k2 * bj); } }
#pragma unroll
        for (int q = 0; q < 4; ++q) { const int id = tid + NT * q, j = id & 127, e8 = (id >> 7) * 8; const u32x4 raw = *(const u32x4*)(P + (size_t)(t0 + j) * PW + C_RV + h * 128 + e8);
#pragma unroll
            for (int e = 0; e < 4; ++e) { VT[(e8 + 2 * e) * 136 + j] = (bf16_t)(raw[e] & 0xffffu); VT[(e8 + 2 * e + 1) * 136 + j] = (bf16_t)(raw[e] >> 16); } }
        SYNCTHREADS();
        f32x4 af[4], ab[4];
#pragma unroll
        for (int nt = 0; nt < 4; ++nt) { af[nt] = (f32x4){0.f, 0.f, 0.f, 0.f}; ab[nt] = (f32x4){0.f, 0.f, 0.f, 0.f}; }
        wave_mma<4, 4>(af, VT + wv * 16 * 136, 136, KF, 136);
        wave_mma<4, 4>(ab, VT + wv * 16 * 136, 136, KB, 136);
        const size_t ob = (((size_t)(u >> 3) * 8 + h) * 128 + wv * 16 + fr) * 64 + 4 * fq;
#pragma unroll
        for (int nt = 0; nt < 4; ++nt) { *(f32x4*)(KVF + ob + 16 * nt) = af[nt]; *(f32x4*)(KVB + ob + 16 * nt) = ab[nt]; }
        SYNCTHREADS();
    }
}
__device__ __forceinline__ void ph_ret_state(const Ctx& c) {
    const float* KVF = WSF(O_KVF); const float* KVB = WSF(O_KVB); float* STF = WSF(O_STF); float* STB = WSF(O_STB);
    for (long i = GT_; i < (long)NB * 8 * 8192; i += GS_) {
        const int x = (int)(i % 8192), h = (int)((i / 8192) % 8), b = (int)(i / 65536);
        const float cd = expf(128.f * loggamma_(h)); float st = 0.f;
#pragma unroll 16
        for (int n = 0; n < NCH; ++n) { const size_t idx = (((size_t)b * NCH + n) * 8 + h) * 8192 + x; STF[idx] = st; st = cd * st + KVF[idx]; }
        st = 0.f;
#pragma unroll 16
        for (int n = NCH - 1; n >= 0; --n) { const size_t idx = (((size_t)b * NCH + n) * 8 + h) * 8192 + x; STB[idx] = st; st = cd * st + KVB[idx]; }
    }
}
__device__ __forceinline__ void ph_ret_out(const Ctx& c, float* ldsf) {
    const int* pos = (const int*)c.in[2]; const bf16_t* P = WSH(O_P); const float* STF = WSF(O_STF); const float* STB = WSF(O_STB); bf16_t* Y = WSH(O_YS);
    bf16_t* Qs = (bf16_t*)ldsf; bf16_t* Ks = Qs + 128 * 72; bf16_t* VT = Ks + 128 * 72; bf16_t* Ss = VT + 128 * 136; bf16_t* SF = Ss + 128 * 136; bf16_t* SB = SF + 128 * 72; float* tab = (float*)(SB + 128 * 72);
    const int tid = threadIdx.x, wv = tid >> 6, lane = tid & 63, fr = lane & 15, fq = lane >> 4;
    for (int u = blockIdx.x; u < (T / 128) * 8; u += gridDim.x) {
        const int h = u & 7; const long t0 = (long)(u >> 3) * 128;
        ret_tables(tab, h);
        SYNCTHREADS();
#pragma unroll 1
        for (int qh = 0; qh < 8; qh += 4) { float q1[4], q2[4], k1[4], k2[4], pj[4];
#pragma unroll
          for (int q = 0; q < 4; ++q) { const int id = tid + NT * (qh + q), j = id >> 5, dj = id & 31; const bf16_t* prow = P + (size_t)(t0 + j) * PW;
            q1[q] = bf2f(prow[C_RQ + h * 64 + dj]); q2[q] = bf2f(prow[C_RQ + h * 64 + dj + 32]); k1[q] = bf2f(prow[C_RK + h * 64 + dj]); k2[q] = bf2f(prow[C_RK + h * 64 + dj + 32]); pj[q] = (float)pos[t0 + j]; }
#pragma unroll
          for (int q = 0; q < 4; ++q) { const int id = tid + NT * (qh + q), j = id >> 5, dj = id & 31; const float ang = pj[q] * tab[dj]; const float cs = cosf(ang), sn = sinf(ang);
            Qs[j * 72 + dj] = (bf16_t)f2bf((q1[q] * cs - q2[q] * sn) * 0.125f); Qs[j * 72 + dj + 32] = (bf16_t)f2bf((q2[q] * cs + q1[q] * sn) * 0.125f); Ks[j * 72 + dj] = (bf16_t)f2bf(k1[q] * cs - k2[q] * sn); Ks[j * 72 + dj + 32] = (bf16_t)f2bf(k2[q] * cs + k1[q] * sn); } }
#pragma unroll
        for (int q = 0; q < 4; ++q) { const int id = tid + NT * q, j = id & 127, e8 = (id >> 7) * 8; const u32x4 raw = *(const u32x4*)(P + (size_t)(t0 + j) * PW + C_RV + h * 128 + e8);
#pragma unroll
            for (int e = 0; e < 4; ++e) { VT[(e8 + 2 * e) * 136 + j] = (bf16_t)(raw[e] & 0xffffu); VT[(e8 + 2 * e + 1) * 136 + j] = (bf16_t)(raw[e] >> 16); } }
        const size_t sbase = (((size_t)(u >> 3) * 8 + h)) * 8192;
#pragma unroll
        for (int q = 0; q < 4; ++q) { const int id = tid + NT * q, e = id >> 4, d4 = (id & 15) * 4; st_bf4(SF + e * 72 + d4, *(const f32x4*)(STF + sbase + (size_t)e * 64 + d4)); st_bf4(SB + e * 72 + d4, *(const f32x4*)(STB + sbase + (size_t)e * 64 + d4)); }
        SYNCTHREADS();
        const int i = wv * 16 + fr; const long t = t0 + i;
        {
            f32x4 sc[8];
#pragma unroll
            for (int nt = 0; nt < 8; ++nt) sc[nt] = (f32x4){0.f, 0.f, 0.f, 0.f};
            wave_mma<2, 8>(sc, Qs + wv * 16 * 72, 72, Ks, 72);
#pragma unroll
            for (int nt = 0; nt < 8; ++nt) { const int j0 = 16 * nt + 4 * fq; f32x4 sv;
#pragma unroll
                for (int e = 0; e < 4; ++e) { const int j = j0 + e, dist = i > j ? i - j : j - i; sv[e] = sc[nt][e] * tab[64 + dist]; }
                st_bf4(Ss + i * 136 + j0, sv); }
        }
#ifdef CPU_EMU
        SYNCTHREADS();
#else
        asm volatile("s_waitcnt lgkmcnt(0)" ::: "memory");
#endif
        f32x4 ao[8], tm[8];
#pragma unroll
        for (int nt = 0; nt < 8; ++nt) { ao[nt] = (f32x4){0.f, 0.f, 0.f, 0.f}; tm[nt] = (f32x4){0.f, 0.f, 0.f, 0.f}; }
        wave_mma<4, 8>(ao, Ss + wv * 16 * 136, 136, VT, 136);
        wave_mma<2, 8>(tm, Qs + wv * 16 * 72, 72, SF, 72);
        { const float qf = tab[64 + i + 1];
#pragma unroll
            for (int nt = 0; nt < 8; ++nt) { ao[nt] += tm[nt] * qf; tm[nt] = (f32x4){0.f, 0.f, 0.f, 0.f}; } }
        wave_mma<2, 8>(tm, Qs + wv * 16 * 72, 72, SB, 72);
        { const float qb = tab[64 + 128 - i];
#pragma unroll
            for (int nt = 0; nt < 8; ++nt) ao[nt] += tm[nt] * qb; }
        float sm = 0.f;
#pragma unroll
        for (int nt = 0; nt < 8; ++nt) sm += (ao[nt][0] + ao[nt][1]) + (ao[nt][2] + ao[nt][3]);
        sm += SHFL_XOR(sm, 16); sm += SHFL_XOR(sm, 32);
        const float mu = sm * (1.f / 128.f); float sq = 0.f;
#pragma unroll
        for (int nt = 0; nt < 8; ++nt) { ao[nt] -= mu; sq += (ao[nt][0] * ao[nt][0] + ao[nt][1] * ao[nt][1]) + (ao[nt][2] * ao[nt][2] + ao[nt][3] * ao[nt][3]); }
        sq += SHFL_XOR(sq, 16); sq += SHFL_XOR(sq, 32);
        const float rs = 1.f / sqrtf(sq * (1.f / 128.f) + EPS);
#pragma unroll
        for (int nt = 0; nt < 8; ++nt) { const int e0 = 16 * nt + 4 * fq; f32x4 gv = ld_bf4(P + (size_t)t * PW + C_RG + h * 128 + e0);
#pragma unroll
            for (int e = 0; e < 4; ++e) gv[e] = siluf_(gv[e]) * (ao[nt][e] * rs);
            st_bf4(Y + (size_t)t * 4 * W + 1 * W + h * 128 + e0, gv); }
        SYNCTHREADS();
    }
}
__device__ __forceinline__ void ph_sgu_norm(const Ctx& c, int l) {
    const bf16_t* P = WSH(O_P); float* ST = WSF(O_VN);
    const int lane = threadIdx.x & 63, gw = blockIdx.x * (NT / 64) + (threadIdx.x >> 6), ngw = gridDim.x * (NT / 64);
    for (int t = gw; t < T; t += ngw) {
        f32x4 v[4]; float sm = 0.f;
#pragma unroll
        for (int j = 0; j < 4; ++j) { v[j] = ld_bf4(P + (size_t)t * PW + C_SV + (j * 64 + lane) * 4);
#pragma unroll
            for (int q = 0; q < 4; ++q) { v[j][q] = geluf_(v[j][q]); sm += v[j][q]; } }
        const float mu = wave_sum(sm) * (1.f / W); float sq = 0.f;
#pragma unroll
        for (int j = 0; j < 4; ++j)
#pragma unroll
            for (int q = 0; q < 4; ++q) { const float dd = v[j][q] - mu; sq += dd * dd; }
        const float rs = 1.f / sqrtf(wave_sum(sq) * (1.f / W) + EPS);
        if (lane == 0) { ST[(size_t)t * 2] = mu; ST[(size_t)t * 2 + 1] = rs; }
    }
}
__device__ __forceinline__ void ph_sgu_mix(const Ctx& c, int l, float* ldsf) {
    const bf16_t* P = WSH(O_P); const float* ST = WSF(O_VN); bf16_t* Y = WSH(O_YS); const float* ng = c.in[15] + (size_t)l * W;
    bf16_t* As = (bf16_t*)ldsf; bf16_t* Bs = As + 128 * 136; const int tid = threadIdx.x, wv = tid >> 6, lane = tid & 63, fr = lane & 15, fq = lane >> 4;
    for (int u = blockIdx.x; u < (T / 128) * 8; u += gridDim.x) {
        const int g = u & 7; const long t0 = (long)(u >> 3) * 128;
        const float* ws = c.in[16] + ((size_t)l * 8 + g) * 128 * 128; const float* bs = c.in[17] + ((size_t)l * 8 + g) * 128;
#pragma unroll
        for (int q = 0; q < 8; ++q) { const int id = tid + NT * q, i = id >> 5, j4 = (id & 31) * 4; st_bf4(As + i * 136 + j4, *(const f32x4*)(ws + i * 128 + j4)); }
#pragma unroll
        for (int q = 0; q < 4; ++q) { const int id = tid + NT * q, j = id & 127, d8 = (id >> 7) * 8; const float mu = ST[(size_t)(t0 + j) * 2], rs = ST[(size_t)(t0 + j) * 2 + 1];
            const u32x4 raw = *(const u32x4*)(P + (size_t)(t0 + j) * PW + C_SV + g * 128 + d8);
#pragma unroll
            for (int e = 0; e < 4; ++e) { const float v0 = (geluf_(bflo(raw[e])) - mu) * rs * ng[g * 128 + d8 + 2 * e], v1 = (geluf_(bfhi(raw[e])) - mu) * rs * ng[g * 128 + d8 + 2 * e + 1];
                Bs[(d8 + 2 * e) * 136 + j] = (bf16_t)f2bf(v0); Bs[(d8 + 2 * e + 1) * 136 + j] = (bf16_t)f2bf(v1); } }
        SYNCTHREADS();
        f32x4 acc[8];
#pragma unroll
        for (int nt = 0; nt < 8; ++nt) acc[nt] = (f32x4){0.f, 0.f, 0.f, 0.f};
        wave_mma<4, 8>(acc, As + wv * 16 * 136, 136, Bs, 136);
        const int i = wv * 16 + fr; const long t = t0 + i; const float bsi = bs[i];
#pragma unroll
        for (int nt = 0; nt < 8; ++nt) { const int d = 16 * nt + 4 * fq; f32x4 uu = ld_bf4(P + (size_t)t * PW + C_SU + g * 128 + d);
#pragma unroll
            for (int e = 0; e < 4; ++e) uu[e] = geluf_(uu[e]) * (acc[nt][e] + bsi);
            st_bf4(Y + (size_t)t * 4 * W + 2 * W + g * 128 + d, uu); }
        SYNCTHREADS();
    }
}
__device__ __forceinline__ void ph_rw_shift(const Ctx& c, int l) {
    const bf16_t* P = WSH(O_P); const float* mup = c.in[18] + (size_t)l * RF; const float* mun = c.in[19] + (size_t)l * RF; bf16_t* FS = WSH(O_FS);
    const int lane = threadIdx.x & 63, gw = blockIdx.x * (NT / 64) + (threadIdx.x >> 6), ngw = gridDim.x * (NT / 64);
    for (int t = gw; t < T; t += ngw) {
        const int sI = t % S; const bf16_t* pc = P + (size_t)t * PW + C_RW;
#pragma unroll 2
        for (int j = lane * 4; j < RF; j += 256) {
            const f32x4 f = ld_bf4(pc + j), z4 = (f32x4){0.f, 0.f, 0.f, 0.f}; const f32x4 pv = sI > 0 ? ld_bf4(pc - PW + j) : z4, nv = sI < S - 1 ? ld_bf4(pc + PW + j) : z4;
            f32x4 v = f + *(const f32x4*)(mup + j) * (pv - f) + *(const f32x4*)(mun + j) * (nv - f);
            if (j >= 3072 && j < 3200) {
#pragma unroll
                for (int e = 0; e < 4; ++e) v[e] = tanhf_(v[e]); }
            else if (j >= 3328) {
#pragma unroll
                for (int e = 0; e < 4; ++e) v[e] = sigmoidf_(v[e]); }
            st_bf4(FS + (size_t)t * RF + j, v);
        }
    }
}
__device__ __forceinline__ void ph_rw_lora(const Ctx& c, int l, float* ldsf) {
    const bf16_t* FS = WSH(O_FS); const float* w0 = c.in[20] + (size_t)l * 2 * W; const float* a0 = c.in[22] + (size_t)l * 2 * W;
    const bf16_t* WUT = WSH(O_WUT); const bf16_t* WAT = WSH(O_WAT); const bf16_t* WGT = WSH(O_WGT);
    bf16_t* DEC = WSH(O_DEC); bf16_t* AA = WSH(O_AA); bf16_t* GG = WSH(O_GG);
    bf16_t* F = (bf16_t*)ldsf; bf16_t* B1 = F + 128 * 136; bf16_t* B2 = B1 + 128 * 136; const int tid = threadIdx.x, wv = tid >> 6, lane = tid & 63, fr = lane & 15, fq = lane >> 4;
    for (int u = blockIdx.x; u < (T / 128) * 8; u += gridDim.x) {
        const int wc0 = (u & 7) * 128; const long t0 = (long)(u >> 3) * 128;
        for (int rd = 0; rd < 3; ++rd) {
#pragma unroll
            for (int q = 0; q < 8; ++q) { const int id = tid + NT * q, r = id >> 5, c4 = (id & 31) * 4;
                const int col = rd < 2 ? (c4 < 64 ? 3072 + rd * 64 + c4 : 3200 + rd * 64 + (c4 - 64)) : 3328 + c4;
                *(unsigned long long*)(F + r * 136 + c4) = *(const unsigned long long*)(FS + (size_t)(t0 + r) * RF + col); }
            if (rd < 2) {
#pragma unroll
                for (int q = 0; q < 2; ++q) { const int id = tid + NT * q, w = id >> 3, r8 = (id & 7) * 8;
                    *(u32x4*)(B1 + w * 72 + r8) = *(const u32x4*)(WUT + ((size_t)rd * W + wc0 + w) * 64 + r8); *(u32x4*)(B2 + w * 72 + r8) = *(const u32x4*)(WAT + ((size_t)rd * W + wc0 + w) * 64 + r8); }
            } else {
#pragma unroll
                for (int q = 0; q < 4; ++q) { const int id = tid + NT * q, w = id >> 4, r8 = (id & 15) * 8; *(u32x4*)(B1 + w * 136 + r8) = *(const u32x4*)(WGT + ((size_t)wc0 + w) * 128 + r8); }
            }
            SYNCTHREADS();
            f32x4 a1[8], a2[8];
#pragma unroll
            for (int nt = 0; nt < 8; ++nt) { a1[nt] = (f32x4){0.f, 0.f, 0.f, 0.f}; a2[nt] = (f32x4){0.f, 0.f, 0.f, 0.f}; }
            const long t = t0 + wv * 16 + fr;
            if (rd < 2) {
                wave_mma<2, 8>(a1, F + wv * 16 * 136, 136, B1, 72);
                wave_mma<2, 8>(a2, F + wv * 16 * 136 + 64, 136, B2, 72);
#pragma unroll
                for (int nt = 0; nt < 8; ++nt) { const int ch = wc0 + 16 * nt + 4 * fq; const f32x4 w0v = *(const f32x4*)(w0 + rd * W + ch), a0v = *(const f32x4*)(a0 + rd * W + ch); f32x4 dv, av;
#pragma unroll
                    for (int e = 0; e < 4; ++e) { dv[e] = fexp_(-DECAY_SCALE * sigmoidf_(a1[nt][e] + w0v[e])); av[e] = sigmoidf_(a2[nt][e] + a0v[e]); }
                    st_bf4(DEC + ((size_t)rd * T + t) * W + ch, dv); st_bf4(AA + ((size_t)rd * T + t) * W + ch, av); }
            } else {
                wave_mma<4, 8>(a1, F + wv * 16 * 136, 136, B1, 136);
#pragma unroll
                for (int nt = 0; nt < 8; ++nt) st_bf4(GG + (size_t)t * W + wc0 + 16 * nt + 4 * fq, a1[nt]);
            }
            SYNCTHREADS();
        }
    }
}
#ifdef CPU_EMU
__device__ __forceinline__ float red16_(float x) { x += SHFL_XOR(x, 1); x += SHFL_XOR(x, 2); x += SHFL_XOR(x, 4); x += SHFL_XOR(x, 8); return x; }
#define LDS_BARRIER() emu_syncthreads()
#else
__device__ __forceinline__ float red16_(float x) {
    x += __builtin_bit_cast(float, __builtin_amdgcn_update_dpp(0, __builtin_bit_cast(int, x), 0xB1, 0xF, 0xF, true));
    x += __builtin_bit_cast(float, __builtin_amdgcn_update_dpp(0, __builtin_bit_cast(int, x), 0x4E, 0xF, 0xF, true));
    x += __builtin_bit_cast(float, __builtin_amdgcn_update_dpp(0, __builtin_bit_cast(int, x), 0x141, 0xF, 0xF, true));
    x += __builtin_bit_cast(float, __builtin_amdgcn_update_dpp(0, __builtin_bit_cast(int, x), 0x140, 0xF, 0xF, true));
    return x;
}
#define LDS_BARRIER() do { asm volatile("s_waitcnt lgkmcnt(0)" ::: "memory"); __builtin_amdgcn_s_barrier(); asm volatile("" ::: "memory"); } while (0)
#endif
#define RC_M(k) (lm + (k) * 4608)
__device__ __forceinline__ void ph_rw_chunk(const Ctx& c, int l, float* ldsf) {
    const bf16_t* FS = WSH(O_FS); const bf16_t* DEC = WSH(O_DEC); const bf16_t* AA = WSH(O_AA); float* BON = WSF(O_BON);
    const float* kkw = c.in[25] + (size_t)l * W; const float* kaw = c.in[26] + (size_t)l * W; const float* rk = c.in[27] + (size_t)l * W;
    bf16_t* PST = WSH(O_PST); bf16_t* PYT = WSH(O_PYT); bf16_t* SVB = WSH(O_SVB); bf16_t* YVB = WSH(O_YVB);
    bf16_t* lm = (bf16_t*)ldsf; float* gam = (float*)RC_M(7); float* segp = (float*)RC_M(13); float* gl = segp + 512;
    const int tid = threadIdx.x, wv = tid >> 6, lane = tid & 63, fr = lane & 15, fq = lane >> 4, rt = wv & 3, hf = wv >> 2;
    const int m0 = 16 * rt + fr;
    float wv8[8], kv8[8], rv8[8], vv8[8], aa8[8];
#define RC_LOAD(uu) do { const int chain_ = (uu) / NRC, ck_ = (uu) % NRC, h_ = chain_ & 15, b_ = (chain_ >> 4) & 1, z_ = chain_ >> 5; \
        const long tb_ = (long)b_ * S + (z_ ? S - 1 - ck_ * RCK : ck_ * RCK); const int dirn_ = z_ ? -1 : 1; \
        const bf16_t* decp_ = DEC + ((size_t)z_ * T) * W + h_ * 64; const bf16_t* aap_ = AA + ((size_t)z_ * T) * W + h_ * 64; const int ch_ = h_ * 64 + lane; \
        _Pragma("unroll") for (int q = 0; q < 8; ++q) wv8[q] = bf2f(decp_[(size_t)(tb_ + dirn_ * ((tid >> 6) * 8 + q)) * W + (tid & 63)]); \
        _Pragma("unroll") for (int q = 0; q < 8; ++q) { const long t_ = tb_ + dirn_ * (wv + 8 * q); const bf16_t* f_ = FS + (size_t)t_ * RF; kv8[q] = bf2f(f_[1024 + ch_]); rv8[q] = bf2f(f_[ch_]); vv8[q] = bf2f(f_[2048 + ch_]); aa8[q] = bf2f(aap_[(size_t)t_ * W + lane]); } } while (0)
    if ((int)blockIdx.x < 64 * NRC) RC_LOAD((int)blockIdx.x);
    for (int u = blockIdx.x; u < 64 * NRC; u += gridDim.x) {
        const int chain = u / NRC, ck = u % NRC, h = chain & 15, b = (chain >> 4) & 1, z = chain >> 5;
        const long tb = (long)b * S + (z ? S - 1 - ck * RCK : ck * RCK); const int dirn = z ? -1 : 1;
        { const int k = tid & 63, sg = tid >> 6; float p = 1.f;
#pragma unroll
          for (int q = 0; q < 8; ++q) { p *= wv8[q]; gam[(sg * 8 + q) * 64 + k] = p; }
          segp[sg * 64 + k] = p; }
        LDS_BARRIER();
        { const int k = tid & 63, sg = tid >> 6; float pre = 1.f;
          for (int q = 0; q < sg; ++q) pre *= segp[q * 64 + k];
#pragma unroll
          for (int q = 0; q < 8; ++q) gam[(sg * 8 + q) * 64 + k] *= pre;
          if (sg == 7) gl[k] = gam[63 * 64 + k]; }
        LDS_BARRIER();
        { const int k = lane, ch = h * 64 + k; const float kkwv = kkw[ch], kav = kaw[ch], rkv = rk[ch];
#pragma unroll
          for (int q = 0; q < 8; ++q) { const int tt = wv + 8 * q; const long t = tb + dirn * tt;
            const float vk = kv8[q] * kkwv; const float kkn = vk * frsq_(wave_sum(vk * vk) + EPS); const float ktv = kv8[q] * (1.f + (aa8[q] - 1.f) * kav);
            const float bsum = wave_sum(rv8[q] * rkv * ktv); if (lane == 0) BON[((size_t)z * T + t) * 16 + h] = bsum;
            const float g = gam[tt * 64 + k], gp = tt ? gam[(tt - 1) * 64 + k] : 1.f, ig = frcp_(g);
            const bf16_t khv = (bf16_t)f2bf(kkn * gp), bhv = (bf16_t)f2bf(aa8[q] * kkn * ig);
            RC_M(0)[tt * 72 + k] = khv; RC_M(1)[k * 72 + tt] = khv; RC_M(2)[tt * 72 + k] = bhv; RC_M(3)[k * 72 + tt] = bhv;
            RC_M(4)[tt * 72 + k] = (bf16_t)f2bf(ktv * ig); RC_M(5)[tt * 72 + k] = (bf16_t)f2bf(rv8[q] * g); RC_M(6)[k * 72 + tt] = (bf16_t)f2bf(vv8[q]); } }
        if (u + (int)gridDim.x < 64 * NRC) RC_LOAD(u + (int)gridDim.x);
        LDS_BARRIER();
        f32x4 mkr[2], khr[2], rhT[2];
        {
            f32x4 a0[2], a1[2], a2[2], a3[2];
#pragma unroll
            for (int nt = 0; nt < 2; ++nt) { a0[nt] = (f32x4){0.f, 0.f, 0.f, 0.f}; a1[nt] = a0[nt]; a2[nt] = a0[nt]; a3[nt] = a0[nt]; }
            wave_mma<2, 2>(a0, RC_M(2) + rt * 16 * 72, 72, RC_M(0) + hf * 32 * 72, 72);
            wave_mma<2, 2>(a1, RC_M(4) + rt * 16 * 72, 72, RC_M(0) + hf * 32 * 72, 72);
            wave_mma<2, 2>(a2, RC_M(2) + rt * 16 * 72, 72, RC_M(5) + hf * 32 * 72, 72);
            wave_mma<2, 2>(a3, RC_M(4) + rt * 16 * 72, 72, RC_M(5) + hf * 32 * 72, 72);
#pragma unroll
            for (int nt = 0; nt < 2; ++nt) { const int n0 = 32 * hf + 16 * nt + 4 * fq; f32x4 nn, ti, mk;
#pragma unroll
                for (int r = 0; r < 4; ++r) { const int n = n0 + r; const bool lt = m0 < n, le = m0 <= n;
                    nn[r] = lt ? -a0[nt][r] : 0.f; ti[r] = nn[r] + (m0 == n ? 1.f : 0.f); mk[r] = lt ? a1[nt][r] : 0.f; mkr[nt][r] = le ? a3[nt][r] : 0.f;
                    RC_M(12)[n * 72 + m0] = (bf16_t)f2bf(le ? a2[nt][r] : 0.f);
                    RC_M(8)[n * 72 + m0] = (bf16_t)f2bf(nn[r]);
                    khr[nt][r] = bf2f(RC_M(4)[m0 * 72 + n]); rhT[nt][r] = bf2f(RC_M(5)[n * 72 + m0]); }
                st_bf4(RC_M(7) + m0 * 72 + n0, nn); st_bf4(RC_M(9) + m0 * 72 + n0, ti); st_bf4(RC_M(11) + m0 * 72 + n0, mk); }
        }
        LDS_BARRIER();
        f32x4 tiv[2];
#pragma unroll
        for (int nt = 0; nt < 2; ++nt) tiv[nt] = ld_bf4(RC_M(9) + m0 * 72 + 32 * hf + 16 * nt + 4 * fq);
#pragma unroll 1
        for (int it = 0; it < 5; ++it) {
            bf16_t* pw = (it & 1) ? RC_M(0) : RC_M(7); bf16_t* pwT = (it & 1) ? RC_M(2) : RC_M(8); bf16_t* pw2 = (it & 1) ? RC_M(7) : RC_M(0); bf16_t* pw2T = (it & 1) ? RC_M(8) : RC_M(2);
            bf16_t* tcur = (it & 1) ? RC_M(4) : RC_M(9); bf16_t* tnxt = (it & 1) ? RC_M(9) : RC_M(4);
            f32x4 sq[2];
#pragma unroll
            for (int nt = 0; nt < 2; ++nt) sq[nt] = (f32x4){0.f, 0.f, 0.f, 0.f};
            wave_mma<2, 2>(sq, pw + rt * 16 * 72, 72, pwT + hf * 32 * 72, 72);
#pragma unroll
            for (int nt = 0; nt < 2; ++nt) { const int n0 = 32 * hf + 16 * nt + 4 * fq; st_bf4(pw2 + m0 * 72 + n0, sq[nt]);
#pragma unroll
                for (int r = 0; r < 4; ++r) pw2T[(n0 + r) * 72 + m0] = (bf16_t)f2bf(sq[nt][r]); }
            LDS_BARRIER();
            f32x4 up[2];
#pragma unroll
            for (int nt = 0; nt < 2; ++nt) up[nt] = (f32x4){0.f, 0.f, 0.f, 0.f};
            wave_mma<2, 2>(up, tcur + rt * 16 * 72, 72, pw2T + hf * 32 * 72, 72);
#pragma unroll
            for (int nt = 0; nt < 2; ++nt) { const int n0 = 32 * hf + 16 * nt + 4 * fq; tiv[nt] += up[nt]; st_bf4(tnxt + m0 * 72 + n0, tiv[nt]);
                if (it == 4) {
#pragma unroll
                    for (int r = 0; r < 4; ++r) RC_M(10)[(n0 + r) * 72 + m0] = (bf16_t)f2bf(tiv[nt][r]); } }
            LDS_BARRIER();
        }
        {
            f32x4 w1[2], w2[2];
#pragma unroll
            for (int nt = 0; nt < 2; ++nt) { w1[nt] = (f32x4){0.f, 0.f, 0.f, 0.f}; w2[nt] = w1[nt]; }
            wave_mma<2, 2>(w1, RC_M(1) + rt * 16 * 72, 72, RC_M(10) + hf * 32 * 72, 72);
            wave_mma<2, 2>(w2, RC_M(11) + rt * 16 * 72, 72, RC_M(10) + hf * 32 * 72, 72);
#pragma unroll
            for (int nt = 0; nt < 2; ++nt) { const int n0 = 32 * hf + 16 * nt + 4 * fq; st_bf4(RC_M(7) + m0 * 72 + n0, w1[nt]); st_bf4(RC_M(8) + m0 * 72 + n0, w2[nt]); }
        }
        LDS_BARRIER();
        {
            f32x4 py[2], qy[2], ps[2], qs[2];
#pragma unroll
            for (int nt = 0; nt < 2; ++nt) { py[nt] = (f32x4){0.f, 0.f, 0.f, 0.f}; qy[nt] = py[nt]; ps[nt] = py[nt]; qs[nt] = py[nt]; }
            wave_mma<2, 2>(py, RC_M(7) + rt * 16 * 72, 72, RC_M(12) + hf * 32 * 72, 72);
            wave_mma<2, 2>(qy, RC_M(8) + rt * 16 * 72, 72, RC_M(12) + hf * 32 * 72, 72);
            wave_mma<2, 2>(ps, RC_M(7) + rt * 16 * 72, 72, RC_M(3) + hf * 32 * 72, 72);
            wave_mma<2, 2>(qs, RC_M(8) + rt * 16 * 72, 72, RC_M(3) + hf * 32 * 72, 72);
#pragma unroll
            for (int nt = 0; nt < 2; ++nt) { const int n0 = 32 * hf + 16 * nt + 4 * fq;
#pragma unroll
                for (int r = 0; r < 4; ++r) { const int n = n0 + r; const float gln = gl[n];
                    RC_M(0)[n * 72 + m0] = (bf16_t)f2bf(rhT[nt][r] - py[nt][r]); RC_M(2)[n * 72 + m0] = (bf16_t)f2bf(mkr[nt][r] - qy[nt][r]);
                    RC_M(4)[n * 72 + m0] = (bf16_t)f2bf(((m0 == n ? 1.f : 0.f) - ps[nt][r]) * gln); RC_M(5)[n * 72 + m0] = (bf16_t)f2bf((khr[nt][r] - qs[nt][r]) * gln); } }
        }
        LDS_BARRIER();
        {
            f32x4 yv[2], sv[2];
#pragma unroll
            for (int nt = 0; nt < 2; ++nt) { yv[nt] = (f32x4){0.f, 0.f, 0.f, 0.f}; sv[nt] = yv[nt]; }
            wave_mma<2, 2>(yv, RC_M(6) + rt * 16 * 72, 72, RC_M(2) + hf * 32 * 72, 72);
            wave_mma<2, 2>(sv, RC_M(6) + rt * 16 * 72, 72, RC_M(5) + hf * 32 * 72, 72);
#pragma unroll
            for (int nt = 0; nt < 2; ++nt) { const int n0 = 32 * hf + 16 * nt + 4 * fq; st_bf4(YVB + (size_t)u * 4096 + m0 * 64 + n0, yv[nt]); st_bf4(SVB + (size_t)u * 4096 + m0 * 64 + n0, sv[nt]); }
            { const int rr = tid >> 3, c8 = (tid & 7) * 8; *(u32x4*)(PYT + (size_t)u * 4096 + rr * 64 + c8) = *(const u32x4*)(RC_M(0) + rr * 72 + c8); *(u32x4*)(PST + (size_t)u * 4096 + rr * 64 + c8) = *(const u32x4*)(RC_M(4) + rr * 72 + c8); }
        }
        LDS_BARRIER();
    }
}
#undef RC_M
#undef RC_LOAD
__device__ __forceinline__ void ph_rw_seq(const Ctx& c, float* ldsf) {
    const bf16_t* PST = WSH(O_PST); const bf16_t* PYT = WSH(O_PYT); const bf16_t* SVB = WSH(O_SVB); const bf16_t* YVB = WSH(O_YVB); bf16_t* YY = WSH(O_YY);
    bf16_t* Sb = (bf16_t*)ldsf;
    bf16_t* Pm = Sb + 2 * 16 * 72;
    const int tid = threadIdx.x, wv = tid >> 6, lane = tid & 63, fr = lane & 15, fq = lane >> 4, isY = wv >> 2, nt0 = wv & 3;
    for (int u = blockIdx.x; u < 256; u += gridDim.x) {
        const int x = u & 7, jq = u >> 3, chain = x * 8 + (jq >> 2), qt = jq & 3, h = chain & 15, b = (chain >> 4) & 1, z = chain >> 5;
        const size_t ub = (size_t)chain * NRC;
        const int rr = tid >> 3, c8 = (tid & 7) * 8;
        constexpr int PD = NRC >= 8 ? 8 : 4;
        for (int i = tid; i < 2 * 16 * 72 / 2; i += NT) ((unsigned*)Sb)[i] = 0u;
        const int row = 16 * qt + fr, n0 = 16 * nt0 + 4 * fq; const bf16_t* addp = (isY ? YVB : SVB) + ub * 4096 + row * 64 + n0;
        const bf16_t* psp = PST + ub * 4096 + rr * 64 + c8; const bf16_t* pyp = PYT + ub * 4096 + rr * 64 + c8;
        u32x4 gps[PD], gpy[PD]; f32x4 add[PD];
#pragma unroll
        for (int j = 0; j < PD; ++j) { gps[j] = *(const u32x4*)(psp + (size_t)j * 4096); gpy[j] = *(const u32x4*)(pyp + (size_t)j * 4096); add[j] = ld_bf4(addp + (size_t)j * 4096); }
        *(u32x4*)(Pm + (0 * 2 + 0) * 4608 + rr * 72 + c8) = gps[0]; *(u32x4*)(Pm + (0 * 2 + 1) * 4608 + rr * 72 + c8) = gpy[0];
        if (PD < NRC) { gps[0] = *(const u32x4*)(psp + (size_t)PD * 4096); gpy[0] = *(const u32x4*)(pyp + (size_t)PD * 4096); }
        SYNCTHREADS();
        for (int ck0 = 0; ck0 < NRC; ck0 += PD) {
#pragma unroll
            for (int j = 0; j < PD; ++j) {
                const int ck = ck0 + j, cur = j & 1, nxt = cur ^ 1;
                f32x4 acc[1]; acc[0] = (f32x4){0.f, 0.f, 0.f, 0.f};
                wave_mma<2, 1>(acc, Sb + cur * 16 * 72, 72, Pm + (cur * 2 + isY) * 4608 + nt0 * 16 * 72, 72);
                acc[0] += add[j];
                if (ck + PD < NRC) add[j] = ld_bf4(addp + (size_t)(ck + PD) * 4096);
                if (isY) {
#pragma unroll
                    for (int r = 0; r < 4; ++r) { const int step = ck * RCK + n0 + r, sidx = z ? S - 1 - step : step; YY[((size_t)z * T + (size_t)b * S + sidx) * W + h * 64 + row] = (bf16_t)f2bf(acc[0][r]); }
                } else st_bf4(Sb + nxt * 16 * 72 + fr * 72 + n0, acc[0]);
                const int jn = (j + 1) % PD;
                if (ck + 1 < NRC) { *(u32x4*)(Pm + (nxt * 2 + 0) * 4608 + rr * 72 + c8) = gps[jn]; *(u32x4*)(Pm + (nxt * 2 + 1) * 4608 + rr * 72 + c8) = gpy[jn]; }
                if (ck + 1 + PD < NRC) { gps[jn] = *(const u32x4*)(psp + (size_t)(ck + 1 + PD) * 4096); gpy[jn] = *(const u32x4*)(pyp + (size_t)(ck + 1 + PD) * 4096); }
                LDS_BARRIER();
            }
        }
    }
}
__device__ __forceinline__ void ph_rw_out(const Ctx& c) {
    const bf16_t* FS = WSH(O_FS); const bf16_t* YY = WSH(O_YY); const float* BON = WSF(O_BON); const bf16_t* GG = WSH(O_GG); bf16_t* Y = WSH(O_YS);
    const int lane = threadIdx.x & 63, gw = blockIdx.x * (NT / 64) + (threadIdx.x >> 6), ngw = gridDim.x * (NT / 64);
    for (int i = gw; i < T * 4; i += ngw) {
        const int h0 = (i & 3) * 4; const long t = i >> 2; float y0[4], y1[4], gv[4], vv[4], bs[4];
#pragma unroll
        for (int q = 0; q < 4; ++q) { const int ch = (h0 + q) * 64 + lane; y0[q] = bf2f(YY[(size_t)t * W + ch]); y1[q] = bf2f(YY[((size_t)T + t) * W + ch]); gv[q] = bf2f(GG[(size_t)t * W + ch]); vv[q] = bf2f(FS[(size_t)t * RF + 2048 + ch]);
            bs[q] = BON[(size_t)t * 16 + h0 + q] + BON[((size_t)T + t) * 16 + h0 + q]; }
#pragma unroll
        for (int q = 0; q < 4; ++q) { const int ch = (h0 + q) * 64 + lane;
            const float m0 = wave_sum(y0[q]) * (1.f / 64.f), m1 = wave_sum(y1[q]) * (1.f / 64.f); const float d0 = y0[q] - m0, d1 = y1[q] - m1;
            const float r0 = 1.f / sqrtf(wave_sum(d0 * d0) * (1.f / 64.f) + EPS), r1 = 1.f / sqrtf(wave_sum(d1 * d1) * (1.f / 64.f) + EPS);
            Y[(size_t)t * 4 * W + 3 * W + ch] = (bf16_t)f2bf((d0 * r0 + d1 * r1 + bs[q] * vv[q]) * gv[q]); }
    }
}
__device__ __forceinline__ void ph_router(const Ctx& c, int l, float* ldsf, const float* X, const float* gN, const float* shN, const float* scN) {
    const float* RS = WSF(O_HF); const bf16_t* WH = WSH(O_WRH); const bf16_t* WL = WSH(O_WRL); const float* bg = c.in[31] + (size_t)l * 4; const float* be = c.in[33] + (size_t)l * 32;
    int* EID = WSI(O_EID); float* EWT = WSF(O_EWT); int* cnt = CTLW(c) + CW_CNT + l * 64;
    const int tid = threadIdx.x, wv = tid >> 6, lane = tid & 63, fr = lane & 15, fq = lane >> 4, rt = wv & 1, kq = wv >> 1;
    float* part = ldsf;
    for (int u = blockIdx.x; u < T / 32; u += gridDim.x) {
        const long t0 = (long)u * 32; f32x4 acc[3];
#pragma unroll
        for (int nt = 0; nt < 3; ++nt) acc[nt] = (f32x4){0.f, 0.f, 0.f, 0.f};
#ifdef CPU_EMU
        for (int nt = 0; nt < 3; ++nt) for (int r = 0; r < 4; ++r) { const int n = 16 * nt + 4 * fq + r; float sacc = 0.f;
            for (int k = kq * 512; k < kq * 512 + 512; ++k) { const long tr = t0 + 16 * rt + fr; const int bb = (int)(tr / S); const float hv = X[(size_t)tr * D + k] * RS[tr] * gN[k] * (1.f + scN[bb * D6 + k]) + shN[bb * D6 + k]; const float hh = bf2f((bf16_t)f2bf(hv)), hl = bf2f((bf16_t)f2bf(hv - hh));
                const float wh = bf2f(WH[(size_t)n * D + k]), wl = bf2f(WL[(size_t)n * D + k]); sacc += hh * wh + hl * wh + hh * wl; }
            acc[nt][r] = sacc; }
#else
        const long tr = t0 + 16 * rt + fr; const int bb = (int)(tr / S); const float rsv = RS[tr]; const int kb = kq * 512 + fq * 8;
        const float* hp = X + (size_t)tr * D + kb; const float* gp_ = gN + kb; const float* scp = scN + bb * D6 + kb; const float* shp = shN + bb * D6 + kb;
#pragma unroll 4
        for (int ks = 0; ks < 16; ++ks) {
            const f32x4 h0 = *(const f32x4*)(hp + ks * 32) * rsv * *(const f32x4*)(gp_ + ks * 32) * (*(const f32x4*)(scp + ks * 32) + 1.f) + *(const f32x4*)(shp + ks * 32);
            const f32x4 h1 = *(const f32x4*)(hp + ks * 32 + 4) * rsv * *(const f32x4*)(gp_ + ks * 32 + 4) * (*(const f32x4*)(scp + ks * 32 + 4) + 1.f) + *(const f32x4*)(shp + ks * 32 + 4); bf16x8 ah, al;
#pragma unroll
            for (int e = 0; e < 4; ++e) { const unsigned b0 = f2bf(h0[e]), b1 = f2bf(h1[e]); ah[e] = (short)b0; ah[4 + e] = (short)b1; al[e] = (short)f2bf(h0[e] - u2f_(b0 << 16)); al[4 + e] = (short)f2bf(h1[e] - u2f_(b1 << 16)); }
#pragma unroll
            for (int nt = 0; nt < 3; ++nt) { const size_t wo = (size_t)(16 * nt + fr) * D + kq * 512 + ks * 32 + fq * 8; const bf16x8 bh = *(const bf16x8*)(WH + wo), bl = *(const bf16x8*)(WL + wo);
                acc[nt] = __builtin_amdgcn_mfma_f32_16x16x32_bf16(bh, ah, acc[nt], 0, 0, 0); acc[nt] = __builtin_amdgcn_mfma_f32_16x16x32_bf16(bh, al, acc[nt], 0, 0, 0); acc[nt] = __builtin_amdgcn_mfma_f32_16x16x32_bf16(bl, ah, acc[nt], 0, 0, 0); }
        }
#endif
#pragma unroll
        for (int nt = 0; nt < 3; ++nt) *(f32x4*)(part + (kq * 32 + 16 * rt + fr) * 48 + 16 * nt + 4 * fq) = acc[nt];
        SYNCTHREADS();
        if (tid < 32) { const long t = t0 + tid; float lg[36];
#pragma unroll
            for (int q = 0; q < 36; ++q) lg[q] = (part[(0 * 32 + tid) * 48 + q] + part[(1 * 32 + tid) * 48 + q]) + (part[(2 * 32 + tid) * 48 + q] + part[(3 * 32 + tid) * 48 + q]) + (q < 4 ? bg[q < 4 ? q : 0] : be[q >= 4 ? q - 4 : 0]);
            int gi = 0; float m = lg[0];
#pragma unroll
            for (int q = 1; q < 4; ++q) if (lg[q] > m) { m = lg[q]; gi = q; }
            float den = 0.f;
#pragma unroll
            for (int q = 0; q < 4; ++q) den += expf(lg[q] - m);
            const float gp = 1.f / den; float el[8];
#pragma unroll
            for (int q = 0; q < 8; ++q) el[q] = gi == 0 ? lg[4 + q] : gi == 1 ? lg[12 + q] : gi == 2 ? lg[20 + q] : lg[28 + q];
            int i1 = 0; float m1 = el[0];
#pragma unroll
            for (int q = 1; q < 8; ++q) if (el[q] > m1) { m1 = el[q]; i1 = q; }
            int i2 = -1; float m2 = 0.f;
#pragma unroll
            for (int q = 0; q < 8; ++q) if (q != i1 && (i2 < 0 || el[q] > m2)) { m2 = el[q]; i2 = q; }
            const float p2 = expf(m2 - m1);
            EID[t * 2] = gi * 8 + i1; EID[t * 2 + 1] = gi * 8 + i2; EWT[t * 2] = gp / (1.f + p2); EWT[t * 2 + 1] = gp * p2 / (1.f + p2);
            atomic_add_i(cnt + gi * 8 + i1, 1); atomic_add_i(cnt + gi * 8 + i2, 1);
        }
        SYNCTHREADS();
    }
}
__device__ __forceinline__ void ph_moe_plan(const Ctx& c, int l) {
    int* cnt = CTLW(c) + CW_CNT + l * 64; int* plan = CTLW(c) + CW_PLAN + l * 256;
    if (GT_ == 0) {
        int ps = 0, nb = 0;
        for (int e = 0; e < NE; ++e) { plan[e] = ps; const int nblk = (cnt[e] + 255) / 256; for (int q = 0; q < nblk; ++q) plan[64 + nb++] = e; ps += nblk * 256; }
        plan[32] = ps; plan[40] = nb;
    }
}
__device__ __forceinline__ void ph_moe_assign(const Ctx& c, int l) {
    const int* EID = WSI(O_EID); int* fill = CTLW(c) + CW_FILL + l * 64; const int* plan = CTLW(c) + CW_PLAN + l * 256; int* DEST = WSI(O_DEST);
    for (long i = GT_; i < (long)T * 2; i += GS_) { const int e = EID[i]; const int pos = atomic_add_i(fill + e, 1); DEST[i] = plan[e] + pos; }
}
__device__ __forceinline__ void ph_moe_gather(const Ctx& c) {
    const int* DEST = WSI(O_DEST); const u32x4* H = (const u32x4*)WSH(O_H); u32x4* XS = (u32x4*)WSH(O_XS);
    for (long i = GT_; i < (long)T * 2 * (D / 8); i += GS_) { const int q = (int)(i % (D / 8)); const long a = i / (D / 8); XS[(size_t)DEST[a] * (D / 8) + q] = H[(size_t)(a >> 1) * (D / 8) + q]; }
}
#ifndef CPU_EMU
#define XB_TMO      128
#define XB_XCNT(j)  (256  + 64 * (j))
#define XB_XSUB(j)  (1280 + 64 * (j))
#define XB_XGEN(j)  (2304 + 64 * (j))
#define XB_TOP      3328
#define XB_TOPGEN   3392
#define XCD_BAR_WORDS 3456
#define XB_SPIN_CAP (1u << 26)
#define LAS __attribute__((address_space(3)))
__device__ __forceinline__ unsigned xb_ld(unsigned* p)              { return __hip_atomic_load(p, __ATOMIC_RELAXED, __HIP_MEMORY_SCOPE_AGENT); }
__device__ __forceinline__ unsigned xb_add(unsigned* p, unsigned v) { return __hip_atomic_fetch_add(p, v, __ATOMIC_RELAXED, __HIP_MEMORY_SCOPE_AGENT); }
__device__ __forceinline__ unsigned xb_xcc_id() { return (unsigned)__builtin_amdgcn_s_getreg((3 << 11) | 20) & 0xFu; }
#define XB_SPIN(cond, bar) do { unsigned _sp = 0; while (cond) { __builtin_amdgcn_s_sleep(1); \
    if ((++_sp & 255u) == 0u) { if (xb_ld(&(bar)[XB_TMO])) break; if (_sp > XB_SPIN_CAP) { atomicAdd(&(bar)[XB_TMO], 1u); break; } } } } while (0)
struct XcdBarrier { unsigned* bar; unsigned x; volatile LAS unsigned* st; };
__device__ __forceinline__ XcdBarrier xcd_barrier_post(unsigned* bar, volatile LAS unsigned* st) {
    XcdBarrier b; b.bar = bar; b.x = xb_xcc_id(); b.st = st;
    if (threadIdx.x == 0) (void)xb_add(&bar[XB_XCNT(b.x)], 1u);
    return b;
}
__device__ __forceinline__ void xcd_barrier_complete(unsigned* bar, unsigned x, unsigned& nloc, unsigned& nx) {
    const unsigned G = gridDim.x * gridDim.y * gridDim.z;
    unsigned sum, cnt, mine, sp = 0u;
    for (;;) {
        sum = 0u; cnt = 0u; mine = 0u;
#pragma unroll
        for (unsigned j = 0; j < 16; ++j) { const unsigned cc = xb_ld(&bar[XB_XCNT(j)]); sum += cc; cnt += (cc > 0u) ? 1u : 0u; mine = (j == x) ? cc : mine; }
        if (sum == G) break;
        __builtin_amdgcn_s_sleep(1);
        if ((++sp & 255u) == 0u) { if (xb_ld(&bar[XB_TMO])) break; if (sp > XB_SPIN_CAP) { atomicAdd(&bar[XB_TMO], 1u); break; } }
    }
    nloc = mine > 0u ? mine : 1u; nx = cnt > 0u ? cnt : 1u;
}
__device__ __forceinline__ void xcd_barrier(const XcdBarrier& b) {
    asm volatile("s_waitcnt vmcnt(0)" ::: "memory");
    __syncthreads();
    if (threadIdx.x == 0) {
        unsigned* bar = b.bar;
        __builtin_amdgcn_s_waitcnt(0);
        unsigned nloc = b.st[0], nx = b.st[1];
        if (nloc == 0u) { xcd_barrier_complete(bar, b.x, nloc, nx); b.st[0] = nloc; b.st[1] = nx; }
        const unsigned old = xb_add(&bar[XB_XSUB(b.x)], 1u);
        const unsigned gen = old / nloc;
        if (old + 1u == (gen + 1u) * nloc) {
            __builtin_amdgcn_fence(__ATOMIC_RELEASE, "agent");
            asm volatile("s_waitcnt vmcnt(0)" ::: "memory");
            const unsigned og = xb_add(&bar[XB_TOP], 1u);
            const unsigned tg = og / nx;
            if (og + 1u == (tg + 1u) * nx) xb_add(&bar[XB_TOPGEN], 1u);
            else XB_SPIN(xb_ld(&bar[XB_TOPGEN]) == tg, bar);
            __builtin_amdgcn_fence(__ATOMIC_ACQUIRE, "agent");
            xb_add(&bar[XB_XGEN(b.x)], 1u);
            asm volatile("s_waitcnt vmcnt(0)" ::: "memory");
        } else {
            XB_SPIN(xb_ld(&bar[XB_XGEN(b.x)]) == gen, bar);
            __builtin_amdgcn_fence(__ATOMIC_ACQUIRE, "agent");
            asm volatile("s_waitcnt vmcnt(0)" ::: "memory");
        }
    }
    __syncthreads();
}
#endif

constexpr int LDS_BYTES = 147456;

__global__ void __launch_bounds__(NT, 2) fwd(Params p) {
#ifdef CPU_EMU
    unsigned char* lds = g_lds; float* ldsf = (float*)g_lds;
#else
    extern __shared__ __attribute__((aligned(16))) unsigned char lds[];
    float* ldsf = (float*)lds;
    volatile LAS unsigned* misc = (volatile LAS unsigned*)((LAS unsigned char*)lds + LDS_BYTES - 64);
    if (threadIdx.x == 0) { misc[0] = 0u; misc[1] = 0u; }
    __syncthreads();
    XcdBarrier bar = xcd_barrier_post((unsigned*)(p.ws + O_CTL) + CW_BAR, misc);
#endif
    Ctx c; c.in = p.in; c.out = p.out; c.ws = p.ws;
    const int lo = p.ph_lo, hi = p.ph_hi; int ph = 0;
    const int G = (int)gridDim.x, cwg = (int)blockIdx.x;
#ifdef CPU_EMU
#define GRID_BAR()
#else
#define GRID_BAR() xcd_barrier(bar)
#endif
#ifndef REPEAT_MASK
#define REPEAT_MASK 0
#endif
#ifndef TIME_PHASE
#define TIME_PHASE -1
#endif
#if TIME_PHASE >= 0 && !defined(CPU_EMU)
    unsigned long long tp0 = 0, tp1 = 0;
#define TP_BEGIN() do { if (ph == TIME_PHASE) tp0 = __builtin_amdgcn_s_memrealtime(); } while (0)
#define TP_END() do { if (ph == TIME_PHASE) tp1 = __builtin_amdgcn_s_memrealtime(); } while (0)
#else
#define TP_BEGIN()
#define TP_END()
#endif
#define PHASE(...) do { if (lo <= ph && ph < hi) { TP_BEGIN(); __VA_ARGS__; if (ph + 1 < hi) { GRID_BAR(); } TP_END(); } ++ph; } while (0)
#define PHASEG(grp, ...) do { if (lo <= ph && ph < hi) { TP_BEGIN(); if ((REPEAT_MASK >> (grp)) & 1) { __VA_ARGS__; GRID_BAR(); } __VA_ARGS__; if (ph + 1 < hi) { GRID_BAR(); } TP_END(); } ++ph; } while (0)
    PHASE(ph_mod(c, ldsf));
#define LAYER_BODY(l) do { const float* mod = WSF(O_MOD); \
        const float* xin = l == 0 ? c.in[0] : WSF(O_X1); float* xmid = WSF(O_X0); float* xout = WSF(O_X1); \
        const float* ml = mod + (size_t)l * NB * D6; \
        PHASEG(3, ph_convert(c, l, ldsf)); \
        PHASEG(0, { pg8::Gemm g{D, D, D}; pg8::StaticOrder so; so.init(T, PW, G, cwg, WSH(O_H), WSH(O_WIN), D, D); pg8::EpiP E{WSH(O_P), (unsigned char*)(c.ws + O_G8)}; pg8::gemm_phase(lds, g, so, E); \
            { const int nun_ = (T / 256) * (PW / 256), rem_ = nun_ % G; if (rem_ != 0 && cwg >= rem_) { SYNCTHREADS(); convert_big(c, l, ldsf, J_ALL - convert_tail_tiles(), J_ALL, cwg - rem_, G - rem_); } } }); \
        PHASE(ph_lru<1>(c, l, ldsf); ph_ret_kv(c, ldsf); ph_sgu_norm(c, l); ph_rw_shift(c, l)); \
        PHASE(ph_lru_scan2(c); ph_ret_state(c); ph_sgu_mix(c, l, ldsf); ph_rw_lora(c, l, ldsf)); \
        PHASE(ph_lru<2>(c, l, ldsf); ph_ret_out(c, ldsf); ph_rw_chunk(c, l, ldsf)); \
        PHASE(ph_rw_seq(c, ldsf)); \
        PHASE(ph_rw_out(c)); \
        PHASEG(1, { pg8::Gemm g{W, 4 * W, 4 * W}; pg8::MergeOrder mo; mo.so.init(T, D, G, cwg, WSH(O_YS), WSH(O_WBR), 4 * W, 4 * W); mo.kseg_bytes = W * 2; pg8::EpiMerge E{(const unsigned char*)(c.ws + O_G8), WSH(O_MRG)}; pg8::gemm_phase(lds, g, mo, E); }); \
        PHASEG(1, { pg8::Gemm g{D, D, D}; pg8::StaticOrder so; so.init(T, D, G, cwg, WSH(O_MRG), WSH(O_WOUT), D, D); pg8::EpiResid E{xin, ml + 2 * D, xmid}; pg8::gemm_phase(lds, g, so, E); }); \
        PHASEG(6, ph_norm(c, xmid, c.in[4] + (size_t)l * D, ml + 3 * D, ml + 4 * D, WSH(O_H), WSF(O_HF))); \
        PHASE(ph_router(c, l, ldsf, xmid, c.in[4] + (size_t)l * D, ml + 3 * D, ml + 4 * D)); \
        PHASE(ph_moe_plan(c, l)); \
        PHASE(ph_moe_assign(c, l)); \
        PHASEG(6, ph_moe_gather(c)); \
        const int* plan = CTLW(c) + CW_PLAN + l * 256; \
        PHASEG(2, { pg8::Gemm g{D, D, D}; pg8::MoeOrder mo{G, cwg, 4, plan, (const char*)WSH(O_XS), (const char*)WSH(O_WGU), (size_t)256 * D * 2, (size_t)256 * D * 2, (size_t)1024 * D * 2}; pg8::EpiGU E{WSH(O_ACT)}; pg8::gemm_phase(lds, g, mo, E); \
            if (l == 0) { const int nrest_ = plan[40] * 4 - G; if (nrest_ >= 0 && nrest_ < G && cwg >= nrest_) { SYNCTHREADS(); convert_big(c, 1, ldsf, 0, convert_early_tiles(c), cwg - nrest_, G - nrest_); } } }); \
        PHASEG(2, { pg8::Gemm g{512, 512, 512}; pg8::MoeOrder mo{G, cwg, 8, plan, (const char*)WSH(O_ACT), (const char*)WSH(O_WDN), (size_t)256 * 512 * 2, (size_t)256 * 512 * 2, (size_t)D * 512 * 2}; pg8::EpiBf16 E{WSH(O_YE), D}; pg8::gemm_phase(lds, g, mo, E); }); \
        if (l == 0) PHASE(ph_comb_norm<0>(c, xmid, ml + 5 * D, xout, c.in[3] + (size_t)1 * D, mod + (size_t)1 * NB * D6 + 0 * D, mod + (size_t)1 * NB * D6 + 1 * D, WSH(O_H), nullptr)); \
        else PHASE(ph_comb_norm<1>(c, xmid, ml + 5 * D, xout, c.in[36], nullptr, nullptr, nullptr, c.out)); \
    } while (0)
    PHASE(ph_norm(c, c.in[0], c.in[3], WSF(O_MOD) + 0 * D, WSF(O_MOD) + 1 * D, WSH(O_H), nullptr));
    LAYER_BODY(0);
    LAYER_BODY(1);
#undef LAYER_BODY
#if TIME_PHASE >= 0 && !defined(CPU_EMU)
    if (blockIdx.x == 0) { const unsigned long long te = __builtin_amdgcn_s_memrealtime(), dl = 8ull * (tp1 - tp0); while (__builtin_amdgcn_s_memrealtime() - te < dl) __builtin_amdgcn_s_sleep(8); }
#endif
#undef PHASE
}
}

#ifndef CPU_EMU
extern "C" void kernel_launch(void* const* d_in, const int* in_sizes, int n_in, void* d_out, int out_size, void* d_ws, size_t ws_size, hipStream_t stream) {
    static int grid = 0;
    if (grid == 0) {
        if (n_in != 37 || out_size != T * D || ws_size < WS_END) { fprintf(stderr, "kernel_launch: unexpected shapes (n_in %d out %d ws %zu need %zu)\n", n_in, out_size, ws_size, (size_t)WS_END); grid = -1; return; }
        int dev = 0, cus = 0, per_cu = 0;
        if (hipGetDevice(&dev) != hipSuccess || hipDeviceGetAttribute(&cus, hipDeviceAttributeMultiprocessorCount, dev) != hipSuccess) { grid = -1; return; }
        if (hipFuncSetAttribute((const void*)fwd, hipFuncAttributeMaxDynamicSharedMemorySize, LDS_BYTES) != hipSuccess) { fprintf(stderr, "kernel_launch: hipFuncSetAttribute failed\n"); grid = -1; return; }
        if (hipOccupancyMaxActiveBlocksPerMultiprocessor(&per_cu, (const void*)fwd, NT, LDS_BYTES) != hipSuccess || per_cu < 1) fprintf(stderr, "kernel_launch: occupancy query says %d\n", per_cu);
        (void)hipGetLastError();
        grid = cus;
    }
    if (grid < 0) return;
    (void)in_sizes;
    (void)hipMemsetAsync((char*)d_ws + O_CTL, 0, CTL_BYTES, stream);
    Params p{};
    for (int i = 0; i < 37; ++i) p.in[i] = (const float*)d_in[i];
    p.out = (float*)d_out; p.ws = (unsigned char*)d_ws;
#if ONE_LAUNCH
    p.ph_lo = 0; p.ph_hi = NPH;
    hipLaunchKernelGGL(fwd, dim3(grid), dim3(NT), LDS_BYTES, stream, p);
#else
    for (int k = 0; k < NPH; ++k) { p.ph_lo = k; p.ph_hi = k + 1; hipLaunchKernelGGL(fwd, dim3(grid), dim3(NT), LDS_BYTES, stream, p); }
#endif
}
#endif
```

```cpp
#ifndef CPU_EMU
#include <hip/hip_runtime.h>
#endif
#include <cstdio>
#include <cstdint>
#include <cmath>
#include <cstring>

#ifndef SEQ
#define SEQ 4096
#endif
#ifndef ONE_LAUNCH
#define ONE_LAUNCH 1
#endif

namespace {
constexpr int D = 2048, NB = 2, S = SEQ, T = NB * S, NL = 2, W = 1024;
constexpr int INW = 18816, RF = 3456, D6 = 6 * D;
constexpr int C_LX = 0, C_LG = 1024, C_RQ = 2048, C_RK = 2560, C_RV = 3072, C_RG = 4096, C_SU = 5120, C_SV = 6144, C_RW = 7168;
constexpr int PW = 18944, C_MLP = 10752;
constexpr int NCH = S / 128;
constexpr int NLC = S / 64;
constexpr int NE = 32, CAP = (T * 2 / 256 + NE) * 256, MAXBLK = CAP / 256;
constexpr float EPS = 1e-6f;
constexpr float DECAY_SCALE = 0.60653065971263342f;
constexpr int NT = 512;
constexpr int NPH_LAYER = 17, NPH = 2 + NL * NPH_LAYER;
typedef unsigned short bf16_t;
#ifdef CPU_EMU
typedef float f32x4 __attribute__((vector_size(16)));
typedef unsigned u32x4 __attribute__((vector_size(16)));
#else
typedef float f32x4 __attribute__((ext_vector_type(4)));
typedef unsigned u32x4 __attribute__((ext_vector_type(4)));
typedef short bf16x8 __attribute__((ext_vector_type(8)));
#endif

constexpr size_t al256(size_t x) { return (x + 255) & ~(size_t)255; }
constexpr size_t SZ_X = (size_t)T * D * 4, SZ_W = (size_t)T * W * 4;
constexpr size_t O_CTL = 0, CTL_BYTES = 1u << 20;
constexpr size_t O_MOD = CTL_BYTES;
constexpr size_t O_X0 = O_MOD + al256((size_t)NL * NB * D6 * 4);
constexpr size_t O_X1 = O_X0 + SZ_X;
constexpr size_t O_H = O_X1 + SZ_X;
constexpr size_t O_HF = O_H + SZ_X / 2;
constexpr size_t O_P = O_HF + SZ_X;
constexpr size_t SZ_P = (size_t)T * PW * 2;
constexpr size_t O_XC = O_P + SZ_P;
constexpr size_t O_LA = O_XC + SZ_W, O_LU = O_LA + 2 * SZ_W;
constexpr size_t SZ_LC = (size_t)2 * NB * NLC * W * 4;
constexpr size_t O_LCA = O_LU + 2 * SZ_W, O_LCH = O_LCA + SZ_LC, O_LCI = O_LCH + SZ_LC;
constexpr size_t O_YS = O_LCI + SZ_LC;
constexpr size_t O_SC = O_YS + (size_t)T * 4 * W * 2;
constexpr size_t SZ_KV = (size_t)NB * NCH * 8 * 64 * 128 * 4;
constexpr size_t O_KVF = O_SC, O_KVB = O_KVF + SZ_KV, O_STF = O_KVB + SZ_KV, O_STB = O_STF + SZ_KV;
constexpr size_t O_VN = O_STB + SZ_KV;
constexpr size_t O_FS = O_VN + SZ_W;
constexpr size_t O_DEC = O_FS + al256((size_t)T * RF * 4), O_AA = O_DEC + 2 * SZ_W, O_AKK = O_AA + 2 * SZ_W;
constexpr size_t O_GG = O_AKK, O_YY = O_GG + SZ_W;
constexpr int RCK = 64, NRC = S / RCK;
constexpr size_t O_BON = O_YY + 2 * SZ_W;
constexpr size_t O_PART = O_BON + al256((size_t)2 * T * 16 * 4);
constexpr size_t O_MRG = O_PART + SZ_X;
constexpr size_t O_LOG = O_MRG + SZ_X / 2;
constexpr size_t O_EID = O_LOG + al256((size_t)T * 40 * 4), O_EWT = O_EID + al256((size_t)T * 2 * 4), O_DEST = O_EWT + al256((size_t)T * 2 * 4);
constexpr size_t O_SLOT = O_DEST + al256((size_t)T * 2 * 4);
constexpr size_t O_PST = O_SLOT + al256((size_t)CAP * 4), O_PYT = O_PST + (size_t)64 * NRC * 4096 * 2, O_SVB = O_PYT + (size_t)64 * NRC * 4096 * 2, O_YVB = O_SVB + (size_t)64 * NRC * 4096 * 4;
constexpr size_t O_WIN = O_YVB + (size_t)64 * NRC * 4096 * 4;
constexpr size_t O_WBR = O_WIN + (size_t)PW * D * 2;
constexpr size_t O_WOUT = O_WBR + (size_t)D * 4 * W * 2;
constexpr size_t O_WGU = O_WOUT + (size_t)D * D * 2;
constexpr size_t O_WDN = O_WGU + (size_t)NE * 1024 * D * 2;
constexpr size_t O_G8 = O_WDN + (size_t)NE * D * 512 * 2;
constexpr size_t O_ROPE = O_G8 + (size_t)T * 4 * D;
constexpr size_t O_WLR = O_ROPE + (size_t)T * 64 * 4;
constexpr size_t O_WUT = O_WLR + (size_t)32 * 128 * 128 * 2;
constexpr size_t O_WAT = O_WUT + (size_t)2 * W * 64 * 2;
constexpr size_t O_WGT = O_WAT + (size_t)2 * W * 64 * 2;
constexpr size_t O_WRH = O_WGT + (size_t)W * 128 * 2;
constexpr size_t O_WRL = O_WRH + (size_t)48 * D * 2;
constexpr size_t WS_END0 = O_WRL + (size_t)48 * D * 2;
constexpr size_t SZ_MOE = (size_t)CAP * (D + 512 + D) * 2;
constexpr bool MOE_OVERLAY = SZ_MOE <= SZ_P;
constexpr size_t O_XS = MOE_OVERLAY ? O_P : WS_END0;
constexpr size_t O_ACT = O_XS + (size_t)CAP * D * 2;
constexpr size_t O_YE = O_ACT + (size_t)CAP * 512 * 2;
constexpr size_t WS_END = MOE_OVERLAY ? WS_END0 : WS_END0 + SZ_MOE;
static_assert(SEQ != 4096 || WS_END <= (size_t)2040 * 1024 * 1024, "workspace budget: d_ws is 4 x the largest input = 2048 MiB");
constexpr int CW_BAR = 4096;
constexpr int CW_CNT = 32768;
constexpr int CW_FILL = CW_CNT + NL * 64;
constexpr int CW_PLAN = CW_FILL + NL * 64;
static_assert(MAXBLK <= 160, "plan words");

struct Params { const float* in[37]; float* out; unsigned char* ws; int ph_lo, ph_hi; };

struct Ctx { const float* const* in; float* out; unsigned char* ws; };
#define GT_ ((long)blockIdx.x * NT + threadIdx.x)
#define GS_ ((long)gridDim.x * NT)
#define WSF(off) ((float*)(c.ws + (off)))
#define WSI(off) ((int*)(c.ws + (off)))
#define WSH(off) ((bf16_t*)(c.ws + (off)))
#define CTLW(c) ((int*)((c).ws + O_CTL))

#ifdef CPU_EMU
__device__ __forceinline__ float fexp_(float x) { return expf(x); }
__device__ __forceinline__ float frcp_(float x) { return 1.f / x; }
__device__ __forceinline__ float frsq_(float x) { return 1.f / sqrtf(x); }
#else
__device__ __forceinline__ float fexp_(float x) { return __builtin_amdgcn_exp2f(x * 1.4426950408889634f); }
__device__ __forceinline__ float frcp_(float x) { return __builtin_amdgcn_rcpf(x); }
__device__ __forceinline__ float frsq_(float x) { return __builtin_amdgcn_rsqf(x); }
#endif
__device__ __forceinline__ float sigmoidf_(float x) { return frcp_(1.f + fexp_(-x)); }
__device__ __forceinline__ float siluf_(float x) { return x * frcp_(1.f + fexp_(-x)); }
__device__ __forceinline__ float tanhf_(float x) { return 1.f - 2.f * frcp_(1.f + fexp_(2.f * x)); }
__device__ __forceinline__ float geluf_(float x) { return 0.5f * x * (1.f + tanhf_(0.7978845608028654f * (x + 0.044715f * x * x * x))); }
__device__ __forceinline__ float softplusf_(float x) { return x > 0.f ? x + log1pf(expf(-x)) : log1pf(expf(x)); }
__device__ __forceinline__ float loggamma_(int h) { return log1pf(-exp2f(-5.f - (float)h)); }
__device__ __forceinline__ unsigned f2u_(float f) { unsigned u; memcpy(&u, &f, 4); return u; }
__device__ __forceinline__ float u2f_(unsigned u) { float f; memcpy(&f, &u, 4); return f; }
__device__ __forceinline__ float bf2f(bf16_t v) { return u2f_((unsigned)v << 16); }
__device__ __forceinline__ unsigned f2bf(float f) { const unsigned u = f2u_(f); return (u + 0x7fffu + ((u >> 16) & 1u)) >> 16; }
__device__ __forceinline__ unsigned pk2(float lo, float hi) { return f2bf(lo) | (f2bf(hi) << 16); }
__device__ __forceinline__ float bflo(unsigned w) { return u2f_(w << 16); }
__device__ __forceinline__ float bfhi(unsigned w) { return u2f_(w & 0xffff0000u); }
__device__ __forceinline__ int atomic_add_i(int* p, int v) {
#ifdef CPU_EMU
    return __atomic_fetch_add(p, v, __ATOMIC_RELAXED);
#else
    return atomicAdd(p, v);
#endif
}
#define PF(P, r, col) bf2f((P)[(size_t)(r) * PW + (col)])
#ifdef CPU_EMU
#define SYNCTHREADS() emu_syncthreads()
#define SHFL_XOR(v, m) emu_shfl_xor(v, m)
#else
#define SYNCTHREADS() __syncthreads()
#define SHFL_XOR(v, m) __shfl_xor(v, m)
#endif
#ifdef CPU_EMU
__device__ __forceinline__ float wave_sum(float v) {
    for (int o = 1; o < 64; o <<= 1) v += SHFL_XOR(v, o);
    return v;
}
#else
__device__ __forceinline__ float wave_sum(float x) {
    x += __builtin_bit_cast(float, __builtin_amdgcn_update_dpp(0, __builtin_bit_cast(int, x), 0xB1, 0xF, 0xF, true));
    x += __builtin_bit_cast(float, __builtin_amdgcn_update_dpp(0, __builtin_bit_cast(int, x), 0x4E, 0xF, 0xF, true));
    x += __builtin_bit_cast(float, __builtin_amdgcn_update_dpp(0, __builtin_bit_cast(int, x), 0x141, 0xF, 0xF, true));
    x += __builtin_bit_cast(float, __builtin_amdgcn_update_dpp(0, __builtin_bit_cast(int, x), 0x140, 0xF, 0xF, true));
    const int xi = __builtin_bit_cast(int, x);
    return (__builtin_bit_cast(float, __builtin_amdgcn_readlane(xi, 0)) + __builtin_bit_cast(float, __builtin_amdgcn_readlane(xi, 16))) + (__builtin_bit_cast(float, __builtin_amdgcn_readlane(xi, 32)) + __builtin_bit_cast(float, __builtin_amdgcn_readlane(xi, 48)));
}
#endif
__device__ __forceinline__ f32x4 ld_bf4(const bf16_t* p) { const unsigned long long q = *(const unsigned long long*)p; const unsigned lo = (unsigned)q, hi = (unsigned)(q >> 32); return (f32x4){bflo(lo), bfhi(lo), bflo(hi), bfhi(hi)}; }
__device__ __forceinline__ void st_bf4(bf16_t* p, const f32x4 v) { *(unsigned long long*)p = (unsigned long long)pk2(v[0], v[1]) | ((unsigned long long)pk2(v[2], v[3]) << 32); }

template <int KT, int NTL>
__device__ __forceinline__ void wave_mma(f32x4 (&acc)[NTL], const bf16_t* A, int lda, const bf16_t* Bt, int ldb) {
    const int lane = threadIdx.x & 63, fr = lane & 15, fq = lane >> 4;
#ifdef CPU_EMU
    for (int nt = 0; nt < NTL; ++nt) for (int r = 0; r < 4; ++r) { float sacc = 0.f; const bf16_t* a = A + fr * lda; const bf16_t* b = Bt + (16 * nt + 4 * fq + r) * ldb;
        for (int k = 0; k < 32 * KT; ++k) sacc += bf2f(a[k]) * bf2f(b[k]);
        acc[nt][r] += sacc; }
#else
#pragma unroll
    for (int kt = 0; kt < KT; ++kt) {
        const bf16x8 af = *(const bf16x8*)(A + fr * lda + kt * 32 + fq * 8);
#pragma unroll
        for (int nt = 0; nt < NTL; ++nt) { const bf16x8 bfr = *(const bf16x8*)(Bt + (16 * nt + fr) * ldb + kt * 32 + fq * 8);
            acc[nt] = __builtin_amdgcn_mfma_f32_16x16x32_bf16(bfr, af, acc[nt], 0, 0, 0); }
    }
#endif
}
__device__ __forceinline__ void ph_mod(const Ctx& c, float* ldsf) {
    const float* cc = c.in[1]; const float* aw = c.in[5]; const float* ab = c.in[6]; float* mod = WSF(O_MOD);
    float* scs = ldsf; float* part = ldsf + NB * D; const int tid = threadIdx.x, c4 = (tid & 31) * 4, kq = tid >> 5;
    for (int i = tid; i < NB * D; i += NT) scs[i] = siluf_(cc[i]);
    SYNCTHREADS();
    for (int u = blockIdx.x; u < NL * (D6 / 128); u += gridDim.x) {
        const int l = u / (D6 / 128), j0 = (u % (D6 / 128)) * 128;
        const float* w = aw + (size_t)l * D * D6 + j0 + c4; f32x4 a0 = (f32x4){0.f, 0.f, 0.f, 0.f}, a1 = a0;
#pragma unroll 8
        for (int k = kq * 128; k < kq * 128 + 128; ++k) { const f32x4 wv = *(const f32x4*)(w + (size_t)k * D6); a0 += wv * scs[k]; a1 += wv * scs[D + k]; }
        *(f32x4*)(part + (kq * 2 + 0) * 128 + c4) = a0; *(f32x4*)(part + (kq * 2 + 1) * 128 + c4) = a1;
        SYNCTHREADS();
        if (tid < 256) { const int b = tid >> 7, col = tid & 127; float sacc = 0.f;
#pragma unroll
            for (int q = 0; q < 16; ++q) sacc += part[(q * 2 + b) * 128 + col];
            mod[((size_t)l * NB + b) * D6 + j0 + col] = sacc + ab[l * D6 + j0 + col]; }
        SYNCTHREADS();
    }
}
__device__ __forceinline__ void ph_norm(const Ctx& c, const float* x, const float* g, const float* sh, const float* sc, bf16_t* hb, float* hf) {
    const int lane = threadIdx.x & 63, gw = blockIdx.x * (NT / 64) + (threadIdx.x >> 6), ngw = gridDim.x * (NT / 64);
    for (int t0 = gw * 2; t0 < T; t0 += ngw * 2) {
        f32x4 v[2][8]; float ss[2] = {0.f, 0.f};
#pragma unroll
        for (int r = 0; r < 2; ++r)
#pragma unroll
            for (int j = 0; j < 8; ++j) v[r][j] = *(const f32x4*)(x + (size_t)(t0 + r) * D + (j * 64 + lane) * 4);
#pragma unroll
        for (int r = 0; r < 2; ++r) {
#pragma unroll
            for (int j = 0; j < 8; ++j) ss[r] += (v[r][j][0] * v[r][j][0] + v[r][j][1] * v[r][j][1]) + (v[r][j][2] * v[r][j][2] + v[r][j][3] * v[r][j][3]);
            const int t = t0 + r, b = t / S; const float rs = 1.f / sqrtf(wave_sum(ss[r]) * (1.f / D) + EPS);
#pragma unroll
            for (int j = 0; j < 8; ++j) { const int col = (j * 64 + lane) * 4;
                const f32x4 o = v[r][j] * rs * *(const f32x4*)(g + col) * (*(const f32x4*)(sc + b * D6 + col) + 1.f) + *(const f32x4*)(sh + b * D6 + col);
                st_bf4(hb + (size_t)t * D + col, o); }
            if (hf && lane == 0) hf[t] = rs;
        }
    }
}
template <int MODE>
__device__ __forceinline__ void ph_comb_norm(const Ctx& c, const float* xmid, const float* g2, float* xout, const float* g, const float* sh, const float* sc, bf16_t* hb, float* outp) {
    const bf16_t* YE = WSH(O_YE); const float* EWT = WSF(O_EWT); const int* DEST = WSI(O_DEST);
    const int lane = threadIdx.x & 63, gw = blockIdx.x * (NT / 64) + (threadIdx.x >> 6), ngw = gridDim.x * (NT / 64);
    for (int t = gw; t < T; t += ngw) {
        const int b = t / S; const float w0 = EWT[t * 2], w1 = EWT[t * 2 + 1]; const bf16_t* y0 = YE + (size_t)DEST[t * 2] * D; const bf16_t* y1 = YE + (size_t)DEST[t * 2 + 1] * D;
        f32x4 v[8]; float ss = 0.f;
#pragma unroll
        for (int j = 0; j < 8; ++j) { const int col = (j * 64 + lane) * 4;
            v[j] = *(const f32x4*)(xmid + (size_t)t * D + col) + *(const f32x4*)(g2 + b * D6 + col) * (ld_bf4(y0 + col) * w0 + ld_bf4(y1 + col) * w1);
            if (MODE == 0) *(f32x4*)(xout + (size_t)t * D + col) = v[j];
            ss += (v[j][0] * v[j][0] + v[j][1] * v[j][1]) + (v[j][2] * v[j][2] + v[j][3] * v[j][3]); }
        const float rs = 1.f / sqrtf(wave_sum(ss) * (1.f / D) + EPS);
#pragma unroll
        for (int j = 0; j < 8; ++j) { const int col = (j * 64 + lane) * 4;
            if (MODE == 0) st_bf4(hb + (size_t)t * D + col, v[j] * rs * *(const f32x4*)(g + col) * (*(const f32x4*)(sc + b * D6 + col) + 1.f) + *(const f32x4*)(sh + b * D6 + col));
            else *(f32x4*)(outp + (size_t)t * D + col) = v[j] * rs * *(const f32x4*)(g + col); }
    }
}

struct CvtItem { const float* Wp; int ldw; bf16_t* WT; int ldt; int drow, k0, n0; };
constexpr int I_IN = 32 * (INW / 32), I_BR = 4 * 16 * 64, I_OUT = 32 * 64, I_GU = NE * 32 * 32, I_DN = NE * 8 * 64, I_LR = 32 * 8, I_WU = 2 * 32, I_WG = 64, I_BIG = I_IN + I_BR + I_OUT + I_GU + I_DN, I_ALL = I_BIG + I_LR + 2 * I_WU + I_WG;
__device__ __forceinline__ CvtItem cvt_decode(const Ctx& c, int l, int it) {
    CvtItem r;
    if (it < I_IN) { const int kb = it / (INW / 32), nb = it % (INW / 32); r.n0 = nb * 32; r.k0 = kb * 64; r.Wp = c.in[7] + (size_t)l * D * INW; r.ldw = INW; r.WT = WSH(O_WIN); r.ldt = D; r.drow = r.n0 < 10624 ? r.n0 : r.n0 + 128; return r; }
    it -= I_IN;
    if (it < I_BR) { const int sgm = it / 1024, q = it % 1024, kb = q / 64, nb = q % 64; r.n0 = nb * 32; r.k0 = kb * 64; r.Wp = c.in[28] + ((size_t)l * 4 + sgm) * W * D; r.ldw = D; r.WT = WSH(O_WBR) + sgm * W; r.ldt = 4 * W; r.drow = r.n0; return r; }
    it -= I_BR;
    if (it < I_OUT) { const int kb = it / 64, nb = it % 64; r.n0 = nb * 32; r.k0 = kb * 64; r.Wp = c.in[29] + (size_t)l * D * D; r.ldw = D; r.WT = WSH(O_WOUT); r.ldt = D; r.drow = r.n0; return r; }
    it -= I_OUT;
    if (it < I_GU) { const int e = it / 1024, q = it % 1024, kb = q / 32, nb = q % 32; r.n0 = nb * 32; r.k0 = kb * 64; r.Wp = c.in[34] + ((size_t)l * NE + e) * D * 1024; r.ldw = 1024; r.WT = WSH(O_WGU) + (size_t)e * 1024 * D; r.ldt = D;
        r.drow = r.n0 < 512 ? (r.n0 / 128) * 256 + (r.n0 % 128) : ((r.n0 - 512) / 128) * 256 + 128 + ((r.n0 - 512) % 128); return r; }
    it -= I_GU;
    if (it < I_DN) { const int e = it / 512, q = it % 512, kb = q / 64, nb = q % 64; r.n0 = nb * 32; r.k0 = kb * 64; r.Wp = c.in[35] + ((size_t)l * NE + e) * 512 * D; r.ldw = D; r.WT = WSH(O_WDN) + (size_t)e * D * 512; r.ldt = 512; r.drow = r.n0; return r; }
    it -= I_DN;
    if (it < I_LR) { const int m = it / 8, q = it % 8, kb = q / 4, nb = q % 4, z = m >> 4, ty = (m >> 3) & 1, n = m & 7; r.n0 = nb * 32; r.k0 = kb * 64; r.Wp = c.in[ty ? 12 : 10] + (((size_t)l * 2 + z) * 8 + n) * 128 * 128; r.ldw = 128;
        r.WT = WSH(O_WLR) + (size_t)m * 128 * 128; r.ldt = 128; r.drow = r.n0; return r; }
    it -= I_LR;
    if (it < 2 * I_WU) { const int ua = it / I_WU, q = it % I_WU, z = q / 32, nb = q % 32; r.n0 = nb * 32; r.k0 = 0; r.Wp = c.in[ua ? 23 : 21] + ((size_t)l * 2 + z) * 64 * W; r.ldw = W; r.WT = WSH(ua ? O_WAT : O_WUT) + (size_t)z * W * 64; r.ldt = 64; r.drow = r.n0; return r; }
    it -= 2 * I_WU;
    { const int kb = it / 32, nb = it % 32; r.n0 = nb * 32; r.k0 = kb * 64; r.Wp = c.in[24] + (size_t)l * 128 * W; r.ldw = W; r.WT = WSH(O_WGT); r.ldt = 128; r.drow = r.n0; return r; }
}
constexpr int J_IN = 16 * (INW / 128), J_BR = 4 * 8 * 16, J_OUT = 16 * 16, J_GU = NE * 16 * 8, J_DN = NE * 4 * 16, J_ALL = J_IN + J_BR + J_OUT + J_GU + J_DN;
__device__ __forceinline__ CvtItem cvt_decode_big(const Ctx& c, int l, int it) {
    CvtItem r;
    if (it < J_IN) { const int kb = it / (INW / 128), nb = it % (INW / 128); r.n0 = nb * 128; r.k0 = kb * 128; r.Wp = c.in[7] + (size_t)l * D * INW; r.ldw = INW; r.WT = WSH(O_WIN); r.ldt = D; r.drow = r.n0 < 10624 ? r.n0 : r.n0 + 128; return r; }
    it -= J_IN;
    if (it < J_BR) { const int sgm = it / 128, q = it % 128, kb = q / 16, nb = q % 16; r.n0 = nb * 128; r.k0 = kb * 128; r.Wp = c.in[28] + ((size_t)l * 4 + sgm) * W * D; r.ldw = D; r.WT = WSH(O_WBR) + sgm * W; r.ldt = 4 * W; r.drow = r.n0; return r; }
    it -= J_BR;
    if (it < J_OUT) { const int kb = it / 16, nb = it % 16; r.n0 = nb * 128; r.k0 = kb * 128; r.Wp = c.in[29] + (size_t)l * D * D; r.ldw = D; r.WT = WSH(O_WOUT); r.ldt = D; r.drow = r.n0; return r; }
    it -= J_OUT;
    if (it < J_GU) { const int e = it / 128, q = it % 128, kb = q / 8, nb = q % 8; r.n0 = nb * 128; r.k0 = kb * 128; r.Wp = c.in[34] + ((size_t)l * NE + e) * D * 1024; r.ldw = 1024; r.WT = WSH(O_WGU) + (size_t)e * 1024 * D; r.ldt = D;
        r.drow = r.n0 < 512 ? (r.n0 / 128) * 256 : ((r.n0 - 512) / 128) * 256 + 128; return r; }
    it -= J_GU;
    { const int e = it / 64, q = it % 64, kb = q / 16, nb = q % 16; r.n0 = nb * 128; r.k0 = kb * 128; r.Wp = c.in[35] + ((size_t)l * NE + e) * 512 * D; r.ldw = D; r.WT = WSH(O_WDN) + (size_t)e * D * 512; r.ldt = 512; r.drow = r.n0; return r; }
}
__device__ __forceinline__ void convert_big(const Ctx& c, int l, float* ldsf, int first, int last, int widx, int wcnt) {
    const int tid = threadIdx.x, lr = tid >> 5, lc = (tid & 31) * 4;
    f32x4 rg[8]; int it = first + widx; CvtItem r;
    if (it < last) { r = cvt_decode_big(c, l, it);
#pragma unroll
        for (int i = 0; i < 8; ++i) rg[i] = *(const f32x4*)(r.Wp + (size_t)(r.k0 + lr + 16 * i) * r.ldw + r.n0 + lc); }
    for (; it < last; it += wcnt) {
#pragma unroll
        for (int i = 0; i < 8; ++i) { float* dp = ldsf + (lr + 16 * i) * 129 + lc; dp[0] = rg[i][0]; dp[1] = rg[i][1]; dp[2] = rg[i][2]; dp[3] = rg[i][3]; }
        const CvtItem cur = r; const int nx = it + wcnt;
        if (nx < last) { r = cvt_decode_big(c, l, nx);
#pragma unroll
            for (int i = 0; i < 8; ++i) rg[i] = *(const f32x4*)(r.Wp + (size_t)(r.k0 + lr + 16 * i) * r.ldw + r.n0 + lc); }
        SYNCTHREADS();
#pragma unroll
        for (int q = 0; q < 4; ++q) { const int id = tid + NT * q, n = id >> 4, k8 = (id & 15) * 8; const float* sp = ldsf + k8 * 129 + n;
            u32x4 o; o[0] = pk2(sp[0 * 129], sp[1 * 129]); o[1] = pk2(sp[2 * 129], sp[3 * 129]); o[2] = pk2(sp[4 * 129], sp[5 * 129]); o[3] = pk2(sp[6 * 129], sp[7 * 129]);
            *(u32x4*)(cur.WT + (size_t)(cur.drow + n) * cur.ldt + cur.k0 + k8) = o; }
        SYNCTHREADS();
    }
}
__device__ __forceinline__ int convert_tail_tiles() { const int nun = (T / 256) * (PW / 256), G = (int)gridDim.x, rem = nun % G; return rem == 0 ? 0 : (G - rem) * 10 < J_GU + J_DN ? (G - rem) * 10 : J_GU + J_DN; }
__device__ __forceinline__ int convert_early_tiles(const Ctx& c) { const int G = (int)gridDim.x, nrest = (CTLW(c) + CW_PLAN)[40] * 4 - G; return (nrest >= 0 && nrest < G) ? ((G - nrest) * 12 < J_IN ? (G - nrest) * 12 : J_IN) : 0; }
__device__ __forceinline__ void ph_convert(const Ctx& c, int l, float* ldsf) {
    const int lane = threadIdx.x & 63, wave = threadIdx.x >> 6; const int gw = blockIdx.x * (NT / 64) + wave, ngw = gridDim.x * (NT / 64);
    convert_big(c, l, ldsf, l == 1 ? convert_early_tiles(c) : 0, J_ALL - convert_tail_tiles(), (int)blockIdx.x, (int)gridDim.x);
#ifdef CPU_EMU
    if (lane == 0) for (int it = I_BIG + gw; it < I_ALL; it += ngw) { const CvtItem r = cvt_decode(c, l, it);
        for (int kk = 0; kk < 64; ++kk) for (int nn = 0; nn < 32; ++nn) r.WT[(size_t)(r.drow + nn) * r.ldt + r.k0 + kk] = (bf16_t)f2bf(r.Wp[(size_t)(r.k0 + kk) * r.ldw + r.n0 + nn]); }
#else
    float* scr = ldsf + wave * (64 * 33 + 16);
    for (int it = I_BIG + gw; it < I_ALL; it += ngw) {
        const CvtItem r = cvt_decode(c, l, it);
#pragma unroll 8
        for (int i = 0; i < 32; ++i) { const int kk = 2 * i + (lane >> 5); scr[kk * 33 + (lane & 31)] = r.Wp[(size_t)(r.k0 + kk) * r.ldw + r.n0 + (lane & 31)]; }
        asm volatile("s_waitcnt lgkmcnt(0)" ::: "memory");
        const int cc = lane & 7;
#pragma unroll
        for (int j = 0; j < 4; ++j) { const int n = (lane >> 3) + 8 * j; const float* sp = scr + (8 * cc) * 33 + n;
            u32x4 o; o[0] = pk2(sp[0 * 33], sp[1 * 33]); o[1] = pk2(sp[2 * 33], sp[3 * 33]); o[2] = pk2(sp[4 * 33], sp[5 * 33]); o[3] = pk2(sp[6 * 33], sp[7 * 33]);
            *(u32x4*)(r.WT + (size_t)(r.drow + n) * r.ldt + r.k0 + 8 * cc) = o; }
        asm volatile("s_waitcnt lgkmcnt(0)" ::: "memory");
    }
#endif
    { const float* wg = c.in[30] + (size_t)l * D * 4; const float* we = c.in[32] + (size_t)l * D * 32; bf16_t* wh = WSH(O_WRH); bf16_t* wl = WSH(O_WRL);
      for (long i = GT_; i < (long)48 * D; i += GS_) { const int n = (int)(i / D), k = (int)(i % D); const float w = n < 4 ? wg[k * 4 + n] : n < 36 ? we[k * 32 + (n - 4)] : 0.f; const unsigned hb = f2bf(w); wh[i] = (bf16_t)hb; wl[i] = (bf16_t)f2bf(w - bf2f((bf16_t)hb)); } }
    for (long i = GT_; i < (long)128 * D / 2; i += GS_) ((unsigned*)(WSH(O_WIN) + (size_t)10624 * D))[i] = 0u;
}

namespace pg8 {
constexpr int BM = 256, BK = 64, HALF = 128, HTB = HALF * BK * 2, STAGE_BYTES = 8 * HTB;
__host__ __device__ __forceinline__ int lds_byte(int r, int cc) { const int st = (r >> 4) * 2 + (cc >> 5), rr = r & 15, c2 = cc & 31, ob = rr * 64 + c2 * 2; return st * 1024 + (ob ^ (((ob >> 9) & 1) << 5)); }
__host__ __device__ __forceinline__ void stage_rc(int b, int& R, int& C) { const int st = b / 1024, sb = b % 1024, swz = sb ^ (((sb >> 9) & 1) << 5); R = (st >> 1) * 16 + swz / 64; C = (st & 1) * 32 + (swz % 64) / 2; }
__host__ __device__ __forceinline__ int perm32(int rho) { const int n = rho >> 4, i = rho & 15; return 8 * (i >> 2) + 4 * n + (i & 3); }
struct Unit { int pm, pn, aux; const char* A; const char* B; };
struct Gemm { int K, lda, ldb; };

template <class Epi, class Sched>
__device__ __forceinline__ void gemm_phase(unsigned char* lds_, const Gemm g, const Sched& S, const Epi& E) {
#ifdef CPU_EMU
    if (threadIdx.x != 0) return;
    Unit u; const int K = g.K;
    float* Af = (float*)malloc((size_t)256 * K * 4); float* Bf = (float*)malloc((size_t)256 * K * 4); float* Cf = (float*)malloc(256 * 256 * 4);
    for (int i = 0; S.next(i, u); ++i) {
        const bf16_t* A = (const bf16_t*)u.A; const bf16_t* B = (const bf16_t*)u.B;
        for (int r = 0; r < 256; ++r) for (int k = 0; k < K; ++k) { Af[(size_t)r * K + k] = bf2f(A[(size_t)r * g.lda + k]); Bf[(size_t)r * K + k] = bf2f(B[(size_t)r * g.ldb + k]); }
        for (int r = 0; r < 256; ++r) for (int cc = 0; cc < 256; ++cc) { const float* a = Af + (size_t)r * K; const float* b = Bf + (size_t)cc * K; float sacc = 0.f; for (int k = 0; k < K; ++k) sacc += a[k] * b[k]; Cf[r * 256 + cc] = sacc; }
        for (int wid = 0; wid < 8; ++wid) for (int lane = 0; lane < 64; ++lane) {
            const int wr = wid >> 2, wc = wid & 3, fr = lane & 15, fq = lane >> 4; f32x4 acc[2][2][4][2];
            for (int ai = 0; ai < 2; ++ai) for (int bj = 0; bj < 2; ++bj) for (int m = 0; m < 4; ++m) for (int n = 0; n < 2; ++n) for (int j = 0; j < 4; ++j) {
                const int r = 128 * ai + 64 * wr + 16 * m + fr, cc = 128 * bj + 32 * wc + (Epi::PERM ? 8 * fq + 4 * n + j : 16 * n + 4 * fq + j); acc[ai][bj][m][n][j] = Cf[r * 256 + cc]; }
            E(acc, u, wr, wc, fr, fq);
        }
    }
    free(Af); free(Bf); free(Cf);
#else
    typedef __attribute__((address_space(3))) unsigned char* ldsp_t;
    ldsp_t lds = (ldsp_t)lds_;
    const int tid = threadIdx.x, wid = __builtin_amdgcn_readfirstlane(tid >> 6), lane = tid & 63, wr = wid >> 2, wc = wid & 3, fr = lane & 15, fq = lane >> 4;
    const int K = g.K, nt = K / BK;
    unsigned voffA[2], voffB[2];
#pragma unroll
    for (int i = 0; i < 2; ++i) { int R, C; stage_rc(tid * 16 + i * 8192, R, C); const int Rb = Epi::PERM ? ((R & ~31) + perm32(R & 31)) : R;
        voffA[i] = (unsigned)(R * g.lda + C) * 2u; voffB[i] = (unsigned)(Rb * g.ldb + C) * 2u; }
    const size_t kstep = (size_t)(BK * 2);
    const size_t hstepA = (size_t)HALF * g.lda * 2, hstepB = (size_t)HALF * g.ldb * 2;
    const unsigned ldsw = (unsigned)wid * 1024u;
    const int aoff = lds_byte(wr * 64 + fr, fq * 8), boff = lds_byte(wc * 32 + fr, fq * 8);
#define PG8_SA(b, h) (((b) * 2 + (h)) * HTB)
#define PG8_SB(b, h) ((4 + (b) * 2 + (h)) * HTB)
#define PG8_STAGE(bufoff, gbase, voff) do { _Pragma("unroll") for (int _i = 0; _i < 2; ++_i) \
        __builtin_amdgcn_global_load_lds((const unsigned*)((const char*)(gbase) + (voff)[_i]), (__attribute__((address_space(3))) unsigned*)(lds + (bufoff) + ldsw + _i * 8192), 16, 0, 0); } while (0)
#define PG8_LDA(dst, b, h) do { _Pragma("unroll") for (int m = 0; m < 4; ++m) _Pragma("unroll") for (int k = 0; k < 2; ++k) dst[m][k] = *(const __attribute__((address_space(3))) bf16x8*)(lds + PG8_SA(b, h) + aoff + m * 2048 + k * 1024); } while (0)
#define PG8_LDB(dst, b, h) do { _Pragma("unroll") for (int n = 0; n < 2; ++n) _Pragma("unroll") for (int k = 0; k < 2; ++k) dst[n][k] = *(const __attribute__((address_space(3))) bf16x8*)(lds + PG8_SB(b, h) + boff + n * 2048 + k * 1024); } while (0)
#define PG8_MMA(ai, bj, At, Bt) do { __builtin_amdgcn_s_setprio(1); _Pragma("unroll") for (int m = 0; m < 4; ++m) _Pragma("unroll") for (int n = 0; n < 2; ++n) _Pragma("unroll") for (int k = 0; k < 2; ++k) \
        acc[ai][bj][m][n] = __builtin_amdgcn_mfma_f32_16x16x32_bf16(Bt[n][k], At[m][k], acc[ai][bj][m][n], 0, 0, 0); __builtin_amdgcn_s_setprio(0); } while (0)
#define PG8_WAIT_V(n) asm volatile("s_waitcnt vmcnt(" #n ")" ::: "memory")
#define PG8_WAIT_L(n) asm volatile("s_waitcnt lgkmcnt(" #n ")" ::: "memory")
#define PG8_BAR __builtin_amdgcn_s_barrier()
#define PG8_SCHED __builtin_amdgcn_sched_barrier(0)
    Unit cur, nxt; int ui = 0;
    if (!S.next(0, cur)) return;
    f32x4 acc[2][2][4][2];
#pragma unroll
    for (int a = 0; a < 2; ++a)
#pragma unroll
        for (int b = 0; b < 2; ++b)
#pragma unroll
            for (int m = 0; m < 4; ++m)
#pragma unroll
                for (int n = 0; n < 2; ++n) acc[a][b][m][n] = (f32x4){0.f, 0.f, 0.f, 0.f};
    bf16x8 At[4][2], B0[2][2], B1[2][2];
    const char* cA = cur.A; const char* cB = cur.B;
    S.a_ready(cur);
    PG8_STAGE(PG8_SB(0, 0), cB, voffB); PG8_STAGE(PG8_SA(0, 0), cA, voffA); PG8_STAGE(PG8_SB(0, 1), cB + hstepB, voffB); PG8_STAGE(PG8_SA(0, 1), cA + hstepA, voffA);
    if (wr == 1) PG8_BAR;
    PG8_WAIT_V(4); PG8_BAR;
    PG8_STAGE(PG8_SB(1, 0), cB + kstep, voffB); PG8_STAGE(PG8_SA(1, 0), cA + kstep, voffA); PG8_STAGE(PG8_SB(1, 1), cB + hstepB + kstep, voffB);
    PG8_WAIT_V(6); PG8_BAR;
    for (;;) {
        const bool has_next = S.next(ui + 1, nxt);
        const char* nA = has_next ? nxt.A : cA; const char* nB = has_next ? nxt.B : cB;
        for (int t = 0; t < nt; t += 2) {
            const bool last = (t == nt - 2);
            const char* a1 = cA + (size_t)(t + 1) * kstep;
            const char* a2 = last ? nA : cA + (size_t)(t + 2) * kstep; const char* b2 = last ? nB : cB + (size_t)(t + 2) * kstep;
            const char* a3 = a2 + kstep; const char* b3 = b2 + kstep;
            if (last && has_next) S.a_ready(nxt);
            PG8_LDB(B0, 0, 0); PG8_SCHED; PG8_LDA(At, 0, 0); PG8_STAGE(PG8_SA(1, 1), a1 + hstepA, voffA);
            PG8_WAIT_L(8); PG8_BAR; PG8_WAIT_L(0); PG8_MMA(0, 0, At, B0); PG8_BAR; PG8_SCHED;
            PG8_LDB(B1, 0, 1); PG8_STAGE(PG8_SB(0, 0), b2, voffB);
            PG8_BAR; PG8_WAIT_L(0); PG8_MMA(0, 1, At, B1); PG8_BAR;
            PG8_LDA(At, 0, 1); PG8_STAGE(PG8_SA(0, 0), a2, voffA);
            PG8_BAR; PG8_WAIT_L(0); PG8_MMA(1, 0, At, B0); PG8_BAR; PG8_SCHED;
            PG8_STAGE(PG8_SB(0, 1), b2 + hstepB, voffB);
            PG8_WAIT_V(6); PG8_BAR; PG8_MMA(1, 1, At, B1); PG8_BAR;
            PG8_LDB(B0, 1, 0); PG8_SCHED; PG8_LDA(At, 1, 0); PG8_STAGE(PG8_SA(0, 1), a2 + hstepA, voffA);
            PG8_WAIT_L(8); PG8_BAR; PG8_WAIT_L(0); PG8_MMA(0, 0, At, B0); PG8_BAR; PG8_SCHED;
            PG8_LDB(B1, 1, 1); PG8_STAGE(PG8_SB(1, 0), b3, voffB);
            PG8_BAR; PG8_WAIT_L(0); PG8_MMA(0, 1, At, B1); PG8_BAR;
            PG8_LDA(At, 1, 1); PG8_STAGE(PG8_SA(1, 0), a3, voffA);
            PG8_BAR; PG8_WAIT_L(0); PG8_MMA(1, 0, At, B0); PG8_BAR; PG8_SCHED;
            PG8_STAGE(PG8_SB(1, 1), b3 + hstepB, voffB);
            PG8_WAIT_V(6); PG8_BAR; PG8_MMA(1, 1, At, B1); PG8_BAR;
        }
        E(acc, cur, wr, wc, fr, fq); S.done(cur);
        if (!has_next) break;
#pragma unroll
        for (int a = 0; a < 2; ++a)
#pragma unroll
            for (int b = 0; b < 2; ++b)
#pragma unroll
                for (int m = 0; m < 4; ++m)
#pragma unroll
                    for (int n = 0; n < 2; ++n) acc[a][b][m][n] = (f32x4){0.f, 0.f, 0.f, 0.f};
        cur = nxt; cA = nA; cB = nB; ++ui;
    }
    PG8_WAIT_V(0);
    if (wr == 0) PG8_BAR;
    PG8_BAR;
#undef PG8_SA
#undef PG8_SB
#undef PG8_STAGE
#undef PG8_LDA
#undef PG8_LDB
#undef PG8_MMA
#undef PG8_WAIT_V
#undef PG8_WAIT_L
#undef PG8_BAR
#undef PG8_SCHED
#endif
}

struct StaticOrder {
    int nM, nN, nwg, G, c; const char* A; const char* B; size_t tstepA, tstepB;
    __device__ __forceinline__ void init(int M, int N, int G_, int c_, const void* A_, const void* B_, int lda, int ldb) { nM = M / BM; nN = N / BM; nwg = nM * nN; G = G_; c = c_; A = (const char*)A_; B = (const char*)B_; tstepA = (size_t)BM * lda * 2; tstepB = (size_t)BM * ldb * 2; }
    __device__ __forceinline__ bool next(int i, Unit& u) const {
        const long L = (long)i * G + c; if (L >= nwg) return false;
        int wgid = (int)L; { const int q = nwg / 8, r = nwg % 8, xcd = wgid % 8, off = wgid / 8; wgid = (xcd < r ? xcd * (q + 1) : r * (q + 1) + (xcd - r) * q) + off; }
        const int nig = 8 * nN, gid = wgid / nig, fm = gid * 8, gsz = (nM - fm) < 8 ? (nM - fm) : 8;
        u.pm = fm + ((wgid % nig) % gsz); u.pn = (wgid % nig) / gsz; u.aux = 0; u.A = A + (size_t)u.pm * tstepA; u.B = B + (size_t)u.pn * tstepB; return true;
    }
    __device__ __forceinline__ void a_ready(const Unit&) const {}
    __device__ __forceinline__ void done(const Unit&) const {}
};
struct MergeOrder {
    StaticOrder so; int kseg_bytes;
    __device__ __forceinline__ bool next(int i, Unit& u) const { if (!so.next(i >> 2, u)) return false; u.aux = i & 3; u.A += (size_t)u.aux * kseg_bytes; u.B += (size_t)u.aux * kseg_bytes; return true; }
    __device__ __forceinline__ void a_ready(const Unit&) const {}
    __device__ __forceinline__ void done(const Unit&) const {}
};
struct MoeOrder {
    int G, c, ncol; const int* plan; const char* A; const char* B; size_t tstepA, tstepB, estep;
    __device__ __forceinline__ bool next(int i, Unit& u) const {
        const long L = (long)i * G + c; const int nblk = plan[40]; if (L >= (long)nblk * ncol) return false;
        u.pm = (int)(L / ncol); u.pn = (int)(L % ncol); u.aux = plan[64 + u.pm]; u.A = A + (size_t)u.pm * tstepA; u.B = B + (size_t)u.aux * estep + (size_t)u.pn * tstepB; return true;
    }
    __device__ __forceinline__ void a_ready(const Unit&) const {}
    __device__ __forceinline__ void done(const Unit&) const {}
};

__device__ __forceinline__ u32x4 pack8(const f32x4 v0, const f32x4 v1) { u32x4 w; w[0] = pk2(v0[0], v0[1]); w[1] = pk2(v0[2], v0[3]); w[2] = pk2(v1[0], v1[1]); w[3] = pk2(v1[2], v1[3]); return w; }
struct EpiBf16 {
    static constexpr bool PERM = true; bf16_t* O; int ldc;
    __device__ __forceinline__ void operator()(const f32x4 (&acc)[2][2][4][2], const Unit& u, int wr, int wc, int fr, int fq) const {
        const int row0 = u.pm * BM + wr * 64 + fr, col0 = u.pn * BM + wc * 32 + 8 * fq;
#pragma unroll
        for (int ai = 0; ai < 2; ++ai)
#pragma unroll
            for (int m = 0; m < 4; ++m) { bf16_t* rowp = O + (size_t)(row0 + ai * HALF + m * 16) * ldc + col0;
#pragma unroll
                for (int bj = 0; bj < 2; ++bj) *(u32x4*)(rowp + bj * HALF) = pack8(acc[ai][bj][m][0], acc[ai][bj][m][1]); }
    }
};
struct EpiP {
    static constexpr bool PERM = true; bf16_t* O; unsigned char* G8;
    __device__ __forceinline__ void operator()(const f32x4 (&acc)[2][2][4][2], const Unit& u, int wr, int wc, int fr, int fq) const {
        const int row0 = u.pm * BM + wr * 64 + fr, col0 = u.pn * BM + wc * 32 + 8 * fq;
        if (u.pn * BM < C_MLP) {
#pragma unroll
            for (int ai = 0; ai < 2; ++ai)
#pragma unroll
                for (int m = 0; m < 4; ++m) { bf16_t* rowp = O + (size_t)(row0 + ai * HALF + m * 16) * PW + col0;
#pragma unroll
                    for (int bj = 0; bj < 2; ++bj) *(u32x4*)(rowp + bj * HALF) = pack8(acc[ai][bj][m][0], acc[ai][bj][m][1]); }
        } else {
#pragma unroll
            for (int ai = 0; ai < 2; ++ai)
#pragma unroll
                for (int m = 0; m < 4; ++m) { unsigned char* rowp = G8 + (size_t)(row0 + ai * HALF + m * 16) * (4 * D) + (col0 - C_MLP);
#pragma unroll
                    for (int bj = 0; bj < 2; ++bj) { unsigned long long w = 0ull;
#pragma unroll
                        for (int q = 0; q < 8; ++q) { const float gq = sigmoidf_(acc[ai][bj][m][q >> 2][q & 3]); w |= (unsigned long long)(unsigned)(gq * 255.f + 0.5f) << (8 * q); }
                        *(unsigned long long*)(rowp + bj * HALF) = w; } }
        }
    }
};
struct EpiMerge {
    static constexpr bool PERM = true; const unsigned char* G8; bf16_t* MRG;
    __device__ __forceinline__ void operator()(const f32x4 (&acc)[2][2][4][2], const Unit& u, int wr, int wc, int fr, int fq) const {
        const int row0 = u.pm * BM + wr * 64 + fr, col0 = u.pn * BM + wc * 32 + 8 * fq, seg = u.aux;
#pragma unroll
        for (int ai = 0; ai < 2; ++ai)
#pragma unroll
            for (int m = 0; m < 4; ++m) { const size_t r = (size_t)(row0 + ai * HALF + m * 16);
#pragma unroll
                for (int bj = 0; bj < 2; ++bj) { const int cc = col0 + bj * HALF;
                    const unsigned long long gw = *(const unsigned long long*)(G8 + r * (4 * D) + seg * D + cc);
                    f32x4 v0, v1;
#pragma unroll
                    for (int q = 0; q < 4; ++q) { v0[q] = (float)((unsigned)(gw >> (8 * q)) & 255u) * (1.f / 255.f) * acc[ai][bj][m][0][q]; v1[q] = (float)((unsigned)(gw >> (8 * (4 + q))) & 255u) * (1.f / 255.f) * acc[ai][bj][m][1][q]; }
                    bf16_t* mp = MRG + r * D + cc;
                    if (seg > 0) { const u32x4 pw = *(const u32x4*)mp;
#pragma unroll
                        for (int q = 0; q < 2; ++q) { v0[2 * q] += bflo(pw[q]); v0[2 * q + 1] += bfhi(pw[q]); v1[2 * q] += bflo(pw[2 + q]); v1[2 * q + 1] += bfhi(pw[2 + q]); } }
                    *(u32x4*)mp = pack8(v0, v1);
                }
#ifndef CPU_EMU
                asm volatile("" ::: "memory");
#endif
            }
    }
};
struct EpiResid {
    static constexpr bool PERM = false; const float* xin; const float* g1; float* xmid;
    __device__ __forceinline__ void operator()(const f32x4 (&acc)[2][2][4][2], const Unit& u, int wr, int wc, int fr, int fq) const {
        const int row0 = u.pm * BM + wr * 64 + fr, col0 = u.pn * BM + wc * 32 + 4 * fq;
#pragma unroll
        for (int ai = 0; ai < 2; ++ai)
#pragma unroll
            for (int m = 0; m < 4; ++m) { const int r = row0 + ai * HALF + m * 16; const float* gp = g1 + (size_t)(r / S) * D6;
#pragma unroll
                for (int bj = 0; bj < 2; ++bj)
#pragma unroll
                    for (int n = 0; n < 2; ++n) { const int cc = col0 + bj * HALF + n * 16; *(f32x4*)(xmid + (size_t)r * D + cc) = *(const f32x4*)(xin + (size_t)r * D + cc) + *(const f32x4*)(gp + cc) * acc[ai][bj][m][n]; }
#ifndef CPU_EMU
                asm volatile("" ::: "memory");
#endif
            }
    }
};
struct EpiGU {
    static constexpr bool PERM = true; bf16_t* ACT;
    __device__ __forceinline__ void operator()(const f32x4 (&acc)[2][2][4][2], const Unit& u, int wr, int wc, int fr, int fq) const {
        const int row0 = u.pm * BM + wr * 64 + fr, col0 = u.pn * HALF + wc * 32 + 8 * fq;
#pragma unroll
        for (int ai = 0; ai < 2; ++ai)
#pragma unroll
            for (int m = 0; m < 4; ++m) { f32x4 v0, v1;
#pragma unroll
                for (int j = 0; j < 4; ++j) { v0[j] = siluf_(acc[ai][0][m][0][j]) * acc[ai][1][m][0][j]; v1[j] = siluf_(acc[ai][0][m][1][j]) * acc[ai][1][m][1][j]; }
                *(u32x4*)(ACT + (size_t)(row0 + ai * HALF + m * 16) * 512 + col0) = pack8(v0, v1); }
    }
};
}

template <int PASS>
__device__ __forceinline__ void ph_lru(const Ctx& c, int l, float* ldsf) {
    const bf16_t* P = WSH(O_P); const float* cw = c.in[8] + (size_t)l * 4 * W; const float* cb = c.in[9] + (size_t)l * W;
    const float* br = c.in[11] + (size_t)l * 2 * W; const float* bi = c.in[13] + (size_t)l * 2 * W; const float* lam = c.in[14] + (size_t)l * 2 * W; const bf16_t* WLR = WSH(O_WLR);
    float* CA = WSF(O_LCA); float* CH = WSF(O_LCH); const float* CI = WSF(O_LCI); bf16_t* Y = WSH(O_YS); unsigned* LAU = (unsigned*)(c.ws + O_LA);
    bf16_t* Xs = (bf16_t*)ldsf; bf16_t* Wr = Xs + 64 * 136; bf16_t* Wi = Wr + 128 * 136; float* AUa = (float*)Wr; float* AUu = AUa + 64 * 128; float* HF = (float*)(Wi + 128 * 136); float* spl = HF + 64 * 128;
    const int tid = threadIdx.x, wv = tid >> 6, lane = tid & 63, fr = lane & 15, fq = lane >> 4, rt = wv & 3, hf = wv >> 2;
    for (int u = blockIdx.x; u < (T / 64) * 8; u += gridDim.x) {
        const int n = u & 7, tile = u >> 3, b = tile / NLC, chk = tile % NLC; const long t0 = (long)tile * 64;
        if (tid < 256) spl[tid] = softplusf_(-lam[(tid >> 7) * W + n * 128 + (tid & 127)]);
#pragma unroll
        for (int q = 0; q < 4; ++q) { const int id = tid + NT * q, tl = id >> 5, e4 = (id & 31) * 4, ch = n * 128 + e4; const long t = t0 + tl; const int sI = (int)(t % S);
            f32x4 acc = *(const f32x4*)(cb + ch);
#pragma unroll
            for (int k = 0; k < 4; ++k) { const int ss = sI + k - 2; if (ss >= 0 && ss < S) acc += ld_bf4(P + (size_t)(t + k - 2) * PW + C_LX + ch) * *(const f32x4*)(cw + k * W + ch); }
            st_bf4(Xs + tl * 136 + e4, acc); }
        for (int z = 0; z < 2; ++z) {
#pragma unroll
            for (int q = 0; q < 4; ++q) { const int id = tid + NT * q, f = id >> 4, e8 = (id & 15) * 8;
                *(u32x4*)(Wr + f * 136 + e8) = *(const u32x4*)(WLR + ((size_t)((z * 2 + 0) * 8 + n) * 128 + f) * 128 + e8); *(u32x4*)(Wi + f * 136 + e8) = *(const u32x4*)(WLR + ((size_t)((z * 2 + 1) * 8 + n) * 128 + f) * 128 + e8); }
            SYNCTHREADS();
            f32x4 ar[4], ai[4];
#pragma unroll
            for (int nt = 0; nt < 4; ++nt) { ar[nt] = (f32x4){0.f, 0.f, 0.f, 0.f}; ai[nt] = (f32x4){0.f, 0.f, 0.f, 0.f}; }
            wave_mma<4, 4>(ar, Xs + rt * 16 * 136, 136, Wr + hf * 64 * 136, 136);
            wave_mma<4, 4>(ai, Xs + rt * 16 * 136, 136, Wi + hf * 64 * 136, 136);
            SYNCTHREADS();
            const int tl = rt * 16 + fr;
#pragma unroll
            for (int nt = 0; nt < 4; ++nt) { const int f = 64 * hf + 16 * nt + 4 * fq, ch = n * 128 + f;
                const f32x4 brv = *(const f32x4*)(br + z * W + ch), biv = *(const f32x4*)(bi + z * W + ch), lmv = *(const f32x4*)(spl + z * 128 + f), xcv = ld_bf4(Xs + tl * 136 + f); f32x4 av, uv, lav;
#pragma unroll
                for (int e = 0; e < 4; ++e) { const float r = sigmoidf_(ar[nt][e] + brv[e]), ig = sigmoidf_(ai[nt][e] + biv[e]), la = -8.f * r * lmv[e]; const float a = fexp_(la); av[e] = a; lav[e] = la; uv[e] = sqrtf(fmaxf(1.f - a * a, 0.f)) * ig * xcv[e]; }
                *(f32x4*)(AUa + tl * 128 + f) = av; *(f32x4*)(AUu + tl * 128 + f) = uv;
                if (PASS == 1) { u32x4 pk;
#pragma unroll
                    for (int e = 0; e < 4; ++e) pk[e] = pk2(lav[e], uv[e]);
                    *(u32x4*)(LAU + ((size_t)z * T + t0 + tl) * W + ch) = pk; } }
            SYNCTHREADS();
            if (tid < 128) { const int f = tid; const size_t ci = (((size_t)z * NB + b) * NLC + chk) * W + n * 128 + f;
                if (PASS == 1) { float prod = 1.f, h = 0.f;
#pragma unroll 8
                    for (int q = 0; q < 64; ++q) { const int sI = z == 0 ? q : 63 - q; const float a = AUa[sI * 128 + f]; h = a * h + AUu[sI * 128 + f]; prod *= a; }
                    CA[ci] = prod; CH[ci] = h;
                } else { float h = CI[ci];
                    if (z == 0) {
#pragma unroll 8
                        for (int q = 0; q < 64; ++q) { h = AUa[q * 128 + f] * h + AUu[q * 128 + f]; HF[q * 128 + f] = h; }
                    } else {
#pragma unroll 8
                        for (int q = 63; q >= 0; --q) { h = AUa[q * 128 + f] * h + AUu[q * 128 + f]; HF[q * 128 + f] += h; } } }
            }
            SYNCTHREADS();
        }
        if (PASS == 2) {
#pragma unroll
            for (int q = 0; q < 4; ++q) { const int id = tid + NT * q, tl = id >> 5, f4 = (id & 31) * 4; const long t = t0 + tl; f32x4 hv = *(const f32x4*)(HF + tl * 128 + f4); const f32x4 gv = ld_bf4(P + (size_t)t * PW + C_LG + n * 128 + f4);
#pragma unroll
                for (int e = 0; e < 4; ++e) hv[e] *= geluf_(gv[e]);
                st_bf4(Y + (size_t)t * 4 * W + 0 * W + n * 128 + f4, hv); }
            SYNCTHREADS();
        }
    }
}
__device__ __forceinline__ void ph_lru_fin(const Ctx& c, float* ldsf) {
    const bf16_t* P = WSH(O_P); const unsigned* LAU = (const unsigned*)(c.ws + O_LA); const float* CI = WSF(O_LCI); bf16_t* Y = WSH(O_YS);
    unsigned* Lz = (unsigned*)ldsf; float* Hz = ldsf + 2 * 64 * 128; const int tid = threadIdx.x;
    for (int u = blockIdx.x; u < (T / 64) * 8; u += gridDim.x) {
        const int n = u & 7, tile = u >> 3, b = tile / NLC, chk = tile % NLC; const long t0 = (long)tile * 64;
#pragma unroll
        for (int q = 0; q < 8; ++q) { const int id = tid + NT * q, z = id >> 11, r = (id >> 5) & 63, c4 = (id & 31) * 4; *(u32x4*)(Lz + z * 8192 + r * 128 + c4) = *(const u32x4*)(LAU + ((size_t)z * T + t0 + r) * W + n * 128 + c4); }
        SYNCTHREADS();
        if (tid < 256) { const int z = tid >> 7, f = tid & 127; float h = CI[(((size_t)z * NB + b) * NLC + chk) * W + n * 128 + f]; const unsigned* lp = Lz + z * 8192 + f; float* hp = Hz + z * 8192 + f;
#pragma unroll 8
            for (int q = 0; q < 64; ++q) { const int sI = z == 0 ? q : 63 - q; const unsigned w = lp[sI * 128]; h = fexp_(bflo(w)) * h + bfhi(w); hp[sI * 128] = h; } }
        SYNCTHREADS();
#pragma unroll
        for (int q = 0; q < 4; ++q) { const int id = tid + NT * q, r = id >> 5, f4 = (id & 31) * 4; const long t = t0 + r; f32x4 o = *(const f32x4*)(Hz + r * 128 + f4) + *(const f32x4*)(Hz + 8192 + r * 128 + f4); const f32x4 gv = ld_bf4(P + (size_t)t * PW + C_LG + n * 128 + f4);
#pragma unroll
            for (int e = 0; e < 4; ++e) o[e] *= geluf_(gv[e]);
            st_bf4(Y + (size_t)t * 4 * W + 0 * W + n * 128 + f4, o); }
        SYNCTHREADS();
    }
}
__device__ __forceinline__ void ph_lru_scan2(const Ctx& c) {
    const float* CA = WSF(O_LCA); const float* CH = WSF(O_LCH); float* CI = WSF(O_LCI);
    for (long i = GT_; i < (long)2 * NB * W; i += GS_) {
        const int w = (int)(i % W), b = (int)((i / W) % NB), z = (int)(i / ((long)W * NB)); float carry = 0.f;
#pragma unroll 16
        for (int q = 0; q < NLC; ++q) { const int ch = z == 0 ? q : NLC - 1 - q; const size_t idx = (((size_t)z * NB + b) * NLC + ch) * W + w; CI[idx] = carry; carry = CA[idx] * carry + CH[idx]; }
    }
}
__device__ __forceinline__ void ph_rope_table(const Ctx& c) {
    const int* pos = (const int*)c.in[2]; float* RT = WSF(O_ROPE);
    for (long i = GT_; i < (long)T * 32; i += GS_) { const int j = (int)(i & 31); const float ang = (float)pos[i >> 5] * powf(10000.f, -(float)(2 * j) / 64.f); RT[i * 2] = cosf(ang); RT[i * 2 + 1] = sinf(ang); }
}
__device__ __forceinline__ void ret_tables(float* tab, int h) {
    const int tid = threadIdx.x; const float lg = loggamma_(h);
    if (tid < 32) tab[tid] = powf(10000.f, -(float)(2 * tid) / 64.f);
    if (tid >= 64 && tid < 64 + 129) tab[tid] = expf((float)(tid - 64) * lg);
}
__device__ __forceinline__ void ph_ret_kv(const Ctx& c, float* ldsf) {
    const float* RT = WSF(O_ROPE); const bf16_t* P = WSH(O_P); float* KVF = WSF(O_KVF); float* KVB = WSF(O_KVB);
    bf16_t* VT = (bf16_t*)ldsf; bf16_t* KF = VT + 128 * 136; bf16_t* KB = KF + 64 * 136; float* tab = (float*)(KB + 64 * 136);
    const int tid = threadIdx.x, wv = tid >> 6, lane = tid & 63, fr = lane & 15, fq = lane >> 4;
    for (int u = blockIdx.x; u < (T / 128) * 8; u += gridDim.x) {
        const int h = u & 7; const long t0 = (long)(u >> 3) * 128;
        ret_tables(tab, h);
        SYNCTHREADS();
        { float x1[8], x2[8];
#pragma unroll
          for (int q = 0; q < 8; ++q) { const int id = tid + NT * q, j = id & 127, dj = id >> 7; const bf16_t* prow = P + (size_t)(t0 + j) * PW + C_RK + h * 64; x1[q] = bf2f(prow[dj]); x2[q] = bf2f(prow[dj + 32]); }
#pragma unroll 1
          for (int q = 0; q < 8; ++q) { const int id = tid + NT * q, j = id & 127, dj = id >> 7; const float cs = RT[((size_t)(t0 + j) * 32 + dj) * 2], sn = RT[((size_t)(t0 + j) * 32 + dj) * 2 + 1];
            const float k1 = x1[q] * cs - x2[q] * sn, k2 = x2[q] * cs + x1[q] * sn, fj = tab[64 + 127 - j], bj = tab[64 + j];
            KF[dj * 136 + j] = (bf16_t)f2bf(k1 * fj); KF[(dj + 32) * 136 + j] = (bf16_t)f2bf(k2 * fj); KB[dj * 136 + j] = (bf16_t)f2bf(k1 * bj); KB[(dj + 32) * 136 + j] = (bf16_t)f2bf(k2 * bj); } }
#pragma unroll
        for (int q = 0; q < 4; ++q) { const int id = tid + NT * q, j = id & 127, e8 = (id >> 7) * 8; const u32x4 raw = *(const u32x4*)(P + (size_t)(t0 + j) * PW + C_RV + h * 128 + e8);
#pragma unroll
            for (int e = 0; e < 4; ++e) { VT[(e8 + 2 * e) * 136 + j] = (bf16_t)(raw[e] & 0xffffu); VT[(e8 + 2 * e + 1) * 136 + j] = (bf16_t)(raw[e] >> 16); } }
        SYNCTHREADS();
        f32x4 af[4], ab[4];
#pragma unroll
        for (int nt = 0; nt < 4; ++nt) { af[nt] = (f32x4){0.f, 0.f, 0.f, 0.f}; ab[nt] = (f32x4){0.f, 0.f, 0.f, 0.f}; }
        wave_mma<4, 4>(af, VT + wv * 16 * 136, 136, KF, 136);
        wave_mma<4, 4>(ab, VT + wv * 16 * 136, 136, KB, 136);
        const size_t ob = (((size_t)(u >> 3) * 8 + h) * 128 + wv * 16 + fr) * 64 + 4 * fq;
#pragma unroll
        for (int nt = 0; nt < 4; ++nt) { *(f32x4*)(KVF + ob + 16 * nt) = af[nt]; *(f32x4*)(KVB + ob + 16 * nt) = ab[nt]; }
        SYNCTHREADS();
    }
}
__device__ __forceinline__ void ph_ret_state(const Ctx& c) {
    const float* KVF = WSF(O_KVF); const float* KVB = WSF(O_KVB); float* STF = WSF(O_STF); float* STB = WSF(O_STB);
    for (long i = GT_; i < (long)NB * 8 * 8192; i += GS_) {
        const int x = (int)(i % 8192), h = (int)((i / 8192) % 8), b = (int)(i / 65536);
        const float cd = expf(128.f * loggamma_(h)); float st = 0.f;
#pragma unroll 16
        for (int n = 0; n < NCH; ++n) { const size_t idx = (((size_t)b * NCH + n) * 8 + h) * 8192 + x; STF[idx] = st; st = cd * st + KVF[idx]; }
        st = 0.f;
#pragma unroll 16
        for (int n = NCH - 1; n >= 0; --n) { const size_t idx = (((size_t)b * NCH + n) * 8 + h) * 8192 + x; STB[idx] = st; st = cd * st + KVB[idx]; }
    }
}
__device__ __forceinline__ void ph_ret_out(const Ctx& c, float* ldsf) {
    const float* RT = WSF(O_ROPE); const bf16_t* P = WSH(O_P); const float* STF = WSF(O_STF); const float* STB = WSF(O_STB); bf16_t* Y = WSH(O_YS);
    bf16_t* Qs = (bf16_t*)ldsf; bf16_t* Ks = Qs + 128 * 72; bf16_t* VT = Ks + 128 * 72; bf16_t* Ss = VT + 128 * 136; bf16_t* SF = Ss + 128 * 136; bf16_t* SB = SF + 128 * 72; float* tab = (float*)(SB + 128 * 72);
    const int tid = threadIdx.x, wv = tid >> 6, lane = tid & 63, fr = lane & 15, fq = lane >> 4;
    for (int u = blockIdx.x; u < (T / 128) * 8; u += gridDim.x) {
        const int h = u & 7; const long t0 = (long)(u >> 3) * 128;
        ret_tables(tab, h);
        SYNCTHREADS();
#pragma unroll 1
        for (int qh = 0; qh < 8; qh += 4) { float q1[4], q2[4], k1[4], k2[4];
#pragma unroll
          for (int q = 0; q < 4; ++q) { const int id = tid + NT * (qh + q), j = id >> 5, dj = id & 31; const bf16_t* prow = P + (size_t)(t0 + j) * PW;
            q1[q] = bf2f(prow[C_RQ + h * 64 + dj]); q2[q] = bf2f(prow[C_RQ + h * 64 + dj + 32]); k1[q] = bf2f(prow[C_RK + h * 64 + dj]); k2[q] = bf2f(prow[C_RK + h * 64 + dj + 32]); }
#pragma unroll
          for (int q = 0; q < 4; ++q) { const int id = tid + NT * (qh + q), j = id >> 5, dj = id & 31; const float cs = RT[((size_t)(t0 + j) * 32 + dj) * 2], sn = RT[((size_t)(t0 + j) * 32 + dj) * 2 + 1];
            Qs[j * 72 + dj] = (bf16_t)f2bf((q1[q] * cs - q2[q] * sn) * 0.125f); Qs[j * 72 + dj + 32] = (bf16_t)f2bf((q2[q] * cs + q1[q] * sn) * 0.125f); Ks[j * 72 + dj] = (bf16_t)f2bf(k1[q] * cs - k2[q] * sn); Ks[j * 72 + dj + 32] = (bf16_t)f2bf(k2[q] * cs + k1[q] * sn); } }
#pragma unroll
        for (int q = 0; q < 4; ++q) { const int id = tid + NT * q, j = id & 127, e8 = (id >> 7) * 8; const u32x4 raw = *(const u32x4*)(P + (size_t)(t0 + j) * PW + C_RV + h * 128 + e8);
#pragma unroll
            for (int e = 0; e < 4; ++e) { VT[(e8 + 2 * e) * 136 + j] = (bf16_t)(raw[e] & 0xffffu); VT[(e8 + 2 * e + 1) * 136 + j] = (bf16_t)(raw[e] >> 16); } }
        const size_t sbase = (((size_t)(u >> 3) * 8 + h)) * 8192;
#pragma unroll
        for (int q = 0; q < 4; ++q) { const int id = tid + NT * q, e = id >> 4, d4 = (id & 15) * 4; st_bf4(SF + e * 72 + d4, *(const f32x4*)(STF + sbase + (size_t)e * 64 + d4)); st_bf4(SB + e * 72 + d4, *(const f32x4*)(STB + sbase + (size_t)e * 64 + d4)); }
        SYNCTHREADS();
        const int i = wv * 16 + fr; const long t = t0 + i;
        {
            f32x4 sc[8];
#pragma unroll
            for (int nt = 0; nt < 8; ++nt) sc[nt] = (f32x4){0.f, 0.f, 0.f, 0.f};
            wave_mma<2, 8>(sc, Qs + wv * 16 * 72, 72, Ks, 72);
#pragma unroll
            for (int nt = 0; nt < 8; ++nt) { const int j0 = 16 * nt + 4 * fq; f32x4 sv;
#pragma unroll
                for (int e = 0; e < 4; ++e) { const int j = j0 + e, dist = i > j ? i - j : j - i; sv[e] = sc[nt][e] * tab[64 + dist]; }
                st_bf4(Ss + i * 136 + j0, sv); }
        }
#ifdef CPU_EMU
        SYNCTHREADS();
#else
        asm volatile("s_waitcnt lgkmcnt(0)" ::: "memory");
#endif
        f32x4 ao[8], tm[8];
#pragma unroll
        for (int nt = 0; nt < 8; ++nt) { ao[nt] = (f32x4){0.f, 0.f, 0.f, 0.f}; tm[nt] = (f32x4){0.f, 0.f, 0.f, 0.f}; }
        wave_mma<4, 8>(ao, Ss + wv * 16 * 136, 136, VT, 136);
        wave_mma<2, 8>(tm, Qs + wv * 16 * 72, 72, SF, 72);
        { const float qf = tab[64 + i + 1];
#pragma unroll
            for (int nt = 0; nt < 8; ++nt) { ao[nt] += tm[nt] * qf; tm[nt] = (f32x4){0.f, 0.f, 0.f, 0.f}; } }
        wave_mma<2, 8>(tm, Qs + wv * 16 * 72, 72, SB, 72);
        { const float qb = tab[64 + 128 - i];
#pragma unroll
            for (int nt = 0; nt < 8; ++nt) ao[nt] += tm[nt] * qb; }
        float sm = 0.f;
#pragma unroll
        for (int nt = 0; nt < 8; ++nt) sm += (ao[nt][0] + ao[nt][1]) + (ao[nt][2] + ao[nt][3]);
        sm += SHFL_XOR(sm, 16); sm += SHFL_XOR(sm, 32);
        const float mu = sm * (1.f / 128.f); float sq = 0.f;
#pragma unroll
        for (int nt = 0; nt < 8; ++nt) { ao[nt] -= mu; sq += (ao[nt][0] * ao[nt][0] + ao[nt][1] * ao[nt][1]) + (ao[nt][2] * ao[nt][2] + ao[nt][3] * ao[nt][3]); }
        sq += SHFL_XOR(sq, 16); sq += SHFL_XOR(sq, 32);
        const float rs = 1.f / sqrtf(sq * (1.f / 128.f) + EPS);
#pragma unroll
        for (int nt = 0; nt < 8; ++nt) { const int e0 = 16 * nt + 4 * fq; f32x4 gv = ld_bf4(P + (size_t)t * PW + C_RG + h * 128 + e0);
#pragma unroll
            for (int e = 0; e < 4; ++e) gv[e] = siluf_(gv[e]) * (ao[nt][e] * rs);
            st_bf4(Y + (size_t)t * 4 * W + 1 * W + h * 128 + e0, gv); }
        SYNCTHREADS();
    }
}
__device__ __forceinline__ void ph_sgu_norm(const Ctx& c, int l) {
    const bf16_t* P = WSH(O_P); float* ST = WSF(O_VN);
    const int lane = threadIdx.x & 63, gw = blockIdx.x * (NT / 64) + (threadIdx.x >> 6), ngw = gridDim.x * (NT / 64);
    for (int t = gw; t < T; t += ngw) {
        f32x4 v[4]; float sm = 0.f;
#pragma unroll
        for (int j = 0; j < 4; ++j) { v[j] = ld_bf4(P + (size_t)t * PW + C_SV + (j * 64 + lane) * 4);
#pragma unroll
            for (int q = 0; q < 4; ++q) { v[j][q] = geluf_(v[j][q]); sm += v[j][q]; } }
        const float mu = wave_sum(sm) * (1.f / W); float sq = 0.f;
#pragma unroll
        for (int j = 0; j < 4; ++j)
#pragma unroll
            for (int q = 0; q < 4; ++q) { const float dd = v[j][q] - mu; sq += dd * dd; }
        const float rs = 1.f / sqrtf(wave_sum(sq) * (1.f / W) + EPS);
        if (lane == 0) { ST[(size_t)t * 2] = mu; ST[(size_t)t * 2 + 1] = rs; }
    }
}
__device__ __forceinline__ void ph_sgu_mix(const Ctx& c, int l, float* ldsf) {
    const bf16_t* P = WSH(O_P); const float* ST = WSF(O_VN); bf16_t* Y = WSH(O_YS); const float* ng = c.in[15] + (size_t)l * W;
    bf16_t* As = (bf16_t*)ldsf; bf16_t* Bs = As + 128 * 136; const int tid = threadIdx.x, wv = tid >> 6, lane = tid & 63, fr = lane & 15, fq = lane >> 4;
    for (int u = blockIdx.x; u < (T / 128) * 8; u += gridDim.x) {
        const int g = u & 7; const long t0 = (long)(u >> 3) * 128;
        const float* ws = c.in[16] + ((size_t)l * 8 + g) * 128 * 128; const float* bs = c.in[17] + ((size_t)l * 8 + g) * 128;
#pragma unroll
        for (int q = 0; q < 8; ++q) { const int id = tid + NT * q, i = id >> 5, j4 = (id & 31) * 4; st_bf4(As + i * 136 + j4, *(const f32x4*)(ws + i * 128 + j4)); }
#pragma unroll
        for (int q = 0; q < 4; ++q) { const int id = tid + NT * q, j = id & 127, d8 = (id >> 7) * 8; const float mu = ST[(size_t)(t0 + j) * 2], rs = ST[(size_t)(t0 + j) * 2 + 1];
            const u32x4 raw = *(const u32x4*)(P + (size_t)(t0 + j) * PW + C_SV + g * 128 + d8);
#pragma unroll
            for (int e = 0; e < 4; ++e) { const float v0 = (geluf_(bflo(raw[e])) - mu) * rs * ng[g * 128 + d8 + 2 * e], v1 = (geluf_(bfhi(raw[e])) - mu) * rs * ng[g * 128 + d8 + 2 * e + 1];
                Bs[(d8 + 2 * e) * 136 + j] = (bf16_t)f2bf(v0); Bs[(d8 + 2 * e + 1) * 136 + j] = (bf16_t)f2bf(v1); } }
        SYNCTHREADS();
        f32x4 acc[8];
#pragma unroll
        for (int nt = 0; nt < 8; ++nt) acc[nt] = (f32x4){0.f, 0.f, 0.f, 0.f};
        wave_mma<4, 8>(acc, As + wv * 16 * 136, 136, Bs, 136);
        const int i = wv * 16 + fr; const long t = t0 + i; const float bsi = bs[i];
#pragma unroll
        for (int nt = 0; nt < 8; ++nt) { const int d = 16 * nt + 4 * fq; f32x4 uu = ld_bf4(P + (size_t)t * PW + C_SU + g * 128 + d);
#pragma unroll
            for (int e = 0; e < 4; ++e) uu[e] = geluf_(uu[e]) * (acc[nt][e] + bsi);
            st_bf4(Y + (size_t)t * 4 * W + 2 * W + g * 128 + d, uu); }
        SYNCTHREADS();
    }
}
__device__ __forceinline__ void ph_rw_shift(const Ctx& c, int l) {
    const bf16_t* P = WSH(O_P); const float* mup = c.in[18] + (size_t)l * RF; const float* mun = c.in[19] + (size_t)l * RF; bf16_t* FS = WSH(O_FS);
    const int lane = threadIdx.x & 63, gw = blockIdx.x * (NT / 64) + (threadIdx.x >> 6), ngw = gridDim.x * (NT / 64);
    for (int t = gw; t < T; t += ngw) {
        const int sI = t % S; const bf16_t* pc = P + (size_t)t * PW + C_RW;
#pragma unroll 2
        for (int j = lane * 4; j < RF; j += 256) {
            const f32x4 f = ld_bf4(pc + j), z4 = (f32x4){0.f, 0.f, 0.f, 0.f}; const f32x4 pv = sI > 0 ? ld_bf4(pc - PW + j) : z4, nv = sI < S - 1 ? ld_bf4(pc + PW + j) : z4;
            f32x4 v = f + *(const f32x4*)(mup + j) * (pv - f) + *(const f32x4*)(mun + j) * (nv - f);
            if (j >= 3072 && j < 3200) {
#pragma unroll
                for (int e = 0; e < 4; ++e) v[e] = tanhf_(v[e]); }
            else if (j >= 3328) {
#pragma unroll
                for (int e = 0; e < 4; ++e) v[e] = sigmoidf_(v[e]); }
            st_bf4(FS + (size_t)t * RF + j, v);
        }
    }
}
__device__ __forceinline__ void ph_rw_lora(const Ctx& c, int l, float* ldsf) {
    const bf16_t* FS = WSH(O_FS); const float* w0 = c.in[20] + (size_t)l * 2 * W; const float* a0 = c.in[22] + (size_t)l * 2 * W;
    const bf16_t* WUT = WSH(O_WUT); const bf16_t* WAT = WSH(O_WAT); const bf16_t* WGT = WSH(O_WGT);
    bf16_t* DEC = WSH(O_DEC); bf16_t* AA = WSH(O_AA); bf16_t* GG = WSH(O_GG);
    bf16_t* F = (bf16_t*)ldsf; bf16_t* B1 = F + 128 * 136; bf16_t* B2 = B1 + 128 * 136; const int tid = threadIdx.x, wv = tid >> 6, lane = tid & 63, fr = lane & 15, fq = lane >> 4;
    for (int u = blockIdx.x; u < (T / 128) * 8; u += gridDim.x) {
        const int wc0 = (u & 7) * 128; const long t0 = (long)(u >> 3) * 128;
        for (int rd = 0; rd < 3; ++rd) {
#pragma unroll
            for (int q = 0; q < 8; ++q) { const int id = tid + NT * q, r = id >> 5, c4 = (id & 31) * 4;
                const int col = rd < 2 ? (c4 < 64 ? 3072 + rd * 64 + c4 : 3200 + rd * 64 + (c4 - 64)) : 3328 + c4;
                *(unsigned long long*)(F + r * 136 + c4) = *(const unsigned long long*)(FS + (size_t)(t0 + r) * RF + col); }
            if (rd < 2) {
#pragma unroll
                for (int q = 0; q < 2; ++q) { const int id = tid + NT * q, w = id >> 3, r8 = (id & 7) * 8;
                    *(u32x4*)(B1 + w * 72 + r8) = *(const u32x4*)(WUT + ((size_t)rd * W + wc0 + w) * 64 + r8); *(u32x4*)(B2 + w * 72 + r8) = *(const u32x4*)(WAT + ((size_t)rd * W + wc0 + w) * 64 + r8); }
            } else {
#pragma unroll
                for (int q = 0; q < 4; ++q) { const int id = tid + NT * q, w = id >> 4, r8 = (id & 15) * 8; *(u32x4*)(B1 + w * 136 + r8) = *(const u32x4*)(WGT + ((size_t)wc0 + w) * 128 + r8); }
            }
            SYNCTHREADS();
            f32x4 a1[8], a2[8];
#pragma unroll
            for (int nt = 0; nt < 8; ++nt) { a1[nt] = (f32x4){0.f, 0.f, 0.f, 0.f}; a2[nt] = (f32x4){0.f, 0.f, 0.f, 0.f}; }
            const long t = t0 + wv * 16 + fr;
            if (rd < 2) {
                wave_mma<2, 8>(a1, F + wv * 16 * 136, 136, B1, 72);
                wave_mma<2, 8>(a2, F + wv * 16 * 136 + 64, 136, B2, 72);
#pragma unroll
                for (int nt = 0; nt < 8; ++nt) { const int ch = wc0 + 16 * nt + 4 * fq; const f32x4 w0v = *(const f32x4*)(w0 + rd * W + ch), a0v = *(const f32x4*)(a0 + rd * W + ch); f32x4 dv, av;
#pragma unroll
                    for (int e = 0; e < 4; ++e) { dv[e] = fexp_(-DECAY_SCALE * sigmoidf_(a1[nt][e] + w0v[e])); av[e] = sigmoidf_(a2[nt][e] + a0v[e]); }
                    st_bf4(DEC + ((size_t)rd * T + t) * W + ch, dv); st_bf4(AA + ((size_t)rd * T + t) * W + ch, av); }
            } else {
                wave_mma<4, 8>(a1, F + wv * 16 * 136, 136, B1, 136);
#pragma unroll
                for (int nt = 0; nt < 8; ++nt) st_bf4(GG + (size_t)t * W + wc0 + 16 * nt + 4 * fq, a1[nt]);
            }
            SYNCTHREADS();
        }
    }
}
#ifdef CPU_EMU
__device__ __forceinline__ float red16_(float x) { x += SHFL_XOR(x, 1); x += SHFL_XOR(x, 2); x += SHFL_XOR(x, 4); x += SHFL_XOR(x, 8); return x; }
#define LDS_BARRIER() emu_syncthreads()
#else
__device__ __forceinline__ float red16_(float x) {
    x += __builtin_bit_cast(float, __builtin_amdgcn_update_dpp(0, __builtin_bit_cast(int, x), 0xB1, 0xF, 0xF, true));
    x += __builtin_bit_cast(float, __builtin_amdgcn_update_dpp(0, __builtin_bit_cast(int, x), 0x4E, 0xF, 0xF, true));
    x += __builtin_bit_cast(float, __builtin_amdgcn_update_dpp(0, __builtin_bit_cast(int, x), 0x141, 0xF, 0xF, true));
    x += __builtin_bit_cast(float, __builtin_amdgcn_update_dpp(0, __builtin_bit_cast(int, x), 0x140, 0xF, 0xF, true));
    return x;
}
#define LDS_BARRIER() do { asm volatile("s_waitcnt lgkmcnt(0)" ::: "memory"); __builtin_amdgcn_s_barrier(); asm volatile("" ::: "memory"); } while (0)
#endif
#define RC_M(k) (lm + (k) * 4608)
__device__ __forceinline__ void ph_rw_chunk(const Ctx& c, int l, float* ldsf) {
    const bf16_t* FS = WSH(O_FS); const bf16_t* DEC = WSH(O_DEC); const bf16_t* AA = WSH(O_AA); float* BON = WSF(O_BON);
    const float* kkw = c.in[25] + (size_t)l * W; const float* kaw = c.in[26] + (size_t)l * W; const float* rk = c.in[27] + (size_t)l * W;
    bf16_t* PST = WSH(O_PST); bf16_t* PYT = WSH(O_PYT); bf16_t* SVB = WSH(O_SVB); bf16_t* YVB = WSH(O_YVB);
    bf16_t* lm = (bf16_t*)ldsf; float* gam = (float*)RC_M(7); float* segp = (float*)RC_M(13); float* gl = segp + 512;
    const int tid = threadIdx.x, wv = tid >> 6, lane = tid & 63, fr = lane & 15, fq = lane >> 4, rt = wv & 3, hf = wv >> 2;
    const int m0 = 16 * rt + fr;
    float wv8[8], kv8[8], rv8[8], vv8[8], aa8[8];
#define RC_LOAD(uu) do { const int chain_ = (uu) / NRC, ck_ = (uu) % NRC, h_ = chain_ & 15, b_ = (chain_ >> 4) & 1, z_ = chain_ >> 5; \
        const long tb_ = (long)b_ * S + (z_ ? S - 1 - ck_ * RCK : ck_ * RCK); const int dirn_ = z_ ? -1 : 1; \
        const bf16_t* decp_ = DEC + ((size_t)z_ * T) * W + h_ * 64; const bf16_t* aap_ = AA + ((size_t)z_ * T) * W + h_ * 64; const int ch_ = h_ * 64 + lane; \
        _Pragma("unroll") for (int q = 0; q < 8; ++q) wv8[q] = bf2f(decp_[(size_t)(tb_ + dirn_ * ((tid >> 6) * 8 + q)) * W + (tid & 63)]); \
        _Pragma("unroll") for (int q = 0; q < 8; ++q) { const long t_ = tb_ + dirn_ * (wv + 8 * q); const bf16_t* f_ = FS + (size_t)t_ * RF; kv8[q] = bf2f(f_[1024 + ch_]); rv8[q] = bf2f(f_[ch_]); vv8[q] = bf2f(f_[2048 + ch_]); aa8[q] = bf2f(aap_[(size_t)t_ * W + lane]); } } while (0)
    if ((int)blockIdx.x < 64 * NRC) RC_LOAD((int)blockIdx.x);
    for (int u = blockIdx.x; u < 64 * NRC; u += gridDim.x) {
        const int chain = u / NRC, ck = u % NRC, h = chain & 15, b = (chain >> 4) & 1, z = chain >> 5;
        const long tb = (long)b * S + (z ? S - 1 - ck * RCK : ck * RCK); const int dirn = z ? -1 : 1;
        { const int k = tid & 63, sg = tid >> 6; float p = 1.f;
#pragma unroll
          for (int q = 0; q < 8; ++q) { p *= wv8[q]; gam[(sg * 8 + q) * 64 + k] = p; }
          segp[sg * 64 + k] = p; }
        LDS_BARRIER();
        { const int k = tid & 63, sg = tid >> 6; float pre = 1.f;
          for (int q = 0; q < sg; ++q) pre *= segp[q * 64 + k];
#pragma unroll
          for (int q = 0; q < 8; ++q) gam[(sg * 8 + q) * 64 + k] *= pre;
          if (sg == 7) gl[k] = gam[63 * 64 + k]; }
        LDS_BARRIER();
        { const int k = lane, ch = h * 64 + k; const float kkwv = kkw[ch], kav = kaw[ch], rkv = rk[ch];
#pragma unroll
          for (int q = 0; q < 8; ++q) { const int tt = wv + 8 * q; const long t = tb + dirn * tt;
            const float vk = kv8[q] * kkwv; const float kkn = vk * frsq_(wave_sum(vk * vk) + EPS); const float ktv = kv8[q] * (1.f + (aa8[q] - 1.f) * kav);
            const float bsum = wave_sum(rv8[q] * rkv * ktv); if (lane == 0) BON[((size_t)z * T + t) * 16 + h] = bsum;
            const float g = gam[tt * 64 + k], gp = tt ? gam[(tt - 1) * 64 + k] : 1.f, ig = frcp_(g);
            const bf16_t khv = (bf16_t)f2bf(kkn * gp), bhv = (bf16_t)f2bf(aa8[q] * kkn * ig);
            RC_M(0)[tt * 72 + k] = khv; RC_M(1)[k * 72 + tt] = khv; RC_M(2)[tt * 72 + k] = bhv; RC_M(3)[k * 72 + tt] = bhv;
            RC_M(4)[tt * 72 + k] = (bf16_t)f2bf(ktv * ig); RC_M(5)[tt * 72 + k] = (bf16_t)f2bf(rv8[q] * g); RC_M(6)[k * 72 + tt] = (bf16_t)f2bf(vv8[q]); } }
        if (u + (int)gridDim.x < 64 * NRC) RC_LOAD(u + (int)gridDim.x);
        LDS_BARRIER();
        f32x4 mkr[2], khr[2], rhT[2];
        {
            f32x4 a0[2], a1[2], a2[2], a3[2];
#pragma unroll
            for (int nt = 0; nt < 2; ++nt) { a0[nt] = (f32x4){0.f, 0.f, 0.f, 0.f}; a1[nt] = a0[nt]; a2[nt] = a0[nt]; a3[nt] = a0[nt]; }
            wave_mma<2, 2>(a0, RC_M(2) + rt * 16 * 72, 72, RC_M(0) + hf * 32 * 72, 72);
            wave_mma<2, 2>(a1, RC_M(4) + rt * 16 * 72, 72, RC_M(0) + hf * 32 * 72, 72);
            wave_mma<2, 2>(a2, RC_M(2) + rt * 16 * 72, 72, RC_M(5) + hf * 32 * 72, 72);
            wave_mma<2, 2>(a3, RC_M(4) + rt * 16 * 72, 72, RC_M(5) + hf * 32 * 72, 72);
#pragma unroll
            for (int nt = 0; nt < 2; ++nt) { const int n0 = 32 * hf + 16 * nt + 4 * fq; f32x4 nn, ti, mk;
#pragma unroll
                for (int r = 0; r < 4; ++r) { const int n = n0 + r; const bool lt = m0 < n, le = m0 <= n;
                    nn[r] = lt ? -a0[nt][r] : 0.f; ti[r] = nn[r] + (m0 == n ? 1.f : 0.f); mk[r] = lt ? a1[nt][r] : 0.f; mkr[nt][r] = le ? a3[nt][r] : 0.f;
                    RC_M(12)[n * 72 + m0] = (bf16_t)f2bf(le ? a2[nt][r] : 0.f);
                    RC_M(8)[n * 72 + m0] = (bf16_t)f2bf(nn[r]);
                    khr[nt][r] = bf2f(RC_M(4)[m0 * 72 + n]); rhT[nt][r] = bf2f(RC_M(5)[n * 72 + m0]); }
                st_bf4(RC_M(7) + m0 * 72 + n0, nn); st_bf4(RC_M(9) + m0 * 72 + n0, ti); st_bf4(RC_M(11) + m0 * 72 + n0, mk); }
        }
        LDS_BARRIER();
        f32x4 tiv[2];
#pragma unroll
        for (int nt = 0; nt < 2; ++nt) tiv[nt] = ld_bf4(RC_M(9) + m0 * 72 + 32 * hf + 16 * nt + 4 * fq);
#pragma unroll 1
        for (int it = 0; it < 5; ++it) {
            bf16_t* pw = (it & 1) ? RC_M(0) : RC_M(7); bf16_t* pwT = (it & 1) ? RC_M(2) : RC_M(8); bf16_t* pw2 = (it & 1) ? RC_M(7) : RC_M(0); bf16_t* pw2T = (it & 1) ? RC_M(8) : RC_M(2);
            bf16_t* tcur = (it & 1) ? RC_M(4) : RC_M(9); bf16_t* tnxt = (it & 1) ? RC_M(9) : RC_M(4);
            f32x4 sq[2];
#pragma unroll
            for (int nt = 0; nt < 2; ++nt) sq[nt] = (f32x4){0.f, 0.f, 0.f, 0.f};
            wave_mma<2, 2>(sq, pw + rt * 16 * 72, 72, pwT + hf * 32 * 72, 72);
#pragma unroll
            for (int nt = 0; nt < 2; ++nt) { const int n0 = 32 * hf + 16 * nt + 4 * fq; st_bf4(pw2 + m0 * 72 + n0, sq[nt]);
#pragma unroll
                for (int r = 0; r < 4; ++r) pw2T[(n0 + r) * 72 + m0] = (bf16_t)f2bf(sq[nt][r]); }
            LDS_BARRIER();
            f32x4 up[2];
#pragma unroll
            for (int nt = 0; nt < 2; ++nt) up[nt] = (f32x4){0.f, 0.f, 0.f, 0.f};
            wave_mma<2, 2>(up, tcur + rt * 16 * 72, 72, pw2T + hf * 32 * 72, 72);
#pragma unroll
            for (int nt = 0; nt < 2; ++nt) { const int n0 = 32 * hf + 16 * nt + 4 * fq; tiv[nt] += up[nt]; st_bf4(tnxt + m0 * 72 + n0, tiv[nt]);
                if (it == 4) {
#pragma unroll
                    for (int r = 0; r < 4; ++r) RC_M(10)[(n0 + r) * 72 + m0] = (bf16_t)f2bf(tiv[nt][r]); } }
            LDS_BARRIER();
        }
        {
            f32x4 w1[2], w2[2];
#pragma unroll
            for (int nt = 0; nt < 2; ++nt) { w1[nt] = (f32x4){0.f, 0.f, 0.f, 0.f}; w2[nt] = w1[nt]; }
            wave_mma<2, 2>(w1, RC_M(1) + rt * 16 * 72, 72, RC_M(10) + hf * 32 * 72, 72);
            wave_mma<2, 2>(w2, RC_M(11) + rt * 16 * 72, 72, RC_M(10) + hf * 32 * 72, 72);
#pragma unroll
            for (int nt = 0; nt < 2; ++nt) { const int n0 = 32 * hf + 16 * nt + 4 * fq; st_bf4(RC_M(7) + m0 * 72 + n0, w1[nt]); st_bf4(RC_M(8) + m0 * 72 + n0, w2[nt]); }
        }
        LDS_BARRIER();
        {
            f32x4 py[2], qy[2], ps[2], qs[2];
#pragma unroll
            for (int nt = 0; nt < 2; ++nt) { py[nt] = (f32x4){0.f, 0.f, 0.f, 0.f}; qy[nt] = py[nt]; ps[nt] = py[nt]; qs[nt] = py[nt]; }
            wave_mma<2, 2>(py, RC_M(7) + rt * 16 * 72, 72, RC_M(12) + hf * 32 * 72, 72);
            wave_mma<2, 2>(qy, RC_M(8) + rt * 16 * 72, 72, RC_M(12) + hf * 32 * 72, 72);
            wave_mma<2, 2>(ps, RC_M(7) + rt * 16 * 72, 72, RC_M(3) + hf * 32 * 72, 72);
            wave_mma<2, 2>(qs, RC_M(8) + rt * 16 * 72, 72, RC_M(3) + hf * 32 * 72, 72);
#pragma unroll
            for (int nt = 0; nt < 2; ++nt) { const int n0 = 32 * hf + 16 * nt + 4 * fq;
#pragma unroll
                for (int r = 0; r < 4; ++r) { const int n = n0 + r; const float gln = gl[n];
                    RC_M(0)[n * 72 + m0] = (bf16_t)f2bf(rhT[nt][r] - py[nt][r]); RC_M(2)[n * 72 + m0] = (bf16_t)f2bf(mkr[nt][r] - qy[nt][r]);
                    RC_M(4)[n * 72 + m0] = (bf16_t)f2bf(((m0 == n ? 1.f : 0.f) - ps[nt][r]) * gln); RC_M(5)[n * 72 + m0] = (bf16_t)f2bf((khr[nt][r] - qs[nt][r]) * gln); } }
        }
        LDS_BARRIER();
        {
            f32x4 yv[2], sv[2];
#pragma unroll
            for (int nt = 0; nt < 2; ++nt) { yv[nt] = (f32x4){0.f, 0.f, 0.f, 0.f}; sv[nt] = yv[nt]; }
            wave_mma<2, 2>(yv, RC_M(6) + rt * 16 * 72, 72, RC_M(2) + hf * 32 * 72, 72);
            wave_mma<2, 2>(sv, RC_M(6) + rt * 16 * 72, 72, RC_M(5) + hf * 32 * 72, 72);
#pragma unroll
            for (int nt = 0; nt < 2; ++nt) { const int n0 = 32 * hf + 16 * nt + 4 * fq; st_bf4(YVB + (size_t)u * 4096 + m0 * 64 + n0, yv[nt]); st_bf4(SVB + (size_t)u * 4096 + m0 * 64 + n0, sv[nt]); }
            { const int rr = tid >> 3, c8 = (tid & 7) * 8; *(u32x4*)(PYT + (size_t)u * 4096 + rr * 64 + c8) = *(const u32x4*)(RC_M(0) + rr * 72 + c8); *(u32x4*)(PST + (size_t)u * 4096 + rr * 64 + c8) = *(const u32x4*)(RC_M(4) + rr * 72 + c8); }
        }
        LDS_BARRIER();
    }
}
#undef RC_M
#undef RC_LOAD
__device__ __forceinline__ void ph_rw_seq(const Ctx& c, float* ldsf) {
    const bf16_t* PST = WSH(O_PST); const bf16_t* PYT = WSH(O_PYT); const bf16_t* SVB = WSH(O_SVB); const bf16_t* YVB = WSH(O_YVB); bf16_t* YY = WSH(O_YY);
    bf16_t* Sb = (bf16_t*)ldsf;
    bf16_t* Pm = Sb + 2 * 16 * 72;
    const int tid = threadIdx.x, wv = tid >> 6, lane = tid & 63, fr = lane & 15, fq = lane >> 4, isY = wv >> 2, nt0 = wv & 3;
    for (int u = blockIdx.x; u < 256; u += gridDim.x) {
        const int x = u & 7, jq = u >> 3, chain = x * 8 + (jq >> 2), qt = jq & 3, h = chain & 15, b = (chain >> 4) & 1, z = chain >> 5;
        const size_t ub = (size_t)chain * NRC;
        const int rr = tid >> 3, c8 = (tid & 7) * 8;
        constexpr int PD = NRC >= 8 ? 8 : 4;
        for (int i = tid; i < 2 * 16 * 72 / 2; i += NT) ((unsigned*)Sb)[i] = 0u;
        const int row = 16 * qt + fr, n0 = 16 * nt0 + 4 * fq; const bf16_t* addp = (isY ? YVB : SVB) + ub * 4096 + row * 64 + n0;
        const bf16_t* psp = PST + ub * 4096 + rr * 64 + c8; const bf16_t* pyp = PYT + ub * 4096 + rr * 64 + c8;
        u32x4 gps[PD], gpy[PD]; f32x4 add[PD];
#pragma unroll
        for (int j = 0; j < PD; ++j) { gps[j] = *(const u32x4*)(psp + (size_t)j * 4096); gpy[j] = *(const u32x4*)(pyp + (size_t)j * 4096); add[j] = ld_bf4(addp + (size_t)j * 4096); }
        *(u32x4*)(Pm + (0 * 2 + 0) * 4608 + rr * 72 + c8) = gps[0]; *(u32x4*)(Pm + (0 * 2 + 1) * 4608 + rr * 72 + c8) = gpy[0];
        if (PD < NRC) { gps[0] = *(const u32x4*)(psp + (size_t)PD * 4096); gpy[0] = *(const u32x4*)(pyp + (size_t)PD * 4096); }
        SYNCTHREADS();
        for (int ck0 = 0; ck0 < NRC; ck0 += PD) {
#pragma unroll
            for (int j = 0; j < PD; ++j) {
                const int ck = ck0 + j, cur = j & 1, nxt = cur ^ 1;
                f32x4 acc[1]; acc[0] = (f32x4){0.f, 0.f, 0.f, 0.f};
                wave_mma<2, 1>(acc, Sb + cur * 16 * 72, 72, Pm + (cur * 2 + isY) * 4608 + nt0 * 16 * 72, 72);
                acc[0] += add[j];
                if (ck + PD < NRC) add[j] = ld_bf4(addp + (size_t)(ck + PD) * 4096);
                if (isY) {
#pragma unroll
                    for (int r = 0; r < 4; ++r) { const int step = ck * RCK + n0 + r, sidx = z ? S - 1 - step : step; YY[((size_t)z * T + (size_t)b * S + sidx) * W + h * 64 + row] = (bf16_t)f2bf(acc[0][r]); }
                } else st_bf4(Sb + nxt * 16 * 72 + fr * 72 + n0, acc[0]);
                const int jn = (j + 1) % PD;
                if (ck + 1 < NRC) { *(u32x4*)(Pm + (nxt * 2 + 0) * 4608 + rr * 72 + c8) = gps[jn]; *(u32x4*)(Pm + (nxt * 2 + 1) * 4608 + rr * 72 + c8) = gpy[jn]; }
                if (ck + 1 + PD < NRC) { gps[jn] = *(const u32x4*)(psp + (size_t)(ck + 1 + PD) * 4096); gpy[jn] = *(const u32x4*)(pyp + (size_t)(ck + 1 + PD) * 4096); }
                LDS_BARRIER();
            }
        }
    }
}
__device__ __forceinline__ void ph_rw_out(const Ctx& c) {
    const bf16_t* FS = WSH(O_FS); const bf16_t* YY = WSH(O_YY); const float* BON = WSF(O_BON); const bf16_t* GG = WSH(O_GG); bf16_t* Y = WSH(O_YS);
    const int lane = threadIdx.x & 63, gw = blockIdx.x * (NT / 64) + (threadIdx.x >> 6), ngw = gridDim.x * (NT / 64);
    for (int i = gw; i < T * 4; i += ngw) {
        const int h0 = (i & 3) * 4; const long t = i >> 2; float y0[4], y1[4], gv[4], vv[4], bs[4];
#pragma unroll
        for (int q = 0; q < 4; ++q) { const int ch = (h0 + q) * 64 + lane; y0[q] = bf2f(YY[(size_t)t * W + ch]); y1[q] = bf2f(YY[((size_t)T + t) * W + ch]); gv[q] = bf2f(GG[(size_t)t * W + ch]); vv[q] = bf2f(FS[(size_t)t * RF + 2048 + ch]);
            bs[q] = BON[(size_t)t * 16 + h0 + q] + BON[((size_t)T + t) * 16 + h0 + q]; }
#pragma unroll
        for (int q = 0; q < 4; ++q) { const int ch = (h0 + q) * 64 + lane;
            const float m0 = wave_sum(y0[q]) * (1.f / 64.f), m1 = wave_sum(y1[q]) * (1.f / 64.f); const float d0 = y0[q] - m0, d1 = y1[q] - m1;
            const float r0 = 1.f / sqrtf(wave_sum(d0 * d0) * (1.f / 64.f) + EPS), r1 = 1.f / sqrtf(wave_sum(d1 * d1) * (1.f / 64.f) + EPS);
            Y[(size_t)t * 4 * W + 3 * W + ch] = (bf16_t)f2bf((d0 * r0 + d1 * r1 + bs[q] * vv[q]) * gv[q]); }
    }
}
__device__ __forceinline__ void ph_router(const Ctx& c, int l, float* ldsf, const float* X, const float* gN, const float* shN, const float* scN) {
    const float* RS = WSF(O_HF); const bf16_t* WH = WSH(O_WRH); const bf16_t* WL = WSH(O_WRL); const float* bg = c.in[31] + (size_t)l * 4; const float* be = c.in[33] + (size_t)l * 32;
    int* EID = WSI(O_EID); float* EWT = WSF(O_EWT); int* cnt = CTLW(c) + CW_CNT + l * 64;
    const int tid = threadIdx.x, wv = tid >> 6, lane = tid & 63, fr = lane & 15, fq = lane >> 4, rt = wv & 1, kq = wv >> 1;
    float* part = ldsf;
    for (int u = blockIdx.x; u < T / 32; u += gridDim.x) {
        const long t0 = (long)u * 32; f32x4 acc[3];
#pragma unroll
        for (int nt = 0; nt < 3; ++nt) acc[nt] = (f32x4){0.f, 0.f, 0.f, 0.f};
#ifdef CPU_EMU
        for (int nt = 0; nt < 3; ++nt) for (int r = 0; r < 4; ++r) { const int n = 16 * nt + 4 * fq + r; float sacc = 0.f;
            for (int k = kq * 512; k < kq * 512 + 512; ++k) { const long tr = t0 + 16 * rt + fr; const int bb = (int)(tr / S); const float hv = X[(size_t)tr * D + k] * RS[tr] * gN[k] * (1.f + scN[bb * D6 + k]) + shN[bb * D6 + k]; const float hh = bf2f((bf16_t)f2bf(hv)), hl = bf2f((bf16_t)f2bf(hv - hh));
                const float wh = bf2f(WH[(size_t)n * D + k]), wl = bf2f(WL[(size_t)n * D + k]); sacc += hh * wh + hl * wh + hh * wl; }
            acc[nt][r] = sacc; }
#else
        const long tr = t0 + 16 * rt + fr; const int bb = (int)(tr / S); const float rsv = RS[tr]; const int kb = kq * 512 + fq * 8;
        const float* hp = X + (size_t)tr * D + kb; const float* gp_ = gN + kb; const float* scp = scN + bb * D6 + kb; const float* shp = shN + bb * D6 + kb;
#pragma unroll 4
        for (int ks = 0; ks < 16; ++ks) {
            const f32x4 h0 = *(const f32x4*)(hp + ks * 32) * rsv * *(const f32x4*)(gp_ + ks * 32) * (*(const f32x4*)(scp + ks * 32) + 1.f) + *(const f32x4*)(shp + ks * 32);
            const f32x4 h1 = *(const f32x4*)(hp + ks * 32 + 4) * rsv * *(const f32x4*)(gp_ + ks * 32 + 4) * (*(const f32x4*)(scp + ks * 32 + 4) + 1.f) + *(const f32x4*)(shp + ks * 32 + 4); bf16x8 ah, al;
#pragma unroll
            for (int e = 0; e < 4; ++e) { const unsigned b0 = f2bf(h0[e]), b1 = f2bf(h1[e]); ah[e] = (short)b0; ah[4 + e] = (short)b1; al[e] = (short)f2bf(h0[e] - u2f_(b0 << 16)); al[4 + e] = (short)f2bf(h1[e] - u2f_(b1 << 16)); }
#pragma unroll
            for (int nt = 0; nt < 3; ++nt) { const size_t wo = (size_t)(16 * nt + fr) * D + kq * 512 + ks * 32 + fq * 8; const bf16x8 bh = *(const bf16x8*)(WH + wo), bl = *(const bf16x8*)(WL + wo);
                acc[nt] = __builtin_amdgcn_mfma_f32_16x16x32_bf16(bh, ah, acc[nt], 0, 0, 0); acc[nt] = __builtin_amdgcn_mfma_f32_16x16x32_bf16(bh, al, acc[nt], 0, 0, 0); acc[nt] = __builtin_amdgcn_mfma_f32_16x16x32_bf16(bl, ah, acc[nt], 0, 0, 0); }
        }
#endif
#pragma unroll
        for (int nt = 0; nt < 3; ++nt) *(f32x4*)(part + (kq * 32 + 16 * rt + fr) * 48 + 16 * nt + 4 * fq) = acc[nt];
        SYNCTHREADS();
        if (tid < 32) { const long t = t0 + tid; float lg[36];
#pragma unroll
            for (int q = 0; q < 36; ++q) lg[q] = (part[(0 * 32 + tid) * 48 + q] + part[(1 * 32 + tid) * 48 + q]) + (part[(2 * 32 + tid) * 48 + q] + part[(3 * 32 + tid) * 48 + q]) + (q < 4 ? bg[q < 4 ? q : 0] : be[q >= 4 ? q - 4 : 0]);
            int gi = 0; float m = lg[0];
#pragma unroll
            for (int q = 1; q < 4; ++q) if (lg[q] > m) { m = lg[q]; gi = q; }
            float den = 0.f;
#pragma unroll
            for (int q = 0; q < 4; ++q) den += expf(lg[q] - m);
            const float gp = 1.f / den; float el[8];
#pragma unroll
            for (int q = 0; q < 8; ++q) el[q] = gi == 0 ? lg[4 + q] : gi == 1 ? lg[12 + q] : gi == 2 ? lg[20 + q] : lg[28 + q];
            int i1 = 0; float m1 = el[0];
#pragma unroll
            for (int q = 1; q < 8; ++q) if (el[q] > m1) { m1 = el[q]; i1 = q; }
            int i2 = -1; float m2 = 0.f;
#pragma unroll
            for (int q = 0; q < 8; ++q) if (q != i1 && (i2 < 0 || el[q] > m2)) { m2 = el[q]; i2 = q; }
            const float p2 = expf(m2 - m1);
            EID[t * 2] = gi * 8 + i1; EID[t * 2 + 1] = gi * 8 + i2; EWT[t * 2] = gp / (1.f + p2); EWT[t * 2 + 1] = gp * p2 / (1.f + p2);
            atomic_add_i(cnt + gi * 8 + i1, 1); atomic_add_i(cnt + gi * 8 + i2, 1);
        }
        SYNCTHREADS();
    }
}
__device__ __forceinline__ void ph_moe_plan(const Ctx& c, int l) {
    int* cnt = CTLW(c) + CW_CNT + l * 64; int* plan = CTLW(c) + CW_PLAN + l * 256;
    if (GT_ == 0) {
        int ps = 0, nb = 0;
        for (int e = 0; e < NE; ++e) { plan[e] = ps; const int nblk = (cnt[e] + 255) / 256; for (int q = 0; q < nblk; ++q) plan[64 + nb++] = e; ps += nblk * 256; }
        plan[32] = ps; plan[40] = nb;
    }
}
__device__ __forceinline__ void ph_moe_assign(const Ctx& c, int l) {
    const int* EID = WSI(O_EID); int* fill = CTLW(c) + CW_FILL + l * 64; const int* plan = CTLW(c) + CW_PLAN + l * 256; int* DEST = WSI(O_DEST);
    for (long i = GT_; i < (long)T * 2; i += GS_) { const int e = EID[i]; const int pos = atomic_add_i(fill + e, 1); DEST[i] = plan[e] + pos; }
}
__device__ __forceinline__ void ph_moe_gather(const Ctx& c) {
    const int* DEST = WSI(O_DEST); const u32x4* H = (const u32x4*)WSH(O_H); u32x4* XS = (u32x4*)WSH(O_XS);
    for (long i = GT_; i < (long)T * 2 * (D / 8); i += GS_) { const int q = (int)(i % (D / 8)); const long a = i / (D / 8); XS[(size_t)DEST[a] * (D / 8) + q] = H[(size_t)(a >> 1) * (D / 8) + q]; }
}
#ifndef CPU_EMU
#define XB_TMO      128
#define XB_XCNT(j)  (256  + 64 * (j))
#define XB_XSUB(j)  (1280 + 64 * (j))
#define XB_XGEN(j)  (2304 + 64 * (j))
#define XB_TOP      3328
#define XB_TOPGEN   3392
#define XCD_BAR_WORDS 3456
#define XB_SPIN_CAP (1u << 26)
#define LAS __attribute__((address_space(3)))
__device__ __forceinline__ unsigned xb_ld(unsigned* p)              { return __hip_atomic_load(p, __ATOMIC_RELAXED, __HIP_MEMORY_SCOPE_AGENT); }
__device__ __forceinline__ unsigned xb_add(unsigned* p, unsigned v) { return __hip_atomic_fetch_add(p, v, __ATOMIC_RELAXED, __HIP_MEMORY_SCOPE_AGENT); }
__device__ __forceinline__ unsigned xb_xcc_id() { return (unsigned)__builtin_amdgcn_s_getreg((3 << 11) | 20) & 0xFu; }
#define XB_SPIN(cond, bar) do { unsigned _sp = 0; while (cond) { __builtin_amdgcn_s_sleep(1); \
    if ((++_sp & 255u) == 0u) { if (xb_ld(&(bar)[XB_TMO])) break; if (_sp > XB_SPIN_CAP) { atomicAdd(&(bar)[XB_TMO], 1u); break; } } } } while (0)
struct XcdBarrier { unsigned* bar; unsigned x; volatile LAS unsigned* st; };
__device__ __forceinline__ XcdBarrier xcd_barrier_post(unsigned* bar, volatile LAS unsigned* st) {
    XcdBarrier b; b.bar = bar; b.x = xb_xcc_id(); b.st = st;
    if (threadIdx.x == 0) (void)xb_add(&bar[XB_XCNT(b.x)], 1u);
    return b;
}
__device__ __forceinline__ void xcd_barrier_complete(unsigned* bar, unsigned x, unsigned& nloc, unsigned& nx) {
    const unsigned G = gridDim.x * gridDim.y * gridDim.z;
    unsigned sum, cnt, mine, sp = 0u;
    for (;;) {
        sum = 0u; cnt = 0u; mine = 0u;
#pragma unroll
        for (unsigned j = 0; j < 16; ++j) { const unsigned cc = xb_ld(&bar[XB_XCNT(j)]); sum += cc; cnt += (cc > 0u) ? 1u : 0u; mine = (j == x) ? cc : mine; }
        if (sum == G) break;
        __builtin_amdgcn_s_sleep(1);
        if ((++sp & 255u) == 0u) { if (xb_ld(&bar[XB_TMO])) break; if (sp > XB_SPIN_CAP) { atomicAdd(&bar[XB_TMO], 1u); break; } }
    }
    nloc = mine > 0u ? mine : 1u; nx = cnt > 0u ? cnt : 1u;
}
__device__ __forceinline__ void xcd_barrier(const XcdBarrier& b) {
    asm volatile("s_waitcnt vmcnt(0)" ::: "memory");
    __syncthreads();
    if (threadIdx.x == 0) {
        unsigned* bar = b.bar;
        __builtin_amdgcn_s_waitcnt(0);
        unsigned nloc = b.st[0], nx = b.st[1];
        if (nloc == 0u) { xcd_barrier_complete(bar, b.x, nloc, nx); b.st[0] = nloc; b.st[1] = nx; }
        const unsigned old = xb_add(&bar[XB_XSUB(b.x)], 1u);
        const unsigned gen = old / nloc;
        if (old + 1u == (gen + 1u) * nloc) {
            __builtin_amdgcn_fence(__ATOMIC_RELEASE, "agent");
            asm volatile("s_waitcnt vmcnt(0)" ::: "memory");
            const unsigned og = xb_add(&bar[XB_TOP], 1u);
            const unsigned tg = og / nx;
            if (og + 1u == (tg + 1u) * nx) xb_add(&bar[XB_TOPGEN], 1u);
            else XB_SPIN(xb_ld(&bar[XB_TOPGEN]) == tg, bar);
            __builtin_amdgcn_fence(__ATOMIC_ACQUIRE, "agent");
            xb_add(&bar[XB_XGEN(b.x)], 1u);
            asm volatile("s_waitcnt vmcnt(0)" ::: "memory");
        } else {
            XB_SPIN(xb_ld(&bar[XB_XGEN(b.x)]) == gen, bar);
            __builtin_amdgcn_fence(__ATOMIC_ACQUIRE, "agent");
            asm volatile("s_waitcnt vmcnt(0)" ::: "memory");
        }
    }
    __syncthreads();
}
#endif

constexpr int LDS_BYTES = 147456;

__global__ void __launch_bounds__(NT, 2) fwd(Params p) {
#ifdef CPU_EMU
    unsigned char* lds = g_lds; float* ldsf = (float*)g_lds;
#else
    extern __shared__ __attribute__((aligned(16))) unsigned char lds[];
    float* ldsf = (float*)lds;
    volatile LAS unsigned* misc = (volatile LAS unsigned*)((LAS unsigned char*)lds + LDS_BYTES - 64);
    if (threadIdx.x == 0) { misc[0] = 0u; misc[1] = 0u; }
    __syncthreads();
    XcdBarrier bar = xcd_barrier_post((unsigned*)(p.ws + O_CTL) + CW_BAR, misc);
#endif
    Ctx c; c.in = p.in; c.out = p.out; c.ws = p.ws;
    const int lo = p.ph_lo, hi = p.ph_hi; int ph = 0;
    const int G = (int)gridDim.x, cwg = (int)blockIdx.x;
#ifdef CPU_EMU
#define GRID_BAR()
#else
#define GRID_BAR() xcd_barrier(bar)
#endif
#ifndef REPEAT_MASK
#define REPEAT_MASK 0
#endif
#ifndef TIME_PHASE
#define TIME_PHASE -1
#endif
#if TIME_PHASE >= 0 && !defined(CPU_EMU)
    unsigned long long tp0 = 0, tp1 = 0;
#define TP_BEGIN() do { if (ph == TIME_PHASE) tp0 = __builtin_amdgcn_s_memrealtime(); } while (0)
#define TP_END() do { if (ph == TIME_PHASE) tp1 = __builtin_amdgcn_s_memrealtime(); } while (0)
#else
#define TP_BEGIN()
#define TP_END()
#endif
#define PHASE(...) do { if (lo <= ph && ph < hi) { TP_BEGIN(); __VA_ARGS__; if (ph + 1 < hi) { GRID_BAR(); } TP_END(); } ++ph; } while (0)
#define PHASEG(grp, ...) do { if (lo <= ph && ph < hi) { TP_BEGIN(); if ((REPEAT_MASK >> (grp)) & 1) { __VA_ARGS__; GRID_BAR(); } __VA_ARGS__; if (ph + 1 < hi) { GRID_BAR(); } TP_END(); } ++ph; } while (0)
    PHASE(ph_mod(c, ldsf); ph_rope_table(c));
#define LAYER_BODY(l) do { const float* mod = WSF(O_MOD); \
        const float* xin = l == 0 ? c.in[0] : WSF(O_X1); float* xmid = WSF(O_X0); float* xout = WSF(O_X1); \
        const float* ml = mod + (size_t)l * NB * D6; \
        PHASEG(3, ph_convert(c, l, ldsf)); \
        PHASEG(0, { pg8::Gemm g{D, D, D}; pg8::StaticOrder so; so.init(T, PW, G, cwg, WSH(O_H), WSH(O_WIN), D, D); pg8::EpiP E{WSH(O_P), (unsigned char*)(c.ws + O_G8)}; pg8::gemm_phase(lds, g, so, E); \
            { const int nun_ = (T / 256) * (PW / 256), rem_ = nun_ % G; if (rem_ != 0 && cwg >= rem_) { SYNCTHREADS(); convert_big(c, l, ldsf, J_ALL - convert_tail_tiles(), J_ALL, cwg - rem_, G - rem_); } } }); \
        PHASE(ph_lru<1>(c, l, ldsf); ph_ret_kv(c, ldsf); ph_sgu_norm(c, l); ph_rw_shift(c, l)); \
        PHASE(ph_lru_scan2(c); ph_ret_state(c); ph_sgu_mix(c, l, ldsf); ph_rw_lora(c, l, ldsf)); \
        PHASE(ph_lru_fin(c, ldsf); ph_ret_out(c, ldsf); ph_rw_chunk(c, l, ldsf)); \
        PHASE(ph_rw_seq(c, ldsf)); \
        PHASE(ph_rw_out(c)); \
        PHASEG(1, { pg8::Gemm g{W, 4 * W, 4 * W}; pg8::MergeOrder mo; mo.so.init(T, D, G, cwg, WSH(O_YS), WSH(O_WBR), 4 * W, 4 * W); mo.kseg_bytes = W * 2; pg8::EpiMerge E{(const unsigned char*)(c.ws + O_G8), WSH(O_MRG)}; pg8::gemm_phase(lds, g, mo, E); }); \
        PHASEG(1, { pg8::Gemm g{D, D, D}; pg8::StaticOrder so; so.init(T, D, G, cwg, WSH(O_MRG), WSH(O_WOUT), D, D); pg8::EpiResid E{xin, ml + 2 * D, xmid}; pg8::gemm_phase(lds, g, so, E); }); \
        PHASEG(6, ph_norm(c, xmid, c.in[4] + (size_t)l * D, ml + 3 * D, ml + 4 * D, WSH(O_H), WSF(O_HF))); \
        PHASE(ph_router(c, l, ldsf, xmid, c.in[4] + (size_t)l * D, ml + 3 * D, ml + 4 * D)); \
        PHASE(ph_moe_plan(c, l)); \
        PHASE(ph_moe_assign(c, l)); \
        PHASEG(6, ph_moe_gather(c)); \
        const int* plan = CTLW(c) + CW_PLAN + l * 256; \
        PHASEG(2, { pg8::Gemm g{D, D, D}; pg8::MoeOrder mo{G, cwg, 4, plan, (const char*)WSH(O_XS), (const char*)WSH(O_WGU), (size_t)256 * D * 2, (size_t)256 * D * 2, (size_t)1024 * D * 2}; pg8::EpiGU E{WSH(O_ACT)}; pg8::gemm_phase(lds, g, mo, E); \
            if (l == 0) { const int nrest_ = plan[40] * 4 - G; if (nrest_ >= 0 && nrest_ < G && cwg >= nrest_) { SYNCTHREADS(); convert_big(c, 1, ldsf, 0, convert_early_tiles(c), cwg - nrest_, G - nrest_); } } }); \
        PHASEG(2, { pg8::Gemm g{512, 512, 512}; pg8::MoeOrder mo{G, cwg, 8, plan, (const char*)WSH(O_ACT), (const char*)WSH(O_WDN), (size_t)256 * 512 * 2, (size_t)256 * 512 * 2, (size_t)D * 512 * 2}; pg8::EpiBf16 E{WSH(O_YE), D}; pg8::gemm_phase(lds, g, mo, E); }); \
        if (l == 0) PHASE(ph_comb_norm<0>(c, xmid, ml + 5 * D, xout, c.in[3] + (size_t)1 * D, mod + (size_t)1 * NB * D6 + 0 * D, mod + (size_t)1 * NB * D6 + 1 * D, WSH(O_H), nullptr)); \
        else PHASE(ph_comb_norm<1>(c, xmid, ml + 5 * D, xout, c.in[36], nullptr, nullptr, nullptr, c.out)); \
    } while (0)
    PHASE(ph_norm(c, c.in[0], c.in[3], WSF(O_MOD) + 0 * D, WSF(O_MOD) + 1 * D, WSH(O_H), nullptr));
    LAYER_BODY(0);
    LAYER_BODY(1);
#undef LAYER_BODY
#if TIME_PHASE >= 0 && !defined(CPU_EMU)
    if (blockIdx.x == 0) { const unsigned long long te = __builtin_amdgcn_s_memrealtime(), dl = 8ull * (tp1 - tp0); while (__builtin_amdgcn_s_memrealtime() - te < dl) __builtin_amdgcn_s_sleep(8); }
#endif
#undef PHASE
}
}

#ifndef CPU_EMU
extern "C" void kernel_launch(void* const* d_in, const int* in_sizes, int n_in, void* d_out, int out_size, void* d_ws, size_t ws_size, hipStream_t stream) {
    static int grid = 0;
    if (grid == 0) {
        if (n_in != 37 || out_size != T * D || ws_size < WS_END) { fprintf(stderr, "kernel_launch: unexpected shapes (n_in %d out %d ws %zu need %zu)\n", n_in, out_size, ws_size, (size_t)WS_END); grid = -1; return; }
        int dev = 0, cus = 0, per_cu = 0;
        if (hipGetDevice(&dev) != hipSuccess || hipDeviceGetAttribute(&cus, hipDeviceAttributeMultiprocessorCount, dev) != hipSuccess) { grid = -1; return; }
        if (hipFuncSetAttribute((const void*)fwd, hipFuncAttributeMaxDynamicSharedMemorySize, LDS_BYTES) != hipSuccess) { fprintf(stderr, "kernel_launch: hipFuncSetAttribute failed\n"); grid = -1; return; }
        if (hipOccupancyMaxActiveBlocksPerMultiprocessor(&per_cu, (const void*)fwd, NT, LDS_BYTES) != hipSuccess || per_cu < 1) fprintf(stderr, "kernel_launch: occupancy query says %d\n", per_cu);
        (void)hipGetLastError();
        grid = cus;
    }
    if (grid < 0) return;
    (void)in_sizes;
    (void)hipMemsetAsync((char*)d_ws + O_CTL, 0, CTL_BYTES, stream);
    Params p{};
    for (int i = 0; i < 37; ++i) p.in[i] = (const float*)d_in[i];
    p.out = (float*)d_out; p.ws = (unsigned char*)d_ws;
#if ONE_LAUNCH
    p.ph_lo = 0; p.ph_hi = NPH;
    hipLaunchKernelGGL(fwd, dim3(grid), dim3(NT), LDS_BYTES, stream, p);
#else
    for (int k = 0; k < NPH; ++k) { p.ph_lo = k; p.ph_hi = k + 1; hipLaunchKernelGGL(fwd, dim3(grid), dim3(NT), LDS_BYTES, stream, p); }
#endif
}
#endif
```

```cpp
#ifndef CPU_EMU
#include <hip/hip_runtime.h>
#endif
#include <cstdio>
#include <cstdint>
#include <cmath>
#include <cstring>

#ifndef SEQ
#define SEQ 4096
#endif
#ifndef ONE_LAUNCH
#define ONE_LAUNCH 1
#endif

namespace {
constexpr int D = 2048, NB = 2, S = SEQ, T = NB * S, NL = 2, W = 1024;
constexpr int INW = 18816, RF = 3456, D6 = 6 * D;
constexpr int C_LX = 0, C_LG = 1024, C_RQ = 2048, C_RK = 2560, C_RV = 3072, C_RG = 4096, C_SU = 5120, C_SV = 6144, C_RW = 7168;
constexpr int PW = 18944, C_MLP = 10752;
constexpr int NCH = S / 128;
constexpr int NLC = S / 64;
constexpr int NE = 32, CAP = (T * 2 / 256 + NE) * 256, MAXBLK = CAP / 256;
constexpr float EPS = 1e-6f;
constexpr float DECAY_SCALE = 0.60653065971263342f;
constexpr int NT = 512;
constexpr int NPH_LAYER = 17, NPH = 2 + NL * NPH_LAYER;
typedef unsigned short bf16_t;
#ifdef CPU_EMU
typedef float f32x4 __attribute__((vector_size(16)));
typedef unsigned u32x4 __attribute__((vector_size(16)));
#else
typedef float f32x4 __attribute__((ext_vector_type(4)));
typedef unsigned u32x4 __attribute__((ext_vector_type(4)));
typedef short bf16x8 __attribute__((ext_vector_type(8)));
#endif

constexpr size_t al256(size_t x) { return (x + 255) & ~(size_t)255; }
constexpr size_t SZ_X = (size_t)T * D * 4, SZ_W = (size_t)T * W * 4;
constexpr size_t O_CTL = 0, CTL_BYTES = 1u << 20;
constexpr size_t O_MOD = CTL_BYTES;
constexpr size_t O_X0 = O_MOD + al256((size_t)NL * NB * D6 * 4);
constexpr size_t O_X1 = O_X0 + SZ_X;
constexpr size_t O_H = O_X1 + SZ_X;
constexpr size_t O_HF = O_H + SZ_X / 2;
constexpr size_t O_P = O_HF + SZ_X;
constexpr size_t SZ_P = (size_t)T * PW * 2;
constexpr size_t O_XC = O_P + SZ_P;
constexpr size_t O_LA = O_XC + SZ_W, O_LU = O_LA + 2 * SZ_W;
constexpr size_t SZ_LC = (size_t)2 * NB * NLC * W * 4;
constexpr size_t O_LCA = O_LU + 2 * SZ_W, O_LCH = O_LCA + SZ_LC, O_LCI = O_LCH + SZ_LC;
constexpr size_t O_YS = O_LCI + SZ_LC;
constexpr size_t O_SC = O_YS + (size_t)T * 4 * W * 2;
constexpr size_t SZ_KV = (size_t)NB * NCH * 8 * 64 * 128 * 4;
constexpr size_t O_KVF = O_SC, O_KVB = O_KVF + SZ_KV, O_STF = O_KVB + SZ_KV, O_STB = O_STF + SZ_KV;
constexpr size_t O_VN = O_STB + SZ_KV;
constexpr size_t O_FS = O_VN + SZ_W;
constexpr size_t O_DEC = O_FS + al256((size_t)T * RF * 4), O_AA = O_DEC + 2 * SZ_W, O_AKK = O_AA + 2 * SZ_W;
constexpr size_t O_GG = O_AKK, O_YY = O_GG + SZ_W;
constexpr int RCK = 64, NRC = S / RCK;
constexpr size_t O_BON = O_YY + 2 * SZ_W;
constexpr size_t O_PART = O_BON + al256((size_t)2 * T * 16 * 4);
constexpr size_t O_MRG = O_PART + SZ_X;
constexpr size_t O_LOG = O_MRG + SZ_X / 2;
constexpr size_t O_EID = O_LOG + al256((size_t)T * 40 * 4), O_EWT = O_EID + al256((size_t)T * 2 * 4), O_DEST = O_EWT + al256((size_t)T * 2 * 4);
constexpr size_t O_SLOT = O_DEST + al256((size_t)T * 2 * 4);
constexpr size_t O_PST = O_SLOT + al256((size_t)CAP * 4), O_PYT = O_PST + (size_t)64 * NRC * 4096 * 2, O_SVB = O_PYT + (size_t)64 * NRC * 4096 * 2, O_YVB = O_SVB + (size_t)64 * NRC * 4096 * 4;
constexpr size_t O_WIN = O_YVB + (size_t)64 * NRC * 4096 * 4;
constexpr size_t O_WBR = O_WIN + (size_t)PW * D * 2;
constexpr size_t O_WOUT = O_WBR + (size_t)D * 4 * W * 2;
constexpr size_t O_WGU = O_WOUT + (size_t)D * D * 2;
constexpr size_t O_WDN = O_WGU + (size_t)NE * 1024 * D * 2;
constexpr size_t O_G8 = O_WDN + (size_t)NE * D * 512 * 2;
constexpr size_t O_ROPE = O_G8 + (size_t)T * 4 * D;
constexpr size_t O_WLR = O_ROPE + (size_t)T * 64 * 4;
constexpr size_t O_WUT = O_WLR + (size_t)32 * 128 * 128 * 2;
constexpr size_t O_WAT = O_WUT + (size_t)2 * W * 64 * 2;
constexpr size_t O_WGT = O_WAT + (size_t)2 * W * 64 * 2;
constexpr size_t O_WRH = O_WGT + (size_t)W * 128 * 2;
constexpr size_t O_WRL = O_WRH + (size_t)48 * D * 2;
constexpr size_t WS_END0 = O_WRL + (size_t)48 * D * 2;
constexpr size_t SZ_MOE = (size_t)CAP * (D + 512 + D) * 2;
constexpr bool MOE_OVERLAY = SZ_MOE <= SZ_P;
constexpr size_t O_XS = MOE_OVERLAY ? O_P : WS_END0;
constexpr size_t O_ACT = O_XS + (size_t)CAP * D * 2;
constexpr size_t O_YE = O_ACT + (size_t)CAP * 512 * 2;
constexpr size_t WS_END = MOE_OVERLAY ? WS_END0 : WS_END0 + SZ_MOE;
static_assert(SEQ != 4096 || WS_END <= (size_t)2040 * 1024 * 1024, "workspace budget: d_ws is 4 x the largest input = 2048 MiB");
constexpr int CW_BAR = 4096;
constexpr int CW_CNT = 32768;
constexpr int CW_FILL = CW_CNT + NL * 64;
constexpr int CW_PLAN = CW_FILL + NL * 64;
static_assert(MAXBLK <= 160, "plan words");

struct Params { const float* in[37]; float* out; unsigned char* ws; int ph_lo, ph_hi; };

struct Ctx { const float* const* in; float* out; unsigned char* ws; };
#define GT_ ((long)blockIdx.x * NT + threadIdx.x)
#define GS_ ((long)gridDim.x * NT)
#define WSF(off) ((float*)(c.ws + (off)))
#define WSI(off) ((int*)(c.ws + (off)))
#define WSH(off) ((bf16_t*)(c.ws + (off)))
#define CTLW(c) ((int*)((c).ws + O_CTL))

#ifdef CPU_EMU
__device__ __forceinline__ float fexp_(float x) { return expf(x); }
__device__ __forceinline__ float frcp_(float x) { return 1.f / x; }
__device__ __forceinline__ float frsq_(float x) { return 1.f / sqrtf(x); }
#else
__device__ __forceinline__ float fexp_(float x) { return __builtin_amdgcn_exp2f(x * 1.4426950408889634f); }
__device__ __forceinline__ float frcp_(float x) { return __builtin_amdgcn_rcpf(x); }
__device__ __forceinline__ float frsq_(float x) { return __builtin_amdgcn_rsqf(x); }
#endif
__device__ __forceinline__ float sigmoidf_(float x) { return frcp_(1.f + fexp_(-x)); }
__device__ __forceinline__ float siluf_(float x) { return x * frcp_(1.f + fexp_(-x)); }
__device__ __forceinline__ float tanhf_(float x) { return 1.f - 2.f * frcp_(1.f + fexp_(2.f * x)); }
__device__ __forceinline__ float geluf_(float x) { return 0.5f * x * (1.f + tanhf_(0.7978845608028654f * (x + 0.044715f * x * x * x))); }
__device__ __forceinline__ float softplusf_(float x) { return x > 0.f ? x + log1pf(expf(-x)) : log1pf(expf(x)); }
__device__ __forceinline__ float loggamma_(int h) { return log1pf(-exp2f(-5.f - (float)h)); }
__device__ __forceinline__ unsigned f2u_(float f) { unsigned u; memcpy(&u, &f, 4); return u; }
__device__ __forceinline__ float u2f_(unsigned u) { float f; memcpy(&f, &u, 4); return f; }
__device__ __forceinline__ float bf2f(bf16_t v) { return u2f_((unsigned)v << 16); }
__device__ __forceinline__ unsigned f2bf(float f) { const unsigned u = f2u_(f); return (u + 0x7fffu + ((u >> 16) & 1u)) >> 16; }
__device__ __forceinline__ unsigned pk2(float lo, float hi) { return f2bf(lo) | (f2bf(hi) << 16); }
__device__ __forceinline__ float bflo(unsigned w) { return u2f_(w << 16); }
__device__ __forceinline__ float bfhi(unsigned w) { return u2f_(w & 0xffff0000u); }
__device__ __forceinline__ int atomic_add_i(int* p, int v) {
#ifdef CPU_EMU
    return __atomic_fetch_add(p, v, __ATOMIC_RELAXED);
#else
    return atomicAdd(p, v);
#endif
}
#define PF(P, r, col) bf2f((P)[(size_t)(r) * PW + (col)])
#ifdef CPU_EMU
#define SYNCTHREADS() emu_syncthreads()
#define SHFL_XOR(v, m) emu_shfl_xor(v, m)
#else
#define SYNCTHREADS() __syncthreads()
#define SHFL_XOR(v, m) __shfl_xor(v, m)
#endif
#ifdef CPU_EMU
__device__ __forceinline__ float wave_sum(float v) {
    for (int o = 1; o < 64; o <<= 1) v += SHFL_XOR(v, o);
    return v;
}
#else
__device__ __forceinline__ float wave_sum(float x) {
    x += __builtin_bit_cast(float, __builtin_amdgcn_update_dpp(0, __builtin_bit_cast(int, x), 0xB1, 0xF, 0xF, true));
    x += __builtin_bit_cast(float, __builtin_amdgcn_update_dpp(0, __builtin_bit_cast(int, x), 0x4E, 0xF, 0xF, true));
    x += __builtin_bit_cast(float, __builtin_amdgcn_update_dpp(0, __builtin_bit_cast(int, x), 0x141, 0xF, 0xF, true));
    x += __builtin_bit_cast(float, __builtin_amdgcn_update_dpp(0, __builtin_bit_cast(int, x), 0x140, 0xF, 0xF, true));
    const int xi = __builtin_bit_cast(int, x);
    return (__builtin_bit_cast(float, __builtin_amdgcn_readlane(xi, 0)) + __builtin_bit_cast(float, __builtin_amdgcn_readlane(xi, 16))) + (__builtin_bit_cast(float, __builtin_amdgcn_readlane(xi, 32)) + __builtin_bit_cast(float, __builtin_amdgcn_readlane(xi, 48)));
}
#endif
__device__ __forceinline__ f32x4 ld_bf4(const bf16_t* p) { const unsigned long long q = *(const unsigned long long*)p; const unsigned lo = (unsigned)q, hi = (unsigned)(q >> 32); return (f32x4){bflo(lo), bfhi(lo), bflo(hi), bfhi(hi)}; }
__device__ __forceinline__ void st_bf4(bf16_t* p, const f32x4 v) { *(unsigned long long*)p = (unsigned long long)pk2(v[0], v[1]) | ((unsigned long long)pk2(v[2], v[3]) << 32); }

template <int KT, int NTL>
__device__ __forceinline__ void wave_mma(f32x4 (&acc)[NTL], const bf16_t* A, int lda, const bf16_t* Bt, int ldb) {
    const int lane = threadIdx.x & 63, fr = lane & 15, fq = lane >> 4;
#ifdef CPU_EMU
    for (int nt = 0; nt < NTL; ++nt) for (int r = 0; r < 4; ++r) { float sacc = 0.f; const bf16_t* a = A + fr * lda; const bf16_t* b = Bt + (16 * nt + 4 * fq + r) * ldb;
        for (int k = 0; k < 32 * KT; ++k) sacc += bf2f(a[k]) * bf2f(b[k]);
        acc[nt][r] += sacc; }
#else
#pragma unroll
    for (int kt = 0; kt < KT; ++kt) {
        const bf16x8 af = *(const bf16x8*)(A + fr * lda + kt * 32 + fq * 8);
#pragma unroll
        for (int nt = 0; nt < NTL; ++nt) { const bf16x8 bfr = *(const bf16x8*)(Bt + (16 * nt + fr) * ldb + kt * 32 + fq * 8);
            acc[nt] = __builtin_amdgcn_mfma_f32_16x16x32_bf16(bfr, af, acc[nt], 0, 0, 0); }
    }
#endif
}
__device__ __forceinline__ void ph_mod(const Ctx& c, float* ldsf) {
    const float* cc = c.in[1]; const float* aw = c.in[5]; const float* ab = c.in[6]; float* mod = WSF(O_MOD);
    float* scs = ldsf; float* part = ldsf + NB * D; const int tid = threadIdx.x, c4 = (tid & 31) * 4, kq = tid >> 5;
    for (int i = tid; i < NB * D; i += NT) scs[i] = siluf_(cc[i]);
    SYNCTHREADS();
    for (int u = blockIdx.x; u < NL * (D6 / 128); u += gridDim.x) {
        const int l = u / (D6 / 128), j0 = (u % (D6 / 128)) * 128;
        const float* w = aw + (size_t)l * D * D6 + j0 + c4; f32x4 a0 = (f32x4){0.f, 0.f, 0.f, 0.f}, a1 = a0;
#pragma unroll 8
        for (int k = kq * 128; k < kq * 128 + 128; ++k) { const f32x4 wv = *(const f32x4*)(w + (size_t)k * D6); a0 += wv * scs[k]; a1 += wv * scs[D + k]; }
        *(f32x4*)(part + (kq * 2 + 0) * 128 + c4) = a0; *(f32x4*)(part + (kq * 2 + 1) * 128 + c4) = a1;
        SYNCTHREADS();
        if (tid < 256) { const int b = tid >> 7, col = tid & 127; float sacc = 0.f;
#pragma unroll
            for (int q = 0; q < 16; ++q) sacc += part[(q * 2 + b) * 128 + col];
            mod[((size_t)l * NB + b) * D6 + j0 + col] = sacc + ab[l * D6 + j0 + col]; }
        SYNCTHREADS();
    }
}
__device__ __forceinline__ void ph_norm(const Ctx& c, const float* x, const float* g, const float* sh, const float* sc, bf16_t* hb, float* hf) {
    const int lane = threadIdx.x & 63, gw = blockIdx.x * (NT / 64) + (threadIdx.x >> 6), ngw = gridDim.x * (NT / 64);
    for (int t0 = gw * 2; t0 < T; t0 += ngw * 2) {
        f32x4 v[2][8]; float ss[2] = {0.f, 0.f};
#pragma unroll
        for (int r = 0; r < 2; ++r)
#pragma unroll
            for (int j = 0; j < 8; ++j) v[r][j] = *(const f32x4*)(x + (size_t)(t0 + r) * D + (j * 64 + lane) * 4);
#pragma unroll
        for (int r = 0; r < 2; ++r) {
#pragma unroll
            for (int j = 0; j < 8; ++j) ss[r] += (v[r][j][0] * v[r][j][0] + v[r][j][1] * v[r][j][1]) + (v[r][j][2] * v[r][j][2] + v[r][j][3] * v[r][j][3]);
            const int t = t0 + r, b = t / S; const float rs = 1.f / sqrtf(wave_sum(ss[r]) * (1.f / D) + EPS);
#pragma unroll
            for (int j = 0; j < 8; ++j) { const int col = (j * 64 + lane) * 4;
                const f32x4 o = v[r][j] * rs * *(const f32x4*)(g + col) * (*(const f32x4*)(sc + b * D6 + col) + 1.f) + *(const f32x4*)(sh + b * D6 + col);
                st_bf4(hb + (size_t)t * D + col, o); }
            if (hf && lane == 0) hf[t] = rs;
        }
    }
}
template <int MODE>
__device__ __forceinline__ void ph_comb_norm(const Ctx& c, const float* xmid, const float* g2, float* xout, const float* g, const float* sh, const float* sc, bf16_t* hb, float* outp) {
    const bf16_t* YE = WSH(O_YE); const float* EWT = WSF(O_EWT); const int* DEST = WSI(O_DEST);
    const int lane = threadIdx.x & 63, gw = blockIdx.x * (NT / 64) + (threadIdx.x >> 6), ngw = gridDim.x * (NT / 64);
    for (int t = gw; t < T; t += ngw) {
        const int b = t / S; const float w0 = EWT[t * 2], w1 = EWT[t * 2 + 1]; const bf16_t* y0 = YE + (size_t)DEST[t * 2] * D; const bf16_t* y1 = YE + (size_t)DEST[t * 2 + 1] * D;
        f32x4 v[8]; float ss = 0.f;
#pragma unroll
        for (int j = 0; j < 8; ++j) { const int col = (j * 64 + lane) * 4;
            v[j] = *(const f32x4*)(xmid + (size_t)t * D + col) + *(const f32x4*)(g2 + b * D6 + col) * (ld_bf4(y0 + col) * w0 + ld_bf4(y1 + col) * w1);
            if (MODE == 0) *(f32x4*)(xout + (size_t)t * D + col) = v[j];
            ss += (v[j][0] * v[j][0] + v[j][1] * v[j][1]) + (v[j][2] * v[j][2] + v[j][3] * v[j][3]); }
        const float rs = 1.f / sqrtf(wave_sum(ss) * (1.f / D) + EPS);
#pragma unroll
        for (int j = 0; j < 8; ++j) { const int col = (j * 64 + lane) * 4;
            if (MODE == 0) st_bf4(hb + (size_t)t * D + col, v[j] * rs * *(const f32x4*)(g + col) * (*(const f32x4*)(sc + b * D6 + col) + 1.f) + *(const f32x4*)(sh + b * D6 + col));
            else *(f32x4*)(outp + (size_t)t * D + col) = v[j] * rs * *(const f32x4*)(g + col); }
    }
}

struct CvtItem { const float* Wp; int ldw; bf16_t* WT; int ldt; int drow, k0, n0; };
constexpr int I_IN = 32 * (INW / 32), I_BR = 4 * 16 * 64, I_OUT = 32 * 64, I_GU = NE * 32 * 32, I_DN = NE * 8 * 64, I_LR = 32 * 8, I_WU = 2 * 32, I_WG = 64, I_BIG = I_IN + I_BR + I_OUT + I_GU + I_DN, I_ALL = I_BIG + I_LR + 2 * I_WU + I_WG;
__device__ __forceinline__ CvtItem cvt_decode(const Ctx& c, int l, int it) {
    CvtItem r;
    if (it < I_IN) { const int kb = it / (INW / 32), nb = it % (INW / 32); r.n0 = nb * 32; r.k0 = kb * 64; r.Wp = c.in[7] + (size_t)l * D * INW; r.ldw = INW; r.WT = WSH(O_WIN); r.ldt = D; r.drow = r.n0 < 10624 ? r.n0 : r.n0 + 128; return r; }
    it -= I_IN;
    if (it < I_BR) { const int sgm = it / 1024, q = it % 1024, kb = q / 64, nb = q % 64; r.n0 = nb * 32; r.k0 = kb * 64; r.Wp = c.in[28] + ((size_t)l * 4 + sgm) * W * D; r.ldw = D; r.WT = WSH(O_WBR) + sgm * W; r.ldt = 4 * W; r.drow = r.n0; return r; }
    it -= I_BR;
    if (it < I_OUT) { const int kb = it / 64, nb = it % 64; r.n0 = nb * 32; r.k0 = kb * 64; r.Wp = c.in[29] + (size_t)l * D * D; r.ldw = D; r.WT = WSH(O_WOUT); r.ldt = D; r.drow = r.n0; return r; }
    it -= I_OUT;
    if (it < I_GU) { const int e = it / 1024, q = it % 1024, kb = q / 32, nb = q % 32; r.n0 = nb * 32; r.k0 = kb * 64; r.Wp = c.in[34] + ((size_t)l * NE + e) * D * 1024; r.ldw = 1024; r.WT = WSH(O_WGU) + (size_t)e * 1024 * D; r.ldt = D;
        r.drow = r.n0 < 512 ? (r.n0 / 128) * 256 + (r.n0 % 128) : ((r.n0 - 512) / 128) * 256 + 128 + ((r.n0 - 512) % 128); return r; }
    it -= I_GU;
    if (it < I_DN) { const int e = it / 512, q = it % 512, kb = q / 64, nb = q % 64; r.n0 = nb * 32; r.k0 = kb * 64; r.Wp = c.in[35] + ((size_t)l * NE + e) * 512 * D; r.ldw = D; r.WT = WSH(O_WDN) + (size_t)e * D * 512; r.ldt = 512; r.drow = r.n0; return r; }
    it -= I_DN;
    if (it < I_LR) { const int m = it / 8, q = it % 8, kb = q / 4, nb = q % 4, z = m >> 4, ty = (m >> 3) & 1, n = m & 7; r.n0 = nb * 32; r.k0 = kb * 64; r.Wp = c.in[ty ? 12 : 10] + (((size_t)l * 2 + z) * 8 + n) * 128 * 128; r.ldw = 128;
        r.WT = WSH(O_WLR) + (size_t)m * 128 * 128; r.ldt = 128; r.drow = r.n0; return r; }
    it -= I_LR;
    if (it < 2 * I_WU) { const int ua = it / I_WU, q = it % I_WU, z = q / 32, nb = q % 32; r.n0 = nb * 32; r.k0 = 0; r.Wp = c.in[ua ? 23 : 21] + ((size_t)l * 2 + z) * 64 * W; r.ldw = W; r.WT = WSH(ua ? O_WAT : O_WUT) + (size_t)z * W * 64; r.ldt = 64; r.drow = r.n0; return r; }
    it -= 2 * I_WU;
    { const int kb = it / 32, nb = it % 32; r.n0 = nb * 32; r.k0 = kb * 64; r.Wp = c.in[24] + (size_t)l * 128 * W; r.ldw = W; r.WT = WSH(O_WGT); r.ldt = 128; r.drow = r.n0; return r; }
}
constexpr int J_IN = 16 * (INW / 128), J_BR = 4 * 8 * 16, J_OUT = 16 * 16, J_GU = NE * 16 * 8, J_DN = NE * 4 * 16, J_ALL = J_IN + J_BR + J_OUT + J_GU + J_DN;
__device__ __forceinline__ CvtItem cvt_decode_big(const Ctx& c, int l, int it) {
    CvtItem r;
    if (it < J_IN) { const int kb = it / (INW / 128), nb = it % (INW / 128); r.n0 = nb * 128; r.k0 = kb * 128; r.Wp = c.in[7] + (size_t)l * D * INW; r.ldw = INW; r.WT = WSH(O_WIN); r.ldt = D; r.drow = r.n0 < 10624 ? r.n0 : r.n0 + 128; return r; }
    it -= J_IN;
    if (it < J_BR) { const int sgm = it / 128, q = it % 128, kb = q / 16, nb = q % 16; r.n0 = nb * 128; r.k0 = kb * 128; r.Wp = c.in[28] + ((size_t)l * 4 + sgm) * W * D; r.ldw = D; r.WT = WSH(O_WBR) + sgm * W; r.ldt = 4 * W; r.drow = r.n0; return r; }
    it -= J_BR;
    if (it < J_OUT) { const int kb = it / 16, nb = it % 16; r.n0 = nb * 128; r.k0 = kb * 128; r.Wp = c.in[29] + (size_t)l * D * D; r.ldw = D; r.WT = WSH(O_WOUT); r.ldt = D; r.drow = r.n0; return r; }
    it -= J_OUT;
    if (it < J_GU) { const int e = it / 128, q = it % 128, kb = q / 8, nb = q % 8; r.n0 = nb * 128; r.k0 = kb * 128; r.Wp = c.in[34] + ((size_t)l * NE + e) * D * 1024; r.ldw = 1024; r.WT = WSH(O_WGU) + (size_t)e * 1024 * D; r.ldt = D;
        r.drow = r.n0 < 512 ? (r.n0 / 128) * 256 : ((r.n0 - 512) / 128) * 256 + 128; return r; }
    it -= J_GU;
    { const int e = it / 64, q = it % 64, kb = q / 16, nb = q % 16; r.n0 = nb * 128; r.k0 = kb * 128; r.Wp = c.in[35] + ((size_t)l * NE + e) * 512 * D; r.ldw = D; r.WT = WSH(O_WDN) + (size_t)e * D * 512; r.ldt = 512; r.drow = r.n0; return r; }
}
__device__ __forceinline__ void convert_big(const Ctx& c, int l, float* ldsf, int first, int last, int widx, int wcnt) {
    const int tid = threadIdx.x, lr = tid >> 5, lc = (tid & 31) * 4;
    f32x4 rg[8]; int it = first + widx; CvtItem r;
    if (it < last) { r = cvt_decode_big(c, l, it);
#pragma unroll
        for (int i = 0; i < 8; ++i) rg[i] = *(const f32x4*)(r.Wp + (size_t)(r.k0 + lr + 16 * i) * r.ldw + r.n0 + lc); }
    for (; it < last; it += wcnt) {
#pragma unroll
        for (int i = 0; i < 8; ++i) { float* dp = ldsf + (lr + 16 * i) * 129 + lc; dp[0] = rg[i][0]; dp[1] = rg[i][1]; dp[2] = rg[i][2]; dp[3] = rg[i][3]; }
        const CvtItem cur = r; const int nx = it + wcnt;
        if (nx < last) { r = cvt_decode_big(c, l, nx);
#pragma unroll
            for (int i = 0; i < 8; ++i) rg[i] = *(const f32x4*)(r.Wp + (size_t)(r.k0 + lr + 16 * i) * r.ldw + r.n0 + lc); }
        SYNCTHREADS();
#pragma unroll
        for (int q = 0; q < 4; ++q) { const int id = tid + NT * q, n = id >> 4, k8 = (id & 15) * 8; const float* sp = ldsf + k8 * 129 + n;
            u32x4 o; o[0] = pk2(sp[0 * 129], sp[1 * 129]); o[1] = pk2(sp[2 * 129], sp[3 * 129]); o[2] = pk2(sp[4 * 129], sp[5 * 129]); o[3] = pk2(sp[6 * 129], sp[7 * 129]);
            *(u32x4*)(cur.WT + (size_t)(cur.drow + n) * cur.ldt + cur.k0 + k8) = o; }
        SYNCTHREADS();
    }
}
__device__ __forceinline__ int convert_tail_tiles() { const int nun = (T / 256) * (PW / 256), G = (int)gridDim.x, rem = nun % G; return rem == 0 ? 0 : (G - rem) * 10 < J_GU + J_DN ? (G - rem) * 10 : J_GU + J_DN; }
__device__ __forceinline__ int convert_early_tiles(const Ctx& c) { const int G = (int)gridDim.x, nrest = (CTLW(c) + CW_PLAN)[40] * 4 - G; return (nrest >= 0 && nrest < G) ? ((G - nrest) * 12 < J_IN ? (G - nrest) * 12 : J_IN) : 0; }
__device__ __forceinline__ void ph_convert(const Ctx& c, int l, float* ldsf) {
    const int lane = threadIdx.x & 63, wave = threadIdx.x >> 6; const int gw = blockIdx.x * (NT / 64) + wave, ngw = gridDim.x * (NT / 64);
    convert_big(c, l, ldsf, l == 1 ? convert_early_tiles(c) : 0, J_ALL - convert_tail_tiles(), (int)blockIdx.x, (int)gridDim.x);
#ifdef CPU_EMU
    if (lane == 0) for (int it = I_BIG + gw; it < I_ALL; it += ngw) { const CvtItem r = cvt_decode(c, l, it);
        for (int kk = 0; kk < 64; ++kk) for (int nn = 0; nn < 32; ++nn) r.WT[(size_t)(r.drow + nn) * r.ldt + r.k0 + kk] = (bf16_t)f2bf(r.Wp[(size_t)(r.k0 + kk) * r.ldw + r.n0 + nn]); }
#else
    float* scr = ldsf + wave * (64 * 33 + 16);
    for (int it = I_BIG + gw; it < I_ALL; it += ngw) {
        const CvtItem r = cvt_decode(c, l, it);
#pragma unroll 8
        for (int i = 0; i < 32; ++i) { const int kk = 2 * i + (lane >> 5); scr[kk * 33 + (lane & 31)] = r.Wp[(size_t)(r.k0 + kk) * r.ldw + r.n0 + (lane & 31)]; }
        asm volatile("s_waitcnt lgkmcnt(0)" ::: "memory");
        const int cc = lane & 7;
#pragma unroll
        for (int j = 0; j < 4; ++j) { const int n = (lane >> 3) + 8 * j; const float* sp = scr + (8 * cc) * 33 + n;
            u32x4 o; o[0] = pk2(sp[0 * 33], sp[1 * 33]); o[1] = pk2(sp[2 * 33], sp[3 * 33]); o[2] = pk2(sp[4 * 33], sp[5 * 33]); o[3] = pk2(sp[6 * 33], sp[7 * 33]);
            *(u32x4*)(r.WT + (size_t)(r.drow + n) * r.ldt + r.k0 + 8 * cc) = o; }
        asm volatile("s_waitcnt lgkmcnt(0)" ::: "memory");
    }
#endif
    { const float* wg = c.in[30] + (size_t)l * D * 4; const float* we = c.in[32] + (size_t)l * D * 32; bf16_t* wh = WSH(O_WRH); bf16_t* wl = WSH(O_WRL);
      for (long i = GT_; i < (long)48 * D; i += GS_) { const int n = (int)(i / D), k = (int)(i % D); const float w = n < 4 ? wg[k * 4 + n] : n < 36 ? we[k * 32 + (n - 4)] : 0.f; const unsigned hb = f2bf(w); wh[i] = (bf16_t)hb; wl[i] = (bf16_t)f2bf(w - bf2f((bf16_t)hb)); } }
    for (long i = GT_; i < (long)128 * D / 2; i += GS_) ((unsigned*)(WSH(O_WIN) + (size_t)10624 * D))[i] = 0u;
}

namespace pg8 {
constexpr int BM = 256, BK = 64, HALF = 128, HTB = HALF * BK * 2, STAGE_BYTES = 8 * HTB;
__host__ __device__ __forceinline__ int lds_byte(int r, int cc) { const int st = (r >> 4) * 2 + (cc >> 5), rr = r & 15, c2 = cc & 31, ob = rr * 64 + c2 * 2; return st * 1024 + (ob ^ (((ob >> 9) & 1) << 5)); }
__host__ __device__ __forceinline__ void stage_rc(int b, int& R, int& C) { const int st = b / 1024, sb = b % 1024, swz = sb ^ (((sb >> 9) & 1) << 5); R = (st >> 1) * 16 + swz / 64; C = (st & 1) * 32 + (swz % 64) / 2; }
__host__ __device__ __forceinline__ int perm32(int rho) { const int n = rho >> 4, i = rho & 15; return 8 * (i >> 2) + 4 * n + (i & 3); }
struct Unit { int pm, pn, aux; const char* A; const char* B; };
struct Gemm { int K, lda, ldb; };

template <class Epi, class Sched>
__device__ __forceinline__ void gemm_phase(unsigned char* lds_, const Gemm g, const Sched& S, const Epi& E) {
#ifdef CPU_EMU
    if (threadIdx.x != 0) return;
    Unit u; const int K = g.K;
    float* Af = (float*)malloc((size_t)256 * K * 4); float* Bf = (float*)malloc((size_t)256 * K * 4); float* Cf = (float*)malloc(256 * 256 * 4);
    for (int i = 0; S.next(i, u); ++i) {
        const bf16_t* A = (const bf16_t*)u.A; const bf16_t* B = (const bf16_t*)u.B;
        for (int r = 0; r < 256; ++r) for (int k = 0; k < K; ++k) { Af[(size_t)r * K + k] = bf2f(A[(size_t)r * g.lda + k]); Bf[(size_t)r * K + k] = bf2f(B[(size_t)r * g.ldb + k]); }
        const int nseg = Epi::SEGT > 0 ? K / (Epi::SEGT * 64) : 1, kseg = K / nseg;
        for (int wid = 0; wid < 8; ++wid) for (int lane = 0; lane < 64; ++lane) {
            const int wr = wid >> 2, wc = wid & 3, fr = lane & 15, fq = lane >> 4; f32x4 acc[2][2][4][2];
            for (int ai = 0; ai < 2; ++ai) for (int bj = 0; bj < 2; ++bj) for (int m = 0; m < 4; ++m) for (int n = 0; n < 2; ++n) for (int j = 0; j < 4; ++j) acc[ai][bj][m][n][j] = 0.f;
            for (int sg = 0; sg < nseg; ++sg) {
                for (int ai = 0; ai < 2; ++ai) for (int bj = 0; bj < 2; ++bj) for (int m = 0; m < 4; ++m) for (int n = 0; n < 2; ++n) for (int j = 0; j < 4; ++j) {
                    const int r = 128 * ai + 64 * wr + 16 * m + fr, cc = 128 * bj + 32 * wc + (Epi::PERM ? 8 * fq + 4 * n + j : 16 * n + 4 * fq + j);
                    const float* a = Af + (size_t)r * K + sg * kseg; const float* b = Bf + (size_t)cc * K + sg * kseg; float sacc = 0.f; for (int k = 0; k < kseg; ++k) sacc += a[k] * b[k];
                    acc[ai][bj][m][n][j] += sacc; }
                if constexpr (Epi::SEGT > 0) { if (sg + 1 < nseg) E.segment(acc, u, sg, wr, wc, fr, fq); }
            }
            E(acc, u, wr, wc, fr, fq);
        }
    }
    free(Af); free(Bf); free(Cf);
#else
    typedef __attribute__((address_space(3))) unsigned char* ldsp_t;
    ldsp_t lds = (ldsp_t)lds_;
    const int tid = threadIdx.x, wid = __builtin_amdgcn_readfirstlane(tid >> 6), lane = tid & 63, wr = wid >> 2, wc = wid & 3, fr = lane & 15, fq = lane >> 4;
    const int K = g.K, nt = K / BK;
    unsigned voffA[2], voffB[2];
#pragma unroll
    for (int i = 0; i < 2; ++i) { int R, C; stage_rc(tid * 16 + i * 8192, R, C); const int Rb = Epi::PERM ? ((R & ~31) + perm32(R & 31)) : R;
        voffA[i] = (unsigned)(R * g.lda + C) * 2u; voffB[i] = (unsigned)(Rb * g.ldb + C) * 2u; }
    const size_t kstep = (size_t)(BK * 2);
    const size_t hstepA = (size_t)HALF * g.lda * 2, hstepB = (size_t)HALF * g.ldb * 2;
    const unsigned ldsw = (unsigned)wid * 1024u;
    const int aoff = lds_byte(wr * 64 + fr, fq * 8), boff = lds_byte(wc * 32 + fr, fq * 8);
#define PG8_SA(b, h) (((b) * 2 + (h)) * HTB)
#define PG8_SB(b, h) ((4 + (b) * 2 + (h)) * HTB)
#define PG8_STAGE(bufoff, gbase, voff) do { _Pragma("unroll") for (int _i = 0; _i < 2; ++_i) \
        __builtin_amdgcn_global_load_lds((const unsigned*)((const char*)(gbase) + (voff)[_i]), (__attribute__((address_space(3))) unsigned*)(lds + (bufoff) + ldsw + _i * 8192), 16, 0, 0); } while (0)
#define PG8_LDA(dst, b, h) do { _Pragma("unroll") for (int m = 0; m < 4; ++m) _Pragma("unroll") for (int k = 0; k < 2; ++k) dst[m][k] = *(const __attribute__((address_space(3))) bf16x8*)(lds + PG8_SA(b, h) + aoff + m * 2048 + k * 1024); } while (0)
#define PG8_LDB(dst, b, h) do { _Pragma("unroll") for (int n = 0; n < 2; ++n) _Pragma("unroll") for (int k = 0; k < 2; ++k) dst[n][k] = *(const __attribute__((address_space(3))) bf16x8*)(lds + PG8_SB(b, h) + boff + n * 2048 + k * 1024); } while (0)
#define PG8_MMA(ai, bj, At, Bt) do { __builtin_amdgcn_s_setprio(1); _Pragma("unroll") for (int m = 0; m < 4; ++m) _Pragma("unroll") for (int n = 0; n < 2; ++n) _Pragma("unroll") for (int k = 0; k < 2; ++k) \
        acc[ai][bj][m][n] = __builtin_amdgcn_mfma_f32_16x16x32_bf16(Bt[n][k], At[m][k], acc[ai][bj][m][n], 0, 0, 0); __builtin_amdgcn_s_setprio(0); } while (0)
#define PG8_WAIT_V(n) asm volatile("s_waitcnt vmcnt(" #n ")" ::: "memory")
#define PG8_WAIT_L(n) asm volatile("s_waitcnt lgkmcnt(" #n ")" ::: "memory")
#define PG8_BAR __builtin_amdgcn_s_barrier()
#define PG8_SCHED __builtin_amdgcn_sched_barrier(0)
    Unit cur, nxt; int ui = 0;
    if (!S.next(0, cur)) return;
    f32x4 acc[2][2][4][2];
#pragma unroll
    for (int a = 0; a < 2; ++a)
#pragma unroll
        for (int b = 0; b < 2; ++b)
#pragma unroll
            for (int m = 0; m < 4; ++m)
#pragma unroll
                for (int n = 0; n < 2; ++n) acc[a][b][m][n] = (f32x4){0.f, 0.f, 0.f, 0.f};
    bf16x8 At[4][2], B0[2][2], B1[2][2];
    const char* cA = cur.A; const char* cB = cur.B;
    S.a_ready(cur);
    PG8_STAGE(PG8_SB(0, 0), cB, voffB); PG8_STAGE(PG8_SA(0, 0), cA, voffA); PG8_STAGE(PG8_SB(0, 1), cB + hstepB, voffB); PG8_STAGE(PG8_SA(0, 1), cA + hstepA, voffA);
    if (wr == 1) PG8_BAR;
    PG8_WAIT_V(4); PG8_BAR;
    PG8_STAGE(PG8_SB(1, 0), cB + kstep, voffB); PG8_STAGE(PG8_SA(1, 0), cA + kstep, voffA); PG8_STAGE(PG8_SB(1, 1), cB + hstepB + kstep, voffB);
    PG8_WAIT_V(6); PG8_BAR;
    for (;;) {
        const bool has_next = S.next(ui + 1, nxt);
        const char* nA = has_next ? nxt.A : cA; const char* nB = has_next ? nxt.B : cB;
        for (int t = 0; t < nt; t += 2) {
            const bool last = (t == nt - 2);
            const char* a1 = cA + (size_t)(t + 1) * kstep;
            const char* a2 = last ? nA : cA + (size_t)(t + 2) * kstep; const char* b2 = last ? nB : cB + (size_t)(t + 2) * kstep;
            const char* a3 = a2 + kstep; const char* b3 = b2 + kstep;
            if (last && has_next) S.a_ready(nxt);
            PG8_LDB(B0, 0, 0); PG8_SCHED; PG8_LDA(At, 0, 0); PG8_STAGE(PG8_SA(1, 1), a1 + hstepA, voffA);
            PG8_WAIT_L(8); PG8_BAR; PG8_WAIT_L(0); PG8_MMA(0, 0, At, B0); PG8_BAR; PG8_SCHED;
            PG8_LDB(B1, 0, 1); PG8_STAGE(PG8_SB(0, 0), b2, voffB);
            PG8_BAR; PG8_WAIT_L(0); PG8_MMA(0, 1, At, B1); PG8_BAR;
            PG8_LDA(At, 0, 1); PG8_STAGE(PG8_SA(0, 0), a2, voffA);
            PG8_BAR; PG8_WAIT_L(0); PG8_MMA(1, 0, At, B0); PG8_BAR; PG8_SCHED;
            PG8_STAGE(PG8_SB(0, 1), b2 + hstepB, voffB);
            PG8_WAIT_V(6); PG8_BAR; PG8_MMA(1, 1, At, B1); PG8_BAR;
            PG8_LDB(B0, 1, 0); PG8_SCHED; PG8_LDA(At, 1, 0); PG8_STAGE(PG8_SA(0, 1), a2 + hstepA, voffA);
            PG8_WAIT_L(8); PG8_BAR; PG8_WAIT_L(0); PG8_MMA(0, 0, At, B0); PG8_BAR; PG8_SCHED;
            PG8_LDB(B1, 1, 1); PG8_STAGE(PG8_SB(1, 0), b3, voffB);
            PG8_BAR; PG8_WAIT_L(0); PG8_MMA(0, 1, At, B1); PG8_BAR;
            PG8_LDA(At, 1, 1); PG8_STAGE(PG8_SA(1, 0), a3, voffA);
            PG8_BAR; PG8_WAIT_L(0); PG8_MMA(1, 0, At, B0); PG8_BAR; PG8_SCHED;
            PG8_STAGE(PG8_SB(1, 1), b3 + hstepB, voffB);
            PG8_WAIT_V(6); PG8_BAR; PG8_MMA(1, 1, At, B1); PG8_BAR;
            if constexpr (Epi::SEGT > 0) { if ((t + 2) % Epi::SEGT == 0 && t + 2 < nt) E.segment(acc, cur, (t + 2) / Epi::SEGT - 1, wr, wc, fr, fq); }
        }
        E(acc, cur, wr, wc, fr, fq); S.done(cur);
        if (!has_next) break;
#pragma unroll
        for (int a = 0; a < 2; ++a)
#pragma unroll
            for (int b = 0; b < 2; ++b)
#pragma unroll
                for (int m = 0; m < 4; ++m)
#pragma unroll
                    for (int n = 0; n < 2; ++n) acc[a][b][m][n] = (f32x4){0.f, 0.f, 0.f, 0.f};
        cur = nxt; cA = nA; cB = nB; ++ui;
    }
    PG8_WAIT_V(0);
    if (wr == 0) PG8_BAR;
    PG8_BAR;
#undef PG8_SA
#undef PG8_SB
#undef PG8_STAGE
#undef PG8_LDA
#undef PG8_LDB
#undef PG8_MMA
#undef PG8_WAIT_V
#undef PG8_WAIT_L
#undef PG8_BAR
#undef PG8_SCHED
#endif
}

struct StaticOrder {
    int nM, nN, nwg, G, c; const char* A; const char* B; size_t tstepA, tstepB;
    __device__ __forceinline__ void init(int M, int N, int G_, int c_, const void* A_, const void* B_, int lda, int ldb) { nM = M / BM; nN = N / BM; nwg = nM * nN; G = G_; c = c_; A = (const char*)A_; B = (const char*)B_; tstepA = (size_t)BM * lda * 2; tstepB = (size_t)BM * ldb * 2; }
    __device__ __forceinline__ bool next(int i, Unit& u) const {
        const long L = (long)i * G + c; if (L >= nwg) return false;
        int wgid = (int)L; { const int q = nwg / 8, r = nwg % 8, xcd = wgid % 8, off = wgid / 8; wgid = (xcd < r ? xcd * (q + 1) : r * (q + 1) + (xcd - r) * q) + off; }
        const int nig = 8 * nN, gid = wgid / nig, fm = gid * 8, gsz = (nM - fm) < 8 ? (nM - fm) : 8;
        u.pm = fm + ((wgid % nig) % gsz); u.pn = (wgid % nig) / gsz; u.aux = 0; u.A = A + (size_t)u.pm * tstepA; u.B = B + (size_t)u.pn * tstepB; return true;
    }
    __device__ __forceinline__ void a_ready(const Unit&) const {}
    __device__ __forceinline__ void done(const Unit&) const {}
};
struct MergeOrder {
    StaticOrder so; int kseg_bytes;
    __device__ __forceinline__ bool next(int i, Unit& u) const { if (!so.next(i >> 2, u)) return false; u.aux = i & 3; u.A += (size_t)u.aux * kseg_bytes; u.B += (size_t)u.aux * kseg_bytes; return true; }
    __device__ __forceinline__ void a_ready(const Unit&) const {}
    __device__ __forceinline__ void done(const Unit&) const {}
};
struct MoeOrder {
    int G, c, ncol; const int* plan; const char* A; const char* B; size_t tstepA, tstepB, estep;
    __device__ __forceinline__ bool next(int i, Unit& u) const {
        const long L = (long)i * G + c; const int nblk = plan[40]; if (L >= (long)nblk * ncol) return false;
        u.pm = (int)(L / ncol); u.pn = (int)(L % ncol); u.aux = plan[64 + u.pm]; u.A = A + (size_t)u.pm * tstepA; u.B = B + (size_t)u.aux * estep + (size_t)u.pn * tstepB; return true;
    }
    __device__ __forceinline__ void a_ready(const Unit&) const {}
    __device__ __forceinline__ void done(const Unit&) const {}
};

__device__ __forceinline__ u32x4 pack8(const f32x4 v0, const f32x4 v1) { u32x4 w; w[0] = pk2(v0[0], v0[1]); w[1] = pk2(v0[2], v0[3]); w[2] = pk2(v1[0], v1[1]); w[3] = pk2(v1[2], v1[3]); return w; }
struct EpiBf16 {
    static constexpr int SEGT = 0; static constexpr bool PERM = true; bf16_t* O; int ldc;
    __device__ __forceinline__ void operator()(const f32x4 (&acc)[2][2][4][2], const Unit& u, int wr, int wc, int fr, int fq) const {
        const int row0 = u.pm * BM + wr * 64 + fr, col0 = u.pn * BM + wc * 32 + 8 * fq;
#pragma unroll
        for (int ai = 0; ai < 2; ++ai)
#pragma unroll
            for (int m = 0; m < 4; ++m) { bf16_t* rowp = O + (size_t)(row0 + ai * HALF + m * 16) * ldc + col0;
#pragma unroll
                for (int bj = 0; bj < 2; ++bj) *(u32x4*)(rowp + bj * HALF) = pack8(acc[ai][bj][m][0], acc[ai][bj][m][1]); }
    }
};
struct EpiP {
    static constexpr int SEGT = 0; static constexpr bool PERM = true; bf16_t* O; unsigned char* G8;
    __device__ __forceinline__ void operator()(const f32x4 (&acc)[2][2][4][2], const Unit& u, int wr, int wc, int fr, int fq) const {
        const int row0 = u.pm * BM + wr * 64 + fr, col0 = u.pn * BM + wc * 32 + 8 * fq;
        if (u.pn * BM < C_MLP) {
#pragma unroll
            for (int ai = 0; ai < 2; ++ai)
#pragma unroll
                for (int m = 0; m < 4; ++m) { bf16_t* rowp = O + (size_t)(row0 + ai * HALF + m * 16) * PW + col0;
#pragma unroll
                    for (int bj = 0; bj < 2; ++bj) *(u32x4*)(rowp + bj * HALF) = pack8(acc[ai][bj][m][0], acc[ai][bj][m][1]); }
        } else {
#pragma unroll
            for (int ai = 0; ai < 2; ++ai)
#pragma unroll
                for (int m = 0; m < 4; ++m) { unsigned char* rowp = G8 + (size_t)(row0 + ai * HALF + m * 16) * (4 * D) + (col0 - C_MLP);
#pragma unroll
                    for (int bj = 0; bj < 2; ++bj) { unsigned long long w = 0ull;
#pragma unroll
                        for (int q = 0; q < 8; ++q) { const float gq = sigmoidf_(acc[ai][bj][m][q >> 2][q & 3]); w |= (unsigned long long)(unsigned)(gq * 255.f + 0.5f) << (8 * q); }
                        *(unsigned long long*)(rowp + bj * HALF) = w; } }
        }
    }
};
struct EpiMerge {
    static constexpr int SEGT = 16; static constexpr bool PERM = true; const unsigned char* G8; bf16_t* MRG;
    static __device__ __forceinline__ float gq(unsigned long long w, int q) { const unsigned b = (unsigned)(w >> (8 * q)) & 255u; return (b ? (float)b : 0.5f) * (1.f / 255.f); }
    __device__ __forceinline__ void segment(f32x4 (&acc)[2][2][4][2], const Unit& u, int seg, int wr, int wc, int fr, int fq) const {
        const int row0 = u.pm * BM + wr * 64 + fr, col0 = u.pn * BM + wc * 32 + 8 * fq;
#pragma unroll
        for (int ai = 0; ai < 2; ++ai)
#pragma unroll
            for (int m = 0; m < 4; ++m) { const size_t r = (size_t)(row0 + ai * HALF + m * 16);
#pragma unroll
                for (int bj = 0; bj < 2; ++bj) { const int cc = col0 + bj * HALF;
                    const unsigned long long g0 = *(const unsigned long long*)(G8 + r * (4 * D) + seg * D + cc), g1 = *(const unsigned long long*)(G8 + r * (4 * D) + (seg + 1) * D + cc);
#pragma unroll
                    for (int q = 0; q < 4; ++q) { acc[ai][bj][m][0][q] *= gq(g0, q) * frcp_(gq(g1, q)); acc[ai][bj][m][1][q] *= gq(g0, 4 + q) * frcp_(gq(g1, 4 + q)); } }
#ifndef CPU_EMU
                asm volatile("" ::: "memory");
#endif
            }
    }
    __device__ __forceinline__ void operator()(const f32x4 (&acc)[2][2][4][2], const Unit& u, int wr, int wc, int fr, int fq) const {
        const int row0 = u.pm * BM + wr * 64 + fr, col0 = u.pn * BM + wc * 32 + 8 * fq;
#pragma unroll
        for (int ai = 0; ai < 2; ++ai)
#pragma unroll
            for (int m = 0; m < 4; ++m) { const size_t r = (size_t)(row0 + ai * HALF + m * 16);
#pragma unroll
                for (int bj = 0; bj < 2; ++bj) { const int cc = col0 + bj * HALF;
                    const unsigned long long g3 = *(const unsigned long long*)(G8 + r * (4 * D) + 3 * D + cc); f32x4 v0, v1;
#pragma unroll
                    for (int q = 0; q < 4; ++q) { v0[q] = gq(g3, q) * acc[ai][bj][m][0][q]; v1[q] = gq(g3, 4 + q) * acc[ai][bj][m][1][q]; }
                    *(u32x4*)(MRG + r * D + cc) = pack8(v0, v1); }
#ifndef CPU_EMU
                asm volatile("" ::: "memory");
#endif
            }
    }
};
struct EpiResid {
    static constexpr int SEGT = 0; static constexpr bool PERM = false; const float* xin; const float* g1; float* xmid;
    __device__ __forceinline__ void operator()(const f32x4 (&acc)[2][2][4][2], const Unit& u, int wr, int wc, int fr, int fq) const {
        const int row0 = u.pm * BM + wr * 64 + fr, col0 = u.pn * BM + wc * 32 + 4 * fq;
#pragma unroll
        for (int ai = 0; ai < 2; ++ai)
#pragma unroll
            for (int m = 0; m < 4; ++m) { const int r = row0 + ai * HALF + m * 16; const float* gp = g1 + (size_t)(r / S) * D6;
#pragma unroll
                for (int bj = 0; bj < 2; ++bj)
#pragma unroll
                    for (int n = 0; n < 2; ++n) { const int cc = col0 + bj * HALF + n * 16; *(f32x4*)(xmid + (size_t)r * D + cc) = *(const f32x4*)(xin + (size_t)r * D + cc) + *(const f32x4*)(gp + cc) * acc[ai][bj][m][n]; }
#ifndef CPU_EMU
                asm volatile("" ::: "memory");
#endif
            }
    }
};
struct EpiGU {
    static constexpr int SEGT = 0; static constexpr bool PERM = true; bf16_t* ACT;
    __device__ __forceinline__ void operator()(const f32x4 (&acc)[2][2][4][2], const Unit& u, int wr, int wc, int fr, int fq) const {
        const int row0 = u.pm * BM + wr * 64 + fr, col0 = u.pn * HALF + wc * 32 + 8 * fq;
#pragma unroll
        for (int ai = 0; ai < 2; ++ai)
#pragma unroll
            for (int m = 0; m < 4; ++m) { f32x4 v0, v1;
#pragma unroll
                for (int j = 0; j < 4; ++j) { v0[j] = siluf_(acc[ai][0][m][0][j]) * acc[ai][1][m][0][j]; v1[j] = siluf_(acc[ai][0][m][1][j]) * acc[ai][1][m][1][j]; }
                *(u32x4*)(ACT + (size_t)(row0 + ai * HALF + m * 16) * 512 + col0) = pack8(v0, v1); }
    }
};
}

template <int PASS>
__device__ __forceinline__ void ph_lru(const Ctx& c, int l, float* ldsf) {
    const bf16_t* P = WSH(O_P); const float* cw = c.in[8] + (size_t)l * 4 * W; const float* cb = c.in[9] + (size_t)l * W;
    const float* br = c.in[11] + (size_t)l * 2 * W; const float* bi = c.in[13] + (size_t)l * 2 * W; const float* lam = c.in[14] + (size_t)l * 2 * W; const bf16_t* WLR = WSH(O_WLR);
    float* CA = WSF(O_LCA); float* CH = WSF(O_LCH); const float* CI = WSF(O_LCI); bf16_t* Y = WSH(O_YS); unsigned* LAU = (unsigned*)(c.ws + O_LA);
    bf16_t* Xs = (bf16_t*)ldsf; bf16_t* Wr = Xs + 64 * 136; bf16_t* Wi = Wr + 128 * 136; float* AUa = (float*)Wr; float* AUu = AUa + 64 * 128; float* HF = (float*)(Wi + 128 * 136); float* spl = HF + 64 * 128;
    const int tid = threadIdx.x, wv = tid >> 6, lane = tid & 63, fr = lane & 15, fq = lane >> 4, rt = wv & 3, hf = wv >> 2;
    for (int u = blockIdx.x; u < (T / 64) * 8; u += gridDim.x) {
        const int n = u & 7, tile = u >> 3, b = tile / NLC, chk = tile % NLC; const long t0 = (long)tile * 64;
        if (tid < 256) spl[tid] = softplusf_(-lam[(tid >> 7) * W + n * 128 + (tid & 127)]);
#pragma unroll
        for (int q = 0; q < 4; ++q) { const int id = tid + NT * q, tl = id >> 5, e4 = (id & 31) * 4, ch = n * 128 + e4; const long t = t0 + tl; const int sI = (int)(t % S);
            f32x4 acc = *(const f32x4*)(cb + ch);
#pragma unroll
            for (int k = 0; k < 4; ++k) { const int ss = sI + k - 2; if (ss >= 0 && ss < S) acc += ld_bf4(P + (size_t)(t + k - 2) * PW + C_LX + ch) * *(const f32x4*)(cw + k * W + ch); }
            st_bf4(Xs + tl * 136 + e4, acc); }
        for (int z = 0; z < 2; ++z) {
#pragma unroll
            for (int q = 0; q < 4; ++q) { const int id = tid + NT * q, f = id >> 4, e8 = (id & 15) * 8;
                *(u32x4*)(Wr + f * 136 + e8) = *(const u32x4*)(WLR + ((size_t)((z * 2 + 0) * 8 + n) * 128 + f) * 128 + e8); *(u32x4*)(Wi + f * 136 + e8) = *(const u32x4*)(WLR + ((size_t)((z * 2 + 1) * 8 + n) * 128 + f) * 128 + e8); }
            SYNCTHREADS();
            f32x4 ar[4], ai[4];
#pragma unroll
            for (int nt = 0; nt < 4; ++nt) { ar[nt] = (f32x4){0.f, 0.f, 0.f, 0.f}; ai[nt] = (f32x4){0.f, 0.f, 0.f, 0.f}; }
            wave_mma<4, 4>(ar, Xs + rt * 16 * 136, 136, Wr + hf * 64 * 136, 136);
            wave_mma<4, 4>(ai, Xs + rt * 16 * 136, 136, Wi + hf * 64 * 136, 136);
            SYNCTHREADS();
            const int tl = rt * 16 + fr;
#pragma unroll
            for (int nt = 0; nt < 4; ++nt) { const int f = 64 * hf + 16 * nt + 4 * fq, ch = n * 128 + f;
                const f32x4 brv = *(const f32x4*)(br + z * W + ch), biv = *(const f32x4*)(bi + z * W + ch), lmv = *(const f32x4*)(spl + z * 128 + f), xcv = ld_bf4(Xs + tl * 136 + f); f32x4 av, uv, lav;
#pragma unroll
                for (int e = 0; e < 4; ++e) { const float r = sigmoidf_(ar[nt][e] + brv[e]), ig = sigmoidf_(ai[nt][e] + biv[e]), la = -8.f * r * lmv[e]; const float a = fexp_(la); av[e] = a; lav[e] = la; uv[e] = sqrtf(fmaxf(1.f - a * a, 0.f)) * ig * xcv[e]; }
                *(f32x4*)(AUa + tl * 128 + f) = av; *(f32x4*)(AUu + tl * 128 + f) = uv;
                if (PASS == 1) { u32x4 pk;
#pragma unroll
                    for (int e = 0; e < 4; ++e) pk[e] = pk2(lav[e], uv[e]);
                    *(u32x4*)(LAU + ((size_t)z * T + t0 + tl) * W + ch) = pk; } }
            SYNCTHREADS();
            if (tid < 128) { const int f = tid; const size_t ci = (((size_t)z * NB + b) * NLC + chk) * W + n * 128 + f;
                if (PASS == 1) { float prod = 1.f, h = 0.f;
#pragma unroll 8
                    for (int q = 0; q < 64; ++q) { const int sI = z == 0 ? q : 63 - q; const float a = AUa[sI * 128 + f]; h = a * h + AUu[sI * 128 + f]; prod *= a; }
                    CA[ci] = prod; CH[ci] = h;
                } else { float h = CI[ci];
                    if (z == 0) {
#pragma unroll 8
                        for (int q = 0; q < 64; ++q) { h = AUa[q * 128 + f] * h + AUu[q * 128 + f]; HF[q * 128 + f] = h; }
                    } else {
#pragma unroll 8
                        for (int q = 63; q >= 0; --q) { h = AUa[q * 128 + f] * h + AUu[q * 128 + f]; HF[q * 128 + f] += h; } } }
            }
            SYNCTHREADS();
        }
        if (PASS == 2) {
#pragma unroll
            for (int q = 0; q < 4; ++q) { const int id = tid + NT * q, tl = id >> 5, f4 = (id & 31) * 4; const long t = t0 + tl; f32x4 hv = *(const f32x4*)(HF + tl * 128 + f4); const f32x4 gv = ld_bf4(P + (size_t)t * PW + C_LG + n * 128 + f4);
#pragma unroll
                for (int e = 0; e < 4; ++e) hv[e] *= geluf_(gv[e]);
                st_bf4(Y + (size_t)t * 4 * W + 0 * W + n * 128 + f4, hv); }
            SYNCTHREADS();
        }
    }
}
__device__ __forceinline__ void ph_lru_fin(const Ctx& c, float* ldsf) {
    const bf16_t* P = WSH(O_P); const unsigned* LAU = (const unsigned*)(c.ws + O_LA); const float* CI = WSF(O_LCI); bf16_t* Y = WSH(O_YS);
    unsigned* Lz = (unsigned*)ldsf; float* Hz = ldsf + 2 * 64 * 128; const int tid = threadIdx.x;
    for (int u = blockIdx.x; u < (T / 64) * 8; u += gridDim.x) {
        const int n = u & 7, tile = u >> 3, b = tile / NLC, chk = tile % NLC; const long t0 = (long)tile * 64;
#pragma unroll
        for (int q = 0; q < 8; ++q) { const int id = tid + NT * q, z = id >> 11, r = (id >> 5) & 63, c4 = (id & 31) * 4; *(u32x4*)(Lz + z * 8192 + r * 128 + c4) = *(const u32x4*)(LAU + ((size_t)z * T + t0 + r) * W + n * 128 + c4); }
        SYNCTHREADS();
        if (tid < 256) { const int z = tid >> 7, f = tid & 127; float h = CI[(((size_t)z * NB + b) * NLC + chk) * W + n * 128 + f]; const unsigned* lp = Lz + z * 8192 + f; float* hp = Hz + z * 8192 + f;
#pragma unroll 8
            for (int q = 0; q < 64; ++q) { const int sI = z == 0 ? q : 63 - q; const unsigned w = lp[sI * 128]; h = fexp_(bflo(w)) * h + bfhi(w); hp[sI * 128] = h; } }
        SYNCTHREADS();
#pragma unroll
        for (int q = 0; q < 4; ++q) { const int id = tid + NT * q, r = id >> 5, f4 = (id & 31) * 4; const long t = t0 + r; f32x4 o = *(const f32x4*)(Hz + r * 128 + f4) + *(const f32x4*)(Hz + 8192 + r * 128 + f4); const f32x4 gv = ld_bf4(P + (size_t)t * PW + C_LG + n * 128 + f4);
#pragma unroll
            for (int e = 0; e < 4; ++e) o[e] *= geluf_(gv[e]);
            st_bf4(Y + (size_t)t * 4 * W + 0 * W + n * 128 + f4, o); }
        SYNCTHREADS();
    }
}
__device__ __forceinline__ void ph_lru_scan2(const Ctx& c) {
    const float* CA = WSF(O_LCA); const float* CH = WSF(O_LCH); float* CI = WSF(O_LCI);
    for (long i = GT_; i < (long)2 * NB * W; i += GS_) {
        const int w = (int)(i % W), b = (int)((i / W) % NB), z = (int)(i / ((long)W * NB)); float carry = 0.f;
#pragma unroll 16
        for (int q = 0; q < NLC; ++q) { const int ch = z == 0 ? q : NLC - 1 - q; const size_t idx = (((size_t)z * NB + b) * NLC + ch) * W + w; CI[idx] = carry; carry = CA[idx] * carry + CH[idx]; }
    }
}
__device__ __forceinline__ void ph_rope_table(const Ctx& c) {
    const int* pos = (const int*)c.in[2]; float* RT = WSF(O_ROPE);
    for (long i = GT_; i < (long)T * 32; i += GS_) { const int j = (int)(i & 31); const float ang = (float)pos[i >> 5] * powf(10000.f, -(float)(2 * j) / 64.f); RT[i * 2] = cosf(ang); RT[i * 2 + 1] = sinf(ang); }
}
__device__ __forceinline__ void ret_tables(float* tab, int h) {
    const int tid = threadIdx.x; const float lg = loggamma_(h);
    if (tid < 32) tab[tid] = powf(10000.f, -(float)(2 * tid) / 64.f);
    if (tid >= 64 && tid < 64 + 129) tab[tid] = expf((float)(tid - 64) * lg);
}
__device__ __forceinline__ void ph_ret_kv(const Ctx& c, float* ldsf) {
    const float* RT = WSF(O_ROPE); const bf16_t* P = WSH(O_P); float* KVF = WSF(O_KVF); float* KVB = WSF(O_KVB);
    bf16_t* VT = (bf16_t*)ldsf; bf16_t* KF = VT + 128 * 136; bf16_t* KB = KF + 64 * 136; float* tab = (float*)(KB + 64 * 136);
    const int tid = threadIdx.x, wv = tid >> 6, lane = tid & 63, fr = lane & 15, fq = lane >> 4;
    for (int u = blockIdx.x; u < (T / 128) * 8; u += gridDim.x) {
        const int h = u & 7; const long t0 = (long)(u >> 3) * 128;
        ret_tables(tab, h);
        SYNCTHREADS();
        { float x1[8], x2[8];
#pragma unroll
          for (int q = 0; q < 8; ++q) { const int id = tid + NT * q, j = id & 127, dj = id >> 7; const bf16_t* prow = P + (size_t)(t0 + j) * PW + C_RK + h * 64; x1[q] = bf2f(prow[dj]); x2[q] = bf2f(prow[dj + 32]); }
#pragma unroll 1
          for (int q = 0; q < 8; ++q) { const int id = tid + NT * q, j = id & 127, dj = id >> 7; const float cs = RT[((size_t)(t0 + j) * 32 + dj) * 2], sn = RT[((size_t)(t0 + j) * 32 + dj) * 2 + 1];
            const float k1 = x1[q] * cs - x2[q] * sn, k2 = x2[q] * cs + x1[q] * sn, fj = tab[64 + 127 - j], bj = tab[64 + j];
            KF[dj * 136 + j] = (bf16_t)f2bf(k1 * fj); KF[(dj + 32) * 136 + j] = (bf16_t)f2bf(k2 * fj); KB[dj * 136 + j] = (bf16_t)f2bf(k1 * bj); KB[(dj + 32) * 136 + j] = (bf16_t)f2bf(k2 * bj); } }
#pragma unroll
        for (int q = 0; q < 4; ++q) { const int id = tid + NT * q, j = id & 127, e8 = (id >> 7) * 8; const u32x4 raw = *(const u32x4*)(P + (size_t)(t0 + j) * PW + C_RV + h * 128 + e8);
#pragma unroll
            for (int e = 0; e < 4; ++e) { VT[(e8 + 2 * e) * 136 + j] = (bf16_t)(raw[e] & 0xffffu); VT[(e8 + 2 * e + 1) * 136 + j] = (bf16_t)(raw[e] >> 16); } }
        SYNCTHREADS();
        f32x4 af[4], ab[4];
#pragma unroll
        for (int nt = 0; nt < 4; ++nt) { af[nt] = (f32x4){0.f, 0.f, 0.f, 0.f}; ab[nt] = (f32x4){0.f, 0.f, 0.f, 0.f}; }
        wave_mma<4, 4>(af, VT + wv * 16 * 136, 136, KF, 136);
        wave_mma<4, 4>(ab, VT + wv * 16 * 136, 136, KB, 136);
        const size_t ob = (((size_t)(u >> 3) * 8 + h) * 128 + wv * 16 + fr) * 64 + 4 * fq;
#pragma unroll
        for (int nt = 0; nt < 4; ++nt) { *(f32x4*)(KVF + ob + 16 * nt) = af[nt]; *(f32x4*)(KVB + ob + 16 * nt) = ab[nt]; }
        SYNCTHREADS();
    }
}
__device__ __forceinline__ void ph_ret_state(const Ctx& c) {
    const float* KVF = WSF(O_KVF); const float* KVB = WSF(O_KVB); float* STF = WSF(O_STF); float* STB = WSF(O_STB);
    for (long i = GT_; i < (long)NB * 8 * 8192; i += GS_) {
        const int x = (int)(i % 8192), h = (int)((i / 8192) % 8), b = (int)(i / 65536);
        const float cd = expf(128.f * loggamma_(h)); float st = 0.f;
#pragma unroll 16
        for (int n = 0; n < NCH; ++n) { const size_t idx = (((size_t)b * NCH + n) * 8 + h) * 8192 + x; STF[idx] = st; st = cd * st + KVF[idx]; }
        st = 0.f;
#pragma unroll 16
        for (int n = NCH - 1; n >= 0; --n) { const size_t idx = (((size_t)b * NCH + n) * 8 + h) * 8192 + x; STB[idx] = st; st = cd * st + KVB[idx]; }
    }
}
__device__ __forceinline__ void ph_ret_out(const Ctx& c, float* ldsf) {
    const float* RT = WSF(O_ROPE); const bf16_t* P = WSH(O_P); const float* STF = WSF(O_STF); const float* STB = WSF(O_STB); bf16_t* Y = WSH(O_YS);
    bf16_t* Qs = (bf16_t*)ldsf; bf16_t* Ks = Qs + 128 * 72; bf16_t* VT = Ks + 128 * 72; bf16_t* Ss = VT + 128 * 136; bf16_t* SF = Ss + 128 * 136; bf16_t* SB = SF + 128 * 72; float* tab = (float*)(SB + 128 * 72);
    const int tid = threadIdx.x, wv = tid >> 6, lane = tid & 63, fr = lane & 15, fq = lane >> 4;
    for (int u = blockIdx.x; u < (T / 128) * 8; u += gridDim.x) {
        const int h = u & 7; const long t0 = (long)(u >> 3) * 128;
        ret_tables(tab, h);
        SYNCTHREADS();
#pragma unroll 1
        for (int qh = 0; qh < 8; qh += 4) { float q1[4], q2[4], k1[4], k2[4];
#pragma unroll
          for (int q = 0; q < 4; ++q) { const int id = tid + NT * (qh + q), j = id >> 5, dj = id & 31; const bf16_t* prow = P + (size_t)(t0 + j) * PW;
            q1[q] = bf2f(prow[C_RQ + h * 64 + dj]); q2[q] = bf2f(prow[C_RQ + h * 64 + dj + 32]); k1[q] = bf2f(prow[C_RK + h * 64 + dj]); k2[q] = bf2f(prow[C_RK + h * 64 + dj + 32]); }
#pragma unroll
          for (int q = 0; q < 4; ++q) { const int id = tid + NT * (qh + q), j = id >> 5, dj = id & 31; const float cs = RT[((size_t)(t0 + j) * 32 + dj) * 2], sn = RT[((size_t)(t0 + j) * 32 + dj) * 2 + 1];
            Qs[j * 72 + dj] = (bf16_t)f2bf((q1[q] * cs - q2[q] * sn) * 0.125f); Qs[j * 72 + dj + 32] = (bf16_t)f2bf((q2[q] * cs + q1[q] * sn) * 0.125f); Ks[j * 72 + dj] = (bf16_t)f2bf(k1[q] * cs - k2[q] * sn); Ks[j * 72 + dj + 32] = (bf16_t)f2bf(k2[q] * cs + k1[q] * sn); } }
#pragma unroll
        for (int q = 0; q < 4; ++q) { const int id = tid + NT * q, j = id & 127, e8 = (id >> 7) * 8; const u32x4 raw = *(const u32x4*)(P + (size_t)(t0 + j) * PW + C_RV + h * 128 + e8);
#pragma unroll
            for (int e = 0; e < 4; ++e) { VT[(e8 + 2 * e) * 136 + j] = (bf16_t)(raw[e] & 0xffffu); VT[(e8 + 2 * e + 1) * 136 + j] = (bf16_t)(raw[e] >> 16); } }
        const size_t sbase = (((size_t)(u >> 3) * 8 + h)) * 8192;
#pragma unroll
        for (int q = 0; q < 4; ++q) { const int id = tid + NT * q, e = id >> 4, d4 = (id & 15) * 4; st_bf4(SF + e * 72 + d4, *(const f32x4*)(STF + sbase + (size_t)e * 64 + d4)); st_bf4(SB + e * 72 + d4, *(const f32x4*)(STB + sbase + (size_t)e * 64 + d4)); }
        SYNCTHREADS();
        const int i = wv * 16 + fr; const long t = t0 + i;
        {
            f32x4 sc[8];
#pragma unroll
            for (int nt = 0; nt < 8; ++nt) sc[nt] = (f32x4){0.f, 0.f, 0.f, 0.f};
            wave_mma<2, 8>(sc, Qs + wv * 16 * 72, 72, Ks, 72);
#pragma unroll
            for (int nt = 0; nt < 8; ++nt) { const int j0 = 16 * nt + 4 * fq; f32x4 sv;
#pragma unroll
                for (int e = 0; e < 4; ++e) { const int j = j0 + e, dist = i > j ? i - j : j - i; sv[e] = sc[nt][e] * tab[64 + dist]; }
                st_bf4(Ss + i * 136 + j0, sv); }
        }
#ifdef CPU_EMU
        SYNCTHREADS();
#else
        asm volatile("s_waitcnt lgkmcnt(0)" ::: "memory");
#endif
        f32x4 ao[8], tm[8];
#pragma unroll
        for (int nt = 0; nt < 8; ++nt) { ao[nt] = (f32x4){0.f, 0.f, 0.f, 0.f}; tm[nt] = (f32x4){0.f, 0.f, 0.f, 0.f}; }
        wave_mma<4, 8>(ao, Ss + wv * 16 * 136, 136, VT, 136);
        wave_mma<2, 8>(tm, Qs + wv * 16 * 72, 72, SF, 72);
        { const float qf = tab[64 + i + 1];
#pragma unroll
            for (int nt = 0; nt < 8; ++nt) { ao[nt] += tm[nt] * qf; tm[nt] = (f32x4){0.f, 0.f, 0.f, 0.f}; } }
        wave_mma<2, 8>(tm, Qs + wv * 16 * 72, 72, SB, 72);
        { const float qb = tab[64 + 128 - i];
#pragma unroll
            for (int nt = 0; nt < 8; ++nt) ao[nt] += tm[nt] * qb; }
        float sm = 0.f;
#pragma unroll
        for (int nt = 0; nt < 8; ++nt) sm += (ao[nt][0] + ao[nt][1]) + (ao[nt][2] + ao[nt][3]);
        sm += SHFL_XOR(sm, 16); sm += SHFL_XOR(sm, 32);
        const float mu = sm * (1.f / 128.f); float sq = 0.f;
#pragma unroll
        for (int nt = 0; nt < 8; ++nt) { ao[nt] -= mu; sq += (ao[nt][0] * ao[nt][0] + ao[nt][1] * ao[nt][1]) + (ao[nt][2] * ao[nt][2] + ao[nt][3] * ao[nt][3]); }
        sq += SHFL_XOR(sq, 16); sq += SHFL_XOR(sq, 32);
        const float rs = 1.f / sqrtf(sq * (1.f / 128.f) + EPS);
#pragma unroll
        for (int nt = 0; nt < 8; ++nt) { const int e0 = 16 * nt + 4 * fq; f32x4 gv = ld_bf4(P + (size_t)t * PW + C_RG + h * 128 + e0);
#pragma unroll
            for (int e = 0; e < 4; ++e) gv[e] = siluf_(gv[e]) * (ao[nt][e] * rs);
            st_bf4(Y + (size_t)t * 4 * W + 1 * W + h * 128 + e0, gv); }
        SYNCTHREADS();
    }
}
__device__ __forceinline__ void ph_sgu_norm(const Ctx& c, int l) {
    const bf16_t* P = WSH(O_P); float* ST = WSF(O_VN);
    const int lane = threadIdx.x & 63, gw = blockIdx.x * (NT / 64) + (threadIdx.x >> 6), ngw = gridDim.x * (NT / 64);
    for (int t = gw; t < T; t += ngw) {
        f32x4 v[4]; float sm = 0.f;
#pragma unroll
        for (int j = 0; j < 4; ++j) { v[j] = ld_bf4(P + (size_t)t * PW + C_SV + (j * 64 + lane) * 4);
#pragma unroll
            for (int q = 0; q < 4; ++q) { v[j][q] = geluf_(v[j][q]); sm += v[j][q]; } }
        const float mu = wave_sum(sm) * (1.f / W); float sq = 0.f;
#pragma unroll
        for (int j = 0; j < 4; ++j)
#pragma unroll
            for (int q = 0; q < 4; ++q) { const float dd = v[j][q] - mu; sq += dd * dd; }
        const float rs = 1.f / sqrtf(wave_sum(sq) * (1.f / W) + EPS);
        if (lane == 0) { ST[(size_t)t * 2] = mu; ST[(size_t)t * 2 + 1] = rs; }
    }
}
__device__ __forceinline__ void ph_sgu_mix(const Ctx& c, int l, float* ldsf) {
    const bf16_t* P = WSH(O_P); const float* ST = WSF(O_VN); bf16_t* Y = WSH(O_YS); const float* ng = c.in[15] + (size_t)l * W;
    bf16_t* As = (bf16_t*)ldsf; bf16_t* Bs = As + 128 * 136; const int tid = threadIdx.x, wv = tid >> 6, lane = tid & 63, fr = lane & 15, fq = lane >> 4;
    for (int u = blockIdx.x; u < (T / 128) * 8; u += gridDim.x) {
        const int g = u & 7; const long t0 = (long)(u >> 3) * 128;
        const float* ws = c.in[16] + ((size_t)l * 8 + g) * 128 * 128; const float* bs = c.in[17] + ((size_t)l * 8 + g) * 128;
#pragma unroll
        for (int q = 0; q < 8; ++q) { const int id = tid + NT * q, i = id >> 5, j4 = (id & 31) * 4; st_bf4(As + i * 136 + j4, *(const f32x4*)(ws + i * 128 + j4)); }
#pragma unroll
        for (int q = 0; q < 4; ++q) { const int id = tid + NT * q, j = id & 127, d8 = (id >> 7) * 8; const float mu = ST[(size_t)(t0 + j) * 2], rs = ST[(size_t)(t0 + j) * 2 + 1];
            const u32x4 raw = *(const u32x4*)(P + (size_t)(t0 + j) * PW + C_SV + g * 128 + d8);
#pragma unroll
            for (int e = 0; e < 4; ++e) { const float v0 = (geluf_(bflo(raw[e])) - mu) * rs * ng[g * 128 + d8 + 2 * e], v1 = (geluf_(bfhi(raw[e])) - mu) * rs * ng[g * 128 + d8 + 2 * e + 1];
                Bs[(d8 + 2 * e) * 136 + j] = (bf16_t)f2bf(v0); Bs[(d8 + 2 * e + 1) * 136 + j] = (bf16_t)f2bf(v1); } }
        SYNCTHREADS();
        f32x4 acc[8];
#pragma unroll
        for (int nt = 0; nt < 8; ++nt) acc[nt] = (f32x4){0.f, 0.f, 0.f, 0.f};
        wave_mma<4, 8>(acc, As + wv * 16 * 136, 136, Bs, 136);
        const int i = wv * 16 + fr; const long t = t0 + i; const float bsi = bs[i];
#pragma unroll
        for (int nt = 0; nt < 8; ++nt) { const int d = 16 * nt + 4 * fq; f32x4 uu = ld_bf4(P + (size_t)t * PW + C_SU + g * 128 + d);
#pragma unroll
            for (int e = 0; e < 4; ++e) uu[e] = geluf_(uu[e]) * (acc[nt][e] + bsi);
            st_bf4(Y + (size_t)t * 4 * W + 2 * W + g * 128 + d, uu); }
        SYNCTHREADS();
    }
}
__device__ __forceinline__ void ph_rw_shift(const Ctx& c, int l) {
    const bf16_t* P = WSH(O_P); const float* mup = c.in[18] + (size_t)l * RF; const float* mun = c.in[19] + (size_t)l * RF; bf16_t* FS = WSH(O_FS);
    const int lane = threadIdx.x & 63, gw = blockIdx.x * (NT / 64) + (threadIdx.x >> 6), ngw = gridDim.x * (NT / 64);
    for (int t = gw; t < T; t += ngw) {
        const int sI = t % S; const bf16_t* pc = P + (size_t)t * PW + C_RW;
#pragma unroll 2
        for (int j = lane * 4; j < RF; j += 256) {
            const f32x4 f = ld_bf4(pc + j), z4 = (f32x4){0.f, 0.f, 0.f, 0.f}; const f32x4 pv = sI > 0 ? ld_bf4(pc - PW + j) : z4, nv = sI < S - 1 ? ld_bf4(pc + PW + j) : z4;
            f32x4 v = f + *(const f32x4*)(mup + j) * (pv - f) + *(const f32x4*)(mun + j) * (nv - f);
            if (j >= 3072 && j < 3200) {
#pragma unroll
                for (int e = 0; e < 4; ++e) v[e] = tanhf_(v[e]); }
            else if (j >= 3328) {
#pragma unroll
                for (int e = 0; e < 4; ++e) v[e] = sigmoidf_(v[e]); }
            st_bf4(FS + (size_t)t * RF + j, v);
        }
    }
}
__device__ __forceinline__ void ph_rw_lora(const Ctx& c, int l, float* ldsf) {
    const bf16_t* FS = WSH(O_FS); const float* w0 = c.in[20] + (size_t)l * 2 * W; const float* a0 = c.in[22] + (size_t)l * 2 * W;
    const bf16_t* WUT = WSH(O_WUT); const bf16_t* WAT = WSH(O_WAT); const bf16_t* WGT = WSH(O_WGT);
    bf16_t* DEC = WSH(O_DEC); bf16_t* AA = WSH(O_AA); bf16_t* GG = WSH(O_GG);
    bf16_t* F = (bf16_t*)ldsf; bf16_t* B1 = F + 128 * 136; bf16_t* B2 = B1 + 128 * 136; const int tid = threadIdx.x, wv = tid >> 6, lane = tid & 63, fr = lane & 15, fq = lane >> 4;
    for (int u = blockIdx.x; u < (T / 128) * 8; u += gridDim.x) {
        const int wc0 = (u & 7) * 128; const long t0 = (long)(u >> 3) * 128;
        for (int rd = 0; rd < 3; ++rd) {
#pragma unroll
            for (int q = 0; q < 8; ++q) { const int id = tid + NT * q, r = id >> 5, c4 = (id & 31) * 4;
                const int col = rd < 2 ? (c4 < 64 ? 3072 + rd * 64 + c4 : 3200 + rd * 64 + (c4 - 64)) : 3328 + c4;
                *(unsigned long long*)(F + r * 136 + c4) = *(const unsigned long long*)(FS + (size_t)(t0 + r) * RF + col); }
            if (rd < 2) {
#pragma unroll
                for (int q = 0; q < 2; ++q) { const int id = tid + NT * q, w = id >> 3, r8 = (id & 7) * 8;
                    *(u32x4*)(B1 + w * 72 + r8) = *(const u32x4*)(WUT + ((size_t)rd * W + wc0 + w) * 64 + r8); *(u32x4*)(B2 + w * 72 + r8) = *(const u32x4*)(WAT + ((size_t)rd * W + wc0 + w) * 64 + r8); }
            } else {
#pragma unroll
                for (int q = 0; q < 4; ++q) { const int id = tid + NT * q, w = id >> 4, r8 = (id & 15) * 8; *(u32x4*)(B1 + w * 136 + r8) = *(const u32x4*)(WGT + ((size_t)wc0 + w) * 128 + r8); }
            }
            SYNCTHREADS();
            f32x4 a1[8], a2[8];
#pragma unroll
            for (int nt = 0; nt < 8; ++nt) { a1[nt] = (f32x4){0.f, 0.f, 0.f, 0.f}; a2[nt] = (f32x4){0.f, 0.f, 0.f, 0.f}; }
            const long t = t0 + wv * 16 + fr;
            if (rd < 2) {
                wave_mma<2, 8>(a1, F + wv * 16 * 136, 136, B1, 72);
                wave_mma<2, 8>(a2, F + wv * 16 * 136 + 64, 136, B2, 72);
#pragma unroll
                for (int nt = 0; nt < 8; ++nt) { const int ch = wc0 + 16 * nt + 4 * fq; const f32x4 w0v = *(const f32x4*)(w0 + rd * W + ch), a0v = *(const f32x4*)(a0 + rd * W + ch); f32x4 dv, av;
#pragma unroll
                    for (int e = 0; e < 4; ++e) { dv[e] = fexp_(-DECAY_SCALE * sigmoidf_(a1[nt][e] + w0v[e])); av[e] = sigmoidf_(a2[nt][e] + a0v[e]); }
                    st_bf4(DEC + ((size_t)rd * T + t) * W + ch, dv); st_bf4(AA + ((size_t)rd * T + t) * W + ch, av); }
            } else {
                wave_mma<4, 8>(a1, F + wv * 16 * 136, 136, B1, 136);
#pragma unroll
                for (int nt = 0; nt < 8; ++nt) st_bf4(GG + (size_t)t * W + wc0 + 16 * nt + 4 * fq, a1[nt]);
            }
            SYNCTHREADS();
        }
    }
}
#ifdef CPU_EMU
__device__ __forceinline__ float red16_(float x) { x += SHFL_XOR(x, 1); x += SHFL_XOR(x, 2); x += SHFL_XOR(x, 4); x += SHFL_XOR(x, 8); return x; }
#define LDS_BARRIER() emu_syncthreads()
#else
__device__ __forceinline__ float red16_(float x) {
    x += __builtin_bit_cast(float, __builtin_amdgcn_update_dpp(0, __builtin_bit_cast(int, x), 0xB1, 0xF, 0xF, true));
    x += __builtin_bit_cast(float, __builtin_amdgcn_update_dpp(0, __builtin_bit_cast(int, x), 0x4E, 0xF, 0xF, true));
    x += __builtin_bit_cast(float, __builtin_amdgcn_update_dpp(0, __builtin_bit_cast(int, x), 0x141, 0xF, 0xF, true));
    x += __builtin_bit_cast(float, __builtin_amdgcn_update_dpp(0, __builtin_bit_cast(int, x), 0x140, 0xF, 0xF, true));
    return x;
}
#define LDS_BARRIER() do { asm volatile("s_waitcnt lgkmcnt(0)" ::: "memory"); __builtin_amdgcn_s_barrier(); asm volatile("" ::: "memory"); } while (0)
#endif
#define RC_M(k) (lm + (k) * 4608)
__device__ __forceinline__ void ph_rw_chunk(const Ctx& c, int l, float* ldsf) {
    const bf16_t* FS = WSH(O_FS); const bf16_t* DEC = WSH(O_DEC); const bf16_t* AA = WSH(O_AA); float* BON = WSF(O_BON);
    const float* kkw = c.in[25] + (size_t)l * W; const float* kaw = c.in[26] + (size_t)l * W; const float* rk = c.in[27] + (size_t)l * W;
    bf16_t* PST = WSH(O_PST); bf16_t* PYT = WSH(O_PYT); bf16_t* SVB = WSH(O_SVB); bf16_t* YVB = WSH(O_YVB);
    bf16_t* lm = (bf16_t*)ldsf; float* gam = (float*)RC_M(7); float* segp = (float*)RC_M(13); float* gl = segp + 512;
    const int tid = threadIdx.x, wv = tid >> 6, lane = tid & 63, fr = lane & 15, fq = lane >> 4, rt = wv & 3, hf = wv >> 2;
    const int m0 = 16 * rt + fr;
    float wv8[8], kv8[8], rv8[8], vv8[8], aa8[8];
#define RC_LOAD(uu) do { const int chain_ = (uu) / NRC, ck_ = (uu) % NRC, h_ = chain_ & 15, b_ = (chain_ >> 4) & 1, z_ = chain_ >> 5; \
        const long tb_ = (long)b_ * S + (z_ ? S - 1 - ck_ * RCK : ck_ * RCK); const int dirn_ = z_ ? -1 : 1; \
        const bf16_t* decp_ = DEC + ((size_t)z_ * T) * W + h_ * 64; const bf16_t* aap_ = AA + ((size_t)z_ * T) * W + h_ * 64; const int ch_ = h_ * 64 + lane; \
        _Pragma("unroll") for (int q = 0; q < 8; ++q) wv8[q] = bf2f(decp_[(size_t)(tb_ + dirn_ * ((tid >> 6) * 8 + q)) * W + (tid & 63)]); \
        _Pragma("unroll") for (int q = 0; q < 8; ++q) { const long t_ = tb_ + dirn_ * (wv + 8 * q); const bf16_t* f_ = FS + (size_t)t_ * RF; kv8[q] = bf2f(f_[1024 + ch_]); rv8[q] = bf2f(f_[ch_]); vv8[q] = bf2f(f_[2048 + ch_]); aa8[q] = bf2f(aap_[(size_t)t_ * W + lane]); } } while (0)
    if ((int)blockIdx.x < 64 * NRC) RC_LOAD((int)blockIdx.x);
    for (int u = blockIdx.x; u < 64 * NRC; u += gridDim.x) {
        const int chain = u / NRC, ck = u % NRC, h = chain & 15, b = (chain >> 4) & 1, z = chain >> 5;
        const long tb = (long)b * S + (z ? S - 1 - ck * RCK : ck * RCK); const int dirn = z ? -1 : 1;
        { const int k = tid & 63, sg = tid >> 6; float p = 1.f;
#pragma unroll
          for (int q = 0; q < 8; ++q) { p *= wv8[q]; gam[(sg * 8 + q) * 64 + k] = p; }
          segp[sg * 64 + k] = p; }
        LDS_BARRIER();
        { const int k = tid & 63, sg = tid >> 6; float pre = 1.f;
          for (int q = 0; q < sg; ++q) pre *= segp[q * 64 + k];
#pragma unroll
          for (int q = 0; q < 8; ++q) gam[(sg * 8 + q) * 64 + k] *= pre;
          if (sg == 7) gl[k] = gam[63 * 64 + k]; }
        LDS_BARRIER();
        { const int k = lane, ch = h * 64 + k; const float kkwv = kkw[ch], kav = kaw[ch], rkv = rk[ch];
#pragma unroll
          for (int q = 0; q < 8; ++q) { const int tt = wv + 8 * q; const long t = tb + dirn * tt;
            const float vk = kv8[q] * kkwv; const float kkn = vk * frsq_(wave_sum(vk * vk) + EPS); const float ktv = kv8[q] * (1.f + (aa8[q] - 1.f) * kav);
            const float bsum = wave_sum(rv8[q] * rkv * ktv); if (lane == 0) BON[((size_t)z * T + t) * 16 + h] = bsum;
            const float g = gam[tt * 64 + k], gp = tt ? gam[(tt - 1) * 64 + k] : 1.f, ig = frcp_(g);
            const bf16_t khv = (bf16_t)f2bf(kkn * gp), bhv = (bf16_t)f2bf(aa8[q] * kkn * ig);
            RC_M(0)[tt * 72 + k] = khv; RC_M(1)[k * 72 + tt] = khv; RC_M(2)[tt * 72 + k] = bhv; RC_M(3)[k * 72 + tt] = bhv;
            RC_M(4)[tt * 72 + k] = (bf16_t)f2bf(ktv * ig); RC_M(5)[tt * 72 + k] = (bf16_t)f2bf(rv8[q] * g); RC_M(6)[k * 72 + tt] = (bf16_t)f2bf(vv8[q]); } }
        if (u + (int)gridDim.x < 64 * NRC) RC_LOAD(u + (int)gridDim.x);
        LDS_BARRIER();
        f32x4 mkr[2], khr[2], rhT[2];
        {
            f32x4 a0[2], a1[2], a2[2], a3[2];
#pragma unroll
            for (int nt = 0; nt < 2; ++nt) { a0[nt] = (f32x4){0.f, 0.f, 0.f, 0.f}; a1[nt] = a0[nt]; a2[nt] = a0[nt]; a3[nt] = a0[nt]; }
            wave_mma<2, 2>(a0, RC_M(2) + rt * 16 * 72, 72, RC_M(0) + hf * 32 * 72, 72);
            wave_mma<2, 2>(a1, RC_M(4) + rt * 16 * 72, 72, RC_M(0) + hf * 32 * 72, 72);
            wave_mma<2, 2>(a2, RC_M(2) + rt * 16 * 72, 72, RC_M(5) + hf * 32 * 72, 72);
            wave_mma<2, 2>(a3, RC_M(4) + rt * 16 * 72, 72, RC_M(5) + hf * 32 * 72, 72);
#pragma unroll
            for (int nt = 0; nt < 2; ++nt) { const int n0 = 32 * hf + 16 * nt + 4 * fq; f32x4 nn, ti, mk;
#pragma unroll
                for (int r = 0; r < 4; ++r) { const int n = n0 + r; const bool lt = m0 < n, le = m0 <= n;
                    nn[r] = lt ? -a0[nt][r] : 0.f; ti[r] = nn[r] + (m0 == n ? 1.f : 0.f); mk[r] = lt ? a1[nt][r] : 0.f; mkr[nt][r] = le ? a3[nt][r] : 0.f;
                    RC_M(12)[n * 72 + m0] = (bf16_t)f2bf(le ? a2[nt][r] : 0.f);
                    RC_M(8)[n * 72 + m0] = (bf16_t)f2bf(nn[r]);
                    khr[nt][r] = bf2f(RC_M(4)[m0 * 72 + n]); rhT[nt][r] = bf2f(RC_M(5)[n * 72 + m0]); }
                st_bf4(RC_M(7) + m0 * 72 + n0, nn); st_bf4(RC_M(9) + m0 * 72 + n0, ti); st_bf4(RC_M(11) + m0 * 72 + n0, mk); }
        }
        LDS_BARRIER();
        f32x4 tiv[2];
#pragma unroll
        for (int nt = 0; nt < 2; ++nt) tiv[nt] = ld_bf4(RC_M(9) + m0 * 72 + 32 * hf + 16 * nt + 4 * fq);
#pragma unroll 1
        for (int it = 0; it < 5; ++it) {
            bf16_t* pw = (it & 1) ? RC_M(0) : RC_M(7); bf16_t* pwT = (it & 1) ? RC_M(2) : RC_M(8); bf16_t* pw2 = (it & 1) ? RC_M(7) : RC_M(0); bf16_t* pw2T = (it & 1) ? RC_M(8) : RC_M(2);
            bf16_t* tcur = (it & 1) ? RC_M(4) : RC_M(9); bf16_t* tnxt = (it & 1) ? RC_M(9) : RC_M(4);
            f32x4 sq[2];
#pragma unroll
            for (int nt = 0; nt < 2; ++nt) sq[nt] = (f32x4){0.f, 0.f, 0.f, 0.f};
            wave_mma<2, 2>(sq, pw + rt * 16 * 72, 72, pwT + hf * 32 * 72, 72);
#pragma unroll
            for (int nt = 0; nt < 2; ++nt) { const int n0 = 32 * hf + 16 * nt + 4 * fq; st_bf4(pw2 + m0 * 72 + n0, sq[nt]);
#pragma unroll
                for (int r = 0; r < 4; ++r) pw2T[(n0 + r) * 72 + m0] = (bf16_t)f2bf(sq[nt][r]); }
            LDS_BARRIER();
            f32x4 up[2];
#pragma unroll
            for (int nt = 0; nt < 2; ++nt) up[nt] = (f32x4){0.f, 0.f, 0.f, 0.f};
            wave_mma<2, 2>(up, tcur + rt * 16 * 72, 72, pw2T + hf * 32 * 72, 72);
#pragma unroll
            for (int nt = 0; nt < 2; ++nt) { const int n0 = 32 * hf + 16 * nt + 4 * fq; tiv[nt] += up[nt]; st_bf4(tnxt + m0 * 72 + n0, tiv[nt]);
                if (it == 4) {
#pragma unroll
                    for (int r = 0; r < 4; ++r) RC_M(10)[(n0 + r) * 72 + m0] = (bf16_t)f2bf(tiv[nt][r]); } }
            LDS_BARRIER();
        }
        {
            f32x4 w1[2], w2[2];
#pragma unroll
            for (int nt = 0; nt < 2; ++nt) { w1[nt] = (f32x4){0.f, 0.f, 0.f, 0.f}; w2[nt] = w1[nt]; }
            wave_mma<2, 2>(w1, RC_M(1) + rt * 16 * 72, 72, RC_M(10) + hf * 32 * 72, 72);
            wave_mma<2, 2>(w2, RC_M(11) + rt * 16 * 72, 72, RC_M(10) + hf * 32 * 72, 72);
#pragma unroll
            for (int nt = 0; nt < 2; ++nt) { const int n0 = 32 * hf + 16 * nt + 4 * fq; st_bf4(RC_M(7) + m0 * 72 + n0, w1[nt]); st_bf4(RC_M(8) + m0 * 72 + n0, w2[nt]); }
        }
        LDS_BARRIER();
        {
            f32x4 py[2], qy[2], ps[2], qs[2];
#pragma unroll
            for (int nt = 0; nt < 2; ++nt) { py[nt] = (f32x4){0.f, 0.f, 0.f, 0.f}; qy[nt] = py[nt]; ps[nt] = py[nt]; qs[nt] = py[nt]; }
            wave_mma<2, 2>(py, RC_M(7) + rt * 16 * 72, 72, RC_M(12) + hf * 32 * 72, 72);
            wave_mma<2, 2>(qy, RC_M(8) + rt * 16 * 72, 72, RC_M(12) + hf * 32 * 72, 72);
            wave_mma<2, 2>(ps, RC_M(7) + rt * 16 * 72, 72, RC_M(3) + hf * 32 * 72, 72);
            wave_mma<2, 2>(qs, RC_M(8) + rt * 16 * 72, 72, RC_M(3) + hf * 32 * 72, 72);
#pragma unroll
            for (int nt = 0; nt < 2; ++nt) { const int n0 = 32 * hf + 16 * nt + 4 * fq;
#pragma unroll
                for (int r = 0; r < 4; ++r) { const int n = n0 + r; const float gln = gl[n];
                    RC_M(0)[n * 72 + m0] = (bf16_t)f2bf(rhT[nt][r] - py[nt][r]); RC_M(2)[n * 72 + m0] = (bf16_t)f2bf(mkr[nt][r] - qy[nt][r]);
                    RC_M(4)[n * 72 + m0] = (bf16_t)f2bf(((m0 == n ? 1.f : 0.f) - ps[nt][r]) * gln); RC_M(5)[n * 72 + m0] = (bf16_t)f2bf((khr[nt][r] - qs[nt][r]) * gln); } }
        }
        LDS_BARRIER();
        {
            f32x4 yv[2], sv[2];
#pragma unroll
            for (int nt = 0; nt < 2; ++nt) { yv[nt] = (f32x4){0.f, 0.f, 0.f, 0.f}; sv[nt] = yv[nt]; }
            wave_mma<2, 2>(yv, RC_M(6) + rt * 16 * 72, 72, RC_M(2) + hf * 32 * 72, 72);
            wave_mma<2, 2>(sv, RC_M(6) + rt * 16 * 72, 72, RC_M(5) + hf * 32 * 72, 72);
#pragma unroll
            for (int nt = 0; nt < 2; ++nt) { const int n0 = 32 * hf + 16 * nt + 4 * fq; st_bf4(YVB + (size_t)u * 4096 + m0 * 64 + n0, yv[nt]); st_bf4(SVB + (size_t)u * 4096 + m0 * 64 + n0, sv[nt]); }
            { const int rr = tid >> 3, c8 = (tid & 7) * 8; *(u32x4*)(PYT + (size_t)u * 4096 + rr * 64 + c8) = *(const u32x4*)(RC_M(0) + rr * 72 + c8); *(u32x4*)(PST + (size_t)u * 4096 + rr * 64 + c8) = *(const u32x4*)(RC_M(4) + rr * 72 + c8); }
        }
        LDS_BARRIER();
    }
}
#undef RC_M
#undef RC_LOAD
__device__ __forceinline__ void ph_rw_seq(const Ctx& c, float* ldsf) {
    const bf16_t* PST = WSH(O_PST); const bf16_t* PYT = WSH(O_PYT); const bf16_t* SVB = WSH(O_SVB); const bf16_t* YVB = WSH(O_YVB); bf16_t* YY = WSH(O_YY);
    bf16_t* Sb = (bf16_t*)ldsf;
    bf16_t* Pm = Sb + 2 * 16 * 72;
    const int tid = threadIdx.x, wv = tid >> 6, lane = tid & 63, fr = lane & 15, fq = lane >> 4, isY = wv >> 2, nt0 = wv & 3;
    for (int u = blockIdx.x; u < 256; u += gridDim.x) {
        const int x = u & 7, jq = u >> 3, chain = x * 8 + (jq >> 2), qt = jq & 3, h = chain & 15, b = (chain >> 4) & 1, z = chain >> 5;
        const size_t ub = (size_t)chain * NRC;
        const int rr = tid >> 3, c8 = (tid & 7) * 8;
        constexpr int PD = NRC >= 8 ? 8 : 4;
        for (int i = tid; i < 2 * 16 * 72 / 2; i += NT) ((unsigned*)Sb)[i] = 0u;
        const int row = 16 * qt + fr, n0 = 16 * nt0 + 4 * fq; const bf16_t* addp = (isY ? YVB : SVB) + ub * 4096 + row * 64 + n0;
        const bf16_t* psp = PST + ub * 4096 + rr * 64 + c8; const bf16_t* pyp = PYT + ub * 4096 + rr * 64 + c8;
        u32x4 gps[PD], gpy[PD]; f32x4 add[PD];
#pragma unroll
        for (int j = 0; j < PD; ++j) { gps[j] = *(const u32x4*)(psp + (size_t)j * 4096); gpy[j] = *(const u32x4*)(pyp + (size_t)j * 4096); add[j] = ld_bf4(addp + (size_t)j * 4096); }
        *(u32x4*)(Pm + (0 * 2 + 0) * 4608 + rr * 72 + c8) = gps[0]; *(u32x4*)(Pm + (0 * 2 + 1) * 4608 + rr * 72 + c8) = gpy[0];
        if (PD < NRC) { gps[0] = *(const u32x4*)(psp + (size_t)PD * 4096); gpy[0] = *(const u32x4*)(pyp + (size_t)PD * 4096); }
        SYNCTHREADS();
        for (int ck0 = 0; ck0 < NRC; ck0 += PD) {
#pragma unroll
            for (int j = 0; j < PD; ++j) {
                const int ck = ck0 + j, cur = j & 1, nxt = cur ^ 1;
                f32x4 acc[1]; acc[0] = (f32x4){0.f, 0.f, 0.f, 0.f};
                wave_mma<2, 1>(acc, Sb + cur * 16 * 72, 72, Pm + (cur * 2 + isY) * 4608 + nt0 * 16 * 72, 72);
                acc[0] += add[j];
                if (ck + PD < NRC) add[j] = ld_bf4(addp + (size_t)(ck + PD) * 4096);
                if (isY) {
#pragma unroll
                    for (int r = 0; r < 4; ++r) { const int step = ck * RCK + n0 + r, sidx = z ? S - 1 - step : step; YY[((size_t)z * T + (size_t)b * S + sidx) * W + h * 64 + row] = (bf16_t)f2bf(acc[0][r]); }
                } else st_bf4(Sb + nxt * 16 * 72 + fr * 72 + n0, acc[0]);
                const int jn = (j + 1) % PD;
                if (ck + 1 < NRC) { *(u32x4*)(Pm + (nxt * 2 + 0) * 4608 + rr * 72 + c8) = gps[jn]; *(u32x4*)(Pm + (nxt * 2 + 1) * 4608 + rr * 72 + c8) = gpy[jn]; }
                if (ck + 1 + PD < NRC) { gps[jn] = *(const u32x4*)(psp + (size_t)(ck + 1 + PD) * 4096); gpy[jn] = *(const u32x4*)(pyp + (size_t)(ck + 1 + PD) * 4096); }
                LDS_BARRIER();
            }
        }
    }
}
__device__ __forceinline__ void ph_rw_out(const Ctx& c) {
    const bf16_t* FS = WSH(O_FS); const bf16_t* YY = WSH(O_YY); const float* BON = WSF(O_BON); const bf16_t* GG = WSH(O_GG); bf16_t* Y = WSH(O_YS);
    const int lane = threadIdx.x & 63, gw = blockIdx.x * (NT / 64) + (threadIdx.x >> 6), ngw = gridDim.x * (NT / 64);
    for (int i = gw; i < T * 4; i += ngw) {
        const int h0 = (i & 3) * 4; const long t = i >> 2; float y0[4], y1[4], gv[4], vv[4], bs[4];
#pragma unroll
        for (int q = 0; q < 4; ++q) { const int ch = (h0 + q) * 64 + lane; y0[q] = bf2f(YY[(size_t)t * W + ch]); y1[q] = bf2f(YY[((size_t)T + t) * W + ch]); gv[q] = bf2f(GG[(size_t)t * W + ch]); vv[q] = bf2f(FS[(size_t)t * RF + 2048 + ch]);
            bs[q] = BON[(size_t)t * 16 + h0 + q] + BON[((size_t)T + t) * 16 + h0 + q]; }
#pragma unroll
        for (int q = 0; q < 4; ++q) { const int ch = (h0 + q) * 64 + lane;
            const float m0 = wave_sum(y0[q]) * (1.f / 64.f), m1 = wave_sum(y1[q]) * (1.f / 64.f); const float d0 = y0[q] - m0, d1 = y1[q] - m1;
            const float r0 = 1.f / sqrtf(wave_sum(d0 * d0) * (1.f / 64.f) + EPS), r1 = 1.f / sqrtf(wave_sum(d1 * d1) * (1.f / 64.f) + EPS);
            Y[(size_t)t * 4 * W + 3 * W + ch] = (bf16_t)f2bf((d0 * r0 + d1 * r1 + bs[q] * vv[q]) * gv[q]); }
    }
}
__device__ __forceinline__ void ph_router(const Ctx& c, int l, float* ldsf, const float* X, const float* gN, const float* shN, const float* scN) {
    const float* RS = WSF(O_HF); const bf16_t* WH = WSH(O_WRH); const bf16_t* WL = WSH(O_WRL); const float* bg = c.in[31] + (size_t)l * 4; const float* be = c.in[33] + (size_t)l * 32;
    int* EID = WSI(O_EID); float* EWT = WSF(O_EWT); int* cnt = CTLW(c) + CW_CNT + l * 64;
    const int tid = threadIdx.x, wv = tid >> 6, lane = tid & 63, fr = lane & 15, fq = lane >> 4, rt = wv & 1, kq = wv >> 1;
    float* part = ldsf;
    for (int u = blockIdx.x; u < T / 32; u += gridDim.x) {
        const long t0 = (long)u * 32; f32x4 acc[3];
#pragma unroll
        for (int nt = 0; nt < 3; ++nt) acc[nt] = (f32x4){0.f, 0.f, 0.f, 0.f};
#ifdef CPU_EMU
        for (int nt = 0; nt < 3; ++nt) for (int r = 0; r < 4; ++r) { const int n = 16 * nt + 4 * fq + r; float sacc = 0.f;
            for (int k = kq * 512; k < kq * 512 + 512; ++k) { const long tr = t0 + 16 * rt + fr; const int bb = (int)(tr / S); const float hv = X[(size_t)tr * D + k] * RS[tr] * gN[k] * (1.f + scN[bb * D6 + k]) + shN[bb * D6 + k]; const float hh = bf2f((bf16_t)f2bf(hv)), hl = bf2f((bf16_t)f2bf(hv - hh));
                const float wh = bf2f(WH[(size_t)n * D + k]), wl = bf2f(WL[(size_t)n * D + k]); sacc += hh * wh + hl * wh + hh * wl; }
            acc[nt][r] = sacc; }
#else
        const long tr = t0 + 16 * rt + fr; const int bb = (int)(tr / S); const float rsv = RS[tr]; const int kb = kq * 512 + fq * 8;
        const float* hp = X + (size_t)tr * D + kb; const float* gp_ = gN + kb; const float* scp = scN + bb * D6 + kb; const float* shp = shN + bb * D6 + kb;
#pragma unroll 4
        for (int ks = 0; ks < 16; ++ks) {
            const f32x4 h0 = *(const f32x4*)(hp + ks * 32) * rsv * *(const f32x4*)(gp_ + ks * 32) * (*(const f32x4*)(scp + ks * 32) + 1.f) + *(const f32x4*)(shp + ks * 32);
            const f32x4 h1 = *(const f32x4*)(hp + ks * 32 + 4) * rsv * *(const f32x4*)(gp_ + ks * 32 + 4) * (*(const f32x4*)(scp + ks * 32 + 4) + 1.f) + *(const f32x4*)(shp + ks * 32 + 4); bf16x8 ah, al;
#pragma unroll
            for (int e = 0; e < 4; ++e) { const unsigned b0 = f2bf(h0[e]), b1 = f2bf(h1[e]); ah[e] = (short)b0; ah[4 + e] = (short)b1; al[e] = (short)f2bf(h0[e] - u2f_(b0 << 16)); al[4 + e] = (short)f2bf(h1[e] - u2f_(b1 << 16)); }
#pragma unroll
            for (int nt = 0; nt < 3; ++nt) { const size_t wo = (size_t)(16 * nt + fr) * D + kq * 512 + ks * 32 + fq * 8; const bf16x8 bh = *(const bf16x8*)(WH + wo), bl = *(const bf16x8*)(WL + wo);
                acc[nt] = __builtin_amdgcn_mfma_f32_16x16x32_bf16(bh, ah, acc[nt], 0, 0, 0); acc[nt] = __builtin_amdgcn_mfma_f32_16x16x32_bf16(bh, al, acc[nt], 0, 0, 0); acc[nt] = __builtin_amdgcn_mfma_f32_16x16x32_bf16(bl, ah, acc[nt], 0, 0, 0); }
        }
#endif
#pragma unroll
        for (int nt = 0; nt < 3; ++nt) *(f32x4*)(part + (kq * 32 + 16 * rt + fr) * 48 + 16 * nt + 4 * fq) = acc[nt];
        SYNCTHREADS();
        if (tid < 32) { const long t = t0 + tid; float lg[36];
#pragma unroll
            for (int q = 0; q < 36; ++q) lg[q] = (part[(0 * 32 + tid) * 48 + q] + part[(1 * 32 + tid) * 48 + q]) + (part[(2 * 32 + tid) * 48 + q] + part[(3 * 32 + tid) * 48 + q]) + (q < 4 ? bg[q < 4 ? q : 0] : be[q >= 4 ? q - 4 : 0]);
            int gi = 0; float m = lg[0];
#pragma unroll
            for (int q = 1; q < 4; ++q) if (lg[q] > m) { m = lg[q]; gi = q; }
            float den = 0.f;
#pragma unroll
            for (int q = 0; q < 4; ++q) den += expf(lg[q] - m);
            const float gp = 1.f / den; float el[8];
#pragma unroll
            for (int q = 0; q < 8; ++q) el[q] = gi == 0 ? lg[4 + q] : gi == 1 ? lg[12 + q] : gi == 2 ? lg[20 + q] : lg[28 + q];
            int i1 = 0; float m1 = el[0];
#pragma unroll
            for (int q = 1; q < 8; ++q) if (el[q] > m1) { m1 = el[q]; i1 = q; }
            int i2 = -1; float m2 = 0.f;
#pragma unroll
            for (int q = 0; q < 8; ++q) if (q != i1 && (i2 < 0 || el[q] > m2)) { m2 = el[q]; i2 = q; }
            const float p2 = expf(m2 - m1);
            EID[t * 2] = gi * 8 + i1; EID[t * 2 + 1] = gi * 8 + i2; EWT[t * 2] = gp / (1.f + p2); EWT[t * 2 + 1] = gp * p2 / (1.f + p2);
            atomic_add_i(cnt + gi * 8 + i1, 1); atomic_add_i(cnt + gi * 8 + i2, 1);
        }
        SYNCTHREADS();
    }
}
__device__ __forceinline__ void ph_moe_plan(const Ctx& c, int l) {
    int* cnt = CTLW(c) + CW_CNT + l * 64; int* plan = CTLW(c) + CW_PLAN + l * 256;
    if (GT_ == 0) {
        int ps = 0, nb = 0;
        for (int e = 0; e < NE; ++e) { plan[e] = ps; const int nblk = (cnt[e] + 255) / 256; for (int q = 0; q < nblk; ++q) plan[64 + nb++] = e; ps += nblk * 256; }
        plan[32] = ps; plan[40] = nb;
    }
}
__device__ __forceinline__ void ph_moe_assign(const Ctx& c, int l) {
    const int* EID = WSI(O_EID); int* fill = CTLW(c) + CW_FILL + l * 64; const int* plan = CTLW(c) + CW_PLAN + l * 256; int* DEST = WSI(O_DEST);
    for (long i = GT_; i < (long)T * 2; i += GS_) { const int e = EID[i]; const int pos = atomic_add_i(fill + e, 1); DEST[i] = plan[e] + pos; }
}
__device__ __forceinline__ void ph_moe_gather(const Ctx& c) {
    const int* DEST = WSI(O_DEST); const u32x4* H = (const u32x4*)WSH(O_H); u32x4* XS = (u32x4*)WSH(O_XS);
    for (long i = GT_; i < (long)T * 2 * (D / 8); i += GS_) { const int q = (int)(i % (D / 8)); const long a = i / (D / 8); XS[(size_t)DEST[a] * (D / 8) + q] = H[(size_t)(a >> 1) * (D / 8) + q]; }
}
#ifndef CPU_EMU
#define XB_TMO      128
#define XB_XCNT(j)  (256  + 64 * (j))
#define XB_XSUB(j)  (1280 + 64 * (j))
#define XB_XGEN(j)  (2304 + 64 * (j))
#define XB_TOP      3328
#define XB_TOPGEN   3392
#define XCD_BAR_WORDS 3456
#define XB_SPIN_CAP (1u << 26)
#define LAS __attribute__((address_space(3)))
__device__ __forceinline__ unsigned xb_ld(unsigned* p)              { return __hip_atomic_load(p, __ATOMIC_RELAXED, __HIP_MEMORY_SCOPE_AGENT); }
__device__ __forceinline__ unsigned xb_add(unsigned* p, unsigned v) { return __hip_atomic_fetch_add(p, v, __ATOMIC_RELAXED, __HIP_MEMORY_SCOPE_AGENT); }
__device__ __forceinline__ unsigned xb_xcc_id() { return (unsigned)__builtin_amdgcn_s_getreg((3 << 11) | 20) & 0xFu; }
#define XB_SPIN(cond, bar) do { unsigned _sp = 0; while (cond) { __builtin_amdgcn_s_sleep(1); \
    if ((++_sp & 255u) == 0u) { if (xb_ld(&(bar)[XB_TMO])) break; if (_sp > XB_SPIN_CAP) { atomicAdd(&(bar)[XB_TMO], 1u); break; } } } } while (0)
struct XcdBarrier { unsigned* bar; unsigned x; volatile LAS unsigned* st; };
__device__ __forceinline__ XcdBarrier xcd_barrier_post(unsigned* bar, volatile LAS unsigned* st) {
    XcdBarrier b; b.bar = bar; b.x = xb_xcc_id(); b.st = st;
    if (threadIdx.x == 0) (void)xb_add(&bar[XB_XCNT(b.x)], 1u);
    return b;
}
__device__ __forceinline__ void xcd_barrier_complete(unsigned* bar, unsigned x, unsigned& nloc, unsigned& nx) {
    const unsigned G = gridDim.x * gridDim.y * gridDim.z;
    unsigned sum, cnt, mine, sp = 0u;
    for (;;) {
        sum = 0u; cnt = 0u; mine = 0u;
#pragma unroll
        for (unsigned j = 0; j < 16; ++j) { const unsigned cc = xb_ld(&bar[XB_XCNT(j)]); sum += cc; cnt += (cc > 0u) ? 1u : 0u; mine = (j == x) ? cc : mine; }
        if (sum == G) break;
        __builtin_amdgcn_s_sleep(1);
        if ((++sp & 255u) == 0u) { if (xb_ld(&bar[XB_TMO])) break; if (sp > XB_SPIN_CAP) { atomicAdd(&bar[XB_TMO], 1u); break; } }
    }
    nloc = mine > 0u ? mine : 1u; nx = cnt > 0u ? cnt : 1u;
}
__device__ __forceinline__ void xcd_barrier(const XcdBarrier& b) {
    asm volatile("s_waitcnt vmcnt(0)" ::: "memory");
    __syncthreads();
    if (threadIdx.x == 0) {
        unsigned* bar = b.bar;
        __builtin_amdgcn_s_waitcnt(0);
        unsigned nloc = b.st[0], nx = b.st[1];
        if (nloc == 0u) { xcd_barrier_complete(bar, b.x, nloc, nx); b.st[0] = nloc; b.st[1] = nx; }
        const unsigned old = xb_add(&bar[XB_XSUB(b.x)], 1u);
        const unsigned gen = old / nloc;
        if (old + 1u == (gen + 1u) * nloc) {
            __builtin_amdgcn_fence(__ATOMIC_RELEASE, "agent");
            asm volatile("s_waitcnt vmcnt(0)" ::: "memory");
            const unsigned og = xb_add(&bar[XB_TOP], 1u);
            const unsigned tg = og / nx;
            if (og + 1u == (tg + 1u) * nx) xb_add(&bar[XB_TOPGEN], 1u);
            else XB_SPIN(xb_ld(&bar[XB_TOPGEN]) == tg, bar);
            __builtin_amdgcn_fence(__ATOMIC_ACQUIRE, "agent");
            xb_add(&bar[XB_XGEN(b.x)], 1u);
            asm volatile("s_waitcnt vmcnt(0)" ::: "memory");
        } else {
            XB_SPIN(xb_ld(&bar[XB_XGEN(b.x)]) == gen, bar);
            __builtin_amdgcn_fence(__ATOMIC_ACQUIRE, "agent");
            asm volatile("s_waitcnt vmcnt(0)" ::: "memory");
        }
    }
    __syncthreads();
}
#endif

constexpr int LDS_BYTES = 147456;

__global__ void __launch_bounds__(NT, 2) fwd(Params p) {
#ifdef CPU_EMU
    unsigned char* lds = g_lds; float* ldsf = (float*)g_lds;
#else
    extern __shared__ __attribute__((aligned(16))) unsigned char lds[];
    float* ldsf = (float*)lds;
    volatile LAS unsigned* misc = (volatile LAS unsigned*)((LAS unsigned char*)lds + LDS_BYTES - 64);
    if (threadIdx.x == 0) { misc[0] = 0u; misc[1] = 0u; }
    __syncthreads();
    XcdBarrier bar = xcd_barrier_post((unsigned*)(p.ws + O_CTL) + CW_BAR, misc);
#endif
    Ctx c; c.in = p.in; c.out = p.out; c.ws = p.ws;
    const int lo = p.ph_lo, hi = p.ph_hi; int ph = 0;
    const int G = (int)gridDim.x, cwg = (int)blockIdx.x;
#ifdef CPU_EMU
#define GRID_BAR()
#else
#define GRID_BAR() xcd_barrier(bar)
#endif
#ifndef REPEAT_MASK
#define REPEAT_MASK 0
#endif
#ifndef TIME_PHASE
#define TIME_PHASE -1
#endif
#if TIME_PHASE >= 0 && !defined(CPU_EMU)
    unsigned long long tp0 = 0, tp1 = 0;
#define TP_BEGIN() do { if (ph == TIME_PHASE) tp0 = __builtin_amdgcn_s_memrealtime(); } while (0)
#define TP_END() do { if (ph == TIME_PHASE) tp1 = __builtin_amdgcn_s_memrealtime(); } while (0)
#else
#define TP_BEGIN()
#define TP_END()
#endif
#define PHASE(...) do { if (lo <= ph && ph < hi) { TP_BEGIN(); __VA_ARGS__; if (ph + 1 < hi) { GRID_BAR(); } TP_END(); } ++ph; } while (0)
#define PHASEG(grp, ...) do { if (lo <= ph && ph < hi) { TP_BEGIN(); if ((REPEAT_MASK >> (grp)) & 1) { __VA_ARGS__; GRID_BAR(); } __VA_ARGS__; if (ph + 1 < hi) { GRID_BAR(); } TP_END(); } ++ph; } while (0)
    PHASE(ph_mod(c, ldsf); ph_rope_table(c));
#define LAYER_BODY(l) do { const float* mod = WSF(O_MOD); \
        const float* xin = l == 0 ? c.in[0] : WSF(O_X1); float* xmid = WSF(O_X0); float* xout = WSF(O_X1); \
        const float* ml = mod + (size_t)l * NB * D6; \
        PHASEG(3, ph_convert(c, l, ldsf)); \
        PHASEG(0, { pg8::Gemm g{D, D, D}; pg8::StaticOrder so; so.init(T, PW, G, cwg, WSH(O_H), WSH(O_WIN), D, D); pg8::EpiP E{WSH(O_P), (unsigned char*)(c.ws + O_G8)}; pg8::gemm_phase(lds, g, so, E); \
            { const int nun_ = (T / 256) * (PW / 256), rem_ = nun_ % G; if (rem_ != 0 && cwg >= rem_) { SYNCTHREADS(); convert_big(c, l, ldsf, J_ALL - convert_tail_tiles(), J_ALL, cwg - rem_, G - rem_); } } }); \
        PHASE(ph_lru<1>(c, l, ldsf); ph_ret_kv(c, ldsf); ph_sgu_norm(c, l); ph_rw_shift(c, l)); \
        PHASE(ph_lru_scan2(c); ph_ret_state(c); ph_sgu_mix(c, l, ldsf); ph_rw_lora(c, l, ldsf)); \
        PHASE(ph_lru_fin(c, ldsf); ph_ret_out(c, ldsf); ph_rw_chunk(c, l, ldsf)); \
        PHASE(ph_rw_seq(c, ldsf)); \
        PHASE(ph_rw_out(c)); \
        PHASEG(1, { pg8::Gemm g{4 * W, 4 * W, 4 * W}; pg8::StaticOrder so; so.init(T, D, G, cwg, WSH(O_YS), WSH(O_WBR), 4 * W, 4 * W); pg8::EpiMerge E{(const unsigned char*)(c.ws + O_G8), WSH(O_MRG)}; pg8::gemm_phase(lds, g, so, E); }); \
        PHASEG(1, { pg8::Gemm g{D, D, D}; pg8::StaticOrder so; so.init(T, D, G, cwg, WSH(O_MRG), WSH(O_WOUT), D, D); pg8::EpiResid E{xin, ml + 2 * D, xmid}; pg8::gemm_phase(lds, g, so, E); }); \
        PHASEG(6, ph_norm(c, xmid, c.in[4] + (size_t)l * D, ml + 3 * D, ml + 4 * D, WSH(O_H), WSF(O_HF))); \
        PHASE(ph_router(c, l, ldsf, xmid, c.in[4] + (size_t)l * D, ml + 3 * D, ml + 4 * D)); \
        PHASE(ph_moe_plan(c, l)); \
        PHASE(ph_moe_assign(c, l)); \
        PHASEG(6, ph_moe_gather(c)); \
        const int* plan = CTLW(c) + CW_PLAN + l * 256; \
        PHASEG(2, { pg8::Gemm g{D, D, D}; pg8::MoeOrder mo{G, cwg, 4, plan, (const char*)WSH(O_XS), (const char*)WSH(O_WGU), (size_t)256 * D * 2, (size_t)256 * D * 2, (size_t)1024 * D * 2}; pg8::EpiGU E{WSH(O_ACT)}; pg8::gemm_phase(lds, g, mo, E); \
            if (l == 0) { const int nrest_ = plan[40] * 4 - G; if (nrest_ >= 0 && nrest_ < G && cwg >= nrest_) { SYNCTHREADS(); convert_big(c, 1, ldsf, 0, convert_early_tiles(c), cwg - nrest_, G - nrest_); } } }); \
        PHASEG(2, { pg8::Gemm g{512, 512, 512}; pg8::MoeOrder mo{G, cwg, 8, plan, (const char*)WSH(O_ACT), (const char*)WSH(O_WDN), (size_t)256 * 512 * 2, (size_t)256 * 512 * 2, (size_t)D * 512 * 2}; pg8::EpiBf16 E{WSH(O_YE), D}; pg8::gemm_phase(lds, g, mo, E); }); \
        if (l == 0) PHASE(ph_comb_norm<0>(c, xmid, ml + 5 * D, xout, c.in[3] + (size_t)1 * D, mod + (size_t)1 * NB * D6 + 0 * D, mod + (size_t)1 * NB * D6 + 1 * D, WSH(O_H), nullptr)); \
        else PHASE(ph_comb_norm<1>(c, xmid, ml + 5 * D, xout, c.in[36], nullptr, nullptr, nullptr, c.out)); \
    } while (0)
    PHASE(ph_norm(c, c.in[0], c.in[3], WSF(O_MOD) + 0 * D, WSF(O_MOD) + 1 * D, WSH(O_H), nullptr));
    LAYER_BODY(0);
    LAYER_BODY(1);
#undef LAYER_BODY
#if TIME_PHASE >= 0 && !defined(CPU_EMU)
    if (blockIdx.x == 0) { const unsigned long long te = __builtin_amdgcn_s_memrealtime(), dl = 8ull * (tp1 - tp0); while (__builtin_amdgcn_s_memrealtime() - te < dl) __builtin_amdgcn_s_sleep(8); }
#endif
#undef PHASE
}
}

#ifndef CPU_EMU
extern "C" void kernel_launch(void* const* d_in, const int* in_sizes, int n_in, void* d_out, int out_size, void* d_ws, size_t ws_size, hipStream_t stream) {
    static int grid = 0;
    if (grid == 0) {
        if (n_in != 37 || out_size != T * D || ws_size < WS_END) { fprintf(stderr, "kernel_launch: unexpected shapes (n_in %d out %d ws %zu need %zu)\n", n_in, out_size, ws_size, (size_t)WS_END); grid = -1; return; }
        int dev = 0, cus = 0, per_cu = 0;
        if (hipGetDevice(&dev) != hipSuccess || hipDeviceGetAttribute(&cus, hipDeviceAttributeMultiprocessorCount, dev) != hipSuccess) { grid = -1; return; }
        if (hipFuncSetAttribute((const void*)fwd, hipFuncAttributeMaxDynamicSharedMemorySize, LDS_BYTES) != hipSuccess) { fprintf(stderr, "kernel_launch: hipFuncSetAttribute failed\n"); grid = -1; return; }
        if (hipOccupancyMaxActiveBlocksPerMultiprocessor(&per_cu, (const void*)fwd, NT, LDS_BYTES) != hipSuccess || per_cu < 1) fprintf(stderr, "kernel_launch: occupancy query says %d\n", per_cu);
        (void)hipGetLastError();
        grid = cus;
    }
    if (grid < 0) return;
    (void)in_sizes;
    (void)hipMemsetAsync((char*)d_ws + O_CTL, 0, CTL_BYTES, stream);
    Params p{};
    for (int i = 0; i < 37; ++i) p.in[i] = (const float*)d_in[i];
    p.out = (float*)d_out; p.ws = (unsigned char*)d_ws;
#if ONE_LAUNCH
    p.ph_lo = 0; p.ph_hi = NPH;
    hipLaunchKernelGGL(fwd, dim3(grid), dim3(NT), LDS_BYTES, stream, p);
#else
    for (int k = 0; k < NPH; ++k) { p.ph_lo = k; p.ph_hi = k + 1; hipLaunchKernelGGL(fwd, dim3(grid), dim3(NT), LDS_BYTES, stream, p); }
#endif
}
#endif
```

```cpp
#ifndef CPU_EMU
#include <hip/hip_runtime.h>
#endif
#include <cstdio>
#include <cstdint>
#include <cmath>
#include <cstring>

#ifndef SEQ
#define SEQ 4096
#endif
#ifndef ONE_LAUNCH
#define ONE_LAUNCH 1
#endif

namespace {
constexpr int D = 2048, NB = 2, S = SEQ, T = NB * S, NL = 2, W = 1024;
constexpr int INW = 18816, RF = 3456, D6 = 6 * D;
constexpr int C_LX = 0, C_LG = 1024, C_RQ = 2048, C_RK = 2560, C_RV = 3072, C_RG = 4096, C_SU = 5120, C_SV = 6144, C_RW = 7168;
constexpr int PW = 18944, C_MLP = 10752;
constexpr int NCH = S / 128;
constexpr int NLC = S / 64;
constexpr int NE = 32, CAP = (T * 2 / 256 + NE) * 256, MAXBLK = CAP / 256;
constexpr float EPS = 1e-6f;
constexpr float DECAY_SCALE = 0.60653065971263342f;
constexpr int NT = 512;
constexpr int NPH_LAYER = 15, NPH = 2 + NL * NPH_LAYER;
typedef unsigned short bf16_t;
#ifdef CPU_EMU
typedef float f32x4 __attribute__((vector_size(16)));
typedef unsigned u32x4 __attribute__((vector_size(16)));
#else
typedef float f32x4 __attribute__((ext_vector_type(4)));
typedef unsigned u32x4 __attribute__((ext_vector_type(4)));
typedef short bf16x8 __attribute__((ext_vector_type(8)));
#endif

constexpr size_t al256(size_t x) { return (x + 255) & ~(size_t)255; }
constexpr size_t SZ_X = (size_t)T * D * 4, SZ_W = (size_t)T * W * 4;
constexpr size_t O_CTL = 0, CTL_BYTES = 1u << 20;
constexpr size_t O_MOD = CTL_BYTES;
constexpr size_t O_X0 = O_MOD + al256((size_t)NL * NB * D6 * 4);
constexpr size_t O_X1 = O_X0 + SZ_X;
constexpr size_t O_H = O_X1 + SZ_X;
constexpr size_t O_HF = O_H + SZ_X / 2;
constexpr size_t O_P = O_HF + SZ_X;
constexpr size_t SZ_P = (size_t)T * PW * 2;
constexpr size_t O_XC = O_P + SZ_P;
constexpr size_t O_LA = O_XC + SZ_W, O_LU = O_LA + 2 * SZ_W;
constexpr size_t SZ_LC = (size_t)2 * NB * NLC * W * 4;
constexpr size_t O_LCA = O_LU + 2 * SZ_W, O_LCH = O_LCA + SZ_LC, O_LCI = O_LCH + SZ_LC;
constexpr size_t O_YS = O_LCI + SZ_LC;
constexpr size_t O_SC = O_YS + (size_t)T * 4 * W * 2;
constexpr size_t SZ_KV = (size_t)NB * NCH * 8 * 64 * 128 * 4;
constexpr size_t O_KVF = O_SC, O_KVB = O_KVF + SZ_KV, O_STF = O_KVB + SZ_KV, O_STB = O_STF + SZ_KV;
constexpr size_t O_VN = O_STB + SZ_KV;
constexpr size_t O_FS = O_VN + SZ_W;
constexpr size_t O_DEC = O_FS + al256((size_t)T * RF * 4), O_AA = O_DEC + 2 * SZ_W, O_AKK = O_AA + 2 * SZ_W;
constexpr size_t O_GG = O_AKK, O_YY = O_GG + SZ_W;
constexpr int RCK = 64, NRC = S / RCK;
constexpr size_t O_BON = O_YY + 2 * SZ_W;
constexpr size_t O_PART = O_BON + al256((size_t)2 * T * 16 * 4);
constexpr size_t O_MRG = O_PART + SZ_X;
constexpr size_t O_LOG = O_MRG + SZ_X / 2;
constexpr size_t O_EID = O_LOG + al256((size_t)T * 40 * 4), O_EWT = O_EID + al256((size_t)T * 2 * 4), O_DEST = O_EWT + al256((size_t)T * 2 * 4);
constexpr size_t O_SLOT = O_DEST + al256((size_t)T * 2 * 4);
constexpr size_t O_PST = O_SLOT + al256((size_t)CAP * 4), O_PYT = O_PST + (size_t)64 * NRC * 4096 * 2, O_SVB = O_PYT + (size_t)64 * NRC * 4096 * 2, O_YVB = O_SVB + (size_t)64 * NRC * 4096 * 4;
constexpr size_t O_WIN = O_YVB + (size_t)64 * NRC * 4096 * 4;
constexpr size_t O_WBR = O_WIN + (size_t)PW * D * 2;
constexpr size_t O_WOUT = O_WBR + (size_t)D * 4 * W * 2;
constexpr size_t O_WGU = O_WOUT + (size_t)D * D * 2;
constexpr size_t O_WDN = O_WGU + (size_t)NE * 1024 * D * 2;
constexpr size_t O_G8 = O_WDN + (size_t)NE * D * 512 * 2;
constexpr size_t O_ROPE = O_G8 + (size_t)T * 4 * D;
constexpr size_t O_WLR = O_ROPE + (size_t)T * 64 * 4;
constexpr size_t O_WUT = O_WLR + (size_t)32 * 128 * 128 * 2;
constexpr size_t O_WAT = O_WUT + (size_t)2 * W * 64 * 2;
constexpr size_t O_WGT = O_WAT + (size_t)2 * W * 64 * 2;
constexpr size_t O_WRH = O_WGT + (size_t)W * 128 * 2;
constexpr size_t O_WRL = O_WRH + (size_t)48 * D * 2;
constexpr size_t WS_END0 = O_WRL + (size_t)48 * D * 2;
constexpr size_t SZ_MOE = (size_t)CAP * (D + 512 + D) * 2;
constexpr bool MOE_OVERLAY = SZ_MOE <= SZ_P;
constexpr size_t O_XS = MOE_OVERLAY ? O_P : WS_END0;
constexpr size_t O_ACT = O_XS + (size_t)CAP * D * 2;
constexpr size_t O_YE = O_ACT + (size_t)CAP * 512 * 2;
constexpr size_t WS_END = MOE_OVERLAY ? WS_END0 : WS_END0 + SZ_MOE;
static_assert(SEQ != 4096 || WS_END <= (size_t)2040 * 1024 * 1024, "workspace budget: d_ws is 4 x the largest input = 2048 MiB");
constexpr int CW_BAR = 4096;
constexpr int CW_CNT = 32768;
constexpr int CW_FILL = CW_CNT + NL * 64;
constexpr int CW_PLAN = CW_FILL + NL * 64;
static_assert(MAXBLK <= 160, "plan words");

struct Params { const float* in[37]; float* out; unsigned char* ws; int ph_lo, ph_hi; };

struct Ctx { const float* const* in; float* out; unsigned char* ws; };
#define GT_ ((long)blockIdx.x * NT + threadIdx.x)
#define GS_ ((long)gridDim.x * NT)
#define WSF(off) ((float*)(c.ws + (off)))
#define WSI(off) ((int*)(c.ws + (off)))
#define WSH(off) ((bf16_t*)(c.ws + (off)))
#define CTLW(c) ((int*)((c).ws + O_CTL))

#ifdef CPU_EMU
__device__ __forceinline__ float fexp_(float x) { return expf(x); }
__device__ __forceinline__ float frcp_(float x) { return 1.f / x; }
__device__ __forceinline__ float frsq_(float x) { return 1.f / sqrtf(x); }
#else
__device__ __forceinline__ float fexp_(float x) { return __builtin_amdgcn_exp2f(x * 1.4426950408889634f); }
__device__ __forceinline__ float frcp_(float x) { return __builtin_amdgcn_rcpf(x); }
__device__ __forceinline__ float frsq_(float x) { return __builtin_amdgcn_rsqf(x); }
#endif
__device__ __forceinline__ float sigmoidf_(float x) { return frcp_(1.f + fexp_(-x)); }
__device__ __forceinline__ float siluf_(float x) { return x * frcp_(1.f + fexp_(-x)); }
__device__ __forceinline__ float tanhf_(float x) { return 1.f - 2.f * frcp_(1.f + fexp_(2.f * x)); }
__device__ __forceinline__ float geluf_(float x) { return 0.5f * x * (1.f + tanhf_(0.7978845608028654f * (x + 0.044715f * x * x * x))); }
__device__ __forceinline__ float softplusf_(float x) { return x > 0.f ? x + log1pf(expf(-x)) : log1pf(expf(x)); }
__device__ __forceinline__ float loggamma_(int h) { return log1pf(-exp2f(-5.f - (float)h)); }
__device__ __forceinline__ unsigned f2u_(float f) { unsigned u; memcpy(&u, &f, 4); return u; }
__device__ __forceinline__ float u2f_(unsigned u) { float f; memcpy(&f, &u, 4); return f; }
__device__ __forceinline__ float bf2f(bf16_t v) { return u2f_((unsigned)v << 16); }
__device__ __forceinline__ unsigned f2bf(float f) { const unsigned u = f2u_(f); return (u + 0x7fffu + ((u >> 16) & 1u)) >> 16; }
__device__ __forceinline__ unsigned pk2(float lo, float hi) { return f2bf(lo) | (f2bf(hi) << 16); }
__device__ __forceinline__ float bflo(unsigned w) { return u2f_(w << 16); }
__device__ __forceinline__ float bfhi(unsigned w) { return u2f_(w & 0xffff0000u); }
__device__ __forceinline__ int atomic_add_i(int* p, int v) {
#ifdef CPU_EMU
    return __atomic_fetch_add(p, v, __ATOMIC_RELAXED);
#else
    return atomicAdd(p, v);
#endif
}
#define PF(P, r, col) bf2f((P)[(size_t)(r) * PW + (col)])
#ifdef CPU_EMU
#define SYNCTHREADS() emu_syncthreads()
#define SHFL_XOR(v, m) emu_shfl_xor(v, m)
#else
#define SYNCTHREADS() __syncthreads()
#define SHFL_XOR(v, m) __shfl_xor(v, m)
#endif
#ifdef CPU_EMU
__device__ __forceinline__ float wave_sum(float v) {
    for (int o = 1; o < 64; o <<= 1) v += SHFL_XOR(v, o);
    return v;
}
#else
__device__ __forceinline__ float wave_sum(float x) {
    x += __builtin_bit_cast(float, __builtin_amdgcn_update_dpp(0, __builtin_bit_cast(int, x), 0xB1, 0xF, 0xF, true));
    x += __builtin_bit_cast(float, __builtin_amdgcn_update_dpp(0, __builtin_bit_cast(int, x), 0x4E, 0xF, 0xF, true));
    x += __builtin_bit_cast(float, __builtin_amdgcn_update_dpp(0, __builtin_bit_cast(int, x), 0x141, 0xF, 0xF, true));
    x += __builtin_bit_cast(float, __builtin_amdgcn_update_dpp(0, __builtin_bit_cast(int, x), 0x140, 0xF, 0xF, true));
    const int xi = __builtin_bit_cast(int, x);
    return (__builtin_bit_cast(float, __builtin_amdgcn_readlane(xi, 0)) + __builtin_bit_cast(float, __builtin_amdgcn_readlane(xi, 16))) + (__builtin_bit_cast(float, __builtin_amdgcn_readlane(xi, 32)) + __builtin_bit_cast(float, __builtin_amdgcn_readlane(xi, 48)));
}
#endif
__device__ __forceinline__ f32x4 ld_bf4(const bf16_t* p) { const unsigned long long q = *(const unsigned long long*)p; const unsigned lo = (unsigned)q, hi = (unsigned)(q >> 32); return (f32x4){bflo(lo), bfhi(lo), bflo(hi), bfhi(hi)}; }
__device__ __forceinline__ void st_bf4(bf16_t* p, const f32x4 v) { *(unsigned long long*)p = (unsigned long long)pk2(v[0], v[1]) | ((unsigned long long)pk2(v[2], v[3]) << 32); }

template <int KT, int NTL>
__device__ __forceinline__ void wave_mma(f32x4 (&acc)[NTL], const bf16_t* A, int lda, const bf16_t* Bt, int ldb) {
    const int lane = threadIdx.x & 63, fr = lane & 15, fq = lane >> 4;
#ifdef CPU_EMU
    for (int nt = 0; nt < NTL; ++nt) for (int r = 0; r < 4; ++r) { float sacc = 0.f; const bf16_t* a = A + fr * lda; const bf16_t* b = Bt + (16 * nt + 4 * fq + r) * ldb;
        for (int k = 0; k < 32 * KT; ++k) sacc += bf2f(a[k]) * bf2f(b[k]);
        acc[nt][r] += sacc; }
#else
#pragma unroll
    for (int kt = 0; kt < KT; ++kt) {
        const bf16x8 af = *(const bf16x8*)(A + fr * lda + kt * 32 + fq * 8);
#pragma unroll
        for (int nt = 0; nt < NTL; ++nt) { const bf16x8 bfr = *(const bf16x8*)(Bt + (16 * nt + fr) * ldb + kt * 32 + fq * 8);
            acc[nt] = __builtin_amdgcn_mfma_f32_16x16x32_bf16(bfr, af, acc[nt], 0, 0, 0); }
    }
#endif
}
__device__ __forceinline__ void ph_mod(const Ctx& c, float* ldsf) {
    const float* cc = c.in[1]; const float* aw = c.in[5]; const float* ab = c.in[6]; float* mod = WSF(O_MOD);
    float* scs = ldsf; float* part = ldsf + NB * D; const int tid = threadIdx.x, c4 = (tid & 31) * 4, kq = tid >> 5;
    for (int i = tid; i < NB * D; i += NT) scs[i] = siluf_(cc[i]);
    SYNCTHREADS();
    for (int u = blockIdx.x; u < NL * (D6 / 128); u += gridDim.x) {
        const int l = u / (D6 / 128), j0 = (u % (D6 / 128)) * 128;
        const float* w = aw + (size_t)l * D * D6 + j0 + c4; f32x4 a0 = (f32x4){0.f, 0.f, 0.f, 0.f}, a1 = a0;
#pragma unroll 8
        for (int k = kq * 128; k < kq * 128 + 128; ++k) { const f32x4 wv = *(const f32x4*)(w + (size_t)k * D6); a0 += wv * scs[k]; a1 += wv * scs[D + k]; }
        *(f32x4*)(part + (kq * 2 + 0) * 128 + c4) = a0; *(f32x4*)(part + (kq * 2 + 1) * 128 + c4) = a1;
        SYNCTHREADS();
        if (tid < 256) { const int b = tid >> 7, col = tid & 127; float sacc = 0.f;
#pragma unroll
            for (int q = 0; q < 16; ++q) sacc += part[(q * 2 + b) * 128 + col];
            mod[((size_t)l * NB + b) * D6 + j0 + col] = sacc + ab[l * D6 + j0 + col]; }
        SYNCTHREADS();
    }
}
__device__ __forceinline__ void ph_norm(const Ctx& c, const float* x, const float* g, const float* sh, const float* sc, bf16_t* hb, float* hf) {
    const int lane = threadIdx.x & 63, gw = blockIdx.x * (NT / 64) + (threadIdx.x >> 6), ngw = gridDim.x * (NT / 64);
    for (int t0 = gw * 2; t0 < T; t0 += ngw * 2) {
        f32x4 v[2][8]; float ss[2] = {0.f, 0.f};
#pragma unroll
        for (int r = 0; r < 2; ++r)
#pragma unroll
            for (int j = 0; j < 8; ++j) v[r][j] = *(const f32x4*)(x + (size_t)(t0 + r) * D + (j * 64 + lane) * 4);
#pragma unroll
        for (int r = 0; r < 2; ++r) {
#pragma unroll
            for (int j = 0; j < 8; ++j) ss[r] += (v[r][j][0] * v[r][j][0] + v[r][j][1] * v[r][j][1]) + (v[r][j][2] * v[r][j][2] + v[r][j][3] * v[r][j][3]);
            const int t = t0 + r, b = t / S; const float rs = 1.f / sqrtf(wave_sum(ss[r]) * (1.f / D) + EPS);
#pragma unroll
            for (int j = 0; j < 8; ++j) { const int col = (j * 64 + lane) * 4;
                const f32x4 o = v[r][j] * rs * *(const f32x4*)(g + col) * (*(const f32x4*)(sc + b * D6 + col) + 1.f) + *(const f32x4*)(sh + b * D6 + col);
                st_bf4(hb + (size_t)t * D + col, o); }
            if (hf && lane == 0) hf[t] = rs;
        }
    }
}
template <int MODE>
__device__ __forceinline__ void ph_comb_norm(const Ctx& c, const float* xmid, const float* g2, float* xout, const float* g, const float* sh, const float* sc, bf16_t* hb, float* outp) {
    const bf16_t* YE = WSH(O_YE); const float* EWT = WSF(O_EWT); const int* DEST = WSI(O_DEST);
    const int lane = threadIdx.x & 63, gw = blockIdx.x * (NT / 64) + (threadIdx.x >> 6), ngw = gridDim.x * (NT / 64);
    for (int t = gw; t < T; t += ngw) {
        const int b = t / S; const float w0 = EWT[t * 2], w1 = EWT[t * 2 + 1]; const bf16_t* y0 = YE + (size_t)DEST[t * 2] * D; const bf16_t* y1 = YE + (size_t)DEST[t * 2 + 1] * D;
        f32x4 v[8]; float ss = 0.f;
#pragma unroll
        for (int j = 0; j < 8; ++j) { const int col = (j * 64 + lane) * 4;
            v[j] = *(const f32x4*)(xmid + (size_t)t * D + col) + *(const f32x4*)(g2 + b * D6 + col) * (ld_bf4(y0 + col) * w0 + ld_bf4(y1 + col) * w1);
            if (MODE == 0) *(f32x4*)(xout + (size_t)t * D + col) = v[j];
            ss += (v[j][0] * v[j][0] + v[j][1] * v[j][1]) + (v[j][2] * v[j][2] + v[j][3] * v[j][3]); }
        const float rs = 1.f / sqrtf(wave_sum(ss) * (1.f / D) + EPS);
#pragma unroll
        for (int j = 0; j < 8; ++j) { const int col = (j * 64 + lane) * 4;
            if (MODE == 0) st_bf4(hb + (size_t)t * D + col, v[j] * rs * *(const f32x4*)(g + col) * (*(const f32x4*)(sc + b * D6 + col) + 1.f) + *(const f32x4*)(sh + b * D6 + col));
            else *(f32x4*)(outp + (size_t)t * D + col) = v[j] * rs * *(const f32x4*)(g + col); }
    }
}

struct CvtItem { const float* Wp; int ldw; bf16_t* WT; int ldt; int drow, k0, n0; };
constexpr int I_IN = 32 * (INW / 32), I_BR = 4 * 16 * 64, I_OUT = 32 * 64, I_GU = NE * 32 * 32, I_DN = NE * 8 * 64, I_LR = 32 * 8, I_WU = 2 * 32, I_WG = 64, I_BIG = I_IN + I_BR + I_OUT + I_GU + I_DN, I_ALL = I_BIG + I_LR + 2 * I_WU + I_WG;
__device__ __forceinline__ CvtItem cvt_decode(const Ctx& c, int l, int it) {
    CvtItem r;
    if (it < I_IN) { const int kb = it / (INW / 32), nb = it % (INW / 32); r.n0 = nb * 32; r.k0 = kb * 64; r.Wp = c.in[7] + (size_t)l * D * INW; r.ldw = INW; r.WT = WSH(O_WIN); r.ldt = D; r.drow = r.n0 < 10624 ? r.n0 : r.n0 + 128; return r; }
    it -= I_IN;
    if (it < I_BR) { const int sgm = it / 1024, q = it % 1024, kb = q / 64, nb = q % 64; r.n0 = nb * 32; r.k0 = kb * 64; r.Wp = c.in[28] + ((size_t)l * 4 + sgm) * W * D; r.ldw = D; r.WT = WSH(O_WBR) + sgm * W; r.ldt = 4 * W; r.drow = r.n0; return r; }
    it -= I_BR;
    if (it < I_OUT) { const int kb = it / 64, nb = it % 64; r.n0 = nb * 32; r.k0 = kb * 64; r.Wp = c.in[29] + (size_t)l * D * D; r.ldw = D; r.WT = WSH(O_WOUT); r.ldt = D; r.drow = r.n0; return r; }
    it -= I_OUT;
    if (it < I_GU) { const int e = it / 1024, q = it % 1024, kb = q / 32, nb = q % 32; r.n0 = nb * 32; r.k0 = kb * 64; r.Wp = c.in[34] + ((size_t)l * NE + e) * D * 1024; r.ldw = 1024; r.WT = WSH(O_WGU) + (size_t)e * 1024 * D; r.ldt = D;
        r.drow = r.n0 < 512 ? (r.n0 / 128) * 256 + (r.n0 % 128) : ((r.n0 - 512) / 128) * 256 + 128 + ((r.n0 - 512) % 128); return r; }
    it -= I_GU;
    if (it < I_DN) { const int e = it / 512, q = it % 512, kb = q / 64, nb = q % 64; r.n0 = nb * 32; r.k0 = kb * 64; r.Wp = c.in[35] + ((size_t)l * NE + e) * 512 * D; r.ldw = D; r.WT = WSH(O_WDN) + (size_t)e * D * 512; r.ldt = 512; r.drow = r.n0; return r; }
    it -= I_DN;
    if (it < I_LR) { const int m = it / 8, q = it % 8, kb = q / 4, nb = q % 4, z = m >> 4, ty = (m >> 3) & 1, n = m & 7; r.n0 = nb * 32; r.k0 = kb * 64; r.Wp = c.in[ty ? 12 : 10] + (((size_t)l * 2 + z) * 8 + n) * 128 * 128; r.ldw = 128;
        r.WT = WSH(O_WLR) + (size_t)m * 128 * 128; r.ldt = 128; r.drow = r.n0; return r; }
    it -= I_LR;
    if (it < 2 * I_WU) { const int ua = it / I_WU, q = it % I_WU, z = q / 32, nb = q % 32; r.n0 = nb * 32; r.k0 = 0; r.Wp = c.in[ua ? 23 : 21] + ((size_t)l * 2 + z) * 64 * W; r.ldw = W; r.WT = WSH(ua ? O_WAT : O_WUT) + (size_t)z * W * 64; r.ldt = 64; r.drow = r.n0; return r; }
    it -= 2 * I_WU;
    { const int kb = it / 32, nb = it % 32; r.n0 = nb * 32; r.k0 = kb * 64; r.Wp = c.in[24] + (size_t)l * 128 * W; r.ldw = W; r.WT = WSH(O_WGT); r.ldt = 128; r.drow = r.n0; return r; }
}
constexpr int J_IN = 16 * (INW / 128), J_BR = 4 * 8 * 16, J_OUT = 16 * 16, J_GU = NE * 16 * 8, J_DN = NE * 4 * 16, J_ALL = J_IN + J_BR + J_OUT + J_GU + J_DN;
__device__ __forceinline__ CvtItem cvt_decode_big(const Ctx& c, int l, int it) {
    CvtItem r;
    if (it < J_IN) { const int kb = it / (INW / 128), nb = it % (INW / 128); r.n0 = nb * 128; r.k0 = kb * 128; r.Wp = c.in[7] + (size_t)l * D * INW; r.ldw = INW; r.WT = WSH(O_WIN); r.ldt = D; r.drow = r.n0 < 10624 ? r.n0 : r.n0 + 128; return r; }
    it -= J_IN;
    if (it < J_BR) { const int sgm = it / 128, q = it % 128, kb = q / 16, nb = q % 16; r.n0 = nb * 128; r.k0 = kb * 128; r.Wp = c.in[28] + ((size_t)l * 4 + sgm) * W * D; r.ldw = D; r.WT = WSH(O_WBR) + sgm * W; r.ldt = 4 * W; r.drow = r.n0; return r; }
    it -= J_BR;
    if (it < J_OUT) { const int kb = it / 16, nb = it % 16; r.n0 = nb * 128; r.k0 = kb * 128; r.Wp = c.in[29] + (size_t)l * D * D; r.ldw = D; r.WT = WSH(O_WOUT); r.ldt = D; r.drow = r.n0; return r; }
    it -= J_OUT;
    if (it < J_GU) { const int e = it / 128, q = it % 128, kb = q / 8, nb = q % 8; r.n0 = nb * 128; r.k0 = kb * 128; r.Wp = c.in[34] + ((size_t)l * NE + e) * D * 1024; r.ldw = 1024; r.WT = WSH(O_WGU) + (size_t)e * 1024 * D; r.ldt = D;
        r.drow = r.n0 < 512 ? (r.n0 / 128) * 256 : ((r.n0 - 512) / 128) * 256 + 128; return r; }
    it -= J_GU;
    { const int e = it / 64, q = it % 64, kb = q / 16, nb = q % 16; r.n0 = nb * 128; r.k0 = kb * 128; r.Wp = c.in[35] + ((size_t)l * NE + e) * 512 * D; r.ldw = D; r.WT = WSH(O_WDN) + (size_t)e * D * 512; r.ldt = 512; r.drow = r.n0; return r; }
}
__device__ __forceinline__ void convert_big(const Ctx& c, int l, float* ldsf, int first, int last, int widx, int wcnt) {
    const int tid = threadIdx.x, lr = tid >> 5, lc = (tid & 31) * 4;
    f32x4 rg[8]; int it = first + widx; CvtItem r;
    if (it < last) { r = cvt_decode_big(c, l, it);
#pragma unroll
        for (int i = 0; i < 8; ++i) rg[i] = *(const f32x4*)(r.Wp + (size_t)(r.k0 + lr + 16 * i) * r.ldw + r.n0 + lc); }
    for (; it < last; it += wcnt) {
#pragma unroll
        for (int i = 0; i < 8; ++i) { float* dp = ldsf + (lr + 16 * i) * 129 + lc; dp[0] = rg[i][0]; dp[1] = rg[i][1]; dp[2] = rg[i][2]; dp[3] = rg[i][3]; }
        const CvtItem cur = r; const int nx = it + wcnt;
        if (nx < last) { r = cvt_decode_big(c, l, nx);
#pragma unroll
            for (int i = 0; i < 8; ++i) rg[i] = *(const f32x4*)(r.Wp + (size_t)(r.k0 + lr + 16 * i) * r.ldw + r.n0 + lc); }
        SYNCTHREADS();
#pragma unroll
        for (int q = 0; q < 4; ++q) { const int id = tid + NT * q, n = id >> 4, k8 = (id & 15) * 8; const float* sp = ldsf + k8 * 129 + n;
            u32x4 o; o[0] = pk2(sp[0 * 129], sp[1 * 129]); o[1] = pk2(sp[2 * 129], sp[3 * 129]); o[2] = pk2(sp[4 * 129], sp[5 * 129]); o[3] = pk2(sp[6 * 129], sp[7 * 129]);
            *(u32x4*)(cur.WT + (size_t)(cur.drow + n) * cur.ldt + cur.k0 + k8) = o; }
        SYNCTHREADS();
    }
}
__device__ __forceinline__ int convert_tail_tiles() { const int nun = (T / 256) * (PW / 256), G = (int)gridDim.x, rem = nun % G; return rem == 0 ? 0 : (G - rem) * 10 < J_GU + J_DN ? (G - rem) * 10 : J_GU + J_DN; }
__device__ __forceinline__ int convert_early_tiles(const Ctx& c) { const int G = (int)gridDim.x, nrest = (CTLW(c) + CW_PLAN)[40] * 4 - G; return (nrest >= 0 && nrest < G) ? ((G - nrest) * 12 < J_IN ? (G - nrest) * 12 : J_IN) : 0; }
__device__ __forceinline__ void ph_convert(const Ctx& c, int l, float* ldsf) {
    const int lane = threadIdx.x & 63, wave = threadIdx.x >> 6; const int gw = blockIdx.x * (NT / 64) + wave, ngw = gridDim.x * (NT / 64);
    convert_big(c, l, ldsf, l == 1 ? convert_early_tiles(c) : 0, J_ALL - convert_tail_tiles(), (int)blockIdx.x, (int)gridDim.x);
#ifdef CPU_EMU
    if (lane == 0) for (int it = I_BIG + gw; it < I_ALL; it += ngw) { const CvtItem r = cvt_decode(c, l, it);
        for (int kk = 0; kk < 64; ++kk) for (int nn = 0; nn < 32; ++nn) r.WT[(size_t)(r.drow + nn) * r.ldt + r.k0 + kk] = (bf16_t)f2bf(r.Wp[(size_t)(r.k0 + kk) * r.ldw + r.n0 + nn]); }
#else
    float* scr = ldsf + wave * (64 * 33 + 16);
    for (int it = I_BIG + gw; it < I_ALL; it += ngw) {
        const CvtItem r = cvt_decode(c, l, it);
#pragma unroll 8
        for (int i = 0; i < 32; ++i) { const int kk = 2 * i + (lane >> 5); scr[kk * 33 + (lane & 31)] = r.Wp[(size_t)(r.k0 + kk) * r.ldw + r.n0 + (lane & 31)]; }
        asm volatile("s_waitcnt lgkmcnt(0)" ::: "memory");
        const int cc = lane & 7;
#pragma unroll
        for (int j = 0; j < 4; ++j) { const int n = (lane >> 3) + 8 * j; const float* sp = scr + (8 * cc) * 33 + n;
            u32x4 o; o[0] = pk2(sp[0 * 33], sp[1 * 33]); o[1] = pk2(sp[2 * 33], sp[3 * 33]); o[2] = pk2(sp[4 * 33], sp[5 * 33]); o[3] = pk2(sp[6 * 33], sp[7 * 33]);
            *(u32x4*)(r.WT + (size_t)(r.drow + n) * r.ldt + r.k0 + 8 * cc) = o; }
        asm volatile("s_waitcnt lgkmcnt(0)" ::: "memory");
    }
#endif
    { const float* wg = c.in[30] + (size_t)l * D * 4; const float* we = c.in[32] + (size_t)l * D * 32; bf16_t* wh = WSH(O_WRH); bf16_t* wl = WSH(O_WRL);
      for (long i = GT_; i < (long)48 * D; i += GS_) { const int n = (int)(i / D), k = (int)(i % D); const float w = n < 4 ? wg[k * 4 + n] : n < 36 ? we[k * 32 + (n - 4)] : 0.f; const unsigned hb = f2bf(w); wh[i] = (bf16_t)hb; wl[i] = (bf16_t)f2bf(w - bf2f((bf16_t)hb)); } }
    for (long i = GT_; i < (long)128 * D / 2; i += GS_) ((unsigned*)(WSH(O_WIN) + (size_t)10624 * D))[i] = 0u;
}

namespace pg8 {
constexpr int BM = 256, BK = 64, HALF = 128, HTB = HALF * BK * 2, STAGE_BYTES = 8 * HTB;
__host__ __device__ __forceinline__ int lds_byte(int r, int cc) { const int st = (r >> 4) * 2 + (cc >> 5), rr = r & 15, c2 = cc & 31, ob = rr * 64 + c2 * 2; return st * 1024 + (ob ^ (((ob >> 9) & 1) << 5)); }
__host__ __device__ __forceinline__ void stage_rc(int b, int& R, int& C) { const int st = b / 1024, sb = b % 1024, swz = sb ^ (((sb >> 9) & 1) << 5); R = (st >> 1) * 16 + swz / 64; C = (st & 1) * 32 + (swz % 64) / 2; }
__host__ __device__ __forceinline__ int perm32(int rho) { const int n = rho >> 4, i = rho & 15; return 8 * (i >> 2) + 4 * n + (i & 3); }
struct Unit { int pm, pn, aux; const char* A; const char* B; };
struct Gemm { int K, lda, ldb; };

template <class Epi, class Sched>
__device__ __forceinline__ void gemm_phase(unsigned char* lds_, const Gemm g, const Sched& S, const Epi& E) {
#ifdef CPU_EMU
    if (threadIdx.x != 0) return;
    Unit u; const int K = g.K;
    float* Af = (float*)malloc((size_t)256 * K * 4); float* Bf = (float*)malloc((size_t)256 * K * 4); float* Cf = (float*)malloc(256 * 256 * 4);
    for (int i = 0; S.next(i, u); ++i) {
        const bf16_t* A = (const bf16_t*)u.A; const bf16_t* B = (const bf16_t*)u.B;
        for (int r = 0; r < 256; ++r) for (int k = 0; k < K; ++k) { Af[(size_t)r * K + k] = bf2f(A[(size_t)r * g.lda + k]); Bf[(size_t)r * K + k] = bf2f(B[(size_t)r * g.ldb + k]); }
        const int nseg = Epi::SEGT > 0 ? K / (Epi::SEGT * 64) : 1, kseg = K / nseg;
        for (int wid = 0; wid < 8; ++wid) for (int lane = 0; lane < 64; ++lane) {
            const int wr = wid >> 2, wc = wid & 3, fr = lane & 15, fq = lane >> 4; f32x4 acc[2][2][4][2];
            for (int ai = 0; ai < 2; ++ai) for (int bj = 0; bj < 2; ++bj) for (int m = 0; m < 4; ++m) for (int n = 0; n < 2; ++n) for (int j = 0; j < 4; ++j) acc[ai][bj][m][n][j] = 0.f;
            for (int sg = 0; sg < nseg; ++sg) {
                for (int ai = 0; ai < 2; ++ai) for (int bj = 0; bj < 2; ++bj) for (int m = 0; m < 4; ++m) for (int n = 0; n < 2; ++n) for (int j = 0; j < 4; ++j) {
                    const int r = 128 * ai + 64 * wr + 16 * m + fr, cc = 128 * bj + 32 * wc + (Epi::PERM ? 8 * fq + 4 * n + j : 16 * n + 4 * fq + j);
                    const float* a = Af + (size_t)r * K + sg * kseg; const float* b = Bf + (size_t)cc * K + sg * kseg; float sacc = 0.f; for (int k = 0; k < kseg; ++k) sacc += a[k] * b[k];
                    acc[ai][bj][m][n][j] += sacc; }
                if constexpr (Epi::SEGT > 0) { if (sg + 1 < nseg) E.segment(acc, u, sg, wr, wc, fr, fq); }
            }
            E(acc, u, wr, wc, fr, fq);
        }
    }
    free(Af); free(Bf); free(Cf);
#else
    typedef __attribute__((address_space(3))) unsigned char* ldsp_t;
    ldsp_t lds = (ldsp_t)lds_;
    const int tid = threadIdx.x, wid = __builtin_amdgcn_readfirstlane(tid >> 6), lane = tid & 63, wr = wid >> 2, wc = wid & 3, fr = lane & 15, fq = lane >> 4;
    const int K = g.K, nt = K / BK;
    unsigned voffA[2], voffB[2];
#pragma unroll
    for (int i = 0; i < 2; ++i) { int R, C; stage_rc(tid * 16 + i * 8192, R, C); const int Rb = Epi::PERM ? ((R & ~31) + perm32(R & 31)) : R;
        voffA[i] = (unsigned)(R * g.lda + C) * 2u; voffB[i] = (unsigned)(Rb * g.ldb + C) * 2u; }
    const size_t kstep = (size_t)(BK * 2);
    const size_t hstepA = (size_t)HALF * g.lda * 2, hstepB = (size_t)HALF * g.ldb * 2;
    const unsigned ldsw = (unsigned)wid * 1024u;
    const int aoff = lds_byte(wr * 64 + fr, fq * 8), boff = lds_byte(wc * 32 + fr, fq * 8);
#define PG8_SA(b, h) (((b) * 2 + (h)) * HTB)
#define PG8_SB(b, h) ((4 + (b) * 2 + (h)) * HTB)
#define PG8_STAGE(bufoff, gbase, voff) do { _Pragma("unroll") for (int _i = 0; _i < 2; ++_i) \
        __builtin_amdgcn_global_load_lds((const unsigned*)((const char*)(gbase) + (voff)[_i]), (__attribute__((address_space(3))) unsigned*)(lds + (bufoff) + ldsw + _i * 8192), 16, 0, 0); } while (0)
#define PG8_LDA(dst, b, h) do { _Pragma("unroll") for (int m = 0; m < 4; ++m) _Pragma("unroll") for (int k = 0; k < 2; ++k) dst[m][k] = *(const __attribute__((address_space(3))) bf16x8*)(lds + PG8_SA(b, h) + aoff + m * 2048 + k * 1024); } while (0)
#define PG8_LDB(dst, b, h) do { _Pragma("unroll") for (int n = 0; n < 2; ++n) _Pragma("unroll") for (int k = 0; k < 2; ++k) dst[n][k] = *(const __attribute__((address_space(3))) bf16x8*)(lds + PG8_SB(b, h) + boff + n * 2048 + k * 1024); } while (0)
#define PG8_MMA(ai, bj, At, Bt) do { __builtin_amdgcn_s_setprio(1); _Pragma("unroll") for (int m = 0; m < 4; ++m) _Pragma("unroll") for (int n = 0; n < 2; ++n) _Pragma("unroll") for (int k = 0; k < 2; ++k) \
        acc[ai][bj][m][n] = __builtin_amdgcn_mfma_f32_16x16x32_bf16(Bt[n][k], At[m][k], acc[ai][bj][m][n], 0, 0, 0); __builtin_amdgcn_s_setprio(0); } while (0)
#define PG8_WAIT_V(n) asm volatile("s_waitcnt vmcnt(" #n ")" ::: "memory")
#define PG8_WAIT_L(n) asm volatile("s_waitcnt lgkmcnt(" #n ")" ::: "memory")
#define PG8_BAR __builtin_amdgcn_s_barrier()
#define PG8_SCHED __builtin_amdgcn_sched_barrier(0)
    Unit cur, nxt; int ui = 0;
    if (!S.next(0, cur)) return;
    f32x4 acc[2][2][4][2];
#pragma unroll
    for (int a = 0; a < 2; ++a)
#pragma unroll
        for (int b = 0; b < 2; ++b)
#pragma unroll
            for (int m = 0; m < 4; ++m)
#pragma unroll
                for (int n = 0; n < 2; ++n) acc[a][b][m][n] = (f32x4){0.f, 0.f, 0.f, 0.f};
    bf16x8 At[4][2], B0[2][2], B1[2][2];
    const char* cA = cur.A; const char* cB = cur.B;
    S.a_ready(cur);
    PG8_STAGE(PG8_SB(0, 0), cB, voffB); PG8_STAGE(PG8_SA(0, 0), cA, voffA); PG8_STAGE(PG8_SB(0, 1), cB + hstepB, voffB); PG8_STAGE(PG8_SA(0, 1), cA + hstepA, voffA);
    if (wr == 1) PG8_BAR;
    PG8_WAIT_V(4); PG8_BAR;
    PG8_STAGE(PG8_SB(1, 0), cB + kstep, voffB); PG8_STAGE(PG8_SA(1, 0), cA + kstep, voffA); PG8_STAGE(PG8_SB(1, 1), cB + hstepB + kstep, voffB);
    PG8_WAIT_V(6); PG8_BAR;
    for (;;) {
        const bool has_next = S.next(ui + 1, nxt);
        const char* nA = has_next ? nxt.A : cA; const char* nB = has_next ? nxt.B : cB;
        for (int t = 0; t < nt; t += 2) {
            const bool last = (t == nt - 2);
            const char* a1 = cA + (size_t)(t + 1) * kstep;
            const char* a2 = last ? nA : cA + (size_t)(t + 2) * kstep; const char* b2 = last ? nB : cB + (size_t)(t + 2) * kstep;
            const char* a3 = a2 + kstep; const char* b3 = b2 + kstep;
            if (last && has_next) S.a_ready(nxt);
            PG8_LDB(B0, 0, 0); PG8_SCHED; PG8_LDA(At, 0, 0); PG8_STAGE(PG8_SA(1, 1), a1 + hstepA, voffA);
            PG8_WAIT_L(8); PG8_BAR; PG8_WAIT_L(0); PG8_MMA(0, 0, At, B0); PG8_BAR; PG8_SCHED;
            PG8_LDB(B1, 0, 1); PG8_STAGE(PG8_SB(0, 0), b2, voffB);
            PG8_BAR; PG8_WAIT_L(0); PG8_MMA(0, 1, At, B1); PG8_BAR;
            PG8_LDA(At, 0, 1); PG8_STAGE(PG8_SA(0, 0), a2, voffA);
            PG8_BAR; PG8_WAIT_L(0); PG8_MMA(1, 0, At, B0); PG8_BAR; PG8_SCHED;
            PG8_STAGE(PG8_SB(0, 1), b2 + hstepB, voffB);
            PG8_WAIT_V(6); PG8_BAR; PG8_MMA(1, 1, At, B1); PG8_BAR;
            PG8_LDB(B0, 1, 0); PG8_SCHED; PG8_LDA(At, 1, 0); PG8_STAGE(PG8_SA(0, 1), a2 + hstepA, voffA);
            PG8_WAIT_L(8); PG8_BAR; PG8_WAIT_L(0); PG8_MMA(0, 0, At, B0); PG8_BAR; PG8_SCHED;
            PG8_LDB(B1, 1, 1); PG8_STAGE(PG8_SB(1, 0), b3, voffB);
            PG8_BAR; PG8_WAIT_L(0); PG8_MMA(0, 1, At, B1); PG8_BAR;
            PG8_LDA(At, 1, 1); PG8_STAGE(PG8_SA(1, 0), a3, voffA);
            PG8_BAR; PG8_WAIT_L(0); PG8_MMA(1, 0, At, B0); PG8_BAR; PG8_SCHED;
            PG8_STAGE(PG8_SB(1, 1), b3 + hstepB, voffB);
            PG8_WAIT_V(6); PG8_BAR; PG8_MMA(1, 1, At, B1); PG8_BAR;
            if constexpr (Epi::SEGT > 0) { if ((t + 2) % Epi::SEGT == 0 && t + 2 < nt) E.segment(acc, cur, (t + 2) / Epi::SEGT - 1, wr, wc, fr, fq); }
        }
        E(acc, cur, wr, wc, fr, fq); S.done(cur);
        if (!has_next) break;
#pragma unroll
        for (int a = 0; a < 2; ++a)
#pragma unroll
            for (int b = 0; b < 2; ++b)
#pragma unroll
                for (int m = 0; m < 4; ++m)
#pragma unroll
                    for (int n = 0; n < 2; ++n) acc[a][b][m][n] = (f32x4){0.f, 0.f, 0.f, 0.f};
        cur = nxt; cA = nA; cB = nB; ++ui;
    }
    PG8_WAIT_V(0);
    if (wr == 0) PG8_BAR;
    PG8_BAR;
#undef PG8_SA
#undef PG8_SB
#undef PG8_STAGE
#undef PG8_LDA
#undef PG8_LDB
#undef PG8_MMA
#undef PG8_WAIT_V
#undef PG8_WAIT_L
#undef PG8_BAR
#undef PG8_SCHED
#endif
}

struct StaticOrder {
    int nM, nN, nwg, G, c; const char* A; const char* B; size_t tstepA, tstepB;
    __device__ __forceinline__ void init(int M, int N, int G_, int c_, const void* A_, const void* B_, int lda, int ldb) { nM = M / BM; nN = N / BM; nwg = nM * nN; G = G_; c = c_; A = (const char*)A_; B = (const char*)B_; tstepA = (size_t)BM * lda * 2; tstepB = (size_t)BM * ldb * 2; }
    __device__ __forceinline__ bool next(int i, Unit& u) const {
        const long L = (long)i * G + c; if (L >= nwg) return false;
        int wgid = (int)L; { const int q = nwg / 8, r = nwg % 8, xcd = wgid % 8, off = wgid / 8; wgid = (xcd < r ? xcd * (q + 1) : r * (q + 1) + (xcd - r) * q) + off; }
        const int nig = 8 * nN, gid = wgid / nig, fm = gid * 8, gsz = (nM - fm) < 8 ? (nM - fm) : 8;
        u.pm = fm + ((wgid % nig) % gsz); u.pn = (wgid % nig) / gsz; u.aux = 0; u.A = A + (size_t)u.pm * tstepA; u.B = B + (size_t)u.pn * tstepB; return true;
    }
    __device__ __forceinline__ void a_ready(const Unit&) const {}
    __device__ __forceinline__ void done(const Unit&) const {}
};
struct MergeOrder {
    StaticOrder so; int kseg_bytes;
    __device__ __forceinline__ bool next(int i, Unit& u) const { if (!so.next(i >> 2, u)) return false; u.aux = i & 3; u.A += (size_t)u.aux * kseg_bytes; u.B += (size_t)u.aux * kseg_bytes; return true; }
    __device__ __forceinline__ void a_ready(const Unit&) const {}
    __device__ __forceinline__ void done(const Unit&) const {}
};
struct MoeOrder {
    int G, c, ncol; const int* plan; const char* A; const char* B; size_t tstepA, tstepB, estep;
    __device__ __forceinline__ bool next(int i, Unit& u) const {
        const long L = (long)i * G + c; const int nblk = plan[40]; if (L >= (long)nblk * ncol) return false;
        u.pm = (int)(L / ncol); u.pn = (int)(L % ncol); u.aux = plan[64 + u.pm]; u.A = A + (size_t)u.pm * tstepA; u.B = B + (size_t)u.aux * estep + (size_t)u.pn * tstepB; return true;
    }
    __device__ __forceinline__ void a_ready(const Unit&) const {}
    __device__ __forceinline__ void done(const Unit&) const {}
};

__device__ __forceinline__ u32x4 pack8(const f32x4 v0, const f32x4 v1) { u32x4 w; w[0] = pk2(v0[0], v0[1]); w[1] = pk2(v0[2], v0[3]); w[2] = pk2(v1[0], v1[1]); w[3] = pk2(v1[2], v1[3]); return w; }
struct EpiBf16 {
    static constexpr int SEGT = 0; static constexpr bool PERM = true; bf16_t* O; int ldc;
    __device__ __forceinline__ void operator()(const f32x4 (&acc)[2][2][4][2], const Unit& u, int wr, int wc, int fr, int fq) const {
        const int row0 = u.pm * BM + wr * 64 + fr, col0 = u.pn * BM + wc * 32 + 8 * fq;
#pragma unroll
        for (int ai = 0; ai < 2; ++ai)
#pragma unroll
            for (int m = 0; m < 4; ++m) { bf16_t* rowp = O + (size_t)(row0 + ai * HALF + m * 16) * ldc + col0;
#pragma unroll
                for (int bj = 0; bj < 2; ++bj) *(u32x4*)(rowp + bj * HALF) = pack8(acc[ai][bj][m][0], acc[ai][bj][m][1]); }
    }
};
struct EpiP {
    static constexpr int SEGT = 0; static constexpr bool PERM = true; bf16_t* O; unsigned char* G8;
    __device__ __forceinline__ void operator()(const f32x4 (&acc)[2][2][4][2], const Unit& u, int wr, int wc, int fr, int fq) const {
        const int row0 = u.pm * BM + wr * 64 + fr, col0 = u.pn * BM + wc * 32 + 8 * fq;
        if (u.pn * BM < C_MLP) {
#pragma unroll
            for (int ai = 0; ai < 2; ++ai)
#pragma unroll
                for (int m = 0; m < 4; ++m) { bf16_t* rowp = O + (size_t)(row0 + ai * HALF + m * 16) * PW + col0;
#pragma unroll
                    for (int bj = 0; bj < 2; ++bj) *(u32x4*)(rowp + bj * HALF) = pack8(acc[ai][bj][m][0], acc[ai][bj][m][1]); }
        } else {
#pragma unroll
            for (int ai = 0; ai < 2; ++ai)
#pragma unroll
                for (int m = 0; m < 4; ++m) { unsigned char* rowp = G8 + (size_t)(row0 + ai * HALF + m * 16) * (4 * D) + (col0 - C_MLP);
#pragma unroll
                    for (int bj = 0; bj < 2; ++bj) { unsigned long long w = 0ull;
#pragma unroll
                        for (int q = 0; q < 8; ++q) { const float gq = sigmoidf_(acc[ai][bj][m][q >> 2][q & 3]); w |= (unsigned long long)(unsigned)(gq * 255.f + 0.5f) << (8 * q); }
                        *(unsigned long long*)(rowp + bj * HALF) = w; } }
        }
    }
};
struct EpiMerge {
    static constexpr int SEGT = 16; static constexpr bool PERM = true; const unsigned char* G8; bf16_t* MRG;
    static __device__ __forceinline__ float gq(unsigned long long w, int q) { const unsigned b = (unsigned)(w >> (8 * q)) & 255u; return (b ? (float)b : 0.5f) * (1.f / 255.f); }
    __device__ __forceinline__ void segment(f32x4 (&acc)[2][2][4][2], const Unit& u, int seg, int wr, int wc, int fr, int fq) const {
        const int row0 = u.pm * BM + wr * 64 + fr, col0 = u.pn * BM + wc * 32 + 8 * fq;
#pragma unroll
        for (int ai = 0; ai < 2; ++ai)
#pragma unroll
            for (int m = 0; m < 4; ++m) { const size_t r = (size_t)(row0 + ai * HALF + m * 16);
#pragma unroll
                for (int bj = 0; bj < 2; ++bj) { const int cc = col0 + bj * HALF;
                    const unsigned long long g0 = *(const unsigned long long*)(G8 + r * (4 * D) + seg * D + cc), g1 = *(const unsigned long long*)(G8 + r * (4 * D) + (seg + 1) * D + cc);
#pragma unroll
                    for (int q = 0; q < 4; ++q) { acc[ai][bj][m][0][q] *= gq(g0, q) * frcp_(gq(g1, q)); acc[ai][bj][m][1][q] *= gq(g0, 4 + q) * frcp_(gq(g1, 4 + q)); } }
#ifndef CPU_EMU
                asm volatile("" ::: "memory");
#endif
            }
    }
    __device__ __forceinline__ void operator()(const f32x4 (&acc)[2][2][4][2], const Unit& u, int wr, int wc, int fr, int fq) const {
        const int row0 = u.pm * BM + wr * 64 + fr, col0 = u.pn * BM + wc * 32 + 8 * fq;
#pragma unroll
        for (int ai = 0; ai < 2; ++ai)
#pragma unroll
            for (int m = 0; m < 4; ++m) { const size_t r = (size_t)(row0 + ai * HALF + m * 16);
#pragma unroll
                for (int bj = 0; bj < 2; ++bj) { const int cc = col0 + bj * HALF;
                    const unsigned long long g3 = *(const unsigned long long*)(G8 + r * (4 * D) + 3 * D + cc); f32x4 v0, v1;
#pragma unroll
                    for (int q = 0; q < 4; ++q) { v0[q] = gq(g3, q) * acc[ai][bj][m][0][q]; v1[q] = gq(g3, 4 + q) * acc[ai][bj][m][1][q]; }
                    *(u32x4*)(MRG + r * D + cc) = pack8(v0, v1); }
#ifndef CPU_EMU
                asm volatile("" ::: "memory");
#endif
            }
    }
};
struct EpiResid {
    static constexpr int SEGT = 0; static constexpr bool PERM = false; const float* xin; const float* g1; float* xmid;
    __device__ __forceinline__ void operator()(const f32x4 (&acc)[2][2][4][2], const Unit& u, int wr, int wc, int fr, int fq) const {
        const int row0 = u.pm * BM + wr * 64 + fr, col0 = u.pn * BM + wc * 32 + 4 * fq;
#pragma unroll
        for (int ai = 0; ai < 2; ++ai)
#pragma unroll
            for (int m = 0; m < 4; ++m) { const int r = row0 + ai * HALF + m * 16; const float* gp = g1 + (size_t)(r / S) * D6;
#pragma unroll
                for (int bj = 0; bj < 2; ++bj)
#pragma unroll
                    for (int n = 0; n < 2; ++n) { const int cc = col0 + bj * HALF + n * 16; *(f32x4*)(xmid + (size_t)r * D + cc) = *(const f32x4*)(xin + (size_t)r * D + cc) + *(const f32x4*)(gp + cc) * acc[ai][bj][m][n]; }
#ifndef CPU_EMU
                asm volatile("" ::: "memory");
#endif
            }
    }
};
struct EpiGU {
    static constexpr int SEGT = 0; static constexpr bool PERM = true; bf16_t* ACT;
    __device__ __forceinline__ void operator()(const f32x4 (&acc)[2][2][4][2], const Unit& u, int wr, int wc, int fr, int fq) const {
        const int row0 = u.pm * BM + wr * 64 + fr, col0 = u.pn * HALF + wc * 32 + 8 * fq;
#pragma unroll
        for (int ai = 0; ai < 2; ++ai)
#pragma unroll
            for (int m = 0; m < 4; ++m) { f32x4 v0, v1;
#pragma unroll
                for (int j = 0; j < 4; ++j) { v0[j] = siluf_(acc[ai][0][m][0][j]) * acc[ai][1][m][0][j]; v1[j] = siluf_(acc[ai][0][m][1][j]) * acc[ai][1][m][1][j]; }
                *(u32x4*)(ACT + (size_t)(row0 + ai * HALF + m * 16) * 512 + col0) = pack8(v0, v1); }
    }
};
}

template <int PASS>
__device__ __forceinline__ void ph_lru(const Ctx& c, int l, float* ldsf) {
    const bf16_t* P = WSH(O_P); const float* cw = c.in[8] + (size_t)l * 4 * W; const float* cb = c.in[9] + (size_t)l * W;
    const float* br = c.in[11] + (size_t)l * 2 * W; const float* bi = c.in[13] + (size_t)l * 2 * W; const float* lam = c.in[14] + (size_t)l * 2 * W; const bf16_t* WLR = WSH(O_WLR);
    float* CA = WSF(O_LCA); float* CH = WSF(O_LCH); const float* CI = WSF(O_LCI); bf16_t* Y = WSH(O_YS); unsigned* LAU = (unsigned*)(c.ws + O_LA);
    bf16_t* Xs = (bf16_t*)ldsf; bf16_t* Wr = Xs + 64 * 136; bf16_t* Wi = Wr + 128 * 136; float* AUa = (float*)Wr; float* AUu = AUa + 64 * 128; float* HF = (float*)(Wi + 128 * 136); float* spl = HF + 64 * 128;
    const int tid = threadIdx.x, wv = tid >> 6, lane = tid & 63, fr = lane & 15, fq = lane >> 4, rt = wv & 3, hf = wv >> 2;
    for (int u = blockIdx.x; u < (T / 64) * 8; u += gridDim.x) {
        const int n = u & 7, tile = u >> 3, b = tile / NLC, chk = tile % NLC; const long t0 = (long)tile * 64;
        if (tid < 256) spl[tid] = softplusf_(-lam[(tid >> 7) * W + n * 128 + (tid & 127)]);
#pragma unroll
        for (int q = 0; q < 4; ++q) { const int id = tid + NT * q, tl = id >> 5, e4 = (id & 31) * 4, ch = n * 128 + e4; const long t = t0 + tl; const int sI = (int)(t % S);
            f32x4 acc = *(const f32x4*)(cb + ch);
#pragma unroll
            for (int k = 0; k < 4; ++k) { const int ss = sI + k - 2; if (ss >= 0 && ss < S) acc += ld_bf4(P + (size_t)(t + k - 2) * PW + C_LX + ch) * *(const f32x4*)(cw + k * W + ch); }
            st_bf4(Xs + tl * 136 + e4, acc); }
        for (int z = 0; z < 2; ++z) {
#pragma unroll
            for (int q = 0; q < 4; ++q) { const int id = tid + NT * q, f = id >> 4, e8 = (id & 15) * 8;
                *(u32x4*)(Wr + f * 136 + e8) = *(const u32x4*)(WLR + ((size_t)((z * 2 + 0) * 8 + n) * 128 + f) * 128 + e8); *(u32x4*)(Wi + f * 136 + e8) = *(const u32x4*)(WLR + ((size_t)((z * 2 + 1) * 8 + n) * 128 + f) * 128 + e8); }
            SYNCTHREADS();
            f32x4 ar[4], ai[4];
#pragma unroll
            for (int nt = 0; nt < 4; ++nt) { ar[nt] = (f32x4){0.f, 0.f, 0.f, 0.f}; ai[nt] = (f32x4){0.f, 0.f, 0.f, 0.f}; }
            wave_mma<4, 4>(ar, Xs + rt * 16 * 136, 136, Wr + hf * 64 * 136, 136);
            wave_mma<4, 4>(ai, Xs + rt * 16 * 136, 136, Wi + hf * 64 * 136, 136);
            SYNCTHREADS();
            const int tl = rt * 16 + fr;
#pragma unroll
            for (int nt = 0; nt < 4; ++nt) { const int f = 64 * hf + 16 * nt + 4 * fq, ch = n * 128 + f;
                const f32x4 brv = *(const f32x4*)(br + z * W + ch), biv = *(const f32x4*)(bi + z * W + ch), lmv = *(const f32x4*)(spl + z * 128 + f), xcv = ld_bf4(Xs + tl * 136 + f); f32x4 av, uv, lav;
#pragma unroll
                for (int e = 0; e < 4; ++e) { const float r = sigmoidf_(ar[nt][e] + brv[e]), ig = sigmoidf_(ai[nt][e] + biv[e]), la = -8.f * r * lmv[e]; const float a = fexp_(la); av[e] = a; lav[e] = la; uv[e] = sqrtf(fmaxf(1.f - a * a, 0.f)) * ig * xcv[e]; }
                *(f32x4*)(AUa + tl * 128 + f) = av; *(f32x4*)(AUu + tl * 128 + f) = uv;
                if (PASS == 1) { u32x4 pk;
#pragma unroll
                    for (int e = 0; e < 4; ++e) pk[e] = pk2(lav[e], uv[e]);
                    *(u32x4*)(LAU + ((size_t)z * T + t0 + tl) * W + ch) = pk; } }
            SYNCTHREADS();
            if (tid < 128) { const int f = tid; const size_t ci = (((size_t)z * NB + b) * NLC + chk) * W + n * 128 + f;
                if (PASS == 1) { float prod = 1.f, h = 0.f;
#pragma unroll 8
                    for (int q = 0; q < 64; ++q) { const int sI = z == 0 ? q : 63 - q; const float a = AUa[sI * 128 + f]; h = a * h + AUu[sI * 128 + f]; prod *= a; }
                    CA[ci] = prod; CH[ci] = h;
                } else { float h = CI[ci];
                    if (z == 0) {
#pragma unroll 8
                        for (int q = 0; q < 64; ++q) { h = AUa[q * 128 + f] * h + AUu[q * 128 + f]; HF[q * 128 + f] = h; }
                    } else {
#pragma unroll 8
                        for (int q = 63; q >= 0; --q) { h = AUa[q * 128 + f] * h + AUu[q * 128 + f]; HF[q * 128 + f] += h; } } }
            }
            SYNCTHREADS();
        }
        if (PASS == 2) {
#pragma unroll
            for (int q = 0; q < 4; ++q) { const int id = tid + NT * q, tl = id >> 5, f4 = (id & 31) * 4; const long t = t0 + tl; f32x4 hv = *(const f32x4*)(HF + tl * 128 + f4); const f32x4 gv = ld_bf4(P + (size_t)t * PW + C_LG + n * 128 + f4);
#pragma unroll
                for (int e = 0; e < 4; ++e) hv[e] *= geluf_(gv[e]);
                st_bf4(Y + (size_t)t * 4 * W + 0 * W + n * 128 + f4, hv); }
            SYNCTHREADS();
        }
    }
}
__device__ __forceinline__ void ph_lru_fin(const Ctx& c, float* ldsf) {
    const bf16_t* P = WSH(O_P); const unsigned* LAU = (const unsigned*)(c.ws + O_LA); const float* CI = WSF(O_LCI); bf16_t* Y = WSH(O_YS);
    unsigned* Lz = (unsigned*)ldsf; float* Hz = ldsf + 2 * 64 * 128; const int tid = threadIdx.x;
    for (int u = blockIdx.x; u < (T / 64) * 8; u += gridDim.x) {
        const int n = u & 7, tile = u >> 3, b = tile / NLC, chk = tile % NLC; const long t0 = (long)tile * 64;
#pragma unroll
        for (int q = 0; q < 8; ++q) { const int id = tid + NT * q, z = id >> 11, r = (id >> 5) & 63, c4 = (id & 31) * 4; *(u32x4*)(Lz + z * 8192 + r * 128 + c4) = *(const u32x4*)(LAU + ((size_t)z * T + t0 + r) * W + n * 128 + c4); }
        SYNCTHREADS();
        if (tid < 256) { const int z = tid >> 7, f = tid & 127; float h = CI[(((size_t)z * NB + b) * NLC + chk) * W + n * 128 + f]; const unsigned* lp = Lz + z * 8192 + f; float* hp = Hz + z * 8192 + f;
#pragma unroll 8
            for (int q = 0; q < 64; ++q) { const int sI = z == 0 ? q : 63 - q; const unsigned w = lp[sI * 128]; h = fexp_(bflo(w)) * h + bfhi(w); hp[sI * 128] = h; } }
        SYNCTHREADS();
#pragma unroll
        for (int q = 0; q < 4; ++q) { const int id = tid + NT * q, r = id >> 5, f4 = (id & 31) * 4; const long t = t0 + r; f32x4 o = *(const f32x4*)(Hz + r * 128 + f4) + *(const f32x4*)(Hz + 8192 + r * 128 + f4); const f32x4 gv = ld_bf4(P + (size_t)t * PW + C_LG + n * 128 + f4);
#pragma unroll
            for (int e = 0; e < 4; ++e) o[e] *= geluf_(gv[e]);
            st_bf4(Y + (size_t)t * 4 * W + 0 * W + n * 128 + f4, o); }
        SYNCTHREADS();
    }
}
__device__ __forceinline__ void ph_lru_scan2(const Ctx& c) {
    const float* CA = WSF(O_LCA); const float* CH = WSF(O_LCH); float* CI = WSF(O_LCI);
    for (long i = GT_; i < (long)2 * NB * W; i += GS_) {
        const int w = (int)(i % W), b = (int)((i / W) % NB), z = (int)(i / ((long)W * NB)); float carry = 0.f;
#pragma unroll 16
        for (int q = 0; q < NLC; ++q) { const int ch = z == 0 ? q : NLC - 1 - q; const size_t idx = (((size_t)z * NB + b) * NLC + ch) * W + w; CI[idx] = carry; carry = CA[idx] * carry + CH[idx]; }
    }
}
__device__ __forceinline__ void ph_rope_table(const Ctx& c) {
    const int* pos = (const int*)c.in[2]; float* RT = WSF(O_ROPE);
    for (long i = GT_; i < (long)T * 32; i += GS_) { const int j = (int)(i & 31); const float ang = (float)pos[i >> 5] * powf(10000.f, -(float)(2 * j) / 64.f); RT[i * 2] = cosf(ang); RT[i * 2 + 1] = sinf(ang); }
}
__device__ __forceinline__ void ret_tables(float* tab, int h) {
    const int tid = threadIdx.x; const float lg = loggamma_(h);
    if (tid < 32) tab[tid] = powf(10000.f, -(float)(2 * tid) / 64.f);
    if (tid >= 64 && tid < 64 + 129) tab[tid] = expf((float)(tid - 64) * lg);
}
__device__ __forceinline__ void ph_ret_kv(const Ctx& c, float* ldsf) {
    const float* RT = WSF(O_ROPE); const bf16_t* P = WSH(O_P); float* KVF = WSF(O_KVF); float* KVB = WSF(O_KVB);
    bf16_t* VT = (bf16_t*)ldsf; bf16_t* KF = VT + 128 * 136; bf16_t* KB = KF + 64 * 136; float* tab = (float*)(KB + 64 * 136);
    const int tid = threadIdx.x, wv = tid >> 6, lane = tid & 63, fr = lane & 15, fq = lane >> 4;
    for (int u = blockIdx.x; u < (T / 128) * 8; u += gridDim.x) {
        const int h = u & 7; const long t0 = (long)(u >> 3) * 128;
        ret_tables(tab, h);
        SYNCTHREADS();
        { float x1[8], x2[8];
#pragma unroll
          for (int q = 0; q < 8; ++q) { const int id = tid + NT * q, j = id & 127, dj = id >> 7; const bf16_t* prow = P + (size_t)(t0 + j) * PW + C_RK + h * 64; x1[q] = bf2f(prow[dj]); x2[q] = bf2f(prow[dj + 32]); }
#pragma unroll 1
          for (int q = 0; q < 8; ++q) { const int id = tid + NT * q, j = id & 127, dj = id >> 7; const float cs = RT[((size_t)(t0 + j) * 32 + dj) * 2], sn = RT[((size_t)(t0 + j) * 32 + dj) * 2 + 1];
            const float k1 = x1[q] * cs - x2[q] * sn, k2 = x2[q] * cs + x1[q] * sn, fj = tab[64 + 127 - j], bj = tab[64 + j];
            KF[dj * 136 + j] = (bf16_t)f2bf(k1 * fj); KF[(dj + 32) * 136 + j] = (bf16_t)f2bf(k2 * fj); KB[dj * 136 + j] = (bf16_t)f2bf(k1 * bj); KB[(dj + 32) * 136 + j] = (bf16_t)f2bf(k2 * bj); } }
#pragma unroll
        for (int q = 0; q < 4; ++q) { const int id = tid + NT * q, j = id & 127, e8 = (id >> 7) * 8; const u32x4 raw = *(const u32x4*)(P + (size_t)(t0 + j) * PW + C_RV + h * 128 + e8);
#pragma unroll
            for (int e = 0; e < 4; ++e) { VT[(e8 + 2 * e) * 136 + j] = (bf16_t)(raw[e] & 0xffffu); VT[(e8 + 2 * e + 1) * 136 + j] = (bf16_t)(raw[e] >> 16); } }
        SYNCTHREADS();
        f32x4 af[4], ab[4];
#pragma unroll
        for (int nt = 0; nt < 4; ++nt) { af[nt] = (f32x4){0.f, 0.f, 0.f, 0.f}; ab[nt] = (f32x4){0.f, 0.f, 0.f, 0.f}; }
        wave_mma<4, 4>(af, VT + wv * 16 * 136, 136, KF, 136);
        wave_mma<4, 4>(ab, VT + wv * 16 * 136, 136, KB, 136);
        const size_t ob = (((size_t)(u >> 3) * 8 + h) * 128 + wv * 16 + fr) * 64 + 4 * fq;
#pragma unroll
        for (int nt = 0; nt < 4; ++nt) { *(f32x4*)(KVF + ob + 16 * nt) = af[nt]; *(f32x4*)(KVB + ob + 16 * nt) = ab[nt]; }
        SYNCTHREADS();
    }
}
__device__ __forceinline__ void ph_ret_state(const Ctx& c) {
    const float* KVF = WSF(O_KVF); const float* KVB = WSF(O_KVB); float* STF = WSF(O_STF); float* STB = WSF(O_STB);
    for (long i = GT_; i < (long)NB * 8 * 8192; i += GS_) {
        const int x = (int)(i % 8192), h = (int)((i / 8192) % 8), b = (int)(i / 65536);
        const float cd = expf(128.f * loggamma_(h)); float st = 0.f;
#pragma unroll 16
        for (int n = 0; n < NCH; ++n) { const size_t idx = (((size_t)b * NCH + n) * 8 + h) * 8192 + x; STF[idx] = st; st = cd * st + KVF[idx]; }
        st = 0.f;
#pragma unroll 16
        for (int n = NCH - 1; n >= 0; --n) { const size_t idx = (((size_t)b * NCH + n) * 8 + h) * 8192 + x; STB[idx] = st; st = cd * st + KVB[idx]; }
    }
}
__device__ __forceinline__ void ph_ret_out(const Ctx& c, float* ldsf) {
    const float* RT = WSF(O_ROPE); const bf16_t* P = WSH(O_P); const float* STF = WSF(O_STF); const float* STB = WSF(O_STB); bf16_t* Y = WSH(O_YS);
    bf16_t* Qs = (bf16_t*)ldsf; bf16_t* Ks = Qs + 128 * 72; bf16_t* VT = Ks + 128 * 72; bf16_t* Ss = VT + 128 * 136; bf16_t* SF = Ss + 128 * 136; bf16_t* SB = SF + 128 * 72; float* tab = (float*)(SB + 128 * 72);
    const int tid = threadIdx.x, wv = tid >> 6, lane = tid & 63, fr = lane & 15, fq = lane >> 4;
    for (int u = blockIdx.x; u < (T / 128) * 8; u += gridDim.x) {
        const int h = u & 7; const long t0 = (long)(u >> 3) * 128;
        ret_tables(tab, h);
        SYNCTHREADS();
#pragma unroll 1
        for (int qh = 0; qh < 8; qh += 4) { float q1[4], q2[4], k1[4], k2[4];
#pragma unroll
          for (int q = 0; q < 4; ++q) { const int id = tid + NT * (qh + q), j = id >> 5, dj = id & 31; const bf16_t* prow = P + (size_t)(t0 + j) * PW;
            q1[q] = bf2f(prow[C_RQ + h * 64 + dj]); q2[q] = bf2f(prow[C_RQ + h * 64 + dj + 32]); k1[q] = bf2f(prow[C_RK + h * 64 + dj]); k2[q] = bf2f(prow[C_RK + h * 64 + dj + 32]); }
#pragma unroll
          for (int q = 0; q < 4; ++q) { const int id = tid + NT * (qh + q), j = id >> 5, dj = id & 31; const float cs = RT[((size_t)(t0 + j) * 32 + dj) * 2], sn = RT[((size_t)(t0 + j) * 32 + dj) * 2 + 1];
            Qs[j * 72 + dj] = (bf16_t)f2bf((q1[q] * cs - q2[q] * sn) * 0.125f); Qs[j * 72 + dj + 32] = (bf16_t)f2bf((q2[q] * cs + q1[q] * sn) * 0.125f); Ks[j * 72 + dj] = (bf16_t)f2bf(k1[q] * cs - k2[q] * sn); Ks[j * 72 + dj + 32] = (bf16_t)f2bf(k2[q] * cs + k1[q] * sn); } }
#pragma unroll
        for (int q = 0; q < 4; ++q) { const int id = tid + NT * q, j = id & 127, e8 = (id >> 7) * 8; const u32x4 raw = *(const u32x4*)(P + (size_t)(t0 + j) * PW + C_RV + h * 128 + e8);
#pragma unroll
            for (int e = 0; e < 4; ++e) { VT[(e8 + 2 * e) * 136 + j] = (bf16_t)(raw[e] & 0xffffu); VT[(e8 + 2 * e + 1) * 136 + j] = (bf16_t)(raw[e] >> 16); } }
        const size_t sbase = (((size_t)(u >> 3) * 8 + h)) * 8192;
#pragma unroll
        for (int q = 0; q < 4; ++q) { const int id = tid + NT * q, e = id >> 4, d4 = (id & 15) * 4; st_bf4(SF + e * 72 + d4, *(const f32x4*)(STF + sbase + (size_t)e * 64 + d4)); st_bf4(SB + e * 72 + d4, *(const f32x4*)(STB + sbase + (size_t)e * 64 + d4)); }
        SYNCTHREADS();
        const int i = wv * 16 + fr; const long t = t0 + i;
        {
            f32x4 sc[8];
#pragma unroll
            for (int nt = 0; nt < 8; ++nt) sc[nt] = (f32x4){0.f, 0.f, 0.f, 0.f};
            wave_mma<2, 8>(sc, Qs + wv * 16 * 72, 72, Ks, 72);
#pragma unroll
            for (int nt = 0; nt < 8; ++nt) { const int j0 = 16 * nt + 4 * fq; f32x4 sv;
#pragma unroll
                for (int e = 0; e < 4; ++e) { const int j = j0 + e, dist = i > j ? i - j : j - i; sv[e] = sc[nt][e] * tab[64 + dist]; }
                st_bf4(Ss + i * 136 + j0, sv); }
        }
#ifdef CPU_EMU
        SYNCTHREADS();
#else
        asm volatile("s_waitcnt lgkmcnt(0)" ::: "memory");
#endif
        f32x4 ao[8], tm[8];
#pragma unroll
        for (int nt = 0; nt < 8; ++nt) { ao[nt] = (f32x4){0.f, 0.f, 0.f, 0.f}; tm[nt] = (f32x4){0.f, 0.f, 0.f, 0.f}; }
        wave_mma<4, 8>(ao, Ss + wv * 16 * 136, 136, VT, 136);
        wave_mma<2, 8>(tm, Qs + wv * 16 * 72, 72, SF, 72);
        { const float qf = tab[64 + i + 1];
#pragma unroll
            for (int nt = 0; nt < 8; ++nt) { ao[nt] += tm[nt] * qf; tm[nt] = (f32x4){0.f, 0.f, 0.f, 0.f}; } }
        wave_mma<2, 8>(tm, Qs + wv * 16 * 72, 72, SB, 72);
        { const float qb = tab[64 + 128 - i];
#pragma unroll
            for (int nt = 0; nt < 8; ++nt) ao[nt] += tm[nt] * qb; }
        float sm = 0.f;
#pragma unroll
        for (int nt = 0; nt < 8; ++nt) sm += (ao[nt][0] + ao[nt][1]) + (ao[nt][2] + ao[nt][3]);
        sm += SHFL_XOR(sm, 16); sm += SHFL_XOR(sm, 32);
        const float mu = sm * (1.f / 128.f); float sq = 0.f;
#pragma unroll
        for (int nt = 0; nt < 8; ++nt) { ao[nt] -= mu; sq += (ao[nt][0] * ao[nt][0] + ao[nt][1] * ao[nt][1]) + (ao[nt][2] * ao[nt][2] + ao[nt][3] * ao[nt][3]); }
        sq += SHFL_XOR(sq, 16); sq += SHFL_XOR(sq, 32);
        const float rs = 1.f / sqrtf(sq * (1.f / 128.f) + EPS);
#pragma unroll
        for (int nt = 0; nt < 8; ++nt) { const int e0 = 16 * nt + 4 * fq; f32x4 gv = ld_bf4(P + (size_t)t * PW + C_RG + h * 128 + e0);
#pragma unroll
            for (int e = 0; e < 4; ++e) gv[e] = siluf_(gv[e]) * (ao[nt][e] * rs);
            st_bf4(Y + (size_t)t * 4 * W + 1 * W + h * 128 + e0, gv); }
        SYNCTHREADS();
    }
}
__device__ __forceinline__ void ph_sgu_norm(const Ctx& c, int l) {
    const bf16_t* P = WSH(O_P); float* ST = WSF(O_VN);
    const int lane = threadIdx.x & 63, gw = blockIdx.x * (NT / 64) + (threadIdx.x >> 6), ngw = gridDim.x * (NT / 64);
    for (int t = gw; t < T; t += ngw) {
        f32x4 v[4]; float sm = 0.f;
#pragma unroll
        for (int j = 0; j < 4; ++j) { v[j] = ld_bf4(P + (size_t)t * PW + C_SV + (j * 64 + lane) * 4);
#pragma unroll
            for (int q = 0; q < 4; ++q) { v[j][q] = geluf_(v[j][q]); sm += v[j][q]; } }
        const float mu = wave_sum(sm) * (1.f / W); float sq = 0.f;
#pragma unroll
        for (int j = 0; j < 4; ++j)
#pragma unroll
            for (int q = 0; q < 4; ++q) { const float dd = v[j][q] - mu; sq += dd * dd; }
        const float rs = 1.f / sqrtf(wave_sum(sq) * (1.f / W) + EPS);
        if (lane == 0) { ST[(size_t)t * 2] = mu; ST[(size_t)t * 2 + 1] = rs; }
    }
}
__device__ __forceinline__ void ph_sgu_mix(const Ctx& c, int l, float* ldsf) {
    const bf16_t* P = WSH(O_P); const float* ST = WSF(O_VN); bf16_t* Y = WSH(O_YS); const float* ng = c.in[15] + (size_t)l * W;
    bf16_t* As = (bf16_t*)ldsf; bf16_t* Bs = As + 128 * 136; const int tid = threadIdx.x, wv = tid >> 6, lane = tid & 63, fr = lane & 15, fq = lane >> 4;
    for (int u = blockIdx.x; u < (T / 128) * 8; u += gridDim.x) {
        const int g = u & 7; const long t0 = (long)(u >> 3) * 128;
        const float* ws = c.in[16] + ((size_t)l * 8 + g) * 128 * 128; const float* bs = c.in[17] + ((size_t)l * 8 + g) * 128;
#pragma unroll
        for (int q = 0; q < 8; ++q) { const int id = tid + NT * q, i = id >> 5, j4 = (id & 31) * 4; st_bf4(As + i * 136 + j4, *(const f32x4*)(ws + i * 128 + j4)); }
#pragma unroll
        for (int q = 0; q < 4; ++q) { const int id = tid + NT * q, j = id & 127, d8 = (id >> 7) * 8; const float mu = ST[(size_t)(t0 + j) * 2], rs = ST[(size_t)(t0 + j) * 2 + 1];
            const u32x4 raw = *(const u32x4*)(P + (size_t)(t0 + j) * PW + C_SV + g * 128 + d8);
#pragma unroll
            for (int e = 0; e < 4; ++e) { const float v0 = (geluf_(bflo(raw[e])) - mu) * rs * ng[g * 128 + d8 + 2 * e], v1 = (geluf_(bfhi(raw[e])) - mu) * rs * ng[g * 128 + d8 + 2 * e + 1];
                Bs[(d8 + 2 * e) * 136 + j] = (bf16_t)f2bf(v0); Bs[(d8 + 2 * e + 1) * 136 + j] = (bf16_t)f2bf(v1); } }
        SYNCTHREADS();
        f32x4 acc[8];
#pragma unroll
        for (int nt = 0; nt < 8; ++nt) acc[nt] = (f32x4){0.f, 0.f, 0.f, 0.f};
        wave_mma<4, 8>(acc, As + wv * 16 * 136, 136, Bs, 136);
        const int i = wv * 16 + fr; const long t = t0 + i; const float bsi = bs[i];
#pragma unroll
        for (int nt = 0; nt < 8; ++nt) { const int d = 16 * nt + 4 * fq; f32x4 uu = ld_bf4(P + (size_t)t * PW + C_SU + g * 128 + d);
#pragma unroll
            for (int e = 0; e < 4; ++e) uu[e] = geluf_(uu[e]) * (acc[nt][e] + bsi);
            st_bf4(Y + (size_t)t * 4 * W + 2 * W + g * 128 + d, uu); }
        SYNCTHREADS();
    }
}
__device__ __forceinline__ void ph_rw_shift(const Ctx& c, int l) {
    const bf16_t* P = WSH(O_P); const float* mup = c.in[18] + (size_t)l * RF; const float* mun = c.in[19] + (size_t)l * RF; bf16_t* FS = WSH(O_FS);
    const int lane = threadIdx.x & 63, gw = blockIdx.x * (NT / 64) + (threadIdx.x >> 6), ngw = gridDim.x * (NT / 64);
    for (int t = gw; t < T; t += ngw) {
        const int sI = t % S; const bf16_t* pc = P + (size_t)t * PW + C_RW;
#pragma unroll 2
        for (int j = lane * 4; j < RF; j += 256) {
            const f32x4 f = ld_bf4(pc + j), z4 = (f32x4){0.f, 0.f, 0.f, 0.f}; const f32x4 pv = sI > 0 ? ld_bf4(pc - PW + j) : z4, nv = sI < S - 1 ? ld_bf4(pc + PW + j) : z4;
            f32x4 v = f + *(const f32x4*)(mup + j) * (pv - f) + *(const f32x4*)(mun + j) * (nv - f);
            if (j >= 3072 && j < 3200) {
#pragma unroll
                for (int e = 0; e < 4; ++e) v[e] = tanhf_(v[e]); }
            else if (j >= 3328) {
#pragma unroll
                for (int e = 0; e < 4; ++e) v[e] = sigmoidf_(v[e]); }
            st_bf4(FS + (size_t)t * RF + j, v);
        }
    }
}
__device__ __forceinline__ void ph_rw_lora(const Ctx& c, int l, float* ldsf) {
    const bf16_t* FS = WSH(O_FS); const float* w0 = c.in[20] + (size_t)l * 2 * W; const float* a0 = c.in[22] + (size_t)l * 2 * W;
    const bf16_t* WUT = WSH(O_WUT); const bf16_t* WAT = WSH(O_WAT); const bf16_t* WGT = WSH(O_WGT);
    bf16_t* DEC = WSH(O_DEC); bf16_t* AA = WSH(O_AA); bf16_t* GG = WSH(O_GG);
    bf16_t* F = (bf16_t*)ldsf; bf16_t* B1 = F + 128 * 136; bf16_t* B2 = B1 + 128 * 136; const int tid = threadIdx.x, wv = tid >> 6, lane = tid & 63, fr = lane & 15, fq = lane >> 4;
    for (int u = blockIdx.x; u < (T / 128) * 8; u += gridDim.x) {
        const int wc0 = (u & 7) * 128; const long t0 = (long)(u >> 3) * 128;
        for (int rd = 0; rd < 3; ++rd) {
#pragma unroll
            for (int q = 0; q < 8; ++q) { const int id = tid + NT * q, r = id >> 5, c4 = (id & 31) * 4;
                const int col = rd < 2 ? (c4 < 64 ? 3072 + rd * 64 + c4 : 3200 + rd * 64 + (c4 - 64)) : 3328 + c4;
                *(unsigned long long*)(F + r * 136 + c4) = *(const unsigned long long*)(FS + (size_t)(t0 + r) * RF + col); }
            if (rd < 2) {
#pragma unroll
                for (int q = 0; q < 2; ++q) { const int id = tid + NT * q, w = id >> 3, r8 = (id & 7) * 8;
                    *(u32x4*)(B1 + w * 72 + r8) = *(const u32x4*)(WUT + ((size_t)rd * W + wc0 + w) * 64 + r8); *(u32x4*)(B2 + w * 72 + r8) = *(const u32x4*)(WAT + ((size_t)rd * W + wc0 + w) * 64 + r8); }
            } else {
#pragma unroll
                for (int q = 0; q < 4; ++q) { const int id = tid + NT * q, w = id >> 4, r8 = (id & 15) * 8; *(u32x4*)(B1 + w * 136 + r8) = *(const u32x4*)(WGT + ((size_t)wc0 + w) * 128 + r8); }
            }
            SYNCTHREADS();
            f32x4 a1[8], a2[8];
#pragma unroll
            for (int nt = 0; nt < 8; ++nt) { a1[nt] = (f32x4){0.f, 0.f, 0.f, 0.f}; a2[nt] = (f32x4){0.f, 0.f, 0.f, 0.f}; }
            const long t = t0 + wv * 16 + fr;
            if (rd < 2) {
                wave_mma<2, 8>(a1, F + wv * 16 * 136, 136, B1, 72);
                wave_mma<2, 8>(a2, F + wv * 16 * 136 + 64, 136, B2, 72);
#pragma unroll
                for (int nt = 0; nt < 8; ++nt) { const int ch = wc0 + 16 * nt + 4 * fq; const f32x4 w0v = *(const f32x4*)(w0 + rd * W + ch), a0v = *(const f32x4*)(a0 + rd * W + ch); f32x4 dv, av;
#pragma unroll
                    for (int e = 0; e < 4; ++e) { dv[e] = fexp_(-DECAY_SCALE * sigmoidf_(a1[nt][e] + w0v[e])); av[e] = sigmoidf_(a2[nt][e] + a0v[e]); }
                    st_bf4(DEC + ((size_t)rd * T + t) * W + ch, dv); st_bf4(AA + ((size_t)rd * T + t) * W + ch, av); }
            } else {
                wave_mma<4, 8>(a1, F + wv * 16 * 136, 136, B1, 136);
#pragma unroll
                for (int nt = 0; nt < 8; ++nt) st_bf4(GG + (size_t)t * W + wc0 + 16 * nt + 4 * fq, a1[nt]);
            }
            SYNCTHREADS();
        }
    }
}
#ifdef CPU_EMU
__device__ __forceinline__ float red16_(float x) { x += SHFL_XOR(x, 1); x += SHFL_XOR(x, 2); x += SHFL_XOR(x, 4); x += SHFL_XOR(x, 8); return x; }
#define LDS_BARRIER() emu_syncthreads()
#else
__device__ __forceinline__ float red16_(float x) {
    x += __builtin_bit_cast(float, __builtin_amdgcn_update_dpp(0, __builtin_bit_cast(int, x), 0xB1, 0xF, 0xF, true));
    x += __builtin_bit_cast(float, __builtin_amdgcn_update_dpp(0, __builtin_bit_cast(int, x), 0x4E, 0xF, 0xF, true));
    x += __builtin_bit_cast(float, __builtin_amdgcn_update_dpp(0, __builtin_bit_cast(int, x), 0x141, 0xF, 0xF, true));
    x += __builtin_bit_cast(float, __builtin_amdgcn_update_dpp(0, __builtin_bit_cast(int, x), 0x140, 0xF, 0xF, true));
    return x;
}
#define LDS_BARRIER() do { asm volatile("s_waitcnt lgkmcnt(0)" ::: "memory"); __builtin_amdgcn_s_barrier(); asm volatile("" ::: "memory"); } while (0)
#endif
#define RC_M(k) (lm + (k) * 4608)
__device__ __forceinline__ void ph_rw_chunk(const Ctx& c, int l, float* ldsf) {
    const bf16_t* FS = WSH(O_FS); const bf16_t* DEC = WSH(O_DEC); const bf16_t* AA = WSH(O_AA); float* BON = WSF(O_BON);
    const float* kkw = c.in[25] + (size_t)l * W; const float* kaw = c.in[26] + (size_t)l * W; const float* rk = c.in[27] + (size_t)l * W;
    bf16_t* PST = WSH(O_PST); bf16_t* PYT = WSH(O_PYT); bf16_t* SVB = WSH(O_SVB); bf16_t* YVB = WSH(O_YVB);
    bf16_t* lm = (bf16_t*)ldsf; float* gam = (float*)RC_M(7); float* segp = (float*)RC_M(13); float* gl = segp + 512;
    const int tid = threadIdx.x, wv = tid >> 6, lane = tid & 63, fr = lane & 15, fq = lane >> 4, rt = wv & 3, hf = wv >> 2;
    const int m0 = 16 * rt + fr;
    float wv8[8], kv8[8], rv8[8], vv8[8], aa8[8];
#define RC_LOAD(uu) do { const int chain_ = (uu) / NRC, ck_ = (uu) % NRC, h_ = chain_ & 15, b_ = (chain_ >> 4) & 1, z_ = chain_ >> 5; \
        const long tb_ = (long)b_ * S + (z_ ? S - 1 - ck_ * RCK : ck_ * RCK); const int dirn_ = z_ ? -1 : 1; \
        const bf16_t* decp_ = DEC + ((size_t)z_ * T) * W + h_ * 64; const bf16_t* aap_ = AA + ((size_t)z_ * T) * W + h_ * 64; const int ch_ = h_ * 64 + lane; \
        _Pragma("unroll") for (int q = 0; q < 8; ++q) wv8[q] = bf2f(decp_[(size_t)(tb_ + dirn_ * ((tid >> 6) * 8 + q)) * W + (tid & 63)]); \
        _Pragma("unroll") for (int q = 0; q < 8; ++q) { const long t_ = tb_ + dirn_ * (wv + 8 * q); const bf16_t* f_ = FS + (size_t)t_ * RF; kv8[q] = bf2f(f_[1024 + ch_]); rv8[q] = bf2f(f_[ch_]); vv8[q] = bf2f(f_[2048 + ch_]); aa8[q] = bf2f(aap_[(size_t)t_ * W + lane]); } } while (0)
    if ((int)blockIdx.x < 64 * NRC) RC_LOAD((int)blockIdx.x);
    for (int u = blockIdx.x; u < 64 * NRC; u += gridDim.x) {
        const int chain = u / NRC, ck = u % NRC, h = chain & 15, b = (chain >> 4) & 1, z = chain >> 5;
        const long tb = (long)b * S + (z ? S - 1 - ck * RCK : ck * RCK); const int dirn = z ? -1 : 1;
        { const int k = tid & 63, sg = tid >> 6; float p = 1.f;
#pragma unroll
          for (int q = 0; q < 8; ++q) { p *= wv8[q]; gam[(sg * 8 + q) * 64 + k] = p; }
          segp[sg * 64 + k] = p; }
        LDS_BARRIER();
        { const int k = tid & 63, sg = tid >> 6; float pre = 1.f;
          for (int q = 0; q < sg; ++q) pre *= segp[q * 64 + k];
#pragma unroll
          for (int q = 0; q < 8; ++q) gam[(sg * 8 + q) * 64 + k] *= pre;
          if (sg == 7) gl[k] = gam[63 * 64 + k]; }
        LDS_BARRIER();
        { const int k = lane, ch = h * 64 + k; const float kkwv = kkw[ch], kav = kaw[ch], rkv = rk[ch];
#pragma unroll
          for (int q = 0; q < 8; ++q) { const int tt = wv + 8 * q; const long t = tb + dirn * tt;
            const float vk = kv8[q] * kkwv; const float kkn = vk * frsq_(wave_sum(vk * vk) + EPS); const float ktv = kv8[q] * (1.f + (aa8[q] - 1.f) * kav);
            const float bsum = wave_sum(rv8[q] * rkv * ktv); if (lane == 0) BON[((size_t)z * T + t) * 16 + h] = bsum;
            const float g = gam[tt * 64 + k], gp = tt ? gam[(tt - 1) * 64 + k] : 1.f, ig = frcp_(g);
            const bf16_t khv = (bf16_t)f2bf(kkn * gp), bhv = (bf16_t)f2bf(aa8[q] * kkn * ig);
            RC_M(0)[tt * 72 + k] = khv; RC_M(1)[k * 72 + tt] = khv; RC_M(2)[tt * 72 + k] = bhv; RC_M(3)[k * 72 + tt] = bhv;
            RC_M(4)[tt * 72 + k] = (bf16_t)f2bf(ktv * ig); RC_M(5)[tt * 72 + k] = (bf16_t)f2bf(rv8[q] * g); RC_M(6)[k * 72 + tt] = (bf16_t)f2bf(vv8[q]); } }
        if (u + (int)gridDim.x < 64 * NRC) RC_LOAD(u + (int)gridDim.x);
        LDS_BARRIER();
        f32x4 mkr[2], khr[2], rhT[2];
        {
            f32x4 a0[2], a1[2], a2[2], a3[2];
#pragma unroll
            for (int nt = 0; nt < 2; ++nt) { a0[nt] = (f32x4){0.f, 0.f, 0.f, 0.f}; a1[nt] = a0[nt]; a2[nt] = a0[nt]; a3[nt] = a0[nt]; }
            wave_mma<2, 2>(a0, RC_M(2) + rt * 16 * 72, 72, RC_M(0) + hf * 32 * 72, 72);
            wave_mma<2, 2>(a1, RC_M(4) + rt * 16 * 72, 72, RC_M(0) + hf * 32 * 72, 72);
            wave_mma<2, 2>(a2, RC_M(2) + rt * 16 * 72, 72, RC_M(5) + hf * 32 * 72, 72);
            wave_mma<2, 2>(a3, RC_M(4) + rt * 16 * 72, 72, RC_M(5) + hf * 32 * 72, 72);
#pragma unroll
            for (int nt = 0; nt < 2; ++nt) { const int n0 = 32 * hf + 16 * nt + 4 * fq; f32x4 nn, ti, mk;
#pragma unroll
                for (int r = 0; r < 4; ++r) { const int n = n0 + r; const bool lt = m0 < n, le = m0 <= n;
                    nn[r] = lt ? -a0[nt][r] : 0.f; ti[r] = nn[r] + (m0 == n ? 1.f : 0.f); mk[r] = lt ? a1[nt][r] : 0.f; mkr[nt][r] = le ? a3[nt][r] : 0.f;
                    RC_M(12)[n * 72 + m0] = (bf16_t)f2bf(le ? a2[nt][r] : 0.f);
                    RC_M(8)[n * 72 + m0] = (bf16_t)f2bf(nn[r]);
                    khr[nt][r] = bf2f(RC_M(4)[m0 * 72 + n]); rhT[nt][r] = bf2f(RC_M(5)[n * 72 + m0]); }
                st_bf4(RC_M(7) + m0 * 72 + n0, nn); st_bf4(RC_M(9) + m0 * 72 + n0, ti); st_bf4(RC_M(11) + m0 * 72 + n0, mk); }
        }
        LDS_BARRIER();
        f32x4 tiv[2];
#pragma unroll
        for (int nt = 0; nt < 2; ++nt) tiv[nt] = ld_bf4(RC_M(9) + m0 * 72 + 32 * hf + 16 * nt + 4 * fq);
#pragma unroll 1
        for (int it = 0; it < 5; ++it) {
            bf16_t* pw = (it & 1) ? RC_M(0) : RC_M(7); bf16_t* pwT = (it & 1) ? RC_M(2) : RC_M(8); bf16_t* pw2 = (it & 1) ? RC_M(7) : RC_M(0); bf16_t* pw2T = (it & 1) ? RC_M(8) : RC_M(2);
            bf16_t* tcur = (it & 1) ? RC_M(4) : RC_M(9); bf16_t* tnxt = (it & 1) ? RC_M(9) : RC_M(4);
            f32x4 sq[2];
#pragma unroll
            for (int nt = 0; nt < 2; ++nt) sq[nt] = (f32x4){0.f, 0.f, 0.f, 0.f};
            wave_mma<2, 2>(sq, pw + rt * 16 * 72, 72, pwT + hf * 32 * 72, 72);
#pragma unroll
            for (int nt = 0; nt < 2; ++nt) { const int n0 = 32 * hf + 16 * nt + 4 * fq; st_bf4(pw2 + m0 * 72 + n0, sq[nt]);
#pragma unroll
                for (int r = 0; r < 4; ++r) pw2T[(n0 + r) * 72 + m0] = (bf16_t)f2bf(sq[nt][r]); }
            LDS_BARRIER();
            f32x4 up[2];
#pragma unroll
            for (int nt = 0; nt < 2; ++nt) up[nt] = (f32x4){0.f, 0.f, 0.f, 0.f};
            wave_mma<2, 2>(up, tcur + rt * 16 * 72, 72, pw2T + hf * 32 * 72, 72);
#pragma unroll
            for (int nt = 0; nt < 2; ++nt) { const int n0 = 32 * hf + 16 * nt + 4 * fq; tiv[nt] += up[nt]; st_bf4(tnxt + m0 * 72 + n0, tiv[nt]);
                if (it == 4) {
#pragma unroll
                    for (int r = 0; r < 4; ++r) RC_M(10)[(n0 + r) * 72 + m0] = (bf16_t)f2bf(tiv[nt][r]); } }
            LDS_BARRIER();
        }
        {
            f32x4 w1[2], w2[2];
#pragma unroll
            for (int nt = 0; nt < 2; ++nt) { w1[nt] = (f32x4){0.f, 0.f, 0.f, 0.f}; w2[nt] = w1[nt]; }
            wave_mma<2, 2>(w1, RC_M(1) + rt * 16 * 72, 72, RC_M(10) + hf * 32 * 72, 72);
            wave_mma<2, 2>(w2, RC_M(11) + rt * 16 * 72, 72, RC_M(10) + hf * 32 * 72, 72);
#pragma unroll
            for (int nt = 0; nt < 2; ++nt) { const int n0 = 32 * hf + 16 * nt + 4 * fq; st_bf4(RC_M(7) + m0 * 72 + n0, w1[nt]); st_bf4(RC_M(8) + m0 * 72 + n0, w2[nt]); }
        }
        LDS_BARRIER();
        {
            f32x4 py[2], qy[2], ps[2], qs[2];
#pragma unroll
            for (int nt = 0; nt < 2; ++nt) { py[nt] = (f32x4){0.f, 0.f, 0.f, 0.f}; qy[nt] = py[nt]; ps[nt] = py[nt]; qs[nt] = py[nt]; }
            wave_mma<2, 2>(py, RC_M(7) + rt * 16 * 72, 72, RC_M(12) + hf * 32 * 72, 72);
            wave_mma<2, 2>(qy, RC_M(8) + rt * 16 * 72, 72, RC_M(12) + hf * 32 * 72, 72);
            wave_mma<2, 2>(ps, RC_M(7) + rt * 16 * 72, 72, RC_M(3) + hf * 32 * 72, 72);
            wave_mma<2, 2>(qs, RC_M(8) + rt * 16 * 72, 72, RC_M(3) + hf * 32 * 72, 72);
#pragma unroll
            for (int nt = 0; nt < 2; ++nt) { const int n0 = 32 * hf + 16 * nt + 4 * fq;
#pragma unroll
                for (int r = 0; r < 4; ++r) { const int n = n0 + r; const float gln = gl[n];
                    RC_M(0)[n * 72 + m0] = (bf16_t)f2bf(rhT[nt][r] - py[nt][r]); RC_M(2)[n * 72 + m0] = (bf16_t)f2bf(mkr[nt][r] - qy[nt][r]);
                    RC_M(4)[n * 72 + m0] = (bf16_t)f2bf(((m0 == n ? 1.f : 0.f) - ps[nt][r]) * gln); RC_M(5)[n * 72 + m0] = (bf16_t)f2bf((khr[nt][r] - qs[nt][r]) * gln); } }
        }
        LDS_BARRIER();
        {
            f32x4 yv[2], sv[2];
#pragma unroll
            for (int nt = 0; nt < 2; ++nt) { yv[nt] = (f32x4){0.f, 0.f, 0.f, 0.f}; sv[nt] = yv[nt]; }
            wave_mma<2, 2>(yv, RC_M(6) + rt * 16 * 72, 72, RC_M(2) + hf * 32 * 72, 72);
            wave_mma<2, 2>(sv, RC_M(6) + rt * 16 * 72, 72, RC_M(5) + hf * 32 * 72, 72);
#pragma unroll
            for (int nt = 0; nt < 2; ++nt) { const int n0 = 32 * hf + 16 * nt + 4 * fq; st_bf4(YVB + (size_t)u * 4096 + m0 * 64 + n0, yv[nt]); st_bf4(SVB + (size_t)u * 4096 + m0 * 64 + n0, sv[nt]); }
            { const int rr = tid >> 3, c8 = (tid & 7) * 8; *(u32x4*)(PYT + (size_t)u * 4096 + rr * 64 + c8) = *(const u32x4*)(RC_M(0) + rr * 72 + c8); *(u32x4*)(PST + (size_t)u * 4096 + rr * 64 + c8) = *(const u32x4*)(RC_M(4) + rr * 72 + c8); }
        }
        LDS_BARRIER();
    }
}
#undef RC_M
#undef RC_LOAD
__device__ __forceinline__ void ph_rw_seq(const Ctx& c, float* ldsf) {
    const bf16_t* PST = WSH(O_PST); const bf16_t* PYT = WSH(O_PYT); const bf16_t* SVB = WSH(O_SVB); const bf16_t* YVB = WSH(O_YVB); bf16_t* YY = WSH(O_YY);
    bf16_t* Sb = (bf16_t*)ldsf;
    bf16_t* Pm = Sb + 2 * 16 * 72;
    const int tid = threadIdx.x, wv = tid >> 6, lane = tid & 63, fr = lane & 15, fq = lane >> 4, isY = wv >> 2, nt0 = wv & 3;
    for (int u = blockIdx.x; u < 256; u += gridDim.x) {
        const int x = u & 7, jq = u >> 3, chain = x * 8 + (jq >> 2), qt = jq & 3, h = chain & 15, b = (chain >> 4) & 1, z = chain >> 5;
        const size_t ub = (size_t)chain * NRC;
        const int rr = tid >> 3, c8 = (tid & 7) * 8;
        constexpr int PD = NRC >= 8 ? 8 : 4;
        for (int i = tid; i < 2 * 16 * 72 / 2; i += NT) ((unsigned*)Sb)[i] = 0u;
        const int row = 16 * qt + fr, n0 = 16 * nt0 + 4 * fq; const bf16_t* addp = (isY ? YVB : SVB) + ub * 4096 + row * 64 + n0;
        const bf16_t* psp = PST + ub * 4096 + rr * 64 + c8; const bf16_t* pyp = PYT + ub * 4096 + rr * 64 + c8;
        u32x4 gps[PD], gpy[PD]; f32x4 add[PD];
#pragma unroll
        for (int j = 0; j < PD; ++j) { gps[j] = *(const u32x4*)(psp + (size_t)j * 4096); gpy[j] = *(const u32x4*)(pyp + (size_t)j * 4096); add[j] = ld_bf4(addp + (size_t)j * 4096); }
        *(u32x4*)(Pm + (0 * 2 + 0) * 4608 + rr * 72 + c8) = gps[0]; *(u32x4*)(Pm + (0 * 2 + 1) * 4608 + rr * 72 + c8) = gpy[0];
        if (PD < NRC) { gps[0] = *(const u32x4*)(psp + (size_t)PD * 4096); gpy[0] = *(const u32x4*)(pyp + (size_t)PD * 4096); }
        SYNCTHREADS();
        for (int ck0 = 0; ck0 < NRC; ck0 += PD) {
#pragma unroll
            for (int j = 0; j < PD; ++j) {
                const int ck = ck0 + j, cur = j & 1, nxt = cur ^ 1;
                f32x4 acc[1]; acc[0] = (f32x4){0.f, 0.f, 0.f, 0.f};
                wave_mma<2, 1>(acc, Sb + cur * 16 * 72, 72, Pm + (cur * 2 + isY) * 4608 + nt0 * 16 * 72, 72);
                acc[0] += add[j];
                if (ck + PD < NRC) add[j] = ld_bf4(addp + (size_t)(ck + PD) * 4096);
                if (isY) {
#pragma unroll
                    for (int r = 0; r < 4; ++r) { const int step = ck * RCK + n0 + r, sidx = z ? S - 1 - step : step; YY[((size_t)z * T + (size_t)b * S + sidx) * W + h * 64 + row] = (bf16_t)f2bf(acc[0][r]); }
                } else st_bf4(Sb + nxt * 16 * 72 + fr * 72 + n0, acc[0]);
                const int jn = (j + 1) % PD;
                if (ck + 1 < NRC) { *(u32x4*)(Pm + (nxt * 2 + 0) * 4608 + rr * 72 + c8) = gps[jn]; *(u32x4*)(Pm + (nxt * 2 + 1) * 4608 + rr * 72 + c8) = gpy[jn]; }
                if (ck + 1 + PD < NRC) { gps[jn] = *(const u32x4*)(psp + (size_t)(ck + 1 + PD) * 4096); gpy[jn] = *(const u32x4*)(pyp + (size_t)(ck + 1 + PD) * 4096); }
                LDS_BARRIER();
            }
        }
    }
}
__device__ __forceinline__ void ph_rw_out(const Ctx& c) {
    const bf16_t* FS = WSH(O_FS); const bf16_t* YY = WSH(O_YY); const float* BON = WSF(O_BON); const bf16_t* GG = WSH(O_GG); bf16_t* Y = WSH(O_YS);
    const int lane = threadIdx.x & 63, gw = blockIdx.x * (NT / 64) + (threadIdx.x >> 6), ngw = gridDim.x * (NT / 64);
    for (int i = gw; i < T * 4; i += ngw) {
        const int h0 = (i & 3) * 4; const long t = i >> 2; float y0[4], y1[4], gv[4], vv[4], bs[4];
#pragma unroll
        for (int q = 0; q < 4; ++q) { const int ch = (h0 + q) * 64 + lane; y0[q] = bf2f(YY[(size_t)t * W + ch]); y1[q] = bf2f(YY[((size_t)T + t) * W + ch]); gv[q] = bf2f(GG[(size_t)t * W + ch]); vv[q] = bf2f(FS[(size_t)t * RF + 2048 + ch]);
            bs[q] = BON[(size_t)t * 16 + h0 + q] + BON[((size_t)T + t) * 16 + h0 + q]; }
#pragma unroll
        for (int q = 0; q < 4; ++q) { const int ch = (h0 + q) * 64 + lane;
            const float m0 = wave_sum(y0[q]) * (1.f / 64.f), m1 = wave_sum(y1[q]) * (1.f / 64.f); const float d0 = y0[q] - m0, d1 = y1[q] - m1;
            const float r0 = 1.f / sqrtf(wave_sum(d0 * d0) * (1.f / 64.f) + EPS), r1 = 1.f / sqrtf(wave_sum(d1 * d1) * (1.f / 64.f) + EPS);
            Y[(size_t)t * 4 * W + 3 * W + ch] = (bf16_t)f2bf((d0 * r0 + d1 * r1 + bs[q] * vv[q]) * gv[q]); }
    }
}
__device__ __forceinline__ void ph_router(const Ctx& c, int l, float* ldsf, const float* X, const float* gN, const float* shN, const float* scN) {
    const float* RS = WSF(O_HF); const bf16_t* WH = WSH(O_WRH); const bf16_t* WL = WSH(O_WRL); const float* bg = c.in[31] + (size_t)l * 4; const float* be = c.in[33] + (size_t)l * 32;
    int* EID = WSI(O_EID); float* EWT = WSF(O_EWT); int* cnt = CTLW(c) + CW_CNT + l * 64;
    const int tid = threadIdx.x, wv = tid >> 6, lane = tid & 63, fr = lane & 15, fq = lane >> 4, rt = wv & 1, kq = wv >> 1;
    float* part = ldsf;
    for (int u = blockIdx.x; u < T / 32; u += gridDim.x) {
        const long t0 = (long)u * 32; f32x4 acc[3];
#pragma unroll
        for (int nt = 0; nt < 3; ++nt) acc[nt] = (f32x4){0.f, 0.f, 0.f, 0.f};
#ifdef CPU_EMU
        for (int nt = 0; nt < 3; ++nt) for (int r = 0; r < 4; ++r) { const int n = 16 * nt + 4 * fq + r; float sacc = 0.f;
            for (int k = kq * 512; k < kq * 512 + 512; ++k) { const long tr = t0 + 16 * rt + fr; const int bb = (int)(tr / S); const float hv = X[(size_t)tr * D + k] * RS[tr] * gN[k] * (1.f + scN[bb * D6 + k]) + shN[bb * D6 + k]; const float hh = bf2f((bf16_t)f2bf(hv)), hl = bf2f((bf16_t)f2bf(hv - hh));
                const float wh = bf2f(WH[(size_t)n * D + k]), wl = bf2f(WL[(size_t)n * D + k]); sacc += hh * wh + hl * wh + hh * wl; }
            acc[nt][r] = sacc; }
#else
        const long tr = t0 + 16 * rt + fr; const int bb = (int)(tr / S); const float rsv = RS[tr]; const int kb = kq * 512 + fq * 8;
        const float* hp = X + (size_t)tr * D + kb; const float* gp_ = gN + kb; const float* scp = scN + bb * D6 + kb; const float* shp = shN + bb * D6 + kb;
#pragma unroll 4
        for (int ks = 0; ks < 16; ++ks) {
            const f32x4 h0 = *(const f32x4*)(hp + ks * 32) * rsv * *(const f32x4*)(gp_ + ks * 32) * (*(const f32x4*)(scp + ks * 32) + 1.f) + *(const f32x4*)(shp + ks * 32);
            const f32x4 h1 = *(const f32x4*)(hp + ks * 32 + 4) * rsv * *(const f32x4*)(gp_ + ks * 32 + 4) * (*(const f32x4*)(scp + ks * 32 + 4) + 1.f) + *(const f32x4*)(shp + ks * 32 + 4); bf16x8 ah, al;
#pragma unroll
            for (int e = 0; e < 4; ++e) { const unsigned b0 = f2bf(h0[e]), b1 = f2bf(h1[e]); ah[e] = (short)b0; ah[4 + e] = (short)b1; al[e] = (short)f2bf(h0[e] - u2f_(b0 << 16)); al[4 + e] = (short)f2bf(h1[e] - u2f_(b1 << 16)); }
#pragma unroll
            for (int nt = 0; nt < 3; ++nt) { const size_t wo = (size_t)(16 * nt + fr) * D + kq * 512 + ks * 32 + fq * 8; const bf16x8 bh = *(const bf16x8*)(WH + wo), bl = *(const bf16x8*)(WL + wo);
                acc[nt] = __builtin_amdgcn_mfma_f32_16x16x32_bf16(bh, ah, acc[nt], 0, 0, 0); acc[nt] = __builtin_amdgcn_mfma_f32_16x16x32_bf16(bh, al, acc[nt], 0, 0, 0); acc[nt] = __builtin_amdgcn_mfma_f32_16x16x32_bf16(bl, ah, acc[nt], 0, 0, 0); }
        }
#endif
#pragma unroll
        for (int nt = 0; nt < 3; ++nt) *(f32x4*)(part + (kq * 32 + 16 * rt + fr) * 48 + 16 * nt + 4 * fq) = acc[nt];
        SYNCTHREADS();
        if (tid < 32) { const long t = t0 + tid; float lg[36];
#pragma unroll
            for (int q = 0; q < 36; ++q) lg[q] = (part[(0 * 32 + tid) * 48 + q] + part[(1 * 32 + tid) * 48 + q]) + (part[(2 * 32 + tid) * 48 + q] + part[(3 * 32 + tid) * 48 + q]) + (q < 4 ? bg[q < 4 ? q : 0] : be[q >= 4 ? q - 4 : 0]);
            int gi = 0; float m = lg[0];
#pragma unroll
            for (int q = 1; q < 4; ++q) if (lg[q] > m) { m = lg[q]; gi = q; }
            float den = 0.f;
#pragma unroll
            for (int q = 0; q < 4; ++q) den += expf(lg[q] - m);
            const float gp = 1.f / den; float el[8];
#pragma unroll
            for (int q = 0; q < 8; ++q) el[q] = gi == 0 ? lg[4 + q] : gi == 1 ? lg[12 + q] : gi == 2 ? lg[20 + q] : lg[28 + q];
            int i1 = 0; float m1 = el[0];
#pragma unroll
            for (int q = 1; q < 8; ++q) if (el[q] > m1) { m1 = el[q]; i1 = q; }
            int i2 = -1; float m2 = 0.f;
#pragma unroll
            for (int q = 0; q < 8; ++q) if (q != i1 && (i2 < 0 || el[q] > m2)) { m2 = el[q]; i2 = q; }
            const float p2 = expf(m2 - m1);
            EID[t * 2] = gi * 8 + i1; EID[t * 2 + 1] = gi * 8 + i2; EWT[t * 2] = gp / (1.f + p2); EWT[t * 2 + 1] = gp * p2 / (1.f + p2);
            atomic_add_i(cnt + gi * 8 + i1, 1); atomic_add_i(cnt + gi * 8 + i2, 1);
        }
        SYNCTHREADS();
    }
}
__device__ __forceinline__ void ph_moe_assign(const Ctx& c, int l, float* ldsf) {
    const int* cnt = CTLW(c) + CW_CNT + l * 64; int* plan = CTLW(c) + CW_PLAN + l * 256; const int* EID = WSI(O_EID); int* fill = CTLW(c) + CW_FILL + l * 64; int* DEST = WSI(O_DEST);
    int* pstart = (int*)ldsf;
    if (threadIdx.x == 0) { int ps = 0, nb = 0; const bool pub = blockIdx.x == 0;
        for (int e = 0; e < NE; ++e) { pstart[e] = ps; if (pub) plan[e] = ps; const int nblk = (cnt[e] + 255) / 256; if (pub) for (int q = 0; q < nblk; ++q) plan[64 + nb + q] = e; nb += nblk; ps += nblk * 256; }
        if (pub) { plan[32] = ps; plan[40] = nb; } }
    SYNCTHREADS();
    for (long i = GT_; i < (long)T * 2; i += GS_) { const int e = EID[i]; const int pos = atomic_add_i(fill + e, 1); DEST[i] = pstart[e] + pos; }
    SYNCTHREADS();
}
__device__ __forceinline__ void ph_moe_gather(const Ctx& c) {
    const int* DEST = WSI(O_DEST); const u32x4* H = (const u32x4*)WSH(O_H); u32x4* XS = (u32x4*)WSH(O_XS);
    for (long i = GT_; i < (long)T * 2 * (D / 8); i += GS_) { const int q = (int)(i % (D / 8)); const long a = i / (D / 8); XS[(size_t)DEST[a] * (D / 8) + q] = H[(size_t)(a >> 1) * (D / 8) + q]; }
}
#ifndef CPU_EMU
#define XB_TMO      128
#define XB_XCNT(j)  (256  + 64 * (j))
#define XB_XSUB(j)  (1280 + 64 * (j))
#define XB_XGEN(j)  (2304 + 64 * (j))
#define XB_TOP      3328
#define XB_TOPGEN   3392
#define XCD_BAR_WORDS 3456
#define XB_SPIN_CAP (1u << 26)
#define LAS __attribute__((address_space(3)))
__device__ __forceinline__ unsigned xb_ld(unsigned* p)              { return __hip_atomic_load(p, __ATOMIC_RELAXED, __HIP_MEMORY_SCOPE_AGENT); }
__device__ __forceinline__ unsigned xb_add(unsigned* p, unsigned v) { return __hip_atomic_fetch_add(p, v, __ATOMIC_RELAXED, __HIP_MEMORY_SCOPE_AGENT); }
__device__ __forceinline__ unsigned xb_xcc_id() { return (unsigned)__builtin_amdgcn_s_getreg((3 << 11) | 20) & 0xFu; }
#define XB_SPIN(cond, bar) do { unsigned _sp = 0; while (cond) { __builtin_amdgcn_s_sleep(1); \
    if ((++_sp & 255u) == 0u) { if (xb_ld(&(bar)[XB_TMO])) break; if (_sp > XB_SPIN_CAP) { atomicAdd(&(bar)[XB_TMO], 1u); break; } } } } while (0)
struct XcdBarrier { unsigned* bar; unsigned x; volatile LAS unsigned* st; };
__device__ __forceinline__ XcdBarrier xcd_barrier_post(unsigned* bar, volatile LAS unsigned* st) {
    XcdBarrier b; b.bar = bar; b.x = xb_xcc_id(); b.st = st;
    if (threadIdx.x == 0) (void)xb_add(&bar[XB_XCNT(b.x)], 1u);
    return b;
}
__device__ __forceinline__ void xcd_barrier_complete(unsigned* bar, unsigned x, unsigned& nloc, unsigned& nx) {
    const unsigned G = gridDim.x * gridDim.y * gridDim.z;
    unsigned sum, cnt, mine, sp = 0u;
    for (;;) {
        sum = 0u; cnt = 0u; mine = 0u;
#pragma unroll
        for (unsigned j = 0; j < 16; ++j) { const unsigned cc = xb_ld(&bar[XB_XCNT(j)]); sum += cc; cnt += (cc > 0u) ? 1u : 0u; mine = (j == x) ? cc : mine; }
        if (sum == G) break;
        __builtin_amdgcn_s_sleep(1);
        if ((++sp & 255u) == 0u) { if (xb_ld(&bar[XB_TMO])) break; if (sp > XB_SPIN_CAP) { atomicAdd(&bar[XB_TMO], 1u); break; } }
    }
    nloc = mine > 0u ? mine : 1u; nx = cnt > 0u ? cnt : 1u;
}
__device__ __forceinline__ void xcd_barrier(const XcdBarrier& b) {
    asm volatile("s_waitcnt vmcnt(0)" ::: "memory");
    __syncthreads();
    if (threadIdx.x == 0) {
        unsigned* bar = b.bar;
        __builtin_amdgcn_s_waitcnt(0);
        unsigned nloc = b.st[0], nx = b.st[1];
        if (nloc == 0u) { xcd_barrier_complete(bar, b.x, nloc, nx); b.st[0] = nloc; b.st[1] = nx; }
        const unsigned old = xb_add(&bar[XB_XSUB(b.x)], 1u);
        const unsigned gen = old / nloc;
        if (old + 1u == (gen + 1u) * nloc) {
            __builtin_amdgcn_fence(__ATOMIC_RELEASE, "agent");
            asm volatile("s_waitcnt vmcnt(0)" ::: "memory");
            const unsigned og = xb_add(&bar[XB_TOP], 1u);
            const unsigned tg = og / nx;
            if (og + 1u == (tg + 1u) * nx) xb_add(&bar[XB_TOPGEN], 1u);
            else XB_SPIN(xb_ld(&bar[XB_TOPGEN]) == tg, bar);
            __builtin_amdgcn_fence(__ATOMIC_ACQUIRE, "agent");
            xb_add(&bar[XB_XGEN(b.x)], 1u);
            asm volatile("s_waitcnt vmcnt(0)" ::: "memory");
        } else {
            XB_SPIN(xb_ld(&bar[XB_XGEN(b.x)]) == gen, bar);
            __builtin_amdgcn_fence(__ATOMIC_ACQUIRE, "agent");
            asm volatile("s_waitcnt vmcnt(0)" ::: "memory");
        }
    }
    __syncthreads();
}
#endif

constexpr int LDS_BYTES = 147456;

__global__ void __launch_bounds__(NT, 2) fwd(Params p) {
#ifdef CPU_EMU
    unsigned char* lds = g_lds; float* ldsf = (float*)g_lds;
#else
    extern __shared__ __attribute__((aligned(16))) unsigned char lds[];
    float* ldsf = (float*)lds;
    volatile LAS unsigned* misc = (volatile LAS unsigned*)((LAS unsigned char*)lds + LDS_BYTES - 64);
    if (threadIdx.x == 0) { misc[0] = 0u; misc[1] = 0u; }
    __syncthreads();
    XcdBarrier bar = xcd_barrier_post((unsigned*)(p.ws + O_CTL) + CW_BAR, misc);
#endif
    Ctx c; c.in = p.in; c.out = p.out; c.ws = p.ws;
    const int lo = p.ph_lo, hi = p.ph_hi; int ph = 0;
    const int G = (int)gridDim.x, cwg = (int)blockIdx.x;
#ifdef CPU_EMU
#define GRID_BAR()
#else
#define GRID_BAR() xcd_barrier(bar)
#endif
#ifndef REPEAT_MASK
#define REPEAT_MASK 0
#endif
#ifndef TIME_PHASE
#define TIME_PHASE -1
#endif
#if TIME_PHASE >= 0 && !defined(CPU_EMU)
    unsigned long long tp0 = 0, tp1 = 0;
#define TP_BEGIN() do { if (ph == TIME_PHASE) tp0 = __builtin_amdgcn_s_memrealtime(); } while (0)
#define TP_END() do { if (ph == TIME_PHASE) tp1 = __builtin_amdgcn_s_memrealtime(); } while (0)
#else
#define TP_BEGIN()
#define TP_END()
#endif
#define PHASE(...) do { if (lo <= ph && ph < hi) { TP_BEGIN(); __VA_ARGS__; if (ph + 1 < hi) { GRID_BAR(); } TP_END(); } ++ph; } while (0)
#define PHASEG(grp, ...) do { if (lo <= ph && ph < hi) { TP_BEGIN(); if ((REPEAT_MASK >> (grp)) & 1) { __VA_ARGS__; GRID_BAR(); } __VA_ARGS__; if (ph + 1 < hi) { GRID_BAR(); } TP_END(); } ++ph; } while (0)
    PHASE(ph_mod(c, ldsf); ph_rope_table(c); ph_convert(c, 0, ldsf));
#define LAYER_BODY(l) do { const float* mod = WSF(O_MOD); \
        const float* xin = l == 0 ? c.in[0] : WSF(O_X1); float* xmid = WSF(O_X0); float* xout = WSF(O_X1); \
        const float* ml = mod + (size_t)l * NB * D6; \
        PHASEG(0, { pg8::Gemm g{D, D, D}; pg8::StaticOrder so; so.init(T, PW, G, cwg, WSH(O_H), WSH(O_WIN), D, D); pg8::EpiP E{WSH(O_P), (unsigned char*)(c.ws + O_G8)}; pg8::gemm_phase(lds, g, so, E); \
            { const int nun_ = (T / 256) * (PW / 256), rem_ = nun_ % G; if (rem_ != 0 && cwg >= rem_) { SYNCTHREADS(); convert_big(c, l, ldsf, J_ALL - convert_tail_tiles(), J_ALL, cwg - rem_, G - rem_); } } }); \
        PHASE(ph_lru<1>(c, l, ldsf); ph_ret_kv(c, ldsf); ph_sgu_norm(c, l); ph_rw_shift(c, l)); \
        PHASE(ph_lru_scan2(c); ph_ret_state(c); ph_sgu_mix(c, l, ldsf); ph_rw_lora(c, l, ldsf)); \
        PHASE(ph_lru_fin(c, ldsf); ph_ret_out(c, ldsf); ph_rw_chunk(c, l, ldsf)); \
        PHASE(ph_rw_seq(c, ldsf)); \
        PHASE(ph_rw_out(c)); \
        PHASEG(1, { pg8::Gemm g{4 * W, 4 * W, 4 * W}; pg8::StaticOrder so; so.init(T, D, G, cwg, WSH(O_YS), WSH(O_WBR), 4 * W, 4 * W); pg8::EpiMerge E{(const unsigned char*)(c.ws + O_G8), WSH(O_MRG)}; pg8::gemm_phase(lds, g, so, E); }); \
        PHASEG(1, { pg8::Gemm g{D, D, D}; pg8::StaticOrder so; so.init(T, D, G, cwg, WSH(O_MRG), WSH(O_WOUT), D, D); pg8::EpiResid E{xin, ml + 2 * D, xmid}; pg8::gemm_phase(lds, g, so, E); }); \
        PHASEG(6, ph_norm(c, xmid, c.in[4] + (size_t)l * D, ml + 3 * D, ml + 4 * D, WSH(O_H), WSF(O_HF))); \
        PHASE(ph_router(c, l, ldsf, xmid, c.in[4] + (size_t)l * D, ml + 3 * D, ml + 4 * D)); \
        PHASE(ph_moe_assign(c, l, ldsf)); \
        PHASEG(6, ph_moe_gather(c)); \
        const int* plan = CTLW(c) + CW_PLAN + l * 256; \
        PHASEG(2, { pg8::Gemm g{D, D, D}; pg8::MoeOrder mo{G, cwg, 4, plan, (const char*)WSH(O_XS), (const char*)WSH(O_WGU), (size_t)256 * D * 2, (size_t)256 * D * 2, (size_t)1024 * D * 2}; pg8::EpiGU E{WSH(O_ACT)}; pg8::gemm_phase(lds, g, mo, E); \
            if (l == 0) { const int nrest_ = plan[40] * 4 - G; if (nrest_ >= 0 && nrest_ < G && cwg >= nrest_) { SYNCTHREADS(); convert_big(c, 1, ldsf, 0, convert_early_tiles(c), cwg - nrest_, G - nrest_); } } }); \
        PHASEG(2, { pg8::Gemm g{512, 512, 512}; pg8::MoeOrder mo{G, cwg, 8, plan, (const char*)WSH(O_ACT), (const char*)WSH(O_WDN), (size_t)256 * 512 * 2, (size_t)256 * 512 * 2, (size_t)D * 512 * 2}; pg8::EpiBf16 E{WSH(O_YE), D}; pg8::gemm_phase(lds, g, mo, E); }); \
        if (l == 0) PHASE(ph_comb_norm<0>(c, xmid, ml + 5 * D, xout, c.in[3] + (size_t)1 * D, mod + (size_t)1 * NB * D6 + 0 * D, mod + (size_t)1 * NB * D6 + 1 * D, WSH(O_H), nullptr); ph_convert(c, 1, ldsf)); \
        else PHASE(ph_comb_norm<1>(c, xmid, ml + 5 * D, xout, c.in[36], nullptr, nullptr, nullptr, c.out)); \
    } while (0)
    PHASE(ph_norm(c, c.in[0], c.in[3], WSF(O_MOD) + 0 * D, WSF(O_MOD) + 1 * D, WSH(O_H), nullptr));
    LAYER_BODY(0);
    LAYER_BODY(1);
#undef LAYER_BODY
#if TIME_PHASE >= 0 && !defined(CPU_EMU)
    if (blockIdx.x == 0) { const unsigned long long te = __builtin_amdgcn_s_memrealtime(), dl = 8ull * (tp1 - tp0); while (__builtin_amdgcn_s_memrealtime() - te < dl) __builtin_amdgcn_s_sleep(8); }
#endif
#undef PHASE
}
}

#ifndef CPU_EMU
extern "C" void kernel_launch(void* const* d_in, const int* in_sizes, int n_in, void* d_out, int out_size, void* d_ws, size_t ws_size, hipStream_t stream) {
    static int grid = 0;
    if (grid == 0) {
        if (n_in != 37 || out_size != T * D || ws_size < WS_END) { fprintf(stderr, "kernel_launch: unexpected shapes (n_in %d out %d ws %zu need %zu)\n", n_in, out_size, ws_size, (size_t)WS_END); grid = -1; return; }
        int dev = 0, cus = 0, per_cu = 0;
        if (hipGetDevice(&dev) != hipSuccess || hipDeviceGetAttribute(&cus, hipDeviceAttributeMultiprocessorCount, dev) != hipSuccess) { grid = -1; return; }
        if (hipFuncSetAttribute((const void*)fwd, hipFuncAttributeMaxDynamicSharedMemorySize, LDS_BYTES) != hipSuccess) { fprintf(stderr, "kernel_launch: hipFuncSetAttribute failed\n"); grid = -1; return; }
        if (hipOccupancyMaxActiveBlocksPerMultiprocessor(&per_cu, (const void*)fwd, NT, LDS_BYTES) != hipSuccess || per_cu < 1) fprintf(stderr, "kernel_launch: occupancy query says %d\n", per_cu);
        (void)hipGetLastError();
        grid = cus;
    }
    if (grid < 0) return;
    (void)in_sizes;
    (void)hipMemsetAsync((char*)d_ws + O_CTL, 0, CTL_BYTES, stream);
    Params p{};
    for (int i = 0; i < 37; ++i) p.in[i] = (const float*)d_in[i];
    p.out = (float*)d_out; p.ws = (unsigned char*)d_ws;
#if ONE_LAUNCH
    p.ph_lo = 0; p.ph_hi = NPH;
    hipLaunchKernelGGL(fwd, dim3(grid), dim3(NT), LDS_BYTES, stream, p);
#else
    for (int k = 0; k < NPH; ++k) { p.ph_lo = k; p.ph_hi = k + 1; hipLaunchKernelGGL(fwd, dim3(grid), dim3(NT), LDS_BYTES, stream, p); }
#endif
}
#endif
```

```cpp
#ifndef CPU_EMU
#include <hip/hip_runtime.h>
#endif
#include <cstdio>
#include <cstdint>
#include <cmath>
#include <cstring>

#ifndef SEQ
#define SEQ 4096
#endif
#ifndef ONE_LAUNCH
#define ONE_LAUNCH 1
#endif

namespace {
constexpr int D = 2048, NB = 2, S = SEQ, T = NB * S, NL = 2, W = 1024;
constexpr int INW = 18816, RF = 3456, D6 = 6 * D;
constexpr int C_LX = 0, C_LG = 1024, C_RQ = 2048, C_RK = 2560, C_RV = 3072, C_RG = 4096, C_SU = 5120, C_SV = 6144, C_RW = 7168;
constexpr int PW = 18944, C_MLP = 10752;
constexpr int NCH = S / 128;
constexpr int NLC = S / 64;
constexpr int NE = 32, CAP = (T * 2 / 256 + NE) * 256, MAXBLK = CAP / 256;
constexpr float EPS = 1e-6f;
constexpr float DECAY_SCALE = 0.60653065971263342f;
constexpr int NT = 512;
constexpr int NPH_LAYER = 15, NPH = 2 + NL * NPH_LAYER;
typedef unsigned short bf16_t;
#ifdef CPU_EMU
typedef float f32x4 __attribute__((vector_size(16)));
typedef unsigned u32x4 __attribute__((vector_size(16)));
#else
typedef float f32x4 __attribute__((ext_vector_type(4)));
typedef unsigned u32x4 __attribute__((ext_vector_type(4)));
typedef short bf16x8 __attribute__((ext_vector_type(8)));
#endif

constexpr size_t al256(size_t x) { return (x + 255) & ~(size_t)255; }
constexpr size_t SZ_X = (size_t)T * D * 4, SZ_W = (size_t)T * W * 4;
constexpr size_t O_CTL = 0, CTL_BYTES = 1u << 20;
constexpr size_t O_MOD = CTL_BYTES;
constexpr size_t O_X0 = O_MOD + al256((size_t)NL * NB * D6 * 4);
constexpr size_t O_X1 = O_X0 + SZ_X;
constexpr size_t O_H = O_X1 + SZ_X;
constexpr size_t O_HF = O_H + SZ_X / 2;
constexpr size_t O_P = O_HF + SZ_X;
constexpr size_t SZ_P = (size_t)T * PW * 2;
constexpr size_t O_XC = O_P + SZ_P;
constexpr size_t O_LA = O_XC + SZ_W, O_LU = O_LA + 2 * SZ_W;
constexpr size_t SZ_LC = (size_t)2 * NB * NLC * W * 4;
constexpr size_t O_LCA = O_LU + 2 * SZ_W, O_LCH = O_LCA + SZ_LC, O_LCI = O_LCH + SZ_LC;
constexpr size_t O_YS = O_LCI + SZ_LC;
constexpr size_t O_SC = O_YS + (size_t)T * 4 * W * 2;
constexpr size_t SZ_KV = (size_t)NB * NCH * 8 * 64 * 128 * 4;
constexpr size_t O_KVF = O_SC, O_KVB = O_KVF + SZ_KV, O_STF = O_KVB + SZ_KV, O_STB = O_STF + SZ_KV;
constexpr size_t O_VN = O_STB + SZ_KV;
constexpr size_t O_FS = O_VN + SZ_W;
constexpr size_t O_DEC = O_FS + al256((size_t)T * RF * 4), O_AA = O_DEC + 2 * SZ_W, O_AKK = O_AA + 2 * SZ_W;
constexpr size_t O_GG = O_AKK, O_YY = O_GG + SZ_W;
constexpr int RCK = 64, NRC = S / RCK;
constexpr size_t O_BON = O_YY + 2 * SZ_W;
constexpr size_t O_PART = O_BON + al256((size_t)2 * T * 16 * 4);
constexpr size_t O_MRG = O_PART + SZ_X;
constexpr size_t O_LOG = O_MRG + SZ_X / 2;
constexpr size_t O_EID = O_LOG + al256((size_t)T * 40 * 4), O_EWT = O_EID + al256((size_t)T * 2 * 4), O_DEST = O_EWT + al256((size_t)T * 2 * 4);
constexpr size_t O_SLOT = O_DEST + al256((size_t)T * 2 * 4);
constexpr size_t O_PST = O_SLOT + al256((size_t)CAP * 4), O_PYT = O_PST + (size_t)64 * NRC * 4096 * 2, O_SVB = O_PYT + (size_t)64 * NRC * 4096 * 2, O_YVB = O_SVB + (size_t)64 * NRC * 4096 * 4;
constexpr size_t O_WIN = O_YVB + (size_t)64 * NRC * 4096 * 4;
constexpr size_t O_WBR = O_WIN + (size_t)PW * D * 2;
constexpr size_t O_WOUT = O_WBR + (size_t)D * 4 * W * 2;
constexpr size_t O_WGU = O_WOUT + (size_t)D * D * 2;
constexpr size_t O_WDN = O_WGU + (size_t)NE * 1024 * D * 2;
constexpr size_t O_G8 = O_WDN + (size_t)NE * D * 512 * 2;
constexpr size_t O_ROPE = O_G8 + (size_t)T * 4 * D;
constexpr size_t O_WLR = O_ROPE + (size_t)T * 64 * 4;
constexpr size_t O_WUT = O_WLR + (size_t)32 * 128 * 128 * 2;
constexpr size_t O_WAT = O_WUT + (size_t)2 * W * 64 * 2;
constexpr size_t O_WGT = O_WAT + (size_t)2 * W * 64 * 2;
constexpr size_t O_WRH = O_WGT + (size_t)W * 128 * 2;
constexpr size_t O_WRL = O_WRH + (size_t)48 * D * 2;
constexpr size_t WS_END0 = O_WRL + (size_t)48 * D * 2;
constexpr size_t SZ_MOE = (size_t)CAP * (D + 512 + D) * 2;
constexpr bool MOE_OVERLAY = SZ_MOE <= SZ_P;
constexpr size_t O_XS = MOE_OVERLAY ? O_P : WS_END0;
constexpr size_t O_ACT = O_XS + (size_t)CAP * D * 2;
constexpr size_t O_YE = O_ACT + (size_t)CAP * 512 * 2;
constexpr size_t WS_END = MOE_OVERLAY ? WS_END0 : WS_END0 + SZ_MOE;
static_assert(SEQ != 4096 || WS_END <= (size_t)2040 * 1024 * 1024, "workspace budget: d_ws is 4 x the largest input = 2048 MiB");
constexpr int CW_BAR = 4096;
constexpr int CW_CNT = 32768;
constexpr int CW_FILL = CW_CNT + NL * 64;
constexpr int CW_PLAN = CW_FILL + NL * 64;
static_assert(MAXBLK <= 160, "plan words");

struct Params { const float* in[37]; float* out; unsigned char* ws; int ph_lo, ph_hi; };

struct Ctx { const float* const* in; float* out; unsigned char* ws; };
#define GT_ ((long)blockIdx.x * NT + threadIdx.x)
#define GS_ ((long)gridDim.x * NT)
#define WSF(off) ((float*)(c.ws + (off)))
#define WSI(off) ((int*)(c.ws + (off)))
#define WSH(off) ((bf16_t*)(c.ws + (off)))
#define CTLW(c) ((int*)((c).ws + O_CTL))

#ifdef CPU_EMU
__device__ __forceinline__ float fexp_(float x) { return expf(x); }
__device__ __forceinline__ float frcp_(float x) { return 1.f / x; }
__device__ __forceinline__ float frsq_(float x) { return 1.f / sqrtf(x); }
#else
__device__ __forceinline__ float fexp_(float x) { return __builtin_amdgcn_exp2f(x * 1.4426950408889634f); }
__device__ __forceinline__ float frcp_(float x) { return __builtin_amdgcn_rcpf(x); }
__device__ __forceinline__ float frsq_(float x) { return __builtin_amdgcn_rsqf(x); }
#endif
__device__ __forceinline__ float sigmoidf_(float x) { return frcp_(1.f + fexp_(-x)); }
__device__ __forceinline__ float siluf_(float x) { return x * frcp_(1.f + fexp_(-x)); }
__device__ __forceinline__ float tanhf_(float x) { return 1.f - 2.f * frcp_(1.f + fexp_(2.f * x)); }
__device__ __forceinline__ float geluf_(float x) { return 0.5f * x * (1.f + tanhf_(0.7978845608028654f * (x + 0.044715f * x * x * x))); }
__device__ __forceinline__ float softplusf_(float x) { return x > 0.f ? x + log1pf(expf(-x)) : log1pf(expf(x)); }
__device__ __forceinline__ float loggamma_(int h) { return log1pf(-exp2f(-5.f - (float)h)); }
__device__ __forceinline__ unsigned f2u_(float f) { unsigned u; memcpy(&u, &f, 4); return u; }
__device__ __forceinline__ float u2f_(unsigned u) { float f; memcpy(&f, &u, 4); return f; }
__device__ __forceinline__ float bf2f(bf16_t v) { return u2f_((unsigned)v << 16); }
__device__ __forceinline__ unsigned f2bf(float f) { const unsigned u = f2u_(f); return (u + 0x7fffu + ((u >> 16) & 1u)) >> 16; }
__device__ __forceinline__ unsigned pk2(float lo, float hi) { return f2bf(lo) | (f2bf(hi) << 16); }
__device__ __forceinline__ float bflo(unsigned w) { return u2f_(w << 16); }
__device__ __forceinline__ float bfhi(unsigned w) { return u2f_(w & 0xffff0000u); }
__device__ __forceinline__ int atomic_add_i(int* p, int v) {
#ifdef CPU_EMU
    return __atomic_fetch_add(p, v, __ATOMIC_RELAXED);
#else
    return atomicAdd(p, v);
#endif
}
#define PF(P, r, col) bf2f((P)[(size_t)(r) * PW + (col)])
#ifdef CPU_EMU
#define SYNCTHREADS() emu_syncthreads()
#define SHFL_XOR(v, m) emu_shfl_xor(v, m)
#else
#define SYNCTHREADS() __syncthreads()
#define SHFL_XOR(v, m) __shfl_xor(v, m)
#endif
#ifdef CPU_EMU
__device__ __forceinline__ float wave_sum(float v) {
    for (int o = 1; o < 64; o <<= 1) v += SHFL_XOR(v, o);
    return v;
}
#else
__device__ __forceinline__ float wave_sum(float x) {
    x += __builtin_bit_cast(float, __builtin_amdgcn_update_dpp(0, __builtin_bit_cast(int, x), 0xB1, 0xF, 0xF, true));
    x += __builtin_bit_cast(float, __builtin_amdgcn_update_dpp(0, __builtin_bit_cast(int, x), 0x4E, 0xF, 0xF, true));
    x += __builtin_bit_cast(float, __builtin_amdgcn_update_dpp(0, __builtin_bit_cast(int, x), 0x141, 0xF, 0xF, true));
    x += __builtin_bit_cast(float, __builtin_amdgcn_update_dpp(0, __builtin_bit_cast(int, x), 0x140, 0xF, 0xF, true));
    const int xi = __builtin_bit_cast(int, x);
    return (__builtin_bit_cast(float, __builtin_amdgcn_readlane(xi, 0)) + __builtin_bit_cast(float, __builtin_amdgcn_readlane(xi, 16))) + (__builtin_bit_cast(float, __builtin_amdgcn_readlane(xi, 32)) + __builtin_bit_cast(float, __builtin_amdgcn_readlane(xi, 48)));
}
#endif
__device__ __forceinline__ f32x4 ld_bf4(const bf16_t* p) { const unsigned long long q = *(const unsigned long long*)p; const unsigned lo = (unsigned)q, hi = (unsigned)(q >> 32); return (f32x4){bflo(lo), bfhi(lo), bflo(hi), bfhi(hi)}; }
__device__ __forceinline__ void st_bf4(bf16_t* p, const f32x4 v) { *(unsigned long long*)p = (unsigned long long)pk2(v[0], v[1]) | ((unsigned long long)pk2(v[2], v[3]) << 32); }

template <int KT, int NTL>
__device__ __forceinline__ void wave_mma(f32x4 (&acc)[NTL], const bf16_t* A, int lda, const bf16_t* Bt, int ldb) {
    const int lane = threadIdx.x & 63, fr = lane & 15, fq = lane >> 4;
#ifdef CPU_EMU
    for (int nt = 0; nt < NTL; ++nt) for (int r = 0; r < 4; ++r) { float sacc = 0.f; const bf16_t* a = A + fr * lda; const bf16_t* b = Bt + (16 * nt + 4 * fq + r) * ldb;
        for (int k = 0; k < 32 * KT; ++k) sacc += bf2f(a[k]) * bf2f(b[k]);
        acc[nt][r] += sacc; }
#else
#pragma unroll
    for (int kt = 0; kt < KT; ++kt) {
        const bf16x8 af = *(const bf16x8*)(A + fr * lda + kt * 32 + fq * 8);
#pragma unroll
        for (int nt = 0; nt < NTL; ++nt) { const bf16x8 bfr = *(const bf16x8*)(Bt + (16 * nt + fr) * ldb + kt * 32 + fq * 8);
            acc[nt] = __builtin_amdgcn_mfma_f32_16x16x32_bf16(bfr, af, acc[nt], 0, 0, 0); }
    }
#endif
}
__device__ __forceinline__ void ph_mod(const Ctx& c, float* ldsf) {
    const float* cc = c.in[1]; const float* aw = c.in[5]; const float* ab = c.in[6]; float* mod = WSF(O_MOD);
    float* scs = ldsf; float* part = ldsf + NB * D; const int tid = threadIdx.x, c4 = (tid & 31) * 4, kq = tid >> 5;
    for (int i = tid; i < NB * D; i += NT) scs[i] = siluf_(cc[i]);
    SYNCTHREADS();
    for (int u = blockIdx.x; u < NL * (D6 / 128); u += gridDim.x) {
        const int l = u / (D6 / 128), j0 = (u % (D6 / 128)) * 128;
        const float* w = aw + (size_t)l * D * D6 + j0 + c4; f32x4 a0 = (f32x4){0.f, 0.f, 0.f, 0.f}, a1 = a0;
#pragma unroll 8
        for (int k = kq * 128; k < kq * 128 + 128; ++k) { const f32x4 wv = *(const f32x4*)(w + (size_t)k * D6); a0 += wv * scs[k]; a1 += wv * scs[D + k]; }
        *(f32x4*)(part + (kq * 2 + 0) * 128 + c4) = a0; *(f32x4*)(part + (kq * 2 + 1) * 128 + c4) = a1;
        SYNCTHREADS();
        if (tid < 256) { const int b = tid >> 7, col = tid & 127; float sacc = 0.f;
#pragma unroll
            for (int q = 0; q < 16; ++q) sacc += part[(q * 2 + b) * 128 + col];
            mod[((size_t)l * NB + b) * D6 + j0 + col] = sacc + ab[l * D6 + j0 + col]; }
        SYNCTHREADS();
    }
}
__device__ __forceinline__ void ph_norm(const Ctx& c, const float* x, const float* g, const float* sh, const float* sc, bf16_t* hb, float* hf) {
    const int lane = threadIdx.x & 63, gw = blockIdx.x * (NT / 64) + (threadIdx.x >> 6), ngw = gridDim.x * (NT / 64);
    for (int t0 = gw * 2; t0 < T; t0 += ngw * 2) {
        f32x4 v[2][8]; float ss[2] = {0.f, 0.f};
#pragma unroll
        for (int r = 0; r < 2; ++r)
#pragma unroll
            for (int j = 0; j < 8; ++j) v[r][j] = *(const f32x4*)(x + (size_t)(t0 + r) * D + (j * 64 + lane) * 4);
#pragma unroll
        for (int r = 0; r < 2; ++r) {
#pragma unroll
            for (int j = 0; j < 8; ++j) ss[r] += (v[r][j][0] * v[r][j][0] + v[r][j][1] * v[r][j][1]) + (v[r][j][2] * v[r][j][2] + v[r][j][3] * v[r][j][3]);
            const int t = t0 + r, b = t / S; const float rs = 1.f / sqrtf(wave_sum(ss[r]) * (1.f / D) + EPS);
#pragma unroll
            for (int j = 0; j < 8; ++j) { const int col = (j * 64 + lane) * 4;
                const f32x4 o = v[r][j] * rs * *(const f32x4*)(g + col) * (*(const f32x4*)(sc + b * D6 + col) + 1.f) + *(const f32x4*)(sh + b * D6 + col);
                st_bf4(hb + (size_t)t * D + col, o); }
            if (hf && lane == 0) hf[t] = rs;
        }
    }
}
template <int MODE>
__device__ __forceinline__ void ph_comb_norm(const Ctx& c, const float* xmid, const float* g2, float* xout, const float* g, const float* sh, const float* sc, bf16_t* hb, float* outp) {
    const bf16_t* YE = WSH(O_YE); const float* EWT = WSF(O_EWT); const int* DEST = WSI(O_DEST);
    const int lane = threadIdx.x & 63, gw = blockIdx.x * (NT / 64) + (threadIdx.x >> 6), ngw = gridDim.x * (NT / 64);
    for (int t = gw; t < T; t += ngw) {
        const int b = t / S; const float w0 = EWT[t * 2], w1 = EWT[t * 2 + 1]; const bf16_t* y0 = YE + (size_t)DEST[t * 2] * D; const bf16_t* y1 = YE + (size_t)DEST[t * 2 + 1] * D;
        f32x4 v[8]; float ss = 0.f;
#pragma unroll
        for (int j = 0; j < 8; ++j) { const int col = (j * 64 + lane) * 4;
            v[j] = *(const f32x4*)(xmid + (size_t)t * D + col) + *(const f32x4*)(g2 + b * D6 + col) * (ld_bf4(y0 + col) * w0 + ld_bf4(y1 + col) * w1);
            if (MODE == 0) *(f32x4*)(xout + (size_t)t * D + col) = v[j];
            ss += (v[j][0] * v[j][0] + v[j][1] * v[j][1]) + (v[j][2] * v[j][2] + v[j][3] * v[j][3]); }
        const float rs = 1.f / sqrtf(wave_sum(ss) * (1.f / D) + EPS);
#pragma unroll
        for (int j = 0; j < 8; ++j) { const int col = (j * 64 + lane) * 4;
            if (MODE == 0) st_bf4(hb + (size_t)t * D + col, v[j] * rs * *(const f32x4*)(g + col) * (*(const f32x4*)(sc + b * D6 + col) + 1.f) + *(const f32x4*)(sh + b * D6 + col));
            else *(f32x4*)(outp + (size_t)t * D + col) = v[j] * rs * *(const f32x4*)(g + col); }
    }
}

struct CvtItem { const float* Wp; int ldw; bf16_t* WT; int ldt; int drow, k0, n0; };
constexpr int I_IN = 32 * (INW / 32), I_BR = 4 * 16 * 64, I_OUT = 32 * 64, I_GU = NE * 32 * 32, I_DN = NE * 8 * 64, I_LR = 32 * 8, I_WU = 2 * 32, I_WG = 64, I_BIG = I_IN + I_BR + I_OUT + I_GU + I_DN, I_ALL = I_BIG + I_LR + 2 * I_WU + I_WG;
__device__ __forceinline__ CvtItem cvt_decode(const Ctx& c, int l, int it) {
    CvtItem r;
    if (it < I_IN) { const int kb = it / (INW / 32), nb = it % (INW / 32); r.n0 = nb * 32; r.k0 = kb * 64; r.Wp = c.in[7] + (size_t)l * D * INW; r.ldw = INW; r.WT = WSH(O_WIN); r.ldt = D; r.drow = r.n0 < 10624 ? r.n0 : r.n0 + 128; return r; }
    it -= I_IN;
    if (it < I_BR) { const int sgm = it / 1024, q = it % 1024, kb = q / 64, nb = q % 64; r.n0 = nb * 32; r.k0 = kb * 64; r.Wp = c.in[28] + ((size_t)l * 4 + sgm) * W * D; r.ldw = D; r.WT = WSH(O_WBR) + sgm * W; r.ldt = 4 * W; r.drow = r.n0; return r; }
    it -= I_BR;
    if (it < I_OUT) { const int kb = it / 64, nb = it % 64; r.n0 = nb * 32; r.k0 = kb * 64; r.Wp = c.in[29] + (size_t)l * D * D; r.ldw = D; r.WT = WSH(O_WOUT); r.ldt = D; r.drow = r.n0; return r; }
    it -= I_OUT;
    if (it < I_GU) { const int e = it / 1024, q = it % 1024, kb = q / 32, nb = q % 32; r.n0 = nb * 32; r.k0 = kb * 64; r.Wp = c.in[34] + ((size_t)l * NE + e) * D * 1024; r.ldw = 1024; r.WT = WSH(O_WGU) + (size_t)e * 1024 * D; r.ldt = D;
        r.drow = r.n0 < 512 ? (r.n0 / 128) * 256 + (r.n0 % 128) : ((r.n0 - 512) / 128) * 256 + 128 + ((r.n0 - 512) % 128); return r; }
    it -= I_GU;
    if (it < I_DN) { const int e = it / 512, q = it % 512, kb = q / 64, nb = q % 64; r.n0 = nb * 32; r.k0 = kb * 64; r.Wp = c.in[35] + ((size_t)l * NE + e) * 512 * D; r.ldw = D; r.WT = WSH(O_WDN) + (size_t)e * D * 512; r.ldt = 512; r.drow = r.n0; return r; }
    it -= I_DN;
    if (it < I_LR) { const int m = it / 8, q = it % 8, kb = q / 4, nb = q % 4, z = m >> 4, ty = (m >> 3) & 1, n = m & 7; r.n0 = nb * 32; r.k0 = kb * 64; r.Wp = c.in[ty ? 12 : 10] + (((size_t)l * 2 + z) * 8 + n) * 128 * 128; r.ldw = 128;
        r.WT = WSH(O_WLR) + (size_t)m * 128 * 128; r.ldt = 128; r.drow = r.n0; return r; }
    it -= I_LR;
    if (it < 2 * I_WU) { const int ua = it / I_WU, q = it % I_WU, z = q / 32, nb = q % 32; r.n0 = nb * 32; r.k0 = 0; r.Wp = c.in[ua ? 23 : 21] + ((size_t)l * 2 + z) * 64 * W; r.ldw = W; r.WT = WSH(ua ? O_WAT : O_WUT) + (size_t)z * W * 64; r.ldt = 64; r.drow = r.n0; return r; }
    it -= 2 * I_WU;
    { const int kb = it / 32, nb = it % 32; r.n0 = nb * 32; r.k0 = kb * 64; r.Wp = c.in[24] + (size_t)l * 128 * W; r.ldw = W; r.WT = WSH(O_WGT); r.ldt = 128; r.drow = r.n0; return r; }
}
constexpr int J_IN = 16 * (INW / 128), J_BR = 4 * 8 * 16, J_OUT = 16 * 16, J_GU = NE * 16 * 8, J_DN = NE * 4 * 16, J_ALL = J_IN + J_BR + J_OUT + J_GU + J_DN;
__device__ __forceinline__ CvtItem cvt_decode_big(const Ctx& c, int l, int it) {
    CvtItem r;
    if (it < J_IN) { const int kb = it / (INW / 128), nb = it % (INW / 128); r.n0 = nb * 128; r.k0 = kb * 128; r.Wp = c.in[7] + (size_t)l * D * INW; r.ldw = INW; r.WT = WSH(O_WIN); r.ldt = D; r.drow = r.n0 < 10624 ? r.n0 : r.n0 + 128; return r; }
    it -= J_IN;
    if (it < J_BR) { const int sgm = it / 128, q = it % 128, kb = q / 16, nb = q % 16; r.n0 = nb * 128; r.k0 = kb * 128; r.Wp = c.in[28] + ((size_t)l * 4 + sgm) * W * D; r.ldw = D; r.WT = WSH(O_WBR) + sgm * W; r.ldt = 4 * W; r.drow = r.n0; return r; }
    it -= J_BR;
    if (it < J_OUT) { const int kb = it / 16, nb = it % 16; r.n0 = nb * 128; r.k0 = kb * 128; r.Wp = c.in[29] + (size_t)l * D * D; r.ldw = D; r.WT = WSH(O_WOUT); r.ldt = D; r.drow = r.n0; return r; }
    it -= J_OUT;
    if (it < J_GU) { const int e = it / 128, q = it % 128, kb = q / 8, nb = q % 8; r.n0 = nb * 128; r.k0 = kb * 128; r.Wp = c.in[34] + ((size_t)l * NE + e) * D * 1024; r.ldw = 1024; r.WT = WSH(O_WGU) + (size_t)e * 1024 * D; r.ldt = D;
        r.drow = r.n0 < 512 ? (r.n0 / 128) * 256 : ((r.n0 - 512) / 128) * 256 + 128; return r; }
    it -= J_GU;
    { const int e = it / 64, q = it % 64, kb = q / 16, nb = q % 16; r.n0 = nb * 128; r.k0 = kb * 128; r.Wp = c.in[35] + ((size_t)l * NE + e) * 512 * D; r.ldw = D; r.WT = WSH(O_WDN) + (size_t)e * D * 512; r.ldt = 512; r.drow = r.n0; return r; }
}
__device__ __forceinline__ void convert_big(const Ctx& c, int l, float* ldsf, int first, int last, int widx, int wcnt) {
    const int tid = threadIdx.x, lr = tid >> 5, lc = (tid & 31) * 4;
    f32x4 rg[8]; int it = first + widx; CvtItem r;
    if (it < last) { r = cvt_decode_big(c, l, it);
#pragma unroll
        for (int i = 0; i < 8; ++i) rg[i] = *(const f32x4*)(r.Wp + (size_t)(r.k0 + lr + 16 * i) * r.ldw + r.n0 + lc); }
    for (; it < last; it += wcnt) {
#pragma unroll
        for (int i = 0; i < 8; ++i) { float* dp = ldsf + (lr + 16 * i) * 129 + lc; dp[0] = rg[i][0]; dp[1] = rg[i][1]; dp[2] = rg[i][2]; dp[3] = rg[i][3]; }
        const CvtItem cur = r; const int nx = it + wcnt;
        if (nx < last) { r = cvt_decode_big(c, l, nx);
#pragma unroll
            for (int i = 0; i < 8; ++i) rg[i] = *(const f32x4*)(r.Wp + (size_t)(r.k0 + lr + 16 * i) * r.ldw + r.n0 + lc); }
        SYNCTHREADS();
#pragma unroll
        for (int q = 0; q < 4; ++q) { const int id = tid + NT * q, n = id >> 4, k8 = (id & 15) * 8; const float* sp = ldsf + k8 * 129 + n;
            u32x4 o; o[0] = pk2(sp[0 * 129], sp[1 * 129]); o[1] = pk2(sp[2 * 129], sp[3 * 129]); o[2] = pk2(sp[4 * 129], sp[5 * 129]); o[3] = pk2(sp[6 * 129], sp[7 * 129]);
            *(u32x4*)(cur.WT + (size_t)(cur.drow + n) * cur.ldt + cur.k0 + k8) = o; }
        SYNCTHREADS();
    }
}
__device__ __forceinline__ int convert_tail_tiles() { const int nun = (T / 256) * (PW / 256), G = (int)gridDim.x, rem = nun % G; return rem == 0 ? 0 : (G - rem) * 10 < J_GU + J_DN ? (G - rem) * 10 : J_GU + J_DN; }
__device__ __forceinline__ int convert_early_tiles(const Ctx& c) { const int G = (int)gridDim.x, nrest = (CTLW(c) + CW_PLAN)[40] * 4 - G; return (nrest >= 0 && nrest < G) ? ((G - nrest) * 12 < J_IN ? (G - nrest) * 12 : J_IN) : 0; }
__device__ __forceinline__ void ph_convert(const Ctx& c, int l, float* ldsf) {
    const int lane = threadIdx.x & 63, wave = threadIdx.x >> 6; const int gw = blockIdx.x * (NT / 64) + wave, ngw = gridDim.x * (NT / 64);
    convert_big(c, l, ldsf, l == 1 ? convert_early_tiles(c) : 0, J_ALL - convert_tail_tiles(), (int)blockIdx.x, (int)gridDim.x);
#ifdef CPU_EMU
    if (lane == 0) for (int it = I_BIG + gw; it < I_ALL; it += ngw) { const CvtItem r = cvt_decode(c, l, it);
        for (int kk = 0; kk < 64; ++kk) for (int nn = 0; nn < 32; ++nn) r.WT[(size_t)(r.drow + nn) * r.ldt + r.k0 + kk] = (bf16_t)f2bf(r.Wp[(size_t)(r.k0 + kk) * r.ldw + r.n0 + nn]); }
#else
    float* scr = ldsf + wave * (64 * 33 + 16);
    for (int it = I_BIG + gw; it < I_ALL; it += ngw) {
        const CvtItem r = cvt_decode(c, l, it);
#pragma unroll 8
        for (int i = 0; i < 32; ++i) { const int kk = 2 * i + (lane >> 5); scr[kk * 33 + (lane & 31)] = r.Wp[(size_t)(r.k0 + kk) * r.ldw + r.n0 + (lane & 31)]; }
        asm volatile("s_waitcnt lgkmcnt(0)" ::: "memory");
        const int cc = lane & 7;
#pragma unroll
        for (int j = 0; j < 4; ++j) { const int n = (lane >> 3) + 8 * j; const float* sp = scr + (8 * cc) * 33 + n;
            u32x4 o; o[0] = pk2(sp[0 * 33], sp[1 * 33]); o[1] = pk2(sp[2 * 33], sp[3 * 33]); o[2] = pk2(sp[4 * 33], sp[5 * 33]); o[3] = pk2(sp[6 * 33], sp[7 * 33]);
            *(u32x4*)(r.WT + (size_t)(r.drow + n) * r.ldt + r.k0 + 8 * cc) = o; }
        asm volatile("s_waitcnt lgkmcnt(0)" ::: "memory");
    }
#endif
    { const float* wg = c.in[30] + (size_t)l * D * 4; const float* we = c.in[32] + (size_t)l * D * 32; bf16_t* wh = WSH(O_WRH); bf16_t* wl = WSH(O_WRL);
      for (long i = GT_; i < (long)48 * D; i += GS_) { const int n = (int)(i / D), k = (int)(i % D); const float w = n < 4 ? wg[k * 4 + n] : n < 36 ? we[k * 32 + (n - 4)] : 0.f; const unsigned hb = f2bf(w); wh[i] = (bf16_t)hb; wl[i] = (bf16_t)f2bf(w - bf2f((bf16_t)hb)); } }
    for (long i = GT_; i < (long)128 * D / 2; i += GS_) ((unsigned*)(WSH(O_WIN) + (size_t)10624 * D))[i] = 0u;
}

namespace pg8 {
constexpr int BM = 256, BK = 64, HALF = 128, HTB = HALF * BK * 2, STAGE_BYTES = 8 * HTB;
__host__ __device__ __forceinline__ int lds_byte(int r, int cc) { const int st = (r >> 4) * 2 + (cc >> 5), rr = r & 15, c2 = cc & 31, ob = rr * 64 + c2 * 2; return st * 1024 + (ob ^ (((ob >> 9) & 1) << 5)); }
__host__ __device__ __forceinline__ void stage_rc(int b, int& R, int& C) { const int st = b / 1024, sb = b % 1024, swz = sb ^ (((sb >> 9) & 1) << 5); R = (st >> 1) * 16 + swz / 64; C = (st & 1) * 32 + (swz % 64) / 2; }
__host__ __device__ __forceinline__ int perm32(int rho) { const int n = rho >> 4, i = rho & 15; return 8 * (i >> 2) + 4 * n + (i & 3); }
struct Unit { int pm, pn, aux; const char* A; const char* B; };
struct Gemm { int K, lda, ldb; };

template <class Epi, class Sched>
__device__ __forceinline__ void gemm_phase(unsigned char* lds_, const Gemm g, const Sched& S, const Epi& E) {
#ifdef CPU_EMU
    if (threadIdx.x != 0) return;
    Unit u; const int K = g.K;
    float* Af = (float*)malloc((size_t)256 * K * 4); float* Bf = (float*)malloc((size_t)256 * K * 4); float* Cf = (float*)malloc(256 * 256 * 4);
    for (int i = 0; S.next(i, u); ++i) {
        const bf16_t* A = (const bf16_t*)u.A; const bf16_t* B = (const bf16_t*)u.B;
        for (int r = 0; r < 256; ++r) for (int k = 0; k < K; ++k) { Af[(size_t)r * K + k] = bf2f(A[(size_t)r * g.lda + k]); Bf[(size_t)r * K + k] = bf2f(B[(size_t)r * g.ldb + k]); }
        const int nseg = Epi::SEGT > 0 ? K / (Epi::SEGT * 64) : 1, kseg = K / nseg;
        for (int wid = 0; wid < 8; ++wid) for (int lane = 0; lane < 64; ++lane) {
            const int wr = wid >> 2, wc = wid & 3, fr = lane & 15, fq = lane >> 4; f32x4 acc[2][2][4][2];
            for (int ai = 0; ai < 2; ++ai) for (int bj = 0; bj < 2; ++bj) for (int m = 0; m < 4; ++m) for (int n = 0; n < 2; ++n) for (int j = 0; j < 4; ++j) acc[ai][bj][m][n][j] = 0.f;
            for (int sg = 0; sg < nseg; ++sg) {
                for (int ai = 0; ai < 2; ++ai) for (int bj = 0; bj < 2; ++bj) for (int m = 0; m < 4; ++m) for (int n = 0; n < 2; ++n) for (int j = 0; j < 4; ++j) {
                    const int r = 128 * ai + 64 * wr + 16 * m + fr, cc = 128 * bj + 32 * wc + (Epi::PERM ? 8 * fq + 4 * n + j : 16 * n + 4 * fq + j);
                    const float* a = Af + (size_t)r * K + sg * kseg; const float* b = Bf + (size_t)cc * K + sg * kseg; float sacc = 0.f; for (int k = 0; k < kseg; ++k) sacc += a[k] * b[k];
                    acc[ai][bj][m][n][j] += sacc; }
                if constexpr (Epi::SEGT > 0) { if (sg + 1 < nseg) E.segment(acc, u, sg, wr, wc, fr, fq); }
            }
            E(acc, u, wr, wc, fr, fq);
        }
    }
    free(Af); free(Bf); free(Cf);
#else
    typedef __attribute__((address_space(3))) unsigned char* ldsp_t;
    ldsp_t lds = (ldsp_t)lds_;
    const int tid = threadIdx.x, wid = __builtin_amdgcn_readfirstlane(tid >> 6), lane = tid & 63, wr = wid >> 2, wc = wid & 3, fr = lane & 15, fq = lane >> 4;
    const int K = g.K, nt = K / BK;
    unsigned voffA[2], voffB[2];
#pragma unroll
    for (int i = 0; i < 2; ++i) { int R, C; stage_rc(tid * 16 + i * 8192, R, C); const int Rb = Epi::PERM ? ((R & ~31) + perm32(R & 31)) : R;
        voffA[i] = (unsigned)(R * g.lda + C) * 2u; voffB[i] = (unsigned)(Rb * g.ldb + C) * 2u; }
    const size_t kstep = (size_t)(BK * 2);
    const size_t hstepA = (size_t)HALF * g.lda * 2, hstepB = (size_t)HALF * g.ldb * 2;
    const unsigned ldsw = (unsigned)wid * 1024u;
    const int aoff = lds_byte(wr * 64 + fr, fq * 8), boff = lds_byte(wc * 32 + fr, fq * 8);
#define PG8_SA(b, h) (((b) * 2 + (h)) * HTB)
#define PG8_SB(b, h) ((4 + (b) * 2 + (h)) * HTB)
#define PG8_STAGE(bufoff, gbase, voff) do { _Pragma("unroll") for (int _i = 0; _i < 2; ++_i) \
        __builtin_amdgcn_global_load_lds((const unsigned*)((const char*)(gbase) + (voff)[_i]), (__attribute__((address_space(3))) unsigned*)(lds + (bufoff) + ldsw + _i * 8192), 16, 0, 0); } while (0)
#define PG8_LDA(dst, b, h) do { _Pragma("unroll") for (int m = 0; m < 4; ++m) _Pragma("unroll") for (int k = 0; k < 2; ++k) dst[m][k] = *(const __attribute__((address_space(3))) bf16x8*)(lds + PG8_SA(b, h) + aoff + m * 2048 + k * 1024); } while (0)
#define PG8_LDB(dst, b, h) do { _Pragma("unroll") for (int n = 0; n < 2; ++n) _Pragma("unroll") for (int k = 0; k < 2; ++k) dst[n][k] = *(const __attribute__((address_space(3))) bf16x8*)(lds + PG8_SB(b, h) + boff + n * 2048 + k * 1024); } while (0)
#define PG8_MMA(ai, bj, At, Bt) do { __builtin_amdgcn_s_setprio(1); _Pragma("unroll") for (int m = 0; m < 4; ++m) _Pragma("unroll") for (int n = 0; n < 2; ++n) _Pragma("unroll") for (int k = 0; k < 2; ++k) \
        acc[ai][bj][m][n] = __builtin_amdgcn_mfma_f32_16x16x32_bf16(Bt[n][k], At[m][k], acc[ai][bj][m][n], 0, 0, 0); __builtin_amdgcn_s_setprio(0); } while (0)
#define PG8_WAIT_V(n) asm volatile("s_waitcnt vmcnt(" #n ")" ::: "memory")
#define PG8_WAIT_L(n) asm volatile("s_waitcnt lgkmcnt(" #n ")" ::: "memory")
#define PG8_BAR __builtin_amdgcn_s_barrier()
#define PG8_SCHED __builtin_amdgcn_sched_barrier(0)
    Unit cur, nxt; int ui = 0;
    if (!S.next(0, cur)) return;
    f32x4 acc[2][2][4][2];
#pragma unroll
    for (int a = 0; a < 2; ++a)
#pragma unroll
        for (int b = 0; b < 2; ++b)
#pragma unroll
            for (int m = 0; m < 4; ++m)
#pragma unroll
                for (int n = 0; n < 2; ++n) acc[a][b][m][n] = (f32x4){0.f, 0.f, 0.f, 0.f};
    bf16x8 At[4][2], B0[2][2], B1[2][2];
    const char* cA = cur.A; const char* cB = cur.B;
    S.a_ready(cur);
    PG8_STAGE(PG8_SB(0, 0), cB, voffB); PG8_STAGE(PG8_SA(0, 0), cA, voffA); PG8_STAGE(PG8_SB(0, 1), cB + hstepB, voffB); PG8_STAGE(PG8_SA(0, 1), cA + hstepA, voffA);
    if (wr == 1) PG8_BAR;
    PG8_WAIT_V(4); PG8_BAR;
    PG8_STAGE(PG8_SB(1, 0), cB + kstep, voffB); PG8_STAGE(PG8_SA(1, 0), cA + kstep, voffA); PG8_STAGE(PG8_SB(1, 1), cB + hstepB + kstep, voffB);
    PG8_WAIT_V(6); PG8_BAR;
    for (;;) {
        const bool has_next = S.next(ui + 1, nxt);
        const char* nA = has_next ? nxt.A : cA; const char* nB = has_next ? nxt.B : cB;
        for (int t = 0; t < nt; t += 2) {
            const bool last = (t == nt - 2);
            const char* a1 = cA + (size_t)(t + 1) * kstep;
            const char* a2 = last ? nA : cA + (size_t)(t + 2) * kstep; const char* b2 = last ? nB : cB + (size_t)(t + 2) * kstep;
            const char* a3 = a2 + kstep; const char* b3 = b2 + kstep;
            if (last && has_next) S.a_ready(nxt);
            PG8_LDB(B0, 0, 0); PG8_SCHED; PG8_LDA(At, 0, 0); PG8_STAGE(PG8_SA(1, 1), a1 + hstepA, voffA);
            PG8_WAIT_L(8); PG8_BAR; PG8_WAIT_L(0); PG8_MMA(0, 0, At, B0); PG8_BAR; PG8_SCHED;
            PG8_LDB(B1, 0, 1); PG8_STAGE(PG8_SB(0, 0), b2, voffB);
            PG8_BAR; PG8_WAIT_L(0); PG8_MMA(0, 1, At, B1); PG8_BAR;
            PG8_LDA(At, 0, 1); PG8_STAGE(PG8_SA(0, 0), a2, voffA);
            PG8_BAR; PG8_WAIT_L(0); PG8_MMA(1, 0, At, B0); PG8_BAR; PG8_SCHED;
            PG8_STAGE(PG8_SB(0, 1), b2 + hstepB, voffB);
            PG8_WAIT_V(6); PG8_BAR; PG8_MMA(1, 1, At, B1); PG8_BAR;
            PG8_LDB(B0, 1, 0); PG8_SCHED; PG8_LDA(At, 1, 0); PG8_STAGE(PG8_SA(0, 1), a2 + hstepA, voffA);
            PG8_WAIT_L(8); PG8_BAR; PG8_WAIT_L(0); PG8_MMA(0, 0, At, B0); PG8_BAR; PG8_SCHED;
            PG8_LDB(B1, 1, 1); PG8_STAGE(PG8_SB(1, 0), b3, voffB);
            PG8_BAR; PG8_WAIT_L(0); PG8_MMA(0, 1, At, B1); PG8_BAR;
            PG8_LDA(At, 1, 1); PG8_STAGE(PG8_SA(1, 0), a3, voffA);
            PG8_BAR; PG8_WAIT_L(0); PG8_MMA(1, 0, At, B0); PG8_BAR; PG8_SCHED;
            PG8_STAGE(PG8_SB(1, 1), b3 + hstepB, voffB);
            PG8_WAIT_V(6); PG8_BAR; PG8_MMA(1, 1, At, B1); PG8_BAR;
            if constexpr (Epi::SEGT > 0) { if ((t + 2) % Epi::SEGT == 0 && t + 2 < nt) E.segment(acc, cur, (t + 2) / Epi::SEGT - 1, wr, wc, fr, fq); }
        }
        E(acc, cur, wr, wc, fr, fq); S.done(cur);
        if (!has_next) break;
#pragma unroll
        for (int a = 0; a < 2; ++a)
#pragma unroll
            for (int b = 0; b < 2; ++b)
#pragma unroll
                for (int m = 0; m < 4; ++m)
#pragma unroll
                    for (int n = 0; n < 2; ++n) acc[a][b][m][n] = (f32x4){0.f, 0.f, 0.f, 0.f};
        cur = nxt; cA = nA; cB = nB; ++ui;
    }
    PG8_WAIT_V(0);
    if (wr == 0) PG8_BAR;
    PG8_BAR;
#undef PG8_SA
#undef PG8_SB
#undef PG8_STAGE
#undef PG8_LDA
#undef PG8_LDB
#undef PG8_MMA
#undef PG8_WAIT_V
#undef PG8_WAIT_L
#undef PG8_BAR
#undef PG8_SCHED
#endif
}

struct StaticOrder {
    int nM, nN, nwg, G, c; const char* A; const char* B; size_t tstepA, tstepB;
    __device__ __forceinline__ void init(int M, int N, int G_, int c_, const void* A_, const void* B_, int lda, int ldb) { nM = M / BM; nN = N / BM; nwg = nM * nN; G = G_; c = c_; A = (const char*)A_; B = (const char*)B_; tstepA = (size_t)BM * lda * 2; tstepB = (size_t)BM * ldb * 2; }
    __device__ __forceinline__ bool next(int i, Unit& u) const {
        const long L = (long)i * G + c; if (L >= nwg) return false;
        int wgid = (int)L; { const int q = nwg / 8, r = nwg % 8, xcd = wgid % 8, off = wgid / 8; wgid = (xcd < r ? xcd * (q + 1) : r * (q + 1) + (xcd - r) * q) + off; }
        const int nig = 8 * nN, gid = wgid / nig, fm = gid * 8, gsz = (nM - fm) < 8 ? (nM - fm) : 8;
        u.pm = fm + ((wgid % nig) % gsz); u.pn = (wgid % nig) / gsz; u.aux = 0; u.A = A + (size_t)u.pm * tstepA; u.B = B + (size_t)u.pn * tstepB; return true;
    }
    __device__ __forceinline__ void a_ready(const Unit&) const {}
    __device__ __forceinline__ void done(const Unit&) const {}
};
struct MergeOrder {
    StaticOrder so; int kseg_bytes;
    __device__ __forceinline__ bool next(int i, Unit& u) const { if (!so.next(i >> 2, u)) return false; u.aux = i & 3; u.A += (size_t)u.aux * kseg_bytes; u.B += (size_t)u.aux * kseg_bytes; return true; }
    __device__ __forceinline__ void a_ready(const Unit&) const {}
    __device__ __forceinline__ void done(const Unit&) const {}
};
struct MoeOrder {
    int G, c, ncol; const int* plan; const char* A; const char* B; size_t tstepA, tstepB, estep;
    __device__ __forceinline__ bool next(int i, Unit& u) const {
        const long L = (long)i * G + c; const int nblk = plan[40]; if (L >= (long)nblk * ncol) return false;
        u.pm = (int)(L / ncol); u.pn = (int)(L % ncol); u.aux = plan[64 + u.pm]; u.A = A + (size_t)u.pm * tstepA; u.B = B + (size_t)u.aux * estep + (size_t)u.pn * tstepB; return true;
    }
    __device__ __forceinline__ void a_ready(const Unit&) const {}
    __device__ __forceinline__ void done(const Unit&) const {}
};

__device__ __forceinline__ u32x4 pack8(const f32x4 v0, const f32x4 v1) { u32x4 w; w[0] = pk2(v0[0], v0[1]); w[1] = pk2(v0[2], v0[3]); w[2] = pk2(v1[0], v1[1]); w[3] = pk2(v1[2], v1[3]); return w; }
struct EpiBf16 {
    static constexpr int SEGT = 0; static constexpr bool PERM = true; bf16_t* O; int ldc;
    __device__ __forceinline__ void operator()(const f32x4 (&acc)[2][2][4][2], const Unit& u, int wr, int wc, int fr, int fq) const {
        const int row0 = u.pm * BM + wr * 64 + fr, col0 = u.pn * BM + wc * 32 + 8 * fq;
#pragma unroll
        for (int ai = 0; ai < 2; ++ai)
#pragma unroll
            for (int m = 0; m < 4; ++m) { bf16_t* rowp = O + (size_t)(row0 + ai * HALF + m * 16) * ldc + col0;
#pragma unroll
                for (int bj = 0; bj < 2; ++bj) *(u32x4*)(rowp + bj * HALF) = pack8(acc[ai][bj][m][0], acc[ai][bj][m][1]); }
    }
};
struct EpiP {
    static constexpr int SEGT = 0; static constexpr bool PERM = true; bf16_t* O; unsigned char* G8;
    __device__ __forceinline__ void operator()(const f32x4 (&acc)[2][2][4][2], const Unit& u, int wr, int wc, int fr, int fq) const {
        const int row0 = u.pm * BM + wr * 64 + fr, col0 = u.pn * BM + wc * 32 + 8 * fq;
        if (u.pn * BM < C_MLP) {
#pragma unroll
            for (int ai = 0; ai < 2; ++ai)
#pragma unroll
                for (int m = 0; m < 4; ++m) { bf16_t* rowp = O + (size_t)(row0 + ai * HALF + m * 16) * PW + col0;
#pragma unroll
                    for (int bj = 0; bj < 2; ++bj) *(u32x4*)(rowp + bj * HALF) = pack8(acc[ai][bj][m][0], acc[ai][bj][m][1]); }
        } else {
#pragma unroll
            for (int ai = 0; ai < 2; ++ai)
#pragma unroll
                for (int m = 0; m < 4; ++m) { unsigned char* rowp = G8 + (size_t)(row0 + ai * HALF + m * 16) * (4 * D) + (col0 - C_MLP);
#pragma unroll
                    for (int bj = 0; bj < 2; ++bj) { unsigned long long w = 0ull;
#pragma unroll
                        for (int q = 0; q < 8; ++q) { const float gq = sigmoidf_(acc[ai][bj][m][q >> 2][q & 3]); w |= (unsigned long long)(unsigned)(gq * 255.f + 0.5f) << (8 * q); }
                        *(unsigned long long*)(rowp + bj * HALF) = w; } }
        }
    }
};
struct EpiMerge {
    static constexpr int SEGT = 16; static constexpr bool PERM = true; const unsigned char* G8; bf16_t* MRG;
    static __device__ __forceinline__ float gq(unsigned long long w, int q) { const unsigned b = (unsigned)(w >> (8 * q)) & 255u; return (b ? (float)b : 0.5f) * (1.f / 255.f); }
    __device__ __forceinline__ void segment(f32x4 (&acc)[2][2][4][2], const Unit& u, int seg, int wr, int wc, int fr, int fq) const {
        const int row0 = u.pm * BM + wr * 64 + fr, col0 = u.pn * BM + wc * 32 + 8 * fq;
#pragma unroll
        for (int ai = 0; ai < 2; ++ai)
#pragma unroll
            for (int m = 0; m < 4; ++m) { const size_t r = (size_t)(row0 + ai * HALF + m * 16);
#pragma unroll
                for (int bj = 0; bj < 2; ++bj) { const int cc = col0 + bj * HALF;
                    const unsigned long long g0 = *(const unsigned long long*)(G8 + r * (4 * D) + seg * D + cc), g1 = *(const unsigned long long*)(G8 + r * (4 * D) + (seg + 1) * D + cc);
#pragma unroll
                    for (int q = 0; q < 4; ++q) { acc[ai][bj][m][0][q] *= gq(g0, q) * frcp_(gq(g1, q)); acc[ai][bj][m][1][q] *= gq(g0, 4 + q) * frcp_(gq(g1, 4 + q)); } }
#ifndef CPU_EMU
                asm volatile("" ::: "memory");
#endif
            }
    }
    __device__ __forceinline__ void operator()(const f32x4 (&acc)[2][2][4][2], const Unit& u, int wr, int wc, int fr, int fq) const {
        const int row0 = u.pm * BM + wr * 64 + fr, col0 = u.pn * BM + wc * 32 + 8 * fq;
#pragma unroll
        for (int ai = 0; ai < 2; ++ai)
#pragma unroll
            for (int m = 0; m < 4; ++m) { const size_t r = (size_t)(row0 + ai * HALF + m * 16);
#pragma unroll
                for (int bj = 0; bj < 2; ++bj) { const int cc = col0 + bj * HALF;
                    const unsigned long long g3 = *(const unsigned long long*)(G8 + r * (4 * D) + 3 * D + cc); f32x4 v0, v1;
#pragma unroll
                    for (int q = 0; q < 4; ++q) { v0[q] = gq(g3, q) * acc[ai][bj][m][0][q]; v1[q] = gq(g3, 4 + q) * acc[ai][bj][m][1][q]; }
                    *(u32x4*)(MRG + r * D + cc) = pack8(v0, v1); }
#ifndef CPU_EMU
                asm volatile("" ::: "memory");
#endif
            }
    }
};
struct EpiResid {
    static constexpr int SEGT = 0; static constexpr bool PERM = false; const float* xin; const float* g1; float* xmid;
    __device__ __forceinline__ void operator()(const f32x4 (&acc)[2][2][4][2], const Unit& u, int wr, int wc, int fr, int fq) const {
        const int row0 = u.pm * BM + wr * 64 + fr, col0 = u.pn * BM + wc * 32 + 4 * fq;
#pragma unroll
        for (int ai = 0; ai < 2; ++ai)
#pragma unroll
            for (int m = 0; m < 4; ++m) { const int r = row0 + ai * HALF + m * 16; const float* gp = g1 + (size_t)(r / S) * D6;
#pragma unroll
                for (int bj = 0; bj < 2; ++bj)
#pragma unroll
                    for (int n = 0; n < 2; ++n) { const int cc = col0 + bj * HALF + n * 16; *(f32x4*)(xmid + (size_t)r * D + cc) = *(const f32x4*)(xin + (size_t)r * D + cc) + *(const f32x4*)(gp + cc) * acc[ai][bj][m][n]; }
#ifndef CPU_EMU
                asm volatile("" ::: "memory");
#endif
            }
    }
};
struct EpiGU {
    static constexpr int SEGT = 0; static constexpr bool PERM = true; bf16_t* ACT;
    __device__ __forceinline__ void operator()(const f32x4 (&acc)[2][2][4][2], const Unit& u, int wr, int wc, int fr, int fq) const {
        const int row0 = u.pm * BM + wr * 64 + fr, col0 = u.pn * HALF + wc * 32 + 8 * fq;
#pragma unroll
        for (int ai = 0; ai < 2; ++ai)
#pragma unroll
            for (int m = 0; m < 4; ++m) { f32x4 v0, v1;
#pragma unroll
                for (int j = 0; j < 4; ++j) { v0[j] = siluf_(acc[ai][0][m][0][j]) * acc[ai][1][m][0][j]; v1[j] = siluf_(acc[ai][0][m][1][j]) * acc[ai][1][m][1][j]; }
                *(u32x4*)(ACT + (size_t)(row0 + ai * HALF + m * 16) * 512 + col0) = pack8(v0, v1); }
    }
};
}

template <int PASS>
__device__ __forceinline__ void ph_lru(const Ctx& c, int l, float* ldsf) {
    const bf16_t* P = WSH(O_P); const float* cw = c.in[8] + (size_t)l * 4 * W; const float* cb = c.in[9] + (size_t)l * W;
    const float* br = c.in[11] + (size_t)l * 2 * W; const float* bi = c.in[13] + (size_t)l * 2 * W; const float* lam = c.in[14] + (size_t)l * 2 * W; const bf16_t* WLR = WSH(O_WLR);
    float* CA = WSF(O_LCA); float* CH = WSF(O_LCH); const float* CI = WSF(O_LCI); bf16_t* Y = WSH(O_YS); unsigned* LAU = (unsigned*)(c.ws + O_LA);
    bf16_t* Xs = (bf16_t*)ldsf; bf16_t* Wr = Xs + 64 * 136; bf16_t* Wi = Wr + 128 * 136; float* AUa = (float*)Wr; float* AUu = AUa + 64 * 128; float* HF = (float*)(Wi + 128 * 136); float* spl = HF + 64 * 128;
    const int tid = threadIdx.x, wv = tid >> 6, lane = tid & 63, fr = lane & 15, fq = lane >> 4, rt = wv & 3, hf = wv >> 2;
    for (int u = blockIdx.x; u < (T / 64) * 8; u += gridDim.x) {
        const int n = u & 7, tile = u >> 3, b = tile / NLC, chk = tile % NLC; const long t0 = (long)tile * 64;
        if (tid < 256) spl[tid] = softplusf_(-lam[(tid >> 7) * W + n * 128 + (tid & 127)]);
#pragma unroll
        for (int q = 0; q < 4; ++q) { const int id = tid + NT * q, tl = id >> 5, e4 = (id & 31) * 4, ch = n * 128 + e4; const long t = t0 + tl; const int sI = (int)(t % S);
            f32x4 acc = *(const f32x4*)(cb + ch);
#pragma unroll
            for (int k = 0; k < 4; ++k) { const int ss = sI + k - 2; if (ss >= 0 && ss < S) acc += ld_bf4(P + (size_t)(t + k - 2) * PW + C_LX + ch) * *(const f32x4*)(cw + k * W + ch); }
            st_bf4(Xs + tl * 136 + e4, acc); }
        for (int z = 0; z < 2; ++z) {
#pragma unroll
            for (int q = 0; q < 4; ++q) { const int id = tid + NT * q, f = id >> 4, e8 = (id & 15) * 8;
                *(u32x4*)(Wr + f * 136 + e8) = *(const u32x4*)(WLR + ((size_t)((z * 2 + 0) * 8 + n) * 128 + f) * 128 + e8); *(u32x4*)(Wi + f * 136 + e8) = *(const u32x4*)(WLR + ((size_t)((z * 2 + 1) * 8 + n) * 128 + f) * 128 + e8); }
            SYNCTHREADS();
            f32x4 ar[4], ai[4];
#pragma unroll
            for (int nt = 0; nt < 4; ++nt) { ar[nt] = (f32x4){0.f, 0.f, 0.f, 0.f}; ai[nt] = (f32x4){0.f, 0.f, 0.f, 0.f}; }
            wave_mma<4, 4>(ar, Xs + rt * 16 * 136, 136, Wr + hf * 64 * 136, 136);
            wave_mma<4, 4>(ai, Xs + rt * 16 * 136, 136, Wi + hf * 64 * 136, 136);
            SYNCTHREADS();
            const int tl = rt * 16 + fr;
#pragma unroll
            for (int nt = 0; nt < 4; ++nt) { const int f = 64 * hf + 16 * nt + 4 * fq, ch = n * 128 + f;
                const f32x4 brv = *(const f32x4*)(br + z * W + ch), biv = *(const f32x4*)(bi + z * W + ch), lmv = *(const f32x4*)(spl + z * 128 + f), xcv = ld_bf4(Xs + tl * 136 + f); f32x4 av, uv, lav;
#pragma unroll
                for (int e = 0; e < 4; ++e) { const float r = sigmoidf_(ar[nt][e] + brv[e]), ig = sigmoidf_(ai[nt][e] + biv[e]), la = -8.f * r * lmv[e]; const float a = fexp_(la); av[e] = a; lav[e] = la; uv[e] = sqrtf(fmaxf(1.f - a * a, 0.f)) * ig * xcv[e]; }
                *(f32x4*)(AUa + tl * 128 + f) = av; *(f32x4*)(AUu + tl * 128 + f) = uv;
                if (PASS == 1) { u32x4 pk;
#pragma unroll
                    for (int e = 0; e < 4; ++e) pk[e] = pk2(lav[e], uv[e]);
                    *(u32x4*)(LAU + ((size_t)z * T + t0 + tl) * W + ch) = pk; } }
            SYNCTHREADS();
            if (tid < 128) { const int f = tid; const size_t ci = (((size_t)z * NB + b) * NLC + chk) * W + n * 128 + f;
                if (PASS == 1) { float prod = 1.f, h = 0.f;
#pragma unroll 8
                    for (int q = 0; q < 64; ++q) { const int sI = z == 0 ? q : 63 - q; const float a = AUa[sI * 128 + f]; h = a * h + AUu[sI * 128 + f]; prod *= a; }
                    CA[ci] = prod; CH[ci] = h;
                } else { float h = CI[ci];
                    if (z == 0) {
#pragma unroll 8
                        for (int q = 0; q < 64; ++q) { h = AUa[q * 128 + f] * h + AUu[q * 128 + f]; HF[q * 128 + f] = h; }
                    } else {
#pragma unroll 8
                        for (int q = 63; q >= 0; --q) { h = AUa[q * 128 + f] * h + AUu[q * 128 + f]; HF[q * 128 + f] += h; } } }
            }
            SYNCTHREADS();
        }
        if (PASS == 2) {
#pragma unroll
            for (int q = 0; q < 4; ++q) { const int id = tid + NT * q, tl = id >> 5, f4 = (id & 31) * 4; const long t = t0 + tl; f32x4 hv = *(const f32x4*)(HF + tl * 128 + f4); const f32x4 gv = ld_bf4(P + (size_t)t * PW + C_LG + n * 128 + f4);
#pragma unroll
                for (int e = 0; e < 4; ++e) hv[e] *= geluf_(gv[e]);
                st_bf4(Y + (size_t)t * 4 * W + 0 * W + n * 128 + f4, hv); }
            SYNCTHREADS();
        }
    }
}
__device__ __forceinline__ void ph_lru_fin(const Ctx& c, float* ldsf) {
    const bf16_t* P = WSH(O_P); const unsigned* LAU = (const unsigned*)(c.ws + O_LA); const float* CI = WSF(O_LCI); bf16_t* Y = WSH(O_YS);
    unsigned* Lz = (unsigned*)ldsf; float* Hz = ldsf + 2 * 64 * 128; const int tid = threadIdx.x;
    for (int u = blockIdx.x; u < (T / 64) * 8; u += gridDim.x) {
        const int n = u & 7, tile = u >> 3, b = tile / NLC, chk = tile % NLC; const long t0 = (long)tile * 64;
#pragma unroll
        for (int q = 0; q < 8; ++q) { const int id = tid + NT * q, z = id >> 11, r = (id >> 5) & 63, c4 = (id & 31) * 4; *(u32x4*)(Lz + z * 8192 + r * 128 + c4) = *(const u32x4*)(LAU + ((size_t)z * T + t0 + r) * W + n * 128 + c4); }
        SYNCTHREADS();
        if (tid < 256) { const int z = tid >> 7, f = tid & 127; float h = CI[(((size_t)z * NB + b) * NLC + chk) * W + n * 128 + f]; const unsigned* lp = Lz + z * 8192 + f; float* hp = Hz + z * 8192 + f;
#pragma unroll 8
            for (int q = 0; q < 64; ++q) { const int sI = z == 0 ? q : 63 - q; const unsigned w = lp[sI * 128]; h = fexp_(bflo(w)) * h + bfhi(w); hp[sI * 128] = h; } }
        SYNCTHREADS();
#pragma unroll
        for (int q = 0; q < 4; ++q) { const int id = tid + NT * q, r = id >> 5, f4 = (id & 31) * 4; const long t = t0 + r; f32x4 o = *(const f32x4*)(Hz + r * 128 + f4) + *(const f32x4*)(Hz + 8192 + r * 128 + f4); const f32x4 gv = ld_bf4(P + (size_t)t * PW + C_LG + n * 128 + f4);
#pragma unroll
            for (int e = 0; e < 4; ++e) o[e] *= geluf_(gv[e]);
            st_bf4(Y + (size_t)t * 4 * W + 0 * W + n * 128 + f4, o); }
        SYNCTHREADS();
    }
}
__device__ __forceinline__ void ph_lru_scan2(const Ctx& c) {
    const float* CA = WSF(O_LCA); const float* CH = WSF(O_LCH); float* CI = WSF(O_LCI);
    for (long i = GT_; i < (long)2 * NB * W; i += GS_) {
        const int w = (int)(i % W), b = (int)((i / W) % NB), z = (int)(i / ((long)W * NB)); float carry = 0.f;
#pragma unroll 16
        for (int q = 0; q < NLC; ++q) { const int ch = z == 0 ? q : NLC - 1 - q; const size_t idx = (((size_t)z * NB + b) * NLC + ch) * W + w; CI[idx] = carry; carry = CA[idx] * carry + CH[idx]; }
    }
}
__device__ __forceinline__ void ph_rope_table(const Ctx& c) {
    const int* pos = (const int*)c.in[2]; float* RT = WSF(O_ROPE);
    for (long i = GT_; i < (long)T * 32; i += GS_) { const int j = (int)(i & 31); const float ang = (float)pos[i >> 5] * powf(10000.f, -(float)(2 * j) / 64.f); RT[i * 2] = cosf(ang); RT[i * 2 + 1] = sinf(ang); }
}
__device__ __forceinline__ void ret_tables(float* tab, int h) {
    const int tid = threadIdx.x; const float lg = loggamma_(h);
    if (tid < 32) tab[tid] = powf(10000.f, -(float)(2 * tid) / 64.f);
    if (tid >= 64 && tid < 64 + 129) tab[tid] = expf((float)(tid - 64) * lg);
}
__device__ __forceinline__ void ph_ret_kv(const Ctx& c, float* ldsf) {
    const float* RT = WSF(O_ROPE); const bf16_t* P = WSH(O_P); float* KVF = WSF(O_KVF); float* KVB = WSF(O_KVB);
    bf16_t* VT = (bf16_t*)ldsf; bf16_t* KF = VT + 128 * 136; bf16_t* KB = KF + 64 * 136; float* tab = (float*)(KB + 64 * 136);
    const int tid = threadIdx.x, wv = tid >> 6, lane = tid & 63, fr = lane & 15, fq = lane >> 4;
    for (int u = blockIdx.x; u < (T / 128) * 8; u += gridDim.x) {
        const int h = u & 7; const long t0 = (long)(u >> 3) * 128;
        ret_tables(tab, h);
        SYNCTHREADS();
        { float x1[8], x2[8];
#pragma unroll
          for (int q = 0; q < 8; ++q) { const int id = tid + NT * q, j = id & 127, dj = id >> 7; const bf16_t* prow = P + (size_t)(t0 + j) * PW + C_RK + h * 64; x1[q] = bf2f(prow[dj]); x2[q] = bf2f(prow[dj + 32]); }
#pragma unroll 1
          for (int q = 0; q < 8; ++q) { const int id = tid + NT * q, j = id & 127, dj = id >> 7; const float cs = RT[((size_t)(t0 + j) * 32 + dj) * 2], sn = RT[((size_t)(t0 + j) * 32 + dj) * 2 + 1];
            const float k1 = x1[q] * cs - x2[q] * sn, k2 = x2[q] * cs + x1[q] * sn, fj = tab[64 + 127 - j], bj = tab[64 + j];
            KF[dj * 136 + j] = (bf16_t)f2bf(k1 * fj); KF[(dj + 32) * 136 + j] = (bf16_t)f2bf(k2 * fj); KB[dj * 136 + j] = (bf16_t)f2bf(k1 * bj); KB[(dj + 32) * 136 + j] = (bf16_t)f2bf(k2 * bj); } }
#pragma unroll
        for (int q = 0; q < 4; ++q) { const int id = tid + NT * q, j = id & 127, e8 = (id >> 7) * 8; const u32x4 raw = *(const u32x4*)(P + (size_t)(t0 + j) * PW + C_RV + h * 128 + e8);
#pragma unroll
            for (int e = 0; e < 4; ++e) { VT[(e8 + 2 * e) * 136 + j] = (bf16_t)(raw[e] & 0xffffu); VT[(e8 + 2 * e + 1) * 136 + j] = (bf16_t)(raw[e] >> 16); } }
        SYNCTHREADS();
        f32x4 af[4], ab[4];
#pragma unroll
        for (int nt = 0; nt < 4; ++nt) { af[nt] = (f32x4){0.f, 0.f, 0.f, 0.f}; ab[nt] = (f32x4){0.f, 0.f, 0.f, 0.f}; }
        wave_mma<4, 4>(af, VT + wv * 16 * 136, 136, KF, 136);
        wave_mma<4, 4>(ab, VT + wv * 16 * 136, 136, KB, 136);
        const size_t ob = (((size_t)(u >> 3) * 8 + h) * 128 + wv * 16 + fr) * 64 + 4 * fq;
#pragma unroll
        for (int nt = 0; nt < 4; ++nt) { *(f32x4*)(KVF + ob + 16 * nt) = af[nt]; *(f32x4*)(KVB + ob + 16 * nt) = ab[nt]; }
        SYNCTHREADS();
    }
}
__device__ __forceinline__ void ph_ret_state(const Ctx& c) {
    const float* KVF = WSF(O_KVF); const float* KVB = WSF(O_KVB); float* STF = WSF(O_STF); float* STB = WSF(O_STB);
    for (long i = GT_; i < (long)NB * 8 * 8192; i += GS_) {
        const int x = (int)(i % 8192), h = (int)((i / 8192) % 8), b = (int)(i / 65536);
        const float cd = expf(128.f * loggamma_(h)); float st = 0.f;
#pragma unroll 16
        for (int n = 0; n < NCH; ++n) { const size_t idx = (((size_t)b * NCH + n) * 8 + h) * 8192 + x; STF[idx] = st; st = cd * st + KVF[idx]; }
        st = 0.f;
#pragma unroll 16
        for (int n = NCH - 1; n >= 0; --n) { const size_t idx = (((size_t)b * NCH + n) * 8 + h) * 8192 + x; STB[idx] = st; st = cd * st + KVB[idx]; }
    }
}
__device__ __forceinline__ void ph_ret_out(const Ctx& c, float* ldsf) {
    const float* RT = WSF(O_ROPE); const bf16_t* P = WSH(O_P); const float* STF = WSF(O_STF); const float* STB = WSF(O_STB); bf16_t* Y = WSH(O_YS);
    bf16_t* Qs = (bf16_t*)ldsf; bf16_t* Ks = Qs + 128 * 72; bf16_t* VT = Ks + 128 * 72; bf16_t* Ss = VT + 128 * 136; bf16_t* SF = Ss + 128 * 136; bf16_t* SB = SF + 128 * 72; float* tab = (float*)(SB + 128 * 72);
    const int tid = threadIdx.x, wv = tid >> 6, lane = tid & 63, fr = lane & 15, fq = lane >> 4;
    for (int u = blockIdx.x; u < (T / 128) * 8; u += gridDim.x) {
        const int h = u & 7; const long t0 = (long)(u >> 3) * 128;
        ret_tables(tab, h);
        SYNCTHREADS();
#pragma unroll 1
        for (int qh = 0; qh < 8; qh += 4) { float q1[4], q2[4], k1[4], k2[4];
#pragma unroll
          for (int q = 0; q < 4; ++q) { const int id = tid + NT * (qh + q), j = id >> 5, dj = id & 31; const bf16_t* prow = P + (size_t)(t0 + j) * PW;
            q1[q] = bf2f(prow[C_RQ + h * 64 + dj]); q2[q] = bf2f(prow[C_RQ + h * 64 + dj + 32]); k1[q] = bf2f(prow[C_RK + h * 64 + dj]); k2[q] = bf2f(prow[C_RK + h * 64 + dj + 32]); }
#pragma unroll
          for (int q = 0; q < 4; ++q) { const int id = tid + NT * (qh + q), j = id >> 5, dj = id & 31; const float cs = RT[((size_t)(t0 + j) * 32 + dj) * 2], sn = RT[((size_t)(t0 + j) * 32 + dj) * 2 + 1];
            Qs[j * 72 + dj] = (bf16_t)f2bf((q1[q] * cs - q2[q] * sn) * 0.125f); Qs[j * 72 + dj + 32] = (bf16_t)f2bf((q2[q] * cs + q1[q] * sn) * 0.125f); Ks[j * 72 + dj] = (bf16_t)f2bf(k1[q] * cs - k2[q] * sn); Ks[j * 72 + dj + 32] = (bf16_t)f2bf(k2[q] * cs + k1[q] * sn); } }
#pragma unroll
        for (int q = 0; q < 4; ++q) { const int id = tid + NT * q, j = id & 127, e8 = (id >> 7) * 8; const u32x4 raw = *(const u32x4*)(P + (size_t)(t0 + j) * PW + C_RV + h * 128 + e8);
#pragma unroll
            for (int e = 0; e < 4; ++e) { VT[(e8 + 2 * e) * 136 + j] = (bf16_t)(raw[e] & 0xffffu); VT[(e8 + 2 * e + 1) * 136 + j] = (bf16_t)(raw[e] >> 16); } }
        const size_t sbase = (((size_t)(u >> 3) * 8 + h)) * 8192;
#pragma unroll
        for (int q = 0; q < 4; ++q) { const int id = tid + NT * q, e = id >> 4, d4 = (id & 15) * 4; st_bf4(SF + e * 72 + d4, *(const f32x4*)(STF + sbase + (size_t)e * 64 + d4)); st_bf4(SB + e * 72 + d4, *(const f32x4*)(STB + sbase + (size_t)e * 64 + d4)); }
        SYNCTHREADS();
        const int i = wv * 16 + fr; const long t = t0 + i;
        {
            f32x4 sc[8];
#pragma unroll
            for (int nt = 0; nt < 8; ++nt) sc[nt] = (f32x4){0.f, 0.f, 0.f, 0.f};
            wave_mma<2, 8>(sc, Qs + wv * 16 * 72, 72, Ks, 72);
#pragma unroll
            for (int nt = 0; nt < 8; ++nt) { const int j0 = 16 * nt + 4 * fq; f32x4 sv;
#pragma unroll
                for (int e = 0; e < 4; ++e) { const int j = j0 + e, dist = i > j ? i - j : j - i; sv[e] = sc[nt][e] * tab[64 + dist]; }
                st_bf4(Ss + i * 136 + j0, sv); }
        }
#ifdef CPU_EMU
        SYNCTHREADS();
#else
        asm volatile("s_waitcnt lgkmcnt(0)" ::: "memory");
#endif
        f32x4 ao[8], tm[8];
#pragma unroll
        for (int nt = 0; nt < 8; ++nt) { ao[nt] = (f32x4){0.f, 0.f, 0.f, 0.f}; tm[nt] = (f32x4){0.f, 0.f, 0.f, 0.f}; }
        wave_mma<4, 8>(ao, Ss + wv * 16 * 136, 136, VT, 136);
        wave_mma<2, 8>(tm, Qs + wv * 16 * 72, 72, SF, 72);
        { const float qf = tab[64 + i + 1];
#pragma unroll
            for (int nt = 0; nt < 8; ++nt) { ao[nt] += tm[nt] * qf; tm[nt] = (f32x4){0.f, 0.f, 0.f, 0.f}; } }
        wave_mma<2, 8>(tm, Qs + wv * 16 * 72, 72, SB, 72);
        { const float qb = tab[64 + 128 - i];
#pragma unroll
            for (int nt = 0; nt < 8; ++nt) ao[nt] += tm[nt] * qb; }
        float sm = 0.f;
#pragma unroll
        for (int nt = 0; nt < 8; ++nt) sm += (ao[nt][0] + ao[nt][1]) + (ao[nt][2] + ao[nt][3]);
        sm += SHFL_XOR(sm, 16); sm += SHFL_XOR(sm, 32);
        const float mu = sm * (1.f / 128.f); float sq = 0.f;
#pragma unroll
        for (int nt = 0; nt < 8; ++nt) { ao[nt] -= mu; sq += (ao[nt][0] * ao[nt][0] + ao[nt][1] * ao[nt][1]) + (ao[nt][2] * ao[nt][2] + ao[nt][3] * ao[nt][3]); }
        sq += SHFL_XOR(sq, 16); sq += SHFL_XOR(sq, 32);
        const float rs = 1.f / sqrtf(sq * (1.f / 128.f) + EPS);
#pragma unroll
        for (int nt = 0; nt < 8; ++nt) { const int e0 = 16 * nt + 4 * fq; f32x4 gv = ld_bf4(P + (size_t)t * PW + C_RG + h * 128 + e0);
#pragma unroll
            for (int e = 0; e < 4; ++e) gv[e] = siluf_(gv[e]) * (ao[nt][e] * rs);
            st_bf4(Y + (size_t)t * 4 * W + 1 * W + h * 128 + e0, gv); }
        SYNCTHREADS();
    }
}
__device__ __forceinline__ void ph_sgu_norm(const Ctx& c, int l) {
    const bf16_t* P = WSH(O_P); float* ST = WSF(O_VN);
    const int lane = threadIdx.x & 63, gw = blockIdx.x * (NT / 64) + (threadIdx.x >> 6), ngw = gridDim.x * (NT / 64);
    for (int t = gw; t < T; t += ngw) {
        f32x4 v[4]; float sm = 0.f;
#pragma unroll
        for (int j = 0; j < 4; ++j) { v[j] = ld_bf4(P + (size_t)t * PW + C_SV + (j * 64 + lane) * 4);
#pragma unroll
            for (int q = 0; q < 4; ++q) { v[j][q] = geluf_(v[j][q]); sm += v[j][q]; } }
        const float mu = wave_sum(sm) * (1.f / W); float sq = 0.f;
#pragma unroll
        for (int j = 0; j < 4; ++j)
#pragma unroll
            for (int q = 0; q < 4; ++q) { const float dd = v[j][q] - mu; sq += dd * dd; }
        const float rs = 1.f / sqrtf(wave_sum(sq) * (1.f / W) + EPS);
        if (lane == 0) { ST[(size_t)t * 2] = mu; ST[(size_t)t * 2 + 1] = rs; }
    }
}
__device__ __forceinline__ void ph_sgu_mix(const Ctx& c, int l, float* ldsf) {
    const bf16_t* P = WSH(O_P); const float* ST = WSF(O_VN); bf16_t* Y = WSH(O_YS); const float* ng = c.in[15] + (size_t)l * W;
    bf16_t* As = (bf16_t*)ldsf; bf16_t* Bs = As + 128 * 136; const int tid = threadIdx.x, wv = tid >> 6, lane = tid & 63, fr = lane & 15, fq = lane >> 4;
    for (int u = blockIdx.x; u < (T / 128) * 8; u += gridDim.x) {
        const int g = u & 7; const long t0 = (long)(u >> 3) * 128;
        const float* ws = c.in[16] + ((size_t)l * 8 + g) * 128 * 128; const float* bs = c.in[17] + ((size_t)l * 8 + g) * 128;
#pragma unroll
        for (int q = 0; q < 8; ++q) { const int id = tid + NT * q, i = id >> 5, j4 = (id & 31) * 4; st_bf4(As + i * 136 + j4, *(const f32x4*)(ws + i * 128 + j4)); }
#pragma unroll
        for (int q = 0; q < 4; ++q) { const int id = tid + NT * q, j = id & 127, d8 = (id >> 7) * 8; const float mu = ST[(size_t)(t0 + j) * 2], rs = ST[(size_t)(t0 + j) * 2 + 1];
            const u32x4 raw = *(const u32x4*)(P + (size_t)(t0 + j) * PW + C_SV + g * 128 + d8);
#pragma unroll
            for (int e = 0; e < 4; ++e) { const float v0 = (geluf_(bflo(raw[e])) - mu) * rs * ng[g * 128 + d8 + 2 * e], v1 = (geluf_(bfhi(raw[e])) - mu) * rs * ng[g * 128 + d8 + 2 * e + 1];
                Bs[(d8 + 2 * e) * 136 + j] = (bf16_t)f2bf(v0); Bs[(d8 + 2 * e + 1) * 136 + j] = (bf16_t)f2bf(v1); } }
        SYNCTHREADS();
        f32x4 acc[8];
#pragma unroll
        for (int nt = 0; nt < 8; ++nt) acc[nt] = (f32x4){0.f, 0.f, 0.f, 0.f};
        wave_mma<4, 8>(acc, As + wv * 16 * 136, 136, Bs, 136);
        const int i = wv * 16 + fr; const long t = t0 + i; const float bsi = bs[i];
#pragma unroll
        for (int nt = 0; nt < 8; ++nt) { const int d = 16 * nt + 4 * fq; f32x4 uu = ld_bf4(P + (size_t)t * PW + C_SU + g * 128 + d);
#pragma unroll
            for (int e = 0; e < 4; ++e) uu[e] = geluf_(uu[e]) * (acc[nt][e] + bsi);
            st_bf4(Y + (size_t)t * 4 * W + 2 * W + g * 128 + d, uu); }
        SYNCTHREADS();
    }
}
__device__ __forceinline__ void ph_rw_shift(const Ctx& c, int l) {
    const bf16_t* P = WSH(O_P); const float* mup = c.in[18] + (size_t)l * RF; const float* mun = c.in[19] + (size_t)l * RF; bf16_t* FS = WSH(O_FS);
    const int lane = threadIdx.x & 63, gw = blockIdx.x * (NT / 64) + (threadIdx.x >> 6), ngw = gridDim.x * (NT / 64);
    for (int t = gw; t < T; t += ngw) {
        const int sI = t % S; const bf16_t* pc = P + (size_t)t * PW + C_RW;
#pragma unroll 2
        for (int j = lane * 4; j < RF; j += 256) {
            const f32x4 f = ld_bf4(pc + j), z4 = (f32x4){0.f, 0.f, 0.f, 0.f}; const f32x4 pv = sI > 0 ? ld_bf4(pc - PW + j) : z4, nv = sI < S - 1 ? ld_bf4(pc + PW + j) : z4;
            f32x4 v = f + *(const f32x4*)(mup + j) * (pv - f) + *(const f32x4*)(mun + j) * (nv - f);
            if (j >= 3072 && j < 3200) {
#pragma unroll
                for (int e = 0; e < 4; ++e) v[e] = tanhf_(v[e]); }
            else if (j >= 3328) {
#pragma unroll
                for (int e = 0; e < 4; ++e) v[e] = sigmoidf_(v[e]); }
            st_bf4(FS + (size_t)t * RF + j, v);
        }
    }
}
__device__ __forceinline__ void ph_rw_lora(const Ctx& c, int l, float* ldsf) {
    const bf16_t* FS = WSH(O_FS); const float* w0 = c.in[20] + (size_t)l * 2 * W; const float* a0 = c.in[22] + (size_t)l * 2 * W;
    const bf16_t* WUT = WSH(O_WUT); const bf16_t* WAT = WSH(O_WAT); const bf16_t* WGT = WSH(O_WGT);
    bf16_t* DEC = WSH(O_DEC); bf16_t* AA = WSH(O_AA); bf16_t* GG = WSH(O_GG);
    bf16_t* F = (bf16_t*)ldsf; bf16_t* B1 = F + 128 * 136; bf16_t* B2 = B1 + 128 * 136; const int tid = threadIdx.x, wv = tid >> 6, lane = tid & 63, fr = lane & 15, fq = lane >> 4;
    for (int u = blockIdx.x; u < (T / 128) * 8; u += gridDim.x) {
        const int wc0 = (u & 7) * 128; const long t0 = (long)(u >> 3) * 128;
        for (int rd = 0; rd < 3; ++rd) {
#pragma unroll
            for (int q = 0; q < 8; ++q) { const int id = tid + NT * q, r = id >> 5, c4 = (id & 31) * 4;
                const int col = rd < 2 ? (c4 < 64 ? 3072 + rd * 64 + c4 : 3200 + rd * 64 + (c4 - 64)) : 3328 + c4;
                *(unsigned long long*)(F + r * 136 + c4) = *(const unsigned long long*)(FS + (size_t)(t0 + r) * RF + col); }
            if (rd < 2) {
#pragma unroll
                for (int q = 0; q < 2; ++q) { const int id = tid + NT * q, w = id >> 3, r8 = (id & 7) * 8;
                    *(u32x4*)(B1 + w * 72 + r8) = *(const u32x4*)(WUT + ((size_t)rd * W + wc0 + w) * 64 + r8); *(u32x4*)(B2 + w * 72 + r8) = *(const u32x4*)(WAT + ((size_t)rd * W + wc0 + w) * 64 + r8); }
            } else {
#pragma unroll
                for (int q = 0; q < 4; ++q) { const int id = tid + NT * q, w = id >> 4, r8 = (id & 15) * 8; *(u32x4*)(B1 + w * 136 + r8) = *(const u32x4*)(WGT + ((size_t)wc0 + w) * 128 + r8); }
            }
            SYNCTHREADS();
            f32x4 a1[8], a2[8];
#pragma unroll
            for (int nt = 0; nt < 8; ++nt) { a1[nt] = (f32x4){0.f, 0.f, 0.f, 0.f}; a2[nt] = (f32x4){0.f, 0.f, 0.f, 0.f}; }
            const long t = t0 + wv * 16 + fr;
            if (rd < 2) {
                wave_mma<2, 8>(a1, F + wv * 16 * 136, 136, B1, 72);
                wave_mma<2, 8>(a2, F + wv * 16 * 136 + 64, 136, B2, 72);
#pragma unroll
                for (int nt = 0; nt < 8; ++nt) { const int ch = wc0 + 16 * nt + 4 * fq; const f32x4 w0v = *(const f32x4*)(w0 + rd * W + ch), a0v = *(const f32x4*)(a0 + rd * W + ch); f32x4 dv, av;
#pragma unroll
                    for (int e = 0; e < 4; ++e) { dv[e] = fexp_(-DECAY_SCALE * sigmoidf_(a1[nt][e] + w0v[e])); av[e] = sigmoidf_(a2[nt][e] + a0v[e]); }
                    st_bf4(DEC + ((size_t)rd * T + t) * W + ch, dv); st_bf4(AA + ((size_t)rd * T + t) * W + ch, av); }
            } else {
                wave_mma<4, 8>(a1, F + wv * 16 * 136, 136, B1, 136);
#pragma unroll
                for (int nt = 0; nt < 8; ++nt) st_bf4(GG + (size_t)t * W + wc0 + 16 * nt + 4 * fq, a1[nt]);
            }
            SYNCTHREADS();
        }
    }
}
#ifdef CPU_EMU
__device__ __forceinline__ float red16_(float x) { x += SHFL_XOR(x, 1); x += SHFL_XOR(x, 2); x += SHFL_XOR(x, 4); x += SHFL_XOR(x, 8); return x; }
#define LDS_BARRIER() emu_syncthreads()
#else
__device__ __forceinline__ float red16_(float x) {
    x += __builtin_bit_cast(float, __builtin_amdgcn_update_dpp(0, __builtin_bit_cast(int, x), 0xB1, 0xF, 0xF, true));
    x += __builtin_bit_cast(float, __builtin_amdgcn_update_dpp(0, __builtin_bit_cast(int, x), 0x4E, 0xF, 0xF, true));
    x += __builtin_bit_cast(float, __builtin_amdgcn_update_dpp(0, __builtin_bit_cast(int, x), 0x141, 0xF, 0xF, true));
    x += __builtin_bit_cast(float, __builtin_amdgcn_update_dpp(0, __builtin_bit_cast(int, x), 0x140, 0xF, 0xF, true));
    return x;
}
#define LDS_BARRIER() do { asm volatile("s_waitcnt lgkmcnt(0)" ::: "memory"); __builtin_amdgcn_s_barrier(); asm volatile("" ::: "memory"); } while (0)
#endif
#define RC_M(k) (lm + (k) * 4608)
__device__ __forceinline__ void ph_rw_chunk(const Ctx& c, int l, float* ldsf) {
    const bf16_t* FS = WSH(O_FS); const bf16_t* DEC = WSH(O_DEC); const bf16_t* AA = WSH(O_AA); float* BON = WSF(O_BON);
    const float* kkw = c.in[25] + (size_t)l * W; const float* kaw = c.in[26] + (size_t)l * W; const float* rk = c.in[27] + (size_t)l * W;
    bf16_t* PST = WSH(O_PST); bf16_t* PYT = WSH(O_PYT); bf16_t* SVB = WSH(O_SVB); bf16_t* YVB = WSH(O_YVB);
    bf16_t* lm = (bf16_t*)ldsf; float* gam = (float*)RC_M(7); float* segp = (float*)RC_M(13); float* gl = segp + 512;
    const int tid = threadIdx.x, wv = tid >> 6, lane = tid & 63, fr = lane & 15, fq = lane >> 4, rt = wv & 3, hf = wv >> 2;
    const int m0 = 16 * rt + fr;
    float wv8[8], kv8[8], rv8[8], vv8[8], aa8[8];
#define RC_LOAD(uu) do { const int chain_ = (uu) / NRC, ck_ = (uu) % NRC, h_ = chain_ & 15, b_ = (chain_ >> 4) & 1, z_ = chain_ >> 5; \
        const long tb_ = (long)b_ * S + (z_ ? S - 1 - ck_ * RCK : ck_ * RCK); const int dirn_ = z_ ? -1 : 1; \
        const bf16_t* decp_ = DEC + ((size_t)z_ * T) * W + h_ * 64; const bf16_t* aap_ = AA + ((size_t)z_ * T) * W + h_ * 64; const int ch_ = h_ * 64 + lane; \
        _Pragma("unroll") for (int q = 0; q < 8; ++q) wv8[q] = bf2f(decp_[(size_t)(tb_ + dirn_ * ((tid >> 6) * 8 + q)) * W + (tid & 63)]); \
        _Pragma("unroll") for (int q = 0; q < 8; ++q) { const long t_ = tb_ + dirn_ * (wv + 8 * q); const bf16_t* f_ = FS + (size_t)t_ * RF; kv8[q] = bf2f(f_[1024 + ch_]); rv8[q] = bf2f(f_[ch_]); vv8[q] = bf2f(f_[2048 + ch_]); aa8[q] = bf2f(aap_[(size_t)t_ * W + lane]); } } while (0)
    if ((int)blockIdx.x < 64 * NRC) RC_LOAD((int)blockIdx.x);
    for (int u = blockIdx.x; u < 64 * NRC; u += gridDim.x) {
        const int chain = u / NRC, ck = u % NRC, h = chain & 15, b = (chain >> 4) & 1, z = chain >> 5;
        const long tb = (long)b * S + (z ? S - 1 - ck * RCK : ck * RCK); const int dirn = z ? -1 : 1;
        { const int k = tid & 63, sg = tid >> 6; float p = 1.f;
#pragma unroll
          for (int q = 0; q < 8; ++q) { p *= wv8[q]; gam[(sg * 8 + q) * 64 + k] = p; }
          segp[sg * 64 + k] = p; }
        LDS_BARRIER();
        { const int k = tid & 63, sg = tid >> 6; float pre = 1.f;
          for (int q = 0; q < sg; ++q) pre *= segp[q * 64 + k];
#pragma unroll
          for (int q = 0; q < 8; ++q) gam[(sg * 8 + q) * 64 + k] *= pre;
          if (sg == 7) gl[k] = gam[63 * 64 + k]; }
        LDS_BARRIER();
        { const int k = lane, ch = h * 64 + k; const float kkwv = kkw[ch], kav = kaw[ch], rkv = rk[ch];
#pragma unroll
          for (int q = 0; q < 8; ++q) { const int tt = wv + 8 * q; const long t = tb + dirn * tt;
            const float vk = kv8[q] * kkwv; const float kkn = vk * frsq_(wave_sum(vk * vk) + EPS); const float ktv = kv8[q] * (1.f + (aa8[q] - 1.f) * kav);
            const float bsum = wave_sum(rv8[q] * rkv * ktv); if (lane == 0) BON[((size_t)z * T + t) * 16 + h] = bsum;
            const float g = gam[tt * 64 + k], gp = tt ? gam[(tt - 1) * 64 + k] : 1.f, ig = frcp_(g);
            const bf16_t khv = (bf16_t)f2bf(kkn * gp), bhv = (bf16_t)f2bf(aa8[q] * kkn * ig);
            RC_M(0)[tt * 72 + k] = khv; RC_M(1)[k * 72 + tt] = khv; RC_M(2)[tt * 72 + k] = bhv; RC_M(3)[k * 72 + tt] = bhv;
            RC_M(4)[tt * 72 + k] = (bf16_t)f2bf(ktv * ig); RC_M(5)[tt * 72 + k] = (bf16_t)f2bf(rv8[q] * g); RC_M(6)[k * 72 + tt] = (bf16_t)f2bf(vv8[q]); } }
        if (u + (int)gridDim.x < 64 * NRC) RC_LOAD(u + (int)gridDim.x);
        LDS_BARRIER();
        f32x4 mkr[2], khr[2], rhT[2];
        {
            f32x4 a0[2], a1[2], a2[2], a3[2];
#pragma unroll
            for (int nt = 0; nt < 2; ++nt) { a0[nt] = (f32x4){0.f, 0.f, 0.f, 0.f}; a1[nt] = a0[nt]; a2[nt] = a0[nt]; a3[nt] = a0[nt]; }
            wave_mma<2, 2>(a0, RC_M(2) + rt * 16 * 72, 72, RC_M(0) + hf * 32 * 72, 72);
            wave_mma<2, 2>(a1, RC_M(4) + rt * 16 * 72, 72, RC_M(0) + hf * 32 * 72, 72);
            wave_mma<2, 2>(a2, RC_M(2) + rt * 16 * 72, 72, RC_M(5) + hf * 32 * 72, 72);
            wave_mma<2, 2>(a3, RC_M(4) + rt * 16 * 72, 72, RC_M(5) + hf * 32 * 72, 72);
#pragma unroll
            for (int nt = 0; nt < 2; ++nt) { const int n0 = 32 * hf + 16 * nt + 4 * fq; f32x4 nn, ti, mk;
#pragma unroll
                for (int r = 0; r < 4; ++r) { const int n = n0 + r; const bool lt = m0 < n, le = m0 <= n;
                    nn[r] = lt ? -a0[nt][r] : 0.f; ti[r] = nn[r] + (m0 == n ? 1.f : 0.f); mk[r] = lt ? a1[nt][r] : 0.f; mkr[nt][r] = le ? a3[nt][r] : 0.f;
                    RC_M(12)[n * 72 + m0] = (bf16_t)f2bf(le ? a2[nt][r] : 0.f);
                    RC_M(8)[n * 72 + m0] = (bf16_t)f2bf(nn[r]);
                    khr[nt][r] = bf2f(RC_M(4)[m0 * 72 + n]); rhT[nt][r] = bf2f(RC_M(5)[n * 72 + m0]); }
                st_bf4(RC_M(7) + m0 * 72 + n0, nn); st_bf4(RC_M(9) + m0 * 72 + n0, ti); st_bf4(RC_M(11) + m0 * 72 + n0, mk); }
        }
        LDS_BARRIER();
        f32x4 tiv[2];
#pragma unroll
        for (int nt = 0; nt < 2; ++nt) tiv[nt] = ld_bf4(RC_M(9) + m0 * 72 + 32 * hf + 16 * nt + 4 * fq);
#pragma unroll 1
        for (int it = 0; it < 5; ++it) {
            bf16_t* pw = (it & 1) ? RC_M(0) : RC_M(7); bf16_t* pwT = (it & 1) ? RC_M(2) : RC_M(8); bf16_t* pw2 = (it & 1) ? RC_M(7) : RC_M(0); bf16_t* pw2T = (it & 1) ? RC_M(8) : RC_M(2);
            bf16_t* tcur = (it & 1) ? RC_M(4) : RC_M(9); bf16_t* tnxt = (it & 1) ? RC_M(9) : RC_M(4);
            f32x4 sq[2];
#pragma unroll
            for (int nt = 0; nt < 2; ++nt) sq[nt] = (f32x4){0.f, 0.f, 0.f, 0.f};
            wave_mma<2, 2>(sq, pw + rt * 16 * 72, 72, pwT + hf * 32 * 72, 72);
#pragma unroll
            for (int nt = 0; nt < 2; ++nt) { const int n0 = 32 * hf + 16 * nt + 4 * fq; st_bf4(pw2 + m0 * 72 + n0, sq[nt]);
#pragma unroll
                for (int r = 0; r < 4; ++r) pw2T[(n0 + r) * 72 + m0] = (bf16_t)f2bf(sq[nt][r]); }
            LDS_BARRIER();
            f32x4 up[2];
#pragma unroll
            for (int nt = 0; nt < 2; ++nt) up[nt] = (f32x4){0.f, 0.f, 0.f, 0.f};
            wave_mma<2, 2>(up, tcur + rt * 16 * 72, 72, pw2T + hf * 32 * 72, 72);
#pragma unroll
            for (int nt = 0; nt < 2; ++nt) { const int n0 = 32 * hf + 16 * nt + 4 * fq; tiv[nt] += up[nt]; st_bf4(tnxt + m0 * 72 + n0, tiv[nt]);
                if (it == 4) {
#pragma unroll
                    for (int r = 0; r < 4; ++r) RC_M(10)[(n0 + r) * 72 + m0] = (bf16_t)f2bf(tiv[nt][r]); } }
            LDS_BARRIER();
        }
        {
            f32x4 w1[2], w2[2];
#pragma unroll
            for (int nt = 0; nt < 2; ++nt) { w1[nt] = (f32x4){0.f, 0.f, 0.f, 0.f}; w2[nt] = w1[nt]; }
            wave_mma<2, 2>(w1, RC_M(1) + rt * 16 * 72, 72, RC_M(10) + hf * 32 * 72, 72);
            wave_mma<2, 2>(w2, RC_M(11) + rt * 16 * 72, 72, RC_M(10) + hf * 32 * 72, 72);
#pragma unroll
            for (int nt = 0; nt < 2; ++nt) { const int n0 = 32 * hf + 16 * nt + 4 * fq; st_bf4(RC_M(7) + m0 * 72 + n0, w1[nt]); st_bf4(RC_M(8) + m0 * 72 + n0, w2[nt]); }
        }
        LDS_BARRIER();
        {
            f32x4 py[2], qy[2], ps[2], qs[2];
#pragma unroll
            for (int nt = 0; nt < 2; ++nt) { py[nt] = (f32x4){0.f, 0.f, 0.f, 0.f}; qy[nt] = py[nt]; ps[nt] = py[nt]; qs[nt] = py[nt]; }
            wave_mma<2, 2>(py, RC_M(7) + rt * 16 * 72, 72, RC_M(12) + hf * 32 * 72, 72);
            wave_mma<2, 2>(qy, RC_M(8) + rt * 16 * 72, 72, RC_M(12) + hf * 32 * 72, 72);
            wave_mma<2, 2>(ps, RC_M(7) + rt * 16 * 72, 72, RC_M(3) + hf * 32 * 72, 72);
            wave_mma<2, 2>(qs, RC_M(8) + rt * 16 * 72, 72, RC_M(3) + hf * 32 * 72, 72);
#pragma unroll
            for (int nt = 0; nt < 2; ++nt) { const int n0 = 32 * hf + 16 * nt + 4 * fq;
#pragma unroll
                for (int r = 0; r < 4; ++r) { const int n = n0 + r; const float gln = gl[n];
                    RC_M(0)[n * 72 + m0] = (bf16_t)f2bf(rhT[nt][r] - py[nt][r]); RC_M(2)[n * 72 + m0] = (bf16_t)f2bf(mkr[nt][r] - qy[nt][r]);
                    RC_M(4)[n * 72 + m0] = (bf16_t)f2bf(((m0 == n ? 1.f : 0.f) - ps[nt][r]) * gln); RC_M(5)[n * 72 + m0] = (bf16_t)f2bf((khr[nt][r] - qs[nt][r]) * gln); } }
        }
        LDS_BARRIER();
        {
            f32x4 yv[2], sv[2];
#pragma unroll
            for (int nt = 0; nt < 2; ++nt) { yv[nt] = (f32x4){0.f, 0.f, 0.f, 0.f}; sv[nt] = yv[nt]; }
            wave_mma<2, 2>(yv, RC_M(6) + rt * 16 * 72, 72, RC_M(2) + hf * 32 * 72, 72);
            wave_mma<2, 2>(sv, RC_M(6) + rt * 16 * 72, 72, RC_M(5) + hf * 32 * 72, 72);
#pragma unroll
            for (int nt = 0; nt < 2; ++nt) { const int n0 = 32 * hf + 16 * nt + 4 * fq; st_bf4(YVB + (size_t)u * 4096 + m0 * 64 + n0, yv[nt]); st_bf4(SVB + (size_t)u * 4096 + m0 * 64 + n0, sv[nt]); }
            { const int rr = tid >> 3, c8 = (tid & 7) * 8; *(u32x4*)(PYT + (size_t)u * 4096 + rr * 64 + c8) = *(const u32x4*)(RC_M(0) + rr * 72 + c8); *(u32x4*)(PST + (size_t)u * 4096 + rr * 64 + c8) = *(const u32x4*)(RC_M(4) + rr * 72 + c8); }
        }
        LDS_BARRIER();
    }
}
#undef RC_M
#undef RC_LOAD
__device__ __forceinline__ void ph_rw_seq(const Ctx& c, float* ldsf) {
    const bf16_t* PST = WSH(O_PST); const bf16_t* PYT = WSH(O_PYT); const bf16_t* SVB = WSH(O_SVB); const bf16_t* YVB = WSH(O_YVB); bf16_t* YY = WSH(O_YY);
    bf16_t* Sb = (bf16_t*)ldsf;
    bf16_t* Pm = Sb + 2 * 16 * 72;
    const int tid = threadIdx.x, wv = tid >> 6, lane = tid & 63, fr = lane & 15, fq = lane >> 4, nt0 = wv & 3;
#ifdef CPU_EMU
    const int isY = wv >> 2;
#else
    const int isY = __builtin_amdgcn_readfirstlane(wv >> 2);
#endif
    for (int u = blockIdx.x; u < 256; u += gridDim.x) {
        const int x = u & 7, jq = u >> 3, chain = x * 8 + (jq >> 2), qt = jq & 3, h = chain & 15, b = (chain >> 4) & 1, z = chain >> 5;
        const size_t ub = (size_t)chain * NRC;
        const int rr = tid >> 3, c8 = (tid & 7) * 8;
        constexpr int PD = NRC >= 8 ? 8 : 4;
        for (int i = tid; i < 2 * 16 * 72 / 2; i += NT) ((unsigned*)Sb)[i] = 0u;
        const int row = 16 * qt + fr, n0 = 16 * nt0 + 4 * fq; const bf16_t* addp = (isY ? YVB : SVB) + ub * 4096 + row * 64 + n0;
        const bf16_t* psp = PST + ub * 4096 + rr * 64 + c8; const bf16_t* pyp = PYT + ub * 4096 + rr * 64 + c8;
        u32x4 gps[PD], gpy[PD]; unsigned long long addr[PD];
#pragma unroll
        for (int j = 0; j < PD; ++j) { gps[j] = *(const u32x4*)(psp + (size_t)j * 4096); gpy[j] = *(const u32x4*)(pyp + (size_t)j * 4096); addr[j] = *(const unsigned long long*)(addp + (size_t)j * 4096); }
        *(u32x4*)(Pm + (0 * 2 + 0) * 4608 + rr * 72 + c8) = gps[0]; *(u32x4*)(Pm + (0 * 2 + 1) * 4608 + rr * 72 + c8) = gpy[0];
        { const int cl = PD < NRC ? PD : NRC - 1; gps[0] = *(const u32x4*)(psp + (size_t)cl * 4096); gpy[0] = *(const u32x4*)(pyp + (size_t)cl * 4096); }
        SYNCTHREADS();
#define RS_LOOP(ISY) \
        for (int ck0 = 0; ck0 < NRC; ck0 += PD) { \
            _Pragma("unroll") for (int j = 0; j < PD; ++j) { \
                const int ck = ck0 + j, cur = j & 1, nxt = cur ^ 1;        \
                f32x4 acc[1]; acc[0] = (f32x4){0.f, 0.f, 0.f, 0.f}; \
                wave_mma<2, 1>(acc, Sb + cur * 16 * 72, 72, Pm + (cur * 2 + ISY) * 4608 + nt0 * 16 * 72, 72); \
                { const unsigned lo_ = (unsigned)addr[j], hi_ = (unsigned)(addr[j] >> 32); acc[0][0] += bflo(lo_); acc[0][1] += bfhi(lo_); acc[0][2] += bflo(hi_); acc[0][3] += bfhi(hi_); } \
                { const int cl = ck + PD < NRC ? ck + PD : NRC - 1; addr[j] = *(const unsigned long long*)(addp + (size_t)cl * 4096); } \
                if (ISY) { \
                    _Pragma("unroll") for (int r = 0; r < 4; ++r) { const int step = ck * RCK + n0 + r, sidx = z ? S - 1 - step : step; YY[((size_t)z * T + (size_t)b * S + sidx) * W + h * 64 + row] = (bf16_t)f2bf(acc[0][r]); } \
                } else st_bf4(Sb + nxt * 16 * 72 + fr * 72 + n0, acc[0]); \
                const int jn = (j + 1) % PD; \
                *(u32x4*)(Pm + (nxt * 2 + 0) * 4608 + rr * 72 + c8) = gps[jn]; *(u32x4*)(Pm + (nxt * 2 + 1) * 4608 + rr * 72 + c8) = gpy[jn]; \
                { const int cl = ck + 1 + PD < NRC ? ck + 1 + PD : NRC - 1; gps[jn] = *(const u32x4*)(psp + (size_t)cl * 4096); gpy[jn] = *(const u32x4*)(pyp + (size_t)cl * 4096); } \
                LDS_BARRIER(); \
            } \
        }
        if (isY) { RS_LOOP(1) } else { RS_LOOP(0) }
#undef RS_LOOP
    }
}
__device__ __forceinline__ void ph_rw_out(const Ctx& c) {
    const bf16_t* FS = WSH(O_FS); const bf16_t* YY = WSH(O_YY); const float* BON = WSF(O_BON); const bf16_t* GG = WSH(O_GG); bf16_t* Y = WSH(O_YS);
    const int lane = threadIdx.x & 63, gw = blockIdx.x * (NT / 64) + (threadIdx.x >> 6), ngw = gridDim.x * (NT / 64);
    for (int i = gw; i < T * 4; i += ngw) {
        const int h0 = (i & 3) * 4; const long t = i >> 2; float y0[4], y1[4], gv[4], vv[4], bs[4];
#pragma unroll
        for (int q = 0; q < 4; ++q) { const int ch = (h0 + q) * 64 + lane; y0[q] = bf2f(YY[(size_t)t * W + ch]); y1[q] = bf2f(YY[((size_t)T + t) * W + ch]); gv[q] = bf2f(GG[(size_t)t * W + ch]); vv[q] = bf2f(FS[(size_t)t * RF + 2048 + ch]);
            bs[q] = BON[(size_t)t * 16 + h0 + q] + BON[((size_t)T + t) * 16 + h0 + q]; }
#pragma unroll
        for (int q = 0; q < 4; ++q) { const int ch = (h0 + q) * 64 + lane;
            const float m0 = wave_sum(y0[q]) * (1.f / 64.f), m1 = wave_sum(y1[q]) * (1.f / 64.f); const float d0 = y0[q] - m0, d1 = y1[q] - m1;
            const float r0 = 1.f / sqrtf(wave_sum(d0 * d0) * (1.f / 64.f) + EPS), r1 = 1.f / sqrtf(wave_sum(d1 * d1) * (1.f / 64.f) + EPS);
            Y[(size_t)t * 4 * W + 3 * W + ch] = (bf16_t)f2bf((d0 * r0 + d1 * r1 + bs[q] * vv[q]) * gv[q]); }
    }
}
__device__ __forceinline__ void ph_router(const Ctx& c, int l, float* ldsf, const float* X, const float* gN, const float* shN, const float* scN) {
    const float* RS = WSF(O_HF); const bf16_t* WH = WSH(O_WRH); const bf16_t* WL = WSH(O_WRL); const float* bg = c.in[31] + (size_t)l * 4; const float* be = c.in[33] + (size_t)l * 32;
    int* EID = WSI(O_EID); float* EWT = WSF(O_EWT); int* cnt = CTLW(c) + CW_CNT + l * 64;
    const int tid = threadIdx.x, wv = tid >> 6, lane = tid & 63, fr = lane & 15, fq = lane >> 4, rt = wv & 1, kq = wv >> 1;
    float* part = ldsf;
    for (int u = blockIdx.x; u < T / 32; u += gridDim.x) {
        const long t0 = (long)u * 32; f32x4 acc[3];
#pragma unroll
        for (int nt = 0; nt < 3; ++nt) acc[nt] = (f32x4){0.f, 0.f, 0.f, 0.f};
#ifdef CPU_EMU
        for (int nt = 0; nt < 3; ++nt) for (int r = 0; r < 4; ++r) { const int n = 16 * nt + 4 * fq + r; float sacc = 0.f;
            for (int k = kq * 512; k < kq * 512 + 512; ++k) { const long tr = t0 + 16 * rt + fr; const int bb = (int)(tr / S); const float hv = X[(size_t)tr * D + k] * RS[tr] * gN[k] * (1.f + scN[bb * D6 + k]) + shN[bb * D6 + k]; const float hh = bf2f((bf16_t)f2bf(hv)), hl = bf2f((bf16_t)f2bf(hv - hh));
                const float wh = bf2f(WH[(size_t)n * D + k]), wl = bf2f(WL[(size_t)n * D + k]); sacc += hh * wh + hl * wh + hh * wl; }
            acc[nt][r] = sacc; }
#else
        const long tr = t0 + 16 * rt + fr; const int bb = (int)(tr / S); const float rsv = RS[tr]; const int kb = kq * 512 + fq * 8;
        const float* hp = X + (size_t)tr * D + kb; const float* gp_ = gN + kb; const float* scp = scN + bb * D6 + kb; const float* shp = shN + bb * D6 + kb;
#pragma unroll 4
        for (int ks = 0; ks < 16; ++ks) {
            const f32x4 h0 = *(const f32x4*)(hp + ks * 32) * rsv * *(const f32x4*)(gp_ + ks * 32) * (*(const f32x4*)(scp + ks * 32) + 1.f) + *(const f32x4*)(shp + ks * 32);
            const f32x4 h1 = *(const f32x4*)(hp + ks * 32 + 4) * rsv * *(const f32x4*)(gp_ + ks * 32 + 4) * (*(const f32x4*)(scp + ks * 32 + 4) + 1.f) + *(const f32x4*)(shp + ks * 32 + 4); bf16x8 ah, al;
#pragma unroll
            for (int e = 0; e < 4; ++e) { const unsigned b0 = f2bf(h0[e]), b1 = f2bf(h1[e]); ah[e] = (short)b0; ah[4 + e] = (short)b1; al[e] = (short)f2bf(h0[e] - u2f_(b0 << 16)); al[4 + e] = (short)f2bf(h1[e] - u2f_(b1 << 16)); }
#pragma unroll
            for (int nt = 0; nt < 3; ++nt) { const size_t wo = (size_t)(16 * nt + fr) * D + kq * 512 + ks * 32 + fq * 8; const bf16x8 bh = *(const bf16x8*)(WH + wo), bl = *(const bf16x8*)(WL + wo);
                acc[nt] = __builtin_amdgcn_mfma_f32_16x16x32_bf16(bh, ah, acc[nt], 0, 0, 0); acc[nt] = __builtin_amdgcn_mfma_f32_16x16x32_bf16(bh, al, acc[nt], 0, 0, 0); acc[nt] = __builtin_amdgcn_mfma_f32_16x16x32_bf16(bl, ah, acc[nt], 0, 0, 0); }
        }
#endif
#pragma unroll
        for (int nt = 0; nt < 3; ++nt) *(f32x4*)(part + (kq * 32 + 16 * rt + fr) * 48 + 16 * nt + 4 * fq) = acc[nt];
        SYNCTHREADS();
        if (tid < 32) { const long t = t0 + tid; float lg[36];
#pragma unroll
            for (int q = 0; q < 36; ++q) lg[q] = (part[(0 * 32 + tid) * 48 + q] + part[(1 * 32 + tid) * 48 + q]) + (part[(2 * 32 + tid) * 48 + q] + part[(3 * 32 + tid) * 48 + q]) + (q < 4 ? bg[q < 4 ? q : 0] : be[q >= 4 ? q - 4 : 0]);
            int gi = 0; float m = lg[0];
#pragma unroll
            for (int q = 1; q < 4; ++q) if (lg[q] > m) { m = lg[q]; gi = q; }
            float den = 0.f;
#pragma unroll
            for (int q = 0; q < 4; ++q) den += expf(lg[q] - m);
            const float gp = 1.f / den; float el[8];
#pragma unroll
            for (int q = 0; q < 8; ++q) el[q] = gi == 0 ? lg[4 + q] : gi == 1 ? lg[12 + q] : gi == 2 ? lg[20 + q] : lg[28 + q];
            int i1 = 0; float m1 = el[0];
#pragma unroll
            for (int q = 1; q < 8; ++q) if (el[q] > m1) { m1 = el[q]; i1 = q; }
            int i2 = -1; float m2 = 0.f;
#pragma unroll
            for (int q = 0; q < 8; ++q) if (q != i1 && (i2 < 0 || el[q] > m2)) { m2 = el[q]; i2 = q; }
            const float p2 = expf(m2 - m1);
            EID[t * 2] = gi * 8 + i1; EID[t * 2 + 1] = gi * 8 + i2; EWT[t * 2] = gp / (1.f + p2); EWT[t * 2 + 1] = gp * p2 / (1.f + p2);
            atomic_add_i(cnt + gi * 8 + i1, 1); atomic_add_i(cnt + gi * 8 + i2, 1);
        }
        SYNCTHREADS();
    }
}
__device__ __forceinline__ void ph_moe_assign(const Ctx& c, int l, float* ldsf) {
    const int* cnt = CTLW(c) + CW_CNT + l * 64; int* plan = CTLW(c) + CW_PLAN + l * 256; const int* EID = WSI(O_EID); int* fill = CTLW(c) + CW_FILL + l * 64; int* DEST = WSI(O_DEST);
    int* pstart = (int*)ldsf;
    if (threadIdx.x == 0) { int ps = 0, nb = 0; const bool pub = blockIdx.x == 0;
        for (int e = 0; e < NE; ++e) { pstart[e] = ps; if (pub) plan[e] = ps; const int nblk = (cnt[e] + 255) / 256; if (pub) for (int q = 0; q < nblk; ++q) plan[64 + nb + q] = e; nb += nblk; ps += nblk * 256; }
        if (pub) { plan[32] = ps; plan[40] = nb; } }
    SYNCTHREADS();
    for (long i = GT_; i < (long)T * 2; i += GS_) { const int e = EID[i]; const int pos = atomic_add_i(fill + e, 1); DEST[i] = pstart[e] + pos; }
    SYNCTHREADS();
}
__device__ __forceinline__ void ph_moe_gather(const Ctx& c) {
    const int* DEST = WSI(O_DEST); const u32x4* H = (const u32x4*)WSH(O_H); u32x4* XS = (u32x4*)WSH(O_XS);
    for (long i = GT_; i < (long)T * 2 * (D / 8); i += GS_) { const int q = (int)(i % (D / 8)); const long a = i / (D / 8); XS[(size_t)DEST[a] * (D / 8) + q] = H[(size_t)(a >> 1) * (D / 8) + q]; }
}
#ifndef CPU_EMU
#define XB_TMO      128
#define XB_XCNT(j)  (256  + 64 * (j))
#define XB_XSUB(j)  (1280 + 64 * (j))
#define XB_XGEN(j)  (2304 + 64 * (j))
#define XB_TOP      3328
#define XB_TOPGEN   3392
#define XCD_BAR_WORDS 3456
#define XB_SPIN_CAP (1u << 26)
#define LAS __attribute__((address_space(3)))
__device__ __forceinline__ unsigned xb_ld(unsigned* p)              { return __hip_atomic_load(p, __ATOMIC_RELAXED, __HIP_MEMORY_SCOPE_AGENT); }
__device__ __forceinline__ unsigned xb_add(unsigned* p, unsigned v) { return __hip_atomic_fetch_add(p, v, __ATOMIC_RELAXED, __HIP_MEMORY_SCOPE_AGENT); }
__device__ __forceinline__ unsigned xb_xcc_id() { return (unsigned)__builtin_amdgcn_s_getreg((3 << 11) | 20) & 0xFu; }
#define XB_SPIN(cond, bar) do { unsigned _sp = 0; while (cond) { __builtin_amdgcn_s_sleep(1); \
    if ((++_sp & 255u) == 0u) { if (xb_ld(&(bar)[XB_TMO])) break; if (_sp > XB_SPIN_CAP) { atomicAdd(&(bar)[XB_TMO], 1u); break; } } } } while (0)
struct XcdBarrier { unsigned* bar; unsigned x; volatile LAS unsigned* st; };
__device__ __forceinline__ XcdBarrier xcd_barrier_post(unsigned* bar, volatile LAS unsigned* st) {
    XcdBarrier b; b.bar = bar; b.x = xb_xcc_id(); b.st = st;
    if (threadIdx.x == 0) (void)xb_add(&bar[XB_XCNT(b.x)], 1u);
    return b;
}
__device__ __forceinline__ void xcd_barrier_complete(unsigned* bar, unsigned x, unsigned& nloc, unsigned& nx) {
    const unsigned G = gridDim.x * gridDim.y * gridDim.z;
    unsigned sum, cnt, mine, sp = 0u;
    for (;;) {
        sum = 0u; cnt = 0u; mine = 0u;
#pragma unroll
        for (unsigned j = 0; j < 16; ++j) { const unsigned cc = xb_ld(&bar[XB_XCNT(j)]); sum += cc; cnt += (cc > 0u) ? 1u : 0u; mine = (j == x) ? cc : mine; }
        if (sum == G) break;
        __builtin_amdgcn_s_sleep(1);
        if ((++sp & 255u) == 0u) { if (xb_ld(&bar[XB_TMO])) break; if (sp > XB_SPIN_CAP) { atomicAdd(&bar[XB_TMO], 1u); break; } }
    }
    nloc = mine > 0u ? mine : 1u; nx = cnt > 0u ? cnt : 1u;
}
__device__ __forceinline__ void xcd_barrier(const XcdBarrier& b) {
    asm volatile("s_waitcnt vmcnt(0)" ::: "memory");
    __syncthreads();
    if (threadIdx.x == 0) {
        unsigned* bar = b.bar;
        __builtin_amdgcn_s_waitcnt(0);
        unsigned nloc = b.st[0], nx = b.st[1];
        if (nloc == 0u) { xcd_barrier_complete(bar, b.x, nloc, nx); b.st[0] = nloc; b.st[1] = nx; }
        const unsigned old = xb_add(&bar[XB_XSUB(b.x)], 1u);
        const unsigned gen = old / nloc;
        if (old + 1u == (gen + 1u) * nloc) {
            __builtin_amdgcn_fence(__ATOMIC_RELEASE, "agent");
            asm volatile("s_waitcnt vmcnt(0)" ::: "memory");
            const unsigned og = xb_add(&bar[XB_TOP], 1u);
            const unsigned tg = og / nx;
            if (og + 1u == (tg + 1u) * nx) xb_add(&bar[XB_TOPGEN], 1u);
            else XB_SPIN(xb_ld(&bar[XB_TOPGEN]) == tg, bar);
            __builtin_amdgcn_fence(__ATOMIC_ACQUIRE, "agent");
            xb_add(&bar[XB_XGEN(b.x)], 1u);
            asm volatile("s_waitcnt vmcnt(0)" ::: "memory");
        } else {
            XB_SPIN(xb_ld(&bar[XB_XGEN(b.x)]) == gen, bar);
            __builtin_amdgcn_fence(__ATOMIC_ACQUIRE, "agent");
            asm volatile("s_waitcnt vmcnt(0)" ::: "memory");
        }
    }
    __syncthreads();
}
#endif

constexpr int LDS_BYTES = 147456;

__global__ void __launch_bounds__(NT, 2) fwd(Params p) {
#ifdef CPU_EMU
    unsigned char* lds = g_lds; float* ldsf = (float*)g_lds;
#else
    extern __shared__ __attribute__((aligned(16))) unsigned char lds[];
    float* ldsf = (float*)lds;
    volatile LAS unsigned* misc = (volatile LAS unsigned*)((LAS unsigned char*)lds + LDS_BYTES - 64);
    if (threadIdx.x == 0) { misc[0] = 0u; misc[1] = 0u; }
    __syncthreads();
    XcdBarrier bar = xcd_barrier_post((unsigned*)(p.ws + O_CTL) + CW_BAR, misc);
#endif
    Ctx c; c.in = p.in; c.out = p.out; c.ws = p.ws;
    const int lo = p.ph_lo, hi = p.ph_hi; int ph = 0;
    const int G = (int)gridDim.x, cwg = (int)blockIdx.x;
#ifdef CPU_EMU
#define GRID_BAR()
#else
#define GRID_BAR() xcd_barrier(bar)
#endif
#ifndef REPEAT_MASK
#define REPEAT_MASK 0
#endif
#ifndef TIME_PHASE
#define TIME_PHASE -1
#endif
#if TIME_PHASE >= 0 && !defined(CPU_EMU)
    unsigned long long tp0 = 0, tp1 = 0;
#define TP_BEGIN() do { if (ph == TIME_PHASE) tp0 = __builtin_amdgcn_s_memrealtime(); } while (0)
#define TP_END() do { if (ph == TIME_PHASE) tp1 = __builtin_amdgcn_s_memrealtime(); } while (0)
#else
#define TP_BEGIN()
#define TP_END()
#endif
#define PHASE(...) do { if (lo <= ph && ph < hi) { TP_BEGIN(); __VA_ARGS__; if (ph + 1 < hi) { GRID_BAR(); } TP_END(); } ++ph; } while (0)
#define PHASEG(grp, ...) do { if (lo <= ph && ph < hi) { TP_BEGIN(); if ((REPEAT_MASK >> (grp)) & 1) { __VA_ARGS__; GRID_BAR(); } __VA_ARGS__; if (ph + 1 < hi) { GRID_BAR(); } TP_END(); } ++ph; } while (0)
    PHASE(ph_mod(c, ldsf); ph_rope_table(c); ph_convert(c, 0, ldsf));
#define LAYER_BODY(l) do { const float* mod = WSF(O_MOD); \
        const float* xin = l == 0 ? c.in[0] : WSF(O_X1); float* xmid = WSF(O_X0); float* xout = WSF(O_X1); \
        const float* ml = mod + (size_t)l * NB * D6; \
        PHASEG(0, { pg8::Gemm g{D, D, D}; pg8::StaticOrder so; so.init(T, PW, G, cwg, WSH(O_H), WSH(O_WIN), D, D); pg8::EpiP E{WSH(O_P), (unsigned char*)(c.ws + O_G8)}; pg8::gemm_phase(lds, g, so, E); \
            { const int nun_ = (T / 256) * (PW / 256), rem_ = nun_ % G; if (rem_ != 0 && cwg >= rem_) { SYNCTHREADS(); convert_big(c, l, ldsf, J_ALL - convert_tail_tiles(), J_ALL, cwg - rem_, G - rem_); } } }); \
        PHASE(ph_lru<1>(c, l, ldsf); ph_ret_kv(c, ldsf); ph_sgu_norm(c, l); ph_rw_shift(c, l)); \
        PHASE(ph_lru_scan2(c); ph_ret_state(c); ph_sgu_mix(c, l, ldsf); ph_rw_lora(c, l, ldsf)); \
        PHASE(ph_lru_fin(c, ldsf); ph_ret_out(c, ldsf); ph_rw_chunk(c, l, ldsf)); \
        PHASE(ph_rw_seq(c, ldsf)); \
        PHASE(ph_rw_out(c)); \
        PHASEG(1, { pg8::Gemm g{4 * W, 4 * W, 4 * W}; pg8::StaticOrder so; so.init(T, D, G, cwg, WSH(O_YS), WSH(O_WBR), 4 * W, 4 * W); pg8::EpiMerge E{(const unsigned char*)(c.ws + O_G8), WSH(O_MRG)}; pg8::gemm_phase(lds, g, so, E); }); \
        PHASEG(1, { pg8::Gemm g{D, D, D}; pg8::StaticOrder so; so.init(T, D, G, cwg, WSH(O_MRG), WSH(O_WOUT), D, D); pg8::EpiResid E{xin, ml + 2 * D, xmid}; pg8::gemm_phase(lds, g, so, E); }); \
        PHASEG(6, ph_norm(c, xmid, c.in[4] + (size_t)l * D, ml + 3 * D, ml + 4 * D, WSH(O_H), WSF(O_HF))); \
        PHASE(ph_router(c, l, ldsf, xmid, c.in[4] + (size_t)l * D, ml + 3 * D, ml + 4 * D)); \
        PHASE(ph_moe_assign(c, l, ldsf)); \
        PHASEG(6, ph_moe_gather(c)); \
        const int* plan = CTLW(c) + CW_PLAN + l * 256; \
        PHASEG(2, { pg8::Gemm g{D, D, D}; pg8::MoeOrder mo{G, cwg, 4, plan, (const char*)WSH(O_XS), (const char*)WSH(O_WGU), (size_t)256 * D * 2, (size_t)256 * D * 2, (size_t)1024 * D * 2}; pg8::EpiGU E{WSH(O_ACT)}; pg8::gemm_phase(lds, g, mo, E); \
            if (l == 0) { const int nrest_ = plan[40] * 4 - G; if (nrest_ >= 0 && nrest_ < G && cwg >= nrest_) { SYNCTHREADS(); convert_big(c, 1, ldsf, 0, convert_early_tiles(c), cwg - nrest_, G - nrest_); } } }); \
        PHASEG(2, { pg8::Gemm g{512, 512, 512}; pg8::MoeOrder mo{G, cwg, 8, plan, (const char*)WSH(O_ACT), (const char*)WSH(O_WDN), (size_t)256 * 512 * 2, (size_t)256 * 512 * 2, (size_t)D * 512 * 2}; pg8::EpiBf16 E{WSH(O_YE), D}; pg8::gemm_phase(lds, g, mo, E); }); \
        if (l == 0) PHASE(ph_comb_norm<0>(c, xmid, ml + 5 * D, xout, c.in[3] + (size_t)1 * D, mod + (size_t)1 * NB * D6 + 0 * D, mod + (size_t)1 * NB * D6 + 1 * D, WSH(O_H), nullptr); ph_convert(c, 1, ldsf)); \
        else PHASE(ph_comb_norm<1>(c, xmid, ml + 5 * D, xout, c.in[36], nullptr, nullptr, nullptr, c.out)); \
    } while (0)
    PHASE(ph_norm(c, c.in[0], c.in[3], WSF(O_MOD) + 0 * D, WSF(O_MOD) + 1 * D, WSH(O_H), nullptr));
    LAYER_BODY(0);
    LAYER_BODY(1);
#undef LAYER_BODY
#if TIME_PHASE >= 0 && !defined(CPU_EMU)
    if (blockIdx.x == 0) { const unsigned long long te = __builtin_amdgcn_s_memrealtime(), dl = 8ull * (tp1 - tp0); while (__builtin_amdgcn_s_memrealtime() - te < dl) __builtin_amdgcn_s_sleep(8); }
#endif
#undef PHASE
}
}

#ifndef CPU_EMU
extern "C" void kernel_launch(void* const* d_in, const int* in_sizes, int n_in, void* d_out, int out_size, void* d_ws, size_t ws_size, hipStream_t stream) {
    static int grid = 0;
    if (grid == 0) {
        if (n_in != 37 || out_size != T * D || ws_size < WS_END) { fprintf(stderr, "kernel_launch: unexpected shapes (n_in %d out %d ws %zu need %zu)\n", n_in, out_size, ws_size, (size_t)WS_END); grid = -1; return; }
        int dev = 0, cus = 0, per_cu = 0;
        if (hipGetDevice(&dev) != hipSuccess || hipDeviceGetAttribute(&cus, hipDeviceAttributeMultiprocessorCount, dev) != hipSuccess) { grid = -1; return; }
        if (hipFuncSetAttribute((const void*)fwd, hipFuncAttributeMaxDynamicSharedMemorySize, LDS_BYTES) != hipSuccess) { fprintf(stderr, "kernel_launch: hipFuncSetAttribute failed\n"); grid = -1; return; }
        if (hipOccupancyMaxActiveBlocksPerMultiprocessor(&per_cu, (const void*)fwd, NT, LDS_BYTES) != hipSuccess || per_cu < 1) fprintf(stderr, "kernel_launch: occupancy query says %d\n", per_cu);
        (void)hipGetLastError();
        grid = cus;
    }
    if (grid < 0) return;
    (void)in_sizes;
    (void)hipMemsetAsync((char*)d_ws + O_CTL, 0, CTL_BYTES, stream);
    Params p{};
    for (int i = 0; i < 37; ++i) p.in[i] = (const float*)d_in[i];
    p.out = (float*)d_out; p.ws = (unsigned char*)d_ws;
#if ONE_LAUNCH
    p.ph_lo = 0; p.ph_hi = NPH;
    hipLaunchKernelGGL(fwd, dim3(grid), dim3(NT), LDS_BYTES, stream, p);
#else
    for (int k = 0; k < NPH; ++k) { p.ph_lo = k; p.ph_hi = k + 1; hipLaunchKernelGGL(fwd, dim3(grid), dim3(NT), LDS_BYTES, stream, p); }
#endif
}
#endif
```

```cpp
#ifndef CPU_EMU
#include <hip/hip_runtime.h>
#endif
#include <cstdio>
#include <cstdint>
#include <cmath>
#include <cstring>

#ifndef SEQ
#define SEQ 4096
#endif
#ifndef ONE_LAUNCH
#define ONE_LAUNCH 1
#endif

namespace {
constexpr int D = 2048, NB = 2, S = SEQ, T = NB * S, NL = 2, W = 1024;
constexpr int INW = 18816, RF = 3456, D6 = 6 * D;
constexpr int C_LX = 0, C_LG = 1024, C_RQ = 2048, C_RK = 2560, C_RV = 3072, C_RG = 4096, C_SU = 5120, C_SV = 6144, C_RW = 7168;
constexpr int PW = 18944, C_MLP = 10752;
constexpr int NCH = S / 128;
constexpr int NLC = S / 64;
constexpr int NE = 32, CAP = (T * 2 / 256 + NE) * 256, MAXBLK = CAP / 256;
constexpr float EPS = 1e-6f;
constexpr float DECAY_SCALE = 0.60653065971263342f;
constexpr int NT = 512;
constexpr int NPH_LAYER = 15, NPH = 2 + NL * NPH_LAYER;
typedef unsigned short bf16_t;
#ifdef CPU_EMU
typedef float f32x4 __attribute__((vector_size(16)));
typedef unsigned u32x4 __attribute__((vector_size(16)));
#else
typedef float f32x4 __attribute__((ext_vector_type(4)));
typedef unsigned u32x4 __attribute__((ext_vector_type(4)));
typedef short bf16x8 __attribute__((ext_vector_type(8)));
#endif

constexpr size_t al256(size_t x) { return (x + 255) & ~(size_t)255; }
constexpr size_t SZ_X = (size_t)T * D * 4, SZ_W = (size_t)T * W * 4;
constexpr size_t O_CTL = 0, CTL_BYTES = 1u << 20;
constexpr size_t O_MOD = CTL_BYTES;
constexpr size_t O_X0 = O_MOD + al256((size_t)NL * NB * D6 * 4);
constexpr size_t O_X1 = O_X0 + SZ_X;
constexpr size_t O_H = O_X1 + SZ_X;
constexpr size_t O_HF = O_H + SZ_X / 2;
constexpr size_t O_P = O_HF + SZ_X;
constexpr size_t SZ_P = (size_t)T * PW * 2;
constexpr size_t O_XC = O_P + SZ_P;
constexpr size_t O_LA = O_XC + SZ_W, O_LU = O_LA + 2 * SZ_W;
constexpr size_t SZ_LC = (size_t)2 * NB * NLC * W * 4;
constexpr size_t O_LCA = O_LU + 2 * SZ_W, O_LCH = O_LCA + SZ_LC, O_LCI = O_LCH + SZ_LC;
constexpr size_t O_YS = O_LCI + SZ_LC;
constexpr size_t O_SC = O_YS + (size_t)T * 4 * W * 2;
constexpr size_t SZ_KV = (size_t)NB * NCH * 8 * 64 * 128 * 4;
constexpr size_t O_KVF = O_SC, O_KVB = O_KVF + SZ_KV, O_STF = O_KVB + SZ_KV, O_STB = O_STF + SZ_KV;
constexpr size_t O_VN = O_STB + SZ_KV;
constexpr size_t O_FS = O_VN + SZ_W;
constexpr size_t O_DEC = O_FS + al256((size_t)T * RF * 4), O_AA = O_DEC + 2 * SZ_W, O_AKK = O_AA + 2 * SZ_W;
constexpr size_t O_GG = O_AKK, O_YY = O_GG + SZ_W;
constexpr int RCK = 64, NRC = S / RCK;
constexpr size_t O_BON = O_YY + 2 * SZ_W;
constexpr size_t O_PART = O_BON + al256((size_t)2 * T * 16 * 4);
constexpr size_t O_MRG = O_PART + SZ_X;
constexpr size_t O_LOG = O_MRG + SZ_X / 2;
constexpr size_t O_EID = O_LOG + al256((size_t)T * 40 * 4), O_EWT = O_EID + al256((size_t)T * 2 * 4), O_DEST = O_EWT + al256((size_t)T * 2 * 4);
constexpr size_t O_SLOT = O_DEST + al256((size_t)T * 2 * 4);
constexpr size_t O_PST = O_SLOT + al256((size_t)CAP * 4), O_PYT = O_PST + (size_t)64 * NRC * 4096 * 2, O_SVB = O_PYT + (size_t)64 * NRC * 4096 * 2, O_YVB = O_SVB + (size_t)64 * NRC * 4096 * 4;
constexpr size_t O_WIN = O_YVB + (size_t)64 * NRC * 4096 * 4;
constexpr size_t O_WBR = O_WIN + (size_t)PW * D * 2;
constexpr size_t O_WOUT = O_WBR + (size_t)D * 4 * W * 2;
constexpr size_t O_WGU = O_WOUT + (size_t)D * D * 2;
constexpr size_t O_WDN = O_WGU + (size_t)NE * 1024 * D * 2;
constexpr size_t O_G8 = O_WDN + (size_t)NE * D * 512 * 2;
constexpr size_t O_ROPE = O_G8 + (size_t)T * 4 * D;
constexpr size_t O_WLR = O_ROPE + (size_t)T * 64 * 4;
constexpr size_t O_WUT = O_WLR + (size_t)32 * 128 * 128 * 2;
constexpr size_t O_WAT = O_WUT + (size_t)2 * W * 64 * 2;
constexpr size_t O_WGT = O_WAT + (size_t)2 * W * 64 * 2;
constexpr size_t O_WRH = O_WGT + (size_t)W * 128 * 2;
constexpr size_t O_WRL = O_WRH + (size_t)48 * D * 2;
constexpr size_t WS_END0 = O_WRL + (size_t)48 * D * 2;
constexpr size_t SZ_MOE = (size_t)CAP * (D + 512 + D) * 2;
constexpr bool MOE_OVERLAY = SZ_MOE <= SZ_P;
constexpr size_t O_XS = MOE_OVERLAY ? O_P : WS_END0;
constexpr size_t O_ACT = O_XS + (size_t)CAP * D * 2;
constexpr size_t O_YE = O_ACT + (size_t)CAP * 512 * 2;
constexpr size_t WS_END = MOE_OVERLAY ? WS_END0 : WS_END0 + SZ_MOE;
static_assert(SEQ != 4096 || WS_END <= (size_t)2040 * 1024 * 1024, "workspace budget: d_ws is 4 x the largest input = 2048 MiB");
constexpr int CW_BAR = 4096;
constexpr int CW_CNT = 32768;
constexpr int CW_FILL = CW_CNT + NL * 64;
constexpr int CW_PLAN = CW_FILL + NL * 64;
static_assert(MAXBLK <= 160, "plan words");

struct Params { const float* in[37]; float* out; unsigned char* ws; int ph_lo, ph_hi; };

struct Ctx { const float* const* in; float* out; unsigned char* ws; };
#define GT_ ((long)blockIdx.x * NT + threadIdx.x)
#define GS_ ((long)gridDim.x * NT)
#define WSF(off) ((float*)(c.ws + (off)))
#define WSI(off) ((int*)(c.ws + (off)))
#define WSH(off) ((bf16_t*)(c.ws + (off)))
#define CTLW(c) ((int*)((c).ws + O_CTL))

#ifdef CPU_EMU
__device__ __forceinline__ float fexp_(float x) { return expf(x); }
__device__ __forceinline__ float frcp_(float x) { return 1.f / x; }
__device__ __forceinline__ float frsq_(float x) { return 1.f / sqrtf(x); }
#else
__device__ __forceinline__ float fexp_(float x) { return __builtin_amdgcn_exp2f(x * 1.4426950408889634f); }
__device__ __forceinline__ float frcp_(float x) { return __builtin_amdgcn_rcpf(x); }
__device__ __forceinline__ float frsq_(float x) { return __builtin_amdgcn_rsqf(x); }
#endif
__device__ __forceinline__ float sigmoidf_(float x) { return frcp_(1.f + fexp_(-x)); }
__device__ __forceinline__ float siluf_(float x) { return x * frcp_(1.f + fexp_(-x)); }
__device__ __forceinline__ float tanhf_(float x) { return 1.f - 2.f * frcp_(1.f + fexp_(2.f * x)); }
__device__ __forceinline__ float geluf_(float x) { return 0.5f * x * (1.f + tanhf_(0.7978845608028654f * (x + 0.044715f * x * x * x))); }
__device__ __forceinline__ float softplusf_(float x) { return x > 0.f ? x + log1pf(expf(-x)) : log1pf(expf(x)); }
__device__ __forceinline__ float loggamma_(int h) { return log1pf(-exp2f(-5.f - (float)h)); }
__device__ __forceinline__ unsigned f2u_(float f) { unsigned u; memcpy(&u, &f, 4); return u; }
__device__ __forceinline__ float u2f_(unsigned u) { float f; memcpy(&f, &u, 4); return f; }
__device__ __forceinline__ float bf2f(bf16_t v) { return u2f_((unsigned)v << 16); }
#ifdef CPU_EMU
__device__ __forceinline__ unsigned f2bf(float f) { const unsigned u = f2u_(f); return (u + 0x7fffu + ((u >> 16) & 1u)) >> 16; }
__device__ __forceinline__ unsigned pk2(float lo, float hi) { return f2bf(lo) | (f2bf(hi) << 16); }
#else
typedef __attribute__((ext_vector_type(2))) __bf16 hwbf2_t; typedef __attribute__((ext_vector_type(2))) float hwf2_t;
__device__ __forceinline__ unsigned f2bf(float f) { const __bf16 s = (__bf16)f; return (unsigned)__builtin_bit_cast(unsigned short, s); }
__device__ __forceinline__ unsigned pk2(float lo, float hi) { const hwf2_t v = {lo, hi}; return __builtin_bit_cast(unsigned, __builtin_convertvector(v, hwbf2_t)); }
#endif
__device__ __forceinline__ float bflo(unsigned w) { return u2f_(w << 16); }
__device__ __forceinline__ float bfhi(unsigned w) { return u2f_(w & 0xffff0000u); }
__device__ __forceinline__ int atomic_add_i(int* p, int v) {
#ifdef CPU_EMU
    return __atomic_fetch_add(p, v, __ATOMIC_RELAXED);
#else
    return atomicAdd(p, v);
#endif
}
#define PF(P, r, col) bf2f((P)[(size_t)(r) * PW + (col)])
#ifdef CPU_EMU
#define SYNCTHREADS() emu_syncthreads()
#define SHFL_XOR(v, m) emu_shfl_xor(v, m)
#else
#define SYNCTHREADS() __syncthreads()
#define SHFL_XOR(v, m) __shfl_xor(v, m)
#endif
#ifdef CPU_EMU
__device__ __forceinline__ float wave_sum(float v) {
    for (int o = 1; o < 64; o <<= 1) v += SHFL_XOR(v, o);
    return v;
}
#else
__device__ __forceinline__ float wave_sum(float x) {
    x += __builtin_bit_cast(float, __builtin_amdgcn_update_dpp(0, __builtin_bit_cast(int, x), 0xB1, 0xF, 0xF, true));
    x += __builtin_bit_cast(float, __builtin_amdgcn_update_dpp(0, __builtin_bit_cast(int, x), 0x4E, 0xF, 0xF, true));
    x += __builtin_bit_cast(float, __builtin_amdgcn_update_dpp(0, __builtin_bit_cast(int, x), 0x141, 0xF, 0xF, true));
    x += __builtin_bit_cast(float, __builtin_amdgcn_update_dpp(0, __builtin_bit_cast(int, x), 0x140, 0xF, 0xF, true));
    const int xi = __builtin_bit_cast(int, x);
    return (__builtin_bit_cast(float, __builtin_amdgcn_readlane(xi, 0)) + __builtin_bit_cast(float, __builtin_amdgcn_readlane(xi, 16))) + (__builtin_bit_cast(float, __builtin_amdgcn_readlane(xi, 32)) + __builtin_bit_cast(float, __builtin_amdgcn_readlane(xi, 48)));
}
#endif
__device__ __forceinline__ f32x4 ld_bf4(const bf16_t* p) { const unsigned long long q = *(const unsigned long long*)p; const unsigned lo = (unsigned)q, hi = (unsigned)(q >> 32); return (f32x4){bflo(lo), bfhi(lo), bflo(hi), bfhi(hi)}; }
__device__ __forceinline__ void st_bf4(bf16_t* p, const f32x4 v) { *(unsigned long long*)p = (unsigned long long)pk2(v[0], v[1]) | ((unsigned long long)pk2(v[2], v[3]) << 32); }

template <int KT, int NTL>
__device__ __forceinline__ void wave_mma(f32x4 (&acc)[NTL], const bf16_t* A, int lda, const bf16_t* Bt, int ldb) {
    const int lane = threadIdx.x & 63, fr = lane & 15, fq = lane >> 4;
#ifdef CPU_EMU
    for (int nt = 0; nt < NTL; ++nt) for (int r = 0; r < 4; ++r) { float sacc = 0.f; const bf16_t* a = A + fr * lda; const bf16_t* b = Bt + (16 * nt + 4 * fq + r) * ldb;
        for (int k = 0; k < 32 * KT; ++k) sacc += bf2f(a[k]) * bf2f(b[k]);
        acc[nt][r] += sacc; }
#else
#pragma unroll
    for (int kt = 0; kt < KT; ++kt) {
        const bf16x8 af = *(const bf16x8*)(A + fr * lda + kt * 32 + fq * 8);
#pragma unroll
        for (int nt = 0; nt < NTL; ++nt) { const bf16x8 bfr = *(const bf16x8*)(Bt + (16 * nt + fr) * ldb + kt * 32 + fq * 8);
            acc[nt] = __builtin_amdgcn_mfma_f32_16x16x32_bf16(bfr, af, acc[nt], 0, 0, 0); }
    }
#endif
}
__device__ __forceinline__ void ph_mod(const Ctx& c, float* ldsf) {
    const float* cc = c.in[1]; const float* aw = c.in[5]; const float* ab = c.in[6]; float* mod = WSF(O_MOD);
    float* scs = ldsf; float* part = ldsf + NB * D; const int tid = threadIdx.x, c4 = (tid & 31) * 4, kq = tid >> 5;
    for (int i = tid; i < NB * D; i += NT) scs[i] = siluf_(cc[i]);
    SYNCTHREADS();
    for (int u = blockIdx.x; u < NL * (D6 / 128); u += gridDim.x) {
        const int l = u / (D6 / 128), j0 = (u % (D6 / 128)) * 128;
        const float* w = aw + (size_t)l * D * D6 + j0 + c4; f32x4 a0 = (f32x4){0.f, 0.f, 0.f, 0.f}, a1 = a0;
#pragma unroll 8
        for (int k = kq * 128; k < kq * 128 + 128; ++k) { const f32x4 wv = *(const f32x4*)(w + (size_t)k * D6); a0 += wv * scs[k]; a1 += wv * scs[D + k]; }
        *(f32x4*)(part + (kq * 2 + 0) * 128 + c4) = a0; *(f32x4*)(part + (kq * 2 + 1) * 128 + c4) = a1;
        SYNCTHREADS();
        if (tid < 256) { const int b = tid >> 7, col = tid & 127; float sacc = 0.f;
#pragma unroll
            for (int q = 0; q < 16; ++q) sacc += part[(q * 2 + b) * 128 + col];
            mod[((size_t)l * NB + b) * D6 + j0 + col] = sacc + ab[l * D6 + j0 + col]; }
        SYNCTHREADS();
    }
}
__device__ __forceinline__ void ph_norm(const Ctx& c, const float* x, const float* g, const float* sh, const float* sc, bf16_t* hb, float* hf) {
    const int lane = threadIdx.x & 63, gw = blockIdx.x * (NT / 64) + (threadIdx.x >> 6), ngw = gridDim.x * (NT / 64);
    for (int t0 = gw * 2; t0 < T; t0 += ngw * 2) {
        f32x4 v[2][8]; float ss[2] = {0.f, 0.f};
#pragma unroll
        for (int r = 0; r < 2; ++r)
#pragma unroll
            for (int j = 0; j < 8; ++j) v[r][j] = *(const f32x4*)(x + (size_t)(t0 + r) * D + (j * 64 + lane) * 4);
#pragma unroll
        for (int r = 0; r < 2; ++r) {
#pragma unroll
            for (int j = 0; j < 8; ++j) ss[r] += (v[r][j][0] * v[r][j][0] + v[r][j][1] * v[r][j][1]) + (v[r][j][2] * v[r][j][2] + v[r][j][3] * v[r][j][3]);
            const int t = t0 + r, b = t / S; const float rs = 1.f / sqrtf(wave_sum(ss[r]) * (1.f / D) + EPS);
#pragma unroll
            for (int j = 0; j < 8; ++j) { const int col = (j * 64 + lane) * 4;
                const f32x4 o = v[r][j] * rs * *(const f32x4*)(g + col) * (*(const f32x4*)(sc + b * D6 + col) + 1.f) + *(const f32x4*)(sh + b * D6 + col);
                st_bf4(hb + (size_t)t * D + col, o); }
            if (hf && lane == 0) hf[t] = rs;
        }
    }
}
template <int MODE>
__device__ __forceinline__ void ph_comb_norm(const Ctx& c, const float* xmid, const float* g2, float* xout, const float* g, const float* sh, const float* sc, bf16_t* hb, float* outp) {
    const bf16_t* YE = WSH(O_YE); const float* EWT = WSF(O_EWT); const int* DEST = WSI(O_DEST);
    const int lane = threadIdx.x & 63, gw = blockIdx.x * (NT / 64) + (threadIdx.x >> 6), ngw = gridDim.x * (NT / 64);
    for (int t = gw; t < T; t += ngw) {
        const int b = t / S; const float w0 = EWT[t * 2], w1 = EWT[t * 2 + 1]; const bf16_t* y0 = YE + (size_t)DEST[t * 2] * D; const bf16_t* y1 = YE + (size_t)DEST[t * 2 + 1] * D;
        f32x4 v[8]; float ss = 0.f;
#pragma unroll
        for (int j = 0; j < 8; ++j) { const int col = (j * 64 + lane) * 4;
            v[j] = *(const f32x4*)(xmid + (size_t)t * D + col) + *(const f32x4*)(g2 + b * D6 + col) * (ld_bf4(y0 + col) * w0 + ld_bf4(y1 + col) * w1);
            if (MODE == 0) *(f32x4*)(xout + (size_t)t * D + col) = v[j];
            ss += (v[j][0] * v[j][0] + v[j][1] * v[j][1]) + (v[j][2] * v[j][2] + v[j][3] * v[j][3]); }
        const float rs = 1.f / sqrtf(wave_sum(ss) * (1.f / D) + EPS);
#pragma unroll
        for (int j = 0; j < 8; ++j) { const int col = (j * 64 + lane) * 4;
            if (MODE == 0) st_bf4(hb + (size_t)t * D + col, v[j] * rs * *(const f32x4*)(g + col) * (*(const f32x4*)(sc + b * D6 + col) + 1.f) + *(const f32x4*)(sh + b * D6 + col));
            else *(f32x4*)(outp + (size_t)t * D + col) = v[j] * rs * *(const f32x4*)(g + col); }
    }
}

struct CvtItem { const float* Wp; int ldw; bf16_t* WT; int ldt; int drow, k0, n0; };
constexpr int I_IN = 32 * (INW / 32), I_BR = 4 * 16 * 64, I_OUT = 32 * 64, I_GU = NE * 32 * 32, I_DN = NE * 8 * 64, I_LR = 32 * 8, I_WU = 2 * 32, I_WG = 64, I_BIG = I_IN + I_BR + I_OUT + I_GU + I_DN, I_ALL = I_BIG + I_LR + 2 * I_WU + I_WG;
__device__ __forceinline__ CvtItem cvt_decode(const Ctx& c, int l, int it) {
    CvtItem r;
    if (it < I_IN) { const int kb = it / (INW / 32), nb = it % (INW / 32); r.n0 = nb * 32; r.k0 = kb * 64; r.Wp = c.in[7] + (size_t)l * D * INW; r.ldw = INW; r.WT = WSH(O_WIN); r.ldt = D; r.drow = r.n0 < 10624 ? r.n0 : r.n0 + 128; return r; }
    it -= I_IN;
    if (it < I_BR) { const int sgm = it / 1024, q = it % 1024, kb = q / 64, nb = q % 64; r.n0 = nb * 32; r.k0 = kb * 64; r.Wp = c.in[28] + ((size_t)l * 4 + sgm) * W * D; r.ldw = D; r.WT = WSH(O_WBR) + sgm * W; r.ldt = 4 * W; r.drow = r.n0; return r; }
    it -= I_BR;
    if (it < I_OUT) { const int kb = it / 64, nb = it % 64; r.n0 = nb * 32; r.k0 = kb * 64; r.Wp = c.in[29] + (size_t)l * D * D; r.ldw = D; r.WT = WSH(O_WOUT); r.ldt = D; r.drow = r.n0; return r; }
    it -= I_OUT;
    if (it < I_GU) { const int e = it / 1024, q = it % 1024, kb = q / 32, nb = q % 32; r.n0 = nb * 32; r.k0 = kb * 64; r.Wp = c.in[34] + ((size_t)l * NE + e) * D * 1024; r.ldw = 1024; r.WT = WSH(O_WGU) + (size_t)e * 1024 * D; r.ldt = D;
        r.drow = r.n0 < 512 ? (r.n0 / 128) * 256 + (r.n0 % 128) : ((r.n0 - 512) / 128) * 256 + 128 + ((r.n0 - 512) % 128); return r; }
    it -= I_GU;
    if (it < I_DN) { const int e = it / 512, q = it % 512, kb = q / 64, nb = q % 64; r.n0 = nb * 32; r.k0 = kb * 64; r.Wp = c.in[35] + ((size_t)l * NE + e) * 512 * D; r.ldw = D; r.WT = WSH(O_WDN) + (size_t)e * D * 512; r.ldt = 512; r.drow = r.n0; return r; }
    it -= I_DN;
    if (it < I_LR) { const int m = it / 8, q = it % 8, kb = q / 4, nb = q % 4, z = m >> 4, ty = (m >> 3) & 1, n = m & 7; r.n0 = nb * 32; r.k0 = kb * 64; r.Wp = c.in[ty ? 12 : 10] + (((size_t)l * 2 + z) * 8 + n) * 128 * 128; r.ldw = 128;
        r.WT = WSH(O_WLR) + (size_t)m * 128 * 128; r.ldt = 128; r.drow = r.n0; return r; }
    it -= I_LR;
    if (it < 2 * I_WU) { const int ua = it / I_WU, q = it % I_WU, z = q / 32, nb = q % 32; r.n0 = nb * 32; r.k0 = 0; r.Wp = c.in[ua ? 23 : 21] + ((size_t)l * 2 + z) * 64 * W; r.ldw = W; r.WT = WSH(ua ? O_WAT : O_WUT) + (size_t)z * W * 64; r.ldt = 64; r.drow = r.n0; return r; }
    it -= 2 * I_WU;
    { const int kb = it / 32, nb = it % 32; r.n0 = nb * 32; r.k0 = kb * 64; r.Wp = c.in[24] + (size_t)l * 128 * W; r.ldw = W; r.WT = WSH(O_WGT); r.ldt = 128; r.drow = r.n0; return r; }
}
constexpr int J_IN = 16 * (INW / 128), J_BR = 4 * 8 * 16, J_OUT = 16 * 16, J_GU = NE * 16 * 8, J_DN = NE * 4 * 16, J_ALL = J_IN + J_BR + J_OUT + J_GU + J_DN;
__device__ __forceinline__ CvtItem cvt_decode_big(const Ctx& c, int l, int it) {
    CvtItem r;
    if (it < J_IN) { const int kb = it / (INW / 128), nb = it % (INW / 128); r.n0 = nb * 128; r.k0 = kb * 128; r.Wp = c.in[7] + (size_t)l * D * INW; r.ldw = INW; r.WT = WSH(O_WIN); r.ldt = D; r.drow = r.n0 < 10624 ? r.n0 : r.n0 + 128; return r; }
    it -= J_IN;
    if (it < J_BR) { const int sgm = it / 128, q = it % 128, kb = q / 16, nb = q % 16; r.n0 = nb * 128; r.k0 = kb * 128; r.Wp = c.in[28] + ((size_t)l * 4 + sgm) * W * D; r.ldw = D; r.WT = WSH(O_WBR) + sgm * W; r.ldt = 4 * W; r.drow = r.n0; return r; }
    it -= J_BR;
    if (it < J_OUT) { const int kb = it / 16, nb = it % 16; r.n0 = nb * 128; r.k0 = kb * 128; r.Wp = c.in[29] + (size_t)l * D * D; r.ldw = D; r.WT = WSH(O_WOUT); r.ldt = D; r.drow = r.n0; return r; }
    it -= J_OUT;
    if (it < J_GU) { const int e = it / 128, q = it % 128, kb = q / 8, nb = q % 8; r.n0 = nb * 128; r.k0 = kb * 128; r.Wp = c.in[34] + ((size_t)l * NE + e) * D * 1024; r.ldw = 1024; r.WT = WSH(O_WGU) + (size_t)e * 1024 * D; r.ldt = D;
        r.drow = r.n0 < 512 ? (r.n0 / 128) * 256 : ((r.n0 - 512) / 128) * 256 + 128; return r; }
    it -= J_GU;
    { const int e = it / 64, q = it % 64, kb = q / 16, nb = q % 16; r.n0 = nb * 128; r.k0 = kb * 128; r.Wp = c.in[35] + ((size_t)l * NE + e) * 512 * D; r.ldw = D; r.WT = WSH(O_WDN) + (size_t)e * D * 512; r.ldt = 512; r.drow = r.n0; return r; }
}
__device__ __forceinline__ void convert_big(const Ctx& c, int l, float* ldsf, int first, int last, int widx, int wcnt) {
    const int tid = threadIdx.x, lr = tid >> 5, lc = (tid & 31) * 4;
    f32x4 rg[8]; int it = first + widx; CvtItem r;
    if (it < last) { r = cvt_decode_big(c, l, it);
#pragma unroll
        for (int i = 0; i < 8; ++i) rg[i] = *(const f32x4*)(r.Wp + (size_t)(r.k0 + lr + 16 * i) * r.ldw + r.n0 + lc); }
    for (; it < last; it += wcnt) {
#pragma unroll
        for (int i = 0; i < 8; ++i) { float* dp = ldsf + (lr + 16 * i) * 129 + lc; dp[0] = rg[i][0]; dp[1] = rg[i][1]; dp[2] = rg[i][2]; dp[3] = rg[i][3]; }
        const CvtItem cur = r; const int nx = it + wcnt;
        if (nx < last) { r = cvt_decode_big(c, l, nx);
#pragma unroll
            for (int i = 0; i < 8; ++i) rg[i] = *(const f32x4*)(r.Wp + (size_t)(r.k0 + lr + 16 * i) * r.ldw + r.n0 + lc); }
        SYNCTHREADS();
#pragma unroll
        for (int q = 0; q < 4; ++q) { const int id = tid + NT * q, n = id >> 4, k8 = (id & 15) * 8; const float* sp = ldsf + k8 * 129 + n;
            u32x4 o; o[0] = pk2(sp[0 * 129], sp[1 * 129]); o[1] = pk2(sp[2 * 129], sp[3 * 129]); o[2] = pk2(sp[4 * 129], sp[5 * 129]); o[3] = pk2(sp[6 * 129], sp[7 * 129]);
            *(u32x4*)(cur.WT + (size_t)(cur.drow + n) * cur.ldt + cur.k0 + k8) = o; }
        SYNCTHREADS();
    }
}
__device__ __forceinline__ int convert_tail_tiles() { const int nun = (T / 256) * (PW / 256), G = (int)gridDim.x, rem = nun % G; return rem == 0 ? 0 : (G - rem) * 10 < J_GU + J_DN ? (G - rem) * 10 : J_GU + J_DN; }
__device__ __forceinline__ int convert_early_tiles(const Ctx& c) { const int G = (int)gridDim.x, nrest = (CTLW(c) + CW_PLAN)[40] * 4 - G; return (nrest >= 0 && nrest < G) ? ((G - nrest) * 12 < J_IN ? (G - nrest) * 12 : J_IN) : 0; }
__device__ __forceinline__ void ph_convert(const Ctx& c, int l, float* ldsf) {
    const int lane = threadIdx.x & 63, wave = threadIdx.x >> 6; const int gw = blockIdx.x * (NT / 64) + wave, ngw = gridDim.x * (NT / 64);
    convert_big(c, l, ldsf, l == 1 ? convert_early_tiles(c) : 0, J_ALL - convert_tail_tiles(), (int)blockIdx.x, (int)gridDim.x);
#ifdef CPU_EMU
    if (lane == 0) for (int it = I_BIG + gw; it < I_ALL; it += ngw) { const CvtItem r = cvt_decode(c, l, it);
        for (int kk = 0; kk < 64; ++kk) for (int nn = 0; nn < 32; ++nn) r.WT[(size_t)(r.drow + nn) * r.ldt + r.k0 + kk] = (bf16_t)f2bf(r.Wp[(size_t)(r.k0 + kk) * r.ldw + r.n0 + nn]); }
#else
    float* scr = ldsf + wave * (64 * 33 + 16);
    for (int it = I_BIG + gw; it < I_ALL; it += ngw) {
        const CvtItem r = cvt_decode(c, l, it);
#pragma unroll 8
        for (int i = 0; i < 32; ++i) { const int kk = 2 * i + (lane >> 5); scr[kk * 33 + (lane & 31)] = r.Wp[(size_t)(r.k0 + kk) * r.ldw + r.n0 + (lane & 31)]; }
        asm volatile("s_waitcnt lgkmcnt(0)" ::: "memory");
        const int cc = lane & 7;
#pragma unroll
        for (int j = 0; j < 4; ++j) { const int n = (lane >> 3) + 8 * j; const float* sp = scr + (8 * cc) * 33 + n;
            u32x4 o; o[0] = pk2(sp[0 * 33], sp[1 * 33]); o[1] = pk2(sp[2 * 33], sp[3 * 33]); o[2] = pk2(sp[4 * 33], sp[5 * 33]); o[3] = pk2(sp[6 * 33], sp[7 * 33]);
            *(u32x4*)(r.WT + (size_t)(r.drow + n) * r.ldt + r.k0 + 8 * cc) = o; }
        asm volatile("s_waitcnt lgkmcnt(0)" ::: "memory");
    }
#endif
    { const float* wg = c.in[30] + (size_t)l * D * 4; const float* we = c.in[32] + (size_t)l * D * 32; bf16_t* wh = WSH(O_WRH); bf16_t* wl = WSH(O_WRL);
      for (long i = GT_; i < (long)48 * D; i += GS_) { const int n = (int)(i / D), k = (int)(i % D); const float w = n < 4 ? wg[k * 4 + n] : n < 36 ? we[k * 32 + (n - 4)] : 0.f; const unsigned hb = f2bf(w); wh[i] = (bf16_t)hb; wl[i] = (bf16_t)f2bf(w - bf2f((bf16_t)hb)); } }
    for (long i = GT_; i < (long)128 * D / 2; i += GS_) ((unsigned*)(WSH(O_WIN) + (size_t)10624 * D))[i] = 0u;
}

namespace pg8 {
constexpr int BM = 256, BK = 64, HALF = 128, HTB = HALF * BK * 2, STAGE_BYTES = 8 * HTB;
__host__ __device__ __forceinline__ int lds_byte(int r, int cc) { const int st = (r >> 4) * 2 + (cc >> 5), rr = r & 15, c2 = cc & 31, ob = rr * 64 + c2 * 2; return st * 1024 + (ob ^ (((ob >> 9) & 1) << 5)); }
__host__ __device__ __forceinline__ void stage_rc(int b, int& R, int& C) { const int st = b / 1024, sb = b % 1024, swz = sb ^ (((sb >> 9) & 1) << 5); R = (st >> 1) * 16 + swz / 64; C = (st & 1) * 32 + (swz % 64) / 2; }
__host__ __device__ __forceinline__ int perm32(int rho) { const int n = rho >> 4, i = rho & 15; return 8 * (i >> 2) + 4 * n + (i & 3); }
struct Unit { int pm, pn, aux; const char* A; const char* B; };
struct Gemm { int K, lda, ldb; };

template <class Epi, class Sched>
__device__ __forceinline__ void gemm_phase(unsigned char* lds_, const Gemm g, const Sched& S, const Epi& E) {
#ifdef CPU_EMU
    if (threadIdx.x != 0) return;
    Unit u; const int K = g.K;
    float* Af = (float*)malloc((size_t)256 * K * 4); float* Bf = (float*)malloc((size_t)256 * K * 4); float* Cf = (float*)malloc(256 * 256 * 4);
    for (int i = 0; S.next(i, u); ++i) {
        const bf16_t* A = (const bf16_t*)u.A; const bf16_t* B = (const bf16_t*)u.B;
        for (int r = 0; r < 256; ++r) for (int k = 0; k < K; ++k) { Af[(size_t)r * K + k] = bf2f(A[(size_t)r * g.lda + k]); Bf[(size_t)r * K + k] = bf2f(B[(size_t)r * g.ldb + k]); }
        const int nseg = Epi::SEGT > 0 ? K / (Epi::SEGT * 64) : 1, kseg = K / nseg;
        for (int wid = 0; wid < 8; ++wid) for (int lane = 0; lane < 64; ++lane) {
            const int wr = wid >> 2, wc = wid & 3, fr = lane & 15, fq = lane >> 4; f32x4 acc[2][2][4][2];
            for (int ai = 0; ai < 2; ++ai) for (int bj = 0; bj < 2; ++bj) for (int m = 0; m < 4; ++m) for (int n = 0; n < 2; ++n) for (int j = 0; j < 4; ++j) acc[ai][bj][m][n][j] = 0.f;
            for (int sg = 0; sg < nseg; ++sg) {
                for (int ai = 0; ai < 2; ++ai) for (int bj = 0; bj < 2; ++bj) for (int m = 0; m < 4; ++m) for (int n = 0; n < 2; ++n) for (int j = 0; j < 4; ++j) {
                    const int r = 128 * ai + 64 * wr + 16 * m + fr, cc = 128 * bj + 32 * wc + (Epi::PERM ? 8 * fq + 4 * n + j : 16 * n + 4 * fq + j);
                    const float* a = Af + (size_t)r * K + sg * kseg; const float* b = Bf + (size_t)cc * K + sg * kseg; float sacc = 0.f; for (int k = 0; k < kseg; ++k) sacc += a[k] * b[k];
                    acc[ai][bj][m][n][j] += sacc; }
                if constexpr (Epi::SEGT > 0) { if (sg + 1 < nseg) E.segment(acc, u, sg, wr, wc, fr, fq); }
            }
            E(acc, u, wr, wc, fr, fq);
        }
    }
    free(Af); free(Bf); free(Cf);
#else
    typedef __attribute__((address_space(3))) unsigned char* ldsp_t;
    ldsp_t lds = (ldsp_t)lds_;
    const int tid = threadIdx.x, wid = __builtin_amdgcn_readfirstlane(tid >> 6), lane = tid & 63, wr = wid >> 2, wc = wid & 3, fr = lane & 15, fq = lane >> 4;
    const int K = g.K, nt = K / BK;
    unsigned voffA[2], voffB[2];
#pragma unroll
    for (int i = 0; i < 2; ++i) { int R, C; stage_rc(tid * 16 + i * 8192, R, C); const int Rb = Epi::PERM ? ((R & ~31) + perm32(R & 31)) : R;
        voffA[i] = (unsigned)(R * g.lda + C) * 2u; voffB[i] = (unsigned)(Rb * g.ldb + C) * 2u; }
    const size_t kstep = (size_t)(BK * 2);
    const size_t hstepA = (size_t)HALF * g.lda * 2, hstepB = (size_t)HALF * g.ldb * 2;
    const unsigned ldsw = (unsigned)wid * 1024u;
    const int aoff = lds_byte(wr * 64 + fr, fq * 8), boff = lds_byte(wc * 32 + fr, fq * 8);
#define PG8_SA(b, h) (((b) * 2 + (h)) * HTB)
#define PG8_SB(b, h) ((4 + (b) * 2 + (h)) * HTB)
#define PG8_STAGE(bufoff, gbase, voff) do { _Pragma("unroll") for (int _i = 0; _i < 2; ++_i) \
        __builtin_amdgcn_global_load_lds((const unsigned*)((const char*)(gbase) + (voff)[_i]), (__attribute__((address_space(3))) unsigned*)(lds + (bufoff) + ldsw + _i * 8192), 16, 0, 0); } while (0)
#define PG8_LDA(dst, b, h) do { _Pragma("unroll") for (int m = 0; m < 4; ++m) _Pragma("unroll") for (int k = 0; k < 2; ++k) dst[m][k] = *(const __attribute__((address_space(3))) bf16x8*)(lds + PG8_SA(b, h) + aoff + m * 2048 + k * 1024); } while (0)
#define PG8_LDB(dst, b, h) do { _Pragma("unroll") for (int n = 0; n < 2; ++n) _Pragma("unroll") for (int k = 0; k < 2; ++k) dst[n][k] = *(const __attribute__((address_space(3))) bf16x8*)(lds + PG8_SB(b, h) + boff + n * 2048 + k * 1024); } while (0)
#define PG8_MMA(ai, bj, At, Bt) do { __builtin_amdgcn_s_setprio(1); _Pragma("unroll") for (int m = 0; m < 4; ++m) _Pragma("unroll") for (int n = 0; n < 2; ++n) _Pragma("unroll") for (int k = 0; k < 2; ++k) \
        acc[ai][bj][m][n] = __builtin_amdgcn_mfma_f32_16x16x32_bf16(Bt[n][k], At[m][k], acc[ai][bj][m][n], 0, 0, 0); __builtin_amdgcn_s_setprio(0); } while (0)
#define PG8_WAIT_V(n) asm volatile("s_waitcnt vmcnt(" #n ")" ::: "memory")
#define PG8_WAIT_L(n) asm volatile("s_waitcnt lgkmcnt(" #n ")" ::: "memory")
#define PG8_BAR __builtin_amdgcn_s_barrier()
#define PG8_SCHED __builtin_amdgcn_sched_barrier(0)
    Unit cur, nxt; int ui = 0;
    if (!S.next(0, cur)) return;
    f32x4 acc[2][2][4][2];
#pragma unroll
    for (int a = 0; a < 2; ++a)
#pragma unroll
        for (int b = 0; b < 2; ++b)
#pragma unroll
            for (int m = 0; m < 4; ++m)
#pragma unroll
                for (int n = 0; n < 2; ++n) acc[a][b][m][n] = (f32x4){0.f, 0.f, 0.f, 0.f};
    bf16x8 At[4][2], B0[2][2], B1[2][2];
    const char* cA = cur.A; const char* cB = cur.B;
    S.a_ready(cur);
    PG8_STAGE(PG8_SB(0, 0), cB, voffB); PG8_STAGE(PG8_SA(0, 0), cA, voffA); PG8_STAGE(PG8_SB(0, 1), cB + hstepB, voffB); PG8_STAGE(PG8_SA(0, 1), cA + hstepA, voffA);
    if (wr == 1) PG8_BAR;
    PG8_WAIT_V(4); PG8_BAR;
    PG8_STAGE(PG8_SB(1, 0), cB + kstep, voffB); PG8_STAGE(PG8_SA(1, 0), cA + kstep, voffA); PG8_STAGE(PG8_SB(1, 1), cB + hstepB + kstep, voffB);
    PG8_WAIT_V(6); PG8_BAR;
    for (;;) {
        const bool has_next = S.next(ui + 1, nxt);
        const char* nA = has_next ? nxt.A : cA; const char* nB = has_next ? nxt.B : cB;
        for (int t = 0; t < nt; t += 2) {
            const bool last = (t == nt - 2);
            const char* a1 = cA + (size_t)(t + 1) * kstep;
            const char* a2 = last ? nA : cA + (size_t)(t + 2) * kstep; const char* b2 = last ? nB : cB + (size_t)(t + 2) * kstep;
            const char* a3 = a2 + kstep; const char* b3 = b2 + kstep;
            if (last && has_next) S.a_ready(nxt);
            PG8_LDB(B0, 0, 0); PG8_SCHED; PG8_LDA(At, 0, 0); PG8_STAGE(PG8_SA(1, 1), a1 + hstepA, voffA);
            PG8_WAIT_L(8); PG8_BAR; PG8_WAIT_L(0); PG8_MMA(0, 0, At, B0); PG8_BAR; PG8_SCHED;
            PG8_LDB(B1, 0, 1); PG8_STAGE(PG8_SB(0, 0), b2, voffB);
            PG8_BAR; PG8_WAIT_L(0); PG8_MMA(0, 1, At, B1); PG8_BAR;
            PG8_LDA(At, 0, 1); PG8_STAGE(PG8_SA(0, 0), a2, voffA);
            PG8_BAR; PG8_WAIT_L(0); PG8_MMA(1, 0, At, B0); PG8_BAR; PG8_SCHED;
            PG8_STAGE(PG8_SB(0, 1), b2 + hstepB, voffB);
            PG8_WAIT_V(6); PG8_BAR; PG8_MMA(1, 1, At, B1); PG8_BAR;
            PG8_LDB(B0, 1, 0); PG8_SCHED; PG8_LDA(At, 1, 0); PG8_STAGE(PG8_SA(0, 1), a2 + hstepA, voffA);
            PG8_WAIT_L(8); PG8_BAR; PG8_WAIT_L(0); PG8_MMA(0, 0, At, B0); PG8_BAR; PG8_SCHED;
            PG8_LDB(B1, 1, 1); PG8_STAGE(PG8_SB(1, 0), b3, voffB);
            PG8_BAR; PG8_WAIT_L(0); PG8_MMA(0, 1, At, B1); PG8_BAR;
            PG8_LDA(At, 1, 1); PG8_STAGE(PG8_SA(1, 0), a3, voffA);
            PG8_BAR; PG8_WAIT_L(0); PG8_MMA(1, 0, At, B0); PG8_BAR; PG8_SCHED;
            PG8_STAGE(PG8_SB(1, 1), b3 + hstepB, voffB);
            PG8_WAIT_V(6); PG8_BAR; PG8_MMA(1, 1, At, B1); PG8_BAR;
            if constexpr (Epi::SEGT > 0) { if ((t + 2) % Epi::SEGT == 0 && t + 2 < nt) E.segment(acc, cur, (t + 2) / Epi::SEGT - 1, wr, wc, fr, fq); }
        }
        E(acc, cur, wr, wc, fr, fq); S.done(cur);
        if (!has_next) break;
#pragma unroll
        for (int a = 0; a < 2; ++a)
#pragma unroll
            for (int b = 0; b < 2; ++b)
#pragma unroll
                for (int m = 0; m < 4; ++m)
#pragma unroll
                    for (int n = 0; n < 2; ++n) acc[a][b][m][n] = (f32x4){0.f, 0.f, 0.f, 0.f};
        cur = nxt; cA = nA; cB = nB; ++ui;
    }
    PG8_WAIT_V(0);
    if (wr == 0) PG8_BAR;
    PG8_BAR;
#undef PG8_SA
#undef PG8_SB
#undef PG8_STAGE
#undef PG8_LDA
#undef PG8_LDB
#undef PG8_MMA
#undef PG8_WAIT_V
#undef PG8_WAIT_L
#undef PG8_BAR
#undef PG8_SCHED
#endif
}

struct StaticOrder {
    int nM, nN, nwg, G, c; const char* A; const char* B; size_t tstepA, tstepB;
    __device__ __forceinline__ void init(int M, int N, int G_, int c_, const void* A_, const void* B_, int lda, int ldb) { nM = M / BM; nN = N / BM; nwg = nM * nN; G = G_; c = c_; A = (const char*)A_; B = (const char*)B_; tstepA = (size_t)BM * lda * 2; tstepB = (size_t)BM * ldb * 2; }
    __device__ __forceinline__ bool next(int i, Unit& u) const {
        const long L = (long)i * G + c; if (L >= nwg) return false;
        int wgid = (int)L; { const int q = nwg / 8, r = nwg % 8, xcd = wgid % 8, off = wgid / 8; wgid = (xcd < r ? xcd * (q + 1) : r * (q + 1) + (xcd - r) * q) + off; }
        const int nig = 8 * nN, gid = wgid / nig, fm = gid * 8, gsz = (nM - fm) < 8 ? (nM - fm) : 8;
        u.pm = fm + ((wgid % nig) % gsz); u.pn = (wgid % nig) / gsz; u.aux = 0; u.A = A + (size_t)u.pm * tstepA; u.B = B + (size_t)u.pn * tstepB; return true;
    }
    __device__ __forceinline__ void a_ready(const Unit&) const {}
    __device__ __forceinline__ void done(const Unit&) const {}
};
struct MergeOrder {
    StaticOrder so; int kseg_bytes;
    __device__ __forceinline__ bool next(int i, Unit& u) const { if (!so.next(i >> 2, u)) return false; u.aux = i & 3; u.A += (size_t)u.aux * kseg_bytes; u.B += (size_t)u.aux * kseg_bytes; return true; }
    __device__ __forceinline__ void a_ready(const Unit&) const {}
    __device__ __forceinline__ void done(const Unit&) const {}
};
struct MoeOrder {
    int G, c, ncol; const int* plan; const char* A; const char* B; size_t tstepA, tstepB, estep;
    __device__ __forceinline__ bool next(int i, Unit& u) const {
        const long L = (long)i * G + c; const int nblk = plan[40]; if (L >= (long)nblk * ncol) return false;
        u.pm = (int)(L / ncol); u.pn = (int)(L % ncol); u.aux = plan[64 + u.pm]; u.A = A + (size_t)u.pm * tstepA; u.B = B + (size_t)u.aux * estep + (size_t)u.pn * tstepB; return true;
    }
    __device__ __forceinline__ void a_ready(const Unit&) const {}
    __device__ __forceinline__ void done(const Unit&) const {}
};

__device__ __forceinline__ u32x4 pack8(const f32x4 v0, const f32x4 v1) { u32x4 w; w[0] = pk2(v0[0], v0[1]); w[1] = pk2(v0[2], v0[3]); w[2] = pk2(v1[0], v1[1]); w[3] = pk2(v1[2], v1[3]); return w; }
struct EpiBf16 {
    static constexpr int SEGT = 0; static constexpr bool PERM = true; bf16_t* O; int ldc;
    __device__ __forceinline__ void operator()(const f32x4 (&acc)[2][2][4][2], const Unit& u, int wr, int wc, int fr, int fq) const {
        const int row0 = u.pm * BM + wr * 64 + fr, col0 = u.pn * BM + wc * 32 + 8 * fq;
#pragma unroll
        for (int ai = 0; ai < 2; ++ai)
#pragma unroll
            for (int m = 0; m < 4; ++m) { bf16_t* rowp = O + (size_t)(row0 + ai * HALF + m * 16) * ldc + col0;
#pragma unroll
                for (int bj = 0; bj < 2; ++bj) *(u32x4*)(rowp + bj * HALF) = pack8(acc[ai][bj][m][0], acc[ai][bj][m][1]); }
    }
};
struct EpiP {
    static constexpr int SEGT = 0; static constexpr bool PERM = true; bf16_t* O; unsigned char* G8;
    __device__ __forceinline__ void operator()(const f32x4 (&acc)[2][2][4][2], const Unit& u, int wr, int wc, int fr, int fq) const {
        const int row0 = u.pm * BM + wr * 64 + fr, col0 = u.pn * BM + wc * 32 + 8 * fq;
        if (u.pn * BM < C_MLP) {
#pragma unroll
            for (int ai = 0; ai < 2; ++ai)
#pragma unroll
                for (int m = 0; m < 4; ++m) { bf16_t* rowp = O + (size_t)(row0 + ai * HALF + m * 16) * PW + col0;
#pragma unroll
                    for (int bj = 0; bj < 2; ++bj) *(u32x4*)(rowp + bj * HALF) = pack8(acc[ai][bj][m][0], acc[ai][bj][m][1]); }
        } else {
#pragma unroll
            for (int ai = 0; ai < 2; ++ai)
#pragma unroll
                for (int m = 0; m < 4; ++m) { unsigned char* rowp = G8 + (size_t)(row0 + ai * HALF + m * 16) * (4 * D) + (col0 - C_MLP);
#pragma unroll
                    for (int bj = 0; bj < 2; ++bj) { unsigned long long w = 0ull;
#pragma unroll
                        for (int q = 0; q < 8; ++q) { const float gq = sigmoidf_(acc[ai][bj][m][q >> 2][q & 3]); w |= (unsigned long long)(unsigned)(gq * 255.f + 0.5f) << (8 * q); }
                        *(unsigned long long*)(rowp + bj * HALF) = w; } }
        }
    }
};
struct EpiMerge {
    static constexpr int SEGT = 16; static constexpr bool PERM = true; const unsigned char* G8; bf16_t* MRG;
    static __device__ __forceinline__ float gq(unsigned long long w, int q) { const unsigned b = (unsigned)(w >> (8 * q)) & 255u; return (b ? (float)b : 0.5f) * (1.f / 255.f); }
    __device__ __forceinline__ void segment(f32x4 (&acc)[2][2][4][2], const Unit& u, int seg, int wr, int wc, int fr, int fq) const {
        const int row0 = u.pm * BM + wr * 64 + fr, col0 = u.pn * BM + wc * 32 + 8 * fq;
#pragma unroll
        for (int ai = 0; ai < 2; ++ai)
#pragma unroll
            for (int m = 0; m < 4; ++m) { const size_t r = (size_t)(row0 + ai * HALF + m * 16);
#pragma unroll
                for (int bj = 0; bj < 2; ++bj) { const int cc = col0 + bj * HALF;
                    const unsigned long long g0 = *(const unsigned long long*)(G8 + r * (4 * D) + seg * D + cc), g1 = *(const unsigned long long*)(G8 + r * (4 * D) + (seg + 1) * D + cc);
#pragma unroll
                    for (int q = 0; q < 4; ++q) { acc[ai][bj][m][0][q] *= gq(g0, q) * frcp_(gq(g1, q)); acc[ai][bj][m][1][q] *= gq(g0, 4 + q) * frcp_(gq(g1, 4 + q)); } }
#ifndef CPU_EMU
                asm volatile("" ::: "memory");
#endif
            }
    }
    __device__ __forceinline__ void operator()(const f32x4 (&acc)[2][2][4][2], const Unit& u, int wr, int wc, int fr, int fq) const {
        const int row0 = u.pm * BM + wr * 64 + fr, col0 = u.pn * BM + wc * 32 + 8 * fq;
#pragma unroll
        for (int ai = 0; ai < 2; ++ai)
#pragma unroll
            for (int m = 0; m < 4; ++m) { const size_t r = (size_t)(row0 + ai * HALF + m * 16);
#pragma unroll
                for (int bj = 0; bj < 2; ++bj) { const int cc = col0 + bj * HALF;
                    const unsigned long long g3 = *(const unsigned long long*)(G8 + r * (4 * D) + 3 * D + cc); f32x4 v0, v1;
#pragma unroll
                    for (int q = 0; q < 4; ++q) { v0[q] = gq(g3, q) * acc[ai][bj][m][0][q]; v1[q] = gq(g3, 4 + q) * acc[ai][bj][m][1][q]; }
                    *(u32x4*)(MRG + r * D + cc) = pack8(v0, v1); }
#ifndef CPU_EMU
                asm volatile("" ::: "memory");
#endif
            }
    }
};
struct EpiResid {
    static constexpr int SEGT = 0; static constexpr bool PERM = false; const float* xin; const float* g1; float* xmid;
    __device__ __forceinline__ void operator()(const f32x4 (&acc)[2][2][4][2], const Unit& u, int wr, int wc, int fr, int fq) const {
        const int row0 = u.pm * BM + wr * 64 + fr, col0 = u.pn * BM + wc * 32 + 4 * fq;
#pragma unroll
        for (int ai = 0; ai < 2; ++ai)
#pragma unroll
            for (int m = 0; m < 4; ++m) { const int r = row0 + ai * HALF + m * 16; const float* gp = g1 + (size_t)(r / S) * D6;
#pragma unroll
                for (int bj = 0; bj < 2; ++bj)
#pragma unroll
                    for (int n = 0; n < 2; ++n) { const int cc = col0 + bj * HALF + n * 16; *(f32x4*)(xmid + (size_t)r * D + cc) = *(const f32x4*)(xin + (size_t)r * D + cc) + *(const f32x4*)(gp + cc) * acc[ai][bj][m][n]; }
#ifndef CPU_EMU
                asm volatile("" ::: "memory");
#endif
            }
    }
};
struct EpiGU {
    static constexpr int SEGT = 0; static constexpr bool PERM = true; bf16_t* ACT;
    __device__ __forceinline__ void operator()(const f32x4 (&acc)[2][2][4][2], const Unit& u, int wr, int wc, int fr, int fq) const {
        const int row0 = u.pm * BM + wr * 64 + fr, col0 = u.pn * HALF + wc * 32 + 8 * fq;
#pragma unroll
        for (int ai = 0; ai < 2; ++ai)
#pragma unroll
            for (int m = 0; m < 4; ++m) { f32x4 v0, v1;
#pragma unroll
                for (int j = 0; j < 4; ++j) { v0[j] = siluf_(acc[ai][0][m][0][j]) * acc[ai][1][m][0][j]; v1[j] = siluf_(acc[ai][0][m][1][j]) * acc[ai][1][m][1][j]; }
                *(u32x4*)(ACT + (size_t)(row0 + ai * HALF + m * 16) * 512 + col0) = pack8(v0, v1); }
    }
};
}

template <int PASS>
__device__ __forceinline__ void ph_lru(const Ctx& c, int l, float* ldsf) {
    const bf16_t* P = WSH(O_P); const float* cw = c.in[8] + (size_t)l * 4 * W; const float* cb = c.in[9] + (size_t)l * W;
    const float* br = c.in[11] + (size_t)l * 2 * W; const float* bi = c.in[13] + (size_t)l * 2 * W; const float* lam = c.in[14] + (size_t)l * 2 * W; const bf16_t* WLR = WSH(O_WLR);
    float* CA = WSF(O_LCA); float* CH = WSF(O_LCH); const float* CI = WSF(O_LCI); bf16_t* Y = WSH(O_YS); unsigned* LAU = (unsigned*)(c.ws + O_LA);
    bf16_t* Xs = (bf16_t*)ldsf; bf16_t* Wr = Xs + 64 * 136; bf16_t* Wi = Wr + 128 * 136; float* AUa = (float*)Wr; float* AUu = AUa + 64 * 128; float* HF = (float*)(Wi + 128 * 136); float* spl = HF + 64 * 128;
    const int tid = threadIdx.x, wv = tid >> 6, lane = tid & 63, fr = lane & 15, fq = lane >> 4, rt = wv & 3, hf = wv >> 2;
    for (int u = blockIdx.x; u < (T / 64) * 8; u += gridDim.x) {
        const int n = u & 7, tile = u >> 3, b = tile / NLC, chk = tile % NLC; const long t0 = (long)tile * 64;
        if (tid < 256) spl[tid] = softplusf_(-lam[(tid >> 7) * W + n * 128 + (tid & 127)]);
#pragma unroll
        for (int q = 0; q < 4; ++q) { const int id = tid + NT * q, tl = id >> 5, e4 = (id & 31) * 4, ch = n * 128 + e4; const long t = t0 + tl; const int sI = (int)(t % S);
            f32x4 acc = *(const f32x4*)(cb + ch);
#pragma unroll
            for (int k = 0; k < 4; ++k) { const int ss = sI + k - 2; if (ss >= 0 && ss < S) acc += ld_bf4(P + (size_t)(t + k - 2) * PW + C_LX + ch) * *(const f32x4*)(cw + k * W + ch); }
            st_bf4(Xs + tl * 136 + e4, acc); }
        for (int z = 0; z < 2; ++z) {
#pragma unroll
            for (int q = 0; q < 4; ++q) { const int id = tid + NT * q, f = id >> 4, e8 = (id & 15) * 8;
                *(u32x4*)(Wr + f * 136 + e8) = *(const u32x4*)(WLR + ((size_t)((z * 2 + 0) * 8 + n) * 128 + f) * 128 + e8); *(u32x4*)(Wi + f * 136 + e8) = *(const u32x4*)(WLR + ((size_t)((z * 2 + 1) * 8 + n) * 128 + f) * 128 + e8); }
            SYNCTHREADS();
            f32x4 ar[4], ai[4];
#pragma unroll
            for (int nt = 0; nt < 4; ++nt) { ar[nt] = (f32x4){0.f, 0.f, 0.f, 0.f}; ai[nt] = (f32x4){0.f, 0.f, 0.f, 0.f}; }
            wave_mma<4, 4>(ar, Xs + rt * 16 * 136, 136, Wr + hf * 64 * 136, 136);
            wave_mma<4, 4>(ai, Xs + rt * 16 * 136, 136, Wi + hf * 64 * 136, 136);
            SYNCTHREADS();
            const int tl = rt * 16 + fr;
#pragma unroll
            for (int nt = 0; nt < 4; ++nt) { const int f = 64 * hf + 16 * nt + 4 * fq, ch = n * 128 + f;
                const f32x4 brv = *(const f32x4*)(br + z * W + ch), biv = *(const f32x4*)(bi + z * W + ch), lmv = *(const f32x4*)(spl + z * 128 + f), xcv = ld_bf4(Xs + tl * 136 + f); f32x4 av, uv, lav;
#pragma unroll
                for (int e = 0; e < 4; ++e) { const float r = sigmoidf_(ar[nt][e] + brv[e]), ig = sigmoidf_(ai[nt][e] + biv[e]), la = -8.f * r * lmv[e]; const float a = fexp_(la); av[e] = a; lav[e] = la; uv[e] = sqrtf(fmaxf(1.f - a * a, 0.f)) * ig * xcv[e]; }
                *(f32x4*)(AUa + tl * 128 + f) = av; *(f32x4*)(AUu + tl * 128 + f) = uv;
                if (PASS == 1) { u32x4 pk;
#pragma unroll
                    for (int e = 0; e < 4; ++e) pk[e] = pk2(lav[e], uv[e]);
                    *(u32x4*)(LAU + ((size_t)z * T + t0 + tl) * W + ch) = pk; } }
            SYNCTHREADS();
            if (tid < 128) { const int f = tid; const size_t ci = (((size_t)z * NB + b) * NLC + chk) * W + n * 128 + f;
                if (PASS == 1) { float prod = 1.f, h = 0.f;
#pragma unroll 8
                    for (int q = 0; q < 64; ++q) { const int sI = z == 0 ? q : 63 - q; const float a = AUa[sI * 128 + f]; h = a * h + AUu[sI * 128 + f]; prod *= a; }
                    CA[ci] = prod; CH[ci] = h;
                } else { float h = CI[ci];
                    if (z == 0) {
#pragma unroll 8
                        for (int q = 0; q < 64; ++q) { h = AUa[q * 128 + f] * h + AUu[q * 128 + f]; HF[q * 128 + f] = h; }
                    } else {
#pragma unroll 8
                        for (int q = 63; q >= 0; --q) { h = AUa[q * 128 + f] * h + AUu[q * 128 + f]; HF[q * 128 + f] += h; } } }
            }
            SYNCTHREADS();
        }
        if (PASS == 2) {
#pragma unroll
            for (int q = 0; q < 4; ++q) { const int id = tid + NT * q, tl = id >> 5, f4 = (id & 31) * 4; const long t = t0 + tl; f32x4 hv = *(const f32x4*)(HF + tl * 128 + f4); const f32x4 gv = ld_bf4(P + (size_t)t * PW + C_LG + n * 128 + f4);
#pragma unroll
                for (int e = 0; e < 4; ++e) hv[e] *= geluf_(gv[e]);
                st_bf4(Y + (size_t)t * 4 * W + 0 * W + n * 128 + f4, hv); }
            SYNCTHREADS();
        }
    }
}
__device__ __forceinline__ void ph_lru_fin(const Ctx& c, float* ldsf) {
    const bf16_t* P = WSH(O_P); const unsigned* LAU = (const unsigned*)(c.ws + O_LA); const float* CI = WSF(O_LCI); bf16_t* Y = WSH(O_YS);
    unsigned* Lz = (unsigned*)ldsf; float* Hz = ldsf + 2 * 64 * 128; const int tid = threadIdx.x;
    for (int u = blockIdx.x; u < (T / 64) * 8; u += gridDim.x) {
        const int n = u & 7, tile = u >> 3, b = tile / NLC, chk = tile % NLC; const long t0 = (long)tile * 64;
#pragma unroll
        for (int q = 0; q < 8; ++q) { const int id = tid + NT * q, z = id >> 11, r = (id >> 5) & 63, c4 = (id & 31) * 4; *(u32x4*)(Lz + z * 8192 + r * 128 + c4) = *(const u32x4*)(LAU + ((size_t)z * T + t0 + r) * W + n * 128 + c4); }
        SYNCTHREADS();
        if (tid < 256) { const int z = tid >> 7, f = tid & 127; float h = CI[(((size_t)z * NB + b) * NLC + chk) * W + n * 128 + f]; const unsigned* lp = Lz + z * 8192 + f; float* hp = Hz + z * 8192 + f;
#pragma unroll 8
            for (int q = 0; q < 64; ++q) { const int sI = z == 0 ? q : 63 - q; const unsigned w = lp[sI * 128]; h = fexp_(bflo(w)) * h + bfhi(w); hp[sI * 128] = h; } }
        SYNCTHREADS();
#pragma unroll
        for (int q = 0; q < 4; ++q) { const int id = tid + NT * q, r = id >> 5, f4 = (id & 31) * 4; const long t = t0 + r; f32x4 o = *(const f32x4*)(Hz + r * 128 + f4) + *(const f32x4*)(Hz + 8192 + r * 128 + f4); const f32x4 gv = ld_bf4(P + (size_t)t * PW + C_LG + n * 128 + f4);
#pragma unroll
            for (int e = 0; e < 4; ++e) o[e] *= geluf_(gv[e]);
            st_bf4(Y + (size_t)t * 4 * W + 0 * W + n * 128 + f4, o); }
        SYNCTHREADS();
    }
}
__device__ __forceinline__ void ph_lru_scan2(const Ctx& c) {
    const float* CA = WSF(O_LCA); const float* CH = WSF(O_LCH); float* CI = WSF(O_LCI);
    for (long i = GT_; i < (long)2 * NB * W; i += GS_) {
        const int w = (int)(i % W), b = (int)((i / W) % NB), z = (int)(i / ((long)W * NB)); float carry = 0.f;
#pragma unroll 16
        for (int q = 0; q < NLC; ++q) { const int ch = z == 0 ? q : NLC - 1 - q; const size_t idx = (((size_t)z * NB + b) * NLC + ch) * W + w; CI[idx] = carry; carry = CA[idx] * carry + CH[idx]; }
    }
}
__device__ __forceinline__ void ph_rope_table(const Ctx& c) {
    const int* pos = (const int*)c.in[2]; float* RT = WSF(O_ROPE);
    for (long i = GT_; i < (long)T * 32; i += GS_) { const int j = (int)(i & 31); const float ang = (float)pos[i >> 5] * powf(10000.f, -(float)(2 * j) / 64.f); RT[i * 2] = cosf(ang); RT[i * 2 + 1] = sinf(ang); }
}
__device__ __forceinline__ void ret_tables(float* tab, int h) {
    const int tid = threadIdx.x; const float lg = loggamma_(h);
    if (tid < 32) tab[tid] = powf(10000.f, -(float)(2 * tid) / 64.f);
    if (tid >= 64 && tid < 64 + 129) tab[tid] = expf((float)(tid - 64) * lg);
}
__device__ __forceinline__ void ph_ret_kv(const Ctx& c, float* ldsf) {
    const float* RT = WSF(O_ROPE); const bf16_t* P = WSH(O_P); float* KVF = WSF(O_KVF); float* KVB = WSF(O_KVB);
    bf16_t* VT = (bf16_t*)ldsf; bf16_t* KF = VT + 128 * 136; bf16_t* KB = KF + 64 * 136; float* tab = (float*)(KB + 64 * 136);
    const int tid = threadIdx.x, wv = tid >> 6, lane = tid & 63, fr = lane & 15, fq = lane >> 4;
    for (int u = blockIdx.x; u < (T / 128) * 8; u += gridDim.x) {
        const int h = u & 7; const long t0 = (long)(u >> 3) * 128;
        ret_tables(tab, h);
        SYNCTHREADS();
        { float x1[8], x2[8];
#pragma unroll
          for (int q = 0; q < 8; ++q) { const int id = tid + NT * q, j = id & 127, dj = id >> 7; const bf16_t* prow = P + (size_t)(t0 + j) * PW + C_RK + h * 64; x1[q] = bf2f(prow[dj]); x2[q] = bf2f(prow[dj + 32]); }
#pragma unroll 1
          for (int q = 0; q < 8; ++q) { const int id = tid + NT * q, j = id & 127, dj = id >> 7; const float cs = RT[((size_t)(t0 + j) * 32 + dj) * 2], sn = RT[((size_t)(t0 + j) * 32 + dj) * 2 + 1];
            const float k1 = x1[q] * cs - x2[q] * sn, k2 = x2[q] * cs + x1[q] * sn, fj = tab[64 + 127 - j], bj = tab[64 + j];
            KF[dj * 136 + j] = (bf16_t)f2bf(k1 * fj); KF[(dj + 32) * 136 + j] = (bf16_t)f2bf(k2 * fj); KB[dj * 136 + j] = (bf16_t)f2bf(k1 * bj); KB[(dj + 32) * 136 + j] = (bf16_t)f2bf(k2 * bj); } }
#pragma unroll
        for (int q = 0; q < 4; ++q) { const int id = tid + NT * q, j = id & 127, e8 = (id >> 7) * 8; const u32x4 raw = *(const u32x4*)(P + (size_t)(t0 + j) * PW + C_RV + h * 128 + e8);
#pragma unroll
            for (int e = 0; e < 4; ++e) { VT[(e8 + 2 * e) * 136 + j] = (bf16_t)(raw[e] & 0xffffu); VT[(e8 + 2 * e + 1) * 136 + j] = (bf16_t)(raw[e] >> 16); } }
        SYNCTHREADS();
        f32x4 af[4], ab[4];
#pragma unroll
        for (int nt = 0; nt < 4; ++nt) { af[nt] = (f32x4){0.f, 0.f, 0.f, 0.f}; ab[nt] = (f32x4){0.f, 0.f, 0.f, 0.f}; }
        wave_mma<4, 4>(af, VT + wv * 16 * 136, 136, KF, 136);
        wave_mma<4, 4>(ab, VT + wv * 16 * 136, 136, KB, 136);
        const size_t ob = (((size_t)(u >> 3) * 8 + h) * 128 + wv * 16 + fr) * 64 + 4 * fq;
#pragma unroll
        for (int nt = 0; nt < 4; ++nt) { *(f32x4*)(KVF + ob + 16 * nt) = af[nt]; *(f32x4*)(KVB + ob + 16 * nt) = ab[nt]; }
        SYNCTHREADS();
    }
}
__device__ __forceinline__ void ph_ret_state(const Ctx& c) {
    const float* KVF = WSF(O_KVF); const float* KVB = WSF(O_KVB); float* STF = WSF(O_STF); float* STB = WSF(O_STB);
    for (long i = GT_; i < (long)NB * 8 * 8192; i += GS_) {
        const int x = (int)(i % 8192), h = (int)((i / 8192) % 8), b = (int)(i / 65536);
        const float cd = expf(128.f * loggamma_(h)); float st = 0.f;
#pragma unroll 16
        for (int n = 0; n < NCH; ++n) { const size_t idx = (((size_t)b * NCH + n) * 8 + h) * 8192 + x; STF[idx] = st; st = cd * st + KVF[idx]; }
        st = 0.f;
#pragma unroll 16
        for (int n = NCH - 1; n >= 0; --n) { const size_t idx = (((size_t)b * NCH + n) * 8 + h) * 8192 + x; STB[idx] = st; st = cd * st + KVB[idx]; }
    }
}
__device__ __forceinline__ void ph_ret_out(const Ctx& c, float* ldsf) {
    const float* RT = WSF(O_ROPE); const bf16_t* P = WSH(O_P); const float* STF = WSF(O_STF); const float* STB = WSF(O_STB); bf16_t* Y = WSH(O_YS);
    bf16_t* Qs = (bf16_t*)ldsf; bf16_t* Ks = Qs + 128 * 72; bf16_t* VT = Ks + 128 * 72; bf16_t* Ss = VT + 128 * 136; bf16_t* SF = Ss + 128 * 136; bf16_t* SB = SF + 128 * 72; float* tab = (float*)(SB + 128 * 72);
    const int tid = threadIdx.x, wv = tid >> 6, lane = tid & 63, fr = lane & 15, fq = lane >> 4;
    for (int u = blockIdx.x; u < (T / 128) * 8; u += gridDim.x) {
        const int h = u & 7; const long t0 = (long)(u >> 3) * 128;
        ret_tables(tab, h);
        SYNCTHREADS();
#pragma unroll 1
        for (int qh = 0; qh < 8; qh += 4) { float q1[4], q2[4], k1[4], k2[4];
#pragma unroll
          for (int q = 0; q < 4; ++q) { const int id = tid + NT * (qh + q), j = id >> 5, dj = id & 31; const bf16_t* prow = P + (size_t)(t0 + j) * PW;
            q1[q] = bf2f(prow[C_RQ + h * 64 + dj]); q2[q] = bf2f(prow[C_RQ + h * 64 + dj + 32]); k1[q] = bf2f(prow[C_RK + h * 64 + dj]); k2[q] = bf2f(prow[C_RK + h * 64 + dj + 32]); }
#pragma unroll
          for (int q = 0; q < 4; ++q) { const int id = tid + NT * (qh + q), j = id >> 5, dj = id & 31; const float cs = RT[((size_t)(t0 + j) * 32 + dj) * 2], sn = RT[((size_t)(t0 + j) * 32 + dj) * 2 + 1];
            Qs[j * 72 + dj] = (bf16_t)f2bf((q1[q] * cs - q2[q] * sn) * 0.125f); Qs[j * 72 + dj + 32] = (bf16_t)f2bf((q2[q] * cs + q1[q] * sn) * 0.125f); Ks[j * 72 + dj] = (bf16_t)f2bf(k1[q] * cs - k2[q] * sn); Ks[j * 72 + dj + 32] = (bf16_t)f2bf(k2[q] * cs + k1[q] * sn); } }
#pragma unroll
        for (int q = 0; q < 4; ++q) { const int id = tid + NT * q, j = id & 127, e8 = (id >> 7) * 8; const u32x4 raw = *(const u32x4*)(P + (size_t)(t0 + j) * PW + C_RV + h * 128 + e8);
#pragma unroll
            for (int e = 0; e < 4; ++e) { VT[(e8 + 2 * e) * 136 + j] = (bf16_t)(raw[e] & 0xffffu); VT[(e8 + 2 * e + 1) * 136 + j] = (bf16_t)(raw[e] >> 16); } }
        const size_t sbase = (((size_t)(u >> 3) * 8 + h)) * 8192;
#pragma unroll
        for (int q = 0; q < 4; ++q) { const int id = tid + NT * q, e = id >> 4, d4 = (id & 15) * 4; st_bf4(SF + e * 72 + d4, *(const f32x4*)(STF + sbase + (size_t)e * 64 + d4)); st_bf4(SB + e * 72 + d4, *(const f32x4*)(STB + sbase + (size_t)e * 64 + d4)); }
        SYNCTHREADS();
        const int i = wv * 16 + fr; const long t = t0 + i;
        {
            f32x4 sc[8];
#pragma unroll
            for (int nt = 0; nt < 8; ++nt) sc[nt] = (f32x4){0.f, 0.f, 0.f, 0.f};
            wave_mma<2, 8>(sc, Qs + wv * 16 * 72, 72, Ks, 72);
#pragma unroll
            for (int nt = 0; nt < 8; ++nt) { const int j0 = 16 * nt + 4 * fq; f32x4 sv;
#pragma unroll
                for (int e = 0; e < 4; ++e) { const int j = j0 + e, dist = i > j ? i - j : j - i; sv[e] = sc[nt][e] * tab[64 + dist]; }
                st_bf4(Ss + i * 136 + j0, sv); }
        }
#ifdef CPU_EMU
        SYNCTHREADS();
#else
        asm volatile("s_waitcnt lgkmcnt(0)" ::: "memory");
#endif
        f32x4 ao[8], tm[8];
#pragma unroll
        for (int nt = 0; nt < 8; ++nt) { ao[nt] = (f32x4){0.f, 0.f, 0.f, 0.f}; tm[nt] = (f32x4){0.f, 0.f, 0.f, 0.f}; }
        wave_mma<4, 8>(ao, Ss + wv * 16 * 136, 136, VT, 136);
        wave_mma<2, 8>(tm, Qs + wv * 16 * 72, 72, SF, 72);
        { const float qf = tab[64 + i + 1];
#pragma unroll
            for (int nt = 0; nt < 8; ++nt) { ao[nt] += tm[nt] * qf; tm[nt] = (f32x4){0.f, 0.f, 0.f, 0.f}; } }
        wave_mma<2, 8>(tm, Qs + wv * 16 * 72, 72, SB, 72);
        { const float qb = tab[64 + 128 - i];
#pragma unroll
            for (int nt = 0; nt < 8; ++nt) ao[nt] += tm[nt] * qb; }
        float sm = 0.f;
#pragma unroll
        for (int nt = 0; nt < 8; ++nt) sm += (ao[nt][0] + ao[nt][1]) + (ao[nt][2] + ao[nt][3]);
        sm += SHFL_XOR(sm, 16); sm += SHFL_XOR(sm, 32);
        const float mu = sm * (1.f / 128.f); float sq = 0.f;
#pragma unroll
        for (int nt = 0; nt < 8; ++nt) { ao[nt] -= mu; sq += (ao[nt][0] * ao[nt][0] + ao[nt][1] * ao[nt][1]) + (ao[nt][2] * ao[nt][2] + ao[nt][3] * ao[nt][3]); }
        sq += SHFL_XOR(sq, 16); sq += SHFL_XOR(sq, 32);
        const float rs = 1.f / sqrtf(sq * (1.f / 128.f) + EPS);
#pragma unroll
        for (int nt = 0; nt < 8; ++nt) { const int e0 = 16 * nt + 4 * fq; f32x4 gv = ld_bf4(P + (size_t)t * PW + C_RG + h * 128 + e0);
#pragma unroll
            for (int e = 0; e < 4; ++e) gv[e] = siluf_(gv[e]) * (ao[nt][e] * rs);
            st_bf4(Y + (size_t)t * 4 * W + 1 * W + h * 128 + e0, gv); }
        SYNCTHREADS();
    }
}
__device__ __forceinline__ void ph_sgu_norm(const Ctx& c, int l) {
    const bf16_t* P = WSH(O_P); float* ST = WSF(O_VN);
    const int lane = threadIdx.x & 63, gw = blockIdx.x * (NT / 64) + (threadIdx.x >> 6), ngw = gridDim.x * (NT / 64);
    for (int t = gw; t < T; t += ngw) {
        f32x4 v[4]; float sm = 0.f;
#pragma unroll
        for (int j = 0; j < 4; ++j) { v[j] = ld_bf4(P + (size_t)t * PW + C_SV + (j * 64 + lane) * 4);
#pragma unroll
            for (int q = 0; q < 4; ++q) { v[j][q] = geluf_(v[j][q]); sm += v[j][q]; } }
        const float mu = wave_sum(sm) * (1.f / W); float sq = 0.f;
#pragma unroll
        for (int j = 0; j < 4; ++j)
#pragma unroll
            for (int q = 0; q < 4; ++q) { const float dd = v[j][q] - mu; sq += dd * dd; }
        const float rs = 1.f / sqrtf(wave_sum(sq) * (1.f / W) + EPS);
        if (lane == 0) { ST[(size_t)t * 2] = mu; ST[(size_t)t * 2 + 1] = rs; }
    }
}
__device__ __forceinline__ void ph_sgu_mix(const Ctx& c, int l, float* ldsf) {
    const bf16_t* P = WSH(O_P); const float* ST = WSF(O_VN); bf16_t* Y = WSH(O_YS); const float* ng = c.in[15] + (size_t)l * W;
    bf16_t* As = (bf16_t*)ldsf; bf16_t* Bs = As + 128 * 136; const int tid = threadIdx.x, wv = tid >> 6, lane = tid & 63, fr = lane & 15, fq = lane >> 4;
    for (int u = blockIdx.x; u < (T / 128) * 8; u += gridDim.x) {
        const int g = u & 7; const long t0 = (long)(u >> 3) * 128;
        const float* ws = c.in[16] + ((size_t)l * 8 + g) * 128 * 128; const float* bs = c.in[17] + ((size_t)l * 8 + g) * 128;
#pragma unroll
        for (int q = 0; q < 8; ++q) { const int id = tid + NT * q, i = id >> 5, j4 = (id & 31) * 4; st_bf4(As + i * 136 + j4, *(const f32x4*)(ws + i * 128 + j4)); }
#pragma unroll
        for (int q = 0; q < 4; ++q) { const int id = tid + NT * q, j = id & 127, d8 = (id >> 7) * 8; const float mu = ST[(size_t)(t0 + j) * 2], rs = ST[(size_t)(t0 + j) * 2 + 1];
            const u32x4 raw = *(const u32x4*)(P + (size_t)(t0 + j) * PW + C_SV + g * 128 + d8);
#pragma unroll
            for (int e = 0; e < 4; ++e) { const float v0 = (geluf_(bflo(raw[e])) - mu) * rs * ng[g * 128 + d8 + 2 * e], v1 = (geluf_(bfhi(raw[e])) - mu) * rs * ng[g * 128 + d8 + 2 * e + 1];
                Bs[(d8 + 2 * e) * 136 + j] = (bf16_t)f2bf(v0); Bs[(d8 + 2 * e + 1) * 136 + j] = (bf16_t)f2bf(v1); } }
        SYNCTHREADS();
        f32x4 acc[8];
#pragma unroll
        for (int nt = 0; nt < 8; ++nt) acc[nt] = (f32x4){0.f, 0.f, 0.f, 0.f};
        wave_mma<4, 8>(acc, As + wv * 16 * 136, 136, Bs, 136);
        const int i = wv * 16 + fr; const long t = t0 + i; const float bsi = bs[i];
#pragma unroll
        for (int nt = 0; nt < 8; ++nt) { const int d = 16 * nt + 4 * fq; f32x4 uu = ld_bf4(P + (size_t)t * PW + C_SU + g * 128 + d);
#pragma unroll
            for (int e = 0; e < 4; ++e) uu[e] = geluf_(uu[e]) * (acc[nt][e] + bsi);
            st_bf4(Y + (size_t)t * 4 * W + 2 * W + g * 128 + d, uu); }
        SYNCTHREADS();
    }
}
__device__ __forceinline__ void ph_rw_shift(const Ctx& c, int l) {
    const bf16_t* P = WSH(O_P); const float* mup = c.in[18] + (size_t)l * RF; const float* mun = c.in[19] + (size_t)l * RF; bf16_t* FS = WSH(O_FS);
    const int lane = threadIdx.x & 63, gw = blockIdx.x * (NT / 64) + (threadIdx.x >> 6), ngw = gridDim.x * (NT / 64);
    for (int t = gw; t < T; t += ngw) {
        const int sI = t % S; const bf16_t* pc = P + (size_t)t * PW + C_RW;
#pragma unroll 2
        for (int j = lane * 4; j < RF; j += 256) {
            const f32x4 f = ld_bf4(pc + j), z4 = (f32x4){0.f, 0.f, 0.f, 0.f}; const f32x4 pv = sI > 0 ? ld_bf4(pc - PW + j) : z4, nv = sI < S - 1 ? ld_bf4(pc + PW + j) : z4;
            f32x4 v = f + *(const f32x4*)(mup + j) * (pv - f) + *(const f32x4*)(mun + j) * (nv - f);
            if (j >= 3072 && j < 3200) {
#pragma unroll
                for (int e = 0; e < 4; ++e) v[e] = tanhf_(v[e]); }
            else if (j >= 3328) {
#pragma unroll
                for (int e = 0; e < 4; ++e) v[e] = sigmoidf_(v[e]); }
            st_bf4(FS + (size_t)t * RF + j, v);
        }
    }
}
__device__ __forceinline__ void ph_rw_lora(const Ctx& c, int l, float* ldsf) {
    const bf16_t* FS = WSH(O_FS); const float* w0 = c.in[20] + (size_t)l * 2 * W; const float* a0 = c.in[22] + (size_t)l * 2 * W;
    const bf16_t* WUT = WSH(O_WUT); const bf16_t* WAT = WSH(O_WAT); const bf16_t* WGT = WSH(O_WGT);
    bf16_t* DEC = WSH(O_DEC); bf16_t* AA = WSH(O_AA); bf16_t* GG = WSH(O_GG);
    bf16_t* F = (bf16_t*)ldsf; bf16_t* B1 = F + 128 * 136; bf16_t* B2 = B1 + 128 * 136; const int tid = threadIdx.x, wv = tid >> 6, lane = tid & 63, fr = lane & 15, fq = lane >> 4;
    for (int u = blockIdx.x; u < (T / 128) * 8; u += gridDim.x) {
        const int wc0 = (u & 7) * 128; const long t0 = (long)(u >> 3) * 128;
        for (int rd = 0; rd < 3; ++rd) {
#pragma unroll
            for (int q = 0; q < 8; ++q) { const int id = tid + NT * q, r = id >> 5, c4 = (id & 31) * 4;
                const int col = rd < 2 ? (c4 < 64 ? 3072 + rd * 64 + c4 : 3200 + rd * 64 + (c4 - 64)) : 3328 + c4;
                *(unsigned long long*)(F + r * 136 + c4) = *(const unsigned long long*)(FS + (size_t)(t0 + r) * RF + col); }
            if (rd < 2) {
#pragma unroll
                for (int q = 0; q < 2; ++q) { const int id = tid + NT * q, w = id >> 3, r8 = (id & 7) * 8;
                    *(u32x4*)(B1 + w * 72 + r8) = *(const u32x4*)(WUT + ((size_t)rd * W + wc0 + w) * 64 + r8); *(u32x4*)(B2 + w * 72 + r8) = *(const u32x4*)(WAT + ((size_t)rd * W + wc0 + w) * 64 + r8); }
            } else {
#pragma unroll
                for (int q = 0; q < 4; ++q) { const int id = tid + NT * q, w = id >> 4, r8 = (id & 15) * 8; *(u32x4*)(B1 + w * 136 + r8) = *(const u32x4*)(WGT + ((size_t)wc0 + w) * 128 + r8); }
            }
            SYNCTHREADS();
            f32x4 a1[8], a2[8];
#pragma unroll
            for (int nt = 0; nt < 8; ++nt) { a1[nt] = (f32x4){0.f, 0.f, 0.f, 0.f}; a2[nt] = (f32x4){0.f, 0.f, 0.f, 0.f}; }
            const long t = t0 + wv * 16 + fr;
            if (rd < 2) {
                wave_mma<2, 8>(a1, F + wv * 16 * 136, 136, B1, 72);
                wave_mma<2, 8>(a2, F + wv * 16 * 136 + 64, 136, B2, 72);
#pragma unroll
                for (int nt = 0; nt < 8; ++nt) { const int ch = wc0 + 16 * nt + 4 * fq; const f32x4 w0v = *(const f32x4*)(w0 + rd * W + ch), a0v = *(const f32x4*)(a0 + rd * W + ch); f32x4 dv, av;
#pragma unroll
                    for (int e = 0; e < 4; ++e) { dv[e] = fexp_(-DECAY_SCALE * sigmoidf_(a1[nt][e] + w0v[e])); av[e] = sigmoidf_(a2[nt][e] + a0v[e]); }
                    st_bf4(DEC + ((size_t)rd * T + t) * W + ch, dv); st_bf4(AA + ((size_t)rd * T + t) * W + ch, av); }
            } else {
                wave_mma<4, 8>(a1, F + wv * 16 * 136, 136, B1, 136);
#pragma unroll
                for (int nt = 0; nt < 8; ++nt) st_bf4(GG + (size_t)t * W + wc0 + 16 * nt + 4 * fq, a1[nt]);
            }
            SYNCTHREADS();
        }
    }
}
#ifdef CPU_EMU
__device__ __forceinline__ float red16_(float x) { x += SHFL_XOR(x, 1); x += SHFL_XOR(x, 2); x += SHFL_XOR(x, 4); x += SHFL_XOR(x, 8); return x; }
#define LDS_BARRIER() emu_syncthreads()
#else
__device__ __forceinline__ float red16_(float x) {
    x += __builtin_bit_cast(float, __builtin_amdgcn_update_dpp(0, __builtin_bit_cast(int, x), 0xB1, 0xF, 0xF, true));
    x += __builtin_bit_cast(float, __builtin_amdgcn_update_dpp(0, __builtin_bit_cast(int, x), 0x4E, 0xF, 0xF, true));
    x += __builtin_bit_cast(float, __builtin_amdgcn_update_dpp(0, __builtin_bit_cast(int, x), 0x141, 0xF, 0xF, true));
    x += __builtin_bit_cast(float, __builtin_amdgcn_update_dpp(0, __builtin_bit_cast(int, x), 0x140, 0xF, 0xF, true));
    return x;
}
#define LDS_BARRIER() do { asm volatile("s_waitcnt lgkmcnt(0)" ::: "memory"); __builtin_amdgcn_s_barrier(); asm volatile("" ::: "memory"); } while (0)
#endif
#define RC_M(k) (lm + (k) * 4608)
__device__ __forceinline__ void ph_rw_chunk(const Ctx& c, int l, float* ldsf) {
    const bf16_t* FS = WSH(O_FS); const bf16_t* DEC = WSH(O_DEC); const bf16_t* AA = WSH(O_AA); float* BON = WSF(O_BON);
    const float* kkw = c.in[25] + (size_t)l * W; const float* kaw = c.in[26] + (size_t)l * W; const float* rk = c.in[27] + (size_t)l * W;
    bf16_t* PST = WSH(O_PST); bf16_t* PYT = WSH(O_PYT); bf16_t* SVB = WSH(O_SVB); bf16_t* YVB = WSH(O_YVB);
    bf16_t* lm = (bf16_t*)ldsf; float* gam = (float*)RC_M(7); float* segp = (float*)RC_M(13); float* gl = segp + 512;
    const int tid = threadIdx.x, wv = tid >> 6, lane = tid & 63, fr = lane & 15, fq = lane >> 4, rt = wv & 3, hf = wv >> 2;
    const int m0 = 16 * rt + fr;
    float wv8[8], kv8[8], rv8[8], vv8[8], aa8[8];
#define RC_LOAD(uu) do { const int chain_ = (uu) / NRC, ck_ = (uu) % NRC, h_ = chain_ & 15, b_ = (chain_ >> 4) & 1, z_ = chain_ >> 5; \
        const long tb_ = (long)b_ * S + (z_ ? S - 1 - ck_ * RCK : ck_ * RCK); const int dirn_ = z_ ? -1 : 1; \
        const bf16_t* decp_ = DEC + ((size_t)z_ * T) * W + h_ * 64; const bf16_t* aap_ = AA + ((size_t)z_ * T) * W + h_ * 64; const int ch_ = h_ * 64 + lane; \
        _Pragma("unroll") for (int q = 0; q < 8; ++q) wv8[q] = bf2f(decp_[(size_t)(tb_ + dirn_ * ((tid >> 6) * 8 + q)) * W + (tid & 63)]); \
        _Pragma("unroll") for (int q = 0; q < 8; ++q) { const long t_ = tb_ + dirn_ * (wv + 8 * q); const bf16_t* f_ = FS + (size_t)t_ * RF; kv8[q] = bf2f(f_[1024 + ch_]); rv8[q] = bf2f(f_[ch_]); vv8[q] = bf2f(f_[2048 + ch_]); aa8[q] = bf2f(aap_[(size_t)t_ * W + lane]); } } while (0)
    if ((int)blockIdx.x < 64 * NRC) RC_LOAD((int)blockIdx.x);
    for (int u = blockIdx.x; u < 64 * NRC; u += gridDim.x) {
        const int chain = u / NRC, ck = u % NRC, h = chain & 15, b = (chain >> 4) & 1, z = chain >> 5;
        const long tb = (long)b * S + (z ? S - 1 - ck * RCK : ck * RCK); const int dirn = z ? -1 : 1;
        { const int k = tid & 63, sg = tid >> 6; float p = 1.f;
#pragma unroll
          for (int q = 0; q < 8; ++q) { p *= wv8[q]; gam[(sg * 8 + q) * 64 + k] = p; }
          segp[sg * 64 + k] = p; }
        LDS_BARRIER();
        { const int k = tid & 63, sg = tid >> 6; float pre = 1.f;
          for (int q = 0; q < sg; ++q) pre *= segp[q * 64 + k];
#pragma unroll
          for (int q = 0; q < 8; ++q) gam[(sg * 8 + q) * 64 + k] *= pre;
          if (sg == 7) gl[k] = gam[63 * 64 + k]; }
        LDS_BARRIER();
        { const int k = lane, ch = h * 64 + k; const float kkwv = kkw[ch], kav = kaw[ch], rkv = rk[ch];
#pragma unroll
          for (int q = 0; q < 8; ++q) { const int tt = wv + 8 * q; const long t = tb + dirn * tt;
            const float vk = kv8[q] * kkwv; const float kkn = vk * frsq_(wave_sum(vk * vk) + EPS); const float ktv = kv8[q] * (1.f + (aa8[q] - 1.f) * kav);
            const float bsum = wave_sum(rv8[q] * rkv * ktv); if (lane == 0) BON[((size_t)z * T + t) * 16 + h] = bsum;
            const float g = gam[tt * 64 + k], gp = tt ? gam[(tt - 1) * 64 + k] : 1.f, ig = frcp_(g);
            const bf16_t khv = (bf16_t)f2bf(kkn * gp), bhv = (bf16_t)f2bf(aa8[q] * kkn * ig);
            RC_M(0)[tt * 72 + k] = khv; RC_M(1)[k * 72 + tt] = khv; RC_M(2)[tt * 72 + k] = bhv; RC_M(3)[k * 72 + tt] = bhv;
            RC_M(4)[tt * 72 + k] = (bf16_t)f2bf(ktv * ig); RC_M(5)[tt * 72 + k] = (bf16_t)f2bf(rv8[q] * g); RC_M(6)[k * 72 + tt] = (bf16_t)f2bf(vv8[q]); } }
        if (u + (int)gridDim.x < 64 * NRC) RC_LOAD(u + (int)gridDim.x);
        LDS_BARRIER();
        f32x4 mkr[2], khr[2], rhT[2];
        {
            f32x4 a0[2], a1[2], a2[2], a3[2];
#pragma unroll
            for (int nt = 0; nt < 2; ++nt) { a0[nt] = (f32x4){0.f, 0.f, 0.f, 0.f}; a1[nt] = a0[nt]; a2[nt] = a0[nt]; a3[nt] = a0[nt]; }
            wave_mma<2, 2>(a0, RC_M(2) + rt * 16 * 72, 72, RC_M(0) + hf * 32 * 72, 72);
            wave_mma<2, 2>(a1, RC_M(4) + rt * 16 * 72, 72, RC_M(0) + hf * 32 * 72, 72);
            wave_mma<2, 2>(a2, RC_M(2) + rt * 16 * 72, 72, RC_M(5) + hf * 32 * 72, 72);
            wave_mma<2, 2>(a3, RC_M(4) + rt * 16 * 72, 72, RC_M(5) + hf * 32 * 72, 72);
#pragma unroll
            for (int nt = 0; nt < 2; ++nt) { const int n0 = 32 * hf + 16 * nt + 4 * fq; f32x4 nn, ti, mk;
#pragma unroll
                for (int r = 0; r < 4; ++r) { const int n = n0 + r; const bool lt = m0 < n, le = m0 <= n;
                    nn[r] = lt ? -a0[nt][r] : 0.f; ti[r] = nn[r] + (m0 == n ? 1.f : 0.f); mk[r] = lt ? a1[nt][r] : 0.f; mkr[nt][r] = le ? a3[nt][r] : 0.f;
                    RC_M(12)[n * 72 + m0] = (bf16_t)f2bf(le ? a2[nt][r] : 0.f);
                    RC_M(8)[n * 72 + m0] = (bf16_t)f2bf(nn[r]);
                    khr[nt][r] = bf2f(RC_M(4)[m0 * 72 + n]); rhT[nt][r] = bf2f(RC_M(5)[n * 72 + m0]); }
                st_bf4(RC_M(7) + m0 * 72 + n0, nn); st_bf4(RC_M(9) + m0 * 72 + n0, ti); st_bf4(RC_M(11) + m0 * 72 + n0, mk); }
        }
        LDS_BARRIER();
        f32x4 tiv[2];
#pragma unroll
        for (int nt = 0; nt < 2; ++nt) tiv[nt] = ld_bf4(RC_M(9) + m0 * 72 + 32 * hf + 16 * nt + 4 * fq);
#pragma unroll 1
        for (int it = 0; it < 5; ++it) {
            bf16_t* pw = (it & 1) ? RC_M(0) : RC_M(7); bf16_t* pwT = (it & 1) ? RC_M(2) : RC_M(8); bf16_t* pw2 = (it & 1) ? RC_M(7) : RC_M(0); bf16_t* pw2T = (it & 1) ? RC_M(8) : RC_M(2);
            bf16_t* tcur = (it & 1) ? RC_M(4) : RC_M(9); bf16_t* tnxt = (it & 1) ? RC_M(9) : RC_M(4);
            f32x4 sq[2];
#pragma unroll
            for (int nt = 0; nt < 2; ++nt) sq[nt] = (f32x4){0.f, 0.f, 0.f, 0.f};
            wave_mma<2, 2>(sq, pw + rt * 16 * 72, 72, pwT + hf * 32 * 72, 72);
#pragma unroll
            for (int nt = 0; nt < 2; ++nt) { const int n0 = 32 * hf + 16 * nt + 4 * fq; st_bf4(pw2 + m0 * 72 + n0, sq[nt]);
#pragma unroll
                for (int r = 0; r < 4; ++r) pw2T[(n0 + r) * 72 + m0] = (bf16_t)f2bf(sq[nt][r]); }
            LDS_BARRIER();
            f32x4 up[2];
#pragma unroll
            for (int nt = 0; nt < 2; ++nt) up[nt] = (f32x4){0.f, 0.f, 0.f, 0.f};
            wave_mma<2, 2>(up, tcur + rt * 16 * 72, 72, pw2T + hf * 32 * 72, 72);
#pragma unroll
            for (int nt = 0; nt < 2; ++nt) { const int n0 = 32 * hf + 16 * nt + 4 * fq; tiv[nt] += up[nt]; st_bf4(tnxt + m0 * 72 + n0, tiv[nt]);
                if (it == 4) {
#pragma unroll
                    for (int r = 0; r < 4; ++r) RC_M(10)[(n0 + r) * 72 + m0] = (bf16_t)f2bf(tiv[nt][r]); } }
            LDS_BARRIER();
        }
        {
            f32x4 w1[2], w2[2];
#pragma unroll
            for (int nt = 0; nt < 2; ++nt) { w1[nt] = (f32x4){0.f, 0.f, 0.f, 0.f}; w2[nt] = w1[nt]; }
            wave_mma<2, 2>(w1, RC_M(1) + rt * 16 * 72, 72, RC_M(10) + hf * 32 * 72, 72);
            wave_mma<2, 2>(w2, RC_M(11) + rt * 16 * 72, 72, RC_M(10) + hf * 32 * 72, 72);
#pragma unroll
            for (int nt = 0; nt < 2; ++nt) { const int n0 = 32 * hf + 16 * nt + 4 * fq; st_bf4(RC_M(7) + m0 * 72 + n0, w1[nt]); st_bf4(RC_M(8) + m0 * 72 + n0, w2[nt]); }
        }
        LDS_BARRIER();
        {
            f32x4 py[2], qy[2], ps[2], qs[2];
#pragma unroll
            for (int nt = 0; nt < 2; ++nt) { py[nt] = (f32x4){0.f, 0.f, 0.f, 0.f}; qy[nt] = py[nt]; ps[nt] = py[nt]; qs[nt] = py[nt]; }
            wave_mma<2, 2>(py, RC_M(7) + rt * 16 * 72, 72, RC_M(12) + hf * 32 * 72, 72);
            wave_mma<2, 2>(qy, RC_M(8) + rt * 16 * 72, 72, RC_M(12) + hf * 32 * 72, 72);
            wave_mma<2, 2>(ps, RC_M(7) + rt * 16 * 72, 72, RC_M(3) + hf * 32 * 72, 72);
            wave_mma<2, 2>(qs, RC_M(8) + rt * 16 * 72, 72, RC_M(3) + hf * 32 * 72, 72);
#pragma unroll
            for (int nt = 0; nt < 2; ++nt) { const int n0 = 32 * hf + 16 * nt + 4 * fq;
#pragma unroll
                for (int r = 0; r < 4; ++r) { const int n = n0 + r; const float gln = gl[n];
                    RC_M(0)[n * 72 + m0] = (bf16_t)f2bf(rhT[nt][r] - py[nt][r]); RC_M(2)[n * 72 + m0] = (bf16_t)f2bf(mkr[nt][r] - qy[nt][r]);
                    RC_M(4)[n * 72 + m0] = (bf16_t)f2bf(((m0 == n ? 1.f : 0.f) - ps[nt][r]) * gln); RC_M(5)[n * 72 + m0] = (bf16_t)f2bf((khr[nt][r] - qs[nt][r]) * gln); } }
        }
        LDS_BARRIER();
        {
            f32x4 yv[2], sv[2];
#pragma unroll
            for (int nt = 0; nt < 2; ++nt) { yv[nt] = (f32x4){0.f, 0.f, 0.f, 0.f}; sv[nt] = yv[nt]; }
            wave_mma<2, 2>(yv, RC_M(6) + rt * 16 * 72, 72, RC_M(2) + hf * 32 * 72, 72);
            wave_mma<2, 2>(sv, RC_M(6) + rt * 16 * 72, 72, RC_M(5) + hf * 32 * 72, 72);
#pragma unroll
            for (int nt = 0; nt < 2; ++nt) { const int n0 = 32 * hf + 16 * nt + 4 * fq; st_bf4(YVB + (size_t)u * 4096 + m0 * 64 + n0, yv[nt]); st_bf4(SVB + (size_t)u * 4096 + m0 * 64 + n0, sv[nt]); }
            { const int rr = tid >> 3, c8 = (tid & 7) * 8; *(u32x4*)(PYT + (size_t)u * 4096 + rr * 64 + c8) = *(const u32x4*)(RC_M(0) + rr * 72 + c8); *(u32x4*)(PST + (size_t)u * 4096 + rr * 64 + c8) = *(const u32x4*)(RC_M(4) + rr * 72 + c8); }
        }
        LDS_BARRIER();
    }
}
#undef RC_M
#undef RC_LOAD
__device__ __forceinline__ void ph_rw_seq(const Ctx& c, float* ldsf) {
    const bf16_t* PST = WSH(O_PST); const bf16_t* PYT = WSH(O_PYT); const bf16_t* SVB = WSH(O_SVB); const bf16_t* YVB = WSH(O_YVB); bf16_t* YY = WSH(O_YY);
    bf16_t* Sb = (bf16_t*)ldsf;
    bf16_t* Pm = Sb + 2 * 16 * 72;
    const int tid = threadIdx.x, wv = tid >> 6, lane = tid & 63, fr = lane & 15, fq = lane >> 4, nt0 = wv & 3;
#ifdef CPU_EMU
    const int isY = wv >> 2;
#else
    const int isY = __builtin_amdgcn_readfirstlane(wv >> 2);
#endif
    for (int u = blockIdx.x; u < 256; u += gridDim.x) {
        const int x = u & 7, jq = u >> 3, chain = x * 8 + (jq >> 2), qt = jq & 3, h = chain & 15, b = (chain >> 4) & 1, z = chain >> 5;
        const size_t ub = (size_t)chain * NRC;
        const int rr = tid >> 3, c8 = (tid & 7) * 8;
        constexpr int PD = NRC >= 8 ? 8 : 4;
        for (int i = tid; i < 2 * 16 * 72 / 2; i += NT) ((unsigned*)Sb)[i] = 0u;
        const int row = 16 * qt + fr, n0 = 16 * nt0 + 4 * fq; const bf16_t* addp = (isY ? YVB : SVB) + ub * 4096 + row * 64 + n0;
        const bf16_t* psp = PST + ub * 4096 + rr * 64 + c8; const bf16_t* pyp = PYT + ub * 4096 + rr * 64 + c8;
        u32x4 gps[PD], gpy[PD]; unsigned long long addr[PD];
#pragma unroll
        for (int j = 0; j < PD; ++j) { gps[j] = *(const u32x4*)(psp + (size_t)j * 4096); gpy[j] = *(const u32x4*)(pyp + (size_t)j * 4096); addr[j] = *(const unsigned long long*)(addp + (size_t)j * 4096); }
        *(u32x4*)(Pm + (0 * 2 + 0) * 4608 + rr * 72 + c8) = gps[0]; *(u32x4*)(Pm + (0 * 2 + 1) * 4608 + rr * 72 + c8) = gpy[0];
        { const int cl = PD < NRC ? PD : NRC - 1; gps[0] = *(const u32x4*)(psp + (size_t)cl * 4096); gpy[0] = *(const u32x4*)(pyp + (size_t)cl * 4096); }
        SYNCTHREADS();
#define RS_LOOP(ISY) \
        for (int ck0 = 0; ck0 < NRC; ck0 += PD) { \
            _Pragma("unroll") for (int j = 0; j < PD; ++j) { \
                const int ck = ck0 + j, cur = j & 1, nxt = cur ^ 1;        \
                f32x4 acc[1]; acc[0] = (f32x4){0.f, 0.f, 0.f, 0.f}; \
                wave_mma<2, 1>(acc, Sb + cur * 16 * 72, 72, Pm + (cur * 2 + ISY) * 4608 + nt0 * 16 * 72, 72); \
                { const unsigned lo_ = (unsigned)addr[j], hi_ = (unsigned)(addr[j] >> 32); acc[0][0] += bflo(lo_); acc[0][1] += bfhi(lo_); acc[0][2] += bflo(hi_); acc[0][3] += bfhi(hi_); } \
                { const int cl = ck + PD < NRC ? ck + PD : NRC - 1; addr[j] = *(const unsigned long long*)(addp + (size_t)cl * 4096); } \
                if (ISY) { \
                    _Pragma("unroll") for (int r = 0; r < 4; ++r) { const int step = ck * RCK + n0 + r, sidx = z ? S - 1 - step : step; YY[((size_t)z * T + (size_t)b * S + sidx) * W + h * 64 + row] = (bf16_t)f2bf(acc[0][r]); } \
                } else st_bf4(Sb + nxt * 16 * 72 + fr * 72 + n0, acc[0]); \
                const int jn = (j + 1) % PD; \
                *(u32x4*)(Pm + (nxt * 2 + 0) * 4608 + rr * 72 + c8) = gps[jn]; *(u32x4*)(Pm + (nxt * 2 + 1) * 4608 + rr * 72 + c8) = gpy[jn]; \
                { const int cl = ck + 1 + PD < NRC ? ck + 1 + PD : NRC - 1; gps[jn] = *(const u32x4*)(psp + (size_t)cl * 4096); gpy[jn] = *(const u32x4*)(pyp + (size_t)cl * 4096); } \
                LDS_BARRIER(); \
            } \
        }
        if (isY) { RS_LOOP(1) } else { RS_LOOP(0) }
#undef RS_LOOP
    }
}
__device__ __forceinline__ void ph_rw_out(const Ctx& c) {
    const bf16_t* FS = WSH(O_FS); const bf16_t* YY = WSH(O_YY); const float* BON = WSF(O_BON); const bf16_t* GG = WSH(O_GG); bf16_t* Y = WSH(O_YS);
    const int lane = threadIdx.x & 63, gw = blockIdx.x * (NT / 64) + (threadIdx.x >> 6), ngw = gridDim.x * (NT / 64);
    for (int i = gw; i < T * 4; i += ngw) {
        const int h0 = (i & 3) * 4; const long t = i >> 2; float y0[4], y1[4], gv[4], vv[4], bs[4];
#pragma unroll
        for (int q = 0; q < 4; ++q) { const int ch = (h0 + q) * 64 + lane; y0[q] = bf2f(YY[(size_t)t * W + ch]); y1[q] = bf2f(YY[((size_t)T + t) * W + ch]); gv[q] = bf2f(GG[(size_t)t * W + ch]); vv[q] = bf2f(FS[(size_t)t * RF + 2048 + ch]);
            bs[q] = BON[(size_t)t * 16 + h0 + q] + BON[((size_t)T + t) * 16 + h0 + q]; }
#pragma unroll
        for (int q = 0; q < 4; ++q) { const int ch = (h0 + q) * 64 + lane;
            const float m0 = wave_sum(y0[q]) * (1.f / 64.f), m1 = wave_sum(y1[q]) * (1.f / 64.f); const float d0 = y0[q] - m0, d1 = y1[q] - m1;
            const float r0 = 1.f / sqrtf(wave_sum(d0 * d0) * (1.f / 64.f) + EPS), r1 = 1.f / sqrtf(wave_sum(d1 * d1) * (1.f / 64.f) + EPS);
            Y[(size_t)t * 4 * W + 3 * W + ch] = (bf16_t)f2bf((d0 * r0 + d1 * r1 + bs[q] * vv[q]) * gv[q]); }
    }
}
__device__ __forceinline__ void ph_router(const Ctx& c, int l, float* ldsf, const float* X, const float* gN, const float* shN, const float* scN) {
    const float* RS = WSF(O_HF); const bf16_t* WH = WSH(O_WRH); const bf16_t* WL = WSH(O_WRL); const float* bg = c.in[31] + (size_t)l * 4; const float* be = c.in[33] + (size_t)l * 32;
    int* EID = WSI(O_EID); float* EWT = WSF(O_EWT); int* cnt = CTLW(c) + CW_CNT + l * 64;
    const int tid = threadIdx.x, wv = tid >> 6, lane = tid & 63, fr = lane & 15, fq = lane >> 4, rt = wv & 1, kq = wv >> 1;
    float* part = ldsf;
    for (int u = blockIdx.x; u < T / 32; u += gridDim.x) {
        const long t0 = (long)u * 32; f32x4 acc[3];
#pragma unroll
        for (int nt = 0; nt < 3; ++nt) acc[nt] = (f32x4){0.f, 0.f, 0.f, 0.f};
#ifdef CPU_EMU
        for (int nt = 0; nt < 3; ++nt) for (int r = 0; r < 4; ++r) { const int n = 16 * nt + 4 * fq + r; float sacc = 0.f;
            for (int k = kq * 512; k < kq * 512 + 512; ++k) { const long tr = t0 + 16 * rt + fr; const int bb = (int)(tr / S); const float hv = X[(size_t)tr * D + k] * RS[tr] * gN[k] * (1.f + scN[bb * D6 + k]) + shN[bb * D6 + k]; const float hh = bf2f((bf16_t)f2bf(hv)), hl = bf2f((bf16_t)f2bf(hv - hh));
                const float wh = bf2f(WH[(size_t)n * D + k]), wl = bf2f(WL[(size_t)n * D + k]); sacc += hh * wh + hl * wh + hh * wl; }
            acc[nt][r] = sacc; }
#else
        const long tr = t0 + 16 * rt + fr; const int bb = (int)(tr / S); const float rsv = RS[tr]; const int kb = kq * 512 + fq * 8;
        const float* hp = X + (size_t)tr * D + kb; const float* gp_ = gN + kb; const float* scp = scN + bb * D6 + kb; const float* shp = shN + bb * D6 + kb;
#pragma unroll 4
        for (int ks = 0; ks < 16; ++ks) {
            const f32x4 h0 = *(const f32x4*)(hp + ks * 32) * rsv * *(const f32x4*)(gp_ + ks * 32) * (*(const f32x4*)(scp + ks * 32) + 1.f) + *(const f32x4*)(shp + ks * 32);
            const f32x4 h1 = *(const f32x4*)(hp + ks * 32 + 4) * rsv * *(const f32x4*)(gp_ + ks * 32 + 4) * (*(const f32x4*)(scp + ks * 32 + 4) + 1.f) + *(const f32x4*)(shp + ks * 32 + 4); bf16x8 ah, al;
#pragma unroll
            for (int e = 0; e < 4; ++e) { const unsigned b0 = f2bf(h0[e]), b1 = f2bf(h1[e]); ah[e] = (short)b0; ah[4 + e] = (short)b1; al[e] = (short)f2bf(h0[e] - u2f_(b0 << 16)); al[4 + e] = (short)f2bf(h1[e] - u2f_(b1 << 16)); }
#pragma unroll
            for (int nt = 0; nt < 3; ++nt) { const size_t wo = (size_t)(16 * nt + fr) * D + kq * 512 + ks * 32 + fq * 8; const bf16x8 bh = *(const bf16x8*)(WH + wo), bl = *(const bf16x8*)(WL + wo);
                acc[nt] = __builtin_amdgcn_mfma_f32_16x16x32_bf16(bh, ah, acc[nt], 0, 0, 0); acc[nt] = __builtin_amdgcn_mfma_f32_16x16x32_bf16(bh, al, acc[nt], 0, 0, 0); acc[nt] = __builtin_amdgcn_mfma_f32_16x16x32_bf16(bl, ah, acc[nt], 0, 0, 0); }
        }
#endif
#pragma unroll
        for (int nt = 0; nt < 3; ++nt) *(f32x4*)(part + (kq * 32 + 16 * rt + fr) * 48 + 16 * nt + 4 * fq) = acc[nt];
        SYNCTHREADS();
        if (tid < 32) { const long t = t0 + tid; float lg[36];
#pragma unroll
            for (int q = 0; q < 36; ++q) lg[q] = (part[(0 * 32 + tid) * 48 + q] + part[(1 * 32 + tid) * 48 + q]) + (part[(2 * 32 + tid) * 48 + q] + part[(3 * 32 + tid) * 48 + q]) + (q < 4 ? bg[q < 4 ? q : 0] : be[q >= 4 ? q - 4 : 0]);
            int gi = 0; float m = lg[0];
#pragma unroll
            for (int q = 1; q < 4; ++q) if (lg[q] > m) { m = lg[q]; gi = q; }
            float den = 0.f;
#pragma unroll
            for (int q = 0; q < 4; ++q) den += expf(lg[q] - m);
            const float gp = 1.f / den; float el[8];
#pragma unroll
            for (int q = 0; q < 8; ++q) el[q] = gi == 0 ? lg[4 + q] : gi == 1 ? lg[12 + q] : gi == 2 ? lg[20 + q] : lg[28 + q];
            int i1 = 0; float m1 = el[0];
#pragma unroll
            for (int q = 1; q < 8; ++q) if (el[q] > m1) { m1 = el[q]; i1 = q; }
            int i2 = -1; float m2 = 0.f;
#pragma unroll
            for (int q = 0; q < 8; ++q) if (q != i1 && (i2 < 0 || el[q] > m2)) { m2 = el[q]; i2 = q; }
            const float p2 = expf(m2 - m1);
            EID[t * 2] = gi * 8 + i1; EID[t * 2 + 1] = gi * 8 + i2; EWT[t * 2] = gp / (1.f + p2); EWT[t * 2 + 1] = gp * p2 / (1.f + p2);
            atomic_add_i(cnt + gi * 8 + i1, 1); atomic_add_i(cnt + gi * 8 + i2, 1);
        }
        SYNCTHREADS();
    }
}
__device__ __forceinline__ void ph_moe_assign(const Ctx& c, int l, float* ldsf) {
    const int* cnt = CTLW(c) + CW_CNT + l * 64; int* plan = CTLW(c) + CW_PLAN + l * 256; const int* EID = WSI(O_EID); int* fill = CTLW(c) + CW_FILL + l * 64; int* DEST = WSI(O_DEST);
    int* pstart = (int*)ldsf;
    if (threadIdx.x == 0) { int ps = 0, nb = 0; const bool pub = blockIdx.x == 0;
        for (int e = 0; e < NE; ++e) { pstart[e] = ps; if (pub) plan[e] = ps; const int nblk = (cnt[e] + 255) / 256; if (pub) for (int q = 0; q < nblk; ++q) plan[64 + nb + q] = e; nb += nblk; ps += nblk * 256; }
        if (pub) { plan[32] = ps; plan[40] = nb; } }
    SYNCTHREADS();
    for (long i = GT_; i < (long)T * 2; i += GS_) { const int e = EID[i]; const int pos = atomic_add_i(fill + e, 1); DEST[i] = pstart[e] + pos; }
    SYNCTHREADS();
}
__device__ __forceinline__ void ph_moe_gather(const Ctx& c) {
    const int* DEST = WSI(O_DEST); const u32x4* H = (const u32x4*)WSH(O_H); u32x4* XS = (u32x4*)WSH(O_XS);
    for (long i = GT_; i < (long)T * 2 * (D / 8); i += GS_) { const int q = (int)(i % (D / 8)); const long a = i / (D / 8); XS[(size_t)DEST[a] * (D / 8) + q] = H[(size_t)(a >> 1) * (D / 8) + q]; }
}
#ifndef CPU_EMU
#define XB_TMO      128
#define XB_XCNT(j)  (256  + 64 * (j))
#define XB_XSUB(j)  (1280 + 64 * (j))
#define XB_XGEN(j)  (2304 + 64 * (j))
#define XB_TOP      3328
#define XB_TOPGEN   3392
#define XCD_BAR_WORDS 3456
#define XB_SPIN_CAP (1u << 26)
#define LAS __attribute__((address_space(3)))
__device__ __forceinline__ unsigned xb_ld(unsigned* p)              { return __hip_atomic_load(p, __ATOMIC_RELAXED, __HIP_MEMORY_SCOPE_AGENT); }
__device__ __forceinline__ unsigned xb_add(unsigned* p, unsigned v) { return __hip_atomic_fetch_add(p, v, __ATOMIC_RELAXED, __HIP_MEMORY_SCOPE_AGENT); }
__device__ __forceinline__ unsigned xb_xcc_id() { return (unsigned)__builtin_amdgcn_s_getreg((3 << 11) | 20) & 0xFu; }
#define XB_SPIN(cond, bar) do { unsigned _sp = 0; while (cond) { __builtin_amdgcn_s_sleep(1); \
    if ((++_sp & 255u) == 0u) { if (xb_ld(&(bar)[XB_TMO])) break; if (_sp > XB_SPIN_CAP) { atomicAdd(&(bar)[XB_TMO], 1u); break; } } } } while (0)
struct XcdBarrier { unsigned* bar; unsigned x; volatile LAS unsigned* st; };
__device__ __forceinline__ XcdBarrier xcd_barrier_post(unsigned* bar, volatile LAS unsigned* st) {
    XcdBarrier b; b.bar = bar; b.x = xb_xcc_id(); b.st = st;
    if (threadIdx.x == 0) (void)xb_add(&bar[XB_XCNT(b.x)], 1u);
    return b;
}
__device__ __forceinline__ void xcd_barrier_complete(unsigned* bar, unsigned x, unsigned& nloc, unsigned& nx) {
    const unsigned G = gridDim.x * gridDim.y * gridDim.z;
    unsigned sum, cnt, mine, sp = 0u;
    for (;;) {
        sum = 0u; cnt = 0u; mine = 0u;
#pragma unroll
        for (unsigned j = 0; j < 16; ++j) { const unsigned cc = xb_ld(&bar[XB_XCNT(j)]); sum += cc; cnt += (cc > 0u) ? 1u : 0u; mine = (j == x) ? cc : mine; }
        if (sum == G) break;
        __builtin_amdgcn_s_sleep(1);
        if ((++sp & 255u) == 0u) { if (xb_ld(&bar[XB_TMO])) break; if (sp > XB_SPIN_CAP) { atomicAdd(&bar[XB_TMO], 1u); break; } }
    }
    nloc = mine > 0u ? mine : 1u; nx = cnt > 0u ? cnt : 1u;
}
__device__ __forceinline__ void xcd_barrier(const XcdBarrier& b) {
    asm volatile("s_waitcnt vmcnt(0)" ::: "memory");
    __syncthreads();
    if (threadIdx.x == 0) {
        unsigned* bar = b.bar;
        __builtin_amdgcn_s_waitcnt(0);
        unsigned nloc = b.st[0], nx = b.st[1];
        if (nloc == 0u) { xcd_barrier_complete(bar, b.x, nloc, nx); b.st[0] = nloc; b.st[1] = nx; }
        const unsigned old = xb_add(&bar[XB_XSUB(b.x)], 1u);
        const unsigned gen = old / nloc;
        if (old + 1u == (gen + 1u) * nloc) {
            __builtin_amdgcn_fence(__ATOMIC_RELEASE, "agent");
            asm volatile("s_waitcnt vmcnt(0)" ::: "memory");
            const unsigned og = xb_add(&bar[XB_TOP], 1u);
            const unsigned tg = og / nx;
            if (og + 1u == (tg + 1u) * nx) xb_add(&bar[XB_TOPGEN], 1u);
            else XB_SPIN(xb_ld(&bar[XB_TOPGEN]) == tg, bar);
            __builtin_amdgcn_fence(__ATOMIC_ACQUIRE, "agent");
            xb_add(&bar[XB_XGEN(b.x)], 1u);
            asm volatile("s_waitcnt vmcnt(0)" ::: "memory");
        } else {
            XB_SPIN(xb_ld(&bar[XB_XGEN(b.x)]) == gen, bar);
            __builtin_amdgcn_fence(__ATOMIC_ACQUIRE, "agent");
            asm volatile("s_waitcnt vmcnt(0)" ::: "memory");
        }
    }
    __syncthreads();
}
#endif

constexpr int LDS_BYTES = 147456;

__global__ void __launch_bounds__(NT, 2) fwd(Params p) {
#ifdef CPU_EMU
    unsigned char* lds = g_lds; float* ldsf = (float*)g_lds;
#else
    extern __shared__ __attribute__((aligned(16))) unsigned char lds[];
    float* ldsf = (float*)lds;
    volatile LAS unsigned* misc = (volatile LAS unsigned*)((LAS unsigned char*)lds + LDS_BYTES - 64);
    if (threadIdx.x == 0) { misc[0] = 0u; misc[1] = 0u; }
    __syncthreads();
    XcdBarrier bar = xcd_barrier_post((unsigned*)(p.ws + O_CTL) + CW_BAR, misc);
#endif
    Ctx c; c.in = p.in; c.out = p.out; c.ws = p.ws;
    const int lo = p.ph_lo, hi = p.ph_hi; int ph = 0;
    const int G = (int)gridDim.x, cwg = (int)blockIdx.x;
#ifdef CPU_EMU
#define GRID_BAR()
#else
#define GRID_BAR() xcd_barrier(bar)
#endif
#ifndef REPEAT_MASK
#define REPEAT_MASK 0
#endif
#ifndef TIME_PHASE
#define TIME_PHASE -1
#endif
#if TIME_PHASE >= 0 && !defined(CPU_EMU)
    unsigned long long tp0 = 0, tp1 = 0;
#define TP_BEGIN() do { if (ph == TIME_PHASE) tp0 = __builtin_amdgcn_s_memrealtime(); } while (0)
#define TP_END() do { if (ph == TIME_PHASE) tp1 = __builtin_amdgcn_s_memrealtime(); } while (0)
#else
#define TP_BEGIN()
#define TP_END()
#endif
#define PHASE(...) do { if (lo <= ph && ph < hi) { TP_BEGIN(); __VA_ARGS__; if (ph + 1 < hi) { GRID_BAR(); } TP_END(); } ++ph; } while (0)
#define PHASEG(grp, ...) do { if (lo <= ph && ph < hi) { TP_BEGIN(); if ((REPEAT_MASK >> (grp)) & 1) { __VA_ARGS__; GRID_BAR(); } __VA_ARGS__; if (ph + 1 < hi) { GRID_BAR(); } TP_END(); } ++ph; } while (0)
    PHASE(ph_mod(c, ldsf); ph_rope_table(c); ph_convert(c, 0, ldsf));
#define LAYER_BODY(l) do { const float* mod = WSF(O_MOD); \
        const float* xin = l == 0 ? c.in[0] : WSF(O_X1); float* xmid = WSF(O_X0); float* xout = WSF(O_X1); \
        const float* ml = mod + (size_t)l * NB * D6; \
        PHASEG(0, { pg8::Gemm g{D, D, D}; pg8::StaticOrder so; so.init(T, PW, G, cwg, WSH(O_H), WSH(O_WIN), D, D); pg8::EpiP E{WSH(O_P), (unsigned char*)(c.ws + O_G8)}; pg8::gemm_phase(lds, g, so, E); \
            { const int nun_ = (T / 256) * (PW / 256), rem_ = nun_ % G; if (rem_ != 0 && cwg >= rem_) { SYNCTHREADS(); convert_big(c, l, ldsf, J_ALL - convert_tail_tiles(), J_ALL, cwg - rem_, G - rem_); } } }); \
        PHASE(ph_lru<1>(c, l, ldsf); ph_ret_kv(c, ldsf); ph_sgu_norm(c, l); ph_rw_shift(c, l)); \
        PHASE(ph_lru_scan2(c); ph_ret_state(c); ph_sgu_mix(c, l, ldsf); ph_rw_lora(c, l, ldsf)); \
        PHASE(ph_lru_fin(c, ldsf); ph_ret_out(c, ldsf); ph_rw_chunk(c, l, ldsf)); \
        PHASE(ph_rw_seq(c, ldsf)); \
        PHASE(ph_rw_out(c)); \
        PHASEG(1, { pg8::Gemm g{4 * W, 4 * W, 4 * W}; pg8::StaticOrder so; so.init(T, D, G, cwg, WSH(O_YS), WSH(O_WBR), 4 * W, 4 * W); pg8::EpiMerge E{(const unsigned char*)(c.ws + O_G8), WSH(O_MRG)}; pg8::gemm_phase(lds, g, so, E); }); \
        PHASEG(1, { pg8::Gemm g{D, D, D}; pg8::StaticOrder so; so.init(T, D, G, cwg, WSH(O_MRG), WSH(O_WOUT), D, D); pg8::EpiResid E{xin, ml + 2 * D, xmid}; pg8::gemm_phase(lds, g, so, E); }); \
        PHASEG(6, ph_norm(c, xmid, c.in[4] + (size_t)l * D, ml + 3 * D, ml + 4 * D, WSH(O_H), WSF(O_HF))); \
        PHASE(ph_router(c, l, ldsf, xmid, c.in[4] + (size_t)l * D, ml + 3 * D, ml + 4 * D)); \
        PHASE(ph_moe_assign(c, l, ldsf)); \
        PHASEG(6, ph_moe_gather(c)); \
        const int* plan = CTLW(c) + CW_PLAN + l * 256; \
        PHASEG(2, { pg8::Gemm g{D, D, D}; pg8::MoeOrder mo{G, cwg, 4, plan, (const char*)WSH(O_XS), (const char*)WSH(O_WGU), (size_t)256 * D * 2, (size_t)256 * D * 2, (size_t)1024 * D * 2}; pg8::EpiGU E{WSH(O_ACT)}; pg8::gemm_phase(lds, g, mo, E); \
            if (l == 0) { const int nrest_ = plan[40] * 4 - G; if (nrest_ >= 0 && nrest_ < G && cwg >= nrest_) { SYNCTHREADS(); convert_big(c, 1, ldsf, 0, convert_early_tiles(c), cwg - nrest_, G - nrest_); } } }); \
        PHASEG(2, { pg8::Gemm g{512, 512, 512}; pg8::MoeOrder mo{G, cwg, 8, plan, (const char*)WSH(O_ACT), (const char*)WSH(O_WDN), (size_t)256 * 512 * 2, (size_t)256 * 512 * 2, (size_t)D * 512 * 2}; pg8::EpiBf16 E{WSH(O_YE), D}; pg8::gemm_phase(lds, g, mo, E); }); \
        if (l == 0) PHASE(ph_comb_norm<0>(c, xmid, ml + 5 * D, xout, c.in[3] + (size_t)1 * D, mod + (size_t)1 * NB * D6 + 0 * D, mod + (size_t)1 * NB * D6 + 1 * D, WSH(O_H), nullptr); ph_convert(c, 1, ldsf)); \
        else PHASE(ph_comb_norm<1>(c, xmid, ml + 5 * D, xout, c.in[36], nullptr, nullptr, nullptr, c.out)); \
    } while (0)
    PHASE(ph_norm(c, c.in[0], c.in[3], WSF(O_MOD) + 0 * D, WSF(O_MOD) + 1 * D, WSH(O_H), nullptr));
    LAYER_BODY(0);
    LAYER_BODY(1);
#undef LAYER_BODY
#if TIME_PHASE >= 0 && !defined(CPU_EMU)
    if (blockIdx.x == 0) { const unsigned long long te = __builtin_amdgcn_s_memrealtime(), dl = 8ull * (tp1 - tp0); while (__builtin_amdgcn_s_memrealtime() - te < dl) __builtin_amdgcn_s_sleep(8); }
#endif
#undef PHASE
}
}

#ifndef CPU_EMU
extern "C" void kernel_launch(void* const* d_in, const int* in_sizes, int n_in, void* d_out, int out_size, void* d_ws, size_t ws_size, hipStream_t stream) {
    static int grid = 0;
    if (grid == 0) {
        if (n_in != 37 || out_size != T * D || ws_size < WS_END) { fprintf(stderr, "kernel_launch: unexpected shapes (n_in %d out %d ws %zu need %zu)\n", n_in, out_size, ws_size, (size_t)WS_END); grid = -1; return; }
        int dev = 0, cus = 0, per_cu = 0;
        if (hipGetDevice(&dev) != hipSuccess || hipDeviceGetAttribute(&cus, hipDeviceAttributeMultiprocessorCount, dev) != hipSuccess) { grid = -1; return; }
        if (hipFuncSetAttribute((const void*)fwd, hipFuncAttributeMaxDynamicSharedMemorySize, LDS_BYTES) != hipSuccess) { fprintf(stderr, "kernel_launch: hipFuncSetAttribute failed\n"); grid = -1; return; }
        if (hipOccupancyMaxActiveBlocksPerMultiprocessor(&per_cu, (const void*)fwd, NT, LDS_BYTES) != hipSuccess || per_cu < 1) fprintf(stderr, "kernel_launch: occupancy query says %d\n", per_cu);
        (void)hipGetLastError();
        grid = cus;
    }
    if (grid < 0) return;
    (void)in_sizes;
    (void)hipMemsetAsync((char*)d_ws + O_CTL, 0, CTL_BYTES, stream);
    Params p{};
    for (int i = 0; i < 37; ++i) p.in[i] = (const float*)d_in[i];
    p.out = (float*)d_out; p.ws = (unsigned char*)d_ws;
#if ONE_LAUNCH
    p.ph_lo = 0; p.ph_hi = NPH;
    hipLaunchKernelGGL(fwd, dim3(grid), dim3(NT), LDS_BYTES, stream, p);
#else
    for (int k = 0; k < NPH; ++k) { p.ph_lo = k; p.ph_hi = k + 1; hipLaunchKernelGGL(fwd, dim3(grid), dim3(NT), LDS_BYTES, stream, p); }
#endif
}
#endif
```

```cpp
#ifndef CPU_EMU
#include <hip/hip_runtime.h>
#endif
#include <cstdio>
#include <cstdint>
#include <cmath>
#include <cstring>

#ifndef SEQ
#define SEQ 4096
#endif
#ifndef ONE_LAUNCH
#define ONE_LAUNCH 1
#endif

namespace {
constexpr int D = 2048, NB = 2, S = SEQ, T = NB * S, NL = 2, W = 1024;
constexpr int INW = 18816, RF = 3456, D6 = 6 * D;
constexpr int C_LX = 0, C_LG = 1024, C_RQ = 2048, C_RK = 2560, C_RV = 3072, C_RG = 4096, C_SU = 5120, C_SV = 6144, C_RW = 7168;
constexpr int PW = 18944, C_MLP = 10752;
constexpr int NCH = S / 128;
constexpr int NLC = S / 64;
constexpr int NE = 32, CAP = (T * 2 / 256 + NE) * 256, MAXBLK = CAP / 256;
constexpr float EPS = 1e-6f;
constexpr float DECAY_SCALE = 0.60653065971263342f;
constexpr int NT = 512;
constexpr int NPH_LAYER = 15, NPH = 2 + NL * NPH_LAYER;
typedef unsigned short bf16_t;
#ifdef CPU_EMU
typedef float f32x4 __attribute__((vector_size(16)));
typedef unsigned u32x4 __attribute__((vector_size(16)));
#else
typedef float f32x4 __attribute__((ext_vector_type(4)));
typedef unsigned u32x4 __attribute__((ext_vector_type(4)));
typedef short bf16x8 __attribute__((ext_vector_type(8)));
#endif

constexpr size_t al256(size_t x) { return (x + 255) & ~(size_t)255; }
constexpr size_t SZ_X = (size_t)T * D * 4, SZ_W = (size_t)T * W * 4;
constexpr size_t O_CTL = 0, CTL_BYTES = 1u << 20;
constexpr size_t O_MOD = CTL_BYTES;
constexpr size_t O_X0 = O_MOD + al256((size_t)NL * NB * D6 * 4);
constexpr size_t O_X1 = O_X0 + SZ_X;
constexpr size_t O_H = O_X1 + SZ_X;
constexpr size_t O_HF = O_H + SZ_X / 2;
constexpr size_t O_P = O_HF + SZ_X;
constexpr size_t SZ_P = (size_t)T * PW * 2;
constexpr size_t O_XC = O_P + SZ_P;
constexpr size_t O_LA = O_XC + SZ_W, O_LU = O_LA + 2 * SZ_W;
constexpr size_t SZ_LC = (size_t)2 * NB * NLC * W * 4;
constexpr size_t O_LCA = O_LU + 2 * SZ_W, O_LCH = O_LCA + SZ_LC, O_LCI = O_LCH + SZ_LC;
constexpr size_t O_YS = O_LCI + SZ_LC;
constexpr size_t O_SC = O_YS + (size_t)T * 4 * W * 2;
constexpr size_t SZ_KV = (size_t)NB * NCH * 8 * 64 * 128 * 4;
constexpr size_t O_KVF = O_SC, O_KVB = O_KVF + SZ_KV, O_STF = O_KVB + SZ_KV, O_STB = O_STF + SZ_KV;
constexpr size_t O_VN = O_STB + SZ_KV;
constexpr size_t O_FS = O_VN + SZ_W;
constexpr size_t O_DEC = O_FS + al256((size_t)T * RF * 4), O_AA = O_DEC + 2 * SZ_W, O_AKK = O_AA + 2 * SZ_W;
constexpr size_t O_GG = O_AKK, O_YY = O_GG + SZ_W;
constexpr int RCK = 64, NRC = S / RCK;
constexpr size_t O_BON = O_YY + 2 * SZ_W;
constexpr size_t O_PART = O_BON + al256((size_t)2 * T * 16 * 4);
constexpr size_t O_MRG = O_PART + SZ_X;
constexpr size_t O_LOG = O_MRG + SZ_X / 2;
constexpr size_t O_EID = O_LOG + al256((size_t)T * 40 * 4), O_EWT = O_EID + al256((size_t)T * 2 * 4), O_DEST = O_EWT + al256((size_t)T * 2 * 4);
constexpr size_t O_SLOT = O_DEST + al256((size_t)T * 2 * 4);
constexpr size_t O_PST = O_SLOT + al256((size_t)CAP * 4), O_PYT = O_PST + (size_t)64 * NRC * 4096 * 2, O_SVB = O_PYT + (size_t)64 * NRC * 4096 * 2, O_YVB = O_SVB + (size_t)64 * NRC * 4096 * 4;
constexpr size_t O_WIN = O_YVB + (size_t)64 * NRC * 4096 * 4;
constexpr size_t O_WBR = O_WIN + (size_t)PW * D * 2;
constexpr size_t O_WOUT = O_WBR + (size_t)D * 4 * W * 2;
constexpr size_t O_WGU = O_WOUT + (size_t)D * D * 2;
constexpr size_t O_WDN = O_WGU + (size_t)NE * 1024 * D * 2;
constexpr size_t O_G8 = O_WDN + (size_t)NE * D * 512 * 2;
constexpr size_t O_ROPE = O_G8 + (size_t)T * 4 * D;
constexpr size_t O_WLR = O_ROPE + (size_t)T * 64 * 4;
constexpr size_t O_WUT = O_WLR + (size_t)32 * 128 * 128 * 2;
constexpr size_t O_WAT = O_WUT + (size_t)2 * W * 64 * 2;
constexpr size_t O_WGT = O_WAT + (size_t)2 * W * 64 * 2;
constexpr size_t O_WRH = O_WGT + (size_t)W * 128 * 2;
constexpr size_t O_WRL = O_WRH + (size_t)48 * D * 2;
constexpr size_t WS_END0 = O_WRL + (size_t)48 * D * 2;
constexpr size_t SZ_MOE = (size_t)CAP * (D + 512 + D) * 2;
constexpr bool MOE_OVERLAY = SZ_MOE <= SZ_P;
constexpr size_t O_XS = MOE_OVERLAY ? O_P : WS_END0;
constexpr size_t O_ACT = O_XS + (size_t)CAP * D * 2;
constexpr size_t O_YE = O_ACT + (size_t)CAP * 512 * 2;
constexpr size_t WS_END = MOE_OVERLAY ? WS_END0 : WS_END0 + SZ_MOE;
static_assert(SEQ != 4096 || WS_END <= (size_t)2040 * 1024 * 1024, "workspace budget: d_ws is 4 x the largest input = 2048 MiB");
constexpr int CW_BAR = 4096;
constexpr int CW_CNT = 32768;
constexpr int CW_FILL = CW_CNT + NL * 64;
constexpr int CW_PLAN = CW_FILL + NL * 64;
static_assert(MAXBLK <= 160, "plan words");

struct Params { const float* in[37]; float* out; unsigned char* ws; int ph_lo, ph_hi; };

struct Ctx { const float* const* in; float* out; unsigned char* ws; };
#define GT_ ((long)blockIdx.x * NT + threadIdx.x)
#define GS_ ((long)gridDim.x * NT)
#define WSF(off) ((float*)(c.ws + (off)))
#define WSI(off) ((int*)(c.ws + (off)))
#define WSH(off) ((bf16_t*)(c.ws + (off)))
#define CTLW(c) ((int*)((c).ws + O_CTL))

#ifdef CPU_EMU
__device__ __forceinline__ float fexp_(float x) { return expf(x); }
__device__ __forceinline__ float frcp_(float x) { return 1.f / x; }
__device__ __forceinline__ float frsq_(float x) { return 1.f / sqrtf(x); }
#else
__device__ __forceinline__ float fexp_(float x) { return __builtin_amdgcn_exp2f(x * 1.4426950408889634f); }
__device__ __forceinline__ float frcp_(float x) { return __builtin_amdgcn_rcpf(x); }
__device__ __forceinline__ float frsq_(float x) { return __builtin_amdgcn_rsqf(x); }
#endif
__device__ __forceinline__ float sigmoidf_(float x) { return frcp_(1.f + fexp_(-x)); }
__device__ __forceinline__ float siluf_(float x) { return x * frcp_(1.f + fexp_(-x)); }
__device__ __forceinline__ float tanhf_(float x) { return 1.f - 2.f * frcp_(1.f + fexp_(2.f * x)); }
__device__ __forceinline__ float geluf_(float x) { return 0.5f * x * (1.f + tanhf_(0.7978845608028654f * (x + 0.044715f * x * x * x))); }
__device__ __forceinline__ float softplusf_(float x) { return x > 0.f ? x + log1pf(expf(-x)) : log1pf(expf(x)); }
__device__ __forceinline__ float loggamma_(int h) { return log1pf(-exp2f(-5.f - (float)h)); }
__device__ __forceinline__ unsigned f2u_(float f) { unsigned u; memcpy(&u, &f, 4); return u; }
__device__ __forceinline__ float u2f_(unsigned u) { float f; memcpy(&f, &u, 4); return f; }
__device__ __forceinline__ float bf2f(bf16_t v) { return u2f_((unsigned)v << 16); }
#ifdef CPU_EMU
__device__ __forceinline__ unsigned f2bf(float f) { const unsigned u = f2u_(f); return (u + 0x7fffu + ((u >> 16) & 1u)) >> 16; }
__device__ __forceinline__ unsigned pk2(float lo, float hi) { return f2bf(lo) | (f2bf(hi) << 16); }
#else
typedef __attribute__((ext_vector_type(2))) __bf16 hwbf2_t; typedef __attribute__((ext_vector_type(2))) float hwf2_t;
__device__ __forceinline__ unsigned f2bf(float f) { const __bf16 s = (__bf16)f; return (unsigned)__builtin_bit_cast(unsigned short, s); }
__device__ __forceinline__ unsigned pk2(float lo, float hi) { const hwf2_t v = {lo, hi}; return __builtin_bit_cast(unsigned, __builtin_convertvector(v, hwbf2_t)); }
#endif
__device__ __forceinline__ float bflo(unsigned w) { return u2f_(w << 16); }
__device__ __forceinline__ float bfhi(unsigned w) { return u2f_(w & 0xffff0000u); }
__device__ __forceinline__ int atomic_add_i(int* p, int v) {
#ifdef CPU_EMU
    return __atomic_fetch_add(p, v, __ATOMIC_RELAXED);
#else
    return atomicAdd(p, v);
#endif
}
#define PF(P, r, col) bf2f((P)[(size_t)(r) * PW + (col)])
#ifdef CPU_EMU
#define SYNCTHREADS() emu_syncthreads()
#define SHFL_XOR(v, m) emu_shfl_xor(v, m)
#else
#define SYNCTHREADS() __syncthreads()
#define SHFL_XOR(v, m) __shfl_xor(v, m)
#endif
#ifdef CPU_EMU
__device__ __forceinline__ float wave_sum(float v) {
    for (int o = 1; o < 64; o <<= 1) v += SHFL_XOR(v, o);
    return v;
}
#else
__device__ __forceinline__ float wave_sum(float x) {
    x += __builtin_bit_cast(float, __builtin_amdgcn_update_dpp(0, __builtin_bit_cast(int, x), 0xB1, 0xF, 0xF, true));
    x += __builtin_bit_cast(float, __builtin_amdgcn_update_dpp(0, __builtin_bit_cast(int, x), 0x4E, 0xF, 0xF, true));
    x += __builtin_bit_cast(float, __builtin_amdgcn_update_dpp(0, __builtin_bit_cast(int, x), 0x141, 0xF, 0xF, true));
    x += __builtin_bit_cast(float, __builtin_amdgcn_update_dpp(0, __builtin_bit_cast(int, x), 0x140, 0xF, 0xF, true));
    const int xi = __builtin_bit_cast(int, x);
    return (__builtin_bit_cast(float, __builtin_amdgcn_readlane(xi, 0)) + __builtin_bit_cast(float, __builtin_amdgcn_readlane(xi, 16))) + (__builtin_bit_cast(float, __builtin_amdgcn_readlane(xi, 32)) + __builtin_bit_cast(float, __builtin_amdgcn_readlane(xi, 48)));
}
#endif
__device__ __forceinline__ f32x4 ld_bf4(const bf16_t* p) { const unsigned long long q = *(const unsigned long long*)p; const unsigned lo = (unsigned)q, hi = (unsigned)(q >> 32); return (f32x4){bflo(lo), bfhi(lo), bflo(hi), bfhi(hi)}; }
__device__ __forceinline__ void st_bf4(bf16_t* p, const f32x4 v) { *(unsigned long long*)p = (unsigned long long)pk2(v[0], v[1]) | ((unsigned long long)pk2(v[2], v[3]) << 32); }

template <int KT, int NTL>
__device__ __forceinline__ void wave_mma(f32x4 (&acc)[NTL], const bf16_t* A, int lda, const bf16_t* Bt, int ldb) {
    const int lane = threadIdx.x & 63, fr = lane & 15, fq = lane >> 4;
#ifdef CPU_EMU
    for (int nt = 0; nt < NTL; ++nt) for (int r = 0; r < 4; ++r) { float sacc = 0.f; const bf16_t* a = A + fr * lda; const bf16_t* b = Bt + (16 * nt + 4 * fq + r) * ldb;
        for (int k = 0; k < 32 * KT; ++k) sacc += bf2f(a[k]) * bf2f(b[k]);
        acc[nt][r] += sacc; }
#else
#pragma unroll
    for (int kt = 0; kt < KT; ++kt) {
        const bf16x8 af = *(const bf16x8*)(A + fr * lda + kt * 32 + fq * 8);
#pragma unroll
        for (int nt = 0; nt < NTL; ++nt) { const bf16x8 bfr = *(const bf16x8*)(Bt + (16 * nt + fr) * ldb + kt * 32 + fq * 8);
            acc[nt] = __builtin_amdgcn_mfma_f32_16x16x32_bf16(bfr, af, acc[nt], 0, 0, 0); }
    }
#endif
}
__device__ __forceinline__ void ph_mod(const Ctx& c, float* ldsf) {
    const float* cc = c.in[1]; const float* aw = c.in[5]; const float* ab = c.in[6]; float* mod = WSF(O_MOD);
    float* scs = ldsf; float* part = ldsf + NB * D; const int tid = threadIdx.x, c4 = (tid & 31) * 4, kq = tid >> 5;
    for (int i = tid; i < NB * D; i += NT) scs[i] = siluf_(cc[i]);
    SYNCTHREADS();
    for (int u = blockIdx.x; u < NL * (D6 / 128); u += gridDim.x) {
        const int l = u / (D6 / 128), j0 = (u % (D6 / 128)) * 128;
        const float* w = aw + (size_t)l * D * D6 + j0 + c4; f32x4 a0 = (f32x4){0.f, 0.f, 0.f, 0.f}, a1 = a0;
#pragma unroll 8
        for (int k = kq * 128; k < kq * 128 + 128; ++k) { const f32x4 wv = *(const f32x4*)(w + (size_t)k * D6); a0 += wv * scs[k]; a1 += wv * scs[D + k]; }
        *(f32x4*)(part + (kq * 2 + 0) * 128 + c4) = a0; *(f32x4*)(part + (kq * 2 + 1) * 128 + c4) = a1;
        SYNCTHREADS();
        if (tid < 256) { const int b = tid >> 7, col = tid & 127; float sacc = 0.f;
#pragma unroll
            for (int q = 0; q < 16; ++q) sacc += part[(q * 2 + b) * 128 + col];
            mod[((size_t)l * NB + b) * D6 + j0 + col] = sacc + ab[l * D6 + j0 + col]; }
        SYNCTHREADS();
    }
}
__device__ __forceinline__ void ph_norm(const Ctx& c, const float* x, const float* g, const float* sh, const float* sc, bf16_t* hb, float* hf) {
    const int lane = threadIdx.x & 63, gw = blockIdx.x * (NT / 64) + (threadIdx.x >> 6), ngw = gridDim.x * (NT / 64);
    for (int t0 = gw * 2; t0 < T; t0 += ngw * 2) {
        f32x4 v[2][8]; float ss[2] = {0.f, 0.f};
#pragma unroll
        for (int r = 0; r < 2; ++r)
#pragma unroll
            for (int j = 0; j < 8; ++j) v[r][j] = *(const f32x4*)(x + (size_t)(t0 + r) * D + (j * 64 + lane) * 4);
#pragma unroll
        for (int r = 0; r < 2; ++r) {
#pragma unroll
            for (int j = 0; j < 8; ++j) ss[r] += (v[r][j][0] * v[r][j][0] + v[r][j][1] * v[r][j][1]) + (v[r][j][2] * v[r][j][2] + v[r][j][3] * v[r][j][3]);
            const int t = t0 + r, b = t / S; const float rs = 1.f / sqrtf(wave_sum(ss[r]) * (1.f / D) + EPS);
#pragma unroll
            for (int j = 0; j < 8; ++j) { const int col = (j * 64 + lane) * 4;
                const f32x4 o = v[r][j] * rs * *(const f32x4*)(g + col) * (*(const f32x4*)(sc + b * D6 + col) + 1.f) + *(const f32x4*)(sh + b * D6 + col);
                st_bf4(hb + (size_t)t * D + col, o); }
            if (hf && lane == 0) hf[t] = rs;
        }
    }
}
template <int MODE>
__device__ __forceinline__ void ph_comb_norm(const Ctx& c, const float* xmid, const float* g2, float* xout, const float* g, const float* sh, const float* sc, bf16_t* hb, float* outp) {
    const bf16_t* YE = WSH(O_YE); const float* EWT = WSF(O_EWT); const int* DEST = WSI(O_DEST);
    const int lane = threadIdx.x & 63, gw = blockIdx.x * (NT / 64) + (threadIdx.x >> 6), ngw = gridDim.x * (NT / 64);
    for (int t = gw; t < T; t += ngw) {
        const int b = t / S; const float w0 = EWT[t * 2], w1 = EWT[t * 2 + 1]; const bf16_t* y0 = YE + (size_t)DEST[t * 2] * D; const bf16_t* y1 = YE + (size_t)DEST[t * 2 + 1] * D;
        f32x4 v[8]; float ss = 0.f;
#pragma unroll
        for (int j = 0; j < 8; ++j) { const int col = (j * 64 + lane) * 4;
            v[j] = *(const f32x4*)(xmid + (size_t)t * D + col) + *(const f32x4*)(g2 + b * D6 + col) * (ld_bf4(y0 + col) * w0 + ld_bf4(y1 + col) * w1);
            if (MODE == 0) *(f32x4*)(xout + (size_t)t * D + col) = v[j];
            ss += (v[j][0] * v[j][0] + v[j][1] * v[j][1]) + (v[j][2] * v[j][2] + v[j][3] * v[j][3]); }
        const float rs = 1.f / sqrtf(wave_sum(ss) * (1.f / D) + EPS);
#pragma unroll
        for (int j = 0; j < 8; ++j) { const int col = (j * 64 + lane) * 4;
            if (MODE == 0) st_bf4(hb + (size_t)t * D + col, v[j] * rs * *(const f32x4*)(g + col) * (*(const f32x4*)(sc + b * D6 + col) + 1.f) + *(const f32x4*)(sh + b * D6 + col));
            else *(f32x4*)(outp + (size_t)t * D + col) = v[j] * rs * *(const f32x4*)(g + col); }
    }
}

struct CvtItem { const float* Wp; int ldw; bf16_t* WT; int ldt; int drow, k0, n0; };
constexpr int I_IN = 32 * (INW / 32), I_BR = 4 * 16 * 64, I_OUT = 32 * 64, I_GU = NE * 32 * 32, I_DN = NE * 8 * 64, I_LR = 32 * 8, I_WU = 2 * 32, I_WG = 64, I_BIG = I_IN + I_BR + I_OUT + I_GU + I_DN, I_ALL = I_BIG + I_LR + 2 * I_WU + I_WG;
__device__ __forceinline__ CvtItem cvt_decode(const Ctx& c, int l, int it) {
    CvtItem r;
    if (it < I_IN) { const int kb = it / (INW / 32), nb = it % (INW / 32); r.n0 = nb * 32; r.k0 = kb * 64; r.Wp = c.in[7] + (size_t)l * D * INW; r.ldw = INW; r.WT = WSH(O_WIN); r.ldt = D; r.drow = r.n0 < 10624 ? r.n0 : r.n0 + 128; return r; }
    it -= I_IN;
    if (it < I_BR) { const int sgm = it / 1024, q = it % 1024, kb = q / 64, nb = q % 64; r.n0 = nb * 32; r.k0 = kb * 64; r.Wp = c.in[28] + ((size_t)l * 4 + sgm) * W * D; r.ldw = D; r.WT = WSH(O_WBR) + sgm * W; r.ldt = 4 * W; r.drow = r.n0; return r; }
    it -= I_BR;
    if (it < I_OUT) { const int kb = it / 64, nb = it % 64; r.n0 = nb * 32; r.k0 = kb * 64; r.Wp = c.in[29] + (size_t)l * D * D; r.ldw = D; r.WT = WSH(O_WOUT); r.ldt = D; r.drow = r.n0; return r; }
    it -= I_OUT;
    if (it < I_GU) { const int e = it / 1024, q = it % 1024, kb = q / 32, nb = q % 32; r.n0 = nb * 32; r.k0 = kb * 64; r.Wp = c.in[34] + ((size_t)l * NE + e) * D * 1024; r.ldw = 1024; r.WT = WSH(O_WGU) + (size_t)e * 1024 * D; r.ldt = D;
        r.drow = r.n0 < 512 ? (r.n0 / 128) * 256 + (r.n0 % 128) : ((r.n0 - 512) / 128) * 256 + 128 + ((r.n0 - 512) % 128); return r; }
    it -= I_GU;
    if (it < I_DN) { const int e = it / 512, q = it % 512, kb = q / 64, nb = q % 64; r.n0 = nb * 32; r.k0 = kb * 64; r.Wp = c.in[35] + ((size_t)l * NE + e) * 512 * D; r.ldw = D; r.WT = WSH(O_WDN) + (size_t)e * D * 512; r.ldt = 512; r.drow = r.n0; return r; }
    it -= I_DN;
    if (it < I_LR) { const int m = it / 8, q = it % 8, kb = q / 4, nb = q % 4, z = m >> 4, ty = (m >> 3) & 1, n = m & 7; r.n0 = nb * 32; r.k0 = kb * 64; r.Wp = c.in[ty ? 12 : 10] + (((size_t)l * 2 + z) * 8 + n) * 128 * 128; r.ldw = 128;
        r.WT = WSH(O_WLR) + (size_t)m * 128 * 128; r.ldt = 128; r.drow = r.n0; return r; }
    it -= I_LR;
    if (it < 2 * I_WU) { const int ua = it / I_WU, q = it % I_WU, z = q / 32, nb = q % 32; r.n0 = nb * 32; r.k0 = 0; r.Wp = c.in[ua ? 23 : 21] + ((size_t)l * 2 + z) * 64 * W; r.ldw = W; r.WT = WSH(ua ? O_WAT : O_WUT) + (size_t)z * W * 64; r.ldt = 64; r.drow = r.n0; return r; }
    it -= 2 * I_WU;
    { const int kb = it / 32, nb = it % 32; r.n0 = nb * 32; r.k0 = kb * 64; r.Wp = c.in[24] + (size_t)l * 128 * W; r.ldw = W; r.WT = WSH(O_WGT); r.ldt = 128; r.drow = r.n0; return r; }
}
constexpr int J_IN = 16 * (INW / 128), J_BR = 4 * 8 * 16, J_OUT = 16 * 16, J_GU = NE * 16 * 8, J_DN = NE * 4 * 16, J_ALL = J_IN + J_BR + J_OUT + J_GU + J_DN;
__device__ __forceinline__ CvtItem cvt_decode_big(const Ctx& c, int l, int it) {
    CvtItem r;
    if (it < J_IN) { const int kb = it / (INW / 128), nb = it % (INW / 128); r.n0 = nb * 128; r.k0 = kb * 128; r.Wp = c.in[7] + (size_t)l * D * INW; r.ldw = INW; r.WT = WSH(O_WIN); r.ldt = D; r.drow = r.n0 < 10624 ? r.n0 : r.n0 + 128; return r; }
    it -= J_IN;
    if (it < J_BR) { const int sgm = it / 128, q = it % 128, kb = q / 16, nb = q % 16; r.n0 = nb * 128; r.k0 = kb * 128; r.Wp = c.in[28] + ((size_t)l * 4 + sgm) * W * D; r.ldw = D; r.WT = WSH(O_WBR) + sgm * W; r.ldt = 4 * W; r.drow = r.n0; return r; }
    it -= J_BR;
    if (it < J_OUT) { const int kb = it / 16, nb = it % 16; r.n0 = nb * 128; r.k0 = kb * 128; r.Wp = c.in[29] + (size_t)l * D * D; r.ldw = D; r.WT = WSH(O_WOUT); r.ldt = D; r.drow = r.n0; return r; }
    it -= J_OUT;
    if (it < J_GU) { const int e = it / 128, q = it % 128, kb = q / 8, nb = q % 8; r.n0 = nb * 128; r.k0 = kb * 128; r.Wp = c.in[34] + ((size_t)l * NE + e) * D * 1024; r.ldw = 1024; r.WT = WSH(O_WGU) + (size_t)e * 1024 * D; r.ldt = D;
        r.drow = r.n0 < 512 ? (r.n0 / 128) * 256 : ((r.n0 - 512) / 128) * 256 + 128; return r; }
    it -= J_GU;
    { const int e = it / 64, q = it % 64, kb = q / 16, nb = q % 16; r.n0 = nb * 128; r.k0 = kb * 128; r.Wp = c.in[35] + ((size_t)l * NE + e) * 512 * D; r.ldw = D; r.WT = WSH(O_WDN) + (size_t)e * D * 512; r.ldt = 512; r.drow = r.n0; return r; }
}
__device__ __forceinline__ void convert_big(const Ctx& c, int l, float* ldsf, int first, int last, int widx, int wcnt) {
    const int tid = threadIdx.x, lr = tid >> 5, lc = (tid & 31) * 4;
    f32x4 rg[8]; int it = first + widx; CvtItem r;
    if (it < last) { r = cvt_decode_big(c, l, it);
#pragma unroll
        for (int i = 0; i < 8; ++i) rg[i] = *(const f32x4*)(r.Wp + (size_t)(r.k0 + lr + 16 * i) * r.ldw + r.n0 + lc); }
    for (; it < last; it += wcnt) {
#pragma unroll
        for (int i = 0; i < 8; ++i) { float* dp = ldsf + (lr + 16 * i) * 129 + lc; dp[0] = rg[i][0]; dp[1] = rg[i][1]; dp[2] = rg[i][2]; dp[3] = rg[i][3]; }
        const CvtItem cur = r; const int nx = it + wcnt;
        if (nx < last) { r = cvt_decode_big(c, l, nx);
#pragma unroll
            for (int i = 0; i < 8; ++i) rg[i] = *(const f32x4*)(r.Wp + (size_t)(r.k0 + lr + 16 * i) * r.ldw + r.n0 + lc); }
        SYNCTHREADS();
#pragma unroll
        for (int q = 0; q < 4; ++q) { const int id = tid + NT * q, n = id >> 4, k8 = (id & 15) * 8; const float* sp = ldsf + k8 * 129 + n;
            u32x4 o; o[0] = pk2(sp[0 * 129], sp[1 * 129]); o[1] = pk2(sp[2 * 129], sp[3 * 129]); o[2] = pk2(sp[4 * 129], sp[5 * 129]); o[3] = pk2(sp[6 * 129], sp[7 * 129]);
            *(u32x4*)(cur.WT + (size_t)(cur.drow + n) * cur.ldt + cur.k0 + k8) = o; }
        SYNCTHREADS();
    }
}
__device__ __forceinline__ int convert_tail_tiles() { const int nun = (T / 256) * (PW / 256), G = (int)gridDim.x, rem = nun % G; return rem == 0 ? 0 : (G - rem) * 10 < J_GU + J_DN ? (G - rem) * 10 : J_GU + J_DN; }
__device__ __forceinline__ int convert_early_tiles(const Ctx& c) { const int G = (int)gridDim.x, nrest = (CTLW(c) + CW_PLAN)[40] * 4 - G; return (nrest >= 0 && nrest < G) ? ((G - nrest) * 12 < J_IN ? (G - nrest) * 12 : J_IN) : 0; }
__device__ __forceinline__ void ph_convert(const Ctx& c, int l, float* ldsf) {
    const int lane = threadIdx.x & 63, wave = threadIdx.x >> 6; const int gw = blockIdx.x * (NT / 64) + wave, ngw = gridDim.x * (NT / 64);
    convert_big(c, l, ldsf, l == 1 ? convert_early_tiles(c) : 0, J_ALL - convert_tail_tiles(), (int)blockIdx.x, (int)gridDim.x);
#ifdef CPU_EMU
    if (lane == 0) for (int it = I_BIG + gw; it < I_ALL; it += ngw) { const CvtItem r = cvt_decode(c, l, it);
        for (int kk = 0; kk < 64; ++kk) for (int nn = 0; nn < 32; ++nn) r.WT[(size_t)(r.drow + nn) * r.ldt + r.k0 + kk] = (bf16_t)f2bf(r.Wp[(size_t)(r.k0 + kk) * r.ldw + r.n0 + nn]); }
#else
    float* scr = ldsf + wave * (64 * 33 + 16);
    for (int it = I_BIG + gw; it < I_ALL; it += ngw) {
        const CvtItem r = cvt_decode(c, l, it);
#pragma unroll 8
        for (int i = 0; i < 32; ++i) { const int kk = 2 * i + (lane >> 5); scr[kk * 33 + (lane & 31)] = r.Wp[(size_t)(r.k0 + kk) * r.ldw + r.n0 + (lane & 31)]; }
        asm volatile("s_waitcnt lgkmcnt(0)" ::: "memory");
        const int cc = lane & 7;
#pragma unroll
        for (int j = 0; j < 4; ++j) { const int n = (lane >> 3) + 8 * j; const float* sp = scr + (8 * cc) * 33 + n;
            u32x4 o; o[0] = pk2(sp[0 * 33], sp[1 * 33]); o[1] = pk2(sp[2 * 33], sp[3 * 33]); o[2] = pk2(sp[4 * 33], sp[5 * 33]); o[3] = pk2(sp[6 * 33], sp[7 * 33]);
            *(u32x4*)(r.WT + (size_t)(r.drow + n) * r.ldt + r.k0 + 8 * cc) = o; }
        asm volatile("s_waitcnt lgkmcnt(0)" ::: "memory");
    }
#endif
    { const float* wg = c.in[30] + (size_t)l * D * 4; const float* we = c.in[32] + (size_t)l * D * 32; bf16_t* wh = WSH(O_WRH); bf16_t* wl = WSH(O_WRL);
      for (long i = GT_; i < (long)48 * D; i += GS_) { const int n = (int)(i / D), k = (int)(i % D); const float w = n < 4 ? wg[k * 4 + n] : n < 36 ? we[k * 32 + (n - 4)] : 0.f; const unsigned hb = f2bf(w); wh[i] = (bf16_t)hb; wl[i] = (bf16_t)f2bf(w - bf2f((bf16_t)hb)); } }
    for (long i = GT_; i < (long)128 * D / 2; i += GS_) ((unsigned*)(WSH(O_WIN) + (size_t)10624 * D))[i] = 0u;
}

namespace pg8 {
constexpr int BM = 256, BK = 64, HALF = 128, HTB = HALF * BK * 2, STAGE_BYTES = 8 * HTB;
__host__ __device__ __forceinline__ int lds_byte(int r, int cc) { const int st = (r >> 4) * 2 + (cc >> 5), rr = r & 15, c2 = cc & 31, ob = rr * 64 + c2 * 2; return st * 1024 + (ob ^ (((ob >> 9) & 1) << 5)); }
__host__ __device__ __forceinline__ void stage_rc(int b, int& R, int& C) { const int st = b / 1024, sb = b % 1024, swz = sb ^ (((sb >> 9) & 1) << 5); R = (st >> 1) * 16 + swz / 64; C = (st & 1) * 32 + (swz % 64) / 2; }
__host__ __device__ __forceinline__ int perm32(int rho) { const int n = rho >> 4, i = rho & 15; return 8 * (i >> 2) + 4 * n + (i & 3); }
struct Unit { int pm, pn, aux; const char* A; const char* B; };
struct Gemm { int K, lda, ldb; };

template <class Epi, class Sched>
__device__ __forceinline__ void gemm_phase(unsigned char* lds_, const Gemm g, const Sched& S, const Epi& E) {
#ifdef CPU_EMU
    if (threadIdx.x != 0) return;
    Unit u; const int K = g.K;
    float* Af = (float*)malloc((size_t)256 * K * 4); float* Bf = (float*)malloc((size_t)256 * K * 4); float* Cf = (float*)malloc(256 * 256 * 4);
    for (int i = 0; S.next(i, u); ++i) {
        const bf16_t* A = (const bf16_t*)u.A; const bf16_t* B = (const bf16_t*)u.B;
        for (int r = 0; r < 256; ++r) for (int k = 0; k < K; ++k) { Af[(size_t)r * K + k] = bf2f(A[(size_t)r * g.lda + k]); Bf[(size_t)r * K + k] = bf2f(B[(size_t)r * g.ldb + k]); }
        const int nseg = Epi::SEGT > 0 ? K / (Epi::SEGT * 64) : 1, kseg = K / nseg;
        for (int wid = 0; wid < 8; ++wid) for (int lane = 0; lane < 64; ++lane) {
            const int wr = wid >> 2, wc = wid & 3, fr = lane & 15, fq = lane >> 4; f32x4 acc[2][2][4][2];
            for (int ai = 0; ai < 2; ++ai) for (int bj = 0; bj < 2; ++bj) for (int m = 0; m < 4; ++m) for (int n = 0; n < 2; ++n) for (int j = 0; j < 4; ++j) acc[ai][bj][m][n][j] = 0.f;
            for (int sg = 0; sg < nseg; ++sg) {
                for (int ai = 0; ai < 2; ++ai) for (int bj = 0; bj < 2; ++bj) for (int m = 0; m < 4; ++m) for (int n = 0; n < 2; ++n) for (int j = 0; j < 4; ++j) {
                    const int r = 128 * ai + 64 * wr + 16 * m + fr, cc = 128 * bj + 32 * wc + (Epi::PERM ? 8 * fq + 4 * n + j : 16 * n + 4 * fq + j);
                    const float* a = Af + (size_t)r * K + sg * kseg; const float* b = Bf + (size_t)cc * K + sg * kseg; float sacc = 0.f; for (int k = 0; k < kseg; ++k) sacc += a[k] * b[k];
                    acc[ai][bj][m][n][j] += sacc; }
                if constexpr (Epi::SEGT > 0) { if (sg + 1 < nseg) E.segment(acc, u, sg, wr, wc, fr, fq); }
            }
            E(acc, u, wr, wc, fr, fq);
        }
    }
    free(Af); free(Bf); free(Cf);
#else
    typedef __attribute__((address_space(3))) unsigned char* ldsp_t;
    ldsp_t lds = (ldsp_t)lds_;
    const int tid = threadIdx.x, wid = __builtin_amdgcn_readfirstlane(tid >> 6), lane = tid & 63, wr = wid >> 2, wc = wid & 3, fr = lane & 15, fq = lane >> 4;
    const int K = g.K, nt = K / BK;
    unsigned voffA[2], voffB[2];
#pragma unroll
    for (int i = 0; i < 2; ++i) { int R, C; stage_rc(tid * 16 + i * 8192, R, C); const int Rb = Epi::PERM ? ((R & ~31) + perm32(R & 31)) : R;
        voffA[i] = (unsigned)(R * g.lda + C) * 2u; voffB[i] = (unsigned)(Rb * g.ldb + C) * 2u; }
    const size_t kstep = (size_t)(BK * 2);
    const size_t hstepA = (size_t)HALF * g.lda * 2, hstepB = (size_t)HALF * g.ldb * 2;
    const unsigned ldsw = (unsigned)wid * 1024u;
    const int aoff = lds_byte(wr * 64 + fr, fq * 8), boff = lds_byte(wc * 32 + fr, fq * 8);
#define PG8_SA(b, h) (((b) * 2 + (h)) * HTB)
#define PG8_SB(b, h) ((4 + (b) * 2 + (h)) * HTB)
#define PG8_STAGE(bufoff, gbase, voff) do { _Pragma("unroll") for (int _i = 0; _i < 2; ++_i) \
        __builtin_amdgcn_global_load_lds((const unsigned*)((const char*)(gbase) + (voff)[_i]), (__attribute__((address_space(3))) unsigned*)(lds + (bufoff) + ldsw + _i * 8192), 16, 0, 0); } while (0)
#define PG8_LDA(dst, b, h) do { _Pragma("unroll") for (int m = 0; m < 4; ++m) _Pragma("unroll") for (int k = 0; k < 2; ++k) dst[m][k] = *(const __attribute__((address_space(3))) bf16x8*)(lds + PG8_SA(b, h) + aoff + m * 2048 + k * 1024); } while (0)
#define PG8_LDB(dst, b, h) do { _Pragma("unroll") for (int n = 0; n < 2; ++n) _Pragma("unroll") for (int k = 0; k < 2; ++k) dst[n][k] = *(const __attribute__((address_space(3))) bf16x8*)(lds + PG8_SB(b, h) + boff + n * 2048 + k * 1024); } while (0)
#define PG8_MMA(ai, bj, At, Bt) do { __builtin_amdgcn_s_setprio(1); _Pragma("unroll") for (int m = 0; m < 4; ++m) _Pragma("unroll") for (int n = 0; n < 2; ++n) _Pragma("unroll") for (int k = 0; k < 2; ++k) \
        acc[ai][bj][m][n] = __builtin_amdgcn_mfma_f32_16x16x32_bf16(Bt[n][k], At[m][k], acc[ai][bj][m][n], 0, 0, 0); __builtin_amdgcn_s_setprio(0); } while (0)
#define PG8_WAIT_V(n) asm volatile("s_waitcnt vmcnt(" #n ")" ::: "memory")
#define PG8_WAIT_L(n) asm volatile("s_waitcnt lgkmcnt(" #n ")" ::: "memory")
#define PG8_BAR __builtin_amdgcn_s_barrier()
#define PG8_SCHED __builtin_amdgcn_sched_barrier(0)
    Unit cur, nxt; int ui = 0;
    if (!S.next(0, cur)) return;
    f32x4 acc[2][2][4][2];
#pragma unroll
    for (int a = 0; a < 2; ++a)
#pragma unroll
        for (int b = 0; b < 2; ++b)
#pragma unroll
            for (int m = 0; m < 4; ++m)
#pragma unroll
                for (int n = 0; n < 2; ++n) acc[a][b][m][n] = (f32x4){0.f, 0.f, 0.f, 0.f};
    bf16x8 At[4][2], B0[2][2], B1[2][2];
    const char* cA = cur.A; const char* cB = cur.B;
    S.a_ready(cur);
    PG8_STAGE(PG8_SB(0, 0), cB, voffB); PG8_STAGE(PG8_SA(0, 0), cA, voffA); PG8_STAGE(PG8_SB(0, 1), cB + hstepB, voffB); PG8_STAGE(PG8_SA(0, 1), cA + hstepA, voffA);
    if (wr == 1) PG8_BAR;
    PG8_WAIT_V(4); PG8_BAR;
    PG8_STAGE(PG8_SB(1, 0), cB + kstep, voffB); PG8_STAGE(PG8_SA(1, 0), cA + kstep, voffA); PG8_STAGE(PG8_SB(1, 1), cB + hstepB + kstep, voffB);
    PG8_WAIT_V(6); PG8_BAR;
    for (;;) {
        const bool has_next = S.next(ui + 1, nxt);
        const char* nA = has_next ? nxt.A : cA; const char* nB = has_next ? nxt.B : cB;
        for (int t = 0; t < nt; t += 2) {
            const bool last = (t == nt - 2);
            const char* a1 = cA + (size_t)(t + 1) * kstep;
            const char* a2 = last ? nA : cA + (size_t)(t + 2) * kstep; const char* b2 = last ? nB : cB + (size_t)(t + 2) * kstep;
            const char* a3 = a2 + kstep; const char* b3 = b2 + kstep;
            if (last && has_next) S.a_ready(nxt);
            PG8_LDB(B0, 0, 0); PG8_SCHED; PG8_LDA(At, 0, 0); PG8_STAGE(PG8_SA(1, 1), a1 + hstepA, voffA);
            PG8_WAIT_L(8); PG8_BAR; PG8_WAIT_L(0); PG8_MMA(0, 0, At, B0); PG8_BAR; PG8_SCHED;
            PG8_LDB(B1, 0, 1); PG8_STAGE(PG8_SB(0, 0), b2, voffB);
            PG8_BAR; PG8_WAIT_L(0); PG8_MMA(0, 1, At, B1); PG8_BAR;
            PG8_LDA(At, 0, 1); PG8_STAGE(PG8_SA(0, 0), a2, voffA);
            PG8_BAR; PG8_WAIT_L(0); PG8_MMA(1, 0, At, B0); PG8_BAR; PG8_SCHED;
            PG8_STAGE(PG8_SB(0, 1), b2 + hstepB, voffB);
            PG8_WAIT_V(6); PG8_BAR; PG8_MMA(1, 1, At, B1); PG8_BAR;
            PG8_LDB(B0, 1, 0); PG8_SCHED; PG8_LDA(At, 1, 0); PG8_STAGE(PG8_SA(0, 1), a2 + hstepA, voffA);
            PG8_WAIT_L(8); PG8_BAR; PG8_WAIT_L(0); PG8_MMA(0, 0, At, B0); PG8_BAR; PG8_SCHED;
            PG8_LDB(B1, 1, 1); PG8_STAGE(PG8_SB(1, 0), b3, voffB);
            PG8_BAR; PG8_WAIT_L(0); PG8_MMA(0, 1, At, B1); PG8_BAR;
            PG8_LDA(At, 1, 1); PG8_STAGE(PG8_SA(1, 0), a3, voffA);
            PG8_BAR; PG8_WAIT_L(0); PG8_MMA(1, 0, At, B0); PG8_BAR; PG8_SCHED;
            PG8_STAGE(PG8_SB(1, 1), b3 + hstepB, voffB);
            PG8_WAIT_V(6); PG8_BAR; PG8_MMA(1, 1, At, B1); PG8_BAR;
            if constexpr (Epi::SEGT > 0) { if ((t + 2) % Epi::SEGT == 0 && t + 2 < nt) E.segment(acc, cur, (t + 2) / Epi::SEGT - 1, wr, wc, fr, fq); }
        }
        E(acc, cur, wr, wc, fr, fq); S.done(cur);
        if (!has_next) break;
#pragma unroll
        for (int a = 0; a < 2; ++a)
#pragma unroll
            for (int b = 0; b < 2; ++b)
#pragma unroll
                for (int m = 0; m < 4; ++m)
#pragma unroll
                    for (int n = 0; n < 2; ++n) acc[a][b][m][n] = (f32x4){0.f, 0.f, 0.f, 0.f};
        cur = nxt; cA = nA; cB = nB; ++ui;
    }
    PG8_WAIT_V(0);
    if (wr == 0) PG8_BAR;
    PG8_BAR;
#undef PG8_SA
#undef PG8_SB
#undef PG8_STAGE
#undef PG8_LDA
#undef PG8_LDB
#undef PG8_MMA
#undef PG8_WAIT_V
#undef PG8_WAIT_L
#undef PG8_BAR
#undef PG8_SCHED
#endif
}

struct StaticOrder {
    int nM, nN, nwg, G, c; const char* A; const char* B; size_t tstepA, tstepB;
    __device__ __forceinline__ void init(int M, int N, int G_, int c_, const void* A_, const void* B_, int lda, int ldb) { nM = M / BM; nN = N / BM; nwg = nM * nN; G = G_; c = c_; A = (const char*)A_; B = (const char*)B_; tstepA = (size_t)BM * lda * 2; tstepB = (size_t)BM * ldb * 2; }
    __device__ __forceinline__ bool next(int i, Unit& u) const {
        const long L = (long)i * G + c; if (L >= nwg) return false;
        int wgid = (int)L; { const int q = nwg / 8, r = nwg % 8, xcd = wgid % 8, off = wgid / 8; wgid = (xcd < r ? xcd * (q + 1) : r * (q + 1) + (xcd - r) * q) + off; }
        const int nig = 8 * nN, gid = wgid / nig, fm = gid * 8, gsz = (nM - fm) < 8 ? (nM - fm) : 8;
        u.pm = fm + ((wgid % nig) % gsz); u.pn = (wgid % nig) / gsz; u.aux = 0; u.A = A + (size_t)u.pm * tstepA; u.B = B + (size_t)u.pn * tstepB; return true;
    }
    __device__ __forceinline__ void a_ready(const Unit&) const {}
    __device__ __forceinline__ void done(const Unit&) const {}
};
struct MergeOrder {
    StaticOrder so; int kseg_bytes;
    __device__ __forceinline__ bool next(int i, Unit& u) const { if (!so.next(i >> 2, u)) return false; u.aux = i & 3; u.A += (size_t)u.aux * kseg_bytes; u.B += (size_t)u.aux * kseg_bytes; return true; }
    __device__ __forceinline__ void a_ready(const Unit&) const {}
    __device__ __forceinline__ void done(const Unit&) const {}
};
struct MoeOrder {
    int G, c, ncol; const int* plan; const char* A; const char* B; size_t tstepA, tstepB, estep;
    __device__ __forceinline__ bool next(int i, Unit& u) const {
        const long L = (long)i * G + c; const int nblk = plan[40]; if (L >= (long)nblk * ncol) return false;
        u.pm = (int)(L / ncol); u.pn = (int)(L % ncol); u.aux = plan[64 + u.pm]; u.A = A + (size_t)u.pm * tstepA; u.B = B + (size_t)u.aux * estep + (size_t)u.pn * tstepB; return true;
    }
    __device__ __forceinline__ void a_ready(const Unit&) const {}
    __device__ __forceinline__ void done(const Unit&) const {}
};

__device__ __forceinline__ u32x4 pack8(const f32x4 v0, const f32x4 v1) { u32x4 w; w[0] = pk2(v0[0], v0[1]); w[1] = pk2(v0[2], v0[3]); w[2] = pk2(v1[0], v1[1]); w[3] = pk2(v1[2], v1[3]); return w; }
struct EpiBf16 {
    static constexpr int SEGT = 0; static constexpr bool PERM = true; bf16_t* O; int ldc;
    __device__ __forceinline__ void operator()(const f32x4 (&acc)[2][2][4][2], const Unit& u, int wr, int wc, int fr, int fq) const {
        const int row0 = u.pm * BM + wr * 64 + fr, col0 = u.pn * BM + wc * 32 + 8 * fq;
#pragma unroll
        for (int ai = 0; ai < 2; ++ai)
#pragma unroll
            for (int m = 0; m < 4; ++m) { bf16_t* rowp = O + (size_t)(row0 + ai * HALF + m * 16) * ldc + col0;
#pragma unroll
                for (int bj = 0; bj < 2; ++bj) *(u32x4*)(rowp + bj * HALF) = pack8(acc[ai][bj][m][0], acc[ai][bj][m][1]); }
    }
};
struct EpiP {
    static constexpr int SEGT = 0; static constexpr bool PERM = true; bf16_t* O; unsigned char* G8;
    __device__ __forceinline__ void operator()(const f32x4 (&acc)[2][2][4][2], const Unit& u, int wr, int wc, int fr, int fq) const {
        const int row0 = u.pm * BM + wr * 64 + fr, col0 = u.pn * BM + wc * 32 + 8 * fq;
        if (u.pn * BM < C_MLP) {
#pragma unroll
            for (int ai = 0; ai < 2; ++ai)
#pragma unroll
                for (int m = 0; m < 4; ++m) { bf16_t* rowp = O + (size_t)(row0 + ai * HALF + m * 16) * PW + col0;
#pragma unroll
                    for (int bj = 0; bj < 2; ++bj) *(u32x4*)(rowp + bj * HALF) = pack8(acc[ai][bj][m][0], acc[ai][bj][m][1]); }
        } else {
#pragma unroll
            for (int ai = 0; ai < 2; ++ai)
#pragma unroll
                for (int m = 0; m < 4; ++m) { unsigned char* rowp = G8 + (size_t)(row0 + ai * HALF + m * 16) * (4 * D) + (col0 - C_MLP);
#pragma unroll
                    for (int bj = 0; bj < 2; ++bj) { unsigned long long w = 0ull;
#pragma unroll
                        for (int q = 0; q < 8; ++q) { const float gq = sigmoidf_(acc[ai][bj][m][q >> 2][q & 3]); w |= (unsigned long long)(unsigned)(gq * 255.f + 0.5f) << (8 * q); }
                        *(unsigned long long*)(rowp + bj * HALF) = w; } }
        }
    }
};
struct EpiMerge {
    static constexpr int SEGT = 16; static constexpr bool PERM = true; const unsigned char* G8; bf16_t* MRG;
    static __device__ __forceinline__ float gq(unsigned long long w, int q) { const unsigned b = (unsigned)(w >> (8 * q)) & 255u; return (b ? (float)b : 0.5f) * (1.f / 255.f); }
    __device__ __forceinline__ void segment(f32x4 (&acc)[2][2][4][2], const Unit& u, int seg, int wr, int wc, int fr, int fq) const {
        const int row0 = u.pm * BM + wr * 64 + fr, col0 = u.pn * BM + wc * 32 + 8 * fq;
#pragma unroll
        for (int ai = 0; ai < 2; ++ai)
#pragma unroll
            for (int m = 0; m < 4; ++m) { const size_t r = (size_t)(row0 + ai * HALF + m * 16);
#pragma unroll
                for (int bj = 0; bj < 2; ++bj) { const int cc = col0 + bj * HALF;
                    const unsigned long long g0 = *(const unsigned long long*)(G8 + r * (4 * D) + seg * D + cc), g1 = *(const unsigned long long*)(G8 + r * (4 * D) + (seg + 1) * D + cc);
#pragma unroll
                    for (int q = 0; q < 4; ++q) { acc[ai][bj][m][0][q] *= gq(g0, q) * frcp_(gq(g1, q)); acc[ai][bj][m][1][q] *= gq(g0, 4 + q) * frcp_(gq(g1, 4 + q)); } }
#ifndef CPU_EMU
                asm volatile("" ::: "memory");
#endif
            }
    }
    __device__ __forceinline__ void operator()(const f32x4 (&acc)[2][2][4][2], const Unit& u, int wr, int wc, int fr, int fq) const {
        const int row0 = u.pm * BM + wr * 64 + fr, col0 = u.pn * BM + wc * 32 + 8 * fq;
#pragma unroll
        for (int ai = 0; ai < 2; ++ai)
#pragma unroll
            for (int m = 0; m < 4; ++m) { const size_t r = (size_t)(row0 + ai * HALF + m * 16);
#pragma unroll
                for (int bj = 0; bj < 2; ++bj) { const int cc = col0 + bj * HALF;
                    const unsigned long long g3 = *(const unsigned long long*)(G8 + r * (4 * D) + 3 * D + cc); f32x4 v0, v1;
#pragma unroll
                    for (int q = 0; q < 4; ++q) { v0[q] = gq(g3, q) * acc[ai][bj][m][0][q]; v1[q] = gq(g3, 4 + q) * acc[ai][bj][m][1][q]; }
                    *(u32x4*)(MRG + r * D + cc) = pack8(v0, v1); }
#ifndef CPU_EMU
                asm volatile("" ::: "memory");
#endif
            }
    }
};
struct EpiResid {
    static constexpr int SEGT = 0; static constexpr bool PERM = false; const float* xin; const float* g1; float* xmid;
    __device__ __forceinline__ void operator()(const f32x4 (&acc)[2][2][4][2], const Unit& u, int wr, int wc, int fr, int fq) const {
        const int row0 = u.pm * BM + wr * 64 + fr, col0 = u.pn * BM + wc * 32 + 4 * fq;
#pragma unroll
        for (int ai = 0; ai < 2; ++ai)
#pragma unroll
            for (int m = 0; m < 4; ++m) { const int r = row0 + ai * HALF + m * 16; const float* gp = g1 + (size_t)(r / S) * D6;
#pragma unroll
                for (int bj = 0; bj < 2; ++bj)
#pragma unroll
                    for (int n = 0; n < 2; ++n) { const int cc = col0 + bj * HALF + n * 16; *(f32x4*)(xmid + (size_t)r * D + cc) = *(const f32x4*)(xin + (size_t)r * D + cc) + *(const f32x4*)(gp + cc) * acc[ai][bj][m][n]; }
#ifndef CPU_EMU
                asm volatile("" ::: "memory");
#endif
            }
    }
};
struct EpiGU {
    static constexpr int SEGT = 0; static constexpr bool PERM = true; bf16_t* ACT;
    __device__ __forceinline__ void operator()(const f32x4 (&acc)[2][2][4][2], const Unit& u, int wr, int wc, int fr, int fq) const {
        const int row0 = u.pm * BM + wr * 64 + fr, col0 = u.pn * HALF + wc * 32 + 8 * fq;
#pragma unroll
        for (int ai = 0; ai < 2; ++ai)
#pragma unroll
            for (int m = 0; m < 4; ++m) { f32x4 v0, v1;
#pragma unroll
                for (int j = 0; j < 4; ++j) { v0[j] = siluf_(acc[ai][0][m][0][j]) * acc[ai][1][m][0][j]; v1[j] = siluf_(acc[ai][0][m][1][j]) * acc[ai][1][m][1][j]; }
                *(u32x4*)(ACT + (size_t)(row0 + ai * HALF + m * 16) * 512 + col0) = pack8(v0, v1); }
    }
};
}

template <int PASS>
__device__ __forceinline__ void ph_lru(const Ctx& c, int l, float* ldsf) {
    const bf16_t* P = WSH(O_P); const float* cw = c.in[8] + (size_t)l * 4 * W; const float* cb = c.in[9] + (size_t)l * W;
    const float* br = c.in[11] + (size_t)l * 2 * W; const float* bi = c.in[13] + (size_t)l * 2 * W; const float* lam = c.in[14] + (size_t)l * 2 * W; const bf16_t* WLR = WSH(O_WLR);
    float* CA = WSF(O_LCA); float* CH = WSF(O_LCH); const float* CI = WSF(O_LCI); bf16_t* Y = WSH(O_YS); unsigned* LAU = (unsigned*)(c.ws + O_LA);
    bf16_t* Xs = (bf16_t*)ldsf; bf16_t* Wr = Xs + 64 * 136; bf16_t* Wi = Wr + 128 * 136; float* AUa = (float*)Wr; float* AUu = AUa + 64 * 128; float* HF = (float*)(Wi + 128 * 136); float* spl = HF + 64 * 128;
    const int tid = threadIdx.x, wv = tid >> 6, lane = tid & 63, fr = lane & 15, fq = lane >> 4, rt = wv & 3, hf = wv >> 2;
    for (int u = blockIdx.x; u < (T / 64) * 8; u += gridDim.x) {
        const int n = u & 7, tile = u >> 3, b = tile / NLC, chk = tile % NLC; const long t0 = (long)tile * 64;
        if (tid < 256) spl[tid] = softplusf_(-lam[(tid >> 7) * W + n * 128 + (tid & 127)]);
#pragma unroll
        for (int q = 0; q < 4; ++q) { const int id = tid + NT * q, tl = id >> 5, e4 = (id & 31) * 4, ch = n * 128 + e4; const long t = t0 + tl; const int sI = (int)(t % S);
            f32x4 acc = *(const f32x4*)(cb + ch);
#pragma unroll
            for (int k = 0; k < 4; ++k) { const int ss = sI + k - 2; if (ss >= 0 && ss < S) acc += ld_bf4(P + (size_t)(t + k - 2) * PW + C_LX + ch) * *(const f32x4*)(cw + k * W + ch); }
            st_bf4(Xs + tl * 136 + e4, acc); }
        for (int z = 0; z < 2; ++z) {
#pragma unroll
            for (int q = 0; q < 4; ++q) { const int id = tid + NT * q, f = id >> 4, e8 = (id & 15) * 8;
                *(u32x4*)(Wr + f * 136 + e8) = *(const u32x4*)(WLR + ((size_t)((z * 2 + 0) * 8 + n) * 128 + f) * 128 + e8); *(u32x4*)(Wi + f * 136 + e8) = *(const u32x4*)(WLR + ((size_t)((z * 2 + 1) * 8 + n) * 128 + f) * 128 + e8); }
            SYNCTHREADS();
            f32x4 ar[4], ai[4];
#pragma unroll
            for (int nt = 0; nt < 4; ++nt) { ar[nt] = (f32x4){0.f, 0.f, 0.f, 0.f}; ai[nt] = (f32x4){0.f, 0.f, 0.f, 0.f}; }
            wave_mma<4, 4>(ar, Xs + rt * 16 * 136, 136, Wr + hf * 64 * 136, 136);
            wave_mma<4, 4>(ai, Xs + rt * 16 * 136, 136, Wi + hf * 64 * 136, 136);
            SYNCTHREADS();
            const int tl = rt * 16 + fr;
#pragma unroll
            for (int nt = 0; nt < 4; ++nt) { const int f = 64 * hf + 16 * nt + 4 * fq, ch = n * 128 + f;
                const f32x4 brv = *(const f32x4*)(br + z * W + ch), biv = *(const f32x4*)(bi + z * W + ch), lmv = *(const f32x4*)(spl + z * 128 + f), xcv = ld_bf4(Xs + tl * 136 + f); f32x4 av, uv, lav;
#pragma unroll
                for (int e = 0; e < 4; ++e) { const float r = sigmoidf_(ar[nt][e] + brv[e]), ig = sigmoidf_(ai[nt][e] + biv[e]), la = -8.f * r * lmv[e]; const float a = fexp_(la); av[e] = a; lav[e] = la; uv[e] = sqrtf(fmaxf(1.f - a * a, 0.f)) * ig * xcv[e]; }
                *(f32x4*)(AUa + tl * 128 + f) = av; *(f32x4*)(AUu + tl * 128 + f) = uv;
                if (PASS == 1) { u32x4 pk;
#pragma unroll
                    for (int e = 0; e < 4; ++e) pk[e] = pk2(lav[e], uv[e]);
                    *(u32x4*)(LAU + ((size_t)z * T + t0 + tl) * W + ch) = pk; } }
            SYNCTHREADS();
            if (tid < 128) { const int f = tid; const size_t ci = (((size_t)z * NB + b) * NLC + chk) * W + n * 128 + f;
                if (PASS == 1) { float prod = 1.f, h = 0.f;
#pragma unroll 8
                    for (int q = 0; q < 64; ++q) { const int sI = z == 0 ? q : 63 - q; const float a = AUa[sI * 128 + f]; h = a * h + AUu[sI * 128 + f]; prod *= a; }
                    CA[ci] = prod; CH[ci] = h;
                } else { float h = CI[ci];
                    if (z == 0) {
#pragma unroll 8
                        for (int q = 0; q < 64; ++q) { h = AUa[q * 128 + f] * h + AUu[q * 128 + f]; HF[q * 128 + f] = h; }
                    } else {
#pragma unroll 8
                        for (int q = 63; q >= 0; --q) { h = AUa[q * 128 + f] * h + AUu[q * 128 + f]; HF[q * 128 + f] += h; } } }
            }
            SYNCTHREADS();
        }
        if (PASS == 2) {
#pragma unroll
            for (int q = 0; q < 4; ++q) { const int id = tid + NT * q, tl = id >> 5, f4 = (id & 31) * 4; const long t = t0 + tl; f32x4 hv = *(const f32x4*)(HF + tl * 128 + f4); const f32x4 gv = ld_bf4(P + (size_t)t * PW + C_LG + n * 128 + f4);
#pragma unroll
                for (int e = 0; e < 4; ++e) hv[e] *= geluf_(gv[e]);
                st_bf4(Y + (size_t)t * 4 * W + 0 * W + n * 128 + f4, hv); }
            SYNCTHREADS();
        }
    }
}
__device__ __forceinline__ void ph_lru_fin(const Ctx& c, float* ldsf) {
    const bf16_t* P = WSH(O_P); const unsigned* LAU = (const unsigned*)(c.ws + O_LA); const float* CI = WSF(O_LCI); bf16_t* Y = WSH(O_YS);
    unsigned* Lz = (unsigned*)ldsf; float* Hz = ldsf + 2 * 64 * 128; const int tid = threadIdx.x;
    for (int u = blockIdx.x; u < (T / 64) * 8; u += gridDim.x) {
        const int n = u & 7, tile = u >> 3, b = tile / NLC, chk = tile % NLC; const long t0 = (long)tile * 64;
#pragma unroll
        for (int q = 0; q < 8; ++q) { const int id = tid + NT * q, z = id >> 11, r = (id >> 5) & 63, c4 = (id & 31) * 4; *(u32x4*)(Lz + z * 8192 + r * 128 + c4) = *(const u32x4*)(LAU + ((size_t)z * T + t0 + r) * W + n * 128 + c4); }
        SYNCTHREADS();
        if (tid < 256) { const int z = tid >> 7, f = tid & 127; float h = CI[(((size_t)z * NB + b) * NLC + chk) * W + n * 128 + f]; const unsigned* lp = Lz + z * 8192 + f; float* hp = Hz + z * 8192 + f;
#pragma unroll 8
            for (int q = 0; q < 64; ++q) { const int sI = z == 0 ? q : 63 - q; const unsigned w = lp[sI * 128]; h = fexp_(bflo(w)) * h + bfhi(w); hp[sI * 128] = h; } }
        SYNCTHREADS();
#pragma unroll
        for (int q = 0; q < 4; ++q) { const int id = tid + NT * q, r = id >> 5, f4 = (id & 31) * 4; const long t = t0 + r; f32x4 o = *(const f32x4*)(Hz + r * 128 + f4) + *(const f32x4*)(Hz + 8192 + r * 128 + f4); const f32x4 gv = ld_bf4(P + (size_t)t * PW + C_LG + n * 128 + f4);
#pragma unroll
            for (int e = 0; e < 4; ++e) o[e] *= geluf_(gv[e]);
            st_bf4(Y + (size_t)t * 4 * W + 0 * W + n * 128 + f4, o); }
        SYNCTHREADS();
    }
}
__device__ __forceinline__ void ph_lru_scan2(const Ctx& c) {
    const float* CA = WSF(O_LCA); const float* CH = WSF(O_LCH); float* CI = WSF(O_LCI);
    for (long i = GT_; i < (long)2 * NB * W; i += GS_) {
        const int w = (int)(i % W), b = (int)((i / W) % NB), z = (int)(i / ((long)W * NB)); float carry = 0.f;
#pragma unroll 16
        for (int q = 0; q < NLC; ++q) { const int ch = z == 0 ? q : NLC - 1 - q; const size_t idx = (((size_t)z * NB + b) * NLC + ch) * W + w; CI[idx] = carry; carry = CA[idx] * carry + CH[idx]; }
    }
}
__device__ __forceinline__ void ph_rope_table(const Ctx& c) {
    const int* pos = (const int*)c.in[2]; float* RT = WSF(O_ROPE);
    for (long i = GT_; i < (long)T * 32; i += GS_) { const int j = (int)(i & 31); const float ang = (float)pos[i >> 5] * powf(10000.f, -(float)(2 * j) / 64.f); RT[i * 2] = cosf(ang); RT[i * 2 + 1] = sinf(ang); }
}
__device__ __forceinline__ void ret_tables(float* tab, int h) {
    const int tid = threadIdx.x; const float lg = loggamma_(h);
    if (tid < 32) tab[tid] = powf(10000.f, -(float)(2 * tid) / 64.f);
    if (tid >= 64 && tid < 64 + 129) tab[tid] = expf((float)(tid - 64) * lg);
}
__device__ __forceinline__ void ph_ret_kv(const Ctx& c, float* ldsf) {
    const float* RT = WSF(O_ROPE); const bf16_t* P = WSH(O_P); float* KVF = WSF(O_KVF); float* KVB = WSF(O_KVB);
    bf16_t* VT = (bf16_t*)ldsf; bf16_t* KF = VT + 128 * 136; bf16_t* KB = KF + 64 * 136; float* tab = (float*)(KB + 64 * 136);
    const int tid = threadIdx.x, wv = tid >> 6, lane = tid & 63, fr = lane & 15, fq = lane >> 4;
    for (int u = blockIdx.x; u < (T / 128) * 8; u += gridDim.x) {
        const int h = u & 7; const long t0 = (long)(u >> 3) * 128;
        ret_tables(tab, h);
        SYNCTHREADS();
        { float x1[8], x2[8];
#pragma unroll
          for (int q = 0; q < 8; ++q) { const int id = tid + NT * q, j = id & 127, dj = id >> 7; const bf16_t* prow = P + (size_t)(t0 + j) * PW + C_RK + h * 64; x1[q] = bf2f(prow[dj]); x2[q] = bf2f(prow[dj + 32]); }
#pragma unroll 1
          for (int q = 0; q < 8; ++q) { const int id = tid + NT * q, j = id & 127, dj = id >> 7; const float cs = RT[((size_t)(t0 + j) * 32 + dj) * 2], sn = RT[((size_t)(t0 + j) * 32 + dj) * 2 + 1];
            const float k1 = x1[q] * cs - x2[q] * sn, k2 = x2[q] * cs + x1[q] * sn, fj = tab[64 + 127 - j], bj = tab[64 + j];
            KF[dj * 136 + j] = (bf16_t)f2bf(k1 * fj); KF[(dj + 32) * 136 + j] = (bf16_t)f2bf(k2 * fj); KB[dj * 136 + j] = (bf16_t)f2bf(k1 * bj); KB[(dj + 32) * 136 + j] = (bf16_t)f2bf(k2 * bj); } }
#pragma unroll
        for (int q = 0; q < 4; ++q) { const int id = tid + NT * q, j = id & 127, e8 = (id >> 7) * 8; const u32x4 raw = *(const u32x4*)(P + (size_t)(t0 + j) * PW + C_RV + h * 128 + e8);
#pragma unroll
            for (int e = 0; e < 4; ++e) { VT[(e8 + 2 * e) * 136 + j] = (bf16_t)(raw[e] & 0xffffu); VT[(e8 + 2 * e + 1) * 136 + j] = (bf16_t)(raw[e] >> 16); } }
        SYNCTHREADS();
        f32x4 af[4], ab[4];
#pragma unroll
        for (int nt = 0; nt < 4; ++nt) { af[nt] = (f32x4){0.f, 0.f, 0.f, 0.f}; ab[nt] = (f32x4){0.f, 0.f, 0.f, 0.f}; }
        wave_mma<4, 4>(af, VT + wv * 16 * 136, 136, KF, 136);
        wave_mma<4, 4>(ab, VT + wv * 16 * 136, 136, KB, 136);
        const size_t ob = (((size_t)(u >> 3) * 8 + h) * 128 + wv * 16 + fr) * 64 + 4 * fq;
#pragma unroll
        for (int nt = 0; nt < 4; ++nt) { *(f32x4*)(KVF + ob + 16 * nt) = af[nt]; *(f32x4*)(KVB + ob + 16 * nt) = ab[nt]; }
        SYNCTHREADS();
    }
}
__device__ __forceinline__ void ph_ret_state(const Ctx& c) {
    const float* KVF = WSF(O_KVF); const float* KVB = WSF(O_KVB); float* STF = WSF(O_STF); float* STB = WSF(O_STB);
    for (long i = GT_; i < (long)NB * 8 * 8192; i += GS_) {
        const int x = (int)(i % 8192), h = (int)((i / 8192) % 8), b = (int)(i / 65536);
        const float cd = expf(128.f * loggamma_(h)); float st = 0.f;
#pragma unroll 16
        for (int n = 0; n < NCH; ++n) { const size_t idx = (((size_t)b * NCH + n) * 8 + h) * 8192 + x; STF[idx] = st; st = cd * st + KVF[idx]; }
        st = 0.f;
#pragma unroll 16
        for (int n = NCH - 1; n >= 0; --n) { const size_t idx = (((size_t)b * NCH + n) * 8 + h) * 8192 + x; STB[idx] = st; st = cd * st + KVB[idx]; }
    }
}
__device__ __forceinline__ void ph_ret_out(const Ctx& c, float* ldsf) {
    const float* RT = WSF(O_ROPE); const bf16_t* P = WSH(O_P); const float* STF = WSF(O_STF); const float* STB = WSF(O_STB); bf16_t* Y = WSH(O_YS);
    bf16_t* Qs = (bf16_t*)ldsf; bf16_t* Ks = Qs + 128 * 72; bf16_t* VT = Ks + 128 * 72; bf16_t* Ss = VT + 128 * 136; bf16_t* SF = Ss + 128 * 136; bf16_t* SB = SF + 128 * 72; float* tab = (float*)(SB + 128 * 72);
    const int tid = threadIdx.x, wv = tid >> 6, lane = tid & 63, fr = lane & 15, fq = lane >> 4;
    for (int u = blockIdx.x; u < (T / 128) * 8; u += gridDim.x) {
        const int h = u & 7; const long t0 = (long)(u >> 3) * 128;
        ret_tables(tab, h);
        SYNCTHREADS();
#pragma unroll 1
        for (int qh = 0; qh < 8; qh += 4) { float q1[4], q2[4], k1[4], k2[4];
#pragma unroll
          for (int q = 0; q < 4; ++q) { const int id = tid + NT * (qh + q), j = id >> 5, dj = id & 31; const bf16_t* prow = P + (size_t)(t0 + j) * PW;
            q1[q] = bf2f(prow[C_RQ + h * 64 + dj]); q2[q] = bf2f(prow[C_RQ + h * 64 + dj + 32]); k1[q] = bf2f(prow[C_RK + h * 64 + dj]); k2[q] = bf2f(prow[C_RK + h * 64 + dj + 32]); }
#pragma unroll
          for (int q = 0; q < 4; ++q) { const int id = tid + NT * (qh + q), j = id >> 5, dj = id & 31; const float cs = RT[((size_t)(t0 + j) * 32 + dj) * 2], sn = RT[((size_t)(t0 + j) * 32 + dj) * 2 + 1];
            Qs[j * 72 + dj] = (bf16_t)f2bf((q1[q] * cs - q2[q] * sn) * 0.125f); Qs[j * 72 + dj + 32] = (bf16_t)f2bf((q2[q] * cs + q1[q] * sn) * 0.125f); Ks[j * 72 + dj] = (bf16_t)f2bf(k1[q] * cs - k2[q] * sn); Ks[j * 72 + dj + 32] = (bf16_t)f2bf(k2[q] * cs + k1[q] * sn); } }
#pragma unroll
        for (int q = 0; q < 4; ++q) { const int id = tid + NT * q, j = id & 127, e8 = (id >> 7) * 8; const u32x4 raw = *(const u32x4*)(P + (size_t)(t0 + j) * PW + C_RV + h * 128 + e8);
#pragma unroll
            for (int e = 0; e < 4; ++e) { VT[(e8 + 2 * e) * 136 + j] = (bf16_t)(raw[e] & 0xffffu); VT[(e8 + 2 * e + 1) * 136 + j] = (bf16_t)(raw[e] >> 16); } }
        const size_t sbase = (((size_t)(u >> 3) * 8 + h)) * 8192;
#pragma unroll
        for (int q = 0; q < 4; ++q) { const int id = tid + NT * q, e = id >> 4, d4 = (id & 15) * 4; st_bf4(SF + e * 72 + d4, *(const f32x4*)(STF + sbase + (size_t)e * 64 + d4)); st_bf4(SB + e * 72 + d4, *(const f32x4*)(STB + sbase + (size_t)e * 64 + d4)); }
        SYNCTHREADS();
        const int i = wv * 16 + fr; const long t = t0 + i;
        {
            f32x4 sc[8];
#pragma unroll
            for (int nt = 0; nt < 8; ++nt) sc[nt] = (f32x4){0.f, 0.f, 0.f, 0.f};
            wave_mma<2, 8>(sc, Qs + wv * 16 * 72, 72, Ks, 72);
#pragma unroll
            for (int nt = 0; nt < 8; ++nt) { const int j0 = 16 * nt + 4 * fq; f32x4 sv;
#pragma unroll
                for (int e = 0; e < 4; ++e) { const int j = j0 + e, dist = i > j ? i - j : j - i; sv[e] = sc[nt][e] * tab[64 + dist]; }
                st_bf4(Ss + i * 136 + j0, sv); }
        }
#ifdef CPU_EMU
        SYNCTHREADS();
#else
        asm volatile("s_waitcnt lgkmcnt(0)" ::: "memory");
#endif
        f32x4 ao[8], tm[8];
#pragma unroll
        for (int nt = 0; nt < 8; ++nt) { ao[nt] = (f32x4){0.f, 0.f, 0.f, 0.f}; tm[nt] = (f32x4){0.f, 0.f, 0.f, 0.f}; }
        wave_mma<4, 8>(ao, Ss + wv * 16 * 136, 136, VT, 136);
        wave_mma<2, 8>(tm, Qs + wv * 16 * 72, 72, SF, 72);
        { const float qf = tab[64 + i + 1];
#pragma unroll
            for (int nt = 0; nt < 8; ++nt) { ao[nt] += tm[nt] * qf; tm[nt] = (f32x4){0.f, 0.f, 0.f, 0.f}; } }
        wave_mma<2, 8>(tm, Qs + wv * 16 * 72, 72, SB, 72);
        { const float qb = tab[64 + 128 - i];
#pragma unroll
            for (int nt = 0; nt < 8; ++nt) ao[nt] += tm[nt] * qb; }
        float sm = 0.f;
#pragma unroll
        for (int nt = 0; nt < 8; ++nt) sm += (ao[nt][0] + ao[nt][1]) + (ao[nt][2] + ao[nt][3]);
        sm += SHFL_XOR(sm, 16); sm += SHFL_XOR(sm, 32);
        const float mu = sm * (1.f / 128.f); float sq = 0.f;
#pragma unroll
        for (int nt = 0; nt < 8; ++nt) { ao[nt] -= mu; sq += (ao[nt][0] * ao[nt][0] + ao[nt][1] * ao[nt][1]) + (ao[nt][2] * ao[nt][2] + ao[nt][3] * ao[nt][3]); }
        sq += SHFL_XOR(sq, 16); sq += SHFL_XOR(sq, 32);
        const float rs = 1.f / sqrtf(sq * (1.f / 128.f) + EPS);
#pragma unroll
        for (int nt = 0; nt < 8; ++nt) { const int e0 = 16 * nt + 4 * fq; f32x4 gv = ld_bf4(P + (size_t)t * PW + C_RG + h * 128 + e0);
#pragma unroll
            for (int e = 0; e < 4; ++e) gv[e] = siluf_(gv[e]) * (ao[nt][e] * rs);
            st_bf4(Y + (size_t)t * 4 * W + 1 * W + h * 128 + e0, gv); }
        SYNCTHREADS();
    }
}
__device__ __forceinline__ void ph_sgu_norm(const Ctx& c, int l) {
    const bf16_t* P = WSH(O_P); float* ST = WSF(O_VN);
    const int lane = threadIdx.x & 63, gw = blockIdx.x * (NT / 64) + (threadIdx.x >> 6), ngw = gridDim.x * (NT / 64);
    for (int t = gw; t < T; t += ngw) {
        f32x4 v[4]; float sm = 0.f;
#pragma unroll
        for (int j = 0; j < 4; ++j) { v[j] = ld_bf4(P + (size_t)t * PW + C_SV + (j * 64 + lane) * 4);
#pragma unroll
            for (int q = 0; q < 4; ++q) { v[j][q] = geluf_(v[j][q]); sm += v[j][q]; } }
        const float mu = wave_sum(sm) * (1.f / W); float sq = 0.f;
#pragma unroll
        for (int j = 0; j < 4; ++j)
#pragma unroll
            for (int q = 0; q < 4; ++q) { const float dd = v[j][q] - mu; sq += dd * dd; }
        const float rs = 1.f / sqrtf(wave_sum(sq) * (1.f / W) + EPS);
        if (lane == 0) { ST[(size_t)t * 2] = mu; ST[(size_t)t * 2 + 1] = rs; }
    }
}
__device__ __forceinline__ void ph_sgu_mix(const Ctx& c, int l, float* ldsf) {
    const bf16_t* P = WSH(O_P); const float* ST = WSF(O_VN); bf16_t* Y = WSH(O_YS); const float* ng = c.in[15] + (size_t)l * W;
    bf16_t* As = (bf16_t*)ldsf; bf16_t* Bs = As + 128 * 136; const int tid = threadIdx.x, wv = tid >> 6, lane = tid & 63, fr = lane & 15, fq = lane >> 4;
    for (int u = blockIdx.x; u < (T / 128) * 8; u += gridDim.x) {
        const int g = u & 7; const long t0 = (long)(u >> 3) * 128;
        const float* ws = c.in[16] + ((size_t)l * 8 + g) * 128 * 128; const float* bs = c.in[17] + ((size_t)l * 8 + g) * 128;
#pragma unroll
        for (int q = 0; q < 8; ++q) { const int id = tid + NT * q, i = id >> 5, j4 = (id & 31) * 4; st_bf4(As + i * 136 + j4, *(const f32x4*)(ws + i * 128 + j4)); }
#pragma unroll
        for (int q = 0; q < 4; ++q) { const int id = tid + NT * q, j = id & 127, d8 = (id >> 7) * 8; const float mu = ST[(size_t)(t0 + j) * 2], rs = ST[(size_t)(t0 + j) * 2 + 1];
            const u32x4 raw = *(const u32x4*)(P + (size_t)(t0 + j) * PW + C_SV + g * 128 + d8);
#pragma unroll
            for (int e = 0; e < 4; ++e) { const float v0 = (geluf_(bflo(raw[e])) - mu) * rs * ng[g * 128 + d8 + 2 * e], v1 = (geluf_(bfhi(raw[e])) - mu) * rs * ng[g * 128 + d8 + 2 * e + 1];
                Bs[(d8 + 2 * e) * 136 + j] = (bf16_t)f2bf(v0); Bs[(d8 + 2 * e + 1) * 136 + j] = (bf16_t)f2bf(v1); } }
        SYNCTHREADS();
        f32x4 acc[8];
#pragma unroll
        for (int nt = 0; nt < 8; ++nt) acc[nt] = (f32x4){0.f, 0.f, 0.f, 0.f};
        wave_mma<4, 8>(acc, As + wv * 16 * 136, 136, Bs, 136);
        const int i = wv * 16 + fr; const long t = t0 + i; const float bsi = bs[i];
#pragma unroll
        for (int nt = 0; nt < 8; ++nt) { const int d = 16 * nt + 4 * fq; f32x4 uu = ld_bf4(P + (size_t)t * PW + C_SU + g * 128 + d);
#pragma unroll
            for (int e = 0; e < 4; ++e) uu[e] = geluf_(uu[e]) * (acc[nt][e] + bsi);
            st_bf4(Y + (size_t)t * 4 * W + 2 * W + g * 128 + d, uu); }
        SYNCTHREADS();
    }
}
__device__ __forceinline__ void ph_rw_shift(const Ctx& c, int l) {
    const bf16_t* P = WSH(O_P); const float* mup = c.in[18] + (size_t)l * RF; const float* mun = c.in[19] + (size_t)l * RF; bf16_t* FS = WSH(O_FS);
    const int lane = threadIdx.x & 63, gw = blockIdx.x * (NT / 64) + (threadIdx.x >> 6), ngw = gridDim.x * (NT / 64);
    for (int t = gw; t < T; t += ngw) {
        const int sI = t % S; const bf16_t* pc = P + (size_t)t * PW + C_RW;
#pragma unroll 2
        for (int j = lane * 4; j < RF; j += 256) {
            const f32x4 f = ld_bf4(pc + j), z4 = (f32x4){0.f, 0.f, 0.f, 0.f}; const f32x4 pv = sI > 0 ? ld_bf4(pc - PW + j) : z4, nv = sI < S - 1 ? ld_bf4(pc + PW + j) : z4;
            f32x4 v = f + *(const f32x4*)(mup + j) * (pv - f) + *(const f32x4*)(mun + j) * (nv - f);
            if (j >= 3072 && j < 3200) {
#pragma unroll
                for (int e = 0; e < 4; ++e) v[e] = tanhf_(v[e]); }
            else if (j >= 3328) {
#pragma unroll
                for (int e = 0; e < 4; ++e) v[e] = sigmoidf_(v[e]); }
            st_bf4(FS + (size_t)t * RF + j, v);
        }
    }
}
__device__ __forceinline__ void ph_rw_lora(const Ctx& c, int l, float* ldsf) {
    const bf16_t* FS = WSH(O_FS); const float* w0 = c.in[20] + (size_t)l * 2 * W; const float* a0 = c.in[22] + (size_t)l * 2 * W;
    const bf16_t* WUT = WSH(O_WUT); const bf16_t* WAT = WSH(O_WAT); const bf16_t* WGT = WSH(O_WGT);
    bf16_t* DEC = WSH(O_DEC); bf16_t* AA = WSH(O_AA); bf16_t* GG = WSH(O_GG);
    bf16_t* F = (bf16_t*)ldsf; bf16_t* B1 = F + 128 * 136; bf16_t* B2 = B1 + 128 * 136; const int tid = threadIdx.x, wv = tid >> 6, lane = tid & 63, fr = lane & 15, fq = lane >> 4;
    for (int u = blockIdx.x; u < (T / 128) * 8; u += gridDim.x) {
        const int wc0 = (u & 7) * 128; const long t0 = (long)(u >> 3) * 128;
        for (int rd = 0; rd < 3; ++rd) {
#pragma unroll
            for (int q = 0; q < 8; ++q) { const int id = tid + NT * q, r = id >> 5, c4 = (id & 31) * 4;
                const int col = rd < 2 ? (c4 < 64 ? 3072 + rd * 64 + c4 : 3200 + rd * 64 + (c4 - 64)) : 3328 + c4;
                *(unsigned long long*)(F + r * 136 + c4) = *(const unsigned long long*)(FS + (size_t)(t0 + r) * RF + col); }
            if (rd < 2) {
#pragma unroll
                for (int q = 0; q < 2; ++q) { const int id = tid + NT * q, w = id >> 3, r8 = (id & 7) * 8;
                    *(u32x4*)(B1 + w * 72 + r8) = *(const u32x4*)(WUT + ((size_t)rd * W + wc0 + w) * 64 + r8); *(u32x4*)(B2 + w * 72 + r8) = *(const u32x4*)(WAT + ((size_t)rd * W + wc0 + w) * 64 + r8); }
            } else {
#pragma unroll
                for (int q = 0; q < 4; ++q) { const int id = tid + NT * q, w = id >> 4, r8 = (id & 15) * 8; *(u32x4*)(B1 + w * 136 + r8) = *(const u32x4*)(WGT + ((size_t)wc0 + w) * 128 + r8); }
            }
            SYNCTHREADS();
            f32x4 a1[8], a2[8];
#pragma unroll
            for (int nt = 0; nt < 8; ++nt) { a1[nt] = (f32x4){0.f, 0.f, 0.f, 0.f}; a2[nt] = (f32x4){0.f, 0.f, 0.f, 0.f}; }
            const long t = t0 + wv * 16 + fr;
            if (rd < 2) {
                wave_mma<2, 8>(a1, F + wv * 16 * 136, 136, B1, 72);
                wave_mma<2, 8>(a2, F + wv * 16 * 136 + 64, 136, B2, 72);
#pragma unroll
                for (int nt = 0; nt < 8; ++nt) { const int ch = wc0 + 16 * nt + 4 * fq; const f32x4 w0v = *(const f32x4*)(w0 + rd * W + ch), a0v = *(const f32x4*)(a0 + rd * W + ch); f32x4 dv, av;
#pragma unroll
                    for (int e = 0; e < 4; ++e) { dv[e] = fexp_(-DECAY_SCALE * sigmoidf_(a1[nt][e] + w0v[e])); av[e] = sigmoidf_(a2[nt][e] + a0v[e]); }
                    st_bf4(DEC + ((size_t)rd * T + t) * W + ch, dv); st_bf4(AA + ((size_t)rd * T + t) * W + ch, av); }
            } else {
                wave_mma<4, 8>(a1, F + wv * 16 * 136, 136, B1, 136);
#pragma unroll
                for (int nt = 0; nt < 8; ++nt) st_bf4(GG + (size_t)t * W + wc0 + 16 * nt + 4 * fq, a1[nt]);
            }
            SYNCTHREADS();
        }
    }
}
#ifdef CPU_EMU
__device__ __forceinline__ float red16_(float x) { x += SHFL_XOR(x, 1); x += SHFL_XOR(x, 2); x += SHFL_XOR(x, 4); x += SHFL_XOR(x, 8); return x; }
__device__ __forceinline__ float red8_(float x) { x += SHFL_XOR(x, 1); x += SHFL_XOR(x, 2); x += SHFL_XOR(x, 4); return x; }
#define LDS_BARRIER() emu_syncthreads()
#else
__device__ __forceinline__ float red8_(float x) {
    x += __builtin_bit_cast(float, __builtin_amdgcn_update_dpp(0, __builtin_bit_cast(int, x), 0xB1, 0xF, 0xF, true));
    x += __builtin_bit_cast(float, __builtin_amdgcn_update_dpp(0, __builtin_bit_cast(int, x), 0x4E, 0xF, 0xF, true));
    x += __builtin_bit_cast(float, __builtin_amdgcn_update_dpp(0, __builtin_bit_cast(int, x), 0x141, 0xF, 0xF, true));
    return x;
}
__device__ __forceinline__ float red16_(float x) {
    x += __builtin_bit_cast(float, __builtin_amdgcn_update_dpp(0, __builtin_bit_cast(int, x), 0xB1, 0xF, 0xF, true));
    x += __builtin_bit_cast(float, __builtin_amdgcn_update_dpp(0, __builtin_bit_cast(int, x), 0x4E, 0xF, 0xF, true));
    x += __builtin_bit_cast(float, __builtin_amdgcn_update_dpp(0, __builtin_bit_cast(int, x), 0x141, 0xF, 0xF, true));
    x += __builtin_bit_cast(float, __builtin_amdgcn_update_dpp(0, __builtin_bit_cast(int, x), 0x140, 0xF, 0xF, true));
    return x;
}
#define LDS_BARRIER() do { asm volatile("s_waitcnt lgkmcnt(0)" ::: "memory"); __builtin_amdgcn_s_barrier(); asm volatile("" ::: "memory"); } while (0)
#endif
#define RC_M(k) (lm + (k) * 4608)
__device__ __forceinline__ void ph_rw_chunk(const Ctx& c, int l, float* ldsf) {
    const bf16_t* FS = WSH(O_FS); const bf16_t* DEC = WSH(O_DEC); const bf16_t* AA = WSH(O_AA); float* BON = WSF(O_BON);
    const float* kkw = c.in[25] + (size_t)l * W; const float* kaw = c.in[26] + (size_t)l * W; const float* rk = c.in[27] + (size_t)l * W;
    bf16_t* PST = WSH(O_PST); bf16_t* PYT = WSH(O_PYT); bf16_t* SVB = WSH(O_SVB); bf16_t* YVB = WSH(O_YVB);
    bf16_t* lm = (bf16_t*)ldsf; float* gam = (float*)RC_M(7); float* segp = (float*)RC_M(13); float* gl = segp + 512;
    const int tid = threadIdx.x, wv = tid >> 6, lane = tid & 63, fr = lane & 15, fq = lane >> 4, rt = wv & 3, hf = wv >> 2;
    const int m0 = 16 * rt + fr;
    u32x4 wq, kq, rq, vq, aq;
#define RC_LOAD(uu) do { const int chain_ = (uu) / NRC, ck_ = (uu) % NRC, h_ = chain_ & 15, b_ = (chain_ >> 4) & 1, z_ = chain_ >> 5; \
        const long t_ = (long)b_ * S + (z_ ? S - 1 - ck_ * RCK - (tid >> 3) : ck_ * RCK + (tid >> 3)); const int ch_ = h_ * 64 + (tid & 7) * 8; \
        wq = *(const u32x4*)(DEC + ((size_t)z_ * T + t_) * W + ch_); aq = *(const u32x4*)(AA + ((size_t)z_ * T + t_) * W + ch_); \
        const bf16_t* f_ = FS + (size_t)t_ * RF; rq = *(const u32x4*)(f_ + ch_); kq = *(const u32x4*)(f_ + 1024 + ch_); vq = *(const u32x4*)(f_ + 2048 + ch_); } while (0)
    if ((int)blockIdx.x < 64 * NRC) RC_LOAD((int)blockIdx.x);
    for (int u = blockIdx.x; u < 64 * NRC; u += gridDim.x) {
        const int chain = u / NRC, ck = u % NRC, h = chain & 15, b = (chain >> 4) & 1, z = chain >> 5;
        const long tb = (long)b * S + (z ? S - 1 - ck * RCK : ck * RCK); const int dirn = z ? -1 : 1;
        const int tt = tid >> 3, o8 = (tid & 7) * 8;
        const f32x4 kw0 = *(const f32x4*)(kkw + h * 64 + o8), kw1 = *(const f32x4*)(kkw + h * 64 + o8 + 4), ka0 = *(const f32x4*)(kaw + h * 64 + o8), ka1 = *(const f32x4*)(kaw + h * 64 + o8 + 4),
                    rk0 = *(const f32x4*)(rk + h * 64 + o8), rk1 = *(const f32x4*)(rk + h * 64 + o8 + 4);
        *(f32x4*)(gam + tt * 64 + o8) = (f32x4){bflo(wq[0]), bfhi(wq[0]), bflo(wq[1]), bfhi(wq[1])};
        *(f32x4*)(gam + tt * 64 + o8 + 4) = (f32x4){bflo(wq[2]), bfhi(wq[2]), bflo(wq[3]), bfhi(wq[3])};
        LDS_BARRIER();
        { const int k = tid & 63, sg = tid >> 6; float p = 1.f;
#pragma unroll
          for (int q = 0; q < 8; ++q) { p *= gam[(sg * 8 + q) * 64 + k]; gam[(sg * 8 + q) * 64 + k] = p; }
          segp[sg * 64 + k] = p; }
        LDS_BARRIER();
        { const int k = tid & 63, sg = tid >> 6; float pre = 1.f;
          for (int q = 0; q < sg; ++q) pre *= segp[q * 64 + k];
#pragma unroll
          for (int q = 0; q < 8; ++q) gam[(sg * 8 + q) * 64 + k] *= pre;
          if (sg == 7) gl[k] = gam[63 * 64 + k]; }
        LDS_BARRIER();
        { const long t = tb + dirn * tt;
          const f32x4 g0 = *(const f32x4*)(gam + tt * 64 + o8), g1 = *(const f32x4*)(gam + tt * 64 + o8 + 4);
          f32x4 p0 = (f32x4){1.f, 1.f, 1.f, 1.f}, p1 = p0; if (tt) { p0 = *(const f32x4*)(gam + (tt - 1) * 64 + o8); p1 = *(const f32x4*)(gam + (tt - 1) * 64 + o8 + 4); }
          float gx[8], gpx[8], kwx[8], kax[8], rkx[8], kx[8], ax[8], rx[8];
#pragma unroll
          for (int e = 0; e < 4; ++e) { gx[e] = g0[e]; gx[4 + e] = g1[e]; gpx[e] = p0[e]; gpx[4 + e] = p1[e]; kwx[e] = kw0[e]; kwx[4 + e] = kw1[e]; kax[e] = ka0[e]; kax[4 + e] = ka1[e]; rkx[e] = rk0[e]; rkx[4 + e] = rk1[e];
              kx[2 * e] = bflo(kq[e]); kx[2 * e + 1] = bfhi(kq[e]); ax[2 * e] = bflo(aq[e]); ax[2 * e + 1] = bfhi(aq[e]); rx[2 * e] = bflo(rq[e]); rx[2 * e + 1] = bfhi(rq[e]); }
          float vk[8], ktv[8], ss = 0.f, bs = 0.f;
#pragma unroll
          for (int e = 0; e < 8; ++e) { vk[e] = kx[e] * kwx[e]; ss += vk[e] * vk[e]; ktv[e] = kx[e] * (1.f + (ax[e] - 1.f) * kax[e]); bs += rx[e] * rkx[e] * ktv[e]; }
          ss = red8_(ss); bs = red8_(bs);
          if ((tid & 7) == 0) BON[((size_t)z * T + t) * 16 + h] = bs;
          const float rn = frsq_(ss + EPS); float khv[8], bhv[8], k2v[8], rhv[8];
#pragma unroll
          for (int e = 0; e < 8; ++e) { const float kkn = vk[e] * rn, ig = frcp_(gx[e]); khv[e] = kkn * gpx[e]; bhv[e] = ax[e] * kkn * ig; k2v[e] = ktv[e] * ig; rhv[e] = rx[e] * gx[e]; }
          u32x4 K4, B4, C4, R4;
#pragma unroll
          for (int e = 0; e < 4; ++e) { K4[e] = pk2(khv[2 * e], khv[2 * e + 1]); B4[e] = pk2(bhv[2 * e], bhv[2 * e + 1]); C4[e] = pk2(k2v[2 * e], k2v[2 * e + 1]); R4[e] = pk2(rhv[2 * e], rhv[2 * e + 1]); }
          *(u32x4*)(RC_M(0) + tt * 72 + o8) = K4; *(u32x4*)(RC_M(2) + tt * 72 + o8) = B4; *(u32x4*)(RC_M(4) + tt * 72 + o8) = C4; *(u32x4*)(RC_M(5) + tt * 72 + o8) = R4;
#pragma unroll
          for (int e = 0; e < 8; ++e) { const int sh = 16 * (e & 1);
              RC_M(1)[(o8 + e) * 72 + tt] = (bf16_t)(K4[e >> 1] >> sh); RC_M(3)[(o8 + e) * 72 + tt] = (bf16_t)(B4[e >> 1] >> sh); RC_M(6)[(o8 + e) * 72 + tt] = (bf16_t)(vq[e >> 1] >> sh); } }
        if (u + (int)gridDim.x < 64 * NRC) RC_LOAD(u + (int)gridDim.x);
        LDS_BARRIER();
        f32x4 mkr[2], khr[2], rhT[2];
        {
            f32x4 a0[2], a1[2], a2[2], a3[2];
#pragma unroll
            for (int nt = 0; nt < 2; ++nt) { a0[nt] = (f32x4){0.f, 0.f, 0.f, 0.f}; a1[nt] = a0[nt]; a2[nt] = a0[nt]; a3[nt] = a0[nt]; }
            wave_mma<2, 2>(a0, RC_M(2) + rt * 16 * 72, 72, RC_M(0) + hf * 32 * 72, 72);
            wave_mma<2, 2>(a1, RC_M(4) + rt * 16 * 72, 72, RC_M(0) + hf * 32 * 72, 72);
            wave_mma<2, 2>(a2, RC_M(2) + rt * 16 * 72, 72, RC_M(5) + hf * 32 * 72, 72);
            wave_mma<2, 2>(a3, RC_M(4) + rt * 16 * 72, 72, RC_M(5) + hf * 32 * 72, 72);
#pragma unroll
            for (int nt = 0; nt < 2; ++nt) { const int n0 = 32 * hf + 16 * nt + 4 * fq; f32x4 nn, ti, mk;
#pragma unroll
                for (int r = 0; r < 4; ++r) { const int n = n0 + r; const bool lt = m0 < n, le = m0 <= n;
                    nn[r] = lt ? -a0[nt][r] : 0.f; ti[r] = nn[r] + (m0 == n ? 1.f : 0.f); mk[r] = lt ? a1[nt][r] : 0.f; mkr[nt][r] = le ? a3[nt][r] : 0.f;
                    RC_M(12)[n * 72 + m0] = (bf16_t)f2bf(le ? a2[nt][r] : 0.f);
                    RC_M(8)[n * 72 + m0] = (bf16_t)f2bf(nn[r]);
                    khr[nt][r] = bf2f(RC_M(4)[m0 * 72 + n]); rhT[nt][r] = bf2f(RC_M(5)[n * 72 + m0]); }
                st_bf4(RC_M(7) + m0 * 72 + n0, nn); st_bf4(RC_M(9) + m0 * 72 + n0, ti); st_bf4(RC_M(11) + m0 * 72 + n0, mk); }
        }
        LDS_BARRIER();
        f32x4 tiv[2];
#pragma unroll
        for (int nt = 0; nt < 2; ++nt) tiv[nt] = ld_bf4(RC_M(9) + m0 * 72 + 32 * hf + 16 * nt + 4 * fq);
#pragma unroll 1
        for (int it = 0; it < 5; ++it) {
            bf16_t* pw = (it & 1) ? RC_M(0) : RC_M(7); bf16_t* pwT = (it & 1) ? RC_M(2) : RC_M(8); bf16_t* pw2 = (it & 1) ? RC_M(7) : RC_M(0); bf16_t* pw2T = (it & 1) ? RC_M(8) : RC_M(2);
            bf16_t* tcur = (it & 1) ? RC_M(4) : RC_M(9); bf16_t* tnxt = (it & 1) ? RC_M(9) : RC_M(4);
            f32x4 sq[2];
#pragma unroll
            for (int nt = 0; nt < 2; ++nt) sq[nt] = (f32x4){0.f, 0.f, 0.f, 0.f};
            wave_mma<2, 2>(sq, pw + rt * 16 * 72, 72, pwT + hf * 32 * 72, 72);
#pragma unroll
            for (int nt = 0; nt < 2; ++nt) { const int n0 = 32 * hf + 16 * nt + 4 * fq; st_bf4(pw2 + m0 * 72 + n0, sq[nt]);
#pragma unroll
                for (int r = 0; r < 4; ++r) pw2T[(n0 + r) * 72 + m0] = (bf16_t)f2bf(sq[nt][r]); }
            LDS_BARRIER();
            f32x4 up[2];
#pragma unroll
            for (int nt = 0; nt < 2; ++nt) up[nt] = (f32x4){0.f, 0.f, 0.f, 0.f};
            wave_mma<2, 2>(up, tcur + rt * 16 * 72, 72, pw2T + hf * 32 * 72, 72);
#pragma unroll
            for (int nt = 0; nt < 2; ++nt) { const int n0 = 32 * hf + 16 * nt + 4 * fq; tiv[nt] += up[nt]; st_bf4(tnxt + m0 * 72 + n0, tiv[nt]);
                if (it == 4) {
#pragma unroll
                    for (int r = 0; r < 4; ++r) RC_M(10)[(n0 + r) * 72 + m0] = (bf16_t)f2bf(tiv[nt][r]); } }
            LDS_BARRIER();
        }
        {
            f32x4 w1[2], w2[2];
#pragma unroll
            for (int nt = 0; nt < 2; ++nt) { w1[nt] = (f32x4){0.f, 0.f, 0.f, 0.f}; w2[nt] = w1[nt]; }
            wave_mma<2, 2>(w1, RC_M(1) + rt * 16 * 72, 72, RC_M(10) + hf * 32 * 72, 72);
            wave_mma<2, 2>(w2, RC_M(11) + rt * 16 * 72, 72, RC_M(10) + hf * 32 * 72, 72);
#pragma unroll
            for (int nt = 0; nt < 2; ++nt) { const int n0 = 32 * hf + 16 * nt + 4 * fq; st_bf4(RC_M(7) + m0 * 72 + n0, w1[nt]); st_bf4(RC_M(8) + m0 * 72 + n0, w2[nt]); }
        }
        LDS_BARRIER();
        {
            f32x4 py[2], qy[2], ps[2], qs[2];
#pragma unroll
            for (int nt = 0; nt < 2; ++nt) { py[nt] = (f32x4){0.f, 0.f, 0.f, 0.f}; qy[nt] = py[nt]; ps[nt] = py[nt]; qs[nt] = py[nt]; }
            wave_mma<2, 2>(py, RC_M(7) + rt * 16 * 72, 72, RC_M(12) + hf * 32 * 72, 72);
            wave_mma<2, 2>(qy, RC_M(8) + rt * 16 * 72, 72, RC_M(12) + hf * 32 * 72, 72);
            wave_mma<2, 2>(ps, RC_M(7) + rt * 16 * 72, 72, RC_M(3) + hf * 32 * 72, 72);
            wave_mma<2, 2>(qs, RC_M(8) + rt * 16 * 72, 72, RC_M(3) + hf * 32 * 72, 72);
#pragma unroll
            for (int nt = 0; nt < 2; ++nt) { const int n0 = 32 * hf + 16 * nt + 4 * fq;
#pragma unroll
                for (int r = 0; r < 4; ++r) { const int n = n0 + r; const float gln = gl[n];
                    RC_M(0)[n * 72 + m0] = (bf16_t)f2bf(rhT[nt][r] - py[nt][r]); RC_M(2)[n * 72 + m0] = (bf16_t)f2bf(mkr[nt][r] - qy[nt][r]);
                    RC_M(4)[n * 72 + m0] = (bf16_t)f2bf(((m0 == n ? 1.f : 0.f) - ps[nt][r]) * gln); RC_M(5)[n * 72 + m0] = (bf16_t)f2bf((khr[nt][r] - qs[nt][r]) * gln); } }
        }
        LDS_BARRIER();
        {
            f32x4 yv[2], sv[2];
#pragma unroll
            for (int nt = 0; nt < 2; ++nt) { yv[nt] = (f32x4){0.f, 0.f, 0.f, 0.f}; sv[nt] = yv[nt]; }
            wave_mma<2, 2>(yv, RC_M(6) + rt * 16 * 72, 72, RC_M(2) + hf * 32 * 72, 72);
            wave_mma<2, 2>(sv, RC_M(6) + rt * 16 * 72, 72, RC_M(5) + hf * 32 * 72, 72);
#pragma unroll
            for (int nt = 0; nt < 2; ++nt) { const int n0 = 32 * hf + 16 * nt + 4 * fq; st_bf4(YVB + (size_t)u * 4096 + m0 * 64 + n0, yv[nt]); st_bf4(SVB + (size_t)u * 4096 + m0 * 64 + n0, sv[nt]); }
            { const int rr = tid >> 3, c8 = (tid & 7) * 8; *(u32x4*)(PYT + (size_t)u * 4096 + rr * 64 + c8) = *(const u32x4*)(RC_M(0) + rr * 72 + c8); *(u32x4*)(PST + (size_t)u * 4096 + rr * 64 + c8) = *(const u32x4*)(RC_M(4) + rr * 72 + c8); }
        }
        LDS_BARRIER();
    }
}
#undef RC_M
#undef RC_LOAD
__device__ __forceinline__ void ph_rw_seq(const Ctx& c, float* ldsf) {
    const bf16_t* PST = WSH(O_PST); const bf16_t* PYT = WSH(O_PYT); const bf16_t* SVB = WSH(O_SVB); const bf16_t* YVB = WSH(O_YVB); bf16_t* YY = WSH(O_YY);
    bf16_t* Sb = (bf16_t*)ldsf;
    bf16_t* Pm = Sb + 2 * 16 * 72;
    const int tid = threadIdx.x, wv = tid >> 6, lane = tid & 63, fr = lane & 15, fq = lane >> 4, nt0 = wv & 3;
#ifdef CPU_EMU
    const int isY = wv >> 2;
#else
    const int isY = __builtin_amdgcn_readfirstlane(wv >> 2);
#endif
    for (int u = blockIdx.x; u < 256; u += gridDim.x) {
        const int x = u & 7, jq = u >> 3, chain = x * 8 + (jq >> 2), qt = jq & 3, h = chain & 15, b = (chain >> 4) & 1, z = chain >> 5;
        const size_t ub = (size_t)chain * NRC;
        const int rr = tid >> 3, c8 = (tid & 7) * 8;
        constexpr int PD = NRC >= 8 ? 8 : 4;
        for (int i = tid; i < 2 * 16 * 72 / 2; i += NT) ((unsigned*)Sb)[i] = 0u;
        const int row = 16 * qt + fr, n0 = 16 * nt0 + 4 * fq; const bf16_t* addp = (isY ? YVB : SVB) + ub * 4096 + row * 64 + n0;
        const bf16_t* psp = PST + ub * 4096 + rr * 64 + c8; const bf16_t* pyp = PYT + ub * 4096 + rr * 64 + c8;
        u32x4 gps[PD], gpy[PD]; unsigned long long addr[PD];
#pragma unroll
        for (int j = 0; j < PD; ++j) { gps[j] = *(const u32x4*)(psp + (size_t)j * 4096); gpy[j] = *(const u32x4*)(pyp + (size_t)j * 4096); addr[j] = *(const unsigned long long*)(addp + (size_t)j * 4096); }
        *(u32x4*)(Pm + (0 * 2 + 0) * 4608 + rr * 72 + c8) = gps[0]; *(u32x4*)(Pm + (0 * 2 + 1) * 4608 + rr * 72 + c8) = gpy[0];
        { const int cl = PD < NRC ? PD : NRC - 1; gps[0] = *(const u32x4*)(psp + (size_t)cl * 4096); gpy[0] = *(const u32x4*)(pyp + (size_t)cl * 4096); }
        SYNCTHREADS();
#define RS_LOOP(ISY) \
        for (int ck0 = 0; ck0 < NRC; ck0 += PD) { \
            _Pragma("unroll") for (int j = 0; j < PD; ++j) { \
                const int ck = ck0 + j, cur = j & 1, nxt = cur ^ 1;        \
                f32x4 acc[1]; acc[0] = (f32x4){0.f, 0.f, 0.f, 0.f}; \
                wave_mma<2, 1>(acc, Sb + cur * 16 * 72, 72, Pm + (cur * 2 + ISY) * 4608 + nt0 * 16 * 72, 72); \
                { const unsigned lo_ = (unsigned)addr[j], hi_ = (unsigned)(addr[j] >> 32); acc[0][0] += bflo(lo_); acc[0][1] += bfhi(lo_); acc[0][2] += bflo(hi_); acc[0][3] += bfhi(hi_); } \
                { const int cl = ck + PD < NRC ? ck + PD : NRC - 1; addr[j] = *(const unsigned long long*)(addp + (size_t)cl * 4096); } \
                if (ISY) { \
                    _Pragma("unroll") for (int r = 0; r < 4; ++r) { const int step = ck * RCK + n0 + r, sidx = z ? S - 1 - step : step; YY[((size_t)z * T + (size_t)b * S + sidx) * W + h * 64 + row] = (bf16_t)f2bf(acc[0][r]); } \
                } else st_bf4(Sb + nxt * 16 * 72 + fr * 72 + n0, acc[0]); \
                const int jn = (j + 1) % PD; \
                *(u32x4*)(Pm + (nxt * 2 + 0) * 4608 + rr * 72 + c8) = gps[jn]; *(u32x4*)(Pm + (nxt * 2 + 1) * 4608 + rr * 72 + c8) = gpy[jn]; \
                { const int cl = ck + 1 + PD < NRC ? ck + 1 + PD : NRC - 1; gps[jn] = *(const u32x4*)(psp + (size_t)cl * 4096); gpy[jn] = *(const u32x4*)(pyp + (size_t)cl * 4096); } \
                LDS_BARRIER(); \
            } \
        }
        if (isY) { RS_LOOP(1) } else { RS_LOOP(0) }
#undef RS_LOOP
    }
}
__device__ __forceinline__ void ph_rw_out(const Ctx& c) {
    const bf16_t* FS = WSH(O_FS); const bf16_t* YY = WSH(O_YY); const float* BON = WSF(O_BON); const bf16_t* GG = WSH(O_GG); bf16_t* Y = WSH(O_YS);
    const int lane = threadIdx.x & 63, gw = blockIdx.x * (NT / 64) + (threadIdx.x >> 6), ngw = gridDim.x * (NT / 64);
    for (int i = gw; i < T * 4; i += ngw) {
        const int h0 = (i & 3) * 4; const long t = i >> 2; float y0[4], y1[4], gv[4], vv[4], bs[4];
#pragma unroll
        for (int q = 0; q < 4; ++q) { const int ch = (h0 + q) * 64 + lane; y0[q] = bf2f(YY[(size_t)t * W + ch]); y1[q] = bf2f(YY[((size_t)T + t) * W + ch]); gv[q] = bf2f(GG[(size_t)t * W + ch]); vv[q] = bf2f(FS[(size_t)t * RF + 2048 + ch]);
            bs[q] = BON[(size_t)t * 16 + h0 + q] + BON[((size_t)T + t) * 16 + h0 + q]; }
#pragma unroll
        for (int q = 0; q < 4; ++q) { const int ch = (h0 + q) * 64 + lane;
            const float m0 = wave_sum(y0[q]) * (1.f / 64.f), m1 = wave_sum(y1[q]) * (1.f / 64.f); const float d0 = y0[q] - m0, d1 = y1[q] - m1;
            const float r0 = 1.f / sqrtf(wave_sum(d0 * d0) * (1.f / 64.f) + EPS), r1 = 1.f / sqrtf(wave_sum(d1 * d1) * (1.f / 64.f) + EPS);
            Y[(size_t)t * 4 * W + 3 * W + ch] = (bf16_t)f2bf((d0 * r0 + d1 * r1 + bs[q] * vv[q]) * gv[q]); }
    }
}
__device__ __forceinline__ void ph_router(const Ctx& c, int l, float* ldsf, const float* X, const float* gN, const float* shN, const float* scN) {
    const float* RS = WSF(O_HF); const bf16_t* WH = WSH(O_WRH); const bf16_t* WL = WSH(O_WRL); const float* bg = c.in[31] + (size_t)l * 4; const float* be = c.in[33] + (size_t)l * 32;
    int* EID = WSI(O_EID); float* EWT = WSF(O_EWT); int* cnt = CTLW(c) + CW_CNT + l * 64;
    const int tid = threadIdx.x, wv = tid >> 6, lane = tid & 63, fr = lane & 15, fq = lane >> 4, rt = wv & 1, kq = wv >> 1;
    float* part = ldsf;
    for (int u = blockIdx.x; u < T / 32; u += gridDim.x) {
        const long t0 = (long)u * 32; f32x4 acc[3];
#pragma unroll
        for (int nt = 0; nt < 3; ++nt) acc[nt] = (f32x4){0.f, 0.f, 0.f, 0.f};
#ifdef CPU_EMU
        for (int nt = 0; nt < 3; ++nt) for (int r = 0; r < 4; ++r) { const int n = 16 * nt + 4 * fq + r; float sacc = 0.f;
            for (int k = kq * 512; k < kq * 512 + 512; ++k) { const long tr = t0 + 16 * rt + fr; const int bb = (int)(tr / S); const float hv = X[(size_t)tr * D + k] * RS[tr] * gN[k] * (1.f + scN[bb * D6 + k]) + shN[bb * D6 + k]; const float hh = bf2f((bf16_t)f2bf(hv)), hl = bf2f((bf16_t)f2bf(hv - hh));
                const float wh = bf2f(WH[(size_t)n * D + k]), wl = bf2f(WL[(size_t)n * D + k]); sacc += hh * wh + hl * wh + hh * wl; }
            acc[nt][r] = sacc; }
#else
        const long tr = t0 + 16 * rt + fr; const int bb = (int)(tr / S); const float rsv = RS[tr]; const int kb = kq * 512 + fq * 8;
        const float* hp = X + (size_t)tr * D + kb; const float* gp_ = gN + kb; const float* scp = scN + bb * D6 + kb; const float* shp = shN + bb * D6 + kb;
#pragma unroll 4
        for (int ks = 0; ks < 16; ++ks) {
            const f32x4 h0 = *(const f32x4*)(hp + ks * 32) * rsv * *(const f32x4*)(gp_ + ks * 32) * (*(const f32x4*)(scp + ks * 32) + 1.f) + *(const f32x4*)(shp + ks * 32);
            const f32x4 h1 = *(const f32x4*)(hp + ks * 32 + 4) * rsv * *(const f32x4*)(gp_ + ks * 32 + 4) * (*(const f32x4*)(scp + ks * 32 + 4) + 1.f) + *(const f32x4*)(shp + ks * 32 + 4); bf16x8 ah, al;
#pragma unroll
            for (int e = 0; e < 4; ++e) { const unsigned b0 = f2bf(h0[e]), b1 = f2bf(h1[e]); ah[e] = (short)b0; ah[4 + e] = (short)b1; al[e] = (short)f2bf(h0[e] - u2f_(b0 << 16)); al[4 + e] = (short)f2bf(h1[e] - u2f_(b1 << 16)); }
#pragma unroll
            for (int nt = 0; nt < 3; ++nt) { const size_t wo = (size_t)(16 * nt + fr) * D + kq * 512 + ks * 32 + fq * 8; const bf16x8 bh = *(const bf16x8*)(WH + wo), bl = *(const bf16x8*)(WL + wo);
                acc[nt] = __builtin_amdgcn_mfma_f32_16x16x32_bf16(bh, ah, acc[nt], 0, 0, 0); acc[nt] = __builtin_amdgcn_mfma_f32_16x16x32_bf16(bh, al, acc[nt], 0, 0, 0); acc[nt] = __builtin_amdgcn_mfma_f32_16x16x32_bf16(bl, ah, acc[nt], 0, 0, 0); }
        }
#endif
#pragma unroll
        for (int nt = 0; nt < 3; ++nt) *(f32x4*)(part + (kq * 32 + 16 * rt + fr) * 48 + 16 * nt + 4 * fq) = acc[nt];
        SYNCTHREADS();
        if (tid < 32) { const long t = t0 + tid; float lg[36];
#pragma unroll
            for (int q = 0; q < 36; ++q) lg[q] = (part[(0 * 32 + tid) * 48 + q] + part[(1 * 32 + tid) * 48 + q]) + (part[(2 * 32 + tid) * 48 + q] + part[(3 * 32 + tid) * 48 + q]) + (q < 4 ? bg[q < 4 ? q : 0] : be[q >= 4 ? q - 4 : 0]);
            int gi = 0; float m = lg[0];
#pragma unroll
            for (int q = 1; q < 4; ++q) if (lg[q] > m) { m = lg[q]; gi = q; }
            float den = 0.f;
#pragma unroll
            for (int q = 0; q < 4; ++q) den += expf(lg[q] - m);
            const float gp = 1.f / den; float el[8];
#pragma unroll
            for (int q = 0; q < 8; ++q) el[q] = gi == 0 ? lg[4 + q] : gi == 1 ? lg[12 + q] : gi == 2 ? lg[20 + q] : lg[28 + q];
            int i1 = 0; float m1 = el[0];
#pragma unroll
            for (int q = 1; q < 8; ++q) if (el[q] > m1) { m1 = el[q]; i1 = q; }
            int i2 = -1; float m2 = 0.f;
#pragma unroll
            for (int q = 0; q < 8; ++q) if (q != i1 && (i2 < 0 || el[q] > m2)) { m2 = el[q]; i2 = q; }
            const float p2 = expf(m2 - m1);
            EID[t * 2] = gi * 8 + i1; EID[t * 2 + 1] = gi * 8 + i2; EWT[t * 2] = gp / (1.f + p2); EWT[t * 2 + 1] = gp * p2 / (1.f + p2);
            atomic_add_i(cnt + gi * 8 + i1, 1); atomic_add_i(cnt + gi * 8 + i2, 1);
        }
        SYNCTHREADS();
    }
}
__device__ __forceinline__ void ph_moe_assign(const Ctx& c, int l, float* ldsf) {
    const int* cnt = CTLW(c) + CW_CNT + l * 64; int* plan = CTLW(c) + CW_PLAN + l * 256; const int* EID = WSI(O_EID); int* fill = CTLW(c) + CW_FILL + l * 64; int* DEST = WSI(O_DEST);
    int* pstart = (int*)ldsf;
    if (threadIdx.x == 0) { int ps = 0, nb = 0; const bool pub = blockIdx.x == 0;
        for (int e = 0; e < NE; ++e) { pstart[e] = ps; if (pub) plan[e] = ps; const int nblk = (cnt[e] + 255) / 256; if (pub) for (int q = 0; q < nblk; ++q) plan[64 + nb + q] = e; nb += nblk; ps += nblk * 256; }
        if (pub) { plan[32] = ps; plan[40] = nb; } }
    SYNCTHREADS();
    for (long i = GT_; i < (long)T * 2; i += GS_) { const int e = EID[i]; const int pos = atomic_add_i(fill + e, 1); DEST[i] = pstart[e] + pos; }
    SYNCTHREADS();
}
__device__ __forceinline__ void ph_moe_gather(const Ctx& c) {
    const int* DEST = WSI(O_DEST); const u32x4* H = (const u32x4*)WSH(O_H); u32x4* XS = (u32x4*)WSH(O_XS);
    for (long i = GT_; i < (long)T * 2 * (D / 8); i += GS_) { const int q = (int)(i % (D / 8)); const long a = i / (D / 8); XS[(size_t)DEST[a] * (D / 8) + q] = H[(size_t)(a >> 1) * (D / 8) + q]; }
}
#ifndef CPU_EMU
#define XB_TMO      128
#define XB_XCNT(j)  (256  + 64 * (j))
#define XB_XSUB(j)  (1280 + 64 * (j))
#define XB_XGEN(j)  (2304 + 64 * (j))
#define XB_TOP      3328
#define XB_TOPGEN   3392
#define XCD_BAR_WORDS 3456
#define XB_SPIN_CAP (1u << 26)
#define LAS __attribute__((address_space(3)))
__device__ __forceinline__ unsigned xb_ld(unsigned* p)              { return __hip_atomic_load(p, __ATOMIC_RELAXED, __HIP_MEMORY_SCOPE_AGENT); }
__device__ __forceinline__ unsigned xb_add(unsigned* p, unsigned v) { return __hip_atomic_fetch_add(p, v, __ATOMIC_RELAXED, __HIP_MEMORY_SCOPE_AGENT); }
__device__ __forceinline__ unsigned xb_xcc_id() { return (unsigned)__builtin_amdgcn_s_getreg((3 << 11) | 20) & 0xFu; }
#define XB_SPIN(cond, bar) do { unsigned _sp = 0; while (cond) { __builtin_amdgcn_s_sleep(1); \
    if ((++_sp & 255u) == 0u) { if (xb_ld(&(bar)[XB_TMO])) break; if (_sp > XB_SPIN_CAP) { atomicAdd(&(bar)[XB_TMO], 1u); break; } } } } while (0)
struct XcdBarrier { unsigned* bar; unsigned x; volatile LAS unsigned* st; };
__device__ __forceinline__ XcdBarrier xcd_barrier_post(unsigned* bar, volatile LAS unsigned* st) {
    XcdBarrier b; b.bar = bar; b.x = xb_xcc_id(); b.st = st;
    if (threadIdx.x == 0) (void)xb_add(&bar[XB_XCNT(b.x)], 1u);
    return b;
}
__device__ __forceinline__ void xcd_barrier_complete(unsigned* bar, unsigned x, unsigned& nloc, unsigned& nx) {
    const unsigned G = gridDim.x * gridDim.y * gridDim.z;
    unsigned sum, cnt, mine, sp = 0u;
    for (;;) {
        sum = 0u; cnt = 0u; mine = 0u;
#pragma unroll
        for (unsigned j = 0; j < 16; ++j) { const unsigned cc = xb_ld(&bar[XB_XCNT(j)]); sum += cc; cnt += (cc > 0u) ? 1u : 0u; mine = (j == x) ? cc : mine; }
        if (sum == G) break;
        __builtin_amdgcn_s_sleep(1);
        if ((++sp & 255u) == 0u) { if (xb_ld(&bar[XB_TMO])) break; if (sp > XB_SPIN_CAP) { atomicAdd(&bar[XB_TMO], 1u); break; } }
    }
    nloc = mine > 0u ? mine : 1u; nx = cnt > 0u ? cnt : 1u;
}
__device__ __forceinline__ void xcd_barrier(const XcdBarrier& b) {
    asm volatile("s_waitcnt vmcnt(0)" ::: "memory");
    __syncthreads();
    if (threadIdx.x == 0) {
        unsigned* bar = b.bar;
        __builtin_amdgcn_s_waitcnt(0);
        unsigned nloc = b.st[0], nx = b.st[1];
        if (nloc == 0u) { xcd_barrier_complete(bar, b.x, nloc, nx); b.st[0] = nloc; b.st[1] = nx; }
        const unsigned old = xb_add(&bar[XB_XSUB(b.x)], 1u);
        const unsigned gen = old / nloc;
        if (old + 1u == (gen + 1u) * nloc) {
            __builtin_amdgcn_fence(__ATOMIC_RELEASE, "agent");
            asm volatile("s_waitcnt vmcnt(0)" ::: "memory");
            const unsigned og = xb_add(&bar[XB_TOP], 1u);
            const unsigned tg = og / nx;
            if (og + 1u == (tg + 1u) * nx) xb_add(&bar[XB_TOPGEN], 1u);
            else XB_SPIN(xb_ld(&bar[XB_TOPGEN]) == tg, bar);
            __builtin_amdgcn_fence(__ATOMIC_ACQUIRE, "agent");
            xb_add(&bar[XB_XGEN(b.x)], 1u);
            asm volatile("s_waitcnt vmcnt(0)" ::: "memory");
        } else {
            XB_SPIN(xb_ld(&bar[XB_XGEN(b.x)]) == gen, bar);
            __builtin_amdgcn_fence(__ATOMIC_ACQUIRE, "agent");
            asm volatile("s_waitcnt vmcnt(0)" ::: "memory");
        }
    }
    __syncthreads();
}
#endif

constexpr int LDS_BYTES = 147456;

__global__ void __launch_bounds__(NT, 2) fwd(Params p) {
#ifdef CPU_EMU
    unsigned char* lds = g_lds; float* ldsf = (float*)g_lds;
#else
    extern __shared__ __attribute__((aligned(16))) unsigned char lds[];
    float* ldsf = (float*)lds;
    volatile LAS unsigned* misc = (volatile LAS unsigned*)((LAS unsigned char*)lds + LDS_BYTES - 64);
    if (threadIdx.x == 0) { misc[0] = 0u; misc[1] = 0u; }
    __syncthreads();
    XcdBarrier bar = xcd_barrier_post((unsigned*)(p.ws + O_CTL) + CW_BAR, misc);
#endif
    Ctx c; c.in = p.in; c.out = p.out; c.ws = p.ws;
    const int lo = p.ph_lo, hi = p.ph_hi; int ph = 0;
    const int G = (int)gridDim.x, cwg = (int)blockIdx.x;
#ifdef CPU_EMU
#define GRID_BAR()
#else
#define GRID_BAR() xcd_barrier(bar)
#endif
#ifndef REPEAT_MASK
#define REPEAT_MASK 0
#endif
#ifndef TIME_PHASE
#define TIME_PHASE -1
#endif
#if TIME_PHASE >= 0 && !defined(CPU_EMU)
    unsigned long long tp0 = 0, tp1 = 0;
#define TP_BEGIN() do { if (ph == TIME_PHASE) tp0 = __builtin_amdgcn_s_memrealtime(); } while (0)
#define TP_END() do { if (ph == TIME_PHASE) tp1 = __builtin_amdgcn_s_memrealtime(); } while (0)
#else
#define TP_BEGIN()
#define TP_END()
#endif
#define PHASE(...) do { if (lo <= ph && ph < hi) { TP_BEGIN(); __VA_ARGS__; if (ph + 1 < hi) { GRID_BAR(); } TP_END(); } ++ph; } while (0)
#define PHASEG(grp, ...) do { if (lo <= ph && ph < hi) { TP_BEGIN(); if ((REPEAT_MASK >> (grp)) & 1) { __VA_ARGS__; GRID_BAR(); } __VA_ARGS__; if (ph + 1 < hi) { GRID_BAR(); } TP_END(); } ++ph; } while (0)
    PHASE(ph_mod(c, ldsf); ph_rope_table(c); ph_convert(c, 0, ldsf));
#define LAYER_BODY(l) do { const float* mod = WSF(O_MOD); \
        const float* xin = l == 0 ? c.in[0] : WSF(O_X1); float* xmid = WSF(O_X0); float* xout = WSF(O_X1); \
        const float* ml = mod + (size_t)l * NB * D6; \
        PHASEG(0, { pg8::Gemm g{D, D, D}; pg8::StaticOrder so; so.init(T, PW, G, cwg, WSH(O_H), WSH(O_WIN), D, D); pg8::EpiP E{WSH(O_P), (unsigned char*)(c.ws + O_G8)}; pg8::gemm_phase(lds, g, so, E); \
            { const int nun_ = (T / 256) * (PW / 256), rem_ = nun_ % G; if (rem_ != 0 && cwg >= rem_) { SYNCTHREADS(); convert_big(c, l, ldsf, J_ALL - convert_tail_tiles(), J_ALL, cwg - rem_, G - rem_); } } }); \
        PHASE(ph_lru<1>(c, l, ldsf); ph_ret_kv(c, ldsf); ph_sgu_norm(c, l); ph_rw_shift(c, l)); \
        PHASE(ph_lru_scan2(c); ph_ret_state(c); ph_sgu_mix(c, l, ldsf); ph_rw_lora(c, l, ldsf)); \
        PHASE(ph_lru_fin(c, ldsf); ph_ret_out(c, ldsf); ph_rw_chunk(c, l, ldsf)); \
        PHASE(ph_rw_seq(c, ldsf)); \
        PHASE(ph_rw_out(c)); \
        PHASEG(1, { pg8::Gemm g{4 * W, 4 * W, 4 * W}; pg8::StaticOrder so; so.init(T, D, G, cwg, WSH(O_YS), WSH(O_WBR), 4 * W, 4 * W); pg8::EpiMerge E{(const unsigned char*)(c.ws + O_G8), WSH(O_MRG)}; pg8::gemm_phase(lds, g, so, E); }); \
        PHASEG(1, { pg8::Gemm g{D, D, D}; pg8::StaticOrder so; so.init(T, D, G, cwg, WSH(O_MRG), WSH(O_WOUT), D, D); pg8::EpiResid E{xin, ml + 2 * D, xmid}; pg8::gemm_phase(lds, g, so, E); }); \
        PHASEG(6, ph_norm(c, xmid, c.in[4] + (size_t)l * D, ml + 3 * D, ml + 4 * D, WSH(O_H), WSF(O_HF))); \
        PHASE(ph_router(c, l, ldsf, xmid, c.in[4] + (size_t)l * D, ml + 3 * D, ml + 4 * D)); \
        PHASE(ph_moe_assign(c, l, ldsf)); \
        PHASEG(6, ph_moe_gather(c)); \
        const int* plan = CTLW(c) + CW_PLAN + l * 256; \
        PHASEG(2, { pg8::Gemm g{D, D, D}; pg8::MoeOrder mo{G, cwg, 4, plan, (const char*)WSH(O_XS), (const char*)WSH(O_WGU), (size_t)256 * D * 2, (size_t)256 * D * 2, (size_t)1024 * D * 2}; pg8::EpiGU E{WSH(O_ACT)}; pg8::gemm_phase(lds, g, mo, E); \
            if (l == 0) { const int nrest_ = plan[40] * 4 - G; if (nrest_ >= 0 && nrest_ < G && cwg >= nrest_) { SYNCTHREADS(); convert_big(c, 1, ldsf, 0, convert_early_tiles(c), cwg - nrest_, G - nrest_); } } }); \
        PHASEG(2, { pg8::Gemm g{512, 512, 512}; pg8::MoeOrder mo{G, cwg, 8, plan, (const char*)WSH(O_ACT), (const char*)WSH(O_WDN), (size_t)256 * 512 * 2, (size_t)256 * 512 * 2, (size_t)D * 512 * 2}; pg8::EpiBf16 E{WSH(O_YE), D}; pg8::gemm_phase(lds, g, mo, E); }); \
        if (l == 0) PHASE(ph_comb_norm<0>(c, xmid, ml + 5 * D, xout, c.in[3] + (size_t)1 * D, mod + (size_t)1 * NB * D6 + 0 * D, mod + (size_t)1 * NB * D6 + 1 * D, WSH(O_H), nullptr); ph_convert(c, 1, ldsf)); \
        else PHASE(ph_comb_norm<1>(c, xmid, ml + 5 * D, xout, c.in[36], nullptr, nullptr, nullptr, c.out)); \
    } while (0)
    PHASE(ph_norm(c, c.in[0], c.in[3], WSF(O_MOD) + 0 * D, WSF(O_MOD) + 1 * D, WSH(O_H), nullptr));
    LAYER_BODY(0);
    LAYER_BODY(1);
#undef LAYER_BODY
#if TIME_PHASE >= 0 && !defined(CPU_EMU)
    if (blockIdx.x == 0) { const unsigned long long te = __builtin_amdgcn_s_memrealtime(), dl = 8ull * (tp1 - tp0); while (__builtin_amdgcn_s_memrealtime() - te < dl) __builtin_amdgcn_s_sleep(8); }
#endif
#undef PHASE
}
}

#ifndef CPU_EMU
extern "C" void kernel_launch(void* const* d_in, const int* in_sizes, int n_in, void* d_out, int out_size, void* d_ws, size_t ws_size, hipStream_t stream) {
    static int grid = 0;
    if (grid == 0) {
        if (n_in != 37 || out_size != T * D || ws_size < WS_END) { fprintf(stderr, "kernel_launch: unexpected shapes (n_in %d out %d ws %zu need %zu)\n", n_in, out_size, ws_size, (size_t)WS_END); grid = -1; return; }
        int dev = 0, cus = 0, per_cu = 0;
        if (hipGetDevice(&dev) != hipSuccess || hipDeviceGetAttribute(&cus, hipDeviceAttributeMultiprocessorCount, dev) != hipSuccess) { grid = -1; return; }
        if (hipFuncSetAttribute((const void*)fwd, hipFuncAttributeMaxDynamicSharedMemorySize, LDS_BYTES) != hipSuccess) { fprintf(stderr, "kernel_launch: hipFuncSetAttribute failed\n"); grid = -1; return; }
        if (hipOccupancyMaxActiveBlocksPerMultiprocessor(&per_cu, (const void*)fwd, NT, LDS_BYTES) != hipSuccess || per_cu < 1) fprintf(stderr, "kernel_launch: occupancy query says %d\n", per_cu);
        (void)hipGetLastError();
        grid = cus;
    }
    if (grid < 0) return;
    (void)in_sizes;
    (void)hipMemsetAsync((char*)d_ws + O_CTL, 0, CTL_BYTES, stream);
    Params p{};
    for (int i = 0; i < 37; ++i) p.in[i] = (const float*)d_in[i];
    p.out = (float*)d_out; p.ws = (unsigned char*)d_ws;
#if ONE_LAUNCH
    p.ph_lo = 0; p.ph_hi = NPH;
    hipLaunchKernelGGL(fwd, dim3(grid), dim3(NT), LDS_BYTES, stream, p);
#else
    for (int k = 0; k < NPH; ++k) { p.ph_lo = k; p.ph_hi = k + 1; hipLaunchKernelGGL(fwd, dim3(grid), dim3(NT), LDS_BYTES, stream, p); }
#endif
}
#endif
```

```cpp
#ifndef CPU_EMU
#include <hip/hip_runtime.h>
#endif
#include <cstdio>
#include <cstdint>
#include <cmath>
#include <cstring>

#ifndef SEQ
#define SEQ 4096
#endif
#ifndef ONE_LAUNCH
#define ONE_LAUNCH 1
#endif

namespace {
constexpr int D = 2048, NB = 2, S = SEQ, T = NB * S, NL = 2, W = 1024;
constexpr int INW = 18816, RF = 3456, D6 = 6 * D;
constexpr int C_LX = 0, C_LG = 1024, C_RQ = 2048, C_RK = 2560, C_RV = 3072, C_RG = 4096, C_SU = 5120, C_SV = 6144, C_RW = 7168;
constexpr int PW = 18944, C_MLP = 10752;
constexpr int NCH = S / 128;
constexpr int NLC = S / 64;
constexpr int NE = 32, CAP = (T * 2 / 256 + NE) * 256, MAXBLK = CAP / 256;
constexpr float EPS = 1e-6f;
constexpr float DECAY_SCALE = 0.60653065971263342f;
constexpr int NT = 512;
constexpr int NPH_LAYER = 15, NPH = 2 + NL * NPH_LAYER;
typedef unsigned short bf16_t;
#ifdef CPU_EMU
typedef float f32x4 __attribute__((vector_size(16)));
typedef unsigned u32x4 __attribute__((vector_size(16)));
#else
typedef float f32x4 __attribute__((ext_vector_type(4)));
typedef unsigned u32x4 __attribute__((ext_vector_type(4)));
typedef short bf16x8 __attribute__((ext_vector_type(8)));
#endif

constexpr size_t al256(size_t x) { return (x + 255) & ~(size_t)255; }
constexpr size_t SZ_X = (size_t)T * D * 4, SZ_W = (size_t)T * W * 4;
constexpr size_t O_CTL = 0, CTL_BYTES = 1u << 20;
constexpr size_t O_MOD = CTL_BYTES;
constexpr size_t O_X0 = O_MOD + al256((size_t)NL * NB * D6 * 4);
constexpr size_t O_X1 = O_X0 + SZ_X;
constexpr size_t O_H = O_X1 + SZ_X;
constexpr size_t O_HF = O_H + SZ_X / 2;
constexpr size_t O_P = O_HF + SZ_X;
constexpr size_t SZ_P = (size_t)T * PW * 2;
constexpr size_t O_XC = O_P + SZ_P;
constexpr size_t O_LA = O_XC + SZ_W, O_LU = O_LA + 2 * SZ_W;
constexpr size_t SZ_LC = (size_t)2 * NB * NLC * W * 4;
constexpr size_t O_LCA = O_LU + 2 * SZ_W, O_LCH = O_LCA + SZ_LC, O_LCI = O_LCH + SZ_LC;
constexpr size_t O_YS = O_LCI + SZ_LC;
constexpr size_t O_SC = O_YS + (size_t)T * 4 * W * 2;
constexpr size_t SZ_KV = (size_t)NB * NCH * 8 * 64 * 128 * 4;
constexpr size_t O_KVF = O_SC, O_KVB = O_KVF + SZ_KV, O_STF = O_KVB + SZ_KV, O_STB = O_STF + SZ_KV;
constexpr size_t O_VN = O_STB + SZ_KV;
constexpr size_t O_FS = O_VN + SZ_W;
constexpr size_t O_DEC = O_FS + al256((size_t)T * RF * 4), O_AA = O_DEC + 2 * SZ_W, O_AKK = O_AA + 2 * SZ_W;
constexpr size_t O_GG = O_AKK, O_YY = O_GG + SZ_W;
constexpr int RCK = 64, NRC = S / RCK;
constexpr size_t O_BON = O_YY + 2 * SZ_W;
constexpr size_t O_PART = O_BON + al256((size_t)2 * T * 16 * 4);
constexpr size_t O_MRG = O_PART + SZ_X;
constexpr size_t O_LOG = O_MRG + SZ_X / 2;
constexpr size_t O_EID = O_LOG + al256((size_t)T * 40 * 4), O_EWT = O_EID + al256((size_t)T * 2 * 4), O_DEST = O_EWT + al256((size_t)T * 2 * 4);
constexpr size_t O_SLOT = O_DEST + al256((size_t)T * 2 * 4);
constexpr size_t O_PST = O_SLOT + al256((size_t)CAP * 4), O_PYT = O_PST + (size_t)64 * NRC * 4096 * 2, O_SVB = O_PYT + (size_t)64 * NRC * 4096 * 2, O_YVB = O_SVB + (size_t)64 * NRC * 4096 * 4;
constexpr size_t O_WIN = O_YVB + (size_t)64 * NRC * 4096 * 4;
constexpr size_t O_WBR = O_WIN + (size_t)PW * D * 2;
constexpr size_t O_WOUT = O_WBR + (size_t)D * 4 * W * 2;
constexpr size_t O_WGU = O_WOUT + (size_t)D * D * 2;
constexpr size_t O_WDN = O_WGU + (size_t)NE * 1024 * D * 2;
constexpr size_t O_G8 = O_WDN + (size_t)NE * D * 512 * 2;
constexpr size_t O_ROPE = O_G8 + (size_t)T * 4 * D;
constexpr size_t O_WLR = O_ROPE + (size_t)T * 64 * 4;
constexpr size_t O_WUT = O_WLR + (size_t)32 * 128 * 128 * 2;
constexpr size_t O_WAT = O_WUT + (size_t)2 * W * 64 * 2;
constexpr size_t O_WGT = O_WAT + (size_t)2 * W * 64 * 2;
constexpr size_t O_WRH = O_WGT + (size_t)W * 128 * 2;
constexpr size_t O_WRL = O_WRH + (size_t)48 * D * 2;
constexpr size_t WS_END0 = O_WRL + (size_t)48 * D * 2;
constexpr size_t SZ_MOE = (size_t)CAP * (D + 512 + D) * 2;
constexpr bool MOE_OVERLAY = SZ_MOE <= SZ_P;
constexpr size_t O_XS = MOE_OVERLAY ? O_P : WS_END0;
constexpr size_t O_ACT = O_XS + (size_t)CAP * D * 2;
constexpr size_t O_YE = O_ACT + (size_t)CAP * 512 * 2;
constexpr size_t WS_END = MOE_OVERLAY ? WS_END0 : WS_END0 + SZ_MOE;
static_assert(SEQ != 4096 || WS_END <= (size_t)2040 * 1024 * 1024, "workspace budget: d_ws is 4 x the largest input = 2048 MiB");
constexpr int CW_BAR = 4096;
constexpr int CW_CNT = 32768;
constexpr int CW_FILL = CW_CNT + NL * 64;
constexpr int CW_PLAN = CW_FILL + NL * 64;
static_assert(MAXBLK <= 160, "plan words");

struct Params { const float* in[37]; float* out; unsigned char* ws; int ph_lo, ph_hi; };

struct Ctx { const float* const* in; float* out; unsigned char* ws; };
#define GT_ ((long)blockIdx.x * NT + threadIdx.x)
#define GS_ ((long)gridDim.x * NT)
#define WSF(off) ((float*)(c.ws + (off)))
#define WSI(off) ((int*)(c.ws + (off)))
#define WSH(off) ((bf16_t*)(c.ws + (off)))
#define CTLW(c) ((int*)((c).ws + O_CTL))

#ifdef CPU_EMU
__device__ __forceinline__ float fexp_(float x) { return expf(x); }
__device__ __forceinline__ float frcp_(float x) { return 1.f / x; }
__device__ __forceinline__ float frsq_(float x) { return 1.f / sqrtf(x); }
#else
__device__ __forceinline__ float fexp_(float x) { return __builtin_amdgcn_exp2f(x * 1.4426950408889634f); }
__device__ __forceinline__ float frcp_(float x) { return __builtin_amdgcn_rcpf(x); }
__device__ __forceinline__ float frsq_(float x) { return __builtin_amdgcn_rsqf(x); }
#endif
__device__ __forceinline__ float sigmoidf_(float x) { return frcp_(1.f + fexp_(-x)); }
__device__ __forceinline__ float siluf_(float x) { return x * frcp_(1.f + fexp_(-x)); }
__device__ __forceinline__ float tanhf_(float x) { return 1.f - 2.f * frcp_(1.f + fexp_(2.f * x)); }
__device__ __forceinline__ float geluf_(float x) { return 0.5f * x * (1.f + tanhf_(0.7978845608028654f * (x + 0.044715f * x * x * x))); }
__device__ __forceinline__ float softplusf_(float x) { return x > 0.f ? x + log1pf(expf(-x)) : log1pf(expf(x)); }
__device__ __forceinline__ float loggamma_(int h) { return log1pf(-exp2f(-5.f - (float)h)); }
__device__ __forceinline__ unsigned f2u_(float f) { unsigned u; memcpy(&u, &f, 4); return u; }
__device__ __forceinline__ float u2f_(unsigned u) { float f; memcpy(&f, &u, 4); return f; }
__device__ __forceinline__ float bf2f(bf16_t v) { return u2f_((unsigned)v << 16); }
#ifdef CPU_EMU
__device__ __forceinline__ unsigned f2bf(float f) { const unsigned u = f2u_(f); return (u + 0x7fffu + ((u >> 16) & 1u)) >> 16; }
__device__ __forceinline__ unsigned pk2(float lo, float hi) { return f2bf(lo) | (f2bf(hi) << 16); }
#else
typedef __attribute__((ext_vector_type(2))) __bf16 hwbf2_t; typedef __attribute__((ext_vector_type(2))) float hwf2_t;
__device__ __forceinline__ unsigned f2bf(float f) { const __bf16 s = (__bf16)f; return (unsigned)__builtin_bit_cast(unsigned short, s); }
__device__ __forceinline__ unsigned pk2(float lo, float hi) { const hwf2_t v = {lo, hi}; return __builtin_bit_cast(unsigned, __builtin_convertvector(v, hwbf2_t)); }
#endif
__device__ __forceinline__ float bflo(unsigned w) { return u2f_(w << 16); }
__device__ __forceinline__ float bfhi(unsigned w) { return u2f_(w & 0xffff0000u); }
__device__ __forceinline__ int atomic_add_i(int* p, int v) {
#ifdef CPU_EMU
    return __atomic_fetch_add(p, v, __ATOMIC_RELAXED);
#else
    return atomicAdd(p, v);
#endif
}
#define PF(P, r, col) bf2f((P)[(size_t)(r) * PW + (col)])
#ifdef CPU_EMU
#define SYNCTHREADS() emu_syncthreads()
#define SHFL_XOR(v, m) emu_shfl_xor(v, m)
#else
#define SYNCTHREADS() __syncthreads()
#define SHFL_XOR(v, m) __shfl_xor(v, m)
#endif
#ifdef CPU_EMU
__device__ __forceinline__ float wave_sum(float v) {
    for (int o = 1; o < 64; o <<= 1) v += SHFL_XOR(v, o);
    return v;
}
#else
__device__ __forceinline__ float wave_sum(float x) {
    x += __builtin_bit_cast(float, __builtin_amdgcn_update_dpp(0, __builtin_bit_cast(int, x), 0xB1, 0xF, 0xF, true));
    x += __builtin_bit_cast(float, __builtin_amdgcn_update_dpp(0, __builtin_bit_cast(int, x), 0x4E, 0xF, 0xF, true));
    x += __builtin_bit_cast(float, __builtin_amdgcn_update_dpp(0, __builtin_bit_cast(int, x), 0x141, 0xF, 0xF, true));
    x += __builtin_bit_cast(float, __builtin_amdgcn_update_dpp(0, __builtin_bit_cast(int, x), 0x140, 0xF, 0xF, true));
    const int xi = __builtin_bit_cast(int, x);
    return (__builtin_bit_cast(float, __builtin_amdgcn_readlane(xi, 0)) + __builtin_bit_cast(float, __builtin_amdgcn_readlane(xi, 16))) + (__builtin_bit_cast(float, __builtin_amdgcn_readlane(xi, 32)) + __builtin_bit_cast(float, __builtin_amdgcn_readlane(xi, 48)));
}
#endif
__device__ __forceinline__ f32x4 ld_bf4(const bf16_t* p) { const unsigned long long q = *(const unsigned long long*)p; const unsigned lo = (unsigned)q, hi = (unsigned)(q >> 32); return (f32x4){bflo(lo), bfhi(lo), bflo(hi), bfhi(hi)}; }
__device__ __forceinline__ void st_bf4(bf16_t* p, const f32x4 v) { *(unsigned long long*)p = (unsigned long long)pk2(v[0], v[1]) | ((unsigned long long)pk2(v[2], v[3]) << 32); }

template <int KT, int NTL>
__device__ __forceinline__ void wave_mma(f32x4 (&acc)[NTL], const bf16_t* A, int lda, const bf16_t* Bt, int ldb) {
    const int lane = threadIdx.x & 63, fr = lane & 15, fq = lane >> 4;
#ifdef CPU_EMU
    for (int nt = 0; nt < NTL; ++nt) for (int r = 0; r < 4; ++r) { float sacc = 0.f; const bf16_t* a = A + fr * lda; const bf16_t* b = Bt + (16 * nt + 4 * fq + r) * ldb;
        for (int k = 0; k < 32 * KT; ++k) sacc += bf2f(a[k]) * bf2f(b[k]);
        acc[nt][r] += sacc; }
#else
#pragma unroll
    for (int kt = 0; kt < KT; ++kt) {
        const bf16x8 af = *(const bf16x8*)(A + fr * lda + kt * 32 + fq * 8);
#pragma unroll
        for (int nt = 0; nt < NTL; ++nt) { const bf16x8 bfr = *(const bf16x8*)(Bt + (16 * nt + fr) * ldb + kt * 32 + fq * 8);
            acc[nt] = __builtin_amdgcn_mfma_f32_16x16x32_bf16(bfr, af, acc[nt], 0, 0, 0); }
    }
#endif
}
__device__ __forceinline__ void ph_mod(const Ctx& c, float* ldsf) {
    const float* cc = c.in[1]; const float* aw = c.in[5]; const float* ab = c.in[6]; float* mod = WSF(O_MOD);
    float* scs = ldsf; float* part = ldsf + NB * D; const int tid = threadIdx.x, c4 = (tid & 31) * 4, kq = tid >> 5;
    for (int i = tid; i < NB * D; i += NT) scs[i] = siluf_(cc[i]);
    SYNCTHREADS();
    for (int u = blockIdx.x; u < NL * (D6 / 128); u += gridDim.x) {
        const int l = u / (D6 / 128), j0 = (u % (D6 / 128)) * 128;
        const float* w = aw + (size_t)l * D * D6 + j0 + c4; f32x4 a0 = (f32x4){0.f, 0.f, 0.f, 0.f}, a1 = a0;
#pragma unroll 8
        for (int k = kq * 128; k < kq * 128 + 128; ++k) { const f32x4 wv = *(const f32x4*)(w + (size_t)k * D6); a0 += wv * scs[k]; a1 += wv * scs[D + k]; }
        *(f32x4*)(part + (kq * 2 + 0) * 128 + c4) = a0; *(f32x4*)(part + (kq * 2 + 1) * 128 + c4) = a1;
        SYNCTHREADS();
        if (tid < 256) { const int b = tid >> 7, col = tid & 127; float sacc = 0.f;
#pragma unroll
            for (int q = 0; q < 16; ++q) sacc += part[(q * 2 + b) * 128 + col];
            mod[((size_t)l * NB + b) * D6 + j0 + col] = sacc + ab[l * D6 + j0 + col]; }
        SYNCTHREADS();
    }
}
__device__ __forceinline__ void ph_norm(const Ctx& c, const float* x, const float* g, const float* sh, const float* sc, bf16_t* hb, float* hf) {
    const int lane = threadIdx.x & 63, gw = blockIdx.x * (NT / 64) + (threadIdx.x >> 6), ngw = gridDim.x * (NT / 64);
    for (int t0 = gw * 2; t0 < T; t0 += ngw * 2) {
        f32x4 v[2][8]; float ss[2] = {0.f, 0.f};
#pragma unroll
        for (int r = 0; r < 2; ++r)
#pragma unroll
            for (int j = 0; j < 8; ++j) v[r][j] = *(const f32x4*)(x + (size_t)(t0 + r) * D + (j * 64 + lane) * 4);
#pragma unroll
        for (int r = 0; r < 2; ++r) {
#pragma unroll
            for (int j = 0; j < 8; ++j) ss[r] += (v[r][j][0] * v[r][j][0] + v[r][j][1] * v[r][j][1]) + (v[r][j][2] * v[r][j][2] + v[r][j][3] * v[r][j][3]);
            const int t = t0 + r, b = t / S; const float rs = 1.f / sqrtf(wave_sum(ss[r]) * (1.f / D) + EPS);
#pragma unroll
            for (int j = 0; j < 8; ++j) { const int col = (j * 64 + lane) * 4;
                const f32x4 o = v[r][j] * rs * *(const f32x4*)(g + col) * (*(const f32x4*)(sc + b * D6 + col) + 1.f) + *(const f32x4*)(sh + b * D6 + col);
                st_bf4(hb + (size_t)t * D + col, o); }
            if (hf && lane == 0) hf[t] = rs;
        }
    }
}
template <int MODE>
__device__ __forceinline__ void ph_comb_norm(const Ctx& c, const float* xmid, const float* g2, float* xout, const float* g, const float* sh, const float* sc, bf16_t* hb, float* outp) {
    const bf16_t* YE = WSH(O_YE); const float* EWT = WSF(O_EWT); const int* DEST = WSI(O_DEST);
    const int lane = threadIdx.x & 63, gw = blockIdx.x * (NT / 64) + (threadIdx.x >> 6), ngw = gridDim.x * (NT / 64);
    for (int t = gw; t < T; t += ngw) {
        const int b = t / S; const float w0 = EWT[t * 2], w1 = EWT[t * 2 + 1]; const bf16_t* y0 = YE + (size_t)DEST[t * 2] * D; const bf16_t* y1 = YE + (size_t)DEST[t * 2 + 1] * D;
        f32x4 v[8]; float ss = 0.f;
#pragma unroll
        for (int j = 0; j < 8; ++j) { const int col = (j * 64 + lane) * 4;
            v[j] = *(const f32x4*)(xmid + (size_t)t * D + col) + *(const f32x4*)(g2 + b * D6 + col) * (ld_bf4(y0 + col) * w0 + ld_bf4(y1 + col) * w1);
            if (MODE == 0) *(f32x4*)(xout + (size_t)t * D + col) = v[j];
            ss += (v[j][0] * v[j][0] + v[j][1] * v[j][1]) + (v[j][2] * v[j][2] + v[j][3] * v[j][3]); }
        const float rs = 1.f / sqrtf(wave_sum(ss) * (1.f / D) + EPS);
#pragma unroll
        for (int j = 0; j < 8; ++j) { const int col = (j * 64 + lane) * 4;
            if (MODE == 0) st_bf4(hb + (size_t)t * D + col, v[j] * rs * *(const f32x4*)(g + col) * (*(const f32x4*)(sc + b * D6 + col) + 1.f) + *(const f32x4*)(sh + b * D6 + col));
            else *(f32x4*)(outp + (size_t)t * D + col) = v[j] * rs * *(const f32x4*)(g + col); }
    }
}

struct CvtItem { const float* Wp; int ldw; bf16_t* WT; int ldt; int drow, k0, n0; };
constexpr int I_IN = 32 * (INW / 32), I_BR = 4 * 16 * 64, I_OUT = 32 * 64, I_GU = NE * 32 * 32, I_DN = NE * 8 * 64, I_LR = 32 * 8, I_WU = 2 * 32, I_WG = 64, I_BIG = I_IN + I_BR + I_OUT + I_GU + I_DN, I_ALL = I_BIG + I_LR + 2 * I_WU + I_WG;
__device__ __forceinline__ CvtItem cvt_decode(const Ctx& c, int l, int it) {
    CvtItem r;
    if (it < I_IN) { const int kb = it / (INW / 32), nb = it % (INW / 32); r.n0 = nb * 32; r.k0 = kb * 64; r.Wp = c.in[7] + (size_t)l * D * INW; r.ldw = INW; r.WT = WSH(O_WIN); r.ldt = D; r.drow = r.n0 < 10624 ? r.n0 : r.n0 + 128; return r; }
    it -= I_IN;
    if (it < I_BR) { const int sgm = it / 1024, q = it % 1024, kb = q / 64, nb = q % 64; r.n0 = nb * 32; r.k0 = kb * 64; r.Wp = c.in[28] + ((size_t)l * 4 + sgm) * W * D; r.ldw = D; r.WT = WSH(O_WBR) + sgm * W; r.ldt = 4 * W; r.drow = r.n0; return r; }
    it -= I_BR;
    if (it < I_OUT) { const int kb = it / 64, nb = it % 64; r.n0 = nb * 32; r.k0 = kb * 64; r.Wp = c.in[29] + (size_t)l * D * D; r.ldw = D; r.WT = WSH(O_WOUT); r.ldt = D; r.drow = r.n0; return r; }
    it -= I_OUT;
    if (it < I_GU) { const int e = it / 1024, q = it % 1024, kb = q / 32, nb = q % 32; r.n0 = nb * 32; r.k0 = kb * 64; r.Wp = c.in[34] + ((size_t)l * NE + e) * D * 1024; r.ldw = 1024; r.WT = WSH(O_WGU) + (size_t)e * 1024 * D; r.ldt = D;
        r.drow = r.n0 < 512 ? (r.n0 / 128) * 256 + (r.n0 % 128) : ((r.n0 - 512) / 128) * 256 + 128 + ((r.n0 - 512) % 128); return r; }
    it -= I_GU;
    if (it < I_DN) { const int e = it / 512, q = it % 512, kb = q / 64, nb = q % 64; r.n0 = nb * 32; r.k0 = kb * 64; r.Wp = c.in[35] + ((size_t)l * NE + e) * 512 * D; r.ldw = D; r.WT = WSH(O_WDN) + (size_t)e * D * 512; r.ldt = 512; r.drow = r.n0; return r; }
    it -= I_DN;
    if (it < I_LR) { const int m = it / 8, q = it % 8, kb = q / 4, nb = q % 4, z = m >> 4, ty = (m >> 3) & 1, n = m & 7; r.n0 = nb * 32; r.k0 = kb * 64; r.Wp = c.in[ty ? 12 : 10] + (((size_t)l * 2 + z) * 8 + n) * 128 * 128; r.ldw = 128;
        r.WT = WSH(O_WLR) + (size_t)m * 128 * 128; r.ldt = 128; r.drow = r.n0; return r; }
    it -= I_LR;
    if (it < 2 * I_WU) { const int ua = it / I_WU, q = it % I_WU, z = q / 32, nb = q % 32; r.n0 = nb * 32; r.k0 = 0; r.Wp = c.in[ua ? 23 : 21] + ((size_t)l * 2 + z) * 64 * W; r.ldw = W; r.WT = WSH(ua ? O_WAT : O_WUT) + (size_t)z * W * 64; r.ldt = 64; r.drow = r.n0; return r; }
    it -= 2 * I_WU;
    { const int kb = it / 32, nb = it % 32; r.n0 = nb * 32; r.k0 = kb * 64; r.Wp = c.in[24] + (size_t)l * 128 * W; r.ldw = W; r.WT = WSH(O_WGT); r.ldt = 128; r.drow = r.n0; return r; }
}
constexpr int J_IN = 16 * (INW / 128), J_BR = 4 * 8 * 16, J_OUT = 16 * 16, J_GU = NE * 16 * 8, J_DN = NE * 4 * 16, J_ALL = J_IN + J_BR + J_OUT + J_GU + J_DN;
__device__ __forceinline__ CvtItem cvt_decode_big(const Ctx& c, int l, int it) {
    CvtItem r;
    if (it < J_IN) { const int kb = it / (INW / 128), nb = it % (INW / 128); r.n0 = nb * 128; r.k0 = kb * 128; r.Wp = c.in[7] + (size_t)l * D * INW; r.ldw = INW; r.WT = WSH(O_WIN); r.ldt = D; r.drow = r.n0 < 10624 ? r.n0 : r.n0 + 128; return r; }
    it -= J_IN;
    if (it < J_BR) { const int sgm = it / 128, q = it % 128, kb = q / 16, nb = q % 16; r.n0 = nb * 128; r.k0 = kb * 128; r.Wp = c.in[28] + ((size_t)l * 4 + sgm) * W * D; r.ldw = D; r.WT = WSH(O_WBR) + sgm * W; r.ldt = 4 * W; r.drow = r.n0; return r; }
    it -= J_BR;
    if (it < J_OUT) { const int kb = it / 16, nb = it % 16; r.n0 = nb * 128; r.k0 = kb * 128; r.Wp = c.in[29] + (size_t)l * D * D; r.ldw = D; r.WT = WSH(O_WOUT); r.ldt = D; r.drow = r.n0; return r; }
    it -= J_OUT;
    if (it < J_GU) { const int e = it / 128, q = it % 128, kb = q / 8, nb = q % 8; r.n0 = nb * 128; r.k0 = kb * 128; r.Wp = c.in[34] + ((size_t)l * NE + e) * D * 1024; r.ldw = 1024; r.WT = WSH(O_WGU) + (size_t)e * 1024 * D; r.ldt = D;
        r.drow = r.n0 < 512 ? (r.n0 / 128) * 256 : ((r.n0 - 512) / 128) * 256 + 128; return r; }
    it -= J_GU;
    { const int e = it / 64, q = it % 64, kb = q / 16, nb = q % 16; r.n0 = nb * 128; r.k0 = kb * 128; r.Wp = c.in[35] + ((size_t)l * NE + e) * 512 * D; r.ldw = D; r.WT = WSH(O_WDN) + (size_t)e * D * 512; r.ldt = 512; r.drow = r.n0; return r; }
}
__device__ __forceinline__ void convert_big(const Ctx& c, int l, float* ldsf, int first, int last, int widx, int wcnt) {
    const int tid = threadIdx.x, lr = tid >> 5, lc = (tid & 31) * 4;
    f32x4 rg[8]; int it = first + widx; CvtItem r;
    if (it < last) { r = cvt_decode_big(c, l, it);
#pragma unroll
        for (int i = 0; i < 8; ++i) rg[i] = *(const f32x4*)(r.Wp + (size_t)(r.k0 + lr + 16 * i) * r.ldw + r.n0 + lc); }
    for (; it < last; it += wcnt) {
#pragma unroll
        for (int i = 0; i < 8; ++i) { float* dp = ldsf + (lr + 16 * i) * 129 + lc; dp[0] = rg[i][0]; dp[1] = rg[i][1]; dp[2] = rg[i][2]; dp[3] = rg[i][3]; }
        const CvtItem cur = r; const int nx = it + wcnt;
        if (nx < last) { r = cvt_decode_big(c, l, nx);
#pragma unroll
            for (int i = 0; i < 8; ++i) rg[i] = *(const f32x4*)(r.Wp + (size_t)(r.k0 + lr + 16 * i) * r.ldw + r.n0 + lc); }
        SYNCTHREADS();
#pragma unroll
        for (int q = 0; q < 4; ++q) { const int id = tid + NT * q, n = id >> 4, k8 = (id & 15) * 8; const float* sp = ldsf + k8 * 129 + n;
            u32x4 o; o[0] = pk2(sp[0 * 129], sp[1 * 129]); o[1] = pk2(sp[2 * 129], sp[3 * 129]); o[2] = pk2(sp[4 * 129], sp[5 * 129]); o[3] = pk2(sp[6 * 129], sp[7 * 129]);
            *(u32x4*)(cur.WT + (size_t)(cur.drow + n) * cur.ldt + cur.k0 + k8) = o; }
        SYNCTHREADS();
    }
}
__device__ __forceinline__ int convert_tail_tiles() { const int nun = (T / 256) * (PW / 256), G = (int)gridDim.x, rem = nun % G; return rem == 0 ? 0 : (G - rem) * 10 < J_GU + J_DN ? (G - rem) * 10 : J_GU + J_DN; }
__device__ __forceinline__ int convert_early_tiles(const Ctx& c) { const int G = (int)gridDim.x, nrest = (CTLW(c) + CW_PLAN)[40] * 4 - G; return (nrest >= 0 && nrest < G) ? ((G - nrest) * 12 < J_IN ? (G - nrest) * 12 : J_IN) : 0; }
__device__ __forceinline__ void ph_convert(const Ctx& c, int l, float* ldsf) {
    const int lane = threadIdx.x & 63, wave = threadIdx.x >> 6; const int gw = blockIdx.x * (NT / 64) + wave, ngw = gridDim.x * (NT / 64);
    convert_big(c, l, ldsf, l == 1 ? convert_early_tiles(c) : 0, J_ALL - convert_tail_tiles(), (int)blockIdx.x, (int)gridDim.x);
#ifdef CPU_EMU
    if (lane == 0) for (int it = I_BIG + gw; it < I_ALL; it += ngw) { const CvtItem r = cvt_decode(c, l, it);
        for (int kk = 0; kk < 64; ++kk) for (int nn = 0; nn < 32; ++nn) r.WT[(size_t)(r.drow + nn) * r.ldt + r.k0 + kk] = (bf16_t)f2bf(r.Wp[(size_t)(r.k0 + kk) * r.ldw + r.n0 + nn]); }
#else
    float* scr = ldsf + wave * (64 * 33 + 16);
    for (int it = I_BIG + gw; it < I_ALL; it += ngw) {
        const CvtItem r = cvt_decode(c, l, it);
#pragma unroll 8
        for (int i = 0; i < 32; ++i) { const int kk = 2 * i + (lane >> 5); scr[kk * 33 + (lane & 31)] = r.Wp[(size_t)(r.k0 + kk) * r.ldw + r.n0 + (lane & 31)]; }
        asm volatile("s_waitcnt lgkmcnt(0)" ::: "memory");
        const int cc = lane & 7;
#pragma unroll
        for (int j = 0; j < 4; ++j) { const int n = (lane >> 3) + 8 * j; const float* sp = scr + (8 * cc) * 33 + n;
            u32x4 o; o[0] = pk2(sp[0 * 33], sp[1 * 33]); o[1] = pk2(sp[2 * 33], sp[3 * 33]); o[2] = pk2(sp[4 * 33], sp[5 * 33]); o[3] = pk2(sp[6 * 33], sp[7 * 33]);
            *(u32x4*)(r.WT + (size_t)(r.drow + n) * r.ldt + r.k0 + 8 * cc) = o; }
        asm volatile("s_waitcnt lgkmcnt(0)" ::: "memory");
    }
#endif
    { const float* wg = c.in[30] + (size_t)l * D * 4; const float* we = c.in[32] + (size_t)l * D * 32; bf16_t* wh = WSH(O_WRH); bf16_t* wl = WSH(O_WRL);
      for (long i = GT_; i < (long)48 * D; i += GS_) { const int n = (int)(i / D), k = (int)(i % D); const float w = n < 4 ? wg[k * 4 + n] : n < 36 ? we[k * 32 + (n - 4)] : 0.f; const unsigned hb = f2bf(w); wh[i] = (bf16_t)hb; wl[i] = (bf16_t)f2bf(w - bf2f((bf16_t)hb)); } }
    for (long i = GT_; i < (long)128 * D / 2; i += GS_) ((unsigned*)(WSH(O_WIN) + (size_t)10624 * D))[i] = 0u;
}

namespace pg8 {
constexpr int BM = 256, BK = 64, HALF = 128, HTB = HALF * BK * 2, STAGE_BYTES = 8 * HTB;
__host__ __device__ __forceinline__ int lds_byte(int r, int cc) { const int st = (r >> 4) * 2 + (cc >> 5), rr = r & 15, c2 = cc & 31, ob = rr * 64 + c2 * 2; return st * 1024 + (ob ^ (((ob >> 9) & 1) << 5)); }
__host__ __device__ __forceinline__ void stage_rc(int b, int& R, int& C) { const int st = b / 1024, sb = b % 1024, swz = sb ^ (((sb >> 9) & 1) << 5); R = (st >> 1) * 16 + swz / 64; C = (st & 1) * 32 + (swz % 64) / 2; }
__host__ __device__ __forceinline__ int perm32(int rho) { const int n = rho >> 4, i = rho & 15; return 8 * (i >> 2) + 4 * n + (i & 3); }
struct Unit { int pm, pn, aux; const char* A; const char* B; };
struct Gemm { int K, lda, ldb; };

template <class Epi, class Sched>
__device__ __forceinline__ void gemm_phase(unsigned char* lds_, const Gemm g, const Sched& S, const Epi& E) {
#ifdef CPU_EMU
    if (threadIdx.x != 0) return;
    Unit u; const int K = g.K;
    float* Af = (float*)malloc((size_t)256 * K * 4); float* Bf = (float*)malloc((size_t)256 * K * 4); float* Cf = (float*)malloc(256 * 256 * 4);
    for (int i = 0; S.next(i, u); ++i) {
        const bf16_t* A = (const bf16_t*)u.A; const bf16_t* B = (const bf16_t*)u.B;
        for (int r = 0; r < 256; ++r) for (int k = 0; k < K; ++k) { Af[(size_t)r * K + k] = bf2f(A[(size_t)r * g.lda + k]); Bf[(size_t)r * K + k] = bf2f(B[(size_t)r * g.ldb + k]); }
        const int nseg = Epi::SEGT > 0 ? K / (Epi::SEGT * 64) : 1, kseg = K / nseg;
        for (int wid = 0; wid < 8; ++wid) for (int lane = 0; lane < 64; ++lane) {
            const int wr = wid >> 2, wc = wid & 3, fr = lane & 15, fq = lane >> 4; f32x4 acc[2][2][4][2];
            for (int ai = 0; ai < 2; ++ai) for (int bj = 0; bj < 2; ++bj) for (int m = 0; m < 4; ++m) for (int n = 0; n < 2; ++n) for (int j = 0; j < 4; ++j) acc[ai][bj][m][n][j] = 0.f;
            for (int sg = 0; sg < nseg; ++sg) {
                for (int ai = 0; ai < 2; ++ai) for (int bj = 0; bj < 2; ++bj) for (int m = 0; m < 4; ++m) for (int n = 0; n < 2; ++n) for (int j = 0; j < 4; ++j) {
                    const int r = 128 * ai + 64 * wr + 16 * m + fr, cc = 128 * bj + 32 * wc + (Epi::PERM ? 8 * fq + 4 * n + j : 16 * n + 4 * fq + j);
                    const float* a = Af + (size_t)r * K + sg * kseg; const float* b = Bf + (size_t)cc * K + sg * kseg; float sacc = 0.f; for (int k = 0; k < kseg; ++k) sacc += a[k] * b[k];
                    acc[ai][bj][m][n][j] += sacc; }
                if constexpr (Epi::SEGT > 0) { if (sg + 1 < nseg) E.segment(acc, u, sg, wr, wc, fr, fq); }
            }
            E(acc, u, wr, wc, fr, fq);
        }
    }
    free(Af); free(Bf); free(Cf);
#else
    typedef __attribute__((address_space(3))) unsigned char* ldsp_t;
    ldsp_t lds = (ldsp_t)lds_;
    const int tid = threadIdx.x, wid = __builtin_amdgcn_readfirstlane(tid >> 6), lane = tid & 63, wr = wid >> 2, wc = wid & 3, fr = lane & 15, fq = lane >> 4;
    const int K = g.K, nt = K / BK;
    unsigned voffA[2], voffB[2];
#pragma unroll
    for (int i = 0; i < 2; ++i) { int R, C; stage_rc(tid * 16 + i * 8192, R, C); const int Rb = Epi::PERM ? ((R & ~31) + perm32(R & 31)) : R;
        voffA[i] = (unsigned)(R * g.lda + C) * 2u; voffB[i] = (unsigned)(Rb * g.ldb + C) * 2u; }
    const size_t kstep = (size_t)(BK * 2);
    const size_t hstepA = (size_t)HALF * g.lda * 2, hstepB = (size_t)HALF * g.ldb * 2;
    const unsigned ldsw = (unsigned)wid * 1024u;
    const int aoff = lds_byte(wr * 64 + fr, fq * 8), boff = lds_byte(wc * 32 + fr, fq * 8);
#define PG8_SA(b, h) (((b) * 2 + (h)) * HTB)
#define PG8_SB(b, h) ((4 + (b) * 2 + (h)) * HTB)
#define PG8_STAGE(bufoff, gbase, voff) do { _Pragma("unroll") for (int _i = 0; _i < 2; ++_i) \
        __builtin_amdgcn_global_load_lds((const unsigned*)((const char*)(gbase) + (voff)[_i]), (__attribute__((address_space(3))) unsigned*)(lds + (bufoff) + ldsw + _i * 8192), 16, 0, 0); } while (0)
#define PG8_LDA(dst, b, h) do { _Pragma("unroll") for (int m = 0; m < 4; ++m) _Pragma("unroll") for (int k = 0; k < 2; ++k) dst[m][k] = *(const __attribute__((address_space(3))) bf16x8*)(lds + PG8_SA(b, h) + aoff + m * 2048 + k * 1024); } while (0)
#define PG8_LDB(dst, b, h) do { _Pragma("unroll") for (int n = 0; n < 2; ++n) _Pragma("unroll") for (int k = 0; k < 2; ++k) dst[n][k] = *(const __attribute__((address_space(3))) bf16x8*)(lds + PG8_SB(b, h) + boff + n * 2048 + k * 1024); } while (0)
#define PG8_MMA(ai, bj, At, Bt) do { __builtin_amdgcn_s_setprio(1); _Pragma("unroll") for (int m = 0; m < 4; ++m) _Pragma("unroll") for (int n = 0; n < 2; ++n) _Pragma("unroll") for (int k = 0; k < 2; ++k) \
        acc[ai][bj][m][n] = __builtin_amdgcn_mfma_f32_16x16x32_bf16(Bt[n][k], At[m][k], acc[ai][bj][m][n], 0, 0, 0); __builtin_amdgcn_s_setprio(0); } while (0)
#define PG8_WAIT_V(n) asm volatile("s_waitcnt vmcnt(" #n ")" ::: "memory")
#define PG8_WAIT_L(n) asm volatile("s_waitcnt lgkmcnt(" #n ")" ::: "memory")
#define PG8_BAR __builtin_amdgcn_s_barrier()
#define PG8_SCHED __builtin_amdgcn_sched_barrier(0)
    Unit cur, nxt; int ui = 0;
    if (!S.next(0, cur)) return;
    f32x4 acc[2][2][4][2];
#pragma unroll
    for (int a = 0; a < 2; ++a)
#pragma unroll
        for (int b = 0; b < 2; ++b)
#pragma unroll
            for (int m = 0; m < 4; ++m)
#pragma unroll
                for (int n = 0; n < 2; ++n) acc[a][b][m][n] = (f32x4){0.f, 0.f, 0.f, 0.f};
    bf16x8 At[4][2], B0[2][2], B1[2][2];
    const char* cA = cur.A; const char* cB = cur.B;
    S.a_ready(cur);
    PG8_STAGE(PG8_SB(0, 0), cB, voffB); PG8_STAGE(PG8_SA(0, 0), cA, voffA); PG8_STAGE(PG8_SB(0, 1), cB + hstepB, voffB); PG8_STAGE(PG8_SA(0, 1), cA + hstepA, voffA);
    if (wr == 1) PG8_BAR;
    PG8_WAIT_V(4); PG8_BAR;
    PG8_STAGE(PG8_SB(1, 0), cB + kstep, voffB); PG8_STAGE(PG8_SA(1, 0), cA + kstep, voffA); PG8_STAGE(PG8_SB(1, 1), cB + hstepB + kstep, voffB);
    PG8_WAIT_V(6); PG8_BAR;
    for (;;) {
        const bool has_next = S.next(ui + 1, nxt);
        const char* nA = has_next ? nxt.A : cA; const char* nB = has_next ? nxt.B : cB;
        for (int t = 0; t < nt; t += 2) {
            const bool last = (t == nt - 2);
            const char* a1 = cA + (size_t)(t + 1) * kstep;
            const char* a2 = last ? nA : cA + (size_t)(t + 2) * kstep; const char* b2 = last ? nB : cB + (size_t)(t + 2) * kstep;
            const char* a3 = a2 + kstep; const char* b3 = b2 + kstep;
            if (last && has_next) S.a_ready(nxt);
            PG8_LDB(B0, 0, 0); PG8_SCHED; PG8_LDA(At, 0, 0); PG8_STAGE(PG8_SA(1, 1), a1 + hstepA, voffA);
            PG8_WAIT_L(8); PG8_BAR; PG8_WAIT_L(0); PG8_MMA(0, 0, At, B0); PG8_BAR; PG8_SCHED;
            PG8_LDB(B1, 0, 1); PG8_STAGE(PG8_SB(0, 0), b2, voffB);
            PG8_BAR; PG8_WAIT_L(0); PG8_MMA(0, 1, At, B1); PG8_BAR;
            PG8_LDA(At, 0, 1); PG8_STAGE(PG8_SA(0, 0), a2, voffA);
            PG8_BAR; PG8_WAIT_L(0); PG8_MMA(1, 0, At, B0); PG8_BAR; PG8_SCHED;
            PG8_STAGE(PG8_SB(0, 1), b2 + hstepB, voffB);
            PG8_WAIT_V(6); PG8_BAR; PG8_MMA(1, 1, At, B1); PG8_BAR;
            PG8_LDB(B0, 1, 0); PG8_SCHED; PG8_LDA(At, 1, 0); PG8_STAGE(PG8_SA(0, 1), a2 + hstepA, voffA);
            PG8_WAIT_L(8); PG8_BAR; PG8_WAIT_L(0); PG8_MMA(0, 0, At, B0); PG8_BAR; PG8_SCHED;
            PG8_LDB(B1, 1, 1); PG8_STAGE(PG8_SB(1, 0), b3, voffB);
            PG8_BAR; PG8_WAIT_L(0); PG8_MMA(0, 1, At, B1); PG8_BAR;
            PG8_LDA(At, 1, 1); PG8_STAGE(PG8_SA(1, 0), a3, voffA);
            PG8_BAR; PG8_WAIT_L(0); PG8_MMA(1, 0, At, B0); PG8_BAR; PG8_SCHED;
            PG8_STAGE(PG8_SB(1, 1), b3 + hstepB, voffB);
            PG8_WAIT_V(6); PG8_BAR; PG8_MMA(1, 1, At, B1); PG8_BAR;
            if constexpr (Epi::SEGT > 0) { if ((t + 2) % Epi::SEGT == 0 && t + 2 < nt) E.segment(acc, cur, (t + 2) / Epi::SEGT - 1, wr, wc, fr, fq); }
        }
        E(acc, cur, wr, wc, fr, fq); S.done(cur);
        if (!has_next) break;
#pragma unroll
        for (int a = 0; a < 2; ++a)
#pragma unroll
            for (int b = 0; b < 2; ++b)
#pragma unroll
                for (int m = 0; m < 4; ++m)
#pragma unroll
                    for (int n = 0; n < 2; ++n) acc[a][b][m][n] = (f32x4){0.f, 0.f, 0.f, 0.f};
        cur = nxt; cA = nA; cB = nB; ++ui;
    }
    PG8_WAIT_V(0);
    if (wr == 0) PG8_BAR;
    PG8_BAR;
#undef PG8_SA
#undef PG8_SB
#undef PG8_STAGE
#undef PG8_LDA
#undef PG8_LDB
#undef PG8_MMA
#undef PG8_WAIT_V
#undef PG8_WAIT_L
#undef PG8_BAR
#undef PG8_SCHED
#endif
}

struct StaticOrder {
    int nM, nN, nwg, G, c; const char* A; const char* B; size_t tstepA, tstepB;
    __device__ __forceinline__ void init(int M, int N, int G_, int c_, const void* A_, const void* B_, int lda, int ldb) { nM = M / BM; nN = N / BM; nwg = nM * nN; G = G_; c = c_; A = (const char*)A_; B = (const char*)B_; tstepA = (size_t)BM * lda * 2; tstepB = (size_t)BM * ldb * 2; }
    __device__ __forceinline__ bool next(int i, Unit& u) const {
        const long L = (long)i * G + c; if (L >= nwg) return false;
        int wgid = (int)L; { const int q = nwg / 8, r = nwg % 8, xcd = wgid % 8, off = wgid / 8; wgid = (xcd < r ? xcd * (q + 1) : r * (q + 1) + (xcd - r) * q) + off; }
        const int nig = 8 * nN, gid = wgid / nig, fm = gid * 8, gsz = (nM - fm) < 8 ? (nM - fm) : 8;
        u.pm = fm + ((wgid % nig) % gsz); u.pn = (wgid % nig) / gsz; u.aux = 0; u.A = A + (size_t)u.pm * tstepA; u.B = B + (size_t)u.pn * tstepB; return true;
    }
    __device__ __forceinline__ void a_ready(const Unit&) const {}
    __device__ __forceinline__ void done(const Unit&) const {}
};
struct MergeOrder {
    StaticOrder so; int kseg_bytes;
    __device__ __forceinline__ bool next(int i, Unit& u) const { if (!so.next(i >> 2, u)) return false; u.aux = i & 3; u.A += (size_t)u.aux * kseg_bytes; u.B += (size_t)u.aux * kseg_bytes; return true; }
    __device__ __forceinline__ void a_ready(const Unit&) const {}
    __device__ __forceinline__ void done(const Unit&) const {}
};
struct MoeOrder {
    int G, c, ncol; const int* plan; const char* A; const char* B; size_t tstepA, tstepB, estep;
    __device__ __forceinline__ bool next(int i, Unit& u) const {
        const long L = (long)i * G + c; const int nblk = plan[40]; if (L >= (long)nblk * ncol) return false;
        u.pm = (int)(L / ncol); u.pn = (int)(L % ncol); u.aux = plan[64 + u.pm]; u.A = A + (size_t)u.pm * tstepA; u.B = B + (size_t)u.aux * estep + (size_t)u.pn * tstepB; return true;
    }
    __device__ __forceinline__ void a_ready(const Unit&) const {}
    __device__ __forceinline__ void done(const Unit&) const {}
};

__device__ __forceinline__ u32x4 pack8(const f32x4 v0, const f32x4 v1) { u32x4 w; w[0] = pk2(v0[0], v0[1]); w[1] = pk2(v0[2], v0[3]); w[2] = pk2(v1[0], v1[1]); w[3] = pk2(v1[2], v1[3]); return w; }
struct EpiBf16 {
    static constexpr int SEGT = 0; static constexpr bool PERM = true; bf16_t* O; int ldc;
    __device__ __forceinline__ void operator()(const f32x4 (&acc)[2][2][4][2], const Unit& u, int wr, int wc, int fr, int fq) const {
        const int row0 = u.pm * BM + wr * 64 + fr, col0 = u.pn * BM + wc * 32 + 8 * fq;
#pragma unroll
        for (int ai = 0; ai < 2; ++ai)
#pragma unroll
            for (int m = 0; m < 4; ++m) { bf16_t* rowp = O + (size_t)(row0 + ai * HALF + m * 16) * ldc + col0;
#pragma unroll
                for (int bj = 0; bj < 2; ++bj) *(u32x4*)(rowp + bj * HALF) = pack8(acc[ai][bj][m][0], acc[ai][bj][m][1]); }
    }
};
struct EpiP {
    static constexpr int SEGT = 0; static constexpr bool PERM = true; bf16_t* O; unsigned char* G8;
    __device__ __forceinline__ void operator()(const f32x4 (&acc)[2][2][4][2], const Unit& u, int wr, int wc, int fr, int fq) const {
        const int row0 = u.pm * BM + wr * 64 + fr, col0 = u.pn * BM + wc * 32 + 8 * fq;
        if (u.pn * BM < C_MLP) {
#pragma unroll
            for (int ai = 0; ai < 2; ++ai)
#pragma unroll
                for (int m = 0; m < 4; ++m) { bf16_t* rowp = O + (size_t)(row0 + ai * HALF + m * 16) * PW + col0;
#pragma unroll
                    for (int bj = 0; bj < 2; ++bj) *(u32x4*)(rowp + bj * HALF) = pack8(acc[ai][bj][m][0], acc[ai][bj][m][1]); }
        } else {
#pragma unroll
            for (int ai = 0; ai < 2; ++ai)
#pragma unroll
                for (int m = 0; m < 4; ++m) { unsigned char* rowp = G8 + (size_t)(row0 + ai * HALF + m * 16) * (4 * D) + (col0 - C_MLP);
#pragma unroll
                    for (int bj = 0; bj < 2; ++bj) { unsigned long long w = 0ull;
#pragma unroll
                        for (int q = 0; q < 8; ++q) { const float gq = sigmoidf_(acc[ai][bj][m][q >> 2][q & 3]); w |= (unsigned long long)(unsigned)(gq * 255.f + 0.5f) << (8 * q); }
                        *(unsigned long long*)(rowp + bj * HALF) = w; } }
        }
    }
};
struct EpiMerge {
    static constexpr int SEGT = 16; static constexpr bool PERM = true; const unsigned char* G8; bf16_t* MRG;
    static __device__ __forceinline__ float gq(unsigned long long w, int q) { const unsigned b = (unsigned)(w >> (8 * q)) & 255u; return (b ? (float)b : 0.5f) * (1.f / 255.f); }
    __device__ __forceinline__ void segment(f32x4 (&acc)[2][2][4][2], const Unit& u, int seg, int wr, int wc, int fr, int fq) const {
        const int row0 = u.pm * BM + wr * 64 + fr, col0 = u.pn * BM + wc * 32 + 8 * fq;
#pragma unroll
        for (int ai = 0; ai < 2; ++ai)
#pragma unroll
            for (int m = 0; m < 4; ++m) { const size_t r = (size_t)(row0 + ai * HALF + m * 16);
#pragma unroll
                for (int bj = 0; bj < 2; ++bj) { const int cc = col0 + bj * HALF;
                    const unsigned long long g0 = *(const unsigned long long*)(G8 + r * (4 * D) + seg * D + cc), g1 = *(const unsigned long long*)(G8 + r * (4 * D) + (seg + 1) * D + cc);
#pragma unroll
                    for (int q = 0; q < 4; ++q) { acc[ai][bj][m][0][q] *= gq(g0, q) * frcp_(gq(g1, q)); acc[ai][bj][m][1][q] *= gq(g0, 4 + q) * frcp_(gq(g1, 4 + q)); } }
#ifndef CPU_EMU
                asm volatile("" ::: "memory");
#endif
            }
    }
    __device__ __forceinline__ void operator()(const f32x4 (&acc)[2][2][4][2], const Unit& u, int wr, int wc, int fr, int fq) const {
        const int row0 = u.pm * BM + wr * 64 + fr, col0 = u.pn * BM + wc * 32 + 8 * fq;
#pragma unroll
        for (int ai = 0; ai < 2; ++ai)
#pragma unroll
            for (int m = 0; m < 4; ++m) { const size_t r = (size_t)(row0 + ai * HALF + m * 16);
#pragma unroll
                for (int bj = 0; bj < 2; ++bj) { const int cc = col0 + bj * HALF;
                    const unsigned long long g3 = *(const unsigned long long*)(G8 + r * (4 * D) + 3 * D + cc); f32x4 v0, v1;
#pragma unroll
                    for (int q = 0; q < 4; ++q) { v0[q] = gq(g3, q) * acc[ai][bj][m][0][q]; v1[q] = gq(g3, 4 + q) * acc[ai][bj][m][1][q]; }
                    *(u32x4*)(MRG + r * D + cc) = pack8(v0, v1); }
#ifndef CPU_EMU
                asm volatile("" ::: "memory");
#endif
            }
    }
};
struct EpiResid {
    static constexpr int SEGT = 0; static constexpr bool PERM = false; const float* xin; const float* g1; float* xmid;
    __device__ __forceinline__ void operator()(const f32x4 (&acc)[2][2][4][2], const Unit& u, int wr, int wc, int fr, int fq) const {
        const int row0 = u.pm * BM + wr * 64 + fr, col0 = u.pn * BM + wc * 32 + 4 * fq;
#pragma unroll
        for (int ai = 0; ai < 2; ++ai)
#pragma unroll
            for (int m = 0; m < 4; ++m) { const int r = row0 + ai * HALF + m * 16; const float* gp = g1 + (size_t)(r / S) * D6;
#pragma unroll
                for (int bj = 0; bj < 2; ++bj)
#pragma unroll
                    for (int n = 0; n < 2; ++n) { const int cc = col0 + bj * HALF + n * 16; *(f32x4*)(xmid + (size_t)r * D + cc) = *(const f32x4*)(xin + (size_t)r * D + cc) + *(const f32x4*)(gp + cc) * acc[ai][bj][m][n]; }
#ifndef CPU_EMU
                asm volatile("" ::: "memory");
#endif
            }
    }
};
struct EpiGU {
    static constexpr int SEGT = 0; static constexpr bool PERM = true; bf16_t* ACT;
    __device__ __forceinline__ void operator()(const f32x4 (&acc)[2][2][4][2], const Unit& u, int wr, int wc, int fr, int fq) const {
        const int row0 = u.pm * BM + wr * 64 + fr, col0 = u.pn * HALF + wc * 32 + 8 * fq;
#pragma unroll
        for (int ai = 0; ai < 2; ++ai)
#pragma unroll
            for (int m = 0; m < 4; ++m) { f32x4 v0, v1;
#pragma unroll
                for (int j = 0; j < 4; ++j) { v0[j] = siluf_(acc[ai][0][m][0][j]) * acc[ai][1][m][0][j]; v1[j] = siluf_(acc[ai][0][m][1][j]) * acc[ai][1][m][1][j]; }
                *(u32x4*)(ACT + (size_t)(row0 + ai * HALF + m * 16) * 512 + col0) = pack8(v0, v1); }
    }
};
}

template <int PASS>
__device__ __forceinline__ void ph_lru(const Ctx& c, int l, float* ldsf) {
    const bf16_t* P = WSH(O_P); const float* cw = c.in[8] + (size_t)l * 4 * W; const float* cb = c.in[9] + (size_t)l * W;
    const float* br = c.in[11] + (size_t)l * 2 * W; const float* bi = c.in[13] + (size_t)l * 2 * W; const float* lam = c.in[14] + (size_t)l * 2 * W; const bf16_t* WLR = WSH(O_WLR);
    float* CA = WSF(O_LCA); float* CH = WSF(O_LCH); const float* CI = WSF(O_LCI); bf16_t* Y = WSH(O_YS); unsigned* LAU = (unsigned*)(c.ws + O_LA);
    bf16_t* Xs = (bf16_t*)ldsf; bf16_t* Wr = Xs + 64 * 136; bf16_t* Wi = Wr + 128 * 136; float* AUa = (float*)Wr; float* AUu = AUa + 64 * 128; float* HF = (float*)(Wi + 128 * 136); float* spl = HF + 64 * 128;
    const int tid = threadIdx.x, wv = tid >> 6, lane = tid & 63, fr = lane & 15, fq = lane >> 4, rt = wv & 3, hf = wv >> 2;
    for (int u = blockIdx.x; u < (T / 64) * 8; u += gridDim.x) {
        const int n = u & 7, tile = u >> 3, b = tile / NLC, chk = tile % NLC; const long t0 = (long)tile * 64;
        if (tid < 256) spl[tid] = softplusf_(-lam[(tid >> 7) * W + n * 128 + (tid & 127)]);
#pragma unroll
        for (int q = 0; q < 4; ++q) { const int id = tid + NT * q, tl = id >> 5, e4 = (id & 31) * 4, ch = n * 128 + e4; const long t = t0 + tl; const int sI = (int)(t % S);
            f32x4 acc = *(const f32x4*)(cb + ch);
#pragma unroll
            for (int k = 0; k < 4; ++k) { const int ss = sI + k - 2; if (ss >= 0 && ss < S) acc += ld_bf4(P + (size_t)(t + k - 2) * PW + C_LX + ch) * *(const f32x4*)(cw + k * W + ch); }
            st_bf4(Xs + tl * 136 + e4, acc); }
        for (int z = 0; z < 2; ++z) {
#pragma unroll
            for (int q = 0; q < 4; ++q) { const int id = tid + NT * q, f = id >> 4, e8 = (id & 15) * 8;
                *(u32x4*)(Wr + f * 136 + e8) = *(const u32x4*)(WLR + ((size_t)((z * 2 + 0) * 8 + n) * 128 + f) * 128 + e8); *(u32x4*)(Wi + f * 136 + e8) = *(const u32x4*)(WLR + ((size_t)((z * 2 + 1) * 8 + n) * 128 + f) * 128 + e8); }
            SYNCTHREADS();
            f32x4 ar[4], ai[4];
#pragma unroll
            for (int nt = 0; nt < 4; ++nt) { ar[nt] = (f32x4){0.f, 0.f, 0.f, 0.f}; ai[nt] = (f32x4){0.f, 0.f, 0.f, 0.f}; }
            wave_mma<4, 4>(ar, Xs + rt * 16 * 136, 136, Wr + hf * 64 * 136, 136);
            wave_mma<4, 4>(ai, Xs + rt * 16 * 136, 136, Wi + hf * 64 * 136, 136);
            SYNCTHREADS();
            const int tl = rt * 16 + fr;
#pragma unroll
            for (int nt = 0; nt < 4; ++nt) { const int f = 64 * hf + 16 * nt + 4 * fq, ch = n * 128 + f;
                const f32x4 brv = *(const f32x4*)(br + z * W + ch), biv = *(const f32x4*)(bi + z * W + ch), lmv = *(const f32x4*)(spl + z * 128 + f), xcv = ld_bf4(Xs + tl * 136 + f); f32x4 av, uv, lav;
#pragma unroll
                for (int e = 0; e < 4; ++e) { const float r = sigmoidf_(ar[nt][e] + brv[e]), ig = sigmoidf_(ai[nt][e] + biv[e]), la = -8.f * r * lmv[e]; const float a = fexp_(la); av[e] = a; lav[e] = la; uv[e] = sqrtf(fmaxf(1.f - a * a, 0.f)) * ig * xcv[e]; }
                *(f32x4*)(AUa + tl * 128 + f) = av; *(f32x4*)(AUu + tl * 128 + f) = uv;
                if (PASS == 1) { u32x4 pk;
#pragma unroll
                    for (int e = 0; e < 4; ++e) pk[e] = pk2(lav[e], uv[e]);
                    *(u32x4*)(LAU + ((size_t)z * T + t0 + tl) * W + ch) = pk; } }
            SYNCTHREADS();
            if (tid < 128) { const int f = tid; const size_t ci = (((size_t)z * NB + b) * NLC + chk) * W + n * 128 + f;
                if (PASS == 1) { float prod = 1.f, h = 0.f;
#pragma unroll 8
                    for (int q = 0; q < 64; ++q) { const int sI = z == 0 ? q : 63 - q; const float a = AUa[sI * 128 + f]; h = a * h + AUu[sI * 128 + f]; prod *= a; }
                    CA[ci] = prod; CH[ci] = h;
                } else { float h = CI[ci];
                    if (z == 0) {
#pragma unroll 8
                        for (int q = 0; q < 64; ++q) { h = AUa[q * 128 + f] * h + AUu[q * 128 + f]; HF[q * 128 + f] = h; }
                    } else {
#pragma unroll 8
                        for (int q = 63; q >= 0; --q) { h = AUa[q * 128 + f] * h + AUu[q * 128 + f]; HF[q * 128 + f] += h; } } }
            }
            SYNCTHREADS();
        }
        if (PASS == 2) {
#pragma unroll
            for (int q = 0; q < 4; ++q) { const int id = tid + NT * q, tl = id >> 5, f4 = (id & 31) * 4; const long t = t0 + tl; f32x4 hv = *(const f32x4*)(HF + tl * 128 + f4); const f32x4 gv = ld_bf4(P + (size_t)t * PW + C_LG + n * 128 + f4);
#pragma unroll
                for (int e = 0; e < 4; ++e) hv[e] *= geluf_(gv[e]);
                st_bf4(Y + (size_t)t * 4 * W + 0 * W + n * 128 + f4, hv); }
            SYNCTHREADS();
        }
    }
}
__device__ __forceinline__ void ph_lru_fin(const Ctx& c, float* ldsf) {
    const bf16_t* P = WSH(O_P); const unsigned* LAU = (const unsigned*)(c.ws + O_LA); const float* CI = WSF(O_LCI); bf16_t* Y = WSH(O_YS);
    unsigned* Lz = (unsigned*)ldsf; float* Hz = ldsf + 2 * 64 * 128; const int tid = threadIdx.x;
    for (int u = blockIdx.x; u < (T / 64) * 8; u += gridDim.x) {
        const int n = u & 7, tile = u >> 3, b = tile / NLC, chk = tile % NLC; const long t0 = (long)tile * 64;
#pragma unroll
        for (int q = 0; q < 8; ++q) { const int id = tid + NT * q, z = id >> 11, r = (id >> 5) & 63, c4 = (id & 31) * 4; *(u32x4*)(Lz + z * 8192 + r * 128 + c4) = *(const u32x4*)(LAU + ((size_t)z * T + t0 + r) * W + n * 128 + c4); }
        SYNCTHREADS();
        if (tid < 256) { const int z = tid >> 7, f = tid & 127; float h = CI[(((size_t)z * NB + b) * NLC + chk) * W + n * 128 + f]; const unsigned* lp = Lz + z * 8192 + f; float* hp = Hz + z * 8192 + f;
#pragma unroll 8
            for (int q = 0; q < 64; ++q) { const int sI = z == 0 ? q : 63 - q; const unsigned w = lp[sI * 128]; h = fexp_(bflo(w)) * h + bfhi(w); hp[sI * 128] = h; } }
        SYNCTHREADS();
#pragma unroll
        for (int q = 0; q < 4; ++q) { const int id = tid + NT * q, r = id >> 5, f4 = (id & 31) * 4; const long t = t0 + r; f32x4 o = *(const f32x4*)(Hz + r * 128 + f4) + *(const f32x4*)(Hz + 8192 + r * 128 + f4); const f32x4 gv = ld_bf4(P + (size_t)t * PW + C_LG + n * 128 + f4);
#pragma unroll
            for (int e = 0; e < 4; ++e) o[e] *= geluf_(gv[e]);
            st_bf4(Y + (size_t)t * 4 * W + 0 * W + n * 128 + f4, o); }
        SYNCTHREADS();
    }
}
__device__ __forceinline__ void ph_lru_scan2(const Ctx& c) {
    const float* CA = WSF(O_LCA); const float* CH = WSF(O_LCH); float* CI = WSF(O_LCI);
    for (long i = GT_; i < (long)2 * NB * W; i += GS_) {
        const int w = (int)(i % W), b = (int)((i / W) % NB), z = (int)(i / ((long)W * NB)); float carry = 0.f;
#pragma unroll 16
        for (int q = 0; q < NLC; ++q) { const int ch = z == 0 ? q : NLC - 1 - q; const size_t idx = (((size_t)z * NB + b) * NLC + ch) * W + w; CI[idx] = carry; carry = CA[idx] * carry + CH[idx]; }
    }
}
__device__ __forceinline__ void ph_rope_table(const Ctx& c) {
    const int* pos = (const int*)c.in[2]; float* RT = WSF(O_ROPE);
    for (long i = GT_; i < (long)T * 32; i += GS_) { const int j = (int)(i & 31); const float ang = (float)pos[i >> 5] * powf(10000.f, -(float)(2 * j) / 64.f); RT[i * 2] = cosf(ang); RT[i * 2 + 1] = sinf(ang); }
}
__device__ __forceinline__ void ret_tables(float* tab, int h) {
    const int tid = threadIdx.x; const float lg = loggamma_(h);
    if (tid < 32) tab[tid] = powf(10000.f, -(float)(2 * tid) / 64.f);
    if (tid >= 64 && tid < 64 + 129) tab[tid] = expf((float)(tid - 64) * lg);
}
__device__ __forceinline__ void ph_ret_kv(const Ctx& c, float* ldsf) {
    const float* RT = WSF(O_ROPE); const bf16_t* P = WSH(O_P); float* KVF = WSF(O_KVF); float* KVB = WSF(O_KVB);
    bf16_t* VT = (bf16_t*)ldsf; bf16_t* KF = VT + 128 * 136; bf16_t* KB = KF + 64 * 136; float* tab = (float*)(KB + 64 * 136);
    const int tid = threadIdx.x, wv = tid >> 6, lane = tid & 63, fr = lane & 15, fq = lane >> 4;
    for (int u = blockIdx.x; u < (T / 128) * 8; u += gridDim.x) {
        const int h = u & 7; const long t0 = (long)(u >> 3) * 128;
        ret_tables(tab, h);
        SYNCTHREADS();
        { float x1[8], x2[8];
#pragma unroll
          for (int q = 0; q < 8; ++q) { const int id = tid + NT * q, j = id & 127, dj = id >> 7; const bf16_t* prow = P + (size_t)(t0 + j) * PW + C_RK + h * 64; x1[q] = bf2f(prow[dj]); x2[q] = bf2f(prow[dj + 32]); }
#pragma unroll 1
          for (int q = 0; q < 8; ++q) { const int id = tid + NT * q, j = id & 127, dj = id >> 7; const float cs = RT[((size_t)(t0 + j) * 32 + dj) * 2], sn = RT[((size_t)(t0 + j) * 32 + dj) * 2 + 1];
            const float k1 = x1[q] * cs - x2[q] * sn, k2 = x2[q] * cs + x1[q] * sn, fj = tab[64 + 127 - j], bj = tab[64 + j];
            KF[dj * 136 + j] = (bf16_t)f2bf(k1 * fj); KF[(dj + 32) * 136 + j] = (bf16_t)f2bf(k2 * fj); KB[dj * 136 + j] = (bf16_t)f2bf(k1 * bj); KB[(dj + 32) * 136 + j] = (bf16_t)f2bf(k2 * bj); } }
#pragma unroll
        for (int q = 0; q < 4; ++q) { const int id = tid + NT * q, j = id & 127, e8 = (id >> 7) * 8; const u32x4 raw = *(const u32x4*)(P + (size_t)(t0 + j) * PW + C_RV + h * 128 + e8);
#pragma unroll
            for (int e = 0; e < 4; ++e) { VT[(e8 + 2 * e) * 136 + j] = (bf16_t)(raw[e] & 0xffffu); VT[(e8 + 2 * e + 1) * 136 + j] = (bf16_t)(raw[e] >> 16); } }
        SYNCTHREADS();
        f32x4 af[4], ab[4];
#pragma unroll
        for (int nt = 0; nt < 4; ++nt) { af[nt] = (f32x4){0.f, 0.f, 0.f, 0.f}; ab[nt] = (f32x4){0.f, 0.f, 0.f, 0.f}; }
        wave_mma<4, 4>(af, VT + wv * 16 * 136, 136, KF, 136);
        wave_mma<4, 4>(ab, VT + wv * 16 * 136, 136, KB, 136);
        const size_t ob = (((size_t)(u >> 3) * 8 + h) * 128 + wv * 16 + fr) * 64 + 4 * fq;
#pragma unroll
        for (int nt = 0; nt < 4; ++nt) { *(f32x4*)(KVF + ob + 16 * nt) = af[nt]; *(f32x4*)(KVB + ob + 16 * nt) = ab[nt]; }
        SYNCTHREADS();
    }
}
__device__ __forceinline__ void ph_ret_state(const Ctx& c) {
    const float* KVF = WSF(O_KVF); const float* KVB = WSF(O_KVB); float* STF = WSF(O_STF); float* STB = WSF(O_STB);
    for (long i = GT_; i < (long)NB * 8 * 8192; i += GS_) {
        const int x = (int)(i % 8192), h = (int)((i / 8192) % 8), b = (int)(i / 65536);
        const float cd = expf(128.f * loggamma_(h)); float st = 0.f;
#pragma unroll 16
        for (int n = 0; n < NCH; ++n) { const size_t idx = (((size_t)b * NCH + n) * 8 + h) * 8192 + x; STF[idx] = st; st = cd * st + KVF[idx]; }
        st = 0.f;
#pragma unroll 16
        for (int n = NCH - 1; n >= 0; --n) { const size_t idx = (((size_t)b * NCH + n) * 8 + h) * 8192 + x; STB[idx] = st; st = cd * st + KVB[idx]; }
    }
}
__device__ __forceinline__ void ph_ret_out(const Ctx& c, float* ldsf) {
    const float* RT = WSF(O_ROPE); const bf16_t* P = WSH(O_P); const float* STF = WSF(O_STF); const float* STB = WSF(O_STB); bf16_t* Y = WSH(O_YS);
    bf16_t* Qs = (bf16_t*)ldsf; bf16_t* Ks = Qs + 128 * 72; bf16_t* VT = Ks + 128 * 72; bf16_t* Ss = VT + 128 * 136; bf16_t* SF = Ss + 128 * 136; bf16_t* SB = SF + 128 * 72; float* tab = (float*)(SB + 128 * 72);
    const int tid = threadIdx.x, wv = tid >> 6, lane = tid & 63, fr = lane & 15, fq = lane >> 4;
    for (int u = blockIdx.x; u < (T / 128) * 8; u += gridDim.x) {
        const int h = u & 7; const long t0 = (long)(u >> 3) * 128;
        ret_tables(tab, h);
        SYNCTHREADS();
#pragma unroll 1
        for (int qh = 0; qh < 8; qh += 4) { float q1[4], q2[4], k1[4], k2[4];
#pragma unroll
          for (int q = 0; q < 4; ++q) { const int id = tid + NT * (qh + q), j = id >> 5, dj = id & 31; const bf16_t* prow = P + (size_t)(t0 + j) * PW;
            q1[q] = bf2f(prow[C_RQ + h * 64 + dj]); q2[q] = bf2f(prow[C_RQ + h * 64 + dj + 32]); k1[q] = bf2f(prow[C_RK + h * 64 + dj]); k2[q] = bf2f(prow[C_RK + h * 64 + dj + 32]); }
#pragma unroll
          for (int q = 0; q < 4; ++q) { const int id = tid + NT * (qh + q), j = id >> 5, dj = id & 31; const float cs = RT[((size_t)(t0 + j) * 32 + dj) * 2], sn = RT[((size_t)(t0 + j) * 32 + dj) * 2 + 1];
            Qs[j * 72 + dj] = (bf16_t)f2bf((q1[q] * cs - q2[q] * sn) * 0.125f); Qs[j * 72 + dj + 32] = (bf16_t)f2bf((q2[q] * cs + q1[q] * sn) * 0.125f); Ks[j * 72 + dj] = (bf16_t)f2bf(k1[q] * cs - k2[q] * sn); Ks[j * 72 + dj + 32] = (bf16_t)f2bf(k2[q] * cs + k1[q] * sn); } }
#pragma unroll
        for (int q = 0; q < 4; ++q) { const int id = tid + NT * q, j = id & 127, e8 = (id >> 7) * 8; const u32x4 raw = *(const u32x4*)(P + (size_t)(t0 + j) * PW + C_RV + h * 128 + e8);
#pragma unroll
            for (int e = 0; e < 4; ++e) { VT[(e8 + 2 * e) * 136 + j] = (bf16_t)(raw[e] & 0xffffu); VT[(e8 + 2 * e + 1) * 136 + j] = (bf16_t)(raw[e] >> 16); } }
        const size_t sbase = (((size_t)(u >> 3) * 8 + h)) * 8192;
#pragma unroll
        for (int q = 0; q < 4; ++q) { const int id = tid + NT * q, e = id >> 4, d4 = (id & 15) * 4; st_bf4(SF + e * 72 + d4, *(const f32x4*)(STF + sbase + (size_t)e * 64 + d4)); st_bf4(SB + e * 72 + d4, *(const f32x4*)(STB + sbase + (size_t)e * 64 + d4)); }
        SYNCTHREADS();
        const int i = wv * 16 + fr; const long t = t0 + i;
        {
            f32x4 sc[8];
#pragma unroll
            for (int nt = 0; nt < 8; ++nt) sc[nt] = (f32x4){0.f, 0.f, 0.f, 0.f};
            wave_mma<2, 8>(sc, Qs + wv * 16 * 72, 72, Ks, 72);
#pragma unroll
            for (int nt = 0; nt < 8; ++nt) { const int j0 = 16 * nt + 4 * fq; f32x4 sv;
#pragma unroll
                for (int e = 0; e < 4; ++e) { const int j = j0 + e, dist = i > j ? i - j : j - i; sv[e] = sc[nt][e] * tab[64 + dist]; }
                st_bf4(Ss + i * 136 + j0, sv); }
        }
#ifdef CPU_EMU
        SYNCTHREADS();
#else
        asm volatile("s_waitcnt lgkmcnt(0)" ::: "memory");
#endif
        f32x4 ao[8], tm[8];
#pragma unroll
        for (int nt = 0; nt < 8; ++nt) { ao[nt] = (f32x4){0.f, 0.f, 0.f, 0.f}; tm[nt] = (f32x4){0.f, 0.f, 0.f, 0.f}; }
        wave_mma<4, 8>(ao, Ss + wv * 16 * 136, 136, VT, 136);
        wave_mma<2, 8>(tm, Qs + wv * 16 * 72, 72, SF, 72);
        { const float qf = tab[64 + i + 1];
#pragma unroll
            for (int nt = 0; nt < 8; ++nt) { ao[nt] += tm[nt] * qf; tm[nt] = (f32x4){0.f, 0.f, 0.f, 0.f}; } }
        wave_mma<2, 8>(tm, Qs + wv * 16 * 72, 72, SB, 72);
        { const float qb = tab[64 + 128 - i];
#pragma unroll
            for (int nt = 0; nt < 8; ++nt) ao[nt] += tm[nt] * qb; }
        float sm = 0.f;
#pragma unroll
        for (int nt = 0; nt < 8; ++nt) sm += (ao[nt][0] + ao[nt][1]) + (ao[nt][2] + ao[nt][3]);
        sm += SHFL_XOR(sm, 16); sm += SHFL_XOR(sm, 32);
        const float mu = sm * (1.f / 128.f); float sq = 0.f;
#pragma unroll
        for (int nt = 0; nt < 8; ++nt) { ao[nt] -= mu; sq += (ao[nt][0] * ao[nt][0] + ao[nt][1] * ao[nt][1]) + (ao[nt][2] * ao[nt][2] + ao[nt][3] * ao[nt][3]); }
        sq += SHFL_XOR(sq, 16); sq += SHFL_XOR(sq, 32);
        const float rs = 1.f / sqrtf(sq * (1.f / 128.f) + EPS);
#pragma unroll
        for (int nt = 0; nt < 8; ++nt) { const int e0 = 16 * nt + 4 * fq; f32x4 gv = ld_bf4(P + (size_t)t * PW + C_RG + h * 128 + e0);
#pragma unroll
            for (int e = 0; e < 4; ++e) gv[e] = siluf_(gv[e]) * (ao[nt][e] * rs);
            st_bf4(Y + (size_t)t * 4 * W + 1 * W + h * 128 + e0, gv); }
        SYNCTHREADS();
    }
}
__device__ __forceinline__ void ph_sgu_norm(const Ctx& c, int l) {
    const bf16_t* P = WSH(O_P); float* ST = WSF(O_VN);
    const int lane = threadIdx.x & 63, gw = blockIdx.x * (NT / 64) + (threadIdx.x >> 6), ngw = gridDim.x * (NT / 64);
    for (int t = gw; t < T; t += ngw) {
        f32x4 v[4]; float sm = 0.f;
#pragma unroll
        for (int j = 0; j < 4; ++j) { v[j] = ld_bf4(P + (size_t)t * PW + C_SV + (j * 64 + lane) * 4);
#pragma unroll
            for (int q = 0; q < 4; ++q) { v[j][q] = geluf_(v[j][q]); sm += v[j][q]; } }
        const float mu = wave_sum(sm) * (1.f / W); float sq = 0.f;
#pragma unroll
        for (int j = 0; j < 4; ++j)
#pragma unroll
            for (int q = 0; q < 4; ++q) { const float dd = v[j][q] - mu; sq += dd * dd; }
        const float rs = 1.f / sqrtf(wave_sum(sq) * (1.f / W) + EPS);
        if (lane == 0) { ST[(size_t)t * 2] = mu; ST[(size_t)t * 2 + 1] = rs; }
    }
}
__device__ __forceinline__ void ph_sgu_mix(const Ctx& c, int l, float* ldsf) {
    const bf16_t* P = WSH(O_P); const float* ST = WSF(O_VN); bf16_t* Y = WSH(O_YS); const float* ng = c.in[15] + (size_t)l * W;
    bf16_t* As = (bf16_t*)ldsf; bf16_t* Bs = As + 128 * 136; const int tid = threadIdx.x, wv = tid >> 6, lane = tid & 63, fr = lane & 15, fq = lane >> 4;
    for (int u = blockIdx.x; u < (T / 128) * 8; u += gridDim.x) {
        const int g = u & 7; const long t0 = (long)(u >> 3) * 128;
        const float* ws = c.in[16] + ((size_t)l * 8 + g) * 128 * 128; const float* bs = c.in[17] + ((size_t)l * 8 + g) * 128;
#pragma unroll
        for (int q = 0; q < 8; ++q) { const int id = tid + NT * q, i = id >> 5, j4 = (id & 31) * 4; st_bf4(As + i * 136 + j4, *(const f32x4*)(ws + i * 128 + j4)); }
#pragma unroll
        for (int q = 0; q < 4; ++q) { const int id = tid + NT * q, j = id & 127, d8 = (id >> 7) * 8; const float mu = ST[(size_t)(t0 + j) * 2], rs = ST[(size_t)(t0 + j) * 2 + 1];
            const u32x4 raw = *(const u32x4*)(P + (size_t)(t0 + j) * PW + C_SV + g * 128 + d8);
#pragma unroll
            for (int e = 0; e < 4; ++e) { const float v0 = (geluf_(bflo(raw[e])) - mu) * rs * ng[g * 128 + d8 + 2 * e], v1 = (geluf_(bfhi(raw[e])) - mu) * rs * ng[g * 128 + d8 + 2 * e + 1];
                Bs[(d8 + 2 * e) * 136 + j] = (bf16_t)f2bf(v0); Bs[(d8 + 2 * e + 1) * 136 + j] = (bf16_t)f2bf(v1); } }
        SYNCTHREADS();
        f32x4 acc[8];
#pragma unroll
        for (int nt = 0; nt < 8; ++nt) acc[nt] = (f32x4){0.f, 0.f, 0.f, 0.f};
        wave_mma<4, 8>(acc, As + wv * 16 * 136, 136, Bs, 136);
        const int i = wv * 16 + fr; const long t = t0 + i; const float bsi = bs[i];
#pragma unroll
        for (int nt = 0; nt < 8; ++nt) { const int d = 16 * nt + 4 * fq; f32x4 uu = ld_bf4(P + (size_t)t * PW + C_SU + g * 128 + d);
#pragma unroll
            for (int e = 0; e < 4; ++e) uu[e] = geluf_(uu[e]) * (acc[nt][e] + bsi);
            st_bf4(Y + (size_t)t * 4 * W + 2 * W + g * 128 + d, uu); }
        SYNCTHREADS();
    }
}
__device__ __forceinline__ void ph_rw_shift(const Ctx& c, int l) {
    const bf16_t* P = WSH(O_P); const float* mup = c.in[18] + (size_t)l * RF; const float* mun = c.in[19] + (size_t)l * RF; bf16_t* FS = WSH(O_FS);
    const int lane = threadIdx.x & 63, gw = blockIdx.x * (NT / 64) + (threadIdx.x >> 6), ngw = gridDim.x * (NT / 64);
    for (int t = gw; t < T; t += ngw) {
        const int sI = t % S; const bf16_t* pc = P + (size_t)t * PW + C_RW;
#pragma unroll 2
        for (int j = lane * 4; j < RF; j += 256) {
            const f32x4 f = ld_bf4(pc + j), z4 = (f32x4){0.f, 0.f, 0.f, 0.f}; const f32x4 pv = sI > 0 ? ld_bf4(pc - PW + j) : z4, nv = sI < S - 1 ? ld_bf4(pc + PW + j) : z4;
            f32x4 v = f + *(const f32x4*)(mup + j) * (pv - f) + *(const f32x4*)(mun + j) * (nv - f);
            if (j >= 3072 && j < 3200) {
#pragma unroll
                for (int e = 0; e < 4; ++e) v[e] = tanhf_(v[e]); }
            else if (j >= 3328) {
#pragma unroll
                for (int e = 0; e < 4; ++e) v[e] = sigmoidf_(v[e]); }
            st_bf4(FS + (size_t)t * RF + j, v);
        }
    }
}
__device__ __forceinline__ void ph_rw_lora(const Ctx& c, int l, float* ldsf) {
    const bf16_t* FS = WSH(O_FS); const float* w0 = c.in[20] + (size_t)l * 2 * W; const float* a0 = c.in[22] + (size_t)l * 2 * W;
    const bf16_t* WUT = WSH(O_WUT); const bf16_t* WAT = WSH(O_WAT); const bf16_t* WGT = WSH(O_WGT);
    bf16_t* DEC = WSH(O_DEC); bf16_t* AA = WSH(O_AA); bf16_t* GG = WSH(O_GG);
    bf16_t* F = (bf16_t*)ldsf; bf16_t* B1 = F + 128 * 136; bf16_t* B2 = B1 + 128 * 136; const int tid = threadIdx.x, wv = tid >> 6, lane = tid & 63, fr = lane & 15, fq = lane >> 4;
    for (int u = blockIdx.x; u < (T / 128) * 8; u += gridDim.x) {
        const int wc0 = (u & 7) * 128; const long t0 = (long)(u >> 3) * 128;
        for (int rd = 0; rd < 3; ++rd) {
#pragma unroll
            for (int q = 0; q < 8; ++q) { const int id = tid + NT * q, r = id >> 5, c4 = (id & 31) * 4;
                const int col = rd < 2 ? (c4 < 64 ? 3072 + rd * 64 + c4 : 3200 + rd * 64 + (c4 - 64)) : 3328 + c4;
                *(unsigned long long*)(F + r * 136 + c4) = *(const unsigned long long*)(FS + (size_t)(t0 + r) * RF + col); }
            if (rd < 2) {
#pragma unroll
                for (int q = 0; q < 2; ++q) { const int id = tid + NT * q, w = id >> 3, r8 = (id & 7) * 8;
                    *(u32x4*)(B1 + w * 72 + r8) = *(const u32x4*)(WUT + ((size_t)rd * W + wc0 + w) * 64 + r8); *(u32x4*)(B2 + w * 72 + r8) = *(const u32x4*)(WAT + ((size_t)rd * W + wc0 + w) * 64 + r8); }
            } else {
#pragma unroll
                for (int q = 0; q < 4; ++q) { const int id = tid + NT * q, w = id >> 4, r8 = (id & 15) * 8; *(u32x4*)(B1 + w * 136 + r8) = *(const u32x4*)(WGT + ((size_t)wc0 + w) * 128 + r8); }
            }
            SYNCTHREADS();
            f32x4 a1[8], a2[8];
#pragma unroll
            for (int nt = 0; nt < 8; ++nt) { a1[nt] = (f32x4){0.f, 0.f, 0.f, 0.f}; a2[nt] = (f32x4){0.f, 0.f, 0.f, 0.f}; }
            const long t = t0 + wv * 16 + fr;
            if (rd < 2) {
                wave_mma<2, 8>(a1, F + wv * 16 * 136, 136, B1, 72);
                wave_mma<2, 8>(a2, F + wv * 16 * 136 + 64, 136, B2, 72);
#pragma unroll
                for (int nt = 0; nt < 8; ++nt) { const int ch = wc0 + 16 * nt + 4 * fq; const f32x4 w0v = *(const f32x4*)(w0 + rd * W + ch), a0v = *(const f32x4*)(a0 + rd * W + ch); f32x4 dv, av;
#pragma unroll
                    for (int e = 0; e < 4; ++e) { dv[e] = fexp_(-DECAY_SCALE * sigmoidf_(a1[nt][e] + w0v[e])); av[e] = sigmoidf_(a2[nt][e] + a0v[e]); }
                    st_bf4(DEC + ((size_t)rd * T + t) * W + ch, dv); st_bf4(AA + ((size_t)rd * T + t) * W + ch, av); }
            } else {
                wave_mma<4, 8>(a1, F + wv * 16 * 136, 136, B1, 136);
#pragma unroll
                for (int nt = 0; nt < 8; ++nt) st_bf4(GG + (size_t)t * W + wc0 + 16 * nt + 4 * fq, a1[nt]);
            }
            SYNCTHREADS();
        }
    }
}
#ifdef CPU_EMU
__device__ __forceinline__ float red16_(float x) { x += SHFL_XOR(x, 1); x += SHFL_XOR(x, 2); x += SHFL_XOR(x, 4); x += SHFL_XOR(x, 8); return x; }
__device__ __forceinline__ float red8_(float x) { x += SHFL_XOR(x, 1); x += SHFL_XOR(x, 2); x += SHFL_XOR(x, 4); return x; }
#define LDS_BARRIER() emu_syncthreads()
#else
__device__ __forceinline__ float red8_(float x) {
    x += __builtin_bit_cast(float, __builtin_amdgcn_update_dpp(0, __builtin_bit_cast(int, x), 0xB1, 0xF, 0xF, true));
    x += __builtin_bit_cast(float, __builtin_amdgcn_update_dpp(0, __builtin_bit_cast(int, x), 0x4E, 0xF, 0xF, true));
    x += __builtin_bit_cast(float, __builtin_amdgcn_update_dpp(0, __builtin_bit_cast(int, x), 0x141, 0xF, 0xF, true));
    return x;
}
__device__ __forceinline__ float red16_(float x) {
    x += __builtin_bit_cast(float, __builtin_amdgcn_update_dpp(0, __builtin_bit_cast(int, x), 0xB1, 0xF, 0xF, true));
    x += __builtin_bit_cast(float, __builtin_amdgcn_update_dpp(0, __builtin_bit_cast(int, x), 0x4E, 0xF, 0xF, true));
    x += __builtin_bit_cast(float, __builtin_amdgcn_update_dpp(0, __builtin_bit_cast(int, x), 0x141, 0xF, 0xF, true));
    x += __builtin_bit_cast(float, __builtin_amdgcn_update_dpp(0, __builtin_bit_cast(int, x), 0x140, 0xF, 0xF, true));
    return x;
}
#define LDS_BARRIER() do { asm volatile("s_waitcnt lgkmcnt(0)" ::: "memory"); __builtin_amdgcn_s_barrier(); asm volatile("" ::: "memory"); } while (0)
#endif
#define RC_M(k) (lm + (k) * 4608)
__device__ __forceinline__ void ph_rw_chunk(const Ctx& c, int l, float* ldsf) {
    const bf16_t* FS = WSH(O_FS); const bf16_t* DEC = WSH(O_DEC); const bf16_t* AA = WSH(O_AA); float* BON = WSF(O_BON);
    const float* kkw = c.in[25] + (size_t)l * W; const float* kaw = c.in[26] + (size_t)l * W; const float* rk = c.in[27] + (size_t)l * W;
    bf16_t* PST = WSH(O_PST); bf16_t* PYT = WSH(O_PYT); bf16_t* SVB = WSH(O_SVB); bf16_t* YVB = WSH(O_YVB);
    bf16_t* lm = (bf16_t*)ldsf; float* gam = (float*)RC_M(7); float* segp = (float*)RC_M(13); float* gl = segp + 512;
    const int tid = threadIdx.x, wv = tid >> 6, lane = tid & 63, fr = lane & 15, fq = lane >> 4, rt = wv & 3, hf = wv >> 2;
    const int m0 = 16 * rt + fr;
    u32x4 wq, kq, rq, vq, aq;
#define RC_LOAD(uu) do { const int chain_ = (uu) / NRC, ck_ = (uu) % NRC, h_ = chain_ & 15, b_ = (chain_ >> 4) & 1, z_ = chain_ >> 5; \
        const long t_ = (long)b_ * S + (z_ ? S - 1 - ck_ * RCK - (tid >> 3) : ck_ * RCK + (tid >> 3)); const int ch_ = h_ * 64 + (tid & 7) * 8; \
        wq = *(const u32x4*)(DEC + ((size_t)z_ * T + t_) * W + ch_); aq = *(const u32x4*)(AA + ((size_t)z_ * T + t_) * W + ch_); \
        const bf16_t* f_ = FS + (size_t)t_ * RF; rq = *(const u32x4*)(f_ + ch_); kq = *(const u32x4*)(f_ + 1024 + ch_); vq = *(const u32x4*)(f_ + 2048 + ch_); } while (0)
    if ((int)blockIdx.x < 64 * NRC) RC_LOAD((int)blockIdx.x);
    for (int u = blockIdx.x; u < 64 * NRC; u += gridDim.x) {
        const int chain = u / NRC, ck = u % NRC, h = chain & 15, b = (chain >> 4) & 1, z = chain >> 5;
        const long tb = (long)b * S + (z ? S - 1 - ck * RCK : ck * RCK); const int dirn = z ? -1 : 1;
        const int tt = tid >> 3, o8 = (tid & 7) * 8;
        const f32x4 kw0 = *(const f32x4*)(kkw + h * 64 + o8), kw1 = *(const f32x4*)(kkw + h * 64 + o8 + 4), ka0 = *(const f32x4*)(kaw + h * 64 + o8), ka1 = *(const f32x4*)(kaw + h * 64 + o8 + 4),
                    rk0 = *(const f32x4*)(rk + h * 64 + o8), rk1 = *(const f32x4*)(rk + h * 64 + o8 + 4);
        *(f32x4*)(gam + tt * 64 + o8) = (f32x4){bflo(wq[0]), bfhi(wq[0]), bflo(wq[1]), bfhi(wq[1])};
        *(f32x4*)(gam + tt * 64 + o8 + 4) = (f32x4){bflo(wq[2]), bfhi(wq[2]), bflo(wq[3]), bfhi(wq[3])};
        LDS_BARRIER();
        { const int k = tid & 63, sg = tid >> 6; float p = 1.f;
#pragma unroll
          for (int q = 0; q < 8; ++q) { p *= gam[(sg * 8 + q) * 64 + k]; gam[(sg * 8 + q) * 64 + k] = p; }
          segp[sg * 64 + k] = p; }
        LDS_BARRIER();
        { const int k = tid & 63, sg = tid >> 6; float pre = 1.f;
          for (int q = 0; q < sg; ++q) pre *= segp[q * 64 + k];
#pragma unroll
          for (int q = 0; q < 8; ++q) gam[(sg * 8 + q) * 64 + k] *= pre;
          if (sg == 7) gl[k] = gam[63 * 64 + k]; }
        LDS_BARRIER();
        { const long t = tb + dirn * tt;
          const f32x4 g0 = *(const f32x4*)(gam + tt * 64 + o8), g1 = *(const f32x4*)(gam + tt * 64 + o8 + 4);
          f32x4 p0 = (f32x4){1.f, 1.f, 1.f, 1.f}, p1 = p0; if (tt) { p0 = *(const f32x4*)(gam + (tt - 1) * 64 + o8); p1 = *(const f32x4*)(gam + (tt - 1) * 64 + o8 + 4); }
          float gx[8], gpx[8], kwx[8], kax[8], rkx[8], kx[8], ax[8], rx[8];
#pragma unroll
          for (int e = 0; e < 4; ++e) { gx[e] = g0[e]; gx[4 + e] = g1[e]; gpx[e] = p0[e]; gpx[4 + e] = p1[e]; kwx[e] = kw0[e]; kwx[4 + e] = kw1[e]; kax[e] = ka0[e]; kax[4 + e] = ka1[e]; rkx[e] = rk0[e]; rkx[4 + e] = rk1[e];
              kx[2 * e] = bflo(kq[e]); kx[2 * e + 1] = bfhi(kq[e]); ax[2 * e] = bflo(aq[e]); ax[2 * e + 1] = bfhi(aq[e]); rx[2 * e] = bflo(rq[e]); rx[2 * e + 1] = bfhi(rq[e]); }
          float vk[8], ktv[8], ss = 0.f, bs = 0.f;
#pragma unroll
          for (int e = 0; e < 8; ++e) { vk[e] = kx[e] * kwx[e]; ss += vk[e] * vk[e]; ktv[e] = kx[e] * (1.f + (ax[e] - 1.f) * kax[e]); bs += rx[e] * rkx[e] * ktv[e]; }
          ss = red8_(ss); bs = red8_(bs);
          if ((tid & 7) == 0) BON[((size_t)z * T + t) * 16 + h] = bs;
          const float rn = frsq_(ss + EPS); float khv[8], bhv[8], k2v[8], rhv[8];
#pragma unroll
          for (int e = 0; e < 8; ++e) { const float kkn = vk[e] * rn, ig = frcp_(gx[e]); khv[e] = kkn * gpx[e]; bhv[e] = ax[e] * kkn * ig; k2v[e] = ktv[e] * ig; rhv[e] = rx[e] * gx[e]; }
          u32x4 K4, B4, C4, R4;
#pragma unroll
          for (int e = 0; e < 4; ++e) { K4[e] = pk2(khv[2 * e], khv[2 * e + 1]); B4[e] = pk2(bhv[2 * e], bhv[2 * e + 1]); C4[e] = pk2(k2v[2 * e], k2v[2 * e + 1]); R4[e] = pk2(rhv[2 * e], rhv[2 * e + 1]); }
          *(u32x4*)(RC_M(0) + tt * 72 + o8) = K4; *(u32x4*)(RC_M(2) + tt * 72 + o8) = B4; *(u32x4*)(RC_M(4) + tt * 72 + o8) = C4; *(u32x4*)(RC_M(5) + tt * 72 + o8) = R4;
#pragma unroll
          for (int e = 0; e < 8; ++e) { const int sh = 16 * (e & 1);
              RC_M(1)[(o8 + e) * 72 + tt] = (bf16_t)(K4[e >> 1] >> sh); RC_M(3)[(o8 + e) * 72 + tt] = (bf16_t)(B4[e >> 1] >> sh); RC_M(6)[(o8 + e) * 72 + tt] = (bf16_t)(vq[e >> 1] >> sh); } }
        if (u + (int)gridDim.x < 64 * NRC) RC_LOAD(u + (int)gridDim.x);
        LDS_BARRIER();
        f32x4 mkr[2], khr[2], rhT[2];
        {
            f32x4 a0[2], a1[2], a2[2], a3[2];
#pragma unroll
            for (int nt = 0; nt < 2; ++nt) { a0[nt] = (f32x4){0.f, 0.f, 0.f, 0.f}; a1[nt] = a0[nt]; a2[nt] = a0[nt]; a3[nt] = a0[nt]; }
            wave_mma<2, 2>(a0, RC_M(2) + rt * 16 * 72, 72, RC_M(0) + hf * 32 * 72, 72);
            wave_mma<2, 2>(a1, RC_M(4) + rt * 16 * 72, 72, RC_M(0) + hf * 32 * 72, 72);
            wave_mma<2, 2>(a2, RC_M(2) + rt * 16 * 72, 72, RC_M(5) + hf * 32 * 72, 72);
            wave_mma<2, 2>(a3, RC_M(4) + rt * 16 * 72, 72, RC_M(5) + hf * 32 * 72, 72);
#pragma unroll
            for (int nt = 0; nt < 2; ++nt) { const int n0 = 32 * hf + 16 * nt + 4 * fq; f32x4 nn, ti, mk;
#pragma unroll
                for (int r = 0; r < 4; ++r) { const int n = n0 + r; const bool lt = m0 < n, le = m0 <= n;
                    nn[r] = lt ? -a0[nt][r] : 0.f; ti[r] = nn[r] + (m0 == n ? 1.f : 0.f); mk[r] = lt ? a1[nt][r] : 0.f; mkr[nt][r] = le ? a3[nt][r] : 0.f;
                    RC_M(12)[n * 72 + m0] = (bf16_t)f2bf(le ? a2[nt][r] : 0.f);
                    RC_M(8)[n * 72 + m0] = (bf16_t)f2bf(nn[r]);
                    khr[nt][r] = bf2f(RC_M(4)[m0 * 72 + n]); rhT[nt][r] = bf2f(RC_M(5)[n * 72 + m0]); }
                st_bf4(RC_M(7) + m0 * 72 + n0, nn); st_bf4(RC_M(9) + m0 * 72 + n0, ti); st_bf4(RC_M(11) + m0 * 72 + n0, mk); }
        }
        LDS_BARRIER();
        f32x4 tiv[2];
#pragma unroll
        for (int nt = 0; nt < 2; ++nt) tiv[nt] = ld_bf4(RC_M(9) + m0 * 72 + 32 * hf + 16 * nt + 4 * fq);
#pragma unroll 1
        for (int it = 0; it < 5; ++it) {
            bf16_t* pw = (it & 1) ? RC_M(0) : RC_M(7); bf16_t* pwT = (it & 1) ? RC_M(2) : RC_M(8); bf16_t* pw2 = (it & 1) ? RC_M(7) : RC_M(0); bf16_t* pw2T = (it & 1) ? RC_M(8) : RC_M(2);
            bf16_t* tcur = (it & 1) ? RC_M(4) : RC_M(9); bf16_t* tnxt = (it & 1) ? RC_M(9) : RC_M(4);
            f32x4 sq[2];
#pragma unroll
            for (int nt = 0; nt < 2; ++nt) sq[nt] = (f32x4){0.f, 0.f, 0.f, 0.f};
            wave_mma<2, 2>(sq, pw + rt * 16 * 72, 72, pwT + hf * 32 * 72, 72);
#pragma unroll
            for (int nt = 0; nt < 2; ++nt) { const int n0 = 32 * hf + 16 * nt + 4 * fq; st_bf4(pw2 + m0 * 72 + n0, sq[nt]);
#pragma unroll
                for (int r = 0; r < 4; ++r) pw2T[(n0 + r) * 72 + m0] = (bf16_t)f2bf(sq[nt][r]); }
            LDS_BARRIER();
            f32x4 up[2];
#pragma unroll
            for (int nt = 0; nt < 2; ++nt) up[nt] = (f32x4){0.f, 0.f, 0.f, 0.f};
            wave_mma<2, 2>(up, tcur + rt * 16 * 72, 72, pw2T + hf * 32 * 72, 72);
#pragma unroll
            for (int nt = 0; nt < 2; ++nt) { const int n0 = 32 * hf + 16 * nt + 4 * fq; tiv[nt] += up[nt]; st_bf4(tnxt + m0 * 72 + n0, tiv[nt]);
                if (it == 4) {
#pragma unroll
                    for (int r = 0; r < 4; ++r) RC_M(10)[(n0 + r) * 72 + m0] = (bf16_t)f2bf(tiv[nt][r]); } }
            LDS_BARRIER();
        }
        {
            f32x4 w1[2], w2[2];
#pragma unroll
            for (int nt = 0; nt < 2; ++nt) { w1[nt] = (f32x4){0.f, 0.f, 0.f, 0.f}; w2[nt] = w1[nt]; }
            wave_mma<2, 2>(w1, RC_M(1) + rt * 16 * 72, 72, RC_M(10) + hf * 32 * 72, 72);
            wave_mma<2, 2>(w2, RC_M(11) + rt * 16 * 72, 72, RC_M(10) + hf * 32 * 72, 72);
#pragma unroll
            for (int nt = 0; nt < 2; ++nt) { const int n0 = 32 * hf + 16 * nt + 4 * fq; st_bf4(RC_M(7) + m0 * 72 + n0, w1[nt]); st_bf4(RC_M(8) + m0 * 72 + n0, w2[nt]); }
        }
        LDS_BARRIER();
        {
            f32x4 py[2], qy[2], ps[2], qs[2];
#pragma unroll
            for (int nt = 0; nt < 2; ++nt) { py[nt] = (f32x4){0.f, 0.f, 0.f, 0.f}; qy[nt] = py[nt]; ps[nt] = py[nt]; qs[nt] = py[nt]; }
            wave_mma<2, 2>(py, RC_M(7) + rt * 16 * 72, 72, RC_M(12) + hf * 32 * 72, 72);
            wave_mma<2, 2>(qy, RC_M(8) + rt * 16 * 72, 72, RC_M(12) + hf * 32 * 72, 72);
            wave_mma<2, 2>(ps, RC_M(7) + rt * 16 * 72, 72, RC_M(3) + hf * 32 * 72, 72);
            wave_mma<2, 2>(qs, RC_M(8) + rt * 16 * 72, 72, RC_M(3) + hf * 32 * 72, 72);
#pragma unroll
            for (int nt = 0; nt < 2; ++nt) { const int n0 = 32 * hf + 16 * nt + 4 * fq;
#pragma unroll
                for (int r = 0; r < 4; ++r) { const int n = n0 + r; const float gln = gl[n];
                    RC_M(0)[n * 72 + m0] = (bf16_t)f2bf(rhT[nt][r] - py[nt][r]); RC_M(2)[n * 72 + m0] = (bf16_t)f2bf(mkr[nt][r] - qy[nt][r]);
                    RC_M(4)[n * 72 + m0] = (bf16_t)f2bf(((m0 == n ? 1.f : 0.f) - ps[nt][r]) * gln); RC_M(5)[n * 72 + m0] = (bf16_t)f2bf((khr[nt][r] - qs[nt][r]) * gln); } }
        }
        LDS_BARRIER();
        {
            f32x4 yv[2], sv[2];
#pragma unroll
            for (int nt = 0; nt < 2; ++nt) { yv[nt] = (f32x4){0.f, 0.f, 0.f, 0.f}; sv[nt] = yv[nt]; }
            wave_mma<2, 2>(yv, RC_M(6) + rt * 16 * 72, 72, RC_M(2) + hf * 32 * 72, 72);
            wave_mma<2, 2>(sv, RC_M(6) + rt * 16 * 72, 72, RC_M(5) + hf * 32 * 72, 72);
#pragma unroll
            for (int nt = 0; nt < 2; ++nt) { const int n0 = 32 * hf + 16 * nt + 4 * fq; st_bf4(YVB + (size_t)u * 4096 + m0 * 64 + n0, yv[nt]); st_bf4(SVB + (size_t)u * 4096 + m0 * 64 + n0, sv[nt]); }
            { const int rr = tid >> 3, c8 = (tid & 7) * 8; *(u32x4*)(PYT + (size_t)u * 4096 + rr * 64 + c8) = *(const u32x4*)(RC_M(0) + rr * 72 + c8); *(u32x4*)(PST + (size_t)u * 4096 + rr * 64 + c8) = *(const u32x4*)(RC_M(4) + rr * 72 + c8); }
        }
        LDS_BARRIER();
    }
}
#undef RC_M
#undef RC_LOAD
__device__ __forceinline__ void ph_rw_seq(const Ctx& c, float* ldsf) {
    const bf16_t* PST = WSH(O_PST); const bf16_t* PYT = WSH(O_PYT); const bf16_t* SVB = WSH(O_SVB); const bf16_t* YVB = WSH(O_YVB); bf16_t* YY = WSH(O_YY);
    bf16_t* Sb = (bf16_t*)ldsf;
    bf16_t* Pm = Sb + 2 * 16 * 72;
    const int tid = threadIdx.x, wv = tid >> 6, lane = tid & 63, fr = lane & 15, fq = lane >> 4, nt0 = wv & 3;
#ifdef CPU_EMU
    const int isY = wv >> 2;
#else
    const int isY = __builtin_amdgcn_readfirstlane(wv >> 2);
#endif
    for (int u = blockIdx.x; u < 256; u += gridDim.x) {
        const int x = u & 7, jq = u >> 3, chain = x * 8 + (jq >> 2), qt = jq & 3, h = chain & 15, b = (chain >> 4) & 1, z = chain >> 5;
        const size_t ub = (size_t)chain * NRC;
        const int rr = tid >> 3, c8 = (tid & 7) * 8;
        constexpr int PD = NRC >= 8 ? 8 : 4;
        for (int i = tid; i < 2 * 16 * 72 / 2; i += NT) ((unsigned*)Sb)[i] = 0u;
        const int row = 16 * qt + fr, n0 = 16 * nt0 + 4 * fq; const bf16_t* addp = (isY ? YVB : SVB) + ub * 4096 + row * 64 + n0;
        const bf16_t* psp = PST + ub * 4096 + rr * 64 + c8; const bf16_t* pyp = PYT + ub * 4096 + rr * 64 + c8;
        u32x4 gps[PD], gpy[PD]; unsigned long long addr[PD];
#pragma unroll
        for (int j = 0; j < PD; ++j) { gps[j] = *(const u32x4*)(psp + (size_t)j * 4096); gpy[j] = *(const u32x4*)(pyp + (size_t)j * 4096); addr[j] = *(const unsigned long long*)(addp + (size_t)j * 4096); }
        *(u32x4*)(Pm + (0 * 2 + 0) * 4608 + rr * 72 + c8) = gps[0]; *(u32x4*)(Pm + (0 * 2 + 1) * 4608 + rr * 72 + c8) = gpy[0];
        { const int cl = PD < NRC ? PD : NRC - 1; gps[0] = *(const u32x4*)(psp + (size_t)cl * 4096); gpy[0] = *(const u32x4*)(pyp + (size_t)cl * 4096); }
        SYNCTHREADS();
#define RS_LOOP(ISY) \
        for (int ck0 = 0; ck0 < NRC; ck0 += PD) { \
            _Pragma("unroll") for (int j = 0; j < PD; ++j) { \
                const int ck = ck0 + j, cur = j & 1, nxt = cur ^ 1;        \
                f32x4 acc[1]; acc[0] = (f32x4){0.f, 0.f, 0.f, 0.f}; \
                wave_mma<2, 1>(acc, Sb + cur * 16 * 72, 72, Pm + (cur * 2 + ISY) * 4608 + nt0 * 16 * 72, 72); \
                { const unsigned lo_ = (unsigned)addr[j], hi_ = (unsigned)(addr[j] >> 32); acc[0][0] += bflo(lo_); acc[0][1] += bfhi(lo_); acc[0][2] += bflo(hi_); acc[0][3] += bfhi(hi_); } \
                { const int cl = ck + PD < NRC ? ck + PD : NRC - 1; addr[j] = *(const unsigned long long*)(addp + (size_t)cl * 4096); } \
                if (ISY) { \
                    _Pragma("unroll") for (int r = 0; r < 4; ++r) { const int step = ck * RCK + n0 + r, sidx = z ? S - 1 - step : step; YY[((size_t)z * T + (size_t)b * S + sidx) * W + h * 64 + row] = (bf16_t)f2bf(acc[0][r]); } \
                } else st_bf4(Sb + nxt * 16 * 72 + fr * 72 + n0, acc[0]); \
                const int jn = (j + 1) % PD; \
                *(u32x4*)(Pm + (nxt * 2 + 0) * 4608 + rr * 72 + c8) = gps[jn]; *(u32x4*)(Pm + (nxt * 2 + 1) * 4608 + rr * 72 + c8) = gpy[jn]; \
                { const int cl = ck + 1 + PD < NRC ? ck + 1 + PD : NRC - 1; gps[jn] = *(const u32x4*)(psp + (size_t)cl * 4096); gpy[jn] = *(const u32x4*)(pyp + (size_t)cl * 4096); } \
                LDS_BARRIER(); \
            } \
        }
        if (isY) { RS_LOOP(1) } else { RS_LOOP(0) }
#undef RS_LOOP
    }
}
__device__ __forceinline__ void ph_rw_out(const Ctx& c) {
    const bf16_t* FS = WSH(O_FS); const bf16_t* YY = WSH(O_YY); const float* BON = WSF(O_BON); const bf16_t* GG = WSH(O_GG); bf16_t* Y = WSH(O_YS);
    const int lane = threadIdx.x & 63, gw = blockIdx.x * (NT / 64) + (threadIdx.x >> 6), ngw = gridDim.x * (NT / 64);
    for (int i0 = gw; i0 < T * 2; i0 += 2 * ngw) {
        u32x4 a0[2], a1[2], gq[2], vq[2]; float bs[2];
#pragma unroll
        for (int r = 0; r < 2; ++r) { const int i = i0 + r * ngw < T * 2 ? i0 + r * ngw : i0; const long t = i >> 1; const int ch = (i & 1) * 512 + lane * 8, hd = ch >> 6;
            a0[r] = *(const u32x4*)(YY + (size_t)t * W + ch); a1[r] = *(const u32x4*)(YY + ((size_t)T + t) * W + ch); gq[r] = *(const u32x4*)(GG + (size_t)t * W + ch); vq[r] = *(const u32x4*)(FS + (size_t)t * RF + 2048 + ch);
            bs[r] = BON[(size_t)t * 16 + hd] + BON[((size_t)T + t) * 16 + hd]; }
#pragma unroll
        for (int r = 0; r < 2; ++r) { const int i = i0 + r * ngw < T * 2 ? i0 + r * ngw : i0; const long t = i >> 1; const int ch = (i & 1) * 512 + lane * 8;
            float y0[8], y1[8], s0 = 0.f, s1 = 0.f;
#pragma unroll
            for (int e = 0; e < 4; ++e) { y0[2 * e] = bflo(a0[r][e]); y0[2 * e + 1] = bfhi(a0[r][e]); y1[2 * e] = bflo(a1[r][e]); y1[2 * e + 1] = bfhi(a1[r][e]); }
#pragma unroll
            for (int e = 0; e < 8; ++e) { s0 += y0[e]; s1 += y1[e]; }
            const float m0 = red8_(s0) * (1.f / 64.f), m1 = red8_(s1) * (1.f / 64.f); float q0 = 0.f, q1 = 0.f;
#pragma unroll
            for (int e = 0; e < 8; ++e) { y0[e] -= m0; y1[e] -= m1; q0 += y0[e] * y0[e]; q1 += y1[e] * y1[e]; }
            const float r0 = 1.f / sqrtf(red8_(q0) * (1.f / 64.f) + EPS), r1 = 1.f / sqrtf(red8_(q1) * (1.f / 64.f) + EPS);
            u32x4 o;
#pragma unroll
            for (int e = 0; e < 4; ++e) { const float lo = (y0[2 * e] * r0 + y1[2 * e] * r1 + bs[r] * bflo(vq[r][e])) * bflo(gq[r][e]), hi = (y0[2 * e + 1] * r0 + y1[2 * e + 1] * r1 + bs[r] * bfhi(vq[r][e])) * bfhi(gq[r][e]); o[e] = pk2(lo, hi); }
            *(u32x4*)(Y + (size_t)t * 4 * W + 3 * W + ch) = o; }
    }
}
__device__ __forceinline__ void ph_router(const Ctx& c, int l, float* ldsf, const float* X, const float* gN, const float* shN, const float* scN) {
    const float* RS = WSF(O_HF); const bf16_t* WH = WSH(O_WRH); const bf16_t* WL = WSH(O_WRL); const float* bg = c.in[31] + (size_t)l * 4; const float* be = c.in[33] + (size_t)l * 32;
    int* EID = WSI(O_EID); float* EWT = WSF(O_EWT); int* cnt = CTLW(c) + CW_CNT + l * 64;
    const int tid = threadIdx.x, wv = tid >> 6, lane = tid & 63, fr = lane & 15, fq = lane >> 4, rt = wv & 1, kq = wv >> 1;
    float* part = ldsf;
    for (int u = blockIdx.x; u < T / 32; u += gridDim.x) {
        const long t0 = (long)u * 32; f32x4 acc[3];
#pragma unroll
        for (int nt = 0; nt < 3; ++nt) acc[nt] = (f32x4){0.f, 0.f, 0.f, 0.f};
#ifdef CPU_EMU
        for (int nt = 0; nt < 3; ++nt) for (int r = 0; r < 4; ++r) { const int n = 16 * nt + 4 * fq + r; float sacc = 0.f;
            for (int k = kq * 512; k < kq * 512 + 512; ++k) { const long tr = t0 + 16 * rt + fr; const int bb = (int)(tr / S); const float hv = X[(size_t)tr * D + k] * RS[tr] * gN[k] * (1.f + scN[bb * D6 + k]) + shN[bb * D6 + k]; const float hh = bf2f((bf16_t)f2bf(hv)), hl = bf2f((bf16_t)f2bf(hv - hh));
                const float wh = bf2f(WH[(size_t)n * D + k]), wl = bf2f(WL[(size_t)n * D + k]); sacc += hh * wh + hl * wh + hh * wl; }
            acc[nt][r] = sacc; }
#else
        const long tr = t0 + 16 * rt + fr; const int bb = (int)(tr / S); const float rsv = RS[tr]; const int kb = kq * 512 + fq * 8;
        const float* hp = X + (size_t)tr * D + kb; const float* gp_ = gN + kb; const float* scp = scN + bb * D6 + kb; const float* shp = shN + bb * D6 + kb;
#pragma unroll 4
        for (int ks = 0; ks < 16; ++ks) {
            const f32x4 h0 = *(const f32x4*)(hp + ks * 32) * rsv * *(const f32x4*)(gp_ + ks * 32) * (*(const f32x4*)(scp + ks * 32) + 1.f) + *(const f32x4*)(shp + ks * 32);
            const f32x4 h1 = *(const f32x4*)(hp + ks * 32 + 4) * rsv * *(const f32x4*)(gp_ + ks * 32 + 4) * (*(const f32x4*)(scp + ks * 32 + 4) + 1.f) + *(const f32x4*)(shp + ks * 32 + 4); bf16x8 ah, al;
#pragma unroll
            for (int e = 0; e < 4; ++e) { const unsigned b0 = f2bf(h0[e]), b1 = f2bf(h1[e]); ah[e] = (short)b0; ah[4 + e] = (short)b1; al[e] = (short)f2bf(h0[e] - u2f_(b0 << 16)); al[4 + e] = (short)f2bf(h1[e] - u2f_(b1 << 16)); }
#pragma unroll
            for (int nt = 0; nt < 3; ++nt) { const size_t wo = (size_t)(16 * nt + fr) * D + kq * 512 + ks * 32 + fq * 8; const bf16x8 bh = *(const bf16x8*)(WH + wo), bl = *(const bf16x8*)(WL + wo);
                acc[nt] = __builtin_amdgcn_mfma_f32_16x16x32_bf16(bh, ah, acc[nt], 0, 0, 0); acc[nt] = __builtin_amdgcn_mfma_f32_16x16x32_bf16(bh, al, acc[nt], 0, 0, 0); acc[nt] = __builtin_amdgcn_mfma_f32_16x16x32_bf16(bl, ah, acc[nt], 0, 0, 0); }
        }
#endif
#pragma unroll
        for (int nt = 0; nt < 3; ++nt) *(f32x4*)(part + (kq * 32 + 16 * rt + fr) * 48 + 16 * nt + 4 * fq) = acc[nt];
        SYNCTHREADS();
        if (tid < 32) { const long t = t0 + tid; float lg[36];
#pragma unroll
            for (int q = 0; q < 36; ++q) lg[q] = (part[(0 * 32 + tid) * 48 + q] + part[(1 * 32 + tid) * 48 + q]) + (part[(2 * 32 + tid) * 48 + q] + part[(3 * 32 + tid) * 48 + q]) + (q < 4 ? bg[q < 4 ? q : 0] : be[q >= 4 ? q - 4 : 0]);
            int gi = 0; float m = lg[0];
#pragma unroll
            for (int q = 1; q < 4; ++q) if (lg[q] > m) { m = lg[q]; gi = q; }
            float den = 0.f;
#pragma unroll
            for (int q = 0; q < 4; ++q) den += expf(lg[q] - m);
            const float gp = 1.f / den; float el[8];
#pragma unroll
            for (int q = 0; q < 8; ++q) el[q] = gi == 0 ? lg[4 + q] : gi == 1 ? lg[12 + q] : gi == 2 ? lg[20 + q] : lg[28 + q];
            int i1 = 0; float m1 = el[0];
#pragma unroll
            for (int q = 1; q < 8; ++q) if (el[q] > m1) { m1 = el[q]; i1 = q; }
            int i2 = -1; float m2 = 0.f;
#pragma unroll
            for (int q = 0; q < 8; ++q) if (q != i1 && (i2 < 0 || el[q] > m2)) { m2 = el[q]; i2 = q; }
            const float p2 = expf(m2 - m1);
            EID[t * 2] = gi * 8 + i1; EID[t * 2 + 1] = gi * 8 + i2; EWT[t * 2] = gp / (1.f + p2); EWT[t * 2 + 1] = gp * p2 / (1.f + p2);
            atomic_add_i(cnt + gi * 8 + i1, 1); atomic_add_i(cnt + gi * 8 + i2, 1);
        }
        SYNCTHREADS();
    }
}
__device__ __forceinline__ void ph_moe_assign(const Ctx& c, int l, float* ldsf) {
    const int* cnt = CTLW(c) + CW_CNT + l * 64; int* plan = CTLW(c) + CW_PLAN + l * 256; const int* EID = WSI(O_EID); int* fill = CTLW(c) + CW_FILL + l * 64; int* DEST = WSI(O_DEST);
    int* pstart = (int*)ldsf;
    if (threadIdx.x == 0) { int ps = 0, nb = 0; const bool pub = blockIdx.x == 0;
        for (int e = 0; e < NE; ++e) { pstart[e] = ps; if (pub) plan[e] = ps; const int nblk = (cnt[e] + 255) / 256; if (pub) for (int q = 0; q < nblk; ++q) plan[64 + nb + q] = e; nb += nblk; ps += nblk * 256; }
        if (pub) { plan[32] = ps; plan[40] = nb; } }
    SYNCTHREADS();
    for (long i = GT_; i < (long)T * 2; i += GS_) { const int e = EID[i]; const int pos = atomic_add_i(fill + e, 1); DEST[i] = pstart[e] + pos; }
    SYNCTHREADS();
}
__device__ __forceinline__ void ph_moe_gather(const Ctx& c) {
    const int* DEST = WSI(O_DEST); const u32x4* H = (const u32x4*)WSH(O_H); u32x4* XS = (u32x4*)WSH(O_XS);
    for (long i = GT_; i < (long)T * 2 * (D / 8); i += GS_) { const int q = (int)(i % (D / 8)); const long a = i / (D / 8); XS[(size_t)DEST[a] * (D / 8) + q] = H[(size_t)(a >> 1) * (D / 8) + q]; }
}
#ifndef CPU_EMU
#define XB_TMO      128
#define XB_XCNT(j)  (256  + 64 * (j))
#define XB_XSUB(j)  (1280 + 64 * (j))
#define XB_XGEN(j)  (2304 + 64 * (j))
#define XB_TOP      3328
#define XB_TOPGEN   3392
#define XCD_BAR_WORDS 3456
#define XB_SPIN_CAP (1u << 26)
#define LAS __attribute__((address_space(3)))
__device__ __forceinline__ unsigned xb_ld(unsigned* p)              { return __hip_atomic_load(p, __ATOMIC_RELAXED, __HIP_MEMORY_SCOPE_AGENT); }
__device__ __forceinline__ unsigned xb_add(unsigned* p, unsigned v) { return __hip_atomic_fetch_add(p, v, __ATOMIC_RELAXED, __HIP_MEMORY_SCOPE_AGENT); }
__device__ __forceinline__ unsigned xb_xcc_id() { return (unsigned)__builtin_amdgcn_s_getreg((3 << 11) | 20) & 0xFu; }
#define XB_SPIN(cond, bar) do { unsigned _sp = 0; while (cond) { __builtin_amdgcn_s_sleep(1); \
    if ((++_sp & 255u) == 0u) { if (xb_ld(&(bar)[XB_TMO])) break; if (_sp > XB_SPIN_CAP) { atomicAdd(&(bar)[XB_TMO], 1u); break; } } } } while (0)
struct XcdBarrier { unsigned* bar; unsigned x; volatile LAS unsigned* st; };
__device__ __forceinline__ XcdBarrier xcd_barrier_post(unsigned* bar, volatile LAS unsigned* st) {
    XcdBarrier b; b.bar = bar; b.x = xb_xcc_id(); b.st = st;
    if (threadIdx.x == 0) (void)xb_add(&bar[XB_XCNT(b.x)], 1u);
    return b;
}
__device__ __forceinline__ void xcd_barrier_complete(unsigned* bar, unsigned x, unsigned& nloc, unsigned& nx) {
    const unsigned G = gridDim.x * gridDim.y * gridDim.z;
    unsigned sum, cnt, mine, sp = 0u;
    for (;;) {
        sum = 0u; cnt = 0u; mine = 0u;
#pragma unroll
        for (unsigned j = 0; j < 16; ++j) { const unsigned cc = xb_ld(&bar[XB_XCNT(j)]); sum += cc; cnt += (cc > 0u) ? 1u : 0u; mine = (j == x) ? cc : mine; }
        if (sum == G) break;
        __builtin_amdgcn_s_sleep(1);
        if ((++sp & 255u) == 0u) { if (xb_ld(&bar[XB_TMO])) break; if (sp > XB_SPIN_CAP) { atomicAdd(&bar[XB_TMO], 1u); break; } }
    }
    nloc = mine > 0u ? mine : 1u; nx = cnt > 0u ? cnt : 1u;
}
__device__ __forceinline__ void xcd_barrier(const XcdBarrier& b) {
    asm volatile("s_waitcnt vmcnt(0)" ::: "memory");
    __syncthreads();
    if (threadIdx.x == 0) {
        unsigned* bar = b.bar;
        __builtin_amdgcn_s_waitcnt(0);
        unsigned nloc = b.st[0], nx = b.st[1];
        if (nloc == 0u) { xcd_barrier_complete(bar, b.x, nloc, nx); b.st[0] = nloc; b.st[1] = nx; }
        const unsigned old = xb_add(&bar[XB_XSUB(b.x)], 1u);
        const unsigned gen = old / nloc;
        if (old + 1u == (gen + 1u) * nloc) {
            __builtin_amdgcn_fence(__ATOMIC_RELEASE, "agent");
            asm volatile("s_waitcnt vmcnt(0)" ::: "memory");
            const unsigned og = xb_add(&bar[XB_TOP], 1u);
            const unsigned tg = og / nx;
            if (og + 1u == (tg + 1u) * nx) xb_add(&bar[XB_TOPGEN], 1u);
            else XB_SPIN(xb_ld(&bar[XB_TOPGEN]) == tg, bar);
            __builtin_amdgcn_fence(__ATOMIC_ACQUIRE, "agent");
            xb_add(&bar[XB_XGEN(b.x)], 1u);
            asm volatile("s_waitcnt vmcnt(0)" ::: "memory");
        } else {
            XB_SPIN(xb_ld(&bar[XB_XGEN(b.x)]) == gen, bar);
            __builtin_amdgcn_fence(__ATOMIC_ACQUIRE, "agent");
            asm volatile("s_waitcnt vmcnt(0)" ::: "memory");
        }
    }
    __syncthreads();
}
#endif

constexpr int LDS_BYTES = 147456;

__global__ void __launch_bounds__(NT, 2) fwd(Params p) {
#ifdef CPU_EMU
    unsigned char* lds = g_lds; float* ldsf = (float*)g_lds;
#else
    extern __shared__ __attribute__((aligned(16))) unsigned char lds[];
    float* ldsf = (float*)lds;
    volatile LAS unsigned* misc = (volatile LAS unsigned*)((LAS unsigned char*)lds + LDS_BYTES - 64);
    if (threadIdx.x == 0) { misc[0] = 0u; misc[1] = 0u; }
    __syncthreads();
    XcdBarrier bar = xcd_barrier_post((unsigned*)(p.ws + O_CTL) + CW_BAR, misc);
#endif
    Ctx c; c.in = p.in; c.out = p.out; c.ws = p.ws;
    const int lo = p.ph_lo, hi = p.ph_hi; int ph = 0;
    const int G = (int)gridDim.x, cwg = (int)blockIdx.x;
#ifdef CPU_EMU
#define GRID_BAR()
#else
#define GRID_BAR() xcd_barrier(bar)
#endif
#ifndef REPEAT_MASK
#define REPEAT_MASK 0
#endif
#ifndef TIME_PHASE
#define TIME_PHASE -1
#endif
#if TIME_PHASE >= 0 && !defined(CPU_EMU)
    unsigned long long tp0 = 0, tp1 = 0;
#define TP_BEGIN() do { if (ph == TIME_PHASE) tp0 = __builtin_amdgcn_s_memrealtime(); } while (0)
#define TP_END() do { if (ph == TIME_PHASE) tp1 = __builtin_amdgcn_s_memrealtime(); } while (0)
#else
#define TP_BEGIN()
#define TP_END()
#endif
#define PHASE(...) do { if (lo <= ph && ph < hi) { TP_BEGIN(); __VA_ARGS__; if (ph + 1 < hi) { GRID_BAR(); } TP_END(); } ++ph; } while (0)
#define PHASEG(grp, ...) do { if (lo <= ph && ph < hi) { TP_BEGIN(); if ((REPEAT_MASK >> (grp)) & 1) { __VA_ARGS__; GRID_BAR(); } __VA_ARGS__; if (ph + 1 < hi) { GRID_BAR(); } TP_END(); } ++ph; } while (0)
    PHASE(ph_mod(c, ldsf); ph_rope_table(c); ph_convert(c, 0, ldsf));
#define LAYER_BODY(l) do { const float* mod = WSF(O_MOD); \
        const float* xin = l == 0 ? c.in[0] : WSF(O_X1); float* xmid = WSF(O_X0); float* xout = WSF(O_X1); \
        const float* ml = mod + (size_t)l * NB * D6; \
        PHASEG(0, { pg8::Gemm g{D, D, D}; pg8::StaticOrder so; so.init(T, PW, G, cwg, WSH(O_H), WSH(O_WIN), D, D); pg8::EpiP E{WSH(O_P), (unsigned char*)(c.ws + O_G8)}; pg8::gemm_phase(lds, g, so, E); \
            { const int nun_ = (T / 256) * (PW / 256), rem_ = nun_ % G; if (rem_ != 0 && cwg >= rem_) { SYNCTHREADS(); convert_big(c, l, ldsf, J_ALL - convert_tail_tiles(), J_ALL, cwg - rem_, G - rem_); } } }); \
        PHASE(ph_lru<1>(c, l, ldsf); ph_ret_kv(c, ldsf); ph_sgu_norm(c, l); ph_rw_shift(c, l)); \
        PHASE(ph_lru_scan2(c); ph_ret_state(c); ph_sgu_mix(c, l, ldsf); ph_rw_lora(c, l, ldsf)); \
        PHASE(ph_lru_fin(c, ldsf); ph_ret_out(c, ldsf); ph_rw_chunk(c, l, ldsf)); \
        PHASE(ph_rw_seq(c, ldsf)); \
        PHASE(ph_rw_out(c)); \
        PHASEG(1, { pg8::Gemm g{4 * W, 4 * W, 4 * W}; pg8::StaticOrder so; so.init(T, D, G, cwg, WSH(O_YS), WSH(O_WBR), 4 * W, 4 * W); pg8::EpiMerge E{(const unsigned char*)(c.ws + O_G8), WSH(O_MRG)}; pg8::gemm_phase(lds, g, so, E); }); \
        PHASEG(1, { pg8::Gemm g{D, D, D}; pg8::StaticOrder so; so.init(T, D, G, cwg, WSH(O_MRG), WSH(O_WOUT), D, D); pg8::EpiResid E{xin, ml + 2 * D, xmid}; pg8::gemm_phase(lds, g, so, E); }); \
        PHASEG(6, ph_norm(c, xmid, c.in[4] + (size_t)l * D, ml + 3 * D, ml + 4 * D, WSH(O_H), WSF(O_HF))); \
        PHASE(ph_router(c, l, ldsf, xmid, c.in[4] + (size_t)l * D, ml + 3 * D, ml + 4 * D)); \
        PHASE(ph_moe_assign(c, l, ldsf)); \
        PHASEG(6, ph_moe_gather(c)); \
        const int* plan = CTLW(c) + CW_PLAN + l * 256; \
        PHASEG(2, { pg8::Gemm g{D, D, D}; pg8::MoeOrder mo{G, cwg, 4, plan, (const char*)WSH(O_XS), (const char*)WSH(O_WGU), (size_t)256 * D * 2, (size_t)256 * D * 2, (size_t)1024 * D * 2}; pg8::EpiGU E{WSH(O_ACT)}; pg8::gemm_phase(lds, g, mo, E); \
            if (l == 0) { const int nrest_ = plan[40] * 4 - G; if (nrest_ >= 0 && nrest_ < G && cwg >= nrest_) { SYNCTHREADS(); convert_big(c, 1, ldsf, 0, convert_early_tiles(c), cwg - nrest_, G - nrest_); } } }); \
        PHASEG(2, { pg8::Gemm g{512, 512, 512}; pg8::MoeOrder mo{G, cwg, 8, plan, (const char*)WSH(O_ACT), (const char*)WSH(O_WDN), (size_t)256 * 512 * 2, (size_t)256 * 512 * 2, (size_t)D * 512 * 2}; pg8::EpiBf16 E{WSH(O_YE), D}; pg8::gemm_phase(lds, g, mo, E); }); \
        if (l == 0) PHASE(ph_comb_norm<0>(c, xmid, ml + 5 * D, xout, c.in[3] + (size_t)1 * D, mod + (size_t)1 * NB * D6 + 0 * D, mod + (size_t)1 * NB * D6 + 1 * D, WSH(O_H), nullptr); ph_convert(c, 1, ldsf)); \
        else PHASE(ph_comb_norm<1>(c, xmid, ml + 5 * D, xout, c.in[36], nullptr, nullptr, nullptr, c.out)); \
    } while (0)
    PHASE(ph_norm(c, c.in[0], c.in[3], WSF(O_MOD) + 0 * D, WSF(O_MOD) + 1 * D, WSH(O_H), nullptr));
    LAYER_BODY(0);
    LAYER_BODY(1);
#undef LAYER_BODY
#if TIME_PHASE >= 0 && !defined(CPU_EMU)
    if (blockIdx.x == 0) { const unsigned long long te = __builtin_amdgcn_s_memrealtime(), dl = 8ull * (tp1 - tp0); while (__builtin_amdgcn_s_memrealtime() - te < dl) __builtin_amdgcn_s_sleep(8); }
#endif
#undef PHASE
}
}

#ifndef CPU_EMU
extern "C" void kernel_launch(void* const* d_in, const int* in_sizes, int n_in, void* d_out, int out_size, void* d_ws, size_t ws_size, hipStream_t stream) {
    static int grid = 0;
    if (grid == 0) {
        if (n_in != 37 || out_size != T * D || ws_size < WS_END) { fprintf(stderr, "kernel_launch: unexpected shapes (n_in %d out %d ws %zu need %zu)\n", n_in, out_size, ws_size, (size_t)WS_END); grid = -1; return; }
        int dev = 0, cus = 0, per_cu = 0;
        if (hipGetDevice(&dev) != hipSuccess || hipDeviceGetAttribute(&cus, hipDeviceAttributeMultiprocessorCount, dev) != hipSuccess) { grid = -1; return; }
        if (hipFuncSetAttribute((const void*)fwd, hipFuncAttributeMaxDynamicSharedMemorySize, LDS_BYTES) != hipSuccess) { fprintf(stderr, "kernel_launch: hipFuncSetAttribute failed\n"); grid = -1; return; }
        if (hipOccupancyMaxActiveBlocksPerMultiprocessor(&per_cu, (const void*)fwd, NT, LDS_BYTES) != hipSuccess || per_cu < 1) fprintf(stderr, "kernel_launch: occupancy query says %d\n", per_cu);
        (void)hipGetLastError();
        grid = cus;
    }
    if (grid < 0) return;
    (void)in_sizes;
    (void)hipMemsetAsync((char*)d_ws + O_CTL, 0, CTL_BYTES, stream);
    Params p{};
    for (int i = 0; i < 37; ++i) p.in[i] = (const float*)d_in[i];
    p.out = (float*)d_out; p.ws = (unsigned char*)d_ws;
#if ONE_LAUNCH
    p.ph_lo = 0; p.ph_hi = NPH;
    hipLaunchKernelGGL(fwd, dim3(grid), dim3(NT), LDS_BYTES, stream, p);
#else
    for (int k = 0; k < NPH; ++k) { p.ph_lo = k; p.ph_hi = k + 1; hipLaunchKernelGGL(fwd, dim3(grid), dim3(NT), LDS_BYTES, stream, p); }
#endif
}
#endif
```

```cpp
#ifndef CPU_EMU
#include <hip/hip_runtime.h>
#endif
#include <cstdio>
#include <cstdint>
#include <cmath>
#include <cstring>

#ifndef SEQ
#define SEQ 4096
#endif
#ifndef ONE_LAUNCH
#define ONE_LAUNCH 1
#endif

namespace {
constexpr int D = 2048, NB = 2, S = SEQ, T = NB * S, NL = 2, W = 1024;
constexpr int INW = 18816, RF = 3456, D6 = 6 * D;
constexpr int C_LX = 0, C_LG = 1024, C_RQ = 2048, C_RK = 2560, C_RV = 3072, C_RG = 4096, C_SU = 5120, C_SV = 6144, C_RW = 7168;
constexpr int PW = 18944, C_MLP = 10752;
constexpr int NCH = S / 128;
constexpr int NLC = S / 64;
constexpr int NE = 32, CAP = (T * 2 / 256 + NE) * 256, MAXBLK = CAP / 256;
constexpr float EPS = 1e-6f;
constexpr float DECAY_SCALE = 0.60653065971263342f;
constexpr int NT = 512;
constexpr int NPH_LAYER = 15, NPH = 2 + NL * NPH_LAYER;
typedef unsigned short bf16_t;
#ifdef CPU_EMU
typedef float f32x4 __attribute__((vector_size(16)));
typedef unsigned u32x4 __attribute__((vector_size(16)));
#else
typedef float f32x4 __attribute__((ext_vector_type(4)));
typedef unsigned u32x4 __attribute__((ext_vector_type(4)));
typedef short bf16x8 __attribute__((ext_vector_type(8)));
#endif

constexpr size_t al256(size_t x) { return (x + 255) & ~(size_t)255; }
constexpr size_t SZ_X = (size_t)T * D * 4, SZ_W = (size_t)T * W * 4;
constexpr size_t O_CTL = 0, CTL_BYTES = 1u << 20;
constexpr size_t O_MOD = CTL_BYTES;
constexpr size_t O_X0 = O_MOD + al256((size_t)NL * NB * D6 * 4);
constexpr size_t O_X1 = O_X0 + SZ_X;
constexpr size_t O_H = O_X1 + SZ_X;
constexpr size_t O_HF = O_H + SZ_X / 2;
constexpr size_t O_P = O_HF + SZ_X;
constexpr size_t SZ_P = (size_t)T * PW * 2;
constexpr size_t O_XC = O_P + SZ_P;
constexpr size_t O_LA = O_XC + SZ_W, O_LU = O_LA + 2 * SZ_W;
constexpr size_t SZ_LC = (size_t)2 * NB * NLC * W * 4;
constexpr size_t O_LCA = O_LU + 2 * SZ_W, O_LCH = O_LCA + SZ_LC, O_LCI = O_LCH + SZ_LC;
constexpr size_t O_YS = O_LCI + SZ_LC;
constexpr size_t O_SC = O_YS + (size_t)T * 4 * W * 2;
constexpr size_t SZ_KV = (size_t)NB * NCH * 8 * 64 * 128 * 4;
constexpr size_t O_KVF = O_SC, O_KVB = O_KVF + SZ_KV, O_STF = O_KVB + SZ_KV, O_STB = O_STF + SZ_KV;
constexpr size_t O_VN = O_STB + SZ_KV;
constexpr size_t O_FS = O_VN + SZ_W;
constexpr size_t O_DEC = O_FS + al256((size_t)T * RF * 4), O_AA = O_DEC + 2 * SZ_W, O_AKK = O_AA + 2 * SZ_W;
constexpr size_t O_GG = O_AKK, O_YY = O_GG + SZ_W;
constexpr int RCK = 64, NRC = S / RCK;
constexpr size_t O_BON = O_YY + 2 * SZ_W;
constexpr size_t O_PART = O_BON + al256((size_t)2 * T * 16 * 4);
constexpr size_t O_MRG = O_PART + SZ_X;
constexpr size_t O_LOG = O_MRG + SZ_X / 2;
constexpr size_t O_EID = O_LOG + al256((size_t)T * 40 * 4), O_EWT = O_EID + al256((size_t)T * 2 * 4), O_DEST = O_EWT + al256((size_t)T * 2 * 4);
constexpr size_t O_SLOT = O_DEST + al256((size_t)T * 2 * 4);
constexpr size_t O_PST = O_SLOT + al256((size_t)CAP * 4), O_PYT = O_PST + (size_t)64 * NRC * 4096 * 2, O_SVB = O_PYT + (size_t)64 * NRC * 4096 * 2, O_YVB = O_SVB + (size_t)64 * NRC * 4096 * 4;
constexpr size_t O_WIN = O_YVB + (size_t)64 * NRC * 4096 * 4;
constexpr size_t O_WBR = O_WIN + (size_t)PW * D * 2;
constexpr size_t O_WOUT = O_WBR + (size_t)D * 4 * W * 2;
constexpr size_t O_WGU = O_WOUT + (size_t)D * D * 2;
constexpr size_t O_WDN = O_WGU + (size_t)NE * 1024 * D * 2;
constexpr size_t O_G8 = O_WDN + (size_t)NE * D * 512 * 2;
constexpr size_t O_ROPE = O_G8 + (size_t)T * 4 * D;
constexpr size_t O_WLR = O_ROPE + (size_t)T * 64 * 4;
constexpr size_t O_WUT = O_WLR + (size_t)32 * 128 * 128 * 2;
constexpr size_t O_WAT = O_WUT + (size_t)2 * W * 64 * 2;
constexpr size_t O_WGT = O_WAT + (size_t)2 * W * 64 * 2;
constexpr size_t O_WRH = O_WGT + (size_t)W * 128 * 2;
constexpr size_t O_WRL = O_WRH + (size_t)48 * D * 2;
constexpr size_t WS_END0 = O_WRL + (size_t)48 * D * 2;
constexpr size_t SZ_MOE = (size_t)CAP * (D + 512 + D) * 2;
constexpr bool MOE_OVERLAY = SZ_MOE <= SZ_P;
constexpr size_t O_XS = MOE_OVERLAY ? O_P : WS_END0;
constexpr size_t O_ACT = O_XS + (size_t)CAP * D * 2;
constexpr size_t O_YE = O_ACT + (size_t)CAP * 512 * 2;
constexpr size_t WS_END = MOE_OVERLAY ? WS_END0 : WS_END0 + SZ_MOE;
static_assert(SEQ != 4096 || WS_END <= (size_t)2040 * 1024 * 1024, "workspace budget: d_ws is 4 x the largest input = 2048 MiB");
constexpr int CW_BAR = 4096;
constexpr int CW_CNT = 32768;
constexpr int CW_FILL = CW_CNT + NL * 64;
constexpr int CW_PLAN = CW_FILL + NL * 64;
static_assert(MAXBLK <= 160, "plan words");

struct Params { const float* in[37]; float* out; unsigned char* ws; int ph_lo, ph_hi; };

struct Ctx { const float* const* in; float* out; unsigned char* ws; };
#define GT_ ((long)blockIdx.x * NT + threadIdx.x)
#define GS_ ((long)gridDim.x * NT)
#define WSF(off) ((float*)(c.ws + (off)))
#define WSI(off) ((int*)(c.ws + (off)))
#define WSH(off) ((bf16_t*)(c.ws + (off)))
#define CTLW(c) ((int*)((c).ws + O_CTL))

#ifdef CPU_EMU
__device__ __forceinline__ float fexp_(float x) { return expf(x); }
__device__ __forceinline__ float frcp_(float x) { return 1.f / x; }
__device__ __forceinline__ float frsq_(float x) { return 1.f / sqrtf(x); }
#else
__device__ __forceinline__ float fexp_(float x) { return __builtin_amdgcn_exp2f(x * 1.4426950408889634f); }
__device__ __forceinline__ float frcp_(float x) { return __builtin_amdgcn_rcpf(x); }
__device__ __forceinline__ float frsq_(float x) { return __builtin_amdgcn_rsqf(x); }
#endif
__device__ __forceinline__ float sigmoidf_(float x) { return frcp_(1.f + fexp_(-x)); }
__device__ __forceinline__ float siluf_(float x) { return x * frcp_(1.f + fexp_(-x)); }
__device__ __forceinline__ float tanhf_(float x) { return 1.f - 2.f * frcp_(1.f + fexp_(2.f * x)); }
__device__ __forceinline__ float geluf_(float x) { return 0.5f * x * (1.f + tanhf_(0.7978845608028654f * (x + 0.044715f * x * x * x))); }
__device__ __forceinline__ float softplusf_(float x) { return x > 0.f ? x + log1pf(expf(-x)) : log1pf(expf(x)); }
__device__ __forceinline__ float loggamma_(int h) { return log1pf(-exp2f(-5.f - (float)h)); }
__device__ __forceinline__ unsigned f2u_(float f) { unsigned u; memcpy(&u, &f, 4); return u; }
__device__ __forceinline__ float u2f_(unsigned u) { float f; memcpy(&f, &u, 4); return f; }
__device__ __forceinline__ float bf2f(bf16_t v) { return u2f_((unsigned)v << 16); }
#ifdef CPU_EMU
__device__ __forceinline__ unsigned f2bf(float f) { const unsigned u = f2u_(f); return (u + 0x7fffu + ((u >> 16) & 1u)) >> 16; }
__device__ __forceinline__ unsigned pk2(float lo, float hi) { return f2bf(lo) | (f2bf(hi) << 16); }
#else
typedef __attribute__((ext_vector_type(2))) __bf16 hwbf2_t; typedef __attribute__((ext_vector_type(2))) float hwf2_t;
__device__ __forceinline__ unsigned f2bf(float f) { const __bf16 s = (__bf16)f; return (unsigned)__builtin_bit_cast(unsigned short, s); }
__device__ __forceinline__ unsigned pk2(float lo, float hi) { const hwf2_t v = {lo, hi}; return __builtin_bit_cast(unsigned, __builtin_convertvector(v, hwbf2_t)); }
#endif
__device__ __forceinline__ float bflo(unsigned w) { return u2f_(w << 16); }
__device__ __forceinline__ float bfhi(unsigned w) { return u2f_(w & 0xffff0000u); }
__device__ __forceinline__ int atomic_add_i(int* p, int v) {
#ifdef CPU_EMU
    return __atomic_fetch_add(p, v, __ATOMIC_RELAXED);
#else
    return atomicAdd(p, v);
#endif
}
#define PF(P, r, col) bf2f((P)[(size_t)(r) * PW + (col)])
#ifdef CPU_EMU
#define SYNCTHREADS() emu_syncthreads()
#define SHFL_XOR(v, m) emu_shfl_xor(v, m)
#else
#define SYNCTHREADS() __syncthreads()
#define SHFL_XOR(v, m) __shfl_xor(v, m)
#endif
#ifdef CPU_EMU
__device__ __forceinline__ float wave_sum(float v) {
    for (int o = 1; o < 64; o <<= 1) v += SHFL_XOR(v, o);
    return v;
}
#else
__device__ __forceinline__ float wave_sum(float x) {
    x += __builtin_bit_cast(float, __builtin_amdgcn_update_dpp(0, __builtin_bit_cast(int, x), 0xB1, 0xF, 0xF, true));
    x += __builtin_bit_cast(float, __builtin_amdgcn_update_dpp(0, __builtin_bit_cast(int, x), 0x4E, 0xF, 0xF, true));
    x += __builtin_bit_cast(float, __builtin_amdgcn_update_dpp(0, __builtin_bit_cast(int, x), 0x141, 0xF, 0xF, true));
    x += __builtin_bit_cast(float, __builtin_amdgcn_update_dpp(0, __builtin_bit_cast(int, x), 0x140, 0xF, 0xF, true));
    const int xi = __builtin_bit_cast(int, x);
    return (__builtin_bit_cast(float, __builtin_amdgcn_readlane(xi, 0)) + __builtin_bit_cast(float, __builtin_amdgcn_readlane(xi, 16))) + (__builtin_bit_cast(float, __builtin_amdgcn_readlane(xi, 32)) + __builtin_bit_cast(float, __builtin_amdgcn_readlane(xi, 48)));
}
#endif
__device__ __forceinline__ f32x4 ld_bf4(const bf16_t* p) { const unsigned long long q = *(const unsigned long long*)p; const unsigned lo = (unsigned)q, hi = (unsigned)(q >> 32); return (f32x4){bflo(lo), bfhi(lo), bflo(hi), bfhi(hi)}; }
__device__ __forceinline__ void st_bf4(bf16_t* p, const f32x4 v) { *(unsigned long long*)p = (unsigned long long)pk2(v[0], v[1]) | ((unsigned long long)pk2(v[2], v[3]) << 32); }

template <int KT, int NTL>
__device__ __forceinline__ void wave_mma(f32x4 (&acc)[NTL], const bf16_t* A, int lda, const bf16_t* Bt, int ldb) {
    const int lane = threadIdx.x & 63, fr = lane & 15, fq = lane >> 4;
#ifdef CPU_EMU
    for (int nt = 0; nt < NTL; ++nt) for (int r = 0; r < 4; ++r) { float sacc = 0.f; const bf16_t* a = A + fr * lda; const bf16_t* b = Bt + (16 * nt + 4 * fq + r) * ldb;
        for (int k = 0; k < 32 * KT; ++k) sacc += bf2f(a[k]) * bf2f(b[k]);
        acc[nt][r] += sacc; }
#else
#pragma unroll
    for (int kt = 0; kt < KT; ++kt) {
        const bf16x8 af = *(const bf16x8*)(A + fr * lda + kt * 32 + fq * 8);
#pragma unroll
        for (int nt = 0; nt < NTL; ++nt) { const bf16x8 bfr = *(const bf16x8*)(Bt + (16 * nt + fr) * ldb + kt * 32 + fq * 8);
            acc[nt] = __builtin_amdgcn_mfma_f32_16x16x32_bf16(bfr, af, acc[nt], 0, 0, 0); }
    }
#endif
}
__device__ __forceinline__ void ph_mod(const Ctx& c, float* ldsf) {
    const float* cc = c.in[1]; const float* aw = c.in[5]; const float* ab = c.in[6]; float* mod = WSF(O_MOD);
    float* scs = ldsf; float* part = ldsf + NB * D; const int tid = threadIdx.x, c4 = (tid & 31) * 4, kq = tid >> 5;
    for (int i = tid; i < NB * D; i += NT) scs[i] = siluf_(cc[i]);
    SYNCTHREADS();
    for (int u = blockIdx.x; u < NL * (D6 / 128); u += gridDim.x) {
        const int l = u / (D6 / 128), j0 = (u % (D6 / 128)) * 128;
        const float* w = aw + (size_t)l * D * D6 + j0 + c4; f32x4 a0 = (f32x4){0.f, 0.f, 0.f, 0.f}, a1 = a0;
#pragma unroll 8
        for (int k = kq * 128; k < kq * 128 + 128; ++k) { const f32x4 wv = *(const f32x4*)(w + (size_t)k * D6); a0 += wv * scs[k]; a1 += wv * scs[D + k]; }
        *(f32x4*)(part + (kq * 2 + 0) * 128 + c4) = a0; *(f32x4*)(part + (kq * 2 + 1) * 128 + c4) = a1;
        SYNCTHREADS();
        if (tid < 256) { const int b = tid >> 7, col = tid & 127; float sacc = 0.f;
#pragma unroll
            for (int q = 0; q < 16; ++q) sacc += part[(q * 2 + b) * 128 + col];
            mod[((size_t)l * NB + b) * D6 + j0 + col] = sacc + ab[l * D6 + j0 + col]; }
        SYNCTHREADS();
    }
}
__device__ __forceinline__ void ph_norm(const Ctx& c, const float* x, const float* g, const float* sh, const float* sc, bf16_t* hb, float* hf) {
    const int lane = threadIdx.x & 63, gw = blockIdx.x * (NT / 64) + (threadIdx.x >> 6), ngw = gridDim.x * (NT / 64);
    for (int t0 = gw * 2; t0 < T; t0 += ngw * 2) {
        f32x4 v[2][8]; float ss[2] = {0.f, 0.f};
#pragma unroll
        for (int r = 0; r < 2; ++r)
#pragma unroll
            for (int j = 0; j < 8; ++j) v[r][j] = *(const f32x4*)(x + (size_t)(t0 + r) * D + (j * 64 + lane) * 4);
#pragma unroll
        for (int r = 0; r < 2; ++r) {
#pragma unroll
            for (int j = 0; j < 8; ++j) ss[r] += (v[r][j][0] * v[r][j][0] + v[r][j][1] * v[r][j][1]) + (v[r][j][2] * v[r][j][2] + v[r][j][3] * v[r][j][3]);
            const int t = t0 + r, b = t / S; const float rs = 1.f / sqrtf(wave_sum(ss[r]) * (1.f / D) + EPS);
#pragma unroll
            for (int j = 0; j < 8; ++j) { const int col = (j * 64 + lane) * 4;
                const f32x4 o = v[r][j] * rs * *(const f32x4*)(g + col) * (*(const f32x4*)(sc + b * D6 + col) + 1.f) + *(const f32x4*)(sh + b * D6 + col);
                st_bf4(hb + (size_t)t * D + col, o); }
            if (hf && lane == 0) hf[t] = rs;
        }
    }
}
template <int MODE>
__device__ __forceinline__ void ph_comb_norm(const Ctx& c, const float* xmid, const float* g2, float* xout, const float* g, const float* sh, const float* sc, bf16_t* hb, float* outp) {
    const bf16_t* YE = WSH(O_YE); const float* EWT = WSF(O_EWT); const int* DEST = WSI(O_DEST);
    const int lane = threadIdx.x & 63, gw = blockIdx.x * (NT / 64) + (threadIdx.x >> 6), ngw = gridDim.x * (NT / 64);
    for (int t = gw; t < T; t += ngw) {
        const int b = t / S; const float w0 = EWT[t * 2], w1 = EWT[t * 2 + 1]; const bf16_t* y0 = YE + (size_t)DEST[t * 2] * D; const bf16_t* y1 = YE + (size_t)DEST[t * 2 + 1] * D;
        f32x4 v[8]; float ss = 0.f;
#pragma unroll
        for (int j = 0; j < 8; ++j) { const int col = (j * 64 + lane) * 4;
            v[j] = *(const f32x4*)(xmid + (size_t)t * D + col) + *(const f32x4*)(g2 + b * D6 + col) * (ld_bf4(y0 + col) * w0 + ld_bf4(y1 + col) * w1);
            if (MODE == 0) *(f32x4*)(xout + (size_t)t * D + col) = v[j];
            ss += (v[j][0] * v[j][0] + v[j][1] * v[j][1]) + (v[j][2] * v[j][2] + v[j][3] * v[j][3]); }
        const float rs = 1.f / sqrtf(wave_sum(ss) * (1.f / D) + EPS);
#pragma unroll
        for (int j = 0; j < 8; ++j) { const int col = (j * 64 + lane) * 4;
            if (MODE == 0) st_bf4(hb + (size_t)t * D + col, v[j] * rs * *(const f32x4*)(g + col) * (*(const f32x4*)(sc + b * D6 + col) + 1.f) + *(const f32x4*)(sh + b * D6 + col));
            else *(f32x4*)(outp + (size_t)t * D + col) = v[j] * rs * *(const f32x4*)(g + col); }
    }
}

struct CvtItem { const float* Wp; int ldw; bf16_t* WT; int ldt; int drow, k0, n0; };
constexpr int I_IN = 32 * (INW / 32), I_BR = 4 * 16 * 64, I_OUT = 32 * 64, I_GU = NE * 32 * 32, I_DN = NE * 8 * 64, I_LR = 32 * 8, I_WU = 2 * 32, I_WG = 64, I_BIG = I_IN + I_BR + I_OUT + I_GU + I_DN, I_ALL = I_BIG + I_LR + 2 * I_WU + I_WG;
__device__ __forceinline__ CvtItem cvt_decode(const Ctx& c, int l, int it) {
    CvtItem r;
    if (it < I_IN) { const int kb = it / (INW / 32), nb = it % (INW / 32); r.n0 = nb * 32; r.k0 = kb * 64; r.Wp = c.in[7] + (size_t)l * D * INW; r.ldw = INW; r.WT = WSH(O_WIN); r.ldt = D; r.drow = r.n0 < 10624 ? r.n0 : r.n0 + 128; return r; }
    it -= I_IN;
    if (it < I_BR) { const int sgm = it / 1024, q = it % 1024, kb = q / 64, nb = q % 64; r.n0 = nb * 32; r.k0 = kb * 64; r.Wp = c.in[28] + ((size_t)l * 4 + sgm) * W * D; r.ldw = D; r.WT = WSH(O_WBR) + sgm * W; r.ldt = 4 * W; r.drow = r.n0; return r; }
    it -= I_BR;
    if (it < I_OUT) { const int kb = it / 64, nb = it % 64; r.n0 = nb * 32; r.k0 = kb * 64; r.Wp = c.in[29] + (size_t)l * D * D; r.ldw = D; r.WT = WSH(O_WOUT); r.ldt = D; r.drow = r.n0; return r; }
    it -= I_OUT;
    if (it < I_GU) { const int e = it / 1024, q = it % 1024, kb = q / 32, nb = q % 32; r.n0 = nb * 32; r.k0 = kb * 64; r.Wp = c.in[34] + ((size_t)l * NE + e) * D * 1024; r.ldw = 1024; r.WT = WSH(O_WGU) + (size_t)e * 1024 * D; r.ldt = D;
        r.drow = r.n0 < 512 ? (r.n0 / 128) * 256 + (r.n0 % 128) : ((r.n0 - 512) / 128) * 256 + 128 + ((r.n0 - 512) % 128); return r; }
    it -= I_GU;
    if (it < I_DN) { const int e = it / 512, q = it % 512, kb = q / 64, nb = q % 64; r.n0 = nb * 32; r.k0 = kb * 64; r.Wp = c.in[35] + ((size_t)l * NE + e) * 512 * D; r.ldw = D; r.WT = WSH(O_WDN) + (size_t)e * D * 512; r.ldt = 512; r.drow = r.n0; return r; }
    it -= I_DN;
    if (it < I_LR) { const int m = it / 8, q = it % 8, kb = q / 4, nb = q % 4, z = m >> 4, ty = (m >> 3) & 1, n = m & 7; r.n0 = nb * 32; r.k0 = kb * 64; r.Wp = c.in[ty ? 12 : 10] + (((size_t)l * 2 + z) * 8 + n) * 128 * 128; r.ldw = 128;
        r.WT = WSH(O_WLR) + (size_t)m * 128 * 128; r.ldt = 128; r.drow = r.n0; return r; }
    it -= I_LR;
    if (it < 2 * I_WU) { const int ua = it / I_WU, q = it % I_WU, z = q / 32, nb = q % 32; r.n0 = nb * 32; r.k0 = 0; r.Wp = c.in[ua ? 23 : 21] + ((size_t)l * 2 + z) * 64 * W; r.ldw = W; r.WT = WSH(ua ? O_WAT : O_WUT) + (size_t)z * W * 64; r.ldt = 64; r.drow = r.n0; return r; }
    it -= 2 * I_WU;
    { const int kb = it / 32, nb = it % 32; r.n0 = nb * 32; r.k0 = kb * 64; r.Wp = c.in[24] + (size_t)l * 128 * W; r.ldw = W; r.WT = WSH(O_WGT); r.ldt = 128; r.drow = r.n0; return r; }
}
constexpr int J_IN = 16 * (INW / 128), J_BR = 4 * 8 * 16, J_OUT = 16 * 16, J_GU = NE * 16 * 8, J_DN = NE * 4 * 16, J_ALL = J_IN + J_BR + J_OUT + J_GU + J_DN;
__device__ __forceinline__ CvtItem cvt_decode_big(const Ctx& c, int l, int it) {
    CvtItem r;
    if (it < J_IN) { const int kb = it / (INW / 128), nb = it % (INW / 128); r.n0 = nb * 128; r.k0 = kb * 128; r.Wp = c.in[7] + (size_t)l * D * INW; r.ldw = INW; r.WT = WSH(O_WIN); r.ldt = D; r.drow = r.n0 < 10624 ? r.n0 : r.n0 + 128; return r; }
    it -= J_IN;
    if (it < J_BR) { const int sgm = it / 128, q = it % 128, kb = q / 16, nb = q % 16; r.n0 = nb * 128; r.k0 = kb * 128; r.Wp = c.in[28] + ((size_t)l * 4 + sgm) * W * D; r.ldw = D; r.WT = WSH(O_WBR) + sgm * W; r.ldt = 4 * W; r.drow = r.n0; return r; }
    it -= J_BR;
    if (it < J_OUT) { const int kb = it / 16, nb = it % 16; r.n0 = nb * 128; r.k0 = kb * 128; r.Wp = c.in[29] + (size_t)l * D * D; r.ldw = D; r.WT = WSH(O_WOUT); r.ldt = D; r.drow = r.n0; return r; }
    it -= J_OUT;
    if (it < J_GU) { const int e = it / 128, q = it % 128, kb = q / 8, nb = q % 8; r.n0 = nb * 128; r.k0 = kb * 128; r.Wp = c.in[34] + ((size_t)l * NE + e) * D * 1024; r.ldw = 1024; r.WT = WSH(O_WGU) + (size_t)e * 1024 * D; r.ldt = D;
        r.drow = r.n0 < 512 ? (r.n0 / 128) * 256 : ((r.n0 - 512) / 128) * 256 + 128; return r; }
    it -= J_GU;
    { const int e = it / 64, q = it % 64, kb = q / 16, nb = q % 16; r.n0 = nb * 128; r.k0 = kb * 128; r.Wp = c.in[35] + ((size_t)l * NE + e) * 512 * D; r.ldw = D; r.WT = WSH(O_WDN) + (size_t)e * D * 512; r.ldt = 512; r.drow = r.n0; return r; }
}
__device__ __forceinline__ void convert_big(const Ctx& c, int l, float* ldsf, int first, int last, int widx, int wcnt) {
    const int tid = threadIdx.x, lr = tid >> 5, lc = (tid & 31) * 4;
    f32x4 rg[8]; int it = first + widx; CvtItem r;
    if (it < last) { r = cvt_decode_big(c, l, it);
#pragma unroll
        for (int i = 0; i < 8; ++i) rg[i] = *(const f32x4*)(r.Wp + (size_t)(r.k0 + lr + 16 * i) * r.ldw + r.n0 + lc); }
    for (; it < last; it += wcnt) {
#pragma unroll
        for (int i = 0; i < 8; ++i) { float* dp = ldsf + (lr + 16 * i) * 129 + lc; dp[0] = rg[i][0]; dp[1] = rg[i][1]; dp[2] = rg[i][2]; dp[3] = rg[i][3]; }
        const CvtItem cur = r; const int nx = it + wcnt;
        if (nx < last) { r = cvt_decode_big(c, l, nx);
#pragma unroll
            for (int i = 0; i < 8; ++i) rg[i] = *(const f32x4*)(r.Wp + (size_t)(r.k0 + lr + 16 * i) * r.ldw + r.n0 + lc); }
        SYNCTHREADS();
#pragma unroll
        for (int q = 0; q < 4; ++q) { const int id = tid + NT * q, n = id >> 4, k8 = (id & 15) * 8; const float* sp = ldsf + k8 * 129 + n;
            u32x4 o; o[0] = pk2(sp[0 * 129], sp[1 * 129]); o[1] = pk2(sp[2 * 129], sp[3 * 129]); o[2] = pk2(sp[4 * 129], sp[5 * 129]); o[3] = pk2(sp[6 * 129], sp[7 * 129]);
            *(u32x4*)(cur.WT + (size_t)(cur.drow + n) * cur.ldt + cur.k0 + k8) = o; }
        SYNCTHREADS();
    }
}
__device__ __forceinline__ int convert_tail_tiles() { const int nun = (T / 256) * (PW / 256), G = (int)gridDim.x, rem = nun % G; return rem == 0 ? 0 : (G - rem) * 10 < J_GU + J_DN ? (G - rem) * 10 : J_GU + J_DN; }
__device__ __forceinline__ int convert_early_tiles(const Ctx& c) { const int G = (int)gridDim.x, nrest = (CTLW(c) + CW_PLAN)[40] * 4 - G; return (nrest >= 0 && nrest < G) ? ((G - nrest) * 12 < J_IN ? (G - nrest) * 12 : J_IN) : 0; }
__device__ __forceinline__ void ph_convert(const Ctx& c, int l, float* ldsf) {
    const int lane = threadIdx.x & 63, wave = threadIdx.x >> 6; const int gw = blockIdx.x * (NT / 64) + wave, ngw = gridDim.x * (NT / 64);
    convert_big(c, l, ldsf, l == 1 ? convert_early_tiles(c) : 0, J_ALL - convert_tail_tiles(), (int)blockIdx.x, (int)gridDim.x);
#ifdef CPU_EMU
    if (lane == 0) for (int it = I_BIG + gw; it < I_ALL; it += ngw) { const CvtItem r = cvt_decode(c, l, it);
        for (int kk = 0; kk < 64; ++kk) for (int nn = 0; nn < 32; ++nn) r.WT[(size_t)(r.drow + nn) * r.ldt + r.k0 + kk] = (bf16_t)f2bf(r.Wp[(size_t)(r.k0 + kk) * r.ldw + r.n0 + nn]); }
#else
    float* scr = ldsf + wave * (64 * 33 + 16);
    for (int it = I_BIG + gw; it < I_ALL; it += ngw) {
        const CvtItem r = cvt_decode(c, l, it);
#pragma unroll 8
        for (int i = 0; i < 32; ++i) { const int kk = 2 * i + (lane >> 5); scr[kk * 33 + (lane & 31)] = r.Wp[(size_t)(r.k0 + kk) * r.ldw + r.n0 + (lane & 31)]; }
        asm volatile("s_waitcnt lgkmcnt(0)" ::: "memory");
        const int cc = lane & 7;
#pragma unroll
        for (int j = 0; j < 4; ++j) { const int n = (lane >> 3) + 8 * j; const float* sp = scr + (8 * cc) * 33 + n;
            u32x4 o; o[0] = pk2(sp[0 * 33], sp[1 * 33]); o[1] = pk2(sp[2 * 33], sp[3 * 33]); o[2] = pk2(sp[4 * 33], sp[5 * 33]); o[3] = pk2(sp[6 * 33], sp[7 * 33]);
            *(u32x4*)(r.WT + (size_t)(r.drow + n) * r.ldt + r.k0 + 8 * cc) = o; }
        asm volatile("s_waitcnt lgkmcnt(0)" ::: "memory");
    }
#endif
    { const float* wg = c.in[30] + (size_t)l * D * 4; const float* we = c.in[32] + (size_t)l * D * 32; bf16_t* wh = WSH(O_WRH); bf16_t* wl = WSH(O_WRL);
      for (long i = GT_; i < (long)48 * D; i += GS_) { const int n = (int)(i / D), k = (int)(i % D); const float w = n < 4 ? wg[k * 4 + n] : n < 36 ? we[k * 32 + (n - 4)] : 0.f; const unsigned hb = f2bf(w); wh[i] = (bf16_t)hb; wl[i] = (bf16_t)f2bf(w - bf2f((bf16_t)hb)); } }
    for (long i = GT_; i < (long)128 * D / 2; i += GS_) ((unsigned*)(WSH(O_WIN) + (size_t)10624 * D))[i] = 0u;
}

namespace pg8 {
constexpr int BM = 256, BK = 64, HALF = 128, HTB = HALF * BK * 2, STAGE_BYTES = 8 * HTB;
__host__ __device__ __forceinline__ int lds_byte(int r, int cc) { const int st = (r >> 4) * 2 + (cc >> 5), rr = r & 15, c2 = cc & 31, ob = rr * 64 + c2 * 2; return st * 1024 + (ob ^ (((ob >> 9) & 1) << 5)); }
__host__ __device__ __forceinline__ void stage_rc(int b, int& R, int& C) { const int st = b / 1024, sb = b % 1024, swz = sb ^ (((sb >> 9) & 1) << 5); R = (st >> 1) * 16 + swz / 64; C = (st & 1) * 32 + (swz % 64) / 2; }
__host__ __device__ __forceinline__ int perm32(int rho) { const int n = rho >> 4, i = rho & 15; return 8 * (i >> 2) + 4 * n + (i & 3); }
struct Unit { int pm, pn, aux; const char* A; const char* B; };
struct Gemm { int K, lda, ldb; };

template <class Epi, class Sched>
__device__ __forceinline__ void gemm_phase(unsigned char* lds_, const Gemm g, const Sched& S, const Epi& E) {
#ifdef CPU_EMU
    if (threadIdx.x != 0) return;
    Unit u; const int K = g.K;
    float* Af = (float*)malloc((size_t)256 * K * 4); float* Bf = (float*)malloc((size_t)256 * K * 4); float* Cf = (float*)malloc(256 * 256 * 4);
    for (int i = 0; S.next(i, u); ++i) {
        const bf16_t* A = (const bf16_t*)u.A; const bf16_t* B = (const bf16_t*)u.B;
        for (int r = 0; r < 256; ++r) for (int k = 0; k < K; ++k) { Af[(size_t)r * K + k] = bf2f(A[(size_t)r * g.lda + k]); Bf[(size_t)r * K + k] = bf2f(B[(size_t)r * g.ldb + k]); }
        const int nseg = Epi::SEGT > 0 ? K / (Epi::SEGT * 64) : 1, kseg = K / nseg;
        for (int wid = 0; wid < 8; ++wid) for (int lane = 0; lane < 64; ++lane) {
            const int wr = wid >> 2, wc = wid & 3, fr = lane & 15, fq = lane >> 4; f32x4 acc[2][2][4][2];
            for (int ai = 0; ai < 2; ++ai) for (int bj = 0; bj < 2; ++bj) for (int m = 0; m < 4; ++m) for (int n = 0; n < 2; ++n) for (int j = 0; j < 4; ++j) acc[ai][bj][m][n][j] = 0.f;
            for (int sg = 0; sg < nseg; ++sg) {
                for (int ai = 0; ai < 2; ++ai) for (int bj = 0; bj < 2; ++bj) for (int m = 0; m < 4; ++m) for (int n = 0; n < 2; ++n) for (int j = 0; j < 4; ++j) {
                    const int r = 128 * ai + 64 * wr + 16 * m + fr, cc = 128 * bj + 32 * wc + (Epi::PERM ? 8 * fq + 4 * n + j : 16 * n + 4 * fq + j);
                    const float* a = Af + (size_t)r * K + sg * kseg; const float* b = Bf + (size_t)cc * K + sg * kseg; float sacc = 0.f; for (int k = 0; k < kseg; ++k) sacc += a[k] * b[k];
                    acc[ai][bj][m][n][j] += sacc; }
                if constexpr (Epi::SEGT > 0) { if (sg + 1 < nseg) E.segment(acc, u, sg, wr, wc, fr, fq); }
            }
            E(acc, u, wr, wc, fr, fq);
        }
    }
    free(Af); free(Bf); free(Cf);
#else
    typedef __attribute__((address_space(3))) unsigned char* ldsp_t;
    ldsp_t lds = (ldsp_t)lds_;
    const int tid = threadIdx.x, wid = __builtin_amdgcn_readfirstlane(tid >> 6), lane = tid & 63, wr = wid >> 2, wc = wid & 3, fr = lane & 15, fq = lane >> 4;
    const int K = g.K, nt = K / BK;
    unsigned voffA[2], voffB[2];
#pragma unroll
    for (int i = 0; i < 2; ++i) { int R, C; stage_rc(tid * 16 + i * 8192, R, C); const int Rb = Epi::PERM ? ((R & ~31) + perm32(R & 31)) : R;
        voffA[i] = (unsigned)(R * g.lda + C) * 2u; voffB[i] = (unsigned)(Rb * g.ldb + C) * 2u; }
    const size_t kstep = (size_t)(BK * 2);
    const size_t hstepA = (size_t)HALF * g.lda * 2, hstepB = (size_t)HALF * g.ldb * 2;
    const unsigned ldsw = (unsigned)wid * 1024u;
    const int aoff = lds_byte(wr * 64 + fr, fq * 8), boff = lds_byte(wc * 32 + fr, fq * 8);
#define PG8_SA(b, h) (((b) * 2 + (h)) * HTB)
#define PG8_SB(b, h) ((4 + (b) * 2 + (h)) * HTB)
#define PG8_STAGE(bufoff, gbase, voff) do { _Pragma("unroll") for (int _i = 0; _i < 2; ++_i) \
        __builtin_amdgcn_global_load_lds((const unsigned*)((const char*)(gbase) + (voff)[_i]), (__attribute__((address_space(3))) unsigned*)(lds + (bufoff) + ldsw + _i * 8192), 16, 0, 0); } while (0)
#define PG8_LDA(dst, b, h) do { _Pragma("unroll") for (int m = 0; m < 4; ++m) _Pragma("unroll") for (int k = 0; k < 2; ++k) dst[m][k] = *(const __attribute__((address_space(3))) bf16x8*)(lds + PG8_SA(b, h) + aoff + m * 2048 + k * 1024); } while (0)
#define PG8_LDB(dst, b, h) do { _Pragma("unroll") for (int n = 0; n < 2; ++n) _Pragma("unroll") for (int k = 0; k < 2; ++k) dst[n][k] = *(const __attribute__((address_space(3))) bf16x8*)(lds + PG8_SB(b, h) + boff + n * 2048 + k * 1024); } while (0)
#define PG8_MMA(ai, bj, At, Bt) do { __builtin_amdgcn_s_setprio(1); _Pragma("unroll") for (int m = 0; m < 4; ++m) _Pragma("unroll") for (int n = 0; n < 2; ++n) _Pragma("unroll") for (int k = 0; k < 2; ++k) \
        acc[ai][bj][m][n] = __builtin_amdgcn_mfma_f32_16x16x32_bf16(Bt[n][k], At[m][k], acc[ai][bj][m][n], 0, 0, 0); __builtin_amdgcn_s_setprio(0); } while (0)
#define PG8_WAIT_V(n) asm volatile("s_waitcnt vmcnt(" #n ")" ::: "memory")
#define PG8_WAIT_L(n) asm volatile("s_waitcnt lgkmcnt(" #n ")" ::: "memory")
#define PG8_BAR __builtin_amdgcn_s_barrier()
#define PG8_SCHED __builtin_amdgcn_sched_barrier(0)
    Unit cur, nxt; int ui = 0;
    if (!S.next(0, cur)) return;
    f32x4 acc[2][2][4][2];
#pragma unroll
    for (int a = 0; a < 2; ++a)
#pragma unroll
        for (int b = 0; b < 2; ++b)
#pragma unroll
            for (int m = 0; m < 4; ++m)
#pragma unroll
                for (int n = 0; n < 2; ++n) acc[a][b][m][n] = (f32x4){0.f, 0.f, 0.f, 0.f};
    bf16x8 At[4][2], B0[2][2], B1[2][2];
    const char* cA = cur.A; const char* cB = cur.B;
    S.a_ready(cur);
    PG8_STAGE(PG8_SB(0, 0), cB, voffB); PG8_STAGE(PG8_SA(0, 0), cA, voffA); PG8_STAGE(PG8_SB(0, 1), cB + hstepB, voffB); PG8_STAGE(PG8_SA(0, 1), cA + hstepA, voffA);
    if (wr == 1) PG8_BAR;
    PG8_WAIT_V(4); PG8_BAR;
    PG8_STAGE(PG8_SB(1, 0), cB + kstep, voffB); PG8_STAGE(PG8_SA(1, 0), cA + kstep, voffA); PG8_STAGE(PG8_SB(1, 1), cB + hstepB + kstep, voffB);
    PG8_WAIT_V(6); PG8_BAR;
    for (;;) {
        const bool has_next = S.next(ui + 1, nxt);
        const char* nA = has_next ? nxt.A : cA; const char* nB = has_next ? nxt.B : cB;
        for (int t = 0; t < nt; t += 2) {
            const bool last = (t == nt - 2);
            const char* a1 = cA + (size_t)(t + 1) * kstep;
            const char* a2 = last ? nA : cA + (size_t)(t + 2) * kstep; const char* b2 = last ? nB : cB + (size_t)(t + 2) * kstep;
            const char* a3 = a2 + kstep; const char* b3 = b2 + kstep;
            if (last && has_next) S.a_ready(nxt);
            PG8_LDB(B0, 0, 0); PG8_SCHED; PG8_LDA(At, 0, 0); PG8_STAGE(PG8_SA(1, 1), a1 + hstepA, voffA);
            PG8_WAIT_L(8); PG8_BAR; PG8_WAIT_L(0); PG8_MMA(0, 0, At, B0); PG8_BAR; PG8_SCHED;
            PG8_LDB(B1, 0, 1); PG8_STAGE(PG8_SB(0, 0), b2, voffB);
            PG8_BAR; PG8_WAIT_L(0); PG8_MMA(0, 1, At, B1); PG8_BAR;
            PG8_LDA(At, 0, 1); PG8_STAGE(PG8_SA(0, 0), a2, voffA);
            PG8_BAR; PG8_WAIT_L(0); PG8_MMA(1, 0, At, B0); PG8_BAR; PG8_SCHED;
            PG8_STAGE(PG8_SB(0, 1), b2 + hstepB, voffB);
            PG8_WAIT_V(6); PG8_BAR; PG8_MMA(1, 1, At, B1); PG8_BAR;
            PG8_LDB(B0, 1, 0); PG8_SCHED; PG8_LDA(At, 1, 0); PG8_STAGE(PG8_SA(0, 1), a2 + hstepA, voffA);
            PG8_WAIT_L(8); PG8_BAR; PG8_WAIT_L(0); PG8_MMA(0, 0, At, B0); PG8_BAR; PG8_SCHED;
            PG8_LDB(B1, 1, 1); PG8_STAGE(PG8_SB(1, 0), b3, voffB);
            PG8_BAR; PG8_WAIT_L(0); PG8_MMA(0, 1, At, B1); PG8_BAR;
            PG8_LDA(At, 1, 1); PG8_STAGE(PG8_SA(1, 0), a3, voffA);
            PG8_BAR; PG8_WAIT_L(0); PG8_MMA(1, 0, At, B0); PG8_BAR; PG8_SCHED;
            PG8_STAGE(PG8_SB(1, 1), b3 + hstepB, voffB);
            PG8_WAIT_V(6); PG8_BAR; PG8_MMA(1, 1, At, B1); PG8_BAR;
            if constexpr (Epi::SEGT > 0) { if ((t + 2) % Epi::SEGT == 0 && t + 2 < nt) E.segment(acc, cur, (t + 2) / Epi::SEGT - 1, wr, wc, fr, fq); }
        }
        E(acc, cur, wr, wc, fr, fq); S.done(cur);
        if (!has_next) break;
#pragma unroll
        for (int a = 0; a < 2; ++a)
#pragma unroll
            for (int b = 0; b < 2; ++b)
#pragma unroll
                for (int m = 0; m < 4; ++m)
#pragma unroll
                    for (int n = 0; n < 2; ++n) acc[a][b][m][n] = (f32x4){0.f, 0.f, 0.f, 0.f};
        cur = nxt; cA = nA; cB = nB; ++ui;
    }
    PG8_WAIT_V(0);
    if (wr == 0) PG8_BAR;
    PG8_BAR;
#undef PG8_SA
#undef PG8_SB
#undef PG8_STAGE
#undef PG8_LDA
#undef PG8_LDB
#undef PG8_MMA
#undef PG8_WAIT_V
#undef PG8_WAIT_L
#undef PG8_BAR
#undef PG8_SCHED
#endif
}

struct StaticOrder {
    int nM, nN, nwg, G, c; const char* A; const char* B; size_t tstepA, tstepB;
    __device__ __forceinline__ void init(int M, int N, int G_, int c_, const void* A_, const void* B_, int lda, int ldb) { nM = M / BM; nN = N / BM; nwg = nM * nN; G = G_; c = c_; A = (const char*)A_; B = (const char*)B_; tstepA = (size_t)BM * lda * 2; tstepB = (size_t)BM * ldb * 2; }
    __device__ __forceinline__ bool next(int i, Unit& u) const {
        const long L = (long)i * G + c; if (L >= nwg) return false;
        int wgid = (int)L; { const int q = nwg / 8, r = nwg % 8, xcd = wgid % 8, off = wgid / 8; wgid = (xcd < r ? xcd * (q + 1) : r * (q + 1) + (xcd - r) * q) + off; }
        const int nig = 8 * nN, gid = wgid / nig, fm = gid * 8, gsz = (nM - fm) < 8 ? (nM - fm) : 8;
        u.pm = fm + ((wgid % nig) % gsz); u.pn = (wgid % nig) / gsz; u.aux = 0; u.A = A + (size_t)u.pm * tstepA; u.B = B + (size_t)u.pn * tstepB; return true;
    }
    __device__ __forceinline__ void a_ready(const Unit&) const {}
    __device__ __forceinline__ void done(const Unit&) const {}
};
struct MergeOrder {
    StaticOrder so; int kseg_bytes;
    __device__ __forceinline__ bool next(int i, Unit& u) const { if (!so.next(i >> 2, u)) return false; u.aux = i & 3; u.A += (size_t)u.aux * kseg_bytes; u.B += (size_t)u.aux * kseg_bytes; return true; }
    __device__ __forceinline__ void a_ready(const Unit&) const {}
    __device__ __forceinline__ void done(const Unit&) const {}
};
struct MoeOrder {
    int G, c, ncol; const int* plan; const char* A; const char* B; size_t tstepA, tstepB, estep;
    __device__ __forceinline__ bool next(int i, Unit& u) const {
        const long L = (long)i * G + c; const int nblk = plan[40]; if (L >= (long)nblk * ncol) return false;
        u.pm = (int)(L / ncol); u.pn = (int)(L % ncol); u.aux = plan[64 + u.pm]; u.A = A + (size_t)u.pm * tstepA; u.B = B + (size_t)u.aux * estep + (size_t)u.pn * tstepB; return true;
    }
    __device__ __forceinline__ void a_ready(const Unit&) const {}
    __device__ __forceinline__ void done(const Unit&) const {}
};

__device__ __forceinline__ u32x4 pack8(const f32x4 v0, const f32x4 v1) { u32x4 w; w[0] = pk2(v0[0], v0[1]); w[1] = pk2(v0[2], v0[3]); w[2] = pk2(v1[0], v1[1]); w[3] = pk2(v1[2], v1[3]); return w; }
struct EpiBf16 {
    static constexpr int SEGT = 0; static constexpr bool PERM = true; bf16_t* O; int ldc;
    __device__ __forceinline__ void operator()(const f32x4 (&acc)[2][2][4][2], const Unit& u, int wr, int wc, int fr, int fq) const {
        const int row0 = u.pm * BM + wr * 64 + fr, col0 = u.pn * BM + wc * 32 + 8 * fq;
#pragma unroll
        for (int ai = 0; ai < 2; ++ai)
#pragma unroll
            for (int m = 0; m < 4; ++m) { bf16_t* rowp = O + (size_t)(row0 + ai * HALF + m * 16) * ldc + col0;
#pragma unroll
                for (int bj = 0; bj < 2; ++bj) *(u32x4*)(rowp + bj * HALF) = pack8(acc[ai][bj][m][0], acc[ai][bj][m][1]); }
    }
};
struct EpiP {
    static constexpr int SEGT = 0; static constexpr bool PERM = true; bf16_t* O; unsigned char* G8;
    __device__ __forceinline__ void operator()(const f32x4 (&acc)[2][2][4][2], const Unit& u, int wr, int wc, int fr, int fq) const {
        const int row0 = u.pm * BM + wr * 64 + fr, col0 = u.pn * BM + wc * 32 + 8 * fq;
        if (u.pn * BM < C_MLP) {
#pragma unroll
            for (int ai = 0; ai < 2; ++ai)
#pragma unroll
                for (int m = 0; m < 4; ++m) { bf16_t* rowp = O + (size_t)(row0 + ai * HALF + m * 16) * PW + col0;
#pragma unroll
                    for (int bj = 0; bj < 2; ++bj) *(u32x4*)(rowp + bj * HALF) = pack8(acc[ai][bj][m][0], acc[ai][bj][m][1]); }
        } else {
#pragma unroll
            for (int ai = 0; ai < 2; ++ai)
#pragma unroll
                for (int m = 0; m < 4; ++m) { unsigned char* rowp = G8 + (size_t)(row0 + ai * HALF + m * 16) * (4 * D) + (col0 - C_MLP);
#pragma unroll
                    for (int bj = 0; bj < 2; ++bj) { unsigned long long w = 0ull;
#pragma unroll
                        for (int q = 0; q < 8; ++q) { const float gq = sigmoidf_(acc[ai][bj][m][q >> 2][q & 3]); w |= (unsigned long long)(unsigned)(gq * 255.f + 0.5f) << (8 * q); }
                        *(unsigned long long*)(rowp + bj * HALF) = w; } }
        }
    }
};
struct EpiMerge {
    static constexpr int SEGT = 16; static constexpr bool PERM = true; const unsigned char* G8; bf16_t* MRG;
    static __device__ __forceinline__ float gq(unsigned long long w, int q) { const unsigned b = (unsigned)(w >> (8 * q)) & 255u; return (b ? (float)b : 0.5f) * (1.f / 255.f); }
    __device__ __forceinline__ void segment(f32x4 (&acc)[2][2][4][2], const Unit& u, int seg, int wr, int wc, int fr, int fq) const {
        const int row0 = u.pm * BM + wr * 64 + fr, col0 = u.pn * BM + wc * 32 + 8 * fq;
#pragma unroll
        for (int ai = 0; ai < 2; ++ai)
#pragma unroll
            for (int m = 0; m < 4; ++m) { const size_t r = (size_t)(row0 + ai * HALF + m * 16);
#pragma unroll
                for (int bj = 0; bj < 2; ++bj) { const int cc = col0 + bj * HALF;
                    const unsigned long long g0 = *(const unsigned long long*)(G8 + r * (4 * D) + seg * D + cc), g1 = *(const unsigned long long*)(G8 + r * (4 * D) + (seg + 1) * D + cc);
#pragma unroll
                    for (int q = 0; q < 4; ++q) { acc[ai][bj][m][0][q] *= gq(g0, q) * frcp_(gq(g1, q)); acc[ai][bj][m][1][q] *= gq(g0, 4 + q) * frcp_(gq(g1, 4 + q)); } }
#ifndef CPU_EMU
                asm volatile("" ::: "memory");
#endif
            }
    }
    __device__ __forceinline__ void operator()(const f32x4 (&acc)[2][2][4][2], const Unit& u, int wr, int wc, int fr, int fq) const {
        const int row0 = u.pm * BM + wr * 64 + fr, col0 = u.pn * BM + wc * 32 + 8 * fq;
#pragma unroll
        for (int ai = 0; ai < 2; ++ai)
#pragma unroll
            for (int m = 0; m < 4; ++m) { const size_t r = (size_t)(row0 + ai * HALF + m * 16);
#pragma unroll
                for (int bj = 0; bj < 2; ++bj) { const int cc = col0 + bj * HALF;
                    const unsigned long long g3 = *(const unsigned long long*)(G8 + r * (4 * D) + 3 * D + cc); f32x4 v0, v1;
#pragma unroll
                    for (int q = 0; q < 4; ++q) { v0[q] = gq(g3, q) * acc[ai][bj][m][0][q]; v1[q] = gq(g3, 4 + q) * acc[ai][bj][m][1][q]; }
                    *(u32x4*)(MRG + r * D + cc) = pack8(v0, v1); }
#ifndef CPU_EMU
                asm volatile("" ::: "memory");
#endif
            }
    }
};
struct EpiResid {
    static constexpr int SEGT = 0; static constexpr bool PERM = false; const float* xin; const float* g1; float* xmid;
    __device__ __forceinline__ void operator()(const f32x4 (&acc)[2][2][4][2], const Unit& u, int wr, int wc, int fr, int fq) const {
        const int row0 = u.pm * BM + wr * 64 + fr, col0 = u.pn * BM + wc * 32 + 4 * fq;
#pragma unroll
        for (int ai = 0; ai < 2; ++ai)
#pragma unroll
            for (int m = 0; m < 4; ++m) { const int r = row0 + ai * HALF + m * 16; const float* gp = g1 + (size_t)(r / S) * D6;
#pragma unroll
                for (int bj = 0; bj < 2; ++bj)
#pragma unroll
                    for (int n = 0; n < 2; ++n) { const int cc = col0 + bj * HALF + n * 16; *(f32x4*)(xmid + (size_t)r * D + cc) = *(const f32x4*)(xin + (size_t)r * D + cc) + *(const f32x4*)(gp + cc) * acc[ai][bj][m][n]; }
#ifndef CPU_EMU
                asm volatile("" ::: "memory");
#endif
            }
    }
};
struct EpiGU {
    static constexpr int SEGT = 0; static constexpr bool PERM = true; bf16_t* ACT;
    __device__ __forceinline__ void operator()(const f32x4 (&acc)[2][2][4][2], const Unit& u, int wr, int wc, int fr, int fq) const {
        const int row0 = u.pm * BM + wr * 64 + fr, col0 = u.pn * HALF + wc * 32 + 8 * fq;
#pragma unroll
        for (int ai = 0; ai < 2; ++ai)
#pragma unroll
            for (int m = 0; m < 4; ++m) { f32x4 v0, v1;
#pragma unroll
                for (int j = 0; j < 4; ++j) { v0[j] = siluf_(acc[ai][0][m][0][j]) * acc[ai][1][m][0][j]; v1[j] = siluf_(acc[ai][0][m][1][j]) * acc[ai][1][m][1][j]; }
                *(u32x4*)(ACT + (size_t)(row0 + ai * HALF + m * 16) * 512 + col0) = pack8(v0, v1); }
    }
};
}

template <int PASS>
__device__ __forceinline__ void ph_lru(const Ctx& c, int l, float* ldsf) {
    const bf16_t* P = WSH(O_P); const float* cw = c.in[8] + (size_t)l * 4 * W; const float* cb = c.in[9] + (size_t)l * W;
    const float* br = c.in[11] + (size_t)l * 2 * W; const float* bi = c.in[13] + (size_t)l * 2 * W; const float* lam = c.in[14] + (size_t)l * 2 * W; const bf16_t* WLR = WSH(O_WLR);
    float* CA = WSF(O_LCA); float* CH = WSF(O_LCH); const float* CI = WSF(O_LCI); bf16_t* Y = WSH(O_YS); unsigned* LAU = (unsigned*)(c.ws + O_LA);
    bf16_t* Xs = (bf16_t*)ldsf; bf16_t* Wr = Xs + 64 * 136; bf16_t* Wi = Wr + 128 * 136; float* AUa = (float*)Wr; float* AUu = AUa + 64 * 128; float* HF = (float*)(Wi + 128 * 136); float* spl = HF + 64 * 128;
    const int tid = threadIdx.x, wv = tid >> 6, lane = tid & 63, fr = lane & 15, fq = lane >> 4, rt = wv & 3, hf = wv >> 2;
    for (int u = blockIdx.x; u < (T / 64) * 8; u += gridDim.x) {
        const int n = u & 7, tile = u >> 3, b = tile / NLC, chk = tile % NLC; const long t0 = (long)tile * 64;
        if (tid < 256) spl[tid] = softplusf_(-lam[(tid >> 7) * W + n * 128 + (tid & 127)]);
#pragma unroll
        for (int q = 0; q < 4; ++q) { const int id = tid + NT * q, tl = id >> 5, e4 = (id & 31) * 4, ch = n * 128 + e4; const long t = t0 + tl; const int sI = (int)(t % S);
            f32x4 acc = *(const f32x4*)(cb + ch);
#pragma unroll
            for (int k = 0; k < 4; ++k) { const int ss = sI + k - 2; if (ss >= 0 && ss < S) acc += ld_bf4(P + (size_t)(t + k - 2) * PW + C_LX + ch) * *(const f32x4*)(cw + k * W + ch); }
            st_bf4(Xs + tl * 136 + e4, acc); }
        for (int z = 0; z < 2; ++z) {
#pragma unroll
            for (int q = 0; q < 4; ++q) { const int id = tid + NT * q, f = id >> 4, e8 = (id & 15) * 8;
                *(u32x4*)(Wr + f * 136 + e8) = *(const u32x4*)(WLR + ((size_t)((z * 2 + 0) * 8 + n) * 128 + f) * 128 + e8); *(u32x4*)(Wi + f * 136 + e8) = *(const u32x4*)(WLR + ((size_t)((z * 2 + 1) * 8 + n) * 128 + f) * 128 + e8); }
            SYNCTHREADS();
            f32x4 ar[4], ai[4];
#pragma unroll
            for (int nt = 0; nt < 4; ++nt) { ar[nt] = (f32x4){0.f, 0.f, 0.f, 0.f}; ai[nt] = (f32x4){0.f, 0.f, 0.f, 0.f}; }
            wave_mma<4, 4>(ar, Xs + rt * 16 * 136, 136, Wr + hf * 64 * 136, 136);
            wave_mma<4, 4>(ai, Xs + rt * 16 * 136, 136, Wi + hf * 64 * 136, 136);
            SYNCTHREADS();
            const int tl = rt * 16 + fr;
#pragma unroll
            for (int nt = 0; nt < 4; ++nt) { const int f = 64 * hf + 16 * nt + 4 * fq, ch = n * 128 + f;
                const f32x4 brv = *(const f32x4*)(br + z * W + ch), biv = *(const f32x4*)(bi + z * W + ch), lmv = *(const f32x4*)(spl + z * 128 + f), xcv = ld_bf4(Xs + tl * 136 + f); f32x4 av, uv, lav;
#pragma unroll
                for (int e = 0; e < 4; ++e) { const float r = sigmoidf_(ar[nt][e] + brv[e]), ig = sigmoidf_(ai[nt][e] + biv[e]), la = -8.f * r * lmv[e]; const float a = fexp_(la); av[e] = a; lav[e] = la; uv[e] = sqrtf(fmaxf(1.f - a * a, 0.f)) * ig * xcv[e]; }
                *(f32x4*)(AUa + tl * 128 + f) = av; *(f32x4*)(AUu + tl * 128 + f) = uv;
                if (PASS == 1) { u32x4 pk;
#pragma unroll
                    for (int e = 0; e < 4; ++e) pk[e] = pk2(lav[e], uv[e]);
                    *(u32x4*)(LAU + ((size_t)z * T + t0 + tl) * W + ch) = pk; } }
            SYNCTHREADS();
            if (tid < 128) { const int f = tid; const size_t ci = (((size_t)z * NB + b) * NLC + chk) * W + n * 128 + f;
                if (PASS == 1) { float prod = 1.f, h = 0.f;
#pragma unroll 8
                    for (int q = 0; q < 64; ++q) { const int sI = z == 0 ? q : 63 - q; const float a = AUa[sI * 128 + f]; h = a * h + AUu[sI * 128 + f]; prod *= a; }
                    CA[ci] = prod; CH[ci] = h;
                } else { float h = CI[ci];
                    if (z == 0) {
#pragma unroll 8
                        for (int q = 0; q < 64; ++q) { h = AUa[q * 128 + f] * h + AUu[q * 128 + f]; HF[q * 128 + f] = h; }
                    } else {
#pragma unroll 8
                        for (int q = 63; q >= 0; --q) { h = AUa[q * 128 + f] * h + AUu[q * 128 + f]; HF[q * 128 + f] += h; } } }
            }
            SYNCTHREADS();
        }
        if (PASS == 2) {
#pragma unroll
            for (int q = 0; q < 4; ++q) { const int id = tid + NT * q, tl = id >> 5, f4 = (id & 31) * 4; const long t = t0 + tl; f32x4 hv = *(const f32x4*)(HF + tl * 128 + f4); const f32x4 gv = ld_bf4(P + (size_t)t * PW + C_LG + n * 128 + f4);
#pragma unroll
                for (int e = 0; e < 4; ++e) hv[e] *= geluf_(gv[e]);
                st_bf4(Y + (size_t)t * 4 * W + 0 * W + n * 128 + f4, hv); }
            SYNCTHREADS();
        }
    }
}
__device__ __forceinline__ void ph_lru_fin(const Ctx& c, float* ldsf) {
    const bf16_t* P = WSH(O_P); const unsigned* LAU = (const unsigned*)(c.ws + O_LA); const float* CI = WSF(O_LCI); bf16_t* Y = WSH(O_YS);
    unsigned* Lz = (unsigned*)ldsf; float* Hz = ldsf + 2 * 64 * 128; const int tid = threadIdx.x;
    for (int u = blockIdx.x; u < (T / 64) * 8; u += gridDim.x) {
        const int n = u & 7, tile = u >> 3, b = tile / NLC, chk = tile % NLC; const long t0 = (long)tile * 64;
#pragma unroll
        for (int q = 0; q < 8; ++q) { const int id = tid + NT * q, z = id >> 11, r = (id >> 5) & 63, c4 = (id & 31) * 4; *(u32x4*)(Lz + z * 8192 + r * 128 + c4) = *(const u32x4*)(LAU + ((size_t)z * T + t0 + r) * W + n * 128 + c4); }
        SYNCTHREADS();
        if (tid < 256) { const int z = tid >> 7, f = tid & 127; float h = CI[(((size_t)z * NB + b) * NLC + chk) * W + n * 128 + f]; const unsigned* lp = Lz + z * 8192 + f; float* hp = Hz + z * 8192 + f;
#pragma unroll 8
            for (int q = 0; q < 64; ++q) { const int sI = z == 0 ? q : 63 - q; const unsigned w = lp[sI * 128]; h = fexp_(bflo(w)) * h + bfhi(w); hp[sI * 128] = h; } }
        SYNCTHREADS();
#pragma unroll
        for (int q = 0; q < 4; ++q) { const int id = tid + NT * q, r = id >> 5, f4 = (id & 31) * 4; const long t = t0 + r; f32x4 o = *(const f32x4*)(Hz + r * 128 + f4) + *(const f32x4*)(Hz + 8192 + r * 128 + f4); const f32x4 gv = ld_bf4(P + (size_t)t * PW + C_LG + n * 128 + f4);
#pragma unroll
            for (int e = 0; e < 4; ++e) o[e] *= geluf_(gv[e]);
            st_bf4(Y + (size_t)t * 4 * W + 0 * W + n * 128 + f4, o); }
        SYNCTHREADS();
    }
}
__device__ __forceinline__ void ph_lru_scan2(const Ctx& c) {
    const float* CA = WSF(O_LCA); const float* CH = WSF(O_LCH); float* CI = WSF(O_LCI);
    for (long i = GT_; i < (long)2 * NB * W; i += GS_) {
        const int w = (int)(i % W), b = (int)((i / W) % NB), z = (int)(i / ((long)W * NB)); float carry = 0.f;
#pragma unroll 16
        for (int q = 0; q < NLC; ++q) { const int ch = z == 0 ? q : NLC - 1 - q; const size_t idx = (((size_t)z * NB + b) * NLC + ch) * W + w; CI[idx] = carry; carry = CA[idx] * carry + CH[idx]; }
    }
}
__device__ __forceinline__ void ph_rope_table(const Ctx& c) {
    const int* pos = (const int*)c.in[2]; float* RT = WSF(O_ROPE);
    for (long i = GT_; i < (long)T * 32; i += GS_) { const int j = (int)(i & 31); const float ang = (float)pos[i >> 5] * powf(10000.f, -(float)(2 * j) / 64.f); RT[i * 2] = cosf(ang); RT[i * 2 + 1] = sinf(ang); }
}
__device__ __forceinline__ void ret_tables(float* tab, int h) {
    const int tid = threadIdx.x; const float lg = loggamma_(h);
    if (tid < 32) tab[tid] = powf(10000.f, -(float)(2 * tid) / 64.f);
    if (tid >= 64 && tid < 64 + 129) tab[tid] = expf((float)(tid - 64) * lg);
}
__device__ __forceinline__ void ph_ret_kv(const Ctx& c, float* ldsf) {
    const float* RT = WSF(O_ROPE); const bf16_t* P = WSH(O_P); float* KVF = WSF(O_KVF); float* KVB = WSF(O_KVB);
    bf16_t* VT = (bf16_t*)ldsf; bf16_t* KF = VT + 128 * 136; bf16_t* KB = KF + 64 * 136; float* tab = (float*)(KB + 64 * 136);
    const int tid = threadIdx.x, wv = tid >> 6, lane = tid & 63, fr = lane & 15, fq = lane >> 4;
    for (int u = blockIdx.x; u < (T / 128) * 8; u += gridDim.x) {
        const int h = u & 7; const long t0 = (long)(u >> 3) * 128;
        ret_tables(tab, h);
        SYNCTHREADS();
        {
            const int j = tid >> 2, d0 = (tid & 3) * 8; const bf16_t* prow = P + (size_t)(t0 + j) * PW + C_RK + h * 64; const float* rt = RT + ((size_t)(t0 + j) * 32 + d0) * 2;
            const u32x4 kl = *(const u32x4*)(prow + d0), kh = *(const u32x4*)(prow + d0 + 32);
            const f32x4 r0 = *(const f32x4*)rt, r1 = *(const f32x4*)(rt + 4), r2 = *(const f32x4*)(rt + 8), r3 = *(const f32x4*)(rt + 12);
            const float cs[8] = {r0[0], r0[2], r1[0], r1[2], r2[0], r2[2], r3[0], r3[2]}, sn[8] = {r0[1], r0[3], r1[1], r1[3], r2[1], r2[3], r3[1], r3[3]};
            const float fj = tab[64 + 127 - j], bj = tab[64 + j];
#pragma unroll
            for (int e = 0; e < 8; ++e) { const float x1 = (e & 1) ? bfhi(kl[e >> 1]) : bflo(kl[e >> 1]), x2 = (e & 1) ? bfhi(kh[e >> 1]) : bflo(kh[e >> 1]);
                const float k1 = x1 * cs[e] - x2 * sn[e], k2 = x2 * cs[e] + x1 * sn[e];
                KF[(d0 + e) * 136 + j] = (bf16_t)f2bf(k1 * fj); KF[(d0 + e + 32) * 136 + j] = (bf16_t)f2bf(k2 * fj); KB[(d0 + e) * 136 + j] = (bf16_t)f2bf(k1 * bj); KB[(d0 + e + 32) * 136 + j] = (bf16_t)f2bf(k2 * bj); } }
#pragma unroll
        for (int q = 0; q < 4; ++q) { const int id = tid + NT * q, j = id & 127, e8 = (id >> 7) * 8; const u32x4 raw = *(const u32x4*)(P + (size_t)(t0 + j) * PW + C_RV + h * 128 + e8);
#pragma unroll
            for (int e = 0; e < 4; ++e) { VT[(e8 + 2 * e) * 136 + j] = (bf16_t)(raw[e] & 0xffffu); VT[(e8 + 2 * e + 1) * 136 + j] = (bf16_t)(raw[e] >> 16); } }
        SYNCTHREADS();
        f32x4 af[4], ab[4];
#pragma unroll
        for (int nt = 0; nt < 4; ++nt) { af[nt] = (f32x4){0.f, 0.f, 0.f, 0.f}; ab[nt] = (f32x4){0.f, 0.f, 0.f, 0.f}; }
        wave_mma<4, 4>(af, VT + wv * 16 * 136, 136, KF, 136);
        wave_mma<4, 4>(ab, VT + wv * 16 * 136, 136, KB, 136);
        const size_t ob = (((size_t)(u >> 3) * 8 + h) * 128 + wv * 16 + fr) * 64 + 4 * fq;
#pragma unroll
        for (int nt = 0; nt < 4; ++nt) { *(f32x4*)(KVF + ob + 16 * nt) = af[nt]; *(f32x4*)(KVB + ob + 16 * nt) = ab[nt]; }
        SYNCTHREADS();
    }
}
__device__ __forceinline__ void ph_ret_state(const Ctx& c) {
    const float* KVF = WSF(O_KVF); const float* KVB = WSF(O_KVB); float* STF = WSF(O_STF); float* STB = WSF(O_STB);
    for (long i = GT_; i < (long)NB * 8 * 8192; i += GS_) {
        const int x = (int)(i % 8192), h = (int)((i / 8192) % 8), b = (int)(i / 65536);
        const float cd = expf(128.f * loggamma_(h)); float st = 0.f;
#pragma unroll 16
        for (int n = 0; n < NCH; ++n) { const size_t idx = (((size_t)b * NCH + n) * 8 + h) * 8192 + x; STF[idx] = st; st = cd * st + KVF[idx]; }
        st = 0.f;
#pragma unroll 16
        for (int n = NCH - 1; n >= 0; --n) { const size_t idx = (((size_t)b * NCH + n) * 8 + h) * 8192 + x; STB[idx] = st; st = cd * st + KVB[idx]; }
    }
}
__device__ __forceinline__ void ph_ret_out(const Ctx& c, float* ldsf) {
    const float* RT = WSF(O_ROPE); const bf16_t* P = WSH(O_P); const float* STF = WSF(O_STF); const float* STB = WSF(O_STB); bf16_t* Y = WSH(O_YS);
    bf16_t* Qs = (bf16_t*)ldsf; bf16_t* Ks = Qs + 128 * 72; bf16_t* VT = Ks + 128 * 72; bf16_t* Ss = VT + 128 * 136; bf16_t* SF = Ss + 128 * 136; bf16_t* SB = SF + 128 * 72; float* tab = (float*)(SB + 128 * 72);
    const int tid = threadIdx.x, wv = tid >> 6, lane = tid & 63, fr = lane & 15, fq = lane >> 4;
    for (int u = blockIdx.x; u < (T / 128) * 8; u += gridDim.x) {
        const int h = u & 7; const long t0 = (long)(u >> 3) * 128;
        ret_tables(tab, h);
        SYNCTHREADS();
        {
            const int j = tid >> 2, d0 = (tid & 3) * 8; const bf16_t* prow = P + (size_t)(t0 + j) * PW + h * 64 + d0; const float* rt = RT + ((size_t)(t0 + j) * 32 + d0) * 2;
            const u32x4 ql = *(const u32x4*)(prow + C_RQ), qh = *(const u32x4*)(prow + C_RQ + 32), kl = *(const u32x4*)(prow + C_RK), kh = *(const u32x4*)(prow + C_RK + 32);
            const f32x4 r0 = *(const f32x4*)rt, r1 = *(const f32x4*)(rt + 4), r2 = *(const f32x4*)(rt + 8), r3 = *(const f32x4*)(rt + 12);
            const float cs[8] = {r0[0], r0[2], r1[0], r1[2], r2[0], r2[2], r3[0], r3[2]}, sn[8] = {r0[1], r0[3], r1[1], r1[3], r2[1], r2[3], r3[1], r3[3]};
            u32x4 oql, oqh, okl, okh;
#pragma unroll
            for (int e = 0; e < 4; ++e) { const int ea = 2 * e, eb = 2 * e + 1;
                const float q1a = bflo(ql[e]), q1b = bfhi(ql[e]), q2a = bflo(qh[e]), q2b = bfhi(qh[e]), k1a = bflo(kl[e]), k1b = bfhi(kl[e]), k2a = bflo(kh[e]), k2b = bfhi(kh[e]);
                oql[e] = pk2((q1a * cs[ea] - q2a * sn[ea]) * 0.125f, (q1b * cs[eb] - q2b * sn[eb]) * 0.125f); oqh[e] = pk2((q2a * cs[ea] + q1a * sn[ea]) * 0.125f, (q2b * cs[eb] + q1b * sn[eb]) * 0.125f);
                okl[e] = pk2(k1a * cs[ea] - k2a * sn[ea], k1b * cs[eb] - k2b * sn[eb]); okh[e] = pk2(k2a * cs[ea] + k1a * sn[ea], k2b * cs[eb] + k1b * sn[eb]); }
            *(u32x4*)(Qs + j * 72 + d0) = oql; *(u32x4*)(Qs + j * 72 + d0 + 32) = oqh; *(u32x4*)(Ks + j * 72 + d0) = okl; *(u32x4*)(Ks + j * 72 + d0 + 32) = okh; }
#pragma unroll
        for (int q = 0; q < 4; ++q) { const int id = tid + NT * q, j = id & 127, e8 = (id >> 7) * 8; const u32x4 raw = *(const u32x4*)(P + (size_t)(t0 + j) * PW + C_RV + h * 128 + e8);
#pragma unroll
            for (int e = 0; e < 4; ++e) { VT[(e8 + 2 * e) * 136 + j] = (bf16_t)(raw[e] & 0xffffu); VT[(e8 + 2 * e + 1) * 136 + j] = (bf16_t)(raw[e] >> 16); } }
        const size_t sbase = (((size_t)(u >> 3) * 8 + h)) * 8192;
#pragma unroll
        for (int q = 0; q < 4; ++q) { const int id = tid + NT * q, e = id >> 4, d4 = (id & 15) * 4; st_bf4(SF + e * 72 + d4, *(const f32x4*)(STF + sbase + (size_t)e * 64 + d4)); st_bf4(SB + e * 72 + d4, *(const f32x4*)(STB + sbase + (size_t)e * 64 + d4)); }
        SYNCTHREADS();
        const int i = wv * 16 + fr; const long t = t0 + i;
        {
            f32x4 sc[8];
#pragma unroll
            for (int nt = 0; nt < 8; ++nt) sc[nt] = (f32x4){0.f, 0.f, 0.f, 0.f};
            wave_mma<2, 8>(sc, Qs + wv * 16 * 72, 72, Ks, 72);
#pragma unroll
            for (int nt = 0; nt < 8; ++nt) { const int j0 = 16 * nt + 4 * fq; f32x4 sv;
#pragma unroll
                for (int e = 0; e < 4; ++e) { const int j = j0 + e, dist = i > j ? i - j : j - i; sv[e] = sc[nt][e] * tab[64 + dist]; }
                st_bf4(Ss + i * 136 + j0, sv); }
        }
#ifdef CPU_EMU
        SYNCTHREADS();
#else
        asm volatile("s_waitcnt lgkmcnt(0)" ::: "memory");
#endif
        f32x4 ao[8], tm[8];
#pragma unroll
        for (int nt = 0; nt < 8; ++nt) { ao[nt] = (f32x4){0.f, 0.f, 0.f, 0.f}; tm[nt] = (f32x4){0.f, 0.f, 0.f, 0.f}; }
        wave_mma<4, 8>(ao, Ss + wv * 16 * 136, 136, VT, 136);
        wave_mma<2, 8>(tm, Qs + wv * 16 * 72, 72, SF, 72);
        { const float qf = tab[64 + i + 1];
#pragma unroll
            for (int nt = 0; nt < 8; ++nt) { ao[nt] += tm[nt] * qf; tm[nt] = (f32x4){0.f, 0.f, 0.f, 0.f}; } }
        wave_mma<2, 8>(tm, Qs + wv * 16 * 72, 72, SB, 72);
        { const float qb = tab[64 + 128 - i];
#pragma unroll
            for (int nt = 0; nt < 8; ++nt) ao[nt] += tm[nt] * qb; }
        float sm = 0.f;
#pragma unroll
        for (int nt = 0; nt < 8; ++nt) sm += (ao[nt][0] + ao[nt][1]) + (ao[nt][2] + ao[nt][3]);
        sm += SHFL_XOR(sm, 16); sm += SHFL_XOR(sm, 32);
        const float mu = sm * (1.f / 128.f); float sq = 0.f;
#pragma unroll
        for (int nt = 0; nt < 8; ++nt) { ao[nt] -= mu; sq += (ao[nt][0] * ao[nt][0] + ao[nt][1] * ao[nt][1]) + (ao[nt][2] * ao[nt][2] + ao[nt][3] * ao[nt][3]); }
        sq += SHFL_XOR(sq, 16); sq += SHFL_XOR(sq, 32);
        const float rs = 1.f / sqrtf(sq * (1.f / 128.f) + EPS);
#pragma unroll
        for (int nt = 0; nt < 8; ++nt) { const int e0 = 16 * nt + 4 * fq; f32x4 gv = ld_bf4(P + (size_t)t * PW + C_RG + h * 128 + e0);
#pragma unroll
            for (int e = 0; e < 4; ++e) gv[e] = siluf_(gv[e]) * (ao[nt][e] * rs);
            st_bf4(Y + (size_t)t * 4 * W + 1 * W + h * 128 + e0, gv); }
        SYNCTHREADS();
    }
}
__device__ __forceinline__ void ph_sgu_norm(const Ctx& c, int l) {
    const bf16_t* P = WSH(O_P); float* ST = WSF(O_VN);
    const int lane = threadIdx.x & 63, gw = blockIdx.x * (NT / 64) + (threadIdx.x >> 6), ngw = gridDim.x * (NT / 64);
    for (int t = gw; t < T; t += ngw) {
        f32x4 v[4]; float sm = 0.f;
#pragma unroll
        for (int j = 0; j < 4; ++j) { v[j] = ld_bf4(P + (size_t)t * PW + C_SV + (j * 64 + lane) * 4);
#pragma unroll
            for (int q = 0; q < 4; ++q) { v[j][q] = geluf_(v[j][q]); sm += v[j][q]; } }
        const float mu = wave_sum(sm) * (1.f / W); float sq = 0.f;
#pragma unroll
        for (int j = 0; j < 4; ++j)
#pragma unroll
            for (int q = 0; q < 4; ++q) { const float dd = v[j][q] - mu; sq += dd * dd; }
        const float rs = 1.f / sqrtf(wave_sum(sq) * (1.f / W) + EPS);
        if (lane == 0) { ST[(size_t)t * 2] = mu; ST[(size_t)t * 2 + 1] = rs; }
    }
}
__device__ __forceinline__ void ph_sgu_mix(const Ctx& c, int l, float* ldsf) {
    const bf16_t* P = WSH(O_P); const float* ST = WSF(O_VN); bf16_t* Y = WSH(O_YS); const float* ng = c.in[15] + (size_t)l * W;
    bf16_t* As = (bf16_t*)ldsf; bf16_t* Bs = As + 128 * 136; const int tid = threadIdx.x, wv = tid >> 6, lane = tid & 63, fr = lane & 15, fq = lane >> 4;
    for (int u = blockIdx.x; u < (T / 128) * 8; u += gridDim.x) {
        const int g = u & 7; const long t0 = (long)(u >> 3) * 128;
        const float* ws = c.in[16] + ((size_t)l * 8 + g) * 128 * 128; const float* bs = c.in[17] + ((size_t)l * 8 + g) * 128;
#pragma unroll
        for (int q = 0; q < 8; ++q) { const int id = tid + NT * q, i = id >> 5, j4 = (id & 31) * 4; st_bf4(As + i * 136 + j4, *(const f32x4*)(ws + i * 128 + j4)); }
#pragma unroll
        for (int q = 0; q < 4; ++q) { const int id = tid + NT * q, j = id & 127, d8 = (id >> 7) * 8; const float mu = ST[(size_t)(t0 + j) * 2], rs = ST[(size_t)(t0 + j) * 2 + 1];
            const u32x4 raw = *(const u32x4*)(P + (size_t)(t0 + j) * PW + C_SV + g * 128 + d8);
#pragma unroll
            for (int e = 0; e < 4; ++e) { const float v0 = (geluf_(bflo(raw[e])) - mu) * rs * ng[g * 128 + d8 + 2 * e], v1 = (geluf_(bfhi(raw[e])) - mu) * rs * ng[g * 128 + d8 + 2 * e + 1];
                Bs[(d8 + 2 * e) * 136 + j] = (bf16_t)f2bf(v0); Bs[(d8 + 2 * e + 1) * 136 + j] = (bf16_t)f2bf(v1); } }
        SYNCTHREADS();
        f32x4 acc[8];
#pragma unroll
        for (int nt = 0; nt < 8; ++nt) acc[nt] = (f32x4){0.f, 0.f, 0.f, 0.f};
        wave_mma<4, 8>(acc, As + wv * 16 * 136, 136, Bs, 136);
        const int i = wv * 16 + fr; const long t = t0 + i; const float bsi = bs[i];
#pragma unroll
        for (int nt = 0; nt < 8; ++nt) { const int d = 16 * nt + 4 * fq; f32x4 uu = ld_bf4(P + (size_t)t * PW + C_SU + g * 128 + d);
#pragma unroll
            for (int e = 0; e < 4; ++e) uu[e] = geluf_(uu[e]) * (acc[nt][e] + bsi);
            st_bf4(Y + (size_t)t * 4 * W + 2 * W + g * 128 + d, uu); }
        SYNCTHREADS();
    }
}
__device__ __forceinline__ void ph_rw_shift(const Ctx& c, int l) {
    const bf16_t* P = WSH(O_P); const float* mup = c.in[18] + (size_t)l * RF; const float* mun = c.in[19] + (size_t)l * RF; bf16_t* FS = WSH(O_FS);
    const int lane = threadIdx.x & 63, gw = blockIdx.x * (NT / 64) + (threadIdx.x >> 6), ngw = gridDim.x * (NT / 64);
    for (int t = gw; t < T; t += ngw) {
        const int sI = t % S; const bf16_t* pc = P + (size_t)t * PW + C_RW;
#pragma unroll 2
        for (int j = lane * 4; j < RF; j += 256) {
            const f32x4 f = ld_bf4(pc + j), z4 = (f32x4){0.f, 0.f, 0.f, 0.f}; const f32x4 pv = sI > 0 ? ld_bf4(pc - PW + j) : z4, nv = sI < S - 1 ? ld_bf4(pc + PW + j) : z4;
            f32x4 v = f + *(const f32x4*)(mup + j) * (pv - f) + *(const f32x4*)(mun + j) * (nv - f);
            if (j >= 3072 && j < 3200) {
#pragma unroll
                for (int e = 0; e < 4; ++e) v[e] = tanhf_(v[e]); }
            else if (j >= 3328) {
#pragma unroll
                for (int e = 0; e < 4; ++e) v[e] = sigmoidf_(v[e]); }
            st_bf4(FS + (size_t)t * RF + j, v);
        }
    }
}
__device__ __forceinline__ void ph_rw_lora(const Ctx& c, int l, float* ldsf) {
    const bf16_t* FS = WSH(O_FS); const float* w0 = c.in[20] + (size_t)l * 2 * W; const float* a0 = c.in[22] + (size_t)l * 2 * W;
    const bf16_t* WUT = WSH(O_WUT); const bf16_t* WAT = WSH(O_WAT); const bf16_t* WGT = WSH(O_WGT);
    bf16_t* DEC = WSH(O_DEC); bf16_t* AA = WSH(O_AA); bf16_t* GG = WSH(O_GG);
    bf16_t* F = (bf16_t*)ldsf; bf16_t* B1 = F + 128 * 136; bf16_t* B2 = B1 + 128 * 136; const int tid = threadIdx.x, wv = tid >> 6, lane = tid & 63, fr = lane & 15, fq = lane >> 4;
    for (int u = blockIdx.x; u < (T / 128) * 8; u += gridDim.x) {
        const int wc0 = (u & 7) * 128; const long t0 = (long)(u >> 3) * 128;
        for (int rd = 0; rd < 3; ++rd) {
#pragma unroll
            for (int q = 0; q < 8; ++q) { const int id = tid + NT * q, r = id >> 5, c4 = (id & 31) * 4;
                const int col = rd < 2 ? (c4 < 64 ? 3072 + rd * 64 + c4 : 3200 + rd * 64 + (c4 - 64)) : 3328 + c4;
                *(unsigned long long*)(F + r * 136 + c4) = *(const unsigned long long*)(FS + (size_t)(t0 + r) * RF + col); }
            if (rd < 2) {
#pragma unroll
                for (int q = 0; q < 2; ++q) { const int id = tid + NT * q, w = id >> 3, r8 = (id & 7) * 8;
                    *(u32x4*)(B1 + w * 72 + r8) = *(const u32x4*)(WUT + ((size_t)rd * W + wc0 + w) * 64 + r8); *(u32x4*)(B2 + w * 72 + r8) = *(const u32x4*)(WAT + ((size_t)rd * W + wc0 + w) * 64 + r8); }
            } else {
#pragma unroll
                for (int q = 0; q < 4; ++q) { const int id = tid + NT * q, w = id >> 4, r8 = (id & 15) * 8; *(u32x4*)(B1 + w * 136 + r8) = *(const u32x4*)(WGT + ((size_t)wc0 + w) * 128 + r8); }
            }
            SYNCTHREADS();
            f32x4 a1[8], a2[8];
#pragma unroll
            for (int nt = 0; nt < 8; ++nt) { a1[nt] = (f32x4){0.f, 0.f, 0.f, 0.f}; a2[nt] = (f32x4){0.f, 0.f, 0.f, 0.f}; }
            const long t = t0 + wv * 16 + fr;
            if (rd < 2) {
                wave_mma<2, 8>(a1, F + wv * 16 * 136, 136, B1, 72);
                wave_mma<2, 8>(a2, F + wv * 16 * 136 + 64, 136, B2, 72);
#pragma unroll
                for (int nt = 0; nt < 8; ++nt) { const int ch = wc0 + 16 * nt + 4 * fq; const f32x4 w0v = *(const f32x4*)(w0 + rd * W + ch), a0v = *(const f32x4*)(a0 + rd * W + ch); f32x4 dv, av;
#pragma unroll
                    for (int e = 0; e < 4; ++e) { dv[e] = fexp_(-DECAY_SCALE * sigmoidf_(a1[nt][e] + w0v[e])); av[e] = sigmoidf_(a2[nt][e] + a0v[e]); }
                    st_bf4(DEC + ((size_t)rd * T + t) * W + ch, dv); st_bf4(AA + ((size_t)rd * T + t) * W + ch, av); }
            } else {
                wave_mma<4, 8>(a1, F + wv * 16 * 136, 136, B1, 136);
#pragma unroll
                for (int nt = 0; nt < 8; ++nt) st_bf4(GG + (size_t)t * W + wc0 + 16 * nt + 4 * fq, a1[nt]);
            }
            SYNCTHREADS();
        }
    }
}
#ifdef CPU_EMU
__device__ __forceinline__ float red16_(float x) { x += SHFL_XOR(x, 1); x += SHFL_XOR(x, 2); x += SHFL_XOR(x, 4); x += SHFL_XOR(x, 8); return x; }
__device__ __forceinline__ float red8_(float x) { x += SHFL_XOR(x, 1); x += SHFL_XOR(x, 2); x += SHFL_XOR(x, 4); return x; }
#define LDS_BARRIER() emu_syncthreads()
#else
__device__ __forceinline__ float red8_(float x) {
    x += __builtin_bit_cast(float, __builtin_amdgcn_update_dpp(0, __builtin_bit_cast(int, x), 0xB1, 0xF, 0xF, true));
    x += __builtin_bit_cast(float, __builtin_amdgcn_update_dpp(0, __builtin_bit_cast(int, x), 0x4E, 0xF, 0xF, true));
    x += __builtin_bit_cast(float, __builtin_amdgcn_update_dpp(0, __builtin_bit_cast(int, x), 0x141, 0xF, 0xF, true));
    return x;
}
__device__ __forceinline__ float red16_(float x) {
    x += __builtin_bit_cast(float, __builtin_amdgcn_update_dpp(0, __builtin_bit_cast(int, x), 0xB1, 0xF, 0xF, true));
    x += __builtin_bit_cast(float, __builtin_amdgcn_update_dpp(0, __builtin_bit_cast(int, x), 0x4E, 0xF, 0xF, true));
    x += __builtin_bit_cast(float, __builtin_amdgcn_update_dpp(0, __builtin_bit_cast(int, x), 0x141, 0xF, 0xF, true));
    x += __builtin_bit_cast(float, __builtin_amdgcn_update_dpp(0, __builtin_bit_cast(int, x), 0x140, 0xF, 0xF, true));
    return x;
}
#define LDS_BARRIER() do { asm volatile("s_waitcnt lgkmcnt(0)" ::: "memory"); __builtin_amdgcn_s_barrier(); asm volatile("" ::: "memory"); } while (0)
#endif
#define RC_M(k) (lm + (k) * 4608)
__device__ __forceinline__ void ph_rw_chunk(const Ctx& c, int l, float* ldsf) {
    const bf16_t* FS = WSH(O_FS); const bf16_t* DEC = WSH(O_DEC); const bf16_t* AA = WSH(O_AA); float* BON = WSF(O_BON);
    const float* kkw = c.in[25] + (size_t)l * W; const float* kaw = c.in[26] + (size_t)l * W; const float* rk = c.in[27] + (size_t)l * W;
    bf16_t* PST = WSH(O_PST); bf16_t* PYT = WSH(O_PYT); bf16_t* SVB = WSH(O_SVB); bf16_t* YVB = WSH(O_YVB);
    bf16_t* lm = (bf16_t*)ldsf; float* gam = (float*)RC_M(7); float* segp = (float*)RC_M(13); float* gl = segp + 512;
    const int tid = threadIdx.x, wv = tid >> 6, lane = tid & 63, fr = lane & 15, fq = lane >> 4, rt = wv & 3, hf = wv >> 2;
    const int m0 = 16 * rt + fr;
    u32x4 wq, kq, rq, vq, aq;
#define RC_LOAD(uu) do { const int chain_ = (uu) / NRC, ck_ = (uu) % NRC, h_ = chain_ & 15, b_ = (chain_ >> 4) & 1, z_ = chain_ >> 5; \
        const long t_ = (long)b_ * S + (z_ ? S - 1 - ck_ * RCK - (tid >> 3) : ck_ * RCK + (tid >> 3)); const int ch_ = h_ * 64 + (tid & 7) * 8; \
        wq = *(const u32x4*)(DEC + ((size_t)z_ * T + t_) * W + ch_); aq = *(const u32x4*)(AA + ((size_t)z_ * T + t_) * W + ch_); \
        const bf16_t* f_ = FS + (size_t)t_ * RF; rq = *(const u32x4*)(f_ + ch_); kq = *(const u32x4*)(f_ + 1024 + ch_); vq = *(const u32x4*)(f_ + 2048 + ch_); } while (0)
    if ((int)blockIdx.x < 64 * NRC) RC_LOAD((int)blockIdx.x);
    for (int u = blockIdx.x; u < 64 * NRC; u += gridDim.x) {
        const int chain = u / NRC, ck = u % NRC, h = chain & 15, b = (chain >> 4) & 1, z = chain >> 5;
        const long tb = (long)b * S + (z ? S - 1 - ck * RCK : ck * RCK); const int dirn = z ? -1 : 1;
        const int tt = tid >> 3, o8 = (tid & 7) * 8;
        const f32x4 kw0 = *(const f32x4*)(kkw + h * 64 + o8), kw1 = *(const f32x4*)(kkw + h * 64 + o8 + 4), ka0 = *(const f32x4*)(kaw + h * 64 + o8), ka1 = *(const f32x4*)(kaw + h * 64 + o8 + 4),
                    rk0 = *(const f32x4*)(rk + h * 64 + o8), rk1 = *(const f32x4*)(rk + h * 64 + o8 + 4);
        *(f32x4*)(gam + tt * 64 + o8) = (f32x4){bflo(wq[0]), bfhi(wq[0]), bflo(wq[1]), bfhi(wq[1])};
        *(f32x4*)(gam + tt * 64 + o8 + 4) = (f32x4){bflo(wq[2]), bfhi(wq[2]), bflo(wq[3]), bfhi(wq[3])};
        LDS_BARRIER();
        { const int k = tid & 63, sg = tid >> 6; float p = 1.f;
#pragma unroll
          for (int q = 0; q < 8; ++q) { p *= gam[(sg * 8 + q) * 64 + k]; gam[(sg * 8 + q) * 64 + k] = p; }
          segp[sg * 64 + k] = p; }
        LDS_BARRIER();
        { const int k = tid & 63, sg = tid >> 6; float pre = 1.f;
          for (int q = 0; q < sg; ++q) pre *= segp[q * 64 + k];
#pragma unroll
          for (int q = 0; q < 8; ++q) gam[(sg * 8 + q) * 64 + k] *= pre;
          if (sg == 7) gl[k] = gam[63 * 64 + k]; }
        LDS_BARRIER();
        { const long t = tb + dirn * tt;
          const f32x4 g0 = *(const f32x4*)(gam + tt * 64 + o8), g1 = *(const f32x4*)(gam + tt * 64 + o8 + 4);
          f32x4 p0 = (f32x4){1.f, 1.f, 1.f, 1.f}, p1 = p0; if (tt) { p0 = *(const f32x4*)(gam + (tt - 1) * 64 + o8); p1 = *(const f32x4*)(gam + (tt - 1) * 64 + o8 + 4); }
          float gx[8], gpx[8], kwx[8], kax[8], rkx[8], kx[8], ax[8], rx[8];
#pragma unroll
          for (int e = 0; e < 4; ++e) { gx[e] = g0[e]; gx[4 + e] = g1[e]; gpx[e] = p0[e]; gpx[4 + e] = p1[e]; kwx[e] = kw0[e]; kwx[4 + e] = kw1[e]; kax[e] = ka0[e]; kax[4 + e] = ka1[e]; rkx[e] = rk0[e]; rkx[4 + e] = rk1[e];
              kx[2 * e] = bflo(kq[e]); kx[2 * e + 1] = bfhi(kq[e]); ax[2 * e] = bflo(aq[e]); ax[2 * e + 1] = bfhi(aq[e]); rx[2 * e] = bflo(rq[e]); rx[2 * e + 1] = bfhi(rq[e]); }
          float vk[8], ktv[8], ss = 0.f, bs = 0.f;
#pragma unroll
          for (int e = 0; e < 8; ++e) { vk[e] = kx[e] * kwx[e]; ss += vk[e] * vk[e]; ktv[e] = kx[e] * (1.f + (ax[e] - 1.f) * kax[e]); bs += rx[e] * rkx[e] * ktv[e]; }
          ss = red8_(ss); bs = red8_(bs);
          if ((tid & 7) == 0) BON[((size_t)z * T + t) * 16 + h] = bs;
          const float rn = frsq_(ss + EPS); float khv[8], bhv[8], k2v[8], rhv[8];
#pragma unroll
          for (int e = 0; e < 8; ++e) { const float kkn = vk[e] * rn, ig = frcp_(gx[e]); khv[e] = kkn * gpx[e]; bhv[e] = ax[e] * kkn * ig; k2v[e] = ktv[e] * ig; rhv[e] = rx[e] * gx[e]; }
          u32x4 K4, B4, C4, R4;
#pragma unroll
          for (int e = 0; e < 4; ++e) { K4[e] = pk2(khv[2 * e], khv[2 * e + 1]); B4[e] = pk2(bhv[2 * e], bhv[2 * e + 1]); C4[e] = pk2(k2v[2 * e], k2v[2 * e + 1]); R4[e] = pk2(rhv[2 * e], rhv[2 * e + 1]); }
          *(u32x4*)(RC_M(0) + tt * 72 + o8) = K4; *(u32x4*)(RC_M(2) + tt * 72 + o8) = B4; *(u32x4*)(RC_M(4) + tt * 72 + o8) = C4; *(u32x4*)(RC_M(5) + tt * 72 + o8) = R4;
#pragma unroll
          for (int e = 0; e < 8; ++e) { const int sh = 16 * (e & 1);
              RC_M(1)[(o8 + e) * 72 + tt] = (bf16_t)(K4[e >> 1] >> sh); RC_M(3)[(o8 + e) * 72 + tt] = (bf16_t)(B4[e >> 1] >> sh); RC_M(6)[(o8 + e) * 72 + tt] = (bf16_t)(vq[e >> 1] >> sh); } }
        if (u + (int)gridDim.x < 64 * NRC) RC_LOAD(u + (int)gridDim.x);
        LDS_BARRIER();
        f32x4 mkr[2], khr[2], rhT[2];
        {
            f32x4 a0[2], a1[2], a2[2], a3[2];
#pragma unroll
            for (int nt = 0; nt < 2; ++nt) { a0[nt] = (f32x4){0.f, 0.f, 0.f, 0.f}; a1[nt] = a0[nt]; a2[nt] = a0[nt]; a3[nt] = a0[nt]; }
            wave_mma<2, 2>(a0, RC_M(2) + rt * 16 * 72, 72, RC_M(0) + hf * 32 * 72, 72);
            wave_mma<2, 2>(a1, RC_M(4) + rt * 16 * 72, 72, RC_M(0) + hf * 32 * 72, 72);
            wave_mma<2, 2>(a2, RC_M(2) + rt * 16 * 72, 72, RC_M(5) + hf * 32 * 72, 72);
            wave_mma<2, 2>(a3, RC_M(4) + rt * 16 * 72, 72, RC_M(5) + hf * 32 * 72, 72);
#pragma unroll
            for (int nt = 0; nt < 2; ++nt) { const int n0 = 32 * hf + 16 * nt + 4 * fq; f32x4 nn, ti, mk;
#pragma unroll
                for (int r = 0; r < 4; ++r) { const int n = n0 + r; const bool lt = m0 < n, le = m0 <= n;
                    nn[r] = lt ? -a0[nt][r] : 0.f; ti[r] = nn[r] + (m0 == n ? 1.f : 0.f); mk[r] = lt ? a1[nt][r] : 0.f; mkr[nt][r] = le ? a3[nt][r] : 0.f;
                    RC_M(12)[n * 72 + m0] = (bf16_t)f2bf(le ? a2[nt][r] : 0.f);
                    RC_M(8)[n * 72 + m0] = (bf16_t)f2bf(nn[r]);
                    khr[nt][r] = bf2f(RC_M(4)[m0 * 72 + n]); rhT[nt][r] = bf2f(RC_M(5)[n * 72 + m0]); }
                st_bf4(RC_M(7) + m0 * 72 + n0, nn); st_bf4(RC_M(9) + m0 * 72 + n0, ti); st_bf4(RC_M(11) + m0 * 72 + n0, mk); }
        }
        LDS_BARRIER();
        f32x4 tiv[2];
#pragma unroll
        for (int nt = 0; nt < 2; ++nt) tiv[nt] = ld_bf4(RC_M(9) + m0 * 72 + 32 * hf + 16 * nt + 4 * fq);
#pragma unroll 1
        for (int it = 0; it < 5; ++it) {
            bf16_t* pw = (it & 1) ? RC_M(0) : RC_M(7); bf16_t* pwT = (it & 1) ? RC_M(2) : RC_M(8); bf16_t* pw2 = (it & 1) ? RC_M(7) : RC_M(0); bf16_t* pw2T = (it & 1) ? RC_M(8) : RC_M(2);
            bf16_t* tcur = (it & 1) ? RC_M(4) : RC_M(9); bf16_t* tnxt = (it & 1) ? RC_M(9) : RC_M(4);
            f32x4 sq[2];
#pragma unroll
            for (int nt = 0; nt < 2; ++nt) sq[nt] = (f32x4){0.f, 0.f, 0.f, 0.f};
            wave_mma<2, 2>(sq, pw + rt * 16 * 72, 72, pwT + hf * 32 * 72, 72);
#pragma unroll
            for (int nt = 0; nt < 2; ++nt) { const int n0 = 32 * hf + 16 * nt + 4 * fq; st_bf4(pw2 + m0 * 72 + n0, sq[nt]);
#pragma unroll
                for (int r = 0; r < 4; ++r) pw2T[(n0 + r) * 72 + m0] = (bf16_t)f2bf(sq[nt][r]); }
            LDS_BARRIER();
            f32x4 up[2];
#pragma unroll
            for (int nt = 0; nt < 2; ++nt) up[nt] = (f32x4){0.f, 0.f, 0.f, 0.f};
            wave_mma<2, 2>(up, tcur + rt * 16 * 72, 72, pw2T + hf * 32 * 72, 72);
#pragma unroll
            for (int nt = 0; nt < 2; ++nt) { const int n0 = 32 * hf + 16 * nt + 4 * fq; tiv[nt] += up[nt]; st_bf4(tnxt + m0 * 72 + n0, tiv[nt]);
                if (it == 4) {
#pragma unroll
                    for (int r = 0; r < 4; ++r) RC_M(10)[(n0 + r) * 72 + m0] = (bf16_t)f2bf(tiv[nt][r]); } }
            LDS_BARRIER();
        }
        {
            f32x4 w1[2], w2[2];
#pragma unroll
            for (int nt = 0; nt < 2; ++nt) { w1[nt] = (f32x4){0.f, 0.f, 0.f, 0.f}; w2[nt] = w1[nt]; }
            wave_mma<2, 2>(w1, RC_M(1) + rt * 16 * 72, 72, RC_M(10) + hf * 32 * 72, 72);
            wave_mma<2, 2>(w2, RC_M(11) + rt * 16 * 72, 72, RC_M(10) + hf * 32 * 72, 72);
#pragma unroll
            for (int nt = 0; nt < 2; ++nt) { const int n0 = 32 * hf + 16 * nt + 4 * fq; st_bf4(RC_M(7) + m0 * 72 + n0, w1[nt]); st_bf4(RC_M(8) + m0 * 72 + n0, w2[nt]); }
        }
        LDS_BARRIER();
        {
            f32x4 py[2], qy[2], ps[2], qs[2];
#pragma unroll
            for (int nt = 0; nt < 2; ++nt) { py[nt] = (f32x4){0.f, 0.f, 0.f, 0.f}; qy[nt] = py[nt]; ps[nt] = py[nt]; qs[nt] = py[nt]; }
            wave_mma<2, 2>(py, RC_M(7) + rt * 16 * 72, 72, RC_M(12) + hf * 32 * 72, 72);
            wave_mma<2, 2>(qy, RC_M(8) + rt * 16 * 72, 72, RC_M(12) + hf * 32 * 72, 72);
            wave_mma<2, 2>(ps, RC_M(7) + rt * 16 * 72, 72, RC_M(3) + hf * 32 * 72, 72);
            wave_mma<2, 2>(qs, RC_M(8) + rt * 16 * 72, 72, RC_M(3) + hf * 32 * 72, 72);
#pragma unroll
            for (int nt = 0; nt < 2; ++nt) { const int n0 = 32 * hf + 16 * nt + 4 * fq;
#pragma unroll
                for (int r = 0; r < 4; ++r) { const int n = n0 + r; const float gln = gl[n];
                    RC_M(0)[n * 72 + m0] = (bf16_t)f2bf(rhT[nt][r] - py[nt][r]); RC_M(2)[n * 72 + m0] = (bf16_t)f2bf(mkr[nt][r] - qy[nt][r]);
                    RC_M(4)[n * 72 + m0] = (bf16_t)f2bf(((m0 == n ? 1.f : 0.f) - ps[nt][r]) * gln); RC_M(5)[n * 72 + m0] = (bf16_t)f2bf((khr[nt][r] - qs[nt][r]) * gln); } }
        }
        LDS_BARRIER();
        {
            f32x4 yv[2], sv[2];
#pragma unroll
            for (int nt = 0; nt < 2; ++nt) { yv[nt] = (f32x4){0.f, 0.f, 0.f, 0.f}; sv[nt] = yv[nt]; }
            wave_mma<2, 2>(yv, RC_M(6) + rt * 16 * 72, 72, RC_M(2) + hf * 32 * 72, 72);
            wave_mma<2, 2>(sv, RC_M(6) + rt * 16 * 72, 72, RC_M(5) + hf * 32 * 72, 72);
#pragma unroll
            for (int nt = 0; nt < 2; ++nt) { const int n0 = 32 * hf + 16 * nt + 4 * fq; st_bf4(YVB + (size_t)u * 4096 + m0 * 64 + n0, yv[nt]); st_bf4(SVB + (size_t)u * 4096 + m0 * 64 + n0, sv[nt]); }
            { const int rr = tid >> 3, c8 = (tid & 7) * 8; *(u32x4*)(PYT + (size_t)u * 4096 + rr * 64 + c8) = *(const u32x4*)(RC_M(0) + rr * 72 + c8); *(u32x4*)(PST + (size_t)u * 4096 + rr * 64 + c8) = *(const u32x4*)(RC_M(4) + rr * 72 + c8); }
        }
        LDS_BARRIER();
    }
}
#undef RC_M
#undef RC_LOAD
__device__ __forceinline__ void ph_rw_seq(const Ctx& c, float* ldsf) {
    const bf16_t* PST = WSH(O_PST); const bf16_t* PYT = WSH(O_PYT); const bf16_t* SVB = WSH(O_SVB); const bf16_t* YVB = WSH(O_YVB); bf16_t* YY = WSH(O_YY);
    bf16_t* Sb = (bf16_t*)ldsf;
    bf16_t* Pm = Sb + 2 * 16 * 72;
    const int tid = threadIdx.x, wv = tid >> 6, lane = tid & 63, fr = lane & 15, fq = lane >> 4, nt0 = wv & 3;
#ifdef CPU_EMU
    const int isY = wv >> 2;
#else
    const int isY = __builtin_amdgcn_readfirstlane(wv >> 2);
#endif
    for (int u = blockIdx.x; u < 256; u += gridDim.x) {
        const int x = u & 7, jq = u >> 3, chain = x * 8 + (jq >> 2), qt = jq & 3, h = chain & 15, b = (chain >> 4) & 1, z = chain >> 5;
        const size_t ub = (size_t)chain * NRC;
        const int rr = tid >> 3, c8 = (tid & 7) * 8;
        constexpr int PD = NRC >= 8 ? 8 : 4;
        for (int i = tid; i < 2 * 16 * 72 / 2; i += NT) ((unsigned*)Sb)[i] = 0u;
        const int row = 16 * qt + fr, n0 = 16 * nt0 + 4 * fq; const bf16_t* addp = (isY ? YVB : SVB) + ub * 4096 + row * 64 + n0;
        const bf16_t* psp = PST + ub * 4096 + rr * 64 + c8; const bf16_t* pyp = PYT + ub * 4096 + rr * 64 + c8;
        u32x4 gps[PD], gpy[PD]; unsigned long long addr[PD];
#pragma unroll
        for (int j = 0; j < PD; ++j) { gps[j] = *(const u32x4*)(psp + (size_t)j * 4096); gpy[j] = *(const u32x4*)(pyp + (size_t)j * 4096); addr[j] = *(const unsigned long long*)(addp + (size_t)j * 4096); }
        *(u32x4*)(Pm + (0 * 2 + 0) * 4608 + rr * 72 + c8) = gps[0]; *(u32x4*)(Pm + (0 * 2 + 1) * 4608 + rr * 72 + c8) = gpy[0];
        { const int cl = PD < NRC ? PD : NRC - 1; gps[0] = *(const u32x4*)(psp + (size_t)cl * 4096); gpy[0] = *(const u32x4*)(pyp + (size_t)cl * 4096); }
        SYNCTHREADS();
#define RS_LOOP(ISY) \
        for (int ck0 = 0; ck0 < NRC; ck0 += PD) { \
            _Pragma("unroll") for (int j = 0; j < PD; ++j) { \
                const int ck = ck0 + j, cur = j & 1, nxt = cur ^ 1;        \
                f32x4 acc[1]; acc[0] = (f32x4){0.f, 0.f, 0.f, 0.f}; \
                wave_mma<2, 1>(acc, Sb + cur * 16 * 72, 72, Pm + (cur * 2 + ISY) * 4608 + nt0 * 16 * 72, 72); \
                { const unsigned lo_ = (unsigned)addr[j], hi_ = (unsigned)(addr[j] >> 32); acc[0][0] += bflo(lo_); acc[0][1] += bfhi(lo_); acc[0][2] += bflo(hi_); acc[0][3] += bfhi(hi_); } \
                { const int cl = ck + PD < NRC ? ck + PD : NRC - 1; addr[j] = *(const unsigned long long*)(addp + (size_t)cl * 4096); } \
                if (ISY) { \
                    _Pragma("unroll") for (int r = 0; r < 4; ++r) { const int step = ck * RCK + n0 + r, sidx = z ? S - 1 - step : step; YY[((size_t)z * T + (size_t)b * S + sidx) * W + h * 64 + row] = (bf16_t)f2bf(acc[0][r]); } \
                } else st_bf4(Sb + nxt * 16 * 72 + fr * 72 + n0, acc[0]); \
                const int jn = (j + 1) % PD; \
                *(u32x4*)(Pm + (nxt * 2 + 0) * 4608 + rr * 72 + c8) = gps[jn]; *(u32x4*)(Pm + (nxt * 2 + 1) * 4608 + rr * 72 + c8) = gpy[jn]; \
                { const int cl = ck + 1 + PD < NRC ? ck + 1 + PD : NRC - 1; gps[jn] = *(const u32x4*)(psp + (size_t)cl * 4096); gpy[jn] = *(const u32x4*)(pyp + (size_t)cl * 4096); } \
                LDS_BARRIER(); \
            } \
        }
        if (isY) { RS_LOOP(1) } else { RS_LOOP(0) }
#undef RS_LOOP
    }
}
__device__ __forceinline__ void ph_rw_out(const Ctx& c) {
    const bf16_t* FS = WSH(O_FS); const bf16_t* YY = WSH(O_YY); const float* BON = WSF(O_BON); const bf16_t* GG = WSH(O_GG); bf16_t* Y = WSH(O_YS);
    const int lane = threadIdx.x & 63, gw = blockIdx.x * (NT / 64) + (threadIdx.x >> 6), ngw = gridDim.x * (NT / 64);
    for (int i0 = gw; i0 < T * 2; i0 += 2 * ngw) {
        u32x4 a0[2], a1[2], gq[2], vq[2]; float bs[2];
#pragma unroll
        for (int r = 0; r < 2; ++r) { const int i = i0 + r * ngw < T * 2 ? i0 + r * ngw : i0; const long t = i >> 1; const int ch = (i & 1) * 512 + lane * 8, hd = ch >> 6;
            a0[r] = *(const u32x4*)(YY + (size_t)t * W + ch); a1[r] = *(const u32x4*)(YY + ((size_t)T + t) * W + ch); gq[r] = *(const u32x4*)(GG + (size_t)t * W + ch); vq[r] = *(const u32x4*)(FS + (size_t)t * RF + 2048 + ch);
            bs[r] = BON[(size_t)t * 16 + hd] + BON[((size_t)T + t) * 16 + hd]; }
#pragma unroll
        for (int r = 0; r < 2; ++r) { const int i = i0 + r * ngw < T * 2 ? i0 + r * ngw : i0; const long t = i >> 1; const int ch = (i & 1) * 512 + lane * 8;
            float y0[8], y1[8], s0 = 0.f, s1 = 0.f;
#pragma unroll
            for (int e = 0; e < 4; ++e) { y0[2 * e] = bflo(a0[r][e]); y0[2 * e + 1] = bfhi(a0[r][e]); y1[2 * e] = bflo(a1[r][e]); y1[2 * e + 1] = bfhi(a1[r][e]); }
#pragma unroll
            for (int e = 0; e < 8; ++e) { s0 += y0[e]; s1 += y1[e]; }
            const float m0 = red8_(s0) * (1.f / 64.f), m1 = red8_(s1) * (1.f / 64.f); float q0 = 0.f, q1 = 0.f;
#pragma unroll
            for (int e = 0; e < 8; ++e) { y0[e] -= m0; y1[e] -= m1; q0 += y0[e] * y0[e]; q1 += y1[e] * y1[e]; }
            const float r0 = 1.f / sqrtf(red8_(q0) * (1.f / 64.f) + EPS), r1 = 1.f / sqrtf(red8_(q1) * (1.f / 64.f) + EPS);
            u32x4 o;
#pragma unroll
            for (int e = 0; e < 4; ++e) { const float lo = (y0[2 * e] * r0 + y1[2 * e] * r1 + bs[r] * bflo(vq[r][e])) * bflo(gq[r][e]), hi = (y0[2 * e + 1] * r0 + y1[2 * e + 1] * r1 + bs[r] * bfhi(vq[r][e])) * bfhi(gq[r][e]); o[e] = pk2(lo, hi); }
            *(u32x4*)(Y + (size_t)t * 4 * W + 3 * W + ch) = o; }
    }
}
__device__ __forceinline__ void ph_router(const Ctx& c, int l, float* ldsf, const float* X, const float* gN, const float* shN, const float* scN) {
    const float* RS = WSF(O_HF); const bf16_t* WH = WSH(O_WRH); const bf16_t* WL = WSH(O_WRL); const float* bg = c.in[31] + (size_t)l * 4; const float* be = c.in[33] + (size_t)l * 32;
    int* EID = WSI(O_EID); float* EWT = WSF(O_EWT); int* cnt = CTLW(c) + CW_CNT + l * 64;
    const int tid = threadIdx.x, wv = tid >> 6, lane = tid & 63, fr = lane & 15, fq = lane >> 4, rt = wv & 1, kq = wv >> 1;
    float* part = ldsf;
    for (int u = blockIdx.x; u < T / 32; u += gridDim.x) {
        const long t0 = (long)u * 32; f32x4 acc[3];
#pragma unroll
        for (int nt = 0; nt < 3; ++nt) acc[nt] = (f32x4){0.f, 0.f, 0.f, 0.f};
#ifdef CPU_EMU
        for (int nt = 0; nt < 3; ++nt) for (int r = 0; r < 4; ++r) { const int n = 16 * nt + 4 * fq + r; float sacc = 0.f;
            for (int k = kq * 512; k < kq * 512 + 512; ++k) { const long tr = t0 + 16 * rt + fr; const int bb = (int)(tr / S); const float hv = X[(size_t)tr * D + k] * RS[tr] * gN[k] * (1.f + scN[bb * D6 + k]) + shN[bb * D6 + k]; const float hh = bf2f((bf16_t)f2bf(hv)), hl = bf2f((bf16_t)f2bf(hv - hh));
                const float wh = bf2f(WH[(size_t)n * D + k]), wl = bf2f(WL[(size_t)n * D + k]); sacc += hh * wh + hl * wh + hh * wl; }
            acc[nt][r] = sacc; }
#else
        const long tr = t0 + 16 * rt + fr; const int bb = (int)(tr / S); const float rsv = RS[tr]; const int kb = kq * 512 + fq * 8;
        const float* hp = X + (size_t)tr * D + kb; const float* gp_ = gN + kb; const float* scp = scN + bb * D6 + kb; const float* shp = shN + bb * D6 + kb;
#pragma unroll 4
        for (int ks = 0; ks < 16; ++ks) {
            const f32x4 h0 = *(const f32x4*)(hp + ks * 32) * rsv * *(const f32x4*)(gp_ + ks * 32) * (*(const f32x4*)(scp + ks * 32) + 1.f) + *(const f32x4*)(shp + ks * 32);
            const f32x4 h1 = *(const f32x4*)(hp + ks * 32 + 4) * rsv * *(const f32x4*)(gp_ + ks * 32 + 4) * (*(const f32x4*)(scp + ks * 32 + 4) + 1.f) + *(const f32x4*)(shp + ks * 32 + 4); bf16x8 ah, al;
#pragma unroll
            for (int e = 0; e < 4; ++e) { const unsigned b0 = f2bf(h0[e]), b1 = f2bf(h1[e]); ah[e] = (short)b0; ah[4 + e] = (short)b1; al[e] = (short)f2bf(h0[e] - u2f_(b0 << 16)); al[4 + e] = (short)f2bf(h1[e] - u2f_(b1 << 16)); }
#pragma unroll
            for (int nt = 0; nt < 3; ++nt) { const size_t wo = (size_t)(16 * nt + fr) * D + kq * 512 + ks * 32 + fq * 8; const bf16x8 bh = *(const bf16x8*)(WH + wo), bl = *(const bf16x8*)(WL + wo);
                acc[nt] = __builtin_amdgcn_mfma_f32_16x16x32_bf16(bh, ah, acc[nt], 0, 0, 0); acc[nt] = __builtin_amdgcn_mfma_f32_16x16x32_bf16(bh, al, acc[nt], 0, 0, 0); acc[nt] = __builtin_amdgcn_mfma_f32_16x16x32_bf16(bl, ah, acc[nt], 0, 0, 0); }
        }
#endif
#pragma unroll
        for (int nt = 0; nt < 3; ++nt) *(f32x4*)(part + (kq * 32 + 16 * rt + fr) * 48 + 16 * nt + 4 * fq) = acc[nt];
        SYNCTHREADS();
        if (tid < 32) { const long t = t0 + tid; float lg[36];
#pragma unroll
            for (int q = 0; q < 36; ++q) lg[q] = (part[(0 * 32 + tid) * 48 + q] + part[(1 * 32 + tid) * 48 + q]) + (part[(2 * 32 + tid) * 48 + q] + part[(3 * 32 + tid) * 48 + q]) + (q < 4 ? bg[q < 4 ? q : 0] : be[q >= 4 ? q - 4 : 0]);
            int gi = 0; float m = lg[0];
#pragma unroll
            for (int q = 1; q < 4; ++q) if (lg[q] > m) { m = lg[q]; gi = q; }
            float den = 0.f;
#pragma unroll
            for (int q = 0; q < 4; ++q) den += expf(lg[q] - m);
            const float gp = 1.f / den; float el[8];
#pragma unroll
            for (int q = 0; q < 8; ++q) el[q] = gi == 0 ? lg[4 + q] : gi == 1 ? lg[12 + q] : gi == 2 ? lg[20 + q] : lg[28 + q];
            int i1 = 0; float m1 = el[0];
#pragma unroll
            for (int q = 1; q < 8; ++q) if (el[q] > m1) { m1 = el[q]; i1 = q; }
            int i2 = -1; float m2 = 0.f;
#pragma unroll
            for (int q = 0; q < 8; ++q) if (q != i1 && (i2 < 0 || el[q] > m2)) { m2 = el[q]; i2 = q; }
            const float p2 = expf(m2 - m1);
            EID[t * 2] = gi * 8 + i1; EID[t * 2 + 1] = gi * 8 + i2; EWT[t * 2] = gp / (1.f + p2); EWT[t * 2 + 1] = gp * p2 / (1.f + p2);
            atomic_add_i(cnt + gi * 8 + i1, 1); atomic_add_i(cnt + gi * 8 + i2, 1);
        }
        SYNCTHREADS();
    }
}
__device__ __forceinline__ void ph_moe_assign(const Ctx& c, int l, float* ldsf) {
    const int* cnt = CTLW(c) + CW_CNT + l * 64; int* plan = CTLW(c) + CW_PLAN + l * 256; const int* EID = WSI(O_EID); int* fill = CTLW(c) + CW_FILL + l * 64; int* DEST = WSI(O_DEST);
    int* pstart = (int*)ldsf;
    if (threadIdx.x == 0) { int ps = 0, nb = 0; const bool pub = blockIdx.x == 0;
        for (int e = 0; e < NE; ++e) { pstart[e] = ps; if (pub) plan[e] = ps; const int nblk = (cnt[e] + 255) / 256; if (pub) for (int q = 0; q < nblk; ++q) plan[64 + nb + q] = e; nb += nblk; ps += nblk * 256; }
        if (pub) { plan[32] = ps; plan[40] = nb; } }
    SYNCTHREADS();
    for (long i = GT_; i < (long)T * 2; i += GS_) { const int e = EID[i]; const int pos = atomic_add_i(fill + e, 1); DEST[i] = pstart[e] + pos; }
    SYNCTHREADS();
}
__device__ __forceinline__ void ph_moe_gather(const Ctx& c) {
    const int* DEST = WSI(O_DEST); const u32x4* H = (const u32x4*)WSH(O_H); u32x4* XS = (u32x4*)WSH(O_XS);
    for (long i = GT_; i < (long)T * 2 * (D / 8); i += GS_) { const int q = (int)(i % (D / 8)); const long a = i / (D / 8); XS[(size_t)DEST[a] * (D / 8) + q] = H[(size_t)(a >> 1) * (D / 8) + q]; }
}
#ifndef CPU_EMU
#define XB_TMO      128
#define XB_XCNT(j)  (256  + 64 * (j))
#define XB_XSUB(j)  (1280 + 64 * (j))
#define XB_XGEN(j)  (2304 + 64 * (j))
#define XB_TOP      3328
#define XB_TOPGEN   3392
#define XCD_BAR_WORDS 3456
#define XB_SPIN_CAP (1u << 26)
#define LAS __attribute__((address_space(3)))
__device__ __forceinline__ unsigned xb_ld(unsigned* p)              { return __hip_atomic_load(p, __ATOMIC_RELAXED, __HIP_MEMORY_SCOPE_AGENT); }
__device__ __forceinline__ unsigned xb_add(unsigned* p, unsigned v) { return __hip_atomic_fetch_add(p, v, __ATOMIC_RELAXED, __HIP_MEMORY_SCOPE_AGENT); }
__device__ __forceinline__ unsigned xb_xcc_id() { return (unsigned)__builtin_amdgcn_s_getreg((3 << 11) | 20) & 0xFu; }
#define XB_SPIN(cond, bar) do { unsigned _sp = 0; while (cond) { __builtin_amdgcn_s_sleep(1); \
    if ((++_sp & 255u) == 0u) { if (xb_ld(&(bar)[XB_TMO])) break; if (_sp > XB_SPIN_CAP) { atomicAdd(&(bar)[XB_TMO], 1u); break; } } } } while (0)
struct XcdBarrier { unsigned* bar; unsigned x; volatile LAS unsigned* st; };
__device__ __forceinline__ XcdBarrier xcd_barrier_post(unsigned* bar, volatile LAS unsigned* st) {
    XcdBarrier b; b.bar = bar; b.x = xb_xcc_id(); b.st = st;
    if (threadIdx.x == 0) (void)xb_add(&bar[XB_XCNT(b.x)], 1u);
    return b;
}
__device__ __forceinline__ void xcd_barrier_complete(unsigned* bar, unsigned x, unsigned& nloc, unsigned& nx) {
    const unsigned G = gridDim.x * gridDim.y * gridDim.z;
    unsigned sum, cnt, mine, sp = 0u;
    for (;;) {
        sum = 0u; cnt = 0u; mine = 0u;
#pragma unroll
        for (unsigned j = 0; j < 16; ++j) { const unsigned cc = xb_ld(&bar[XB_XCNT(j)]); sum += cc; cnt += (cc > 0u) ? 1u : 0u; mine = (j == x) ? cc : mine; }
        if (sum == G) break;
        __builtin_amdgcn_s_sleep(1);
        if ((++sp & 255u) == 0u) { if (xb_ld(&bar[XB_TMO])) break; if (sp > XB_SPIN_CAP) { atomicAdd(&bar[XB_TMO], 1u); break; } }
    }
    nloc = mine > 0u ? mine : 1u; nx = cnt > 0u ? cnt : 1u;
}
__device__ __forceinline__ void xcd_barrier(const XcdBarrier& b) {
    asm volatile("s_waitcnt vmcnt(0)" ::: "memory");
    __syncthreads();
    if (threadIdx.x == 0) {
        unsigned* bar = b.bar;
        __builtin_amdgcn_s_waitcnt(0);
        unsigned nloc = b.st[0], nx = b.st[1];
        if (nloc == 0u) { xcd_barrier_complete(bar, b.x, nloc, nx); b.st[0] = nloc; b.st[1] = nx; }
        const unsigned old = xb_add(&bar[XB_XSUB(b.x)], 1u);
        const unsigned gen = old / nloc;
        if (old + 1u == (gen + 1u) * nloc) {
            __builtin_amdgcn_fence(__ATOMIC_RELEASE, "agent");
            asm volatile("s_waitcnt vmcnt(0)" ::: "memory");
            const unsigned og = xb_add(&bar[XB_TOP], 1u);
            const unsigned tg = og / nx;
            if (og + 1u == (tg + 1u) * nx) xb_add(&bar[XB_TOPGEN], 1u);
            else XB_SPIN(xb_ld(&bar[XB_TOPGEN]) == tg, bar);
            __builtin_amdgcn_fence(__ATOMIC_ACQUIRE, "agent");
            xb_add(&bar[XB_XGEN(b.x)], 1u);
            asm volatile("s_waitcnt vmcnt(0)" ::: "memory");
        } else {
            XB_SPIN(xb_ld(&bar[XB_XGEN(b.x)]) == gen, bar);
            __builtin_amdgcn_fence(__ATOMIC_ACQUIRE, "agent");
            asm volatile("s_waitcnt vmcnt(0)" ::: "memory");
        }
    }
    __syncthreads();
}
#endif

constexpr int LDS_BYTES = 147456;

__global__ void __launch_bounds__(NT, 2) fwd(Params p) {
#ifdef CPU_EMU
    unsigned char* lds = g_lds; float* ldsf = (float*)g_lds;
#else
    extern __shared__ __attribute__((aligned(16))) unsigned char lds[];
    float* ldsf = (float*)lds;
    volatile LAS unsigned* misc = (volatile LAS unsigned*)((LAS unsigned char*)lds + LDS_BYTES - 64);
    if (threadIdx.x == 0) { misc[0] = 0u; misc[1] = 0u; }
    __syncthreads();
    XcdBarrier bar = xcd_barrier_post((unsigned*)(p.ws + O_CTL) + CW_BAR, misc);
#endif
    Ctx c; c.in = p.in; c.out = p.out; c.ws = p.ws;
    const int lo = p.ph_lo, hi = p.ph_hi; int ph = 0;
    const int G = (int)gridDim.x, cwg = (int)blockIdx.x;
#ifdef CPU_EMU
#define GRID_BAR()
#else
#define GRID_BAR() xcd_barrier(bar)
#endif
#ifndef REPEAT_MASK
#define REPEAT_MASK 0
#endif
#ifndef TIME_PHASE
#define TIME_PHASE -1
#endif
#if TIME_PHASE >= 0 && !defined(CPU_EMU)
    unsigned long long tp0 = 0, tp1 = 0;
#define TP_BEGIN() do { if (ph == TIME_PHASE) tp0 = __builtin_amdgcn_s_memrealtime(); } while (0)
#define TP_END() do { if (ph == TIME_PHASE) tp1 = __builtin_amdgcn_s_memrealtime(); } while (0)
#else
#define TP_BEGIN()
#define TP_END()
#endif
#define PHASE(...) do { if (lo <= ph && ph < hi) { TP_BEGIN(); __VA_ARGS__; if (ph + 1 < hi) { GRID_BAR(); } TP_END(); } ++ph; } while (0)
#define PHASEG(grp, ...) do { if (lo <= ph && ph < hi) { TP_BEGIN(); if ((REPEAT_MASK >> (grp)) & 1) { __VA_ARGS__; GRID_BAR(); } __VA_ARGS__; if (ph + 1 < hi) { GRID_BAR(); } TP_END(); } ++ph; } while (0)
    PHASE(ph_mod(c, ldsf); ph_rope_table(c); ph_convert(c, 0, ldsf));
#define LAYER_BODY(l) do { const float* mod = WSF(O_MOD); \
        const float* xin = l == 0 ? c.in[0] : WSF(O_X1); float* xmid = WSF(O_X0); float* xout = WSF(O_X1); \
        const float* ml = mod + (size_t)l * NB * D6; \
        PHASEG(0, { pg8::Gemm g{D, D, D}; pg8::StaticOrder so; so.init(T, PW, G, cwg, WSH(O_H), WSH(O_WIN), D, D); pg8::EpiP E{WSH(O_P), (unsigned char*)(c.ws + O_G8)}; pg8::gemm_phase(lds, g, so, E); \
            { const int nun_ = (T / 256) * (PW / 256), rem_ = nun_ % G; if (rem_ != 0 && cwg >= rem_) { SYNCTHREADS(); convert_big(c, l, ldsf, J_ALL - convert_tail_tiles(), J_ALL, cwg - rem_, G - rem_); } } }); \
        PHASE(ph_lru<1>(c, l, ldsf); ph_ret_kv(c, ldsf); ph_sgu_norm(c, l); ph_rw_shift(c, l)); \
        PHASE(ph_lru_scan2(c); ph_ret_state(c); ph_sgu_mix(c, l, ldsf); ph_rw_lora(c, l, ldsf)); \
        PHASE(ph_lru_fin(c, ldsf); ph_ret_out(c, ldsf); ph_rw_chunk(c, l, ldsf)); \
        PHASE(ph_rw_seq(c, ldsf)); \
        PHASE(ph_rw_out(c)); \
        PHASEG(1, { pg8::Gemm g{4 * W, 4 * W, 4 * W}; pg8::StaticOrder so; so.init(T, D, G, cwg, WSH(O_YS), WSH(O_WBR), 4 * W, 4 * W); pg8::EpiMerge E{(const unsigned char*)(c.ws + O_G8), WSH(O_MRG)}; pg8::gemm_phase(lds, g, so, E); }); \
        PHASEG(1, { pg8::Gemm g{D, D, D}; pg8::StaticOrder so; so.init(T, D, G, cwg, WSH(O_MRG), WSH(O_WOUT), D, D); pg8::EpiResid E{xin, ml + 2 * D, xmid}; pg8::gemm_phase(lds, g, so, E); }); \
        PHASEG(6, ph_norm(c, xmid, c.in[4] + (size_t)l * D, ml + 3 * D, ml + 4 * D, WSH(O_H), WSF(O_HF))); \
        PHASE(ph_router(c, l, ldsf, xmid, c.in[4] + (size_t)l * D, ml + 3 * D, ml + 4 * D)); \
        PHASE(ph_moe_assign(c, l, ldsf)); \
        PHASEG(6, ph_moe_gather(c)); \
        const int* plan = CTLW(c) + CW_PLAN + l * 256; \
        PHASEG(2, { pg8::Gemm g{D, D, D}; pg8::MoeOrder mo{G, cwg, 4, plan, (const char*)WSH(O_XS), (const char*)WSH(O_WGU), (size_t)256 * D * 2, (size_t)256 * D * 2, (size_t)1024 * D * 2}; pg8::EpiGU E{WSH(O_ACT)}; pg8::gemm_phase(lds, g, mo, E); \
            if (l == 0) { const int nrest_ = plan[40] * 4 - G; if (nrest_ >= 0 && nrest_ < G && cwg >= nrest_) { SYNCTHREADS(); convert_big(c, 1, ldsf, 0, convert_early_tiles(c), cwg - nrest_, G - nrest_); } } }); \
        PHASEG(2, { pg8::Gemm g{512, 512, 512}; pg8::MoeOrder mo{G, cwg, 8, plan, (const char*)WSH(O_ACT), (const char*)WSH(O_WDN), (size_t)256 * 512 * 2, (size_t)256 * 512 * 2, (size_t)D * 512 * 2}; pg8::EpiBf16 E{WSH(O_YE), D}; pg8::gemm_phase(lds, g, mo, E); }); \
        if (l == 0) PHASE(ph_comb_norm<0>(c, xmid, ml + 5 * D, xout, c.in[3] + (size_t)1 * D, mod + (size_t)1 * NB * D6 + 0 * D, mod + (size_t)1 * NB * D6 + 1 * D, WSH(O_H), nullptr); ph_convert(c, 1, ldsf)); \
        else PHASE(ph_comb_norm<1>(c, xmid, ml + 5 * D, xout, c.in[36], nullptr, nullptr, nullptr, c.out)); \
    } while (0)
    PHASE(ph_norm(c, c.in[0], c.in[3], WSF(O_MOD) + 0 * D, WSF(O_MOD) + 1 * D, WSH(O_H), nullptr));
    LAYER_BODY(0);
    LAYER_BODY(1);
#undef LAYER_BODY
#if TIME_PHASE >= 0 && !defined(CPU_EMU)
    if (blockIdx.x == 0) { const unsigned long long te = __builtin_amdgcn_s_memrealtime(), dl = 8ull * (tp1 - tp0); while (__builtin_amdgcn_s_memrealtime() - te < dl) __builtin_amdgcn_s_sleep(8); }
#endif
#undef PHASE
}
}

#ifndef CPU_EMU
extern "C" void kernel_launch(void* const* d_in, const int* in_sizes, int n_in, void* d_out, int out_size, void* d_ws, size_t ws_size, hipStream_t stream) {
    static int grid = 0;
    if (grid == 0) {
        if (n_in != 37 || out_size != T * D || ws_size < WS_END) { fprintf(stderr, "kernel_launch: unexpected shapes (n_in %d out %d ws %zu need %zu)\n", n_in, out_size, ws_size, (size_t)WS_END); grid = -1; return; }
        int dev = 0, cus = 0, per_cu = 0;
        if (hipGetDevice(&dev) != hipSuccess || hipDeviceGetAttribute(&cus, hipDeviceAttributeMultiprocessorCount, dev) != hipSuccess) { grid = -1; return; }
        if (hipFuncSetAttribute((const void*)fwd, hipFuncAttributeMaxDynamicSharedMemorySize, LDS_BYTES) != hipSuccess) { fprintf(stderr, "kernel_launch: hipFuncSetAttribute failed\n"); grid = -1; return; }
        if (hipOccupancyMaxActiveBlocksPerMultiprocessor(&per_cu, (const void*)fwd, NT, LDS_BYTES) != hipSuccess || per_cu < 1) fprintf(stderr, "kernel_launch: occupancy query says %d\n", per_cu);
        (void)hipGetLastError();
        grid = cus;
    }
    if (grid < 0) return;
    (void)in_sizes;
    (void)hipMemsetAsync((char*)d_ws + O_CTL, 0, CTL_BYTES, stream);
    Params p{};
    for (int i = 0; i < 37; ++i) p.in[i] = (const float*)d_in[i];
    p.out = (float*)d_out; p.ws = (unsigned char*)d_ws;
#if ONE_LAUNCH
    p.ph_lo = 0; p.ph_hi = NPH;
    hipLaunchKernelGGL(fwd, dim3(grid), dim3(NT), LDS_BYTES, stream, p);
#else
    for (int k = 0; k < NPH; ++k) { p.ph_lo = k; p.ph_hi = k + 1; hipLaunchKernelGGL(fwd, dim3(grid), dim3(NT), LDS_BYTES, stream, p); }
#endif
}
#endif
```

```cpp
#ifndef CPU_EMU
#include <hip/hip_runtime.h>
#endif
#include <cstdio>
#include <cstdint>
#include <cmath>
#include <cstring>

#ifndef SEQ
#define SEQ 4096
#endif
#ifndef ONE_LAUNCH
#define ONE_LAUNCH 1
#endif

namespace {
constexpr int D = 2048, NB = 2, S = SEQ, T = NB * S, NL = 2, W = 1024;
constexpr int INW = 18816, RF = 3456, D6 = 6 * D;
constexpr int C_LX = 0, C_LG = 1024, C_RQ = 2048, C_RK = 2560, C_RV = 3072, C_RG = 4096, C_SU = 5120, C_SV = 6144, C_RW = 7168;
constexpr int PW = 18944, C_MLP = 10752;
constexpr int NCH = S / 128;
constexpr int NLC = S / 64;
constexpr int NE = 32, CAP = (T * 2 / 256 + NE) * 256, MAXBLK = CAP / 256;
constexpr float EPS = 1e-6f;
constexpr float DECAY_SCALE = 0.60653065971263342f;
constexpr int NT = 512;
constexpr int NPH_LAYER = 13, NPH = 2 + NL * NPH_LAYER;
typedef unsigned short bf16_t;
#ifdef CPU_EMU
typedef float f32x4 __attribute__((vector_size(16)));
typedef unsigned u32x4 __attribute__((vector_size(16)));
#else
typedef float f32x4 __attribute__((ext_vector_type(4)));
typedef unsigned u32x4 __attribute__((ext_vector_type(4)));
typedef short bf16x8 __attribute__((ext_vector_type(8)));
#endif

constexpr size_t al256(size_t x) { return (x + 255) & ~(size_t)255; }
constexpr size_t SZ_X = (size_t)T * D * 4, SZ_W = (size_t)T * W * 4;
constexpr size_t O_CTL = 0, CTL_BYTES = 1u << 20;
constexpr size_t O_MOD = CTL_BYTES;
constexpr size_t O_X0 = O_MOD + al256((size_t)NL * NB * D6 * 4);
constexpr size_t O_X1 = O_X0 + SZ_X;
constexpr size_t O_H = O_X1 + SZ_X;
constexpr size_t O_HF = O_H + SZ_X / 2;
constexpr size_t O_P = O_HF + SZ_X;
constexpr size_t SZ_P = (size_t)T * PW * 2;
constexpr size_t O_XC = O_P + SZ_P;
constexpr size_t O_LA = O_XC + SZ_W, O_LU = O_LA + 2 * SZ_W;
constexpr size_t SZ_LC = (size_t)2 * NB * NLC * W * 4;
constexpr size_t O_LCA = O_LU + 2 * SZ_W, O_LCH = O_LCA + SZ_LC, O_LCI = O_LCH + SZ_LC;
constexpr size_t O_YS = O_LCI + SZ_LC;
constexpr size_t O_SC = O_YS + (size_t)T * 4 * W * 2;
constexpr size_t SZ_KV = (size_t)NB * NCH * 8 * 64 * 128 * 4;
constexpr size_t O_KVF = O_SC, O_KVB = O_KVF + SZ_KV, O_STF = O_KVB + SZ_KV, O_STB = O_STF + SZ_KV;
constexpr size_t O_VN = O_STB + SZ_KV;
constexpr size_t O_FS = O_VN + SZ_W;
constexpr size_t O_DEC = O_FS + al256((size_t)T * RF * 4), O_AA = O_DEC + 2 * SZ_W, O_AKK = O_AA + 2 * SZ_W;
constexpr size_t O_GG = O_AKK, O_YY = O_GG + SZ_W;
constexpr int RCK = 64, NRC = S / RCK;
constexpr size_t O_BON = O_YY + 2 * SZ_W;
constexpr size_t O_PART = O_BON + al256((size_t)2 * T * 16 * 4);
constexpr size_t O_MRG = O_PART + SZ_X;
constexpr size_t O_LOG = O_MRG + SZ_X / 2;
constexpr size_t O_EID = O_LOG + al256((size_t)T * 40 * 4), O_EWT = O_EID + al256((size_t)T * 2 * 4), O_DEST = O_EWT + al256((size_t)T * 2 * 4);
constexpr size_t O_SLOT = O_DEST + al256((size_t)T * 2 * 4);
constexpr size_t O_PST = O_SLOT + al256((size_t)CAP * 4), O_PYT = O_PST + (size_t)64 * NRC * 4096 * 2, O_SVB = O_PYT + (size_t)64 * NRC * 4096 * 2, O_YVB = O_SVB + (size_t)64 * NRC * 4096 * 4;
constexpr size_t O_WIN = O_YVB + (size_t)64 * NRC * 4096 * 4;
constexpr size_t O_WBR = O_WIN + (size_t)PW * D * 2;
constexpr size_t O_WOUT = O_WBR + (size_t)D * 4 * W * 2;
constexpr size_t O_WGU = O_WOUT + (size_t)D * D * 2;
constexpr size_t O_WDN = O_WGU + (size_t)NE * 1024 * D * 2;
constexpr size_t O_G8 = O_WDN + (size_t)NE * D * 512 * 2;
constexpr size_t O_ROPE = O_G8 + (size_t)T * 4 * D;
constexpr size_t O_WLR = O_ROPE + (size_t)T * 64 * 4;
constexpr size_t O_WUT = O_WLR + (size_t)32 * 128 * 128 * 2;
constexpr size_t O_WAT = O_WUT + (size_t)2 * W * 64 * 2;
constexpr size_t O_WGT = O_WAT + (size_t)2 * W * 64 * 2;
constexpr size_t O_WRH = O_WGT + (size_t)W * 128 * 2;
constexpr size_t O_WRL = O_WRH + (size_t)48 * D * 2;
constexpr size_t WS_END0 = O_WRL + (size_t)48 * D * 2;
constexpr size_t SZ_MOE = (size_t)CAP * (D + 512 + D) * 2;
constexpr bool MOE_OVERLAY = SZ_MOE <= SZ_P;
constexpr size_t O_XS = MOE_OVERLAY ? O_P : WS_END0;
constexpr size_t O_ACT = O_XS + (size_t)CAP * D * 2;
constexpr size_t O_YE = O_ACT + (size_t)CAP * 512 * 2;
constexpr size_t WS_END = MOE_OVERLAY ? WS_END0 : WS_END0 + SZ_MOE;
static_assert(SEQ != 4096 || WS_END <= (size_t)2040 * 1024 * 1024, "workspace budget: d_ws is 4 x the largest input = 2048 MiB");
constexpr int CW_BAR = 4096;
constexpr int CW_CNT = 32768;
constexpr int CW_FILL = CW_CNT + NL * 64;
constexpr int CW_PLAN = CW_FILL + NL * 64;
static_assert(MAXBLK <= 160, "plan words");

struct Params { const float* in[37]; float* out; unsigned char* ws; int ph_lo, ph_hi; };

struct Ctx { const float* const* in; float* out; unsigned char* ws; };
#define GT_ ((long)blockIdx.x * NT + threadIdx.x)
#define GS_ ((long)gridDim.x * NT)
#define WSF(off) ((float*)(c.ws + (off)))
#define WSI(off) ((int*)(c.ws + (off)))
#define WSH(off) ((bf16_t*)(c.ws + (off)))
#define CTLW(c) ((int*)((c).ws + O_CTL))

#ifdef CPU_EMU
__device__ __forceinline__ float fexp_(float x) { return expf(x); }
__device__ __forceinline__ float frcp_(float x) { return 1.f / x; }
__device__ __forceinline__ float frsq_(float x) { return 1.f / sqrtf(x); }
__device__ __forceinline__ float fsqrt_(float x) { return sqrtf(x); }
#else
__device__ __forceinline__ float fexp_(float x) { return __builtin_amdgcn_exp2f(x * 1.4426950408889634f); }
__device__ __forceinline__ float frcp_(float x) { return __builtin_amdgcn_rcpf(x); }
__device__ __forceinline__ float frsq_(float x) { return __builtin_amdgcn_rsqf(x); }
__device__ __forceinline__ float fsqrt_(float x) { return __builtin_amdgcn_sqrtf(x); }
#endif
__device__ __forceinline__ float sigmoidf_(float x) { return frcp_(1.f + fexp_(-x)); }
__device__ __forceinline__ float siluf_(float x) { return x * frcp_(1.f + fexp_(-x)); }
__device__ __forceinline__ float tanhf_(float x) { return 1.f - 2.f * frcp_(1.f + fexp_(2.f * x)); }
#ifdef CPU_EMU
__device__ __forceinline__ float geluf_(float x) { return 0.5f * x * (1.f + tanhf_(0.7978845608028654f * (x + 0.044715f * x * x * x))); }
#else
__device__ __forceinline__ float geluf_(float x) { return x * __builtin_amdgcn_rcpf(1.f + __builtin_amdgcn_exp2f(-x * (2.3022082f + 0.10294324f * x * x))); }
#endif
__device__ __forceinline__ float softplusf_(float x) { return x > 0.f ? x + log1pf(expf(-x)) : log1pf(expf(x)); }
__device__ __forceinline__ float loggamma_(int h) { return log1pf(-exp2f(-5.f - (float)h)); }
__device__ __forceinline__ unsigned f2u_(float f) { unsigned u; memcpy(&u, &f, 4); return u; }
__device__ __forceinline__ float u2f_(unsigned u) { float f; memcpy(&f, &u, 4); return f; }
__device__ __forceinline__ float bf2f(bf16_t v) { return u2f_((unsigned)v << 16); }
#ifdef CPU_EMU
__device__ __forceinline__ unsigned f2bf(float f) { const unsigned u = f2u_(f); return (u + 0x7fffu + ((u >> 16) & 1u)) >> 16; }
__device__ __forceinline__ unsigned pk2(float lo, float hi) { return f2bf(lo) | (f2bf(hi) << 16); }
#else
typedef __attribute__((ext_vector_type(2))) __bf16 hwbf2_t; typedef __attribute__((ext_vector_type(2))) float hwf2_t;
__device__ __forceinline__ unsigned f2bf(float f) { const __bf16 s = (__bf16)f; return (unsigned)__builtin_bit_cast(unsigned short, s); }
__device__ __forceinline__ unsigned pk2(float lo, float hi) { const hwf2_t v = {lo, hi}; return __builtin_bit_cast(unsigned, __builtin_convertvector(v, hwbf2_t)); }
#endif
__device__ __forceinline__ float bflo(unsigned w) { return u2f_(w << 16); }
__device__ __forceinline__ float bfhi(unsigned w) { return u2f_(w & 0xffff0000u); }
__device__ __forceinline__ int atomic_add_i(int* p, int v) {
#ifdef CPU_EMU
    return __atomic_fetch_add(p, v, __ATOMIC_RELAXED);
#else
    return atomicAdd(p, v);
#endif
}
#define PF(P, r, col) bf2f((P)[(size_t)(r) * PW + (col)])
#ifdef CPU_EMU
#define SYNCTHREADS() emu_syncthreads()
#define LDS_BARRIER() emu_syncthreads()
#define SHFL_XOR(v, m) emu_shfl_xor(v, m)
#else
#define SYNCTHREADS() __syncthreads()
#define LDS_BARRIER() do { asm volatile("s_waitcnt lgkmcnt(0)" ::: "memory"); __builtin_amdgcn_s_barrier(); asm volatile("" ::: "memory"); } while (0)
#define SHFL_XOR(v, m) __shfl_xor(v, m)
#endif
#ifdef CPU_EMU
__device__ __forceinline__ float wave_sum(float v) {
    for (int o = 1; o < 64; o <<= 1) v += SHFL_XOR(v, o);
    return v;
}
#else
__device__ __forceinline__ float wave_sum(float x) {
    x += __builtin_bit_cast(float, __builtin_amdgcn_update_dpp(0, __builtin_bit_cast(int, x), 0xB1, 0xF, 0xF, true));
    x += __builtin_bit_cast(float, __builtin_amdgcn_update_dpp(0, __builtin_bit_cast(int, x), 0x4E, 0xF, 0xF, true));
    x += __builtin_bit_cast(float, __builtin_amdgcn_update_dpp(0, __builtin_bit_cast(int, x), 0x141, 0xF, 0xF, true));
    x += __builtin_bit_cast(float, __builtin_amdgcn_update_dpp(0, __builtin_bit_cast(int, x), 0x140, 0xF, 0xF, true));
    const int xi = __builtin_bit_cast(int, x);
    return (__builtin_bit_cast(float, __builtin_amdgcn_readlane(xi, 0)) + __builtin_bit_cast(float, __builtin_amdgcn_readlane(xi, 16))) + (__builtin_bit_cast(float, __builtin_amdgcn_readlane(xi, 32)) + __builtin_bit_cast(float, __builtin_amdgcn_readlane(xi, 48)));
}
#endif
__device__ __forceinline__ f32x4 ld_bf4(const bf16_t* p) { const unsigned long long q = *(const unsigned long long*)p; const unsigned lo = (unsigned)q, hi = (unsigned)(q >> 32); return (f32x4){bflo(lo), bfhi(lo), bflo(hi), bfhi(hi)}; }
__device__ __forceinline__ void st_bf4(bf16_t* p, const f32x4 v) { *(unsigned long long*)p = (unsigned long long)pk2(v[0], v[1]) | ((unsigned long long)pk2(v[2], v[3]) << 32); }

template <int KT, int NTL>
__device__ __forceinline__ void wave_mma(f32x4 (&acc)[NTL], const bf16_t* A, int lda, const bf16_t* Bt, int ldb) {
    const int lane = threadIdx.x & 63, fr = lane & 15, fq = lane >> 4;
#ifdef CPU_EMU
    for (int nt = 0; nt < NTL; ++nt) for (int r = 0; r < 4; ++r) { float sacc = 0.f; const bf16_t* a = A + fr * lda; const bf16_t* b = Bt + (16 * nt + 4 * fq + r) * ldb;
        for (int k = 0; k < 32 * KT; ++k) sacc += bf2f(a[k]) * bf2f(b[k]);
        acc[nt][r] += sacc; }
#else
#pragma unroll
    for (int kt = 0; kt < KT; ++kt) {
        const bf16x8 af = *(const bf16x8*)(A + fr * lda + kt * 32 + fq * 8);
#pragma unroll
        for (int nt = 0; nt < NTL; ++nt) { const bf16x8 bfr = *(const bf16x8*)(Bt + (16 * nt + fr) * ldb + kt * 32 + fq * 8);
            acc[nt] = __builtin_amdgcn_mfma_f32_16x16x32_bf16(bfr, af, acc[nt], 0, 0, 0); }
    }
#endif
}
__device__ __forceinline__ void ph_mod(const Ctx& c, float* ldsf) {
    const float* cc = c.in[1]; const float* aw = c.in[5]; const float* ab = c.in[6]; float* mod = WSF(O_MOD);
    float* scs = ldsf; float* part = ldsf + NB * D; const int tid = threadIdx.x, c4 = (tid & 31) * 4, kq = tid >> 5;
    for (int i = tid; i < NB * D; i += NT) scs[i] = siluf_(cc[i]);
    SYNCTHREADS();
    for (int u = blockIdx.x; u < NL * (D6 / 128); u += gridDim.x) {
        const int l = u / (D6 / 128), j0 = (u % (D6 / 128)) * 128;
        const float* w = aw + (size_t)l * D * D6 + j0 + c4; f32x4 a0 = (f32x4){0.f, 0.f, 0.f, 0.f}, a1 = a0;
#pragma unroll 8
        for (int k = kq * 128; k < kq * 128 + 128; ++k) { const f32x4 wv = *(const f32x4*)(w + (size_t)k * D6); a0 += wv * scs[k]; a1 += wv * scs[D + k]; }
        *(f32x4*)(part + (kq * 2 + 0) * 128 + c4) = a0; *(f32x4*)(part + (kq * 2 + 1) * 128 + c4) = a1;
        SYNCTHREADS();
        if (tid < 256) { const int b = tid >> 7, col = tid & 127; float sacc = 0.f;
#pragma unroll
            for (int q = 0; q < 16; ++q) sacc += part[(q * 2 + b) * 128 + col];
            mod[((size_t)l * NB + b) * D6 + j0 + col] = sacc + ab[l * D6 + j0 + col]; }
        SYNCTHREADS();
    }
}
__device__ __forceinline__ void ph_norm(const Ctx& c, const float* x, const float* g, const float* sh, const float* sc, bf16_t* hb, float* hf) {
    const int lane = threadIdx.x & 63, gw = blockIdx.x * (NT / 64) + (threadIdx.x >> 6), ngw = gridDim.x * (NT / 64);
    for (int t0 = gw * 2; t0 < T; t0 += ngw * 2) {
        f32x4 v[2][8]; float ss[2] = {0.f, 0.f};
#pragma unroll
        for (int r = 0; r < 2; ++r)
#pragma unroll
            for (int j = 0; j < 8; ++j) v[r][j] = *(const f32x4*)(x + (size_t)(t0 + r) * D + (j * 64 + lane) * 4);
#pragma unroll
        for (int r = 0; r < 2; ++r) {
#pragma unroll
            for (int j = 0; j < 8; ++j) ss[r] += (v[r][j][0] * v[r][j][0] + v[r][j][1] * v[r][j][1]) + (v[r][j][2] * v[r][j][2] + v[r][j][3] * v[r][j][3]);
            const int t = t0 + r, b = t / S; const float rs = 1.f / sqrtf(wave_sum(ss[r]) * (1.f / D) + EPS);
#pragma unroll
            for (int j = 0; j < 8; ++j) { const int col = (j * 64 + lane) * 4;
                const f32x4 o = v[r][j] * rs * *(const f32x4*)(g + col) * (*(const f32x4*)(sc + b * D6 + col) + 1.f) + *(const f32x4*)(sh + b * D6 + col);
                st_bf4(hb + (size_t)t * D + col, o); }
            if (hf && lane == 0) hf[t] = rs;
        }
    }
}
template <int MODE>
__device__ __forceinline__ void ph_comb_norm(const Ctx& c, const float* xmid, const float* g2, float* xout, const float* g, const float* sh, const float* sc, bf16_t* hb, float* outp) {
    const bf16_t* YE = WSH(O_YE); const float* EWT = WSF(O_EWT); const int* DEST = WSI(O_DEST);
    const int lane = threadIdx.x & 63, gw = blockIdx.x * (NT / 64) + (threadIdx.x >> 6), ngw = gridDim.x * (NT / 64);
    for (int t = gw; t < T; t += ngw) {
        const int b = t / S; const float w0 = EWT[t * 2], w1 = EWT[t * 2 + 1]; const bf16_t* y0 = YE + (size_t)DEST[t * 2] * D; const bf16_t* y1 = YE + (size_t)DEST[t * 2 + 1] * D;
        f32x4 v[8]; float ss = 0.f;
#pragma unroll
        for (int j = 0; j < 8; ++j) { const int col = (j * 64 + lane) * 4;
            v[j] = *(const f32x4*)(xmid + (size_t)t * D + col) + *(const f32x4*)(g2 + b * D6 + col) * (ld_bf4(y0 + col) * w0 + ld_bf4(y1 + col) * w1);
            if (MODE == 0) *(f32x4*)(xout + (size_t)t * D + col) = v[j];
            ss += (v[j][0] * v[j][0] + v[j][1] * v[j][1]) + (v[j][2] * v[j][2] + v[j][3] * v[j][3]); }
        const float rs = 1.f / sqrtf(wave_sum(ss) * (1.f / D) + EPS);
#pragma unroll
        for (int j = 0; j < 8; ++j) { const int col = (j * 64 + lane) * 4;
            if (MODE == 0) st_bf4(hb + (size_t)t * D + col, v[j] * rs * *(const f32x4*)(g + col) * (*(const f32x4*)(sc + b * D6 + col) + 1.f) + *(const f32x4*)(sh + b * D6 + col));
            else *(f32x4*)(outp + (size_t)t * D + col) = v[j] * rs * *(const f32x4*)(g + col); }
    }
}

struct CvtItem { const float* Wp; int ldw; bf16_t* WT; int ldt; int drow, k0, n0; };
constexpr int I_IN = 32 * (INW / 32), I_BR = 4 * 16 * 64, I_OUT = 32 * 64, I_GU = NE * 32 * 32, I_DN = NE * 8 * 64, I_LR = 32 * 8, I_WU = 2 * 32, I_WG = 64, I_BIG = I_IN + I_BR + I_OUT + I_GU + I_DN, I_ALL = I_BIG + I_LR + 2 * I_WU + I_WG;
__device__ __forceinline__ CvtItem cvt_decode(const Ctx& c, int l, int it) {
    CvtItem r;
    if (it < I_IN) { const int kb = it / (INW / 32), nb = it % (INW / 32); r.n0 = nb * 32; r.k0 = kb * 64; r.Wp = c.in[7] + (size_t)l * D * INW; r.ldw = INW; r.WT = WSH(O_WIN); r.ldt = D; r.drow = r.n0 < 10624 ? r.n0 : r.n0 + 128; return r; }
    it -= I_IN;
    if (it < I_BR) { const int sgm = it / 1024, q = it % 1024, kb = q / 64, nb = q % 64; r.n0 = nb * 32; r.k0 = kb * 64; r.Wp = c.in[28] + ((size_t)l * 4 + sgm) * W * D; r.ldw = D; r.WT = WSH(O_WBR) + sgm * W; r.ldt = 4 * W; r.drow = r.n0; return r; }
    it -= I_BR;
    if (it < I_OUT) { const int kb = it / 64, nb = it % 64; r.n0 = nb * 32; r.k0 = kb * 64; r.Wp = c.in[29] + (size_t)l * D * D; r.ldw = D; r.WT = WSH(O_WOUT); r.ldt = D; r.drow = r.n0; return r; }
    it -= I_OUT;
    if (it < I_GU) { const int e = it / 1024, q = it % 1024, kb = q / 32, nb = q % 32; r.n0 = nb * 32; r.k0 = kb * 64; r.Wp = c.in[34] + ((size_t)l * NE + e) * D * 1024; r.ldw = 1024; r.WT = WSH(O_WGU) + (size_t)e * 1024 * D; r.ldt = D;
        r.drow = r.n0 < 512 ? (r.n0 / 128) * 256 + (r.n0 % 128) : ((r.n0 - 512) / 128) * 256 + 128 + ((r.n0 - 512) % 128); return r; }
    it -= I_GU;
    if (it < I_DN) { const int e = it / 512, q = it % 512, kb = q / 64, nb = q % 64; r.n0 = nb * 32; r.k0 = kb * 64; r.Wp = c.in[35] + ((size_t)l * NE + e) * 512 * D; r.ldw = D; r.WT = WSH(O_WDN) + (size_t)e * D * 512; r.ldt = 512; r.drow = r.n0; return r; }
    it -= I_DN;
    if (it < I_LR) { const int m = it / 8, q = it % 8, kb = q / 4, nb = q % 4, z = m >> 4, ty = (m >> 3) & 1, n = m & 7; r.n0 = nb * 32; r.k0 = kb * 64; r.Wp = c.in[ty ? 12 : 10] + (((size_t)l * 2 + z) * 8 + n) * 128 * 128; r.ldw = 128;
        r.WT = WSH(O_WLR) + (size_t)m * 128 * 128; r.ldt = 128; r.drow = r.n0; return r; }
    it -= I_LR;
    if (it < 2 * I_WU) { const int ua = it / I_WU, q = it % I_WU, z = q / 32, nb = q % 32; r.n0 = nb * 32; r.k0 = 0; r.Wp = c.in[ua ? 23 : 21] + ((size_t)l * 2 + z) * 64 * W; r.ldw = W; r.WT = WSH(ua ? O_WAT : O_WUT) + (size_t)z * W * 64; r.ldt = 64; r.drow = r.n0; return r; }
    it -= 2 * I_WU;
    { const int kb = it / 32, nb = it % 32; r.n0 = nb * 32; r.k0 = kb * 64; r.Wp = c.in[24] + (size_t)l * 128 * W; r.ldw = W; r.WT = WSH(O_WGT); r.ldt = 128; r.drow = r.n0; return r; }
}
constexpr int J_IN = 16 * (INW / 128), J_BR = 4 * 8 * 16, J_OUT = 16 * 16, J_GU = NE * 16 * 8, J_DN = NE * 4 * 16, J_ALL = J_IN + J_BR + J_OUT + J_GU + J_DN;
__device__ __forceinline__ CvtItem cvt_decode_big(const Ctx& c, int l, int it) {
    CvtItem r;
    if (it < J_IN) { const int kb = it / (INW / 128), nb = it % (INW / 128); r.n0 = nb * 128; r.k0 = kb * 128; r.Wp = c.in[7] + (size_t)l * D * INW; r.ldw = INW; r.WT = WSH(O_WIN); r.ldt = D; r.drow = r.n0 < 10624 ? r.n0 : r.n0 + 128; return r; }
    it -= J_IN;
    if (it < J_BR) { const int sgm = it / 128, q = it % 128, kb = q / 16, nb = q % 16; r.n0 = nb * 128; r.k0 = kb * 128; r.Wp = c.in[28] + ((size_t)l * 4 + sgm) * W * D; r.ldw = D; r.WT = WSH(O_WBR) + sgm * W; r.ldt = 4 * W; r.drow = r.n0; return r; }
    it -= J_BR;
    if (it < J_OUT) { const int kb = it / 16, nb = it % 16; r.n0 = nb * 128; r.k0 = kb * 128; r.Wp = c.in[29] + (size_t)l * D * D; r.ldw = D; r.WT = WSH(O_WOUT); r.ldt = D; r.drow = r.n0; return r; }
    it -= J_OUT;
    if (it < J_GU) { const int e = it / 128, q = it % 128, kb = q / 8, nb = q % 8; r.n0 = nb * 128; r.k0 = kb * 128; r.Wp = c.in[34] + ((size_t)l * NE + e) * D * 1024; r.ldw = 1024; r.WT = WSH(O_WGU) + (size_t)e * 1024 * D; r.ldt = D;
        r.drow = r.n0 < 512 ? (r.n0 / 128) * 256 : ((r.n0 - 512) / 128) * 256 + 128; return r; }
    it -= J_GU;
    { const int e = it / 64, q = it % 64, kb = q / 16, nb = q % 16; r.n0 = nb * 128; r.k0 = kb * 128; r.Wp = c.in[35] + ((size_t)l * NE + e) * 512 * D; r.ldw = D; r.WT = WSH(O_WDN) + (size_t)e * D * 512; r.ldt = 512; r.drow = r.n0; return r; }
}
__device__ __forceinline__ void convert_big(const Ctx& c, int l, float* ldsf, int first, int last, int widx, int wcnt) {
    const int tid = threadIdx.x, lr = tid >> 5, lc = (tid & 31) * 4;
    f32x4 rg[8]; int it = first + widx; CvtItem r;
    if (it < last) { r = cvt_decode_big(c, l, it);
#pragma unroll
        for (int i = 0; i < 8; ++i) rg[i] = *(const f32x4*)(r.Wp + (size_t)(r.k0 + lr + 16 * i) * r.ldw + r.n0 + lc); }
    for (; it < last; it += wcnt) {
#pragma unroll
        for (int i = 0; i < 8; ++i) { float* dp = ldsf + (lr + 16 * i) * 129 + lc; dp[0] = rg[i][0]; dp[1] = rg[i][1]; dp[2] = rg[i][2]; dp[3] = rg[i][3]; }
        const CvtItem cur = r; const int nx = it + wcnt;
        if (nx < last) { r = cvt_decode_big(c, l, nx);
#pragma unroll
            for (int i = 0; i < 8; ++i) rg[i] = *(const f32x4*)(r.Wp + (size_t)(r.k0 + lr + 16 * i) * r.ldw + r.n0 + lc); }
        SYNCTHREADS();
#pragma unroll
        for (int q = 0; q < 4; ++q) { const int id = tid + NT * q, n = id >> 4, k8 = (id & 15) * 8; const float* sp = ldsf + k8 * 129 + n;
            u32x4 o; o[0] = pk2(sp[0 * 129], sp[1 * 129]); o[1] = pk2(sp[2 * 129], sp[3 * 129]); o[2] = pk2(sp[4 * 129], sp[5 * 129]); o[3] = pk2(sp[6 * 129], sp[7 * 129]);
            *(u32x4*)(cur.WT + (size_t)(cur.drow + n) * cur.ldt + cur.k0 + k8) = o; }
        SYNCTHREADS();
    }
}
__device__ __forceinline__ int convert_tail_tiles() { const int nun = (T / 256) * (PW / 256), G = (int)gridDim.x, rem = nun % G; return rem == 0 ? 0 : (G - rem) * 10 < J_GU + J_DN ? (G - rem) * 10 : J_GU + J_DN; }
__device__ __forceinline__ int convert_early_tiles(const Ctx& c) { const int G = (int)gridDim.x, nrest = (CTLW(c) + CW_PLAN)[40] * 4 - G; return (nrest >= 0 && nrest < G) ? ((G - nrest) * 12 < J_IN ? (G - nrest) * 12 : J_IN) : 0; }
__device__ __forceinline__ void ph_convert(const Ctx& c, int l, float* ldsf) {
    const int lane = threadIdx.x & 63, wave = threadIdx.x >> 6; const int gw = blockIdx.x * (NT / 64) + wave, ngw = gridDim.x * (NT / 64);
    convert_big(c, l, ldsf, l == 1 ? convert_early_tiles(c) : 0, J_ALL - convert_tail_tiles(), (int)blockIdx.x, (int)gridDim.x);
#ifdef CPU_EMU
    if (lane == 0) for (int it = I_BIG + gw; it < I_ALL; it += ngw) { const CvtItem r = cvt_decode(c, l, it);
        for (int kk = 0; kk < 64; ++kk) for (int nn = 0; nn < 32; ++nn) r.WT[(size_t)(r.drow + nn) * r.ldt + r.k0 + kk] = (bf16_t)f2bf(r.Wp[(size_t)(r.k0 + kk) * r.ldw + r.n0 + nn]); }
#else
    float* scr = ldsf + wave * (64 * 33 + 16);
    for (int it = I_BIG + gw; it < I_ALL; it += ngw) {
        const CvtItem r = cvt_decode(c, l, it);
#pragma unroll 8
        for (int i = 0; i < 32; ++i) { const int kk = 2 * i + (lane >> 5); scr[kk * 33 + (lane & 31)] = r.Wp[(size_t)(r.k0 + kk) * r.ldw + r.n0 + (lane & 31)]; }
        asm volatile("s_waitcnt lgkmcnt(0)" ::: "memory");
        const int cc = lane & 7;
#pragma unroll
        for (int j = 0; j < 4; ++j) { const int n = (lane >> 3) + 8 * j; const float* sp = scr + (8 * cc) * 33 + n;
            u32x4 o; o[0] = pk2(sp[0 * 33], sp[1 * 33]); o[1] = pk2(sp[2 * 33], sp[3 * 33]); o[2] = pk2(sp[4 * 33], sp[5 * 33]); o[3] = pk2(sp[6 * 33], sp[7 * 33]);
            *(u32x4*)(r.WT + (size_t)(r.drow + n) * r.ldt + r.k0 + 8 * cc) = o; }
        asm volatile("s_waitcnt lgkmcnt(0)" ::: "memory");
    }
#endif
    { const float* wg = c.in[30] + (size_t)l * D * 4; const float* we = c.in[32] + (size_t)l * D * 32; bf16_t* wh = WSH(O_WRH); bf16_t* wl = WSH(O_WRL);
      for (long i = GT_; i < (long)48 * D; i += GS_) { const int n = (int)(i / D), k = (int)(i % D); const float w = n < 4 ? wg[k * 4 + n] : n < 36 ? we[k * 32 + (n - 4)] : 0.f; const unsigned hb = f2bf(w); wh[i] = (bf16_t)hb; wl[i] = (bf16_t)f2bf(w - bf2f((bf16_t)hb)); } }
    for (long i = GT_; i < (long)128 * D / 2; i += GS_) ((unsigned*)(WSH(O_WIN) + (size_t)10624 * D))[i] = 0u;
}

namespace pg8 {
constexpr int BM = 256, BK = 64, HALF = 128, HTB = HALF * BK * 2, STAGE_BYTES = 8 * HTB;
__host__ __device__ __forceinline__ int lds_byte(int r, int cc) { const int st = (r >> 4) * 2 + (cc >> 5), rr = r & 15, c2 = cc & 31, ob = rr * 64 + c2 * 2; return st * 1024 + (ob ^ (((ob >> 9) & 1) << 5)); }
__host__ __device__ __forceinline__ void stage_rc(int b, int& R, int& C) { const int st = b / 1024, sb = b % 1024, swz = sb ^ (((sb >> 9) & 1) << 5); R = (st >> 1) * 16 + swz / 64; C = (st & 1) * 32 + (swz % 64) / 2; }
__host__ __device__ __forceinline__ int perm32(int rho) { const int n = rho >> 4, i = rho & 15; return 8 * (i >> 2) + 4 * n + (i & 3); }
struct Unit { int pm, pn, aux; const char* A; const char* B; };
struct Gemm { int K, lda, ldb; };

template <class Epi, class Sched>
__device__ __forceinline__ void gemm_phase(unsigned char* lds_, const Gemm g, const Sched& S, const Epi& E) {
#ifdef CPU_EMU
    if (threadIdx.x != 0) return;
    Unit u; const int K = g.K;
    float* Af = (float*)malloc((size_t)256 * K * 4); float* Bf = (float*)malloc((size_t)256 * K * 4); float* Cf = (float*)malloc(256 * 256 * 4);
    for (int i = 0; S.next(i, u); ++i) {
        const bf16_t* A = (const bf16_t*)u.A; const bf16_t* B = (const bf16_t*)u.B;
        for (int r = 0; r < 256; ++r) for (int k = 0; k < K; ++k) { size_t ar = (size_t)r; if constexpr (Sched::GATHER) ar = (size_t)S.row(u.pm * 256 + r); Af[(size_t)r * K + k] = bf2f(A[ar * g.lda + k]); Bf[(size_t)r * K + k] = bf2f(B[(size_t)r * g.ldb + k]); }
        const int nseg = Epi::SEGT > 0 ? K / (Epi::SEGT * 64) : 1, kseg = K / nseg;
        for (int wid = 0; wid < 8; ++wid) for (int lane = 0; lane < 64; ++lane) {
            const int wr = wid >> 2, wc = wid & 3, fr = lane & 15, fq = lane >> 4; f32x4 acc[2][2][4][2];
            for (int ai = 0; ai < 2; ++ai) for (int bj = 0; bj < 2; ++bj) for (int m = 0; m < 4; ++m) for (int n = 0; n < 2; ++n) for (int j = 0; j < 4; ++j) acc[ai][bj][m][n][j] = 0.f;
            for (int sg = 0; sg < nseg; ++sg) {
                for (int ai = 0; ai < 2; ++ai) for (int bj = 0; bj < 2; ++bj) for (int m = 0; m < 4; ++m) for (int n = 0; n < 2; ++n) for (int j = 0; j < 4; ++j) {
                    const int r = 128 * ai + 64 * wr + 16 * m + fr, cc = 128 * bj + 32 * wc + (Epi::PERM ? 8 * fq + 4 * n + j : 16 * n + 4 * fq + j);
                    const float* a = Af + (size_t)r * K + sg * kseg; const float* b = Bf + (size_t)cc * K + sg * kseg; float sacc = 0.f; for (int k = 0; k < kseg; ++k) sacc += a[k] * b[k];
                    acc[ai][bj][m][n][j] += sacc; }
                if constexpr (Epi::SEGT > 0) { if (sg + 1 < nseg) E.segment(acc, u, sg, wr, wc, fr, fq); }
            }
            E(acc, u, wr, wc, fr, fq);
        }
    }
    free(Af); free(Bf); free(Cf);
#else
    typedef __attribute__((address_space(3))) unsigned char* ldsp_t;
    ldsp_t lds = (ldsp_t)lds_;
    const int tid = threadIdx.x, wid = __builtin_amdgcn_readfirstlane(tid >> 6), lane = tid & 63, wr = wid >> 2, wc = wid & 3, fr = lane & 15, fq = lane >> 4;
    const int K = g.K, nt = K / BK;
    unsigned voffA[2], voffB[2];
#pragma unroll
    for (int i = 0; i < 2; ++i) { int R, C; stage_rc(tid * 16 + i * 8192, R, C); const int Rb = Epi::PERM ? ((R & ~31) + perm32(R & 31)) : R;
        voffA[i] = (unsigned)(R * g.lda + C) * 2u; voffB[i] = (unsigned)(Rb * g.ldb + C) * 2u; }
    unsigned vA[2][2], vAn[2][2];
#define PG8_GROWS(uu, vv) do { _Pragma("unroll") for (int h_ = 0; h_ < 2; ++h_) _Pragma("unroll") for (int i_ = 0; i_ < 2; ++i_) { int R_, C_; stage_rc(tid * 16 + i_ * 8192, R_, C_); \
        vv[h_][i_] = (unsigned)(S.row((uu).pm * 256 + h_ * 128 + R_) * g.lda + C_) * 2u; } } while (0)
    const size_t kstep = (size_t)(BK * 2);
    const size_t hstepA = (size_t)HALF * g.lda * 2, hstepB = (size_t)HALF * g.ldb * 2;
    const unsigned ldsw = (unsigned)wid * 1024u;
    const int aoff = lds_byte(wr * 64 + fr, fq * 8), boff = lds_byte(wc * 32 + fr, fq * 8);
#define PG8_SA(b, h) (((b) * 2 + (h)) * HTB)
#define PG8_SB(b, h) ((4 + (b) * 2 + (h)) * HTB)
#define PG8_STAGE(bufoff, gbase, voff) do { _Pragma("unroll") for (int _i = 0; _i < 2; ++_i) \
        __builtin_amdgcn_global_load_lds((const unsigned*)((const char*)(gbase) + (voff)[_i]), (__attribute__((address_space(3))) unsigned*)(lds + (bufoff) + ldsw + _i * 8192), 16, 0, 0); } while (0)
#define PG8_STAGEA(b, h, kp, usen) do { if constexpr (Sched::GATHER) { const unsigned vs_[2] = {(usen) ? vAn[h][0] : vA[h][0], (usen) ? vAn[h][1] : vA[h][1]}; PG8_STAGE(PG8_SA(b, h), kp, vs_); } \
        else { PG8_STAGE(PG8_SA(b, h), (kp) + ((h) ? hstepA : 0), voffA); } } while (0)
#define PG8_LDA(dst, b, h) do { _Pragma("unroll") for (int m = 0; m < 4; ++m) _Pragma("unroll") for (int k = 0; k < 2; ++k) dst[m][k] = *(const __attribute__((address_space(3))) bf16x8*)(lds + PG8_SA(b, h) + aoff + m * 2048 + k * 1024); } while (0)
#define PG8_LDB(dst, b, h) do { _Pragma("unroll") for (int n = 0; n < 2; ++n) _Pragma("unroll") for (int k = 0; k < 2; ++k) dst[n][k] = *(const __attribute__((address_space(3))) bf16x8*)(lds + PG8_SB(b, h) + boff + n * 2048 + k * 1024); } while (0)
#define PG8_MMA(ai, bj, At, Bt) do { __builtin_amdgcn_s_setprio(1); _Pragma("unroll") for (int m = 0; m < 4; ++m) _Pragma("unroll") for (int n = 0; n < 2; ++n) _Pragma("unroll") for (int k = 0; k < 2; ++k) \
        acc[ai][bj][m][n] = __builtin_amdgcn_mfma_f32_16x16x32_bf16(Bt[n][k], At[m][k], acc[ai][bj][m][n], 0, 0, 0); __builtin_amdgcn_s_setprio(0); } while (0)
#define PG8_WAIT_V(n) asm volatile("s_waitcnt vmcnt(" #n ")" ::: "memory")
#define PG8_WAIT_L(n) asm volatile("s_waitcnt lgkmcnt(" #n ")" ::: "memory")
#define PG8_BAR __builtin_amdgcn_s_barrier()
#define PG8_SCHED __builtin_amdgcn_sched_barrier(0)
    Unit cur, nxt; int ui = 0;
    if (!S.next(0, cur)) return;
    f32x4 acc[2][2][4][2];
#pragma unroll
    for (int a = 0; a < 2; ++a)
#pragma unroll
        for (int b = 0; b < 2; ++b)
#pragma unroll
            for (int m = 0; m < 4; ++m)
#pragma unroll
                for (int n = 0; n < 2; ++n) acc[a][b][m][n] = (f32x4){0.f, 0.f, 0.f, 0.f};
    bf16x8 At[4][2], B0[2][2], B1[2][2];
    const char* cA = cur.A; const char* cB = cur.B;
    S.a_ready(cur);
    if constexpr (Sched::GATHER) { PG8_GROWS(cur, vA); }
    PG8_STAGE(PG8_SB(0, 0), cB, voffB); PG8_STAGEA(0, 0, cA, false); PG8_STAGE(PG8_SB(0, 1), cB + hstepB, voffB); PG8_STAGEA(0, 1, cA, false);
    if (wr == 1) PG8_BAR;
    PG8_WAIT_V(4); PG8_BAR;
    PG8_STAGE(PG8_SB(1, 0), cB + kstep, voffB); PG8_STAGEA(1, 0, cA + kstep, false); PG8_STAGE(PG8_SB(1, 1), cB + hstepB + kstep, voffB);
    PG8_WAIT_V(6); PG8_BAR;
    for (;;) {
        const bool has_next = S.next(ui + 1, nxt);
        const char* nA = has_next ? nxt.A : cA; const char* nB = has_next ? nxt.B : cB;
        if constexpr (Sched::GATHER) { if (has_next) { PG8_GROWS(nxt, vAn); } else {
#pragma unroll
            for (int h_ = 0; h_ < 2; ++h_) { vAn[h_][0] = vA[h_][0]; vAn[h_][1] = vA[h_][1]; } } }
        for (int t = 0; t < nt; t += 2) {
            const bool last = (t == nt - 2);
            const char* a1 = cA + (size_t)(t + 1) * kstep;
            const char* a2 = last ? nA : cA + (size_t)(t + 2) * kstep; const char* b2 = last ? nB : cB + (size_t)(t + 2) * kstep;
            const char* a3 = a2 + kstep; const char* b3 = b2 + kstep;
            if (last && has_next) S.a_ready(nxt);
            PG8_LDB(B0, 0, 0); PG8_SCHED; PG8_LDA(At, 0, 0); PG8_STAGEA(1, 1, a1, false);
            PG8_WAIT_L(8); PG8_BAR; PG8_WAIT_L(0); PG8_MMA(0, 0, At, B0); PG8_BAR; PG8_SCHED;
            PG8_LDB(B1, 0, 1); PG8_STAGE(PG8_SB(0, 0), b2, voffB);
            PG8_BAR; PG8_WAIT_L(0); PG8_MMA(0, 1, At, B1); PG8_BAR;
            PG8_LDA(At, 0, 1); PG8_STAGEA(0, 0, a2, last);
            PG8_BAR; PG8_WAIT_L(0); PG8_MMA(1, 0, At, B0); PG8_BAR; PG8_SCHED;
            PG8_STAGE(PG8_SB(0, 1), b2 + hstepB, voffB);
            PG8_WAIT_V(6); PG8_BAR; PG8_MMA(1, 1, At, B1); PG8_BAR;
            PG8_LDB(B0, 1, 0); PG8_SCHED; PG8_LDA(At, 1, 0); PG8_STAGEA(0, 1, a2, last);
            PG8_WAIT_L(8); PG8_BAR; PG8_WAIT_L(0); PG8_MMA(0, 0, At, B0); PG8_BAR; PG8_SCHED;
            PG8_LDB(B1, 1, 1); PG8_STAGE(PG8_SB(1, 0), b3, voffB);
            PG8_BAR; PG8_WAIT_L(0); PG8_MMA(0, 1, At, B1); PG8_BAR;
            PG8_LDA(At, 1, 1); PG8_STAGEA(1, 0, a3, last);
            PG8_BAR; PG8_WAIT_L(0); PG8_MMA(1, 0, At, B0); PG8_BAR; PG8_SCHED;
            PG8_STAGE(PG8_SB(1, 1), b3 + hstepB, voffB);
            PG8_WAIT_V(6); PG8_BAR; PG8_MMA(1, 1, At, B1); PG8_BAR;
            if constexpr (Epi::SEGT > 0) { if ((t + 2) % Epi::SEGT == 0 && t + 2 < nt) E.segment(acc, cur, (t + 2) / Epi::SEGT - 1, wr, wc, fr, fq); }
        }
        E(acc, cur, wr, wc, fr, fq); S.done(cur);
        if (!has_next) break;
#pragma unroll
        for (int a = 0; a < 2; ++a)
#pragma unroll
            for (int b = 0; b < 2; ++b)
#pragma unroll
                for (int m = 0; m < 4; ++m)
#pragma unroll
                    for (int n = 0; n < 2; ++n) acc[a][b][m][n] = (f32x4){0.f, 0.f, 0.f, 0.f};
        cur = nxt; cA = nA; cB = nB; ++ui;
        if constexpr (Sched::GATHER) {
#pragma unroll
            for (int h_ = 0; h_ < 2; ++h_) { vA[h_][0] = vAn[h_][0]; vA[h_][1] = vAn[h_][1]; } }
    }
    PG8_WAIT_V(0);
    if (wr == 0) PG8_BAR;
    PG8_BAR;
#undef PG8_SA
#undef PG8_SB
#undef PG8_STAGE
#undef PG8_STAGEA
#undef PG8_GROWS
#undef PG8_LDA
#undef PG8_LDB
#undef PG8_MMA
#undef PG8_WAIT_V
#undef PG8_WAIT_L
#undef PG8_BAR
#undef PG8_SCHED
#endif
}

struct StaticOrder {
    static constexpr bool GATHER = false;
    int nM, nN, nwg, G, c; const char* A; const char* B; size_t tstepA, tstepB;
    __device__ __forceinline__ void init(int M, int N, int G_, int c_, const void* A_, const void* B_, int lda, int ldb) { nM = M / BM; nN = N / BM; nwg = nM * nN; G = G_; c = c_; A = (const char*)A_; B = (const char*)B_; tstepA = (size_t)BM * lda * 2; tstepB = (size_t)BM * ldb * 2; }
    __device__ __forceinline__ bool next(int i, Unit& u) const {
        const long L = (long)i * G + c; if (L >= nwg) return false;
        int wgid = (int)L; { const int q = nwg / 8, r = nwg % 8, xcd = wgid % 8, off = wgid / 8; wgid = (xcd < r ? xcd * (q + 1) : r * (q + 1) + (xcd - r) * q) + off; }
        const int nig = 8 * nN, gid = wgid / nig, fm = gid * 8, gsz = (nM - fm) < 8 ? (nM - fm) : 8;
        u.pm = fm + ((wgid % nig) % gsz); u.pn = (wgid % nig) / gsz; u.aux = 0; u.A = A + (size_t)u.pm * tstepA; u.B = B + (size_t)u.pn * tstepB; return true;
    }
    __device__ __forceinline__ void a_ready(const Unit&) const {}
    __device__ __forceinline__ void done(const Unit&) const {}
};
struct MergeOrder {
    static constexpr bool GATHER = false;
    StaticOrder so; int kseg_bytes;
    __device__ __forceinline__ bool next(int i, Unit& u) const { if (!so.next(i >> 2, u)) return false; u.aux = i & 3; u.A += (size_t)u.aux * kseg_bytes; u.B += (size_t)u.aux * kseg_bytes; return true; }
    __device__ __forceinline__ void a_ready(const Unit&) const {}
    __device__ __forceinline__ void done(const Unit&) const {}
};
struct MoeOrder {
    static constexpr bool GATHER = false;
    int G, c, ncol; const int* plan; const char* A; const char* B; size_t tstepA, tstepB, estep;
    __device__ __forceinline__ bool next(int i, Unit& u) const {
        const long L = (long)i * G + c; const int nblk = plan[40]; if (L >= (long)nblk * ncol) return false;
        u.pm = (int)(L / ncol); u.pn = (int)(L % ncol); u.aux = plan[64 + u.pm]; u.A = A + (size_t)u.pm * tstepA; u.B = B + (size_t)u.aux * estep + (size_t)u.pn * tstepB; return true;
    }
    __device__ __forceinline__ void a_ready(const Unit&) const {}
    __device__ __forceinline__ void done(const Unit&) const {}
};
struct MoeGatherOrder {
    static constexpr bool GATHER = true;
    int G, c, ncol; const int* plan; const char* A; const char* B; size_t tstepB, estep; const int* src; int nrows;
    __device__ __forceinline__ bool next(int i, Unit& u) const {
        const long L = (long)i * G + c; const int nblk = plan[40]; if (L >= (long)nblk * ncol) return false;
        u.pm = (int)(L / ncol); u.pn = (int)(L % ncol); u.aux = plan[64 + u.pm]; u.A = A; u.B = B + (size_t)u.aux * estep + (size_t)u.pn * tstepB; return true;
    }
    __device__ __forceinline__ int row(int slot) const { const int r = src[slot]; return (unsigned)r < (unsigned)nrows ? r : 0; }
    __device__ __forceinline__ void a_ready(const Unit&) const {}
    __device__ __forceinline__ void done(const Unit&) const {}
};

__device__ __forceinline__ u32x4 pack8(const f32x4 v0, const f32x4 v1) { u32x4 w; w[0] = pk2(v0[0], v0[1]); w[1] = pk2(v0[2], v0[3]); w[2] = pk2(v1[0], v1[1]); w[3] = pk2(v1[2], v1[3]); return w; }
struct EpiBf16 {
    static constexpr int SEGT = 0; static constexpr bool PERM = true; bf16_t* O; int ldc;
    __device__ __forceinline__ void operator()(const f32x4 (&acc)[2][2][4][2], const Unit& u, int wr, int wc, int fr, int fq) const {
        const int row0 = u.pm * BM + wr * 64 + fr, col0 = u.pn * BM + wc * 32 + 8 * fq;
#pragma unroll
        for (int ai = 0; ai < 2; ++ai)
#pragma unroll
            for (int m = 0; m < 4; ++m) { bf16_t* rowp = O + (size_t)(row0 + ai * HALF + m * 16) * ldc + col0;
#pragma unroll
                for (int bj = 0; bj < 2; ++bj) *(u32x4*)(rowp + bj * HALF) = pack8(acc[ai][bj][m][0], acc[ai][bj][m][1]); }
    }
};
struct EpiP {
    static constexpr int SEGT = 0; static constexpr bool PERM = true; bf16_t* O; unsigned char* G8; float* SG;
    __device__ __forceinline__ void operator()(const f32x4 (&acc)[2][2][4][2], const Unit& u, int wr, int wc, int fr, int fq) const {
        const int row0 = u.pm * BM + wr * 64 + fr, col0 = u.pn * BM + wc * 32 + 8 * fq;
        if (u.pn * BM < C_MLP) {
            const bool sgu = u.pn * BM >= C_SV && u.pn * BM < C_SV + W;
#pragma unroll
            for (int ai = 0; ai < 2; ++ai)
#pragma unroll
                for (int m = 0; m < 4; ++m) { const int r = row0 + ai * HALF + m * 16; bf16_t* rowp = O + (size_t)r * PW + col0; float s1 = 0.f, s2 = 0.f;
#pragma unroll
                    for (int bj = 0; bj < 2; ++bj) { const u32x4 pk = pack8(acc[ai][bj][m][0], acc[ai][bj][m][1]); *(u32x4*)(rowp + bj * HALF) = pk;
                        if (sgu) {
#pragma unroll
                            for (int e = 0; e < 4; ++e) { const float g0 = geluf_(bflo(pk[e])), g1 = geluf_(bfhi(pk[e])); s1 += g0 + g1; s2 += g0 * g0 + g1 * g1; } } }
                    if (sgu) { float* sp = SG + ((size_t)r * 16 + (u.pn - C_SV / BM) * 4 + wc) * 2;
#ifdef CPU_EMU
                        if (fq == 0) { sp[0] = s1; sp[1] = s2; } else { sp[0] += s1; sp[1] += s2; }
#else
                        s1 += SHFL_XOR(s1, 16); s1 += SHFL_XOR(s1, 32); s2 += SHFL_XOR(s2, 16); s2 += SHFL_XOR(s2, 32); if (fq == 0) { sp[0] = s1; sp[1] = s2; }
#endif
                    } }
        } else {
#pragma unroll
            for (int ai = 0; ai < 2; ++ai)
#pragma unroll
                for (int m = 0; m < 4; ++m) { unsigned char* rowp = G8 + (size_t)(row0 + ai * HALF + m * 16) * (4 * D) + (col0 - C_MLP);
#pragma unroll
                    for (int bj = 0; bj < 2; ++bj) {
#ifdef CPU_EMU
                        unsigned long long w = 0ull;
#pragma unroll
                        for (int q = 0; q < 8; ++q) { const float gq = sigmoidf_(acc[ai][bj][m][q >> 2][q & 3]); w |= (unsigned long long)(unsigned)(gq * 255.f + 0.5f) << (8 * q); }
#else
                        unsigned w0 = 0u, w1 = 0u;
#pragma unroll
                        for (int q = 0; q < 4; ++q) { w0 = __builtin_amdgcn_cvt_pk_u8_f32(__builtin_rintf(sigmoidf_(acc[ai][bj][m][0][q]) * 255.f), q, w0); w1 = __builtin_amdgcn_cvt_pk_u8_f32(__builtin_rintf(sigmoidf_(acc[ai][bj][m][1][q]) * 255.f), q, w1); }
                        const unsigned long long w = (unsigned long long)w0 | ((unsigned long long)w1 << 32);
#endif
                        *(unsigned long long*)(rowp + bj * HALF) = w; } }
        }
    }
};
struct EpiMerge {
    static constexpr int SEGT = 16; static constexpr bool PERM = true; const unsigned char* G8; bf16_t* MRG;
    static __device__ __forceinline__ float gq(unsigned long long w, int q) { const unsigned b = (unsigned)(w >> (8 * q)) & 255u; return (b ? (float)b : 0.5f) * (1.f / 255.f); }
    __device__ __forceinline__ void segment(f32x4 (&acc)[2][2][4][2], const Unit& u, int seg, int wr, int wc, int fr, int fq) const {
        const int row0 = u.pm * BM + wr * 64 + fr, col0 = u.pn * BM + wc * 32 + 8 * fq;
#pragma unroll
        for (int ai = 0; ai < 2; ++ai)
#pragma unroll
            for (int m = 0; m < 4; ++m) { const size_t r = (size_t)(row0 + ai * HALF + m * 16);
#pragma unroll
                for (int bj = 0; bj < 2; ++bj) { const int cc = col0 + bj * HALF;
                    const unsigned long long g0 = *(const unsigned long long*)(G8 + r * (4 * D) + seg * D + cc), g1 = *(const unsigned long long*)(G8 + r * (4 * D) + (seg + 1) * D + cc);
#pragma unroll
                    for (int q = 0; q < 4; ++q) { acc[ai][bj][m][0][q] *= gq(g0, q) * frcp_(gq(g1, q)); acc[ai][bj][m][1][q] *= gq(g0, 4 + q) * frcp_(gq(g1, 4 + q)); } }
#ifndef CPU_EMU
                asm volatile("" ::: "memory");
#endif
            }
    }
    __device__ __forceinline__ void operator()(const f32x4 (&acc)[2][2][4][2], const Unit& u, int wr, int wc, int fr, int fq) const {
        const int row0 = u.pm * BM + wr * 64 + fr, col0 = u.pn * BM + wc * 32 + 8 * fq;
#pragma unroll
        for (int ai = 0; ai < 2; ++ai)
#pragma unroll
            for (int m = 0; m < 4; ++m) { const size_t r = (size_t)(row0 + ai * HALF + m * 16);
#pragma unroll
                for (int bj = 0; bj < 2; ++bj) { const int cc = col0 + bj * HALF;
                    const unsigned long long g3 = *(const unsigned long long*)(G8 + r * (4 * D) + 3 * D + cc); f32x4 v0, v1;
#pragma unroll
                    for (int q = 0; q < 4; ++q) { v0[q] = gq(g3, q) * acc[ai][bj][m][0][q]; v1[q] = gq(g3, 4 + q) * acc[ai][bj][m][1][q]; }
                    *(u32x4*)(MRG + r * D + cc) = pack8(v0, v1); }
#ifndef CPU_EMU
                asm volatile("" ::: "memory");
#endif
            }
    }
};
struct EpiResid {
    static constexpr int SEGT = 0; static constexpr bool PERM = false; const float* xin; const float* g1; float* xmid; float* ssp;
    __device__ __forceinline__ void operator()(const f32x4 (&acc)[2][2][4][2], const Unit& u, int wr, int wc, int fr, int fq) const {
        const int row0 = u.pm * BM + wr * 64 + fr, col0 = u.pn * BM + wc * 32 + 4 * fq;
#pragma unroll
        for (int ai = 0; ai < 2; ++ai)
#pragma unroll
            for (int m = 0; m < 4; ++m) { const int r = row0 + ai * HALF + m * 16; const float* gp = g1 + (size_t)(r / S) * D6; float sq = 0.f;
#pragma unroll
                for (int bj = 0; bj < 2; ++bj)
#pragma unroll
                    for (int n = 0; n < 2; ++n) { const int cc = col0 + bj * HALF + n * 16; const f32x4 v = *(const f32x4*)(xin + (size_t)r * D + cc) + *(const f32x4*)(gp + cc) * acc[ai][bj][m][n];
                        *(f32x4*)(xmid + (size_t)r * D + cc) = v; sq += (v[0] * v[0] + v[1] * v[1]) + (v[2] * v[2] + v[3] * v[3]); }
                float* sp = ssp + (size_t)r * 32 + u.pn * 4 + wc;
#ifdef CPU_EMU
                if (fq == 0) *sp = sq; else *sp += sq;
#else
                sq += SHFL_XOR(sq, 16); sq += SHFL_XOR(sq, 32); if (fq == 0) *sp = sq;
                asm volatile("" ::: "memory");
#endif
            }
    }
};
struct EpiGU {
    static constexpr int SEGT = 0; static constexpr bool PERM = true; bf16_t* ACT;
    __device__ __forceinline__ void operator()(const f32x4 (&acc)[2][2][4][2], const Unit& u, int wr, int wc, int fr, int fq) const {
        const int row0 = u.pm * BM + wr * 64 + fr, col0 = u.pn * HALF + wc * 32 + 8 * fq;
#pragma unroll
        for (int ai = 0; ai < 2; ++ai)
#pragma unroll
            for (int m = 0; m < 4; ++m) { f32x4 v0, v1;
#pragma unroll
                for (int j = 0; j < 4; ++j) { v0[j] = siluf_(acc[ai][0][m][0][j]) * acc[ai][1][m][0][j]; v1[j] = siluf_(acc[ai][0][m][1][j]) * acc[ai][1][m][1][j]; }
                *(u32x4*)(ACT + (size_t)(row0 + ai * HALF + m * 16) * 512 + col0) = pack8(v0, v1); }
    }
};
}

template <int PASS>
__device__ __forceinline__ void ph_lru(const Ctx& c, int l, float* ldsf) {
    const bf16_t* P = WSH(O_P); const float* cw = c.in[8] + (size_t)l * 4 * W; const float* cb = c.in[9] + (size_t)l * W;
    const float* br = c.in[11] + (size_t)l * 2 * W; const float* bi = c.in[13] + (size_t)l * 2 * W; const float* lam = c.in[14] + (size_t)l * 2 * W; const bf16_t* WLR = WSH(O_WLR);
    float* CA = WSF(O_LCA); float* CH = WSF(O_LCH); const float* CI = WSF(O_LCI); bf16_t* Y = WSH(O_YS); unsigned* LAU = (unsigned*)(c.ws + O_LA);
    bf16_t* Xs = (bf16_t*)ldsf; bf16_t* Wr = Xs + 64 * 136; bf16_t* Wi = Wr + 128 * 136; float* AUa = (float*)Wr; float* AUu = AUa + 64 * 128; float* HF = (float*)(Wi + 128 * 136); float* spl = HF + 64 * 128;
    const int tid = threadIdx.x, wv = tid >> 6, lane = tid & 63, fr = lane & 15, fq = lane >> 4, rt = wv & 3, hf = wv >> 2;
    u32x4 wreg[8];
#define LRU_WLOAD(zz, nn) do { _Pragma("unroll") for (int q = 0; q < 4; ++q) { const int id = tid + NT * q, f = id >> 4, e8 = (id & 15) * 8; \
        wreg[2 * q] = *(const u32x4*)(WLR + ((size_t)(((zz) * 2 + 0) * 8 + (nn)) * 128 + f) * 128 + e8); wreg[2 * q + 1] = *(const u32x4*)(WLR + ((size_t)(((zz) * 2 + 1) * 8 + (nn)) * 128 + f) * 128 + e8); } } while (0)
    if ((int)blockIdx.x < (T / 64) * 8) LRU_WLOAD(0, (int)blockIdx.x & 7);
    for (int u = blockIdx.x; u < (T / 64) * 8; u += gridDim.x) {
        const int n = u & 7, tile = u >> 3, b = tile / NLC, chk = tile % NLC; const long t0 = (long)tile * 64;
        if (tid < 256) spl[tid] = softplusf_(-lam[(tid >> 7) * W + n * 128 + (tid & 127)]);
#pragma unroll
        for (int q = 0; q < 4; ++q) { const int id = tid + NT * q, tl = id >> 5, e4 = (id & 31) * 4, ch = n * 128 + e4; const long t = t0 + tl; const int sI = (int)(t % S);
            f32x4 acc = *(const f32x4*)(cb + ch);
#pragma unroll
            for (int k = 0; k < 4; ++k) { const int ss = sI + k - 2; if (ss >= 0 && ss < S) acc += ld_bf4(P + (size_t)(t + k - 2) * PW + C_LX + ch) * *(const f32x4*)(cw + k * W + ch); }
            st_bf4(Xs + tl * 136 + e4, acc); }
        for (int z = 0; z < 2; ++z) {
#pragma unroll
            for (int q = 0; q < 4; ++q) { const int id = tid + NT * q, f = id >> 4, e8 = (id & 15) * 8; *(u32x4*)(Wr + f * 136 + e8) = wreg[2 * q]; *(u32x4*)(Wi + f * 136 + e8) = wreg[2 * q + 1]; }
            SYNCTHREADS();
            f32x4 ar[4], ai[4];
#pragma unroll
            for (int nt = 0; nt < 4; ++nt) { ar[nt] = (f32x4){0.f, 0.f, 0.f, 0.f}; ai[nt] = (f32x4){0.f, 0.f, 0.f, 0.f}; }
            wave_mma<4, 4>(ar, Xs + rt * 16 * 136, 136, Wr + hf * 64 * 136, 136);
            wave_mma<4, 4>(ai, Xs + rt * 16 * 136, 136, Wi + hf * 64 * 136, 136);
            SYNCTHREADS();
            if (z == 0) LRU_WLOAD(1, n); else if (u + (int)gridDim.x < (T / 64) * 8) LRU_WLOAD(0, (u + (int)gridDim.x) & 7);
            const int tl = rt * 16 + fr;
#pragma unroll
            for (int nt = 0; nt < 4; ++nt) { const int f = 64 * hf + 16 * nt + 4 * fq, ch = n * 128 + f;
                const f32x4 brv = *(const f32x4*)(br + z * W + ch), biv = *(const f32x4*)(bi + z * W + ch), lmv = *(const f32x4*)(spl + z * 128 + f), xcv = ld_bf4(Xs + tl * 136 + f); f32x4 av, uv, lav;
#pragma unroll
                for (int e = 0; e < 4; ++e) { const float r = sigmoidf_(ar[nt][e] + brv[e]), ig = sigmoidf_(ai[nt][e] + biv[e]), la = -8.f * r * lmv[e]; const float a = fexp_(la); av[e] = a; lav[e] = la; uv[e] = fsqrt_(fmaxf(1.f - a * a, 0.f)) * ig * xcv[e]; }
                *(f32x4*)(AUa + tl * 128 + f) = av; *(f32x4*)(AUu + tl * 128 + f) = uv;
                if (PASS == 1) { u32x4 pk;
#pragma unroll
                    for (int e = 0; e < 4; ++e) pk[e] = pk2(lav[e], uv[e]);
                    *(u32x4*)(LAU + ((size_t)z * T + t0 + tl) * W + ch) = pk; } }
            SYNCTHREADS();
            if (PASS == 1) {
                { const int f = tid & 127, sgm = tid >> 7; float prod = 1.f, h = 0.f;
#pragma unroll
                  for (int q = 0; q < 16; ++q) { const int st = sgm * 16 + q, sI = z == 0 ? st : 63 - st; const float a = AUa[sI * 128 + f]; h = a * h + AUu[sI * 128 + f]; prod *= a; }
                  HF[sgm * 128 + f] = prod; HF[512 + sgm * 128 + f] = h; }
                SYNCTHREADS();
                if (tid < 128) { const int f = tid; const size_t ci = (((size_t)z * NB + b) * NLC + chk) * W + n * 128 + f; float prod = 1.f, h = 0.f;
#pragma unroll
                    for (int sgm = 0; sgm < 4; ++sgm) { const float a = HF[sgm * 128 + f]; h = a * h + HF[512 + sgm * 128 + f]; prod *= a; }
                    CA[ci] = prod; CH[ci] = h; }
                continue;
            }
            if (tid < 128) { const int f = tid; const size_t ci = (((size_t)z * NB + b) * NLC + chk) * W + n * 128 + f;
                if (PASS == 1) { float prod = 1.f, h = 0.f;
#pragma unroll 8
                    for (int q = 0; q < 64; ++q) { const int sI = z == 0 ? q : 63 - q; const float a = AUa[sI * 128 + f]; h = a * h + AUu[sI * 128 + f]; prod *= a; }
                    CA[ci] = prod; CH[ci] = h;
                } else { float h = CI[ci];
                    if (z == 0) {
#pragma unroll 8
                        for (int q = 0; q < 64; ++q) { h = AUa[q * 128 + f] * h + AUu[q * 128 + f]; HF[q * 128 + f] = h; }
                    } else {
#pragma unroll 8
                        for (int q = 63; q >= 0; --q) { h = AUa[q * 128 + f] * h + AUu[q * 128 + f]; HF[q * 128 + f] += h; } } }
            }
            SYNCTHREADS();
        }
        if (PASS == 2) {
#pragma unroll
            for (int q = 0; q < 4; ++q) { const int id = tid + NT * q, tl = id >> 5, f4 = (id & 31) * 4; const long t = t0 + tl; f32x4 hv = *(const f32x4*)(HF + tl * 128 + f4); const f32x4 gv = ld_bf4(P + (size_t)t * PW + C_LG + n * 128 + f4);
#pragma unroll
                for (int e = 0; e < 4; ++e) hv[e] *= geluf_(gv[e]);
                st_bf4(Y + (size_t)t * 4 * W + 0 * W + n * 128 + f4, hv); }
            SYNCTHREADS();
        }
    }
}
__device__ __forceinline__ void ph_lru_fin(const Ctx& c, float* ldsf) {
    const bf16_t* P = WSH(O_P); const unsigned* LAU = (const unsigned*)(c.ws + O_LA); const float* CI = WSF(O_LCI); bf16_t* Y = WSH(O_YS);
    unsigned* Lz = (unsigned*)ldsf; float* Hz = ldsf + 2 * 64 * 128; const int tid = threadIdx.x;
    u32x4 lpre[8];
#define LF_LOAD(uu) do { const int n_ = (uu) & 7; const long t0_ = (long)((uu) >> 3) * 64; \
        _Pragma("unroll") for (int q = 0; q < 8; ++q) { const int id = tid + NT * q, z = id >> 11, r = (id >> 5) & 63, c4 = (id & 31) * 4; lpre[q] = *(const u32x4*)(LAU + ((size_t)z * T + t0_ + r) * W + n_ * 128 + c4); } } while (0)
    if ((int)blockIdx.x < (T / 64) * 8) LF_LOAD((int)blockIdx.x);
    for (int u = blockIdx.x; u < (T / 64) * 8; u += gridDim.x) {
        const int n = u & 7, tile = u >> 3, b = tile / NLC, chk = tile % NLC; const long t0 = (long)tile * 64;
#pragma unroll
        for (int q = 0; q < 8; ++q) { const int id = tid + NT * q, z = id >> 11, r = (id >> 5) & 63, c4 = (id & 31) * 4; *(u32x4*)(Lz + z * 8192 + r * 128 + c4) = lpre[q]; }
        SYNCTHREADS();
        if (u + (int)gridDim.x < (T / 64) * 8) LF_LOAD(u + (int)gridDim.x);
        unsigned long long graw[4];
#pragma unroll
        for (int q = 0; q < 4; ++q) { const int id = tid + NT * q, r = id >> 5, f4 = (id & 31) * 4; graw[q] = *(const unsigned long long*)(P + (size_t)(t0 + r) * PW + C_LG + n * 128 + f4); }
        if (tid < 256) { const int z = tid >> 7, f = tid & 127; float h = CI[(((size_t)z * NB + b) * NLC + chk) * W + n * 128 + f]; const unsigned* lp = Lz + z * 8192 + f; float* hp = Hz + z * 8192 + f;
#pragma unroll 8
            for (int q = 0; q < 64; ++q) { const int sI = z == 0 ? q : 63 - q; const unsigned w = lp[sI * 128]; h = fexp_(bflo(w)) * h + bfhi(w); hp[sI * 128] = h; } }
        SYNCTHREADS();
#pragma unroll
        for (int q = 0; q < 4; ++q) { const int id = tid + NT * q, r = id >> 5, f4 = (id & 31) * 4; const long t = t0 + r; f32x4 o = *(const f32x4*)(Hz + r * 128 + f4) + *(const f32x4*)(Hz + 8192 + r * 128 + f4); const unsigned glo = (unsigned)graw[q], ghi = (unsigned)(graw[q] >> 32); const f32x4 gv = (f32x4){bflo(glo), bfhi(glo), bflo(ghi), bfhi(ghi)};
#pragma unroll
            for (int e = 0; e < 4; ++e) o[e] *= geluf_(gv[e]);
            st_bf4(Y + (size_t)t * 4 * W + 0 * W + n * 128 + f4, o); }
        SYNCTHREADS();
    }
}
__device__ __forceinline__ void ph_lru_scan2(const Ctx& c) {
    const float* CA = WSF(O_LCA); const float* CH = WSF(O_LCH); float* CI = WSF(O_LCI);
    for (long i = GT_; i < (long)2 * NB * W; i += GS_) {
        const int w = (int)(i % W), b = (int)((i / W) % NB), z = (int)(i / ((long)W * NB)); float carry = 0.f;
#pragma unroll 16
        for (int q = 0; q < NLC; ++q) { const int ch = z == 0 ? q : NLC - 1 - q; const size_t idx = (((size_t)z * NB + b) * NLC + ch) * W + w; CI[idx] = carry; carry = CA[idx] * carry + CH[idx]; }
    }
}
__device__ __forceinline__ void ph_rope_table(const Ctx& c) {
    const int* pos = (const int*)c.in[2]; float* RT = WSF(O_ROPE);
    for (long i = GT_; i < (long)T * 32; i += GS_) { const int j = (int)(i & 31); const float ang = (float)pos[i >> 5] * powf(10000.f, -(float)(2 * j) / 64.f); RT[i * 2] = cosf(ang); RT[i * 2 + 1] = sinf(ang); }
}
__device__ __forceinline__ void ret_tables(float* tab, int h) {
    const int tid = threadIdx.x; const float lg = loggamma_(h);
    if (tid < 32) tab[tid] = powf(10000.f, -(float)(2 * tid) / 64.f);
    if (tid >= 64 && tid < 64 + 129) tab[tid] = expf((float)(tid - 64) * lg);
}
__device__ __forceinline__ void ph_ret_kv(const Ctx& c, float* ldsf) {
    const float* RT = WSF(O_ROPE); const bf16_t* P = WSH(O_P); float* KVF = WSF(O_KVF); float* KVB = WSF(O_KVB);
    bf16_t* VT = (bf16_t*)ldsf; bf16_t* KF = VT + 128 * 136; bf16_t* KB = KF + 64 * 136; float* tab = (float*)(KB + 64 * 136);
    const int tid = threadIdx.x, wv = tid >> 6, lane = tid & 63, fr = lane & 15, fq = lane >> 4;
    for (int u = blockIdx.x; u < (T / 128) * 8; u += gridDim.x) {
        const int h = u & 7; const long t0 = (long)(u >> 3) * 128;
        ret_tables(tab, h);
        SYNCTHREADS();
        {
            const int j = tid >> 2, d0 = (tid & 3) * 8; const bf16_t* prow = P + (size_t)(t0 + j) * PW + C_RK + h * 64; const float* rt = RT + ((size_t)(t0 + j) * 32 + d0) * 2;
            const u32x4 kl = *(const u32x4*)(prow + d0), kh = *(const u32x4*)(prow + d0 + 32);
            const f32x4 r0 = *(const f32x4*)rt, r1 = *(const f32x4*)(rt + 4), r2 = *(const f32x4*)(rt + 8), r3 = *(const f32x4*)(rt + 12);
            const float cs[8] = {r0[0], r0[2], r1[0], r1[2], r2[0], r2[2], r3[0], r3[2]}, sn[8] = {r0[1], r0[3], r1[1], r1[3], r2[1], r2[3], r3[1], r3[3]};
            const float fj = tab[64 + 127 - j], bj = tab[64 + j];
#pragma unroll
            for (int e = 0; e < 8; ++e) { const float x1 = (e & 1) ? bfhi(kl[e >> 1]) : bflo(kl[e >> 1]), x2 = (e & 1) ? bfhi(kh[e >> 1]) : bflo(kh[e >> 1]);
                const float k1 = x1 * cs[e] - x2 * sn[e], k2 = x2 * cs[e] + x1 * sn[e];
                KF[(d0 + e) * 136 + j] = (bf16_t)f2bf(k1 * fj); KF[(d0 + e + 32) * 136 + j] = (bf16_t)f2bf(k2 * fj); KB[(d0 + e) * 136 + j] = (bf16_t)f2bf(k1 * bj); KB[(d0 + e + 32) * 136 + j] = (bf16_t)f2bf(k2 * bj); } }
#pragma unroll
        for (int q = 0; q < 4; ++q) { const int id = tid + NT * q, j = id & 127, e8 = (id >> 7) * 8; const u32x4 raw = *(const u32x4*)(P + (size_t)(t0 + j) * PW + C_RV + h * 128 + e8);
#pragma unroll
            for (int e = 0; e < 4; ++e) { VT[(e8 + 2 * e) * 136 + j] = (bf16_t)(raw[e] & 0xffffu); VT[(e8 + 2 * e + 1) * 136 + j] = (bf16_t)(raw[e] >> 16); } }
        SYNCTHREADS();
        f32x4 af[4], ab[4];
#pragma unroll
        for (int nt = 0; nt < 4; ++nt) { af[nt] = (f32x4){0.f, 0.f, 0.f, 0.f}; ab[nt] = (f32x4){0.f, 0.f, 0.f, 0.f}; }
        wave_mma<4, 4>(af, VT + wv * 16 * 136, 136, KF, 136);
        wave_mma<4, 4>(ab, VT + wv * 16 * 136, 136, KB, 136);
        const size_t ob = (((size_t)(u >> 3) * 8 + h) * 128 + wv * 16 + fr) * 64 + 4 * fq;
#pragma unroll
        for (int nt = 0; nt < 4; ++nt) { *(f32x4*)(KVF + ob + 16 * nt) = af[nt]; *(f32x4*)(KVB + ob + 16 * nt) = ab[nt]; }
        SYNCTHREADS();
    }
}
__device__ __forceinline__ void ph_ret_state(const Ctx& c) {
    const float* KVF = WSF(O_KVF); const float* KVB = WSF(O_KVB); float* STF = WSF(O_STF); float* STB = WSF(O_STB);
    for (long i = GT_; i < (long)NB * 8 * 8192; i += GS_) {
        const int x = (int)(i % 8192), h = (int)((i / 8192) % 8), b = (int)(i / 65536);
        const float cd = expf(128.f * loggamma_(h)); float st = 0.f;
#pragma unroll 16
        for (int n = 0; n < NCH; ++n) { const size_t idx = (((size_t)b * NCH + n) * 8 + h) * 8192 + x; STF[idx] = st; st = cd * st + KVF[idx]; }
        st = 0.f;
#pragma unroll 16
        for (int n = NCH - 1; n >= 0; --n) { const size_t idx = (((size_t)b * NCH + n) * 8 + h) * 8192 + x; STB[idx] = st; st = cd * st + KVB[idx]; }
    }
}
__device__ __forceinline__ void ph_ret_out(const Ctx& c, float* ldsf) {
    const float* RT = WSF(O_ROPE); const bf16_t* P = WSH(O_P); const float* STF = WSF(O_STF); const float* STB = WSF(O_STB); bf16_t* Y = WSH(O_YS);
    bf16_t* Qs = (bf16_t*)ldsf; bf16_t* Ks = Qs + 128 * 72; bf16_t* VT = Ks + 128 * 72; bf16_t* Ss = VT + 128 * 136; bf16_t* SF = Ss + 128 * 136; bf16_t* SB = SF + 128 * 72; float* tab = (float*)(SB + 128 * 72);
    const int tid = threadIdx.x, wv = tid >> 6, lane = tid & 63, fr = lane & 15, fq = lane >> 4;
    for (int u = blockIdx.x; u < (T / 128) * 8; u += gridDim.x) {
        const int h = u & 7; const long t0 = (long)(u >> 3) * 128;
        ret_tables(tab, h);
        SYNCTHREADS();
        {
            const int j = tid >> 2, d0 = (tid & 3) * 8; const bf16_t* prow = P + (size_t)(t0 + j) * PW + h * 64 + d0; const float* rt = RT + ((size_t)(t0 + j) * 32 + d0) * 2;
            const u32x4 ql = *(const u32x4*)(prow + C_RQ), qh = *(const u32x4*)(prow + C_RQ + 32), kl = *(const u32x4*)(prow + C_RK), kh = *(const u32x4*)(prow + C_RK + 32);
            const f32x4 r0 = *(const f32x4*)rt, r1 = *(const f32x4*)(rt + 4), r2 = *(const f32x4*)(rt + 8), r3 = *(const f32x4*)(rt + 12);
            const float cs[8] = {r0[0], r0[2], r1[0], r1[2], r2[0], r2[2], r3[0], r3[2]}, sn[8] = {r0[1], r0[3], r1[1], r1[3], r2[1], r2[3], r3[1], r3[3]};
            u32x4 oql, oqh, okl, okh;
#pragma unroll
            for (int e = 0; e < 4; ++e) { const int ea = 2 * e, eb = 2 * e + 1;
                const float q1a = bflo(ql[e]), q1b = bfhi(ql[e]), q2a = bflo(qh[e]), q2b = bfhi(qh[e]), k1a = bflo(kl[e]), k1b = bfhi(kl[e]), k2a = bflo(kh[e]), k2b = bfhi(kh[e]);
                oql[e] = pk2((q1a * cs[ea] - q2a * sn[ea]) * 0.125f, (q1b * cs[eb] - q2b * sn[eb]) * 0.125f); oqh[e] = pk2((q2a * cs[ea] + q1a * sn[ea]) * 0.125f, (q2b * cs[eb] + q1b * sn[eb]) * 0.125f);
                okl[e] = pk2(k1a * cs[ea] - k2a * sn[ea], k1b * cs[eb] - k2b * sn[eb]); okh[e] = pk2(k2a * cs[ea] + k1a * sn[ea], k2b * cs[eb] + k1b * sn[eb]); }
            *(u32x4*)(Qs + j * 72 + d0) = oql; *(u32x4*)(Qs + j * 72 + d0 + 32) = oqh; *(u32x4*)(Ks + j * 72 + d0) = okl; *(u32x4*)(Ks + j * 72 + d0 + 32) = okh; }
#pragma unroll
        for (int q = 0; q < 4; ++q) { const int id = tid + NT * q, j = id & 127, e8 = (id >> 7) * 8; const u32x4 raw = *(const u32x4*)(P + (size_t)(t0 + j) * PW + C_RV + h * 128 + e8);
#pragma unroll
            for (int e = 0; e < 4; ++e) { VT[(e8 + 2 * e) * 136 + j] = (bf16_t)(raw[e] & 0xffffu); VT[(e8 + 2 * e + 1) * 136 + j] = (bf16_t)(raw[e] >> 16); } }
        const size_t sbase = (((size_t)(u >> 3) * 8 + h)) * 8192;
#pragma unroll
        for (int q = 0; q < 4; ++q) { const int id = tid + NT * q, e = id >> 4, d4 = (id & 15) * 4; st_bf4(SF + e * 72 + d4, *(const f32x4*)(STF + sbase + (size_t)e * 64 + d4)); st_bf4(SB + e * 72 + d4, *(const f32x4*)(STB + sbase + (size_t)e * 64 + d4)); }
        SYNCTHREADS();
        const int i = wv * 16 + fr; const long t = t0 + i;
        {
            f32x4 sc[8];
#pragma unroll
            for (int nt = 0; nt < 8; ++nt) sc[nt] = (f32x4){0.f, 0.f, 0.f, 0.f};
            wave_mma<2, 8>(sc, Qs + wv * 16 * 72, 72, Ks, 72);
#pragma unroll
            for (int nt = 0; nt < 8; ++nt) { const int j0 = 16 * nt + 4 * fq; f32x4 sv;
#pragma unroll
                for (int e = 0; e < 4; ++e) { const int j = j0 + e, dist = i > j ? i - j : j - i; sv[e] = sc[nt][e] * tab[64 + dist]; }
                st_bf4(Ss + i * 136 + j0, sv); }
        }
#ifdef CPU_EMU
        SYNCTHREADS();
#else
        asm volatile("s_waitcnt lgkmcnt(0)" ::: "memory");
#endif
        f32x4 ao[8], tm[8];
#pragma unroll
        for (int nt = 0; nt < 8; ++nt) { ao[nt] = (f32x4){0.f, 0.f, 0.f, 0.f}; tm[nt] = (f32x4){0.f, 0.f, 0.f, 0.f}; }
        wave_mma<4, 8>(ao, Ss + wv * 16 * 136, 136, VT, 136);
        wave_mma<2, 8>(tm, Qs + wv * 16 * 72, 72, SF, 72);
        { const float qf = tab[64 + i + 1];
#pragma unroll
            for (int nt = 0; nt < 8; ++nt) { ao[nt] += tm[nt] * qf; tm[nt] = (f32x4){0.f, 0.f, 0.f, 0.f}; } }
        wave_mma<2, 8>(tm, Qs + wv * 16 * 72, 72, SB, 72);
        { const float qb = tab[64 + 128 - i];
#pragma unroll
            for (int nt = 0; nt < 8; ++nt) ao[nt] += tm[nt] * qb; }
        float sm = 0.f;
#pragma unroll
        for (int nt = 0; nt < 8; ++nt) sm += (ao[nt][0] + ao[nt][1]) + (ao[nt][2] + ao[nt][3]);
        sm += SHFL_XOR(sm, 16); sm += SHFL_XOR(sm, 32);
        const float mu = sm * (1.f / 128.f); float sq = 0.f;
#pragma unroll
        for (int nt = 0; nt < 8; ++nt) { ao[nt] -= mu; sq += (ao[nt][0] * ao[nt][0] + ao[nt][1] * ao[nt][1]) + (ao[nt][2] * ao[nt][2] + ao[nt][3] * ao[nt][3]); }
        sq += SHFL_XOR(sq, 16); sq += SHFL_XOR(sq, 32);
        const float rs = frsq_(sq * (1.f / 128.f) + EPS);
#pragma unroll
        for (int nt = 0; nt < 8; ++nt) { const int e0 = 16 * nt + 4 * fq; f32x4 gv = ld_bf4(P + (size_t)t * PW + C_RG + h * 128 + e0);
#pragma unroll
            for (int e = 0; e < 4; ++e) gv[e] = siluf_(gv[e]) * (ao[nt][e] * rs);
            st_bf4(Y + (size_t)t * 4 * W + 1 * W + h * 128 + e0, gv); }
        SYNCTHREADS();
    }
}
__device__ __forceinline__ void ph_sgu_norm(const Ctx& c, int l) {
    const bf16_t* P = WSH(O_P); float* ST = WSF(O_VN);
    const int lane = threadIdx.x & 63, gw = blockIdx.x * (NT / 64) + (threadIdx.x >> 6), ngw = gridDim.x * (NT / 64);
    for (int t = gw; t < T; t += ngw) {
        f32x4 v[4]; float sm = 0.f;
#pragma unroll
        for (int j = 0; j < 4; ++j) { v[j] = ld_bf4(P + (size_t)t * PW + C_SV + (j * 64 + lane) * 4);
#pragma unroll
            for (int q = 0; q < 4; ++q) { v[j][q] = geluf_(v[j][q]); sm += v[j][q]; } }
        const float mu = wave_sum(sm) * (1.f / W); float sq = 0.f;
#pragma unroll
        for (int j = 0; j < 4; ++j)
#pragma unroll
            for (int q = 0; q < 4; ++q) { const float dd = v[j][q] - mu; sq += dd * dd; }
        const float rs = 1.f / sqrtf(wave_sum(sq) * (1.f / W) + EPS);
        if (lane == 0) { ST[(size_t)t * 2] = mu; ST[(size_t)t * 2 + 1] = rs; }
    }
}
__device__ __forceinline__ void ph_sgu_mix(const Ctx& c, int l, float* ldsf) {
    const bf16_t* P = WSH(O_P); const float* SG = WSF(O_HF) + (size_t)T * 32; bf16_t* Y = WSH(O_YS); const float* ng = c.in[15] + (size_t)l * W;
    bf16_t* As = (bf16_t*)ldsf; bf16_t* Bs = As + 128 * 136; const int tid = threadIdx.x, wv = tid >> 6, lane = tid & 63, fr = lane & 15, fq = lane >> 4;
    int gprev = -1;
    for (int u = blockIdx.x; u < (T / 128) * 8; u += gridDim.x) {
        const int g = u & 7; const long t0 = (long)(u >> 3) * 128;
        const float* ws = c.in[16] + ((size_t)l * 8 + g) * 128 * 128; const float* bs = c.in[17] + ((size_t)l * 8 + g) * 128;
        if (g != gprev) {
#pragma unroll
            for (int q = 0; q < 8; ++q) { const int id = tid + NT * q, i = id >> 5, j4 = (id & 31) * 4; st_bf4(As + i * 136 + j4, *(const f32x4*)(ws + i * 128 + j4)); }
            gprev = g; }
        float mu, rs;
        { const f32x4* sg = (const f32x4*)(SG + (size_t)(t0 + (tid & 127)) * 32); f32x4 a = sg[0];
#pragma unroll
          for (int i = 1; i < 8; ++i) a += sg[i];
          mu = (a[0] + a[2]) * (1.f / W); rs = frsq_(fmaxf((a[1] + a[3]) * (1.f / W) - mu * mu, 0.f) + EPS); }
#pragma unroll
        for (int q = 0; q < 4; ++q) { const int id = tid + NT * q, j = id & 127, d8 = (id >> 7) * 8;
            const u32x4 raw = *(const u32x4*)(P + (size_t)(t0 + j) * PW + C_SV + g * 128 + d8); const f32x4 n0 = *(const f32x4*)(ng + g * 128 + d8), n1 = *(const f32x4*)(ng + g * 128 + d8 + 4);
            const float ngv[8] = {n0[0], n0[1], n0[2], n0[3], n1[0], n1[1], n1[2], n1[3]};
#pragma unroll
            for (int e = 0; e < 4; ++e) { const float v0 = (geluf_(bflo(raw[e])) - mu) * rs * ngv[2 * e], v1 = (geluf_(bfhi(raw[e])) - mu) * rs * ngv[2 * e + 1];
                Bs[(d8 + 2 * e) * 136 + j] = (bf16_t)f2bf(v0); Bs[(d8 + 2 * e + 1) * 136 + j] = (bf16_t)f2bf(v1); } }
        const int i = wv * 16 + fr; const long t = t0 + i; const float bsi = bs[i];
        unsigned long long uraw[8];
#pragma unroll
        for (int nt = 0; nt < 8; ++nt) uraw[nt] = *(const unsigned long long*)(P + (size_t)t * PW + C_SU + g * 128 + 16 * nt + 4 * fq);
        SYNCTHREADS();
        f32x4 acc[8];
#pragma unroll
        for (int nt = 0; nt < 8; ++nt) acc[nt] = (f32x4){0.f, 0.f, 0.f, 0.f};
        wave_mma<4, 8>(acc, As + wv * 16 * 136, 136, Bs, 136);
#pragma unroll
        for (int nt = 0; nt < 8; ++nt) { const int d = 16 * nt + 4 * fq; const unsigned ulo = (unsigned)uraw[nt], uhi = (unsigned)(uraw[nt] >> 32); f32x4 uu = (f32x4){bflo(ulo), bfhi(ulo), bflo(uhi), bfhi(uhi)};
#pragma unroll
            for (int e = 0; e < 4; ++e) uu[e] = geluf_(uu[e]) * (acc[nt][e] + bsi);
            st_bf4(Y + (size_t)t * 4 * W + 2 * W + g * 128 + d, uu); }
        SYNCTHREADS();
    }
}
__device__ __forceinline__ void ph_rw_shift(const Ctx& c, int l) {
    const bf16_t* P = WSH(O_P); const float* mup = c.in[18] + (size_t)l * RF; const float* mun = c.in[19] + (size_t)l * RF; bf16_t* FS = WSH(O_FS);
    const int lane = threadIdx.x & 63, gw = blockIdx.x * (NT / 64) + (threadIdx.x >> 6), ngw = gridDim.x * (NT / 64);
    for (int t0 = gw * 4; t0 < T; t0 += ngw * 4) {
        const bf16_t* pc = P + (size_t)t0 * PW + C_RW;
#pragma unroll 1
        for (int j = lane * 4; j < RF; j += 256) {
            const f32x4 z4 = (f32x4){0.f, 0.f, 0.f, 0.f}; f32x4 rowv[6];
#pragma unroll
            for (int r = 0; r < 6; ++r) { const int t = t0 - 1 + r; rowv[r] = (t >= 0 && t < T) ? ld_bf4(pc + (long)(r - 1) * PW + j) : z4; }
            const f32x4 mp = *(const f32x4*)(mup + j), mn = *(const f32x4*)(mun + j);
#pragma unroll
            for (int r = 0; r < 4; ++r) { const int t = t0 + r, sI = t % S; const f32x4 f = rowv[r + 1]; const f32x4 pv = sI > 0 ? rowv[r] : z4, nv = sI < S - 1 ? rowv[r + 2] : z4;
                f32x4 v = f + mp * (pv - f) + mn * (nv - f);
                if (j >= 3072 && j < 3200) {
#pragma unroll
                    for (int e = 0; e < 4; ++e) v[e] = tanhf_(v[e]); }
                else if (j >= 3328) {
#pragma unroll
                    for (int e = 0; e < 4; ++e) v[e] = sigmoidf_(v[e]); }
                st_bf4(FS + (size_t)t * RF + j, v); }
        }
    }
}
__device__ __forceinline__ void ph_rw_lora(const Ctx& c, int l, float* ldsf) {
    const bf16_t* FS = WSH(O_FS); const float* w0 = c.in[20] + (size_t)l * 2 * W; const float* a0 = c.in[22] + (size_t)l * 2 * W;
    const bf16_t* WUT = WSH(O_WUT); const bf16_t* WAT = WSH(O_WAT); const bf16_t* WGT = WSH(O_WGT);
    bf16_t* DEC = WSH(O_DEC); bf16_t* AA = WSH(O_AA); bf16_t* GG = WSH(O_GG);
    bf16_t* F = (bf16_t*)ldsf; bf16_t* B1 = F + 128 * 136; bf16_t* B2 = B1 + 128 * 136; const int tid = threadIdx.x, wv = tid >> 6, lane = tid & 63, fr = lane & 15, fq = lane >> 4;
    unsigned long long fpre[8]; u32x4 bpre[4];
#define LORA_LOAD(uu, rdd) do { const int wc0_ = ((uu) & 7) * 128; const long t0_ = (long)((uu) >> 3) * 128; \
        _Pragma("unroll") for (int q = 0; q < 8; ++q) { const int id = tid + NT * q, r = id >> 5, c4 = (id & 31) * 4; \
            const int col = (rdd) < 2 ? (c4 < 64 ? 3072 + (rdd) * 64 + c4 : 3200 + (rdd) * 64 + (c4 - 64)) : 3328 + c4; fpre[q] = *(const unsigned long long*)(FS + (size_t)(t0_ + r) * RF + col); } \
        if ((rdd) < 2) { _Pragma("unroll") for (int q = 0; q < 2; ++q) { const int id = tid + NT * q, w = id >> 3, r8 = (id & 7) * 8; \
            bpre[2 * q] = *(const u32x4*)(WUT + ((size_t)(rdd) * W + wc0_ + w) * 64 + r8); bpre[2 * q + 1] = *(const u32x4*)(WAT + ((size_t)(rdd) * W + wc0_ + w) * 64 + r8); } } \
        else { _Pragma("unroll") for (int q = 0; q < 4; ++q) { const int id = tid + NT * q, w = id >> 4, r8 = (id & 15) * 8; bpre[q] = *(const u32x4*)(WGT + ((size_t)wc0_ + w) * 128 + r8); } } } while (0)
    if ((int)blockIdx.x < (T / 128) * 8) LORA_LOAD((int)blockIdx.x, 0);
    for (int u = blockIdx.x; u < (T / 128) * 8; u += gridDim.x) {
        const int wc0 = (u & 7) * 128; const long t0 = (long)(u >> 3) * 128;
#pragma unroll
        for (int rd = 0; rd < 3; ++rd) {
#pragma unroll
            for (int q = 0; q < 8; ++q) { const int id = tid + NT * q, r = id >> 5, c4 = (id & 31) * 4; *(unsigned long long*)(F + r * 136 + c4) = fpre[q]; }
            if (rd < 2) {
#pragma unroll
                for (int q = 0; q < 2; ++q) { const int id = tid + NT * q, w = id >> 3, r8 = (id & 7) * 8; *(u32x4*)(B1 + w * 72 + r8) = bpre[2 * q]; *(u32x4*)(B2 + w * 72 + r8) = bpre[2 * q + 1]; }
            } else {
#pragma unroll
                for (int q = 0; q < 4; ++q) { const int id = tid + NT * q, w = id >> 4, r8 = (id & 15) * 8; *(u32x4*)(B1 + w * 136 + r8) = bpre[q]; }
            }
            if (rd < 2) LORA_LOAD(u, rd + 1); else if (u + (int)gridDim.x < (T / 128) * 8) LORA_LOAD(u + (int)gridDim.x, 0);
            LDS_BARRIER();
            f32x4 a1[8], a2[8];
#pragma unroll
            for (int nt = 0; nt < 8; ++nt) { a1[nt] = (f32x4){0.f, 0.f, 0.f, 0.f}; a2[nt] = (f32x4){0.f, 0.f, 0.f, 0.f}; }
            const long t = t0 + wv * 16 + fr;
            if (rd < 2) {
                wave_mma<2, 8>(a1, F + wv * 16 * 136, 136, B1, 72);
                wave_mma<2, 8>(a2, F + wv * 16 * 136 + 64, 136, B2, 72);
#pragma unroll
                for (int nt = 0; nt < 8; ++nt) { const int ch = wc0 + 16 * nt + 4 * fq; const f32x4 w0v = *(const f32x4*)(w0 + rd * W + ch), a0v = *(const f32x4*)(a0 + rd * W + ch); f32x4 dv, av;
#pragma unroll
                    for (int e = 0; e < 4; ++e) { dv[e] = fexp_(-DECAY_SCALE * sigmoidf_(a1[nt][e] + w0v[e])); av[e] = sigmoidf_(a2[nt][e] + a0v[e]); }
                    st_bf4(DEC + ((size_t)rd * T + t) * W + ch, dv); st_bf4(AA + ((size_t)rd * T + t) * W + ch, av); }
            } else {
                wave_mma<4, 8>(a1, F + wv * 16 * 136, 136, B1, 136);
#pragma unroll
                for (int nt = 0; nt < 8; ++nt) st_bf4(GG + (size_t)t * W + wc0 + 16 * nt + 4 * fq, a1[nt]);
            }
            LDS_BARRIER();
        }
    }
}
#ifdef CPU_EMU
__device__ __forceinline__ float red16_(float x) { x += SHFL_XOR(x, 1); x += SHFL_XOR(x, 2); x += SHFL_XOR(x, 4); x += SHFL_XOR(x, 8); return x; }
__device__ __forceinline__ float red8_(float x) { x += SHFL_XOR(x, 1); x += SHFL_XOR(x, 2); x += SHFL_XOR(x, 4); return x; }
#else
__device__ __forceinline__ float red8_(float x) {
    x += __builtin_bit_cast(float, __builtin_amdgcn_update_dpp(0, __builtin_bit_cast(int, x), 0xB1, 0xF, 0xF, true));
    x += __builtin_bit_cast(float, __builtin_amdgcn_update_dpp(0, __builtin_bit_cast(int, x), 0x4E, 0xF, 0xF, true));
    x += __builtin_bit_cast(float, __builtin_amdgcn_update_dpp(0, __builtin_bit_cast(int, x), 0x141, 0xF, 0xF, true));
    return x;
}
__device__ __forceinline__ float red16_(float x) {
    x += __builtin_bit_cast(float, __builtin_amdgcn_update_dpp(0, __builtin_bit_cast(int, x), 0xB1, 0xF, 0xF, true));
    x += __builtin_bit_cast(float, __builtin_amdgcn_update_dpp(0, __builtin_bit_cast(int, x), 0x4E, 0xF, 0xF, true));
    x += __builtin_bit_cast(float, __builtin_amdgcn_update_dpp(0, __builtin_bit_cast(int, x), 0x141, 0xF, 0xF, true));
    x += __builtin_bit_cast(float, __builtin_amdgcn_update_dpp(0, __builtin_bit_cast(int, x), 0x140, 0xF, 0xF, true));
    return x;
}
#endif
#define RC_M(k) (lm + (k) * 4608)
__device__ __forceinline__ void ph_rw_chunk(const Ctx& c, int l, float* ldsf) {
    const bf16_t* FS = WSH(O_FS); const bf16_t* DEC = WSH(O_DEC); const bf16_t* AA = WSH(O_AA); float* BON = WSF(O_BON);
    const float* kkw = c.in[25] + (size_t)l * W; const float* kaw = c.in[26] + (size_t)l * W; const float* rk = c.in[27] + (size_t)l * W;
    bf16_t* PST = WSH(O_PST); bf16_t* PYT = WSH(O_PYT); bf16_t* SVB = WSH(O_SVB); bf16_t* YVB = WSH(O_YVB);
    bf16_t* lm = (bf16_t*)ldsf; float* gam = (float*)RC_M(7); float* segp = (float*)RC_M(13); float* gl = segp + 512;
    const int tid = threadIdx.x, wv = tid >> 6, lane = tid & 63, fr = lane & 15, fq = lane >> 4, rt = wv & 3, hf = wv >> 2;
    const int m0 = 16 * rt + fr;
    u32x4 wq, kq, rq, vq, aq;
#define RC_LOAD(uu) do { const int chain_ = (uu) / NRC, ck_ = (uu) % NRC, h_ = chain_ & 15, b_ = (chain_ >> 4) & 1, z_ = chain_ >> 5; \
        const long t_ = (long)b_ * S + (z_ ? S - 1 - ck_ * RCK - (tid >> 3) : ck_ * RCK + (tid >> 3)); const int ch_ = h_ * 64 + (tid & 7) * 8; \
        wq = *(const u32x4*)(DEC + ((size_t)z_ * T + t_) * W + ch_); aq = *(const u32x4*)(AA + ((size_t)z_ * T + t_) * W + ch_); \
        const bf16_t* f_ = FS + (size_t)t_ * RF; rq = *(const u32x4*)(f_ + ch_); kq = *(const u32x4*)(f_ + 1024 + ch_); vq = *(const u32x4*)(f_ + 2048 + ch_); } while (0)
    if ((int)blockIdx.x < 64 * NRC) RC_LOAD((int)blockIdx.x);
    for (int u = blockIdx.x; u < 64 * NRC; u += gridDim.x) {
        const int chain = u / NRC, ck = u % NRC, h = chain & 15, b = (chain >> 4) & 1, z = chain >> 5;
        const long tb = (long)b * S + (z ? S - 1 - ck * RCK : ck * RCK); const int dirn = z ? -1 : 1;
        const int tt = tid >> 3, o8 = (tid & 7) * 8;
        const f32x4 kw0 = *(const f32x4*)(kkw + h * 64 + o8), kw1 = *(const f32x4*)(kkw + h * 64 + o8 + 4), ka0 = *(const f32x4*)(kaw + h * 64 + o8), ka1 = *(const f32x4*)(kaw + h * 64 + o8 + 4),
                    rk0 = *(const f32x4*)(rk + h * 64 + o8), rk1 = *(const f32x4*)(rk + h * 64 + o8 + 4);
        *(f32x4*)(gam + tt * 64 + o8) = (f32x4){bflo(wq[0]), bfhi(wq[0]), bflo(wq[1]), bfhi(wq[1])};
        *(f32x4*)(gam + tt * 64 + o8 + 4) = (f32x4){bflo(wq[2]), bfhi(wq[2]), bflo(wq[3]), bfhi(wq[3])};
        LDS_BARRIER();
        { const int k = tid & 63, sg = tid >> 6; float p = 1.f;
#pragma unroll
          for (int q = 0; q < 8; ++q) { p *= gam[(sg * 8 + q) * 64 + k]; gam[(sg * 8 + q) * 64 + k] = p; }
          segp[sg * 64 + k] = p; }
        LDS_BARRIER();
        { const int k = tid & 63, sg = tid >> 6; float pre = 1.f;
          for (int q = 0; q < sg; ++q) pre *= segp[q * 64 + k];
#pragma unroll
          for (int q = 0; q < 8; ++q) gam[(sg * 8 + q) * 64 + k] *= pre;
          if (sg == 7) gl[k] = gam[63 * 64 + k]; }
        LDS_BARRIER();
        { const long t = tb + dirn * tt;
          const f32x4 g0 = *(const f32x4*)(gam + tt * 64 + o8), g1 = *(const f32x4*)(gam + tt * 64 + o8 + 4);
          f32x4 p0 = (f32x4){1.f, 1.f, 1.f, 1.f}, p1 = p0; if (tt) { p0 = *(const f32x4*)(gam + (tt - 1) * 64 + o8); p1 = *(const f32x4*)(gam + (tt - 1) * 64 + o8 + 4); }
          float gx[8], gpx[8], kwx[8], kax[8], rkx[8], kx[8], ax[8], rx[8];
#pragma unroll
          for (int e = 0; e < 4; ++e) { gx[e] = g0[e]; gx[4 + e] = g1[e]; gpx[e] = p0[e]; gpx[4 + e] = p1[e]; kwx[e] = kw0[e]; kwx[4 + e] = kw1[e]; kax[e] = ka0[e]; kax[4 + e] = ka1[e]; rkx[e] = rk0[e]; rkx[4 + e] = rk1[e];
              kx[2 * e] = bflo(kq[e]); kx[2 * e + 1] = bfhi(kq[e]); ax[2 * e] = bflo(aq[e]); ax[2 * e + 1] = bfhi(aq[e]); rx[2 * e] = bflo(rq[e]); rx[2 * e + 1] = bfhi(rq[e]); }
          float vk[8], ktv[8], ss = 0.f, bs = 0.f;
#pragma unroll
          for (int e = 0; e < 8; ++e) { vk[e] = kx[e] * kwx[e]; ss += vk[e] * vk[e]; ktv[e] = kx[e] * (1.f + (ax[e] - 1.f) * kax[e]); bs += rx[e] * rkx[e] * ktv[e]; }
          ss = red8_(ss); bs = red8_(bs);
          if ((tid & 7) == 0) BON[((size_t)z * T + t) * 16 + h] = bs;
          const float rn = frsq_(ss + EPS); float khv[8], bhv[8], k2v[8], rhv[8];
#pragma unroll
          for (int e = 0; e < 8; ++e) { const float kkn = vk[e] * rn, ig = frcp_(gx[e]); khv[e] = kkn * gpx[e]; bhv[e] = ax[e] * kkn * ig; k2v[e] = ktv[e] * ig; rhv[e] = rx[e] * gx[e]; }
          u32x4 K4, B4, C4, R4;
#pragma unroll
          for (int e = 0; e < 4; ++e) { K4[e] = pk2(khv[2 * e], khv[2 * e + 1]); B4[e] = pk2(bhv[2 * e], bhv[2 * e + 1]); C4[e] = pk2(k2v[2 * e], k2v[2 * e + 1]); R4[e] = pk2(rhv[2 * e], rhv[2 * e + 1]); }
          *(u32x4*)(RC_M(0) + tt * 72 + o8) = K4; *(u32x4*)(RC_M(2) + tt * 72 + o8) = B4; *(u32x4*)(RC_M(4) + tt * 72 + o8) = C4; *(u32x4*)(RC_M(5) + tt * 72 + o8) = R4;
#pragma unroll
          for (int e = 0; e < 8; ++e) { const int sh = 16 * (e & 1);
              RC_M(1)[(o8 + e) * 72 + tt] = (bf16_t)(K4[e >> 1] >> sh); RC_M(3)[(o8 + e) * 72 + tt] = (bf16_t)(B4[e >> 1] >> sh); RC_M(6)[(o8 + e) * 72 + tt] = (bf16_t)(vq[e >> 1] >> sh); } }
        if (u + (int)gridDim.x < 64 * NRC) RC_LOAD(u + (int)gridDim.x);
        LDS_BARRIER();
        f32x4 mkr[2], khr[2], rhT[2];
        {
            f32x4 a0[2], a1[2], a2[2], a3[2];
#pragma unroll
            for (int nt = 0; nt < 2; ++nt) { a0[nt] = (f32x4){0.f, 0.f, 0.f, 0.f}; a1[nt] = a0[nt]; a2[nt] = a0[nt]; a3[nt] = a0[nt]; }
            wave_mma<2, 2>(a0, RC_M(2) + rt * 16 * 72, 72, RC_M(0) + hf * 32 * 72, 72);
            wave_mma<2, 2>(a1, RC_M(4) + rt * 16 * 72, 72, RC_M(0) + hf * 32 * 72, 72);
            wave_mma<2, 2>(a2, RC_M(2) + rt * 16 * 72, 72, RC_M(5) + hf * 32 * 72, 72);
            wave_mma<2, 2>(a3, RC_M(4) + rt * 16 * 72, 72, RC_M(5) + hf * 32 * 72, 72);
#pragma unroll
            for (int nt = 0; nt < 2; ++nt) { const int n0 = 32 * hf + 16 * nt + 4 * fq; f32x4 nn, ti, mk;
#pragma unroll
                for (int r = 0; r < 4; ++r) { const int n = n0 + r; const bool lt = m0 < n, le = m0 <= n;
                    nn[r] = lt ? -a0[nt][r] : 0.f; ti[r] = nn[r] + (m0 == n ? 1.f : 0.f); mk[r] = lt ? a1[nt][r] : 0.f; mkr[nt][r] = le ? a3[nt][r] : 0.f;
                    RC_M(12)[n * 72 + m0] = (bf16_t)f2bf(le ? a2[nt][r] : 0.f);
                    RC_M(8)[n * 72 + m0] = (bf16_t)f2bf(nn[r]);
                    khr[nt][r] = bf2f(RC_M(4)[m0 * 72 + n]); rhT[nt][r] = bf2f(RC_M(5)[n * 72 + m0]); }
                st_bf4(RC_M(7) + m0 * 72 + n0, nn); st_bf4(RC_M(9) + m0 * 72 + n0, ti); st_bf4(RC_M(11) + m0 * 72 + n0, mk); }
        }
        LDS_BARRIER();
        f32x4 tiv[2];
#pragma unroll
        for (int nt = 0; nt < 2; ++nt) tiv[nt] = ld_bf4(RC_M(9) + m0 * 72 + 32 * hf + 16 * nt + 4 * fq);
        {
            f32x4 sq[2];
#pragma unroll
            for (int nt = 0; nt < 2; ++nt) sq[nt] = (f32x4){0.f, 0.f, 0.f, 0.f};
            wave_mma<2, 2>(sq, RC_M(7) + rt * 16 * 72, 72, RC_M(8) + hf * 32 * 72, 72);
#pragma unroll
            for (int nt = 0; nt < 2; ++nt) { const int n0 = 32 * hf + 16 * nt + 4 * fq; st_bf4(RC_M(0) + m0 * 72 + n0, sq[nt]);
#pragma unroll
                for (int r = 0; r < 4; ++r) RC_M(2)[(n0 + r) * 72 + m0] = (bf16_t)f2bf(sq[nt][r]); }
        }
        LDS_BARRIER();
#pragma unroll 1
        for (int k = 1; k <= 5; ++k) {
            bf16_t* pk = (k & 1) ? RC_M(0) : RC_M(7); bf16_t* pkT = (k & 1) ? RC_M(2) : RC_M(8); bf16_t* pn = (k & 1) ? RC_M(7) : RC_M(0); bf16_t* pnT = (k & 1) ? RC_M(8) : RC_M(2);
            bf16_t* tcur = (k & 1) ? RC_M(9) : RC_M(4); bf16_t* tnxt = (k & 1) ? RC_M(4) : RC_M(9);
            f32x4 up[2], sq[2];
#pragma unroll
            for (int nt = 0; nt < 2; ++nt) { up[nt] = (f32x4){0.f, 0.f, 0.f, 0.f}; sq[nt] = up[nt]; }
            wave_mma<2, 2>(up, tcur + rt * 16 * 72, 72, pkT + hf * 32 * 72, 72);
            if (k < 5) wave_mma<2, 2>(sq, pk + rt * 16 * 72, 72, pkT + hf * 32 * 72, 72);
#pragma unroll
            for (int nt = 0; nt < 2; ++nt) { const int n0 = 32 * hf + 16 * nt + 4 * fq; tiv[nt] += up[nt]; st_bf4(tnxt + m0 * 72 + n0, tiv[nt]);
                if (k == 5) {
#pragma unroll
                    for (int r = 0; r < 4; ++r) RC_M(10)[(n0 + r) * 72 + m0] = (bf16_t)f2bf(tiv[nt][r]);
                } else { st_bf4(pn + m0 * 72 + n0, sq[nt]);
#pragma unroll
                    for (int r = 0; r < 4; ++r) pnT[(n0 + r) * 72 + m0] = (bf16_t)f2bf(sq[nt][r]); } }
            LDS_BARRIER();
        }
        {
            f32x4 w1[2], w2[2];
#pragma unroll
            for (int nt = 0; nt < 2; ++nt) { w1[nt] = (f32x4){0.f, 0.f, 0.f, 0.f}; w2[nt] = w1[nt]; }
            wave_mma<2, 2>(w1, RC_M(1) + rt * 16 * 72, 72, RC_M(10) + hf * 32 * 72, 72);
            wave_mma<2, 2>(w2, RC_M(11) + rt * 16 * 72, 72, RC_M(10) + hf * 32 * 72, 72);
#pragma unroll
            for (int nt = 0; nt < 2; ++nt) { const int n0 = 32 * hf + 16 * nt + 4 * fq; st_bf4(RC_M(7) + m0 * 72 + n0, w1[nt]); st_bf4(RC_M(8) + m0 * 72 + n0, w2[nt]); }
        }
        LDS_BARRIER();
        {
            f32x4 py[2], qy[2], ps[2], qs[2];
#pragma unroll
            for (int nt = 0; nt < 2; ++nt) { py[nt] = (f32x4){0.f, 0.f, 0.f, 0.f}; qy[nt] = py[nt]; ps[nt] = py[nt]; qs[nt] = py[nt]; }
            wave_mma<2, 2>(py, RC_M(7) + rt * 16 * 72, 72, RC_M(12) + hf * 32 * 72, 72);
            wave_mma<2, 2>(qy, RC_M(8) + rt * 16 * 72, 72, RC_M(12) + hf * 32 * 72, 72);
            wave_mma<2, 2>(ps, RC_M(7) + rt * 16 * 72, 72, RC_M(3) + hf * 32 * 72, 72);
            wave_mma<2, 2>(qs, RC_M(8) + rt * 16 * 72, 72, RC_M(3) + hf * 32 * 72, 72);
#pragma unroll
            for (int nt = 0; nt < 2; ++nt) { const int n0 = 32 * hf + 16 * nt + 4 * fq;
#pragma unroll
                for (int r = 0; r < 4; ++r) { const int n = n0 + r; const float gln = gl[n];
                    RC_M(0)[n * 72 + m0] = (bf16_t)f2bf(rhT[nt][r] - py[nt][r]); RC_M(2)[n * 72 + m0] = (bf16_t)f2bf(mkr[nt][r] - qy[nt][r]);
                    RC_M(4)[n * 72 + m0] = (bf16_t)f2bf(((m0 == n ? 1.f : 0.f) - ps[nt][r]) * gln); RC_M(5)[n * 72 + m0] = (bf16_t)f2bf((khr[nt][r] - qs[nt][r]) * gln); } }
        }
        LDS_BARRIER();
        {
            f32x4 yv[2], sv[2];
#pragma unroll
            for (int nt = 0; nt < 2; ++nt) { yv[nt] = (f32x4){0.f, 0.f, 0.f, 0.f}; sv[nt] = yv[nt]; }
            wave_mma<2, 2>(yv, RC_M(6) + rt * 16 * 72, 72, RC_M(2) + hf * 32 * 72, 72);
            wave_mma<2, 2>(sv, RC_M(6) + rt * 16 * 72, 72, RC_M(5) + hf * 32 * 72, 72);
#pragma unroll
            for (int nt = 0; nt < 2; ++nt) { const int n0 = 32 * hf + 16 * nt + 4 * fq; st_bf4(YVB + (size_t)u * 4096 + m0 * 64 + n0, yv[nt]); st_bf4(SVB + (size_t)u * 4096 + m0 * 64 + n0, sv[nt]); }
            { const int rr = tid >> 3, c8 = (tid & 7) * 8; *(u32x4*)(PYT + (size_t)u * 4096 + rr * 64 + c8) = *(const u32x4*)(RC_M(0) + rr * 72 + c8); *(u32x4*)(PST + (size_t)u * 4096 + rr * 64 + c8) = *(const u32x4*)(RC_M(4) + rr * 72 + c8); }
        }
        LDS_BARRIER();
    }
}
#undef RC_M
#undef RC_LOAD
__device__ __forceinline__ void ph_rw_seq(const Ctx& c, float* ldsf) {
    const bf16_t* PST = WSH(O_PST); const bf16_t* PYT = WSH(O_PYT); const bf16_t* SVB = WSH(O_SVB); const bf16_t* YVB = WSH(O_YVB); bf16_t* YY = WSH(O_YY);
    bf16_t* Sb = (bf16_t*)ldsf;
    bf16_t* Pm = Sb + 2 * 16 * 72;
    const int tid = threadIdx.x, wv = tid >> 6, lane = tid & 63, fr = lane & 15, fq = lane >> 4, nt0 = wv & 3;
#ifdef CPU_EMU
    const int isY = wv >> 2;
#else
    const int isY = __builtin_amdgcn_readfirstlane(wv >> 2);
#endif
    for (int u = blockIdx.x; u < 256; u += gridDim.x) {
        const int x = u & 7, jq = u >> 3, chain = x * 8 + (jq >> 2), qt = jq & 3, h = chain & 15, b = (chain >> 4) & 1, z = chain >> 5;
        const size_t ub = (size_t)chain * NRC;
        const int rr = tid >> 3, c8 = (tid & 7) * 8;
        constexpr int PD = NRC >= 8 ? 8 : 4;
        for (int i = tid; i < 2 * 16 * 72 / 2; i += NT) ((unsigned*)Sb)[i] = 0u;
        const int row = 16 * qt + fr, n0 = 16 * nt0 + 4 * fq; const bf16_t* addp = (isY ? YVB : SVB) + ub * 4096 + row * 64 + n0;
        const bf16_t* psp = PST + ub * 4096 + rr * 64 + c8; const bf16_t* pyp = PYT + ub * 4096 + rr * 64 + c8;
        u32x4 gps[PD], gpy[PD]; unsigned long long addr[PD];
#pragma unroll
        for (int j = 0; j < PD; ++j) { gps[j] = *(const u32x4*)(psp + (size_t)j * 4096); gpy[j] = *(const u32x4*)(pyp + (size_t)j * 4096); addr[j] = *(const unsigned long long*)(addp + (size_t)j * 4096); }
        *(u32x4*)(Pm + (0 * 2 + 0) * 4608 + rr * 72 + c8) = gps[0]; *(u32x4*)(Pm + (0 * 2 + 1) * 4608 + rr * 72 + c8) = gpy[0];
        { const int cl = PD < NRC ? PD : NRC - 1; gps[0] = *(const u32x4*)(psp + (size_t)cl * 4096); gpy[0] = *(const u32x4*)(pyp + (size_t)cl * 4096); }
        SYNCTHREADS();
#define RS_LOOP(ISY) \
        for (int ck0 = 0; ck0 < NRC; ck0 += PD) { \
            _Pragma("unroll") for (int j = 0; j < PD; ++j) { \
                const int ck = ck0 + j, cur = j & 1, nxt = cur ^ 1;        \
                f32x4 acc[1]; acc[0] = (f32x4){0.f, 0.f, 0.f, 0.f}; \
                wave_mma<2, 1>(acc, Sb + cur * 16 * 72, 72, Pm + (cur * 2 + ISY) * 4608 + nt0 * 16 * 72, 72); \
                { const unsigned lo_ = (unsigned)addr[j], hi_ = (unsigned)(addr[j] >> 32); acc[0][0] += bflo(lo_); acc[0][1] += bfhi(lo_); acc[0][2] += bflo(hi_); acc[0][3] += bfhi(hi_); } \
                { const int cl = ck + PD < NRC ? ck + PD : NRC - 1; addr[j] = *(const unsigned long long*)(addp + (size_t)cl * 4096); } \
                if (ISY) { \
                    _Pragma("unroll") for (int r = 0; r < 4; ++r) { const int step = ck * RCK + n0 + r, sidx = z ? S - 1 - step : step; YY[((size_t)z * T + (size_t)b * S + sidx) * W + h * 64 + row] = (bf16_t)f2bf(acc[0][r]); } \
                } else st_bf4(Sb + nxt * 16 * 72 + fr * 72 + n0, acc[0]); \
                const int jn = (j + 1) % PD; \
                *(u32x4*)(Pm + (nxt * 2 + 0) * 4608 + rr * 72 + c8) = gps[jn]; *(u32x4*)(Pm + (nxt * 2 + 1) * 4608 + rr * 72 + c8) = gpy[jn]; \
                { const int cl = ck + 1 + PD < NRC ? ck + 1 + PD : NRC - 1; gps[jn] = *(const u32x4*)(psp + (size_t)cl * 4096); gpy[jn] = *(const u32x4*)(pyp + (size_t)cl * 4096); } \
                LDS_BARRIER(); \
            } \
        }
        if (isY) { RS_LOOP(1) } else { RS_LOOP(0) }
#undef RS_LOOP
    }
}
__device__ __forceinline__ void ph_rw_out(const Ctx& c) {
    const bf16_t* FS = WSH(O_FS); const bf16_t* YY = WSH(O_YY); const float* BON = WSF(O_BON); const bf16_t* GG = WSH(O_GG); bf16_t* Y = WSH(O_YS);
    const int lane = threadIdx.x & 63, gw = blockIdx.x * (NT / 64) + (threadIdx.x >> 6), ngw = gridDim.x * (NT / 64);
    for (int i0 = gw; i0 < T * 2; i0 += 2 * ngw) {
        u32x4 a0[2], a1[2], gq[2], vq[2]; float bs[2];
#pragma unroll
        for (int r = 0; r < 2; ++r) { const int i = i0 + r * ngw < T * 2 ? i0 + r * ngw : i0; const long t = i >> 1; const int ch = (i & 1) * 512 + lane * 8, hd = ch >> 6;
            a0[r] = *(const u32x4*)(YY + (size_t)t * W + ch); a1[r] = *(const u32x4*)(YY + ((size_t)T + t) * W + ch); gq[r] = *(const u32x4*)(GG + (size_t)t * W + ch); vq[r] = *(const u32x4*)(FS + (size_t)t * RF + 2048 + ch);
            bs[r] = BON[(size_t)t * 16 + hd] + BON[((size_t)T + t) * 16 + hd]; }
#pragma unroll
        for (int r = 0; r < 2; ++r) { const int i = i0 + r * ngw < T * 2 ? i0 + r * ngw : i0; const long t = i >> 1; const int ch = (i & 1) * 512 + lane * 8;
            float y0[8], y1[8], s0 = 0.f, s1 = 0.f;
#pragma unroll
            for (int e = 0; e < 4; ++e) { y0[2 * e] = bflo(a0[r][e]); y0[2 * e + 1] = bfhi(a0[r][e]); y1[2 * e] = bflo(a1[r][e]); y1[2 * e + 1] = bfhi(a1[r][e]); }
#pragma unroll
            for (int e = 0; e < 8; ++e) { s0 += y0[e]; s1 += y1[e]; }
            const float m0 = red8_(s0) * (1.f / 64.f), m1 = red8_(s1) * (1.f / 64.f); float q0 = 0.f, q1 = 0.f;
#pragma unroll
            for (int e = 0; e < 8; ++e) { y0[e] -= m0; y1[e] -= m1; q0 += y0[e] * y0[e]; q1 += y1[e] * y1[e]; }
            const float r0 = frsq_(red8_(q0) * (1.f / 64.f) + EPS), r1 = frsq_(red8_(q1) * (1.f / 64.f) + EPS);
            u32x4 o;
#pragma unroll
            for (int e = 0; e < 4; ++e) { const float lo = (y0[2 * e] * r0 + y1[2 * e] * r1 + bs[r] * bflo(vq[r][e])) * bflo(gq[r][e]), hi = (y0[2 * e + 1] * r0 + y1[2 * e + 1] * r1 + bs[r] * bfhi(vq[r][e])) * bfhi(gq[r][e]); o[e] = pk2(lo, hi); }
            *(u32x4*)(Y + (size_t)t * 4 * W + 3 * W + ch) = o; }
    }
}
__device__ __forceinline__ float row_rstd_(const float* ssp, long tr) { const f32x4* q = (const f32x4*)(ssp + (size_t)tr * 32); f32x4 a = q[0];
#pragma unroll
    for (int i = 1; i < 8; ++i) a += q[i];
    return frsq_(((a[0] + a[1]) + (a[2] + a[3])) * (1.f / D) + EPS); }
__device__ __forceinline__ void ph_router(const Ctx& c, int l, float* ldsf, const float* X, const float* gN, const float* shN, const float* scN) {
    const float* SSP = WSF(O_HF); bf16_t* Hn = WSH(O_H); const bf16_t* WH = WSH(O_WRH); const bf16_t* WL = WSH(O_WRL); const float* bg = c.in[31] + (size_t)l * 4; const float* be = c.in[33] + (size_t)l * 32;
    int* EID = WSI(O_EID); float* EWT = WSF(O_EWT); int* cnt = CTLW(c) + CW_CNT + l * 64;
    const int tid = threadIdx.x, wv = tid >> 6, lane = tid & 63, fr = lane & 15, fq = lane >> 4, rt = wv & 1, kq = wv >> 1;
    float* part = ldsf;
    for (int u = blockIdx.x; u < T / 32; u += gridDim.x) {
        const long t0 = (long)u * 32; f32x4 acc[3];
#pragma unroll
        for (int nt = 0; nt < 3; ++nt) acc[nt] = (f32x4){0.f, 0.f, 0.f, 0.f};
#ifdef CPU_EMU
        for (int nt = 0; nt < 3; ++nt) for (int r = 0; r < 4; ++r) { const int n = 16 * nt + 4 * fq + r; float sacc = 0.f;
            for (int k = kq * 512; k < kq * 512 + 512; ++k) { const long tr = t0 + 16 * rt + fr; const int bb = (int)(tr / S); const float hv = X[(size_t)tr * D + k] * row_rstd_(SSP, tr) * gN[k] * (1.f + scN[bb * D6 + k]) + shN[bb * D6 + k]; const float hh = bf2f((bf16_t)f2bf(hv)), hl = bf2f((bf16_t)f2bf(hv - hh));
                const float wh = bf2f(WH[(size_t)n * D + k]), wl = bf2f(WL[(size_t)n * D + k]); sacc += hh * wh + hl * wh + hh * wl; }
            acc[nt][r] = sacc; }
        if (fq == 0) for (int k = kq * 512; k < kq * 512 + 512; ++k) { const long tr = t0 + 16 * rt + fr; const int bb = (int)(tr / S); Hn[(size_t)tr * D + k] = (bf16_t)f2bf(X[(size_t)tr * D + k] * row_rstd_(SSP, tr) * gN[k] * (1.f + scN[bb * D6 + k]) + shN[bb * D6 + k]); }
#else
        const long tr = t0 + 16 * rt + fr; const int bb = (int)(tr / S); const float rsv = row_rstd_(SSP, tr); const int kb = kq * 512 + fq * 8;
        const float* hp = X + (size_t)tr * D + kb; const float* gp_ = gN + kb; const float* scp = scN + bb * D6 + kb; const float* shp = shN + bb * D6 + kb;
#pragma unroll 4
        for (int ks = 0; ks < 16; ++ks) {
            const f32x4 h0 = *(const f32x4*)(hp + ks * 32) * rsv * *(const f32x4*)(gp_ + ks * 32) * (*(const f32x4*)(scp + ks * 32) + 1.f) + *(const f32x4*)(shp + ks * 32);
            const f32x4 h1 = *(const f32x4*)(hp + ks * 32 + 4) * rsv * *(const f32x4*)(gp_ + ks * 32 + 4) * (*(const f32x4*)(scp + ks * 32 + 4) + 1.f) + *(const f32x4*)(shp + ks * 32 + 4); bf16x8 ah, al;
#pragma unroll
            for (int e = 0; e < 4; ++e) { const unsigned b0 = f2bf(h0[e]), b1 = f2bf(h1[e]); ah[e] = (short)b0; ah[4 + e] = (short)b1; al[e] = (short)f2bf(h0[e] - u2f_(b0 << 16)); al[4 + e] = (short)f2bf(h1[e] - u2f_(b1 << 16)); }
            *(bf16x8*)(Hn + (size_t)tr * D + kb + ks * 32) = ah;
#pragma unroll
            for (int nt = 0; nt < 3; ++nt) { const size_t wo = (size_t)(16 * nt + fr) * D + kq * 512 + ks * 32 + fq * 8; const bf16x8 bh = *(const bf16x8*)(WH + wo), bl = *(const bf16x8*)(WL + wo);
                acc[nt] = __builtin_amdgcn_mfma_f32_16x16x32_bf16(bh, ah, acc[nt], 0, 0, 0); acc[nt] = __builtin_amdgcn_mfma_f32_16x16x32_bf16(bh, al, acc[nt], 0, 0, 0); acc[nt] = __builtin_amdgcn_mfma_f32_16x16x32_bf16(bl, ah, acc[nt], 0, 0, 0); }
        }
#endif
#pragma unroll
        for (int nt = 0; nt < 3; ++nt) *(f32x4*)(part + (kq * 32 + 16 * rt + fr) * 48 + 16 * nt + 4 * fq) = acc[nt];
        SYNCTHREADS();
        if (tid < 32) { const long t = t0 + tid; float lg[36];
#pragma unroll
            for (int q = 0; q < 36; ++q) lg[q] = (part[(0 * 32 + tid) * 48 + q] + part[(1 * 32 + tid) * 48 + q]) + (part[(2 * 32 + tid) * 48 + q] + part[(3 * 32 + tid) * 48 + q]) + (q < 4 ? bg[q < 4 ? q : 0] : be[q >= 4 ? q - 4 : 0]);
            int gi = 0; float m = lg[0];
#pragma unroll
            for (int q = 1; q < 4; ++q) if (lg[q] > m) { m = lg[q]; gi = q; }
            float den = 0.f;
#pragma unroll
            for (int q = 0; q < 4; ++q) den += expf(lg[q] - m);
            const float gp = 1.f / den; float el[8];
#pragma unroll
            for (int q = 0; q < 8; ++q) el[q] = gi == 0 ? lg[4 + q] : gi == 1 ? lg[12 + q] : gi == 2 ? lg[20 + q] : lg[28 + q];
            int i1 = 0; float m1 = el[0];
#pragma unroll
            for (int q = 1; q < 8; ++q) if (el[q] > m1) { m1 = el[q]; i1 = q; }
            int i2 = -1; float m2 = 0.f;
#pragma unroll
            for (int q = 0; q < 8; ++q) if (q != i1 && (i2 < 0 || el[q] > m2)) { m2 = el[q]; i2 = q; }
            const float p2 = expf(m2 - m1);
            EID[t * 2] = gi * 8 + i1; EID[t * 2 + 1] = gi * 8 + i2; EWT[t * 2] = gp / (1.f + p2); EWT[t * 2 + 1] = gp * p2 / (1.f + p2);
            atomic_add_i(cnt + gi * 8 + i1, 1); atomic_add_i(cnt + gi * 8 + i2, 1);
        }
        SYNCTHREADS();
    }
}
__device__ __forceinline__ void ph_moe_assign(const Ctx& c, int l, float* ldsf) {
    const int* cnt = CTLW(c) + CW_CNT + l * 64; int* plan = CTLW(c) + CW_PLAN + l * 256; const int* EID = WSI(O_EID); int* fill = CTLW(c) + CW_FILL + l * 64; int* DEST = WSI(O_DEST); int* SRC = WSI(O_XS);
    int* pstart = (int*)ldsf;
    if (threadIdx.x == 0) { int ps = 0, nb = 0; const bool pub = blockIdx.x == 0;
        for (int e = 0; e < NE; ++e) { pstart[e] = ps; if (pub) plan[e] = ps; const int nblk = (cnt[e] + 255) / 256; if (pub) for (int q = 0; q < nblk; ++q) plan[64 + nb + q] = e; nb += nblk; ps += nblk * 256; }
        if (pub) { plan[32] = ps; plan[40] = nb; } }
    SYNCTHREADS();
    for (long i = GT_; i < (long)T * 2; i += GS_) { const int e = EID[i]; const int pos = atomic_add_i(fill + e, 1); DEST[i] = pstart[e] + pos; SRC[pstart[e] + pos] = (int)(i >> 1); }
    SYNCTHREADS();
}
__device__ __forceinline__ void ph_moe_gather(const Ctx& c) {
    const int* DEST = WSI(O_DEST); const u32x4* H = (const u32x4*)WSH(O_H); u32x4* XS = (u32x4*)WSH(O_XS);
    const long N = (long)T * 2 * (D / 8);
    for (long i0 = GT_; i0 < N; i0 += 4 * GS_) {
        u32x4 v[4]; int d[4];
#pragma unroll
        for (int r = 0; r < 4; ++r) { const long i = i0 + r * GS_ < N ? i0 + r * GS_ : i0; const long a = i / (D / 8); d[r] = DEST[a]; v[r] = H[(size_t)(a >> 1) * (D / 8) + (int)(i % (D / 8))]; }
#pragma unroll
        for (int r = 0; r < 4; ++r) { const long i = i0 + r * GS_ < N ? i0 + r * GS_ : i0; XS[(size_t)d[r] * (D / 8) + (int)(i % (D / 8))] = v[r]; }
    }
}
#ifndef CPU_EMU
#define XB_TMO      128
#define XB_XCNT(j)  (256  + 64 * (j))
#define XB_XSUB(j)  (1280 + 64 * (j))
#define XB_XGEN(j)  (2304 + 64 * (j))
#define XB_TOP      3328
#define XB_TOPGEN   3392
#define XCD_BAR_WORDS 3456
#define XB_SPIN_CAP (1u << 26)
#define LAS __attribute__((address_space(3)))
__device__ __forceinline__ unsigned xb_ld(unsigned* p)              { return __hip_atomic_load(p, __ATOMIC_RELAXED, __HIP_MEMORY_SCOPE_AGENT); }
__device__ __forceinline__ unsigned xb_add(unsigned* p, unsigned v) { return __hip_atomic_fetch_add(p, v, __ATOMIC_RELAXED, __HIP_MEMORY_SCOPE_AGENT); }
__device__ __forceinline__ unsigned xb_xcc_id() { return (unsigned)__builtin_amdgcn_s_getreg((3 << 11) | 20) & 0xFu; }
#define XB_SPIN(cond, bar) do { unsigned _sp = 0; while (cond) { __builtin_amdgcn_s_sleep(1); \
    if ((++_sp & 255u) == 0u) { if (xb_ld(&(bar)[XB_TMO])) break; if (_sp > XB_SPIN_CAP) { atomicAdd(&(bar)[XB_TMO], 1u); break; } } } } while (0)
struct XcdBarrier { unsigned* bar; unsigned x; volatile LAS unsigned* st; };
__device__ __forceinline__ XcdBarrier xcd_barrier_post(unsigned* bar, volatile LAS unsigned* st) {
    XcdBarrier b; b.bar = bar; b.x = xb_xcc_id(); b.st = st;
    if (threadIdx.x == 0) (void)xb_add(&bar[XB_XCNT(b.x)], 1u);
    return b;
}
__device__ __forceinline__ void xcd_barrier_complete(unsigned* bar, unsigned x, unsigned& nloc, unsigned& nx) {
    const unsigned G = gridDim.x * gridDim.y * gridDim.z;
    unsigned sum, cnt, mine, sp = 0u;
    for (;;) {
        sum = 0u; cnt = 0u; mine = 0u;
#pragma unroll
        for (unsigned j = 0; j < 16; ++j) { const unsigned cc = xb_ld(&bar[XB_XCNT(j)]); sum += cc; cnt += (cc > 0u) ? 1u : 0u; mine = (j == x) ? cc : mine; }
        if (sum == G) break;
        __builtin_amdgcn_s_sleep(1);
        if ((++sp & 255u) == 0u) { if (xb_ld(&bar[XB_TMO])) break; if (sp > XB_SPIN_CAP) { atomicAdd(&bar[XB_TMO], 1u); break; } }
    }
    nloc = mine > 0u ? mine : 1u; nx = cnt > 0u ? cnt : 1u;
}
__device__ __forceinline__ void xcd_barrier(const XcdBarrier& b) {
    asm volatile("s_waitcnt vmcnt(0)" ::: "memory");
    __syncthreads();
    if (threadIdx.x == 0) {
        unsigned* bar = b.bar;
        __builtin_amdgcn_s_waitcnt(0);
        unsigned nloc = b.st[0], nx = b.st[1];
        if (nloc == 0u) { xcd_barrier_complete(bar, b.x, nloc, nx); b.st[0] = nloc; b.st[1] = nx; }
        const unsigned old = xb_add(&bar[XB_XSUB(b.x)], 1u);
        const unsigned gen = old / nloc;
        if (old + 1u == (gen + 1u) * nloc) {
            __builtin_amdgcn_fence(__ATOMIC_RELEASE, "agent");
            asm volatile("s_waitcnt vmcnt(0)" ::: "memory");
            const unsigned og = xb_add(&bar[XB_TOP], 1u);
            const unsigned tg = og / nx;
            if (og + 1u == (tg + 1u) * nx) xb_add(&bar[XB_TOPGEN], 1u);
            else XB_SPIN(xb_ld(&bar[XB_TOPGEN]) == tg, bar);
            __builtin_amdgcn_fence(__ATOMIC_ACQUIRE, "agent");
            xb_add(&bar[XB_XGEN(b.x)], 1u);
            asm volatile("s_waitcnt vmcnt(0)" ::: "memory");
        } else {
            XB_SPIN(xb_ld(&bar[XB_XGEN(b.x)]) == gen, bar);
            __builtin_amdgcn_fence(__ATOMIC_ACQUIRE, "agent");
            asm volatile("s_waitcnt vmcnt(0)" ::: "memory");
        }
    }
    __syncthreads();
}
#endif

constexpr int LDS_BYTES = 147456;

__global__ void __launch_bounds__(NT, 2) fwd(Params p) {
#ifdef CPU_EMU
    unsigned char* lds = g_lds; float* ldsf = (float*)g_lds;
#else
    extern __shared__ __attribute__((aligned(16))) unsigned char lds[];
    float* ldsf = (float*)lds;
    volatile LAS unsigned* misc = (volatile LAS unsigned*)((LAS unsigned char*)lds + LDS_BYTES - 64);
    if (threadIdx.x == 0) { misc[0] = 0u; misc[1] = 0u; }
    __syncthreads();
    XcdBarrier bar = xcd_barrier_post((unsigned*)(p.ws + O_CTL) + CW_BAR, misc);
#endif
    Ctx c; c.in = p.in; c.out = p.out; c.ws = p.ws;
    const int lo = p.ph_lo, hi = p.ph_hi; int ph = 0;
    const int G = (int)gridDim.x, cwg = (int)blockIdx.x;
#ifdef CPU_EMU
#define GRID_BAR()
#else
#define GRID_BAR() xcd_barrier(bar)
#endif
#ifndef REPEAT_MASK
#define REPEAT_MASK 0
#endif
#ifndef TIME_PHASE
#define TIME_PHASE -1
#endif
#if TIME_PHASE >= 0 && !defined(CPU_EMU)
    unsigned long long tp0 = 0, tp1 = 0;
#define TP_BEGIN() do { if (ph == TIME_PHASE) tp0 = __builtin_amdgcn_s_memrealtime(); } while (0)
#define TP_END() do { if (ph == TIME_PHASE) tp1 = __builtin_amdgcn_s_memrealtime(); } while (0)
#else
#define TP_BEGIN()
#define TP_END()
#endif
#define PHASE(...) do { if (lo <= ph && ph < hi) { TP_BEGIN(); __VA_ARGS__; if (ph + 1 < hi) { GRID_BAR(); } TP_END(); } ++ph; } while (0)
#define PHASEG(grp, ...) do { if (lo <= ph && ph < hi) { TP_BEGIN(); if ((REPEAT_MASK >> (grp)) & 1) { __VA_ARGS__; GRID_BAR(); } __VA_ARGS__; if (ph + 1 < hi) { GRID_BAR(); } TP_END(); } ++ph; } while (0)
    PHASE(ph_mod(c, ldsf); ph_rope_table(c); ph_convert(c, 0, ldsf));
#define LAYER_BODY(l) do { const float* mod = WSF(O_MOD); \
        const float* xin = l == 0 ? c.in[0] : WSF(O_X1); float* xmid = WSF(O_X0); float* xout = WSF(O_X1); \
        const float* ml = mod + (size_t)l * NB * D6; \
        PHASEG(0, { pg8::Gemm g{D, D, D}; pg8::StaticOrder so; so.init(T, PW, G, cwg, WSH(O_H), WSH(O_WIN), D, D); pg8::EpiP E{WSH(O_P), (unsigned char*)(c.ws + O_G8), WSF(O_HF) + (size_t)T * 32}; pg8::gemm_phase(lds, g, so, E); \
            { const int nun_ = (T / 256) * (PW / 256), rem_ = nun_ % G; if (rem_ != 0 && cwg >= rem_) { SYNCTHREADS(); convert_big(c, l, ldsf, J_ALL - convert_tail_tiles(), J_ALL, cwg - rem_, G - rem_); } } }); \
        PHASE(ph_lru<1>(c, l, ldsf); ph_ret_kv(c, ldsf); ph_rw_shift(c, l)); \
        PHASE(ph_lru_scan2(c); ph_ret_state(c); ph_sgu_mix(c, l, ldsf); ph_rw_lora(c, l, ldsf)); \
        PHASE(ph_lru_fin(c, ldsf); ph_ret_out(c, ldsf); ph_rw_chunk(c, l, ldsf)); \
        PHASE(ph_rw_seq(c, ldsf)); \
        PHASE(ph_rw_out(c)); \
        PHASEG(1, { pg8::Gemm g{4 * W, 4 * W, 4 * W}; pg8::StaticOrder so; so.init(T, D, G, cwg, WSH(O_YS), WSH(O_WBR), 4 * W, 4 * W); pg8::EpiMerge E{(const unsigned char*)(c.ws + O_G8), WSH(O_MRG)}; pg8::gemm_phase(lds, g, so, E); }); \
        PHASEG(1, { pg8::Gemm g{D, D, D}; pg8::StaticOrder so; so.init(T, D, G, cwg, WSH(O_MRG), WSH(O_WOUT), D, D); pg8::EpiResid E{xin, ml + 2 * D, xmid, WSF(O_HF)}; pg8::gemm_phase(lds, g, so, E); }); \
        PHASE(ph_router(c, l, ldsf, xmid, c.in[4] + (size_t)l * D, ml + 3 * D, ml + 4 * D)); \
        PHASE(ph_moe_assign(c, l, ldsf)); \
        const int* plan = CTLW(c) + CW_PLAN + l * 256; \
        PHASEG(2, { pg8::Gemm g{D, D, D}; pg8::MoeGatherOrder mo{G, cwg, 4, plan, (const char*)WSH(O_H), (const char*)WSH(O_WGU), (size_t)256 * D * 2, (size_t)1024 * D * 2, WSI(O_XS), T}; pg8::EpiGU E{WSH(O_ACT)}; pg8::gemm_phase(lds, g, mo, E); \
            if (l == 0) { const int nrest_ = plan[40] * 4 - G; if (nrest_ >= 0 && nrest_ < G && cwg >= nrest_) { SYNCTHREADS(); convert_big(c, 1, ldsf, 0, convert_early_tiles(c), cwg - nrest_, G - nrest_); } } }); \
        PHASEG(2, { pg8::Gemm g{512, 512, 512}; pg8::MoeOrder mo{G, cwg, 8, plan, (const char*)WSH(O_ACT), (const char*)WSH(O_WDN), (size_t)256 * 512 * 2, (size_t)256 * 512 * 2, (size_t)D * 512 * 2}; pg8::EpiBf16 E{WSH(O_YE), D}; pg8::gemm_phase(lds, g, mo, E); }); \
        if (l == 0) PHASE(ph_comb_norm<0>(c, xmid, ml + 5 * D, xout, c.in[3] + (size_t)1 * D, mod + (size_t)1 * NB * D6 + 0 * D, mod + (size_t)1 * NB * D6 + 1 * D, WSH(O_H), nullptr); ph_convert(c, 1, ldsf)); \
        else PHASE(ph_comb_norm<1>(c, xmid, ml + 5 * D, xout, c.in[36], nullptr, nullptr, nullptr, c.out)); \
    } while (0)
    PHASE(ph_norm(c, c.in[0], c.in[3], WSF(O_MOD) + 0 * D, WSF(O_MOD) + 1 * D, WSH(O_H), nullptr));
    LAYER_BODY(0);
    LAYER_BODY(1);
#undef LAYER_BODY
#if TIME_PHASE >= 0 && !defined(CPU_EMU)
    if (blockIdx.x == 0) { const unsigned long long te = __builtin_amdgcn_s_memrealtime(), dl = 8ull * (tp1 - tp0); while (__builtin_amdgcn_s_memrealtime() - te < dl) __builtin_amdgcn_s_sleep(8); }
#endif
#undef PHASE
}
}

#ifndef CPU_EMU
extern "C" void kernel_launch(void* const* d_in, const int* in_sizes, int n_in, void* d_out, int out_size, void* d_ws, size_t ws_size, hipStream_t stream) {
    static int grid = 0;
    if (grid == 0) {
        if (n_in != 37 || out_size != T * D || ws_size < WS_END) { fprintf(stderr, "kernel_launch: unexpected shapes (n_in %d out %d ws %zu need %zu)\n", n_in, out_size, ws_size, (size_t)WS_END); grid = -1; return; }
        int dev = 0, cus = 0, per_cu = 0;
        if (hipGetDevice(&dev) != hipSuccess || hipDeviceGetAttribute(&cus, hipDeviceAttributeMultiprocessorCount, dev) != hipSuccess) { grid = -1; return; }
        if (hipFuncSetAttribute((const void*)fwd, hipFuncAttributeMaxDynamicSharedMemorySize, LDS_BYTES) != hipSuccess) { fprintf(stderr, "kernel_launch: hipFuncSetAttribute failed\n"); grid = -1; return; }
        if (hipOccupancyMaxActiveBlocksPerMultiprocessor(&per_cu, (const void*)fwd, NT, LDS_BYTES) != hipSuccess || per_cu < 1) fprintf(stderr, "kernel_launch: occupancy query says %d\n", per_cu);
        (void)hipGetLastError();
        grid = cus;
    }
    if (grid < 0) return;
    (void)in_sizes;
    (void)hipMemsetAsync((char*)d_ws + O_CTL, 0, CTL_BYTES, stream);
    Params p{};
    for (int i = 0; i < 37; ++i) p.in[i] = (const float*)d_in[i];
    p.out = (float*)d_out; p.ws = (unsigned char*)d_ws;
#if ONE_LAUNCH
    p.ph_lo = 0; p.ph_hi = NPH;
    hipLaunchKernelGGL(fwd, dim3(grid), dim3(NT), LDS_BYTES, stream, p);
#else
    for (int k = 0; k < NPH; ++k) { p.ph_lo = k; p.ph_hi = k + 1; hipLaunchKernelGGL(fwd, dim3(grid), dim3(NT), LDS_BYTES, stream, p); }
#endif
}
#endif
```

```cpp
#ifndef CPU_EMU
#include <hip/hip_runtime.h>
#endif
#include <cstdio>
#include <cstdint>
#include <cmath>
#include <cstring>

#ifndef SEQ
#define SEQ 4096
#endif
#ifndef ONE_LAUNCH
#define ONE_LAUNCH 1
#endif

namespace {
constexpr int D = 2048, NB = 2, S = SEQ, T = NB * S, NL = 2, W = 1024;
constexpr int INW = 18816, RF = 3456, D6 = 6 * D;
constexpr int C_LX = 0, C_LG = 1024, C_RQ = 2048, C_RK = 2560, C_RV = 3072, C_RG = 4096, C_SU = 5120, C_SV = 6144, C_RW = 7168;
constexpr int PW = 18944, C_MLP = 10752;
constexpr int NCH = S / 128;
constexpr int NLC = S / 64;
constexpr int NE = 32, CAP = (T * 2 / 256 + NE) * 256, MAXBLK = CAP / 256;
constexpr float EPS = 1e-6f;
constexpr float DECAY_SCALE = 0.60653065971263342f;
constexpr int NT = 512;
constexpr int NPH_LAYER = 13, NPH = 2 + NL * NPH_LAYER;
typedef unsigned short bf16_t;
#ifdef CPU_EMU
typedef float f32x4 __attribute__((vector_size(16)));
typedef unsigned u32x4 __attribute__((vector_size(16)));
#else
typedef float f32x4 __attribute__((ext_vector_type(4)));
typedef unsigned u32x4 __attribute__((ext_vector_type(4)));
typedef short bf16x8 __attribute__((ext_vector_type(8)));
#endif

constexpr size_t al256(size_t x) { return (x + 255) & ~(size_t)255; }
constexpr size_t SZ_X = (size_t)T * D * 4, SZ_W = (size_t)T * W * 4;
constexpr size_t O_CTL = 0, CTL_BYTES = 1u << 20;
constexpr size_t O_MOD = CTL_BYTES;
constexpr size_t O_X0 = O_MOD + al256((size_t)NL * NB * D6 * 4);
constexpr size_t O_X1 = O_X0 + SZ_X;
constexpr size_t O_H = O_X1 + SZ_X;
constexpr size_t O_HF = O_H + SZ_X / 2;
constexpr size_t O_P = O_HF + SZ_X;
constexpr size_t SZ_P = (size_t)T * PW * 2;
constexpr size_t O_XC = O_P + SZ_P;
constexpr size_t O_LA = O_XC + SZ_W, O_LU = O_LA + 2 * SZ_W;
constexpr size_t SZ_LC = (size_t)2 * NB * NLC * W * 4;
constexpr size_t O_LCA = O_LU + 2 * SZ_W, O_LCH = O_LCA + SZ_LC, O_LCI = O_LCH + SZ_LC;
constexpr size_t O_YS = O_LCI + SZ_LC;
constexpr size_t O_SC = O_YS + (size_t)T * 4 * W * 2;
constexpr size_t SZ_KV = (size_t)NB * NCH * 8 * 64 * 128 * 4;
constexpr size_t O_KVF = O_SC, O_KVB = O_KVF + SZ_KV, O_STF = O_KVB + SZ_KV, O_STB = O_STF + SZ_KV;
constexpr size_t O_VN = O_STB + SZ_KV;
constexpr size_t O_FS = O_VN + SZ_W;
constexpr size_t O_DEC = O_FS + al256((size_t)T * RF * 4), O_AA = O_DEC + 2 * SZ_W, O_AKK = O_AA + 2 * SZ_W;
constexpr size_t O_GG = O_AKK, O_YY = O_GG + SZ_W;
constexpr int RCK = 64, NRC = S / RCK;
constexpr size_t O_BON = O_YY + 2 * SZ_W;
constexpr size_t O_PART = O_BON + al256((size_t)2 * T * 16 * 4);
constexpr size_t O_MRG = O_PART + SZ_X;
constexpr size_t O_LOG = O_MRG + SZ_X / 2;
constexpr size_t O_EID = O_LOG + al256((size_t)T * 40 * 4), O_EWT = O_EID + al256((size_t)T * 2 * 4), O_DEST = O_EWT + al256((size_t)T * 2 * 4);
constexpr size_t O_SLOT = O_DEST + al256((size_t)T * 2 * 4);
constexpr size_t O_PST = O_SLOT + al256((size_t)CAP * 4), O_PYT = O_PST + (size_t)64 * NRC * 4096 * 2, O_SVB = O_PYT + (size_t)64 * NRC * 4096 * 2, O_YVB = O_SVB + (size_t)64 * NRC * 4096 * 4;
constexpr size_t O_WIN = O_YVB + (size_t)64 * NRC * 4096 * 4;
constexpr size_t O_WBR = O_WIN + (size_t)PW * D * 2;
constexpr size_t O_WOUT = O_WBR + (size_t)D * 4 * W * 2;
constexpr size_t O_WGU = O_WOUT + (size_t)D * D * 2;
constexpr size_t O_WDN = O_WGU + (size_t)NE * 1024 * D * 2;
constexpr size_t O_G8 = O_WDN + (size_t)NE * D * 512 * 2;
constexpr size_t O_ROPE = O_G8 + (size_t)T * 4 * D;
constexpr size_t O_WLR = O_ROPE + (size_t)T * 64 * 4;
constexpr size_t O_WUT = O_WLR + (size_t)32 * 128 * 128 * 2;
constexpr size_t O_WAT = O_WUT + (size_t)2 * W * 64 * 2;
constexpr size_t O_WGT = O_WAT + (size_t)2 * W * 64 * 2;
constexpr size_t O_WRH = O_WGT + (size_t)W * 128 * 2;
constexpr size_t O_WRL = O_WRH + (size_t)48 * D * 2;
constexpr size_t WS_END0 = O_WRL + (size_t)48 * D * 2;
constexpr size_t SZ_MOE = (size_t)CAP * (D + 512 + D) * 2;
constexpr bool MOE_OVERLAY = SZ_MOE <= SZ_P;
constexpr size_t O_XS = MOE_OVERLAY ? O_P : WS_END0;
constexpr size_t O_ACT = O_XS + (size_t)CAP * D * 2;
constexpr size_t O_YE = O_ACT + (size_t)CAP * 512 * 2;
constexpr size_t WS_END = MOE_OVERLAY ? WS_END0 : WS_END0 + SZ_MOE;
static_assert(SEQ != 4096 || WS_END <= (size_t)2040 * 1024 * 1024, "workspace budget: d_ws is 4 x the largest input = 2048 MiB");
constexpr int CW_BAR = 4096;
constexpr int CW_CNT = 32768;
constexpr int CW_FILL = CW_CNT + NL * 64;
constexpr int CW_PLAN = CW_FILL + NL * 64;
static_assert(MAXBLK <= 160, "plan words");

struct Params { const float* in[37]; float* out; unsigned char* ws; int ph_lo, ph_hi; };

struct Ctx { const float* const* in; float* out; unsigned char* ws; };
#define GT_ ((long)blockIdx.x * NT + threadIdx.x)
#define GS_ ((long)gridDim.x * NT)
#define WSF(off) ((float*)(c.ws + (off)))
#define WSI(off) ((int*)(c.ws + (off)))
#define WSH(off) ((bf16_t*)(c.ws + (off)))
#define CTLW(c) ((int*)((c).ws + O_CTL))

#ifdef CPU_EMU
__device__ __forceinline__ float fexp_(float x) { return expf(x); }
__device__ __forceinline__ float frcp_(float x) { return 1.f / x; }
__device__ __forceinline__ float frsq_(float x) { return 1.f / sqrtf(x); }
__device__ __forceinline__ float fsqrt_(float x) { return sqrtf(x); }
#else
__device__ __forceinline__ float fexp_(float x) { return __builtin_amdgcn_exp2f(x * 1.4426950408889634f); }
__device__ __forceinline__ float frcp_(float x) { return __builtin_amdgcn_rcpf(x); }
__device__ __forceinline__ float frsq_(float x) { return __builtin_amdgcn_rsqf(x); }
__device__ __forceinline__ float fsqrt_(float x) { return __builtin_amdgcn_sqrtf(x); }
#endif
__device__ __forceinline__ float sigmoidf_(float x) { return frcp_(1.f + fexp_(-x)); }
__device__ __forceinline__ float siluf_(float x) { return x * frcp_(1.f + fexp_(-x)); }
__device__ __forceinline__ float tanhf_(float x) { return 1.f - 2.f * frcp_(1.f + fexp_(2.f * x)); }
#ifdef CPU_EMU
__device__ __forceinline__ float geluf_(float x) { return 0.5f * x * (1.f + tanhf_(0.7978845608028654f * (x + 0.044715f * x * x * x))); }
#else
__device__ __forceinline__ float geluf_(float x) { return x * __builtin_amdgcn_rcpf(1.f + __builtin_amdgcn_exp2f(-x * (2.3022082f + 0.10294324f * x * x))); }
#endif
__device__ __forceinline__ float softplusf_(float x) { return x > 0.f ? x + log1pf(expf(-x)) : log1pf(expf(x)); }
__device__ __forceinline__ float loggamma_(int h) { return log1pf(-exp2f(-5.f - (float)h)); }
__device__ __forceinline__ unsigned f2u_(float f) { unsigned u; memcpy(&u, &f, 4); return u; }
__device__ __forceinline__ float u2f_(unsigned u) { float f; memcpy(&f, &u, 4); return f; }
__device__ __forceinline__ float bf2f(bf16_t v) { return u2f_((unsigned)v << 16); }
#ifdef CPU_EMU
__device__ __forceinline__ unsigned f2bf(float f) { const unsigned u = f2u_(f); return (u + 0x7fffu + ((u >> 16) & 1u)) >> 16; }
__device__ __forceinline__ unsigned pk2(float lo, float hi) { return f2bf(lo) | (f2bf(hi) << 16); }
#else
typedef __attribute__((ext_vector_type(2))) __bf16 hwbf2_t; typedef __attribute__((ext_vector_type(2))) float hwf2_t;
__device__ __forceinline__ unsigned f2bf(float f) { const __bf16 s = (__bf16)f; return (unsigned)__builtin_bit_cast(unsigned short, s); }
__device__ __forceinline__ unsigned pk2(float lo, float hi) { const hwf2_t v = {lo, hi}; return __builtin_bit_cast(unsigned, __builtin_convertvector(v, hwbf2_t)); }
#endif
__device__ __forceinline__ float bflo(unsigned w) { return u2f_(w << 16); }
__device__ __forceinline__ float bfhi(unsigned w) { return u2f_(w & 0xffff0000u); }
__device__ __forceinline__ int atomic_add_i(int* p, int v) {
#ifdef CPU_EMU
    return __atomic_fetch_add(p, v, __ATOMIC_RELAXED);
#else
    return atomicAdd(p, v);
#endif
}
#define PF(P, r, col) bf2f((P)[(size_t)(r) * PW + (col)])
#ifdef CPU_EMU
#define SYNCTHREADS() emu_syncthreads()
#define LDS_BARRIER() emu_syncthreads()
#define SHFL_XOR(v, m) emu_shfl_xor(v, m)
#else
#define SYNCTHREADS() __syncthreads()
#define LDS_BARRIER() do { asm volatile("s_waitcnt lgkmcnt(0)" ::: "memory"); __builtin_amdgcn_s_barrier(); asm volatile("" ::: "memory"); } while (0)
#define SHFL_XOR(v, m) __shfl_xor(v, m)
#endif
#ifdef CPU_EMU
__device__ __forceinline__ float wave_sum(float v) {
    for (int o = 1; o < 64; o <<= 1) v += SHFL_XOR(v, o);
    return v;
}
#else
__device__ __forceinline__ float wave_sum(float x) {
    x += __builtin_bit_cast(float, __builtin_amdgcn_update_dpp(0, __builtin_bit_cast(int, x), 0xB1, 0xF, 0xF, true));
    x += __builtin_bit_cast(float, __builtin_amdgcn_update_dpp(0, __builtin_bit_cast(int, x), 0x4E, 0xF, 0xF, true));
    x += __builtin_bit_cast(float, __builtin_amdgcn_update_dpp(0, __builtin_bit_cast(int, x), 0x141, 0xF, 0xF, true));
    x += __builtin_bit_cast(float, __builtin_amdgcn_update_dpp(0, __builtin_bit_cast(int, x), 0x140, 0xF, 0xF, true));
    const int xi = __builtin_bit_cast(int, x);
    return (__builtin_bit_cast(float, __builtin_amdgcn_readlane(xi, 0)) + __builtin_bit_cast(float, __builtin_amdgcn_readlane(xi, 16))) + (__builtin_bit_cast(float, __builtin_amdgcn_readlane(xi, 32)) + __builtin_bit_cast(float, __builtin_amdgcn_readlane(xi, 48)));
}
#endif
__device__ __forceinline__ f32x4 ld_bf4(const bf16_t* p) { const unsigned long long q = *(const unsigned long long*)p; const unsigned lo = (unsigned)q, hi = (unsigned)(q >> 32); return (f32x4){bflo(lo), bfhi(lo), bflo(hi), bfhi(hi)}; }
__device__ __forceinline__ void st_bf4(bf16_t* p, const f32x4 v) { *(unsigned long long*)p = (unsigned long long)pk2(v[0], v[1]) | ((unsigned long long)pk2(v[2], v[3]) << 32); }

template <int KT, int NTL>
__device__ __forceinline__ void wave_mma(f32x4 (&acc)[NTL], const bf16_t* A, int lda, const bf16_t* Bt, int ldb) {
    const int lane = threadIdx.x & 63, fr = lane & 15, fq = lane >> 4;
#ifdef CPU_EMU
    for (int nt = 0; nt < NTL; ++nt) for (int r = 0; r < 4; ++r) { float sacc = 0.f; const bf16_t* a = A + fr * lda; const bf16_t* b = Bt + (16 * nt + 4 * fq + r) * ldb;
        for (int k = 0; k < 32 * KT; ++k) sacc += bf2f(a[k]) * bf2f(b[k]);
        acc[nt][r] += sacc; }
#else
#pragma unroll
    for (int kt = 0; kt < KT; ++kt) {
        const bf16x8 af = *(const bf16x8*)(A + fr * lda + kt * 32 + fq * 8);
#pragma unroll
        for (int nt = 0; nt < NTL; ++nt) { const bf16x8 bfr = *(const bf16x8*)(Bt + (16 * nt + fr) * ldb + kt * 32 + fq * 8);
            acc[nt] = __builtin_amdgcn_mfma_f32_16x16x32_bf16(bfr, af, acc[nt], 0, 0, 0); }
    }
#endif
}
__device__ __forceinline__ void ph_mod(const Ctx& c, float* ldsf) {
    const float* cc = c.in[1]; const float* aw = c.in[5]; const float* ab = c.in[6]; float* mod = WSF(O_MOD);
    float* scs = ldsf; float* part = ldsf + NB * D; const int tid = threadIdx.x, c4 = (tid & 31) * 4, kq = tid >> 5;
    for (int i = tid; i < NB * D; i += NT) scs[i] = siluf_(cc[i]);
    SYNCTHREADS();
    for (int u = blockIdx.x; u < NL * (D6 / 128); u += gridDim.x) {
        const int l = u / (D6 / 128), j0 = (u % (D6 / 128)) * 128;
        const float* w = aw + (size_t)l * D * D6 + j0 + c4; f32x4 a0 = (f32x4){0.f, 0.f, 0.f, 0.f}, a1 = a0;
#pragma unroll 8
        for (int k = kq * 128; k < kq * 128 + 128; ++k) { const f32x4 wv = *(const f32x4*)(w + (size_t)k * D6); a0 += wv * scs[k]; a1 += wv * scs[D + k]; }
        *(f32x4*)(part + (kq * 2 + 0) * 128 + c4) = a0; *(f32x4*)(part + (kq * 2 + 1) * 128 + c4) = a1;
        SYNCTHREADS();
        if (tid < 256) { const int b = tid >> 7, col = tid & 127; float sacc = 0.f;
#pragma unroll
            for (int q = 0; q < 16; ++q) sacc += part[(q * 2 + b) * 128 + col];
            mod[((size_t)l * NB + b) * D6 + j0 + col] = sacc + ab[l * D6 + j0 + col]; }
        SYNCTHREADS();
    }
}
__device__ __forceinline__ void ph_norm(const Ctx& c, const float* x, const float* g, const float* sh, const float* sc, bf16_t* hb, float* hf) {
    const int lane = threadIdx.x & 63, gw = blockIdx.x * (NT / 64) + (threadIdx.x >> 6), ngw = gridDim.x * (NT / 64);
    for (int t0 = gw * 2; t0 < T; t0 += ngw * 2) {
        f32x4 v[2][8]; float ss[2] = {0.f, 0.f};
#pragma unroll
        for (int r = 0; r < 2; ++r)
#pragma unroll
            for (int j = 0; j < 8; ++j) v[r][j] = *(const f32x4*)(x + (size_t)(t0 + r) * D + (j * 64 + lane) * 4);
#pragma unroll
        for (int r = 0; r < 2; ++r) {
#pragma unroll
            for (int j = 0; j < 8; ++j) ss[r] += (v[r][j][0] * v[r][j][0] + v[r][j][1] * v[r][j][1]) + (v[r][j][2] * v[r][j][2] + v[r][j][3] * v[r][j][3]);
            const int t = t0 + r, b = t / S; const float rs = 1.f / sqrtf(wave_sum(ss[r]) * (1.f / D) + EPS);
#pragma unroll
            for (int j = 0; j < 8; ++j) { const int col = (j * 64 + lane) * 4;
                const f32x4 o = v[r][j] * rs * *(const f32x4*)(g + col) * (*(const f32x4*)(sc + b * D6 + col) + 1.f) + *(const f32x4*)(sh + b * D6 + col);
                st_bf4(hb + (size_t)t * D + col, o); }
            if (hf && lane == 0) hf[t] = rs;
        }
    }
}
template <int MODE>
__device__ __forceinline__ void ph_comb_norm(const Ctx& c, const float* xmid, const float* g2, float* xout, const float* g, const float* sh, const float* sc, bf16_t* hb, float* outp) {
    const bf16_t* YE = WSH(O_YE); const float* EWT = WSF(O_EWT); const int* DEST = WSI(O_DEST);
    const int lane = threadIdx.x & 63, gw = blockIdx.x * (NT / 64) + (threadIdx.x >> 6), ngw = gridDim.x * (NT / 64);
    float w0n = 0.f, w1n = 0.f; int d0n = 0, d1n = 0;
    if (gw < T) { w0n = EWT[gw * 2]; w1n = EWT[gw * 2 + 1]; d0n = DEST[gw * 2]; d1n = DEST[gw * 2 + 1]; }
    for (int t = gw; t < T; t += ngw) {
        const int b = t / S; const float w0 = w0n, w1 = w1n; const bf16_t* y0 = YE + (size_t)d0n * D; const bf16_t* y1 = YE + (size_t)d1n * D;
        if (t + ngw < T) { const int tn = t + ngw; w0n = EWT[tn * 2]; w1n = EWT[tn * 2 + 1]; d0n = DEST[tn * 2]; d1n = DEST[tn * 2 + 1]; }
        f32x4 v[8]; float ss = 0.f;
#pragma unroll
        for (int j = 0; j < 8; ++j) { const int col = (j * 64 + lane) * 4;
            v[j] = *(const f32x4*)(xmid + (size_t)t * D + col) + *(const f32x4*)(g2 + b * D6 + col) * (ld_bf4(y0 + col) * w0 + ld_bf4(y1 + col) * w1);
            if (MODE == 0) *(f32x4*)(xout + (size_t)t * D + col) = v[j];
            ss += (v[j][0] * v[j][0] + v[j][1] * v[j][1]) + (v[j][2] * v[j][2] + v[j][3] * v[j][3]); }
        const float rs = 1.f / sqrtf(wave_sum(ss) * (1.f / D) + EPS);
#pragma unroll
        for (int j = 0; j < 8; ++j) { const int col = (j * 64 + lane) * 4;
            if (MODE == 0) st_bf4(hb + (size_t)t * D + col, v[j] * rs * *(const f32x4*)(g + col) * (*(const f32x4*)(sc + b * D6 + col) + 1.f) + *(const f32x4*)(sh + b * D6 + col));
            else *(f32x4*)(outp + (size_t)t * D + col) = v[j] * rs * *(const f32x4*)(g + col); }
    }
}

struct CvtItem { const float* Wp; int ldw; bf16_t* WT; int ldt; int drow, k0, n0; };
constexpr int I_IN = 32 * (INW / 32), I_BR = 4 * 16 * 64, I_OUT = 32 * 64, I_GU = NE * 32 * 32, I_DN = NE * 8 * 64, I_LR = 32 * 8, I_WU = 2 * 32, I_WG = 64, I_BIG = I_IN + I_BR + I_OUT + I_GU + I_DN, I_ALL = I_BIG + I_LR + 2 * I_WU + I_WG;
__device__ __forceinline__ CvtItem cvt_decode(const Ctx& c, int l, int it) {
    CvtItem r;
    if (it < I_IN) { const int kb = it / (INW / 32), nb = it % (INW / 32); r.n0 = nb * 32; r.k0 = kb * 64; r.Wp = c.in[7] + (size_t)l * D * INW; r.ldw = INW; r.WT = WSH(O_WIN); r.ldt = D; r.drow = r.n0 < 10624 ? r.n0 : r.n0 + 128; return r; }
    it -= I_IN;
    if (it < I_BR) { const int sgm = it / 1024, q = it % 1024, kb = q / 64, nb = q % 64; r.n0 = nb * 32; r.k0 = kb * 64; r.Wp = c.in[28] + ((size_t)l * 4 + sgm) * W * D; r.ldw = D; r.WT = WSH(O_WBR) + sgm * W; r.ldt = 4 * W; r.drow = r.n0; return r; }
    it -= I_BR;
    if (it < I_OUT) { const int kb = it / 64, nb = it % 64; r.n0 = nb * 32; r.k0 = kb * 64; r.Wp = c.in[29] + (size_t)l * D * D; r.ldw = D; r.WT = WSH(O_WOUT); r.ldt = D; r.drow = r.n0; return r; }
    it -= I_OUT;
    if (it < I_GU) { const int e = it / 1024, q = it % 1024, kb = q / 32, nb = q % 32; r.n0 = nb * 32; r.k0 = kb * 64; r.Wp = c.in[34] + ((size_t)l * NE + e) * D * 1024; r.ldw = 1024; r.WT = WSH(O_WGU) + (size_t)e * 1024 * D; r.ldt = D;
        r.drow = r.n0 < 512 ? (r.n0 / 128) * 256 + (r.n0 % 128) : ((r.n0 - 512) / 128) * 256 + 128 + ((r.n0 - 512) % 128); return r; }
    it -= I_GU;
    if (it < I_DN) { const int e = it / 512, q = it % 512, kb = q / 64, nb = q % 64; r.n0 = nb * 32; r.k0 = kb * 64; r.Wp = c.in[35] + ((size_t)l * NE + e) * 512 * D; r.ldw = D; r.WT = WSH(O_WDN) + (size_t)e * D * 512; r.ldt = 512; r.drow = r.n0; return r; }
    it -= I_DN;
    if (it < I_LR) { const int m = it / 8, q = it % 8, kb = q / 4, nb = q % 4, z = m >> 4, ty = (m >> 3) & 1, n = m & 7; r.n0 = nb * 32; r.k0 = kb * 64; r.Wp = c.in[ty ? 12 : 10] + (((size_t)l * 2 + z) * 8 + n) * 128 * 128; r.ldw = 128;
        r.WT = WSH(O_WLR) + (size_t)m * 128 * 128; r.ldt = 128; r.drow = r.n0; return r; }
    it -= I_LR;
    if (it < 2 * I_WU) { const int ua = it / I_WU, q = it % I_WU, z = q / 32, nb = q % 32; r.n0 = nb * 32; r.k0 = 0; r.Wp = c.in[ua ? 23 : 21] + ((size_t)l * 2 + z) * 64 * W; r.ldw = W; r.WT = WSH(ua ? O_WAT : O_WUT) + (size_t)z * W * 64; r.ldt = 64; r.drow = r.n0; return r; }
    it -= 2 * I_WU;
    { const int kb = it / 32, nb = it % 32; r.n0 = nb * 32; r.k0 = kb * 64; r.Wp = c.in[24] + (size_t)l * 128 * W; r.ldw = W; r.WT = WSH(O_WGT); r.ldt = 128; r.drow = r.n0; return r; }
}
constexpr int J_IN = 16 * (INW / 128), J_BR = 4 * 8 * 16, J_OUT = 16 * 16, J_GU = NE * 16 * 8, J_DN = NE * 4 * 16, J_ALL = J_IN + J_BR + J_OUT + J_GU + J_DN;
__device__ __forceinline__ CvtItem cvt_decode_big(const Ctx& c, int l, int it) {
    CvtItem r;
    if (it < J_IN) { const int kb = it / (INW / 128), nb = it % (INW / 128); r.n0 = nb * 128; r.k0 = kb * 128; r.Wp = c.in[7] + (size_t)l * D * INW; r.ldw = INW; r.WT = WSH(O_WIN); r.ldt = D; r.drow = r.n0 < 10624 ? r.n0 : r.n0 + 128; return r; }
    it -= J_IN;
    if (it < J_BR) { const int sgm = it / 128, q = it % 128, kb = q / 16, nb = q % 16; r.n0 = nb * 128; r.k0 = kb * 128; r.Wp = c.in[28] + ((size_t)l * 4 + sgm) * W * D; r.ldw = D; r.WT = WSH(O_WBR) + sgm * W; r.ldt = 4 * W; r.drow = r.n0; return r; }
    it -= J_BR;
    if (it < J_OUT) { const int kb = it / 16, nb = it % 16; r.n0 = nb * 128; r.k0 = kb * 128; r.Wp = c.in[29] + (size_t)l * D * D; r.ldw = D; r.WT = WSH(O_WOUT); r.ldt = D; r.drow = r.n0; return r; }
    it -= J_OUT;
    if (it < J_GU) { const int e = it / 128, q = it % 128, kb = q / 8, nb = q % 8; r.n0 = nb * 128; r.k0 = kb * 128; r.Wp = c.in[34] + ((size_t)l * NE + e) * D * 1024; r.ldw = 1024; r.WT = WSH(O_WGU) + (size_t)e * 1024 * D; r.ldt = D;
        r.drow = r.n0 < 512 ? (r.n0 / 128) * 256 : ((r.n0 - 512) / 128) * 256 + 128; return r; }
    it -= J_GU;
    { const int e = it / 64, q = it % 64, kb = q / 16, nb = q % 16; r.n0 = nb * 128; r.k0 = kb * 128; r.Wp = c.in[35] + ((size_t)l * NE + e) * 512 * D; r.ldw = D; r.WT = WSH(O_WDN) + (size_t)e * D * 512; r.ldt = 512; r.drow = r.n0; return r; }
}
__device__ __forceinline__ void convert_big(const Ctx& c, int l, float* ldsf, int first, int last, int widx, int wcnt) {
    const int tid = threadIdx.x, lr = tid >> 5, lc = (tid & 31) * 4;
    f32x4 rg[8]; int it = first + widx; CvtItem r;
    if (it < last) { r = cvt_decode_big(c, l, it);
#pragma unroll
        for (int i = 0; i < 8; ++i) rg[i] = *(const f32x4*)(r.Wp + (size_t)(r.k0 + lr + 16 * i) * r.ldw + r.n0 + lc); }
    for (; it < last; it += wcnt) {
#pragma unroll
        for (int i = 0; i < 8; ++i) { float* dp = ldsf + (lr + 16 * i) * 129 + lc; dp[0] = rg[i][0]; dp[1] = rg[i][1]; dp[2] = rg[i][2]; dp[3] = rg[i][3]; }
        const CvtItem cur = r; const int nx = it + wcnt;
        if (nx < last) { r = cvt_decode_big(c, l, nx);
#pragma unroll
            for (int i = 0; i < 8; ++i) rg[i] = *(const f32x4*)(r.Wp + (size_t)(r.k0 + lr + 16 * i) * r.ldw + r.n0 + lc); }
        SYNCTHREADS();
#pragma unroll
        for (int q = 0; q < 4; ++q) { const int id = tid + NT * q, n = id >> 4, k8 = (id & 15) * 8; const float* sp = ldsf + k8 * 129 + n;
            u32x4 o; o[0] = pk2(sp[0 * 129], sp[1 * 129]); o[1] = pk2(sp[2 * 129], sp[3 * 129]); o[2] = pk2(sp[4 * 129], sp[5 * 129]); o[3] = pk2(sp[6 * 129], sp[7 * 129]);
            *(u32x4*)(cur.WT + (size_t)(cur.drow + n) * cur.ldt + cur.k0 + k8) = o; }
        SYNCTHREADS();
    }
}
__device__ __forceinline__ int convert_tail_tiles() { const int nun = (T / 256) * (PW / 256), G = (int)gridDim.x, rem = nun % G; return rem == 0 ? 0 : (G - rem) * 10 < J_GU + J_DN ? (G - rem) * 10 : J_GU + J_DN; }
__device__ __forceinline__ int convert_early_tiles(const Ctx& c) { const int G = (int)gridDim.x, nrest = (CTLW(c) + CW_PLAN)[40] * 4 - G; return (nrest >= 0 && nrest < G) ? ((G - nrest) * 12 < J_IN ? (G - nrest) * 12 : J_IN) : 0; }
__device__ __forceinline__ void ph_convert(const Ctx& c, int l, float* ldsf) {
    const int lane = threadIdx.x & 63, wave = threadIdx.x >> 6; const int gw = blockIdx.x * (NT / 64) + wave, ngw = gridDim.x * (NT / 64);
    convert_big(c, l, ldsf, l == 1 ? convert_early_tiles(c) : 0, J_ALL - convert_tail_tiles(), (int)blockIdx.x, (int)gridDim.x);
#ifdef CPU_EMU
    if (lane == 0) for (int it = I_BIG + gw; it < I_ALL; it += ngw) { const CvtItem r = cvt_decode(c, l, it);
        for (int kk = 0; kk < 64; ++kk) for (int nn = 0; nn < 32; ++nn) r.WT[(size_t)(r.drow + nn) * r.ldt + r.k0 + kk] = (bf16_t)f2bf(r.Wp[(size_t)(r.k0 + kk) * r.ldw + r.n0 + nn]); }
#else
    float* scr = ldsf + wave * (64 * 33 + 16);
    for (int it = I_BIG + gw; it < I_ALL; it += ngw) {
        const CvtItem r = cvt_decode(c, l, it);
#pragma unroll 8
        for (int i = 0; i < 32; ++i) { const int kk = 2 * i + (lane >> 5); scr[kk * 33 + (lane & 31)] = r.Wp[(size_t)(r.k0 + kk) * r.ldw + r.n0 + (lane & 31)]; }
        asm volatile("s_waitcnt lgkmcnt(0)" ::: "memory");
        const int cc = lane & 7;
#pragma unroll
        for (int j = 0; j < 4; ++j) { const int n = (lane >> 3) + 8 * j; const float* sp = scr + (8 * cc) * 33 + n;
            u32x4 o; o[0] = pk2(sp[0 * 33], sp[1 * 33]); o[1] = pk2(sp[2 * 33], sp[3 * 33]); o[2] = pk2(sp[4 * 33], sp[5 * 33]); o[3] = pk2(sp[6 * 33], sp[7 * 33]);
            *(u32x4*)(r.WT + (size_t)(r.drow + n) * r.ldt + r.k0 + 8 * cc) = o; }
        asm volatile("s_waitcnt lgkmcnt(0)" ::: "memory");
    }
#endif
    { const float* wg = c.in[30] + (size_t)l * D * 4; const float* we = c.in[32] + (size_t)l * D * 32; bf16_t* wh = WSH(O_WRH); bf16_t* wl = WSH(O_WRL);
      for (long i = GT_; i < (long)48 * D; i += GS_) { const int n = (int)(i / D), k = (int)(i % D); const float w = n < 4 ? wg[k * 4 + n] : n < 36 ? we[k * 32 + (n - 4)] : 0.f; const unsigned hb = f2bf(w); wh[i] = (bf16_t)hb; wl[i] = (bf16_t)f2bf(w - bf2f((bf16_t)hb)); } }
    for (long i = GT_; i < (long)128 * D / 2; i += GS_) ((unsigned*)(WSH(O_WIN) + (size_t)10624 * D))[i] = 0u;
}

namespace pg8 {
constexpr int BM = 256, BK = 64, HALF = 128, HTB = HALF * BK * 2, STAGE_BYTES = 8 * HTB;
__host__ __device__ __forceinline__ int lds_byte(int r, int cc) { const int st = (r >> 4) * 2 + (cc >> 5), rr = r & 15, c2 = cc & 31, ob = rr * 64 + c2 * 2; return st * 1024 + (ob ^ (((ob >> 9) & 1) << 5)); }
__host__ __device__ __forceinline__ void stage_rc(int b, int& R, int& C) { const int st = b / 1024, sb = b % 1024, swz = sb ^ (((sb >> 9) & 1) << 5); R = (st >> 1) * 16 + swz / 64; C = (st & 1) * 32 + (swz % 64) / 2; }
__host__ __device__ __forceinline__ int perm32(int rho) { const int n = rho >> 4, i = rho & 15; return 8 * (i >> 2) + 4 * n + (i & 3); }
struct Unit { int pm, pn, aux; const char* A; const char* B; };
struct Gemm { int K, lda, ldb; };

template <class Epi, class Sched>
__device__ __forceinline__ void gemm_phase(unsigned char* lds_, const Gemm g, const Sched& S, const Epi& E) {
#ifdef CPU_EMU
    if (threadIdx.x != 0) return;
    Unit u; const int K = g.K;
    float* Af = (float*)malloc((size_t)256 * K * 4); float* Bf = (float*)malloc((size_t)256 * K * 4); float* Cf = (float*)malloc(256 * 256 * 4);
    for (int i = 0; S.next(i, u); ++i) {
        const bf16_t* A = (const bf16_t*)u.A; const bf16_t* B = (const bf16_t*)u.B;
        for (int r = 0; r < 256; ++r) for (int k = 0; k < K; ++k) { size_t ar = (size_t)r; if constexpr (Sched::GATHER) ar = (size_t)S.row(u.pm * 256 + r); Af[(size_t)r * K + k] = bf2f(A[ar * g.lda + k]); Bf[(size_t)r * K + k] = bf2f(B[(size_t)r * g.ldb + k]); }
        const int nseg = Epi::SEGT > 0 ? K / (Epi::SEGT * 64) : 1, kseg = K / nseg;
        for (int wid = 0; wid < 8; ++wid) for (int lane = 0; lane < 64; ++lane) {
            const int wr = wid >> 2, wc = wid & 3, fr = lane & 15, fq = lane >> 4; f32x4 acc[2][2][4][2];
            for (int ai = 0; ai < 2; ++ai) for (int bj = 0; bj < 2; ++bj) for (int m = 0; m < 4; ++m) for (int n = 0; n < 2; ++n) for (int j = 0; j < 4; ++j) acc[ai][bj][m][n][j] = 0.f;
            for (int sg = 0; sg < nseg; ++sg) {
                for (int ai = 0; ai < 2; ++ai) for (int bj = 0; bj < 2; ++bj) for (int m = 0; m < 4; ++m) for (int n = 0; n < 2; ++n) for (int j = 0; j < 4; ++j) {
                    const int r = 128 * ai + 64 * wr + 16 * m + fr, cc = 128 * bj + 32 * wc + (Epi::PERM ? 8 * fq + 4 * n + j : 16 * n + 4 * fq + j);
                    const float* a = Af + (size_t)r * K + sg * kseg; const float* b = Bf + (size_t)cc * K + sg * kseg; float sacc = 0.f; for (int k = 0; k < kseg; ++k) sacc += a[k] * b[k];
                    acc[ai][bj][m][n][j] += sacc; }
                if constexpr (Epi::SEGT > 0) { if (sg + 1 < nseg) E.segment(acc, u, sg, wr, wc, fr, fq); }
            }
            E(acc, u, wr, wc, fr, fq);
        }
    }
    free(Af); free(Bf); free(Cf);
#else
    typedef __attribute__((address_space(3))) unsigned char* ldsp_t;
    ldsp_t lds = (ldsp_t)lds_;
    const int tid = threadIdx.x, wid = __builtin_amdgcn_readfirstlane(tid >> 6), lane = tid & 63, wr = wid >> 2, wc = wid & 3, fr = lane & 15, fq = lane >> 4;
    const int K = g.K, nt = K / BK;
    unsigned voffA[2], voffB[2];
#pragma unroll
    for (int i = 0; i < 2; ++i) { int R, C; stage_rc(tid * 16 + i * 8192, R, C); const int Rb = Epi::PERM ? ((R & ~31) + perm32(R & 31)) : R;
        voffA[i] = (unsigned)(R * g.lda + C) * 2u; voffB[i] = (unsigned)(Rb * g.ldb + C) * 2u; }
    unsigned vA[2][2], vAn[2][2];
#define PG8_GROWS(uu, vv) do { _Pragma("unroll") for (int h_ = 0; h_ < 2; ++h_) _Pragma("unroll") for (int i_ = 0; i_ < 2; ++i_) { int R_, C_; stage_rc(tid * 16 + i_ * 8192, R_, C_); \
        vv[h_][i_] = (unsigned)(S.row((uu).pm * 256 + h_ * 128 + R_) * g.lda + C_) * 2u; } } while (0)
    const size_t kstep = (size_t)(BK * 2);
    const size_t hstepA = (size_t)HALF * g.lda * 2, hstepB = (size_t)HALF * g.ldb * 2;
    const unsigned ldsw = (unsigned)wid * 1024u;
    const int aoff = lds_byte(wr * 64 + fr, fq * 8), boff = lds_byte(wc * 32 + fr, fq * 8);
#define PG8_SA(b, h) (((b) * 2 + (h)) * HTB)
#define PG8_SB(b, h) ((4 + (b) * 2 + (h)) * HTB)
#define PG8_STAGE(bufoff, gbase, voff) do { _Pragma("unroll") for (int _i = 0; _i < 2; ++_i) \
        __builtin_amdgcn_global_load_lds((const unsigned*)((const char*)(gbase) + (voff)[_i]), (__attribute__((address_space(3))) unsigned*)(lds + (bufoff) + ldsw + _i * 8192), 16, 0, 0); } while (0)
#define PG8_STAGEA(b, h, kp, usen) do { if constexpr (Sched::GATHER) { const unsigned vs_[2] = {(usen) ? vAn[h][0] : vA[h][0], (usen) ? vAn[h][1] : vA[h][1]}; PG8_STAGE(PG8_SA(b, h), kp, vs_); } \
        else { PG8_STAGE(PG8_SA(b, h), (kp) + ((h) ? hstepA : 0), voffA); } } while (0)
#define PG8_LDA(dst, b, h) do { _Pragma("unroll") for (int m = 0; m < 4; ++m) _Pragma("unroll") for (int k = 0; k < 2; ++k) dst[m][k] = *(const __attribute__((address_space(3))) bf16x8*)(lds + PG8_SA(b, h) + aoff + m * 2048 + k * 1024); } while (0)
#define PG8_LDB(dst, b, h) do { _Pragma("unroll") for (int n = 0; n < 2; ++n) _Pragma("unroll") for (int k = 0; k < 2; ++k) dst[n][k] = *(const __attribute__((address_space(3))) bf16x8*)(lds + PG8_SB(b, h) + boff + n * 2048 + k * 1024); } while (0)
#define PG8_MMA(ai, bj, At, Bt) do { __builtin_amdgcn_s_setprio(1); _Pragma("unroll") for (int m = 0; m < 4; ++m) _Pragma("unroll") for (int n = 0; n < 2; ++n) _Pragma("unroll") for (int k = 0; k < 2; ++k) \
        acc[ai][bj][m][n] = __builtin_amdgcn_mfma_f32_16x16x32_bf16(Bt[n][k], At[m][k], acc[ai][bj][m][n], 0, 0, 0); __builtin_amdgcn_s_setprio(0); } while (0)
#define PG8_WAIT_V(n) asm volatile("s_waitcnt vmcnt(" #n ")" ::: "memory")
#define PG8_WAIT_L(n) asm volatile("s_waitcnt lgkmcnt(" #n ")" ::: "memory")
#define PG8_BAR __builtin_amdgcn_s_barrier()
#define PG8_SCHED __builtin_amdgcn_sched_barrier(0)
    Unit cur, nxt; int ui = 0;
    if (!S.next(0, cur)) return;
    f32x4 acc[2][2][4][2];
#pragma unroll
    for (int a = 0; a < 2; ++a)
#pragma unroll
        for (int b = 0; b < 2; ++b)
#pragma unroll
            for (int m = 0; m < 4; ++m)
#pragma unroll
                for (int n = 0; n < 2; ++n) acc[a][b][m][n] = (f32x4){0.f, 0.f, 0.f, 0.f};
    bf16x8 At[4][2], B0[2][2], B1[2][2];
    const char* cA = cur.A; const char* cB = cur.B;
    S.a_ready(cur);
    if constexpr (Sched::GATHER) { PG8_GROWS(cur, vA); }
    PG8_STAGE(PG8_SB(0, 0), cB, voffB); PG8_STAGEA(0, 0, cA, false); PG8_STAGE(PG8_SB(0, 1), cB + hstepB, voffB); PG8_STAGEA(0, 1, cA, false);
    if (wr == 1) PG8_BAR;
    PG8_WAIT_V(4); PG8_BAR;
    PG8_STAGE(PG8_SB(1, 0), cB + kstep, voffB); PG8_STAGEA(1, 0, cA + kstep, false); PG8_STAGE(PG8_SB(1, 1), cB + hstepB + kstep, voffB);
    PG8_WAIT_V(6); PG8_BAR;
    for (;;) {
        const bool has_next = S.next(ui + 1, nxt);
        const char* nA = has_next ? nxt.A : cA; const char* nB = has_next ? nxt.B : cB;
        if constexpr (Sched::GATHER) { if (has_next) { PG8_GROWS(nxt, vAn); } else {
#pragma unroll
            for (int h_ = 0; h_ < 2; ++h_) { vAn[h_][0] = vA[h_][0]; vAn[h_][1] = vA[h_][1]; } } }
        for (int t = 0; t < nt; t += 2) {
            const bool last = (t == nt - 2);
            const char* a1 = cA + (size_t)(t + 1) * kstep;
            const char* a2 = last ? nA : cA + (size_t)(t + 2) * kstep; const char* b2 = last ? nB : cB + (size_t)(t + 2) * kstep;
            const char* a3 = a2 + kstep; const char* b3 = b2 + kstep;
            if (last && has_next) S.a_ready(nxt);
            PG8_LDB(B0, 0, 0); PG8_SCHED; PG8_LDA(At, 0, 0); PG8_STAGEA(1, 1, a1, false);
            PG8_WAIT_L(8); PG8_BAR; PG8_WAIT_L(0); PG8_MMA(0, 0, At, B0); PG8_BAR; PG8_SCHED;
            PG8_LDB(B1, 0, 1); PG8_STAGE(PG8_SB(0, 0), b2, voffB);
            PG8_BAR; PG8_WAIT_L(0); PG8_MMA(0, 1, At, B1); PG8_BAR;
            PG8_LDA(At, 0, 1); PG8_STAGEA(0, 0, a2, last);
            PG8_BAR; PG8_WAIT_L(0); PG8_MMA(1, 0, At, B0); PG8_BAR; PG8_SCHED;
            PG8_STAGE(PG8_SB(0, 1), b2 + hstepB, voffB);
            PG8_WAIT_V(6); PG8_BAR; PG8_MMA(1, 1, At, B1); PG8_BAR;
            PG8_LDB(B0, 1, 0); PG8_SCHED; PG8_LDA(At, 1, 0); PG8_STAGEA(0, 1, a2, last);
            PG8_WAIT_L(8); PG8_BAR; PG8_WAIT_L(0); PG8_MMA(0, 0, At, B0); PG8_BAR; PG8_SCHED;
            PG8_LDB(B1, 1, 1); PG8_STAGE(PG8_SB(1, 0), b3, voffB);
            PG8_BAR; PG8_WAIT_L(0); PG8_MMA(0, 1, At, B1); PG8_BAR;
            PG8_LDA(At, 1, 1); PG8_STAGEA(1, 0, a3, last);
            PG8_BAR; PG8_WAIT_L(0); PG8_MMA(1, 0, At, B0); PG8_BAR; PG8_SCHED;
            PG8_STAGE(PG8_SB(1, 1), b3 + hstepB, voffB);
            PG8_WAIT_V(6); PG8_BAR; PG8_MMA(1, 1, At, B1); PG8_BAR;
            if constexpr (Epi::SEGT > 0) { if ((t + 2) % Epi::SEGT == 0 && t + 2 < nt) E.segment(acc, cur, (t + 2) / Epi::SEGT - 1, wr, wc, fr, fq); }
        }
        E(acc, cur, wr, wc, fr, fq); S.done(cur);
        if (!has_next) break;
#pragma unroll
        for (int a = 0; a < 2; ++a)
#pragma unroll
            for (int b = 0; b < 2; ++b)
#pragma unroll
                for (int m = 0; m < 4; ++m)
#pragma unroll
                    for (int n = 0; n < 2; ++n) acc[a][b][m][n] = (f32x4){0.f, 0.f, 0.f, 0.f};
        cur = nxt; cA = nA; cB = nB; ++ui;
        if constexpr (Sched::GATHER) {
#pragma unroll
            for (int h_ = 0; h_ < 2; ++h_) { vA[h_][0] = vAn[h_][0]; vA[h_][1] = vAn[h_][1]; } }
    }
    PG8_WAIT_V(0);
    if (wr == 0) PG8_BAR;
    PG8_BAR;
#undef PG8_SA
#undef PG8_SB
#undef PG8_STAGE
#undef PG8_STAGEA
#undef PG8_GROWS
#undef PG8_LDA
#undef PG8_LDB
#undef PG8_MMA
#undef PG8_WAIT_V
#undef PG8_WAIT_L
#undef PG8_BAR
#undef PG8_SCHED
#endif
}

struct StaticOrder {
    static constexpr bool GATHER = false;
    int nM, nN, nwg, G, c; const char* A; const char* B; size_t tstepA, tstepB;
    __device__ __forceinline__ void init(int M, int N, int G_, int c_, const void* A_, const void* B_, int lda, int ldb) { nM = M / BM; nN = N / BM; nwg = nM * nN; G = G_; c = c_; A = (const char*)A_; B = (const char*)B_; tstepA = (size_t)BM * lda * 2; tstepB = (size_t)BM * ldb * 2; }
    __device__ __forceinline__ bool next(int i, Unit& u) const {
        const long L = (long)i * G + c; if (L >= nwg) return false;
        int wgid = (int)L; { const int q = nwg / 8, r = nwg % 8, xcd = wgid % 8, off = wgid / 8; wgid = (xcd < r ? xcd * (q + 1) : r * (q + 1) + (xcd - r) * q) + off; }
        const int nig = 8 * nN, gid = wgid / nig, fm = gid * 8, gsz = (nM - fm) < 8 ? (nM - fm) : 8;
        u.pm = fm + ((wgid % nig) % gsz); u.pn = (wgid % nig) / gsz; u.aux = 0; u.A = A + (size_t)u.pm * tstepA; u.B = B + (size_t)u.pn * tstepB; return true;
    }
    __device__ __forceinline__ void a_ready(const Unit&) const {}
    __device__ __forceinline__ void done(const Unit&) const {}
};
struct MergeOrder {
    static constexpr bool GATHER = false;
    StaticOrder so; int kseg_bytes;
    __device__ __forceinline__ bool next(int i, Unit& u) const { if (!so.next(i >> 2, u)) return false; u.aux = i & 3; u.A += (size_t)u.aux * kseg_bytes; u.B += (size_t)u.aux * kseg_bytes; return true; }
    __device__ __forceinline__ void a_ready(const Unit&) const {}
    __device__ __forceinline__ void done(const Unit&) const {}
};
struct MoeOrder {
    static constexpr bool GATHER = false;
    int G, c, ncol; const int* plan; const char* A; const char* B; size_t tstepA, tstepB, estep;
    __device__ __forceinline__ bool next(int i, Unit& u) const {
        const long L = (long)i * G + c; const int nblk = plan[40]; if (L >= (long)nblk * ncol) return false;
        u.pm = (int)(L / ncol); u.pn = (int)(L % ncol); u.aux = plan[64 + u.pm]; u.A = A + (size_t)u.pm * tstepA; u.B = B + (size_t)u.aux * estep + (size_t)u.pn * tstepB; return true;
    }
    __device__ __forceinline__ void a_ready(const Unit&) const {}
    __device__ __forceinline__ void done(const Unit&) const {}
};
struct MoeGatherOrder {
    static constexpr bool GATHER = true;
    int G, c, ncol; const int* plan; const char* A; const char* B; size_t tstepB, estep; const int* src; int nrows;
    __device__ __forceinline__ bool next(int i, Unit& u) const {
        const long L = (long)i * G + c; const int nblk = plan[40]; if (L >= (long)nblk * ncol) return false;
        u.pm = (int)(L / ncol); u.pn = (int)(L % ncol); u.aux = plan[64 + u.pm]; u.A = A; u.B = B + (size_t)u.aux * estep + (size_t)u.pn * tstepB; return true;
    }
    __device__ __forceinline__ int row(int slot) const { const int r = src[slot]; return (unsigned)r < (unsigned)nrows ? r : 0; }
    __device__ __forceinline__ void a_ready(const Unit&) const {}
    __device__ __forceinline__ void done(const Unit&) const {}
};

__device__ __forceinline__ u32x4 pack8(const f32x4 v0, const f32x4 v1) { u32x4 w; w[0] = pk2(v0[0], v0[1]); w[1] = pk2(v0[2], v0[3]); w[2] = pk2(v1[0], v1[1]); w[3] = pk2(v1[2], v1[3]); return w; }
struct EpiBf16 {
    static constexpr int SEGT = 0; static constexpr bool PERM = true; bf16_t* O; int ldc;
    __device__ __forceinline__ void operator()(const f32x4 (&acc)[2][2][4][2], const Unit& u, int wr, int wc, int fr, int fq) const {
        const int row0 = u.pm * BM + wr * 64 + fr, col0 = u.pn * BM + wc * 32 + 8 * fq;
#pragma unroll
        for (int ai = 0; ai < 2; ++ai)
#pragma unroll
            for (int m = 0; m < 4; ++m) { bf16_t* rowp = O + (size_t)(row0 + ai * HALF + m * 16) * ldc + col0;
#pragma unroll
                for (int bj = 0; bj < 2; ++bj) *(u32x4*)(rowp + bj * HALF) = pack8(acc[ai][bj][m][0], acc[ai][bj][m][1]); }
    }
};
struct EpiP {
    static constexpr int SEGT = 0; static constexpr bool PERM = true; bf16_t* O; unsigned char* G8; float* SG;
    __device__ __forceinline__ void operator()(const f32x4 (&acc)[2][2][4][2], const Unit& u, int wr, int wc, int fr, int fq) const {
        const int row0 = u.pm * BM + wr * 64 + fr, col0 = u.pn * BM + wc * 32 + 8 * fq;
        if (u.pn * BM < C_MLP) {
            const bool sgu = u.pn * BM >= C_SV && u.pn * BM < C_SV + W;
#pragma unroll
            for (int ai = 0; ai < 2; ++ai)
#pragma unroll
                for (int m = 0; m < 4; ++m) { const int r = row0 + ai * HALF + m * 16; bf16_t* rowp = O + (size_t)r * PW + col0; float s1 = 0.f, s2 = 0.f;
#pragma unroll
                    for (int bj = 0; bj < 2; ++bj) { const u32x4 pk = pack8(acc[ai][bj][m][0], acc[ai][bj][m][1]); *(u32x4*)(rowp + bj * HALF) = pk;
                        if (sgu) {
#pragma unroll
                            for (int e = 0; e < 4; ++e) { const float g0 = geluf_(bflo(pk[e])), g1 = geluf_(bfhi(pk[e])); s1 += g0 + g1; s2 += g0 * g0 + g1 * g1; } } }
                    if (sgu) { float* sp = SG + ((size_t)r * 16 + (u.pn - C_SV / BM) * 4 + wc) * 2;
#ifdef CPU_EMU
                        if (fq == 0) { sp[0] = s1; sp[1] = s2; } else { sp[0] += s1; sp[1] += s2; }
#else
                        s1 += SHFL_XOR(s1, 16); s1 += SHFL_XOR(s1, 32); s2 += SHFL_XOR(s2, 16); s2 += SHFL_XOR(s2, 32); if (fq == 0) { sp[0] = s1; sp[1] = s2; }
#endif
                    } }
        } else {
#pragma unroll
            for (int ai = 0; ai < 2; ++ai)
#pragma unroll
                for (int m = 0; m < 4; ++m) { unsigned char* rowp = G8 + (size_t)(row0 + ai * HALF + m * 16) * (4 * D) + (col0 - C_MLP);
#pragma unroll
                    for (int bj = 0; bj < 2; ++bj) { unsigned long long w = 0ull;
#pragma unroll
                        for (int q = 0; q < 8; ++q) { const float gq = sigmoidf_(acc[ai][bj][m][q >> 2][q & 3]); w |= (unsigned long long)(unsigned)(gq * 255.f + 0.5f) << (8 * q); }
                        *(unsigned long long*)(rowp + bj * HALF) = w; } }
        }
    }
};
struct EpiMerge {
    static constexpr int SEGT = 16; static constexpr bool PERM = true; const unsigned char* G8; bf16_t* MRG;
    static __device__ __forceinline__ float gq(unsigned long long w, int q) { const unsigned b = (unsigned)(w >> (8 * q)) & 255u; return (b ? (float)b : 0.5f) * (1.f / 255.f); }
    __device__ __forceinline__ void segment(f32x4 (&acc)[2][2][4][2], const Unit& u, int seg, int wr, int wc, int fr, int fq) const {
        const int row0 = u.pm * BM + wr * 64 + fr, col0 = u.pn * BM + wc * 32 + 8 * fq;
#pragma unroll
        for (int ai = 0; ai < 2; ++ai)
#pragma unroll
            for (int m = 0; m < 4; ++m) { const size_t r = (size_t)(row0 + ai * HALF + m * 16);
#pragma unroll
                for (int bj = 0; bj < 2; ++bj) { const int cc = col0 + bj * HALF;
                    const unsigned long long g0 = *(const unsigned long long*)(G8 + r * (4 * D) + seg * D + cc), g1 = *(const unsigned long long*)(G8 + r * (4 * D) + (seg + 1) * D + cc);
#pragma unroll
                    for (int q = 0; q < 4; ++q) { acc[ai][bj][m][0][q] *= gq(g0, q) * frcp_(gq(g1, q)); acc[ai][bj][m][1][q] *= gq(g0, 4 + q) * frcp_(gq(g1, 4 + q)); } }
#ifndef CPU_EMU
                asm volatile("" ::: "memory");
#endif
            }
    }
    __device__ __forceinline__ void operator()(const f32x4 (&acc)[2][2][4][2], const Unit& u, int wr, int wc, int fr, int fq) const {
        const int row0 = u.pm * BM + wr * 64 + fr, col0 = u.pn * BM + wc * 32 + 8 * fq;
#pragma unroll
        for (int ai = 0; ai < 2; ++ai)
#pragma unroll
            for (int m = 0; m < 4; ++m) { const size_t r = (size_t)(row0 + ai * HALF + m * 16);
#pragma unroll
                for (int bj = 0; bj < 2; ++bj) { const int cc = col0 + bj * HALF;
                    const unsigned long long g3 = *(const unsigned long long*)(G8 + r * (4 * D) + 3 * D + cc); f32x4 v0, v1;
#pragma unroll
                    for (int q = 0; q < 4; ++q) { v0[q] = gq(g3, q) * acc[ai][bj][m][0][q]; v1[q] = gq(g3, 4 + q) * acc[ai][bj][m][1][q]; }
                    *(u32x4*)(MRG + r * D + cc) = pack8(v0, v1); }
#ifndef CPU_EMU
                asm volatile("" ::: "memory");
#endif
            }
    }
};
struct EpiResid {
    static constexpr int SEGT = 0; static constexpr bool PERM = false; const float* xin; const float* g1; float* xmid; float* ssp;
    __device__ __forceinline__ void operator()(const f32x4 (&acc)[2][2][4][2], const Unit& u, int wr, int wc, int fr, int fq) const {
        const int row0 = u.pm * BM + wr * 64 + fr, col0 = u.pn * BM + wc * 32 + 4 * fq;
#pragma unroll
        for (int ai = 0; ai < 2; ++ai)
#pragma unroll
            for (int m = 0; m < 4; ++m) { const int r = row0 + ai * HALF + m * 16; const float* gp = g1 + (size_t)(r / S) * D6; float sq = 0.f;
#pragma unroll
                for (int bj = 0; bj < 2; ++bj)
#pragma unroll
                    for (int n = 0; n < 2; ++n) { const int cc = col0 + bj * HALF + n * 16; const f32x4 v = *(const f32x4*)(xin + (size_t)r * D + cc) + *(const f32x4*)(gp + cc) * acc[ai][bj][m][n];
                        *(f32x4*)(xmid + (size_t)r * D + cc) = v; sq += (v[0] * v[0] + v[1] * v[1]) + (v[2] * v[2] + v[3] * v[3]); }
                float* sp = ssp + (size_t)r * 32 + u.pn * 4 + wc;
#ifdef CPU_EMU
                if (fq == 0) *sp = sq; else *sp += sq;
#else
                sq += SHFL_XOR(sq, 16); sq += SHFL_XOR(sq, 32); if (fq == 0) *sp = sq;
                asm volatile("" ::: "memory");
#endif
            }
    }
};
struct EpiGU {
    static constexpr int SEGT = 0; static constexpr bool PERM = true; bf16_t* ACT;
    __device__ __forceinline__ void operator()(const f32x4 (&acc)[2][2][4][2], const Unit& u, int wr, int wc, int fr, int fq) const {
        const int row0 = u.pm * BM + wr * 64 + fr, col0 = u.pn * HALF + wc * 32 + 8 * fq;
#pragma unroll
        for (int ai = 0; ai < 2; ++ai)
#pragma unroll
            for (int m = 0; m < 4; ++m) { f32x4 v0, v1;
#pragma unroll
                for (int j = 0; j < 4; ++j) { v0[j] = siluf_(acc[ai][0][m][0][j]) * acc[ai][1][m][0][j]; v1[j] = siluf_(acc[ai][0][m][1][j]) * acc[ai][1][m][1][j]; }
                *(u32x4*)(ACT + (size_t)(row0 + ai * HALF + m * 16) * 512 + col0) = pack8(v0, v1); }
    }
};
}

template <int PASS>
__device__ __forceinline__ void ph_lru(const Ctx& c, int l, float* ldsf) {
    const bf16_t* P = WSH(O_P); const float* cw = c.in[8] + (size_t)l * 4 * W; const float* cb = c.in[9] + (size_t)l * W;
    const float* br = c.in[11] + (size_t)l * 2 * W; const float* bi = c.in[13] + (size_t)l * 2 * W; const float* lam = c.in[14] + (size_t)l * 2 * W; const bf16_t* WLR = WSH(O_WLR);
    float* CA = WSF(O_LCA); float* CH = WSF(O_LCH); const float* CI = WSF(O_LCI); bf16_t* Y = WSH(O_YS); unsigned* LAU = (unsigned*)(c.ws + O_LA);
    bf16_t* Xs = (bf16_t*)ldsf; bf16_t* Wr = Xs + 64 * 136; bf16_t* Wi = Wr + 128 * 136; float* AUa = (float*)Wr; float* AUu = AUa + 64 * 128; float* HF = (float*)(Wi + 128 * 136); float* spl = HF + 64 * 128;
    const int tid = threadIdx.x, wv = tid >> 6, lane = tid & 63, fr = lane & 15, fq = lane >> 4, rt = wv & 3, hf = wv >> 2;
    u32x4 wreg[8];
#define LRU_WLOAD(zz, nn) do { _Pragma("unroll") for (int q = 0; q < 4; ++q) { const int id = tid + NT * q, f = id >> 4, e8 = (id & 15) * 8; \
        wreg[2 * q] = *(const u32x4*)(WLR + ((size_t)(((zz) * 2 + 0) * 8 + (nn)) * 128 + f) * 128 + e8); wreg[2 * q + 1] = *(const u32x4*)(WLR + ((size_t)(((zz) * 2 + 1) * 8 + (nn)) * 128 + f) * 128 + e8); } } while (0)
    if ((int)blockIdx.x < (T / 64) * 8) LRU_WLOAD(0, (int)blockIdx.x & 7);
    for (int u = blockIdx.x; u < (T / 64) * 8; u += gridDim.x) {
        const int n = u & 7, tile = u >> 3, b = tile / NLC, chk = tile % NLC; const long t0 = (long)tile * 64;
        if (tid < 256) spl[tid] = softplusf_(-lam[(tid >> 7) * W + n * 128 + (tid & 127)]);
#pragma unroll
        for (int q = 0; q < 4; ++q) { const int id = tid + NT * q, tl = id >> 5, e4 = (id & 31) * 4, ch = n * 128 + e4; const long t = t0 + tl; const int sI = (int)(t % S);
            f32x4 acc = *(const f32x4*)(cb + ch);
#pragma unroll
            for (int k = 0; k < 4; ++k) { const int ss = sI + k - 2; if (ss >= 0 && ss < S) acc += ld_bf4(P + (size_t)(t + k - 2) * PW + C_LX + ch) * *(const f32x4*)(cw + k * W + ch); }
            st_bf4(Xs + tl * 136 + e4, acc); }
        for (int z = 0; z < 2; ++z) {
#pragma unroll
            for (int q = 0; q < 4; ++q) { const int id = tid + NT * q, f = id >> 4, e8 = (id & 15) * 8; *(u32x4*)(Wr + f * 136 + e8) = wreg[2 * q]; *(u32x4*)(Wi + f * 136 + e8) = wreg[2 * q + 1]; }
            SYNCTHREADS();
            f32x4 ar[4], ai[4];
#pragma unroll
            for (int nt = 0; nt < 4; ++nt) { ar[nt] = (f32x4){0.f, 0.f, 0.f, 0.f}; ai[nt] = (f32x4){0.f, 0.f, 0.f, 0.f}; }
            wave_mma<4, 4>(ar, Xs + rt * 16 * 136, 136, Wr + hf * 64 * 136, 136);
            wave_mma<4, 4>(ai, Xs + rt * 16 * 136, 136, Wi + hf * 64 * 136, 136);
            SYNCTHREADS();
            if (z == 0) LRU_WLOAD(1, n); else if (u + (int)gridDim.x < (T / 64) * 8) LRU_WLOAD(0, (u + (int)gridDim.x) & 7);
            const int tl = rt * 16 + fr;
#pragma unroll
            for (int nt = 0; nt < 4; ++nt) { const int f = 64 * hf + 16 * nt + 4 * fq, ch = n * 128 + f;
                const f32x4 brv = *(const f32x4*)(br + z * W + ch), biv = *(const f32x4*)(bi + z * W + ch), lmv = *(const f32x4*)(spl + z * 128 + f), xcv = ld_bf4(Xs + tl * 136 + f); f32x4 av, uv, lav;
#pragma unroll
                for (int e = 0; e < 4; ++e) { const float r = sigmoidf_(ar[nt][e] + brv[e]), ig = sigmoidf_(ai[nt][e] + biv[e]), la = -8.f * r * lmv[e]; const float a = fexp_(la); av[e] = a; lav[e] = la; uv[e] = fsqrt_(fmaxf(1.f - a * a, 0.f)) * ig * xcv[e]; }
                *(f32x4*)(AUa + tl * 128 + f) = av; *(f32x4*)(AUu + tl * 128 + f) = uv;
                if (PASS == 1) { u32x4 pk;
#pragma unroll
                    for (int e = 0; e < 4; ++e) pk[e] = pk2(lav[e], uv[e]);
                    *(u32x4*)(LAU + ((size_t)z * T + t0 + tl) * W + ch) = pk; } }
            SYNCTHREADS();
            if (PASS == 1) {
                { const int f = tid & 127, sgm = tid >> 7; float prod = 1.f, h = 0.f;
#pragma unroll
                  for (int q = 0; q < 16; ++q) { const int st = sgm * 16 + q, sI = z == 0 ? st : 63 - st; const float a = AUa[sI * 128 + f]; h = a * h + AUu[sI * 128 + f]; prod *= a; }
                  HF[sgm * 128 + f] = prod; HF[512 + sgm * 128 + f] = h; }
                SYNCTHREADS();
                if (tid < 128) { const int f = tid; const size_t ci = (((size_t)z * NB + b) * NLC + chk) * W + n * 128 + f; float prod = 1.f, h = 0.f;
#pragma unroll
                    for (int sgm = 0; sgm < 4; ++sgm) { const float a = HF[sgm * 128 + f]; h = a * h + HF[512 + sgm * 128 + f]; prod *= a; }
                    CA[ci] = prod; CH[ci] = h; }
                continue;
            }
            if (tid < 128) { const int f = tid; const size_t ci = (((size_t)z * NB + b) * NLC + chk) * W + n * 128 + f;
                if (PASS == 1) { float prod = 1.f, h = 0.f;
#pragma unroll 8
                    for (int q = 0; q < 64; ++q) { const int sI = z == 0 ? q : 63 - q; const float a = AUa[sI * 128 + f]; h = a * h + AUu[sI * 128 + f]; prod *= a; }
                    CA[ci] = prod; CH[ci] = h;
                } else { float h = CI[ci];
                    if (z == 0) {
#pragma unroll 8
                        for (int q = 0; q < 64; ++q) { h = AUa[q * 128 + f] * h + AUu[q * 128 + f]; HF[q * 128 + f] = h; }
                    } else {
#pragma unroll 8
                        for (int q = 63; q >= 0; --q) { h = AUa[q * 128 + f] * h + AUu[q * 128 + f]; HF[q * 128 + f] += h; } } }
            }
            SYNCTHREADS();
        }
        if (PASS == 2) {
#pragma unroll
            for (int q = 0; q < 4; ++q) { const int id = tid + NT * q, tl = id >> 5, f4 = (id & 31) * 4; const long t = t0 + tl; f32x4 hv = *(const f32x4*)(HF + tl * 128 + f4); const f32x4 gv = ld_bf4(P + (size_t)t * PW + C_LG + n * 128 + f4);
#pragma unroll
                for (int e = 0; e < 4; ++e) hv[e] *= geluf_(gv[e]);
                st_bf4(Y + (size_t)t * 4 * W + 0 * W + n * 128 + f4, hv); }
            SYNCTHREADS();
        }
    }
}
__device__ __forceinline__ void ph_lru_fin(const Ctx& c, float* ldsf) {
    const bf16_t* P = WSH(O_P); const unsigned* LAU = (const unsigned*)(c.ws + O_LA); const float* CI = WSF(O_LCI); bf16_t* Y = WSH(O_YS);
    unsigned* Lz = (unsigned*)ldsf; float* Hz = ldsf + 2 * 64 * 128; const int tid = threadIdx.x;
    u32x4 lpre[8];
#define LF_LOAD(uu) do { const int n_ = (uu) & 7; const long t0_ = (long)((uu) >> 3) * 64; \
        _Pragma("unroll") for (int q = 0; q < 8; ++q) { const int id = tid + NT * q, z = id >> 11, r = (id >> 5) & 63, c4 = (id & 31) * 4; lpre[q] = *(const u32x4*)(LAU + ((size_t)z * T + t0_ + r) * W + n_ * 128 + c4); } } while (0)
    if ((int)blockIdx.x < (T / 64) * 8) LF_LOAD((int)blockIdx.x);
    for (int u = blockIdx.x; u < (T / 64) * 8; u += gridDim.x) {
        const int n = u & 7, tile = u >> 3, b = tile / NLC, chk = tile % NLC; const long t0 = (long)tile * 64;
#pragma unroll
        for (int q = 0; q < 8; ++q) { const int id = tid + NT * q, z = id >> 11, r = (id >> 5) & 63, c4 = (id & 31) * 4; *(u32x4*)(Lz + z * 8192 + r * 128 + c4) = lpre[q]; }
        SYNCTHREADS();
        if (u + (int)gridDim.x < (T / 64) * 8) LF_LOAD(u + (int)gridDim.x);
        unsigned long long graw[4];
#pragma unroll
        for (int q = 0; q < 4; ++q) { const int id = tid + NT * q, r = id >> 5, f4 = (id & 31) * 4; graw[q] = *(const unsigned long long*)(P + (size_t)(t0 + r) * PW + C_LG + n * 128 + f4); }
        if (tid < 256) { const int z = tid >> 7, f = tid & 127; float h = CI[(((size_t)z * NB + b) * NLC + chk) * W + n * 128 + f]; const unsigned* lp = Lz + z * 8192 + f; float* hp = Hz + z * 8192 + f;
#pragma unroll 8
            for (int q = 0; q < 64; ++q) { const int sI = z == 0 ? q : 63 - q; const unsigned w = lp[sI * 128]; h = fexp_(bflo(w)) * h + bfhi(w); hp[sI * 128] = h; } }
        SYNCTHREADS();
#pragma unroll
        for (int q = 0; q < 4; ++q) { const int id = tid + NT * q, r = id >> 5, f4 = (id & 31) * 4; const long t = t0 + r; f32x4 o = *(const f32x4*)(Hz + r * 128 + f4) + *(const f32x4*)(Hz + 8192 + r * 128 + f4); const unsigned glo = (unsigned)graw[q], ghi = (unsigned)(graw[q] >> 32); const f32x4 gv = (f32x4){bflo(glo), bfhi(glo), bflo(ghi), bfhi(ghi)};
#pragma unroll
            for (int e = 0; e < 4; ++e) o[e] *= geluf_(gv[e]);
            st_bf4(Y + (size_t)t * 4 * W + 0 * W + n * 128 + f4, o); }
        SYNCTHREADS();
    }
}
__device__ __forceinline__ void ph_lru_scan2(const Ctx& c) {
    const float* CA = WSF(O_LCA); const float* CH = WSF(O_LCH); float* CI = WSF(O_LCI);
    for (long i = GT_; i < (long)2 * NB * W; i += GS_) {
        const int w = (int)(i % W), b = (int)((i / W) % NB), z = (int)(i / ((long)W * NB)); float carry = 0.f;
#pragma unroll 16
        for (int q = 0; q < NLC; ++q) { const int ch = z == 0 ? q : NLC - 1 - q; const size_t idx = (((size_t)z * NB + b) * NLC + ch) * W + w; CI[idx] = carry; carry = CA[idx] * carry + CH[idx]; }
    }
}
__device__ __forceinline__ void ph_rope_table(const Ctx& c) {
    const int* pos = (const int*)c.in[2]; float* RT = WSF(O_ROPE);
    for (long i = GT_; i < (long)T * 32; i += GS_) { const int j = (int)(i & 31); const float ang = (float)pos[i >> 5] * powf(10000.f, -(float)(2 * j) / 64.f); RT[i * 2] = cosf(ang); RT[i * 2 + 1] = sinf(ang); }
}
__device__ __forceinline__ void ret_tables(float* tab, int h) {
    const int tid = threadIdx.x; const float lg = loggamma_(h);
    if (tid < 32) tab[tid] = powf(10000.f, -(float)(2 * tid) / 64.f);
    if (tid >= 64 && tid < 64 + 129) tab[tid] = expf((float)(tid - 64) * lg);
}
__device__ __forceinline__ void ph_ret_kv(const Ctx& c, float* ldsf) {
    const float* RT = WSF(O_ROPE); const bf16_t* P = WSH(O_P); float* KVF = WSF(O_KVF); float* KVB = WSF(O_KVB);
    bf16_t* VT = (bf16_t*)ldsf; bf16_t* KF = VT + 128 * 136; bf16_t* KB = KF + 64 * 136; float* tab = (float*)(KB + 64 * 136);
    const int tid = threadIdx.x, wv = tid >> 6, lane = tid & 63, fr = lane & 15, fq = lane >> 4;
    for (int u = blockIdx.x; u < (T / 128) * 8; u += gridDim.x) {
        const int h = u & 7; const long t0 = (long)(u >> 3) * 128;
        ret_tables(tab, h);
        SYNCTHREADS();
        {
            const int j = tid >> 2, d0 = (tid & 3) * 8; const bf16_t* prow = P + (size_t)(t0 + j) * PW + C_RK + h * 64; const float* rt = RT + ((size_t)(t0 + j) * 32 + d0) * 2;
            const u32x4 kl = *(const u32x4*)(prow + d0), kh = *(const u32x4*)(prow + d0 + 32);
            const f32x4 r0 = *(const f32x4*)rt, r1 = *(const f32x4*)(rt + 4), r2 = *(const f32x4*)(rt + 8), r3 = *(const f32x4*)(rt + 12);
            const float cs[8] = {r0[0], r0[2], r1[0], r1[2], r2[0], r2[2], r3[0], r3[2]}, sn[8] = {r0[1], r0[3], r1[1], r1[3], r2[1], r2[3], r3[1], r3[3]};
            const float fj = tab[64 + 127 - j], bj = tab[64 + j];
#pragma unroll
            for (int e = 0; e < 8; ++e) { const float x1 = (e & 1) ? bfhi(kl[e >> 1]) : bflo(kl[e >> 1]), x2 = (e & 1) ? bfhi(kh[e >> 1]) : bflo(kh[e >> 1]);
                const float k1 = x1 * cs[e] - x2 * sn[e], k2 = x2 * cs[e] + x1 * sn[e];
                KF[(d0 + e) * 136 + j] = (bf16_t)f2bf(k1 * fj); KF[(d0 + e + 32) * 136 + j] = (bf16_t)f2bf(k2 * fj); KB[(d0 + e) * 136 + j] = (bf16_t)f2bf(k1 * bj); KB[(d0 + e + 32) * 136 + j] = (bf16_t)f2bf(k2 * bj); } }
#pragma unroll
        for (int q = 0; q < 4; ++q) { const int id = tid + NT * q, j = id & 127, e8 = (id >> 7) * 8; const u32x4 raw = *(const u32x4*)(P + (size_t)(t0 + j) * PW + C_RV + h * 128 + e8);
#pragma unroll
            for (int e = 0; e < 4; ++e) { VT[(e8 + 2 * e) * 136 + j] = (bf16_t)(raw[e] & 0xffffu); VT[(e8 + 2 * e + 1) * 136 + j] = (bf16_t)(raw[e] >> 16); } }
        SYNCTHREADS();
        f32x4 af[4], ab[4];
#pragma unroll
        for (int nt = 0; nt < 4; ++nt) { af[nt] = (f32x4){0.f, 0.f, 0.f, 0.f}; ab[nt] = (f32x4){0.f, 0.f, 0.f, 0.f}; }
        wave_mma<4, 4>(af, VT + wv * 16 * 136, 136, KF, 136);
        wave_mma<4, 4>(ab, VT + wv * 16 * 136, 136, KB, 136);
        const size_t ob = (((size_t)(u >> 3) * 8 + h) * 128 + wv * 16 + fr) * 64 + 4 * fq;
#pragma unroll
        for (int nt = 0; nt < 4; ++nt) { *(f32x4*)(KVF + ob + 16 * nt) = af[nt]; *(f32x4*)(KVB + ob + 16 * nt) = ab[nt]; }
        SYNCTHREADS();
    }
}
__device__ __forceinline__ void ph_ret_state(const Ctx& c) {
    const float* KVF = WSF(O_KVF); const float* KVB = WSF(O_KVB); float* STF = WSF(O_STF); float* STB = WSF(O_STB);
    for (long i = GT_; i < (long)NB * 8 * 8192; i += GS_) {
        const int x = (int)(i % 8192), h = (int)((i / 8192) % 8), b = (int)(i / 65536);
        const float cd = expf(128.f * loggamma_(h)); float st = 0.f;
#pragma unroll 16
        for (int n = 0; n < NCH; ++n) { const size_t idx = (((size_t)b * NCH + n) * 8 + h) * 8192 + x; STF[idx] = st; st = cd * st + KVF[idx]; }
        st = 0.f;
#pragma unroll 16
        for (int n = NCH - 1; n >= 0; --n) { const size_t idx = (((size_t)b * NCH + n) * 8 + h) * 8192 + x; STB[idx] = st; st = cd * st + KVB[idx]; }
    }
}
__device__ __forceinline__ void ph_ret_out(const Ctx& c, float* ldsf) {
    const float* RT = WSF(O_ROPE); const bf16_t* P = WSH(O_P); const float* STF = WSF(O_STF); const float* STB = WSF(O_STB); bf16_t* Y = WSH(O_YS);
    bf16_t* Qs = (bf16_t*)ldsf; bf16_t* Ks = Qs + 128 * 72; bf16_t* VT = Ks + 128 * 72; bf16_t* Ss = VT + 128 * 136; bf16_t* SF = Ss + 128 * 136; bf16_t* SB = SF + 128 * 72; float* tab = (float*)(SB + 128 * 72);
    const int tid = threadIdx.x, wv = tid >> 6, lane = tid & 63, fr = lane & 15, fq = lane >> 4;
    for (int u = blockIdx.x; u < (T / 128) * 8; u += gridDim.x) {
        const int h = u & 7; const long t0 = (long)(u >> 3) * 128;
        ret_tables(tab, h);
        SYNCTHREADS();
        {
            const int j = tid >> 2, d0 = (tid & 3) * 8; const bf16_t* prow = P + (size_t)(t0 + j) * PW + h * 64 + d0; const float* rt = RT + ((size_t)(t0 + j) * 32 + d0) * 2;
            const u32x4 ql = *(const u32x4*)(prow + C_RQ), qh = *(const u32x4*)(prow + C_RQ + 32), kl = *(const u32x4*)(prow + C_RK), kh = *(const u32x4*)(prow + C_RK + 32);
            const f32x4 r0 = *(const f32x4*)rt, r1 = *(const f32x4*)(rt + 4), r2 = *(const f32x4*)(rt + 8), r3 = *(const f32x4*)(rt + 12);
            const float cs[8] = {r0[0], r0[2], r1[0], r1[2], r2[0], r2[2], r3[0], r3[2]}, sn[8] = {r0[1], r0[3], r1[1], r1[3], r2[1], r2[3], r3[1], r3[3]};
            u32x4 oql, oqh, okl, okh;
#pragma unroll
            for (int e = 0; e < 4; ++e) { const int ea = 2 * e, eb = 2 * e + 1;
                const float q1a = bflo(ql[e]), q1b = bfhi(ql[e]), q2a = bflo(qh[e]), q2b = bfhi(qh[e]), k1a = bflo(kl[e]), k1b = bfhi(kl[e]), k2a = bflo(kh[e]), k2b = bfhi(kh[e]);
                oql[e] = pk2((q1a * cs[ea] - q2a * sn[ea]) * 0.125f, (q1b * cs[eb] - q2b * sn[eb]) * 0.125f); oqh[e] = pk2((q2a * cs[ea] + q1a * sn[ea]) * 0.125f, (q2b * cs[eb] + q1b * sn[eb]) * 0.125f);
                okl[e] = pk2(k1a * cs[ea] - k2a * sn[ea], k1b * cs[eb] - k2b * sn[eb]); okh[e] = pk2(k2a * cs[ea] + k1a * sn[ea], k2b * cs[eb] + k1b * sn[eb]); }
            *(u32x4*)(Qs + j * 72 + d0) = oql; *(u32x4*)(Qs + j * 72 + d0 + 32) = oqh; *(u32x4*)(Ks + j * 72 + d0) = okl; *(u32x4*)(Ks + j * 72 + d0 + 32) = okh; }
#pragma unroll
        for (int q = 0; q < 4; ++q) { const int id = tid + NT * q, j = id & 127, e8 = (id >> 7) * 8; const u32x4 raw = *(const u32x4*)(P + (size_t)(t0 + j) * PW + C_RV + h * 128 + e8);
#pragma unroll
            for (int e = 0; e < 4; ++e) { VT[(e8 + 2 * e) * 136 + j] = (bf16_t)(raw[e] & 0xffffu); VT[(e8 + 2 * e + 1) * 136 + j] = (bf16_t)(raw[e] >> 16); } }
        const size_t sbase = (((size_t)(u >> 3) * 8 + h)) * 8192;
#pragma unroll
        for (int q = 0; q < 4; ++q) { const int id = tid + NT * q, e = id >> 4, d4 = (id & 15) * 4; st_bf4(SF + e * 72 + d4, *(const f32x4*)(STF + sbase + (size_t)e * 64 + d4)); st_bf4(SB + e * 72 + d4, *(const f32x4*)(STB + sbase + (size_t)e * 64 + d4)); }
        SYNCTHREADS();
        const int i = wv * 16 + fr; const long t = t0 + i;
        {
            f32x4 sc[8];
#pragma unroll
            for (int nt = 0; nt < 8; ++nt) sc[nt] = (f32x4){0.f, 0.f, 0.f, 0.f};
            wave_mma<2, 8>(sc, Qs + wv * 16 * 72, 72, Ks, 72);
#pragma unroll
            for (int nt = 0; nt < 8; ++nt) { const int j0 = 16 * nt + 4 * fq; f32x4 sv;
#pragma unroll
                for (int e = 0; e < 4; ++e) { const int j = j0 + e, dist = i > j ? i - j : j - i; sv[e] = sc[nt][e] * tab[64 + dist]; }
                st_bf4(Ss + i * 136 + j0, sv); }
        }
#ifdef CPU_EMU
        SYNCTHREADS();
#else
        asm volatile("s_waitcnt lgkmcnt(0)" ::: "memory");
#endif
        f32x4 ao[8], tm[8];
#pragma unroll
        for (int nt = 0; nt < 8; ++nt) { ao[nt] = (f32x4){0.f, 0.f, 0.f, 0.f}; tm[nt] = (f32x4){0.f, 0.f, 0.f, 0.f}; }
        wave_mma<4, 8>(ao, Ss + wv * 16 * 136, 136, VT, 136);
        wave_mma<2, 8>(tm, Qs + wv * 16 * 72, 72, SF, 72);
        { const float qf = tab[64 + i + 1];
#pragma unroll
            for (int nt = 0; nt < 8; ++nt) { ao[nt] += tm[nt] * qf; tm[nt] = (f32x4){0.f, 0.f, 0.f, 0.f}; } }
        wave_mma<2, 8>(tm, Qs + wv * 16 * 72, 72, SB, 72);
        { const float qb = tab[64 + 128 - i];
#pragma unroll
            for (int nt = 0; nt < 8; ++nt) ao[nt] += tm[nt] * qb; }
        float sm = 0.f;
#pragma unroll
        for (int nt = 0; nt < 8; ++nt) sm += (ao[nt][0] + ao[nt][1]) + (ao[nt][2] + ao[nt][3]);
        sm += SHFL_XOR(sm, 16); sm += SHFL_XOR(sm, 32);
        const float mu = sm * (1.f / 128.f); float sq = 0.f;
#pragma unroll
        for (int nt = 0; nt < 8; ++nt) { ao[nt] -= mu; sq += (ao[nt][0] * ao[nt][0] + ao[nt][1] * ao[nt][1]) + (ao[nt][2] * ao[nt][2] + ao[nt][3] * ao[nt][3]); }
        sq += SHFL_XOR(sq, 16); sq += SHFL_XOR(sq, 32);
        const float rs = frsq_(sq * (1.f / 128.f) + EPS);
#pragma unroll
        for (int nt = 0; nt < 8; ++nt) { const int e0 = 16 * nt + 4 * fq; f32x4 gv = ld_bf4(P + (size_t)t * PW + C_RG + h * 128 + e0);
#pragma unroll
            for (int e = 0; e < 4; ++e) gv[e] = siluf_(gv[e]) * (ao[nt][e] * rs);
            st_bf4(Y + (size_t)t * 4 * W + 1 * W + h * 128 + e0, gv); }
        SYNCTHREADS();
    }
}
__device__ __forceinline__ void ph_sgu_norm(const Ctx& c, int l) {
    const bf16_t* P = WSH(O_P); float* ST = WSF(O_VN);
    const int lane = threadIdx.x & 63, gw = blockIdx.x * (NT / 64) + (threadIdx.x >> 6), ngw = gridDim.x * (NT / 64);
    for (int t = gw; t < T; t += ngw) {
        f32x4 v[4]; float sm = 0.f;
#pragma unroll
        for (int j = 0; j < 4; ++j) { v[j] = ld_bf4(P + (size_t)t * PW + C_SV + (j * 64 + lane) * 4);
#pragma unroll
            for (int q = 0; q < 4; ++q) { v[j][q] = geluf_(v[j][q]); sm += v[j][q]; } }
        const float mu = wave_sum(sm) * (1.f / W); float sq = 0.f;
#pragma unroll
        for (int j = 0; j < 4; ++j)
#pragma unroll
            for (int q = 0; q < 4; ++q) { const float dd = v[j][q] - mu; sq += dd * dd; }
        const float rs = 1.f / sqrtf(wave_sum(sq) * (1.f / W) + EPS);
        if (lane == 0) { ST[(size_t)t * 2] = mu; ST[(size_t)t * 2 + 1] = rs; }
    }
}
__device__ __forceinline__ void ph_sgu_mix(const Ctx& c, int l, float* ldsf) {
    const bf16_t* P = WSH(O_P); const float* SG = WSF(O_HF) + (size_t)T * 32; bf16_t* Y = WSH(O_YS); const float* ng = c.in[15] + (size_t)l * W;
    bf16_t* As = (bf16_t*)ldsf; bf16_t* Bs = As + 128 * 136; const int tid = threadIdx.x, wv = tid >> 6, lane = tid & 63, fr = lane & 15, fq = lane >> 4;
    int gprev = -1;
    for (int u = blockIdx.x; u < (T / 128) * 8; u += gridDim.x) {
        const int g = u & 7; const long t0 = (long)(u >> 3) * 128;
        const float* ws = c.in[16] + ((size_t)l * 8 + g) * 128 * 128; const float* bs = c.in[17] + ((size_t)l * 8 + g) * 128;
        if (g != gprev) {
#pragma unroll
            for (int q = 0; q < 8; ++q) { const int id = tid + NT * q, i = id >> 5, j4 = (id & 31) * 4; st_bf4(As + i * 136 + j4, *(const f32x4*)(ws + i * 128 + j4)); }
            gprev = g; }
        float mu, rs;
        { const f32x4* sg = (const f32x4*)(SG + (size_t)(t0 + (tid & 127)) * 32); f32x4 a = sg[0];
#pragma unroll
          for (int i = 1; i < 8; ++i) a += sg[i];
          mu = (a[0] + a[2]) * (1.f / W); rs = frsq_(fmaxf((a[1] + a[3]) * (1.f / W) - mu * mu, 0.f) + EPS); }
#pragma unroll
        for (int q = 0; q < 4; ++q) { const int id = tid + NT * q, j = id & 127, d8 = (id >> 7) * 8;
            const u32x4 raw = *(const u32x4*)(P + (size_t)(t0 + j) * PW + C_SV + g * 128 + d8); const f32x4 n0 = *(const f32x4*)(ng + g * 128 + d8), n1 = *(const f32x4*)(ng + g * 128 + d8 + 4);
            const float ngv[8] = {n0[0], n0[1], n0[2], n0[3], n1[0], n1[1], n1[2], n1[3]};
#pragma unroll
            for (int e = 0; e < 4; ++e) { const float v0 = (geluf_(bflo(raw[e])) - mu) * rs * ngv[2 * e], v1 = (geluf_(bfhi(raw[e])) - mu) * rs * ngv[2 * e + 1];
                Bs[(d8 + 2 * e) * 136 + j] = (bf16_t)f2bf(v0); Bs[(d8 + 2 * e + 1) * 136 + j] = (bf16_t)f2bf(v1); } }
        const int i = wv * 16 + fr; const long t = t0 + i; const float bsi = bs[i];
        unsigned long long uraw[8];
#pragma unroll
        for (int nt = 0; nt < 8; ++nt) uraw[nt] = *(const unsigned long long*)(P + (size_t)t * PW + C_SU + g * 128 + 16 * nt + 4 * fq);
        SYNCTHREADS();
        f32x4 acc[8];
#pragma unroll
        for (int nt = 0; nt < 8; ++nt) acc[nt] = (f32x4){0.f, 0.f, 0.f, 0.f};
        wave_mma<4, 8>(acc, As + wv * 16 * 136, 136, Bs, 136);
#pragma unroll
        for (int nt = 0; nt < 8; ++nt) { const int d = 16 * nt + 4 * fq; const unsigned ulo = (unsigned)uraw[nt], uhi = (unsigned)(uraw[nt] >> 32); f32x4 uu = (f32x4){bflo(ulo), bfhi(ulo), bflo(uhi), bfhi(uhi)};
#pragma unroll
            for (int e = 0; e < 4; ++e) uu[e] = geluf_(uu[e]) * (acc[nt][e] + bsi);
            st_bf4(Y + (size_t)t * 4 * W + 2 * W + g * 128 + d, uu); }
        SYNCTHREADS();
    }
}
__device__ __forceinline__ void ph_rw_shift(const Ctx& c, int l) {
    const bf16_t* P = WSH(O_P); const float* mup = c.in[18] + (size_t)l * RF; const float* mun = c.in[19] + (size_t)l * RF; bf16_t* FS = WSH(O_FS);
    const int lane = threadIdx.x & 63, gw = blockIdx.x * (NT / 64) + (threadIdx.x >> 6), ngw = gridDim.x * (NT / 64);
    for (int t0 = gw * 4; t0 < T; t0 += ngw * 4) {
        const bf16_t* pc = P + (size_t)t0 * PW + C_RW;
#pragma unroll 1
        for (int j = lane * 4; j < RF; j += 256) {
            const f32x4 z4 = (f32x4){0.f, 0.f, 0.f, 0.f}; f32x4 rowv[6];
#pragma unroll
            for (int r = 0; r < 6; ++r) { const int t = t0 - 1 + r; rowv[r] = (t >= 0 && t < T) ? ld_bf4(pc + (long)(r - 1) * PW + j) : z4; }
            const f32x4 mp = *(const f32x4*)(mup + j), mn = *(const f32x4*)(mun + j);
#pragma unroll
            for (int r = 0; r < 4; ++r) { const int t = t0 + r, sI = t % S; const f32x4 f = rowv[r + 1]; const f32x4 pv = sI > 0 ? rowv[r] : z4, nv = sI < S - 1 ? rowv[r + 2] : z4;
                f32x4 v = f + mp * (pv - f) + mn * (nv - f);
                if (j >= 3072 && j < 3200) {
#pragma unroll
                    for (int e = 0; e < 4; ++e) v[e] = tanhf_(v[e]); }
                else if (j >= 3328) {
#pragma unroll
                    for (int e = 0; e < 4; ++e) v[e] = sigmoidf_(v[e]); }
                st_bf4(FS + (size_t)t * RF + j, v); }
        }
    }
}
__device__ __forceinline__ void ph_rw_lora(const Ctx& c, int l, float* ldsf) {
    const bf16_t* FS = WSH(O_FS); const float* w0 = c.in[20] + (size_t)l * 2 * W; const float* a0 = c.in[22] + (size_t)l * 2 * W;
    const bf16_t* WUT = WSH(O_WUT); const bf16_t* WAT = WSH(O_WAT); const bf16_t* WGT = WSH(O_WGT);
    bf16_t* DEC = WSH(O_DEC); bf16_t* AA = WSH(O_AA); bf16_t* GG = WSH(O_GG);
    bf16_t* F = (bf16_t*)ldsf; bf16_t* B1 = F + 128 * 136; bf16_t* B2 = B1 + 128 * 136; const int tid = threadIdx.x, wv = tid >> 6, lane = tid & 63, fr = lane & 15, fq = lane >> 4;
    unsigned long long fpre[8]; u32x4 bpre[4];
#define LORA_LOAD(uu, rdd) do { const int wc0_ = ((uu) & 7) * 128; const long t0_ = (long)((uu) >> 3) * 128; \
        _Pragma("unroll") for (int q = 0; q < 8; ++q) { const int id = tid + NT * q, r = id >> 5, c4 = (id & 31) * 4; \
            const int col = (rdd) < 2 ? (c4 < 64 ? 3072 + (rdd) * 64 + c4 : 3200 + (rdd) * 64 + (c4 - 64)) : 3328 + c4; fpre[q] = *(const unsigned long long*)(FS + (size_t)(t0_ + r) * RF + col); } \
        if ((rdd) < 2) { _Pragma("unroll") for (int q = 0; q < 2; ++q) { const int id = tid + NT * q, w = id >> 3, r8 = (id & 7) * 8; \
            bpre[2 * q] = *(const u32x4*)(WUT + ((size_t)(rdd) * W + wc0_ + w) * 64 + r8); bpre[2 * q + 1] = *(const u32x4*)(WAT + ((size_t)(rdd) * W + wc0_ + w) * 64 + r8); } } \
        else { _Pragma("unroll") for (int q = 0; q < 4; ++q) { const int id = tid + NT * q, w = id >> 4, r8 = (id & 15) * 8; bpre[q] = *(const u32x4*)(WGT + ((size_t)wc0_ + w) * 128 + r8); } } } while (0)
    if ((int)blockIdx.x < (T / 128) * 8) LORA_LOAD((int)blockIdx.x, 0);
    for (int u = blockIdx.x; u < (T / 128) * 8; u += gridDim.x) {
        const int wc0 = (u & 7) * 128; const long t0 = (long)(u >> 3) * 128;
#pragma unroll
        for (int rd = 0; rd < 3; ++rd) {
#pragma unroll
            for (int q = 0; q < 8; ++q) { const int id = tid + NT * q, r = id >> 5, c4 = (id & 31) * 4; *(unsigned long long*)(F + r * 136 + c4) = fpre[q]; }
            if (rd < 2) {
#pragma unroll
                for (int q = 0; q < 2; ++q) { const int id = tid + NT * q, w = id >> 3, r8 = (id & 7) * 8; *(u32x4*)(B1 + w * 72 + r8) = bpre[2 * q]; *(u32x4*)(B2 + w * 72 + r8) = bpre[2 * q + 1]; }
            } else {
#pragma unroll
                for (int q = 0; q < 4; ++q) { const int id = tid + NT * q, w = id >> 4, r8 = (id & 15) * 8; *(u32x4*)(B1 + w * 136 + r8) = bpre[q]; }
            }
            if (rd < 2) LORA_LOAD(u, rd + 1); else if (u + (int)gridDim.x < (T / 128) * 8) LORA_LOAD(u + (int)gridDim.x, 0);
            LDS_BARRIER();
            f32x4 a1[8], a2[8];
#pragma unroll
            for (int nt = 0; nt < 8; ++nt) { a1[nt] = (f32x4){0.f, 0.f, 0.f, 0.f}; a2[nt] = (f32x4){0.f, 0.f, 0.f, 0.f}; }
            const long t = t0 + wv * 16 + fr;
            if (rd < 2) {
                wave_mma<2, 8>(a1, F + wv * 16 * 136, 136, B1, 72);
                wave_mma<2, 8>(a2, F + wv * 16 * 136 + 64, 136, B2, 72);
#pragma unroll
                for (int nt = 0; nt < 8; ++nt) { const int ch = wc0 + 16 * nt + 4 * fq; const f32x4 w0v = *(const f32x4*)(w0 + rd * W + ch), a0v = *(const f32x4*)(a0 + rd * W + ch); f32x4 dv, av;
#pragma unroll
                    for (int e = 0; e < 4; ++e) { dv[e] = fexp_(-DECAY_SCALE * sigmoidf_(a1[nt][e] + w0v[e])); av[e] = sigmoidf_(a2[nt][e] + a0v[e]); }
                    st_bf4(DEC + ((size_t)rd * T + t) * W + ch, dv); st_bf4(AA + ((size_t)rd * T + t) * W + ch, av); }
            } else {
                wave_mma<4, 8>(a1, F + wv * 16 * 136, 136, B1, 136);
#pragma unroll
                for (int nt = 0; nt < 8; ++nt) st_bf4(GG + (size_t)t * W + wc0 + 16 * nt + 4 * fq, a1[nt]);
            }
            LDS_BARRIER();
        }
    }
}
#ifdef CPU_EMU
__device__ __forceinline__ float red16_(float x) { x += SHFL_XOR(x, 1); x += SHFL_XOR(x, 2); x += SHFL_XOR(x, 4); x += SHFL_XOR(x, 8); return x; }
__device__ __forceinline__ float red8_(float x) { x += SHFL_XOR(x, 1); x += SHFL_XOR(x, 2); x += SHFL_XOR(x, 4); return x; }
#else
__device__ __forceinline__ float red8_(float x) {
    x += __builtin_bit_cast(float, __builtin_amdgcn_update_dpp(0, __builtin_bit_cast(int, x), 0xB1, 0xF, 0xF, true));
    x += __builtin_bit_cast(float, __builtin_amdgcn_update_dpp(0, __builtin_bit_cast(int, x), 0x4E, 0xF, 0xF, true));
    x += __builtin_bit_cast(float, __builtin_amdgcn_update_dpp(0, __builtin_bit_cast(int, x), 0x141, 0xF, 0xF, true));
    return x;
}
__device__ __forceinline__ float red16_(float x) {
    x += __builtin_bit_cast(float, __builtin_amdgcn_update_dpp(0, __builtin_bit_cast(int, x), 0xB1, 0xF, 0xF, true));
    x += __builtin_bit_cast(float, __builtin_amdgcn_update_dpp(0, __builtin_bit_cast(int, x), 0x4E, 0xF, 0xF, true));
    x += __builtin_bit_cast(float, __builtin_amdgcn_update_dpp(0, __builtin_bit_cast(int, x), 0x141, 0xF, 0xF, true));
    x += __builtin_bit_cast(float, __builtin_amdgcn_update_dpp(0, __builtin_bit_cast(int, x), 0x140, 0xF, 0xF, true));
    return x;
}
#endif
#define RC_M(k) (lm + (k) * 4608)
__device__ __forceinline__ void ph_rw_chunk(const Ctx& c, int l, float* ldsf) {
    const bf16_t* FS = WSH(O_FS); const bf16_t* DEC = WSH(O_DEC); const bf16_t* AA = WSH(O_AA); float* BON = WSF(O_BON);
    const float* kkw = c.in[25] + (size_t)l * W; const float* kaw = c.in[26] + (size_t)l * W; const float* rk = c.in[27] + (size_t)l * W;
    bf16_t* PST = WSH(O_PST); bf16_t* PYT = WSH(O_PYT); bf16_t* SVB = WSH(O_SVB); bf16_t* YVB = WSH(O_YVB);
    bf16_t* lm = (bf16_t*)ldsf; float* gam = (float*)RC_M(7); float* segp = (float*)RC_M(13); float* gl = segp + 512;
    const int tid = threadIdx.x, wv = tid >> 6, lane = tid & 63, fr = lane & 15, fq = lane >> 4, rt = wv & 3, hf = wv >> 2;
    const int m0 = 16 * rt + fr;
    u32x4 wq, kq, rq, vq, aq;
#define RC_LOAD(uu) do { const int chain_ = (uu) / NRC, ck_ = (uu) % NRC, h_ = chain_ & 15, b_ = (chain_ >> 4) & 1, z_ = chain_ >> 5; \
        const long t_ = (long)b_ * S + (z_ ? S - 1 - ck_ * RCK - (tid >> 3) : ck_ * RCK + (tid >> 3)); const int ch_ = h_ * 64 + (tid & 7) * 8; \
        wq = *(const u32x4*)(DEC + ((size_t)z_ * T + t_) * W + ch_); aq = *(const u32x4*)(AA + ((size_t)z_ * T + t_) * W + ch_); \
        const bf16_t* f_ = FS + (size_t)t_ * RF; rq = *(const u32x4*)(f_ + ch_); kq = *(const u32x4*)(f_ + 1024 + ch_); vq = *(const u32x4*)(f_ + 2048 + ch_); } while (0)
    if ((int)blockIdx.x < 64 * NRC) RC_LOAD((int)blockIdx.x);
    for (int u = blockIdx.x; u < 64 * NRC; u += gridDim.x) {
        const int chain = u / NRC, ck = u % NRC, h = chain & 15, b = (chain >> 4) & 1, z = chain >> 5;
        const long tb = (long)b * S + (z ? S - 1 - ck * RCK : ck * RCK); const int dirn = z ? -1 : 1;
        const int tt = tid >> 3, o8 = (tid & 7) * 8;
        const f32x4 kw0 = *(const f32x4*)(kkw + h * 64 + o8), kw1 = *(const f32x4*)(kkw + h * 64 + o8 + 4), ka0 = *(const f32x4*)(kaw + h * 64 + o8), ka1 = *(const f32x4*)(kaw + h * 64 + o8 + 4),
                    rk0 = *(const f32x4*)(rk + h * 64 + o8), rk1 = *(const f32x4*)(rk + h * 64 + o8 + 4);
        *(f32x4*)(gam + tt * 64 + o8) = (f32x4){bflo(wq[0]), bfhi(wq[0]), bflo(wq[1]), bfhi(wq[1])};
        *(f32x4*)(gam + tt * 64 + o8 + 4) = (f32x4){bflo(wq[2]), bfhi(wq[2]), bflo(wq[3]), bfhi(wq[3])};
        LDS_BARRIER();
        { const int k = tid & 63, sg = tid >> 6; float p = 1.f;
#pragma unroll
          for (int q = 0; q < 8; ++q) { p *= gam[(sg * 8 + q) * 64 + k]; gam[(sg * 8 + q) * 64 + k] = p; }
          segp[sg * 64 + k] = p; }
        LDS_BARRIER();
        { const int k = tid & 63, sg = tid >> 6; float pre = 1.f;
          for (int q = 0; q < sg; ++q) pre *= segp[q * 64 + k];
#pragma unroll
          for (int q = 0; q < 8; ++q) gam[(sg * 8 + q) * 64 + k] *= pre;
          if (sg == 7) gl[k] = gam[63 * 64 + k]; }
        LDS_BARRIER();
        { const long t = tb + dirn * tt;
          const f32x4 g0 = *(const f32x4*)(gam + tt * 64 + o8), g1 = *(const f32x4*)(gam + tt * 64 + o8 + 4);
          f32x4 p0 = (f32x4){1.f, 1.f, 1.f, 1.f}, p1 = p0; if (tt) { p0 = *(const f32x4*)(gam + (tt - 1) * 64 + o8); p1 = *(const f32x4*)(gam + (tt - 1) * 64 + o8 + 4); }
          float gx[8], gpx[8], kwx[8], kax[8], rkx[8], kx[8], ax[8], rx[8];
#pragma unroll
          for (int e = 0; e < 4; ++e) { gx[e] = g0[e]; gx[4 + e] = g1[e]; gpx[e] = p0[e]; gpx[4 + e] = p1[e]; kwx[e] = kw0[e]; kwx[4 + e] = kw1[e]; kax[e] = ka0[e]; kax[4 + e] = ka1[e]; rkx[e] = rk0[e]; rkx[4 + e] = rk1[e];
              kx[2 * e] = bflo(kq[e]); kx[2 * e + 1] = bfhi(kq[e]); ax[2 * e] = bflo(aq[e]); ax[2 * e + 1] = bfhi(aq[e]); rx[2 * e] = bflo(rq[e]); rx[2 * e + 1] = bfhi(rq[e]); }
          float vk[8], ktv[8], ss = 0.f, bs = 0.f;
#pragma unroll
          for (int e = 0; e < 8; ++e) { vk[e] = kx[e] * kwx[e]; ss += vk[e] * vk[e]; ktv[e] = kx[e] * (1.f + (ax[e] - 1.f) * kax[e]); bs += rx[e] * rkx[e] * ktv[e]; }
          ss = red8_(ss); bs = red8_(bs);
          if ((tid & 7) == 0) BON[((size_t)z * T + t) * 16 + h] = bs;
          const float rn = frsq_(ss + EPS); float khv[8], bhv[8], k2v[8], rhv[8];
#pragma unroll
          for (int e = 0; e < 8; ++e) { const float kkn = vk[e] * rn, ig = frcp_(gx[e]); khv[e] = kkn * gpx[e]; bhv[e] = ax[e] * kkn * ig; k2v[e] = ktv[e] * ig; rhv[e] = rx[e] * gx[e]; }
          u32x4 K4, B4, C4, R4;
#pragma unroll
          for (int e = 0; e < 4; ++e) { K4[e] = pk2(khv[2 * e], khv[2 * e + 1]); B4[e] = pk2(bhv[2 * e], bhv[2 * e + 1]); C4[e] = pk2(k2v[2 * e], k2v[2 * e + 1]); R4[e] = pk2(rhv[2 * e], rhv[2 * e + 1]); }
          *(u32x4*)(RC_M(0) + tt * 72 + o8) = K4; *(u32x4*)(RC_M(2) + tt * 72 + o8) = B4; *(u32x4*)(RC_M(4) + tt * 72 + o8) = C4; *(u32x4*)(RC_M(5) + tt * 72 + o8) = R4;
#pragma unroll
          for (int e = 0; e < 8; ++e) { const int sh = 16 * (e & 1);
              RC_M(1)[(o8 + e) * 72 + tt] = (bf16_t)(K4[e >> 1] >> sh); RC_M(3)[(o8 + e) * 72 + tt] = (bf16_t)(B4[e >> 1] >> sh); RC_M(6)[(o8 + e) * 72 + tt] = (bf16_t)(vq[e >> 1] >> sh); } }
        if (u + (int)gridDim.x < 64 * NRC) RC_LOAD(u + (int)gridDim.x);
        LDS_BARRIER();
        f32x4 mkr[2], khr[2], rhT[2];
        {
            f32x4 a0[2], a1[2], a2[2], a3[2];
#pragma unroll
            for (int nt = 0; nt < 2; ++nt) { a0[nt] = (f32x4){0.f, 0.f, 0.f, 0.f}; a1[nt] = a0[nt]; a2[nt] = a0[nt]; a3[nt] = a0[nt]; }
            wave_mma<2, 2>(a0, RC_M(2) + rt * 16 * 72, 72, RC_M(0) + hf * 32 * 72, 72);
            wave_mma<2, 2>(a1, RC_M(4) + rt * 16 * 72, 72, RC_M(0) + hf * 32 * 72, 72);
            wave_mma<2, 2>(a2, RC_M(2) + rt * 16 * 72, 72, RC_M(5) + hf * 32 * 72, 72);
            wave_mma<2, 2>(a3, RC_M(4) + rt * 16 * 72, 72, RC_M(5) + hf * 32 * 72, 72);
#pragma unroll
            for (int nt = 0; nt < 2; ++nt) { const int n0 = 32 * hf + 16 * nt + 4 * fq; f32x4 nn, ti, mk;
#pragma unroll
                for (int r = 0; r < 4; ++r) { const int n = n0 + r; const bool lt = m0 < n, le = m0 <= n;
                    nn[r] = lt ? -a0[nt][r] : 0.f; ti[r] = nn[r] + (m0 == n ? 1.f : 0.f); mk[r] = lt ? a1[nt][r] : 0.f; mkr[nt][r] = le ? a3[nt][r] : 0.f;
                    RC_M(12)[n * 72 + m0] = (bf16_t)f2bf(le ? a2[nt][r] : 0.f);
                    RC_M(8)[n * 72 + m0] = (bf16_t)f2bf(nn[r]);
                    khr[nt][r] = bf2f(RC_M(4)[m0 * 72 + n]); rhT[nt][r] = bf2f(RC_M(5)[n * 72 + m0]); }
                st_bf4(RC_M(7) + m0 * 72 + n0, nn); st_bf4(RC_M(9) + m0 * 72 + n0, ti); st_bf4(RC_M(11) + m0 * 72 + n0, mk); }
        }
        LDS_BARRIER();
        f32x4 tiv[2];
#pragma unroll
        for (int nt = 0; nt < 2; ++nt) tiv[nt] = ld_bf4(RC_M(9) + m0 * 72 + 32 * hf + 16 * nt + 4 * fq);
        {
            f32x4 sq[2];
#pragma unroll
            for (int nt = 0; nt < 2; ++nt) sq[nt] = (f32x4){0.f, 0.f, 0.f, 0.f};
            wave_mma<2, 2>(sq, RC_M(7) + rt * 16 * 72, 72, RC_M(8) + hf * 32 * 72, 72);
#pragma unroll
            for (int nt = 0; nt < 2; ++nt) { const int n0 = 32 * hf + 16 * nt + 4 * fq; st_bf4(RC_M(0) + m0 * 72 + n0, sq[nt]);
#pragma unroll
                for (int r = 0; r < 4; ++r) RC_M(2)[(n0 + r) * 72 + m0] = (bf16_t)f2bf(sq[nt][r]); }
        }
        LDS_BARRIER();
#pragma unroll 1
        for (int k = 1; k <= 5; ++k) {
            bf16_t* pk = (k & 1) ? RC_M(0) : RC_M(7); bf16_t* pkT = (k & 1) ? RC_M(2) : RC_M(8); bf16_t* pn = (k & 1) ? RC_M(7) : RC_M(0); bf16_t* pnT = (k & 1) ? RC_M(8) : RC_M(2);
            bf16_t* tcur = (k & 1) ? RC_M(9) : RC_M(4); bf16_t* tnxt = (k & 1) ? RC_M(4) : RC_M(9);
            f32x4 up[2], sq[2];
#pragma unroll
            for (int nt = 0; nt < 2; ++nt) { up[nt] = (f32x4){0.f, 0.f, 0.f, 0.f}; sq[nt] = up[nt]; }
            wave_mma<2, 2>(up, tcur + rt * 16 * 72, 72, pkT + hf * 32 * 72, 72);
            if (k < 5) wave_mma<2, 2>(sq, pk + rt * 16 * 72, 72, pkT + hf * 32 * 72, 72);
#pragma unroll
            for (int nt = 0; nt < 2; ++nt) { const int n0 = 32 * hf + 16 * nt + 4 * fq; tiv[nt] += up[nt]; st_bf4(tnxt + m0 * 72 + n0, tiv[nt]);
                if (k == 5) {
#pragma unroll
                    for (int r = 0; r < 4; ++r) RC_M(10)[(n0 + r) * 72 + m0] = (bf16_t)f2bf(tiv[nt][r]);
                } else { st_bf4(pn + m0 * 72 + n0, sq[nt]);
#pragma unroll
                    for (int r = 0; r < 4; ++r) pnT[(n0 + r) * 72 + m0] = (bf16_t)f2bf(sq[nt][r]); } }
            LDS_BARRIER();
        }
        {
            f32x4 w1[2], w2[2];
#pragma unroll
            for (int nt = 0; nt < 2; ++nt) { w1[nt] = (f32x4){0.f, 0.f, 0.f, 0.f}; w2[nt] = w1[nt]; }
            wave_mma<2, 2>(w1, RC_M(1) + rt * 16 * 72, 72, RC_M(10) + hf * 32 * 72, 72);
            wave_mma<2, 2>(w2, RC_M(11) + rt * 16 * 72, 72, RC_M(10) + hf * 32 * 72, 72);
#pragma unroll
            for (int nt = 0; nt < 2; ++nt) { const int n0 = 32 * hf + 16 * nt + 4 * fq; st_bf4(RC_M(7) + m0 * 72 + n0, w1[nt]); st_bf4(RC_M(8) + m0 * 72 + n0, w2[nt]); }
        }
        LDS_BARRIER();
        {
            f32x4 py[2], qy[2], ps[2], qs[2];
#pragma unroll
            for (int nt = 0; nt < 2; ++nt) { py[nt] = (f32x4){0.f, 0.f, 0.f, 0.f}; qy[nt] = py[nt]; ps[nt] = py[nt]; qs[nt] = py[nt]; }
            wave_mma<2, 2>(py, RC_M(7) + rt * 16 * 72, 72, RC_M(12) + hf * 32 * 72, 72);
            wave_mma<2, 2>(qy, RC_M(8) + rt * 16 * 72, 72, RC_M(12) + hf * 32 * 72, 72);
            wave_mma<2, 2>(ps, RC_M(7) + rt * 16 * 72, 72, RC_M(3) + hf * 32 * 72, 72);
            wave_mma<2, 2>(qs, RC_M(8) + rt * 16 * 72, 72, RC_M(3) + hf * 32 * 72, 72);
#pragma unroll
            for (int nt = 0; nt < 2; ++nt) { const int n0 = 32 * hf + 16 * nt + 4 * fq;
#pragma unroll
                for (int r = 0; r < 4; ++r) { const int n = n0 + r; const float gln = gl[n];
                    RC_M(0)[n * 72 + m0] = (bf16_t)f2bf(rhT[nt][r] - py[nt][r]); RC_M(2)[n * 72 + m0] = (bf16_t)f2bf(mkr[nt][r] - qy[nt][r]);
                    RC_M(4)[n * 72 + m0] = (bf16_t)f2bf(((m0 == n ? 1.f : 0.f) - ps[nt][r]) * gln); RC_M(5)[n * 72 + m0] = (bf16_t)f2bf((khr[nt][r] - qs[nt][r]) * gln); } }
        }
        LDS_BARRIER();
        {
            f32x4 yv[2], sv[2];
#pragma unroll
            for (int nt = 0; nt < 2; ++nt) { yv[nt] = (f32x4){0.f, 0.f, 0.f, 0.f}; sv[nt] = yv[nt]; }
            wave_mma<2, 2>(yv, RC_M(6) + rt * 16 * 72, 72, RC_M(2) + hf * 32 * 72, 72);
            wave_mma<2, 2>(sv, RC_M(6) + rt * 16 * 72, 72, RC_M(5) + hf * 32 * 72, 72);
#pragma unroll
            for (int nt = 0; nt < 2; ++nt) { const int n0 = 32 * hf + 16 * nt + 4 * fq; st_bf4(YVB + (size_t)u * 4096 + m0 * 64 + n0, yv[nt]); st_bf4(SVB + (size_t)u * 4096 + m0 * 64 + n0, sv[nt]); }
            { const int rr = tid >> 3, c8 = (tid & 7) * 8; *(u32x4*)(PYT + (size_t)u * 4096 + rr * 64 + c8) = *(const u32x4*)(RC_M(0) + rr * 72 + c8); *(u32x4*)(PST + (size_t)u * 4096 + rr * 64 + c8) = *(const u32x4*)(RC_M(4) + rr * 72 + c8); }
        }
        LDS_BARRIER();
    }
}
#undef RC_M
#undef RC_LOAD
__device__ __forceinline__ void ph_rw_seq(const Ctx& c, float* ldsf) {
    const bf16_t* PST = WSH(O_PST); const bf16_t* PYT = WSH(O_PYT); const bf16_t* SVB = WSH(O_SVB); const bf16_t* YVB = WSH(O_YVB); bf16_t* YY = WSH(O_YY);
    bf16_t* Sb = (bf16_t*)ldsf;
    bf16_t* Pm = Sb + 2 * 16 * 72;
    const int tid = threadIdx.x, wv = tid >> 6, lane = tid & 63, fr = lane & 15, fq = lane >> 4, nt0 = wv & 3;
#ifdef CPU_EMU
    const int isY = wv >> 2;
#else
    const int isY = __builtin_amdgcn_readfirstlane(wv >> 2);
#endif
    for (int u = blockIdx.x; u < 256; u += gridDim.x) {
        const int x = u & 7, jq = u >> 3, chain = x * 8 + (jq >> 2), qt = jq & 3, h = chain & 15, b = (chain >> 4) & 1, z = chain >> 5;
        const size_t ub = (size_t)chain * NRC;
        const int rr = tid >> 3, c8 = (tid & 7) * 8;
        constexpr int PD = NRC >= 8 ? 8 : 4;
        for (int i = tid; i < 2 * 16 * 72 / 2; i += NT) ((unsigned*)Sb)[i] = 0u;
        const int row = 16 * qt + fr, n0 = 16 * nt0 + 4 * fq; const bf16_t* addp = (isY ? YVB : SVB) + ub * 4096 + row * 64 + n0;
        const bf16_t* psp = PST + ub * 4096 + rr * 64 + c8; const bf16_t* pyp = PYT + ub * 4096 + rr * 64 + c8;
        u32x4 gps[PD], gpy[PD]; unsigned long long addr[PD];
#pragma unroll
        for (int j = 0; j < PD; ++j) { gps[j] = *(const u32x4*)(psp + (size_t)j * 4096); gpy[j] = *(const u32x4*)(pyp + (size_t)j * 4096); addr[j] = *(const unsigned long long*)(addp + (size_t)j * 4096); }
        *(u32x4*)(Pm + (0 * 2 + 0) * 4608 + rr * 72 + c8) = gps[0]; *(u32x4*)(Pm + (0 * 2 + 1) * 4608 + rr * 72 + c8) = gpy[0];
        { const int cl = PD < NRC ? PD : NRC - 1; gps[0] = *(const u32x4*)(psp + (size_t)cl * 4096); gpy[0] = *(const u32x4*)(pyp + (size_t)cl * 4096); }
        SYNCTHREADS();
#define RS_LOOP(ISY) \
        for (int ck0 = 0; ck0 < NRC; ck0 += PD) { \
            _Pragma("unroll") for (int j = 0; j < PD; ++j) { \
                const int ck = ck0 + j, cur = j & 1, nxt = cur ^ 1;        \
                f32x4 acc[1]; acc[0] = (f32x4){0.f, 0.f, 0.f, 0.f}; \
                wave_mma<2, 1>(acc, Sb + cur * 16 * 72, 72, Pm + (cur * 2 + ISY) * 4608 + nt0 * 16 * 72, 72); \
                { const unsigned lo_ = (unsigned)addr[j], hi_ = (unsigned)(addr[j] >> 32); acc[0][0] += bflo(lo_); acc[0][1] += bfhi(lo_); acc[0][2] += bflo(hi_); acc[0][3] += bfhi(hi_); } \
                { const int cl = ck + PD < NRC ? ck + PD : NRC - 1; addr[j] = *(const unsigned long long*)(addp + (size_t)cl * 4096); } \
                if (ISY) { \
                    _Pragma("unroll") for (int r = 0; r < 4; ++r) { const int step = ck * RCK + n0 + r, sidx = z ? S - 1 - step : step; YY[((size_t)z * T + (size_t)b * S + sidx) * W + h * 64 + row] = (bf16_t)f2bf(acc[0][r]); } \
                } else st_bf4(Sb + nxt * 16 * 72 + fr * 72 + n0, acc[0]); \
                const int jn = (j + 1) % PD; \
                *(u32x4*)(Pm + (nxt * 2 + 0) * 4608 + rr * 72 + c8) = gps[jn]; *(u32x4*)(Pm + (nxt * 2 + 1) * 4608 + rr * 72 + c8) = gpy[jn]; \
                { const int cl = ck + 1 + PD < NRC ? ck + 1 + PD : NRC - 1; gps[jn] = *(const u32x4*)(psp + (size_t)cl * 4096); gpy[jn] = *(const u32x4*)(pyp + (size_t)cl * 4096); } \
                LDS_BARRIER(); \
            } \
        }
        if (isY) { RS_LOOP(1) } else { RS_LOOP(0) }
#undef RS_LOOP
    }
}
__device__ __forceinline__ void ph_rw_out(const Ctx& c) {
    const bf16_t* FS = WSH(O_FS); const bf16_t* YY = WSH(O_YY); const float* BON = WSF(O_BON); const bf16_t* GG = WSH(O_GG); bf16_t* Y = WSH(O_YS);
    const int lane = threadIdx.x & 63, gw = blockIdx.x * (NT / 64) + (threadIdx.x >> 6), ngw = gridDim.x * (NT / 64);
    for (int i0 = gw; i0 < T * 2; i0 += 2 * ngw) {
        u32x4 a0[2], a1[2], gq[2], vq[2]; float bs[2];
#pragma unroll
        for (int r = 0; r < 2; ++r) { const int i = i0 + r * ngw < T * 2 ? i0 + r * ngw : i0; const long t = i >> 1; const int ch = (i & 1) * 512 + lane * 8, hd = ch >> 6;
            a0[r] = *(const u32x4*)(YY + (size_t)t * W + ch); a1[r] = *(const u32x4*)(YY + ((size_t)T + t) * W + ch); gq[r] = *(const u32x4*)(GG + (size_t)t * W + ch); vq[r] = *(const u32x4*)(FS + (size_t)t * RF + 2048 + ch);
            bs[r] = BON[(size_t)t * 16 + hd] + BON[((size_t)T + t) * 16 + hd]; }
#pragma unroll
        for (int r = 0; r < 2; ++r) { const int i = i0 + r * ngw < T * 2 ? i0 + r * ngw : i0; const long t = i >> 1; const int ch = (i & 1) * 512 + lane * 8;
            float y0[8], y1[8], s0 = 0.f, s1 = 0.f;
#pragma unroll
            for (int e = 0; e < 4; ++e) { y0[2 * e] = bflo(a0[r][e]); y0[2 * e + 1] = bfhi(a0[r][e]); y1[2 * e] = bflo(a1[r][e]); y1[2 * e + 1] = bfhi(a1[r][e]); }
#pragma unroll
            for (int e = 0; e < 8; ++e) { s0 += y0[e]; s1 += y1[e]; }
            const float m0 = red8_(s0) * (1.f / 64.f), m1 = red8_(s1) * (1.f / 64.f); float q0 = 0.f, q1 = 0.f;
#pragma unroll
            for (int e = 0; e < 8; ++e) { y0[e] -= m0; y1[e] -= m1; q0 += y0[e] * y0[e]; q1 += y1[e] * y1[e]; }
            const float r0 = frsq_(red8_(q0) * (1.f / 64.f) + EPS), r1 = frsq_(red8_(q1) * (1.f / 64.f) + EPS);
            u32x4 o;
#pragma unroll
            for (int e = 0; e < 4; ++e) { const float lo = (y0[2 * e] * r0 + y1[2 * e] * r1 + bs[r] * bflo(vq[r][e])) * bflo(gq[r][e]), hi = (y0[2 * e + 1] * r0 + y1[2 * e + 1] * r1 + bs[r] * bfhi(vq[r][e])) * bfhi(gq[r][e]); o[e] = pk2(lo, hi); }
            *(u32x4*)(Y + (size_t)t * 4 * W + 3 * W + ch) = o; }
    }
}
__device__ __forceinline__ float row_rstd_(const float* ssp, long tr) { const f32x4* q = (const f32x4*)(ssp + (size_t)tr * 32); f32x4 a = q[0];
#pragma unroll
    for (int i = 1; i < 8; ++i) a += q[i];
    return frsq_(((a[0] + a[1]) + (a[2] + a[3])) * (1.f / D) + EPS); }
__device__ __forceinline__ void ph_router(const Ctx& c, int l, float* ldsf, const float* X, const float* gN, const float* shN, const float* scN) {
    const float* SSP = WSF(O_HF); bf16_t* Hn = WSH(O_H); const bf16_t* WH = WSH(O_WRH); const bf16_t* WL = WSH(O_WRL); const float* bg = c.in[31] + (size_t)l * 4; const float* be = c.in[33] + (size_t)l * 32;
    int* EID = WSI(O_EID); float* EWT = WSF(O_EWT); int* cnt = CTLW(c) + CW_CNT + l * 64;
    const int tid = threadIdx.x, wv = tid >> 6, lane = tid & 63, fr = lane & 15, fq = lane >> 4, rt = wv & 1, kq = wv >> 1;
    float* part = ldsf;
    for (int u = blockIdx.x; u < T / 32; u += gridDim.x) {
        const long t0 = (long)u * 32; f32x4 acc[3];
#pragma unroll
        for (int nt = 0; nt < 3; ++nt) acc[nt] = (f32x4){0.f, 0.f, 0.f, 0.f};
#ifdef CPU_EMU
        for (int nt = 0; nt < 3; ++nt) for (int r = 0; r < 4; ++r) { const int n = 16 * nt + 4 * fq + r; float sacc = 0.f;
            for (int k = kq * 512; k < kq * 512 + 512; ++k) { const long tr = t0 + 16 * rt + fr; const int bb = (int)(tr / S); const float hv = X[(size_t)tr * D + k] * row_rstd_(SSP, tr) * gN[k] * (1.f + scN[bb * D6 + k]) + shN[bb * D6 + k]; const float hh = bf2f((bf16_t)f2bf(hv)), hl = bf2f((bf16_t)f2bf(hv - hh));
                const float wh = bf2f(WH[(size_t)n * D + k]), wl = bf2f(WL[(size_t)n * D + k]); sacc += hh * wh + hl * wh + hh * wl; }
            acc[nt][r] = sacc; }
        if (fq == 0) for (int k = kq * 512; k < kq * 512 + 512; ++k) { const long tr = t0 + 16 * rt + fr; const int bb = (int)(tr / S); Hn[(size_t)tr * D + k] = (bf16_t)f2bf(X[(size_t)tr * D + k] * row_rstd_(SSP, tr) * gN[k] * (1.f + scN[bb * D6 + k]) + shN[bb * D6 + k]); }
#else
        const long tr = t0 + 16 * rt + fr; const int bb = (int)(tr / S); const float rsv = row_rstd_(SSP, tr); const int kb = kq * 512 + fq * 8;
        const float* hp = X + (size_t)tr * D + kb; const float* gp_ = gN + kb; const float* scp = scN + bb * D6 + kb; const float* shp = shN + bb * D6 + kb;
#pragma unroll 4
        for (int ks = 0; ks < 16; ++ks) {
            const f32x4 h0 = *(const f32x4*)(hp + ks * 32) * rsv * *(const f32x4*)(gp_ + ks * 32) * (*(const f32x4*)(scp + ks * 32) + 1.f) + *(const f32x4*)(shp + ks * 32);
            const f32x4 h1 = *(const f32x4*)(hp + ks * 32 + 4) * rsv * *(const f32x4*)(gp_ + ks * 32 + 4) * (*(const f32x4*)(scp + ks * 32 + 4) + 1.f) + *(const f32x4*)(shp + ks * 32 + 4); bf16x8 ah, al;
#pragma unroll
            for (int e = 0; e < 4; ++e) { const unsigned b0 = f2bf(h0[e]), b1 = f2bf(h1[e]); ah[e] = (short)b0; ah[4 + e] = (short)b1; al[e] = (short)f2bf(h0[e] - u2f_(b0 << 16)); al[4 + e] = (short)f2bf(h1[e] - u2f_(b1 << 16)); }
            *(bf16x8*)(Hn + (size_t)tr * D + kb + ks * 32) = ah;
#pragma unroll
            for (int nt = 0; nt < 3; ++nt) { const size_t wo = (size_t)(16 * nt + fr) * D + kq * 512 + ks * 32 + fq * 8; const bf16x8 bh = *(const bf16x8*)(WH + wo), bl = *(const bf16x8*)(WL + wo);
                acc[nt] = __builtin_amdgcn_mfma_f32_16x16x32_bf16(bh, ah, acc[nt], 0, 0, 0); acc[nt] = __builtin_amdgcn_mfma_f32_16x16x32_bf16(bh, al, acc[nt], 0, 0, 0); acc[nt] = __builtin_amdgcn_mfma_f32_16x16x32_bf16(bl, ah, acc[nt], 0, 0, 0); }
        }
#endif
#pragma unroll
        for (int nt = 0; nt < 3; ++nt) *(f32x4*)(part + (kq * 32 + 16 * rt + fr) * 48 + 16 * nt + 4 * fq) = acc[nt];
        SYNCTHREADS();
        if (tid < 32) { const long t = t0 + tid; float lg[36];
#pragma unroll
            for (int q = 0; q < 36; ++q) lg[q] = (part[(0 * 32 + tid) * 48 + q] + part[(1 * 32 + tid) * 48 + q]) + (part[(2 * 32 + tid) * 48 + q] + part[(3 * 32 + tid) * 48 + q]) + (q < 4 ? bg[q < 4 ? q : 0] : be[q >= 4 ? q - 4 : 0]);
            int gi = 0; float m = lg[0];
#pragma unroll
            for (int q = 1; q < 4; ++q) if (lg[q] > m) { m = lg[q]; gi = q; }
            float den = 0.f;
#pragma unroll
            for (int q = 0; q < 4; ++q) den += expf(lg[q] - m);
            const float gp = 1.f / den; float el[8];
#pragma unroll
            for (int q = 0; q < 8; ++q) el[q] = gi == 0 ? lg[4 + q] : gi == 1 ? lg[12 + q] : gi == 2 ? lg[20 + q] : lg[28 + q];
            int i1 = 0; float m1 = el[0];
#pragma unroll
            for (int q = 1; q < 8; ++q) if (el[q] > m1) { m1 = el[q]; i1 = q; }
            int i2 = -1; float m2 = 0.f;
#pragma unroll
            for (int q = 0; q < 8; ++q) if (q != i1 && (i2 < 0 || el[q] > m2)) { m2 = el[q]; i2 = q; }
            const float p2 = expf(m2 - m1);
            EID[t * 2] = gi * 8 + i1; EID[t * 2 + 1] = gi * 8 + i2; EWT[t * 2] = gp / (1.f + p2); EWT[t * 2 + 1] = gp * p2 / (1.f + p2);
            atomic_add_i(cnt + gi * 8 + i1, 1); atomic_add_i(cnt + gi * 8 + i2, 1);
        }
        SYNCTHREADS();
    }
}
__device__ __forceinline__ void ph_moe_assign(const Ctx& c, int l, float* ldsf) {
    const int* cnt = CTLW(c) + CW_CNT + l * 64; int* plan = CTLW(c) + CW_PLAN + l * 256; const int* EID = WSI(O_EID); int* fill = CTLW(c) + CW_FILL + l * 64; int* DEST = WSI(O_DEST); int* SRC = WSI(O_XS);
    int* pstart = (int*)ldsf;
    if (threadIdx.x == 0) { int ps = 0, nb = 0; const bool pub = blockIdx.x == 0;
        for (int e = 0; e < NE; ++e) { pstart[e] = ps; if (pub) plan[e] = ps; const int nblk = (cnt[e] + 255) / 256; if (pub) for (int q = 0; q < nblk; ++q) plan[64 + nb + q] = e; nb += nblk; ps += nblk * 256; }
        if (pub) { plan[32] = ps; plan[40] = nb; } }
    SYNCTHREADS();
    for (long i = GT_; i < (long)T * 2; i += GS_) { const int e = EID[i]; const int pos = atomic_add_i(fill + e, 1); DEST[i] = pstart[e] + pos; SRC[pstart[e] + pos] = (int)(i >> 1); }
    SYNCTHREADS();
}
__device__ __forceinline__ void ph_moe_gather(const Ctx& c) {
    const int* DEST = WSI(O_DEST); const u32x4* H = (const u32x4*)WSH(O_H); u32x4* XS = (u32x4*)WSH(O_XS);
    const long N = (long)T * 2 * (D / 8);
    for (long i0 = GT_; i0 < N; i0 += 4 * GS_) {
        u32x4 v[4]; int d[4];
#pragma unroll
        for (int r = 0; r < 4; ++r) { const long i = i0 + r * GS_ < N ? i0 + r * GS_ : i0; const long a = i / (D / 8); d[r] = DEST[a]; v[r] = H[(size_t)(a >> 1) * (D / 8) + (int)(i % (D / 8))]; }
#pragma unroll
        for (int r = 0; r < 4; ++r) { const long i = i0 + r * GS_ < N ? i0 + r * GS_ : i0; XS[(size_t)d[r] * (D / 8) + (int)(i % (D / 8))] = v[r]; }
    }
}
#ifndef CPU_EMU
#define XB_TMO      128
#define XB_XCNT(j)  (256  + 64 * (j))
#define XB_XSUB(j)  (1280 + 64 * (j))
#define XB_XGEN(j)  (2304 + 64 * (j))
#define XB_TOP      3328
#define XB_TOPGEN   3392
#define XCD_BAR_WORDS 3456
#define XB_SPIN_CAP (1u << 26)
#define LAS __attribute__((address_space(3)))
__device__ __forceinline__ unsigned xb_ld(unsigned* p)              { return __hip_atomic_load(p, __ATOMIC_RELAXED, __HIP_MEMORY_SCOPE_AGENT); }
__device__ __forceinline__ unsigned xb_add(unsigned* p, unsigned v) { return __hip_atomic_fetch_add(p, v, __ATOMIC_RELAXED, __HIP_MEMORY_SCOPE_AGENT); }
__device__ __forceinline__ unsigned xb_xcc_id() { return (unsigned)__builtin_amdgcn_s_getreg((3 << 11) | 20) & 0xFu; }
#define XB_SPIN(cond, bar) do { unsigned _sp = 0; while (cond) { __builtin_amdgcn_s_sleep(1); \
    if ((++_sp & 255u) == 0u) { if (xb_ld(&(bar)[XB_TMO])) break; if (_sp > XB_SPIN_CAP) { atomicAdd(&(bar)[XB_TMO], 1u); break; } } } } while (0)
struct XcdBarrier { unsigned* bar; unsigned x; volatile LAS unsigned* st; };
__device__ __forceinline__ XcdBarrier xcd_barrier_post(unsigned* bar, volatile LAS unsigned* st) {
    XcdBarrier b; b.bar = bar; b.x = xb_xcc_id(); b.st = st;
    if (threadIdx.x == 0) (void)xb_add(&bar[XB_XCNT(b.x)], 1u);
    return b;
}
__device__ __forceinline__ void xcd_barrier_complete(unsigned* bar, unsigned x, unsigned& nloc, unsigned& nx) {
    const unsigned G = gridDim.x * gridDim.y * gridDim.z;
    unsigned sum, cnt, mine, sp = 0u;
    for (;;) {
        sum = 0u; cnt = 0u; mine = 0u;
#pragma unroll
        for (unsigned j = 0; j < 16; ++j) { const unsigned cc = xb_ld(&bar[XB_XCNT(j)]); sum += cc; cnt += (cc > 0u) ? 1u : 0u; mine = (j == x) ? cc : mine; }
        if (sum == G) break;
        __builtin_amdgcn_s_sleep(1);
        if ((++sp & 255u) == 0u) { if (xb_ld(&bar[XB_TMO])) break; if (sp > XB_SPIN_CAP) { atomicAdd(&bar[XB_TMO], 1u); break; } }
    }
    nloc = mine > 0u ? mine : 1u; nx = cnt > 0u ? cnt : 1u;
}
__device__ __forceinline__ void xcd_barrier(const XcdBarrier& b) {
    asm volatile("s_waitcnt vmcnt(0)" ::: "memory");
    __syncthreads();
    if (threadIdx.x == 0) {
        unsigned* bar = b.bar;
        __builtin_amdgcn_s_waitcnt(0);
        unsigned nloc = b.st[0], nx = b.st[1];
        if (nloc == 0u) { xcd_barrier_complete(bar, b.x, nloc, nx); b.st[0] = nloc; b.st[1] = nx; }
        const unsigned old = xb_add(&bar[XB_XSUB(b.x)], 1u);
        const unsigned gen = old / nloc;
        if (old + 1u == (gen + 1u) * nloc) {
            __builtin_amdgcn_fence(__ATOMIC_RELEASE, "agent");
            asm volatile("s_waitcnt vmcnt(0)" ::: "memory");
            const unsigned og = xb_add(&bar[XB_TOP], 1u);
            const unsigned tg = og / nx;
            if (og + 1u == (tg + 1u) * nx) xb_add(&bar[XB_TOPGEN], 1u);
            else XB_SPIN(xb_ld(&bar[XB_TOPGEN]) == tg, bar);
            __builtin_amdgcn_fence(__ATOMIC_ACQUIRE, "agent");
            xb_add(&bar[XB_XGEN(b.x)], 1u);
            asm volatile("s_waitcnt vmcnt(0)" ::: "memory");
        } else {
            XB_SPIN(xb_ld(&bar[XB_XGEN(b.x)]) == gen, bar);
            __builtin_amdgcn_fence(__ATOMIC_ACQUIRE, "agent");
            asm volatile("s_waitcnt vmcnt(0)" ::: "memory");
        }
    }
    __syncthreads();
}
#endif

constexpr int LDS_BYTES = 147456;

__global__ void __launch_bounds__(NT, 2) fwd(Params p) {
#ifdef CPU_EMU
    unsigned char* lds = g_lds; float* ldsf = (float*)g_lds;
#else
    extern __shared__ __attribute__((aligned(16))) unsigned char lds[];
    float* ldsf = (float*)lds;
    volatile LAS unsigned* misc = (volatile LAS unsigned*)((LAS unsigned char*)lds + LDS_BYTES - 64);
    if (threadIdx.x == 0) { misc[0] = 0u; misc[1] = 0u; }
    __syncthreads();
    XcdBarrier bar = xcd_barrier_post((unsigned*)(p.ws + O_CTL) + CW_BAR, misc);
#endif
    Ctx c; c.in = p.in; c.out = p.out; c.ws = p.ws;
    const int lo = p.ph_lo, hi = p.ph_hi; int ph = 0;
    const int G = (int)gridDim.x, cwg = (int)blockIdx.x;
#ifdef CPU_EMU
#define GRID_BAR()
#else
#define GRID_BAR() xcd_barrier(bar)
#endif
#ifndef REPEAT_MASK
#define REPEAT_MASK 0
#endif
#ifndef TIME_PHASE
#define TIME_PHASE -1
#endif
#if TIME_PHASE >= 0 && !defined(CPU_EMU)
    unsigned long long tp0 = 0, tp1 = 0;
#define TP_BEGIN() do { if (ph == TIME_PHASE) tp0 = __builtin_amdgcn_s_memrealtime(); } while (0)
#define TP_END() do { if (ph == TIME_PHASE) tp1 = __builtin_amdgcn_s_memrealtime(); } while (0)
#else
#define TP_BEGIN()
#define TP_END()
#endif
#define PHASE(...) do { if (lo <= ph && ph < hi) { TP_BEGIN(); __VA_ARGS__; if (ph + 1 < hi) { GRID_BAR(); } TP_END(); } ++ph; } while (0)
#define PHASEG(grp, ...) do { if (lo <= ph && ph < hi) { TP_BEGIN(); if ((REPEAT_MASK >> (grp)) & 1) { __VA_ARGS__; GRID_BAR(); } __VA_ARGS__; if (ph + 1 < hi) { GRID_BAR(); } TP_END(); } ++ph; } while (0)
    PHASE(ph_mod(c, ldsf); ph_rope_table(c); ph_convert(c, 0, ldsf));
#define LAYER_BODY(l) do { const float* mod = WSF(O_MOD); \
        const float* xin = l == 0 ? c.in[0] : WSF(O_X1); float* xmid = WSF(O_X0); float* xout = WSF(O_X1); \
        const float* ml = mod + (size_t)l * NB * D6; \
        PHASEG(0, { pg8::Gemm g{D, D, D}; pg8::StaticOrder so; so.init(T, PW, G, cwg, WSH(O_H), WSH(O_WIN), D, D); pg8::EpiP E{WSH(O_P), (unsigned char*)(c.ws + O_G8), WSF(O_HF) + (size_t)T * 32}; pg8::gemm_phase(lds, g, so, E); \
            { const int nun_ = (T / 256) * (PW / 256), rem_ = nun_ % G; if (rem_ != 0 && cwg >= rem_) { SYNCTHREADS(); convert_big(c, l, ldsf, J_ALL - convert_tail_tiles(), J_ALL, cwg - rem_, G - rem_); } } }); \
        PHASE(ph_lru<1>(c, l, ldsf); ph_ret_kv(c, ldsf); ph_rw_shift(c, l)); \
        PHASE(ph_lru_scan2(c); ph_ret_state(c); ph_sgu_mix(c, l, ldsf); ph_rw_lora(c, l, ldsf)); \
        PHASE(ph_lru_fin(c, ldsf); ph_ret_out(c, ldsf); ph_rw_chunk(c, l, ldsf)); \
        PHASE(ph_rw_seq(c, ldsf)); \
        PHASE(ph_rw_out(c)); \
        PHASEG(1, { pg8::Gemm g{4 * W, 4 * W, 4 * W}; pg8::StaticOrder so; so.init(T, D, G, cwg, WSH(O_YS), WSH(O_WBR), 4 * W, 4 * W); pg8::EpiMerge E{(const unsigned char*)(c.ws + O_G8), WSH(O_MRG)}; pg8::gemm_phase(lds, g, so, E); }); \
        PHASEG(1, { pg8::Gemm g{D, D, D}; pg8::StaticOrder so; so.init(T, D, G, cwg, WSH(O_MRG), WSH(O_WOUT), D, D); pg8::EpiResid E{xin, ml + 2 * D, xmid, WSF(O_HF)}; pg8::gemm_phase(lds, g, so, E); }); \
        PHASE(ph_router(c, l, ldsf, xmid, c.in[4] + (size_t)l * D, ml + 3 * D, ml + 4 * D)); \
        PHASE(ph_moe_assign(c, l, ldsf)); \
        const int* plan = CTLW(c) + CW_PLAN + l * 256; \
        PHASEG(2, { pg8::Gemm g{D, D, D}; pg8::MoeGatherOrder mo{G, cwg, 4, plan, (const char*)WSH(O_H), (const char*)WSH(O_WGU), (size_t)256 * D * 2, (size_t)1024 * D * 2, WSI(O_XS), T}; pg8::EpiGU E{WSH(O_ACT)}; pg8::gemm_phase(lds, g, mo, E); \
            if (l == 0) { const int nrest_ = plan[40] * 4 - G; if (nrest_ >= 0 && nrest_ < G && cwg >= nrest_) { SYNCTHREADS(); convert_big(c, 1, ldsf, 0, convert_early_tiles(c), cwg - nrest_, G - nrest_); } } }); \
        PHASEG(2, { pg8::Gemm g{512, 512, 512}; pg8::MoeOrder mo{G, cwg, 8, plan, (const char*)WSH(O_ACT), (const char*)WSH(O_WDN), (size_t)256 * 512 * 2, (size_t)256 * 512 * 2, (size_t)D * 512 * 2}; pg8::EpiBf16 E{WSH(O_YE), D}; pg8::gemm_phase(lds, g, mo, E); }); \
        if (l == 0) PHASE(ph_comb_norm<0>(c, xmid, ml + 5 * D, xout, c.in[3] + (size_t)1 * D, mod + (size_t)1 * NB * D6 + 0 * D, mod + (size_t)1 * NB * D6 + 1 * D, WSH(O_H), nullptr); ph_convert(c, 1, ldsf)); \
        else PHASE(ph_comb_norm<1>(c, xmid, ml + 5 * D, xout, c.in[36], nullptr, nullptr, nullptr, c.out)); \
    } while (0)
    PHASE(ph_norm(c, c.in[0], c.in[3], WSF(O_MOD) + 0 * D, WSF(O_MOD) + 1 * D, WSH(O_H), nullptr));
    LAYER_BODY(0);
    LAYER_BODY(1);
#undef LAYER_BODY
#if TIME_PHASE >= 0 && !defined(CPU_EMU)
    if (blockIdx.x == 0) { const unsigned long long te = __builtin_amdgcn_s_memrealtime(), dl = 8ull * (tp1 - tp0); while (__builtin_amdgcn_s_memrealtime() - te < dl) __builtin_amdgcn_s_sleep(8); }
#endif
#undef PHASE
}
}

#ifndef CPU_EMU
extern "C" void kernel_launch(void* const* d_in, const int* in_sizes, int n_in, void* d_out, int out_size, void* d_ws, size_t ws_size, hipStream_t stream) {
    static int grid = 0;
    if (grid == 0) {
        if (n_in != 37 || out_size != T * D || ws_size < WS_END) { fprintf(stderr, "kernel_launch: unexpected shapes (n_in %d out %d ws %zu need %zu)\n", n_in, out_size, ws_size, (size_t)WS_END); grid = -1; return; }
        int dev = 0, cus = 0, per_cu = 0;
        if (hipGetDevice(&dev) != hipSuccess || hipDeviceGetAttribute(&cus, hipDeviceAttributeMultiprocessorCount, dev) != hipSuccess) { grid = -1; return; }
        if (hipFuncSetAttribute((const void*)fwd, hipFuncAttributeMaxDynamicSharedMemorySize, LDS_BYTES) != hipSuccess) { fprintf(stderr, "kernel_launch: hipFuncSetAttribute failed\n"); grid = -1; return; }
        if (hipOccupancyMaxActiveBlocksPerMultiprocessor(&per_cu, (const void*)fwd, NT, LDS_BYTES) != hipSuccess || per_cu < 1) fprintf(stderr, "kernel_launch: occupancy query says %d\n", per_cu);
        (void)hipGetLastError();
        grid = cus;
    }
    if (grid < 0) return;
    (void)in_sizes;
    (void)hipMemsetAsync((char*)d_ws + O_CTL, 0, CTL_BYTES, stream);
    Params p{};
    for (int i = 0; i < 37; ++i) p.in[i] = (const float*)d_in[i];
    p.out = (float*)d_out; p.ws = (unsigned char*)d_ws;
#if ONE_LAUNCH
    p.ph_lo = 0; p.ph_hi = NPH;
    hipLaunchKernelGGL(fwd, dim3(grid), dim3(NT), LDS_BYTES, stream, p);
#else
    for (int k = 0; k < NPH; ++k) { p.ph_lo = k; p.ph_hi = k + 1; hipLaunchKernelGGL(fwd, dim3(grid), dim3(NT), LDS_BYTES, stream, p); }
#endif
}
#endif
```

```cpp
#ifndef CPU_EMU
#include <hip/hip_runtime.h>
#endif
#include <cstdio>
#include <cstdint>
#include <cmath>
#include <cstring>

#ifndef SEQ
#define SEQ 4096
#endif
#ifndef ONE_LAUNCH
#define ONE_LAUNCH 1
#endif

namespace {
constexpr int D = 2048, NB = 2, S = SEQ, T = NB * S, NL = 2, W = 1024;
constexpr int INW = 18816, RF = 3456, D6 = 6 * D;
constexpr int C_LX = 0, C_LG = 1024, C_RQ = 2048, C_RK = 2560, C_RV = 3072, C_RG = 4096, C_SU = 5120, C_SV = 6144, C_RW = 7168;
constexpr int PW = 18944, C_MLP = 10752;
constexpr int NCH = S / 128;
constexpr int NLC = S / 64;
constexpr int NE = 32, CAP = (T * 2 / 256 + NE) * 256, MAXBLK = CAP / 256;
constexpr float EPS = 1e-6f;
constexpr float DECAY_SCALE = 0.60653065971263342f;
constexpr int NT = 512;
constexpr int NPH_LAYER = 13, NPH = 2 + NL * NPH_LAYER;
typedef unsigned short bf16_t;
#ifdef CPU_EMU
typedef float f32x4 __attribute__((vector_size(16)));
typedef unsigned u32x4 __attribute__((vector_size(16)));
#else
typedef float f32x4 __attribute__((ext_vector_type(4)));
typedef unsigned u32x4 __attribute__((ext_vector_type(4)));
typedef short bf16x8 __attribute__((ext_vector_type(8)));
#endif

constexpr size_t al256(size_t x) { return (x + 255) & ~(size_t)255; }
constexpr size_t SZ_X = (size_t)T * D * 4, SZ_W = (size_t)T * W * 4;
constexpr size_t O_CTL = 0, CTL_BYTES = 1u << 20;
constexpr size_t O_MOD = CTL_BYTES;
constexpr size_t O_X0 = O_MOD + al256((size_t)NL * NB * D6 * 4);
constexpr size_t O_X1 = O_X0 + SZ_X;
constexpr size_t O_H = O_X1 + SZ_X;
constexpr size_t O_HF = O_H + SZ_X / 2;
constexpr size_t O_P = O_HF + SZ_X;
constexpr size_t SZ_P = (size_t)T * PW * 2;
constexpr size_t O_XC = O_P + SZ_P;
constexpr size_t O_LA = O_XC + SZ_W, O_LU = O_LA + 2 * SZ_W;
constexpr size_t SZ_LC = (size_t)2 * NB * NLC * W * 4;
constexpr size_t O_LCA = O_LU + 2 * SZ_W, O_LCH = O_LCA + SZ_LC, O_LCI = O_LCH + SZ_LC;
constexpr size_t O_YS = O_LCI + SZ_LC;
constexpr size_t O_SC = O_YS + (size_t)T * 4 * W * 2;
constexpr size_t SZ_KV = (size_t)NB * NCH * 8 * 64 * 128 * 4;
constexpr size_t O_KVF = O_SC, O_KVB = O_KVF + SZ_KV, O_STF = O_KVB + SZ_KV, O_STB = O_STF + SZ_KV;
constexpr size_t O_VN = O_STB + SZ_KV;
constexpr size_t O_FS = O_VN + SZ_W;
constexpr size_t O_DEC = O_FS + al256((size_t)T * RF * 4), O_AA = O_DEC + 2 * SZ_W, O_AKK = O_AA + 2 * SZ_W;
constexpr size_t O_GG = O_AKK, O_YY = O_GG + SZ_W;
constexpr int RCK = 64, NRC = S / RCK;
constexpr size_t O_BON = O_YY + 2 * SZ_W;
constexpr size_t O_PART = O_BON + al256((size_t)2 * T * 16 * 4);
constexpr size_t O_MRG = O_PART + SZ_X;
constexpr size_t O_LOG = O_MRG + SZ_X / 2;
constexpr size_t O_EID = O_LOG + al256((size_t)T * 40 * 4), O_EWT = O_EID + al256((size_t)T * 2 * 4), O_DEST = O_EWT + al256((size_t)T * 2 * 4);
constexpr size_t O_SLOT = O_DEST + al256((size_t)T * 2 * 4);
constexpr size_t O_PST = O_SLOT + al256((size_t)CAP * 4), O_PYT = O_PST + (size_t)64 * NRC * 4096 * 2, O_SVB = O_PYT + (size_t)64 * NRC * 4096 * 2, O_YVB = O_SVB + (size_t)64 * NRC * 4096 * 4;
constexpr size_t O_WIN = O_YVB + (size_t)64 * NRC * 4096 * 4;
constexpr size_t O_WBR = O_WIN + (size_t)PW * D * 2;
constexpr size_t O_WOUT = O_WBR + (size_t)D * 4 * W * 2;
constexpr size_t O_WGU = O_WOUT + (size_t)D * D * 2;
constexpr size_t O_WDN = O_WGU + (size_t)NE * 1024 * D * 2;
constexpr size_t O_G8 = O_WDN + (size_t)NE * D * 512 * 2;
constexpr size_t O_ROPE = O_G8 + (size_t)T * 4 * D;
constexpr size_t O_WLR = O_ROPE + (size_t)T * 64 * 4;
constexpr size_t O_WUT = O_WLR + (size_t)32 * 128 * 128 * 2;
constexpr size_t O_WAT = O_WUT + (size_t)2 * W * 64 * 2;
constexpr size_t O_WGT = O_WAT + (size_t)2 * W * 64 * 2;
constexpr size_t O_WRH = O_WGT + (size_t)W * 128 * 2;
constexpr size_t O_WRL = O_WRH + (size_t)48 * D * 2;
constexpr size_t WS_END0 = O_WRL + (size_t)48 * D * 2;
constexpr size_t SZ_MOE = (size_t)CAP * (D + 512 + D) * 2;
constexpr bool MOE_OVERLAY = SZ_MOE <= SZ_P;
constexpr size_t O_XS = MOE_OVERLAY ? O_P : WS_END0;
constexpr size_t O_ACT = O_XS + (size_t)CAP * D * 2;
constexpr size_t O_YE = O_ACT + (size_t)CAP * 512 * 2;
constexpr size_t WS_END = MOE_OVERLAY ? WS_END0 : WS_END0 + SZ_MOE;
static_assert(SEQ != 4096 || WS_END <= (size_t)2040 * 1024 * 1024, "workspace budget: d_ws is 4 x the largest input = 2048 MiB");
constexpr int CW_BAR = 4096;
constexpr int CW_CNT = 32768;
constexpr int CW_FILL = CW_CNT + NL * 64;
constexpr int CW_PLAN = CW_FILL + NL * 64;
static_assert(MAXBLK <= 160, "plan words");

struct Params { const float* in[37]; float* out; unsigned char* ws; int ph_lo, ph_hi; };

struct Ctx { const float* const* in; float* out; unsigned char* ws; };
#define GT_ ((long)blockIdx.x * NT + threadIdx.x)
#define GS_ ((long)gridDim.x * NT)
#define WSF(off) ((float*)(c.ws + (off)))
#define WSI(off) ((int*)(c.ws + (off)))
#define WSH(off) ((bf16_t*)(c.ws + (off)))
#define CTLW(c) ((int*)((c).ws + O_CTL))

#ifdef CPU_EMU
__device__ __forceinline__ float fexp_(float x) { return expf(x); }
__device__ __forceinline__ float frcp_(float x) { return 1.f / x; }
__device__ __forceinline__ float frsq_(float x) { return 1.f / sqrtf(x); }
__device__ __forceinline__ float fsqrt_(float x) { return sqrtf(x); }
#else
__device__ __forceinline__ float fexp_(float x) { return __builtin_amdgcn_exp2f(x * 1.4426950408889634f); }
__device__ __forceinline__ float frcp_(float x) { return __builtin_amdgcn_rcpf(x); }
__device__ __forceinline__ float frsq_(float x) { return __builtin_amdgcn_rsqf(x); }
__device__ __forceinline__ float fsqrt_(float x) { return __builtin_amdgcn_sqrtf(x); }
#endif
__device__ __forceinline__ float sigmoidf_(float x) { return frcp_(1.f + fexp_(-x)); }
__device__ __forceinline__ float siluf_(float x) { return x * frcp_(1.f + fexp_(-x)); }
__device__ __forceinline__ float tanhf_(float x) { return 1.f - 2.f * frcp_(1.f + fexp_(2.f * x)); }
#ifdef CPU_EMU
__device__ __forceinline__ float geluf_(float x) { return 0.5f * x * (1.f + tanhf_(0.7978845608028654f * (x + 0.044715f * x * x * x))); }
#else
__device__ __forceinline__ float geluf_(float x) { return x * __builtin_amdgcn_rcpf(1.f + __builtin_amdgcn_exp2f(-x * (2.3022082f + 0.10294324f * x * x))); }
#endif
__device__ __forceinline__ float softplusf_(float x) { return x > 0.f ? x + log1pf(expf(-x)) : log1pf(expf(x)); }
__device__ __forceinline__ float loggamma_(int h) { return log1pf(-exp2f(-5.f - (float)h)); }
__device__ __forceinline__ unsigned f2u_(float f) { unsigned u; memcpy(&u, &f, 4); return u; }
__device__ __forceinline__ float u2f_(unsigned u) { float f; memcpy(&f, &u, 4); return f; }
__device__ __forceinline__ float bf2f(bf16_t v) { return u2f_((unsigned)v << 16); }
#ifdef CPU_EMU
__device__ __forceinline__ unsigned f2bf(float f) { const unsigned u = f2u_(f); return (u + 0x7fffu + ((u >> 16) & 1u)) >> 16; }
__device__ __forceinline__ unsigned pk2(float lo, float hi) { return f2bf(lo) | (f2bf(hi) << 16); }
#else
typedef __attribute__((ext_vector_type(2))) __bf16 hwbf2_t; typedef __attribute__((ext_vector_type(2))) float hwf2_t;
__device__ __forceinline__ unsigned f2bf(float f) { const __bf16 s = (__bf16)f; return (unsigned)__builtin_bit_cast(unsigned short, s); }
__device__ __forceinline__ unsigned pk2(float lo, float hi) { const hwf2_t v = {lo, hi}; return __builtin_bit_cast(unsigned, __builtin_convertvector(v, hwbf2_t)); }
#endif
__device__ __forceinline__ float bflo(unsigned w) { return u2f_(w << 16); }
__device__ __forceinline__ float bfhi(unsigned w) { return u2f_(w & 0xffff0000u); }
__device__ __forceinline__ int atomic_add_i(int* p, int v) {
#ifdef CPU_EMU
    return __atomic_fetch_add(p, v, __ATOMIC_RELAXED);
#else
    return atomicAdd(p, v);
#endif
}
#define PF(P, r, col) bf2f((P)[(size_t)(r) * PW + (col)])
#ifdef CPU_EMU
#define SYNCTHREADS() emu_syncthreads()
#define LDS_BARRIER() emu_syncthreads()
#define SHFL_XOR(v, m) emu_shfl_xor(v, m)
#else
#define SYNCTHREADS() __syncthreads()
#define LDS_BARRIER() do { asm volatile("s_waitcnt lgkmcnt(0)" ::: "memory"); __builtin_amdgcn_s_barrier(); asm volatile("" ::: "memory"); } while (0)
#define SHFL_XOR(v, m) __shfl_xor(v, m)
#endif
#ifdef CPU_EMU
__device__ __forceinline__ float wave_sum(float v) {
    for (int o = 1; o < 64; o <<= 1) v += SHFL_XOR(v, o);
    return v;
}
#else
__device__ __forceinline__ float wave_sum(float x) {
    x += __builtin_bit_cast(float, __builtin_amdgcn_update_dpp(0, __builtin_bit_cast(int, x), 0xB1, 0xF, 0xF, true));
    x += __builtin_bit_cast(float, __builtin_amdgcn_update_dpp(0, __builtin_bit_cast(int, x), 0x4E, 0xF, 0xF, true));
    x += __builtin_bit_cast(float, __builtin_amdgcn_update_dpp(0, __builtin_bit_cast(int, x), 0x141, 0xF, 0xF, true));
    x += __builtin_bit_cast(float, __builtin_amdgcn_update_dpp(0, __builtin_bit_cast(int, x), 0x140, 0xF, 0xF, true));
    const int xi = __builtin_bit_cast(int, x);
    return (__builtin_bit_cast(float, __builtin_amdgcn_readlane(xi, 0)) + __builtin_bit_cast(float, __builtin_amdgcn_readlane(xi, 16))) + (__builtin_bit_cast(float, __builtin_amdgcn_readlane(xi, 32)) + __builtin_bit_cast(float, __builtin_amdgcn_readlane(xi, 48)));
}
#endif
__device__ __forceinline__ f32x4 ld_bf4(const bf16_t* p) { const unsigned long long q = *(const unsigned long long*)p; const unsigned lo = (unsigned)q, hi = (unsigned)(q >> 32); return (f32x4){bflo(lo), bfhi(lo), bflo(hi), bfhi(hi)}; }
__device__ __forceinline__ void st_bf4(bf16_t* p, const f32x4 v) { *(unsigned long long*)p = (unsigned long long)pk2(v[0], v[1]) | ((unsigned long long)pk2(v[2], v[3]) << 32); }

template <int KT, int NTL>
__device__ __forceinline__ void wave_mma(f32x4 (&acc)[NTL], const bf16_t* A, int lda, const bf16_t* Bt, int ldb) {
    const int lane = threadIdx.x & 63, fr = lane & 15, fq = lane >> 4;
#ifdef CPU_EMU
    for (int nt = 0; nt < NTL; ++nt) for (int r = 0; r < 4; ++r) { float sacc = 0.f; const bf16_t* a = A + fr * lda; const bf16_t* b = Bt + (16 * nt + 4 * fq + r) * ldb;
        for (int k = 0; k < 32 * KT; ++k) sacc += bf2f(a[k]) * bf2f(b[k]);
        acc[nt][r] += sacc; }
#else
#pragma unroll
    for (int kt = 0; kt < KT; ++kt) {
        const bf16x8 af = *(const bf16x8*)(A + fr * lda + kt * 32 + fq * 8);
#pragma unroll
        for (int nt = 0; nt < NTL; ++nt) { const bf16x8 bfr = *(const bf16x8*)(Bt + (16 * nt + fr) * ldb + kt * 32 + fq * 8);
            acc[nt] = __builtin_amdgcn_mfma_f32_16x16x32_bf16(bfr, af, acc[nt], 0, 0, 0); }
    }
#endif
}
__device__ __forceinline__ void ph_mod(const Ctx& c, float* ldsf) {
    const float* cc = c.in[1]; const float* aw = c.in[5]; const float* ab = c.in[6]; float* mod = WSF(O_MOD);
    float* scs = ldsf; float* part = ldsf + NB * D; const int tid = threadIdx.x, c4 = (tid & 31) * 4, kq = tid >> 5;
    for (int i = tid; i < NB * D; i += NT) scs[i] = siluf_(cc[i]);
    SYNCTHREADS();
    for (int u = blockIdx.x; u < NL * (D6 / 128); u += gridDim.x) {
        const int l = u / (D6 / 128), j0 = (u % (D6 / 128)) * 128;
        const float* w = aw + (size_t)l * D * D6 + j0 + c4; f32x4 a0 = (f32x4){0.f, 0.f, 0.f, 0.f}, a1 = a0;
#pragma unroll 8
        for (int k = kq * 128; k < kq * 128 + 128; ++k) { const f32x4 wv = *(const f32x4*)(w + (size_t)k * D6); a0 += wv * scs[k]; a1 += wv * scs[D + k]; }
        *(f32x4*)(part + (kq * 2 + 0) * 128 + c4) = a0; *(f32x4*)(part + (kq * 2 + 1) * 128 + c4) = a1;
        SYNCTHREADS();
        if (tid < 256) { const int b = tid >> 7, col = tid & 127; float sacc = 0.f;
#pragma unroll
            for (int q = 0; q < 16; ++q) sacc += part[(q * 2 + b) * 128 + col];
            mod[((size_t)l * NB + b) * D6 + j0 + col] = sacc + ab[l * D6 + j0 + col]; }
        SYNCTHREADS();
    }
}
__device__ __forceinline__ void ph_norm(const Ctx& c, const float* x, const float* g, const float* sh, const float* sc, bf16_t* hb, float* hf) {
    const int lane = threadIdx.x & 63, gw = blockIdx.x * (NT / 64) + (threadIdx.x >> 6), ngw = gridDim.x * (NT / 64);
    for (int t0 = gw * 2; t0 < T; t0 += ngw * 2) {
        f32x4 v[2][8]; float ss[2] = {0.f, 0.f};
#pragma unroll
        for (int r = 0; r < 2; ++r)
#pragma unroll
            for (int j = 0; j < 8; ++j) v[r][j] = *(const f32x4*)(x + (size_t)(t0 + r) * D + (j * 64 + lane) * 4);
#pragma unroll
        for (int r = 0; r < 2; ++r) {
#pragma unroll
            for (int j = 0; j < 8; ++j) ss[r] += (v[r][j][0] * v[r][j][0] + v[r][j][1] * v[r][j][1]) + (v[r][j][2] * v[r][j][2] + v[r][j][3] * v[r][j][3]);
            const int t = t0 + r, b = t / S; const float rs = 1.f / sqrtf(wave_sum(ss[r]) * (1.f / D) + EPS);
#pragma unroll
            for (int j = 0; j < 8; ++j) { const int col = (j * 64 + lane) * 4;
                const f32x4 o = v[r][j] * rs * *(const f32x4*)(g + col) * (*(const f32x4*)(sc + b * D6 + col) + 1.f) + *(const f32x4*)(sh + b * D6 + col);
                st_bf4(hb + (size_t)t * D + col, o); }
            if (hf && lane == 0) hf[t] = rs;
        }
    }
}
template <int MODE>
__device__ __forceinline__ void ph_comb_norm(const Ctx& c, const float* xmid, const float* g2, float* xout, const float* g, const float* sh, const float* sc, bf16_t* hb, float* outp) {
    const bf16_t* YE = WSH(O_YE); const float* EWT = WSF(O_EWT); const int* DEST = WSI(O_DEST);
    const int lane = threadIdx.x & 63, gw = blockIdx.x * (NT / 64) + (threadIdx.x >> 6), ngw = gridDim.x * (NT / 64);
    float w0n = 0.f, w1n = 0.f; int d0n = 0, d1n = 0;
    if (gw < T) { w0n = EWT[gw * 2]; w1n = EWT[gw * 2 + 1]; d0n = DEST[gw * 2]; d1n = DEST[gw * 2 + 1]; }
    for (int t = gw; t < T; t += ngw) {
        const int b = t / S; const float w0 = w0n, w1 = w1n; const bf16_t* y0 = YE + (size_t)d0n * D; const bf16_t* y1 = YE + (size_t)d1n * D;
        if (t + ngw < T) { const int tn = t + ngw; w0n = EWT[tn * 2]; w1n = EWT[tn * 2 + 1]; d0n = DEST[tn * 2]; d1n = DEST[tn * 2 + 1]; }
        f32x4 v[8]; float ss = 0.f;
#pragma unroll
        for (int j = 0; j < 8; ++j) { const int col = (j * 64 + lane) * 4;
            v[j] = *(const f32x4*)(xmid + (size_t)t * D + col) + *(const f32x4*)(g2 + b * D6 + col) * (ld_bf4(y0 + col) * w0 + ld_bf4(y1 + col) * w1);
            if (MODE == 0) *(f32x4*)(xout + (size_t)t * D + col) = v[j];
            ss += (v[j][0] * v[j][0] + v[j][1] * v[j][1]) + (v[j][2] * v[j][2] + v[j][3] * v[j][3]); }
        const float rs = 1.f / sqrtf(wave_sum(ss) * (1.f / D) + EPS);
#pragma unroll
        for (int j = 0; j < 8; ++j) { const int col = (j * 64 + lane) * 4;
            if (MODE == 0) st_bf4(hb + (size_t)t * D + col, v[j] * rs * *(const f32x4*)(g + col) * (*(const f32x4*)(sc + b * D6 + col) + 1.f) + *(const f32x4*)(sh + b * D6 + col));
            else *(f32x4*)(outp + (size_t)t * D + col) = v[j] * rs * *(const f32x4*)(g + col); }
    }
}

struct CvtItem { const float* Wp; int ldw; bf16_t* WT; int ldt; int drow, k0, n0; };
constexpr int I_IN = 32 * (INW / 32), I_BR = 4 * 16 * 64, I_OUT = 32 * 64, I_GU = NE * 32 * 32, I_DN = NE * 8 * 64, I_LR = 32 * 8, I_WU = 2 * 32, I_WG = 64, I_BIG = I_IN + I_BR + I_OUT + I_GU + I_DN, I_ALL = I_BIG + I_LR + 2 * I_WU + I_WG;
__device__ __forceinline__ CvtItem cvt_decode(const Ctx& c, int l, int it) {
    CvtItem r;
    if (it < I_IN) { const int kb = it / (INW / 32), nb = it % (INW / 32); r.n0 = nb * 32; r.k0 = kb * 64; r.Wp = c.in[7] + (size_t)l * D * INW; r.ldw = INW; r.WT = WSH(O_WIN); r.ldt = D; r.drow = r.n0 < 10624 ? r.n0 : r.n0 + 128; return r; }
    it -= I_IN;
    if (it < I_BR) { const int sgm = it / 1024, q = it % 1024, kb = q / 64, nb = q % 64; r.n0 = nb * 32; r.k0 = kb * 64; r.Wp = c.in[28] + ((size_t)l * 4 + sgm) * W * D; r.ldw = D; r.WT = WSH(O_WBR) + sgm * W; r.ldt = 4 * W; r.drow = r.n0; return r; }
    it -= I_BR;
    if (it < I_OUT) { const int kb = it / 64, nb = it % 64; r.n0 = nb * 32; r.k0 = kb * 64; r.Wp = c.in[29] + (size_t)l * D * D; r.ldw = D; r.WT = WSH(O_WOUT); r.ldt = D; r.drow = r.n0; return r; }
    it -= I_OUT;
    if (it < I_GU) { const int e = it / 1024, q = it % 1024, kb = q / 32, nb = q % 32; r.n0 = nb * 32; r.k0 = kb * 64; r.Wp = c.in[34] + ((size_t)l * NE + e) * D * 1024; r.ldw = 1024; r.WT = WSH(O_WGU) + (size_t)e * 1024 * D; r.ldt = D;
        r.drow = r.n0 < 512 ? (r.n0 / 128) * 256 + (r.n0 % 128) : ((r.n0 - 512) / 128) * 256 + 128 + ((r.n0 - 512) % 128); return r; }
    it -= I_GU;
    if (it < I_DN) { const int e = it / 512, q = it % 512, kb = q / 64, nb = q % 64; r.n0 = nb * 32; r.k0 = kb * 64; r.Wp = c.in[35] + ((size_t)l * NE + e) * 512 * D; r.ldw = D; r.WT = WSH(O_WDN) + (size_t)e * D * 512; r.ldt = 512; r.drow = r.n0; return r; }
    it -= I_DN;
    if (it < I_LR) { const int m = it / 8, q = it % 8, kb = q / 4, nb = q % 4, z = m >> 4, ty = (m >> 3) & 1, n = m & 7; r.n0 = nb * 32; r.k0 = kb * 64; r.Wp = c.in[ty ? 12 : 10] + (((size_t)l * 2 + z) * 8 + n) * 128 * 128; r.ldw = 128;
        r.WT = WSH(O_WLR) + (size_t)m * 128 * 128; r.ldt = 128; r.drow = r.n0; return r; }
    it -= I_LR;
    if (it < 2 * I_WU) { const int ua = it / I_WU, q = it % I_WU, z = q / 32, nb = q % 32; r.n0 = nb * 32; r.k0 = 0; r.Wp = c.in[ua ? 23 : 21] + ((size_t)l * 2 + z) * 64 * W; r.ldw = W; r.WT = WSH(ua ? O_WAT : O_WUT) + (size_t)z * W * 64; r.ldt = 64; r.drow = r.n0; return r; }
    it -= 2 * I_WU;
    { const int kb = it / 32, nb = it % 32; r.n0 = nb * 32; r.k0 = kb * 64; r.Wp = c.in[24] + (size_t)l * 128 * W; r.ldw = W; r.WT = WSH(O_WGT); r.ldt = 128; r.drow = r.n0; return r; }
}
constexpr int J_IN = 16 * (INW / 128), J_BR = 4 * 8 * 16, J_OUT = 16 * 16, J_GU = NE * 16 * 8, J_DN = NE * 4 * 16, J_ALL = J_IN + J_BR + J_OUT + J_GU + J_DN;
__device__ __forceinline__ CvtItem cvt_decode_big(const Ctx& c, int l, int it) {
    CvtItem r;
    if (it < J_IN) { const int kb = it / (INW / 128), nb = it % (INW / 128); r.n0 = nb * 128; r.k0 = kb * 128; r.Wp = c.in[7] + (size_t)l * D * INW; r.ldw = INW; r.WT = WSH(O_WIN); r.ldt = D; r.drow = r.n0 < 10624 ? r.n0 : r.n0 + 128; return r; }
    it -= J_IN;
    if (it < J_BR) { const int sgm = it / 128, q = it % 128, kb = q / 16, nb = q % 16; r.n0 = nb * 128; r.k0 = kb * 128; r.Wp = c.in[28] + ((size_t)l * 4 + sgm) * W * D; r.ldw = D; r.WT = WSH(O_WBR) + sgm * W; r.ldt = 4 * W; r.drow = r.n0; return r; }
    it -= J_BR;
    if (it < J_OUT) { const int kb = it / 16, nb = it % 16; r.n0 = nb * 128; r.k0 = kb * 128; r.Wp = c.in[29] + (size_t)l * D * D; r.ldw = D; r.WT = WSH(O_WOUT); r.ldt = D; r.drow = r.n0; return r; }
    it -= J_OUT;
    if (it < J_GU) { const int e = it / 128, q = it % 128, kb = q / 8, nb = q % 8; r.n0 = nb * 128; r.k0 = kb * 128; r.Wp = c.in[34] + ((size_t)l * NE + e) * D * 1024; r.ldw = 1024; r.WT = WSH(O_WGU) + (size_t)e * 1024 * D; r.ldt = D;
        r.drow = r.n0 < 512 ? (r.n0 / 128) * 256 : ((r.n0 - 512) / 128) * 256 + 128; return r; }
    it -= J_GU;
    { const int e = it / 64, q = it % 64, kb = q / 16, nb = q % 16; r.n0 = nb * 128; r.k0 = kb * 128; r.Wp = c.in[35] + ((size_t)l * NE + e) * 512 * D; r.ldw = D; r.WT = WSH(O_WDN) + (size_t)e * D * 512; r.ldt = 512; r.drow = r.n0; return r; }
}
__device__ __forceinline__ void convert_big(const Ctx& c, int l, float* ldsf, int first, int last, int widx, int wcnt) {
    const int tid = threadIdx.x, lr = tid >> 5, lc = (tid & 31) * 4;
    f32x4 rg[8]; int it = first + widx; CvtItem r;
    if (it < last) { r = cvt_decode_big(c, l, it);
#pragma unroll
        for (int i = 0; i < 8; ++i) rg[i] = *(const f32x4*)(r.Wp + (size_t)(r.k0 + lr + 16 * i) * r.ldw + r.n0 + lc); }
    for (; it < last; it += wcnt) {
#pragma unroll
        for (int i = 0; i < 8; ++i) { float* dp = ldsf + (lr + 16 * i) * 129 + lc; dp[0] = rg[i][0]; dp[1] = rg[i][1]; dp[2] = rg[i][2]; dp[3] = rg[i][3]; }
        const CvtItem cur = r; const int nx = it + wcnt;
        if (nx < last) { r = cvt_decode_big(c, l, nx);
#pragma unroll
            for (int i = 0; i < 8; ++i) rg[i] = *(const f32x4*)(r.Wp + (size_t)(r.k0 + lr + 16 * i) * r.ldw + r.n0 + lc); }
        SYNCTHREADS();
#pragma unroll
        for (int q = 0; q < 4; ++q) { const int id = tid + NT * q, n = id >> 4, k8 = (id & 15) * 8; const float* sp = ldsf + k8 * 129 + n;
            u32x4 o; o[0] = pk2(sp[0 * 129], sp[1 * 129]); o[1] = pk2(sp[2 * 129], sp[3 * 129]); o[2] = pk2(sp[4 * 129], sp[5 * 129]); o[3] = pk2(sp[6 * 129], sp[7 * 129]);
            *(u32x4*)(cur.WT + (size_t)(cur.drow + n) * cur.ldt + cur.k0 + k8) = o; }
        SYNCTHREADS();
    }
}
__device__ __forceinline__ int convert_tail_tiles() { const int nun = (T / 256) * (PW / 256), G = (int)gridDim.x, rem = nun % G; return rem == 0 ? 0 : (G - rem) * 10 < J_GU + J_DN ? (G - rem) * 10 : J_GU + J_DN; }
__device__ __forceinline__ int convert_early_tiles(const Ctx& c) { const int G = (int)gridDim.x, nrest = (CTLW(c) + CW_PLAN)[40] * 4 - G; return (nrest >= 0 && nrest < G) ? ((G - nrest) * 12 < J_IN ? (G - nrest) * 12 : J_IN) : 0; }
__device__ __forceinline__ void ph_convert(const Ctx& c, int l, float* ldsf) {
    const int lane = threadIdx.x & 63, wave = threadIdx.x >> 6; const int gw = blockIdx.x * (NT / 64) + wave, ngw = gridDim.x * (NT / 64);
    convert_big(c, l, ldsf, l == 1 ? convert_early_tiles(c) : 0, J_ALL - convert_tail_tiles(), (int)blockIdx.x, (int)gridDim.x);
#ifdef CPU_EMU
    if (lane == 0) for (int it = I_BIG + gw; it < I_ALL; it += ngw) { const CvtItem r = cvt_decode(c, l, it);
        for (int kk = 0; kk < 64; ++kk) for (int nn = 0; nn < 32; ++nn) r.WT[(size_t)(r.drow + nn) * r.ldt + r.k0 + kk] = (bf16_t)f2bf(r.Wp[(size_t)(r.k0 + kk) * r.ldw + r.n0 + nn]); }
#else
    float* scr = ldsf + wave * (64 * 33 + 16);
    for (int it = I_BIG + gw; it < I_ALL; it += ngw) {
        const CvtItem r = cvt_decode(c, l, it);
#pragma unroll 8
        for (int i = 0; i < 32; ++i) { const int kk = 2 * i + (lane >> 5); scr[kk * 33 + (lane & 31)] = r.Wp[(size_t)(r.k0 + kk) * r.ldw + r.n0 + (lane & 31)]; }
        asm volatile("s_waitcnt lgkmcnt(0)" ::: "memory");
        const int cc = lane & 7;
#pragma unroll
        for (int j = 0; j < 4; ++j) { const int n = (lane >> 3) + 8 * j; const float* sp = scr + (8 * cc) * 33 + n;
            u32x4 o; o[0] = pk2(sp[0 * 33], sp[1 * 33]); o[1] = pk2(sp[2 * 33], sp[3 * 33]); o[2] = pk2(sp[4 * 33], sp[5 * 33]); o[3] = pk2(sp[6 * 33], sp[7 * 33]);
            *(u32x4*)(r.WT + (size_t)(r.drow + n) * r.ldt + r.k0 + 8 * cc) = o; }
        asm volatile("s_waitcnt lgkmcnt(0)" ::: "memory");
    }
#endif
    { const float* wg = c.in[30] + (size_t)l * D * 4; const float* we = c.in[32] + (size_t)l * D * 32; bf16_t* wh = WSH(O_WRH); bf16_t* wl = WSH(O_WRL);
      for (long i = GT_; i < (long)48 * D; i += GS_) { const int n = (int)(i / D), k = (int)(i % D); const float w = n < 4 ? wg[k * 4 + n] : n < 36 ? we[k * 32 + (n - 4)] : 0.f; const unsigned hb = f2bf(w); wh[i] = (bf16_t)hb; wl[i] = (bf16_t)f2bf(w - bf2f((bf16_t)hb)); } }
    for (long i = GT_; i < (long)128 * D / 2; i += GS_) ((unsigned*)(WSH(O_WIN) + (size_t)10624 * D))[i] = 0u;
}

namespace pg8 {
constexpr int BM = 256, BK = 64, HALF = 128, HTB = HALF * BK * 2, STAGE_BYTES = 8 * HTB;
__host__ __device__ __forceinline__ int lds_byte(int r, int cc) { const int st = (r >> 4) * 2 + (cc >> 5), rr = r & 15, c2 = cc & 31, ob = rr * 64 + c2 * 2; return st * 1024 + (ob ^ (((ob >> 9) & 1) << 5)); }
__host__ __device__ __forceinline__ void stage_rc(int b, int& R, int& C) { const int st = b / 1024, sb = b % 1024, swz = sb ^ (((sb >> 9) & 1) << 5); R = (st >> 1) * 16 + swz / 64; C = (st & 1) * 32 + (swz % 64) / 2; }
__host__ __device__ __forceinline__ int perm32(int rho) { const int n = rho >> 4, i = rho & 15; return 8 * (i >> 2) + 4 * n + (i & 3); }
struct Unit { int pm, pn, aux; const char* A; const char* B; };
struct Gemm { int K, lda, ldb; };

template <class Epi, class Sched>
__device__ __forceinline__ void gemm_phase(unsigned char* lds_, const Gemm g, const Sched& S, const Epi& E) {
#ifdef CPU_EMU
    if (threadIdx.x != 0) return;
    Unit u; const int K = g.K;
    float* Af = (float*)malloc((size_t)256 * K * 4); float* Bf = (float*)malloc((size_t)256 * K * 4); float* Cf = (float*)malloc(256 * 256 * 4);
    for (int i = 0; S.next(i, u); ++i) {
        const bf16_t* A = (const bf16_t*)u.A; const bf16_t* B = (const bf16_t*)u.B;
        for (int r = 0; r < 256; ++r) for (int k = 0; k < K; ++k) { size_t ar = (size_t)r; if constexpr (Sched::GATHER) ar = (size_t)S.row(u.pm * 256 + r); Af[(size_t)r * K + k] = bf2f(A[ar * g.lda + k]); Bf[(size_t)r * K + k] = bf2f(B[(size_t)r * g.ldb + k]); }
        const int nseg = Epi::SEGT > 0 ? K / (Epi::SEGT * 64) : 1, kseg = K / nseg;
        for (int wid = 0; wid < 8; ++wid) for (int lane = 0; lane < 64; ++lane) {
            const int wr = wid >> 2, wc = wid & 3, fr = lane & 15, fq = lane >> 4; f32x4 acc[2][2][4][2];
            for (int ai = 0; ai < 2; ++ai) for (int bj = 0; bj < 2; ++bj) for (int m = 0; m < 4; ++m) for (int n = 0; n < 2; ++n) for (int j = 0; j < 4; ++j) acc[ai][bj][m][n][j] = 0.f;
            for (int sg = 0; sg < nseg; ++sg) {
                for (int ai = 0; ai < 2; ++ai) for (int bj = 0; bj < 2; ++bj) for (int m = 0; m < 4; ++m) for (int n = 0; n < 2; ++n) for (int j = 0; j < 4; ++j) {
                    const int r = 128 * ai + 64 * wr + 16 * m + fr, cc = 128 * bj + 32 * wc + (Epi::PERM ? 8 * fq + 4 * n + j : 16 * n + 4 * fq + j);
                    const float* a = Af + (size_t)r * K + sg * kseg; const float* b = Bf + (size_t)cc * K + sg * kseg; float sacc = 0.f; for (int k = 0; k < kseg; ++k) sacc += a[k] * b[k];
                    acc[ai][bj][m][n][j] += sacc; }
                if constexpr (Epi::SEGT > 0) { if (sg + 1 < nseg) E.segment(acc, u, sg, wr, wc, fr, fq); }
            }
            E(acc, u, wr, wc, fr, fq);
        }
    }
    free(Af); free(Bf); free(Cf);
#else
    typedef __attribute__((address_space(3))) unsigned char* ldsp_t;
    ldsp_t lds = (ldsp_t)lds_;
    const int tid = threadIdx.x, wid = __builtin_amdgcn_readfirstlane(tid >> 6), lane = tid & 63, wr = wid >> 2, wc = wid & 3, fr = lane & 15, fq = lane >> 4;
    const int K = g.K, nt = K / BK;
    unsigned voffA[2], voffB[2];
#pragma unroll
    for (int i = 0; i < 2; ++i) { int R, C; stage_rc(tid * 16 + i * 8192, R, C); const int Rb = Epi::PERM ? ((R & ~31) + perm32(R & 31)) : R;
        voffA[i] = (unsigned)(R * g.lda + C) * 2u; voffB[i] = (unsigned)(Rb * g.ldb + C) * 2u; }
    unsigned vA[2][2], vAn[2][2];
#define PG8_GROWS(uu, vv) do { _Pragma("unroll") for (int h_ = 0; h_ < 2; ++h_) _Pragma("unroll") for (int i_ = 0; i_ < 2; ++i_) { int R_, C_; stage_rc(tid * 16 + i_ * 8192, R_, C_); \
        vv[h_][i_] = (unsigned)(S.row((uu).pm * 256 + h_ * 128 + R_) * g.lda + C_) * 2u; } } while (0)
    const size_t kstep = (size_t)(BK * 2);
    const size_t hstepA = (size_t)HALF * g.lda * 2, hstepB = (size_t)HALF * g.ldb * 2;
    const unsigned ldsw = (unsigned)wid * 1024u;
    const int aoff = lds_byte(wr * 64 + fr, fq * 8), boff = lds_byte(wc * 32 + fr, fq * 8);
#define PG8_SA(b, h) (((b) * 2 + (h)) * HTB)
#define PG8_SB(b, h) ((4 + (b) * 2 + (h)) * HTB)
#define PG8_STAGE(bufoff, gbase, voff) do { _Pragma("unroll") for (int _i = 0; _i < 2; ++_i) \
        __builtin_amdgcn_global_load_lds((const unsigned*)((const char*)(gbase) + (voff)[_i]), (__attribute__((address_space(3))) unsigned*)(lds + (bufoff) + ldsw + _i * 8192), 16, 0, 0); } while (0)
#define PG8_STAGEA(b, h, kp, usen) do { if constexpr (Sched::GATHER) { const unsigned vs_[2] = {(usen) ? vAn[h][0] : vA[h][0], (usen) ? vAn[h][1] : vA[h][1]}; PG8_STAGE(PG8_SA(b, h), kp, vs_); } \
        else { PG8_STAGE(PG8_SA(b, h), (kp) + ((h) ? hstepA : 0), voffA); } } while (0)
#define PG8_LDA(dst, b, h) do { _Pragma("unroll") for (int m = 0; m < 4; ++m) _Pragma("unroll") for (int k = 0; k < 2; ++k) dst[m][k] = *(const __attribute__((address_space(3))) bf16x8*)(lds + PG8_SA(b, h) + aoff + m * 2048 + k * 1024); } while (0)
#define PG8_LDB(dst, b, h) do { _Pragma("unroll") for (int n = 0; n < 2; ++n) _Pragma("unroll") for (int k = 0; k < 2; ++k) dst[n][k] = *(const __attribute__((address_space(3))) bf16x8*)(lds + PG8_SB(b, h) + boff + n * 2048 + k * 1024); } while (0)
#define PG8_MMA(ai, bj, At, Bt) do { __builtin_amdgcn_s_setprio(1); _Pragma("unroll") for (int m = 0; m < 4; ++m) _Pragma("unroll") for (int n = 0; n < 2; ++n) _Pragma("unroll") for (int k = 0; k < 2; ++k) \
        acc[ai][bj][m][n] = __builtin_amdgcn_mfma_f32_16x16x32_bf16(Bt[n][k], At[m][k], acc[ai][bj][m][n], 0, 0, 0); __builtin_amdgcn_s_setprio(0); } while (0)
#define PG8_WAIT_V(n) asm volatile("s_waitcnt vmcnt(" #n ")" ::: "memory")
#define PG8_WAIT_L(n) asm volatile("s_waitcnt lgkmcnt(" #n ")" ::: "memory")
#define PG8_BAR __builtin_amdgcn_s_barrier()
#define PG8_SCHED __builtin_amdgcn_sched_barrier(0)
    Unit cur, nxt; int ui = 0;
    if (!S.next(0, cur)) return;
    f32x4 acc[2][2][4][2];
#pragma unroll
    for (int a = 0; a < 2; ++a)
#pragma unroll
        for (int b = 0; b < 2; ++b)
#pragma unroll
            for (int m = 0; m < 4; ++m)
#pragma unroll
                for (int n = 0; n < 2; ++n) acc[a][b][m][n] = (f32x4){0.f, 0.f, 0.f, 0.f};
    bf16x8 At[4][2], B0[2][2], B1[2][2];
    const char* cA = cur.A; const char* cB = cur.B;
    S.a_ready(cur);
    if constexpr (Sched::GATHER) { PG8_GROWS(cur, vA); }
    PG8_STAGE(PG8_SB(0, 0), cB, voffB); PG8_STAGEA(0, 0, cA, false); PG8_STAGE(PG8_SB(0, 1), cB + hstepB, voffB); PG8_STAGEA(0, 1, cA, false);
    if (wr == 1) PG8_BAR;
    PG8_WAIT_V(4); PG8_BAR;
    PG8_STAGE(PG8_SB(1, 0), cB + kstep, voffB); PG8_STAGEA(1, 0, cA + kstep, false); PG8_STAGE(PG8_SB(1, 1), cB + hstepB + kstep, voffB);
    PG8_WAIT_V(6); PG8_BAR;
    for (;;) {
        const bool has_next = S.next(ui + 1, nxt);
        const char* nA = has_next ? nxt.A : cA; const char* nB = has_next ? nxt.B : cB;
        if constexpr (Sched::GATHER) { if (has_next) { PG8_GROWS(nxt, vAn); } else {
#pragma unroll
            for (int h_ = 0; h_ < 2; ++h_) { vAn[h_][0] = vA[h_][0]; vAn[h_][1] = vA[h_][1]; } } }
        for (int t = 0; t < nt; t += 2) {
            const bool last = (t == nt - 2);
            const char* a1 = cA + (size_t)(t + 1) * kstep;
            const char* a2 = last ? nA : cA + (size_t)(t + 2) * kstep; const char* b2 = last ? nB : cB + (size_t)(t + 2) * kstep;
            const char* a3 = a2 + kstep; const char* b3 = b2 + kstep;
            if (last && has_next) S.a_ready(nxt);
            PG8_LDB(B0, 0, 0); PG8_SCHED; PG8_LDA(At, 0, 0); PG8_STAGEA(1, 1, a1, false);
            PG8_WAIT_L(8); PG8_BAR; PG8_WAIT_L(0); PG8_MMA(0, 0, At, B0); PG8_BAR; PG8_SCHED;
            PG8_LDB(B1, 0, 1); PG8_STAGE(PG8_SB(0, 0), b2, voffB);
            PG8_BAR; PG8_WAIT_L(0); PG8_MMA(0, 1, At, B1); PG8_BAR;
            PG8_LDA(At, 0, 1); PG8_STAGEA(0, 0, a2, last);
            PG8_BAR; PG8_WAIT_L(0); PG8_MMA(1, 0, At, B0); PG8_BAR; PG8_SCHED;
            PG8_STAGE(PG8_SB(0, 1), b2 + hstepB, voffB);
            PG8_WAIT_V(6); PG8_BAR; PG8_MMA(1, 1, At, B1); PG8_BAR;
            PG8_LDB(B0, 1, 0); PG8_SCHED; PG8_LDA(At, 1, 0); PG8_STAGEA(0, 1, a2, last);
            PG8_WAIT_L(8); PG8_BAR; PG8_WAIT_L(0); PG8_MMA(0, 0, At, B0); PG8_BAR; PG8_SCHED;
            PG8_LDB(B1, 1, 1); PG8_STAGE(PG8_SB(1, 0), b3, voffB);
            PG8_BAR; PG8_WAIT_L(0); PG8_MMA(0, 1, At, B1); PG8_BAR;
            PG8_LDA(At, 1, 1); PG8_STAGEA(1, 0, a3, last);
            PG8_BAR; PG8_WAIT_L(0); PG8_MMA(1, 0, At, B0); PG8_BAR; PG8_SCHED;
            PG8_STAGE(PG8_SB(1, 1), b3 + hstepB, voffB);
            PG8_WAIT_V(6); PG8_BAR; PG8_MMA(1, 1, At, B1); PG8_BAR;
            if constexpr (Epi::SEGT > 0) { if ((t + 2) % Epi::SEGT == 0 && t + 2 < nt) E.segment(acc, cur, (t + 2) / Epi::SEGT - 1, wr, wc, fr, fq); }
        }
        E(acc, cur, wr, wc, fr, fq); S.done(cur);
        if (!has_next) break;
#pragma unroll
        for (int a = 0; a < 2; ++a)
#pragma unroll
            for (int b = 0; b < 2; ++b)
#pragma unroll
                for (int m = 0; m < 4; ++m)
#pragma unroll
                    for (int n = 0; n < 2; ++n) acc[a][b][m][n] = (f32x4){0.f, 0.f, 0.f, 0.f};
        cur = nxt; cA = nA; cB = nB; ++ui;
        if constexpr (Sched::GATHER) {
#pragma unroll
            for (int h_ = 0; h_ < 2; ++h_) { vA[h_][0] = vAn[h_][0]; vA[h_][1] = vAn[h_][1]; } }
    }
    PG8_WAIT_V(0);
    if (wr == 0) PG8_BAR;
    PG8_BAR;
#undef PG8_SA
#undef PG8_SB
#undef PG8_STAGE
#undef PG8_STAGEA
#undef PG8_GROWS
#undef PG8_LDA
#undef PG8_LDB
#undef PG8_MMA
#undef PG8_WAIT_V
#undef PG8_WAIT_L
#undef PG8_BAR
#undef PG8_SCHED
#endif
}

struct StaticOrder {
    static constexpr bool GATHER = false;
    int nM, nN, nwg, G, c; const char* A; const char* B; size_t tstepA, tstepB;
    __device__ __forceinline__ void init(int M, int N, int G_, int c_, const void* A_, const void* B_, int lda, int ldb) { nM = M / BM; nN = N / BM; nwg = nM * nN; G = G_; c = c_; A = (const char*)A_; B = (const char*)B_; tstepA = (size_t)BM * lda * 2; tstepB = (size_t)BM * ldb * 2; }
    __device__ __forceinline__ bool next(int i, Unit& u) const {
        const long L = (long)i * G + c; if (L >= nwg) return false;
        int wgid = (int)L; { const int q = nwg / 8, r = nwg % 8, xcd = wgid % 8, off = wgid / 8; wgid = (xcd < r ? xcd * (q + 1) : r * (q + 1) + (xcd - r) * q) + off; }
        const int nig = 8 * nN, gid = wgid / nig, fm = gid * 8, gsz = (nM - fm) < 8 ? (nM - fm) : 8;
        u.pm = fm + ((wgid % nig) % gsz); u.pn = (wgid % nig) / gsz; u.aux = 0; u.A = A + (size_t)u.pm * tstepA; u.B = B + (size_t)u.pn * tstepB; return true;
    }
    __device__ __forceinline__ void a_ready(const Unit&) const {}
    __device__ __forceinline__ void done(const Unit&) const {}
};
struct MergeOrder {
    static constexpr bool GATHER = false;
    StaticOrder so; int kseg_bytes;
    __device__ __forceinline__ bool next(int i, Unit& u) const { if (!so.next(i >> 2, u)) return false; u.aux = i & 3; u.A += (size_t)u.aux * kseg_bytes; u.B += (size_t)u.aux * kseg_bytes; return true; }
    __device__ __forceinline__ void a_ready(const Unit&) const {}
    __device__ __forceinline__ void done(const Unit&) const {}
};
struct MoeOrder {
    static constexpr bool GATHER = false;
    int G, c, ncol; const int* plan; const char* A; const char* B; size_t tstepA, tstepB, estep;
    __device__ __forceinline__ bool next(int i, Unit& u) const {
        const long L = (long)i * G + c; const int nblk = plan[40]; if (L >= (long)nblk * ncol) return false;
        u.pm = (int)(L / ncol); u.pn = (int)(L % ncol); u.aux = plan[64 + u.pm]; u.A = A + (size_t)u.pm * tstepA; u.B = B + (size_t)u.aux * estep + (size_t)u.pn * tstepB; return true;
    }
    __device__ __forceinline__ void a_ready(const Unit&) const {}
    __device__ __forceinline__ void done(const Unit&) const {}
};
struct MoeGatherOrder {
    static constexpr bool GATHER = true;
    int G, c, ncol; const int* plan; const char* A; const char* B; size_t tstepB, estep; const int* src; int nrows;
    __device__ __forceinline__ bool next(int i, Unit& u) const {
        const long L = (long)i * G + c; const int nblk = plan[40]; if (L >= (long)nblk * ncol) return false;
        u.pm = (int)(L / ncol); u.pn = (int)(L % ncol); u.aux = plan[64 + u.pm]; u.A = A; u.B = B + (size_t)u.aux * estep + (size_t)u.pn * tstepB; return true;
    }
    __device__ __forceinline__ int row(int slot) const { const int r = src[slot]; return (unsigned)r < (unsigned)nrows ? r : 0; }
    __device__ __forceinline__ void a_ready(const Unit&) const {}
    __device__ __forceinline__ void done(const Unit&) const {}
};

__device__ __forceinline__ u32x4 pack8(const f32x4 v0, const f32x4 v1) { u32x4 w; w[0] = pk2(v0[0], v0[1]); w[1] = pk2(v0[2], v0[3]); w[2] = pk2(v1[0], v1[1]); w[3] = pk2(v1[2], v1[3]); return w; }
struct EpiBf16 {
    static constexpr int SEGT = 0; static constexpr bool PERM = true; bf16_t* O; int ldc;
    __device__ __forceinline__ void operator()(const f32x4 (&acc)[2][2][4][2], const Unit& u, int wr, int wc, int fr, int fq) const {
        const int row0 = u.pm * BM + wr * 64 + fr, col0 = u.pn * BM + wc * 32 + 8 * fq;
#pragma unroll
        for (int ai = 0; ai < 2; ++ai)
#pragma unroll
            for (int m = 0; m < 4; ++m) { bf16_t* rowp = O + (size_t)(row0 + ai * HALF + m * 16) * ldc + col0;
#pragma unroll
                for (int bj = 0; bj < 2; ++bj) *(u32x4*)(rowp + bj * HALF) = pack8(acc[ai][bj][m][0], acc[ai][bj][m][1]); }
    }
};
struct EpiP {
    static constexpr int SEGT = 0; static constexpr bool PERM = true; bf16_t* O; unsigned char* G8; float* SG;
    __device__ __forceinline__ void operator()(const f32x4 (&acc)[2][2][4][2], const Unit& u, int wr, int wc, int fr, int fq) const {
        const int row0 = u.pm * BM + wr * 64 + fr, col0 = u.pn * BM + wc * 32 + 8 * fq;
        if (u.pn * BM < C_MLP) {
            const bool sgu = u.pn * BM >= C_SV && u.pn * BM < C_SV + W;
#pragma unroll
            for (int ai = 0; ai < 2; ++ai)
#pragma unroll
                for (int m = 0; m < 4; ++m) { const int r = row0 + ai * HALF + m * 16; bf16_t* rowp = O + (size_t)r * PW + col0; float s1 = 0.f, s2 = 0.f;
#pragma unroll
                    for (int bj = 0; bj < 2; ++bj) { const u32x4 pk = pack8(acc[ai][bj][m][0], acc[ai][bj][m][1]); *(u32x4*)(rowp + bj * HALF) = pk;
                        if (sgu) {
#pragma unroll
                            for (int e = 0; e < 4; ++e) { const float g0 = geluf_(bflo(pk[e])), g1 = geluf_(bfhi(pk[e])); s1 += g0 + g1; s2 += g0 * g0 + g1 * g1; } } }
                    if (sgu) { float* sp = SG + ((size_t)r * 16 + (u.pn - C_SV / BM) * 4 + wc) * 2;
#ifdef CPU_EMU
                        if (fq == 0) { sp[0] = s1; sp[1] = s2; } else { sp[0] += s1; sp[1] += s2; }
#else
                        s1 += SHFL_XOR(s1, 16); s1 += SHFL_XOR(s1, 32); s2 += SHFL_XOR(s2, 16); s2 += SHFL_XOR(s2, 32); if (fq == 0) { sp[0] = s1; sp[1] = s2; }
#endif
                    } }
        } else {
#pragma unroll
            for (int ai = 0; ai < 2; ++ai)
#pragma unroll
                for (int m = 0; m < 4; ++m) { unsigned char* rowp = G8 + (size_t)(row0 + ai * HALF + m * 16) * (4 * D) + (col0 - C_MLP);
#pragma unroll
                    for (int bj = 0; bj < 2; ++bj) { unsigned long long w = 0ull;
#pragma unroll
                        for (int q = 0; q < 8; ++q) { const float gq = sigmoidf_(acc[ai][bj][m][q >> 2][q & 3]); w |= (unsigned long long)(unsigned)(gq * 255.f + 0.5f) << (8 * q); }
                        *(unsigned long long*)(rowp + bj * HALF) = w; } }
        }
    }
};
struct EpiMerge {
    static constexpr int SEGT = 16; static constexpr bool PERM = true; const unsigned char* G8; bf16_t* MRG;
    static __device__ __forceinline__ float gb(unsigned w32, int q) { return fmaxf((float)((w32 >> (8 * q)) & 255u), 0.5f); }
    __device__ __forceinline__ void segment(f32x4 (&acc)[2][2][4][2], const Unit& u, int seg, int wr, int wc, int fr, int fq) const {
        const int row0 = u.pm * BM + wr * 64 + fr, col0 = u.pn * BM + wc * 32 + 8 * fq;
#pragma unroll
        for (int ai = 0; ai < 2; ++ai)
#pragma unroll
            for (int m = 0; m < 4; ++m) { const size_t r = (size_t)(row0 + ai * HALF + m * 16);
#pragma unroll
                for (int bj = 0; bj < 2; ++bj) { const int cc = col0 + bj * HALF;
                    const unsigned long long g0 = *(const unsigned long long*)(G8 + r * (4 * D) + seg * D + cc), g1 = *(const unsigned long long*)(G8 + r * (4 * D) + (seg + 1) * D + cc);
                    const unsigned lo0 = (unsigned)g0, hi0 = (unsigned)(g0 >> 32), lo1 = (unsigned)g1, hi1 = (unsigned)(g1 >> 32);
#pragma unroll
                    for (int q = 0; q < 4; ++q) { acc[ai][bj][m][0][q] *= gb(lo0, q) * frcp_(gb(lo1, q)); acc[ai][bj][m][1][q] *= gb(hi0, q) * frcp_(gb(hi1, q)); } }
#ifndef CPU_EMU
                asm volatile("" ::: "memory");
#endif
            }
    }
    __device__ __forceinline__ void operator()(const f32x4 (&acc)[2][2][4][2], const Unit& u, int wr, int wc, int fr, int fq) const {
        const int row0 = u.pm * BM + wr * 64 + fr, col0 = u.pn * BM + wc * 32 + 8 * fq;
#pragma unroll
        for (int ai = 0; ai < 2; ++ai)
#pragma unroll
            for (int m = 0; m < 4; ++m) { const size_t r = (size_t)(row0 + ai * HALF + m * 16);
#pragma unroll
                for (int bj = 0; bj < 2; ++bj) { const int cc = col0 + bj * HALF;
                    const unsigned long long g3 = *(const unsigned long long*)(G8 + r * (4 * D) + 3 * D + cc); f32x4 v0, v1;
#pragma unroll
                    for (int q = 0; q < 4; ++q) { v0[q] = gb((unsigned)g3, q) * (1.f / 255.f) * acc[ai][bj][m][0][q]; v1[q] = gb((unsigned)(g3 >> 32), q) * (1.f / 255.f) * acc[ai][bj][m][1][q]; }
                    *(u32x4*)(MRG + r * D + cc) = pack8(v0, v1); }
#ifndef CPU_EMU
                asm volatile("" ::: "memory");
#endif
            }
    }
};
struct EpiResid {
    static constexpr int SEGT = 0; static constexpr bool PERM = false; const float* xin; const float* g1; float* xmid; float* ssp;
    __device__ __forceinline__ void operator()(const f32x4 (&acc)[2][2][4][2], const Unit& u, int wr, int wc, int fr, int fq) const {
        const int row0 = u.pm * BM + wr * 64 + fr, col0 = u.pn * BM + wc * 32 + 4 * fq;
#pragma unroll
        for (int ai = 0; ai < 2; ++ai)
#pragma unroll
            for (int m = 0; m < 4; ++m) { const int r = row0 + ai * HALF + m * 16; const float* gp = g1 + (size_t)(r / S) * D6; float sq = 0.f;
#pragma unroll
                for (int bj = 0; bj < 2; ++bj)
#pragma unroll
                    for (int n = 0; n < 2; ++n) { const int cc = col0 + bj * HALF + n * 16; const f32x4 v = *(const f32x4*)(xin + (size_t)r * D + cc) + *(const f32x4*)(gp + cc) * acc[ai][bj][m][n];
                        *(f32x4*)(xmid + (size_t)r * D + cc) = v; sq += (v[0] * v[0] + v[1] * v[1]) + (v[2] * v[2] + v[3] * v[3]); }
                float* sp = ssp + (size_t)r * 32 + u.pn * 4 + wc;
#ifdef CPU_EMU
                if (fq == 0) *sp = sq; else *sp += sq;
#else
                sq += SHFL_XOR(sq, 16); sq += SHFL_XOR(sq, 32); if (fq == 0) *sp = sq;
                asm volatile("" ::: "memory");
#endif
            }
    }
};
struct EpiGU {
    static constexpr int SEGT = 0; static constexpr bool PERM = true; bf16_t* ACT;
    __device__ __forceinline__ void operator()(const f32x4 (&acc)[2][2][4][2], const Unit& u, int wr, int wc, int fr, int fq) const {
        const int row0 = u.pm * BM + wr * 64 + fr, col0 = u.pn * HALF + wc * 32 + 8 * fq;
#pragma unroll
        for (int ai = 0; ai < 2; ++ai)
#pragma unroll
            for (int m = 0; m < 4; ++m) { f32x4 v0, v1;
#pragma unroll
                for (int j = 0; j < 4; ++j) { v0[j] = siluf_(acc[ai][0][m][0][j]) * acc[ai][1][m][0][j]; v1[j] = siluf_(acc[ai][0][m][1][j]) * acc[ai][1][m][1][j]; }
                *(u32x4*)(ACT + (size_t)(row0 + ai * HALF + m * 16) * 512 + col0) = pack8(v0, v1); }
    }
};
}

template <int PASS>
__device__ __forceinline__ void ph_lru(const Ctx& c, int l, float* ldsf) {
    const bf16_t* P = WSH(O_P); const float* cw = c.in[8] + (size_t)l * 4 * W; const float* cb = c.in[9] + (size_t)l * W;
    const float* br = c.in[11] + (size_t)l * 2 * W; const float* bi = c.in[13] + (size_t)l * 2 * W; const float* lam = c.in[14] + (size_t)l * 2 * W; const bf16_t* WLR = WSH(O_WLR);
    float* CA = WSF(O_LCA); float* CH = WSF(O_LCH); const float* CI = WSF(O_LCI); bf16_t* Y = WSH(O_YS); unsigned* LAU = (unsigned*)(c.ws + O_LA);
    bf16_t* Xs = (bf16_t*)ldsf; bf16_t* Wr = Xs + 64 * 136; bf16_t* Wi = Wr + 128 * 136; float* AUa = (float*)Wr; float* AUu = AUa + 64 * 128; float* HF = (float*)(Wi + 128 * 136); float* spl = HF + 64 * 128;
    const int tid = threadIdx.x, wv = tid >> 6, lane = tid & 63, fr = lane & 15, fq = lane >> 4, rt = wv & 3, hf = wv >> 2;
    u32x4 wreg[8];
#define LRU_WLOAD(zz, nn) do { _Pragma("unroll") for (int q = 0; q < 4; ++q) { const int id = tid + NT * q, f = id >> 4, e8 = (id & 15) * 8; \
        wreg[2 * q] = *(const u32x4*)(WLR + ((size_t)(((zz) * 2 + 0) * 8 + (nn)) * 128 + f) * 128 + e8); wreg[2 * q + 1] = *(const u32x4*)(WLR + ((size_t)(((zz) * 2 + 1) * 8 + (nn)) * 128 + f) * 128 + e8); } } while (0)
    if ((int)blockIdx.x < (T / 64) * 8) LRU_WLOAD(0, (int)blockIdx.x & 7);
    for (int u = blockIdx.x; u < (T / 64) * 8; u += gridDim.x) {
        const int n = u & 7, tile = u >> 3, b = tile / NLC, chk = tile % NLC; const long t0 = (long)tile * 64;
        if (tid < 256) spl[tid] = softplusf_(-lam[(tid >> 7) * W + n * 128 + (tid & 127)]);
#pragma unroll
        for (int q = 0; q < 4; ++q) { const int id = tid + NT * q, tl = id >> 5, e4 = (id & 31) * 4, ch = n * 128 + e4; const long t = t0 + tl; const int sI = (int)(t % S);
            f32x4 acc = *(const f32x4*)(cb + ch);
#pragma unroll
            for (int k = 0; k < 4; ++k) { const int ss = sI + k - 2; if (ss >= 0 && ss < S) acc += ld_bf4(P + (size_t)(t + k - 2) * PW + C_LX + ch) * *(const f32x4*)(cw + k * W + ch); }
            st_bf4(Xs + tl * 136 + e4, acc); }
        for (int z = 0; z < 2; ++z) {
#pragma unroll
            for (int q = 0; q < 4; ++q) { const int id = tid + NT * q, f = id >> 4, e8 = (id & 15) * 8; *(u32x4*)(Wr + f * 136 + e8) = wreg[2 * q]; *(u32x4*)(Wi + f * 136 + e8) = wreg[2 * q + 1]; }
            SYNCTHREADS();
            f32x4 ar[4], ai[4];
#pragma unroll
            for (int nt = 0; nt < 4; ++nt) { ar[nt] = (f32x4){0.f, 0.f, 0.f, 0.f}; ai[nt] = (f32x4){0.f, 0.f, 0.f, 0.f}; }
            wave_mma<4, 4>(ar, Xs + rt * 16 * 136, 136, Wr + hf * 64 * 136, 136);
            wave_mma<4, 4>(ai, Xs + rt * 16 * 136, 136, Wi + hf * 64 * 136, 136);
            SYNCTHREADS();
            if (z == 0) LRU_WLOAD(1, n); else if (u + (int)gridDim.x < (T / 64) * 8) LRU_WLOAD(0, (u + (int)gridDim.x) & 7);
            const int tl = rt * 16 + fr;
#pragma unroll
            for (int nt = 0; nt < 4; ++nt) { const int f = 64 * hf + 16 * nt + 4 * fq, ch = n * 128 + f;
                const f32x4 brv = *(const f32x4*)(br + z * W + ch), biv = *(const f32x4*)(bi + z * W + ch), lmv = *(const f32x4*)(spl + z * 128 + f), xcv = ld_bf4(Xs + tl * 136 + f); f32x4 av, uv, lav;
#pragma unroll
                for (int e = 0; e < 4; ++e) { const float r = sigmoidf_(ar[nt][e] + brv[e]), ig = sigmoidf_(ai[nt][e] + biv[e]), la = -8.f * r * lmv[e]; const float a = fexp_(la); av[e] = a; lav[e] = la; uv[e] = fsqrt_(fmaxf(1.f - a * a, 0.f)) * ig * xcv[e]; }
                *(f32x4*)(AUa + tl * 128 + f) = av; *(f32x4*)(AUu + tl * 128 + f) = uv;
                if (PASS == 1) { u32x4 pk;
#pragma unroll
                    for (int e = 0; e < 4; ++e) pk[e] = pk2(lav[e], uv[e]);
                    *(u32x4*)(LAU + ((size_t)z * T + t0 + tl) * W + ch) = pk; } }
            SYNCTHREADS();
            if (PASS == 1) {
                { const int f = tid & 127, sgm = tid >> 7; float prod = 1.f, h = 0.f;
#pragma unroll
                  for (int q = 0; q < 16; ++q) { const int st = sgm * 16 + q, sI = z == 0 ? st : 63 - st; const float a = AUa[sI * 128 + f]; h = a * h + AUu[sI * 128 + f]; prod *= a; }
                  HF[sgm * 128 + f] = prod; HF[512 + sgm * 128 + f] = h; }
                SYNCTHREADS();
                if (tid < 128) { const int f = tid; const size_t ci = (((size_t)z * NB + b) * NLC + chk) * W + n * 128 + f; float prod = 1.f, h = 0.f;
#pragma unroll
                    for (int sgm = 0; sgm < 4; ++sgm) { const float a = HF[sgm * 128 + f]; h = a * h + HF[512 + sgm * 128 + f]; prod *= a; }
                    CA[ci] = prod; CH[ci] = h; }
                continue;
            }
            if (tid < 128) { const int f = tid; const size_t ci = (((size_t)z * NB + b) * NLC + chk) * W + n * 128 + f;
                if (PASS == 1) { float prod = 1.f, h = 0.f;
#pragma unroll 8
                    for (int q = 0; q < 64; ++q) { const int sI = z == 0 ? q : 63 - q; const float a = AUa[sI * 128 + f]; h = a * h + AUu[sI * 128 + f]; prod *= a; }
                    CA[ci] = prod; CH[ci] = h;
                } else { float h = CI[ci];
                    if (z == 0) {
#pragma unroll 8
                        for (int q = 0; q < 64; ++q) { h = AUa[q * 128 + f] * h + AUu[q * 128 + f]; HF[q * 128 + f] = h; }
                    } else {
#pragma unroll 8
                        for (int q = 63; q >= 0; --q) { h = AUa[q * 128 + f] * h + AUu[q * 128 + f]; HF[q * 128 + f] += h; } } }
            }
            SYNCTHREADS();
        }
        if (PASS == 2) {
#pragma unroll
            for (int q = 0; q < 4; ++q) { const int id = tid + NT * q, tl = id >> 5, f4 = (id & 31) * 4; const long t = t0 + tl; f32x4 hv = *(const f32x4*)(HF + tl * 128 + f4); const f32x4 gv = ld_bf4(P + (size_t)t * PW + C_LG + n * 128 + f4);
#pragma unroll
                for (int e = 0; e < 4; ++e) hv[e] *= geluf_(gv[e]);
                st_bf4(Y + (size_t)t * 4 * W + 0 * W + n * 128 + f4, hv); }
            SYNCTHREADS();
        }
    }
}
__device__ __forceinline__ void ph_lru_fin(const Ctx& c, float* ldsf) {
    const bf16_t* P = WSH(O_P); const unsigned* LAU = (const unsigned*)(c.ws + O_LA); const float* CI = WSF(O_LCI); bf16_t* Y = WSH(O_YS);
    unsigned* Lz = (unsigned*)ldsf; float* Hz = ldsf + 2 * 64 * 128; const int tid = threadIdx.x;
    u32x4 lpre[8];
#define LF_LOAD(uu) do { const int n_ = (uu) & 7; const long t0_ = (long)((uu) >> 3) * 64; \
        _Pragma("unroll") for (int q = 0; q < 8; ++q) { const int id = tid + NT * q, z = id >> 11, r = (id >> 5) & 63, c4 = (id & 31) * 4; lpre[q] = *(const u32x4*)(LAU + ((size_t)z * T + t0_ + r) * W + n_ * 128 + c4); } } while (0)
    if ((int)blockIdx.x < (T / 64) * 8) LF_LOAD((int)blockIdx.x);
    for (int u = blockIdx.x; u < (T / 64) * 8; u += gridDim.x) {
        const int n = u & 7, tile = u >> 3, b = tile / NLC, chk = tile % NLC; const long t0 = (long)tile * 64;
#pragma unroll
        for (int q = 0; q < 8; ++q) { const int id = tid + NT * q, z = id >> 11, r = (id >> 5) & 63, c4 = (id & 31) * 4; *(u32x4*)(Lz + z * 8192 + r * 128 + c4) = lpre[q]; }
        SYNCTHREADS();
        if (u + (int)gridDim.x < (T / 64) * 8) LF_LOAD(u + (int)gridDim.x);
        unsigned long long graw[4];
#pragma unroll
        for (int q = 0; q < 4; ++q) { const int id = tid + NT * q, r = id >> 5, f4 = (id & 31) * 4; graw[q] = *(const unsigned long long*)(P + (size_t)(t0 + r) * PW + C_LG + n * 128 + f4); }
        if (tid < 256) { const int z = tid >> 7, f = tid & 127; float h = CI[(((size_t)z * NB + b) * NLC + chk) * W + n * 128 + f]; const unsigned* lp = Lz + z * 8192 + f; float* hp = Hz + z * 8192 + f;
#pragma unroll 8
            for (int q = 0; q < 64; ++q) { const int sI = z == 0 ? q : 63 - q; const unsigned w = lp[sI * 128]; h = fexp_(bflo(w)) * h + bfhi(w); hp[sI * 128] = h; } }
        SYNCTHREADS();
#pragma unroll
        for (int q = 0; q < 4; ++q) { const int id = tid + NT * q, r = id >> 5, f4 = (id & 31) * 4; const long t = t0 + r; f32x4 o = *(const f32x4*)(Hz + r * 128 + f4) + *(const f32x4*)(Hz + 8192 + r * 128 + f4); const unsigned glo = (unsigned)graw[q], ghi = (unsigned)(graw[q] >> 32); const f32x4 gv = (f32x4){bflo(glo), bfhi(glo), bflo(ghi), bfhi(ghi)};
#pragma unroll
            for (int e = 0; e < 4; ++e) o[e] *= geluf_(gv[e]);
            st_bf4(Y + (size_t)t * 4 * W + 0 * W + n * 128 + f4, o); }
        SYNCTHREADS();
    }
}
__device__ __forceinline__ void ph_lru_scan2(const Ctx& c) {
    const float* CA = WSF(O_LCA); const float* CH = WSF(O_LCH); float* CI = WSF(O_LCI);
    for (long i = GT_; i < (long)2 * NB * W; i += GS_) {
        const int w = (int)(i % W), b = (int)((i / W) % NB), z = (int)(i / ((long)W * NB)); float carry = 0.f;
#pragma unroll 16
        for (int q = 0; q < NLC; ++q) { const int ch = z == 0 ? q : NLC - 1 - q; const size_t idx = (((size_t)z * NB + b) * NLC + ch) * W + w; CI[idx] = carry; carry = CA[idx] * carry + CH[idx]; }
    }
}
__device__ __forceinline__ void ph_rope_table(const Ctx& c) {
    const int* pos = (const int*)c.in[2]; float* RT = WSF(O_ROPE);
    for (long i = GT_; i < (long)T * 32; i += GS_) { const int j = (int)(i & 31); const float ang = (float)pos[i >> 5] * powf(10000.f, -(float)(2 * j) / 64.f); RT[i * 2] = cosf(ang); RT[i * 2 + 1] = sinf(ang); }
}
__device__ __forceinline__ void ret_tables(float* tab, int h) {
    const int tid = threadIdx.x; const float lg = loggamma_(h);
    if (tid < 32) tab[tid] = powf(10000.f, -(float)(2 * tid) / 64.f);
    if (tid >= 64 && tid < 64 + 129) tab[tid] = expf((float)(tid - 64) * lg);
}
__device__ __forceinline__ void ph_ret_kv(const Ctx& c, float* ldsf) {
    const float* RT = WSF(O_ROPE); const bf16_t* P = WSH(O_P); float* KVF = WSF(O_KVF); float* KVB = WSF(O_KVB);
    bf16_t* VT = (bf16_t*)ldsf; bf16_t* KF = VT + 128 * 136; bf16_t* KB = KF + 64 * 136; float* tab = (float*)(KB + 64 * 136);
    const int tid = threadIdx.x, wv = tid >> 6, lane = tid & 63, fr = lane & 15, fq = lane >> 4;
    for (int u = blockIdx.x; u < (T / 128) * 8; u += gridDim.x) {
        const int h = u & 7; const long t0 = (long)(u >> 3) * 128;
        ret_tables(tab, h);
        SYNCTHREADS();
        {
            const int j = tid >> 2, d0 = (tid & 3) * 8; const bf16_t* prow = P + (size_t)(t0 + j) * PW + C_RK + h * 64; const float* rt = RT + ((size_t)(t0 + j) * 32 + d0) * 2;
            const u32x4 kl = *(const u32x4*)(prow + d0), kh = *(const u32x4*)(prow + d0 + 32);
            const f32x4 r0 = *(const f32x4*)rt, r1 = *(const f32x4*)(rt + 4), r2 = *(const f32x4*)(rt + 8), r3 = *(const f32x4*)(rt + 12);
            const float cs[8] = {r0[0], r0[2], r1[0], r1[2], r2[0], r2[2], r3[0], r3[2]}, sn[8] = {r0[1], r0[3], r1[1], r1[3], r2[1], r2[3], r3[1], r3[3]};
            const float fj = tab[64 + 127 - j], bj = tab[64 + j];
#pragma unroll
            for (int e = 0; e < 8; ++e) { const float x1 = (e & 1) ? bfhi(kl[e >> 1]) : bflo(kl[e >> 1]), x2 = (e & 1) ? bfhi(kh[e >> 1]) : bflo(kh[e >> 1]);
                const float k1 = x1 * cs[e] - x2 * sn[e], k2 = x2 * cs[e] + x1 * sn[e];
                KF[(d0 + e) * 136 + j] = (bf16_t)f2bf(k1 * fj); KF[(d0 + e + 32) * 136 + j] = (bf16_t)f2bf(k2 * fj); KB[(d0 + e) * 136 + j] = (bf16_t)f2bf(k1 * bj); KB[(d0 + e + 32) * 136 + j] = (bf16_t)f2bf(k2 * bj); } }
#pragma unroll
        for (int q = 0; q < 4; ++q) { const int id = tid + NT * q, j = id & 127, e8 = (id >> 7) * 8; const u32x4 raw = *(const u32x4*)(P + (size_t)(t0 + j) * PW + C_RV + h * 128 + e8);
#pragma unroll
            for (int e = 0; e < 4; ++e) { VT[(e8 + 2 * e) * 136 + j] = (bf16_t)(raw[e] & 0xffffu); VT[(e8 + 2 * e + 1) * 136 + j] = (bf16_t)(raw[e] >> 16); } }
        SYNCTHREADS();
        f32x4 af[4], ab[4];
#pragma unroll
        for (int nt = 0; nt < 4; ++nt) { af[nt] = (f32x4){0.f, 0.f, 0.f, 0.f}; ab[nt] = (f32x4){0.f, 0.f, 0.f, 0.f}; }
        wave_mma<4, 4>(af, VT + wv * 16 * 136, 136, KF, 136);
        wave_mma<4, 4>(ab, VT + wv * 16 * 136, 136, KB, 136);
        const size_t ob = (((size_t)(u >> 3) * 8 + h) * 128 + wv * 16 + fr) * 64 + 4 * fq;
#pragma unroll
        for (int nt = 0; nt < 4; ++nt) { *(f32x4*)(KVF + ob + 16 * nt) = af[nt]; *(f32x4*)(KVB + ob + 16 * nt) = ab[nt]; }
        SYNCTHREADS();
    }
}
__device__ __forceinline__ void ph_ret_state(const Ctx& c) {
    const float* KVF = WSF(O_KVF); const float* KVB = WSF(O_KVB); float* STF = WSF(O_STF); float* STB = WSF(O_STB);
    for (long i = GT_; i < (long)NB * 8 * 8192; i += GS_) {
        const int x = (int)(i % 8192), h = (int)((i / 8192) % 8), b = (int)(i / 65536);
        const float cd = expf(128.f * loggamma_(h)); float st = 0.f;
#pragma unroll 16
        for (int n = 0; n < NCH; ++n) { const size_t idx = (((size_t)b * NCH + n) * 8 + h) * 8192 + x; STF[idx] = st; st = cd * st + KVF[idx]; }
        st = 0.f;
#pragma unroll 16
        for (int n = NCH - 1; n >= 0; --n) { const size_t idx = (((size_t)b * NCH + n) * 8 + h) * 8192 + x; STB[idx] = st; st = cd * st + KVB[idx]; }
    }
}
__device__ __forceinline__ void ph_ret_out(const Ctx& c, float* ldsf) {
    const float* RT = WSF(O_ROPE); const bf16_t* P = WSH(O_P); const float* STF = WSF(O_STF); const float* STB = WSF(O_STB); bf16_t* Y = WSH(O_YS);
    bf16_t* Qs = (bf16_t*)ldsf; bf16_t* Ks = Qs + 128 * 72; bf16_t* VT = Ks + 128 * 72; bf16_t* Ss = VT + 128 * 136; bf16_t* SF = Ss + 128 * 136; bf16_t* SB = SF + 128 * 72; float* tab = (float*)(SB + 128 * 72);
    const int tid = threadIdx.x, wv = tid >> 6, lane = tid & 63, fr = lane & 15, fq = lane >> 4;
    for (int u = blockIdx.x; u < (T / 128) * 8; u += gridDim.x) {
        const int h = u & 7; const long t0 = (long)(u >> 3) * 128;
        ret_tables(tab, h);
        SYNCTHREADS();
        {
            const int j = tid >> 2, d0 = (tid & 3) * 8; const bf16_t* prow = P + (size_t)(t0 + j) * PW + h * 64 + d0; const float* rt = RT + ((size_t)(t0 + j) * 32 + d0) * 2;
            const u32x4 ql = *(const u32x4*)(prow + C_RQ), qh = *(const u32x4*)(prow + C_RQ + 32), kl = *(const u32x4*)(prow + C_RK), kh = *(const u32x4*)(prow + C_RK + 32);
            const f32x4 r0 = *(const f32x4*)rt, r1 = *(const f32x4*)(rt + 4), r2 = *(const f32x4*)(rt + 8), r3 = *(const f32x4*)(rt + 12);
            const float cs[8] = {r0[0], r0[2], r1[0], r1[2], r2[0], r2[2], r3[0], r3[2]}, sn[8] = {r0[1], r0[3], r1[1], r1[3], r2[1], r2[3], r3[1], r3[3]};
            u32x4 oql, oqh, okl, okh;
#pragma unroll
            for (int e = 0; e < 4; ++e) { const int ea = 2 * e, eb = 2 * e + 1;
                const float q1a = bflo(ql[e]), q1b = bfhi(ql[e]), q2a = bflo(qh[e]), q2b = bfhi(qh[e]), k1a = bflo(kl[e]), k1b = bfhi(kl[e]), k2a = bflo(kh[e]), k2b = bfhi(kh[e]);
                oql[e] = pk2((q1a * cs[ea] - q2a * sn[ea]) * 0.125f, (q1b * cs[eb] - q2b * sn[eb]) * 0.125f); oqh[e] = pk2((q2a * cs[ea] + q1a * sn[ea]) * 0.125f, (q2b * cs[eb] + q1b * sn[eb]) * 0.125f);
                okl[e] = pk2(k1a * cs[ea] - k2a * sn[ea], k1b * cs[eb] - k2b * sn[eb]); okh[e] = pk2(k2a * cs[ea] + k1a * sn[ea], k2b * cs[eb] + k1b * sn[eb]); }
            *(u32x4*)(Qs + j * 72 + d0) = oql; *(u32x4*)(Qs + j * 72 + d0 + 32) = oqh; *(u32x4*)(Ks + j * 72 + d0) = okl; *(u32x4*)(Ks + j * 72 + d0 + 32) = okh; }
#pragma unroll
        for (int q = 0; q < 4; ++q) { const int id = tid + NT * q, j = id & 127, e8 = (id >> 7) * 8; const u32x4 raw = *(const u32x4*)(P + (size_t)(t0 + j) * PW + C_RV + h * 128 + e8);
#pragma unroll
            for (int e = 0; e < 4; ++e) { VT[(e8 + 2 * e) * 136 + j] = (bf16_t)(raw[e] & 0xffffu); VT[(e8 + 2 * e + 1) * 136 + j] = (bf16_t)(raw[e] >> 16); } }
        const size_t sbase = (((size_t)(u >> 3) * 8 + h)) * 8192;
#pragma unroll
        for (int q = 0; q < 4; ++q) { const int id = tid + NT * q, e = id >> 4, d4 = (id & 15) * 4; st_bf4(SF + e * 72 + d4, *(const f32x4*)(STF + sbase + (size_t)e * 64 + d4)); st_bf4(SB + e * 72 + d4, *(const f32x4*)(STB + sbase + (size_t)e * 64 + d4)); }
        SYNCTHREADS();
        const int i = wv * 16 + fr; const long t = t0 + i;
        {
            f32x4 sc[8];
#pragma unroll
            for (int nt = 0; nt < 8; ++nt) sc[nt] = (f32x4){0.f, 0.f, 0.f, 0.f};
            wave_mma<2, 8>(sc, Qs + wv * 16 * 72, 72, Ks, 72);
#pragma unroll
            for (int nt = 0; nt < 8; ++nt) { const int j0 = 16 * nt + 4 * fq; f32x4 sv;
#pragma unroll
                for (int e = 0; e < 4; ++e) { const int j = j0 + e, dist = i > j ? i - j : j - i; sv[e] = sc[nt][e] * tab[64 + dist]; }
                st_bf4(Ss + i * 136 + j0, sv); }
        }
#ifdef CPU_EMU
        SYNCTHREADS();
#else
        asm volatile("s_waitcnt lgkmcnt(0)" ::: "memory");
#endif
        f32x4 ao[8], tm[8];
#pragma unroll
        for (int nt = 0; nt < 8; ++nt) { ao[nt] = (f32x4){0.f, 0.f, 0.f, 0.f}; tm[nt] = (f32x4){0.f, 0.f, 0.f, 0.f}; }
        wave_mma<4, 8>(ao, Ss + wv * 16 * 136, 136, VT, 136);
        wave_mma<2, 8>(tm, Qs + wv * 16 * 72, 72, SF, 72);
        { const float qf = tab[64 + i + 1];
#pragma unroll
            for (int nt = 0; nt < 8; ++nt) { ao[nt] += tm[nt] * qf; tm[nt] = (f32x4){0.f, 0.f, 0.f, 0.f}; } }
        wave_mma<2, 8>(tm, Qs + wv * 16 * 72, 72, SB, 72);
        { const float qb = tab[64 + 128 - i];
#pragma unroll
            for (int nt = 0; nt < 8; ++nt) ao[nt] += tm[nt] * qb; }
        float sm = 0.f;
#pragma unroll
        for (int nt = 0; nt < 8; ++nt) sm += (ao[nt][0] + ao[nt][1]) + (ao[nt][2] + ao[nt][3]);
        sm += SHFL_XOR(sm, 16); sm += SHFL_XOR(sm, 32);
        const float mu = sm * (1.f / 128.f); float sq = 0.f;
#pragma unroll
        for (int nt = 0; nt < 8; ++nt) { ao[nt] -= mu; sq += (ao[nt][0] * ao[nt][0] + ao[nt][1] * ao[nt][1]) + (ao[nt][2] * ao[nt][2] + ao[nt][3] * ao[nt][3]); }
        sq += SHFL_XOR(sq, 16); sq += SHFL_XOR(sq, 32);
        const float rs = frsq_(sq * (1.f / 128.f) + EPS);
#pragma unroll
        for (int nt = 0; nt < 8; ++nt) { const int e0 = 16 * nt + 4 * fq; f32x4 gv = ld_bf4(P + (size_t)t * PW + C_RG + h * 128 + e0);
#pragma unroll
            for (int e = 0; e < 4; ++e) gv[e] = siluf_(gv[e]) * (ao[nt][e] * rs);
            st_bf4(Y + (size_t)t * 4 * W + 1 * W + h * 128 + e0, gv); }
        SYNCTHREADS();
    }
}
__device__ __forceinline__ void ph_sgu_norm(const Ctx& c, int l) {
    const bf16_t* P = WSH(O_P); float* ST = WSF(O_VN);
    const int lane = threadIdx.x & 63, gw = blockIdx.x * (NT / 64) + (threadIdx.x >> 6), ngw = gridDim.x * (NT / 64);
    for (int t = gw; t < T; t += ngw) {
        f32x4 v[4]; float sm = 0.f;
#pragma unroll
        for (int j = 0; j < 4; ++j) { v[j] = ld_bf4(P + (size_t)t * PW + C_SV + (j * 64 + lane) * 4);
#pragma unroll
            for (int q = 0; q < 4; ++q) { v[j][q] = geluf_(v[j][q]); sm += v[j][q]; } }
        const float mu = wave_sum(sm) * (1.f / W); float sq = 0.f;
#pragma unroll
        for (int j = 0; j < 4; ++j)
#pragma unroll
            for (int q = 0; q < 4; ++q) { const float dd = v[j][q] - mu; sq += dd * dd; }
        const float rs = 1.f / sqrtf(wave_sum(sq) * (1.f / W) + EPS);
        if (lane == 0) { ST[(size_t)t * 2] = mu; ST[(size_t)t * 2 + 1] = rs; }
    }
}
__device__ __forceinline__ void ph_sgu_mix(const Ctx& c, int l, float* ldsf) {
    const bf16_t* P = WSH(O_P); const float* SG = WSF(O_HF) + (size_t)T * 32; bf16_t* Y = WSH(O_YS); const float* ng = c.in[15] + (size_t)l * W;
    bf16_t* As = (bf16_t*)ldsf; bf16_t* Bs = As + 128 * 136; const int tid = threadIdx.x, wv = tid >> 6, lane = tid & 63, fr = lane & 15, fq = lane >> 4;
    int gprev = -1;
    for (int u = blockIdx.x; u < (T / 128) * 8; u += gridDim.x) {
        const int g = u & 7; const long t0 = (long)(u >> 3) * 128;
        const float* ws = c.in[16] + ((size_t)l * 8 + g) * 128 * 128; const float* bs = c.in[17] + ((size_t)l * 8 + g) * 128;
        if (g != gprev) {
#pragma unroll
            for (int q = 0; q < 8; ++q) { const int id = tid + NT * q, i = id >> 5, j4 = (id & 31) * 4; st_bf4(As + i * 136 + j4, *(const f32x4*)(ws + i * 128 + j4)); }
            gprev = g; }
        float mu, rs;
        { const f32x4* sg = (const f32x4*)(SG + (size_t)(t0 + (tid & 127)) * 32); f32x4 a = sg[0];
#pragma unroll
          for (int i = 1; i < 8; ++i) a += sg[i];
          mu = (a[0] + a[2]) * (1.f / W); rs = frsq_(fmaxf((a[1] + a[3]) * (1.f / W) - mu * mu, 0.f) + EPS); }
#pragma unroll
        for (int q = 0; q < 4; ++q) { const int id = tid + NT * q, j = id & 127, d8 = (id >> 7) * 8;
            const u32x4 raw = *(const u32x4*)(P + (size_t)(t0 + j) * PW + C_SV + g * 128 + d8); const f32x4 n0 = *(const f32x4*)(ng + g * 128 + d8), n1 = *(const f32x4*)(ng + g * 128 + d8 + 4);
            const float ngv[8] = {n0[0], n0[1], n0[2], n0[3], n1[0], n1[1], n1[2], n1[3]};
#pragma unroll
            for (int e = 0; e < 4; ++e) { const float v0 = (geluf_(bflo(raw[e])) - mu) * rs * ngv[2 * e], v1 = (geluf_(bfhi(raw[e])) - mu) * rs * ngv[2 * e + 1];
                Bs[(d8 + 2 * e) * 136 + j] = (bf16_t)f2bf(v0); Bs[(d8 + 2 * e + 1) * 136 + j] = (bf16_t)f2bf(v1); } }
        const int i = wv * 16 + fr; const long t = t0 + i; const float bsi = bs[i];
        unsigned long long uraw[8];
#pragma unroll
        for (int nt = 0; nt < 8; ++nt) uraw[nt] = *(const unsigned long long*)(P + (size_t)t * PW + C_SU + g * 128 + 16 * nt + 4 * fq);
        SYNCTHREADS();
        f32x4 acc[8];
#pragma unroll
        for (int nt = 0; nt < 8; ++nt) acc[nt] = (f32x4){0.f, 0.f, 0.f, 0.f};
        wave_mma<4, 8>(acc, As + wv * 16 * 136, 136, Bs, 136);
#pragma unroll
        for (int nt = 0; nt < 8; ++nt) { const int d = 16 * nt + 4 * fq; const unsigned ulo = (unsigned)uraw[nt], uhi = (unsigned)(uraw[nt] >> 32); f32x4 uu = (f32x4){bflo(ulo), bfhi(ulo), bflo(uhi), bfhi(uhi)};
#pragma unroll
            for (int e = 0; e < 4; ++e) uu[e] = geluf_(uu[e]) * (acc[nt][e] + bsi);
            st_bf4(Y + (size_t)t * 4 * W + 2 * W + g * 128 + d, uu); }
        SYNCTHREADS();
    }
}
__device__ __forceinline__ void ph_rw_shift(const Ctx& c, int l) {
    const bf16_t* P = WSH(O_P); const float* mup = c.in[18] + (size_t)l * RF; const float* mun = c.in[19] + (size_t)l * RF; bf16_t* FS = WSH(O_FS);
    const int lane = threadIdx.x & 63, gw = blockIdx.x * (NT / 64) + (threadIdx.x >> 6), ngw = gridDim.x * (NT / 64);
    for (int t0 = gw * 4; t0 < T; t0 += ngw * 4) {
        const bf16_t* pc = P + (size_t)t0 * PW + C_RW;
#pragma unroll 1
        for (int j = lane * 4; j < RF; j += 256) {
            const f32x4 z4 = (f32x4){0.f, 0.f, 0.f, 0.f}; f32x4 rowv[6];
#pragma unroll
            for (int r = 0; r < 6; ++r) { const int t = t0 - 1 + r; rowv[r] = (t >= 0 && t < T) ? ld_bf4(pc + (long)(r - 1) * PW + j) : z4; }
            const f32x4 mp = *(const f32x4*)(mup + j), mn = *(const f32x4*)(mun + j);
#pragma unroll
            for (int r = 0; r < 4; ++r) { const int t = t0 + r, sI = t % S; const f32x4 f = rowv[r + 1]; const f32x4 pv = sI > 0 ? rowv[r] : z4, nv = sI < S - 1 ? rowv[r + 2] : z4;
                f32x4 v = f + mp * (pv - f) + mn * (nv - f);
                if (j >= 3072 && j < 3200) {
#pragma unroll
                    for (int e = 0; e < 4; ++e) v[e] = tanhf_(v[e]); }
                else if (j >= 3328) {
#pragma unroll
                    for (int e = 0; e < 4; ++e) v[e] = sigmoidf_(v[e]); }
                st_bf4(FS + (size_t)t * RF + j, v); }
        }
    }
}
__device__ __forceinline__ void ph_rw_lora(const Ctx& c, int l, float* ldsf) {
    const bf16_t* FS = WSH(O_FS); const float* w0 = c.in[20] + (size_t)l * 2 * W; const float* a0 = c.in[22] + (size_t)l * 2 * W;
    const bf16_t* WUT = WSH(O_WUT); const bf16_t* WAT = WSH(O_WAT); const bf16_t* WGT = WSH(O_WGT);
    bf16_t* DEC = WSH(O_DEC); bf16_t* AA = WSH(O_AA); bf16_t* GG = WSH(O_GG);
    bf16_t* F = (bf16_t*)ldsf; bf16_t* B1 = F + 128 * 136; bf16_t* B2 = B1 + 128 * 136; const int tid = threadIdx.x, wv = tid >> 6, lane = tid & 63, fr = lane & 15, fq = lane >> 4;
    unsigned long long fpre[8]; u32x4 bpre[4];
#define LORA_LOAD(uu, rdd) do { const int wc0_ = ((uu) & 7) * 128; const long t0_ = (long)((uu) >> 3) * 128; \
        _Pragma("unroll") for (int q = 0; q < 8; ++q) { const int id = tid + NT * q, r = id >> 5, c4 = (id & 31) * 4; \
            const int col = (rdd) < 2 ? (c4 < 64 ? 3072 + (rdd) * 64 + c4 : 3200 + (rdd) * 64 + (c4 - 64)) : 3328 + c4; fpre[q] = *(const unsigned long long*)(FS + (size_t)(t0_ + r) * RF + col); } \
        if ((rdd) < 2) { _Pragma("unroll") for (int q = 0; q < 2; ++q) { const int id = tid + NT * q, w = id >> 3, r8 = (id & 7) * 8; \
            bpre[2 * q] = *(const u32x4*)(WUT + ((size_t)(rdd) * W + wc0_ + w) * 64 + r8); bpre[2 * q + 1] = *(const u32x4*)(WAT + ((size_t)(rdd) * W + wc0_ + w) * 64 + r8); } } \
        else { _Pragma("unroll") for (int q = 0; q < 4; ++q) { const int id = tid + NT * q, w = id >> 4, r8 = (id & 15) * 8; bpre[q] = *(const u32x4*)(WGT + ((size_t)wc0_ + w) * 128 + r8); } } } while (0)
    if ((int)blockIdx.x < (T / 128) * 8) LORA_LOAD((int)blockIdx.x, 0);
    for (int u = blockIdx.x; u < (T / 128) * 8; u += gridDim.x) {
        const int wc0 = (u & 7) * 128; const long t0 = (long)(u >> 3) * 128;
#pragma unroll
        for (int rd = 0; rd < 3; ++rd) {
#pragma unroll
            for (int q = 0; q < 8; ++q) { const int id = tid + NT * q, r = id >> 5, c4 = (id & 31) * 4; *(unsigned long long*)(F + r * 136 + c4) = fpre[q]; }
            if (rd < 2) {
#pragma unroll
                for (int q = 0; q < 2; ++q) { const int id = tid + NT * q, w = id >> 3, r8 = (id & 7) * 8; *(u32x4*)(B1 + w * 72 + r8) = bpre[2 * q]; *(u32x4*)(B2 + w * 72 + r8) = bpre[2 * q + 1]; }
            } else {
#pragma unroll
                for (int q = 0; q < 4; ++q) { const int id = tid + NT * q, w = id >> 4, r8 = (id & 15) * 8; *(u32x4*)(B1 + w * 136 + r8) = bpre[q]; }
            }
            if (rd < 2) LORA_LOAD(u, rd + 1); else if (u + (int)gridDim.x < (T / 128) * 8) LORA_LOAD(u + (int)gridDim.x, 0);
            LDS_BARRIER();
            f32x4 a1[8], a2[8];
#pragma unroll
            for (int nt = 0; nt < 8; ++nt) { a1[nt] = (f32x4){0.f, 0.f, 0.f, 0.f}; a2[nt] = (f32x4){0.f, 0.f, 0.f, 0.f}; }
            const long t = t0 + wv * 16 + fr;
            if (rd < 2) {
                wave_mma<2, 8>(a1, F + wv * 16 * 136, 136, B1, 72);
                wave_mma<2, 8>(a2, F + wv * 16 * 136 + 64, 136, B2, 72);
#pragma unroll
                for (int nt = 0; nt < 8; ++nt) { const int ch = wc0 + 16 * nt + 4 * fq; const f32x4 w0v = *(const f32x4*)(w0 + rd * W + ch), a0v = *(const f32x4*)(a0 + rd * W + ch); f32x4 dv, av;
#pragma unroll
                    for (int e = 0; e < 4; ++e) { dv[e] = fexp_(-DECAY_SCALE * sigmoidf_(a1[nt][e] + w0v[e])); av[e] = sigmoidf_(a2[nt][e] + a0v[e]); }
                    st_bf4(DEC + ((size_t)rd * T + t) * W + ch, dv); st_bf4(AA + ((size_t)rd * T + t) * W + ch, av); }
            } else {
                wave_mma<4, 8>(a1, F + wv * 16 * 136, 136, B1, 136);
#pragma unroll
                for (int nt = 0; nt < 8; ++nt) st_bf4(GG + (size_t)t * W + wc0 + 16 * nt + 4 * fq, a1[nt]);
            }
            LDS_BARRIER();
        }
    }
}
#ifdef CPU_EMU
__device__ __forceinline__ float red16_(float x) { x += SHFL_XOR(x, 1); x += SHFL_XOR(x, 2); x += SHFL_XOR(x, 4); x += SHFL_XOR(x, 8); return x; }
__device__ __forceinline__ float red8_(float x) { x += SHFL_XOR(x, 1); x += SHFL_XOR(x, 2); x += SHFL_XOR(x, 4); return x; }
#else
__device__ __forceinline__ float red8_(float x) {
    x += __builtin_bit_cast(float, __builtin_amdgcn_update_dpp(0, __builtin_bit_cast(int, x), 0xB1, 0xF, 0xF, true));
    x += __builtin_bit_cast(float, __builtin_amdgcn_update_dpp(0, __builtin_bit_cast(int, x), 0x4E, 0xF, 0xF, true));
    x += __builtin_bit_cast(float, __builtin_amdgcn_update_dpp(0, __builtin_bit_cast(int, x), 0x141, 0xF, 0xF, true));
    return x;
}
__device__ __forceinline__ float red16_(float x) {
    x += __builtin_bit_cast(float, __builtin_amdgcn_update_dpp(0, __builtin_bit_cast(int, x), 0xB1, 0xF, 0xF, true));
    x += __builtin_bit_cast(float, __builtin_amdgcn_update_dpp(0, __builtin_bit_cast(int, x), 0x4E, 0xF, 0xF, true));
    x += __builtin_bit_cast(float, __builtin_amdgcn_update_dpp(0, __builtin_bit_cast(int, x), 0x141, 0xF, 0xF, true));
    x += __builtin_bit_cast(float, __builtin_amdgcn_update_dpp(0, __builtin_bit_cast(int, x), 0x140, 0xF, 0xF, true));
    return x;
}
#endif
#define RC_M(k) (lm + (k) * 4608)
__device__ __forceinline__ void ph_rw_chunk(const Ctx& c, int l, float* ldsf) {
    const bf16_t* FS = WSH(O_FS); const bf16_t* DEC = WSH(O_DEC); const bf16_t* AA = WSH(O_AA); float* BON = WSF(O_BON);
    const float* kkw = c.in[25] + (size_t)l * W; const float* kaw = c.in[26] + (size_t)l * W; const float* rk = c.in[27] + (size_t)l * W;
    bf16_t* PST = WSH(O_PST); bf16_t* PYT = WSH(O_PYT); bf16_t* SVB = WSH(O_SVB); bf16_t* YVB = WSH(O_YVB);
    bf16_t* lm = (bf16_t*)ldsf; float* gam = (float*)RC_M(7); float* segp = (float*)RC_M(13); float* gl = segp + 512;
    const int tid = threadIdx.x, wv = tid >> 6, lane = tid & 63, fr = lane & 15, fq = lane >> 4, rt = wv & 3, hf = wv >> 2;
    const int m0 = 16 * rt + fr;
    u32x4 wq, kq, rq, vq, aq;
#define RC_LOAD(uu) do { const int chain_ = (uu) / NRC, ck_ = (uu) % NRC, h_ = chain_ & 15, b_ = (chain_ >> 4) & 1, z_ = chain_ >> 5; \
        const long t_ = (long)b_ * S + (z_ ? S - 1 - ck_ * RCK - (tid >> 3) : ck_ * RCK + (tid >> 3)); const int ch_ = h_ * 64 + (tid & 7) * 8; \
        wq = *(const u32x4*)(DEC + ((size_t)z_ * T + t_) * W + ch_); aq = *(const u32x4*)(AA + ((size_t)z_ * T + t_) * W + ch_); \
        const bf16_t* f_ = FS + (size_t)t_ * RF; rq = *(const u32x4*)(f_ + ch_); kq = *(const u32x4*)(f_ + 1024 + ch_); vq = *(const u32x4*)(f_ + 2048 + ch_); } while (0)
    if ((int)blockIdx.x < 64 * NRC) RC_LOAD((int)blockIdx.x);
    for (int u = blockIdx.x; u < 64 * NRC; u += gridDim.x) {
        const int chain = u / NRC, ck = u % NRC, h = chain & 15, b = (chain >> 4) & 1, z = chain >> 5;
        const long tb = (long)b * S + (z ? S - 1 - ck * RCK : ck * RCK); const int dirn = z ? -1 : 1;
        const int tt = tid >> 3, o8 = (tid & 7) * 8;
        const f32x4 kw0 = *(const f32x4*)(kkw + h * 64 + o8), kw1 = *(const f32x4*)(kkw + h * 64 + o8 + 4), ka0 = *(const f32x4*)(kaw + h * 64 + o8), ka1 = *(const f32x4*)(kaw + h * 64 + o8 + 4),
                    rk0 = *(const f32x4*)(rk + h * 64 + o8), rk1 = *(const f32x4*)(rk + h * 64 + o8 + 4);
        *(f32x4*)(gam + tt * 64 + o8) = (f32x4){bflo(wq[0]), bfhi(wq[0]), bflo(wq[1]), bfhi(wq[1])};
        *(f32x4*)(gam + tt * 64 + o8 + 4) = (f32x4){bflo(wq[2]), bfhi(wq[2]), bflo(wq[3]), bfhi(wq[3])};
        LDS_BARRIER();
        { const int k = tid & 63, sg = tid >> 6; float p = 1.f;
#pragma unroll
          for (int q = 0; q < 8; ++q) { p *= gam[(sg * 8 + q) * 64 + k]; gam[(sg * 8 + q) * 64 + k] = p; }
          segp[sg * 64 + k] = p; }
        LDS_BARRIER();
        { const int k = tid & 63, sg = tid >> 6; float pre = 1.f;
          for (int q = 0; q < sg; ++q) pre *= segp[q * 64 + k];
#pragma unroll
          for (int q = 0; q < 8; ++q) gam[(sg * 8 + q) * 64 + k] *= pre;
          if (sg == 7) gl[k] = gam[63 * 64 + k]; }
        LDS_BARRIER();
        { const long t = tb + dirn * tt;
          const f32x4 g0 = *(const f32x4*)(gam + tt * 64 + o8), g1 = *(const f32x4*)(gam + tt * 64 + o8 + 4);
          f32x4 p0 = (f32x4){1.f, 1.f, 1.f, 1.f}, p1 = p0; if (tt) { p0 = *(const f32x4*)(gam + (tt - 1) * 64 + o8); p1 = *(const f32x4*)(gam + (tt - 1) * 64 + o8 + 4); }
          float gx[8], gpx[8], kwx[8], kax[8], rkx[8], kx[8], ax[8], rx[8];
#pragma unroll
          for (int e = 0; e < 4; ++e) { gx[e] = g0[e]; gx[4 + e] = g1[e]; gpx[e] = p0[e]; gpx[4 + e] = p1[e]; kwx[e] = kw0[e]; kwx[4 + e] = kw1[e]; kax[e] = ka0[e]; kax[4 + e] = ka1[e]; rkx[e] = rk0[e]; rkx[4 + e] = rk1[e];
              kx[2 * e] = bflo(kq[e]); kx[2 * e + 1] = bfhi(kq[e]); ax[2 * e] = bflo(aq[e]); ax[2 * e + 1] = bfhi(aq[e]); rx[2 * e] = bflo(rq[e]); rx[2 * e + 1] = bfhi(rq[e]); }
          float vk[8], ktv[8], ss = 0.f, bs = 0.f;
#pragma unroll
          for (int e = 0; e < 8; ++e) { vk[e] = kx[e] * kwx[e]; ss += vk[e] * vk[e]; ktv[e] = kx[e] * (1.f + (ax[e] - 1.f) * kax[e]); bs += rx[e] * rkx[e] * ktv[e]; }
          ss = red8_(ss); bs = red8_(bs);
          if ((tid & 7) == 0) BON[((size_t)z * T + t) * 16 + h] = bs;
          const float rn = frsq_(ss + EPS); float khv[8], bhv[8], k2v[8], rhv[8];
#pragma unroll
          for (int e = 0; e < 8; ++e) { const float kkn = vk[e] * rn, ig = frcp_(gx[e]); khv[e] = kkn * gpx[e]; bhv[e] = ax[e] * kkn * ig; k2v[e] = ktv[e] * ig; rhv[e] = rx[e] * gx[e]; }
          u32x4 K4, B4, C4, R4;
#pragma unroll
          for (int e = 0; e < 4; ++e) { K4[e] = pk2(khv[2 * e], khv[2 * e + 1]); B4[e] = pk2(bhv[2 * e], bhv[2 * e + 1]); C4[e] = pk2(k2v[2 * e], k2v[2 * e + 1]); R4[e] = pk2(rhv[2 * e], rhv[2 * e + 1]); }
          *(u32x4*)(RC_M(0) + tt * 72 + o8) = K4; *(u32x4*)(RC_M(2) + tt * 72 + o8) = B4; *(u32x4*)(RC_M(4) + tt * 72 + o8) = C4; *(u32x4*)(RC_M(5) + tt * 72 + o8) = R4;
#pragma unroll
          for (int e = 0; e < 8; ++e) { const int sh = 16 * (e & 1);
              RC_M(1)[(o8 + e) * 72 + tt] = (bf16_t)(K4[e >> 1] >> sh); RC_M(3)[(o8 + e) * 72 + tt] = (bf16_t)(B4[e >> 1] >> sh); RC_M(6)[(o8 + e) * 72 + tt] = (bf16_t)(vq[e >> 1] >> sh); } }
        if (u + (int)gridDim.x < 64 * NRC) RC_LOAD(u + (int)gridDim.x);
        LDS_BARRIER();
        f32x4 mkr[2], khr[2], rhT[2];
        {
            f32x4 a0[2], a1[2], a2[2], a3[2];
#pragma unroll
            for (int nt = 0; nt < 2; ++nt) { a0[nt] = (f32x4){0.f, 0.f, 0.f, 0.f}; a1[nt] = a0[nt]; a2[nt] = a0[nt]; a3[nt] = a0[nt]; }
            wave_mma<2, 2>(a0, RC_M(2) + rt * 16 * 72, 72, RC_M(0) + hf * 32 * 72, 72);
            wave_mma<2, 2>(a1, RC_M(4) + rt * 16 * 72, 72, RC_M(0) + hf * 32 * 72, 72);
            wave_mma<2, 2>(a2, RC_M(2) + rt * 16 * 72, 72, RC_M(5) + hf * 32 * 72, 72);
            wave_mma<2, 2>(a3, RC_M(4) + rt * 16 * 72, 72, RC_M(5) + hf * 32 * 72, 72);
#pragma unroll
            for (int nt = 0; nt < 2; ++nt) { const int n0 = 32 * hf + 16 * nt + 4 * fq; f32x4 nn, ti, mk;
#pragma unroll
                for (int r = 0; r < 4; ++r) { const int n = n0 + r; const bool lt = m0 < n, le = m0 <= n;
                    nn[r] = lt ? -a0[nt][r] : 0.f; ti[r] = nn[r] + (m0 == n ? 1.f : 0.f); mk[r] = lt ? a1[nt][r] : 0.f; mkr[nt][r] = le ? a3[nt][r] : 0.f;
                    RC_M(12)[n * 72 + m0] = (bf16_t)f2bf(le ? a2[nt][r] : 0.f);
                    RC_M(8)[n * 72 + m0] = (bf16_t)f2bf(nn[r]);
                    khr[nt][r] = bf2f(RC_M(4)[m0 * 72 + n]); rhT[nt][r] = bf2f(RC_M(5)[n * 72 + m0]); }
                st_bf4(RC_M(7) + m0 * 72 + n0, nn); st_bf4(RC_M(9) + m0 * 72 + n0, ti); st_bf4(RC_M(11) + m0 * 72 + n0, mk); }
        }
        LDS_BARRIER();
        f32x4 tiv[2];
#pragma unroll
        for (int nt = 0; nt < 2; ++nt) tiv[nt] = ld_bf4(RC_M(9) + m0 * 72 + 32 * hf + 16 * nt + 4 * fq);
        {
            f32x4 sq[2];
#pragma unroll
            for (int nt = 0; nt < 2; ++nt) sq[nt] = (f32x4){0.f, 0.f, 0.f, 0.f};
            wave_mma<2, 2>(sq, RC_M(7) + rt * 16 * 72, 72, RC_M(8) + hf * 32 * 72, 72);
#pragma unroll
            for (int nt = 0; nt < 2; ++nt) { const int n0 = 32 * hf + 16 * nt + 4 * fq; st_bf4(RC_M(0) + m0 * 72 + n0, sq[nt]);
#pragma unroll
                for (int r = 0; r < 4; ++r) RC_M(2)[(n0 + r) * 72 + m0] = (bf16_t)f2bf(sq[nt][r]); }
        }
        LDS_BARRIER();
#pragma unroll 1
        for (int k = 1; k <= 5; ++k) {
            bf16_t* pk = (k & 1) ? RC_M(0) : RC_M(7); bf16_t* pkT = (k & 1) ? RC_M(2) : RC_M(8); bf16_t* pn = (k & 1) ? RC_M(7) : RC_M(0); bf16_t* pnT = (k & 1) ? RC_M(8) : RC_M(2);
            bf16_t* tcur = (k & 1) ? RC_M(9) : RC_M(4); bf16_t* tnxt = (k & 1) ? RC_M(4) : RC_M(9);
            f32x4 up[2], sq[2];
#pragma unroll
            for (int nt = 0; nt < 2; ++nt) { up[nt] = (f32x4){0.f, 0.f, 0.f, 0.f}; sq[nt] = up[nt]; }
            wave_mma<2, 2>(up, tcur + rt * 16 * 72, 72, pkT + hf * 32 * 72, 72);
            if (k < 5) wave_mma<2, 2>(sq, pk + rt * 16 * 72, 72, pkT + hf * 32 * 72, 72);
#pragma unroll
            for (int nt = 0; nt < 2; ++nt) { const int n0 = 32 * hf + 16 * nt + 4 * fq; tiv[nt] += up[nt]; st_bf4(tnxt + m0 * 72 + n0, tiv[nt]);
                if (k == 5) {
#pragma unroll
                    for (int r = 0; r < 4; ++r) RC_M(10)[(n0 + r) * 72 + m0] = (bf16_t)f2bf(tiv[nt][r]);
                } else { st_bf4(pn + m0 * 72 + n0, sq[nt]);
#pragma unroll
                    for (int r = 0; r < 4; ++r) pnT[(n0 + r) * 72 + m0] = (bf16_t)f2bf(sq[nt][r]); } }
            LDS_BARRIER();
        }
        {
            f32x4 w1[2], w2[2];
#pragma unroll
            for (int nt = 0; nt < 2; ++nt) { w1[nt] = (f32x4){0.f, 0.f, 0.f, 0.f}; w2[nt] = w1[nt]; }
            wave_mma<2, 2>(w1, RC_M(1) + rt * 16 * 72, 72, RC_M(10) + hf * 32 * 72, 72);
            wave_mma<2, 2>(w2, RC_M(11) + rt * 16 * 72, 72, RC_M(10) + hf * 32 * 72, 72);
#pragma unroll
            for (int nt = 0; nt < 2; ++nt) { const int n0 = 32 * hf + 16 * nt + 4 * fq; st_bf4(RC_M(7) + m0 * 72 + n0, w1[nt]); st_bf4(RC_M(8) + m0 * 72 + n0, w2[nt]); }
        }
        LDS_BARRIER();
        {
            f32x4 py[2], qy[2], ps[2], qs[2];
#pragma unroll
            for (int nt = 0; nt < 2; ++nt) { py[nt] = (f32x4){0.f, 0.f, 0.f, 0.f}; qy[nt] = py[nt]; ps[nt] = py[nt]; qs[nt] = py[nt]; }
            wave_mma<2, 2>(py, RC_M(7) + rt * 16 * 72, 72, RC_M(12) + hf * 32 * 72, 72);
            wave_mma<2, 2>(qy, RC_M(8) + rt * 16 * 72, 72, RC_M(12) + hf * 32 * 72, 72);
            wave_mma<2, 2>(ps, RC_M(7) + rt * 16 * 72, 72, RC_M(3) + hf * 32 * 72, 72);
            wave_mma<2, 2>(qs, RC_M(8) + rt * 16 * 72, 72, RC_M(3) + hf * 32 * 72, 72);
#pragma unroll
            for (int nt = 0; nt < 2; ++nt) { const int n0 = 32 * hf + 16 * nt + 4 * fq;
#pragma unroll
                for (int r = 0; r < 4; ++r) { const int n = n0 + r; const float gln = gl[n];
                    RC_M(0)[n * 72 + m0] = (bf16_t)f2bf(rhT[nt][r] - py[nt][r]); RC_M(2)[n * 72 + m0] = (bf16_t)f2bf(mkr[nt][r] - qy[nt][r]);
                    RC_M(4)[n * 72 + m0] = (bf16_t)f2bf(((m0 == n ? 1.f : 0.f) - ps[nt][r]) * gln); RC_M(5)[n * 72 + m0] = (bf16_t)f2bf((khr[nt][r] - qs[nt][r]) * gln); } }
        }
        LDS_BARRIER();
        {
            f32x4 yv[2], sv[2];
#pragma unroll
            for (int nt = 0; nt < 2; ++nt) { yv[nt] = (f32x4){0.f, 0.f, 0.f, 0.f}; sv[nt] = yv[nt]; }
            wave_mma<2, 2>(yv, RC_M(6) + rt * 16 * 72, 72, RC_M(2) + hf * 32 * 72, 72);
            wave_mma<2, 2>(sv, RC_M(6) + rt * 16 * 72, 72, RC_M(5) + hf * 32 * 72, 72);
#pragma unroll
            for (int nt = 0; nt < 2; ++nt) { const int n0 = 32 * hf + 16 * nt + 4 * fq; st_bf4(YVB + (size_t)u * 4096 + m0 * 64 + n0, yv[nt]); st_bf4(SVB + (size_t)u * 4096 + m0 * 64 + n0, sv[nt]); }
            { const int rr = tid >> 3, c8 = (tid & 7) * 8; *(u32x4*)(PYT + (size_t)u * 4096 + rr * 64 + c8) = *(const u32x4*)(RC_M(0) + rr * 72 + c8); *(u32x4*)(PST + (size_t)u * 4096 + rr * 64 + c8) = *(const u32x4*)(RC_M(4) + rr * 72 + c8); }
        }
        LDS_BARRIER();
    }
}
#undef RC_M
#undef RC_LOAD
__device__ __forceinline__ void ph_rw_seq(const Ctx& c, float* ldsf) {
    const bf16_t* PST = WSH(O_PST); const bf16_t* PYT = WSH(O_PYT); const bf16_t* SVB = WSH(O_SVB); const bf16_t* YVB = WSH(O_YVB); bf16_t* YY = WSH(O_YY);
    bf16_t* Sb = (bf16_t*)ldsf;
    bf16_t* Pm = Sb + 2 * 16 * 72;
    const int tid = threadIdx.x, wv = tid >> 6, lane = tid & 63, fr = lane & 15, fq = lane >> 4, nt0 = wv & 3;
#ifdef CPU_EMU
    const int isY = wv >> 2;
#else
    const int isY = __builtin_amdgcn_readfirstlane(wv >> 2);
#endif
    for (int u = blockIdx.x; u < 256; u += gridDim.x) {
        const int x = u & 7, jq = u >> 3, chain = x * 8 + (jq >> 2), qt = jq & 3, h = chain & 15, b = (chain >> 4) & 1, z = chain >> 5;
        const size_t ub = (size_t)chain * NRC;
        const int rr = tid >> 3, c8 = (tid & 7) * 8;
        constexpr int PD = NRC >= 8 ? 8 : 4;
        for (int i = tid; i < 2 * 16 * 72 / 2; i += NT) ((unsigned*)Sb)[i] = 0u;
        const int row = 16 * qt + fr, n0 = 16 * nt0 + 4 * fq; const bf16_t* addp = (isY ? YVB : SVB) + ub * 4096 + row * 64 + n0;
        const bf16_t* psp = PST + ub * 4096 + rr * 64 + c8; const bf16_t* pyp = PYT + ub * 4096 + rr * 64 + c8;
        u32x4 gps[PD], gpy[PD]; unsigned long long addr[PD];
#pragma unroll
        for (int j = 0; j < PD; ++j) { gps[j] = *(const u32x4*)(psp + (size_t)j * 4096); gpy[j] = *(const u32x4*)(pyp + (size_t)j * 4096); addr[j] = *(const unsigned long long*)(addp + (size_t)j * 4096); }
        *(u32x4*)(Pm + (0 * 2 + 0) * 4608 + rr * 72 + c8) = gps[0]; *(u32x4*)(Pm + (0 * 2 + 1) * 4608 + rr * 72 + c8) = gpy[0];
        { const int cl = PD < NRC ? PD : NRC - 1; gps[0] = *(const u32x4*)(psp + (size_t)cl * 4096); gpy[0] = *(const u32x4*)(pyp + (size_t)cl * 4096); }
        SYNCTHREADS();
#define RS_LOOP(ISY) \
        for (int ck0 = 0; ck0 < NRC; ck0 += PD) { \
            _Pragma("unroll") for (int j = 0; j < PD; ++j) { \
                const int ck = ck0 + j, cur = j & 1, nxt = cur ^ 1;        \
                f32x4 acc[1]; acc[0] = (f32x4){0.f, 0.f, 0.f, 0.f}; \
                wave_mma<2, 1>(acc, Sb + cur * 16 * 72, 72, Pm + (cur * 2 + ISY) * 4608 + nt0 * 16 * 72, 72); \
                { const unsigned lo_ = (unsigned)addr[j], hi_ = (unsigned)(addr[j] >> 32); acc[0][0] += bflo(lo_); acc[0][1] += bfhi(lo_); acc[0][2] += bflo(hi_); acc[0][3] += bfhi(hi_); } \
                { const int cl = ck + PD < NRC ? ck + PD : NRC - 1; addr[j] = *(const unsigned long long*)(addp + (size_t)cl * 4096); } \
                if (ISY) { \
                    _Pragma("unroll") for (int r = 0; r < 4; ++r) { const int step = ck * RCK + n0 + r, sidx = z ? S - 1 - step : step; YY[((size_t)z * T + (size_t)b * S + sidx) * W + h * 64 + row] = (bf16_t)f2bf(acc[0][r]); } \
                } else st_bf4(Sb + nxt * 16 * 72 + fr * 72 + n0, acc[0]); \
                const int jn = (j + 1) % PD; \
                *(u32x4*)(Pm + (nxt * 2 + 0) * 4608 + rr * 72 + c8) = gps[jn]; *(u32x4*)(Pm + (nxt * 2 + 1) * 4608 + rr * 72 + c8) = gpy[jn]; \
                { const int cl = ck + 1 + PD < NRC ? ck + 1 + PD : NRC - 1; gps[jn] = *(const u32x4*)(psp + (size_t)cl * 4096); gpy[jn] = *(const u32x4*)(pyp + (size_t)cl * 4096); } \
                LDS_BARRIER(); \
            } \
        }
        if (isY) { RS_LOOP(1) } else { RS_LOOP(0) }
#undef RS_LOOP
    }
}
__device__ __forceinline__ void ph_rw_out(const Ctx& c) {
    const bf16_t* FS = WSH(O_FS); const bf16_t* YY = WSH(O_YY); const float* BON = WSF(O_BON); const bf16_t* GG = WSH(O_GG); bf16_t* Y = WSH(O_YS);
    const int lane = threadIdx.x & 63, gw = blockIdx.x * (NT / 64) + (threadIdx.x >> 6), ngw = gridDim.x * (NT / 64);
    for (int i0 = gw; i0 < T * 2; i0 += 2 * ngw) {
        u32x4 a0[2], a1[2], gq[2], vq[2]; float bs[2];
#pragma unroll
        for (int r = 0; r < 2; ++r) { const int i = i0 + r * ngw < T * 2 ? i0 + r * ngw : i0; const long t = i >> 1; const int ch = (i & 1) * 512 + lane * 8, hd = ch >> 6;
            a0[r] = *(const u32x4*)(YY + (size_t)t * W + ch); a1[r] = *(const u32x4*)(YY + ((size_t)T + t) * W + ch); gq[r] = *(const u32x4*)(GG + (size_t)t * W + ch); vq[r] = *(const u32x4*)(FS + (size_t)t * RF + 2048 + ch);
            bs[r] = BON[(size_t)t * 16 + hd] + BON[((size_t)T + t) * 16 + hd]; }
#pragma unroll
        for (int r = 0; r < 2; ++r) { const int i = i0 + r * ngw < T * 2 ? i0 + r * ngw : i0; const long t = i >> 1; const int ch = (i & 1) * 512 + lane * 8;
            float y0[8], y1[8], s0 = 0.f, s1 = 0.f;
#pragma unroll
            for (int e = 0; e < 4; ++e) { y0[2 * e] = bflo(a0[r][e]); y0[2 * e + 1] = bfhi(a0[r][e]); y1[2 * e] = bflo(a1[r][e]); y1[2 * e + 1] = bfhi(a1[r][e]); }
#pragma unroll
            for (int e = 0; e < 8; ++e) { s0 += y0[e]; s1 += y1[e]; }
            const float m0 = red8_(s0) * (1.f / 64.f), m1 = red8_(s1) * (1.f / 64.f); float q0 = 0.f, q1 = 0.f;
#pragma unroll
            for (int e = 0; e < 8; ++e) { y0[e] -= m0; y1[e] -= m1; q0 += y0[e] * y0[e]; q1 += y1[e] * y1[e]; }
            const float r0 = frsq_(red8_(q0) * (1.f / 64.f) + EPS), r1 = frsq_(red8_(q1) * (1.f / 64.f) + EPS);
            u32x4 o;
#pragma unroll
            for (int e = 0; e < 4; ++e) { const float lo = (y0[2 * e] * r0 + y1[2 * e] * r1 + bs[r] * bflo(vq[r][e])) * bflo(gq[r][e]), hi = (y0[2 * e + 1] * r0 + y1[2 * e + 1] * r1 + bs[r] * bfhi(vq[r][e])) * bfhi(gq[r][e]); o[e] = pk2(lo, hi); }
            *(u32x4*)(Y + (size_t)t * 4 * W + 3 * W + ch) = o; }
    }
}
__device__ __forceinline__ float row_rstd_(const float* ssp, long tr) { const f32x4* q = (const f32x4*)(ssp + (size_t)tr * 32); f32x4 a = q[0];
#pragma unroll
    for (int i = 1; i < 8; ++i) a += q[i];
    return frsq_(((a[0] + a[1]) + (a[2] + a[3])) * (1.f / D) + EPS); }
__device__ __forceinline__ void ph_router(const Ctx& c, int l, float* ldsf, const float* X, const float* gN, const float* shN, const float* scN) {
    const float* SSP = WSF(O_HF); bf16_t* Hn = WSH(O_H); const bf16_t* WH = WSH(O_WRH); const bf16_t* WL = WSH(O_WRL); const float* bg = c.in[31] + (size_t)l * 4; const float* be = c.in[33] + (size_t)l * 32;
    int* EID = WSI(O_EID); float* EWT = WSF(O_EWT); int* cnt = CTLW(c) + CW_CNT + l * 64;
    const int tid = threadIdx.x, wv = tid >> 6, lane = tid & 63, fr = lane & 15, fq = lane >> 4, rt = wv & 1, kq = wv >> 1;
    float* part = ldsf;
    for (int u = blockIdx.x; u < T / 32; u += gridDim.x) {
        const long t0 = (long)u * 32; f32x4 acc[3];
#pragma unroll
        for (int nt = 0; nt < 3; ++nt) acc[nt] = (f32x4){0.f, 0.f, 0.f, 0.f};
#ifdef CPU_EMU
        for (int nt = 0; nt < 3; ++nt) for (int r = 0; r < 4; ++r) { const int n = 16 * nt + 4 * fq + r; float sacc = 0.f;
            for (int k = kq * 512; k < kq * 512 + 512; ++k) { const long tr = t0 + 16 * rt + fr; const int bb = (int)(tr / S); const float hv = X[(size_t)tr * D + k] * row_rstd_(SSP, tr) * gN[k] * (1.f + scN[bb * D6 + k]) + shN[bb * D6 + k]; const float hh = bf2f((bf16_t)f2bf(hv)), hl = bf2f((bf16_t)f2bf(hv - hh));
                const float wh = bf2f(WH[(size_t)n * D + k]), wl = bf2f(WL[(size_t)n * D + k]); sacc += hh * wh + hl * wh + hh * wl; }
            acc[nt][r] = sacc; }
        if (fq == 0) for (int k = kq * 512; k < kq * 512 + 512; ++k) { const long tr = t0 + 16 * rt + fr; const int bb = (int)(tr / S); Hn[(size_t)tr * D + k] = (bf16_t)f2bf(X[(size_t)tr * D + k] * row_rstd_(SSP, tr) * gN[k] * (1.f + scN[bb * D6 + k]) + shN[bb * D6 + k]); }
#else
        const long tr = t0 + 16 * rt + fr; const int bb = (int)(tr / S); const float rsv = row_rstd_(SSP, tr); const int kb = kq * 512 + fq * 8;
        const float* hp = X + (size_t)tr * D + kb; const float* gp_ = gN + kb; const float* scp = scN + bb * D6 + kb; const float* shp = shN + bb * D6 + kb;
#pragma unroll 4
        for (int ks = 0; ks < 16; ++ks) {
            const f32x4 h0 = *(const f32x4*)(hp + ks * 32) * rsv * *(const f32x4*)(gp_ + ks * 32) * (*(const f32x4*)(scp + ks * 32) + 1.f) + *(const f32x4*)(shp + ks * 32);
            const f32x4 h1 = *(const f32x4*)(hp + ks * 32 + 4) * rsv * *(const f32x4*)(gp_ + ks * 32 + 4) * (*(const f32x4*)(scp + ks * 32 + 4) + 1.f) + *(const f32x4*)(shp + ks * 32 + 4); bf16x8 ah, al;
#pragma unroll
            for (int e = 0; e < 4; ++e) { const unsigned b0 = f2bf(h0[e]), b1 = f2bf(h1[e]); ah[e] = (short)b0; ah[4 + e] = (short)b1; al[e] = (short)f2bf(h0[e] - u2f_(b0 << 16)); al[4 + e] = (short)f2bf(h1[e] - u2f_(b1 << 16)); }
            *(bf16x8*)(Hn + (size_t)tr * D + kb + ks * 32) = ah;
#pragma unroll
            for (int nt = 0; nt < 3; ++nt) { const size_t wo = (size_t)(16 * nt + fr) * D + kq * 512 + ks * 32 + fq * 8; const bf16x8 bh = *(const bf16x8*)(WH + wo), bl = *(const bf16x8*)(WL + wo);
                acc[nt] = __builtin_amdgcn_mfma_f32_16x16x32_bf16(bh, ah, acc[nt], 0, 0, 0); acc[nt] = __builtin_amdgcn_mfma_f32_16x16x32_bf16(bh, al, acc[nt], 0, 0, 0); acc[nt] = __builtin_amdgcn_mfma_f32_16x16x32_bf16(bl, ah, acc[nt], 0, 0, 0); }
        }
#endif
#pragma unroll
        for (int nt = 0; nt < 3; ++nt) *(f32x4*)(part + (kq * 32 + 16 * rt + fr) * 48 + 16 * nt + 4 * fq) = acc[nt];
        SYNCTHREADS();
        if (tid < 32) { const long t = t0 + tid; float lg[36];
#pragma unroll
            for (int q = 0; q < 36; ++q) lg[q] = (part[(0 * 32 + tid) * 48 + q] + part[(1 * 32 + tid) * 48 + q]) + (part[(2 * 32 + tid) * 48 + q] + part[(3 * 32 + tid) * 48 + q]) + (q < 4 ? bg[q < 4 ? q : 0] : be[q >= 4 ? q - 4 : 0]);
            int gi = 0; float m = lg[0];
#pragma unroll
            for (int q = 1; q < 4; ++q) if (lg[q] > m) { m = lg[q]; gi = q; }
            float den = 0.f;
#pragma unroll
            for (int q = 0; q < 4; ++q) den += expf(lg[q] - m);
            const float gp = 1.f / den; float el[8];
#pragma unroll
            for (int q = 0; q < 8; ++q) el[q] = gi == 0 ? lg[4 + q] : gi == 1 ? lg[12 + q] : gi == 2 ? lg[20 + q] : lg[28 + q];
            int i1 = 0; float m1 = el[0];
#pragma unroll
            for (int q = 1; q < 8; ++q) if (el[q] > m1) { m1 = el[q]; i1 = q; }
            int i2 = -1; float m2 = 0.f;
#pragma unroll
            for (int q = 0; q < 8; ++q) if (q != i1 && (i2 < 0 || el[q] > m2)) { m2 = el[q]; i2 = q; }
            const float p2 = expf(m2 - m1);
            EID[t * 2] = gi * 8 + i1; EID[t * 2 + 1] = gi * 8 + i2; EWT[t * 2] = gp / (1.f + p2); EWT[t * 2 + 1] = gp * p2 / (1.f + p2);
            atomic_add_i(cnt + gi * 8 + i1, 1); atomic_add_i(cnt + gi * 8 + i2, 1);
        }
        SYNCTHREADS();
    }
}
__device__ __forceinline__ void ph_moe_assign(const Ctx& c, int l, float* ldsf) {
    const int* cnt = CTLW(c) + CW_CNT + l * 64; int* plan = CTLW(c) + CW_PLAN + l * 256; const int* EID = WSI(O_EID); int* fill = CTLW(c) + CW_FILL + l * 64; int* DEST = WSI(O_DEST); int* SRC = WSI(O_XS);
    int* pstart = (int*)ldsf;
    if (threadIdx.x == 0) { int ps = 0, nb = 0; const bool pub = blockIdx.x == 0;
        for (int e = 0; e < NE; ++e) { pstart[e] = ps; if (pub) plan[e] = ps; const int nblk = (cnt[e] + 255) / 256; if (pub) for (int q = 0; q < nblk; ++q) plan[64 + nb + q] = e; nb += nblk; ps += nblk * 256; }
        if (pub) { plan[32] = ps; plan[40] = nb; } }
    SYNCTHREADS();
    for (long i = GT_; i < (long)T * 2; i += GS_) { const int e = EID[i]; const int pos = atomic_add_i(fill + e, 1); DEST[i] = pstart[e] + pos; SRC[pstart[e] + pos] = (int)(i >> 1); }
    SYNCTHREADS();
}
__device__ __forceinline__ void ph_moe_gather(const Ctx& c) {
    const int* DEST = WSI(O_DEST); const u32x4* H = (const u32x4*)WSH(O_H); u32x4* XS = (u32x4*)WSH(O_XS);
    const long N = (long)T * 2 * (D / 8);
    for (long i0 = GT_; i0 < N; i0 += 4 * GS_) {
        u32x4 v[4]; int d[4];
#pragma unroll
        for (int r = 0; r < 4; ++r) { const long i = i0 + r * GS_ < N ? i0 + r * GS_ : i0; const long a = i / (D / 8); d[r] = DEST[a]; v[r] = H[(size_t)(a >> 1) * (D / 8) + (int)(i % (D / 8))]; }
#pragma unroll
        for (int r = 0; r < 4; ++r) { const long i = i0 + r * GS_ < N ? i0 + r * GS_ : i0; XS[(size_t)d[r] * (D / 8) + (int)(i % (D / 8))] = v[r]; }
    }
}
#ifndef CPU_EMU
#define XB_TMO      128
#define XB_XCNT(j)  (256  + 64 * (j))
#define XB_XSUB(j)  (1280 + 64 * (j))
#define XB_XGEN(j)  (2304 + 64 * (j))
#define XB_TOP      3328
#define XB_TOPGEN   3392
#define XCD_BAR_WORDS 3456
#define XB_SPIN_CAP (1u << 26)
#define LAS __attribute__((address_space(3)))
__device__ __forceinline__ unsigned xb_ld(unsigned* p)              { return __hip_atomic_load(p, __ATOMIC_RELAXED, __HIP_MEMORY_SCOPE_AGENT); }
__device__ __forceinline__ unsigned xb_add(unsigned* p, unsigned v) { return __hip_atomic_fetch_add(p, v, __ATOMIC_RELAXED, __HIP_MEMORY_SCOPE_AGENT); }
__device__ __forceinline__ unsigned xb_xcc_id() { return (unsigned)__builtin_amdgcn_s_getreg((3 << 11) | 20) & 0xFu; }
#define XB_SPIN(cond, bar) do { unsigned _sp = 0; while (cond) { __builtin_amdgcn_s_sleep(1); \
    if ((++_sp & 255u) == 0u) { if (xb_ld(&(bar)[XB_TMO])) break; if (_sp > XB_SPIN_CAP) { atomicAdd(&(bar)[XB_TMO], 1u); break; } } } } while (0)
struct XcdBarrier { unsigned* bar; unsigned x; volatile LAS unsigned* st; };
__device__ __forceinline__ XcdBarrier xcd_barrier_post(unsigned* bar, volatile LAS unsigned* st) {
    XcdBarrier b; b.bar = bar; b.x = xb_xcc_id(); b.st = st;
    if (threadIdx.x == 0) (void)xb_add(&bar[XB_XCNT(b.x)], 1u);
    return b;
}
__device__ __forceinline__ void xcd_barrier_complete(unsigned* bar, unsigned x, unsigned& nloc, unsigned& nx) {
    const unsigned G = gridDim.x * gridDim.y * gridDim.z;
    unsigned sum, cnt, mine, sp = 0u;
    for (;;) {
        sum = 0u; cnt = 0u; mine = 0u;
#pragma unroll
        for (unsigned j = 0; j < 16; ++j) { const unsigned cc = xb_ld(&bar[XB_XCNT(j)]); sum += cc; cnt += (cc > 0u) ? 1u : 0u; mine = (j == x) ? cc : mine; }
        if (sum == G) break;
        __builtin_amdgcn_s_sleep(1);
        if ((++sp & 255u) == 0u) { if (xb_ld(&bar[XB_TMO])) break; if (sp > XB_SPIN_CAP) { atomicAdd(&bar[XB_TMO], 1u); break; } }
    }
    nloc = mine > 0u ? mine : 1u; nx = cnt > 0u ? cnt : 1u;
}
__device__ __forceinline__ void xcd_barrier(const XcdBarrier& b) {
    asm volatile("s_waitcnt vmcnt(0)" ::: "memory");
    __syncthreads();
    if (threadIdx.x == 0) {
        unsigned* bar = b.bar;
        __builtin_amdgcn_s_waitcnt(0);
        unsigned nloc = b.st[0], nx = b.st[1];
        if (nloc == 0u) { xcd_barrier_complete(bar, b.x, nloc, nx); b.st[0] = nloc; b.st[1] = nx; }
        const unsigned old = xb_add(&bar[XB_XSUB(b.x)], 1u);
        const unsigned gen = old / nloc;
        if (old + 1u == (gen + 1u) * nloc) {
            __builtin_amdgcn_fence(__ATOMIC_RELEASE, "agent");
            asm volatile("s_waitcnt vmcnt(0)" ::: "memory");
            const unsigned og = xb_add(&bar[XB_TOP], 1u);
            const unsigned tg = og / nx;
            if (og + 1u == (tg + 1u) * nx) xb_add(&bar[XB_TOPGEN], 1u);
            else XB_SPIN(xb_ld(&bar[XB_TOPGEN]) == tg, bar);
            __builtin_amdgcn_fence(__ATOMIC_ACQUIRE, "agent");
            xb_add(&bar[XB_XGEN(b.x)], 1u);
            asm volatile("s_waitcnt vmcnt(0)" ::: "memory");
        } else {
            XB_SPIN(xb_ld(&bar[XB_XGEN(b.x)]) == gen, bar);
            __builtin_amdgcn_fence(__ATOMIC_ACQUIRE, "agent");
            asm volatile("s_waitcnt vmcnt(0)" ::: "memory");
        }
    }
    __syncthreads();
}
#endif

constexpr int LDS_BYTES = 147456;

__global__ void __launch_bounds__(NT, 2) fwd(Params p) {
#ifdef CPU_EMU
    unsigned char* lds = g_lds; float* ldsf = (float*)g_lds;
#else
    extern __shared__ __attribute__((aligned(16))) unsigned char lds[];
    float* ldsf = (float*)lds;
    volatile LAS unsigned* misc = (volatile LAS unsigned*)((LAS unsigned char*)lds + LDS_BYTES - 64);
    if (threadIdx.x == 0) { misc[0] = 0u; misc[1] = 0u; }
    __syncthreads();
    XcdBarrier bar = xcd_barrier_post((unsigned*)(p.ws + O_CTL) + CW_BAR, misc);
#endif
    Ctx c; c.in = p.in; c.out = p.out; c.ws = p.ws;
    const int lo = p.ph_lo, hi = p.ph_hi; int ph = 0;
    const int G = (int)gridDim.x, cwg = (int)blockIdx.x;
#ifdef CPU_EMU
#define GRID_BAR()
#else
#define GRID_BAR() xcd_barrier(bar)
#endif
#ifndef REPEAT_MASK
#define REPEAT_MASK 0
#endif
#ifndef TIME_PHASE
#define TIME_PHASE -1
#endif
#if TIME_PHASE >= 0 && !defined(CPU_EMU)
    unsigned long long tp0 = 0, tp1 = 0;
#define TP_BEGIN() do { if (ph == TIME_PHASE) tp0 = __builtin_amdgcn_s_memrealtime(); } while (0)
#define TP_END() do { if (ph == TIME_PHASE) tp1 = __builtin_amdgcn_s_memrealtime(); } while (0)
#else
#define TP_BEGIN()
#define TP_END()
#endif
#define PHASE(...) do { if (lo <= ph && ph < hi) { TP_BEGIN(); __VA_ARGS__; if (ph + 1 < hi) { GRID_BAR(); } TP_END(); } ++ph; } while (0)
#define PHASEG(grp, ...) do { if (lo <= ph && ph < hi) { TP_BEGIN(); if ((REPEAT_MASK >> (grp)) & 1) { __VA_ARGS__; GRID_BAR(); } __VA_ARGS__; if (ph + 1 < hi) { GRID_BAR(); } TP_END(); } ++ph; } while (0)
    PHASE(ph_mod(c, ldsf); ph_rope_table(c); ph_convert(c, 0, ldsf));
#define LAYER_BODY(l) do { const float* mod = WSF(O_MOD); \
        const float* xin = l == 0 ? c.in[0] : WSF(O_X1); float* xmid = WSF(O_X0); float* xout = WSF(O_X1); \
        const float* ml = mod + (size_t)l * NB * D6; \
        PHASEG(0, { pg8::Gemm g{D, D, D}; pg8::StaticOrder so; so.init(T, PW, G, cwg, WSH(O_H), WSH(O_WIN), D, D); pg8::EpiP E{WSH(O_P), (unsigned char*)(c.ws + O_G8), WSF(O_HF) + (size_t)T * 32}; pg8::gemm_phase(lds, g, so, E); \
            { const int nun_ = (T / 256) * (PW / 256), rem_ = nun_ % G; if (rem_ != 0 && cwg >= rem_) { SYNCTHREADS(); convert_big(c, l, ldsf, J_ALL - convert_tail_tiles(), J_ALL, cwg - rem_, G - rem_); } } }); \
        PHASE(ph_lru<1>(c, l, ldsf); ph_ret_kv(c, ldsf); ph_rw_shift(c, l)); \
        PHASE(ph_lru_scan2(c); ph_ret_state(c); ph_sgu_mix(c, l, ldsf); ph_rw_lora(c, l, ldsf)); \
        PHASE(ph_lru_fin(c, ldsf); ph_ret_out(c, ldsf); ph_rw_chunk(c, l, ldsf)); \
        PHASE(ph_rw_seq(c, ldsf)); \
        PHASE(ph_rw_out(c)); \
        PHASEG(1, { pg8::Gemm g{4 * W, 4 * W, 4 * W}; pg8::StaticOrder so; so.init(T, D, G, cwg, WSH(O_YS), WSH(O_WBR), 4 * W, 4 * W); pg8::EpiMerge E{(const unsigned char*)(c.ws + O_G8), WSH(O_MRG)}; pg8::gemm_phase(lds, g, so, E); }); \
        PHASEG(1, { pg8::Gemm g{D, D, D}; pg8::StaticOrder so; so.init(T, D, G, cwg, WSH(O_MRG), WSH(O_WOUT), D, D); pg8::EpiResid E{xin, ml + 2 * D, xmid, WSF(O_HF)}; pg8::gemm_phase(lds, g, so, E); }); \
        PHASE(ph_router(c, l, ldsf, xmid, c.in[4] + (size_t)l * D, ml + 3 * D, ml + 4 * D)); \
        PHASE(ph_moe_assign(c, l, ldsf)); \
        const int* plan = CTLW(c) + CW_PLAN + l * 256; \
        PHASEG(2, { pg8::Gemm g{D, D, D}; pg8::MoeGatherOrder mo{G, cwg, 4, plan, (const char*)WSH(O_H), (const char*)WSH(O_WGU), (size_t)256 * D * 2, (size_t)1024 * D * 2, WSI(O_XS), T}; pg8::EpiGU E{WSH(O_ACT)}; pg8::gemm_phase(lds, g, mo, E); \
            if (l == 0) { const int nrest_ = plan[40] * 4 - G; if (nrest_ >= 0 && nrest_ < G && cwg >= nrest_) { SYNCTHREADS(); convert_big(c, 1, ldsf, 0, convert_early_tiles(c), cwg - nrest_, G - nrest_); } } }); \
        PHASEG(2, { pg8::Gemm g{512, 512, 512}; pg8::MoeOrder mo{G, cwg, 8, plan, (const char*)WSH(O_ACT), (const char*)WSH(O_WDN), (size_t)256 * 512 * 2, (size_t)256 * 512 * 2, (size_t)D * 512 * 2}; pg8::EpiBf16 E{WSH(O_YE), D}; pg8::gemm_phase(lds, g, mo, E); }); \
        if (l == 0) PHASE(ph_comb_norm<0>(c, xmid, ml + 5 * D, xout, c.in[3] + (size_t)1 * D, mod + (size_t)1 * NB * D6 + 0 * D, mod + (size_t)1 * NB * D6 + 1 * D, WSH(O_H), nullptr); ph_convert(c, 1, ldsf)); \
        else PHASE(ph_comb_norm<1>(c, xmid, ml + 5 * D, xout, c.in[36], nullptr, nullptr, nullptr, c.out)); \
    } while (0)
    PHASE(ph_norm(c, c.in[0], c.in[3], WSF(O_MOD) + 0 * D, WSF(O_MOD) + 1 * D, WSH(O_H), nullptr));
    LAYER_BODY(0);
    LAYER_BODY(1);
#undef LAYER_BODY
#if TIME_PHASE >= 0 && !defined(CPU_EMU)
    if (blockIdx.x == 0) { const unsigned long long te = __builtin_amdgcn_s_memrealtime(), dl = 8ull * (tp1 - tp0); while (__builtin_amdgcn_s_memrealtime() - te < dl) __builtin_amdgcn_s_sleep(8); }
#endif
#undef PHASE
}
}

#ifndef CPU_EMU
extern "C" void kernel_launch(void* const* d_in, const int* in_sizes, int n_in, void* d_out, int out_size, void* d_ws, size_t ws_size, hipStream_t stream) {
    static int grid = 0;
    if (grid == 0) {
        if (n_in != 37 || out_size != T * D || ws_size < WS_END) { fprintf(stderr, "kernel_launch: unexpected shapes (n_in %d out %d ws %zu need %zu)\n", n_in, out_size, ws_size, (size_t)WS_END); grid = -1; return; }
        int dev = 0, cus = 0, per_cu = 0;
        if (hipGetDevice(&dev) != hipSuccess || hipDeviceGetAttribute(&cus, hipDeviceAttributeMultiprocessorCount, dev) != hipSuccess) { grid = -1; return; }
        if (hipFuncSetAttribute((const void*)fwd, hipFuncAttributeMaxDynamicSharedMemorySize, LDS_BYTES) != hipSuccess) { fprintf(stderr, "kernel_launch: hipFuncSetAttribute failed\n"); grid = -1; return; }
        if (hipOccupancyMaxActiveBlocksPerMultiprocessor(&per_cu, (const void*)fwd, NT, LDS_BYTES) != hipSuccess || per_cu < 1) fprintf(stderr, "kernel_launch: occupancy query says %d\n", per_cu);
        (void)hipGetLastError();
        grid = cus;
    }
    if (grid < 0) return;
    (void)in_sizes;
    (void)hipMemsetAsync((char*)d_ws + O_CTL, 0, CTL_BYTES, stream);
    Params p{};
    for (int i = 0; i < 37; ++i) p.in[i] = (const float*)d_in[i];
    p.out = (float*)d_out; p.ws = (unsigned char*)d_ws;
#if ONE_LAUNCH
    p.ph_lo = 0; p.ph_hi = NPH;
    hipLaunchKernelGGL(fwd, dim3(grid), dim3(NT), LDS_BYTES, stream, p);
#else
    for (int k = 0; k < NPH; ++k) { p.ph_lo = k; p.ph_hi = k + 1; hipLaunchKernelGGL(fwd, dim3(grid), dim3(NT), LDS_BYTES, stream, p); }
#endif
}
#endif
```

```cpp
#ifndef CPU_EMU
#include <hip/hip_runtime.h>
#endif
#include <cstdio>
#include <cstdint>
#include <cmath>
#include <cstring>

#ifndef SEQ
#define SEQ 4096
#endif
#ifndef ONE_LAUNCH
#define ONE_LAUNCH 1
#endif

namespace {
constexpr int D = 2048, NB = 2, S = SEQ, T = NB * S, NL = 2, W = 1024;
constexpr int INW = 18816, RF = 3456, D6 = 6 * D;
constexpr int C_LX = 0, C_LG = 1024, C_RQ = 2048, C_RK = 2560, C_RV = 3072, C_RG = 4096, C_SU = 5120, C_SV = 6144, C_RW = 7168;
constexpr int PW = 18944, C_MLP = 10752;
constexpr int NCH = S / 128;
constexpr int NLC = S / 64;
constexpr int NE = 32, CAP = (T * 2 / 256 + NE) * 256, MAXBLK = CAP / 256;
constexpr float EPS = 1e-6f;
constexpr float DECAY_SCALE = 0.60653065971263342f;
constexpr int NT = 512;
constexpr int NPH_LAYER = 13, NPH = 2 + NL * NPH_LAYER;
typedef unsigned short bf16_t;
#ifdef CPU_EMU
typedef float f32x4 __attribute__((vector_size(16)));
typedef unsigned u32x4 __attribute__((vector_size(16)));
#else
typedef float f32x4 __attribute__((ext_vector_type(4)));
typedef unsigned u32x4 __attribute__((ext_vector_type(4)));
typedef short bf16x8 __attribute__((ext_vector_type(8)));
#endif

constexpr size_t al256(size_t x) { return (x + 255) & ~(size_t)255; }
constexpr size_t SZ_X = (size_t)T * D * 4, SZ_W = (size_t)T * W * 4;
constexpr size_t O_CTL = 0, CTL_BYTES = 1u << 20;
constexpr size_t O_MOD = CTL_BYTES;
constexpr size_t O_X0 = O_MOD + al256((size_t)NL * NB * D6 * 4);
constexpr size_t O_X1 = O_X0 + SZ_X;
constexpr size_t O_H = O_X1 + SZ_X;
constexpr size_t O_HF = O_H + SZ_X / 2;
constexpr size_t O_P = O_HF + SZ_X;
constexpr size_t SZ_P = (size_t)T * PW * 2;
constexpr size_t O_XC = O_P + SZ_P;
constexpr size_t O_LA = O_XC + SZ_W, O_LU = O_LA + 2 * SZ_W;
constexpr size_t SZ_LC = (size_t)2 * NB * NLC * W * 4;
constexpr size_t O_LCA = O_LU + 2 * SZ_W, O_LCH = O_LCA + SZ_LC, O_LCI = O_LCH + SZ_LC;
constexpr size_t O_YS = O_LCI + SZ_LC;
constexpr size_t O_SC = O_YS + (size_t)T * 4 * W * 2;
constexpr size_t SZ_KV = (size_t)NB * NCH * 8 * 64 * 128 * 4;
constexpr size_t O_KVF = O_SC, O_KVB = O_KVF + SZ_KV, O_STF = O_KVB + SZ_KV, O_STB = O_STF + SZ_KV;
constexpr size_t O_VN = O_STB + SZ_KV;
constexpr size_t O_FS = O_VN + SZ_W;
constexpr size_t O_DEC = O_FS + al256((size_t)T * RF * 4), O_AA = O_DEC + 2 * SZ_W, O_AKK = O_AA + 2 * SZ_W;
constexpr size_t O_GG = O_AKK, O_YY = O_GG + SZ_W;
constexpr int RCK = 64, NRC = S / RCK;
constexpr size_t O_BON = O_YY + 2 * SZ_W;
constexpr size_t O_PART = O_BON + al256((size_t)2 * T * 16 * 4);
constexpr size_t O_MRG = O_PART + SZ_X;
constexpr size_t O_LOG = O_MRG + SZ_X / 2;
constexpr size_t O_EID = O_LOG + al256((size_t)T * 40 * 4), O_EWT = O_EID + al256((size_t)T * 2 * 4), O_DEST = O_EWT + al256((size_t)T * 2 * 4);
constexpr size_t O_SLOT = O_DEST + al256((size_t)T * 2 * 4);
constexpr size_t O_PST = O_SLOT + al256((size_t)CAP * 4), O_PYT = O_PST + (size_t)64 * NRC * 4096 * 2, O_SVB = O_PYT + (size_t)64 * NRC * 4096 * 2, O_YVB = O_SVB + (size_t)64 * NRC * 4096 * 4;
constexpr size_t O_WIN = O_YVB + (size_t)64 * NRC * 4096 * 4;
constexpr size_t O_WBR = O_WIN + (size_t)PW * D * 2;
constexpr size_t O_WOUT = O_WBR + (size_t)D * 4 * W * 2;
constexpr size_t O_WGU = O_WOUT + (size_t)D * D * 2;
constexpr size_t O_WDN = O_WGU + (size_t)NE * 1024 * D * 2;
constexpr size_t O_G8 = O_WDN + (size_t)NE * D * 512 * 2;
constexpr size_t O_ROPE = O_G8 + (size_t)T * 4 * D;
constexpr size_t O_WLR = O_ROPE + (size_t)T * 64 * 4;
constexpr size_t O_WUT = O_WLR + (size_t)32 * 128 * 128 * 2;
constexpr size_t O_WAT = O_WUT + (size_t)2 * W * 64 * 2;
constexpr size_t O_WGT = O_WAT + (size_t)2 * W * 64 * 2;
constexpr size_t O_WRH = O_WGT + (size_t)W * 128 * 2;
constexpr size_t O_WRL = O_WRH + (size_t)48 * D * 2;
constexpr size_t WS_END0 = O_WRL + (size_t)48 * D * 2;
constexpr size_t SZ_MOE = (size_t)CAP * (D + 512 + D) * 2;
constexpr bool MOE_OVERLAY = SZ_MOE <= SZ_P;
constexpr size_t O_XS = MOE_OVERLAY ? O_P : WS_END0;
constexpr size_t O_ACT = O_XS + (size_t)CAP * D * 2;
constexpr size_t O_YE = O_ACT + (size_t)CAP * 512 * 2;
constexpr size_t WS_END = MOE_OVERLAY ? WS_END0 : WS_END0 + SZ_MOE;
static_assert(SEQ != 4096 || WS_END <= (size_t)2040 * 1024 * 1024, "workspace budget: d_ws is 4 x the largest input = 2048 MiB");
constexpr int CW_BAR = 4096;
constexpr int CW_CNT = 32768;
constexpr int CW_FILL = CW_CNT + NL * 64;
constexpr int CW_PLAN = CW_FILL + NL * 64;
static_assert(MAXBLK <= 160, "plan words");

struct Params { const float* in[37]; float* out; unsigned char* ws; int ph_lo, ph_hi; };

struct Ctx { const float* const* in; float* out; unsigned char* ws; };
#define GT_ ((long)blockIdx.x * NT + threadIdx.x)
#define GS_ ((long)gridDim.x * NT)
#define WSF(off) ((float*)(c.ws + (off)))
#define WSI(off) ((int*)(c.ws + (off)))
#define WSH(off) ((bf16_t*)(c.ws + (off)))
#define CTLW(c) ((int*)((c).ws + O_CTL))

#ifdef CPU_EMU
__device__ __forceinline__ float fexp_(float x) { return expf(x); }
__device__ __forceinline__ float frcp_(float x) { return 1.f / x; }
__device__ __forceinline__ float frsq_(float x) { return 1.f / sqrtf(x); }
__device__ __forceinline__ float fsqrt_(float x) { return sqrtf(x); }
#else
__device__ __forceinline__ float fexp_(float x) { return __builtin_amdgcn_exp2f(x * 1.4426950408889634f); }
__device__ __forceinline__ float frcp_(float x) { return __builtin_amdgcn_rcpf(x); }
__device__ __forceinline__ float frsq_(float x) { return __builtin_amdgcn_rsqf(x); }
__device__ __forceinline__ float fsqrt_(float x) { return __builtin_amdgcn_sqrtf(x); }
#endif
__device__ __forceinline__ float sigmoidf_(float x) { return frcp_(1.f + fexp_(-x)); }
__device__ __forceinline__ float siluf_(float x) { return x * frcp_(1.f + fexp_(-x)); }
__device__ __forceinline__ float tanhf_(float x) { return 1.f - 2.f * frcp_(1.f + fexp_(2.f * x)); }
#ifdef CPU_EMU
__device__ __forceinline__ float geluf_(float x) { return 0.5f * x * (1.f + tanhf_(0.7978845608028654f * (x + 0.044715f * x * x * x))); }
#else
__device__ __forceinline__ float geluf_(float x) { return x * __builtin_amdgcn_rcpf(1.f + __builtin_amdgcn_exp2f(-x * (2.3022082f + 0.10294324f * x * x))); }
#endif
__device__ __forceinline__ float softplusf_(float x) { return x > 0.f ? x + log1pf(expf(-x)) : log1pf(expf(x)); }
__device__ __forceinline__ float loggamma_(int h) { return log1pf(-exp2f(-5.f - (float)h)); }
__device__ __forceinline__ unsigned f2u_(float f) { unsigned u; memcpy(&u, &f, 4); return u; }
__device__ __forceinline__ float u2f_(unsigned u) { float f; memcpy(&f, &u, 4); return f; }
__device__ __forceinline__ float bf2f(bf16_t v) { return u2f_((unsigned)v << 16); }
#ifdef CPU_EMU
__device__ __forceinline__ unsigned f2bf(float f) { const unsigned u = f2u_(f); return (u + 0x7fffu + ((u >> 16) & 1u)) >> 16; }
__device__ __forceinline__ unsigned pk2(float lo, float hi) { return f2bf(lo) | (f2bf(hi) << 16); }
#else
typedef __attribute__((ext_vector_type(2))) __bf16 hwbf2_t; typedef __attribute__((ext_vector_type(2))) float hwf2_t;
__device__ __forceinline__ unsigned f2bf(float f) { const __bf16 s = (__bf16)f; return (unsigned)__builtin_bit_cast(unsigned short, s); }
__device__ __forceinline__ unsigned pk2(float lo, float hi) { const hwf2_t v = {lo, hi}; return __builtin_bit_cast(unsigned, __builtin_convertvector(v, hwbf2_t)); }
#endif
__device__ __forceinline__ float bflo(unsigned w) { return u2f_(w << 16); }
__device__ __forceinline__ float bfhi(unsigned w) { return u2f_(w & 0xffff0000u); }
__device__ __forceinline__ int atomic_add_i(int* p, int v) {
#ifdef CPU_EMU
    return __atomic_fetch_add(p, v, __ATOMIC_RELAXED);
#else
    return atomicAdd(p, v);
#endif
}
#define PF(P, r, col) bf2f((P)[(size_t)(r) * PW + (col)])
#ifdef CPU_EMU
#define SYNCTHREADS() emu_syncthreads()
#define LDS_BARRIER() emu_syncthreads()
#define SHFL_XOR(v, m) emu_shfl_xor(v, m)
#else
#define SYNCTHREADS() __syncthreads()
#define LDS_BARRIER() do { asm volatile("s_waitcnt lgkmcnt(0)" ::: "memory"); __builtin_amdgcn_s_barrier(); asm volatile("" ::: "memory"); } while (0)
#define SHFL_XOR(v, m) __shfl_xor(v, m)
#endif
#ifdef CPU_EMU
__device__ __forceinline__ float wave_sum(float v) {
    for (int o = 1; o < 64; o <<= 1) v += SHFL_XOR(v, o);
    return v;
}
#else
__device__ __forceinline__ float wave_sum(float x) {
    x += __builtin_bit_cast(float, __builtin_amdgcn_update_dpp(0, __builtin_bit_cast(int, x), 0xB1, 0xF, 0xF, true));
    x += __builtin_bit_cast(float, __builtin_amdgcn_update_dpp(0, __builtin_bit_cast(int, x), 0x4E, 0xF, 0xF, true));
    x += __builtin_bit_cast(float, __builtin_amdgcn_update_dpp(0, __builtin_bit_cast(int, x), 0x141, 0xF, 0xF, true));
    x += __builtin_bit_cast(float, __builtin_amdgcn_update_dpp(0, __builtin_bit_cast(int, x), 0x140, 0xF, 0xF, true));
    const int xi = __builtin_bit_cast(int, x);
    return (__builtin_bit_cast(float, __builtin_amdgcn_readlane(xi, 0)) + __builtin_bit_cast(float, __builtin_amdgcn_readlane(xi, 16))) + (__builtin_bit_cast(float, __builtin_amdgcn_readlane(xi, 32)) + __builtin_bit_cast(float, __builtin_amdgcn_readlane(xi, 48)));
}
#endif
__device__ __forceinline__ f32x4 ld_bf4(const bf16_t* p) { const unsigned long long q = *(const unsigned long long*)p; const unsigned lo = (unsigned)q, hi = (unsigned)(q >> 32); return (f32x4){bflo(lo), bfhi(lo), bflo(hi), bfhi(hi)}; }
__device__ __forceinline__ void st_bf4(bf16_t* p, const f32x4 v) { *(unsigned long long*)p = (unsigned long long)pk2(v[0], v[1]) | ((unsigned long long)pk2(v[2], v[3]) << 32); }

template <int KT, int NTL>
__device__ __forceinline__ void wave_mma(f32x4 (&acc)[NTL], const bf16_t* A, int lda, const bf16_t* Bt, int ldb) {
    const int lane = threadIdx.x & 63, fr = lane & 15, fq = lane >> 4;
#ifdef CPU_EMU
    for (int nt = 0; nt < NTL; ++nt) for (int r = 0; r < 4; ++r) { float sacc = 0.f; const bf16_t* a = A + fr * lda; const bf16_t* b = Bt + (16 * nt + 4 * fq + r) * ldb;
        for (int k = 0; k < 32 * KT; ++k) sacc += bf2f(a[k]) * bf2f(b[k]);
        acc[nt][r] += sacc; }
#else
#pragma unroll
    for (int kt = 0; kt < KT; ++kt) {
        const bf16x8 af = *(const bf16x8*)(A + fr * lda + kt * 32 + fq * 8);
#pragma unroll
        for (int nt = 0; nt < NTL; ++nt) { const bf16x8 bfr = *(const bf16x8*)(Bt + (16 * nt + fr) * ldb + kt * 32 + fq * 8);
            acc[nt] = __builtin_amdgcn_mfma_f32_16x16x32_bf16(bfr, af, acc[nt], 0, 0, 0); }
    }
#endif
}
__device__ __forceinline__ void ph_mod(const Ctx& c, float* ldsf) {
    const float* cc = c.in[1]; const float* aw = c.in[5]; const float* ab = c.in[6]; float* mod = WSF(O_MOD);
    float* scs = ldsf; float* part = ldsf + NB * D; const int tid = threadIdx.x, c4 = (tid & 31) * 4, kq = tid >> 5;
    for (int i = tid; i < NB * D; i += NT) scs[i] = siluf_(cc[i]);
    SYNCTHREADS();
    for (int u = blockIdx.x; u < NL * (D6 / 128); u += gridDim.x) {
        const int l = u / (D6 / 128), j0 = (u % (D6 / 128)) * 128;
        const float* w = aw + (size_t)l * D * D6 + j0 + c4; f32x4 a0 = (f32x4){0.f, 0.f, 0.f, 0.f}, a1 = a0;
#pragma unroll 8
        for (int k = kq * 128; k < kq * 128 + 128; ++k) { const f32x4 wv = *(const f32x4*)(w + (size_t)k * D6); a0 += wv * scs[k]; a1 += wv * scs[D + k]; }
        *(f32x4*)(part + (kq * 2 + 0) * 128 + c4) = a0; *(f32x4*)(part + (kq * 2 + 1) * 128 + c4) = a1;
        SYNCTHREADS();
        if (tid < 256) { const int b = tid >> 7, col = tid & 127; float sacc = 0.f;
#pragma unroll
            for (int q = 0; q < 16; ++q) sacc += part[(q * 2 + b) * 128 + col];
            mod[((size_t)l * NB + b) * D6 + j0 + col] = sacc + ab[l * D6 + j0 + col]; }
        SYNCTHREADS();
    }
}
__device__ __forceinline__ void ph_norm(const Ctx& c, const float* x, const float* g, const float* sh, const float* sc, bf16_t* hb, float* hf) {
    const int lane = threadIdx.x & 63, gw = blockIdx.x * (NT / 64) + (threadIdx.x >> 6), ngw = gridDim.x * (NT / 64);
    for (int t0 = gw * 2; t0 < T; t0 += ngw * 2) {
        f32x4 v[2][8]; float ss[2] = {0.f, 0.f};
#pragma unroll
        for (int r = 0; r < 2; ++r)
#pragma unroll
            for (int j = 0; j < 8; ++j) v[r][j] = *(const f32x4*)(x + (size_t)(t0 + r) * D + (j * 64 + lane) * 4);
#pragma unroll
        for (int r = 0; r < 2; ++r) {
#pragma unroll
            for (int j = 0; j < 8; ++j) ss[r] += (v[r][j][0] * v[r][j][0] + v[r][j][1] * v[r][j][1]) + (v[r][j][2] * v[r][j][2] + v[r][j][3] * v[r][j][3]);
            const int t = t0 + r, b = t / S; const float rs = 1.f / sqrtf(wave_sum(ss[r]) * (1.f / D) + EPS);
#pragma unroll
            for (int j = 0; j < 8; ++j) { const int col = (j * 64 + lane) * 4;
                const f32x4 o = v[r][j] * rs * *(const f32x4*)(g + col) * (*(const f32x4*)(sc + b * D6 + col) + 1.f) + *(const f32x4*)(sh + b * D6 + col);
                st_bf4(hb + (size_t)t * D + col, o); }
            if (hf && lane == 0) hf[t] = rs;
        }
    }
}
template <int MODE>
__device__ __forceinline__ void ph_comb_norm(const Ctx& c, const float* xmid, const float* g2, float* xout, const float* g, const float* sh, const float* sc, bf16_t* hb, float* outp) {
    const bf16_t* YE = WSH(O_YE); const float* EWT = WSF(O_EWT); const int* DEST = WSI(O_DEST);
    const int lane = threadIdx.x & 63, gw = blockIdx.x * (NT / 64) + (threadIdx.x >> 6), ngw = gridDim.x * (NT / 64);
    float w0n = 0.f, w1n = 0.f; int d0n = 0, d1n = 0;
    if (gw < T) { w0n = EWT[gw * 2]; w1n = EWT[gw * 2 + 1]; d0n = DEST[gw * 2]; d1n = DEST[gw * 2 + 1]; }
    for (int t = gw; t < T; t += ngw) {
        const int b = t / S; const float w0 = w0n, w1 = w1n; const bf16_t* y0 = YE + (size_t)d0n * D; const bf16_t* y1 = YE + (size_t)d1n * D;
        if (t + ngw < T) { const int tn = t + ngw; w0n = EWT[tn * 2]; w1n = EWT[tn * 2 + 1]; d0n = DEST[tn * 2]; d1n = DEST[tn * 2 + 1]; }
        f32x4 v[8]; float ss = 0.f;
#pragma unroll
        for (int j = 0; j < 8; ++j) { const int col = (j * 64 + lane) * 4;
            v[j] = *(const f32x4*)(xmid + (size_t)t * D + col) + *(const f32x4*)(g2 + b * D6 + col) * (ld_bf4(y0 + col) * w0 + ld_bf4(y1 + col) * w1);
            if (MODE == 0) *(f32x4*)(xout + (size_t)t * D + col) = v[j];
            ss += (v[j][0] * v[j][0] + v[j][1] * v[j][1]) + (v[j][2] * v[j][2] + v[j][3] * v[j][3]); }
        const float rs = 1.f / sqrtf(wave_sum(ss) * (1.f / D) + EPS);
#pragma unroll
        for (int j = 0; j < 8; ++j) { const int col = (j * 64 + lane) * 4;
            if (MODE == 0) st_bf4(hb + (size_t)t * D + col, v[j] * rs * *(const f32x4*)(g + col) * (*(const f32x4*)(sc + b * D6 + col) + 1.f) + *(const f32x4*)(sh + b * D6 + col));
            else *(f32x4*)(outp + (size_t)t * D + col) = v[j] * rs * *(const f32x4*)(g + col); }
    }
}

struct CvtItem { const float* Wp; int ldw; bf16_t* WT; int ldt; int drow, k0, n0; };
constexpr int I_IN = 32 * (INW / 32), I_BR = 4 * 16 * 64, I_OUT = 32 * 64, I_GU = NE * 32 * 32, I_DN = NE * 8 * 64, I_LR = 32 * 8, I_WU = 2 * 32, I_WG = 64, I_BIG = I_IN + I_BR + I_OUT + I_GU + I_DN, I_ALL = I_BIG + I_LR + 2 * I_WU + I_WG;
__device__ __forceinline__ CvtItem cvt_decode(const Ctx& c, int l, int it) {
    CvtItem r;
    if (it < I_IN) { const int kb = it / (INW / 32), nb = it % (INW / 32); r.n0 = nb * 32; r.k0 = kb * 64; r.Wp = c.in[7] + (size_t)l * D * INW; r.ldw = INW; r.WT = WSH(O_WIN); r.ldt = D; r.drow = r.n0 < 10624 ? r.n0 : r.n0 + 128; return r; }
    it -= I_IN;
    if (it < I_BR) { const int sgm = it / 1024, q = it % 1024, kb = q / 64, nb = q % 64; r.n0 = nb * 32; r.k0 = kb * 64; r.Wp = c.in[28] + ((size_t)l * 4 + sgm) * W * D; r.ldw = D; r.WT = WSH(O_WBR) + sgm * W; r.ldt = 4 * W; r.drow = r.n0; return r; }
    it -= I_BR;
    if (it < I_OUT) { const int kb = it / 64, nb = it % 64; r.n0 = nb * 32; r.k0 = kb * 64; r.Wp = c.in[29] + (size_t)l * D * D; r.ldw = D; r.WT = WSH(O_WOUT); r.ldt = D; r.drow = r.n0; return r; }
    it -= I_OUT;
    if (it < I_GU) { const int e = it / 1024, q = it % 1024, kb = q / 32, nb = q % 32; r.n0 = nb * 32; r.k0 = kb * 64; r.Wp = c.in[34] + ((size_t)l * NE + e) * D * 1024; r.ldw = 1024; r.WT = WSH(O_WGU) + (size_t)e * 1024 * D; r.ldt = D;
        r.drow = r.n0 < 512 ? (r.n0 / 128) * 256 + (r.n0 % 128) : ((r.n0 - 512) / 128) * 256 + 128 + ((r.n0 - 512) % 128); return r; }
    it -= I_GU;
    if (it < I_DN) { const int e = it / 512, q = it % 512, kb = q / 64, nb = q % 64; r.n0 = nb * 32; r.k0 = kb * 64; r.Wp = c.in[35] + ((size_t)l * NE + e) * 512 * D; r.ldw = D; r.WT = WSH(O_WDN) + (size_t)e * D * 512; r.ldt = 512; r.drow = r.n0; return r; }
    it -= I_DN;
    if (it < I_LR) { const int m = it / 8, q = it % 8, kb = q / 4, nb = q % 4, z = m >> 4, ty = (m >> 3) & 1, n = m & 7; r.n0 = nb * 32; r.k0 = kb * 64; r.Wp = c.in[ty ? 12 : 10] + (((size_t)l * 2 + z) * 8 + n) * 128 * 128; r.ldw = 128;
        r.WT = WSH(O_WLR) + (size_t)m * 128 * 128; r.ldt = 128; r.drow = r.n0; return r; }
    it -= I_LR;
    if (it < 2 * I_WU) { const int ua = it / I_WU, q = it % I_WU, z = q / 32, nb = q % 32; r.n0 = nb * 32; r.k0 = 0; r.Wp = c.in[ua ? 23 : 21] + ((size_t)l * 2 + z) * 64 * W; r.ldw = W; r.WT = WSH(ua ? O_WAT : O_WUT) + (size_t)z * W * 64; r.ldt = 64; r.drow = r.n0; return r; }
    it -= 2 * I_WU;
    { const int kb = it / 32, nb = it % 32; r.n0 = nb * 32; r.k0 = kb * 64; r.Wp = c.in[24] + (size_t)l * 128 * W; r.ldw = W; r.WT = WSH(O_WGT); r.ldt = 128; r.drow = r.n0; return r; }
}
constexpr int J_IN = 16 * (INW / 128), J_BR = 4 * 8 * 16, J_OUT = 16 * 16, J_GU = NE * 16 * 8, J_DN = NE * 4 * 16, J_ALL = J_IN + J_BR + J_OUT + J_GU + J_DN;
__device__ __forceinline__ CvtItem cvt_decode_big(const Ctx& c, int l, int it) {
    CvtItem r;
    if (it < J_IN) { const int kb = it / (INW / 128), nb = it % (INW / 128); r.n0 = nb * 128; r.k0 = kb * 128; r.Wp = c.in[7] + (size_t)l * D * INW; r.ldw = INW; r.WT = WSH(O_WIN); r.ldt = D; r.drow = r.n0 < 10624 ? r.n0 : r.n0 + 128; return r; }
    it -= J_IN;
    if (it < J_BR) { const int sgm = it / 128, q = it % 128, kb = q / 16, nb = q % 16; r.n0 = nb * 128; r.k0 = kb * 128; r.Wp = c.in[28] + ((size_t)l * 4 + sgm) * W * D; r.ldw = D; r.WT = WSH(O_WBR) + sgm * W; r.ldt = 4 * W; r.drow = r.n0; return r; }
    it -= J_BR;
    if (it < J_OUT) { const int kb = it / 16, nb = it % 16; r.n0 = nb * 128; r.k0 = kb * 128; r.Wp = c.in[29] + (size_t)l * D * D; r.ldw = D; r.WT = WSH(O_WOUT); r.ldt = D; r.drow = r.n0; return r; }
    it -= J_OUT;
    if (it < J_GU) { const int e = it / 128, q = it % 128, kb = q / 8, nb = q % 8; r.n0 = nb * 128; r.k0 = kb * 128; r.Wp = c.in[34] + ((size_t)l * NE + e) * D * 1024; r.ldw = 1024; r.WT = WSH(O_WGU) + (size_t)e * 1024 * D; r.ldt = D;
        r.drow = r.n0 < 512 ? (r.n0 / 128) * 256 : ((r.n0 - 512) / 128) * 256 + 128; return r; }
    it -= J_GU;
    { const int e = it / 64, q = it % 64, kb = q / 16, nb = q % 16; r.n0 = nb * 128; r.k0 = kb * 128; r.Wp = c.in[35] + ((size_t)l * NE + e) * 512 * D; r.ldw = D; r.WT = WSH(O_WDN) + (size_t)e * D * 512; r.ldt = 512; r.drow = r.n0; return r; }
}
__device__ __forceinline__ void convert_big(const Ctx& c, int l, float* ldsf, int first, int last, int widx, int wcnt) {
    const int tid = threadIdx.x, lr = tid >> 5, lc = (tid & 31) * 4;
    f32x4 rg[8]; int it = first + widx; CvtItem r;
    if (it < last) { r = cvt_decode_big(c, l, it);
#pragma unroll
        for (int i = 0; i < 8; ++i) rg[i] = *(const f32x4*)(r.Wp + (size_t)(r.k0 + lr + 16 * i) * r.ldw + r.n0 + lc); }
    for (; it < last; it += wcnt) {
#pragma unroll
        for (int i = 0; i < 8; ++i) { float* dp = ldsf + (lr + 16 * i) * 129 + lc; dp[0] = rg[i][0]; dp[1] = rg[i][1]; dp[2] = rg[i][2]; dp[3] = rg[i][3]; }
        const CvtItem cur = r; const int nx = it + wcnt;
        if (nx < last) { r = cvt_decode_big(c, l, nx);
#pragma unroll
            for (int i = 0; i < 8; ++i) rg[i] = *(const f32x4*)(r.Wp + (size_t)(r.k0 + lr + 16 * i) * r.ldw + r.n0 + lc); }
        SYNCTHREADS();
#pragma unroll
        for (int q = 0; q < 4; ++q) { const int id = tid + NT * q, n = id >> 4, k8 = (id & 15) * 8; const float* sp = ldsf + k8 * 129 + n;
            u32x4 o; o[0] = pk2(sp[0 * 129], sp[1 * 129]); o[1] = pk2(sp[2 * 129], sp[3 * 129]); o[2] = pk2(sp[4 * 129], sp[5 * 129]); o[3] = pk2(sp[6 * 129], sp[7 * 129]);
            *(u32x4*)(cur.WT + (size_t)(cur.drow + n) * cur.ldt + cur.k0 + k8) = o; }
        SYNCTHREADS();
    }
}
__device__ __forceinline__ int convert_tail_tiles() { const int nun = (T / 256) * (PW / 256), G = (int)gridDim.x, rem = nun % G; return rem == 0 ? 0 : (G - rem) * 10 < J_GU + J_DN ? (G - rem) * 10 : J_GU + J_DN; }
__device__ __forceinline__ int convert_early_tiles(const Ctx& c) { const int G = (int)gridDim.x, nrest = (CTLW(c) + CW_PLAN)[40] * 4 - G; return (nrest >= 0 && nrest < G) ? ((G - nrest) * 12 < J_IN ? (G - nrest) * 12 : J_IN) : 0; }
__device__ __forceinline__ void ph_convert(const Ctx& c, int l, float* ldsf) {
    const int lane = threadIdx.x & 63, wave = threadIdx.x >> 6; const int gw = blockIdx.x * (NT / 64) + wave, ngw = gridDim.x * (NT / 64);
    convert_big(c, l, ldsf, l == 1 ? convert_early_tiles(c) : 0, J_ALL - convert_tail_tiles(), (int)blockIdx.x, (int)gridDim.x);
#ifdef CPU_EMU
    if (lane == 0) for (int it = I_BIG + gw; it < I_ALL; it += ngw) { const CvtItem r = cvt_decode(c, l, it);
        for (int kk = 0; kk < 64; ++kk) for (int nn = 0; nn < 32; ++nn) r.WT[(size_t)(r.drow + nn) * r.ldt + r.k0 + kk] = (bf16_t)f2bf(r.Wp[(size_t)(r.k0 + kk) * r.ldw + r.n0 + nn]); }
#else
    float* scr = ldsf + wave * (64 * 33 + 16);
    for (int it = I_BIG + gw; it < I_ALL; it += ngw) {
        const CvtItem r = cvt_decode(c, l, it);
#pragma unroll 8
        for (int i = 0; i < 32; ++i) { const int kk = 2 * i + (lane >> 5); scr[kk * 33 + (lane & 31)] = r.Wp[(size_t)(r.k0 + kk) * r.ldw + r.n0 + (lane & 31)]; }
        asm volatile("s_waitcnt lgkmcnt(0)" ::: "memory");
        const int cc = lane & 7;
#pragma unroll
        for (int j = 0; j < 4; ++j) { const int n = (lane >> 3) + 8 * j; const float* sp = scr + (8 * cc) * 33 + n;
            u32x4 o; o[0] = pk2(sp[0 * 33], sp[1 * 33]); o[1] = pk2(sp[2 * 33], sp[3 * 33]); o[2] = pk2(sp[4 * 33], sp[5 * 33]); o[3] = pk2(sp[6 * 33], sp[7 * 33]);
            *(u32x4*)(r.WT + (size_t)(r.drow + n) * r.ldt + r.k0 + 8 * cc) = o; }
        asm volatile("s_waitcnt lgkmcnt(0)" ::: "memory");
    }
#endif
    { const float* wg = c.in[30] + (size_t)l * D * 4; const float* we = c.in[32] + (size_t)l * D * 32; bf16_t* wh = WSH(O_WRH); bf16_t* wl = WSH(O_WRL);
      for (long i = GT_; i < (long)48 * D; i += GS_) { const int n = (int)(i / D), k = (int)(i % D); const float w = n < 4 ? wg[k * 4 + n] : n < 36 ? we[k * 32 + (n - 4)] : 0.f; const unsigned hb = f2bf(w); wh[i] = (bf16_t)hb; wl[i] = (bf16_t)f2bf(w - bf2f((bf16_t)hb)); } }
    for (long i = GT_; i < (long)128 * D / 2; i += GS_) ((unsigned*)(WSH(O_WIN) + (size_t)10624 * D))[i] = 0u;
}

namespace pg8 {
constexpr int BM = 256, BK = 64, HALF = 128, HTB = HALF * BK * 2, STAGE_BYTES = 8 * HTB;
__host__ __device__ __forceinline__ int lds_byte(int r, int cc) { const int st = (r >> 4) * 2 + (cc >> 5), rr = r & 15, c2 = cc & 31, ob = rr * 64 + c2 * 2; return st * 1024 + (ob ^ (((ob >> 9) & 1) << 5)); }
__host__ __device__ __forceinline__ void stage_rc(int b, int& R, int& C) { const int st = b / 1024, sb = b % 1024, swz = sb ^ (((sb >> 9) & 1) << 5); R = (st >> 1) * 16 + swz / 64; C = (st & 1) * 32 + (swz % 64) / 2; }
__host__ __device__ __forceinline__ int perm32(int rho) { const int n = rho >> 4, i = rho & 15; return 8 * (i >> 2) + 4 * n + (i & 3); }
struct Unit { int pm, pn, aux; const char* A; const char* B; };
struct Gemm { int K, lda, ldb; };

template <class Epi, class Sched>
__device__ __forceinline__ void gemm_phase(unsigned char* lds_, const Gemm g, const Sched& S, const Epi& E) {
#ifdef CPU_EMU
    if (threadIdx.x != 0) return;
    Unit u; const int K = g.K;
    float* Af = (float*)malloc((size_t)256 * K * 4); float* Bf = (float*)malloc((size_t)256 * K * 4); float* Cf = (float*)malloc(256 * 256 * 4);
    for (int i = 0; S.next(i, u); ++i) {
        const bf16_t* A = (const bf16_t*)u.A; const bf16_t* B = (const bf16_t*)u.B;
        for (int r = 0; r < 256; ++r) for (int k = 0; k < K; ++k) { size_t ar = (size_t)r; if constexpr (Sched::GATHER) ar = (size_t)S.row(u.pm * 256 + r); Af[(size_t)r * K + k] = bf2f(A[ar * g.lda + k]); Bf[(size_t)r * K + k] = bf2f(B[(size_t)r * g.ldb + k]); }
        const int nseg = Epi::SEGT > 0 ? K / (Epi::SEGT * 64) : 1, kseg = K / nseg;
        for (int wid = 0; wid < 8; ++wid) for (int lane = 0; lane < 64; ++lane) {
            const int wr = wid >> 2, wc = wid & 3, fr = lane & 15, fq = lane >> 4; f32x4 acc[2][2][4][2];
            for (int ai = 0; ai < 2; ++ai) for (int bj = 0; bj < 2; ++bj) for (int m = 0; m < 4; ++m) for (int n = 0; n < 2; ++n) for (int j = 0; j < 4; ++j) acc[ai][bj][m][n][j] = 0.f;
            for (int sg = 0; sg < nseg; ++sg) {
                for (int ai = 0; ai < 2; ++ai) for (int bj = 0; bj < 2; ++bj) for (int m = 0; m < 4; ++m) for (int n = 0; n < 2; ++n) for (int j = 0; j < 4; ++j) {
                    const int r = 128 * ai + 64 * wr + 16 * m + fr, cc = 128 * bj + 32 * wc + (Epi::PERM ? 8 * fq + 4 * n + j : 16 * n + 4 * fq + j);
                    const float* a = Af + (size_t)r * K + sg * kseg; const float* b = Bf + (size_t)cc * K + sg * kseg; float sacc = 0.f; for (int k = 0; k < kseg; ++k) sacc += a[k] * b[k];
                    acc[ai][bj][m][n][j] += sacc; }
                if constexpr (Epi::SEGT > 0) { if (sg + 1 < nseg) E.segment(acc, u, sg, wr, wc, fr, fq); }
            }
            E(acc, u, wr, wc, fr, fq);
        }
    }
    free(Af); free(Bf); free(Cf);
#else
    typedef __attribute__((address_space(3))) unsigned char* ldsp_t;
    ldsp_t lds = (ldsp_t)lds_;
    const int tid = threadIdx.x, wid = __builtin_amdgcn_readfirstlane(tid >> 6), lane = tid & 63, wr = wid >> 2, wc = wid & 3, fr = lane & 15, fq = lane >> 4;
    const int K = g.K, nt = K / BK;
    unsigned voffA[2], voffB[2];
#pragma unroll
    for (int i = 0; i < 2; ++i) { int R, C; stage_rc(tid * 16 + i * 8192, R, C); const int Rb = Epi::PERM ? ((R & ~31) + perm32(R & 31)) : R;
        voffA[i] = (unsigned)(R * g.lda + C) * 2u; voffB[i] = (unsigned)(Rb * g.ldb + C) * 2u; }
    unsigned vA[2][2], vAn[2][2];
#define PG8_GROWS(uu, vv) do { _Pragma("unroll") for (int h_ = 0; h_ < 2; ++h_) _Pragma("unroll") for (int i_ = 0; i_ < 2; ++i_) { int R_, C_; stage_rc(tid * 16 + i_ * 8192, R_, C_); \
        vv[h_][i_] = (unsigned)(S.row((uu).pm * 256 + h_ * 128 + R_) * g.lda + C_) * 2u; } } while (0)
    const size_t kstep = (size_t)(BK * 2);
    const size_t hstepA = (size_t)HALF * g.lda * 2, hstepB = (size_t)HALF * g.ldb * 2;
    const unsigned ldsw = (unsigned)wid * 1024u;
    const int aoff = lds_byte(wr * 64 + fr, fq * 8), boff = lds_byte(wc * 32 + fr, fq * 8);
#define PG8_SA(b, h) (((b) * 2 + (h)) * HTB)
#define PG8_SB(b, h) ((4 + (b) * 2 + (h)) * HTB)
#define PG8_STAGE(bufoff, gbase, voff) do { _Pragma("unroll") for (int _i = 0; _i < 2; ++_i) \
        __builtin_amdgcn_global_load_lds((const unsigned*)((const char*)(gbase) + (voff)[_i]), (__attribute__((address_space(3))) unsigned*)(lds + (bufoff) + ldsw + _i * 8192), 16, 0, 0); } while (0)
#define PG8_STAGEA(b, h, kp, usen) do { if constexpr (Sched::GATHER) { const unsigned vs_[2] = {(usen) ? vAn[h][0] : vA[h][0], (usen) ? vAn[h][1] : vA[h][1]}; PG8_STAGE(PG8_SA(b, h), kp, vs_); } \
        else { PG8_STAGE(PG8_SA(b, h), (kp) + ((h) ? hstepA : 0), voffA); } } while (0)
#define PG8_LDA(dst, b, h) do { _Pragma("unroll") for (int m = 0; m < 4; ++m) _Pragma("unroll") for (int k = 0; k < 2; ++k) dst[m][k] = *(const __attribute__((address_space(3))) bf16x8*)(lds + PG8_SA(b, h) + aoff + m * 2048 + k * 1024); } while (0)
#define PG8_LDB(dst, b, h) do { _Pragma("unroll") for (int n = 0; n < 2; ++n) _Pragma("unroll") for (int k = 0; k < 2; ++k) dst[n][k] = *(const __attribute__((address_space(3))) bf16x8*)(lds + PG8_SB(b, h) + boff + n * 2048 + k * 1024); } while (0)
#define PG8_MMA(ai, bj, At, Bt) do { __builtin_amdgcn_s_setprio(1); _Pragma("unroll") for (int m = 0; m < 4; ++m) _Pragma("unroll") for (int n = 0; n < 2; ++n) _Pragma("unroll") for (int k = 0; k < 2; ++k) \
        acc[ai][bj][m][n] = __builtin_amdgcn_mfma_f32_16x16x32_bf16(Bt[n][k], At[m][k], acc[ai][bj][m][n], 0, 0, 0); __builtin_amdgcn_s_setprio(0); } while (0)
#define PG8_WAIT_V(n) asm volatile("s_waitcnt vmcnt(" #n ")" ::: "memory")
#define PG8_WAIT_L(n) asm volatile("s_waitcnt lgkmcnt(" #n ")" ::: "memory")
#define PG8_BAR __builtin_amdgcn_s_barrier()
#define PG8_SCHED __builtin_amdgcn_sched_barrier(0)
    Unit cur, nxt; int ui = 0;
    if (!S.next(0, cur)) return;
    f32x4 acc[2][2][4][2];
#pragma unroll
    for (int a = 0; a < 2; ++a)
#pragma unroll
        for (int b = 0; b < 2; ++b)
#pragma unroll
            for (int m = 0; m < 4; ++m)
#pragma unroll
                for (int n = 0; n < 2; ++n) acc[a][b][m][n] = (f32x4){0.f, 0.f, 0.f, 0.f};
    bf16x8 At[4][2], B0[2][2], B1[2][2];
    const char* cA = cur.A; const char* cB = cur.B;
    S.a_ready(cur);
    if constexpr (Sched::GATHER) { PG8_GROWS(cur, vA); }
    PG8_STAGE(PG8_SB(0, 0), cB, voffB); PG8_STAGEA(0, 0, cA, false); PG8_STAGE(PG8_SB(0, 1), cB + hstepB, voffB); PG8_STAGEA(0, 1, cA, false);
    if (wr == 1) PG8_BAR;
    PG8_WAIT_V(4); PG8_BAR;
    PG8_STAGE(PG8_SB(1, 0), cB + kstep, voffB); PG8_STAGEA(1, 0, cA + kstep, false); PG8_STAGE(PG8_SB(1, 1), cB + hstepB + kstep, voffB);
    PG8_WAIT_V(6); PG8_BAR;
    for (;;) {
        const bool has_next = S.next(ui + 1, nxt);
        const char* nA = has_next ? nxt.A : cA; const char* nB = has_next ? nxt.B : cB;
        if constexpr (Sched::GATHER) { if (has_next) { PG8_GROWS(nxt, vAn); } else {
#pragma unroll
            for (int h_ = 0; h_ < 2; ++h_) { vAn[h_][0] = vA[h_][0]; vAn[h_][1] = vA[h_][1]; } } }
        for (int t = 0; t < nt; t += 2) {
            const bool last = (t == nt - 2);
            const char* a1 = cA + (size_t)(t + 1) * kstep;
            const char* a2 = last ? nA : cA + (size_t)(t + 2) * kstep; const char* b2 = last ? nB : cB + (size_t)(t + 2) * kstep;
            const char* a3 = a2 + kstep; const char* b3 = b2 + kstep;
            if (last && has_next) S.a_ready(nxt);
            PG8_LDB(B0, 0, 0); PG8_SCHED; PG8_LDA(At, 0, 0); PG8_STAGEA(1, 1, a1, false);
            PG8_WAIT_L(8); PG8_BAR; PG8_WAIT_L(0); PG8_MMA(0, 0, At, B0); PG8_BAR; PG8_SCHED;
            PG8_LDB(B1, 0, 1); PG8_STAGE(PG8_SB(0, 0), b2, voffB);
            PG8_BAR; PG8_WAIT_L(0); PG8_MMA(0, 1, At, B1); PG8_BAR;
            PG8_LDA(At, 0, 1); PG8_STAGEA(0, 0, a2, last);
            PG8_BAR; PG8_WAIT_L(0); PG8_MMA(1, 0, At, B0); PG8_BAR; PG8_SCHED;
            PG8_STAGE(PG8_SB(0, 1), b2 + hstepB, voffB);
            PG8_WAIT_V(6); PG8_BAR; PG8_MMA(1, 1, At, B1); PG8_BAR;
            PG8_LDB(B0, 1, 0); PG8_SCHED; PG8_LDA(At, 1, 0); PG8_STAGEA(0, 1, a2, last);
            PG8_WAIT_L(8); PG8_BAR; PG8_WAIT_L(0); PG8_MMA(0, 0, At, B0); PG8_BAR; PG8_SCHED;
            PG8_LDB(B1, 1, 1); PG8_STAGE(PG8_SB(1, 0), b3, voffB);
            PG8_BAR; PG8_WAIT_L(0); PG8_MMA(0, 1, At, B1); PG8_BAR;
            PG8_LDA(At, 1, 1); PG8_STAGEA(1, 0, a3, last);
            PG8_BAR; PG8_WAIT_L(0); PG8_MMA(1, 0, At, B0); PG8_BAR; PG8_SCHED;
            PG8_STAGE(PG8_SB(1, 1), b3 + hstepB, voffB);
            PG8_WAIT_V(6); PG8_BAR; PG8_MMA(1, 1, At, B1); PG8_BAR;
            if constexpr (Epi::SEGT > 0) { if ((t + 2) % Epi::SEGT == 0 && t + 2 < nt) E.segment(acc, cur, (t + 2) / Epi::SEGT - 1, wr, wc, fr, fq); }
        }
        E(acc, cur, wr, wc, fr, fq); S.done(cur);
        if (!has_next) break;
#pragma unroll
        for (int a = 0; a < 2; ++a)
#pragma unroll
            for (int b = 0; b < 2; ++b)
#pragma unroll
                for (int m = 0; m < 4; ++m)
#pragma unroll
                    for (int n = 0; n < 2; ++n) acc[a][b][m][n] = (f32x4){0.f, 0.f, 0.f, 0.f};
        cur = nxt; cA = nA; cB = nB; ++ui;
        if constexpr (Sched::GATHER) {
#pragma unroll
            for (int h_ = 0; h_ < 2; ++h_) { vA[h_][0] = vAn[h_][0]; vA[h_][1] = vAn[h_][1]; } }
    }
    PG8_WAIT_V(0);
    if (wr == 0) PG8_BAR;
    PG8_BAR;
#undef PG8_SA
#undef PG8_SB
#undef PG8_STAGE
#undef PG8_STAGEA
#undef PG8_GROWS
#undef PG8_LDA
#undef PG8_LDB
#undef PG8_MMA
#undef PG8_WAIT_V
#undef PG8_WAIT_L
#undef PG8_BAR
#undef PG8_SCHED
#endif
}

struct StaticOrder {
    static constexpr bool GATHER = false;
    int nM, nN, nwg, G, c; const char* A; const char* B; size_t tstepA, tstepB;
    __device__ __forceinline__ void init(int M, int N, int G_, int c_, const void* A_, const void* B_, int lda, int ldb) { nM = M / BM; nN = N / BM; nwg = nM * nN; G = G_; c = c_; A = (const char*)A_; B = (const char*)B_; tstepA = (size_t)BM * lda * 2; tstepB = (size_t)BM * ldb * 2; }
    __device__ __forceinline__ bool next(int i, Unit& u) const {
        const long L = (long)i * G + c; if (L >= nwg) return false;
        int wgid = (int)L; { const int q = nwg / 8, r = nwg % 8, xcd = wgid % 8, off = wgid / 8; wgid = (xcd < r ? xcd * (q + 1) : r * (q + 1) + (xcd - r) * q) + off; }
        const int nig = 8 * nN, gid = wgid / nig, fm = gid * 8, gsz = (nM - fm) < 8 ? (nM - fm) : 8;
        u.pm = fm + ((wgid % nig) % gsz); u.pn = (wgid % nig) / gsz; u.aux = 0; u.A = A + (size_t)u.pm * tstepA; u.B = B + (size_t)u.pn * tstepB; return true;
    }
    __device__ __forceinline__ void a_ready(const Unit&) const {}
    __device__ __forceinline__ void done(const Unit&) const {}
};
struct MergeOrder {
    static constexpr bool GATHER = false;
    StaticOrder so; int kseg_bytes;
    __device__ __forceinline__ bool next(int i, Unit& u) const { if (!so.next(i >> 2, u)) return false; u.aux = i & 3; u.A += (size_t)u.aux * kseg_bytes; u.B += (size_t)u.aux * kseg_bytes; return true; }
    __device__ __forceinline__ void a_ready(const Unit&) const {}
    __device__ __forceinline__ void done(const Unit&) const {}
};
struct MoeOrder {
    static constexpr bool GATHER = false;
    int G, c, ncol; const int* plan; const char* A; const char* B; size_t tstepA, tstepB, estep;
    __device__ __forceinline__ bool next(int i, Unit& u) const {
        const long L = (long)i * G + c; const int nblk = plan[40]; if (L >= (long)nblk * ncol) return false;
        u.pm = (int)(L / ncol); u.pn = (int)(L % ncol); u.aux = plan[64 + u.pm]; u.A = A + (size_t)u.pm * tstepA; u.B = B + (size_t)u.aux * estep + (size_t)u.pn * tstepB; return true;
    }
    __device__ __forceinline__ void a_ready(const Unit&) const {}
    __device__ __forceinline__ void done(const Unit&) const {}
};
struct MoeGatherOrder {
    static constexpr bool GATHER = true;
    int G, c, ncol; const int* plan; const char* A; const char* B; size_t tstepB, estep; const int* src; int nrows;
    __device__ __forceinline__ bool next(int i, Unit& u) const {
        const long L = (long)i * G + c; const int nblk = plan[40]; if (L >= (long)nblk * ncol) return false;
        u.pm = (int)(L / ncol); u.pn = (int)(L % ncol); u.aux = plan[64 + u.pm]; u.A = A; u.B = B + (size_t)u.aux * estep + (size_t)u.pn * tstepB; return true;
    }
    __device__ __forceinline__ int row(int slot) const { const int r = src[slot]; return (unsigned)r < (unsigned)nrows ? r : 0; }
    __device__ __forceinline__ void a_ready(const Unit&) const {}
    __device__ __forceinline__ void done(const Unit&) const {}
};

__device__ __forceinline__ u32x4 pack8(const f32x4 v0, const f32x4 v1) { u32x4 w; w[0] = pk2(v0[0], v0[1]); w[1] = pk2(v0[2], v0[3]); w[2] = pk2(v1[0], v1[1]); w[3] = pk2(v1[2], v1[3]); return w; }
struct EpiBf16 {
    static constexpr int SEGT = 0; static constexpr bool PERM = true; bf16_t* O; int ldc;
    __device__ __forceinline__ void operator()(const f32x4 (&acc)[2][2][4][2], const Unit& u, int wr, int wc, int fr, int fq) const {
        const int row0 = u.pm * BM + wr * 64 + fr, col0 = u.pn * BM + wc * 32 + 8 * fq;
#pragma unroll
        for (int ai = 0; ai < 2; ++ai)
#pragma unroll
            for (int m = 0; m < 4; ++m) { bf16_t* rowp = O + (size_t)(row0 + ai * HALF + m * 16) * ldc + col0;
#pragma unroll
                for (int bj = 0; bj < 2; ++bj) *(u32x4*)(rowp + bj * HALF) = pack8(acc[ai][bj][m][0], acc[ai][bj][m][1]); }
    }
};
struct EpiP {
    static constexpr int SEGT = 0; static constexpr bool PERM = true; bf16_t* O; unsigned char* G8; float* SG;
    __device__ __forceinline__ void operator()(const f32x4 (&acc)[2][2][4][2], const Unit& u, int wr, int wc, int fr, int fq) const {
        const int row0 = u.pm * BM + wr * 64 + fr, col0 = u.pn * BM + wc * 32 + 8 * fq;
        if (u.pn * BM < C_MLP) {
            const bool sgu = u.pn * BM >= C_SV && u.pn * BM < C_SV + W;
#pragma unroll
            for (int ai = 0; ai < 2; ++ai)
#pragma unroll
                for (int m = 0; m < 4; ++m) { const int r = row0 + ai * HALF + m * 16; bf16_t* rowp = O + (size_t)r * PW + col0; float s1 = 0.f, s2 = 0.f;
#pragma unroll
                    for (int bj = 0; bj < 2; ++bj) { const u32x4 pk = pack8(acc[ai][bj][m][0], acc[ai][bj][m][1]); *(u32x4*)(rowp + bj * HALF) = pk;
                        if (sgu) {
#pragma unroll
                            for (int e = 0; e < 4; ++e) { const float g0 = geluf_(bflo(pk[e])), g1 = geluf_(bfhi(pk[e])); s1 += g0 + g1; s2 += g0 * g0 + g1 * g1; } } }
                    if (sgu) { float* sp = SG + ((size_t)r * 16 + (u.pn - C_SV / BM) * 4 + wc) * 2;
#ifdef CPU_EMU
                        if (fq == 0) { sp[0] = s1; sp[1] = s2; } else { sp[0] += s1; sp[1] += s2; }
#else
                        s1 += SHFL_XOR(s1, 16); s1 += SHFL_XOR(s1, 32); s2 += SHFL_XOR(s2, 16); s2 += SHFL_XOR(s2, 32); if (fq == 0) { sp[0] = s1; sp[1] = s2; }
#endif
                    } }
        } else {
#pragma unroll
            for (int ai = 0; ai < 2; ++ai)
#pragma unroll
                for (int m = 0; m < 4; ++m) { unsigned char* rowp = G8 + (size_t)(row0 + ai * HALF + m * 16) * (4 * D) + (col0 - C_MLP);
#pragma unroll
                    for (int bj = 0; bj < 2; ++bj) { unsigned long long w = 0ull;
#pragma unroll
                        for (int q = 0; q < 8; ++q) { const float gq = sigmoidf_(acc[ai][bj][m][q >> 2][q & 3]); w |= (unsigned long long)(unsigned)(gq * 255.f + 0.5f) << (8 * q); }
                        *(unsigned long long*)(rowp + bj * HALF) = w; } }
        }
    }
};
struct EpiMerge {
    static constexpr int SEGT = 16; static constexpr bool PERM = true; const unsigned char* G8; bf16_t* MRG;
    static __device__ __forceinline__ float gb(unsigned w32, int q) { return fmaxf((float)((w32 >> (8 * q)) & 255u), 0.5f); }
    __device__ __forceinline__ void segment(f32x4 (&acc)[2][2][4][2], const Unit& u, int seg, int wr, int wc, int fr, int fq) const {
        const int row0 = u.pm * BM + wr * 64 + fr, col0 = u.pn * BM + wc * 32 + 8 * fq;
#pragma unroll
        for (int ai = 0; ai < 2; ++ai)
#pragma unroll
            for (int m = 0; m < 4; ++m) { const size_t r = (size_t)(row0 + ai * HALF + m * 16);
#pragma unroll
                for (int bj = 0; bj < 2; ++bj) { const int cc = col0 + bj * HALF;
                    const unsigned long long g0 = *(const unsigned long long*)(G8 + r * (4 * D) + seg * D + cc), g1 = *(const unsigned long long*)(G8 + r * (4 * D) + (seg + 1) * D + cc);
                    const unsigned lo0 = (unsigned)g0, hi0 = (unsigned)(g0 >> 32), lo1 = (unsigned)g1, hi1 = (unsigned)(g1 >> 32);
#pragma unroll
                    for (int q = 0; q < 4; ++q) { acc[ai][bj][m][0][q] *= gb(lo0, q) * frcp_(gb(lo1, q)); acc[ai][bj][m][1][q] *= gb(hi0, q) * frcp_(gb(hi1, q)); } }
#ifndef CPU_EMU
                asm volatile("" ::: "memory");
#endif
            }
    }
    __device__ __forceinline__ void operator()(const f32x4 (&acc)[2][2][4][2], const Unit& u, int wr, int wc, int fr, int fq) const {
        const int row0 = u.pm * BM + wr * 64 + fr, col0 = u.pn * BM + wc * 32 + 8 * fq;
#pragma unroll
        for (int ai = 0; ai < 2; ++ai)
#pragma unroll
            for (int m = 0; m < 4; ++m) { const size_t r = (size_t)(row0 + ai * HALF + m * 16);
#pragma unroll
                for (int bj = 0; bj < 2; ++bj) { const int cc = col0 + bj * HALF;
                    const unsigned long long g3 = *(const unsigned long long*)(G8 + r * (4 * D) + 3 * D + cc); f32x4 v0, v1;
#pragma unroll
                    for (int q = 0; q < 4; ++q) { v0[q] = gb((unsigned)g3, q) * (1.f / 255.f) * acc[ai][bj][m][0][q]; v1[q] = gb((unsigned)(g3 >> 32), q) * (1.f / 255.f) * acc[ai][bj][m][1][q]; }
                    *(u32x4*)(MRG + r * D + cc) = pack8(v0, v1); }
#ifndef CPU_EMU
                asm volatile("" ::: "memory");
#endif
            }
    }
};
struct EpiResid {
    static constexpr int SEGT = 0; static constexpr bool PERM = false; const float* xin; const float* g1; float* xmid; float* ssp;
    __device__ __forceinline__ void operator()(const f32x4 (&acc)[2][2][4][2], const Unit& u, int wr, int wc, int fr, int fq) const {
        const int row0 = u.pm * BM + wr * 64 + fr, col0 = u.pn * BM + wc * 32 + 4 * fq;
#pragma unroll
        for (int ai = 0; ai < 2; ++ai)
#pragma unroll
            for (int m = 0; m < 4; ++m) { const int r = row0 + ai * HALF + m * 16; const float* gp = g1 + (size_t)(r / S) * D6; float sq = 0.f;
#pragma unroll
                for (int bj = 0; bj < 2; ++bj)
#pragma unroll
                    for (int n = 0; n < 2; ++n) { const int cc = col0 + bj * HALF + n * 16; const f32x4 v = *(const f32x4*)(xin + (size_t)r * D + cc) + *(const f32x4*)(gp + cc) * acc[ai][bj][m][n];
                        *(f32x4*)(xmid + (size_t)r * D + cc) = v; sq += (v[0] * v[0] + v[1] * v[1]) + (v[2] * v[2] + v[3] * v[3]); }
                float* sp = ssp + (size_t)r * 32 + u.pn * 4 + wc;
#ifdef CPU_EMU
                if (fq == 0) *sp = sq; else *sp += sq;
#else
                sq += SHFL_XOR(sq, 16); sq += SHFL_XOR(sq, 32); if (fq == 0) *sp = sq;
                asm volatile("" ::: "memory");
#endif
            }
    }
};
struct EpiGU {
    static constexpr int SEGT = 0; static constexpr bool PERM = true; bf16_t* ACT;
    __device__ __forceinline__ void operator()(const f32x4 (&acc)[2][2][4][2], const Unit& u, int wr, int wc, int fr, int fq) const {
        const int row0 = u.pm * BM + wr * 64 + fr, col0 = u.pn * HALF + wc * 32 + 8 * fq;
#pragma unroll
        for (int ai = 0; ai < 2; ++ai)
#pragma unroll
            for (int m = 0; m < 4; ++m) { f32x4 v0, v1;
#pragma unroll
                for (int j = 0; j < 4; ++j) { v0[j] = siluf_(acc[ai][0][m][0][j]) * acc[ai][1][m][0][j]; v1[j] = siluf_(acc[ai][0][m][1][j]) * acc[ai][1][m][1][j]; }
                *(u32x4*)(ACT + (size_t)(row0 + ai * HALF + m * 16) * 512 + col0) = pack8(v0, v1); }
    }
};
}

template <int PASS>
__device__ __forceinline__ void ph_lru(const Ctx& c, int l, float* ldsf) {
    const bf16_t* P = WSH(O_P); const float* cw = c.in[8] + (size_t)l * 4 * W; const float* cb = c.in[9] + (size_t)l * W;
    const float* br = c.in[11] + (size_t)l * 2 * W; const float* bi = c.in[13] + (size_t)l * 2 * W; const float* lam = c.in[14] + (size_t)l * 2 * W; const bf16_t* WLR = WSH(O_WLR);
    float* CA = WSF(O_LCA); float* CH = WSF(O_LCH); const float* CI = WSF(O_LCI); bf16_t* Y = WSH(O_YS); unsigned* LAU = (unsigned*)(c.ws + O_LA);
    bf16_t* Xs = (bf16_t*)ldsf; bf16_t* Wr = Xs + 64 * 136; bf16_t* Wi = Wr + 128 * 136; float* AUa = (float*)Wr; float* AUu = AUa + 64 * 128; float* HF = (float*)(Wi + 128 * 136); float* spl = HF + 64 * 128;
    const int tid = threadIdx.x, wv = tid >> 6, lane = tid & 63, fr = lane & 15, fq = lane >> 4, rt = wv & 3, hf = wv >> 2;
    u32x4 wreg[8];
#define LRU_WLOAD(zz, nn) do { _Pragma("unroll") for (int q = 0; q < 4; ++q) { const int id = tid + NT * q, f = id >> 4, e8 = (id & 15) * 8; \
        wreg[2 * q] = *(const u32x4*)(WLR + ((size_t)(((zz) * 2 + 0) * 8 + (nn)) * 128 + f) * 128 + e8); wreg[2 * q + 1] = *(const u32x4*)(WLR + ((size_t)(((zz) * 2 + 1) * 8 + (nn)) * 128 + f) * 128 + e8); } } while (0)
    if ((int)blockIdx.x < (T / 64) * 8) LRU_WLOAD(0, (int)blockIdx.x & 7);
    for (int u = blockIdx.x; u < (T / 64) * 8; u += gridDim.x) {
        const int n = u & 7, tile = u >> 3, b = tile / NLC, chk = tile % NLC; const long t0 = (long)tile * 64;
        if (tid < 256) spl[tid] = softplusf_(-lam[(tid >> 7) * W + n * 128 + (tid & 127)]);
#pragma unroll
        for (int q = 0; q < 4; ++q) { const int id = tid + NT * q, tl = id >> 5, e4 = (id & 31) * 4, ch = n * 128 + e4; const long t = t0 + tl; const int sI = (int)(t % S);
            f32x4 acc = *(const f32x4*)(cb + ch);
#pragma unroll
            for (int k = 0; k < 4; ++k) { const int ss = sI + k - 2; if (ss >= 0 && ss < S) acc += ld_bf4(P + (size_t)(t + k - 2) * PW + C_LX + ch) * *(const f32x4*)(cw + k * W + ch); }
            st_bf4(Xs + tl * 136 + e4, acc); }
        for (int z = 0; z < 2; ++z) {
#pragma unroll
            for (int q = 0; q < 4; ++q) { const int id = tid + NT * q, f = id >> 4, e8 = (id & 15) * 8; *(u32x4*)(Wr + f * 136 + e8) = wreg[2 * q]; *(u32x4*)(Wi + f * 136 + e8) = wreg[2 * q + 1]; }
            SYNCTHREADS();
            f32x4 ar[4], ai[4];
#pragma unroll
            for (int nt = 0; nt < 4; ++nt) { ar[nt] = (f32x4){0.f, 0.f, 0.f, 0.f}; ai[nt] = (f32x4){0.f, 0.f, 0.f, 0.f}; }
            wave_mma<4, 4>(ar, Xs + rt * 16 * 136, 136, Wr + hf * 64 * 136, 136);
            wave_mma<4, 4>(ai, Xs + rt * 16 * 136, 136, Wi + hf * 64 * 136, 136);
            SYNCTHREADS();
            if (z == 0) LRU_WLOAD(1, n); else if (u + (int)gridDim.x < (T / 64) * 8) LRU_WLOAD(0, (u + (int)gridDim.x) & 7);
            const int tl = rt * 16 + fr;
#pragma unroll
            for (int nt = 0; nt < 4; ++nt) { const int f = 64 * hf + 16 * nt + 4 * fq, ch = n * 128 + f;
                const f32x4 brv = *(const f32x4*)(br + z * W + ch), biv = *(const f32x4*)(bi + z * W + ch), lmv = *(const f32x4*)(spl + z * 128 + f), xcv = ld_bf4(Xs + tl * 136 + f); f32x4 av, uv, lav;
#pragma unroll
                for (int e = 0; e < 4; ++e) { const float r = sigmoidf_(ar[nt][e] + brv[e]), ig = sigmoidf_(ai[nt][e] + biv[e]), la = -8.f * r * lmv[e]; const float a = fexp_(la); av[e] = a; lav[e] = la; uv[e] = fsqrt_(fmaxf(1.f - a * a, 0.f)) * ig * xcv[e]; }
                *(f32x4*)(AUa + tl * 128 + f) = av; *(f32x4*)(AUu + tl * 128 + f) = uv;
                if (PASS == 1) { u32x4 pk;
#pragma unroll
                    for (int e = 0; e < 4; ++e) pk[e] = pk2(lav[e], uv[e]);
                    *(u32x4*)(LAU + ((size_t)z * T + t0 + tl) * W + ch) = pk; } }
            SYNCTHREADS();
            if (PASS == 1) {
                { const int f = tid & 127, sgm = tid >> 7; float prod = 1.f, h = 0.f;
#pragma unroll
                  for (int q = 0; q < 16; ++q) { const int st = sgm * 16 + q, sI = z == 0 ? st : 63 - st; const float a = AUa[sI * 128 + f]; h = a * h + AUu[sI * 128 + f]; prod *= a; }
                  HF[sgm * 128 + f] = prod; HF[512 + sgm * 128 + f] = h; }
                SYNCTHREADS();
                if (tid < 128) { const int f = tid; const size_t ci = (((size_t)z * NB + b) * NLC + chk) * W + n * 128 + f; float prod = 1.f, h = 0.f;
#pragma unroll
                    for (int sgm = 0; sgm < 4; ++sgm) { const float a = HF[sgm * 128 + f]; h = a * h + HF[512 + sgm * 128 + f]; prod *= a; }
                    CA[ci] = prod; CH[ci] = h; }
                continue;
            }
            if (tid < 128) { const int f = tid; const size_t ci = (((size_t)z * NB + b) * NLC + chk) * W + n * 128 + f;
                if (PASS == 1) { float prod = 1.f, h = 0.f;
#pragma unroll 8
                    for (int q = 0; q < 64; ++q) { const int sI = z == 0 ? q : 63 - q; const float a = AUa[sI * 128 + f]; h = a * h + AUu[sI * 128 + f]; prod *= a; }
                    CA[ci] = prod; CH[ci] = h;
                } else { float h = CI[ci];
                    if (z == 0) {
#pragma unroll 8
                        for (int q = 0; q < 64; ++q) { h = AUa[q * 128 + f] * h + AUu[q * 128 + f]; HF[q * 128 + f] = h; }
                    } else {
#pragma unroll 8
                        for (int q = 63; q >= 0; --q) { h = AUa[q * 128 + f] * h + AUu[q * 128 + f]; HF[q * 128 + f] += h; } } }
            }
            SYNCTHREADS();
        }
        if (PASS == 2) {
#pragma unroll
            for (int q = 0; q < 4; ++q) { const int id = tid + NT * q, tl = id >> 5, f4 = (id & 31) * 4; const long t = t0 + tl; f32x4 hv = *(const f32x4*)(HF + tl * 128 + f4); const f32x4 gv = ld_bf4(P + (size_t)t * PW + C_LG + n * 128 + f4);
#pragma unroll
                for (int e = 0; e < 4; ++e) hv[e] *= geluf_(gv[e]);
                st_bf4(Y + (size_t)t * 4 * W + 0 * W + n * 128 + f4, hv); }
            SYNCTHREADS();
        }
    }
}
__device__ __forceinline__ void ph_lru_fin(const Ctx& c, float* ldsf) {
    const bf16_t* P = WSH(O_P); const unsigned* LAU = (const unsigned*)(c.ws + O_LA); const float* CI = WSF(O_LCI); bf16_t* Y = WSH(O_YS);
    unsigned* Lz = (unsigned*)ldsf; float* Hz = ldsf + 2 * 64 * 128; const int tid = threadIdx.x;
    u32x4 lpre[8];
#define LF_LOAD(uu) do { const int n_ = (uu) & 7; const long t0_ = (long)((uu) >> 3) * 64; \
        _Pragma("unroll") for (int q = 0; q < 8; ++q) { const int id = tid + NT * q, z = id >> 11, r = (id >> 5) & 63, c4 = (id & 31) * 4; lpre[q] = *(const u32x4*)(LAU + ((size_t)z * T + t0_ + r) * W + n_ * 128 + c4); } } while (0)
    if ((int)blockIdx.x < (T / 64) * 8) LF_LOAD((int)blockIdx.x);
    for (int u = blockIdx.x; u < (T / 64) * 8; u += gridDim.x) {
        const int n = u & 7, tile = u >> 3, b = tile / NLC, chk = tile % NLC; const long t0 = (long)tile * 64;
#pragma unroll
        for (int q = 0; q < 8; ++q) { const int id = tid + NT * q, z = id >> 11, r = (id >> 5) & 63, c4 = (id & 31) * 4; *(u32x4*)(Lz + z * 8192 + r * 128 + c4) = lpre[q]; }
        SYNCTHREADS();
        if (u + (int)gridDim.x < (T / 64) * 8) LF_LOAD(u + (int)gridDim.x);
        unsigned long long graw[4];
#pragma unroll
        for (int q = 0; q < 4; ++q) { const int id = tid + NT * q, r = id >> 5, f4 = (id & 31) * 4; graw[q] = *(const unsigned long long*)(P + (size_t)(t0 + r) * PW + C_LG + n * 128 + f4); }
        if (tid < 256) { const int z = tid >> 7, f = tid & 127; float h = CI[(((size_t)z * NB + b) * NLC + chk) * W + n * 128 + f]; const unsigned* lp = Lz + z * 8192 + f; float* hp = Hz + z * 8192 + f;
#pragma unroll 8
            for (int q = 0; q < 64; ++q) { const int sI = z == 0 ? q : 63 - q; const unsigned w = lp[sI * 128]; h = fexp_(bflo(w)) * h + bfhi(w); hp[sI * 128] = h; } }
        SYNCTHREADS();
#pragma unroll
        for (int q = 0; q < 4; ++q) { const int id = tid + NT * q, r = id >> 5, f4 = (id & 31) * 4; const long t = t0 + r; f32x4 o = *(const f32x4*)(Hz + r * 128 + f4) + *(const f32x4*)(Hz + 8192 + r * 128 + f4); const unsigned glo = (unsigned)graw[q], ghi = (unsigned)(graw[q] >> 32); const f32x4 gv = (f32x4){bflo(glo), bfhi(glo), bflo(ghi), bfhi(ghi)};
#pragma unroll
            for (int e = 0; e < 4; ++e) o[e] *= geluf_(gv[e]);
            st_bf4(Y + (size_t)t * 4 * W + 0 * W + n * 128 + f4, o); }
        SYNCTHREADS();
    }
}
__device__ __forceinline__ void ph_lru_scan2(const Ctx& c) {
    const float* CA = WSF(O_LCA); const float* CH = WSF(O_LCH); float* CI = WSF(O_LCI);
    for (long i = GT_; i < (long)2 * NB * W; i += GS_) {
        const int w = (int)(i % W), b = (int)((i / W) % NB), z = (int)(i / ((long)W * NB)); float carry = 0.f;
#pragma unroll 16
        for (int q = 0; q < NLC; ++q) { const int ch = z == 0 ? q : NLC - 1 - q; const size_t idx = (((size_t)z * NB + b) * NLC + ch) * W + w; CI[idx] = carry; carry = CA[idx] * carry + CH[idx]; }
    }
}
__device__ __forceinline__ void ph_rope_table(const Ctx& c) {
    const int* pos = (const int*)c.in[2]; float* RT = WSF(O_ROPE);
    for (long i = GT_; i < (long)T * 32; i += GS_) { const int j = (int)(i & 31); const float ang = (float)pos[i >> 5] * powf(10000.f, -(float)(2 * j) / 64.f); RT[i * 2] = cosf(ang); RT[i * 2 + 1] = sinf(ang); }
}
__device__ __forceinline__ void ret_tables(float* tab, int h) {
    const int tid = threadIdx.x; const float lg = loggamma_(h);
    if (tid < 32) tab[tid] = powf(10000.f, -(float)(2 * tid) / 64.f);
    if (tid >= 64 && tid < 64 + 129) tab[tid] = expf((float)(tid - 64) * lg);
}
__device__ __forceinline__ void ph_ret_kv(const Ctx& c, float* ldsf) {
    const float* RT = WSF(O_ROPE); const bf16_t* P = WSH(O_P); float* KVF = WSF(O_KVF); float* KVB = WSF(O_KVB);
    bf16_t* VT = (bf16_t*)ldsf; bf16_t* KF = VT + 128 * 136; bf16_t* KB = KF + 64 * 136; float* tab = (float*)(KB + 64 * 136);
    const int tid = threadIdx.x, wv = tid >> 6, lane = tid & 63, fr = lane & 15, fq = lane >> 4;
    for (int u = blockIdx.x; u < (T / 128) * 8; u += gridDim.x) {
        const int h = u & 7; const long t0 = (long)(u >> 3) * 128;
        ret_tables(tab, h);
        SYNCTHREADS();
        {
            const int j = tid >> 2, d0 = (tid & 3) * 8; const bf16_t* prow = P + (size_t)(t0 + j) * PW + C_RK + h * 64; const float* rt = RT + ((size_t)(t0 + j) * 32 + d0) * 2;
            const u32x4 kl = *(const u32x4*)(prow + d0), kh = *(const u32x4*)(prow + d0 + 32);
            const f32x4 r0 = *(const f32x4*)rt, r1 = *(const f32x4*)(rt + 4), r2 = *(const f32x4*)(rt + 8), r3 = *(const f32x4*)(rt + 12);
            const float cs[8] = {r0[0], r0[2], r1[0], r1[2], r2[0], r2[2], r3[0], r3[2]}, sn[8] = {r0[1], r0[3], r1[1], r1[3], r2[1], r2[3], r3[1], r3[3]};
            const float fj = tab[64 + 127 - j], bj = tab[64 + j];
#pragma unroll
            for (int e = 0; e < 8; ++e) { const float x1 = (e & 1) ? bfhi(kl[e >> 1]) : bflo(kl[e >> 1]), x2 = (e & 1) ? bfhi(kh[e >> 1]) : bflo(kh[e >> 1]);
                const float k1 = x1 * cs[e] - x2 * sn[e], k2 = x2 * cs[e] + x1 * sn[e];
                KF[(d0 + e) * 136 + j] = (bf16_t)f2bf(k1 * fj); KF[(d0 + e + 32) * 136 + j] = (bf16_t)f2bf(k2 * fj); KB[(d0 + e) * 136 + j] = (bf16_t)f2bf(k1 * bj); KB[(d0 + e + 32) * 136 + j] = (bf16_t)f2bf(k2 * bj); } }
#pragma unroll
        for (int q = 0; q < 4; ++q) { const int id = tid + NT * q, j = id & 127, e8 = (id >> 7) * 8; const u32x4 raw = *(const u32x4*)(P + (size_t)(t0 + j) * PW + C_RV + h * 128 + e8);
#pragma unroll
            for (int e = 0; e < 4; ++e) { VT[(e8 + 2 * e) * 136 + j] = (bf16_t)(raw[e] & 0xffffu); VT[(e8 + 2 * e + 1) * 136 + j] = (bf16_t)(raw[e] >> 16); } }
        SYNCTHREADS();
        f32x4 af[4], ab[4];
#pragma unroll
        for (int nt = 0; nt < 4; ++nt) { af[nt] = (f32x4){0.f, 0.f, 0.f, 0.f}; ab[nt] = (f32x4){0.f, 0.f, 0.f, 0.f}; }
        wave_mma<4, 4>(af, VT + wv * 16 * 136, 136, KF, 136);
        wave_mma<4, 4>(ab, VT + wv * 16 * 136, 136, KB, 136);
        const size_t ob = (((size_t)(u >> 3) * 8 + h) * 128 + wv * 16 + fr) * 64 + 4 * fq;
#pragma unroll
        for (int nt = 0; nt < 4; ++nt) { *(f32x4*)(KVF + ob + 16 * nt) = af[nt]; *(f32x4*)(KVB + ob + 16 * nt) = ab[nt]; }
        SYNCTHREADS();
    }
}
__device__ __forceinline__ void ph_ret_state(const Ctx& c) {
    const float* KVF = WSF(O_KVF); const float* KVB = WSF(O_KVB); bf16_t* STF = WSH(O_STF); bf16_t* STB = WSH(O_STB);
    for (long i = GT_; i < (long)NB * 8 * 8192; i += GS_) {
        const int x = (int)(i % 8192), h = (int)((i / 8192) % 8), b = (int)(i / 65536);
        const float cd = expf(128.f * loggamma_(h)); float st = 0.f;
#pragma unroll 16
        for (int n = 0; n < NCH; ++n) { const size_t idx = (((size_t)b * NCH + n) * 8 + h) * 8192 + x; STF[idx] = (bf16_t)f2bf(st); st = cd * st + KVF[idx]; }
        st = 0.f;
#pragma unroll 16
        for (int n = NCH - 1; n >= 0; --n) { const size_t idx = (((size_t)b * NCH + n) * 8 + h) * 8192 + x; STB[idx] = (bf16_t)f2bf(st); st = cd * st + KVB[idx]; }
    }
}
__device__ __forceinline__ void ph_ret_out(const Ctx& c, float* ldsf) {
    const float* RT = WSF(O_ROPE); const bf16_t* P = WSH(O_P); const bf16_t* STF = WSH(O_STF); const bf16_t* STB = WSH(O_STB); bf16_t* Y = WSH(O_YS);
    bf16_t* Qs = (bf16_t*)ldsf; bf16_t* Ks = Qs + 128 * 72; bf16_t* VT = Ks + 128 * 72; bf16_t* Ss = VT + 128 * 136; bf16_t* SF = Ss + 128 * 136; bf16_t* SB = SF + 128 * 72; float* tab = (float*)(SB + 128 * 72);
    const int tid = threadIdx.x, wv = tid >> 6, lane = tid & 63, fr = lane & 15, fq = lane >> 4;
    for (int u = blockIdx.x; u < (T / 128) * 8; u += gridDim.x) {
        const int h = u & 7; const long t0 = (long)(u >> 3) * 128;
        ret_tables(tab, h);
        SYNCTHREADS();
        {
            const int j = tid >> 2, d0 = (tid & 3) * 8; const bf16_t* prow = P + (size_t)(t0 + j) * PW + h * 64 + d0; const float* rt = RT + ((size_t)(t0 + j) * 32 + d0) * 2;
            const u32x4 ql = *(const u32x4*)(prow + C_RQ), qh = *(const u32x4*)(prow + C_RQ + 32), kl = *(const u32x4*)(prow + C_RK), kh = *(const u32x4*)(prow + C_RK + 32);
            const f32x4 r0 = *(const f32x4*)rt, r1 = *(const f32x4*)(rt + 4), r2 = *(const f32x4*)(rt + 8), r3 = *(const f32x4*)(rt + 12);
            const float cs[8] = {r0[0], r0[2], r1[0], r1[2], r2[0], r2[2], r3[0], r3[2]}, sn[8] = {r0[1], r0[3], r1[1], r1[3], r2[1], r2[3], r3[1], r3[3]};
            u32x4 oql, oqh, okl, okh;
#pragma unroll
            for (int e = 0; e < 4; ++e) { const int ea = 2 * e, eb = 2 * e + 1;
                const float q1a = bflo(ql[e]), q1b = bfhi(ql[e]), q2a = bflo(qh[e]), q2b = bfhi(qh[e]), k1a = bflo(kl[e]), k1b = bfhi(kl[e]), k2a = bflo(kh[e]), k2b = bfhi(kh[e]);
                oql[e] = pk2((q1a * cs[ea] - q2a * sn[ea]) * 0.125f, (q1b * cs[eb] - q2b * sn[eb]) * 0.125f); oqh[e] = pk2((q2a * cs[ea] + q1a * sn[ea]) * 0.125f, (q2b * cs[eb] + q1b * sn[eb]) * 0.125f);
                okl[e] = pk2(k1a * cs[ea] - k2a * sn[ea], k1b * cs[eb] - k2b * sn[eb]); okh[e] = pk2(k2a * cs[ea] + k1a * sn[ea], k2b * cs[eb] + k1b * sn[eb]); }
            *(u32x4*)(Qs + j * 72 + d0) = oql; *(u32x4*)(Qs + j * 72 + d0 + 32) = oqh; *(u32x4*)(Ks + j * 72 + d0) = okl; *(u32x4*)(Ks + j * 72 + d0 + 32) = okh; }
#pragma unroll
        for (int q = 0; q < 4; ++q) { const int id = tid + NT * q, j = id & 127, e8 = (id >> 7) * 8; const u32x4 raw = *(const u32x4*)(P + (size_t)(t0 + j) * PW + C_RV + h * 128 + e8);
#pragma unroll
            for (int e = 0; e < 4; ++e) { VT[(e8 + 2 * e) * 136 + j] = (bf16_t)(raw[e] & 0xffffu); VT[(e8 + 2 * e + 1) * 136 + j] = (bf16_t)(raw[e] >> 16); } }
        const size_t sbase = (((size_t)(u >> 3) * 8 + h)) * 8192;
#pragma unroll
        for (int q = 0; q < 4; ++q) { const int id = tid + NT * q, e = id >> 4, d4 = (id & 15) * 4; *(unsigned long long*)(SF + e * 72 + d4) = *(const unsigned long long*)(STF + sbase + (size_t)e * 64 + d4); *(unsigned long long*)(SB + e * 72 + d4) = *(const unsigned long long*)(STB + sbase + (size_t)e * 64 + d4); }
        SYNCTHREADS();
        const int i = wv * 16 + fr; const long t = t0 + i;
        {
            f32x4 sc[8];
#pragma unroll
            for (int nt = 0; nt < 8; ++nt) sc[nt] = (f32x4){0.f, 0.f, 0.f, 0.f};
            wave_mma<2, 8>(sc, Qs + wv * 16 * 72, 72, Ks, 72);
#pragma unroll
            for (int nt = 0; nt < 8; ++nt) { const int j0 = 16 * nt + 4 * fq; f32x4 sv;
#pragma unroll
                for (int e = 0; e < 4; ++e) { const int j = j0 + e, dist = i > j ? i - j : j - i; sv[e] = sc[nt][e] * tab[64 + dist]; }
                st_bf4(Ss + i * 136 + j0, sv); }
        }
#ifdef CPU_EMU
        SYNCTHREADS();
#else
        asm volatile("s_waitcnt lgkmcnt(0)" ::: "memory");
#endif
        f32x4 ao[8], tm[8];
#pragma unroll
        for (int nt = 0; nt < 8; ++nt) { ao[nt] = (f32x4){0.f, 0.f, 0.f, 0.f}; tm[nt] = (f32x4){0.f, 0.f, 0.f, 0.f}; }
        wave_mma<4, 8>(ao, Ss + wv * 16 * 136, 136, VT, 136);
        wave_mma<2, 8>(tm, Qs + wv * 16 * 72, 72, SF, 72);
        { const float qf = tab[64 + i + 1];
#pragma unroll
            for (int nt = 0; nt < 8; ++nt) { ao[nt] += tm[nt] * qf; tm[nt] = (f32x4){0.f, 0.f, 0.f, 0.f}; } }
        wave_mma<2, 8>(tm, Qs + wv * 16 * 72, 72, SB, 72);
        { const float qb = tab[64 + 128 - i];
#pragma unroll
            for (int nt = 0; nt < 8; ++nt) ao[nt] += tm[nt] * qb; }
        float sm = 0.f;
#pragma unroll
        for (int nt = 0; nt < 8; ++nt) sm += (ao[nt][0] + ao[nt][1]) + (ao[nt][2] + ao[nt][3]);
        sm += SHFL_XOR(sm, 16); sm += SHFL_XOR(sm, 32);
        const float mu = sm * (1.f / 128.f); float sq = 0.f;
#pragma unroll
        for (int nt = 0; nt < 8; ++nt) { ao[nt] -= mu; sq += (ao[nt][0] * ao[nt][0] + ao[nt][1] * ao[nt][1]) + (ao[nt][2] * ao[nt][2] + ao[nt][3] * ao[nt][3]); }
        sq += SHFL_XOR(sq, 16); sq += SHFL_XOR(sq, 32);
        const float rs = frsq_(sq * (1.f / 128.f) + EPS);
#pragma unroll
        for (int nt = 0; nt < 8; ++nt) { const int e0 = 16 * nt + 4 * fq; f32x4 gv = ld_bf4(P + (size_t)t * PW + C_RG + h * 128 + e0);
#pragma unroll
            for (int e = 0; e < 4; ++e) gv[e] = siluf_(gv[e]) * (ao[nt][e] * rs);
            st_bf4(Y + (size_t)t * 4 * W + 1 * W + h * 128 + e0, gv); }
        SYNCTHREADS();
    }
}
__device__ __forceinline__ void ph_sgu_norm(const Ctx& c, int l) {
    const bf16_t* P = WSH(O_P); float* ST = WSF(O_VN);
    const int lane = threadIdx.x & 63, gw = blockIdx.x * (NT / 64) + (threadIdx.x >> 6), ngw = gridDim.x * (NT / 64);
    for (int t = gw; t < T; t += ngw) {
        f32x4 v[4]; float sm = 0.f;
#pragma unroll
        for (int j = 0; j < 4; ++j) { v[j] = ld_bf4(P + (size_t)t * PW + C_SV + (j * 64 + lane) * 4);
#pragma unroll
            for (int q = 0; q < 4; ++q) { v[j][q] = geluf_(v[j][q]); sm += v[j][q]; } }
        const float mu = wave_sum(sm) * (1.f / W); float sq = 0.f;
#pragma unroll
        for (int j = 0; j < 4; ++j)
#pragma unroll
            for (int q = 0; q < 4; ++q) { const float dd = v[j][q] - mu; sq += dd * dd; }
        const float rs = 1.f / sqrtf(wave_sum(sq) * (1.f / W) + EPS);
        if (lane == 0) { ST[(size_t)t * 2] = mu; ST[(size_t)t * 2 + 1] = rs; }
    }
}
__device__ __forceinline__ void ph_sgu_mix(const Ctx& c, int l, float* ldsf) {
    const bf16_t* P = WSH(O_P); const float* SG = WSF(O_HF) + (size_t)T * 32; bf16_t* Y = WSH(O_YS); const float* ng = c.in[15] + (size_t)l * W;
    bf16_t* As = (bf16_t*)ldsf; bf16_t* Bs = As + 128 * 136; const int tid = threadIdx.x, wv = tid >> 6, lane = tid & 63, fr = lane & 15, fq = lane >> 4;
    int gprev = -1;
    for (int u = blockIdx.x; u < (T / 128) * 8; u += gridDim.x) {
        const int g = u & 7; const long t0 = (long)(u >> 3) * 128;
        const float* ws = c.in[16] + ((size_t)l * 8 + g) * 128 * 128; const float* bs = c.in[17] + ((size_t)l * 8 + g) * 128;
        if (g != gprev) {
#pragma unroll
            for (int q = 0; q < 8; ++q) { const int id = tid + NT * q, i = id >> 5, j4 = (id & 31) * 4; st_bf4(As + i * 136 + j4, *(const f32x4*)(ws + i * 128 + j4)); }
            gprev = g; }
        float mu, rs;
        { const f32x4* sg = (const f32x4*)(SG + (size_t)(t0 + (tid & 127)) * 32); f32x4 a = sg[0];
#pragma unroll
          for (int i = 1; i < 8; ++i) a += sg[i];
          mu = (a[0] + a[2]) * (1.f / W); rs = frsq_(fmaxf((a[1] + a[3]) * (1.f / W) - mu * mu, 0.f) + EPS); }
#pragma unroll
        for (int q = 0; q < 4; ++q) { const int id = tid + NT * q, j = id & 127, d8 = (id >> 7) * 8;
            const u32x4 raw = *(const u32x4*)(P + (size_t)(t0 + j) * PW + C_SV + g * 128 + d8); const f32x4 n0 = *(const f32x4*)(ng + g * 128 + d8), n1 = *(const f32x4*)(ng + g * 128 + d8 + 4);
            const float ngv[8] = {n0[0], n0[1], n0[2], n0[3], n1[0], n1[1], n1[2], n1[3]};
#pragma unroll
            for (int e = 0; e < 4; ++e) { const float v0 = (geluf_(bflo(raw[e])) - mu) * rs * ngv[2 * e], v1 = (geluf_(bfhi(raw[e])) - mu) * rs * ngv[2 * e + 1];
                Bs[(d8 + 2 * e) * 136 + j] = (bf16_t)f2bf(v0); Bs[(d8 + 2 * e + 1) * 136 + j] = (bf16_t)f2bf(v1); } }
        const int i = wv * 16 + fr; const long t = t0 + i; const float bsi = bs[i];
        unsigned long long uraw[8];
#pragma unroll
        for (int nt = 0; nt < 8; ++nt) uraw[nt] = *(const unsigned long long*)(P + (size_t)t * PW + C_SU + g * 128 + 16 * nt + 4 * fq);
        SYNCTHREADS();
        f32x4 acc[8];
#pragma unroll
        for (int nt = 0; nt < 8; ++nt) acc[nt] = (f32x4){0.f, 0.f, 0.f, 0.f};
        wave_mma<4, 8>(acc, As + wv * 16 * 136, 136, Bs, 136);
#pragma unroll
        for (int nt = 0; nt < 8; ++nt) { const int d = 16 * nt + 4 * fq; const unsigned ulo = (unsigned)uraw[nt], uhi = (unsigned)(uraw[nt] >> 32); f32x4 uu = (f32x4){bflo(ulo), bfhi(ulo), bflo(uhi), bfhi(uhi)};
#pragma unroll
            for (int e = 0; e < 4; ++e) uu[e] = geluf_(uu[e]) * (acc[nt][e] + bsi);
            st_bf4(Y + (size_t)t * 4 * W + 2 * W + g * 128 + d, uu); }
        SYNCTHREADS();
    }
}
__device__ __forceinline__ void ph_rw_shift(const Ctx& c, int l) {
    const bf16_t* P = WSH(O_P); const float* mup = c.in[18] + (size_t)l * RF; const float* mun = c.in[19] + (size_t)l * RF; bf16_t* FS = WSH(O_FS);
    const int lane = threadIdx.x & 63, gw = blockIdx.x * (NT / 64) + (threadIdx.x >> 6), ngw = gridDim.x * (NT / 64);
    for (int t0 = gw * 4; t0 < T; t0 += ngw * 4) {
        const bf16_t* pc = P + (size_t)t0 * PW + C_RW;
#pragma unroll 1
        for (int j = lane * 4; j < RF; j += 256) {
            const f32x4 z4 = (f32x4){0.f, 0.f, 0.f, 0.f}; f32x4 rowv[6];
#pragma unroll
            for (int r = 0; r < 6; ++r) { const int t = t0 - 1 + r; rowv[r] = (t >= 0 && t < T) ? ld_bf4(pc + (long)(r - 1) * PW + j) : z4; }
            const f32x4 mp = *(const f32x4*)(mup + j), mn = *(const f32x4*)(mun + j);
#pragma unroll
            for (int r = 0; r < 4; ++r) { const int t = t0 + r, sI = t % S; const f32x4 f = rowv[r + 1]; const f32x4 pv = sI > 0 ? rowv[r] : z4, nv = sI < S - 1 ? rowv[r + 2] : z4;
                f32x4 v = f + mp * (pv - f) + mn * (nv - f);
                if (j >= 3072 && j < 3200) {
#pragma unroll
                    for (int e = 0; e < 4; ++e) v[e] = tanhf_(v[e]); }
                else if (j >= 3328) {
#pragma unroll
                    for (int e = 0; e < 4; ++e) v[e] = sigmoidf_(v[e]); }
                st_bf4(FS + (size_t)t * RF + j, v); }
        }
    }
}
__device__ __forceinline__ void ph_rw_lora(const Ctx& c, int l, float* ldsf) {
    const bf16_t* FS = WSH(O_FS); const float* w0 = c.in[20] + (size_t)l * 2 * W; const float* a0 = c.in[22] + (size_t)l * 2 * W;
    const bf16_t* WUT = WSH(O_WUT); const bf16_t* WAT = WSH(O_WAT); const bf16_t* WGT = WSH(O_WGT);
    bf16_t* DEC = WSH(O_DEC); bf16_t* AA = WSH(O_AA); bf16_t* GG = WSH(O_GG);
    bf16_t* F = (bf16_t*)ldsf; bf16_t* B1 = F + 128 * 136; bf16_t* B2 = B1 + 128 * 136; const int tid = threadIdx.x, wv = tid >> 6, lane = tid & 63, fr = lane & 15, fq = lane >> 4;
    unsigned long long fpre[8]; u32x4 bpre[4];
#define LORA_LOAD(uu, rdd) do { const int wc0_ = ((uu) & 7) * 128; const long t0_ = (long)((uu) >> 3) * 128; \
        _Pragma("unroll") for (int q = 0; q < 8; ++q) { const int id = tid + NT * q, r = id >> 5, c4 = (id & 31) * 4; \
            const int col = (rdd) < 2 ? (c4 < 64 ? 3072 + (rdd) * 64 + c4 : 3200 + (rdd) * 64 + (c4 - 64)) : 3328 + c4; fpre[q] = *(const unsigned long long*)(FS + (size_t)(t0_ + r) * RF + col); } \
        if ((rdd) < 2) { _Pragma("unroll") for (int q = 0; q < 2; ++q) { const int id = tid + NT * q, w = id >> 3, r8 = (id & 7) * 8; \
            bpre[2 * q] = *(const u32x4*)(WUT + ((size_t)(rdd) * W + wc0_ + w) * 64 + r8); bpre[2 * q + 1] = *(const u32x4*)(WAT + ((size_t)(rdd) * W + wc0_ + w) * 64 + r8); } } \
        else { _Pragma("unroll") for (int q = 0; q < 4; ++q) { const int id = tid + NT * q, w = id >> 4, r8 = (id & 15) * 8; bpre[q] = *(const u32x4*)(WGT + ((size_t)wc0_ + w) * 128 + r8); } } } while (0)
    if ((int)blockIdx.x < (T / 128) * 8) LORA_LOAD((int)blockIdx.x, 0);
    for (int u = blockIdx.x; u < (T / 128) * 8; u += gridDim.x) {
        const int wc0 = (u & 7) * 128; const long t0 = (long)(u >> 3) * 128;
#pragma unroll
        for (int rd = 0; rd < 3; ++rd) {
#pragma unroll
            for (int q = 0; q < 8; ++q) { const int id = tid + NT * q, r = id >> 5, c4 = (id & 31) * 4; *(unsigned long long*)(F + r * 136 + c4) = fpre[q]; }
            if (rd < 2) {
#pragma unroll
                for (int q = 0; q < 2; ++q) { const int id = tid + NT * q, w = id >> 3, r8 = (id & 7) * 8; *(u32x4*)(B1 + w * 72 + r8) = bpre[2 * q]; *(u32x4*)(B2 + w * 72 + r8) = bpre[2 * q + 1]; }
            } else {
#pragma unroll
                for (int q = 0; q < 4; ++q) { const int id = tid + NT * q, w = id >> 4, r8 = (id & 15) * 8; *(u32x4*)(B1 + w * 136 + r8) = bpre[q]; }
            }
            if (rd < 2) LORA_LOAD(u, rd + 1); else if (u + (int)gridDim.x < (T / 128) * 8) LORA_LOAD(u + (int)gridDim.x, 0);
            LDS_BARRIER();
            f32x4 a1[8], a2[8];
#pragma unroll
            for (int nt = 0; nt < 8; ++nt) { a1[nt] = (f32x4){0.f, 0.f, 0.f, 0.f}; a2[nt] = (f32x4){0.f, 0.f, 0.f, 0.f}; }
            const long t = t0 + wv * 16 + fr;
            if (rd < 2) {
                wave_mma<2, 8>(a1, F + wv * 16 * 136, 136, B1, 72);
                wave_mma<2, 8>(a2, F + wv * 16 * 136 + 64, 136, B2, 72);
#pragma unroll
                for (int nt = 0; nt < 8; ++nt) { const int ch = wc0 + 16 * nt + 4 * fq; const f32x4 w0v = *(const f32x4*)(w0 + rd * W + ch), a0v = *(const f32x4*)(a0 + rd * W + ch); f32x4 dv, av;
#pragma unroll
                    for (int e = 0; e < 4; ++e) { dv[e] = fexp_(-DECAY_SCALE * sigmoidf_(a1[nt][e] + w0v[e])); av[e] = sigmoidf_(a2[nt][e] + a0v[e]); }
                    st_bf4(DEC + ((size_t)rd * T + t) * W + ch, dv); st_bf4(AA + ((size_t)rd * T + t) * W + ch, av); }
            } else {
                wave_mma<4, 8>(a1, F + wv * 16 * 136, 136, B1, 136);
#pragma unroll
                for (int nt = 0; nt < 8; ++nt) st_bf4(GG + (size_t)t * W + wc0 + 16 * nt + 4 * fq, a1[nt]);
            }
            LDS_BARRIER();
        }
    }
}
#ifdef CPU_EMU
__device__ __forceinline__ float red16_(float x) { x += SHFL_XOR(x, 1); x += SHFL_XOR(x, 2); x += SHFL_XOR(x, 4); x += SHFL_XOR(x, 8); return x; }
__device__ __forceinline__ float red8_(float x) { x += SHFL_XOR(x, 1); x += SHFL_XOR(x, 2); x += SHFL_XOR(x, 4); return x; }
#else
__device__ __forceinline__ float red8_(float x) {
    x += __builtin_bit_cast(float, __builtin_amdgcn_update_dpp(0, __builtin_bit_cast(int, x), 0xB1, 0xF, 0xF, true));
    x += __builtin_bit_cast(float, __builtin_amdgcn_update_dpp(0, __builtin_bit_cast(int, x), 0x4E, 0xF, 0xF, true));
    x += __builtin_bit_cast(float, __builtin_amdgcn_update_dpp(0, __builtin_bit_cast(int, x), 0x141, 0xF, 0xF, true));
    return x;
}
__device__ __forceinline__ float red16_(float x) {
    x += __builtin_bit_cast(float, __builtin_amdgcn_update_dpp(0, __builtin_bit_cast(int, x), 0xB1, 0xF, 0xF, true));
    x += __builtin_bit_cast(float, __builtin_amdgcn_update_dpp(0, __builtin_bit_cast(int, x), 0x4E, 0xF, 0xF, true));
    x += __builtin_bit_cast(float, __builtin_amdgcn_update_dpp(0, __builtin_bit_cast(int, x), 0x141, 0xF, 0xF, true));
    x += __builtin_bit_cast(float, __builtin_amdgcn_update_dpp(0, __builtin_bit_cast(int, x), 0x140, 0xF, 0xF, true));
    return x;
}
#endif
#define RC_M(k) (lm + (k) * 4608)
__device__ __forceinline__ void ph_rw_chunk(const Ctx& c, int l, float* ldsf) {
    const bf16_t* FS = WSH(O_FS); const bf16_t* DEC = WSH(O_DEC); const bf16_t* AA = WSH(O_AA); float* BON = WSF(O_BON);
    const float* kkw = c.in[25] + (size_t)l * W; const float* kaw = c.in[26] + (size_t)l * W; const float* rk = c.in[27] + (size_t)l * W;
    bf16_t* PST = WSH(O_PST); bf16_t* PYT = WSH(O_PYT); bf16_t* SVB = WSH(O_SVB); bf16_t* YVB = WSH(O_YVB);
    bf16_t* lm = (bf16_t*)ldsf; float* gam = (float*)RC_M(7); float* segp = (float*)RC_M(13); float* gl = segp + 512;
    const int tid = threadIdx.x, wv = tid >> 6, lane = tid & 63, fr = lane & 15, fq = lane >> 4, rt = wv & 3, hf = wv >> 2;
    const int m0 = 16 * rt + fr;
    u32x4 wq, kq, rq, vq, aq;
#define RC_LOAD(uu) do { const int chain_ = (uu) / NRC, ck_ = (uu) % NRC, h_ = chain_ & 15, b_ = (chain_ >> 4) & 1, z_ = chain_ >> 5; \
        const long t_ = (long)b_ * S + (z_ ? S - 1 - ck_ * RCK - (tid >> 3) : ck_ * RCK + (tid >> 3)); const int ch_ = h_ * 64 + (tid & 7) * 8; \
        wq = *(const u32x4*)(DEC + ((size_t)z_ * T + t_) * W + ch_); aq = *(const u32x4*)(AA + ((size_t)z_ * T + t_) * W + ch_); \
        const bf16_t* f_ = FS + (size_t)t_ * RF; rq = *(const u32x4*)(f_ + ch_); kq = *(const u32x4*)(f_ + 1024 + ch_); vq = *(const u32x4*)(f_ + 2048 + ch_); } while (0)
    if ((int)blockIdx.x < 64 * NRC) RC_LOAD((int)blockIdx.x);
    for (int u = blockIdx.x; u < 64 * NRC; u += gridDim.x) {
        const int chain = u / NRC, ck = u % NRC, h = chain & 15, b = (chain >> 4) & 1, z = chain >> 5;
        const long tb = (long)b * S + (z ? S - 1 - ck * RCK : ck * RCK); const int dirn = z ? -1 : 1;
        const int tt = tid >> 3, o8 = (tid & 7) * 8;
        const f32x4 kw0 = *(const f32x4*)(kkw + h * 64 + o8), kw1 = *(const f32x4*)(kkw + h * 64 + o8 + 4), ka0 = *(const f32x4*)(kaw + h * 64 + o8), ka1 = *(const f32x4*)(kaw + h * 64 + o8 + 4),
                    rk0 = *(const f32x4*)(rk + h * 64 + o8), rk1 = *(const f32x4*)(rk + h * 64 + o8 + 4);
        *(f32x4*)(gam + tt * 64 + o8) = (f32x4){bflo(wq[0]), bfhi(wq[0]), bflo(wq[1]), bfhi(wq[1])};
        *(f32x4*)(gam + tt * 64 + o8 + 4) = (f32x4){bflo(wq[2]), bfhi(wq[2]), bflo(wq[3]), bfhi(wq[3])};
        LDS_BARRIER();
        { const int k = tid & 63, sg = tid >> 6; float p = 1.f;
#pragma unroll
          for (int q = 0; q < 8; ++q) { p *= gam[(sg * 8 + q) * 64 + k]; gam[(sg * 8 + q) * 64 + k] = p; }
          segp[sg * 64 + k] = p; }
        LDS_BARRIER();
        { const int k = tid & 63, sg = tid >> 6; float pre = 1.f;
          for (int q = 0; q < sg; ++q) pre *= segp[q * 64 + k];
#pragma unroll
          for (int q = 0; q < 8; ++q) gam[(sg * 8 + q) * 64 + k] *= pre;
          if (sg == 7) gl[k] = gam[63 * 64 + k]; }
        LDS_BARRIER();
        { const long t = tb + dirn * tt;
          const f32x4 g0 = *(const f32x4*)(gam + tt * 64 + o8), g1 = *(const f32x4*)(gam + tt * 64 + o8 + 4);
          f32x4 p0 = (f32x4){1.f, 1.f, 1.f, 1.f}, p1 = p0; if (tt) { p0 = *(const f32x4*)(gam + (tt - 1) * 64 + o8); p1 = *(const f32x4*)(gam + (tt - 1) * 64 + o8 + 4); }
          float gx[8], gpx[8], kwx[8], kax[8], rkx[8], kx[8], ax[8], rx[8];
#pragma unroll
          for (int e = 0; e < 4; ++e) { gx[e] = g0[e]; gx[4 + e] = g1[e]; gpx[e] = p0[e]; gpx[4 + e] = p1[e]; kwx[e] = kw0[e]; kwx[4 + e] = kw1[e]; kax[e] = ka0[e]; kax[4 + e] = ka1[e]; rkx[e] = rk0[e]; rkx[4 + e] = rk1[e];
              kx[2 * e] = bflo(kq[e]); kx[2 * e + 1] = bfhi(kq[e]); ax[2 * e] = bflo(aq[e]); ax[2 * e + 1] = bfhi(aq[e]); rx[2 * e] = bflo(rq[e]); rx[2 * e + 1] = bfhi(rq[e]); }
          float vk[8], ktv[8], ss = 0.f, bs = 0.f;
#pragma unroll
          for (int e = 0; e < 8; ++e) { vk[e] = kx[e] * kwx[e]; ss += vk[e] * vk[e]; ktv[e] = kx[e] * (1.f + (ax[e] - 1.f) * kax[e]); bs += rx[e] * rkx[e] * ktv[e]; }
          ss = red8_(ss); bs = red8_(bs);
          if ((tid & 7) == 0) BON[((size_t)z * T + t) * 16 + h] = bs;
          const float rn = frsq_(ss + EPS); float khv[8], bhv[8], k2v[8], rhv[8];
#pragma unroll
          for (int e = 0; e < 8; ++e) { const float kkn = vk[e] * rn, ig = frcp_(gx[e]); khv[e] = kkn * gpx[e]; bhv[e] = ax[e] * kkn * ig; k2v[e] = ktv[e] * ig; rhv[e] = rx[e] * gx[e]; }
          u32x4 K4, B4, C4, R4;
#pragma unroll
          for (int e = 0; e < 4; ++e) { K4[e] = pk2(khv[2 * e], khv[2 * e + 1]); B4[e] = pk2(bhv[2 * e], bhv[2 * e + 1]); C4[e] = pk2(k2v[2 * e], k2v[2 * e + 1]); R4[e] = pk2(rhv[2 * e], rhv[2 * e + 1]); }
          *(u32x4*)(RC_M(0) + tt * 72 + o8) = K4; *(u32x4*)(RC_M(2) + tt * 72 + o8) = B4; *(u32x4*)(RC_M(4) + tt * 72 + o8) = C4; *(u32x4*)(RC_M(5) + tt * 72 + o8) = R4;
#pragma unroll
          for (int e = 0; e < 8; ++e) { const int sh = 16 * (e & 1);
              RC_M(1)[(o8 + e) * 72 + tt] = (bf16_t)(K4[e >> 1] >> sh); RC_M(3)[(o8 + e) * 72 + tt] = (bf16_t)(B4[e >> 1] >> sh); RC_M(6)[(o8 + e) * 72 + tt] = (bf16_t)(vq[e >> 1] >> sh); } }
        if (u + (int)gridDim.x < 64 * NRC) RC_LOAD(u + (int)gridDim.x);
        LDS_BARRIER();
        f32x4 mkr[2], khr[2], rhT[2];
        {
            f32x4 a0[2], a1[2], a2[2], a3[2];
#pragma unroll
            for (int nt = 0; nt < 2; ++nt) { a0[nt] = (f32x4){0.f, 0.f, 0.f, 0.f}; a1[nt] = a0[nt]; a2[nt] = a0[nt]; a3[nt] = a0[nt]; }
            wave_mma<2, 2>(a0, RC_M(2) + rt * 16 * 72, 72, RC_M(0) + hf * 32 * 72, 72);
            wave_mma<2, 2>(a1, RC_M(4) + rt * 16 * 72, 72, RC_M(0) + hf * 32 * 72, 72);
            wave_mma<2, 2>(a2, RC_M(2) + rt * 16 * 72, 72, RC_M(5) + hf * 32 * 72, 72);
            wave_mma<2, 2>(a3, RC_M(4) + rt * 16 * 72, 72, RC_M(5) + hf * 32 * 72, 72);
#pragma unroll
            for (int nt = 0; nt < 2; ++nt) { const int n0 = 32 * hf + 16 * nt + 4 * fq; f32x4 nn, ti, mk;
#pragma unroll
                for (int r = 0; r < 4; ++r) { const int n = n0 + r; const bool lt = m0 < n, le = m0 <= n;
                    nn[r] = lt ? -a0[nt][r] : 0.f; ti[r] = nn[r] + (m0 == n ? 1.f : 0.f); mk[r] = lt ? a1[nt][r] : 0.f; mkr[nt][r] = le ? a3[nt][r] : 0.f;
                    RC_M(12)[n * 72 + m0] = (bf16_t)f2bf(le ? a2[nt][r] : 0.f);
                    RC_M(8)[n * 72 + m0] = (bf16_t)f2bf(nn[r]);
                    khr[nt][r] = bf2f(RC_M(4)[m0 * 72 + n]); rhT[nt][r] = bf2f(RC_M(5)[n * 72 + m0]); }
                st_bf4(RC_M(7) + m0 * 72 + n0, nn); st_bf4(RC_M(9) + m0 * 72 + n0, ti); st_bf4(RC_M(11) + m0 * 72 + n0, mk); }
        }
        LDS_BARRIER();
        f32x4 tiv[2];
#pragma unroll
        for (int nt = 0; nt < 2; ++nt) tiv[nt] = ld_bf4(RC_M(9) + m0 * 72 + 32 * hf + 16 * nt + 4 * fq);
        {
            f32x4 sq[2];
#pragma unroll
            for (int nt = 0; nt < 2; ++nt) sq[nt] = (f32x4){0.f, 0.f, 0.f, 0.f};
            wave_mma<2, 2>(sq, RC_M(7) + rt * 16 * 72, 72, RC_M(8) + hf * 32 * 72, 72);
#pragma unroll
            for (int nt = 0; nt < 2; ++nt) { const int n0 = 32 * hf + 16 * nt + 4 * fq; st_bf4(RC_M(0) + m0 * 72 + n0, sq[nt]);
#pragma unroll
                for (int r = 0; r < 4; ++r) RC_M(2)[(n0 + r) * 72 + m0] = (bf16_t)f2bf(sq[nt][r]); }
        }
        LDS_BARRIER();
#pragma unroll 1
        for (int k = 1; k <= 5; ++k) {
            bf16_t* pk = (k & 1) ? RC_M(0) : RC_M(7); bf16_t* pkT = (k & 1) ? RC_M(2) : RC_M(8); bf16_t* pn = (k & 1) ? RC_M(7) : RC_M(0); bf16_t* pnT = (k & 1) ? RC_M(8) : RC_M(2);
            bf16_t* tcur = (k & 1) ? RC_M(9) : RC_M(4); bf16_t* tnxt = (k & 1) ? RC_M(4) : RC_M(9);
            f32x4 up[2], sq[2];
#pragma unroll
            for (int nt = 0; nt < 2; ++nt) { up[nt] = (f32x4){0.f, 0.f, 0.f, 0.f}; sq[nt] = up[nt]; }
            wave_mma<2, 2>(up, tcur + rt * 16 * 72, 72, pkT + hf * 32 * 72, 72);
            if (k < 5) wave_mma<2, 2>(sq, pk + rt * 16 * 72, 72, pkT + hf * 32 * 72, 72);
#pragma unroll
            for (int nt = 0; nt < 2; ++nt) { const int n0 = 32 * hf + 16 * nt + 4 * fq; tiv[nt] += up[nt]; st_bf4(tnxt + m0 * 72 + n0, tiv[nt]);
                if (k == 5) {
#pragma unroll
                    for (int r = 0; r < 4; ++r) RC_M(10)[(n0 + r) * 72 + m0] = (bf16_t)f2bf(tiv[nt][r]);
                } else { st_bf4(pn + m0 * 72 + n0, sq[nt]);
#pragma unroll
                    for (int r = 0; r < 4; ++r) pnT[(n0 + r) * 72 + m0] = (bf16_t)f2bf(sq[nt][r]); } }
            LDS_BARRIER();
        }
        {
            f32x4 w1[2], w2[2];
#pragma unroll
            for (int nt = 0; nt < 2; ++nt) { w1[nt] = (f32x4){0.f, 0.f, 0.f, 0.f}; w2[nt] = w1[nt]; }
            wave_mma<2, 2>(w1, RC_M(1) + rt * 16 * 72, 72, RC_M(10) + hf * 32 * 72, 72);
            wave_mma<2, 2>(w2, RC_M(11) + rt * 16 * 72, 72, RC_M(10) + hf * 32 * 72, 72);
#pragma unroll
            for (int nt = 0; nt < 2; ++nt) { const int n0 = 32 * hf + 16 * nt + 4 * fq; st_bf4(RC_M(7) + m0 * 72 + n0, w1[nt]); st_bf4(RC_M(8) + m0 * 72 + n0, w2[nt]); }
        }
        LDS_BARRIER();
        {
            f32x4 py[2], qy[2], ps[2], qs[2];
#pragma unroll
            for (int nt = 0; nt < 2; ++nt) { py[nt] = (f32x4){0.f, 0.f, 0.f, 0.f}; qy[nt] = py[nt]; ps[nt] = py[nt]; qs[nt] = py[nt]; }
            wave_mma<2, 2>(py, RC_M(7) + rt * 16 * 72, 72, RC_M(12) + hf * 32 * 72, 72);
            wave_mma<2, 2>(qy, RC_M(8) + rt * 16 * 72, 72, RC_M(12) + hf * 32 * 72, 72);
            wave_mma<2, 2>(ps, RC_M(7) + rt * 16 * 72, 72, RC_M(3) + hf * 32 * 72, 72);
            wave_mma<2, 2>(qs, RC_M(8) + rt * 16 * 72, 72, RC_M(3) + hf * 32 * 72, 72);
#pragma unroll
            for (int nt = 0; nt < 2; ++nt) { const int n0 = 32 * hf + 16 * nt + 4 * fq;
#pragma unroll
                for (int r = 0; r < 4; ++r) { const int n = n0 + r; const float gln = gl[n];
                    RC_M(0)[n * 72 + m0] = (bf16_t)f2bf(rhT[nt][r] - py[nt][r]); RC_M(2)[n * 72 + m0] = (bf16_t)f2bf(mkr[nt][r] - qy[nt][r]);
                    RC_M(4)[n * 72 + m0] = (bf16_t)f2bf(((m0 == n ? 1.f : 0.f) - ps[nt][r]) * gln); RC_M(5)[n * 72 + m0] = (bf16_t)f2bf((khr[nt][r] - qs[nt][r]) * gln); } }
        }
        LDS_BARRIER();
        {
            f32x4 yv[2], sv[2];
#pragma unroll
            for (int nt = 0; nt < 2; ++nt) { yv[nt] = (f32x4){0.f, 0.f, 0.f, 0.f}; sv[nt] = yv[nt]; }
            wave_mma<2, 2>(yv, RC_M(6) + rt * 16 * 72, 72, RC_M(2) + hf * 32 * 72, 72);
            wave_mma<2, 2>(sv, RC_M(6) + rt * 16 * 72, 72, RC_M(5) + hf * 32 * 72, 72);
#pragma unroll
            for (int nt = 0; nt < 2; ++nt) { const int n0 = 32 * hf + 16 * nt + 4 * fq; st_bf4(YVB + (size_t)u * 4096 + m0 * 64 + n0, yv[nt]); st_bf4(SVB + (size_t)u * 4096 + m0 * 64 + n0, sv[nt]); }
            { const int rr = tid >> 3, c8 = (tid & 7) * 8; *(u32x4*)(PYT + (size_t)u * 4096 + rr * 64 + c8) = *(const u32x4*)(RC_M(0) + rr * 72 + c8); *(u32x4*)(PST + (size_t)u * 4096 + rr * 64 + c8) = *(const u32x4*)(RC_M(4) + rr * 72 + c8); }
        }
        LDS_BARRIER();
    }
}
#undef RC_M
#undef RC_LOAD
__device__ __forceinline__ void ph_rw_seq(const Ctx& c, float* ldsf) {
    const bf16_t* PST = WSH(O_PST); const bf16_t* PYT = WSH(O_PYT); const bf16_t* SVB = WSH(O_SVB); const bf16_t* YVB = WSH(O_YVB); bf16_t* YY = WSH(O_YY);
    bf16_t* Sb = (bf16_t*)ldsf;
    bf16_t* Pm = Sb + 2 * 16 * 72;
    const int tid = threadIdx.x, wv = tid >> 6, lane = tid & 63, fr = lane & 15, fq = lane >> 4, nt0 = wv & 3;
#ifdef CPU_EMU
    const int isY = wv >> 2;
#else
    const int isY = __builtin_amdgcn_readfirstlane(wv >> 2);
#endif
    for (int u = blockIdx.x; u < 256; u += gridDim.x) {
        const int x = u & 7, jq = u >> 3, chain = x * 8 + (jq >> 2), qt = jq & 3, h = chain & 15, b = (chain >> 4) & 1, z = chain >> 5;
        const size_t ub = (size_t)chain * NRC;
        const int rr = tid >> 3, c8 = (tid & 7) * 8;
        constexpr int PD = NRC >= 8 ? 8 : 4;
        for (int i = tid; i < 2 * 16 * 72 / 2; i += NT) ((unsigned*)Sb)[i] = 0u;
        const int row = 16 * qt + fr, n0 = 16 * nt0 + 4 * fq; const bf16_t* addp = (isY ? YVB : SVB) + ub * 4096 + row * 64 + n0;
        const bf16_t* psp = PST + ub * 4096 + rr * 64 + c8; const bf16_t* pyp = PYT + ub * 4096 + rr * 64 + c8;
        u32x4 gps[PD], gpy[PD]; unsigned long long addr[PD];
#pragma unroll
        for (int j = 0; j < PD; ++j) { gps[j] = *(const u32x4*)(psp + (size_t)j * 4096); gpy[j] = *(const u32x4*)(pyp + (size_t)j * 4096); addr[j] = *(const unsigned long long*)(addp + (size_t)j * 4096); }
        *(u32x4*)(Pm + (0 * 2 + 0) * 4608 + rr * 72 + c8) = gps[0]; *(u32x4*)(Pm + (0 * 2 + 1) * 4608 + rr * 72 + c8) = gpy[0];
        { const int cl = PD < NRC ? PD : NRC - 1; gps[0] = *(const u32x4*)(psp + (size_t)cl * 4096); gpy[0] = *(const u32x4*)(pyp + (size_t)cl * 4096); }
        SYNCTHREADS();
#define RS_LOOP(ISY) \
        for (int ck0 = 0; ck0 < NRC; ck0 += PD) { \
            _Pragma("unroll") for (int j = 0; j < PD; ++j) { \
                const int ck = ck0 + j, cur = j & 1, nxt = cur ^ 1;        \
                f32x4 acc[1]; acc[0] = (f32x4){0.f, 0.f, 0.f, 0.f}; \
                wave_mma<2, 1>(acc, Sb + cur * 16 * 72, 72, Pm + (cur * 2 + ISY) * 4608 + nt0 * 16 * 72, 72); \
                { const unsigned lo_ = (unsigned)addr[j], hi_ = (unsigned)(addr[j] >> 32); acc[0][0] += bflo(lo_); acc[0][1] += bfhi(lo_); acc[0][2] += bflo(hi_); acc[0][3] += bfhi(hi_); } \
                { const int cl = ck + PD < NRC ? ck + PD : NRC - 1; addr[j] = *(const unsigned long long*)(addp + (size_t)cl * 4096); } \
                if (ISY) { \
                    _Pragma("unroll") for (int r = 0; r < 4; ++r) { const int step = ck * RCK + n0 + r, sidx = z ? S - 1 - step : step; YY[((size_t)z * T + (size_t)b * S + sidx) * W + h * 64 + row] = (bf16_t)f2bf(acc[0][r]); } \
                } else st_bf4(Sb + nxt * 16 * 72 + fr * 72 + n0, acc[0]); \
                const int jn = (j + 1) % PD; \
                *(u32x4*)(Pm + (nxt * 2 + 0) * 4608 + rr * 72 + c8) = gps[jn]; *(u32x4*)(Pm + (nxt * 2 + 1) * 4608 + rr * 72 + c8) = gpy[jn]; \
                { const int cl = ck + 1 + PD < NRC ? ck + 1 + PD : NRC - 1; gps[jn] = *(const u32x4*)(psp + (size_t)cl * 4096); gpy[jn] = *(const u32x4*)(pyp + (size_t)cl * 4096); } \
                LDS_BARRIER(); \
            } \
        }
        if (isY) { RS_LOOP(1) } else { RS_LOOP(0) }
#undef RS_LOOP
    }
}
__device__ __forceinline__ void ph_rw_out(const Ctx& c) {
    const bf16_t* FS = WSH(O_FS); const bf16_t* YY = WSH(O_YY); const float* BON = WSF(O_BON); const bf16_t* GG = WSH(O_GG); bf16_t* Y = WSH(O_YS);
    const int lane = threadIdx.x & 63, gw = blockIdx.x * (NT / 64) + (threadIdx.x >> 6), ngw = gridDim.x * (NT / 64);
    for (int i0 = gw; i0 < T * 2; i0 += 2 * ngw) {
        u32x4 a0[2], a1[2], gq[2], vq[2]; float bs[2];
#pragma unroll
        for (int r = 0; r < 2; ++r) { const int i = i0 + r * ngw < T * 2 ? i0 + r * ngw : i0; const long t = i >> 1; const int ch = (i & 1) * 512 + lane * 8, hd = ch >> 6;
            a0[r] = *(const u32x4*)(YY + (size_t)t * W + ch); a1[r] = *(const u32x4*)(YY + ((size_t)T + t) * W + ch); gq[r] = *(const u32x4*)(GG + (size_t)t * W + ch); vq[r] = *(const u32x4*)(FS + (size_t)t * RF + 2048 + ch);
            bs[r] = BON[(size_t)t * 16 + hd] + BON[((size_t)T + t) * 16 + hd]; }
#pragma unroll
        for (int r = 0; r < 2; ++r) { const int i = i0 + r * ngw < T * 2 ? i0 + r * ngw : i0; const long t = i >> 1; const int ch = (i & 1) * 512 + lane * 8;
            float y0[8], y1[8], s0 = 0.f, s1 = 0.f;
#pragma unroll
            for (int e = 0; e < 4; ++e) { y0[2 * e] = bflo(a0[r][e]); y0[2 * e + 1] = bfhi(a0[r][e]); y1[2 * e] = bflo(a1[r][e]); y1[2 * e + 1] = bfhi(a1[r][e]); }
#pragma unroll
            for (int e = 0; e < 8; ++e) { s0 += y0[e]; s1 += y1[e]; }
            const float m0 = red8_(s0) * (1.f / 64.f), m1 = red8_(s1) * (1.f / 64.f); float q0 = 0.f, q1 = 0.f;
#pragma unroll
            for (int e = 0; e < 8; ++e) { y0[e] -= m0; y1[e] -= m1; q0 += y0[e] * y0[e]; q1 += y1[e] * y1[e]; }
            const float r0 = frsq_(red8_(q0) * (1.f / 64.f) + EPS), r1 = frsq_(red8_(q1) * (1.f / 64.f) + EPS);
            u32x4 o;
#pragma unroll
            for (int e = 0; e < 4; ++e) { const float lo = (y0[2 * e] * r0 + y1[2 * e] * r1 + bs[r] * bflo(vq[r][e])) * bflo(gq[r][e]), hi = (y0[2 * e + 1] * r0 + y1[2 * e + 1] * r1 + bs[r] * bfhi(vq[r][e])) * bfhi(gq[r][e]); o[e] = pk2(lo, hi); }
            *(u32x4*)(Y + (size_t)t * 4 * W + 3 * W + ch) = o; }
    }
}
__device__ __forceinline__ float row_rstd_(const float* ssp, long tr) { const f32x4* q = (const f32x4*)(ssp + (size_t)tr * 32); f32x4 a = q[0];
#pragma unroll
    for (int i = 1; i < 8; ++i) a += q[i];
    return frsq_(((a[0] + a[1]) + (a[2] + a[3])) * (1.f / D) + EPS); }
__device__ __forceinline__ void ph_router(const Ctx& c, int l, float* ldsf, const float* X, const float* gN, const float* shN, const float* scN) {
    const float* SSP = WSF(O_HF); bf16_t* Hn = WSH(O_H); const bf16_t* WH = WSH(O_WRH); const bf16_t* WL = WSH(O_WRL); const float* bg = c.in[31] + (size_t)l * 4; const float* be = c.in[33] + (size_t)l * 32;
    int* EID = WSI(O_EID); float* EWT = WSF(O_EWT); int* cnt = CTLW(c) + CW_CNT + l * 64;
    const int tid = threadIdx.x, wv = tid >> 6, lane = tid & 63, fr = lane & 15, fq = lane >> 4, rt = wv & 1, kq = wv >> 1;
    float* part = ldsf;
    for (int u = blockIdx.x; u < T / 32; u += gridDim.x) {
        const long t0 = (long)u * 32; f32x4 acc[3];
#pragma unroll
        for (int nt = 0; nt < 3; ++nt) acc[nt] = (f32x4){0.f, 0.f, 0.f, 0.f};
#ifdef CPU_EMU
        for (int nt = 0; nt < 3; ++nt) for (int r = 0; r < 4; ++r) { const int n = 16 * nt + 4 * fq + r; float sacc = 0.f;
            for (int k = kq * 512; k < kq * 512 + 512; ++k) { const long tr = t0 + 16 * rt + fr; const int bb = (int)(tr / S); const float hv = X[(size_t)tr * D + k] * row_rstd_(SSP, tr) * gN[k] * (1.f + scN[bb * D6 + k]) + shN[bb * D6 + k]; const float hh = bf2f((bf16_t)f2bf(hv)), hl = bf2f((bf16_t)f2bf(hv - hh));
                const float wh = bf2f(WH[(size_t)n * D + k]), wl = bf2f(WL[(size_t)n * D + k]); sacc += hh * wh + hl * wh + hh * wl; }
            acc[nt][r] = sacc; }
        if (fq == 0) for (int k = kq * 512; k < kq * 512 + 512; ++k) { const long tr = t0 + 16 * rt + fr; const int bb = (int)(tr / S); Hn[(size_t)tr * D + k] = (bf16_t)f2bf(X[(size_t)tr * D + k] * row_rstd_(SSP, tr) * gN[k] * (1.f + scN[bb * D6 + k]) + shN[bb * D6 + k]); }
#else
        const long tr = t0 + 16 * rt + fr; const int bb = (int)(tr / S); const float rsv = row_rstd_(SSP, tr); const int kb = kq * 512 + fq * 8;
        const float* hp = X + (size_t)tr * D + kb; const float* gp_ = gN + kb; const float* scp = scN + bb * D6 + kb; const float* shp = shN + bb * D6 + kb;
#pragma unroll 4
        for (int ks = 0; ks < 16; ++ks) {
            const f32x4 h0 = *(const f32x4*)(hp + ks * 32) * rsv * *(const f32x4*)(gp_ + ks * 32) * (*(const f32x4*)(scp + ks * 32) + 1.f) + *(const f32x4*)(shp + ks * 32);
            const f32x4 h1 = *(const f32x4*)(hp + ks * 32 + 4) * rsv * *(const f32x4*)(gp_ + ks * 32 + 4) * (*(const f32x4*)(scp + ks * 32 + 4) + 1.f) + *(const f32x4*)(shp + ks * 32 + 4); bf16x8 ah, al;
#pragma unroll
            for (int e = 0; e < 4; ++e) { const unsigned b0 = f2bf(h0[e]), b1 = f2bf(h1[e]); ah[e] = (short)b0; ah[4 + e] = (short)b1; al[e] = (short)f2bf(h0[e] - u2f_(b0 << 16)); al[4 + e] = (short)f2bf(h1[e] - u2f_(b1 << 16)); }
            *(bf16x8*)(Hn + (size_t)tr * D + kb + ks * 32) = ah;
#pragma unroll
            for (int nt = 0; nt < 3; ++nt) { const size_t wo = (size_t)(16 * nt + fr) * D + kq * 512 + ks * 32 + fq * 8; const bf16x8 bh = *(const bf16x8*)(WH + wo), bl = *(const bf16x8*)(WL + wo);
                acc[nt] = __builtin_amdgcn_mfma_f32_16x16x32_bf16(bh, ah, acc[nt], 0, 0, 0); acc[nt] = __builtin_amdgcn_mfma_f32_16x16x32_bf16(bh, al, acc[nt], 0, 0, 0); acc[nt] = __builtin_amdgcn_mfma_f32_16x16x32_bf16(bl, ah, acc[nt], 0, 0, 0); }
        }
#endif
#pragma unroll
        for (int nt = 0; nt < 3; ++nt) *(f32x4*)(part + (kq * 32 + 16 * rt + fr) * 48 + 16 * nt + 4 * fq) = acc[nt];
        SYNCTHREADS();
        if (tid < 32) { const long t = t0 + tid; float lg[36];
#pragma unroll
            for (int q = 0; q < 36; ++q) lg[q] = (part[(0 * 32 + tid) * 48 + q] + part[(1 * 32 + tid) * 48 + q]) + (part[(2 * 32 + tid) * 48 + q] + part[(3 * 32 + tid) * 48 + q]) + (q < 4 ? bg[q < 4 ? q : 0] : be[q >= 4 ? q - 4 : 0]);
            int gi = 0; float m = lg[0];
#pragma unroll
            for (int q = 1; q < 4; ++q) if (lg[q] > m) { m = lg[q]; gi = q; }
            float den = 0.f;
#pragma unroll
            for (int q = 0; q < 4; ++q) den += expf(lg[q] - m);
            const float gp = 1.f / den; float el[8];
#pragma unroll
            for (int q = 0; q < 8; ++q) el[q] = gi == 0 ? lg[4 + q] : gi == 1 ? lg[12 + q] : gi == 2 ? lg[20 + q] : lg[28 + q];
            int i1 = 0; float m1 = el[0];
#pragma unroll
            for (int q = 1; q < 8; ++q) if (el[q] > m1) { m1 = el[q]; i1 = q; }
            int i2 = -1; float m2 = 0.f;
#pragma unroll
            for (int q = 0; q < 8; ++q) if (q != i1 && (i2 < 0 || el[q] > m2)) { m2 = el[q]; i2 = q; }
            const float p2 = expf(m2 - m1);
            EID[t * 2] = gi * 8 + i1; EID[t * 2 + 1] = gi * 8 + i2; EWT[t * 2] = gp / (1.f + p2); EWT[t * 2 + 1] = gp * p2 / (1.f + p2);
            atomic_add_i(cnt + gi * 8 + i1, 1); atomic_add_i(cnt + gi * 8 + i2, 1);
        }
        SYNCTHREADS();
    }
}
__device__ __forceinline__ void ph_moe_assign(const Ctx& c, int l, float* ldsf) {
    const int* cnt = CTLW(c) + CW_CNT + l * 64; int* plan = CTLW(c) + CW_PLAN + l * 256; const int* EID = WSI(O_EID); int* fill = CTLW(c) + CW_FILL + l * 64; int* DEST = WSI(O_DEST); int* SRC = WSI(O_XS);
    int* pstart = (int*)ldsf;
    if (threadIdx.x == 0) { int ps = 0, nb = 0; const bool pub = blockIdx.x == 0;
        for (int e = 0; e < NE; ++e) { pstart[e] = ps; if (pub) plan[e] = ps; const int nblk = (cnt[e] + 255) / 256; if (pub) for (int q = 0; q < nblk; ++q) plan[64 + nb + q] = e; nb += nblk; ps += nblk * 256; }
        if (pub) { plan[32] = ps; plan[40] = nb; } }
    SYNCTHREADS();
    for (long i = GT_; i < (long)T * 2; i += GS_) { const int e = EID[i]; const int pos = atomic_add_i(fill + e, 1); DEST[i] = pstart[e] + pos; SRC[pstart[e] + pos] = (int)(i >> 1); }
    SYNCTHREADS();
}
__device__ __forceinline__ void ph_moe_gather(const Ctx& c) {
    const int* DEST = WSI(O_DEST); const u32x4* H = (const u32x4*)WSH(O_H); u32x4* XS = (u32x4*)WSH(O_XS);
    const long N = (long)T * 2 * (D / 8);
    for (long i0 = GT_; i0 < N; i0 += 4 * GS_) {
        u32x4 v[4]; int d[4];
#pragma unroll
        for (int r = 0; r < 4; ++r) { const long i = i0 + r * GS_ < N ? i0 + r * GS_ : i0; const long a = i / (D / 8); d[r] = DEST[a]; v[r] = H[(size_t)(a >> 1) * (D / 8) + (int)(i % (D / 8))]; }
#pragma unroll
        for (int r = 0; r < 4; ++r) { const long i = i0 + r * GS_ < N ? i0 + r * GS_ : i0; XS[(size_t)d[r] * (D / 8) + (int)(i % (D / 8))] = v[r]; }
    }
}
#ifndef CPU_EMU
#define XB_TMO      128
#define XB_XCNT(j)  (256  + 64 * (j))
#define XB_XSUB(j)  (1280 + 64 * (j))
#define XB_XGEN(j)  (2304 + 64 * (j))
#define XB_TOP      3328
#define XB_TOPGEN   3392
#define XCD_BAR_WORDS 3456
#define XB_SPIN_CAP (1u << 26)
#define LAS __attribute__((address_space(3)))
__device__ __forceinline__ unsigned xb_ld(unsigned* p)              { return __hip_atomic_load(p, __ATOMIC_RELAXED, __HIP_MEMORY_SCOPE_AGENT); }
__device__ __forceinline__ unsigned xb_add(unsigned* p, unsigned v) { return __hip_atomic_fetch_add(p, v, __ATOMIC_RELAXED, __HIP_MEMORY_SCOPE_AGENT); }
__device__ __forceinline__ unsigned xb_xcc_id() { return (unsigned)__builtin_amdgcn_s_getreg((3 << 11) | 20) & 0xFu; }
#define XB_SPIN(cond, bar) do { unsigned _sp = 0; while (cond) { __builtin_amdgcn_s_sleep(1); \
    if ((++_sp & 255u) == 0u) { if (xb_ld(&(bar)[XB_TMO])) break; if (_sp > XB_SPIN_CAP) { atomicAdd(&(bar)[XB_TMO], 1u); break; } } } } while (0)
struct XcdBarrier { unsigned* bar; unsigned x; volatile LAS unsigned* st; };
__device__ __forceinline__ XcdBarrier xcd_barrier_post(unsigned* bar, volatile LAS unsigned* st) {
    XcdBarrier b; b.bar = bar; b.x = xb_xcc_id(); b.st = st;
    if (threadIdx.x == 0) (void)xb_add(&bar[XB_XCNT(b.x)], 1u);
    return b;
}
__device__ __forceinline__ void xcd_barrier_complete(unsigned* bar, unsigned x, unsigned& nloc, unsigned& nx) {
    const unsigned G = gridDim.x * gridDim.y * gridDim.z;
    unsigned sum, cnt, mine, sp = 0u;
    for (;;) {
        sum = 0u; cnt = 0u; mine = 0u;
#pragma unroll
        for (unsigned j = 0; j < 16; ++j) { const unsigned cc = xb_ld(&bar[XB_XCNT(j)]); sum += cc; cnt += (cc > 0u) ? 1u : 0u; mine = (j == x) ? cc : mine; }
        if (sum == G) break;
        __builtin_amdgcn_s_sleep(1);
        if ((++sp & 255u) == 0u) { if (xb_ld(&bar[XB_TMO])) break; if (sp > XB_SPIN_CAP) { atomicAdd(&bar[XB_TMO], 1u); break; } }
    }
    nloc = mine > 0u ? mine : 1u; nx = cnt > 0u ? cnt : 1u;
}
__device__ __forceinline__ void xcd_barrier(const XcdBarrier& b) {
    asm volatile("s_waitcnt vmcnt(0)" ::: "memory");
    __syncthreads();
    if (threadIdx.x == 0) {
        unsigned* bar = b.bar;
        __builtin_amdgcn_s_waitcnt(0);
        unsigned nloc = b.st[0], nx = b.st[1];
        if (nloc == 0u) { xcd_barrier_complete(bar, b.x, nloc, nx); b.st[0] = nloc; b.st[1] = nx; }
        const unsigned old = xb_add(&bar[XB_XSUB(b.x)], 1u);
        const unsigned gen = old / nloc;
        if (old + 1u == (gen + 1u) * nloc) {
            __builtin_amdgcn_fence(__ATOMIC_RELEASE, "agent");
            asm volatile("s_waitcnt vmcnt(0)" ::: "memory");
            const unsigned og = xb_add(&bar[XB_TOP], 1u);
            const unsigned tg = og / nx;
            if (og + 1u == (tg + 1u) * nx) xb_add(&bar[XB_TOPGEN], 1u);
            else XB_SPIN(xb_ld(&bar[XB_TOPGEN]) == tg, bar);
            __builtin_amdgcn_fence(__ATOMIC_ACQUIRE, "agent");
            xb_add(&bar[XB_XGEN(b.x)], 1u);
            asm volatile("s_waitcnt vmcnt(0)" ::: "memory");
        } else {
            XB_SPIN(xb_ld(&bar[XB_XGEN(b.x)]) == gen, bar);
            __builtin_amdgcn_fence(__ATOMIC_ACQUIRE, "agent");
            asm volatile("s_waitcnt vmcnt(0)" ::: "memory");
        }
    }
    __syncthreads();
}
#endif

constexpr int LDS_BYTES = 147456;

__global__ void __launch_bounds__(NT, 2) fwd(Params p) {
#ifdef CPU_EMU
    unsigned char* lds = g_lds; float* ldsf = (float*)g_lds;
#else
    extern __shared__ __attribute__((aligned(16))) unsigned char lds[];
    float* ldsf = (float*)lds;
    volatile LAS unsigned* misc = (volatile LAS unsigned*)((LAS unsigned char*)lds + LDS_BYTES - 64);
    if (threadIdx.x == 0) { misc[0] = 0u; misc[1] = 0u; }
    __syncthreads();
    XcdBarrier bar = xcd_barrier_post((unsigned*)(p.ws + O_CTL) + CW_BAR, misc);
#endif
    Ctx c; c.in = p.in; c.out = p.out; c.ws = p.ws;
    const int lo = p.ph_lo, hi = p.ph_hi; int ph = 0;
    const int G = (int)gridDim.x, cwg = (int)blockIdx.x;
#ifdef CPU_EMU
#define GRID_BAR()
#else
#define GRID_BAR() xcd_barrier(bar)
#endif
#ifndef REPEAT_MASK
#define REPEAT_MASK 0
#endif
#ifndef TIME_PHASE
#define TIME_PHASE -1
#endif
#if TIME_PHASE >= 0 && !defined(CPU_EMU)
    unsigned long long tp0 = 0, tp1 = 0;
#define TP_BEGIN() do { if (ph == TIME_PHASE) tp0 = __builtin_amdgcn_s_memrealtime(); } while (0)
#define TP_END() do { if (ph == TIME_PHASE) tp1 = __builtin_amdgcn_s_memrealtime(); } while (0)
#else
#define TP_BEGIN()
#define TP_END()
#endif
#define PHASE(...) do { if (lo <= ph && ph < hi) { TP_BEGIN(); __VA_ARGS__; if (ph + 1 < hi) { GRID_BAR(); } TP_END(); } ++ph; } while (0)
#define PHASEG(grp, ...) do { if (lo <= ph && ph < hi) { TP_BEGIN(); if ((REPEAT_MASK >> (grp)) & 1) { __VA_ARGS__; GRID_BAR(); } __VA_ARGS__; if (ph + 1 < hi) { GRID_BAR(); } TP_END(); } ++ph; } while (0)
    PHASE(ph_mod(c, ldsf); ph_rope_table(c); ph_convert(c, 0, ldsf));
#define LAYER_BODY(l) do { const float* mod = WSF(O_MOD); \
        const float* xin = l == 0 ? c.in[0] : WSF(O_X1); float* xmid = WSF(O_X0); float* xout = WSF(O_X1); \
        const float* ml = mod + (size_t)l * NB * D6; \
        PHASEG(0, { pg8::Gemm g{D, D, D}; pg8::StaticOrder so; so.init(T, PW, G, cwg, WSH(O_H), WSH(O_WIN), D, D); pg8::EpiP E{WSH(O_P), (unsigned char*)(c.ws + O_G8), WSF(O_HF) + (size_t)T * 32}; pg8::gemm_phase(lds, g, so, E); \
            { const int nun_ = (T / 256) * (PW / 256), rem_ = nun_ % G; if (rem_ != 0 && cwg >= rem_) { SYNCTHREADS(); convert_big(c, l, ldsf, J_ALL - convert_tail_tiles(), J_ALL, cwg - rem_, G - rem_); } } }); \
        PHASE(ph_lru<1>(c, l, ldsf); ph_ret_kv(c, ldsf); ph_rw_shift(c, l)); \
        PHASE(ph_lru_scan2(c); ph_ret_state(c); ph_sgu_mix(c, l, ldsf); ph_rw_lora(c, l, ldsf)); \
        PHASE(ph_lru_fin(c, ldsf); ph_ret_out(c, ldsf); ph_rw_chunk(c, l, ldsf)); \
        PHASE(ph_rw_seq(c, ldsf)); \
        PHASE(ph_rw_out(c)); \
        PHASEG(1, { pg8::Gemm g{4 * W, 4 * W, 4 * W}; pg8::StaticOrder so; so.init(T, D, G, cwg, WSH(O_YS), WSH(O_WBR), 4 * W, 4 * W); pg8::EpiMerge E{(const unsigned char*)(c.ws + O_G8), WSH(O_MRG)}; pg8::gemm_phase(lds, g, so, E); }); \
        PHASEG(1, { pg8::Gemm g{D, D, D}; pg8::StaticOrder so; so.init(T, D, G, cwg, WSH(O_MRG), WSH(O_WOUT), D, D); pg8::EpiResid E{xin, ml + 2 * D, xmid, WSF(O_HF)}; pg8::gemm_phase(lds, g, so, E); }); \
        PHASE(ph_router(c, l, ldsf, xmid, c.in[4] + (size_t)l * D, ml + 3 * D, ml + 4 * D)); \
        PHASE(ph_moe_assign(c, l, ldsf)); \
        const int* plan = CTLW(c) + CW_PLAN + l * 256; \
        PHASEG(2, { pg8::Gemm g{D, D, D}; pg8::MoeGatherOrder mo{G, cwg, 4, plan, (const char*)WSH(O_H), (const char*)WSH(O_WGU), (size_t)256 * D * 2, (size_t)1024 * D * 2, WSI(O_XS), T}; pg8::EpiGU E{WSH(O_ACT)}; pg8::gemm_phase(lds, g, mo, E); \
            if (l == 0) { const int nrest_ = plan[40] * 4 - G; if (nrest_ >= 0 && nrest_ < G && cwg >= nrest_) { SYNCTHREADS(); convert_big(c, 1, ldsf, 0, convert_early_tiles(c), cwg - nrest_, G - nrest_); } } }); \
        PHASEG(2, { pg8::Gemm g{512, 512, 512}; pg8::MoeOrder mo{G, cwg, 8, plan, (const char*)WSH(O_ACT), (const char*)WSH(O_WDN), (size_t)256 * 512 * 2, (size_t)256 * 512 * 2, (size_t)D * 512 * 2}; pg8::EpiBf16 E{WSH(O_YE), D}; pg8::gemm_phase(lds, g, mo, E); }); \
        if (l == 0) PHASE(ph_comb_norm<0>(c, xmid, ml + 5 * D, xout, c.in[3] + (size_t)1 * D, mod + (size_t)1 * NB * D6 + 0 * D, mod + (size_t)1 * NB * D6 + 1 * D, WSH(O_H), nullptr); ph_convert(c, 1, ldsf)); \
        else PHASE(ph_comb_norm<1>(c, xmid, ml + 5 * D, xout, c.in[36], nullptr, nullptr, nullptr, c.out)); \
    } while (0)
    PHASE(ph_norm(c, c.in[0], c.in[3], WSF(O_MOD) + 0 * D, WSF(O_MOD) + 1 * D, WSH(O_H), nullptr));
    LAYER_BODY(0);
    LAYER_BODY(1);
#undef LAYER_BODY
#if TIME_PHASE >= 0 && !defined(CPU_EMU)
    if (blockIdx.x == 0) { const unsigned long long te = __builtin_amdgcn_s_memrealtime(), dl = 8ull * (tp1 - tp0); while (__builtin_amdgcn_s_memrealtime() - te < dl) __builtin_amdgcn_s_sleep(8); }
#endif
#undef PHASE
}
}

#ifndef CPU_EMU
extern "C" void kernel_launch(void* const* d_in, const int* in_sizes, int n_in, void* d_out, int out_size, void* d_ws, size_t ws_size, hipStream_t stream) {
    static int grid = 0;
    if (grid == 0) {
        if (n_in != 37 || out_size != T * D || ws_size < WS_END) { fprintf(stderr, "kernel_launch: unexpected shapes (n_in %d out %d ws %zu need %zu)\n", n_in, out_size, ws_size, (size_t)WS_END); grid = -1; return; }
        int dev = 0, cus = 0, per_cu = 0;
        if (hipGetDevice(&dev) != hipSuccess || hipDeviceGetAttribute(&cus, hipDeviceAttributeMultiprocessorCount, dev) != hipSuccess) { grid = -1; return; }
        if (hipFuncSetAttribute((const void*)fwd, hipFuncAttributeMaxDynamicSharedMemorySize, LDS_BYTES) != hipSuccess) { fprintf(stderr, "kernel_launch: hipFuncSetAttribute failed\n"); grid = -1; return; }
        if (hipOccupancyMaxActiveBlocksPerMultiprocessor(&per_cu, (const void*)fwd, NT, LDS_BYTES) != hipSuccess || per_cu < 1) fprintf(stderr, "kernel_launch: occupancy query says %d\n", per_cu);
        (void)hipGetLastError();
        grid = cus;
    }
    if (grid < 0) return;
    (void)in_sizes;
    (void)hipMemsetAsync((char*)d_ws + O_CTL, 0, CTL_BYTES, stream);
    Params p{};
    for (int i = 0; i < 37; ++i) p.in[i] = (const float*)d_in[i];
    p.out = (float*)d_out; p.ws = (unsigned char*)d_ws;
#if ONE_LAUNCH
    p.ph_lo = 0; p.ph_hi = NPH;
    hipLaunchKernelGGL(fwd, dim3(grid), dim3(NT), LDS_BYTES, stream, p);
#else
    for (int k = 0; k < NPH; ++k) { p.ph_lo = k; p.ph_hi = k + 1; hipLaunchKernelGGL(fwd, dim3(grid), dim3(NT), LDS_BYTES, stream, p); }
#endif
}
#endif
```

```cpp
#ifndef CPU_EMU
#include <hip/hip_runtime.h>
#endif
#include <cstdio>
#include <cstdint>
#include <cmath>
#include <cstring>

#ifndef SEQ
#define SEQ 4096
#endif
#ifndef ONE_LAUNCH
#define ONE_LAUNCH 1
#endif

namespace {
constexpr int D = 2048, NB = 2, S = SEQ, T = NB * S, NL = 2, W = 1024;
constexpr int INW = 18816, RF = 3456, D6 = 6 * D;
constexpr int C_LX = 0, C_LG = 1024, C_RQ = 2048, C_RK = 2560, C_RV = 3072, C_RG = 4096, C_SU = 5120, C_SV = 6144, C_RW = 7168;
constexpr int PW = 18944, C_MLP = 10752;
constexpr int NCH = S / 128;
constexpr int NLC = S / 64;
constexpr int NE = 32, CAP = (T * 2 / 256 + NE) * 256, MAXBLK = CAP / 256;
constexpr float EPS = 1e-6f;
constexpr float DECAY_SCALE = 0.60653065971263342f;
constexpr int NT = 512;
constexpr int NPH_LAYER = 13, NPH = 2 + NL * NPH_LAYER;
typedef unsigned short bf16_t;
#ifdef CPU_EMU
typedef float f32x4 __attribute__((vector_size(16)));
typedef unsigned u32x4 __attribute__((vector_size(16)));
#else
typedef float f32x4 __attribute__((ext_vector_type(4)));
typedef unsigned u32x4 __attribute__((ext_vector_type(4)));
typedef short bf16x8 __attribute__((ext_vector_type(8)));
#endif

constexpr size_t al256(size_t x) { return (x + 255) & ~(size_t)255; }
constexpr size_t SZ_X = (size_t)T * D * 4, SZ_W = (size_t)T * W * 4;
constexpr size_t O_CTL = 0, CTL_BYTES = 1u << 20;
constexpr size_t O_MOD = CTL_BYTES;
constexpr size_t O_X0 = O_MOD + al256((size_t)NL * NB * D6 * 4);
constexpr size_t O_X1 = O_X0 + SZ_X;
constexpr size_t O_H = O_X1 + SZ_X;
constexpr size_t O_HF = O_H + SZ_X / 2;
constexpr size_t O_P = O_HF + SZ_X;
constexpr size_t SZ_P = (size_t)T * PW * 2;
constexpr size_t O_XC = O_P + SZ_P;
constexpr size_t O_LA = O_XC + SZ_W, O_LU = O_LA + 2 * SZ_W;
constexpr size_t SZ_LC = (size_t)2 * NB * NLC * W * 4;
constexpr size_t O_LCA = O_LU + 2 * SZ_W, O_LCH = O_LCA + SZ_LC, O_LCI = O_LCH + SZ_LC;
constexpr size_t O_YS = O_LCI + SZ_LC;
constexpr size_t O_SC = O_YS + (size_t)T * 4 * W * 2;
constexpr size_t SZ_KV = (size_t)NB * NCH * 8 * 64 * 128 * 4;
constexpr size_t O_KVF = O_SC, O_KVB = O_KVF + SZ_KV, O_STF = O_KVB + SZ_KV, O_STB = O_STF + SZ_KV;
constexpr size_t O_VN = O_STB + SZ_KV;
constexpr size_t O_FS = O_VN + SZ_W;
constexpr size_t O_DEC = O_FS + al256((size_t)T * RF * 4), O_AA = O_DEC + 2 * SZ_W, O_AKK = O_AA + 2 * SZ_W;
constexpr size_t O_GG = O_AKK, O_YY = O_GG + SZ_W;
constexpr int RCK = 64, NRC = S / RCK;
constexpr size_t O_BON = O_YY + 2 * SZ_W;
constexpr size_t O_PART = O_BON + al256((size_t)2 * T * 16 * 4);
constexpr size_t O_MRG = O_PART + SZ_X;
constexpr size_t O_LOG = O_MRG + SZ_X / 2;
constexpr size_t O_EID = O_LOG + al256((size_t)T * 40 * 4), O_EWT = O_EID + al256((size_t)T * 2 * 4), O_DEST = O_EWT + al256((size_t)T * 2 * 4);
constexpr size_t O_SLOT = O_DEST + al256((size_t)T * 2 * 4);
constexpr size_t O_PST = O_SLOT + al256((size_t)CAP * 4), O_PYT = O_PST + (size_t)64 * NRC * 4096 * 2, O_SVB = O_PYT + (size_t)64 * NRC * 4096 * 2, O_YVB = O_SVB + (size_t)64 * NRC * 4096 * 4;
constexpr size_t O_WIN = O_YVB + (size_t)64 * NRC * 4096 * 4;
constexpr size_t O_WBR = O_WIN + (size_t)PW * D * 2;
constexpr size_t O_WOUT = O_WBR + (size_t)D * 4 * W * 2;
constexpr size_t O_WGU = O_WOUT + (size_t)D * D * 2;
constexpr size_t O_WDN = O_WGU + (size_t)NE * 1024 * D * 2;
constexpr size_t O_G8 = O_WDN + (size_t)NE * D * 512 * 2;
constexpr size_t O_ROPE = O_G8 + (size_t)T * 4 * D;
constexpr size_t O_WLR = O_ROPE + (size_t)T * 64 * 4;
constexpr size_t O_WUT = O_WLR + (size_t)32 * 128 * 128 * 2;
constexpr size_t O_WAT = O_WUT + (size_t)2 * W * 64 * 2;
constexpr size_t O_WGT = O_WAT + (size_t)2 * W * 64 * 2;
constexpr size_t O_WRH = O_WGT + (size_t)W * 128 * 2;
constexpr size_t O_WRL = O_WRH + (size_t)48 * D * 2;
constexpr size_t WS_END0 = O_WRL + (size_t)48 * D * 2;
constexpr size_t SZ_MOE = (size_t)CAP * (D + 512 + D) * 2;
constexpr bool MOE_OVERLAY = SZ_MOE <= SZ_P;
constexpr size_t O_XS = MOE_OVERLAY ? O_P : WS_END0;
constexpr size_t O_ACT = O_XS + (size_t)CAP * D * 2;
constexpr size_t O_YE = O_ACT + (size_t)CAP * 512 * 2;
constexpr size_t WS_END = MOE_OVERLAY ? WS_END0 : WS_END0 + SZ_MOE;
static_assert(SEQ != 4096 || WS_END <= (size_t)2040 * 1024 * 1024, "workspace budget: d_ws is 4 x the largest input = 2048 MiB");
constexpr int CW_BAR = 4096;
constexpr int CW_CNT = 32768;
constexpr int CW_FILL = CW_CNT + NL * 64;
constexpr int CW_PLAN = CW_FILL + NL * 64;
static_assert(MAXBLK <= 160, "plan words");

struct Params { const float* in[37]; float* out; unsigned char* ws; int ph_lo, ph_hi; };

struct Ctx { const float* const* in; float* out; unsigned char* ws; };
#define GT_ ((long)blockIdx.x * NT + threadIdx.x)
#define GS_ ((long)gridDim.x * NT)
#define WSF(off) ((float*)(c.ws + (off)))
#define WSI(off) ((int*)(c.ws + (off)))
#define WSH(off) ((bf16_t*)(c.ws + (off)))
#define CTLW(c) ((int*)((c).ws + O_CTL))

#ifdef CPU_EMU
__device__ __forceinline__ float fexp_(float x) { return expf(x); }
__device__ __forceinline__ float frcp_(float x) { return 1.f / x; }
__device__ __forceinline__ float frsq_(float x) { return 1.f / sqrtf(x); }
__device__ __forceinline__ float fsqrt_(float x) { return sqrtf(x); }
#else
__device__ __forceinline__ float fexp_(float x) { return __builtin_amdgcn_exp2f(x * 1.4426950408889634f); }
__device__ __forceinline__ float frcp_(float x) { return __builtin_amdgcn_rcpf(x); }
__device__ __forceinline__ float frsq_(float x) { return __builtin_amdgcn_rsqf(x); }
__device__ __forceinline__ float fsqrt_(float x) { return __builtin_amdgcn_sqrtf(x); }
#endif
__device__ __forceinline__ float sigmoidf_(float x) { return frcp_(1.f + fexp_(-x)); }
__device__ __forceinline__ float siluf_(float x) { return x * frcp_(1.f + fexp_(-x)); }
__device__ __forceinline__ float tanhf_(float x) { return 1.f - 2.f * frcp_(1.f + fexp_(2.f * x)); }
#ifdef CPU_EMU
__device__ __forceinline__ float geluf_(float x) { return 0.5f * x * (1.f + tanhf_(0.7978845608028654f * (x + 0.044715f * x * x * x))); }
#else
__device__ __forceinline__ float geluf_(float x) { return x * __builtin_amdgcn_rcpf(1.f + __builtin_amdgcn_exp2f(-x * (2.3022082f + 0.10294324f * x * x))); }
#endif
__device__ __forceinline__ float softplusf_(float x) { return x > 0.f ? x + log1pf(expf(-x)) : log1pf(expf(x)); }
__device__ __forceinline__ float loggamma_(int h) { return log1pf(-exp2f(-5.f - (float)h)); }
__device__ __forceinline__ unsigned f2u_(float f) { unsigned u; memcpy(&u, &f, 4); return u; }
__device__ __forceinline__ float u2f_(unsigned u) { float f; memcpy(&f, &u, 4); return f; }
__device__ __forceinline__ float bf2f(bf16_t v) { return u2f_((unsigned)v << 16); }
#ifdef CPU_EMU
__device__ __forceinline__ unsigned f2bf(float f) { const unsigned u = f2u_(f); return (u + 0x7fffu + ((u >> 16) & 1u)) >> 16; }
__device__ __forceinline__ unsigned pk2(float lo, float hi) { return f2bf(lo) | (f2bf(hi) << 16); }
#else
typedef __attribute__((ext_vector_type(2))) __bf16 hwbf2_t; typedef __attribute__((ext_vector_type(2))) float hwf2_t;
__device__ __forceinline__ unsigned f2bf(float f) { const __bf16 s = (__bf16)f; return (unsigned)__builtin_bit_cast(unsigned short, s); }
__device__ __forceinline__ unsigned pk2(float lo, float hi) { const hwf2_t v = {lo, hi}; return __builtin_bit_cast(unsigned, __builtin_convertvector(v, hwbf2_t)); }
#endif
__device__ __forceinline__ float bflo(unsigned w) { return u2f_(w << 16); }
__device__ __forceinline__ float bfhi(unsigned w) { return u2f_(w & 0xffff0000u); }
__device__ __forceinline__ int atomic_add_i(int* p, int v) {
#ifdef CPU_EMU
    return __atomic_fetch_add(p, v, __ATOMIC_RELAXED);
#else
    return atomicAdd(p, v);
#endif
}
#define PF(P, r, col) bf2f((P)[(size_t)(r) * PW + (col)])
#ifdef CPU_EMU
#define SYNCTHREADS() emu_syncthreads()
#define LDS_BARRIER() emu_syncthreads()
#define SHFL_XOR(v, m) emu_shfl_xor(v, m)
#else
#define SYNCTHREADS() __syncthreads()
#define LDS_BARRIER() do { asm volatile("s_waitcnt lgkmcnt(0)" ::: "memory"); __builtin_amdgcn_s_barrier(); asm volatile("" ::: "memory"); } while (0)
#define SHFL_XOR(v, m) __shfl_xor(v, m)
#endif
#ifdef CPU_EMU
__device__ __forceinline__ float wave_sum(float v) {
    for (int o = 1; o < 64; o <<= 1) v += SHFL_XOR(v, o);
    return v;
}
#else
__device__ __forceinline__ float wave_sum(float x) {
    x += __builtin_bit_cast(float, __builtin_amdgcn_update_dpp(0, __builtin_bit_cast(int, x), 0xB1, 0xF, 0xF, true));
    x += __builtin_bit_cast(float, __builtin_amdgcn_update_dpp(0, __builtin_bit_cast(int, x), 0x4E, 0xF, 0xF, true));
    x += __builtin_bit_cast(float, __builtin_amdgcn_update_dpp(0, __builtin_bit_cast(int, x), 0x141, 0xF, 0xF, true));
    x += __builtin_bit_cast(float, __builtin_amdgcn_update_dpp(0, __builtin_bit_cast(int, x), 0x140, 0xF, 0xF, true));
    const int xi = __builtin_bit_cast(int, x);
    return (__builtin_bit_cast(float, __builtin_amdgcn_readlane(xi, 0)) + __builtin_bit_cast(float, __builtin_amdgcn_readlane(xi, 16))) + (__builtin_bit_cast(float, __builtin_amdgcn_readlane(xi, 32)) + __builtin_bit_cast(float, __builtin_amdgcn_readlane(xi, 48)));
}
#endif
__device__ __forceinline__ f32x4 ld_bf4(const bf16_t* p) { const unsigned long long q = *(const unsigned long long*)p; const unsigned lo = (unsigned)q, hi = (unsigned)(q >> 32); return (f32x4){bflo(lo), bfhi(lo), bflo(hi), bfhi(hi)}; }
__device__ __forceinline__ void st_bf4(bf16_t* p, const f32x4 v) { *(unsigned long long*)p = (unsigned long long)pk2(v[0], v[1]) | ((unsigned long long)pk2(v[2], v[3]) << 32); }

template <int KT, int NTL>
__device__ __forceinline__ void wave_mma(f32x4 (&acc)[NTL], const bf16_t* A, int lda, const bf16_t* Bt, int ldb) {
    const int lane = threadIdx.x & 63, fr = lane & 15, fq = lane >> 4;
#ifdef CPU_EMU
    for (int nt = 0; nt < NTL; ++nt) for (int r = 0; r < 4; ++r) { float sacc = 0.f; const bf16_t* a = A + fr * lda; const bf16_t* b = Bt + (16 * nt + 4 * fq + r) * ldb;
        for (int k = 0; k < 32 * KT; ++k) sacc += bf2f(a[k]) * bf2f(b[k]);
        acc[nt][r] += sacc; }
#else
#pragma unroll
    for (int kt = 0; kt < KT; ++kt) {
        const bf16x8 af = *(const bf16x8*)(A + fr * lda + kt * 32 + fq * 8);
#pragma unroll
        for (int nt = 0; nt < NTL; ++nt) { const bf16x8 bfr = *(const bf16x8*)(Bt + (16 * nt + fr) * ldb + kt * 32 + fq * 8);
            acc[nt] = __builtin_amdgcn_mfma_f32_16x16x32_bf16(bfr, af, acc[nt], 0, 0, 0); }
    }
#endif
}
__device__ __forceinline__ void ph_mod(const Ctx& c, float* ldsf) {
    const float* cc = c.in[1]; const float* aw = c.in[5]; const float* ab = c.in[6]; float* mod = WSF(O_MOD);
    float* scs = ldsf; float* part = ldsf + NB * D; const int tid = threadIdx.x, c4 = (tid & 31) * 4, kq = tid >> 5;
    for (int i = tid; i < NB * D; i += NT) scs[i] = siluf_(cc[i]);
    SYNCTHREADS();
    for (int u = blockIdx.x; u < NL * (D6 / 128); u += gridDim.x) {
        const int l = u / (D6 / 128), j0 = (u % (D6 / 128)) * 128;
        const float* w = aw + (size_t)l * D * D6 + j0 + c4; f32x4 a0 = (f32x4){0.f, 0.f, 0.f, 0.f}, a1 = a0;
#pragma unroll 8
        for (int k = kq * 128; k < kq * 128 + 128; ++k) { const f32x4 wv = *(const f32x4*)(w + (size_t)k * D6); a0 += wv * scs[k]; a1 += wv * scs[D + k]; }
        *(f32x4*)(part + (kq * 2 + 0) * 128 + c4) = a0; *(f32x4*)(part + (kq * 2 + 1) * 128 + c4) = a1;
        SYNCTHREADS();
        if (tid < 256) { const int b = tid >> 7, col = tid & 127; float sacc = 0.f;
#pragma unroll
            for (int q = 0; q < 16; ++q) sacc += part[(q * 2 + b) * 128 + col];
            mod[((size_t)l * NB + b) * D6 + j0 + col] = sacc + ab[l * D6 + j0 + col]; }
        SYNCTHREADS();
    }
}
__device__ __forceinline__ void ph_norm(const Ctx& c, const float* x, const float* g, const float* sh, const float* sc, bf16_t* hb, float* hf) {
    const int lane = threadIdx.x & 63, gw = blockIdx.x * (NT / 64) + (threadIdx.x >> 6), ngw = gridDim.x * (NT / 64);
    for (int t0 = gw * 2; t0 < T; t0 += ngw * 2) {
        f32x4 v[2][8]; float ss[2] = {0.f, 0.f};
#pragma unroll
        for (int r = 0; r < 2; ++r)
#pragma unroll
            for (int j = 0; j < 8; ++j) v[r][j] = *(const f32x4*)(x + (size_t)(t0 + r) * D + (j * 64 + lane) * 4);
#pragma unroll
        for (int r = 0; r < 2; ++r) {
#pragma unroll
            for (int j = 0; j < 8; ++j) ss[r] += (v[r][j][0] * v[r][j][0] + v[r][j][1] * v[r][j][1]) + (v[r][j][2] * v[r][j][2] + v[r][j][3] * v[r][j][3]);
            const int t = t0 + r, b = t / S; const float rs = 1.f / sqrtf(wave_sum(ss[r]) * (1.f / D) + EPS);
#pragma unroll
            for (int j = 0; j < 8; ++j) { const int col = (j * 64 + lane) * 4;
                const f32x4 o = v[r][j] * rs * *(const f32x4*)(g + col) * (*(const f32x4*)(sc + b * D6 + col) + 1.f) + *(const f32x4*)(sh + b * D6 + col);
                st_bf4(hb + (size_t)t * D + col, o); }
            if (hf && lane == 0) hf[t] = rs;
        }
    }
}
template <int MODE>
__device__ __forceinline__ void ph_comb_norm(const Ctx& c, const float* xmid, const float* g2, float* xout, const float* g, const float* sh, const float* sc, bf16_t* hb, float* outp) {
    const bf16_t* YE = WSH(O_YE); const float* EWT = WSF(O_EWT); const int* DEST = WSI(O_DEST);
    const int lane = threadIdx.x & 63, gw = blockIdx.x * (NT / 64) + (threadIdx.x >> 6), ngw = gridDim.x * (NT / 64);
    float w0n = 0.f, w1n = 0.f; int d0n = 0, d1n = 0;
    if (gw < T) { w0n = EWT[gw * 2]; w1n = EWT[gw * 2 + 1]; d0n = DEST[gw * 2]; d1n = DEST[gw * 2 + 1]; }
    for (int t = gw; t < T; t += ngw) {
        const int b = t / S; const float w0 = w0n, w1 = w1n; const bf16_t* y0 = YE + (size_t)d0n * D; const bf16_t* y1 = YE + (size_t)d1n * D;
        if (t + ngw < T) { const int tn = t + ngw; w0n = EWT[tn * 2]; w1n = EWT[tn * 2 + 1]; d0n = DEST[tn * 2]; d1n = DEST[tn * 2 + 1]; }
        f32x4 v[8]; float ss = 0.f;
#pragma unroll
        for (int j = 0; j < 8; ++j) { const int col = (j * 64 + lane) * 4;
            v[j] = *(const f32x4*)(xmid + (size_t)t * D + col) + *(const f32x4*)(g2 + b * D6 + col) * (ld_bf4(y0 + col) * w0 + ld_bf4(y1 + col) * w1);
            if (MODE == 0) *(f32x4*)(xout + (size_t)t * D + col) = v[j];
            ss += (v[j][0] * v[j][0] + v[j][1] * v[j][1]) + (v[j][2] * v[j][2] + v[j][3] * v[j][3]); }
        const float rs = 1.f / sqrtf(wave_sum(ss) * (1.f / D) + EPS);
#pragma unroll
        for (int j = 0; j < 8; ++j) { const int col = (j * 64 + lane) * 4;
            if (MODE == 0) st_bf4(hb + (size_t)t * D + col, v[j] * rs * *(const f32x4*)(g + col) * (*(const f32x4*)(sc + b * D6 + col) + 1.f) + *(const f32x4*)(sh + b * D6 + col));
            else *(f32x4*)(outp + (size_t)t * D + col) = v[j] * rs * *(const f32x4*)(g + col); }
    }
}

struct CvtItem { const float* Wp; int ldw; bf16_t* WT; int ldt; int drow, k0, n0; };
constexpr int I_IN = 32 * (INW / 32), I_BR = 4 * 16 * 64, I_OUT = 32 * 64, I_GU = NE * 32 * 32, I_DN = NE * 8 * 64, I_LR = 32 * 8, I_WU = 2 * 32, I_WG = 64, I_BIG = I_IN + I_BR + I_OUT + I_GU + I_DN, I_ALL = I_BIG + I_LR + 2 * I_WU + I_WG;
__device__ __forceinline__ CvtItem cvt_decode(const Ctx& c, int l, int it) {
    CvtItem r;
    if (it < I_IN) { const int kb = it / (INW / 32), nb = it % (INW / 32); r.n0 = nb * 32; r.k0 = kb * 64; r.Wp = c.in[7] + (size_t)l * D * INW; r.ldw = INW; r.WT = WSH(O_WIN); r.ldt = D; r.drow = r.n0 < 10624 ? r.n0 : r.n0 + 128; return r; }
    it -= I_IN;
    if (it < I_BR) { const int sgm = it / 1024, q = it % 1024, kb = q / 64, nb = q % 64; r.n0 = nb * 32; r.k0 = kb * 64; r.Wp = c.in[28] + ((size_t)l * 4 + sgm) * W * D; r.ldw = D; r.WT = WSH(O_WBR) + sgm * W; r.ldt = 4 * W; r.drow = r.n0; return r; }
    it -= I_BR;
    if (it < I_OUT) { const int kb = it / 64, nb = it % 64; r.n0 = nb * 32; r.k0 = kb * 64; r.Wp = c.in[29] + (size_t)l * D * D; r.ldw = D; r.WT = WSH(O_WOUT); r.ldt = D; r.drow = r.n0; return r; }
    it -= I_OUT;
    if (it < I_GU) { const int e = it / 1024, q = it % 1024, kb = q / 32, nb = q % 32; r.n0 = nb * 32; r.k0 = kb * 64; r.Wp = c.in[34] + ((size_t)l * NE + e) * D * 1024; r.ldw = 1024; r.WT = WSH(O_WGU) + (size_t)e * 1024 * D; r.ldt = D;
        r.drow = r.n0 < 512 ? (r.n0 / 128) * 256 + (r.n0 % 128) : ((r.n0 - 512) / 128) * 256 + 128 + ((r.n0 - 512) % 128); return r; }
    it -= I_GU;
    if (it < I_DN) { const int e = it / 512, q = it % 512, kb = q / 64, nb = q % 64; r.n0 = nb * 32; r.k0 = kb * 64; r.Wp = c.in[35] + ((size_t)l * NE + e) * 512 * D; r.ldw = D; r.WT = WSH(O_WDN) + (size_t)e * D * 512; r.ldt = 512; r.drow = r.n0; return r; }
    it -= I_DN;
    if (it < I_LR) { const int m = it / 8, q = it % 8, kb = q / 4, nb = q % 4, z = m >> 4, ty = (m >> 3) & 1, n = m & 7; r.n0 = nb * 32; r.k0 = kb * 64; r.Wp = c.in[ty ? 12 : 10] + (((size_t)l * 2 + z) * 8 + n) * 128 * 128; r.ldw = 128;
        r.WT = WSH(O_WLR) + (size_t)m * 128 * 128; r.ldt = 128; r.drow = r.n0; return r; }
    it -= I_LR;
    if (it < 2 * I_WU) { const int ua = it / I_WU, q = it % I_WU, z = q / 32, nb = q % 32; r.n0 = nb * 32; r.k0 = 0; r.Wp = c.in[ua ? 23 : 21] + ((size_t)l * 2 + z) * 64 * W; r.ldw = W; r.WT = WSH(ua ? O_WAT : O_WUT) + (size_t)z * W * 64; r.ldt = 64; r.drow = r.n0; return r; }
    it -= 2 * I_WU;
    { const int kb = it / 32, nb = it % 32; r.n0 = nb * 32; r.k0 = kb * 64; r.Wp = c.in[24] + (size_t)l * 128 * W; r.ldw = W; r.WT = WSH(O_WGT); r.ldt = 128; r.drow = r.n0; return r; }
}
constexpr int J_IN = 16 * (INW / 128), J_BR = 4 * 8 * 16, J_OUT = 16 * 16, J_GU = NE * 16 * 8, J_DN = NE * 4 * 16, J_ALL = J_IN + J_BR + J_OUT + J_GU + J_DN;
__device__ __forceinline__ CvtItem cvt_decode_big(const Ctx& c, int l, int it) {
    CvtItem r;
    if (it < J_IN) { const int kb = it / (INW / 128), nb = it % (INW / 128); r.n0 = nb * 128; r.k0 = kb * 128; r.Wp = c.in[7] + (size_t)l * D * INW; r.ldw = INW; r.WT = WSH(O_WIN); r.ldt = D; r.drow = r.n0 < 10624 ? r.n0 : r.n0 + 128; return r; }
    it -= J_IN;
    if (it < J_BR) { const int sgm = it / 128, q = it % 128, kb = q / 16, nb = q % 16; r.n0 = nb * 128; r.k0 = kb * 128; r.Wp = c.in[28] + ((size_t)l * 4 + sgm) * W * D; r.ldw = D; r.WT = WSH(O_WBR) + sgm * W; r.ldt = 4 * W; r.drow = r.n0; return r; }
    it -= J_BR;
    if (it < J_OUT) { const int kb = it / 16, nb = it % 16; r.n0 = nb * 128; r.k0 = kb * 128; r.Wp = c.in[29] + (size_t)l * D * D; r.ldw = D; r.WT = WSH(O_WOUT); r.ldt = D; r.drow = r.n0; return r; }
    it -= J_OUT;
    if (it < J_GU) { const int e = it / 128, q = it % 128, kb = q / 8, nb = q % 8; r.n0 = nb * 128; r.k0 = kb * 128; r.Wp = c.in[34] + ((size_t)l * NE + e) * D * 1024; r.ldw = 1024; r.WT = WSH(O_WGU) + (size_t)e * 1024 * D; r.ldt = D;
        r.drow = r.n0 < 512 ? (r.n0 / 128) * 256 : ((r.n0 - 512) / 128) * 256 + 128; return r; }
    it -= J_GU;
    { const int e = it / 64, q = it % 64, kb = q / 16, nb = q % 16; r.n0 = nb * 128; r.k0 = kb * 128; r.Wp = c.in[35] + ((size_t)l * NE + e) * 512 * D; r.ldw = D; r.WT = WSH(O_WDN) + (size_t)e * D * 512; r.ldt = 512; r.drow = r.n0; return r; }
}
__device__ __forceinline__ void convert_big(const Ctx& c, int l, float* ldsf, int first, int last, int widx, int wcnt) {
    const int tid = threadIdx.x, lr = tid >> 5, lc = (tid & 31) * 4;
    f32x4 rg[8]; int it = first + widx; CvtItem r;
    if (it < last) { r = cvt_decode_big(c, l, it);
#pragma unroll
        for (int i = 0; i < 8; ++i) rg[i] = *(const f32x4*)(r.Wp + (size_t)(r.k0 + lr + 16 * i) * r.ldw + r.n0 + lc); }
    for (; it < last; it += wcnt) {
#pragma unroll
        for (int i = 0; i < 8; ++i) { float* dp = ldsf + (lr + 16 * i) * 129 + lc; dp[0] = rg[i][0]; dp[1] = rg[i][1]; dp[2] = rg[i][2]; dp[3] = rg[i][3]; }
        const CvtItem cur = r; const int nx = it + wcnt;
        if (nx < last) { r = cvt_decode_big(c, l, nx);
#pragma unroll
            for (int i = 0; i < 8; ++i) rg[i] = *(const f32x4*)(r.Wp + (size_t)(r.k0 + lr + 16 * i) * r.ldw + r.n0 + lc); }
        SYNCTHREADS();
#pragma unroll
        for (int q = 0; q < 4; ++q) { const int id = tid + NT * q, n = id >> 4, k8 = (id & 15) * 8; const float* sp = ldsf + k8 * 129 + n;
            u32x4 o; o[0] = pk2(sp[0 * 129], sp[1 * 129]); o[1] = pk2(sp[2 * 129], sp[3 * 129]); o[2] = pk2(sp[4 * 129], sp[5 * 129]); o[3] = pk2(sp[6 * 129], sp[7 * 129]);
            *(u32x4*)(cur.WT + (size_t)(cur.drow + n) * cur.ldt + cur.k0 + k8) = o; }
        SYNCTHREADS();
    }
}
__device__ __forceinline__ int convert_tail_tiles() { const int nun = (T / 256) * (PW / 256), G = (int)gridDim.x, rem = nun % G; return rem == 0 ? 0 : (G - rem) * 10 < J_GU + J_DN ? (G - rem) * 10 : J_GU + J_DN; }
__device__ __forceinline__ int convert_early_tiles(const Ctx& c) { const int G = (int)gridDim.x, nrest = (CTLW(c) + CW_PLAN)[40] * 4 - G; return (nrest >= 0 && nrest < G) ? ((G - nrest) * 12 < J_IN ? (G - nrest) * 12 : J_IN) : 0; }
__device__ __forceinline__ void ph_convert(const Ctx& c, int l, float* ldsf) {
    const int lane = threadIdx.x & 63, wave = threadIdx.x >> 6; const int gw = blockIdx.x * (NT / 64) + wave, ngw = gridDim.x * (NT / 64);
    convert_big(c, l, ldsf, l == 1 ? convert_early_tiles(c) : 0, J_ALL - convert_tail_tiles(), (int)blockIdx.x, (int)gridDim.x);
#ifdef CPU_EMU
    if (lane == 0) for (int it = I_BIG + gw; it < I_ALL; it += ngw) { const CvtItem r = cvt_decode(c, l, it);
        for (int kk = 0; kk < 64; ++kk) for (int nn = 0; nn < 32; ++nn) r.WT[(size_t)(r.drow + nn) * r.ldt + r.k0 + kk] = (bf16_t)f2bf(r.Wp[(size_t)(r.k0 + kk) * r.ldw + r.n0 + nn]); }
#else
    float* scr = ldsf + wave * (64 * 33 + 16);
    for (int it = I_BIG + gw; it < I_ALL; it += ngw) {
        const CvtItem r = cvt_decode(c, l, it);
#pragma unroll 8
        for (int i = 0; i < 32; ++i) { const int kk = 2 * i + (lane >> 5); scr[kk * 33 + (lane & 31)] = r.Wp[(size_t)(r.k0 + kk) * r.ldw + r.n0 + (lane & 31)]; }
        asm volatile("s_waitcnt lgkmcnt(0)" ::: "memory");
        const int cc = lane & 7;
#pragma unroll
        for (int j = 0; j < 4; ++j) { const int n = (lane >> 3) + 8 * j; const float* sp = scr + (8 * cc) * 33 + n;
            u32x4 o; o[0] = pk2(sp[0 * 33], sp[1 * 33]); o[1] = pk2(sp[2 * 33], sp[3 * 33]); o[2] = pk2(sp[4 * 33], sp[5 * 33]); o[3] = pk2(sp[6 * 33], sp[7 * 33]);
            *(u32x4*)(r.WT + (size_t)(r.drow + n) * r.ldt + r.k0 + 8 * cc) = o; }
        asm volatile("s_waitcnt lgkmcnt(0)" ::: "memory");
    }
#endif
    { const float* wg = c.in[30] + (size_t)l * D * 4; const float* we = c.in[32] + (size_t)l * D * 32; bf16_t* wh = WSH(O_WRH); bf16_t* wl = WSH(O_WRL);
      for (long i = GT_; i < (long)48 * D; i += GS_) { const int n = (int)(i / D), k = (int)(i % D); const float w = n < 4 ? wg[k * 4 + n] : n < 36 ? we[k * 32 + (n - 4)] : 0.f; const unsigned hb = f2bf(w); wh[i] = (bf16_t)hb; wl[i] = (bf16_t)f2bf(w - bf2f((bf16_t)hb)); } }
    for (long i = GT_; i < (long)128 * D / 2; i += GS_) ((unsigned*)(WSH(O_WIN) + (size_t)10624 * D))[i] = 0u;
}

namespace pg8 {
constexpr int BM = 256, BK = 64, HALF = 128, HTB = HALF * BK * 2, STAGE_BYTES = 8 * HTB;
__host__ __device__ __forceinline__ int lds_byte(int r, int cc) { const int st = (r >> 4) * 2 + (cc >> 5), rr = r & 15, c2 = cc & 31, ob = rr * 64 + c2 * 2; return st * 1024 + (ob ^ (((ob >> 9) & 1) << 5)); }
__host__ __device__ __forceinline__ void stage_rc(int b, int& R, int& C) { const int st = b / 1024, sb = b % 1024, swz = sb ^ (((sb >> 9) & 1) << 5); R = (st >> 1) * 16 + swz / 64; C = (st & 1) * 32 + (swz % 64) / 2; }
__host__ __device__ __forceinline__ int perm32(int rho) { const int n = rho >> 4, i = rho & 15; return 8 * (i >> 2) + 4 * n + (i & 3); }
struct Unit { int pm, pn, aux; const char* A; const char* B; };
struct Gemm { int K, lda, ldb; };

template <class Epi, class Sched>
__device__ __forceinline__ void gemm_phase(unsigned char* lds_, const Gemm g, const Sched& S, const Epi& E) {
#ifdef CPU_EMU
    if (threadIdx.x != 0) return;
    Unit u; const int K = g.K;
    float* Af = (float*)malloc((size_t)256 * K * 4); float* Bf = (float*)malloc((size_t)256 * K * 4); float* Cf = (float*)malloc(256 * 256 * 4);
    for (int i = 0; S.next(i, u); ++i) {
        const bf16_t* A = (const bf16_t*)u.A; const bf16_t* B = (const bf16_t*)u.B;
        for (int r = 0; r < 256; ++r) for (int k = 0; k < K; ++k) { size_t ar = (size_t)r; if constexpr (Sched::GATHER) ar = (size_t)S.row(u.pm * 256 + r); Af[(size_t)r * K + k] = bf2f(A[ar * g.lda + k]); Bf[(size_t)r * K + k] = bf2f(B[(size_t)r * g.ldb + k]); }
        const int nseg = Epi::SEGT > 0 ? K / (Epi::SEGT * 64) : 1, kseg = K / nseg;
        for (int wid = 0; wid < 8; ++wid) for (int lane = 0; lane < 64; ++lane) {
            const int wr = wid >> 2, wc = wid & 3, fr = lane & 15, fq = lane >> 4; f32x4 acc[2][2][4][2];
            for (int ai = 0; ai < 2; ++ai) for (int bj = 0; bj < 2; ++bj) for (int m = 0; m < 4; ++m) for (int n = 0; n < 2; ++n) for (int j = 0; j < 4; ++j) acc[ai][bj][m][n][j] = 0.f;
            for (int sg = 0; sg < nseg; ++sg) {
                for (int ai = 0; ai < 2; ++ai) for (int bj = 0; bj < 2; ++bj) for (int m = 0; m < 4; ++m) for (int n = 0; n < 2; ++n) for (int j = 0; j < 4; ++j) {
                    const int r = 128 * ai + 64 * wr + 16 * m + fr, cc = 128 * bj + 32 * wc + (Epi::PERM ? 8 * fq + 4 * n + j : 16 * n + 4 * fq + j);
                    const float* a = Af + (size_t)r * K + sg * kseg; const float* b = Bf + (size_t)cc * K + sg * kseg; float sacc = 0.f; for (int k = 0; k < kseg; ++k) sacc += a[k] * b[k];
                    acc[ai][bj][m][n][j] += sacc; }
                if constexpr (Epi::SEGT > 0) { if (sg + 1 < nseg) E.segment(acc, u, sg, wr, wc, fr, fq); }
            }
            E(acc, u, wr, wc, fr, fq);
        }
    }
    free(Af); free(Bf); free(Cf);
#else
    typedef __attribute__((address_space(3))) unsigned char* ldsp_t;
    ldsp_t lds = (ldsp_t)lds_;
    const int tid = threadIdx.x, wid = __builtin_amdgcn_readfirstlane(tid >> 6), lane = tid & 63, wr = wid >> 2, wc = wid & 3, fr = lane & 15, fq = lane >> 4;
    const int K = g.K, nt = K / BK;
    unsigned voffA[2], voffB[2];
#pragma unroll
    for (int i = 0; i < 2; ++i) { int R, C; stage_rc(tid * 16 + i * 8192, R, C); const int Rb = Epi::PERM ? ((R & ~31) + perm32(R & 31)) : R;
        voffA[i] = (unsigned)(R * g.lda + C) * 2u; voffB[i] = (unsigned)(Rb * g.ldb + C) * 2u; }
    unsigned vA[2][2], vAn[2][2];
#define PG8_GROWS(uu, vv) do { _Pragma("unroll") for (int h_ = 0; h_ < 2; ++h_) _Pragma("unroll") for (int i_ = 0; i_ < 2; ++i_) { int R_, C_; stage_rc(tid * 16 + i_ * 8192, R_, C_); \
        vv[h_][i_] = (unsigned)(S.row((uu).pm * 256 + h_ * 128 + R_) * g.lda + C_) * 2u; } } while (0)
    const size_t kstep = (size_t)(BK * 2);
    const size_t hstepA = (size_t)HALF * g.lda * 2, hstepB = (size_t)HALF * g.ldb * 2;
    const unsigned ldsw = (unsigned)wid * 1024u;
    const int aoff = lds_byte(wr * 64 + fr, fq * 8), boff = lds_byte(wc * 32 + fr, fq * 8);
#define PG8_SA(b, h) (((b) * 2 + (h)) * HTB)
#define PG8_SB(b, h) ((4 + (b) * 2 + (h)) * HTB)
#define PG8_STAGE(bufoff, gbase, voff) do { _Pragma("unroll") for (int _i = 0; _i < 2; ++_i) \
        __builtin_amdgcn_global_load_lds((const unsigned*)((const char*)(gbase) + (voff)[_i]), (__attribute__((address_space(3))) unsigned*)(lds + (bufoff) + ldsw + _i * 8192), 16, 0, 0); } while (0)
#define PG8_STAGEA(b, h, kp, usen) do { if constexpr (Sched::GATHER) { const unsigned vs_[2] = {(usen) ? vAn[h][0] : vA[h][0], (usen) ? vAn[h][1] : vA[h][1]}; PG8_STAGE(PG8_SA(b, h), kp, vs_); } \
        else { PG8_STAGE(PG8_SA(b, h), (kp) + ((h) ? hstepA : 0), voffA); } } while (0)
#define PG8_LDA(dst, b, h) do { _Pragma("unroll") for (int m = 0; m < 4; ++m) _Pragma("unroll") for (int k = 0; k < 2; ++k) dst[m][k] = *(const __attribute__((address_space(3))) bf16x8*)(lds + PG8_SA(b, h) + aoff + m * 2048 + k * 1024); } while (0)
#define PG8_LDB(dst, b, h) do { _Pragma("unroll") for (int n = 0; n < 2; ++n) _Pragma("unroll") for (int k = 0; k < 2; ++k) dst[n][k] = *(const __attribute__((address_space(3))) bf16x8*)(lds + PG8_SB(b, h) + boff + n * 2048 + k * 1024); } while (0)
#define PG8_MMA(ai, bj, At, Bt) do { __builtin_amdgcn_s_setprio(1); _Pragma("unroll") for (int m = 0; m < 4; ++m) _Pragma("unroll") for (int n = 0; n < 2; ++n) _Pragma("unroll") for (int k = 0; k < 2; ++k) \
        acc[ai][bj][m][n] = __builtin_amdgcn_mfma_f32_16x16x32_bf16(Bt[n][k], At[m][k], acc[ai][bj][m][n], 0, 0, 0); __builtin_amdgcn_s_setprio(0); } while (0)
#define PG8_WAIT_V(n) asm volatile("s_waitcnt vmcnt(" #n ")" ::: "memory")
#define PG8_WAIT_L(n) asm volatile("s_waitcnt lgkmcnt(" #n ")" ::: "memory")
#define PG8_BAR __builtin_amdgcn_s_barrier()
#define PG8_SCHED __builtin_amdgcn_sched_barrier(0)
    Unit cur, nxt; int ui = 0;
    if (!S.next(0, cur)) return;
    f32x4 acc[2][2][4][2];
#pragma unroll
    for (int a = 0; a < 2; ++a)
#pragma unroll
        for (int b = 0; b < 2; ++b)
#pragma unroll
            for (int m = 0; m < 4; ++m)
#pragma unroll
                for (int n = 0; n < 2; ++n) acc[a][b][m][n] = (f32x4){0.f, 0.f, 0.f, 0.f};
    bf16x8 At[4][2], B0[2][2], B1[2][2];
    const char* cA = cur.A; const char* cB = cur.B;
    S.a_ready(cur);
    if constexpr (Sched::GATHER) { PG8_GROWS(cur, vA); }
    PG8_STAGE(PG8_SB(0, 0), cB, voffB); PG8_STAGEA(0, 0, cA, false); PG8_STAGE(PG8_SB(0, 1), cB + hstepB, voffB); PG8_STAGEA(0, 1, cA, false);
    if (wr == 1) PG8_BAR;
    PG8_WAIT_V(4); PG8_BAR;
    PG8_STAGE(PG8_SB(1, 0), cB + kstep, voffB); PG8_STAGEA(1, 0, cA + kstep, false); PG8_STAGE(PG8_SB(1, 1), cB + hstepB + kstep, voffB);
    PG8_WAIT_V(6); PG8_BAR;
    for (;;) {
        const bool has_next = S.next(ui + 1, nxt);
        const char* nA = has_next ? nxt.A : cA; const char* nB = has_next ? nxt.B : cB;
        if constexpr (Sched::GATHER) { if (has_next) { PG8_GROWS(nxt, vAn); } else {
#pragma unroll
            for (int h_ = 0; h_ < 2; ++h_) { vAn[h_][0] = vA[h_][0]; vAn[h_][1] = vA[h_][1]; } } }
        for (int t = 0; t < nt; t += 2) {
            const bool last = (t == nt - 2);
            const char* a1 = cA + (size_t)(t + 1) * kstep;
            const char* a2 = last ? nA : cA + (size_t)(t + 2) * kstep; const char* b2 = last ? nB : cB + (size_t)(t + 2) * kstep;
            const char* a3 = a2 + kstep; const char* b3 = b2 + kstep;
            if (last && has_next) S.a_ready(nxt);
            PG8_LDB(B0, 0, 0); PG8_SCHED; PG8_LDA(At, 0, 0); PG8_STAGEA(1, 1, a1, false);
            PG8_WAIT_L(8); PG8_BAR; PG8_WAIT_L(0); PG8_MMA(0, 0, At, B0); PG8_BAR; PG8_SCHED;
            PG8_LDB(B1, 0, 1); PG8_STAGE(PG8_SB(0, 0), b2, voffB);
            PG8_BAR; PG8_WAIT_L(0); PG8_MMA(0, 1, At, B1); PG8_BAR;
            PG8_LDA(At, 0, 1); PG8_STAGEA(0, 0, a2, last);
            PG8_BAR; PG8_WAIT_L(0); PG8_MMA(1, 0, At, B0); PG8_BAR; PG8_SCHED;
            PG8_STAGE(PG8_SB(0, 1), b2 + hstepB, voffB);
            PG8_WAIT_V(6); PG8_BAR; PG8_MMA(1, 1, At, B1); PG8_BAR;
            PG8_LDB(B0, 1, 0); PG8_SCHED; PG8_LDA(At, 1, 0); PG8_STAGEA(0, 1, a2, last);
            PG8_WAIT_L(8); PG8_BAR; PG8_WAIT_L(0); PG8_MMA(0, 0, At, B0); PG8_BAR; PG8_SCHED;
            PG8_LDB(B1, 1, 1); PG8_STAGE(PG8_SB(1, 0), b3, voffB);
            PG8_BAR; PG8_WAIT_L(0); PG8_MMA(0, 1, At, B1); PG8_BAR;
            PG8_LDA(At, 1, 1); PG8_STAGEA(1, 0, a3, last);
            PG8_BAR; PG8_WAIT_L(0); PG8_MMA(1, 0, At, B0); PG8_BAR; PG8_SCHED;
            PG8_STAGE(PG8_SB(1, 1), b3 + hstepB, voffB);
            PG8_WAIT_V(6); PG8_BAR; PG8_MMA(1, 1, At, B1); PG8_BAR;
            if constexpr (Epi::SEGT > 0) { if ((t + 2) % Epi::SEGT == 0 && t + 2 < nt) E.segment(acc, cur, (t + 2) / Epi::SEGT - 1, wr, wc, fr, fq); }
        }
        E(acc, cur, wr, wc, fr, fq); S.done(cur);
        if (!has_next) break;
#pragma unroll
        for (int a = 0; a < 2; ++a)
#pragma unroll
            for (int b = 0; b < 2; ++b)
#pragma unroll
                for (int m = 0; m < 4; ++m)
#pragma unroll
                    for (int n = 0; n < 2; ++n) acc[a][b][m][n] = (f32x4){0.f, 0.f, 0.f, 0.f};
        cur = nxt; cA = nA; cB = nB; ++ui;
        if constexpr (Sched::GATHER) {
#pragma unroll
            for (int h_ = 0; h_ < 2; ++h_) { vA[h_][0] = vAn[h_][0]; vA[h_][1] = vAn[h_][1]; } }
    }
    PG8_WAIT_V(0);
    if (wr == 0) PG8_BAR;
    PG8_BAR;
#undef PG8_SA
#undef PG8_SB
#undef PG8_STAGE
#undef PG8_STAGEA
#undef PG8_GROWS
#undef PG8_LDA
#undef PG8_LDB
#undef PG8_MMA
#undef PG8_WAIT_V
#undef PG8_WAIT_L
#undef PG8_BAR
#undef PG8_SCHED
#endif
}

struct StaticOrder {
    static constexpr bool GATHER = false;
    int nM, nN, nwg, G, c; const char* A; const char* B; size_t tstepA, tstepB;
    __device__ __forceinline__ void init(int M, int N, int G_, int c_, const void* A_, const void* B_, int lda, int ldb) { nM = M / BM; nN = N / BM; nwg = nM * nN; G = G_; c = c_; A = (const char*)A_; B = (const char*)B_; tstepA = (size_t)BM * lda * 2; tstepB = (size_t)BM * ldb * 2; }
    __device__ __forceinline__ bool next(int i, Unit& u) const {
        const long L = (long)i * G + c; if (L >= nwg) return false;
        int wgid = (int)L; { const int q = nwg / 8, r = nwg % 8, xcd = wgid % 8, off = wgid / 8; wgid = (xcd < r ? xcd * (q + 1) : r * (q + 1) + (xcd - r) * q) + off; }
        const int nig = 8 * nN, gid = wgid / nig, fm = gid * 8, gsz = (nM - fm) < 8 ? (nM - fm) : 8;
        u.pm = fm + ((wgid % nig) % gsz); u.pn = (wgid % nig) / gsz; u.aux = 0; u.A = A + (size_t)u.pm * tstepA; u.B = B + (size_t)u.pn * tstepB; return true;
    }
    __device__ __forceinline__ void a_ready(const Unit&) const {}
    __device__ __forceinline__ void done(const Unit&) const {}
};
struct MergeOrder {
    static constexpr bool GATHER = false;
    StaticOrder so; int kseg_bytes;
    __device__ __forceinline__ bool next(int i, Unit& u) const { if (!so.next(i >> 2, u)) return false; u.aux = i & 3; u.A += (size_t)u.aux * kseg_bytes; u.B += (size_t)u.aux * kseg_bytes; return true; }
    __device__ __forceinline__ void a_ready(const Unit&) const {}
    __device__ __forceinline__ void done(const Unit&) const {}
};
struct MoeOrder {
    static constexpr bool GATHER = false;
    int G, c, ncol; const int* plan; const char* A; const char* B; size_t tstepA, tstepB, estep;
    __device__ __forceinline__ bool next(int i, Unit& u) const {
        const long L = (long)i * G + c; const int nblk = plan[40]; if (L >= (long)nblk * ncol) return false;
        u.pm = (int)(L / ncol); u.pn = (int)(L % ncol); u.aux = plan[64 + u.pm]; u.A = A + (size_t)u.pm * tstepA; u.B = B + (size_t)u.aux * estep + (size_t)u.pn * tstepB; return true;
    }
    __device__ __forceinline__ void a_ready(const Unit&) const {}
    __device__ __forceinline__ void done(const Unit&) const {}
};
struct MoeGatherOrder {
    static constexpr bool GATHER = true;
    int G, c, ncol; const int* plan; const char* A; const char* B; size_t tstepB, estep; const int* src; int nrows;
    __device__ __forceinline__ bool next(int i, Unit& u) const {
        const long L = (long)i * G + c; const int nblk = plan[40]; if (L >= (long)nblk * ncol) return false;
        u.pm = (int)(L / ncol); u.pn = (int)(L % ncol); u.aux = plan[64 + u.pm]; u.A = A; u.B = B + (size_t)u.aux * estep + (size_t)u.pn * tstepB; return true;
    }
    __device__ __forceinline__ int row(int slot) const { const int r = src[slot]; return (unsigned)r < (unsigned)nrows ? r : 0; }
    __device__ __forceinline__ void a_ready(const Unit&) const {}
    __device__ __forceinline__ void done(const Unit&) const {}
};

__device__ __forceinline__ u32x4 pack8(const f32x4 v0, const f32x4 v1) { u32x4 w; w[0] = pk2(v0[0], v0[1]); w[1] = pk2(v0[2], v0[3]); w[2] = pk2(v1[0], v1[1]); w[3] = pk2(v1[2], v1[3]); return w; }
struct EpiBf16 {
    static constexpr int SEGT = 0; static constexpr bool PERM = true; bf16_t* O; int ldc;
    __device__ __forceinline__ void operator()(const f32x4 (&acc)[2][2][4][2], const Unit& u, int wr, int wc, int fr, int fq) const {
        const int row0 = u.pm * BM + wr * 64 + fr, col0 = u.pn * BM + wc * 32 + 8 * fq;
#pragma unroll
        for (int ai = 0; ai < 2; ++ai)
#pragma unroll
            for (int m = 0; m < 4; ++m) { bf16_t* rowp = O + (size_t)(row0 + ai * HALF + m * 16) * ldc + col0;
#pragma unroll
                for (int bj = 0; bj < 2; ++bj) *(u32x4*)(rowp + bj * HALF) = pack8(acc[ai][bj][m][0], acc[ai][bj][m][1]); }
    }
};
struct EpiP {
    static constexpr int SEGT = 0; static constexpr bool PERM = true; bf16_t* O; unsigned char* G8; float* SG;
    __device__ __forceinline__ void operator()(const f32x4 (&acc)[2][2][4][2], const Unit& u, int wr, int wc, int fr, int fq) const {
        const int row0 = u.pm * BM + wr * 64 + fr, col0 = u.pn * BM + wc * 32 + 8 * fq;
        if (u.pn * BM < C_MLP) {
            const bool sgu = u.pn * BM >= C_SV && u.pn * BM < C_SV + W;
#pragma unroll
            for (int ai = 0; ai < 2; ++ai)
#pragma unroll
                for (int m = 0; m < 4; ++m) { const int r = row0 + ai * HALF + m * 16; bf16_t* rowp = O + (size_t)r * PW + col0; float s1 = 0.f, s2 = 0.f;
#pragma unroll
                    for (int bj = 0; bj < 2; ++bj) { const u32x4 pk = pack8(acc[ai][bj][m][0], acc[ai][bj][m][1]); *(u32x4*)(rowp + bj * HALF) = pk;
                        if (sgu) {
#pragma unroll
                            for (int e = 0; e < 4; ++e) { const float g0 = geluf_(bflo(pk[e])), g1 = geluf_(bfhi(pk[e])); s1 += g0 + g1; s2 += g0 * g0 + g1 * g1; } } }
                    if (sgu) { float* sp = SG + ((size_t)r * 16 + (u.pn - C_SV / BM) * 4 + wc) * 2;
#ifdef CPU_EMU
                        if (fq == 0) { sp[0] = s1; sp[1] = s2; } else { sp[0] += s1; sp[1] += s2; }
#else
                        s1 += SHFL_XOR(s1, 16); s1 += SHFL_XOR(s1, 32); s2 += SHFL_XOR(s2, 16); s2 += SHFL_XOR(s2, 32); if (fq == 0) { sp[0] = s1; sp[1] = s2; }
#endif
                    } }
        } else {
#pragma unroll
            for (int ai = 0; ai < 2; ++ai)
#pragma unroll
                for (int m = 0; m < 4; ++m) { unsigned char* rowp = G8 + (size_t)(row0 + ai * HALF + m * 16) * (4 * D) + (col0 - C_MLP);
#pragma unroll
                    for (int bj = 0; bj < 2; ++bj) { unsigned long long w = 0ull;
#pragma unroll
                        for (int q = 0; q < 8; ++q) { const float gq = sigmoidf_(acc[ai][bj][m][q >> 2][q & 3]); w |= (unsigned long long)(unsigned)(gq * 255.f + 0.5f) << (8 * q); }
                        *(unsigned long long*)(rowp + bj * HALF) = w; } }
        }
    }
};
struct EpiMerge {
    static constexpr int SEGT = 16; static constexpr bool PERM = true; const unsigned char* G8; bf16_t* MRG;
    static __device__ __forceinline__ float gb(unsigned w32, int q) { return fmaxf((float)((w32 >> (8 * q)) & 255u), 0.5f); }
    __device__ __forceinline__ void segment(f32x4 (&acc)[2][2][4][2], const Unit& u, int seg, int wr, int wc, int fr, int fq) const {
        const int row0 = u.pm * BM + wr * 64 + fr, col0 = u.pn * BM + wc * 32 + 8 * fq;
#pragma unroll
        for (int ai = 0; ai < 2; ++ai)
#pragma unroll
            for (int m = 0; m < 4; ++m) { const size_t r = (size_t)(row0 + ai * HALF + m * 16);
#pragma unroll
                for (int bj = 0; bj < 2; ++bj) { const int cc = col0 + bj * HALF;
                    const unsigned long long g0 = *(const unsigned long long*)(G8 + r * (4 * D) + seg * D + cc), g1 = *(const unsigned long long*)(G8 + r * (4 * D) + (seg + 1) * D + cc);
                    const unsigned lo0 = (unsigned)g0, hi0 = (unsigned)(g0 >> 32), lo1 = (unsigned)g1, hi1 = (unsigned)(g1 >> 32);
#pragma unroll
                    for (int q = 0; q < 4; ++q) { acc[ai][bj][m][0][q] *= gb(lo0, q) * frcp_(gb(lo1, q)); acc[ai][bj][m][1][q] *= gb(hi0, q) * frcp_(gb(hi1, q)); } }
#ifndef CPU_EMU
                asm volatile("" ::: "memory");
#endif
            }
    }
    __device__ __forceinline__ void operator()(const f32x4 (&acc)[2][2][4][2], const Unit& u, int wr, int wc, int fr, int fq) const {
        const int row0 = u.pm * BM + wr * 64 + fr, col0 = u.pn * BM + wc * 32 + 8 * fq;
#pragma unroll
        for (int ai = 0; ai < 2; ++ai)
#pragma unroll
            for (int m = 0; m < 4; ++m) { const size_t r = (size_t)(row0 + ai * HALF + m * 16);
#pragma unroll
                for (int bj = 0; bj < 2; ++bj) { const int cc = col0 + bj * HALF;
                    const unsigned long long g3 = *(const unsigned long long*)(G8 + r * (4 * D) + 3 * D + cc); f32x4 v0, v1;
#pragma unroll
                    for (int q = 0; q < 4; ++q) { v0[q] = gb((unsigned)g3, q) * (1.f / 255.f) * acc[ai][bj][m][0][q]; v1[q] = gb((unsigned)(g3 >> 32), q) * (1.f / 255.f) * acc[ai][bj][m][1][q]; }
                    *(u32x4*)(MRG + r * D + cc) = pack8(v0, v1); }
#ifndef CPU_EMU
                asm volatile("" ::: "memory");
#endif
            }
    }
};
struct EpiResid {
    static constexpr int SEGT = 0; static constexpr bool PERM = false; const float* xin; const float* g1; float* xmid; float* ssp;
    __device__ __forceinline__ void operator()(const f32x4 (&acc)[2][2][4][2], const Unit& u, int wr, int wc, int fr, int fq) const {
        const int row0 = u.pm * BM + wr * 64 + fr, col0 = u.pn * BM + wc * 32 + 4 * fq;
#pragma unroll
        for (int ai = 0; ai < 2; ++ai)
#pragma unroll
            for (int m = 0; m < 4; ++m) { const int r = row0 + ai * HALF + m * 16; const float* gp = g1 + (size_t)(r / S) * D6; float sq = 0.f;
#pragma unroll
                for (int bj = 0; bj < 2; ++bj)
#pragma unroll
                    for (int n = 0; n < 2; ++n) { const int cc = col0 + bj * HALF + n * 16; const f32x4 v = *(const f32x4*)(xin + (size_t)r * D + cc) + *(const f32x4*)(gp + cc) * acc[ai][bj][m][n];
                        *(f32x4*)(xmid + (size_t)r * D + cc) = v; sq += (v[0] * v[0] + v[1] * v[1]) + (v[2] * v[2] + v[3] * v[3]); }
                float* sp = ssp + (size_t)r * 32 + u.pn * 4 + wc;
#ifdef CPU_EMU
                if (fq == 0) *sp = sq; else *sp += sq;
#else
                sq += SHFL_XOR(sq, 16); sq += SHFL_XOR(sq, 32); if (fq == 0) *sp = sq;
                asm volatile("" ::: "memory");
#endif
            }
    }
};
struct EpiGU {
    static constexpr int SEGT = 0; static constexpr bool PERM = true; bf16_t* ACT;
    __device__ __forceinline__ void operator()(const f32x4 (&acc)[2][2][4][2], const Unit& u, int wr, int wc, int fr, int fq) const {
        const int row0 = u.pm * BM + wr * 64 + fr, col0 = u.pn * HALF + wc * 32 + 8 * fq;
#pragma unroll
        for (int ai = 0; ai < 2; ++ai)
#pragma unroll
            for (int m = 0; m < 4; ++m) { f32x4 v0, v1;
#pragma unroll
                for (int j = 0; j < 4; ++j) { v0[j] = siluf_(acc[ai][0][m][0][j]) * acc[ai][1][m][0][j]; v1[j] = siluf_(acc[ai][0][m][1][j]) * acc[ai][1][m][1][j]; }
                *(u32x4*)(ACT + (size_t)(row0 + ai * HALF + m * 16) * 512 + col0) = pack8(v0, v1); }
    }
};
}

template <int PASS>
__device__ __forceinline__ void ph_lru(const Ctx& c, int l, float* ldsf) {
    const bf16_t* P = WSH(O_P); const float* cw = c.in[8] + (size_t)l * 4 * W; const float* cb = c.in[9] + (size_t)l * W;
    const float* br = c.in[11] + (size_t)l * 2 * W; const float* bi = c.in[13] + (size_t)l * 2 * W; const float* lam = c.in[14] + (size_t)l * 2 * W; const bf16_t* WLR = WSH(O_WLR);
    float* CA = WSF(O_LCA); float* CH = WSF(O_LCH); const float* CI = WSF(O_LCI); bf16_t* Y = WSH(O_YS); unsigned* LAU = (unsigned*)(c.ws + O_LA);
    bf16_t* Xs = (bf16_t*)ldsf; bf16_t* Wr = Xs + 64 * 136; bf16_t* Wi = Wr + 128 * 136; float* AUa = (float*)Wr; float* AUu = AUa + 64 * 128; float* HF = (float*)(Wi + 128 * 136); float* spl = HF + 64 * 128;
    const int tid = threadIdx.x, wv = tid >> 6, lane = tid & 63, fr = lane & 15, fq = lane >> 4, rt = wv & 3, hf = wv >> 2;
    u32x4 wreg[8];
#define LRU_WLOAD(zz, nn) do { _Pragma("unroll") for (int q = 0; q < 4; ++q) { const int id = tid + NT * q, f = id >> 4, e8 = (id & 15) * 8; \
        wreg[2 * q] = *(const u32x4*)(WLR + ((size_t)(((zz) * 2 + 0) * 8 + (nn)) * 128 + f) * 128 + e8); wreg[2 * q + 1] = *(const u32x4*)(WLR + ((size_t)(((zz) * 2 + 1) * 8 + (nn)) * 128 + f) * 128 + e8); } } while (0)
    if ((int)blockIdx.x < (T / 64) * 8) LRU_WLOAD(0, (int)blockIdx.x & 7);
    for (int u = blockIdx.x; u < (T / 64) * 8; u += gridDim.x) {
        const int n = u & 7, tile = u >> 3, b = tile / NLC, chk = tile % NLC; const long t0 = (long)tile * 64;
        if (tid < 256) spl[tid] = softplusf_(-lam[(tid >> 7) * W + n * 128 + (tid & 127)]);
#pragma unroll
        for (int q = 0; q < 4; ++q) { const int id = tid + NT * q, tl = id >> 5, e4 = (id & 31) * 4, ch = n * 128 + e4; const long t = t0 + tl; const int sI = (int)(t % S);
            f32x4 acc = *(const f32x4*)(cb + ch);
#pragma unroll
            for (int k = 0; k < 4; ++k) { const int ss = sI + k - 2; if (ss >= 0 && ss < S) acc += ld_bf4(P + (size_t)(t + k - 2) * PW + C_LX + ch) * *(const f32x4*)(cw + k * W + ch); }
            st_bf4(Xs + tl * 136 + e4, acc); }
        for (int z = 0; z < 2; ++z) {
#pragma unroll
            for (int q = 0; q < 4; ++q) { const int id = tid + NT * q, f = id >> 4, e8 = (id & 15) * 8; *(u32x4*)(Wr + f * 136 + e8) = wreg[2 * q]; *(u32x4*)(Wi + f * 136 + e8) = wreg[2 * q + 1]; }
            SYNCTHREADS();
            f32x4 ar[4], ai[4];
#pragma unroll
            for (int nt = 0; nt < 4; ++nt) { ar[nt] = (f32x4){0.f, 0.f, 0.f, 0.f}; ai[nt] = (f32x4){0.f, 0.f, 0.f, 0.f}; }
            wave_mma<4, 4>(ar, Xs + rt * 16 * 136, 136, Wr + hf * 64 * 136, 136);
            wave_mma<4, 4>(ai, Xs + rt * 16 * 136, 136, Wi + hf * 64 * 136, 136);
            SYNCTHREADS();
            if (z == 0) LRU_WLOAD(1, n); else if (u + (int)gridDim.x < (T / 64) * 8) LRU_WLOAD(0, (u + (int)gridDim.x) & 7);
            const int tl = rt * 16 + fr;
#pragma unroll
            for (int nt = 0; nt < 4; ++nt) { const int f = 64 * hf + 16 * nt + 4 * fq, ch = n * 128 + f;
                const f32x4 brv = *(const f32x4*)(br + z * W + ch), biv = *(const f32x4*)(bi + z * W + ch), lmv = *(const f32x4*)(spl + z * 128 + f), xcv = ld_bf4(Xs + tl * 136 + f); f32x4 av, uv, lav;
#pragma unroll
                for (int e = 0; e < 4; ++e) { const float r = sigmoidf_(ar[nt][e] + brv[e]), ig = sigmoidf_(ai[nt][e] + biv[e]), la = -8.f * r * lmv[e]; const float a = fexp_(la); av[e] = a; lav[e] = la; uv[e] = fsqrt_(fmaxf(1.f - a * a, 0.f)) * ig * xcv[e]; }
                *(f32x4*)(AUa + tl * 128 + f) = av; *(f32x4*)(AUu + tl * 128 + f) = uv;
                if (PASS == 1) { u32x4 pk;
#pragma unroll
                    for (int e = 0; e < 4; ++e) pk[e] = pk2(lav[e], uv[e]);
                    *(u32x4*)(LAU + ((size_t)z * T + t0 + tl) * W + ch) = pk; } }
            SYNCTHREADS();
            if (PASS == 1) {
                { const int f = tid & 127, sgm = tid >> 7; float prod = 1.f, h = 0.f;
#pragma unroll
                  for (int q = 0; q < 16; ++q) { const int st = sgm * 16 + q, sI = z == 0 ? st : 63 - st; const float a = AUa[sI * 128 + f]; h = a * h + AUu[sI * 128 + f]; prod *= a; }
                  HF[sgm * 128 + f] = prod; HF[512 + sgm * 128 + f] = h; }
                SYNCTHREADS();
                if (tid < 128) { const int f = tid; const size_t ci = (((size_t)z * NB + b) * NLC + chk) * W + n * 128 + f; float prod = 1.f, h = 0.f;
#pragma unroll
                    for (int sgm = 0; sgm < 4; ++sgm) { const float a = HF[sgm * 128 + f]; h = a * h + HF[512 + sgm * 128 + f]; prod *= a; }
                    CA[ci] = prod; CH[ci] = h; }
                continue;
            }
            if (tid < 128) { const int f = tid; const size_t ci = (((size_t)z * NB + b) * NLC + chk) * W + n * 128 + f;
                if (PASS == 1) { float prod = 1.f, h = 0.f;
#pragma unroll 8
                    for (int q = 0; q < 64; ++q) { const int sI = z == 0 ? q : 63 - q; const float a = AUa[sI * 128 + f]; h = a * h + AUu[sI * 128 + f]; prod *= a; }
                    CA[ci] = prod; CH[ci] = h;
                } else { float h = CI[ci];
                    if (z == 0) {
#pragma unroll 8
                        for (int q = 0; q < 64; ++q) { h = AUa[q * 128 + f] * h + AUu[q * 128 + f]; HF[q * 128 + f] = h; }
                    } else {
#pragma unroll 8
                        for (int q = 63; q >= 0; --q) { h = AUa[q * 128 + f] * h + AUu[q * 128 + f]; HF[q * 128 + f] += h; } } }
            }
            SYNCTHREADS();
        }
        if (PASS == 2) {
#pragma unroll
            for (int q = 0; q < 4; ++q) { const int id = tid + NT * q, tl = id >> 5, f4 = (id & 31) * 4; const long t = t0 + tl; f32x4 hv = *(const f32x4*)(HF + tl * 128 + f4); const f32x4 gv = ld_bf4(P + (size_t)t * PW + C_LG + n * 128 + f4);
#pragma unroll
                for (int e = 0; e < 4; ++e) hv[e] *= geluf_(gv[e]);
                st_bf4(Y + (size_t)t * 4 * W + 0 * W + n * 128 + f4, hv); }
            SYNCTHREADS();
        }
    }
}
__device__ __forceinline__ void ph_lru_fin(const Ctx& c, float* ldsf) {
    const bf16_t* P = WSH(O_P); const unsigned* LAU = (const unsigned*)(c.ws + O_LA); const float* CI = WSF(O_LCI); bf16_t* Y = WSH(O_YS);
    unsigned* Lz = (unsigned*)ldsf; float* Hz = ldsf + 2 * 64 * 128; const int tid = threadIdx.x;
    u32x4 lpre[8];
#define LF_LOAD(uu) do { const int n_ = (uu) & 7; const long t0_ = (long)((uu) >> 3) * 64; \
        _Pragma("unroll") for (int q = 0; q < 8; ++q) { const int id = tid + NT * q, z = id >> 11, r = (id >> 5) & 63, c4 = (id & 31) * 4; lpre[q] = *(const u32x4*)(LAU + ((size_t)z * T + t0_ + r) * W + n_ * 128 + c4); } } while (0)
    if ((int)blockIdx.x < (T / 64) * 8) LF_LOAD((int)blockIdx.x);
    for (int u = blockIdx.x; u < (T / 64) * 8; u += gridDim.x) {
        const int n = u & 7, tile = u >> 3, b = tile / NLC, chk = tile % NLC; const long t0 = (long)tile * 64;
#pragma unroll
        for (int q = 0; q < 8; ++q) { const int id = tid + NT * q, z = id >> 11, r = (id >> 5) & 63, c4 = (id & 31) * 4; *(u32x4*)(Lz + z * 8192 + r * 128 + c4) = lpre[q]; }
        SYNCTHREADS();
        if (u + (int)gridDim.x < (T / 64) * 8) LF_LOAD(u + (int)gridDim.x);
        unsigned long long graw[4];
#pragma unroll
        for (int q = 0; q < 4; ++q) { const int id = tid + NT * q, r = id >> 5, f4 = (id & 31) * 4; graw[q] = *(const unsigned long long*)(P + (size_t)(t0 + r) * PW + C_LG + n * 128 + f4); }
        if (tid < 256) { const int z = tid >> 7, f = tid & 127; float h = CI[(((size_t)z * NB + b) * NLC + chk) * W + n * 128 + f]; const unsigned* lp = Lz + z * 8192 + f; float* hp = Hz + z * 8192 + f;
#pragma unroll 8
            for (int q = 0; q < 64; ++q) { const int sI = z == 0 ? q : 63 - q; const unsigned w = lp[sI * 128]; h = fexp_(bflo(w)) * h + bfhi(w); hp[sI * 128] = h; } }
        SYNCTHREADS();
#pragma unroll
        for (int q = 0; q < 4; ++q) { const int id = tid + NT * q, r = id >> 5, f4 = (id & 31) * 4; const long t = t0 + r; f32x4 o = *(const f32x4*)(Hz + r * 128 + f4) + *(const f32x4*)(Hz + 8192 + r * 128 + f4); const unsigned glo = (unsigned)graw[q], ghi = (unsigned)(graw[q] >> 32); const f32x4 gv = (f32x4){bflo(glo), bfhi(glo), bflo(ghi), bfhi(ghi)};
#pragma unroll
            for (int e = 0; e < 4; ++e) o[e] *= geluf_(gv[e]);
            st_bf4(Y + (size_t)t * 4 * W + 0 * W + n * 128 + f4, o); }
        SYNCTHREADS();
    }
}
__device__ __forceinline__ void ph_lru_scan2(const Ctx& c) {
    const float* CA = WSF(O_LCA); const float* CH = WSF(O_LCH); float* CI = WSF(O_LCI);
    for (long i = GT_; i < (long)2 * NB * W; i += GS_) {
        const int w = (int)(i % W), b = (int)((i / W) % NB), z = (int)(i / ((long)W * NB)); float carry = 0.f;
#pragma unroll 16
        for (int q = 0; q < NLC; ++q) { const int ch = z == 0 ? q : NLC - 1 - q; const size_t idx = (((size_t)z * NB + b) * NLC + ch) * W + w; CI[idx] = carry; carry = CA[idx] * carry + CH[idx]; }
    }
}
__device__ __forceinline__ void ph_rope_table(const Ctx& c) {
    const int* pos = (const int*)c.in[2]; float* RT = WSF(O_ROPE);
    for (long i = GT_; i < (long)T * 32; i += GS_) { const int j = (int)(i & 31); const float ang = (float)pos[i >> 5] * powf(10000.f, -(float)(2 * j) / 64.f); RT[i * 2] = cosf(ang); RT[i * 2 + 1] = sinf(ang); }
}
__device__ __forceinline__ void ret_tables(float* tab, int h) {
    const int tid = threadIdx.x; const float lg = loggamma_(h);
    if (tid < 32) tab[tid] = powf(10000.f, -(float)(2 * tid) / 64.f);
    if (tid >= 64 && tid < 64 + 129) tab[tid] = expf((float)(tid - 64) * lg);
}
__device__ __forceinline__ void ph_ret_kv(const Ctx& c, float* ldsf) {
    const float* RT = WSF(O_ROPE); const bf16_t* P = WSH(O_P); bf16_t* KVF = WSH(O_KVF); bf16_t* KVB = WSH(O_KVB);
    bf16_t* VT = (bf16_t*)ldsf; bf16_t* KF = VT + 128 * 136; bf16_t* KB = KF + 64 * 136; float* tab = (float*)(KB + 64 * 136);
    const int tid = threadIdx.x, wv = tid >> 6, lane = tid & 63, fr = lane & 15, fq = lane >> 4;
    for (int u = blockIdx.x; u < (T / 128) * 8; u += gridDim.x) {
        const int h = u & 7; const long t0 = (long)(u >> 3) * 128;
        ret_tables(tab, h);
        SYNCTHREADS();
        {
            const int j = tid >> 2, d0 = (tid & 3) * 8; const bf16_t* prow = P + (size_t)(t0 + j) * PW + C_RK + h * 64; const float* rt = RT + ((size_t)(t0 + j) * 32 + d0) * 2;
            const u32x4 kl = *(const u32x4*)(prow + d0), kh = *(const u32x4*)(prow + d0 + 32);
            const f32x4 r0 = *(const f32x4*)rt, r1 = *(const f32x4*)(rt + 4), r2 = *(const f32x4*)(rt + 8), r3 = *(const f32x4*)(rt + 12);
            const float cs[8] = {r0[0], r0[2], r1[0], r1[2], r2[0], r2[2], r3[0], r3[2]}, sn[8] = {r0[1], r0[3], r1[1], r1[3], r2[1], r2[3], r3[1], r3[3]};
            const float fj = tab[64 + 127 - j], bj = tab[64 + j];
#pragma unroll
            for (int e = 0; e < 8; ++e) { const float x1 = (e & 1) ? bfhi(kl[e >> 1]) : bflo(kl[e >> 1]), x2 = (e & 1) ? bfhi(kh[e >> 1]) : bflo(kh[e >> 1]);
                const float k1 = x1 * cs[e] - x2 * sn[e], k2 = x2 * cs[e] + x1 * sn[e];
                KF[(d0 + e) * 136 + j] = (bf16_t)f2bf(k1 * fj); KF[(d0 + e + 32) * 136 + j] = (bf16_t)f2bf(k2 * fj); KB[(d0 + e) * 136 + j] = (bf16_t)f2bf(k1 * bj); KB[(d0 + e + 32) * 136 + j] = (bf16_t)f2bf(k2 * bj); } }
#pragma unroll
        for (int q = 0; q < 4; ++q) { const int id = tid + NT * q, j = id & 127, e8 = (id >> 7) * 8; const u32x4 raw = *(const u32x4*)(P + (size_t)(t0 + j) * PW + C_RV + h * 128 + e8);
#pragma unroll
            for (int e = 0; e < 4; ++e) { VT[(e8 + 2 * e) * 136 + j] = (bf16_t)(raw[e] & 0xffffu); VT[(e8 + 2 * e + 1) * 136 + j] = (bf16_t)(raw[e] >> 16); } }
        SYNCTHREADS();
        f32x4 af[4], ab[4];
#pragma unroll
        for (int nt = 0; nt < 4; ++nt) { af[nt] = (f32x4){0.f, 0.f, 0.f, 0.f}; ab[nt] = (f32x4){0.f, 0.f, 0.f, 0.f}; }
        wave_mma<4, 4>(af, VT + wv * 16 * 136, 136, KF, 136);
        wave_mma<4, 4>(ab, VT + wv * 16 * 136, 136, KB, 136);
        const size_t ob = (((size_t)(u >> 3) * 8 + h) * 128 + wv * 16 + fr) * 64 + 4 * fq;
#pragma unroll
        for (int nt = 0; nt < 4; ++nt) { st_bf4(KVF + ob + 16 * nt, af[nt]); st_bf4(KVB + ob + 16 * nt, ab[nt]); }
        SYNCTHREADS();
    }
}
__device__ __forceinline__ void ph_ret_state(const Ctx& c) {
    const bf16_t* KVF = WSH(O_KVF); const bf16_t* KVB = WSH(O_KVB); bf16_t* STF = WSH(O_STF); bf16_t* STB = WSH(O_STB);
    for (long i = GT_; i < (long)NB * 8 * 8192; i += GS_) {
        const int x = (int)(i % 8192), h = (int)((i / 8192) % 8), b = (int)(i / 65536);
        const float cd = expf(128.f * loggamma_(h)); float st = 0.f;
#pragma unroll 16
        for (int n = 0; n < NCH; ++n) { const size_t idx = (((size_t)b * NCH + n) * 8 + h) * 8192 + x; STF[idx] = (bf16_t)f2bf(st); st = cd * st + bf2f(KVF[idx]); }
        st = 0.f;
#pragma unroll 16
        for (int n = NCH - 1; n >= 0; --n) { const size_t idx = (((size_t)b * NCH + n) * 8 + h) * 8192 + x; STB[idx] = (bf16_t)f2bf(st); st = cd * st + bf2f(KVB[idx]); }
    }
}
__device__ __forceinline__ void ph_ret_out(const Ctx& c, float* ldsf) {
    const float* RT = WSF(O_ROPE); const bf16_t* P = WSH(O_P); const bf16_t* STF = WSH(O_STF); const bf16_t* STB = WSH(O_STB); bf16_t* Y = WSH(O_YS);
    bf16_t* Qs = (bf16_t*)ldsf; bf16_t* Ks = Qs + 128 * 72; bf16_t* VT = Ks + 128 * 72; bf16_t* Ss = VT + 128 * 136; bf16_t* SF = Ss + 128 * 136; bf16_t* SB = SF + 128 * 72; float* tab = (float*)(SB + 128 * 72);
    const int tid = threadIdx.x, wv = tid >> 6, lane = tid & 63, fr = lane & 15, fq = lane >> 4;
    for (int u = blockIdx.x; u < (T / 128) * 8; u += gridDim.x) {
        const int h = u & 7; const long t0 = (long)(u >> 3) * 128;
        ret_tables(tab, h);
        SYNCTHREADS();
        {
            const int j = tid >> 2, d0 = (tid & 3) * 8; const bf16_t* prow = P + (size_t)(t0 + j) * PW + h * 64 + d0; const float* rt = RT + ((size_t)(t0 + j) * 32 + d0) * 2;
            const u32x4 ql = *(const u32x4*)(prow + C_RQ), qh = *(const u32x4*)(prow + C_RQ + 32), kl = *(const u32x4*)(prow + C_RK), kh = *(const u32x4*)(prow + C_RK + 32);
            const f32x4 r0 = *(const f32x4*)rt, r1 = *(const f32x4*)(rt + 4), r2 = *(const f32x4*)(rt + 8), r3 = *(const f32x4*)(rt + 12);
            const float cs[8] = {r0[0], r0[2], r1[0], r1[2], r2[0], r2[2], r3[0], r3[2]}, sn[8] = {r0[1], r0[3], r1[1], r1[3], r2[1], r2[3], r3[1], r3[3]};
            u32x4 oql, oqh, okl, okh;
#pragma unroll
            for (int e = 0; e < 4; ++e) { const int ea = 2 * e, eb = 2 * e + 1;
                const float q1a = bflo(ql[e]), q1b = bfhi(ql[e]), q2a = bflo(qh[e]), q2b = bfhi(qh[e]), k1a = bflo(kl[e]), k1b = bfhi(kl[e]), k2a = bflo(kh[e]), k2b = bfhi(kh[e]);
                oql[e] = pk2((q1a * cs[ea] - q2a * sn[ea]) * 0.125f, (q1b * cs[eb] - q2b * sn[eb]) * 0.125f); oqh[e] = pk2((q2a * cs[ea] + q1a * sn[ea]) * 0.125f, (q2b * cs[eb] + q1b * sn[eb]) * 0.125f);
                okl[e] = pk2(k1a * cs[ea] - k2a * sn[ea], k1b * cs[eb] - k2b * sn[eb]); okh[e] = pk2(k2a * cs[ea] + k1a * sn[ea], k2b * cs[eb] + k1b * sn[eb]); }
            *(u32x4*)(Qs + j * 72 + d0) = oql; *(u32x4*)(Qs + j * 72 + d0 + 32) = oqh; *(u32x4*)(Ks + j * 72 + d0) = okl; *(u32x4*)(Ks + j * 72 + d0 + 32) = okh; }
#pragma unroll
        for (int q = 0; q < 4; ++q) { const int id = tid + NT * q, j = id & 127, e8 = (id >> 7) * 8; const u32x4 raw = *(const u32x4*)(P + (size_t)(t0 + j) * PW + C_RV + h * 128 + e8);
#pragma unroll
            for (int e = 0; e < 4; ++e) { VT[(e8 + 2 * e) * 136 + j] = (bf16_t)(raw[e] & 0xffffu); VT[(e8 + 2 * e + 1) * 136 + j] = (bf16_t)(raw[e] >> 16); } }
        const size_t sbase = (((size_t)(u >> 3) * 8 + h)) * 8192;
#pragma unroll
        for (int q = 0; q < 4; ++q) { const int id = tid + NT * q, e = id >> 4, d4 = (id & 15) * 4; *(unsigned long long*)(SF + e * 72 + d4) = *(const unsigned long long*)(STF + sbase + (size_t)e * 64 + d4); *(unsigned long long*)(SB + e * 72 + d4) = *(const unsigned long long*)(STB + sbase + (size_t)e * 64 + d4); }
        SYNCTHREADS();
        const int i = wv * 16 + fr; const long t = t0 + i;
        {
            f32x4 sc[8];
#pragma unroll
            for (int nt = 0; nt < 8; ++nt) sc[nt] = (f32x4){0.f, 0.f, 0.f, 0.f};
            wave_mma<2, 8>(sc, Qs + wv * 16 * 72, 72, Ks, 72);
#pragma unroll
            for (int nt = 0; nt < 8; ++nt) { const int j0 = 16 * nt + 4 * fq; f32x4 sv;
#pragma unroll
                for (int e = 0; e < 4; ++e) { const int j = j0 + e, dist = i > j ? i - j : j - i; sv[e] = sc[nt][e] * tab[64 + dist]; }
                st_bf4(Ss + i * 136 + j0, sv); }
        }
#ifdef CPU_EMU
        SYNCTHREADS();
#else
        asm volatile("s_waitcnt lgkmcnt(0)" ::: "memory");
#endif
        f32x4 ao[8], tm[8];
#pragma unroll
        for (int nt = 0; nt < 8; ++nt) { ao[nt] = (f32x4){0.f, 0.f, 0.f, 0.f}; tm[nt] = (f32x4){0.f, 0.f, 0.f, 0.f}; }
        wave_mma<4, 8>(ao, Ss + wv * 16 * 136, 136, VT, 136);
        wave_mma<2, 8>(tm, Qs + wv * 16 * 72, 72, SF, 72);
        { const float qf = tab[64 + i + 1];
#pragma unroll
            for (int nt = 0; nt < 8; ++nt) { ao[nt] += tm[nt] * qf; tm[nt] = (f32x4){0.f, 0.f, 0.f, 0.f}; } }
        wave_mma<2, 8>(tm, Qs + wv * 16 * 72, 72, SB, 72);
        { const float qb = tab[64 + 128 - i];
#pragma unroll
            for (int nt = 0; nt < 8; ++nt) ao[nt] += tm[nt] * qb; }
        float sm = 0.f;
#pragma unroll
        for (int nt = 0; nt < 8; ++nt) sm += (ao[nt][0] + ao[nt][1]) + (ao[nt][2] + ao[nt][3]);
        sm += SHFL_XOR(sm, 16); sm += SHFL_XOR(sm, 32);
        const float mu = sm * (1.f / 128.f); float sq = 0.f;
#pragma unroll
        for (int nt = 0; nt < 8; ++nt) { ao[nt] -= mu; sq += (ao[nt][0] * ao[nt][0] + ao[nt][1] * ao[nt][1]) + (ao[nt][2] * ao[nt][2] + ao[nt][3] * ao[nt][3]); }
        sq += SHFL_XOR(sq, 16); sq += SHFL_XOR(sq, 32);
        const float rs = frsq_(sq * (1.f / 128.f) + EPS);
#pragma unroll
        for (int nt = 0; nt < 8; ++nt) { const int e0 = 16 * nt + 4 * fq; f32x4 gv = ld_bf4(P + (size_t)t * PW + C_RG + h * 128 + e0);
#pragma unroll
            for (int e = 0; e < 4; ++e) gv[e] = siluf_(gv[e]) * (ao[nt][e] * rs);
            st_bf4(Y + (size_t)t * 4 * W + 1 * W + h * 128 + e0, gv); }
        SYNCTHREADS();
    }
}
__device__ __forceinline__ void ph_sgu_norm(const Ctx& c, int l) {
    const bf16_t* P = WSH(O_P); float* ST = WSF(O_VN);
    const int lane = threadIdx.x & 63, gw = blockIdx.x * (NT / 64) + (threadIdx.x >> 6), ngw = gridDim.x * (NT / 64);
    for (int t = gw; t < T; t += ngw) {
        f32x4 v[4]; float sm = 0.f;
#pragma unroll
        for (int j = 0; j < 4; ++j) { v[j] = ld_bf4(P + (size_t)t * PW + C_SV + (j * 64 + lane) * 4);
#pragma unroll
            for (int q = 0; q < 4; ++q) { v[j][q] = geluf_(v[j][q]); sm += v[j][q]; } }
        const float mu = wave_sum(sm) * (1.f / W); float sq = 0.f;
#pragma unroll
        for (int j = 0; j < 4; ++j)
#pragma unroll
            for (int q = 0; q < 4; ++q) { const float dd = v[j][q] - mu; sq += dd * dd; }
        const float rs = 1.f / sqrtf(wave_sum(sq) * (1.f / W) + EPS);
        if (lane == 0) { ST[(size_t)t * 2] = mu; ST[(size_t)t * 2 + 1] = rs; }
    }
}
__device__ __forceinline__ void ph_sgu_mix(const Ctx& c, int l, float* ldsf) {
    const bf16_t* P = WSH(O_P); const float* SG = WSF(O_HF) + (size_t)T * 32; bf16_t* Y = WSH(O_YS); const float* ng = c.in[15] + (size_t)l * W;
    bf16_t* As = (bf16_t*)ldsf; bf16_t* Bs = As + 128 * 136; const int tid = threadIdx.x, wv = tid >> 6, lane = tid & 63, fr = lane & 15, fq = lane >> 4;
    int gprev = -1;
    for (int u = blockIdx.x; u < (T / 128) * 8; u += gridDim.x) {
        const int g = u & 7; const long t0 = (long)(u >> 3) * 128;
        const float* ws = c.in[16] + ((size_t)l * 8 + g) * 128 * 128; const float* bs = c.in[17] + ((size_t)l * 8 + g) * 128;
        if (g != gprev) {
#pragma unroll
            for (int q = 0; q < 8; ++q) { const int id = tid + NT * q, i = id >> 5, j4 = (id & 31) * 4; st_bf4(As + i * 136 + j4, *(const f32x4*)(ws + i * 128 + j4)); }
            gprev = g; }
        float mu, rs;
        { const f32x4* sg = (const f32x4*)(SG + (size_t)(t0 + (tid & 127)) * 32); f32x4 a = sg[0];
#pragma unroll
          for (int i = 1; i < 8; ++i) a += sg[i];
          mu = (a[0] + a[2]) * (1.f / W); rs = frsq_(fmaxf((a[1] + a[3]) * (1.f / W) - mu * mu, 0.f) + EPS); }
#pragma unroll
        for (int q = 0; q < 4; ++q) { const int id = tid + NT * q, j = id & 127, d8 = (id >> 7) * 8;
            const u32x4 raw = *(const u32x4*)(P + (size_t)(t0 + j) * PW + C_SV + g * 128 + d8); const f32x4 n0 = *(const f32x4*)(ng + g * 128 + d8), n1 = *(const f32x4*)(ng + g * 128 + d8 + 4);
            const float ngv[8] = {n0[0], n0[1], n0[2], n0[3], n1[0], n1[1], n1[2], n1[3]};
#pragma unroll
            for (int e = 0; e < 4; ++e) { const float v0 = (geluf_(bflo(raw[e])) - mu) * rs * ngv[2 * e], v1 = (geluf_(bfhi(raw[e])) - mu) * rs * ngv[2 * e + 1];
                Bs[(d8 + 2 * e) * 136 + j] = (bf16_t)f2bf(v0); Bs[(d8 + 2 * e + 1) * 136 + j] = (bf16_t)f2bf(v1); } }
        const int i = wv * 16 + fr; const long t = t0 + i; const float bsi = bs[i];
        unsigned long long uraw[8];
#pragma unroll
        for (int nt = 0; nt < 8; ++nt) uraw[nt] = *(const unsigned long long*)(P + (size_t)t * PW + C_SU + g * 128 + 16 * nt + 4 * fq);
        SYNCTHREADS();
        f32x4 acc[8];
#pragma unroll
        for (int nt = 0; nt < 8; ++nt) acc[nt] = (f32x4){0.f, 0.f, 0.f, 0.f};
        wave_mma<4, 8>(acc, As + wv * 16 * 136, 136, Bs, 136);
#pragma unroll
        for (int nt = 0; nt < 8; ++nt) { const int d = 16 * nt + 4 * fq; const unsigned ulo = (unsigned)uraw[nt], uhi = (unsigned)(uraw[nt] >> 32); f32x4 uu = (f32x4){bflo(ulo), bfhi(ulo), bflo(uhi), bfhi(uhi)};
#pragma unroll
            for (int e = 0; e < 4; ++e) uu[e] = geluf_(uu[e]) * (acc[nt][e] + bsi);
            st_bf4(Y + (size_t)t * 4 * W + 2 * W + g * 128 + d, uu); }
        SYNCTHREADS();
    }
}
__device__ __forceinline__ void ph_rw_shift(const Ctx& c, int l) {
    const bf16_t* P = WSH(O_P); const float* mup = c.in[18] + (size_t)l * RF; const float* mun = c.in[19] + (size_t)l * RF; bf16_t* FS = WSH(O_FS);
    const int lane = threadIdx.x & 63, gw = blockIdx.x * (NT / 64) + (threadIdx.x >> 6), ngw = gridDim.x * (NT / 64);
    for (int t0 = gw * 4; t0 < T; t0 += ngw * 4) {
        const bf16_t* pc = P + (size_t)t0 * PW + C_RW;
#pragma unroll 1
        for (int j = lane * 4; j < RF; j += 256) {
            const f32x4 z4 = (f32x4){0.f, 0.f, 0.f, 0.f}; f32x4 rowv[6];
#pragma unroll
            for (int r = 0; r < 6; ++r) { const int t = t0 - 1 + r; rowv[r] = (t >= 0 && t < T) ? ld_bf4(pc + (long)(r - 1) * PW + j) : z4; }
            const f32x4 mp = *(const f32x4*)(mup + j), mn = *(const f32x4*)(mun + j);
#pragma unroll
            for (int r = 0; r < 4; ++r) { const int t = t0 + r, sI = t % S; const f32x4 f = rowv[r + 1]; const f32x4 pv = sI > 0 ? rowv[r] : z4, nv = sI < S - 1 ? rowv[r + 2] : z4;
                f32x4 v = f + mp * (pv - f) + mn * (nv - f);
                if (j >= 3072 && j < 3200) {
#pragma unroll
                    for (int e = 0; e < 4; ++e) v[e] = tanhf_(v[e]); }
                else if (j >= 3328) {
#pragma unroll
                    for (int e = 0; e < 4; ++e) v[e] = sigmoidf_(v[e]); }
                st_bf4(FS + (size_t)t * RF + j, v); }
        }
    }
}
__device__ __forceinline__ void ph_rw_lora(const Ctx& c, int l, float* ldsf) {
    const bf16_t* FS = WSH(O_FS); const float* w0 = c.in[20] + (size_t)l * 2 * W; const float* a0 = c.in[22] + (size_t)l * 2 * W;
    const bf16_t* WUT = WSH(O_WUT); const bf16_t* WAT = WSH(O_WAT); const bf16_t* WGT = WSH(O_WGT);
    bf16_t* DEC = WSH(O_DEC); bf16_t* AA = WSH(O_AA); bf16_t* GG = WSH(O_GG);
    bf16_t* F = (bf16_t*)ldsf; bf16_t* B1 = F + 128 * 136; bf16_t* B2 = B1 + 128 * 136; const int tid = threadIdx.x, wv = tid >> 6, lane = tid & 63, fr = lane & 15, fq = lane >> 4;
    unsigned long long fpre[8]; u32x4 bpre[4];
#define LORA_LOAD(uu, rdd) do { const int wc0_ = ((uu) & 7) * 128; const long t0_ = (long)((uu) >> 3) * 128; \
        _Pragma("unroll") for (int q = 0; q < 8; ++q) { const int id = tid + NT * q, r = id >> 5, c4 = (id & 31) * 4; \
            const int col = (rdd) < 2 ? (c4 < 64 ? 3072 + (rdd) * 64 + c4 : 3200 + (rdd) * 64 + (c4 - 64)) : 3328 + c4; fpre[q] = *(const unsigned long long*)(FS + (size_t)(t0_ + r) * RF + col); } \
        if ((rdd) < 2) { _Pragma("unroll") for (int q = 0; q < 2; ++q) { const int id = tid + NT * q, w = id >> 3, r8 = (id & 7) * 8; \
            bpre[2 * q] = *(const u32x4*)(WUT + ((size_t)(rdd) * W + wc0_ + w) * 64 + r8); bpre[2 * q + 1] = *(const u32x4*)(WAT + ((size_t)(rdd) * W + wc0_ + w) * 64 + r8); } } \
        else { _Pragma("unroll") for (int q = 0; q < 4; ++q) { const int id = tid + NT * q, w = id >> 4, r8 = (id & 15) * 8; bpre[q] = *(const u32x4*)(WGT + ((size_t)wc0_ + w) * 128 + r8); } } } while (0)
    if ((int)blockIdx.x < (T / 128) * 8) LORA_LOAD((int)blockIdx.x, 0);
    for (int u = blockIdx.x; u < (T / 128) * 8; u += gridDim.x) {
        const int wc0 = (u & 7) * 128; const long t0 = (long)(u >> 3) * 128;
#pragma unroll
        for (int rd = 0; rd < 3; ++rd) {
#pragma unroll
            for (int q = 0; q < 8; ++q) { const int id = tid + NT * q, r = id >> 5, c4 = (id & 31) * 4; *(unsigned long long*)(F + r * 136 + c4) = fpre[q]; }
            if (rd < 2) {
#pragma unroll
                for (int q = 0; q < 2; ++q) { const int id = tid + NT * q, w = id >> 3, r8 = (id & 7) * 8; *(u32x4*)(B1 + w * 72 + r8) = bpre[2 * q]; *(u32x4*)(B2 + w * 72 + r8) = bpre[2 * q + 1]; }
            } else {
#pragma unroll
                for (int q = 0; q < 4; ++q) { const int id = tid + NT * q, w = id >> 4, r8 = (id & 15) * 8; *(u32x4*)(B1 + w * 136 + r8) = bpre[q]; }
            }
            if (rd < 2) LORA_LOAD(u, rd + 1); else if (u + (int)gridDim.x < (T / 128) * 8) LORA_LOAD(u + (int)gridDim.x, 0);
            LDS_BARRIER();
            f32x4 a1[8], a2[8];
#pragma unroll
            for (int nt = 0; nt < 8; ++nt) { a1[nt] = (f32x4){0.f, 0.f, 0.f, 0.f}; a2[nt] = (f32x4){0.f, 0.f, 0.f, 0.f}; }
            const long t = t0 + wv * 16 + fr;
            if (rd < 2) {
                wave_mma<2, 8>(a1, F + wv * 16 * 136, 136, B1, 72);
                wave_mma<2, 8>(a2, F + wv * 16 * 136 + 64, 136, B2, 72);
#pragma unroll
                for (int nt = 0; nt < 8; ++nt) { const int ch = wc0 + 16 * nt + 4 * fq; const f32x4 w0v = *(const f32x4*)(w0 + rd * W + ch), a0v = *(const f32x4*)(a0 + rd * W + ch); f32x4 dv, av;
#pragma unroll
                    for (int e = 0; e < 4; ++e) { dv[e] = fexp_(-DECAY_SCALE * sigmoidf_(a1[nt][e] + w0v[e])); av[e] = sigmoidf_(a2[nt][e] + a0v[e]); }
                    st_bf4(DEC + ((size_t)rd * T + t) * W + ch, dv); st_bf4(AA + ((size_t)rd * T + t) * W + ch, av); }
            } else {
                wave_mma<4, 8>(a1, F + wv * 16 * 136, 136, B1, 136);
#pragma unroll
                for (int nt = 0; nt < 8; ++nt) st_bf4(GG + (size_t)t * W + wc0 + 16 * nt + 4 * fq, a1[nt]);
            }
            LDS_BARRIER();
        }
    }
}
#ifdef CPU_EMU
__device__ __forceinline__ float red16_(float x) { x += SHFL_XOR(x, 1); x += SHFL_XOR(x, 2); x += SHFL_XOR(x, 4); x += SHFL_XOR(x, 8); return x; }
__device__ __forceinline__ float red8_(float x) { x += SHFL_XOR(x, 1); x += SHFL_XOR(x, 2); x += SHFL_XOR(x, 4); return x; }
#else
__device__ __forceinline__ float red8_(float x) {
    x += __builtin_bit_cast(float, __builtin_amdgcn_update_dpp(0, __builtin_bit_cast(int, x), 0xB1, 0xF, 0xF, true));
    x += __builtin_bit_cast(float, __builtin_amdgcn_update_dpp(0, __builtin_bit_cast(int, x), 0x4E, 0xF, 0xF, true));
    x += __builtin_bit_cast(float, __builtin_amdgcn_update_dpp(0, __builtin_bit_cast(int, x), 0x141, 0xF, 0xF, true));
    return x;
}
__device__ __forceinline__ float red16_(float x) {
    x += __builtin_bit_cast(float, __builtin_amdgcn_update_dpp(0, __builtin_bit_cast(int, x), 0xB1, 0xF, 0xF, true));
    x += __builtin_bit_cast(float, __builtin_amdgcn_update_dpp(0, __builtin_bit_cast(int, x), 0x4E, 0xF, 0xF, true));
    x += __builtin_bit_cast(float, __builtin_amdgcn_update_dpp(0, __builtin_bit_cast(int, x), 0x141, 0xF, 0xF, true));
    x += __builtin_bit_cast(float, __builtin_amdgcn_update_dpp(0, __builtin_bit_cast(int, x), 0x140, 0xF, 0xF, true));
    return x;
}
#endif
#define RC_M(k) (lm + (k) * 4608)
__device__ __forceinline__ void ph_rw_chunk(const Ctx& c, int l, float* ldsf) {
    const bf16_t* FS = WSH(O_FS); const bf16_t* DEC = WSH(O_DEC); const bf16_t* AA = WSH(O_AA); float* BON = WSF(O_BON);
    const float* kkw = c.in[25] + (size_t)l * W; const float* kaw = c.in[26] + (size_t)l * W; const float* rk = c.in[27] + (size_t)l * W;
    bf16_t* PST = WSH(O_PST); bf16_t* PYT = WSH(O_PYT); bf16_t* SVB = WSH(O_SVB); bf16_t* YVB = WSH(O_YVB);
    bf16_t* lm = (bf16_t*)ldsf; float* gam = (float*)RC_M(7); float* segp = (float*)RC_M(13); float* gl = segp + 512;
    const int tid = threadIdx.x, wv = tid >> 6, lane = tid & 63, fr = lane & 15, fq = lane >> 4, rt = wv & 3, hf = wv >> 2;
    const int m0 = 16 * rt + fr;
    u32x4 wq, kq, rq, vq, aq;
#define RC_LOAD(uu) do { const int chain_ = (uu) / NRC, ck_ = (uu) % NRC, h_ = chain_ & 15, b_ = (chain_ >> 4) & 1, z_ = chain_ >> 5; \
        const long t_ = (long)b_ * S + (z_ ? S - 1 - ck_ * RCK - (tid >> 3) : ck_ * RCK + (tid >> 3)); const int ch_ = h_ * 64 + (tid & 7) * 8; \
        wq = *(const u32x4*)(DEC + ((size_t)z_ * T + t_) * W + ch_); aq = *(const u32x4*)(AA + ((size_t)z_ * T + t_) * W + ch_); \
        const bf16_t* f_ = FS + (size_t)t_ * RF; rq = *(const u32x4*)(f_ + ch_); kq = *(const u32x4*)(f_ + 1024 + ch_); vq = *(const u32x4*)(f_ + 2048 + ch_); } while (0)
    if ((int)blockIdx.x < 64 * NRC) RC_LOAD((int)blockIdx.x);
    for (int u = blockIdx.x; u < 64 * NRC; u += gridDim.x) {
        const int chain = u / NRC, ck = u % NRC, h = chain & 15, b = (chain >> 4) & 1, z = chain >> 5;
        const long tb = (long)b * S + (z ? S - 1 - ck * RCK : ck * RCK); const int dirn = z ? -1 : 1;
        const int tt = tid >> 3, o8 = (tid & 7) * 8;
        const f32x4 kw0 = *(const f32x4*)(kkw + h * 64 + o8), kw1 = *(const f32x4*)(kkw + h * 64 + o8 + 4), ka0 = *(const f32x4*)(kaw + h * 64 + o8), ka1 = *(const f32x4*)(kaw + h * 64 + o8 + 4),
                    rk0 = *(const f32x4*)(rk + h * 64 + o8), rk1 = *(const f32x4*)(rk + h * 64 + o8 + 4);
        *(f32x4*)(gam + tt * 64 + o8) = (f32x4){bflo(wq[0]), bfhi(wq[0]), bflo(wq[1]), bfhi(wq[1])};
        *(f32x4*)(gam + tt * 64 + o8 + 4) = (f32x4){bflo(wq[2]), bfhi(wq[2]), bflo(wq[3]), bfhi(wq[3])};
        LDS_BARRIER();
        { const int k = tid & 63, sg = tid >> 6; float p = 1.f;
#pragma unroll
          for (int q = 0; q < 8; ++q) { p *= gam[(sg * 8 + q) * 64 + k]; gam[(sg * 8 + q) * 64 + k] = p; }
          segp[sg * 64 + k] = p; }
        LDS_BARRIER();
        { const int k = tid & 63, sg = tid >> 6; float pre = 1.f;
          for (int q = 0; q < sg; ++q) pre *= segp[q * 64 + k];
#pragma unroll
          for (int q = 0; q < 8; ++q) gam[(sg * 8 + q) * 64 + k] *= pre;
          if (sg == 7) gl[k] = gam[63 * 64 + k]; }
        LDS_BARRIER();
        { const long t = tb + dirn * tt;
          const f32x4 g0 = *(const f32x4*)(gam + tt * 64 + o8), g1 = *(const f32x4*)(gam + tt * 64 + o8 + 4);
          f32x4 p0 = (f32x4){1.f, 1.f, 1.f, 1.f}, p1 = p0; if (tt) { p0 = *(const f32x4*)(gam + (tt - 1) * 64 + o8); p1 = *(const f32x4*)(gam + (tt - 1) * 64 + o8 + 4); }
          float gx[8], gpx[8], kwx[8], kax[8], rkx[8], kx[8], ax[8], rx[8];
#pragma unroll
          for (int e = 0; e < 4; ++e) { gx[e] = g0[e]; gx[4 + e] = g1[e]; gpx[e] = p0[e]; gpx[4 + e] = p1[e]; kwx[e] = kw0[e]; kwx[4 + e] = kw1[e]; kax[e] = ka0[e]; kax[4 + e] = ka1[e]; rkx[e] = rk0[e]; rkx[4 + e] = rk1[e];
              kx[2 * e] = bflo(kq[e]); kx[2 * e + 1] = bfhi(kq[e]); ax[2 * e] = bflo(aq[e]); ax[2 * e + 1] = bfhi(aq[e]); rx[2 * e] = bflo(rq[e]); rx[2 * e + 1] = bfhi(rq[e]); }
          float vk[8], ktv[8], ss = 0.f, bs = 0.f;
#pragma unroll
          for (int e = 0; e < 8; ++e) { vk[e] = kx[e] * kwx[e]; ss += vk[e] * vk[e]; ktv[e] = kx[e] * (1.f + (ax[e] - 1.f) * kax[e]); bs += rx[e] * rkx[e] * ktv[e]; }
          ss = red8_(ss); bs = red8_(bs);
          if ((tid & 7) == 0) BON[((size_t)z * T + t) * 16 + h] = bs;
          const float rn = frsq_(ss + EPS); float khv[8], bhv[8], k2v[8], rhv[8];
#pragma unroll
          for (int e = 0; e < 8; ++e) { const float kkn = vk[e] * rn, ig = frcp_(gx[e]); khv[e] = kkn * gpx[e]; bhv[e] = ax[e] * kkn * ig; k2v[e] = ktv[e] * ig; rhv[e] = rx[e] * gx[e]; }
          u32x4 K4, B4, C4, R4;
#pragma unroll
          for (int e = 0; e < 4; ++e) { K4[e] = pk2(khv[2 * e], khv[2 * e + 1]); B4[e] = pk2(bhv[2 * e], bhv[2 * e + 1]); C4[e] = pk2(k2v[2 * e], k2v[2 * e + 1]); R4[e] = pk2(rhv[2 * e], rhv[2 * e + 1]); }
          *(u32x4*)(RC_M(0) + tt * 72 + o8) = K4; *(u32x4*)(RC_M(2) + tt * 72 + o8) = B4; *(u32x4*)(RC_M(4) + tt * 72 + o8) = C4; *(u32x4*)(RC_M(5) + tt * 72 + o8) = R4;
#pragma unroll
          for (int e = 0; e < 8; ++e) { const int sh = 16 * (e & 1);
              RC_M(1)[(o8 + e) * 72 + tt] = (bf16_t)(K4[e >> 1] >> sh); RC_M(3)[(o8 + e) * 72 + tt] = (bf16_t)(B4[e >> 1] >> sh); RC_M(6)[(o8 + e) * 72 + tt] = (bf16_t)(vq[e >> 1] >> sh); } }
        if (u + (int)gridDim.x < 64 * NRC) RC_LOAD(u + (int)gridDim.x);
        LDS_BARRIER();
        f32x4 mkr[2], khr[2], rhT[2];
        {
            f32x4 a0[2], a1[2], a2[2], a3[2];
#pragma unroll
            for (int nt = 0; nt < 2; ++nt) { a0[nt] = (f32x4){0.f, 0.f, 0.f, 0.f}; a1[nt] = a0[nt]; a2[nt] = a0[nt]; a3[nt] = a0[nt]; }
            wave_mma<2, 2>(a0, RC_M(2) + rt * 16 * 72, 72, RC_M(0) + hf * 32 * 72, 72);
            wave_mma<2, 2>(a1, RC_M(4) + rt * 16 * 72, 72, RC_M(0) + hf * 32 * 72, 72);
            wave_mma<2, 2>(a2, RC_M(2) + rt * 16 * 72, 72, RC_M(5) + hf * 32 * 72, 72);
            wave_mma<2, 2>(a3, RC_M(4) + rt * 16 * 72, 72, RC_M(5) + hf * 32 * 72, 72);
#pragma unroll
            for (int nt = 0; nt < 2; ++nt) { const int n0 = 32 * hf + 16 * nt + 4 * fq; f32x4 nn, ti, mk;
#pragma unroll
                for (int r = 0; r < 4; ++r) { const int n = n0 + r; const bool lt = m0 < n, le = m0 <= n;
                    nn[r] = lt ? -a0[nt][r] : 0.f; ti[r] = nn[r] + (m0 == n ? 1.f : 0.f); mk[r] = lt ? a1[nt][r] : 0.f; mkr[nt][r] = le ? a3[nt][r] : 0.f;
                    RC_M(12)[n * 72 + m0] = (bf16_t)f2bf(le ? a2[nt][r] : 0.f);
                    RC_M(8)[n * 72 + m0] = (bf16_t)f2bf(nn[r]);
                    khr[nt][r] = bf2f(RC_M(4)[m0 * 72 + n]); rhT[nt][r] = bf2f(RC_M(5)[n * 72 + m0]); }
                st_bf4(RC_M(7) + m0 * 72 + n0, nn); st_bf4(RC_M(9) + m0 * 72 + n0, ti); st_bf4(RC_M(11) + m0 * 72 + n0, mk); }
        }
        LDS_BARRIER();
        f32x4 tiv[2];
#pragma unroll
        for (int nt = 0; nt < 2; ++nt) tiv[nt] = ld_bf4(RC_M(9) + m0 * 72 + 32 * hf + 16 * nt + 4 * fq);
        {
            f32x4 sq[2];
#pragma unroll
            for (int nt = 0; nt < 2; ++nt) sq[nt] = (f32x4){0.f, 0.f, 0.f, 0.f};
            wave_mma<2, 2>(sq, RC_M(7) + rt * 16 * 72, 72, RC_M(8) + hf * 32 * 72, 72);
#pragma unroll
            for (int nt = 0; nt < 2; ++nt) { const int n0 = 32 * hf + 16 * nt + 4 * fq; st_bf4(RC_M(0) + m0 * 72 + n0, sq[nt]);
#pragma unroll
                for (int r = 0; r < 4; ++r) RC_M(2)[(n0 + r) * 72 + m0] = (bf16_t)f2bf(sq[nt][r]); }
        }
        LDS_BARRIER();
#pragma unroll 1
        for (int k = 1; k <= 5; ++k) {
            bf16_t* pk = (k & 1) ? RC_M(0) : RC_M(7); bf16_t* pkT = (k & 1) ? RC_M(2) : RC_M(8); bf16_t* pn = (k & 1) ? RC_M(7) : RC_M(0); bf16_t* pnT = (k & 1) ? RC_M(8) : RC_M(2);
            bf16_t* tcur = (k & 1) ? RC_M(9) : RC_M(4); bf16_t* tnxt = (k & 1) ? RC_M(4) : RC_M(9);
            f32x4 up[2], sq[2];
#pragma unroll
            for (int nt = 0; nt < 2; ++nt) { up[nt] = (f32x4){0.f, 0.f, 0.f, 0.f}; sq[nt] = up[nt]; }
            wave_mma<2, 2>(up, tcur + rt * 16 * 72, 72, pkT + hf * 32 * 72, 72);
            if (k < 5) wave_mma<2, 2>(sq, pk + rt * 16 * 72, 72, pkT + hf * 32 * 72, 72);
#pragma unroll
            for (int nt = 0; nt < 2; ++nt) { const int n0 = 32 * hf + 16 * nt + 4 * fq; tiv[nt] += up[nt]; st_bf4(tnxt + m0 * 72 + n0, tiv[nt]);
                if (k == 5) {
#pragma unroll
                    for (int r = 0; r < 4; ++r) RC_M(10)[(n0 + r) * 72 + m0] = (bf16_t)f2bf(tiv[nt][r]);
                } else { st_bf4(pn + m0 * 72 + n0, sq[nt]);
#pragma unroll
                    for (int r = 0; r < 4; ++r) pnT[(n0 + r) * 72 + m0] = (bf16_t)f2bf(sq[nt][r]); } }
            LDS_BARRIER();
        }
        {
            f32x4 w1[2], w2[2];
#pragma unroll
            for (int nt = 0; nt < 2; ++nt) { w1[nt] = (f32x4){0.f, 0.f, 0.f, 0.f}; w2[nt] = w1[nt]; }
            wave_mma<2, 2>(w1, RC_M(1) + rt * 16 * 72, 72, RC_M(10) + hf * 32 * 72, 72);
            wave_mma<2, 2>(w2, RC_M(11) + rt * 16 * 72, 72, RC_M(10) + hf * 32 * 72, 72);
#pragma unroll
            for (int nt = 0; nt < 2; ++nt) { const int n0 = 32 * hf + 16 * nt + 4 * fq; st_bf4(RC_M(7) + m0 * 72 + n0, w1[nt]); st_bf4(RC_M(8) + m0 * 72 + n0, w2[nt]); }
        }
        LDS_BARRIER();
        {
            f32x4 py[2], qy[2], ps[2], qs[2];
#pragma unroll
            for (int nt = 0; nt < 2; ++nt) { py[nt] = (f32x4){0.f, 0.f, 0.f, 0.f}; qy[nt] = py[nt]; ps[nt] = py[nt]; qs[nt] = py[nt]; }
            wave_mma<2, 2>(py, RC_M(7) + rt * 16 * 72, 72, RC_M(12) + hf * 32 * 72, 72);
            wave_mma<2, 2>(qy, RC_M(8) + rt * 16 * 72, 72, RC_M(12) + hf * 32 * 72, 72);
            wave_mma<2, 2>(ps, RC_M(7) + rt * 16 * 72, 72, RC_M(3) + hf * 32 * 72, 72);
            wave_mma<2, 2>(qs, RC_M(8) + rt * 16 * 72, 72, RC_M(3) + hf * 32 * 72, 72);
#pragma unroll
            for (int nt = 0; nt < 2; ++nt) { const int n0 = 32 * hf + 16 * nt + 4 * fq;
#pragma unroll
                for (int r = 0; r < 4; ++r) { const int n = n0 + r; const float gln = gl[n];
                    RC_M(0)[n * 72 + m0] = (bf16_t)f2bf(rhT[nt][r] - py[nt][r]); RC_M(2)[n * 72 + m0] = (bf16_t)f2bf(mkr[nt][r] - qy[nt][r]);
                    RC_M(4)[n * 72 + m0] = (bf16_t)f2bf(((m0 == n ? 1.f : 0.f) - ps[nt][r]) * gln); RC_M(5)[n * 72 + m0] = (bf16_t)f2bf((khr[nt][r] - qs[nt][r]) * gln); } }
        }
        LDS_BARRIER();
        {
            f32x4 yv[2], sv[2];
#pragma unroll
            for (int nt = 0; nt < 2; ++nt) { yv[nt] = (f32x4){0.f, 0.f, 0.f, 0.f}; sv[nt] = yv[nt]; }
            wave_mma<2, 2>(yv, RC_M(6) + rt * 16 * 72, 72, RC_M(2) + hf * 32 * 72, 72);
            wave_mma<2, 2>(sv, RC_M(6) + rt * 16 * 72, 72, RC_M(5) + hf * 32 * 72, 72);
#pragma unroll
            for (int nt = 0; nt < 2; ++nt) { const int n0 = 32 * hf + 16 * nt + 4 * fq; st_bf4(YVB + (size_t)u * 4096 + m0 * 64 + n0, yv[nt]); st_bf4(SVB + (size_t)u * 4096 + m0 * 64 + n0, sv[nt]); }
            { const int rr = tid >> 3, c8 = (tid & 7) * 8; *(u32x4*)(PYT + (size_t)u * 4096 + rr * 64 + c8) = *(const u32x4*)(RC_M(0) + rr * 72 + c8); *(u32x4*)(PST + (size_t)u * 4096 + rr * 64 + c8) = *(const u32x4*)(RC_M(4) + rr * 72 + c8); }
        }
        LDS_BARRIER();
    }
}
#undef RC_M
#undef RC_LOAD
__device__ __forceinline__ void ph_rw_seq(const Ctx& c, float* ldsf) {
    const bf16_t* PST = WSH(O_PST); const bf16_t* PYT = WSH(O_PYT); const bf16_t* SVB = WSH(O_SVB); const bf16_t* YVB = WSH(O_YVB); bf16_t* YY = WSH(O_YY);
    bf16_t* Sb = (bf16_t*)ldsf;
    bf16_t* Pm = Sb + 2 * 16 * 72;
    const int tid = threadIdx.x, wv = tid >> 6, lane = tid & 63, fr = lane & 15, fq = lane >> 4, nt0 = wv & 3;
#ifdef CPU_EMU
    const int isY = wv >> 2;
#else
    const int isY = __builtin_amdgcn_readfirstlane(wv >> 2);
#endif
    for (int u = blockIdx.x; u < 256; u += gridDim.x) {
        const int x = u & 7, jq = u >> 3, chain = x * 8 + (jq >> 2), qt = jq & 3, h = chain & 15, b = (chain >> 4) & 1, z = chain >> 5;
        const size_t ub = (size_t)chain * NRC;
        const int rr = tid >> 3, c8 = (tid & 7) * 8;
        constexpr int PD = NRC >= 8 ? 8 : 4;
        for (int i = tid; i < 2 * 16 * 72 / 2; i += NT) ((unsigned*)Sb)[i] = 0u;
        const int row = 16 * qt + fr, n0 = 16 * nt0 + 4 * fq; const bf16_t* addp = (isY ? YVB : SVB) + ub * 4096 + row * 64 + n0;
        const bf16_t* psp = PST + ub * 4096 + rr * 64 + c8; const bf16_t* pyp = PYT + ub * 4096 + rr * 64 + c8;
        u32x4 gps[PD], gpy[PD]; unsigned long long addr[PD];
#pragma unroll
        for (int j = 0; j < PD; ++j) { gps[j] = *(const u32x4*)(psp + (size_t)j * 4096); gpy[j] = *(const u32x4*)(pyp + (size_t)j * 4096); addr[j] = *(const unsigned long long*)(addp + (size_t)j * 4096); }
        *(u32x4*)(Pm + (0 * 2 + 0) * 4608 + rr * 72 + c8) = gps[0]; *(u32x4*)(Pm + (0 * 2 + 1) * 4608 + rr * 72 + c8) = gpy[0];
        { const int cl = PD < NRC ? PD : NRC - 1; gps[0] = *(const u32x4*)(psp + (size_t)cl * 4096); gpy[0] = *(const u32x4*)(pyp + (size_t)cl * 4096); }
        SYNCTHREADS();
#define RS_LOOP(ISY) \
        for (int ck0 = 0; ck0 < NRC; ck0 += PD) { \
            _Pragma("unroll") for (int j = 0; j < PD; ++j) { \
                const int ck = ck0 + j, cur = j & 1, nxt = cur ^ 1;        \
                f32x4 acc[1]; acc[0] = (f32x4){0.f, 0.f, 0.f, 0.f}; \
                wave_mma<2, 1>(acc, Sb + cur * 16 * 72, 72, Pm + (cur * 2 + ISY) * 4608 + nt0 * 16 * 72, 72); \
                { const unsigned lo_ = (unsigned)addr[j], hi_ = (unsigned)(addr[j] >> 32); acc[0][0] += bflo(lo_); acc[0][1] += bfhi(lo_); acc[0][2] += bflo(hi_); acc[0][3] += bfhi(hi_); } \
                { const int cl = ck + PD < NRC ? ck + PD : NRC - 1; addr[j] = *(const unsigned long long*)(addp + (size_t)cl * 4096); } \
                if (ISY) { \
                    _Pragma("unroll") for (int r = 0; r < 4; ++r) { const int step = ck * RCK + n0 + r, sidx = z ? S - 1 - step : step; YY[((size_t)z * T + (size_t)b * S + sidx) * W + h * 64 + row] = (bf16_t)f2bf(acc[0][r]); } \
                } else st_bf4(Sb + nxt * 16 * 72 + fr * 72 + n0, acc[0]); \
                const int jn = (j + 1) % PD; \
                *(u32x4*)(Pm + (nxt * 2 + 0) * 4608 + rr * 72 + c8) = gps[jn]; *(u32x4*)(Pm + (nxt * 2 + 1) * 4608 + rr * 72 + c8) = gpy[jn]; \
                { const int cl = ck + 1 + PD < NRC ? ck + 1 + PD : NRC - 1; gps[jn] = *(const u32x4*)(psp + (size_t)cl * 4096); gpy[jn] = *(const u32x4*)(pyp + (size_t)cl * 4096); } \
                LDS_BARRIER(); \
            } \
        }
        if (isY) { RS_LOOP(1) } else { RS_LOOP(0) }
#undef RS_LOOP
    }
}
__device__ __forceinline__ void ph_rw_out(const Ctx& c) {
    const bf16_t* FS = WSH(O_FS); const bf16_t* YY = WSH(O_YY); const float* BON = WSF(O_BON); const bf16_t* GG = WSH(O_GG); bf16_t* Y = WSH(O_YS);
    const int lane = threadIdx.x & 63, gw = blockIdx.x * (NT / 64) + (threadIdx.x >> 6), ngw = gridDim.x * (NT / 64);
    for (int i0 = gw; i0 < T * 2; i0 += 2 * ngw) {
        u32x4 a0[2], a1[2], gq[2], vq[2]; float bs[2];
#pragma unroll
        for (int r = 0; r < 2; ++r) { const int i = i0 + r * ngw < T * 2 ? i0 + r * ngw : i0; const long t = i >> 1; const int ch = (i & 1) * 512 + lane * 8, hd = ch >> 6;
            a0[r] = *(const u32x4*)(YY + (size_t)t * W + ch); a1[r] = *(const u32x4*)(YY + ((size_t)T + t) * W + ch); gq[r] = *(const u32x4*)(GG + (size_t)t * W + ch); vq[r] = *(const u32x4*)(FS + (size_t)t * RF + 2048 + ch);
            bs[r] = BON[(size_t)t * 16 + hd] + BON[((size_t)T + t) * 16 + hd]; }
#pragma unroll
        for (int r = 0; r < 2; ++r) { const int i = i0 + r * ngw < T * 2 ? i0 + r * ngw : i0; const long t = i >> 1; const int ch = (i & 1) * 512 + lane * 8;
            float y0[8], y1[8], s0 = 0.f, s1 = 0.f;
#pragma unroll
            for (int e = 0; e < 4; ++e) { y0[2 * e] = bflo(a0[r][e]); y0[2 * e + 1] = bfhi(a0[r][e]); y1[2 * e] = bflo(a1[r][e]); y1[2 * e + 1] = bfhi(a1[r][e]); }
#pragma unroll
            for (int e = 0; e < 8; ++e) { s0 += y0[e]; s1 += y1[e]; }
            const float m0 = red8_(s0) * (1.f / 64.f), m1 = red8_(s1) * (1.f / 64.f); float q0 = 0.f, q1 = 0.f;
#pragma unroll
            for (int e = 0; e < 8; ++e) { y0[e] -= m0; y1[e] -= m1; q0 += y0[e] * y0[e]; q1 += y1[e] * y1[e]; }
            const float r0 = frsq_(red8_(q0) * (1.f / 64.f) + EPS), r1 = frsq_(red8_(q1) * (1.f / 64.f) + EPS);
            u32x4 o;
#pragma unroll
            for (int e = 0; e < 4; ++e) { const float lo = (y0[2 * e] * r0 + y1[2 * e] * r1 + bs[r] * bflo(vq[r][e])) * bflo(gq[r][e]), hi = (y0[2 * e + 1] * r0 + y1[2 * e + 1] * r1 + bs[r] * bfhi(vq[r][e])) * bfhi(gq[r][e]); o[e] = pk2(lo, hi); }
            *(u32x4*)(Y + (size_t)t * 4 * W + 3 * W + ch) = o; }
    }
}
__device__ __forceinline__ float row_rstd_(const float* ssp, long tr) { const f32x4* q = (const f32x4*)(ssp + (size_t)tr * 32); f32x4 a = q[0];
#pragma unroll
    for (int i = 1; i < 8; ++i) a += q[i];
    return frsq_(((a[0] + a[1]) + (a[2] + a[3])) * (1.f / D) + EPS); }
__device__ __forceinline__ void ph_router(const Ctx& c, int l, float* ldsf, const float* X, const float* gN, const float* shN, const float* scN) {
    const float* SSP = WSF(O_HF); bf16_t* Hn = WSH(O_H); const bf16_t* WH = WSH(O_WRH); const bf16_t* WL = WSH(O_WRL); const float* bg = c.in[31] + (size_t)l * 4; const float* be = c.in[33] + (size_t)l * 32;
    int* EID = WSI(O_EID); float* EWT = WSF(O_EWT); int* cnt = CTLW(c) + CW_CNT + l * 64;
    const int tid = threadIdx.x, wv = tid >> 6, lane = tid & 63, fr = lane & 15, fq = lane >> 4, rt = wv & 1, kq = wv >> 1;
    float* part = ldsf;
    for (int u = blockIdx.x; u < T / 32; u += gridDim.x) {
        const long t0 = (long)u * 32; f32x4 acc[3];
#pragma unroll
        for (int nt = 0; nt < 3; ++nt) acc[nt] = (f32x4){0.f, 0.f, 0.f, 0.f};
#ifdef CPU_EMU
        for (int nt = 0; nt < 3; ++nt) for (int r = 0; r < 4; ++r) { const int n = 16 * nt + 4 * fq + r; float sacc = 0.f;
            for (int k = kq * 512; k < kq * 512 + 512; ++k) { const long tr = t0 + 16 * rt + fr; const int bb = (int)(tr / S); const float hv = X[(size_t)tr * D + k] * row_rstd_(SSP, tr) * gN[k] * (1.f + scN[bb * D6 + k]) + shN[bb * D6 + k]; const float hh = bf2f((bf16_t)f2bf(hv)), hl = bf2f((bf16_t)f2bf(hv - hh));
                const float wh = bf2f(WH[(size_t)n * D + k]), wl = bf2f(WL[(size_t)n * D + k]); sacc += hh * wh + hl * wh + hh * wl; }
            acc[nt][r] = sacc; }
        if (fq == 0) for (int k = kq * 512; k < kq * 512 + 512; ++k) { const long tr = t0 + 16 * rt + fr; const int bb = (int)(tr / S); Hn[(size_t)tr * D + k] = (bf16_t)f2bf(X[(size_t)tr * D + k] * row_rstd_(SSP, tr) * gN[k] * (1.f + scN[bb * D6 + k]) + shN[bb * D6 + k]); }
#else
        const long tr = t0 + 16 * rt + fr; const int bb = (int)(tr / S); const float rsv = row_rstd_(SSP, tr); const int kb = kq * 512 + fq * 8;
        const float* hp = X + (size_t)tr * D + kb; const float* gp_ = gN + kb; const float* scp = scN + bb * D6 + kb; const float* shp = shN + bb * D6 + kb;
#pragma unroll 4
        for (int ks = 0; ks < 16; ++ks) {
            const f32x4 h0 = *(const f32x4*)(hp + ks * 32) * rsv * *(const f32x4*)(gp_ + ks * 32) * (*(const f32x4*)(scp + ks * 32) + 1.f) + *(const f32x4*)(shp + ks * 32);
            const f32x4 h1 = *(const f32x4*)(hp + ks * 32 + 4) * rsv * *(const f32x4*)(gp_ + ks * 32 + 4) * (*(const f32x4*)(scp + ks * 32 + 4) + 1.f) + *(const f32x4*)(shp + ks * 32 + 4); bf16x8 ah, al;
#pragma unroll
            for (int e = 0; e < 4; ++e) { const unsigned b0 = f2bf(h0[e]), b1 = f2bf(h1[e]); ah[e] = (short)b0; ah[4 + e] = (short)b1; al[e] = (short)f2bf(h0[e] - u2f_(b0 << 16)); al[4 + e] = (short)f2bf(h1[e] - u2f_(b1 << 16)); }
            *(bf16x8*)(Hn + (size_t)tr * D + kb + ks * 32) = ah;
#pragma unroll
            for (int nt = 0; nt < 3; ++nt) { const size_t wo = (size_t)(16 * nt + fr) * D + kq * 512 + ks * 32 + fq * 8; const bf16x8 bh = *(const bf16x8*)(WH + wo), bl = *(const bf16x8*)(WL + wo);
                acc[nt] = __builtin_amdgcn_mfma_f32_16x16x32_bf16(bh, ah, acc[nt], 0, 0, 0); acc[nt] = __builtin_amdgcn_mfma_f32_16x16x32_bf16(bh, al, acc[nt], 0, 0, 0); acc[nt] = __builtin_amdgcn_mfma_f32_16x16x32_bf16(bl, ah, acc[nt], 0, 0, 0); }
        }
#endif
#pragma unroll
        for (int nt = 0; nt < 3; ++nt) *(f32x4*)(part + (kq * 32 + 16 * rt + fr) * 48 + 16 * nt + 4 * fq) = acc[nt];
        SYNCTHREADS();
        if (tid < 32) { const long t = t0 + tid; float lg[36];
#pragma unroll
            for (int q = 0; q < 36; ++q) lg[q] = (part[(0 * 32 + tid) * 48 + q] + part[(1 * 32 + tid) * 48 + q]) + (part[(2 * 32 + tid) * 48 + q] + part[(3 * 32 + tid) * 48 + q]) + (q < 4 ? bg[q < 4 ? q : 0] : be[q >= 4 ? q - 4 : 0]);
            int gi = 0; float m = lg[0];
#pragma unroll
            for (int q = 1; q < 4; ++q) if (lg[q] > m) { m = lg[q]; gi = q; }
            float den = 0.f;
#pragma unroll
            for (int q = 0; q < 4; ++q) den += expf(lg[q] - m);
            const float gp = 1.f / den; float el[8];
#pragma unroll
            for (int q = 0; q < 8; ++q) el[q] = gi == 0 ? lg[4 + q] : gi == 1 ? lg[12 + q] : gi == 2 ? lg[20 + q] : lg[28 + q];
            int i1 = 0; float m1 = el[0];
#pragma unroll
            for (int q = 1; q < 8; ++q) if (el[q] > m1) { m1 = el[q]; i1 = q; }
            int i2 = -1; float m2 = 0.f;
#pragma unroll
            for (int q = 0; q < 8; ++q) if (q != i1 && (i2 < 0 || el[q] > m2)) { m2 = el[q]; i2 = q; }
            const float p2 = expf(m2 - m1);
            EID[t * 2] = gi * 8 + i1; EID[t * 2 + 1] = gi * 8 + i2; EWT[t * 2] = gp / (1.f + p2); EWT[t * 2 + 1] = gp * p2 / (1.f + p2);
            atomic_add_i(cnt + gi * 8 + i1, 1); atomic_add_i(cnt + gi * 8 + i2, 1);
        }
        SYNCTHREADS();
    }
}
__device__ __forceinline__ void ph_moe_assign(const Ctx& c, int l, float* ldsf) {
    const int* cnt = CTLW(c) + CW_CNT + l * 64; int* plan = CTLW(c) + CW_PLAN + l * 256; const int* EID = WSI(O_EID); int* fill = CTLW(c) + CW_FILL + l * 64; int* DEST = WSI(O_DEST); int* SRC = WSI(O_XS);
    int* pstart = (int*)ldsf;
    if (threadIdx.x == 0) { int ps = 0, nb = 0; const bool pub = blockIdx.x == 0;
        for (int e = 0; e < NE; ++e) { pstart[e] = ps; if (pub) plan[e] = ps; const int nblk = (cnt[e] + 255) / 256; if (pub) for (int q = 0; q < nblk; ++q) plan[64 + nb + q] = e; nb += nblk; ps += nblk * 256; }
        if (pub) { plan[32] = ps; plan[40] = nb; } }
    SYNCTHREADS();
    for (long i = GT_; i < (long)T * 2; i += GS_) { const int e = EID[i]; const int pos = atomic_add_i(fill + e, 1); DEST[i] = pstart[e] + pos; SRC[pstart[e] + pos] = (int)(i >> 1); }
    SYNCTHREADS();
}
__device__ __forceinline__ void ph_moe_gather(const Ctx& c) {
    const int* DEST = WSI(O_DEST); const u32x4* H = (const u32x4*)WSH(O_H); u32x4* XS = (u32x4*)WSH(O_XS);
    const long N = (long)T * 2 * (D / 8);
    for (long i0 = GT_; i0 < N; i0 += 4 * GS_) {
        u32x4 v[4]; int d[4];
#pragma unroll
        for (int r = 0; r < 4; ++r) { const long i = i0 + r * GS_ < N ? i0 + r * GS_ : i0; const long a = i / (D / 8); d[r] = DEST[a]; v[r] = H[(size_t)(a >> 1) * (D / 8) + (int)(i % (D / 8))]; }
#pragma unroll
        for (int r = 0; r < 4; ++r) { const long i = i0 + r * GS_ < N ? i0 + r * GS_ : i0; XS[(size_t)d[r] * (D / 8) + (int)(i % (D / 8))] = v[r]; }
    }
}
#ifndef CPU_EMU
#define XB_TMO      128
#define XB_XCNT(j)  (256  + 64 * (j))
#define XB_XSUB(j)  (1280 + 64 * (j))
#define XB_XGEN(j)  (2304 + 64 * (j))
#define XB_TOP      3328
#define XB_TOPGEN   3392
#define XCD_BAR_WORDS 3456
#define XB_SPIN_CAP (1u << 26)
#define LAS __attribute__((address_space(3)))
__device__ __forceinline__ unsigned xb_ld(unsigned* p)              { return __hip_atomic_load(p, __ATOMIC_RELAXED, __HIP_MEMORY_SCOPE_AGENT); }
__device__ __forceinline__ unsigned xb_add(unsigned* p, unsigned v) { return __hip_atomic_fetch_add(p, v, __ATOMIC_RELAXED, __HIP_MEMORY_SCOPE_AGENT); }
__device__ __forceinline__ unsigned xb_xcc_id() { return (unsigned)__builtin_amdgcn_s_getreg((3 << 11) | 20) & 0xFu; }
#define XB_SPIN(cond, bar) do { unsigned _sp = 0; while (cond) { __builtin_amdgcn_s_sleep(1); \
    if ((++_sp & 255u) == 0u) { if (xb_ld(&(bar)[XB_TMO])) break; if (_sp > XB_SPIN_CAP) { atomicAdd(&(bar)[XB_TMO], 1u); break; } } } } while (0)
struct XcdBarrier { unsigned* bar; unsigned x; volatile LAS unsigned* st; };
__device__ __forceinline__ XcdBarrier xcd_barrier_post(unsigned* bar, volatile LAS unsigned* st) {
    XcdBarrier b; b.bar = bar; b.x = xb_xcc_id(); b.st = st;
    if (threadIdx.x == 0) (void)xb_add(&bar[XB_XCNT(b.x)], 1u);
    return b;
}
__device__ __forceinline__ void xcd_barrier_complete(unsigned* bar, unsigned x, unsigned& nloc, unsigned& nx) {
    const unsigned G = gridDim.x * gridDim.y * gridDim.z;
    unsigned sum, cnt, mine, sp = 0u;
    for (;;) {
        sum = 0u; cnt = 0u; mine = 0u;
#pragma unroll
        for (unsigned j = 0; j < 16; ++j) { const unsigned cc = xb_ld(&bar[XB_XCNT(j)]); sum += cc; cnt += (cc > 0u) ? 1u : 0u; mine = (j == x) ? cc : mine; }
        if (sum == G) break;
        __builtin_amdgcn_s_sleep(1);
        if ((++sp & 255u) == 0u) { if (xb_ld(&bar[XB_TMO])) break; if (sp > XB_SPIN_CAP) { atomicAdd(&bar[XB_TMO], 1u); break; } }
    }
    nloc = mine > 0u ? mine : 1u; nx = cnt > 0u ? cnt : 1u;
}
__device__ __forceinline__ void xcd_barrier(const XcdBarrier& b) {
    asm volatile("s_waitcnt vmcnt(0)" ::: "memory");
    __syncthreads();
    if (threadIdx.x == 0) {
        unsigned* bar = b.bar;
        __builtin_amdgcn_s_waitcnt(0);
        unsigned nloc = b.st[0], nx = b.st[1];
        if (nloc == 0u) { xcd_barrier_complete(bar, b.x, nloc, nx); b.st[0] = nloc; b.st[1] = nx; }
        const unsigned old = xb_add(&bar[XB_XSUB(b.x)], 1u);
        const unsigned gen = old / nloc;
        if (old + 1u == (gen + 1u) * nloc) {
            __builtin_amdgcn_fence(__ATOMIC_RELEASE, "agent");
            asm volatile("s_waitcnt vmcnt(0)" ::: "memory");
            const unsigned og = xb_add(&bar[XB_TOP], 1u);
            const unsigned tg = og / nx;
            if (og + 1u == (tg + 1u) * nx) xb_add(&bar[XB_TOPGEN], 1u);
            else XB_SPIN(xb_ld(&bar[XB_TOPGEN]) == tg, bar);
            __builtin_amdgcn_fence(__ATOMIC_ACQUIRE, "agent");
            xb_add(&bar[XB_XGEN(b.x)], 1u);
            asm volatile("s_waitcnt vmcnt(0)" ::: "memory");
        } else {
            XB_SPIN(xb_ld(&bar[XB_XGEN(b.x)]) == gen, bar);
            __builtin_amdgcn_fence(__ATOMIC_ACQUIRE, "agent");
            asm volatile("s_waitcnt vmcnt(0)" ::: "memory");
        }
    }
    __syncthreads();
}
#endif

constexpr int LDS_BYTES = 147456;

__global__ void __launch_bounds__(NT, 2) fwd(Params p) {
#ifdef CPU_EMU
    unsigned char* lds = g_lds; float* ldsf = (float*)g_lds;
#else
    extern __shared__ __attribute__((aligned(16))) unsigned char lds[];
    float* ldsf = (float*)lds;
    volatile LAS unsigned* misc = (volatile LAS unsigned*)((LAS unsigned char*)lds + LDS_BYTES - 64);
    if (threadIdx.x == 0) { misc[0] = 0u; misc[1] = 0u; }
    __syncthreads();
    XcdBarrier bar = xcd_barrier_post((unsigned*)(p.ws + O_CTL) + CW_BAR, misc);
#endif
    Ctx c; c.in = p.in; c.out = p.out; c.ws = p.ws;
    const int lo = p.ph_lo, hi = p.ph_hi; int ph = 0;
    const int G = (int)gridDim.x, cwg = (int)blockIdx.x;
#ifdef CPU_EMU
#define GRID_BAR()
#else
#define GRID_BAR() xcd_barrier(bar)
#endif
#ifndef REPEAT_MASK
#define REPEAT_MASK 0
#endif
#ifndef TIME_PHASE
#define TIME_PHASE -1
#endif
#if TIME_PHASE >= 0 && !defined(CPU_EMU)
    unsigned long long tp0 = 0, tp1 = 0;
#define TP_BEGIN() do { if (ph == TIME_PHASE) tp0 = __builtin_amdgcn_s_memrealtime(); } while (0)
#define TP_END() do { if (ph == TIME_PHASE) tp1 = __builtin_amdgcn_s_memrealtime(); } while (0)
#else
#define TP_BEGIN()
#define TP_END()
#endif
#define PHASE(...) do { if (lo <= ph && ph < hi) { TP_BEGIN(); __VA_ARGS__; if (ph + 1 < hi) { GRID_BAR(); } TP_END(); } ++ph; } while (0)
#define PHASEG(grp, ...) do { if (lo <= ph && ph < hi) { TP_BEGIN(); if ((REPEAT_MASK >> (grp)) & 1) { __VA_ARGS__; GRID_BAR(); } __VA_ARGS__; if (ph + 1 < hi) { GRID_BAR(); } TP_END(); } ++ph; } while (0)
    PHASE(ph_mod(c, ldsf); ph_rope_table(c); ph_convert(c, 0, ldsf));
#define LAYER_BODY(l) do { const float* mod = WSF(O_MOD); \
        const float* xin = l == 0 ? c.in[0] : WSF(O_X1); float* xmid = WSF(O_X0); float* xout = WSF(O_X1); \
        const float* ml = mod + (size_t)l * NB * D6; \
        PHASEG(0, { pg8::Gemm g{D, D, D}; pg8::StaticOrder so; so.init(T, PW, G, cwg, WSH(O_H), WSH(O_WIN), D, D); pg8::EpiP E{WSH(O_P), (unsigned char*)(c.ws + O_G8), WSF(O_HF) + (size_t)T * 32}; pg8::gemm_phase(lds, g, so, E); \
            { const int nun_ = (T / 256) * (PW / 256), rem_ = nun_ % G; if (rem_ != 0 && cwg >= rem_) { SYNCTHREADS(); convert_big(c, l, ldsf, J_ALL - convert_tail_tiles(), J_ALL, cwg - rem_, G - rem_); } } }); \
        PHASE(ph_lru<1>(c, l, ldsf); ph_ret_kv(c, ldsf); ph_rw_shift(c, l)); \
        PHASE(ph_lru_scan2(c); ph_ret_state(c); ph_sgu_mix(c, l, ldsf); ph_rw_lora(c, l, ldsf)); \
        PHASE(ph_lru_fin(c, ldsf); ph_ret_out(c, ldsf); ph_rw_chunk(c, l, ldsf)); \
        PHASE(ph_rw_seq(c, ldsf)); \
        PHASE(ph_rw_out(c)); \
        PHASEG(1, { pg8::Gemm g{4 * W, 4 * W, 4 * W}; pg8::StaticOrder so; so.init(T, D, G, cwg, WSH(O_YS), WSH(O_WBR), 4 * W, 4 * W); pg8::EpiMerge E{(const unsigned char*)(c.ws + O_G8), WSH(O_MRG)}; pg8::gemm_phase(lds, g, so, E); }); \
        PHASEG(1, { pg8::Gemm g{D, D, D}; pg8::StaticOrder so; so.init(T, D, G, cwg, WSH(O_MRG), WSH(O_WOUT), D, D); pg8::EpiResid E{xin, ml + 2 * D, xmid, WSF(O_HF)}; pg8::gemm_phase(lds, g, so, E); }); \
        PHASE(ph_router(c, l, ldsf, xmid, c.in[4] + (size_t)l * D, ml + 3 * D, ml + 4 * D)); \
        PHASE(ph_moe_assign(c, l, ldsf)); \
        const int* plan = CTLW(c) + CW_PLAN + l * 256; \
        PHASEG(2, { pg8::Gemm g{D, D, D}; pg8::MoeGatherOrder mo{G, cwg, 4, plan, (const char*)WSH(O_H), (const char*)WSH(O_WGU), (size_t)256 * D * 2, (size_t)1024 * D * 2, WSI(O_XS), T}; pg8::EpiGU E{WSH(O_ACT)}; pg8::gemm_phase(lds, g, mo, E); \
            if (l == 0) { const int nrest_ = plan[40] * 4 - G; if (nrest_ >= 0 && nrest_ < G && cwg >= nrest_) { SYNCTHREADS(); convert_big(c, 1, ldsf, 0, convert_early_tiles(c), cwg - nrest_, G - nrest_); } } }); \
        PHASEG(2, { pg8::Gemm g{512, 512, 512}; pg8::MoeOrder mo{G, cwg, 8, plan, (const char*)WSH(O_ACT), (const char*)WSH(O_WDN), (size_t)256 * 512 * 2, (size_t)256 * 512 * 2, (size_t)D * 512 * 2}; pg8::EpiBf16 E{WSH(O_YE), D}; pg8::gemm_phase(lds, g, mo, E); }); \
        if (l == 0) PHASE(ph_comb_norm<0>(c, xmid, ml + 5 * D, xout, c.in[3] + (size_t)1 * D, mod + (size_t)1 * NB * D6 + 0 * D, mod + (size_t)1 * NB * D6 + 1 * D, WSH(O_H), nullptr); ph_convert(c, 1, ldsf)); \
        else PHASE(ph_comb_norm<1>(c, xmid, ml + 5 * D, xout, c.in[36], nullptr, nullptr, nullptr, c.out)); \
    } while (0)
    PHASE(ph_norm(c, c.in[0], c.in[3], WSF(O_MOD) + 0 * D, WSF(O_MOD) + 1 * D, WSH(O_H), nullptr));
    LAYER_BODY(0);
    LAYER_BODY(1);
#undef LAYER_BODY
#if TIME_PHASE >= 0 && !defined(CPU_EMU)
    if (blockIdx.x == 0) { const unsigned long long te = __builtin_amdgcn_s_memrealtime(), dl = 8ull * (tp1 - tp0); while (__builtin_amdgcn_s_memrealtime() - te < dl) __builtin_amdgcn_s_sleep(8); }
#endif
#undef PHASE
}
}

#ifndef CPU_EMU
extern "C" void kernel_launch(void* const* d_in, const int* in_sizes, int n_in, void* d_out, int out_size, void* d_ws, size_t ws_size, hipStream_t stream) {
    static int grid = 0;
    if (grid == 0) {
        if (n_in != 37 || out_size != T * D || ws_size < WS_END) { fprintf(stderr, "kernel_launch: unexpected shapes (n_in %d out %d ws %zu need %zu)\n", n_in, out_size, ws_size, (size_t)WS_END); grid = -1; return; }
        int dev = 0, cus = 0, per_cu = 0;
        if (hipGetDevice(&dev) != hipSuccess || hipDeviceGetAttribute(&cus, hipDeviceAttributeMultiprocessorCount, dev) != hipSuccess) { grid = -1; return; }
        if (hipFuncSetAttribute((const void*)fwd, hipFuncAttributeMaxDynamicSharedMemorySize, LDS_BYTES) != hipSuccess) { fprintf(stderr, "kernel_launch: hipFuncSetAttribute failed\n"); grid = -1; return; }
        if (hipOccupancyMaxActiveBlocksPerMultiprocessor(&per_cu, (const void*)fwd, NT, LDS_BYTES) != hipSuccess || per_cu < 1) fprintf(stderr, "kernel_launch: occupancy query says %d\n", per_cu);
        (void)hipGetLastError();
        grid = cus;
    }
    if (grid < 0) return;
    (void)in_sizes;
    (void)hipMemsetAsync((char*)d_ws + O_CTL, 0, CTL_BYTES, stream);
    Params p{};
    for (int i = 0; i < 37; ++i) p.in[i] = (const float*)d_in[i];
    p.out = (float*)d_out; p.ws = (unsigned char*)d_ws;
#if ONE_LAUNCH
    p.ph_lo = 0; p.ph_hi = NPH;
    hipLaunchKernelGGL(fwd, dim3(grid), dim3(NT), LDS_BYTES, stream, p);
#else
    for (int k = 0; k < NPH; ++k) { p.ph_lo = k; p.ph_hi = k + 1; hipLaunchKernelGGL(fwd, dim3(grid), dim3(NT), LDS_BYTES, stream, p); }
#endif
}
#endif
```
